# Optimizing an MI355X kernel written in HIP

```python
import jax, jax.numpy as jnp
from jax import lax
import numpy as np

D_MODEL = 1024
BATCH = 4
SEQ = 4096
DEPTH = 2

N_MIXERS = 2
EPS = 1e-6
ROPE_THETA = 500000.0
GM_CHUNK = 128
GM_WIDTH = 2 * D_MODEL
GM_GROUPS = 8
GM_GROUP_DIM = GM_WIDTH // GM_GROUPS
N_HEADS = 8
HEAD_DIM = D_MODEL // N_HEADS
N_KV_HEADS = 2
ROT_DIM = HEAD_DIM // 4
IDX_HEADS = 8
IDX_DIM = 64
IDX_ROT_DIM = IDX_DIM // 4
TOPK_MAX = 256
Q_BLOCK = 128
B_IN_SIZES = (N_HEADS * HEAD_DIM, N_KV_HEADS * HEAD_DIM, N_KV_HEADS * HEAD_DIM,
              IDX_HEADS * IDX_DIM, IDX_DIM, IDX_HEADS)
B_IN_DIM = sum(B_IN_SIZES)
N_EXPERT_GROUPS = 4
EXPERTS_PER_GROUP = 8
N_EXPERTS = N_EXPERT_GROUPS * EXPERTS_PER_GROUP
EXPERT_TOP_K = 2
D_EXPERT = D_MODEL // 2
MOE_BLOCK = 128
PLE_DIM = 256
N_A_LAYERS = (DEPTH + 1) // 2
N_B_LAYERS = DEPTH // 2

kernel_name = 'hybrid_gmlp_dsa_hmoe'


def rmsnorm(x, g):
    xf = x.astype(jnp.float32)
    y = xf * lax.rsqrt(jnp.mean(xf * xf, axis=-1, keepdims=True) + EPS)
    return (y * g.astype(jnp.float32)).astype(x.dtype)


def rope_tables(positions, rot_dim):
    inv_freq = ROPE_THETA ** (-jnp.arange(0, rot_dim, 2, dtype=jnp.float32) / rot_dim)
    ang = positions.astype(jnp.float32)[..., None] * inv_freq
    return jnp.cos(ang)[:, :, None, :], jnp.sin(ang)[:, :, None, :]


def partial_rope(x, tables):
    cos, sin = tables
    half = cos.shape[-1]
    xf = x.astype(jnp.float32)
    x1, x2, rest = xf[..., :half], xf[..., half:2 * half], xf[..., 2 * half:]
    return jnp.concatenate([x1 * cos - x2 * sin, x2 * cos + x1 * sin, rest], axis=-1).astype(x.dtype)


def chunk_gmlp(h, w_in, v_gain, w_s, b_s, w_out):
    B, S, _ = h.shape
    nc = S // GM_CHUNK
    u, v = jnp.split(jax.nn.gelu(h @ w_in), 2, axis=-1)
    v = rmsnorm(v, v_gain).reshape(B, nc, GM_CHUNK, GM_GROUPS, GM_GROUP_DIM)
    causal = jnp.tril(jnp.ones((GM_CHUNK, GM_CHUNK), dtype=w_s.dtype))
    sv = jnp.einsum('gts,bcsgd->bctgd', w_s * causal, v) + b_s.T[:, :, None]
    return (u * sv.reshape(B, S, GM_WIDTH)) @ w_out


def dsa_attention(h, rope_q, rope_i, w_in, w_out):
    B, S, _ = h.shape
    k_top = min(TOPK_MAX, S // 4)
    split_at = [int(c) for c in np.cumsum(B_IN_SIZES)[:-1]]
    q, k, v, qi, ki, wi = jnp.split(h @ w_in, split_at, axis=-1)
    q = partial_rope(q.reshape(B, S, N_HEADS, HEAD_DIM), rope_q)
    k = partial_rope(k.reshape(B, S, N_KV_HEADS, HEAD_DIM), rope_q)
    v = v.reshape(B, S, N_KV_HEADS, HEAD_DIM)
    qi = partial_rope(qi.reshape(B, S, IDX_HEADS, IDX_DIM), rope_i)
    ki_f = partial_rope(ki.reshape(B, S, 1, IDX_DIM), rope_i)[:, :, 0].astype(jnp.float32)
    wi = wi.astype(jnp.float32) * (IDX_HEADS ** -0.5 * IDX_DIM ** -0.5)
    nb = S // Q_BLOCK
    scale = HEAD_DIM ** -0.5
    key_pos = jnp.arange(S)

    def to_blocks(a):
        return jnp.moveaxis(a.reshape(B, nb, Q_BLOCK, *a.shape[2:]), 1, 0)

    def one_block(args):
        qb, qib, wib, blk = args
        t = blk * Q_BLOCK + jnp.arange(Q_BLOCK)
        rel = jax.nn.relu(jnp.einsum('bthd,bsd->bths', qib.astype(jnp.float32), ki_f))
        score = jnp.einsum('bth,bths->bts', wib, rel)
        score = jnp.where((key_pos[None, :] <= t[:, None])[None], score, -jnp.inf)
        _, sel = lax.top_k(score, k_top)
        valid = sel <= t[None, :, None]
        k_sel = jax.vmap(lambda kk, ii: kk[ii])(k, sel)
        v_sel = jax.vmap(lambda vv, ii: vv[ii])(v, sel)
        qg = qb.reshape(B, Q_BLOCK, N_KV_HEADS, N_HEADS // N_KV_HEADS, HEAD_DIM)
        logits = jnp.einsum('btgrd,btkgd->btgrk', qg, k_sel).astype(jnp.float32) * scale
        logits = jnp.where(valid[:, :, None, None, :], logits, -jnp.inf)
        prob = jax.nn.softmax(logits, axis=-1).astype(v.dtype)
        o = jnp.einsum('btgrk,btkgd->btgrd', prob, v_sel)
        return o.reshape(B, Q_BLOCK, N_HEADS * HEAD_DIM)

    out = lax.map(one_block, (to_blocks(q), to_blocks(qi), to_blocks(wi), jnp.arange(nb)))
    out = jnp.moveaxis(out, 0, 1).reshape(B, S, N_HEADS * HEAD_DIM)
    return out @ w_out


def hier_moe(h, w_group, b_group, w_expert, b_expert, w1, w3, w2):
    B, S, D = h.shape
    T = B * S
    xs = h.reshape(T, D)
    g_logits = (xs @ w_group).astype(jnp.float32) + b_group
    g_sel = jnp.argmax(g_logits, axis=-1)
    p_group = jnp.take_along_axis(jax.nn.softmax(g_logits, axis=-1), g_sel[:, None], axis=1)[:, 0]
    e_logits = ((xs @ w_expert).astype(jnp.float32) + b_expert).reshape(T, N_EXPERT_GROUPS, EXPERTS_PER_GROUP)
    local = jnp.take_along_axis(e_logits, g_sel[:, None, None], axis=1)[:, 0]
    top_p, top_i = lax.top_k(jax.nn.softmax(local, axis=-1), EXPERT_TOP_K)
    gates = p_group[:, None] * top_p / jnp.sum(top_p, axis=-1, keepdims=True)
    e_flat = (g_sel[:, None] * EXPERTS_PER_GROUP + top_i).reshape(-1)
    g_flat = gates.reshape(-1)
    tok_flat = jnp.repeat(jnp.arange(T), EXPERT_TOP_K)
    A = T * EXPERT_TOP_K
    order = jnp.argsort(e_flat)
    e_sorted, tok_sorted, g_sorted = e_flat[order], tok_flat[order], g_flat[order]
    counts = jnp.bincount(e_flat, length=N_EXPERTS)
    padded = (counts + MOE_BLOCK - 1) // MOE_BLOCK * MOE_BLOCK
    padded_end = jnp.cumsum(padded)
    padded_start = padded_end - padded
    start = jnp.cumsum(counts) - counts
    dest = padded_start[e_sorted] + jnp.arange(A) - start[e_sorted]
    R = A + N_EXPERTS * MOE_BLOCK
    n_blocks = R // MOE_BLOCK
    buf_tok = jnp.full((R,), T, dtype=tok_sorted.dtype).at[dest].set(tok_sorted)
    x_pad = jnp.concatenate([xs, jnp.zeros((1, D), xs.dtype)], axis=0)
    buf_x = x_pad[buf_tok].reshape(n_blocks, MOE_BLOCK, D)
    block_expert = jnp.minimum(
        jnp.searchsorted(padded_end, jnp.arange(n_blocks) * MOE_BLOCK, side='right'), N_EXPERTS - 1)

    def expert_block(args):
        xb, e = args
        return (jax.nn.silu(xb @ w1[e]) * (xb @ w3[e])) @ w2[e]

    buf_y = lax.map(expert_block, (buf_x, block_expert)).reshape(R, D)
    y = buf_y[dest] * g_sorted[:, None].astype(buf_y.dtype)
    return jax.ops.segment_sum(y, tok_sorted, num_segments=T).reshape(B, S, D)


def setup_inputs(seed: int = 0) -> dict:
    key = jax.random.key(seed)
    ks = jax.random.split(key, 24)
    f32 = jnp.float32

    def normal(k, shape, fan_in):
        return jax.random.normal(k, shape, f32) * fan_in ** -0.5

    def gain(k, shape, s=0.05):
        return 1.0 + s * jax.random.normal(k, shape, f32)

    positions = (jax.random.randint(ks[2], (BATCH, 1), 0, 1024, dtype=jnp.int32)
                 + jnp.arange(SEQ, dtype=jnp.int32)[None, :])
    return {
        'x': jax.random.normal(ks[0], (BATCH, SEQ, D_MODEL), f32),
        'p': jax.random.normal(ks[1], (DEPTH, BATCH, SEQ, PLE_DIM), f32),
        'positions': positions,
        'mix_norm': gain(ks[3], (DEPTH, D_MODEL)),
        'a_w_in': normal(ks[4], (N_A_LAYERS, D_MODEL, 2 * GM_WIDTH), D_MODEL),
        'a_v_gain': gain(ks[5], (N_A_LAYERS, GM_WIDTH)),
        'a_w_s': normal(ks[6], (N_A_LAYERS, GM_GROUPS, GM_CHUNK, GM_CHUNK), GM_CHUNK),
        'a_b_s': gain(ks[7], (N_A_LAYERS, GM_GROUPS, GM_CHUNK), 0.1),
        'a_w_out': normal(ks[8], (N_A_LAYERS, GM_WIDTH, D_MODEL), GM_WIDTH),
        'b_w_in': normal(ks[9], (N_B_LAYERS, D_MODEL, B_IN_DIM), D_MODEL),
        'b_w_out': normal(ks[10], (N_B_LAYERS, N_HEADS * HEAD_DIM, D_MODEL), N_HEADS * HEAD_DIM),
        'ffn_norm': gain(ks[11], (DEPTH, D_MODEL)),
        'moe_w_group': normal(ks[12], (DEPTH, D_MODEL, N_EXPERT_GROUPS), D_MODEL),
        'moe_b_group': 0.01 * jax.random.normal(ks[13], (DEPTH, N_EXPERT_GROUPS), f32),
        'moe_w_expert': normal(ks[14], (DEPTH, D_MODEL, N_EXPERTS), D_MODEL),
        'moe_b_expert': 0.01 * jax.random.normal(ks[15], (DEPTH, N_EXPERTS), f32),
        'moe_w1': normal(ks[16], (DEPTH, N_EXPERTS, D_MODEL, D_EXPERT), D_MODEL),
        'moe_w3': normal(ks[17], (DEPTH, N_EXPERTS, D_MODEL, D_EXPERT), D_MODEL),
        'moe_w2': normal(ks[18], (DEPTH, N_EXPERTS, D_EXPERT, D_MODEL), D_EXPERT),
        'ple_norm': gain(ks[19], (DEPTH, D_MODEL)),
        'ple_w_gate': normal(ks[20], (DEPTH, D_MODEL, D_MODEL), D_MODEL),
        'ple_w_proj': normal(ks[21], (DEPTH, PLE_DIM, D_MODEL), PLE_DIM),
        'final_norm': gain(ks[22], (D_MODEL,)),
    }


def reference(x, p, positions, mix_norm, a_w_in, a_v_gain, a_w_s, a_b_s, a_w_out, b_w_in, b_w_out,
              ffn_norm, moe_w_group, moe_b_group, moe_w_expert, moe_b_expert, moe_w1, moe_w3, moe_w2,
              ple_norm, ple_w_gate, ple_w_proj, final_norm):
    rope_q = rope_tables(positions, ROT_DIM)
    rope_i = rope_tables(positions, IDX_ROT_DIM)
    h = x
    for i in range(DEPTH):
        hn = rmsnorm(h, mix_norm[i])
        j = i // N_MIXERS
        if i % N_MIXERS == 0:
            h = h + chunk_gmlp(hn, a_w_in[j], a_v_gain[j], a_w_s[j], a_b_s[j], a_w_out[j])
        else:
            h = h + dsa_attention(hn, rope_q, rope_i, b_w_in[j], b_w_out[j])
        h = h + hier_moe(rmsnorm(h, ffn_norm[i]), moe_w_group[i], moe_b_group[i], moe_w_expert[i],
                         moe_b_expert[i], moe_w1[i], moe_w3[i], moe_w2[i])
        gate = jax.nn.sigmoid(rmsnorm(h, ple_norm[i]) @ ple_w_gate[i])
        h = h + gate * (p[i] @ ple_w_proj[i])
    return rmsnorm(h, final_norm)
```

```cpp
#include <hip/hip_runtime.h>
#include <stdint.h>
#include <stdio.h>

#ifndef MK_LAST_PHASE
#define MK_LAST_PHASE 20
#endif
#ifndef MK_ONE_LAUNCH
#define MK_ONE_LAUNCH 1
#endif

#define LAS __attribute__((address_space(3)))
typedef unsigned short bf16_t;
typedef short bf16x8 __attribute__((ext_vector_type(8)));
typedef float f32x4 __attribute__((ext_vector_type(4)));
typedef float f32x2 __attribute__((ext_vector_type(2)));
typedef float f32x16 __attribute__((ext_vector_type(16)));
typedef unsigned u32x4 __attribute__((ext_vector_type(4)));
typedef unsigned u32x2 __attribute__((ext_vector_type(2)));

constexpr int T = 16384, D = 1024, SEQ = 4096;
constexpr int GW = 2048;
constexpr int BIN = 2120, BINP = 2176;
constexpr int NE = 32, DE = 512;
constexpr int PLE = 256;
constexpr float EPS = 1e-6f;
constexpr int NTH = 256;
constexpr int LDS_MAIN = 65536;
constexpr int LDS_BYTES = LDS_MAIN + 1024;
constexpr int RPAD = 32768 + NE * 128;

constexpr size_t MB = 1024 * 1024;
constexpr size_t WS_CTL = 0;
constexpr size_t WS_CNT = 16384;
constexpr size_t WS_WR = 32768;
constexpr size_t WS_WAIN = 1 * MB;
constexpr size_t WS_WAOUT = WS_WAIN + 8 * MB;
constexpr size_t WS_WBIN = WS_WAOUT + 4 * MB;
constexpr size_t WS_WBOUT = WS_WBIN + 5 * MB;
constexpr size_t WS_WGATE = WS_WBOUT + 2 * MB;
constexpr size_t WS_WPROJ = WS_WGATE + 4 * MB;
constexpr size_t WS_W1 = WS_WPROJ + 1 * MB;
constexpr size_t WS_W3 = WS_W1 + 32 * MB;
constexpr size_t WS_W2 = WS_W3 + 32 * MB;
constexpr size_t WS_PBF = WS_W2 + 32 * MB;
constexpr size_t WS_XN = WS_PBF + 16 * MB;
constexpr size_t WS_H = WS_XN + 32 * MB;
constexpr size_t WS_LIST = WS_H + 64 * MB;
constexpr size_t WS_GATE = WS_LIST + 2 * MB;
constexpr size_t WS_TOKSLOT = WS_GATE + 2 * MB;
constexpr size_t WS_SCR = WS_TOKSLOT + 1 * MB;
constexpr size_t WS_U = WS_SCR;
constexpr size_t WS_VT = WS_SCR + 64 * MB;
constexpr size_t WS_VSS = WS_SCR + 128 * MB;
constexpr size_t WS_HMID = WS_SCR;
constexpr size_t WS_Y = WS_SCR + 36 * MB;
constexpr size_t WS_RAW = WS_SCR;
constexpr size_t WS_O = WS_SCR;
constexpr size_t WS_Q = WS_SCR + 68 * MB;
constexpr size_t WS_K = WS_Q + 32 * MB;
constexpr size_t WS_V = WS_K + 8 * MB;
constexpr size_t WS_QI = WS_V + 8 * MB;
constexpr size_t WS_KI = WS_QI + 16 * MB;
constexpr size_t WS_WI = WS_KI + 2 * MB;
constexpr size_t WS_SEL = WS_WI + 1 * MB;
constexpr size_t WS_END = WS_SEL + 16 * MB;
static_assert(WS_END <= WS_SCR + 152 * MB, "scratch");
constexpr size_t WS_TOTAL = WS_SCR + 152 * MB;

typedef __bf16 bf16x2_t __attribute__((ext_vector_type(2)));
__device__ __forceinline__ unsigned pk_bf16(float lo, float hi) { f32x2 v = {lo, hi}; bf16x2_t b = __builtin_convertvector(v, bf16x2_t); return __builtin_bit_cast(unsigned, b); }
__device__ __forceinline__ float bf_lo(unsigned u) { return __uint_as_float(u << 16); }
__device__ __forceinline__ float bf_hi(unsigned u) { return __uint_as_float(u & 0xffff0000u); }
__device__ __forceinline__ float wave_sum(float v) {
#pragma unroll
    for (int o = 1; o < 64; o <<= 1) v += __shfl_xor(v, o);
    return v;
}
__device__ __forceinline__ int lds_inc(LAS int* p) { return __hip_atomic_fetch_add(p, 1, __ATOMIC_RELAXED, __HIP_MEMORY_SCOPE_WORKGROUP); }
#define LDS_WAIT() asm volatile("s_waitcnt lgkmcnt(0)" ::: "memory")
#define VM_WAIT() asm volatile("s_waitcnt vmcnt(0)" ::: "memory")

#define XB_TMO      128
#define XB_XCNT(j)  (256  + 64 * (j))
#define XB_XSUB(j)  (1280 + 64 * (j))
#define XB_XGEN(j)  (2304 + 64 * (j))
#define XB_TOP      3328
#define XB_TOPGEN   3392
#define XCD_BAR_WORDS 3456
#define XB_SPIN_CAP (1u << 20)
__device__ __forceinline__ unsigned xb_ld(unsigned* p)              { return __hip_atomic_load(p, __ATOMIC_RELAXED, __HIP_MEMORY_SCOPE_AGENT); }
__device__ __forceinline__ unsigned xb_add(unsigned* p, unsigned v) { return __hip_atomic_fetch_add(p, v, __ATOMIC_RELAXED, __HIP_MEMORY_SCOPE_AGENT); }
__device__ __forceinline__ unsigned xb_xcc_id() { return (unsigned)__builtin_amdgcn_s_getreg((3 << 11) | 20) & 0xFu; }
#define XB_SPIN(cond, bar) do { unsigned _sp = 0; while (cond) { __builtin_amdgcn_s_sleep(1); \
    if ((++_sp & 255u) == 0u) { if (xb_ld(&(bar)[XB_TMO])) break; if (_sp > XB_SPIN_CAP) { atomicAdd(&(bar)[XB_TMO], 1u); break; } } } } while (0)
struct XcdBarrier { unsigned* bar; unsigned x; volatile LAS unsigned* st; };
__device__ __forceinline__ XcdBarrier xcd_barrier_post(unsigned* bar, volatile LAS unsigned* st) {
    XcdBarrier b; b.bar = bar; b.x = xb_xcc_id(); b.st = st;
    if (threadIdx.x == 0) (void)xb_add(&bar[XB_XCNT(b.x)], 1u);
    return b;
}
__device__ __forceinline__ void xcd_barrier_complete(unsigned* bar, unsigned x, unsigned& nloc, unsigned& nx) {
    const unsigned G = gridDim.x;
    unsigned sum, cnt, mine, sp = 0u;
    for (;;) {
        sum = 0u; cnt = 0u; mine = 0u;
#pragma unroll
        for (unsigned j = 0; j < 16; ++j) { const unsigned c = xb_ld(&bar[XB_XCNT(j)]); sum += c; cnt += (c > 0u) ? 1u : 0u; mine = (j == x) ? c : mine; }
        if (sum == G) break;
        __builtin_amdgcn_s_sleep(1);
        if ((++sp & 255u) == 0u) { if (xb_ld(&bar[XB_TMO])) break; if (sp > XB_SPIN_CAP) { atomicAdd(&bar[XB_TMO], 1u); break; } }
    }
    nloc = mine > 0u ? mine : 1u; nx = cnt > 0u ? cnt : 1u;
}
__device__ __forceinline__ void xcd_barrier(const XcdBarrier& b) {
    asm volatile("s_waitcnt vmcnt(0)" ::: "memory");
    __syncthreads();
    if (threadIdx.x == 0) {
        unsigned* bar = b.bar;
        __builtin_amdgcn_s_waitcnt(0);
        unsigned nloc = b.st[0], nx = b.st[1];
        if (nloc == 0u) { xcd_barrier_complete(bar, b.x, nloc, nx); b.st[0] = nloc; b.st[1] = nx; }
        const unsigned old = xb_add(&bar[XB_XSUB(b.x)], 1u);
        const unsigned gen = old / nloc;
        if (old + 1u == (gen + 1u) * nloc) {
            __builtin_amdgcn_fence(__ATOMIC_RELEASE, "agent");
            asm volatile("s_waitcnt vmcnt(0)" ::: "memory");
            const unsigned og = xb_add(&bar[XB_TOP], 1u);
            const unsigned tg = og / nx;
            if (og + 1u == (tg + 1u) * nx) xb_add(&bar[XB_TOPGEN], 1u);
            else XB_SPIN(xb_ld(&bar[XB_TOPGEN]) == tg, bar);
            __builtin_amdgcn_fence(__ATOMIC_ACQUIRE, "agent");
            xb_add(&bar[XB_XGEN(b.x)], 1u);
            asm volatile("s_waitcnt vmcnt(0)" ::: "memory");
        } else {
            XB_SPIN(xb_ld(&bar[XB_XGEN(b.x)]) == gen, bar);
            __builtin_amdgcn_fence(__ATOMIC_ACQUIRE, "agent");
            asm volatile("s_waitcnt vmcnt(0)" ::: "memory");
        }
    }
    __syncthreads();
}

struct Args { const void* in[23]; float* out; unsigned char* ws; int ph_lo, ph_hi; };
enum { IN_X = 0, IN_P, IN_POS, IN_MIXN, IN_AWIN, IN_AVG, IN_AWS, IN_ABS, IN_AWOUT, IN_BWIN, IN_BWOUT, IN_FFNN, IN_WG, IN_BG, IN_WE, IN_BE,
       IN_W1, IN_W3, IN_W2, IN_PLEN, IN_PLEG, IN_PLEP, IN_FINN };

struct Ctx {
    LAS unsigned char* lds;
    int tid, lane, wave, vb, nb;
    const __attribute__((address_space(4))) Args* a;
    unsigned char* ws;
};

template <int BK> struct TileK { static constexpr int NP = (BK == 64) ? 4 : 2; static constexpr int TB = 128 * BK * 2; };

template <int BK>
__device__ __forceinline__ void stage_tile(LAS unsigned char* tile, const bf16_t* const (&rp)[TileK<BK>::NP], int k0, int tid) {
    const int lc = (BK == 64) ? ((tid & 7) ^ ((tid >> 3) & 7)) : ((tid & 3) ^ ((tid >> 3) & 3));
#pragma unroll
    for (int p = 0; p < TileK<BK>::NP; ++p)
        __builtin_amdgcn_global_load_lds((const unsigned*)(rp[p] + k0 + lc * 8), (LAS unsigned*)(tile + p * 4096 + tid * 16), 16, 0, 0);
}
template <int BK>
__device__ __forceinline__ void rows_regular(const bf16_t* (&rp)[TileK<BK>::NP], const bf16_t* base, size_t ld, int tid) {
#pragma unroll
    for (int p = 0; p < TileK<BK>::NP; ++p) { const int r = (BK == 64) ? (p * 32 + (tid >> 3)) : (p * 64 + (tid >> 2)); rp[p] = base + (size_t)r * ld; }
}
template <int BK>
__device__ __forceinline__ int frag_off(int row, int ks, int fq) {
    return (BK == 64) ? (row * 128 + (((ks * 4 + fq) ^ (row & 7)) << 4)) : (row * 64 + ((fq ^ ((row >> 1) & 3)) << 4));
}

template <int BK, int NBOP, bool SWAP>
__device__ __forceinline__ void gemm_loop(const Ctx& c, const bf16_t* const (&ap)[TileK<BK>::NP], const bf16_t* const (&b0p)[TileK<BK>::NP], const bf16_t* const (&b1p)[TileK<BK>::NP],
                                          int K, f32x4 (&acc0)[4][4], f32x4 (&acc1)[4][4]) {
    constexpr int TB = TileK<BK>::TB, SB = (1 + NBOP) * TB;
    static_assert(2 * SB <= LDS_MAIN, "lds");
    const int nk = K / BK, tid = c.tid;
    const int fr = c.lane & 15, fq = c.lane >> 4, wr = c.wave >> 1, wc = c.wave & 1;
    LAS unsigned char* lds = c.lds;
    stage_tile<BK>(lds, ap, 0, tid); stage_tile<BK>(lds + TB, b0p, 0, tid);
    if (NBOP == 2) stage_tile<BK>(lds + 2 * TB, b1p, 0, tid);
    for (int kt = 0; kt < nk; ++kt) {
        VM_WAIT();
        __syncthreads();
        LAS unsigned char* cur = lds + (kt & 1) * SB;
        if (kt + 1 < nk) {
            LAS unsigned char* nxt = lds + ((kt + 1) & 1) * SB;
            stage_tile<BK>(nxt, ap, (kt + 1) * BK, tid); stage_tile<BK>(nxt + TB, b0p, (kt + 1) * BK, tid);
            if (NBOP == 2) stage_tile<BK>(nxt + 2 * TB, b1p, (kt + 1) * BK, tid);
        }
#pragma unroll
        for (int ks = 0; ks < BK / 32; ++ks) {
            bf16x8 af[4], bf0[4], bf1[4];
#pragma unroll
            for (int m = 0; m < 4; ++m) af[m] = *(const LAS bf16x8*)(cur + frag_off<BK>(wr * 64 + m * 16 + fr, ks, fq));
#pragma unroll
            for (int n = 0; n < 4; ++n) bf0[n] = *(const LAS bf16x8*)(cur + TB + frag_off<BK>(wc * 64 + n * 16 + fr, ks, fq));
            if (NBOP == 2) {
#pragma unroll
                for (int n = 0; n < 4; ++n) bf1[n] = *(const LAS bf16x8*)(cur + 2 * TB + frag_off<BK>(wc * 64 + n * 16 + fr, ks, fq));
            }
#pragma unroll
            for (int m = 0; m < 4; ++m)
#pragma unroll
                for (int n = 0; n < 4; ++n) {
                    if (SWAP) acc0[m][n] = __builtin_amdgcn_mfma_f32_16x16x32_bf16(bf0[n], af[m], acc0[m][n], 0, 0, 0);
                    else      acc0[m][n] = __builtin_amdgcn_mfma_f32_16x16x32_bf16(af[m], bf0[n], acc0[m][n], 0, 0, 0);
                    if (NBOP == 2) {
                        if (SWAP) acc1[m][n] = __builtin_amdgcn_mfma_f32_16x16x32_bf16(bf1[n], af[m], acc1[m][n], 0, 0, 0);
                        else      acc1[m][n] = __builtin_amdgcn_mfma_f32_16x16x32_bf16(af[m], bf1[n], acc1[m][n], 0, 0, 0);
                    }
                }
        }
    }
    __syncthreads();
}
__device__ __forceinline__ void zero_acc(f32x4 (&acc)[4][4]) {
#pragma unroll
    for (int m = 0; m < 4; ++m)
#pragma unroll
        for (int n = 0; n < 4; ++n) acc[m][n] = (f32x4){0.f, 0.f, 0.f, 0.f};
}
__device__ __forceinline__ void map_unit(int u, int nnt, int& mt, int& nt) { const int per = 8 * nnt, band = u / per, r = u - band * per; nt = r >> 3; mt = band * 8 + (r & 7); }


__device__ __forceinline__ float gelu_tanh(float x) {
    const float y2 = 1.5957691216057308f * (x + 0.044715f * x * x * x);
    return x / (1.f + __expf(-y2));
}
__device__ __forceinline__ float sigmoidf_(float x) { return 1.f / (1.f + __expf(-x)); }

__device__ __forceinline__ void row_load(const float* row, int lane, f32x4 (&v)[4]) {
#pragma unroll
    for (int j = 0; j < 4; ++j) v[j] = ((const f32x4*)row)[lane + 64 * j];
}
__device__ __forceinline__ float row_sumsq(const f32x4 (&v)[4]) {
    float s = 0.f;
#pragma unroll
    for (int j = 0; j < 4; ++j) s += (v[j].x * v[j].x + v[j].y * v[j].y) + (v[j].z * v[j].z + v[j].w * v[j].w);
    return wave_sum(s);
}
__device__ __forceinline__ void row_store_norm_bf16(bf16_t* orow, int lane, const f32x4 (&v)[4], float r, const float* gain) {
#pragma unroll
    for (int j = 0; j < 4; ++j) {
        const f32x4 g = ((const f32x4*)gain)[lane + 64 * j];
        u32x2 o; o.x = pk_bf16(v[j].x * r * g.x, v[j].y * r * g.y); o.y = pk_bf16(v[j].z * r * g.z, v[j].w * r * g.w);
        ((u32x2*)orow)[lane + 64 * j] = o;
    }
}

__device__ __forceinline__ void transpose_item(const float* W, int K, int N, int nvalid, int ldw, bf16_t* WT, LAS float* scr, int item, int lane) {
    const int nblk = N / 32, kb = item / nblk, nb = item - kb * nblk, k0 = 64 * kb, n0 = 32 * nb;
    const int n = n0 + (lane & 31);
#pragma unroll 8
    for (int i = 0; i < 32; ++i) { const int kk = 2 * i + (lane >> 5); scr[kk * 33 + (lane & 31)] = (n < nvalid) ? W[(size_t)(k0 + kk) * ldw + n] : 0.f; }
    LDS_WAIT();
    const int cc = lane & 7;
#pragma unroll
    for (int j = 0; j < 4; ++j) {
        const int nn = (lane >> 3) + 8 * j; const LAS float* s = scr + (8 * cc) * 33 + nn;
        u32x4 o; o.x = pk_bf16(s[0 * 33], s[1 * 33]); o.y = pk_bf16(s[2 * 33], s[3 * 33]); o.z = pk_bf16(s[4 * 33], s[5 * 33]); o.w = pk_bf16(s[6 * 33], s[7 * 33]);
        *(u32x4*)(WT + (size_t)(n0 + nn) * K + k0 + 8 * cc) = o;
    }
    LDS_WAIT();
}
__device__ __forceinline__ void convert_moe_layer(const Ctx& c, int l) {
    LAS float* scr = (LAS float*)(c.lds + c.wave * 8448);
    const int gw = c.vb * 4 + c.wave, ngw = c.nb * 4;
    const float* w1 = (const float*)c.a->in[IN_W1] + (size_t)l * NE * D * DE;
    const float* w3 = (const float*)c.a->in[IN_W3] + (size_t)l * NE * D * DE;
    const float* w2 = (const float*)c.a->in[IN_W2] + (size_t)l * NE * DE * D;
    bf16_t* W1 = (bf16_t*)(c.ws + WS_W1); bf16_t* W3 = (bf16_t*)(c.ws + WS_W3); bf16_t* W2 = (bf16_t*)(c.ws + WS_W2);
    for (int it = gw; it < NE * 768; it += ngw) {
        const int e = it / 768, r = it - e * 768;
        if (r < 256)      transpose_item(w1 + (size_t)e * D * DE, D, DE, DE, DE, W1 + (size_t)e * DE * D, scr, r, c.lane);
        else if (r < 512) transpose_item(w3 + (size_t)e * D * DE, D, DE, DE, DE, W3 + (size_t)e * DE * D, scr, r - 256, c.lane);
        else              transpose_item(w2 + (size_t)e * DE * D, DE, D, D, D, W2 + (size_t)e * D * DE, scr, r - 512, c.lane);
    }
}

__device__ __forceinline__ void phase_prep(const Ctx& c) {
    const __attribute__((address_space(4))) Args& a = *c.a;
    LAS float* scr = (LAS float*)(c.lds + c.wave * 8448);
    const int gw = c.vb * 4 + c.wave, ngw = c.nb * 4;
    constexpr int I_AIN = 16 * 128, I_AOUT = 32 * 32, I_BIN = 16 * 68, I_BOUT = 16 * 32, I_PG = 16 * 32, I_PP = 4 * 32;
    constexpr int NIT = I_AIN + I_AOUT + I_BIN + I_BOUT + 2 * I_PG + 2 * I_PP;
    for (int it = gw; it < NIT; it += ngw) {
        int r = it;
        if (r < I_AIN) { transpose_item((const float*)a.in[IN_AWIN], D, 4096, 4096, 4096, (bf16_t*)(c.ws + WS_WAIN), scr, r, c.lane); continue; } r -= I_AIN;
        if (r < I_AOUT) { transpose_item((const float*)a.in[IN_AWOUT], GW, D, D, D, (bf16_t*)(c.ws + WS_WAOUT), scr, r, c.lane); continue; } r -= I_AOUT;
        if (r < I_BIN) { transpose_item((const float*)a.in[IN_BWIN], D, BINP, BIN, BIN, (bf16_t*)(c.ws + WS_WBIN), scr, r, c.lane); continue; } r -= I_BIN;
        if (r < I_BOUT) { transpose_item((const float*)a.in[IN_BWOUT], D, D, D, D, (bf16_t*)(c.ws + WS_WBOUT), scr, r, c.lane); continue; } r -= I_BOUT;
        if (r < 2 * I_PG) { const int l = r / I_PG; transpose_item((const float*)a.in[IN_PLEG] + (size_t)l * D * D, D, D, D, D, (bf16_t*)(c.ws + WS_WGATE) + (size_t)l * D * D, scr, r - l * I_PG, c.lane); continue; } r -= 2 * I_PG;
        { const int l = r / I_PP; transpose_item((const float*)a.in[IN_PLEP] + (size_t)l * PLE * D, PLE, D, D, D, (bf16_t*)(c.ws + WS_WPROJ) + (size_t)l * D * PLE, scr, r - l * I_PP, c.lane); }
    }
    convert_moe_layer(c, 0);
    const int gt = c.vb * NTH + c.tid, ngt = c.nb * NTH;
    { const float* p = (const float*)a.in[IN_P]; bf16_t* pb = (bf16_t*)(c.ws + WS_PBF);
      for (int i = gt; i < 2 * T * PLE / 8; i += ngt) {
          const f32x4 v0 = ((const f32x4*)p)[2 * i], v1 = ((const f32x4*)p)[2 * i + 1];
          u32x4 o; o.x = pk_bf16(v0.x, v0.y); o.y = pk_bf16(v0.z, v0.w); o.z = pk_bf16(v1.x, v1.y); o.w = pk_bf16(v1.z, v1.w);
          ((u32x4*)pb)[i] = o; } }
    { float* wr = (float*)(c.ws + WS_WR);
      for (int i = gt; i < 2 * D * 48; i += ngt) {
          const int l = i / (D * 48), r = i - l * D * 48, k = r / 48, o = r - k * 48;
          float w = 0.f;
          if (o < 4) w = ((const float*)a.in[IN_WG])[(size_t)l * D * 4 + k * 4 + o];
          else if (o < 36) w = ((const float*)a.in[IN_WE])[(size_t)l * D * 32 + k * 32 + (o - 4)];
          wr[i] = w * ((const float*)a.in[IN_FFNN])[l * D + k]; } }
    if (c.vb == 0 && c.tid < 64) ((int*)(c.ws + WS_CNT))[c.tid] = 0;
    for (int t = gw; t < T; t += ngw) {
        f32x4 v[4]; row_load((const float*)a.in[IN_X] + (size_t)t * D, c.lane, v);
        const float r = rsqrtf(row_sumsq(v) * (1.f / D) + EPS);
        row_store_norm_bf16((bf16_t*)(c.ws + WS_XN) + (size_t)t * D, c.lane, v, r, (const float*)a.in[IN_MIXN]);
    }
}

__device__ __forceinline__ void phase_a1(const Ctx& c) {
    const bf16_t* XN = (const bf16_t*)(c.ws + WS_XN); const bf16_t* W = (const bf16_t*)(c.ws + WS_WAIN);
    bf16_t* U = (bf16_t*)(c.ws + WS_U); bf16_t* VT = (bf16_t*)(c.ws + WS_VT); float* VSS = (float*)(c.ws + WS_VSS);
    const int fr = c.lane & 15, fq = c.lane >> 4, wr = c.wave >> 1, wc = c.wave & 1;
    for (int u = c.vb; u < 128 * 32; u += c.nb) {
        int mt, nt; map_unit(u, 32, mt, nt);
        const bf16_t* ap[4]; const bf16_t* bp[4];
        rows_regular<64>(ap, XN + (size_t)mt * 128 * D, D, c.tid); rows_regular<64>(bp, W + (size_t)nt * 128 * D, D, c.tid);
        f32x4 acc[4][4]; zero_acc(acc);
        if (nt < 16) {
            gemm_loop<64, 1, true>(c, ap, bp, bp, D, acc, acc);
#pragma unroll
            for (int m = 0; m < 4; ++m)
#pragma unroll
                for (int n = 0; n < 4; ++n) {
                    const int t = mt * 128 + wr * 64 + m * 16 + fr, col = nt * 128 + wc * 64 + n * 16 + fq * 4;
                    const f32x4 v = acc[m][n];
                    u32x2 o; o.x = pk_bf16(gelu_tanh(v.x), gelu_tanh(v.y)); o.y = pk_bf16(gelu_tanh(v.z), gelu_tanh(v.w));
                    *(u32x2*)(U + (size_t)t * GW + col) = o;
                }
        } else {
            gemm_loop<64, 1, false>(c, ap, bp, bp, D, acc, acc);
            const int vn = nt - 16;
#pragma unroll
            for (int m = 0; m < 4; ++m) {
                f32x4 ss = {0.f, 0.f, 0.f, 0.f};
                const int t0 = mt * 128 + wr * 64 + m * 16 + fq * 4;
#pragma unroll
                for (int n = 0; n < 4; ++n) {
                    const int ch = vn * 128 + wc * 64 + n * 16 + fr;
                    f32x4 v = acc[m][n];
                    v.x = gelu_tanh(v.x); v.y = gelu_tanh(v.y); v.z = gelu_tanh(v.z); v.w = gelu_tanh(v.w);
                    ss += v * v;
                    u32x2 o; o.x = pk_bf16(v.x, v.y); o.y = pk_bf16(v.z, v.w);
                    *(u32x2*)(VT + (size_t)ch * T + t0) = o;
                }
#pragma unroll
                for (int o = 1; o < 16; o <<= 1) { ss.x += __shfl_xor(ss.x, o); ss.y += __shfl_xor(ss.y, o); ss.z += __shfl_xor(ss.z, o); ss.w += __shfl_xor(ss.w, o); }
                if (fr == 0) {
                    VSS[(size_t)(t0 + 0) * 32 + vn * 2 + wc] = ss.x; VSS[(size_t)(t0 + 1) * 32 + vn * 2 + wc] = ss.y;
                    VSS[(size_t)(t0 + 2) * 32 + vn * 2 + wc] = ss.z; VSS[(size_t)(t0 + 3) * 32 + vn * 2 + wc] = ss.w;
                }
            }
        }
    }
}

__device__ __forceinline__ void phase_a2(const Ctx& c) {
    const __attribute__((address_space(4))) Args& a = *c.a;
    bf16_t* U = (bf16_t*)(c.ws + WS_U); const bf16_t* VT = (const bf16_t*)(c.ws + WS_VT); const float* VSS = (const float*)(c.ws + WS_VSS);
    const float* ws_ = (const float*)a.in[IN_AWS]; const float* bs_ = (const float*)a.in[IN_ABS]; const float* vg = (const float*)a.in[IN_AVG];
    const int fr = c.lane & 15, fq = c.lane >> 4, wr = c.wave >> 1, wc = c.wave & 1, tid = c.tid;
    LAS unsigned char* lds = c.lds;
    LAS float* rl = (LAS float*)(lds + LDS_MAIN);
    for (int u = c.vb; u < 128 * 8; u += c.nb) {
        const int ci = u >> 3, g = u & 7, tokbase = ci * 128;
        __syncthreads();
        if (tid < 128) {
            const float* p = VSS + (size_t)(tokbase + tid) * 32; float s = 0.f;
#pragma unroll
            for (int i = 0; i < 8; ++i) { const f32x4 q = ((const f32x4*)p)[i]; s += (q.x + q.y) + (q.z + q.w); }
            rl[tid] = rsqrtf(s * (1.f / GW) + EPS);
        }
        __syncthreads();
        {
            const int t = tid >> 1, half = tid & 1;
            const float* wrow = ws_ + ((size_t)g * 128 + t) * 128 + half * 64;
#pragma unroll
            for (int cc = 0; cc < 8; ++cc) {
                const int s0 = half * 64 + cc * 8;
                u32x4 o = {0u, 0u, 0u, 0u};
                if (s0 <= t) {
                    const f32x4 w0 = ((const f32x4*)wrow)[2 * cc], w1 = ((const f32x4*)wrow)[2 * cc + 1];
                    float e[8] = {w0.x, w0.y, w0.z, w0.w, w1.x, w1.y, w1.z, w1.w};
#pragma unroll
                    for (int i = 0; i < 8; ++i) e[i] = (s0 + i <= t) ? e[i] * rl[s0 + i] : 0.f;
                    o.x = pk_bf16(e[0], e[1]); o.y = pk_bf16(e[2], e[3]); o.z = pk_bf16(e[4], e[5]); o.w = pk_bf16(e[6], e[7]);
                }
                *(LAS u32x4*)(lds + half * 16384 + t * 128 + ((cc ^ (t & 7)) << 4)) = o;
            }
        }
        for (int hn = 0; hn < 2; ++hn) {
            const int c0 = g * 256 + hn * 128;
            const bf16_t* bp[4]; rows_regular<64>(bp, VT + (size_t)c0 * T + tokbase, T, tid);
            stage_tile<64>(lds + 32768, bp, 0, tid); stage_tile<64>(lds + 32768 + 16384, bp, 64, tid);
            VM_WAIT();
            __syncthreads();
            f32x4 acc[4][4]; zero_acc(acc);
#pragma unroll 1
            for (int kh = 0; kh < 2; ++kh)
#pragma unroll 1
                for (int ks = 0; ks < 2; ++ks) {
                    bf16x8 af[4], bf[4];
#pragma unroll
                    for (int m = 0; m < 4; ++m) af[m] = *(const LAS bf16x8*)(lds + kh * 16384 + frag_off<64>(wr * 64 + m * 16 + fr, ks, fq));
#pragma unroll
                    for (int n = 0; n < 4; ++n) bf[n] = *(const LAS bf16x8*)(lds + 32768 + kh * 16384 + frag_off<64>(wc * 64 + n * 16 + fr, ks, fq));
#pragma unroll
                    for (int m = 0; m < 4; ++m)
#pragma unroll
                        for (int n = 0; n < 4; ++n) acc[m][n] = __builtin_amdgcn_mfma_f32_16x16x32_bf16(bf[n], af[m], acc[m][n], 0, 0, 0);
                }
#pragma unroll
            for (int m = 0; m < 4; ++m) {
                const int tl = wr * 64 + m * 16 + fr; const float bsv = bs_[g * 128 + tl];
#pragma unroll
                for (int n = 0; n < 4; ++n) {
                    const int ch = c0 + wc * 64 + n * 16 + fq * 4;
                    const f32x4 gn = *(const f32x4*)(vg + ch);
                    u32x2* up = (u32x2*)(U + (size_t)(tokbase + tl) * GW + ch);
                    const u32x2 uv = *up; const f32x4 v = acc[m][n];
                    u32x2 o;
                    o.x = pk_bf16(bf_lo(uv.x) * (gn.x * v.x + bsv), bf_hi(uv.x) * (gn.y * v.y + bsv));
                    o.y = pk_bf16(bf_lo(uv.y) * (gn.z * v.z + bsv), bf_hi(uv.y) * (gn.w * v.w + bsv));
                    *up = o;
                }
            }
            __syncthreads();
        }
    }
}

__device__ __forceinline__ void phase_a3(const Ctx& c) {
    const bf16_t* Z = (const bf16_t*)(c.ws + WS_U); const bf16_t* W = (const bf16_t*)(c.ws + WS_WAOUT);
    const float* X = (const float*)c.a->in[IN_X]; float* H = (float*)(c.ws + WS_H);
    const int fr = c.lane & 15, fq = c.lane >> 4, wr = c.wave >> 1, wc = c.wave & 1;
    for (int u = c.vb; u < 128 * 8; u += c.nb) {
        int mt, nt; map_unit(u, 8, mt, nt);
        const bf16_t* ap[4]; const bf16_t* bp[4];
        rows_regular<64>(ap, Z + (size_t)mt * 128 * GW, GW, c.tid); rows_regular<64>(bp, W + (size_t)nt * 128 * GW, GW, c.tid);
        f32x4 acc[4][4]; zero_acc(acc);
        gemm_loop<64, 1, true>(c, ap, bp, bp, GW, acc, acc);
#pragma unroll
        for (int m = 0; m < 4; ++m)
#pragma unroll
            for (int n = 0; n < 4; ++n) {
                const size_t off = (size_t)(mt * 128 + wr * 64 + m * 16 + fr) * D + nt * 128 + wc * 64 + n * 16 + fq * 4;
                *(f32x4*)(H + off) = *(const f32x4*)(X + off) + acc[m][n];
            }
    }
}

__device__ __forceinline__ void phase_route(const Ctx& c, int l) {
    const __attribute__((address_space(4))) Args& a = *c.a;
    const float* H = (const float*)(c.ws + WS_H); bf16_t* XN = (bf16_t*)(c.ws + WS_XN);
    const float* wr_ = (const float*)(c.ws + WS_WR) + (size_t)l * D * 48;
    const float* gain = (const float*)a.in[IN_FFNN] + l * D;
    int* cnt = (int*)(c.ws + WS_CNT) + l * 32; int* list = (int*)(c.ws + WS_LIST); float* gatel = (float*)(c.ws + WS_GATE); int* tokslot = (int*)(c.ws + WS_TOKSLOT);
    LAS float* rl = (LAS float*)(c.lds);
    LAS float* lgl = (LAS float*)(c.lds + 256);
    const int lane = c.lane, w = c.wave;
    for (int unit = c.vb; unit < T / 32; unit += c.nb) {
        const int tok0 = unit * 32;
        __syncthreads();
        for (int i = 0; i < 8; ++i) {
            const int t = tok0 + w * 8 + i;
            f32x4 v[4]; row_load(H + (size_t)t * D, lane, v);
            const float r = rsqrtf(row_sumsq(v) * (1.f / D) + EPS);
            if (lane == 0) rl[w * 8 + i] = r;
            row_store_norm_bf16(XN + (size_t)t * D, lane, v, r, gain);
        }
        {
            const int th = w & 1, kh = w >> 1, m = lane & 15, q = lane >> 4;
            const float* arow = H + (size_t)(tok0 + 16 * th + m) * D + 512 * kh + 128 * q;
            const float* brow = wr_ + (size_t)(512 * kh + 128 * q) * 48 + m;
            f32x4 acc[3]; acc[0] = acc[1] = acc[2] = (f32x4){0.f, 0.f, 0.f, 0.f};
            for (int i = 0; i < 32; ++i) {
                const f32x4 av = ((const f32x4*)arow)[i];
                const float ae[4] = {av.x, av.y, av.z, av.w};
#pragma unroll
                for (int e = 0; e < 4; ++e) {
                    const float* bp = brow + (size_t)(4 * i + e) * 48;
#pragma unroll
                    for (int nt = 0; nt < 3; ++nt) acc[nt] = __builtin_amdgcn_mfma_f32_16x16x4f32(ae[e], bp[nt * 16], acc[nt], 0, 0, 0);
                }
            }
#pragma unroll
            for (int nt = 0; nt < 3; ++nt)
#pragma unroll
                for (int j = 0; j < 4; ++j) lgl[(kh * 32 + th * 16 + 4 * q + j) * 48 + nt * 16 + m] = acc[nt][j];
        }
        __syncthreads();
        if (c.tid < 32) {
            const int tt = c.tid, t = tok0 + tt; const float r = rl[tt];
            const float* bg = (const float*)a.in[IN_BG] + l * 4; const float* be = (const float*)a.in[IN_BE] + l * 32;
            float gl[4];
#pragma unroll
            for (int o = 0; o < 4; ++o) gl[o] = (lgl[tt * 48 + o] + lgl[(32 + tt) * 48 + o]) * r + bg[o];
            int gs = 0; float gm = gl[0];
#pragma unroll
            for (int o = 1; o < 4; ++o) if (gl[o] > gm) { gm = gl[o]; gs = o; }
            float gden = 0.f;
#pragma unroll
            for (int o = 0; o < 4; ++o) gden += __expf(gl[o] - gm);
            const float pg = 1.f / gden;
            float l1 = -INFINITY, l2 = -INFINITY; int i1 = 0, i2 = 0;
            for (int i = 0; i < 8; ++i) {
                const int o = 4 + gs * 8 + i;
                const float v = (lgl[tt * 48 + o] + lgl[(32 + tt) * 48 + o]) * r + be[gs * 8 + i];
                if (v > l1) { l2 = l1; i2 = i1; l1 = v; i1 = i; } else if (v > l2) { l2 = v; i2 = i; }
            }
            const float e2 = __expf(l2 - l1), inv = 1.f / (1.f + e2);
            const float g1 = pg * inv, g2 = pg * e2 * inv;
            const int ea = gs * 8 + i1, eb = gs * 8 + i2;
            const int sa = atomicAdd(&cnt[ea], 1), sb = atomicAdd(&cnt[eb], 1);
            list[ea * T + sa] = t; gatel[ea * T + sa] = g1; tokslot[2 * t] = (ea << 16) | sa;
            list[eb * T + sb] = t; gatel[eb * T + sb] = g2; tokslot[2 * t + 1] = (eb << 16) | sb;
        }
    }
}

__device__ __forceinline__ void moe_table(const Ctx& c, int l, LAS int* pst, LAS int* cn) {
    __syncthreads();
    if (c.tid == 0) {
        const int* cnt = (const int*)(c.ws + WS_CNT) + l * 32; int acc = 0;
        for (int e = 0; e < 32; ++e) { const int n = cnt[e]; cn[e] = n; pst[e] = acc; acc += (n + 127) >> 7; }
        pst[32] = acc;
    }
    __syncthreads();
}
__device__ __forceinline__ int moe_find(LAS const int* pst, int mb) { int e = 0; for (int i = 1; i < 32; ++i) e = (pst[i] <= mb) ? i : e; return e; }

__device__ __forceinline__ void phase_e1(const Ctx& c, int l) {
    const bf16_t* XN = (const bf16_t*)(c.ws + WS_XN); const bf16_t* W1 = (const bf16_t*)(c.ws + WS_W1); const bf16_t* W3 = (const bf16_t*)(c.ws + WS_W3);
    bf16_t* HM = (bf16_t*)(c.ws + WS_HMID); const int* list = (const int*)(c.ws + WS_LIST);
    LAS int* pst = (LAS int*)(c.lds + LDS_MAIN); LAS int* cn = pst + 40;
    moe_table(c, l, pst, cn);
    const int fr = c.lane & 15, fq = c.lane >> 4, wr = c.wave >> 1, wc = c.wave & 1, tid = c.tid;
    const int nunits = pst[32] * 4;
    for (int u = c.vb; u < nunits; u += c.nb) {
        const int mb = u >> 2, nt = u & 3, e = moe_find(pst, mb), row0 = (mb - pst[e]) * 128, count = cn[e];
        const bf16_t* ap[2]; const bf16_t* b0[2]; const bf16_t* b1[2];
#pragma unroll
        for (int p = 0; p < 2; ++p) { int r = row0 + p * 64 + (tid >> 2); r = r < count ? r : row0; ap[p] = XN + (size_t)list[e * T + r] * D; }
        rows_regular<32>(b0, W1 + ((size_t)e * DE + nt * 128) * D, D, tid); rows_regular<32>(b1, W3 + ((size_t)e * DE + nt * 128) * D, D, tid);
        f32x4 a1[4][4], a3[4][4]; zero_acc(a1); zero_acc(a3);
        gemm_loop<32, 2, true>(c, ap, b0, b1, D, a1, a3);
#pragma unroll
        for (int m = 0; m < 4; ++m)
#pragma unroll
            for (int n = 0; n < 4; ++n) {
                const size_t row = (size_t)mb * 128 + wr * 64 + m * 16 + fr; const int col = nt * 128 + wc * 64 + n * 16 + fq * 4;
                const f32x4 x = a1[m][n], y = a3[m][n];
                u32x2 o; o.x = pk_bf16(x.x * sigmoidf_(x.x) * y.x, x.y * sigmoidf_(x.y) * y.y); o.y = pk_bf16(x.z * sigmoidf_(x.z) * y.z, x.w * sigmoidf_(x.w) * y.w);
                *(u32x2*)(HM + row * DE + col) = o;
            }
    }
}
__device__ __forceinline__ void phase_e2(const Ctx& c, int l) {
    const bf16_t* HM = (const bf16_t*)(c.ws + WS_HMID); const bf16_t* W2 = (const bf16_t*)(c.ws + WS_W2);
    bf16_t* Y = (bf16_t*)(c.ws + WS_Y); const float* gatel = (const float*)(c.ws + WS_GATE);
    LAS int* pst = (LAS int*)(c.lds + LDS_MAIN); LAS int* cn = pst + 40;
    moe_table(c, l, pst, cn);
    const int fr = c.lane & 15, fq = c.lane >> 4, wr = c.wave >> 1, wc = c.wave & 1, tid = c.tid;
    const int nunits = pst[32] * 8;
    for (int u = c.vb; u < nunits; u += c.nb) {
        const int mb = u >> 3, nt = u & 7, e = moe_find(pst, mb), row0 = (mb - pst[e]) * 128, count = cn[e];
        const bf16_t* ap[4]; const bf16_t* bp[4];
        rows_regular<64>(ap, HM + (size_t)mb * 128 * DE, DE, tid); rows_regular<64>(bp, W2 + ((size_t)e * D + nt * 128) * DE, DE, tid);
        f32x4 acc[4][4]; zero_acc(acc);
        gemm_loop<64, 1, true>(c, ap, bp, bp, DE, acc, acc);
#pragma unroll
        for (int m = 0; m < 4; ++m) {
            const int rl_ = wr * 64 + m * 16 + fr; const float gt = (row0 + rl_ < count) ? gatel[e * T + row0 + rl_] : 0.f;
#pragma unroll
            for (int n = 0; n < 4; ++n) {
                const f32x4 v = acc[m][n] * gt;
                u32x2 o; o.x = pk_bf16(v.x, v.y); o.y = pk_bf16(v.z, v.w);
                *(u32x2*)(Y + ((size_t)mb * 128 + rl_) * D + nt * 128 + wc * 64 + n * 16 + fq * 4) = o;
            }
        }
    }
}
__device__ __forceinline__ void phase_p1(const Ctx& c, int l) {
    float* H = (float*)(c.ws + WS_H); bf16_t* XN = (bf16_t*)(c.ws + WS_XN); const bf16_t* Y = (const bf16_t*)(c.ws + WS_Y);
    const int* tokslot = (const int*)(c.ws + WS_TOKSLOT); const float* gain = (const float*)c.a->in[IN_PLEN] + l * D;
    LAS int* pst = (LAS int*)(c.lds + LDS_MAIN); LAS int* cn = pst + 40;
    moe_table(c, l, pst, cn);
    const int gw = c.vb * 4 + c.wave, ngw = c.nb * 4, lane = c.lane;
    for (int t = gw; t < T; t += ngw) {
        const int s0 = tokslot[2 * t], s1 = tokslot[2 * t + 1];
        const bf16_t* y0 = Y + ((size_t)pst[s0 >> 16] * 128 + (s0 & 0xffff)) * D; const bf16_t* y1 = Y + ((size_t)pst[s1 >> 16] * 128 + (s1 & 0xffff)) * D;
        f32x4 v[4]; row_load(H + (size_t)t * D, lane, v);
#pragma unroll
        for (int j = 0; j < 4; ++j) {
            const u32x2 a0 = ((const u32x2*)y0)[lane + 64 * j], a1 = ((const u32x2*)y1)[lane + 64 * j];
            v[j].x += bf_lo(a0.x) + bf_lo(a1.x); v[j].y += bf_hi(a0.x) + bf_hi(a1.x); v[j].z += bf_lo(a0.y) + bf_lo(a1.y); v[j].w += bf_hi(a0.y) + bf_hi(a1.y);
            ((f32x4*)(H + (size_t)t * D))[lane + 64 * j] = v[j];
        }
        const float r = rsqrtf(row_sumsq(v) * (1.f / D) + EPS);
        row_store_norm_bf16(XN + (size_t)t * D, lane, v, r, gain);
    }
}
__device__ __forceinline__ void phase_p2(const Ctx& c, int l) {
    const bf16_t* XN = (const bf16_t*)(c.ws + WS_XN); const bf16_t* WG = (const bf16_t*)(c.ws + WS_WGATE) + (size_t)l * D * D;
    const bf16_t* PB = (const bf16_t*)(c.ws + WS_PBF) + (size_t)l * T * PLE; const bf16_t* WP = (const bf16_t*)(c.ws + WS_WPROJ) + (size_t)l * D * PLE;
    float* H = (float*)(c.ws + WS_H);
    const int fr = c.lane & 15, fq = c.lane >> 4, wr = c.wave >> 1, wc = c.wave & 1;
    for (int u = c.vb; u < 128 * 8; u += c.nb) {
        int mt, nt; map_unit(u, 8, mt, nt);
        const bf16_t* ap[4]; const bf16_t* bp[4];
        f32x4 ag[4][4], apj[4][4]; zero_acc(ag); zero_acc(apj);
        rows_regular<64>(ap, XN + (size_t)mt * 128 * D, D, c.tid); rows_regular<64>(bp, WG + (size_t)nt * 128 * D, D, c.tid);
        gemm_loop<64, 1, true>(c, ap, bp, bp, D, ag, ag);
        rows_regular<64>(ap, PB + (size_t)mt * 128 * PLE, PLE, c.tid); rows_regular<64>(bp, WP + (size_t)nt * 128 * PLE, PLE, c.tid);
        gemm_loop<64, 1, true>(c, ap, bp, bp, PLE, apj, apj);
#pragma unroll
        for (int m = 0; m < 4; ++m)
#pragma unroll
            for (int n = 0; n < 4; ++n) {
                const size_t off = (size_t)(mt * 128 + wr * 64 + m * 16 + fr) * D + nt * 128 + wc * 64 + n * 16 + fq * 4;
                const f32x4 g = ag[m][n], pj = apj[m][n]; f32x4 h = *(const f32x4*)(H + off);
                h.x += sigmoidf_(g.x) * pj.x; h.y += sigmoidf_(g.y) * pj.y; h.z += sigmoidf_(g.z) * pj.z; h.w += sigmoidf_(g.w) * pj.w;
                *(f32x4*)(H + off) = h;
            }
    }
}
__device__ __forceinline__ void phase_norm_bf16(const Ctx& c, const float* gain) {
    const float* H = (const float*)(c.ws + WS_H); bf16_t* XN = (bf16_t*)(c.ws + WS_XN);
    const int gw = c.vb * 4 + c.wave, ngw = c.nb * 4;
    for (int t = gw; t < T; t += ngw) {
        f32x4 v[4]; row_load(H + (size_t)t * D, c.lane, v);
        const float r = rsqrtf(row_sumsq(v) * (1.f / D) + EPS);
        row_store_norm_bf16(XN + (size_t)t * D, c.lane, v, r, gain);
    }
}
__device__ __forceinline__ void phase_final(const Ctx& c) {
    const float* H = (const float*)(c.ws + WS_H); float* O = c.a->out; const float* gain = (const float*)c.a->in[IN_FINN];
    const int gw = c.vb * 4 + c.wave, ngw = c.nb * 4;
    for (int t = gw; t < T; t += ngw) {
        f32x4 v[4]; row_load(H + (size_t)t * D, c.lane, v);
        const float r = rsqrtf(row_sumsq(v) * (1.f / D) + EPS);
#pragma unroll
        for (int j = 0; j < 4; ++j) { const f32x4 g = ((const f32x4*)gain)[c.lane + 64 * j]; ((f32x4*)(O + (size_t)t * D))[c.lane + 64 * j] = v[j] * r * g; }
    }
}

__device__ __forceinline__ void phase_b1(const Ctx& c, size_t raw_off = WS_RAW) {
    const bf16_t* XN = (const bf16_t*)(c.ws + WS_XN); const bf16_t* W = (const bf16_t*)(c.ws + WS_WBIN); bf16_t* RAW = (bf16_t*)(c.ws + raw_off);
    const int fr = c.lane & 15, fq = c.lane >> 4, wr = c.wave >> 1, wc = c.wave & 1;
    for (int u = c.vb; u < 128 * 17; u += c.nb) {
        int mt, nt; map_unit(u, 17, mt, nt);
        const bf16_t* ap[4]; const bf16_t* bp[4];
        rows_regular<64>(ap, XN + (size_t)mt * 128 * D, D, c.tid); rows_regular<64>(bp, W + (size_t)nt * 128 * D, D, c.tid);
        f32x4 acc[4][4]; zero_acc(acc);
        gemm_loop<64, 1, true>(c, ap, bp, bp, D, acc, acc);
#pragma unroll
        for (int m = 0; m < 4; ++m)
#pragma unroll
            for (int n = 0; n < 4; ++n) {
                const f32x4 v = acc[m][n]; u32x2 o; o.x = pk_bf16(v.x, v.y); o.y = pk_bf16(v.z, v.w);
                *(u32x2*)(RAW + (size_t)(mt * 128 + wr * 64 + m * 16 + fr) * BINP + nt * 128 + wc * 64 + n * 16 + fq * 4) = o;
            }
    }
}

__device__ __forceinline__ void unpack8(const u32x4 r, float (&e)[8]) { e[0] = bf_lo(r.x); e[1] = bf_hi(r.x); e[2] = bf_lo(r.y); e[3] = bf_hi(r.y); e[4] = bf_lo(r.z); e[5] = bf_hi(r.z); e[6] = bf_lo(r.w); e[7] = bf_hi(r.w); }
__device__ __forceinline__ u32x4 pack8(const float (&e)[8]) { u32x4 o; o.x = pk_bf16(e[0], e[1]); o.y = pk_bf16(e[2], e[3]); o.z = pk_bf16(e[4], e[5]); o.w = pk_bf16(e[6], e[7]); return o; }
__device__ __forceinline__ void phase_rope(const Ctx& c) {
    const bf16_t* RAW = (const bf16_t*)(c.ws + WS_RAW);
    bf16_t* Q = (bf16_t*)(c.ws + WS_Q); bf16_t* K = (bf16_t*)(c.ws + WS_K); bf16_t* V = (bf16_t*)(c.ws + WS_V);
    bf16_t* QI = (bf16_t*)(c.ws + WS_QI); bf16_t* KI = (bf16_t*)(c.ws + WS_KI); float* WI = (float*)(c.ws + WS_WI);
    const int* pos = (const int*)c.a->in[IN_POS];
    LAS float* cs = (LAS float*)(c.lds + c.wave * 256);
    const int gw = c.vb * 4 + c.wave, ngw = c.nb * 4, lane = c.lane;
    for (int t = gw; t < T; t += ngw) {
        if (lane < 24) {
            const double ex = (lane < 16) ? (double)lane * (1.0 / 16.0) : (double)(lane - 16) * (1.0 / 8.0);
            const float invf = (float)exp2(-ex * 18.931568569324174);
            const float ang = (float)pos[t] * invf;
            const double ad = (double)ang; const double n = rint(ad * 0.15915494309189535); const float red = (float)(ad - n * 6.283185307179586);
            cs[lane] = cosf(red); cs[32 + lane] = sinf(red);
        }
        LDS_WAIT();
        const bf16_t* row = RAW + (size_t)t * BINP;
        for (int ch = lane; ch < BINP / 8; ch += 64) {
            const u32x4 own = ((const u32x4*)row)[ch];
            float e[8]; unpack8(own, e);
            if (ch < 160) {
                const int cc = ch & 15;
                if (cc < 4) {
                    const u32x4 oth = ((const u32x4*)row)[ch ^ 2]; float p[8]; unpack8(oth, p);
                    const int f0 = (cc & 1) * 8;
#pragma unroll
                    for (int i = 0; i < 8; ++i) { const float co = cs[f0 + i], si = cs[32 + f0 + i]; e[i] = (cc < 2) ? (e[i] * co - p[i] * si) : (e[i] * co + p[i] * si); }
                }
                if (ch < 128) {
#pragma unroll
                    for (int i = 0; i < 8; ++i) e[i] *= 0.08838834764831845f;
                    ((u32x4*)(Q + (size_t)t * D))[ch] = pack8(e);
                } else ((u32x4*)(K + (size_t)t * 256))[ch - 128] = pack8(e);
            } else if (ch < 192) {
                ((u32x4*)(V + (size_t)t * 256))[ch - 160] = own;
            } else if (ch < 264) {
                const int cc = ch & 7;
                if (cc < 2) {
                    const u32x4 oth = ((const u32x4*)row)[ch ^ 1]; float p[8]; unpack8(oth, p);
#pragma unroll
                    for (int i = 0; i < 8; ++i) { const float co = cs[16 + i], si = cs[32 + 16 + i]; e[i] = (cc == 0) ? (e[i] * co - p[i] * si) : (e[i] * co + p[i] * si); }
                }
                if (ch < 256) ((u32x4*)(QI + (size_t)t * 512))[ch - 192] = pack8(e);
                else ((u32x4*)(KI + (size_t)t * 64))[ch - 256] = pack8(e);
            } else if (ch == 264) {
                f32x4 w0 = {e[0], e[1], e[2], e[3]}, w1 = {e[4], e[5], e[6], e[7]};
                const float sc = 0.044194173824159216f;
                ((f32x4*)(WI + (size_t)t * 8))[0] = w0 * sc; ((f32x4*)(WI + (size_t)t * 8))[1] = w1 * sc;
            }
        }
        LDS_WAIT();
    }
}

constexpr int NBINS = 2048, CAND_CAP = 512;
__device__ __forceinline__ void phase_index(const Ctx& c) {
    const bf16_t* QI = (const bf16_t*)(c.ws + WS_QI); const bf16_t* KI = (const bf16_t*)(c.ws + WS_KI); const float* WI = (const float*)(c.ws + WS_WI);
    int* SEL = (int*)(c.ws + WS_SEL);
    LAS unsigned char* lds = c.lds;
    LAS int* hist = (LAS int*)lds;
    LAS float* candv = (LAS float*)(lds + 32768);
    LAS int* candi = (LAS int*)(lds + 32768 + 8192);
    LAS float* red = (LAS float*)(lds + 49152);
    LAS float* qmn = red + 32; LAS float* qsc = qmn + 4;
    LAS int* bstar = (LAS int*)(qsc + 4); LAS int* need = bstar + 4; LAS int* ncand = need + 4;
    LAS float* thrv = (LAS float*)(ncand + 4); LAS int* thri = (LAS int*)(thrv + 4);
    LAS int* wcnt = thri + 4;
    const int lane = c.lane, hf = lane >> 5, tid = c.tid;
    for (int u = c.vb; u < T / 4; u += c.nb) {
        int col = lane & 31, w = c.wave;
        asm volatile("" : "+v"(col), "+s"(w));
        const int b = u & 3, tq = 1023 - (u >> 2), t0 = tq * 4;
        if (t0 < 256) continue;
        const int tb = b * SEQ;
        bf16x8 af[4];
        { const int rho = lane & 31, ql = 2 * ((rho >> 2) & 1) + (rho >> 4), hd = 4 * ((rho >> 3) & 1) + (rho & 3);
          const bf16_t* qp = QI + (size_t)(tb + t0 + ql) * 512 + hd * 64 + 8 * hf;
#pragma unroll
          for (int ks = 0; ks < 4; ++ks) af[ks] = *(const bf16x8*)(qp + 16 * ks); }
        f32x4 wv0a, wv0b, wv1a, wv1b;
        { const float* wp = WI + (size_t)(tb + t0 + 2 * hf) * 8; wv0a = ((const f32x4*)wp)[0]; wv0b = ((const f32x4*)wp)[1]; wv1a = ((const f32x4*)wp)[2]; wv1b = ((const f32x4*)wp)[3]; }
        const int tA = t0 + 2 * hf, tB = tA + 1;
        const int nkt = ((t0 + 3) >> 5) + 1;
        float sA[32], sB[32];
        bf16x8 nbf[4];
        { const bf16_t* kp = KI + (size_t)(tb + w * 32 + col) * 64 + 8 * hf;
#pragma unroll
          for (int ks = 0; ks < 4; ++ks) nbf[ks] = *(const bf16x8*)(kp + 16 * ks); }
#pragma unroll
        for (int i = 0; i < 32; ++i) {
            const int kt = 4 * i + w;
            float a_ = -INFINITY, b_ = -INFINITY;
            if (kt < nkt) {
                const int key = kt * 32 + col;
                bf16x8 cb[4];
#pragma unroll
                for (int ks = 0; ks < 4; ++ks) cb[ks] = nbf[ks];
                if (kt + 4 < nkt) {
                    const bf16_t* kp = KI + (size_t)(tb + key + 128) * 64 + 8 * hf;
#pragma unroll
                    for (int ks = 0; ks < 4; ++ks) nbf[ks] = *(const bf16x8*)(kp + 16 * ks);
                }
                f32x16 acc = {};
#pragma unroll
                for (int ks = 0; ks < 4; ++ks) acc = __builtin_amdgcn_mfma_f32_32x32x16_bf16(af[ks], cb[ks], acc, 0, 0, 0);
                float s0 = fmaxf(acc[0], 0.f) * wv0a.x; s0 += fmaxf(acc[1], 0.f) * wv0a.y; s0 += fmaxf(acc[2], 0.f) * wv0a.z; s0 += fmaxf(acc[3], 0.f) * wv0a.w;
                s0 += fmaxf(acc[4], 0.f) * wv0b.x; s0 += fmaxf(acc[5], 0.f) * wv0b.y; s0 += fmaxf(acc[6], 0.f) * wv0b.z; s0 += fmaxf(acc[7], 0.f) * wv0b.w;
                float s1 = fmaxf(acc[8], 0.f) * wv1a.x; s1 += fmaxf(acc[9], 0.f) * wv1a.y; s1 += fmaxf(acc[10], 0.f) * wv1a.z; s1 += fmaxf(acc[11], 0.f) * wv1a.w;
                s1 += fmaxf(acc[12], 0.f) * wv1b.x; s1 += fmaxf(acc[13], 0.f) * wv1b.y; s1 += fmaxf(acc[14], 0.f) * wv1b.z; s1 += fmaxf(acc[15], 0.f) * wv1b.w;
                a_ = (key <= tA) ? s0 : -INFINITY; b_ = (key <= tB) ? s1 : -INFINITY;
            }
            sA[i] = a_; sB[i] = b_;
            asm volatile("" ::: "memory");
        }
        float mnA = INFINITY, mxA = -INFINITY, mnB = INFINITY, mxB = -INFINITY;
#pragma unroll
        for (int i = 0; i < 32; ++i) {
            mxA = fmaxf(mxA, sA[i]); mnA = fminf(mnA, (sA[i] == -INFINITY) ? INFINITY : sA[i]);
            mxB = fmaxf(mxB, sB[i]); mnB = fminf(mnB, (sB[i] == -INFINITY) ? INFINITY : sB[i]);
        }
#pragma unroll
        for (int o = 1; o < 32; o <<= 1) { mxA = fmaxf(mxA, __shfl_xor(mxA, o)); mnA = fminf(mnA, __shfl_xor(mnA, o)); mxB = fmaxf(mxB, __shfl_xor(mxB, o)); mnB = fminf(mnB, __shfl_xor(mnB, o)); }
        __syncthreads();
        if (col == 0) { red[(w * 4 + 2 * hf) * 2] = mnA; red[(w * 4 + 2 * hf) * 2 + 1] = mxA; red[(w * 4 + 2 * hf + 1) * 2] = mnB; red[(w * 4 + 2 * hf + 1) * 2 + 1] = mxB; }
        for (int i = tid; i < 4 * NBINS; i += NTH) hist[i] = 0;
        if (tid < 4) ncand[tid] = 0;
        __syncthreads();
        if (tid < 4) {
            float mn = INFINITY, mx = -INFINITY;
            for (int ww = 0; ww < 4; ++ww) { mn = fminf(mn, red[(ww * 4 + tid) * 2]); mx = fmaxf(mx, red[(ww * 4 + tid) * 2 + 1]); }
            qmn[tid] = mn; qsc[tid] = (mx > mn) ? (float)NBINS / (mx - mn) : 0.f;
        }
        __syncthreads();
        const int qA = 2 * hf, qB = 2 * hf + 1;
        const float mnqA = qmn[qA], scA = qsc[qA], mnqB = qmn[qB], scB = qsc[qB];
#define BINOF(v, mn, sc) min(NBINS - 1, (int)(((v) - (mn)) * (sc)))
#pragma unroll
        for (int i = 0; i < 32; ++i) {
            if (sA[i] != -INFINITY) lds_inc(&hist[qA * NBINS + BINOF(sA[i], mnqA, scA)]);
            if (sB[i] != -INFINITY) lds_inc(&hist[qB * NBINS + BINOF(sB[i], mnqB, scB)]);
        }
        __syncthreads();
        {
            const LAS int* hq = hist + w * NBINS + lane * 32;
            int loc = 0;
#pragma unroll
            for (int i = 0; i < 32; ++i) loc += hq[i];
            int suf = loc;
#pragma unroll
            for (int o = 1; o < 64; o <<= 1) { const int v = __shfl_down(suf, o); if (lane + o < 64) suf += v; }
            const int above = suf - loc;
            if (above < 256 && suf >= 256) {
                int run = above, bs = 0, ab = above;
                for (int i = 31; i >= 0; --i) { const int h = hq[i]; if (run < 256 && run + h >= 256) { bs = lane * 32 + i; ab = run; } run += h; }
                bstar[w] = bs; need[w] = 256 - ab;
            }
        }
        __syncthreads();
        {
            const int bsA = bstar[qA], bsB = bstar[qB];
#pragma unroll
            for (int i = 0; i < 32; ++i) {
                const int key = (4 * i + w) * 32 + col;
                if (sA[i] != -INFINITY && BINOF(sA[i], mnqA, scA) == bsA) { const int p = lds_inc(&ncand[qA]); if (p < CAND_CAP) { candv[qA * CAND_CAP + p] = sA[i]; candi[qA * CAND_CAP + p] = key; } }
                if (sB[i] != -INFINITY && BINOF(sB[i], mnqB, scB) == bsB) { const int p = lds_inc(&ncand[qB]); if (p < CAND_CAP) { candv[qB * CAND_CAP + p] = sB[i]; candi[qB * CAND_CAP + p] = key; } }
            }
        }
        __syncthreads();
        {
            const int n = min(ncand[w], CAND_CAP), nd = need[w];
            for (int i = lane; i < n; i += 64) {
                const float v = candv[w * CAND_CAP + i]; const int id = candi[w * CAND_CAP + i];
                int rank = 0;
                for (int j = 0; j < n; ++j) { const float vj = candv[w * CAND_CAP + j]; const int ij = candi[w * CAND_CAP + j]; rank += (vj > v || (vj == v && ij < id)) ? 1 : 0; }
                if (rank == nd - 1) { thrv[w] = v; thri[w] = id; }
            }
        }
        __syncthreads();
        const float tvA = thrv[qA], tvB = thrv[qB]; const int tiA = thri[qA], tiB = thri[qB];
        int cA = 0, cB = 0;
#pragma unroll
        for (int i = 0; i < 32; ++i) {
            const int key = (4 * i + w) * 32 + col;
            cA += (sA[i] > tvA || (sA[i] == tvA && key <= tiA)) ? 1 : 0;
            cB += (sB[i] > tvB || (sB[i] == tvB && key <= tiB)) ? 1 : 0;
        }
#pragma unroll
        for (int o = 1; o < 32; o <<= 1) { cA += __shfl_xor(cA, o); cB += __shfl_xor(cB, o); }
        if (col == 0) { wcnt[w * 4 + qA] = cA; wcnt[w * 4 + qB] = cB; }
        __syncthreads();
        int baseA = 0, baseB = 0;
        for (int ww = 0; ww < w; ++ww) { baseA += wcnt[ww * 4 + qA]; baseB += wcnt[ww * 4 + qB]; }
        int* selA = SEL + (size_t)(tb + tA) * 256; int* selB = SEL + (size_t)(tb + tB) * 256;
#pragma unroll
        for (int i = 0; i < 32; ++i) {
            const int key = (4 * i + w) * 32 + col;
            const bool pa = (sA[i] > tvA || (sA[i] == tvA && key <= tiA)), pb = (sB[i] > tvB || (sB[i] == tvB && key <= tiB));
            const unsigned long long ma = __ballot(pa), mb = __ballot(pb);
            const unsigned mah = hf ? (unsigned)(ma >> 32) : (unsigned)ma, mbh = hf ? (unsigned)(mb >> 32) : (unsigned)mb;
            const unsigned below = (1u << col) - 1u;
            const int posA = baseA + __popc(mah & below), posB = baseB + __popc(mbh & below);
            if (pa && posA < 256) selA[posA] = key;
            if (pb && posB < 256) selB[posB] = key;
            baseA += __popc(mah); baseB += __popc(mbh);
        }
    }
}

__device__ __forceinline__ void phase_attn(const Ctx& c) {
    const bf16_t* Q = (const bf16_t*)(c.ws + WS_Q); const bf16_t* K = (const bf16_t*)(c.ws + WS_K); const bf16_t* V = (const bf16_t*)(c.ws + WS_V);
    const int* SEL = (const int*)(c.ws + WS_SEL); bf16_t* O = (bf16_t*)(c.ws + WS_O);
    LAS f32x4* pl = (LAS f32x4*)(c.lds + c.wave * 5120);
    LAS int* sl = (LAS int*)(c.lds + c.wave * 5120 + 4096);
    const int lane = c.lane, fr = lane & 15, fq = lane >> 4;
    const int gw = c.vb * 4 + c.wave, ngw = c.nb * 4;
    for (int task = gw; task < T * 2; task += ngw) {
        const int tg = task >> 1, g = task & 1, b = tg >> 12, t = tg & 4095, tb = b * SEQ;
        const int nsel = min(256, t + 1), ntile = (nsel + 15) >> 4;
#pragma unroll
        for (int i = 0; i < 4; ++i) { const int s = lane + 64 * i; int idx = 0; if (s < nsel) idx = (t < 256) ? s : SEL[(size_t)tg * 256 + s]; idx = ((unsigned)idx <= (unsigned)t) ? idx : 0; sl[s] = idx; }
        bf16x8 qf[4];
        { const bf16_t* qp = Q + (size_t)tg * D + (4 * g + (fr & 3)) * 128 + 8 * fq;
#pragma unroll
          for (int ks = 0; ks < 4; ++ks) qf[ks] = *(const bf16x8*)(qp + 32 * ks); }
        LDS_WAIT();
        f32x4 lg[16];
#pragma unroll
        for (int kt = 0; kt < 16; ++kt) {
            lg[kt] = (f32x4){-INFINITY, -INFINITY, -INFINITY, -INFINITY};
            if (kt < ntile) {
                const int key = sl[kt * 16 + fr];
                const bf16_t* kp = K + (size_t)(tb + key) * 256 + g * 128 + 8 * fq;
                f32x4 acc = {0.f, 0.f, 0.f, 0.f};
#pragma unroll
                for (int ks = 0; ks < 4; ++ks) { const bf16x8 kf = *(const bf16x8*)(kp + 32 * ks); acc = __builtin_amdgcn_mfma_f32_16x16x32_bf16(qf[ks], kf, acc, 0, 0, 0); }
                if (kt * 16 + fr < nsel) lg[kt] = acc;
            }
        }
        f32x4 mx = lg[0];
#pragma unroll
        for (int kt = 1; kt < 16; ++kt) { mx.x = fmaxf(mx.x, lg[kt].x); mx.y = fmaxf(mx.y, lg[kt].y); mx.z = fmaxf(mx.z, lg[kt].z); mx.w = fmaxf(mx.w, lg[kt].w); }
#pragma unroll
        for (int o = 1; o < 16; o <<= 1) { mx.x = fmaxf(mx.x, __shfl_xor(mx.x, o)); mx.y = fmaxf(mx.y, __shfl_xor(mx.y, o)); mx.z = fmaxf(mx.z, __shfl_xor(mx.z, o)); mx.w = fmaxf(mx.w, __shfl_xor(mx.w, o)); }
        f32x4 sm = {0.f, 0.f, 0.f, 0.f};
#pragma unroll
        for (int kt = 0; kt < 16; ++kt) { f32x4 p; p.x = __expf(lg[kt].x - mx.x); p.y = __expf(lg[kt].y - mx.y); p.z = __expf(lg[kt].z - mx.z); p.w = __expf(lg[kt].w - mx.w); lg[kt] = p; sm += p; }
#pragma unroll
        for (int o = 1; o < 16; o <<= 1) { sm.x += __shfl_xor(sm.x, o); sm.y += __shfl_xor(sm.y, o); sm.z += __shfl_xor(sm.z, o); sm.w += __shfl_xor(sm.w, o); }
        const f32x4 inv = {1.f / sm.x, 1.f / sm.y, 1.f / sm.z, 1.f / sm.w};
        if (fq == 0) {
#pragma unroll
            for (int kt = 0; kt < 16; ++kt) pl[kt * 16 + fr] = lg[kt] * inv;
        }
        LDS_WAIT();
        f32x2 oa[4][4];
#pragma unroll
        for (int h = 0; h < 4; ++h)
#pragma unroll
            for (int d = 0; d < 4; ++d) oa[h][d] = (f32x2){0.f, 0.f};
        const int nstep = (nsel + 3) >> 2;
        for (int it = 0; it < nstep; ++it) {
            const int s = 4 * it + fq;
            const int key = sl[s]; const f32x4 p = pl[s];
            const u32x4 vv = *(const u32x4*)(V + (size_t)(tb + key) * 256 + g * 128 + 8 * fr);
            const f32x2 v0 = {bf_lo(vv.x), bf_hi(vv.x)}, v1 = {bf_lo(vv.y), bf_hi(vv.y)}, v2 = {bf_lo(vv.z), bf_hi(vv.z)}, v3 = {bf_lo(vv.w), bf_hi(vv.w)};
            oa[0][0] += v0 * p.x; oa[0][1] += v1 * p.x; oa[0][2] += v2 * p.x; oa[0][3] += v3 * p.x;
            oa[1][0] += v0 * p.y; oa[1][1] += v1 * p.y; oa[1][2] += v2 * p.y; oa[1][3] += v3 * p.y;
            oa[2][0] += v0 * p.z; oa[2][1] += v1 * p.z; oa[2][2] += v2 * p.z; oa[2][3] += v3 * p.z;
            oa[3][0] += v0 * p.w; oa[3][1] += v1 * p.w; oa[3][2] += v2 * p.w; oa[3][3] += v3 * p.w;
        }
#pragma unroll
        for (int h = 0; h < 4; ++h)
#pragma unroll
            for (int d = 0; d < 4; ++d) {
                oa[h][d].x += __shfl_xor(oa[h][d].x, 16); oa[h][d].y += __shfl_xor(oa[h][d].y, 16);
                oa[h][d].x += __shfl_xor(oa[h][d].x, 32); oa[h][d].y += __shfl_xor(oa[h][d].y, 32);
            }
        if (fq == 0) {
#pragma unroll
            for (int h = 0; h < 4; ++h) {
                u32x4 o; o.x = pk_bf16(oa[h][0].x, oa[h][0].y); o.y = pk_bf16(oa[h][1].x, oa[h][1].y); o.z = pk_bf16(oa[h][2].x, oa[h][2].y); o.w = pk_bf16(oa[h][3].x, oa[h][3].y);
                *(u32x4*)(O + (size_t)tg * D + (4 * g + h) * 128 + 8 * fr) = o;
            }
        }
        LDS_WAIT();
    }
}

__device__ __forceinline__ void phase_b4(const Ctx& c) {
    const bf16_t* OB = (const bf16_t*)(c.ws + WS_O); const bf16_t* W = (const bf16_t*)(c.ws + WS_WBOUT); float* H = (float*)(c.ws + WS_H);
    const int fr = c.lane & 15, fq = c.lane >> 4, wr = c.wave >> 1, wc = c.wave & 1;
    for (int u = c.vb; u < 128 * 8; u += c.nb) {
        int mt, nt; map_unit(u, 8, mt, nt);
        const bf16_t* ap[4]; const bf16_t* bp[4];
        rows_regular<64>(ap, OB + (size_t)mt * 128 * D, D, c.tid); rows_regular<64>(bp, W + (size_t)nt * 128 * D, D, c.tid);
        f32x4 acc[4][4]; zero_acc(acc);
        gemm_loop<64, 1, true>(c, ap, bp, bp, D, acc, acc);
#pragma unroll
        for (int m = 0; m < 4; ++m)
#pragma unroll
            for (int n = 0; n < 4; ++n) {
                const size_t off = (size_t)(mt * 128 + wr * 64 + m * 16 + fr) * D + nt * 128 + wc * 64 + n * 16 + fq * 4;
                *(f32x4*)(H + off) = *(const f32x4*)(H + off) + acc[m][n];
            }
    }
}

constexpr int NPHASE = 21;
__global__ void __launch_bounds__(NTH, 2) mk_fwd(Args args) {
    extern __shared__ __attribute__((aligned(16))) unsigned char lds_raw[];
    Ctx c;
    c.lds = (LAS unsigned char*)lds_raw; c.tid = threadIdx.x; c.lane = c.tid & 63; c.wave = __builtin_amdgcn_readfirstlane(c.tid >> 6);
    c.nb = gridDim.x; { const int bx = blockIdx.x; c.vb = (c.nb % 8 == 0) ? (bx % 8) * (c.nb / 8) + bx / 8 : bx; }
    c.a = (const __attribute__((address_space(4))) Args*)__builtin_amdgcn_kernarg_segment_ptr(); c.ws = args.ws;
    volatile LAS unsigned* st = (volatile LAS unsigned*)(c.lds + LDS_MAIN + 1008);
    const bool multi = (args.ph_hi - args.ph_lo) > 1;
    XcdBarrier bar; bar.bar = (unsigned*)(c.ws + WS_CTL); bar.x = 0; bar.st = st;
    if (multi) {
        if (c.tid == 0) { st[0] = 0u; st[1] = 0u; }
        __syncthreads();
        bar = xcd_barrier_post((unsigned*)(c.ws + WS_CTL), st);
    }
    const int ph_lo = args.ph_lo, ph_hi = args.ph_hi;
#ifndef PH_MASK
#define PH_MASK 0x1fffff
#endif
#define PHON(k) ((PH_MASK >> (k)) & 1)
#define PHASE(k, body) do { if (PHON(k) && ph_lo <= (k) && (k) < ph_hi) { \
        { int t_ = threadIdx.x, vb_ = __builtin_amdgcn_readfirstlane(c.vb); \
          const __attribute__((address_space(4))) Args* ka = (const __attribute__((address_space(4))) Args*)__builtin_amdgcn_kernarg_segment_ptr(); \
          asm volatile("" : "+v"(t_), "+s"(vb_), "+s"(ka)); \
          c.tid = t_; c.lane = t_ & 63; c.wave = __builtin_amdgcn_readfirstlane(t_ >> 6); c.vb = vb_; c.a = ka; c.ws = ka->ws; } \
        body; \
        if ((k) + 1 < ph_hi) xcd_barrier(bar); } } while (0)
    PHASE(0, phase_prep(c));
    PHASE(1, phase_a1(c));
    PHASE(2, phase_a2(c));
    PHASE(3, phase_a3(c));
    PHASE(4, phase_route(c, 0));
    PHASE(5, phase_e1(c, 0));
    PHASE(6, phase_e2(c, 0));
    PHASE(7, phase_p1(c, 0));
    PHASE(8, phase_p2(c, 0));
    PHASE(9, { phase_norm_bf16(c, (const float*)c.a->in[IN_MIXN] + D); convert_moe_layer(c, 1); });
    PHASE(10, phase_b1(c));
    PHASE(11, phase_rope(c));
    PHASE(12, phase_index(c));
    PHASE(13, phase_attn(c));
    PHASE(14, phase_b4(c));
    PHASE(15, phase_route(c, 1));
    PHASE(16, phase_e1(c, 1));
    PHASE(17, phase_e2(c, 1));
    PHASE(18, phase_p1(c, 1));
    PHASE(19, phase_p2(c, 1));
    PHASE(20, phase_final(c));
}

#ifdef MK_DUMP
__global__ void dump_k(const unsigned char* ws, float* out) {
    const size_t i = (size_t)blockIdx.x * 256 + threadIdx.x;
#if MK_DUMP == 1
    ((f32x4*)out)[i] = ((const f32x4*)(ws + WS_H))[i];
#elif MK_DUMP == 2
    { const u32x2 v = ((const u32x2*)(ws + WS_O))[i]; f32x4 o = {bf_lo(v.x), bf_hi(v.x), bf_lo(v.y), bf_hi(v.y)}; ((f32x4*)out)[i] = o; }
#elif MK_DUMP == 3
    { const int* sp = (const int*)(ws + WS_SEL); f32x4 o = {0.f,0.f,0.f,0.f}; if (i < (size_t)T * 64) { o.x = (float)sp[4*i]; o.y = (float)sp[4*i+1]; o.z = (float)sp[4*i+2]; o.w = (float)sp[4*i+3]; } ((f32x4*)out)[i] = o; }
#elif MK_DUMP == 5
    { const u32x2 v = ((const u32x2*)(ws + WS_XN))[i]; f32x4 o = {bf_lo(v.x), bf_hi(v.x), bf_lo(v.y), bf_hi(v.y)}; ((f32x4*)out)[i] = o; }
#elif MK_DUMP == 6
    { const u32x2 v = ((const u32x2*)(ws + WS_RAW))[i]; f32x4 o = {bf_lo(v.x), bf_hi(v.x), bf_lo(v.y), bf_hi(v.y)}; ((f32x4*)out)[i] = o; }
#elif MK_DUMP == 7
    { f32x4 o = {0.f,0.f,0.f,0.f}; if (i < (size_t)BINP * D / 4) { const u32x2 v = ((const u32x2*)(ws + WS_WBIN))[i]; o = (f32x4){bf_lo(v.x), bf_hi(v.x), bf_lo(v.y), bf_hi(v.y)}; } ((f32x4*)out)[i] = o; }
#elif MK_DUMP == 8
    { const u32x2 v = ((const u32x2*)(ws + WS_RAW))[i], w = ((const u32x2*)(ws + 458 * MB))[i]; f32x4 o = {bf_lo(v.x) - bf_lo(w.x), bf_hi(v.x) - bf_hi(w.x), bf_lo(v.y) - bf_lo(w.y), bf_hi(v.y) - bf_hi(w.y)}; ((f32x4*)out)[i] = o; }
#elif MK_DUMP == 9
    { const u32x2 v = ((const u32x2*)(ws + WS_RAW))[i], w = ((const u32x2*)(ws + 458 * MB))[i]; f32x4 o = {(v.x & 0xffffu) != (w.x & 0xffffu) ? 1.f : 0.f, (v.x >> 16) != (w.x >> 16) ? 1.f : 0.f, (v.y & 0xffffu) != (w.y & 0xffffu) ? 1.f : 0.f, (v.y >> 16) != (w.y >> 16) ? 1.f : 0.f}; ((f32x4*)out)[i] = o; }
#elif MK_DUMP == 4
    { const u32x2 v = ((const u32x2*)(ws + WS_Q))[i]; f32x4 o = {bf_lo(v.x), bf_hi(v.x), bf_lo(v.y), bf_hi(v.y)}; ((f32x4*)out)[i] = o; }
#endif
}
#endif
extern "C" void kernel_launch(void* const* d_in, const int* in_sizes, int n_in, void* d_out, int out_size, void* d_ws, size_t ws_size, hipStream_t stream) {
    static int grid = 0;
    if (grid == 0) {
        if (n_in != 23 || out_size != T * D || ws_size < WS_TOTAL) { fprintf(stderr, "kernel_launch: unexpected sizes n_in %d out %d ws %zu (need %zu)\n", n_in, out_size, ws_size, (size_t)WS_TOTAL); grid = -1; return; }
        int dev = 0, cus = 0, per_cu = 0;
        hipGetDevice(&dev); hipDeviceGetAttribute(&cus, hipDeviceAttributeMultiprocessorCount, dev);
        hipFuncSetAttribute((const void*)mk_fwd, hipFuncAttributeMaxDynamicSharedMemorySize, LDS_BYTES);
        hipOccupancyMaxActiveBlocksPerMultiprocessor(&per_cu, (const void*)mk_fwd, NTH, LDS_BYTES);
        (void)hipGetLastError();
        if (per_cu < 1) per_cu = 1;
        if (per_cu > 2) per_cu = 2;
        grid = cus * per_cu;
    }
    if (grid < 0) return;
    hipMemsetAsync((char*)d_ws + WS_CTL, 0, 16384, stream);
    Args a{};
    for (int i = 0; i < 23; ++i) a.in[i] = d_in[i];
    a.out = (float*)d_out; a.ws = (unsigned char*)d_ws;
#if MK_ONE_LAUNCH
    a.ph_lo = 0; a.ph_hi = NPHASE;
    hipLaunchKernelGGL(mk_fwd, dim3(grid), dim3(NTH), LDS_BYTES, stream, a);
#else
    for (int ph = 0; ph <= MK_LAST_PHASE; ++ph) { a.ph_lo = ph; a.ph_hi = ph + 1; hipLaunchKernelGGL(mk_fwd, dim3(grid), dim3(NTH), LDS_BYTES, stream, a); }
#ifdef MK_DUMP
    hipLaunchKernelGGL(dump_k, dim3(T * D / 4 / 256), dim3(256), 0, stream, (const unsigned char*)d_ws, (float*)d_out);
#endif
#endif
}
```

```cpp
#include <hip/hip_runtime.h>
#include <stdint.h>
#include <stdio.h>

#ifndef MK_LAST_PHASE
#define MK_LAST_PHASE 20
#endif
#ifndef MK_REP
#define MK_REP -1
#endif
#ifndef MK_XBAR
#define MK_XBAR 0
#endif
#ifndef MK_DRY
#define MK_DRY -1
#endif
#ifndef MK_ONE_LAUNCH
#define MK_ONE_LAUNCH 1
#endif

#define LAS __attribute__((address_space(3)))
typedef unsigned short bf16_t;
typedef short bf16x8 __attribute__((ext_vector_type(8)));
typedef float f32x4 __attribute__((ext_vector_type(4)));
typedef float f32x2 __attribute__((ext_vector_type(2)));
typedef float f32x16 __attribute__((ext_vector_type(16)));
typedef unsigned u32x4 __attribute__((ext_vector_type(4)));
typedef unsigned u32x2 __attribute__((ext_vector_type(2)));

constexpr int T = 16384, D = 1024, SEQ = 4096;
constexpr int GW = 2048;
constexpr int BIN = 2120, BINP = 2176;
constexpr int NE = 32, DE = 512;
constexpr int PLE = 256;
constexpr float EPS = 1e-6f;
constexpr int NTH = 256;
constexpr int LDS_MAIN = 4 * 19456;
constexpr int LDS_BYTES = LDS_MAIN + 1024;
constexpr int RPAD = 32768 + NE * 128;

constexpr size_t MB = 1024 * 1024;
constexpr size_t WS_CTL = 0;
constexpr size_t WS_CNT = 16384;
constexpr size_t WS_WR = 32768;
constexpr size_t WS_WAIN = 1 * MB;
constexpr size_t WS_WAOUT = WS_WAIN + 8 * MB;
constexpr size_t WS_WBIN = WS_WAOUT + 4 * MB;
constexpr size_t WS_WBOUT = WS_WBIN + 5 * MB;
constexpr size_t WS_WGATE = WS_WBOUT + 2 * MB;
constexpr size_t WS_WPROJ = WS_WGATE + 4 * MB;
constexpr size_t WS_W1 = WS_WPROJ + 1 * MB;
constexpr size_t WS_W3 = WS_W1 + 32 * MB;
constexpr size_t WS_W2 = WS_W3 + 32 * MB;
constexpr size_t WS_PBF = WS_W2 + 32 * MB;
constexpr size_t WS_XN = WS_PBF + 16 * MB;
constexpr size_t WS_H = WS_XN + 32 * MB;
constexpr size_t WS_LIST = WS_H + 64 * MB;
constexpr size_t WS_GATE = WS_LIST + 2 * MB;
constexpr size_t WS_TOKSLOT = WS_GATE + 2 * MB;
constexpr size_t WS_SCR = WS_TOKSLOT + 1 * MB;
constexpr size_t WS_U = WS_SCR;
constexpr size_t WS_VT = WS_SCR + 64 * MB;
constexpr size_t WS_VSS = WS_SCR + 128 * MB;
constexpr size_t WS_HMID = WS_SCR;
constexpr size_t WS_Y = WS_SCR + 36 * MB;
constexpr size_t WS_RAW = WS_SCR;
constexpr size_t WS_O = WS_SCR;
constexpr size_t WS_Q = WS_SCR + 68 * MB;
constexpr size_t WS_K = WS_Q + 32 * MB;
constexpr size_t WS_V = WS_K + 8 * MB;
constexpr size_t WS_QI = WS_V + 8 * MB;
constexpr size_t WS_KI = WS_QI + 16 * MB;
constexpr size_t WS_WI = WS_KI + 2 * MB;
constexpr size_t WS_SEL = WS_WI + 1 * MB;
constexpr size_t WS_END = WS_SEL + 16 * MB;
static_assert(WS_END <= WS_SCR + 152 * MB, "scratch");
constexpr size_t WS_TOTAL = WS_SCR + 152 * MB;

typedef __bf16 bf16x2_t __attribute__((ext_vector_type(2)));
__device__ __forceinline__ unsigned pk_bf16(float lo, float hi) { f32x2 v = {lo, hi}; bf16x2_t b = __builtin_convertvector(v, bf16x2_t); return __builtin_bit_cast(unsigned, b); }
__device__ __forceinline__ float bf_lo(unsigned u) { return __uint_as_float(u << 16); }
__device__ __forceinline__ float bf_hi(unsigned u) { return __uint_as_float(u & 0xffff0000u); }
__device__ __forceinline__ float wave_sum(float v) {
#pragma unroll
    for (int o = 1; o < 64; o <<= 1) v += __shfl_xor(v, o);
    return v;
}
__device__ __forceinline__ int lds_inc(LAS int* p) { return __hip_atomic_fetch_add(p, 1, __ATOMIC_RELAXED, __HIP_MEMORY_SCOPE_WORKGROUP); }
#define LDS_WAIT() asm volatile("s_waitcnt lgkmcnt(0)" ::: "memory")
#define VM_WAIT() asm volatile("s_waitcnt vmcnt(0)" ::: "memory")

#define XB_TMO      128
#define XB_XCNT(j)  (256  + 64 * (j))
#define XB_XSUB(j)  (1280 + 64 * (j))
#define XB_XGEN(j)  (2304 + 64 * (j))
#define XB_TOP      3328
#define XB_TOPGEN   3392
#define XCD_BAR_WORDS 3456
#define XB_SPIN_CAP (1u << 20)
__device__ __forceinline__ unsigned xb_ld(unsigned* p)              { return __hip_atomic_load(p, __ATOMIC_RELAXED, __HIP_MEMORY_SCOPE_AGENT); }
__device__ __forceinline__ unsigned xb_add(unsigned* p, unsigned v) { return __hip_atomic_fetch_add(p, v, __ATOMIC_RELAXED, __HIP_MEMORY_SCOPE_AGENT); }
__device__ __forceinline__ unsigned xb_xcc_id() { return (unsigned)__builtin_amdgcn_s_getreg((3 << 11) | 20) & 0xFu; }
#define XB_SPIN(cond, bar) do { unsigned _sp = 0; while (cond) { __builtin_amdgcn_s_sleep(1); \
    if ((++_sp & 255u) == 0u) { if (xb_ld(&(bar)[XB_TMO])) break; if (_sp > XB_SPIN_CAP) { atomicAdd(&(bar)[XB_TMO], 1u); break; } } } } while (0)
struct XcdBarrier { unsigned* bar; unsigned x; volatile LAS unsigned* st; };
__device__ __forceinline__ XcdBarrier xcd_barrier_post(unsigned* bar, volatile LAS unsigned* st) {
    XcdBarrier b; b.bar = bar; b.x = xb_xcc_id(); b.st = st;
    if (threadIdx.x == 0) (void)xb_add(&bar[XB_XCNT(b.x)], 1u);
    return b;
}
__device__ __forceinline__ void xcd_barrier_complete(unsigned* bar, unsigned x, unsigned& nloc, unsigned& nx) {
    const unsigned G = gridDim.x;
    unsigned sum, cnt, mine, sp = 0u;
    for (;;) {
        sum = 0u; cnt = 0u; mine = 0u;
#pragma unroll
        for (unsigned j = 0; j < 16; ++j) { const unsigned c = xb_ld(&bar[XB_XCNT(j)]); sum += c; cnt += (c > 0u) ? 1u : 0u; mine = (j == x) ? c : mine; }
        if (sum == G) break;
        __builtin_amdgcn_s_sleep(1);
        if ((++sp & 255u) == 0u) { if (xb_ld(&bar[XB_TMO])) break; if (sp > XB_SPIN_CAP) { atomicAdd(&bar[XB_TMO], 1u); break; } }
    }
    nloc = mine > 0u ? mine : 1u; nx = cnt > 0u ? cnt : 1u;
}
__device__ __forceinline__ void xcd_barrier(const XcdBarrier& b) {
    asm volatile("s_waitcnt vmcnt(0)" ::: "memory");
    __syncthreads();
    if (threadIdx.x == 0) {
        unsigned* bar = b.bar;
        __builtin_amdgcn_s_waitcnt(0);
        unsigned nloc = b.st[0], nx = b.st[1];
        if (nloc == 0u) { xcd_barrier_complete(bar, b.x, nloc, nx); b.st[0] = nloc; b.st[1] = nx; }
        const unsigned old = xb_add(&bar[XB_XSUB(b.x)], 1u);
        const unsigned gen = old / nloc;
        if (old + 1u == (gen + 1u) * nloc) {
            __builtin_amdgcn_fence(__ATOMIC_RELEASE, "agent");
            asm volatile("s_waitcnt vmcnt(0)" ::: "memory");
            const unsigned og = xb_add(&bar[XB_TOP], 1u);
            const unsigned tg = og / nx;
            if (og + 1u == (tg + 1u) * nx) xb_add(&bar[XB_TOPGEN], 1u);
            else XB_SPIN(xb_ld(&bar[XB_TOPGEN]) == tg, bar);
            __builtin_amdgcn_fence(__ATOMIC_ACQUIRE, "agent");
            xb_add(&bar[XB_XGEN(b.x)], 1u);
            asm volatile("s_waitcnt vmcnt(0)" ::: "memory");
        } else {
            XB_SPIN(xb_ld(&bar[XB_XGEN(b.x)]) == gen, bar);
            __builtin_amdgcn_fence(__ATOMIC_ACQUIRE, "agent");
            asm volatile("s_waitcnt vmcnt(0)" ::: "memory");
        }
    }
    __syncthreads();
}

struct Args { const void* in[23]; float* out; unsigned char* ws; int ph_lo, ph_hi; };
enum { IN_X = 0, IN_P, IN_POS, IN_MIXN, IN_AWIN, IN_AVG, IN_AWS, IN_ABS, IN_AWOUT, IN_BWIN, IN_BWOUT, IN_FFNN, IN_WG, IN_BG, IN_WE, IN_BE,
       IN_W1, IN_W3, IN_W2, IN_PLEN, IN_PLEG, IN_PLEP, IN_FINN };

struct Ctx {
    LAS unsigned char* lds;
    int tid, lane, wave, vb, nb;
    const __attribute__((address_space(4))) Args* a;
    unsigned char* ws;
};

template <int BK> struct TileK { static constexpr int NP = (BK == 64) ? 4 : 2; static constexpr int TB = 128 * BK * 2; };

template <int BK>
__device__ __forceinline__ void stage_tile(LAS unsigned char* tile, const bf16_t* const (&rp)[TileK<BK>::NP], int k0, int tid) {
    const int lc = (BK == 64) ? ((tid & 7) ^ ((tid >> 3) & 7)) : ((tid & 3) ^ ((tid >> 3) & 3));
#pragma unroll
    for (int p = 0; p < TileK<BK>::NP; ++p)
        __builtin_amdgcn_global_load_lds((const unsigned*)(rp[p] + k0 + lc * 8), (LAS unsigned*)(tile + p * 4096 + tid * 16), 16, 0, 0);
}
template <int BK>
__device__ __forceinline__ void rows_regular(const bf16_t* (&rp)[TileK<BK>::NP], const bf16_t* base, size_t ld, int tid) {
#pragma unroll
    for (int p = 0; p < TileK<BK>::NP; ++p) { const int r = (BK == 64) ? (p * 32 + (tid >> 3)) : (p * 64 + (tid >> 2)); rp[p] = base + (size_t)r * ld; }
}
template <int BK>
__device__ __forceinline__ int frag_off(int row, int ks, int fq) {
    return (BK == 64) ? (row * 128 + (((ks * 4 + fq) ^ (row & 7)) << 4)) : (row * 64 + ((fq ^ ((row >> 1) & 3)) << 4));
}

template <int BK, int NBOP, bool SWAP>
__device__ __forceinline__ void gemm_loop(const Ctx& c, const bf16_t* const (&ap)[TileK<BK>::NP], const bf16_t* const (&b0p)[TileK<BK>::NP], const bf16_t* const (&b1p)[TileK<BK>::NP],
                                          int K, f32x4 (&acc0)[4][4], f32x4 (&acc1)[4][4]) {
    constexpr int TB = TileK<BK>::TB, SB = (1 + NBOP) * TB;
    static_assert(2 * SB <= LDS_MAIN, "lds");
    const int nk = K / BK, tid = c.tid;
    const int fr = c.lane & 15, fq = c.lane >> 4, wr = c.wave >> 1, wc = c.wave & 1;
    LAS unsigned char* lds = c.lds;
    stage_tile<BK>(lds, ap, 0, tid); stage_tile<BK>(lds + TB, b0p, 0, tid);
    if (NBOP == 2) stage_tile<BK>(lds + 2 * TB, b1p, 0, tid);
    for (int kt = 0; kt < nk; ++kt) {
        VM_WAIT();
        __syncthreads();
        LAS unsigned char* cur = lds + (kt & 1) * SB;
        if (kt + 1 < nk) {
            LAS unsigned char* nxt = lds + ((kt + 1) & 1) * SB;
            stage_tile<BK>(nxt, ap, (kt + 1) * BK, tid); stage_tile<BK>(nxt + TB, b0p, (kt + 1) * BK, tid);
            if (NBOP == 2) stage_tile<BK>(nxt + 2 * TB, b1p, (kt + 1) * BK, tid);
        }
#pragma unroll
        for (int ks = 0; ks < BK / 32; ++ks) {
            bf16x8 af[4], bf0[4], bf1[4];
#pragma unroll
            for (int m = 0; m < 4; ++m) af[m] = *(const LAS bf16x8*)(cur + frag_off<BK>(wr * 64 + m * 16 + fr, ks, fq));
#pragma unroll
            for (int n = 0; n < 4; ++n) bf0[n] = *(const LAS bf16x8*)(cur + TB + frag_off<BK>(wc * 64 + n * 16 + fr, ks, fq));
            if (NBOP == 2) {
#pragma unroll
                for (int n = 0; n < 4; ++n) bf1[n] = *(const LAS bf16x8*)(cur + 2 * TB + frag_off<BK>(wc * 64 + n * 16 + fr, ks, fq));
            }
#pragma unroll
            for (int m = 0; m < 4; ++m)
#pragma unroll
                for (int n = 0; n < 4; ++n) {
                    if (SWAP) acc0[m][n] = __builtin_amdgcn_mfma_f32_16x16x32_bf16(bf0[n], af[m], acc0[m][n], 0, 0, 0);
                    else      acc0[m][n] = __builtin_amdgcn_mfma_f32_16x16x32_bf16(af[m], bf0[n], acc0[m][n], 0, 0, 0);
                    if (NBOP == 2) {
                        if (SWAP) acc1[m][n] = __builtin_amdgcn_mfma_f32_16x16x32_bf16(bf1[n], af[m], acc1[m][n], 0, 0, 0);
                        else      acc1[m][n] = __builtin_amdgcn_mfma_f32_16x16x32_bf16(af[m], bf1[n], acc1[m][n], 0, 0, 0);
                    }
                }
        }
    }
    __syncthreads();
}
__device__ __forceinline__ void zero_acc(f32x4 (&acc)[4][4]) {
#pragma unroll
    for (int m = 0; m < 4; ++m)
#pragma unroll
        for (int n = 0; n < 4; ++n) acc[m][n] = (f32x4){0.f, 0.f, 0.f, 0.f};
}
__device__ __forceinline__ void map_unit(int u, int nnt, int& mt, int& nt) { const int per = 8 * nnt, band = u / per, r = u - band * per; nt = r >> 3; mt = band * 8 + (r & 7); }


__device__ __forceinline__ float gelu_tanh(float x) {
    const float y2 = 1.5957691216057308f * (x + 0.044715f * x * x * x);
    return x / (1.f + __expf(-y2));
}
__device__ __forceinline__ float sigmoidf_(float x) { return 1.f / (1.f + __expf(-x)); }

__device__ __forceinline__ void row_load(const float* row, int lane, f32x4 (&v)[4]) {
#pragma unroll
    for (int j = 0; j < 4; ++j) v[j] = ((const f32x4*)row)[lane + 64 * j];
}
__device__ __forceinline__ float row_sumsq(const f32x4 (&v)[4]) {
    float s = 0.f;
#pragma unroll
    for (int j = 0; j < 4; ++j) s += (v[j].x * v[j].x + v[j].y * v[j].y) + (v[j].z * v[j].z + v[j].w * v[j].w);
    return wave_sum(s);
}
__device__ __forceinline__ void row_store_norm_bf16(bf16_t* orow, int lane, const f32x4 (&v)[4], float r, const float* gain) {
#pragma unroll
    for (int j = 0; j < 4; ++j) {
        const f32x4 g = ((const f32x4*)gain)[lane + 64 * j];
        u32x2 o; o.x = pk_bf16(v[j].x * r * g.x, v[j].y * r * g.y); o.y = pk_bf16(v[j].z * r * g.z, v[j].w * r * g.w);
        ((u32x2*)orow)[lane + 64 * j] = o;
    }
}

constexpr int TR_SCR = 64 * 136;
__device__ __forceinline__ void transpose_item(const float* W, int K, int N, int nvalid, int ldw, bf16_t* WT, LAS unsigned char* scr, int item, int lane) {
    const int nblk = N / 64, kb = item / nblk, nb = item - kb * nblk, k0 = 64 * kb, n0 = 64 * nb;
    const int n = n0 + 4 * (lane & 15);
#pragma unroll 4
    for (int i = 0; i < 16; ++i) {
        const int kk = 4 * i + (lane >> 4);
        f32x4 v = {0.f, 0.f, 0.f, 0.f};
        if (n < nvalid) v = *(const f32x4*)(W + (size_t)(k0 + kk) * ldw + n);
        u32x2 o; o.x = pk_bf16(v.x, v.y); o.y = pk_bf16(v.z, v.w);
        *(LAS u32x2*)(scr + kk * 136 + (lane & 15) * 8) = o;
    }
    LDS_WAIT();
    const int cc = lane & 7;
#pragma unroll
    for (int j = 0; j < 8; ++j) {
        const int nn = (lane >> 3) + 8 * j; const LAS unsigned short* sp = (const LAS unsigned short*)(scr + (8 * cc) * 136 + nn * 2);
        u32x4 o;
        o.x = (unsigned)sp[0 * 68] | ((unsigned)sp[1 * 68] << 16); o.y = (unsigned)sp[2 * 68] | ((unsigned)sp[3 * 68] << 16);
        o.z = (unsigned)sp[4 * 68] | ((unsigned)sp[5 * 68] << 16); o.w = (unsigned)sp[6 * 68] | ((unsigned)sp[7 * 68] << 16);
        *(u32x4*)(WT + (size_t)(n0 + nn) * K + k0 + 8 * cc) = o;
    }
    LDS_WAIT();
}
__device__ __forceinline__ void convert_moe_layer(const Ctx& c, int l) {
    LAS unsigned char* scr = c.lds + c.wave * TR_SCR;
    const int gw = c.vb * 4 + c.wave, ngw = c.nb * 4;
    const float* w1 = (const float*)c.a->in[IN_W1] + (size_t)l * NE * D * DE;
    const float* w3 = (const float*)c.a->in[IN_W3] + (size_t)l * NE * D * DE;
    const float* w2 = (const float*)c.a->in[IN_W2] + (size_t)l * NE * DE * D;
    bf16_t* W1 = (bf16_t*)(c.ws + WS_W1); bf16_t* W3 = (bf16_t*)(c.ws + WS_W3); bf16_t* W2 = (bf16_t*)(c.ws + WS_W2);
    for (int it = gw; it < NE * 384; it += ngw) {
        const int e = it / 384, r = it - e * 384;
        if (r < 128)      transpose_item(w1 + (size_t)e * D * DE, D, DE, DE, DE, W1 + (size_t)e * DE * D, scr, r, c.lane);
        else if (r < 256) transpose_item(w3 + (size_t)e * D * DE, D, DE, DE, DE, W3 + (size_t)e * DE * D, scr, r - 128, c.lane);
        else              transpose_item(w2 + (size_t)e * DE * D, DE, D, D, D, W2 + (size_t)e * D * DE, scr, r - 256, c.lane);
    }
}

__device__ __forceinline__ void phase_prep(const Ctx& c) {
    const __attribute__((address_space(4))) Args& a = *c.a;
    LAS unsigned char* scr = c.lds + c.wave * TR_SCR;
    const int gw = c.vb * 4 + c.wave, ngw = c.nb * 4;
    constexpr int I_AIN = 16 * 64, I_AOUT = 32 * 16, I_BIN = 16 * 34, I_BOUT = 16 * 16, I_PG = 16 * 16, I_PP = 4 * 16;
    constexpr int NIT = I_AIN + I_AOUT + I_BIN + I_BOUT + 2 * I_PG + 2 * I_PP;
    for (int it = gw; it < NIT; it += ngw) {
        int r = it;
        if (r < I_AIN) { transpose_item((const float*)a.in[IN_AWIN], D, 4096, 4096, 4096, (bf16_t*)(c.ws + WS_WAIN), scr, r, c.lane); continue; } r -= I_AIN;
        if (r < I_AOUT) { transpose_item((const float*)a.in[IN_AWOUT], GW, D, D, D, (bf16_t*)(c.ws + WS_WAOUT), scr, r, c.lane); continue; } r -= I_AOUT;
        if (r < I_BIN) { transpose_item((const float*)a.in[IN_BWIN], D, BINP, BIN, BIN, (bf16_t*)(c.ws + WS_WBIN), scr, r, c.lane); continue; } r -= I_BIN;
        if (r < I_BOUT) { transpose_item((const float*)a.in[IN_BWOUT], D, D, D, D, (bf16_t*)(c.ws + WS_WBOUT), scr, r, c.lane); continue; } r -= I_BOUT;
        if (r < 2 * I_PG) { const int l = r / I_PG; transpose_item((const float*)a.in[IN_PLEG] + (size_t)l * D * D, D, D, D, D, (bf16_t*)(c.ws + WS_WGATE) + (size_t)l * D * D, scr, r - l * I_PG, c.lane); continue; } r -= 2 * I_PG;
        { const int l = r / I_PP; transpose_item((const float*)a.in[IN_PLEP] + (size_t)l * PLE * D, PLE, D, D, D, (bf16_t*)(c.ws + WS_WPROJ) + (size_t)l * D * PLE, scr, r - l * I_PP, c.lane); }
    }
    convert_moe_layer(c, 0);
    const int gt = c.vb * NTH + c.tid, ngt = c.nb * NTH;
    { const float* p = (const float*)a.in[IN_P]; bf16_t* pb = (bf16_t*)(c.ws + WS_PBF);
      for (int i = gt; i < 2 * T * PLE / 8; i += ngt) {
          const f32x4 v0 = ((const f32x4*)p)[2 * i], v1 = ((const f32x4*)p)[2 * i + 1];
          u32x4 o; o.x = pk_bf16(v0.x, v0.y); o.y = pk_bf16(v0.z, v0.w); o.z = pk_bf16(v1.x, v1.y); o.w = pk_bf16(v1.z, v1.w);
          ((u32x4*)pb)[i] = o; } }
    { float* wr = (float*)(c.ws + WS_WR);
      for (int i = gt; i < 2 * D * 48; i += ngt) {
          const int l = i / (D * 48), r = i - l * D * 48, k = r / 48, o = r - k * 48;
          float w = 0.f;
          if (o < 4) w = ((const float*)a.in[IN_WG])[(size_t)l * D * 4 + k * 4 + o];
          else if (o < 36) w = ((const float*)a.in[IN_WE])[(size_t)l * D * 32 + k * 32 + (o - 4)];
          wr[i] = w * ((const float*)a.in[IN_FFNN])[l * D + k]; } }
    if (c.vb == 0 && c.tid < 128) ((int*)(c.ws + WS_CNT))[c.tid] = 0;
    for (int t = gw; t < T; t += ngw) {
        f32x4 v[4]; row_load((const float*)a.in[IN_X] + (size_t)t * D, c.lane, v);
        const float r = rsqrtf(row_sumsq(v) * (1.f / D) + EPS);
        row_store_norm_bf16((bf16_t*)(c.ws + WS_XN) + (size_t)t * D, c.lane, v, r, (const float*)a.in[IN_MIXN]);
    }
}

__device__ __forceinline__ void phase_a1(const Ctx& c) {
    const bf16_t* XN = (const bf16_t*)(c.ws + WS_XN); const bf16_t* W = (const bf16_t*)(c.ws + WS_WAIN);
    bf16_t* U = (bf16_t*)(c.ws + WS_U); bf16_t* VT = (bf16_t*)(c.ws + WS_VT); float* VSS = (float*)(c.ws + WS_VSS);
    const int fr = c.lane & 15, fq = c.lane >> 4, wr = c.wave >> 1, wc = c.wave & 1;
    for (int u = c.vb; u < 128 * 32; u += c.nb) {
        int mt, nt; map_unit(u, 32, mt, nt);
        const bf16_t* ap[4]; const bf16_t* bp[4];
        rows_regular<64>(ap, XN + (size_t)mt * 128 * D, D, c.tid); rows_regular<64>(bp, W + (size_t)nt * 128 * D, D, c.tid);
        f32x4 acc[4][4]; zero_acc(acc);
        if (nt < 16) {
            gemm_loop<64, 1, true>(c, ap, bp, bp, D, acc, acc);
#pragma unroll
            for (int m = 0; m < 4; ++m)
#pragma unroll
                for (int n = 0; n < 4; ++n) {
                    const int t = mt * 128 + wr * 64 + m * 16 + fr, col = nt * 128 + wc * 64 + n * 16 + fq * 4;
                    const f32x4 v = acc[m][n];
                    u32x2 o; o.x = pk_bf16(gelu_tanh(v.x), gelu_tanh(v.y)); o.y = pk_bf16(gelu_tanh(v.z), gelu_tanh(v.w));
                    *(u32x2*)(U + (size_t)t * GW + col) = o;
                }
        } else {
            gemm_loop<64, 1, false>(c, ap, bp, bp, D, acc, acc);
            const int vn = nt - 16;
#pragma unroll
            for (int m = 0; m < 4; ++m) {
                f32x4 ss = {0.f, 0.f, 0.f, 0.f};
                const int t0 = mt * 128 + wr * 64 + m * 16 + fq * 4;
#pragma unroll
                for (int n = 0; n < 4; ++n) {
                    const int ch = vn * 128 + wc * 64 + n * 16 + fr;
                    f32x4 v = acc[m][n];
                    v.x = gelu_tanh(v.x); v.y = gelu_tanh(v.y); v.z = gelu_tanh(v.z); v.w = gelu_tanh(v.w);
                    ss += v * v;
                    u32x2 o; o.x = pk_bf16(v.x, v.y); o.y = pk_bf16(v.z, v.w);
                    *(u32x2*)(VT + (size_t)ch * T + t0) = o;
                }
#pragma unroll
                for (int o = 1; o < 16; o <<= 1) { ss.x += __shfl_xor(ss.x, o); ss.y += __shfl_xor(ss.y, o); ss.z += __shfl_xor(ss.z, o); ss.w += __shfl_xor(ss.w, o); }
                if (fr == 0) {
                    VSS[(size_t)(t0 + 0) * 32 + vn * 2 + wc] = ss.x; VSS[(size_t)(t0 + 1) * 32 + vn * 2 + wc] = ss.y;
                    VSS[(size_t)(t0 + 2) * 32 + vn * 2 + wc] = ss.z; VSS[(size_t)(t0 + 3) * 32 + vn * 2 + wc] = ss.w;
                }
            }
        }
    }
}

__device__ __forceinline__ void phase_a2(const Ctx& c, bool dry = false) {
    const __attribute__((address_space(4))) Args& a = *c.a;
    bf16_t* U = (bf16_t*)(c.ws + WS_U); const bf16_t* VT = (const bf16_t*)(c.ws + WS_VT); const float* VSS = (const float*)(c.ws + WS_VSS);
    const float* ws_ = (const float*)a.in[IN_AWS]; const float* bs_ = (const float*)a.in[IN_ABS]; const float* vg = (const float*)a.in[IN_AVG];
    const int fr = c.lane & 15, fq = c.lane >> 4, wr = c.wave >> 1, wc = c.wave & 1, tid = c.tid;
    LAS unsigned char* lds = c.lds;
    LAS float* rl = (LAS float*)(lds + LDS_MAIN);
    for (int u = c.vb; u < 128 * 8; u += c.nb) {
        const int ci = u >> 3, g = u & 7, tokbase = ci * 128;
        __syncthreads();
        if (tid < 128) {
            const float* p = VSS + (size_t)(tokbase + tid) * 32; float s = 0.f;
#pragma unroll
            for (int i = 0; i < 8; ++i) { const f32x4 q = ((const f32x4*)p)[i]; s += (q.x + q.y) + (q.z + q.w); }
            rl[tid] = rsqrtf(s * (1.f / GW) + EPS);
        }
        __syncthreads();
        {
            const int t = tid >> 1, half = tid & 1;
            const float* wrow = ws_ + ((size_t)g * 128 + t) * 128 + half * 64;
#pragma unroll
            for (int cc = 0; cc < 8; ++cc) {
                const int s0 = half * 64 + cc * 8;
                u32x4 o = {0u, 0u, 0u, 0u};
                if (s0 <= t) {
                    const f32x4 w0 = ((const f32x4*)wrow)[2 * cc], w1 = ((const f32x4*)wrow)[2 * cc + 1];
                    float e[8] = {w0.x, w0.y, w0.z, w0.w, w1.x, w1.y, w1.z, w1.w};
#pragma unroll
                    for (int i = 0; i < 8; ++i) e[i] = (s0 + i <= t) ? e[i] * rl[s0 + i] : 0.f;
                    o.x = pk_bf16(e[0], e[1]); o.y = pk_bf16(e[2], e[3]); o.z = pk_bf16(e[4], e[5]); o.w = pk_bf16(e[6], e[7]);
                }
                *(LAS u32x4*)(lds + half * 16384 + t * 128 + ((cc ^ (t & 7)) << 4)) = o;
            }
        }
        for (int hn = 0; hn < 2; ++hn) {
            const int c0 = g * 256 + hn * 128;
            const bf16_t* bp[4]; rows_regular<64>(bp, VT + (size_t)c0 * T + tokbase, T, tid);
            stage_tile<64>(lds + 32768, bp, 0, tid); stage_tile<64>(lds + 32768 + 16384, bp, 64, tid);
            VM_WAIT();
            __syncthreads();
            f32x4 acc[4][4]; zero_acc(acc);
#pragma unroll 1
            for (int kh = 0; kh < 2; ++kh)
#pragma unroll 1
                for (int ks = 0; ks < 2; ++ks) {
                    bf16x8 af[4], bf[4];
#pragma unroll
                    for (int m = 0; m < 4; ++m) af[m] = *(const LAS bf16x8*)(lds + kh * 16384 + frag_off<64>(wr * 64 + m * 16 + fr, ks, fq));
#pragma unroll
                    for (int n = 0; n < 4; ++n) bf[n] = *(const LAS bf16x8*)(lds + 32768 + kh * 16384 + frag_off<64>(wc * 64 + n * 16 + fr, ks, fq));
#pragma unroll
                    for (int m = 0; m < 4; ++m)
#pragma unroll
                        for (int n = 0; n < 4; ++n) acc[m][n] = __builtin_amdgcn_mfma_f32_16x16x32_bf16(bf[n], af[m], acc[m][n], 0, 0, 0);
                }
#pragma unroll
            for (int m = 0; m < 4; ++m) {
                const int tl = wr * 64 + m * 16 + fr; const float bsv = bs_[g * 128 + tl];
#pragma unroll
                for (int n = 0; n < 4; ++n) {
                    const int ch = c0 + wc * 64 + n * 16 + fq * 4;
                    const f32x4 gn = *(const f32x4*)(vg + ch);
                    u32x2* up = (u32x2*)(U + (size_t)(tokbase + tl) * GW + ch);
                    const u32x2 uv = *up; const f32x4 v = acc[m][n];
                    u32x2 o;
                    o.x = pk_bf16(bf_lo(uv.x) * (gn.x * v.x + bsv), bf_hi(uv.x) * (gn.y * v.y + bsv));
                    o.y = pk_bf16(bf_lo(uv.y) * (gn.z * v.z + bsv), bf_hi(uv.y) * (gn.w * v.w + bsv));
                    if (dry) *(u32x2*)(c.ws + 440 * MB + ((size_t)(tokbase + tl) * GW + ch) * 2) = o; else *up = o;
                }
            }
            __syncthreads();
        }
    }
}

__device__ __forceinline__ void phase_a3(const Ctx& c) {
    const bf16_t* Z = (const bf16_t*)(c.ws + WS_U); const bf16_t* W = (const bf16_t*)(c.ws + WS_WAOUT);
    const float* X = (const float*)c.a->in[IN_X]; float* H = (float*)(c.ws + WS_H);
    const int fr = c.lane & 15, fq = c.lane >> 4, wr = c.wave >> 1, wc = c.wave & 1;
    for (int u = c.vb; u < 128 * 8; u += c.nb) {
        int mt, nt; map_unit(u, 8, mt, nt);
        const bf16_t* ap[4]; const bf16_t* bp[4];
        rows_regular<64>(ap, Z + (size_t)mt * 128 * GW, GW, c.tid); rows_regular<64>(bp, W + (size_t)nt * 128 * GW, GW, c.tid);
        f32x4 acc[4][4]; zero_acc(acc);
        gemm_loop<64, 1, true>(c, ap, bp, bp, GW, acc, acc);
#pragma unroll
        for (int m = 0; m < 4; ++m)
#pragma unroll
            for (int n = 0; n < 4; ++n) {
                const size_t off = (size_t)(mt * 128 + wr * 64 + m * 16 + fr) * D + nt * 128 + wc * 64 + n * 16 + fq * 4;
                *(f32x4*)(H + off) = *(const f32x4*)(X + off) + acc[m][n];
            }
    }
}

__device__ __forceinline__ void phase_route(const Ctx& c, int l, bool dry = false) {
    const __attribute__((address_space(4))) Args& a = *c.a;
    const float* H = (const float*)(c.ws + WS_H); bf16_t* XN = (bf16_t*)(c.ws + (dry ? 440 * MB : WS_XN));
    const float* wr_ = (const float*)(c.ws + WS_WR) + (size_t)l * D * 48;
    const float* gain = (const float*)a.in[IN_FFNN] + l * D;
    int* cnt = (int*)(c.ws + WS_CNT) + l * 32 + (dry ? 64 : 0); int* list = (int*)(c.ws + (dry ? 480 * MB : WS_LIST)); float* gatel = (float*)(c.ws + (dry ? 484 * MB : WS_GATE)); int* tokslot = (int*)(c.ws + (dry ? 488 * MB : WS_TOKSLOT));
    LAS float* rl = (LAS float*)(c.lds);
    LAS float* lgl = (LAS float*)(c.lds + 256);
    const int lane = c.lane, w = c.wave;
    for (int unit = c.vb; unit < T / 32; unit += c.nb) {
        const int tok0 = unit * 32;
        __syncthreads();
        for (int i = 0; i < 8; ++i) {
            const int t = tok0 + w * 8 + i;
            f32x4 v[4]; row_load(H + (size_t)t * D, lane, v);
            const float r = rsqrtf(row_sumsq(v) * (1.f / D) + EPS);
            if (lane == 0) rl[w * 8 + i] = r;
            row_store_norm_bf16(XN + (size_t)t * D, lane, v, r, gain);
        }
        {
            const int th = w & 1, kh = w >> 1, m = lane & 15, q = lane >> 4;
            const float* arow = H + (size_t)(tok0 + 16 * th + m) * D + 512 * kh + 128 * q;
            const float* brow = wr_ + (size_t)(512 * kh + 128 * q) * 48 + m;
            f32x4 acc[3]; acc[0] = acc[1] = acc[2] = (f32x4){0.f, 0.f, 0.f, 0.f};
            for (int i = 0; i < 32; ++i) {
                const f32x4 av = ((const f32x4*)arow)[i];
                const float ae[4] = {av.x, av.y, av.z, av.w};
#pragma unroll
                for (int e = 0; e < 4; ++e) {
                    const float* bp = brow + (size_t)(4 * i + e) * 48;
#pragma unroll
                    for (int nt = 0; nt < 3; ++nt) acc[nt] = __builtin_amdgcn_mfma_f32_16x16x4f32(ae[e], bp[nt * 16], acc[nt], 0, 0, 0);
                }
            }
#pragma unroll
            for (int nt = 0; nt < 3; ++nt)
#pragma unroll
                for (int j = 0; j < 4; ++j) lgl[(kh * 32 + th * 16 + 4 * q + j) * 48 + nt * 16 + m] = acc[nt][j];
        }
        __syncthreads();
        if (c.tid < 32) {
            const int tt = c.tid, t = tok0 + tt; const float r = rl[tt];
            const float* bg = (const float*)a.in[IN_BG] + l * 4; const float* be = (const float*)a.in[IN_BE] + l * 32;
            float gl[4];
#pragma unroll
            for (int o = 0; o < 4; ++o) gl[o] = (lgl[tt * 48 + o] + lgl[(32 + tt) * 48 + o]) * r + bg[o];
            int gs = 0; float gm = gl[0];
#pragma unroll
            for (int o = 1; o < 4; ++o) if (gl[o] > gm) { gm = gl[o]; gs = o; }
            float gden = 0.f;
#pragma unroll
            for (int o = 0; o < 4; ++o) gden += __expf(gl[o] - gm);
            const float pg = 1.f / gden;
            float l1 = -INFINITY, l2 = -INFINITY; int i1 = 0, i2 = 0;
            for (int i = 0; i < 8; ++i) {
                const int o = 4 + gs * 8 + i;
                const float v = (lgl[tt * 48 + o] + lgl[(32 + tt) * 48 + o]) * r + be[gs * 8 + i];
                if (v > l1) { l2 = l1; i2 = i1; l1 = v; i1 = i; } else if (v > l2) { l2 = v; i2 = i; }
            }
            const float e2 = __expf(l2 - l1), inv = 1.f / (1.f + e2);
            const float g1 = pg * inv, g2 = pg * e2 * inv;
            const int ea = gs * 8 + i1, eb = gs * 8 + i2;
            const int sa = atomicAdd(&cnt[ea], 1), sb = atomicAdd(&cnt[eb], 1);
            list[ea * T + sa] = t; gatel[ea * T + sa] = g1; tokslot[2 * t] = (ea << 16) | sa;
            list[eb * T + sb] = t; gatel[eb * T + sb] = g2; tokslot[2 * t + 1] = (eb << 16) | sb;
        }
    }
}

__device__ __forceinline__ void moe_table(const Ctx& c, int l, LAS int* pst, LAS int* cn) {
    __syncthreads();
    if (c.tid == 0) {
        const int* cnt = (const int*)(c.ws + WS_CNT) + l * 32; int acc = 0;
        for (int e = 0; e < 32; ++e) { const int n = cnt[e]; cn[e] = n; pst[e] = acc; acc += (n + 127) >> 7; }
        pst[32] = acc;
    }
    __syncthreads();
}
__device__ __forceinline__ int moe_find(LAS const int* pst, int mb) { int e = 0; for (int i = 1; i < 32; ++i) e = (pst[i] <= mb) ? i : e; return e; }

__device__ __forceinline__ void phase_e1(const Ctx& c, int l) {
    const bf16_t* XN = (const bf16_t*)(c.ws + WS_XN); const bf16_t* W1 = (const bf16_t*)(c.ws + WS_W1); const bf16_t* W3 = (const bf16_t*)(c.ws + WS_W3);
    bf16_t* HM = (bf16_t*)(c.ws + WS_HMID); const int* list = (const int*)(c.ws + WS_LIST);
    LAS int* pst = (LAS int*)(c.lds + LDS_MAIN); LAS int* cn = pst + 40;
    moe_table(c, l, pst, cn);
    const int fr = c.lane & 15, fq = c.lane >> 4, wr = c.wave >> 1, wc = c.wave & 1, tid = c.tid;
    const int nunits = pst[32] * 4;
    for (int u = c.vb; u < nunits; u += c.nb) {
        const int mb = u >> 2, nt = u & 3, e = moe_find(pst, mb), row0 = (mb - pst[e]) * 128, count = cn[e];
        const bf16_t* ap[2]; const bf16_t* b0[2]; const bf16_t* b1[2];
#pragma unroll
        for (int p = 0; p < 2; ++p) { int r = row0 + p * 64 + (tid >> 2); r = r < count ? r : row0; ap[p] = XN + (size_t)list[e * T + r] * D; }
        rows_regular<32>(b0, W1 + ((size_t)e * DE + nt * 128) * D, D, tid); rows_regular<32>(b1, W3 + ((size_t)e * DE + nt * 128) * D, D, tid);
        f32x4 a1[4][4], a3[4][4]; zero_acc(a1); zero_acc(a3);
        gemm_loop<32, 2, true>(c, ap, b0, b1, D, a1, a3);
#pragma unroll
        for (int m = 0; m < 4; ++m)
#pragma unroll
            for (int n = 0; n < 4; ++n) {
                const size_t row = (size_t)mb * 128 + wr * 64 + m * 16 + fr; const int col = nt * 128 + wc * 64 + n * 16 + fq * 4;
                const f32x4 x = a1[m][n], y = a3[m][n];
                u32x2 o; o.x = pk_bf16(x.x * sigmoidf_(x.x) * y.x, x.y * sigmoidf_(x.y) * y.y); o.y = pk_bf16(x.z * sigmoidf_(x.z) * y.z, x.w * sigmoidf_(x.w) * y.w);
                *(u32x2*)(HM + row * DE + col) = o;
            }
    }
}
__device__ __forceinline__ void phase_e2(const Ctx& c, int l) {
    const bf16_t* HM = (const bf16_t*)(c.ws + WS_HMID); const bf16_t* W2 = (const bf16_t*)(c.ws + WS_W2);
    bf16_t* Y = (bf16_t*)(c.ws + WS_Y); const float* gatel = (const float*)(c.ws + WS_GATE);
    LAS int* pst = (LAS int*)(c.lds + LDS_MAIN); LAS int* cn = pst + 40;
    moe_table(c, l, pst, cn);
    const int fr = c.lane & 15, fq = c.lane >> 4, wr = c.wave >> 1, wc = c.wave & 1, tid = c.tid;
    const int nunits = pst[32] * 8;
    for (int u = c.vb; u < nunits; u += c.nb) {
        const int mb = u >> 3, nt = u & 7, e = moe_find(pst, mb), row0 = (mb - pst[e]) * 128, count = cn[e];
        const bf16_t* ap[4]; const bf16_t* bp[4];
        rows_regular<64>(ap, HM + (size_t)mb * 128 * DE, DE, tid); rows_regular<64>(bp, W2 + ((size_t)e * D + nt * 128) * DE, DE, tid);
        f32x4 acc[4][4]; zero_acc(acc);
        gemm_loop<64, 1, true>(c, ap, bp, bp, DE, acc, acc);
#pragma unroll
        for (int m = 0; m < 4; ++m) {
            const int rl_ = wr * 64 + m * 16 + fr; const float gt = (row0 + rl_ < count) ? gatel[e * T + row0 + rl_] : 0.f;
#pragma unroll
            for (int n = 0; n < 4; ++n) {
                const f32x4 v = acc[m][n] * gt;
                u32x2 o; o.x = pk_bf16(v.x, v.y); o.y = pk_bf16(v.z, v.w);
                *(u32x2*)(Y + ((size_t)mb * 128 + rl_) * D + nt * 128 + wc * 64 + n * 16 + fq * 4) = o;
            }
        }
    }
}
__device__ __forceinline__ void phase_p1(const Ctx& c, int l, bool dry = false) {
    float* H = (float*)(c.ws + WS_H); float* HO = (float*)(c.ws + (dry ? 440 * MB : WS_H)); bf16_t* XN = (bf16_t*)(c.ws + (dry ? 440 * MB : WS_XN)); const bf16_t* Y = (const bf16_t*)(c.ws + WS_Y);
    const int* tokslot = (const int*)(c.ws + WS_TOKSLOT); const float* gain = (const float*)c.a->in[IN_PLEN] + l * D;
    LAS int* pst = (LAS int*)(c.lds + LDS_MAIN); LAS int* cn = pst + 40;
    moe_table(c, l, pst, cn);
    const int gw = c.vb * 4 + c.wave, ngw = c.nb * 4, lane = c.lane;
    for (int t = gw; t < T; t += ngw) {
        const int s0 = tokslot[2 * t], s1 = tokslot[2 * t + 1];
        const bf16_t* y0 = Y + ((size_t)pst[s0 >> 16] * 128 + (s0 & 0xffff)) * D; const bf16_t* y1 = Y + ((size_t)pst[s1 >> 16] * 128 + (s1 & 0xffff)) * D;
        f32x4 v[4]; row_load(H + (size_t)t * D, lane, v);
#pragma unroll
        for (int j = 0; j < 4; ++j) {
            const u32x2 a0 = ((const u32x2*)y0)[lane + 64 * j], a1 = ((const u32x2*)y1)[lane + 64 * j];
            v[j].x += bf_lo(a0.x) + bf_lo(a1.x); v[j].y += bf_hi(a0.x) + bf_hi(a1.x); v[j].z += bf_lo(a0.y) + bf_lo(a1.y); v[j].w += bf_hi(a0.y) + bf_hi(a1.y);
            ((f32x4*)(HO + (size_t)t * D))[lane + 64 * j] = v[j];
        }
        const float r = rsqrtf(row_sumsq(v) * (1.f / D) + EPS);
        row_store_norm_bf16(XN + (size_t)t * D, lane, v, r, gain);
    }
}
__device__ __forceinline__ void phase_p2(const Ctx& c, int l) {
    const bf16_t* XN = (const bf16_t*)(c.ws + WS_XN); const bf16_t* WG = (const bf16_t*)(c.ws + WS_WGATE) + (size_t)l * D * D;
    const bf16_t* PB = (const bf16_t*)(c.ws + WS_PBF) + (size_t)l * T * PLE; const bf16_t* WP = (const bf16_t*)(c.ws + WS_WPROJ) + (size_t)l * D * PLE;
    float* H = (float*)(c.ws + WS_H);
    const int fr = c.lane & 15, fq = c.lane >> 4, wr = c.wave >> 1, wc = c.wave & 1;
    for (int u = c.vb; u < 128 * 8; u += c.nb) {
        int mt, nt; map_unit(u, 8, mt, nt);
        const bf16_t* ap[4]; const bf16_t* bp[4];
        f32x4 ag[4][4], apj[4][4]; zero_acc(ag); zero_acc(apj);
        rows_regular<64>(ap, XN + (size_t)mt * 128 * D, D, c.tid); rows_regular<64>(bp, WG + (size_t)nt * 128 * D, D, c.tid);
        gemm_loop<64, 1, true>(c, ap, bp, bp, D, ag, ag);
        rows_regular<64>(ap, PB + (size_t)mt * 128 * PLE, PLE, c.tid); rows_regular<64>(bp, WP + (size_t)nt * 128 * PLE, PLE, c.tid);
        gemm_loop<64, 1, true>(c, ap, bp, bp, PLE, apj, apj);
#pragma unroll
        for (int m = 0; m < 4; ++m)
#pragma unroll
            for (int n = 0; n < 4; ++n) {
                const size_t off = (size_t)(mt * 128 + wr * 64 + m * 16 + fr) * D + nt * 128 + wc * 64 + n * 16 + fq * 4;
                const f32x4 g = ag[m][n], pj = apj[m][n]; f32x4 h = *(const f32x4*)(H + off);
                h.x += sigmoidf_(g.x) * pj.x; h.y += sigmoidf_(g.y) * pj.y; h.z += sigmoidf_(g.z) * pj.z; h.w += sigmoidf_(g.w) * pj.w;
                *(f32x4*)(H + off) = h;
            }
    }
}
__device__ __forceinline__ void phase_norm_bf16(const Ctx& c, const float* gain) {
    const float* H = (const float*)(c.ws + WS_H); bf16_t* XN = (bf16_t*)(c.ws + WS_XN);
    const int gw = c.vb * 4 + c.wave, ngw = c.nb * 4;
    for (int t = gw; t < T; t += ngw) {
        f32x4 v[4]; row_load(H + (size_t)t * D, c.lane, v);
        const float r = rsqrtf(row_sumsq(v) * (1.f / D) + EPS);
        row_store_norm_bf16(XN + (size_t)t * D, c.lane, v, r, gain);
    }
}
__device__ __forceinline__ void phase_final(const Ctx& c) {
    const float* H = (const float*)(c.ws + WS_H); float* O = c.a->out; const float* gain = (const float*)c.a->in[IN_FINN];
    const int gw = c.vb * 4 + c.wave, ngw = c.nb * 4;
    for (int t = gw; t < T; t += ngw) {
        f32x4 v[4]; row_load(H + (size_t)t * D, c.lane, v);
        const float r = rsqrtf(row_sumsq(v) * (1.f / D) + EPS);
#pragma unroll
        for (int j = 0; j < 4; ++j) { const f32x4 g = ((const f32x4*)gain)[c.lane + 64 * j]; ((f32x4*)(O + (size_t)t * D))[c.lane + 64 * j] = v[j] * r * g; }
    }
}

__device__ __forceinline__ void phase_b1(const Ctx& c, size_t raw_off = WS_RAW) {
    const bf16_t* XN = (const bf16_t*)(c.ws + WS_XN); const bf16_t* W = (const bf16_t*)(c.ws + WS_WBIN); bf16_t* RAW = (bf16_t*)(c.ws + raw_off);
    const int fr = c.lane & 15, fq = c.lane >> 4, wr = c.wave >> 1, wc = c.wave & 1;
    for (int u = c.vb; u < 128 * 17; u += c.nb) {
        int mt, nt; map_unit(u, 17, mt, nt);
        const bf16_t* ap[4]; const bf16_t* bp[4];
        rows_regular<64>(ap, XN + (size_t)mt * 128 * D, D, c.tid); rows_regular<64>(bp, W + (size_t)nt * 128 * D, D, c.tid);
        f32x4 acc[4][4]; zero_acc(acc);
        gemm_loop<64, 1, true>(c, ap, bp, bp, D, acc, acc);
#pragma unroll
        for (int m = 0; m < 4; ++m)
#pragma unroll
            for (int n = 0; n < 4; ++n) {
                const f32x4 v = acc[m][n]; u32x2 o; o.x = pk_bf16(v.x, v.y); o.y = pk_bf16(v.z, v.w);
                *(u32x2*)(RAW + (size_t)(mt * 128 + wr * 64 + m * 16 + fr) * BINP + nt * 128 + wc * 64 + n * 16 + fq * 4) = o;
            }
    }
}

__device__ __forceinline__ void unpack8(const u32x4 r, float (&e)[8]) { e[0] = bf_lo(r.x); e[1] = bf_hi(r.x); e[2] = bf_lo(r.y); e[3] = bf_hi(r.y); e[4] = bf_lo(r.z); e[5] = bf_hi(r.z); e[6] = bf_lo(r.w); e[7] = bf_hi(r.w); }
__device__ __forceinline__ u32x4 pack8(const float (&e)[8]) { u32x4 o; o.x = pk_bf16(e[0], e[1]); o.y = pk_bf16(e[2], e[3]); o.z = pk_bf16(e[4], e[5]); o.w = pk_bf16(e[6], e[7]); return o; }
__device__ __forceinline__ void phase_rope(const Ctx& c) {
    const bf16_t* RAW = (const bf16_t*)(c.ws + WS_RAW);
    bf16_t* Q = (bf16_t*)(c.ws + WS_Q); bf16_t* K = (bf16_t*)(c.ws + WS_K); bf16_t* V = (bf16_t*)(c.ws + WS_V);
    bf16_t* QI = (bf16_t*)(c.ws + WS_QI); bf16_t* KI = (bf16_t*)(c.ws + WS_KI); float* WI = (float*)(c.ws + WS_WI);
    const int* pos = (const int*)c.a->in[IN_POS];
    LAS float* cs = (LAS float*)(c.lds + c.wave * 256);
    const int gw = c.vb * 4 + c.wave, ngw = c.nb * 4, lane = c.lane;
    for (int t = gw; t < T; t += ngw) {
        if (lane < 24) {
            const double ex = (lane < 16) ? (double)lane * (1.0 / 16.0) : (double)(lane - 16) * (1.0 / 8.0);
            const float invf = (float)exp2(-ex * 18.931568569324174);
            const float ang = (float)pos[t] * invf;
            const double ad = (double)ang; const double n = rint(ad * 0.15915494309189535); const float red = (float)(ad - n * 6.283185307179586);
            cs[lane] = cosf(red); cs[32 + lane] = sinf(red);
        }
        LDS_WAIT();
        const bf16_t* row = RAW + (size_t)t * BINP;
        for (int ch = lane; ch < BINP / 8; ch += 64) {
            const u32x4 own = ((const u32x4*)row)[ch];
            float e[8]; unpack8(own, e);
            if (ch < 160) {
                const int cc = ch & 15;
                if (cc < 4) {
                    const u32x4 oth = ((const u32x4*)row)[ch ^ 2]; float p[8]; unpack8(oth, p);
                    const int f0 = (cc & 1) * 8;
#pragma unroll
                    for (int i = 0; i < 8; ++i) { const float co = cs[f0 + i], si = cs[32 + f0 + i]; e[i] = (cc < 2) ? (e[i] * co - p[i] * si) : (e[i] * co + p[i] * si); }
                }
                if (ch < 128) {
#pragma unroll
                    for (int i = 0; i < 8; ++i) e[i] *= 0.08838834764831845f;
                    ((u32x4*)(Q + (size_t)t * D))[ch] = pack8(e);
                } else ((u32x4*)(K + (size_t)t * 256))[ch - 128] = pack8(e);
            } else if (ch < 192) {
                ((u32x4*)(V + (size_t)t * 256))[ch - 160] = own;
            } else if (ch < 264) {
                const int cc = ch & 7;
                if (cc < 2) {
                    const u32x4 oth = ((const u32x4*)row)[ch ^ 1]; float p[8]; unpack8(oth, p);
#pragma unroll
                    for (int i = 0; i < 8; ++i) { const float co = cs[16 + i], si = cs[32 + 16 + i]; e[i] = (cc == 0) ? (e[i] * co - p[i] * si) : (e[i] * co + p[i] * si); }
                }
                if (ch < 256) ((u32x4*)(QI + (size_t)t * 512))[ch - 192] = pack8(e);
                else ((u32x4*)(KI + (size_t)t * 64))[ch - 256] = pack8(e);
            } else if (ch == 264) {
                f32x4 w0 = {e[0], e[1], e[2], e[3]}, w1 = {e[4], e[5], e[6], e[7]};
                const float sc = 0.044194173824159216f;
                ((f32x4*)(WI + (size_t)t * 8))[0] = w0 * sc; ((f32x4*)(WI + (size_t)t * 8))[1] = w1 * sc;
            }
        }
        LDS_WAIT();
    }
}

constexpr int NBINS = 2048, CAND_CAP = 512;
__device__ __forceinline__ void phase_index(const Ctx& c) {
    const bf16_t* QI = (const bf16_t*)(c.ws + WS_QI); const bf16_t* KI = (const bf16_t*)(c.ws + WS_KI); const float* WI = (const float*)(c.ws + WS_WI);
    int* SEL = (int*)(c.ws + WS_SEL);
    LAS unsigned char* lds = c.lds;
    LAS int* hist = (LAS int*)lds;
    LAS float* candv = (LAS float*)(lds + 32768);
    LAS int* candi = (LAS int*)(lds + 32768 + 8192);
    LAS float* red = (LAS float*)(lds + 49152);
    LAS float* qmn = red + 32; LAS float* qsc = qmn + 4;
    LAS int* bstar = (LAS int*)(qsc + 4); LAS int* need = bstar + 4; LAS int* ncand = need + 4;
    LAS float* thrv = (LAS float*)(ncand + 4); LAS int* thri = (LAS int*)(thrv + 4);
    LAS int* wcnt = thri + 4;
    const int lane = c.lane, hf = lane >> 5, tid = c.tid;
    for (int u = c.vb; u < T / 4; u += c.nb) {
        int col = lane & 31, w = c.wave;
        asm volatile("" : "+v"(col), "+s"(w));
        const int b = u & 3, tq = 1023 - (u >> 2), t0 = tq * 4;
        if (t0 < 256) continue;
        const int tb = b * SEQ;
        bf16x8 af[4];
        { const int rho = lane & 31, ql = 2 * ((rho >> 2) & 1) + (rho >> 4), hd = 4 * ((rho >> 3) & 1) + (rho & 3);
          const bf16_t* qp = QI + (size_t)(tb + t0 + ql) * 512 + hd * 64 + 8 * hf;
#pragma unroll
          for (int ks = 0; ks < 4; ++ks) af[ks] = *(const bf16x8*)(qp + 16 * ks); }
        f32x4 wv0a, wv0b, wv1a, wv1b;
        { const float* wp = WI + (size_t)(tb + t0 + 2 * hf) * 8; wv0a = ((const f32x4*)wp)[0]; wv0b = ((const f32x4*)wp)[1]; wv1a = ((const f32x4*)wp)[2]; wv1b = ((const f32x4*)wp)[3]; }
        const int tA = t0 + 2 * hf, tB = tA + 1;
        const int nkt = ((t0 + 3) >> 5) + 1;
        float sA[32], sB[32];
        bf16x8 nbf[4];
        { const bf16_t* kp = KI + (size_t)(tb + w * 32 + col) * 64 + 8 * hf;
#pragma unroll
          for (int ks = 0; ks < 4; ++ks) nbf[ks] = *(const bf16x8*)(kp + 16 * ks); }
#pragma unroll
        for (int i = 0; i < 32; ++i) {
            const int kt = 4 * i + w;
            float a_ = -INFINITY, b_ = -INFINITY;
            if (kt < nkt) {
                const int key = kt * 32 + col;
                bf16x8 cb[4];
#pragma unroll
                for (int ks = 0; ks < 4; ++ks) cb[ks] = nbf[ks];
                if (kt + 4 < nkt) {
                    const bf16_t* kp = KI + (size_t)(tb + key + 128) * 64 + 8 * hf;
#pragma unroll
                    for (int ks = 0; ks < 4; ++ks) nbf[ks] = *(const bf16x8*)(kp + 16 * ks);
                }
                f32x16 acc = {};
#pragma unroll
                for (int ks = 0; ks < 4; ++ks) acc = __builtin_amdgcn_mfma_f32_32x32x16_bf16(af[ks], cb[ks], acc, 0, 0, 0);
                float s0 = fmaxf(acc[0], 0.f) * wv0a.x; s0 += fmaxf(acc[1], 0.f) * wv0a.y; s0 += fmaxf(acc[2], 0.f) * wv0a.z; s0 += fmaxf(acc[3], 0.f) * wv0a.w;
                s0 += fmaxf(acc[4], 0.f) * wv0b.x; s0 += fmaxf(acc[5], 0.f) * wv0b.y; s0 += fmaxf(acc[6], 0.f) * wv0b.z; s0 += fmaxf(acc[7], 0.f) * wv0b.w;
                float s1 = fmaxf(acc[8], 0.f) * wv1a.x; s1 += fmaxf(acc[9], 0.f) * wv1a.y; s1 += fmaxf(acc[10], 0.f) * wv1a.z; s1 += fmaxf(acc[11], 0.f) * wv1a.w;
                s1 += fmaxf(acc[12], 0.f) * wv1b.x; s1 += fmaxf(acc[13], 0.f) * wv1b.y; s1 += fmaxf(acc[14], 0.f) * wv1b.z; s1 += fmaxf(acc[15], 0.f) * wv1b.w;
                a_ = (key <= tA) ? s0 : -INFINITY; b_ = (key <= tB) ? s1 : -INFINITY;
            }
            sA[i] = a_; sB[i] = b_;
            asm volatile("" ::: "memory");
        }
        float mnA = INFINITY, mxA = -INFINITY, mnB = INFINITY, mxB = -INFINITY;
#pragma unroll
        for (int i = 0; i < 32; ++i) {
            mxA = fmaxf(mxA, sA[i]); mnA = fminf(mnA, (sA[i] == -INFINITY) ? INFINITY : sA[i]);
            mxB = fmaxf(mxB, sB[i]); mnB = fminf(mnB, (sB[i] == -INFINITY) ? INFINITY : sB[i]);
        }
#pragma unroll
        for (int o = 1; o < 32; o <<= 1) { mxA = fmaxf(mxA, __shfl_xor(mxA, o)); mnA = fminf(mnA, __shfl_xor(mnA, o)); mxB = fmaxf(mxB, __shfl_xor(mxB, o)); mnB = fminf(mnB, __shfl_xor(mnB, o)); }
        __syncthreads();
        if (col == 0) { red[(w * 4 + 2 * hf) * 2] = mnA; red[(w * 4 + 2 * hf) * 2 + 1] = mxA; red[(w * 4 + 2 * hf + 1) * 2] = mnB; red[(w * 4 + 2 * hf + 1) * 2 + 1] = mxB; }
        for (int i = tid; i < 4 * NBINS; i += NTH) hist[i] = 0;
        if (tid < 4) ncand[tid] = 0;
        __syncthreads();
        if (tid < 4) {
            float mn = INFINITY, mx = -INFINITY;
            for (int ww = 0; ww < 4; ++ww) { mn = fminf(mn, red[(ww * 4 + tid) * 2]); mx = fmaxf(mx, red[(ww * 4 + tid) * 2 + 1]); }
            qmn[tid] = mn; qsc[tid] = (mx > mn) ? (float)NBINS / (mx - mn) : 0.f;
        }
        __syncthreads();
        const int qA = 2 * hf, qB = 2 * hf + 1;
        const float mnqA = qmn[qA], scA = qsc[qA], mnqB = qmn[qB], scB = qsc[qB];
#define BINOF(v, mn, sc) min(NBINS - 1, (int)(((v) - (mn)) * (sc)))
#pragma unroll
        for (int i = 0; i < 32; ++i) {
            if (sA[i] != -INFINITY) lds_inc(&hist[qA * NBINS + BINOF(sA[i], mnqA, scA)]);
            if (sB[i] != -INFINITY) lds_inc(&hist[qB * NBINS + BINOF(sB[i], mnqB, scB)]);
        }
        __syncthreads();
        {
            const LAS int* hq = hist + w * NBINS + lane * 32;
            int loc = 0;
#pragma unroll
            for (int i = 0; i < 32; ++i) loc += hq[i];
            int suf = loc;
#pragma unroll
            for (int o = 1; o < 64; o <<= 1) { const int v = __shfl_down(suf, o); if (lane + o < 64) suf += v; }
            const int above = suf - loc;
            if (above < 256 && suf >= 256) {
                int run = above, bs = 0, ab = above;
                for (int i = 31; i >= 0; --i) { const int h = hq[i]; if (run < 256 && run + h >= 256) { bs = lane * 32 + i; ab = run; } run += h; }
                bstar[w] = bs; need[w] = 256 - ab;
            }
        }
        __syncthreads();
        {
            const int bsA = bstar[qA], bsB = bstar[qB];
#pragma unroll
            for (int i = 0; i < 32; ++i) {
                const int key = (4 * i + w) * 32 + col;
                if (sA[i] != -INFINITY && BINOF(sA[i], mnqA, scA) == bsA) { const int p = lds_inc(&ncand[qA]); if (p < CAND_CAP) { candv[qA * CAND_CAP + p] = sA[i]; candi[qA * CAND_CAP + p] = key; } }
                if (sB[i] != -INFINITY && BINOF(sB[i], mnqB, scB) == bsB) { const int p = lds_inc(&ncand[qB]); if (p < CAND_CAP) { candv[qB * CAND_CAP + p] = sB[i]; candi[qB * CAND_CAP + p] = key; } }
            }
        }
        __syncthreads();
        {
            const int n = min(ncand[w], CAND_CAP), nd = need[w];
            for (int i = lane; i < n; i += 64) {
                const float v = candv[w * CAND_CAP + i]; const int id = candi[w * CAND_CAP + i];
                int rank = 0;
                for (int j = 0; j < n; ++j) { const float vj = candv[w * CAND_CAP + j]; const int ij = candi[w * CAND_CAP + j]; rank += (vj > v || (vj == v && ij < id)) ? 1 : 0; }
                if (rank == nd - 1) { thrv[w] = v; thri[w] = id; }
            }
        }
        __syncthreads();
        const float tvA = thrv[qA], tvB = thrv[qB]; const int tiA = thri[qA], tiB = thri[qB];
        int cA = 0, cB = 0;
#pragma unroll
        for (int i = 0; i < 32; ++i) {
            const int key = (4 * i + w) * 32 + col;
            cA += (sA[i] > tvA || (sA[i] == tvA && key <= tiA)) ? 1 : 0;
            cB += (sB[i] > tvB || (sB[i] == tvB && key <= tiB)) ? 1 : 0;
        }
#pragma unroll
        for (int o = 1; o < 32; o <<= 1) { cA += __shfl_xor(cA, o); cB += __shfl_xor(cB, o); }
        if (col == 0) { wcnt[w * 4 + qA] = cA; wcnt[w * 4 + qB] = cB; }
        __syncthreads();
        int baseA = 0, baseB = 0;
        for (int ww = 0; ww < w; ++ww) { baseA += wcnt[ww * 4 + qA]; baseB += wcnt[ww * 4 + qB]; }
        int* selA = SEL + (size_t)(tb + tA) * 256; int* selB = SEL + (size_t)(tb + tB) * 256;
#pragma unroll
        for (int i = 0; i < 32; ++i) {
            const int key = (4 * i + w) * 32 + col;
            const bool pa = (sA[i] > tvA || (sA[i] == tvA && key <= tiA)), pb = (sB[i] > tvB || (sB[i] == tvB && key <= tiB));
            const unsigned long long ma = __ballot(pa), mb = __ballot(pb);
            const unsigned mah = hf ? (unsigned)(ma >> 32) : (unsigned)ma, mbh = hf ? (unsigned)(mb >> 32) : (unsigned)mb;
            const unsigned below = (1u << col) - 1u;
            const int posA = baseA + __popc(mah & below), posB = baseB + __popc(mbh & below);
            if (pa && posA < 256) selA[posA] = key;
            if (pb && posB < 256) selB[posB] = key;
            baseA += __popc(mah); baseB += __popc(mbh);
        }
    }
}

typedef short s16x4 __attribute__((ext_vector_type(4)));
__device__ __forceinline__ unsigned vimg_f(unsigned r) { return ((r & 3u) << 2) | ((r >> 2) & 3u); }
__device__ __forceinline__ void tr_read8(const unsigned (&ad)[8], s16x4 (&r)[8]) {
    asm volatile("ds_read_b64_tr_b16 %0, %8\n\tds_read_b64_tr_b16 %1, %9\n\tds_read_b64_tr_b16 %2, %10\n\tds_read_b64_tr_b16 %3, %11\n\t"
                 "ds_read_b64_tr_b16 %4, %12\n\tds_read_b64_tr_b16 %5, %13\n\tds_read_b64_tr_b16 %6, %14\n\tds_read_b64_tr_b16 %7, %15\n\ts_waitcnt lgkmcnt(0)"
                 : "=&v"(r[0]), "=&v"(r[1]), "=&v"(r[2]), "=&v"(r[3]), "=&v"(r[4]), "=&v"(r[5]), "=&v"(r[6]), "=&v"(r[7])
                 : "v"(ad[0]), "v"(ad[1]), "v"(ad[2]), "v"(ad[3]), "v"(ad[4]), "v"(ad[5]), "v"(ad[6]), "v"(ad[7]) : "memory");
}
constexpr int ATT_WAVE_LDS = 19456;
__device__ __forceinline__ void phase_attn(const Ctx& c) {
    const bf16_t* Q = (const bf16_t*)(c.ws + WS_Q); const bf16_t* K = (const bf16_t*)(c.ws + WS_K); const bf16_t* V = (const bf16_t*)(c.ws + WS_V);
    const int* SEL = (const int*)(c.ws + WS_SEL); bf16_t* O = (bf16_t*)(c.ws + WS_O);
    LAS unsigned char* wl = c.lds + c.wave * ATT_WAVE_LDS;
    LAS int* sl = (LAS int*)wl;
    LAS unsigned short* pT = (LAS unsigned short*)(wl + 1024);
    LAS unsigned char* vb = wl + 3072;
    const int lane = c.lane, fr = lane & 15, fq = lane >> 4;
    const int gw = c.vb * 4 + c.wave, ngw = c.nb * 4;
    unsigned tro[16];
    { const unsigned q = (unsigned)fr >> 2, p = (unsigned)fr & 3u;
#pragma unroll
      for (int c2 = 0; c2 < 8; ++c2)
#pragma unroll
          for (int t = 0; t < 2; ++t) { const unsigned row = 8u * fq + 4u * t + q, ch = 2u * c2 + (p >> 1); tro[c2 * 2 + t] = 256u * row + 16u * (ch ^ vimg_f(row)) + 8u * (p & 1u); } }
    const unsigned vb_addr = (unsigned)(size_t)vb;
    for (int task = gw; task < T * 2; task += ngw) {
        const int tg = task >> 1, g = task & 1, b = tg >> 12, t = tg & 4095, tb = b * SEQ;
        const int nsel = min(256, t + 1), ntile = (nsel + 15) >> 4, nch = (nsel + 31) >> 5;
#pragma unroll
        for (int i = 0; i < 4; ++i) { const int s_ = lane + 64 * i; int idx = 0; if (s_ < nsel) idx = (t < 256) ? s_ : SEL[(size_t)tg * 256 + s_]; idx = ((unsigned)idx <= (unsigned)t) ? idx : 0; sl[s_] = idx; }
        bf16x8 qf[4];
        { const bf16_t* qp = Q + (size_t)tg * D + (4 * g + (fr & 3)) * 128 + 8 * fq;
#pragma unroll
          for (int ks = 0; ks < 4; ++ks) qf[ks] = *(const bf16x8*)(qp + 32 * ks); }
        LDS_WAIT();
        const bf16_t* vbase = V + (size_t)tb * 256 + g * 128;
#define V_GATHER(chk, bufsel) do { _Pragma("unroll") for (int i_ = 0; i_ < 8; ++i_) { const int r_ = 4 * i_ + fq; const int key_ = sl[32 * (chk) + r_]; \
            __builtin_amdgcn_global_load_lds((const unsigned*)(vbase + (size_t)key_ * 256 + (((unsigned)fr ^ vimg_f((unsigned)r_)) << 3)), \
                                             (LAS unsigned*)(vb + (bufsel) * 8192 + i_ * 1024 + lane * 16), 16, 0, 0); } } while (0)
        V_GATHER(0, 0);
        f32x4 lg[16];
#pragma unroll
        for (int kt = 0; kt < 16; ++kt) {
            lg[kt] = (f32x4){-INFINITY, -INFINITY, -INFINITY, -INFINITY};
            if (kt < ntile) {
                const int key = sl[kt * 16 + fr];
                const bf16_t* kp = K + (size_t)(tb + key) * 256 + g * 128 + 8 * fq;
                f32x4 acc = {0.f, 0.f, 0.f, 0.f};
#pragma unroll
                for (int ks = 0; ks < 4; ++ks) { const bf16x8 kf = *(const bf16x8*)(kp + 32 * ks); acc = __builtin_amdgcn_mfma_f32_16x16x32_bf16(qf[ks], kf, acc, 0, 0, 0); }
                if (kt * 16 + fr < nsel) lg[kt] = acc;
            }
        }
        f32x4 mx = lg[0];
#pragma unroll
        for (int kt = 1; kt < 16; ++kt) { mx.x = fmaxf(mx.x, lg[kt].x); mx.y = fmaxf(mx.y, lg[kt].y); mx.z = fmaxf(mx.z, lg[kt].z); mx.w = fmaxf(mx.w, lg[kt].w); }
#pragma unroll
        for (int o = 1; o < 16; o <<= 1) { mx.x = fmaxf(mx.x, __shfl_xor(mx.x, o)); mx.y = fmaxf(mx.y, __shfl_xor(mx.y, o)); mx.z = fmaxf(mx.z, __shfl_xor(mx.z, o)); mx.w = fmaxf(mx.w, __shfl_xor(mx.w, o)); }
        f32x4 sm = {0.f, 0.f, 0.f, 0.f};
#pragma unroll
        for (int kt = 0; kt < 16; ++kt) { f32x4 p; p.x = __expf(lg[kt].x - mx.x); p.y = __expf(lg[kt].y - mx.y); p.z = __expf(lg[kt].z - mx.z); p.w = __expf(lg[kt].w - mx.w); lg[kt] = p; sm += p; }
#pragma unroll
        for (int o = 1; o < 16; o <<= 1) { sm.x += __shfl_xor(sm.x, o); sm.y += __shfl_xor(sm.y, o); sm.z += __shfl_xor(sm.z, o); sm.w += __shfl_xor(sm.w, o); }
        { const float inv = 1.f / (fq == 0 ? sm.x : fq == 1 ? sm.y : fq == 2 ? sm.z : sm.w);
#pragma unroll
          for (int kt = 0; kt < 16; ++kt) { const float pv = (fq == 0 ? lg[kt].x : fq == 1 ? lg[kt].y : fq == 2 ? lg[kt].z : lg[kt].w) * inv; pT[fq * 256 + kt * 16 + fr] = (unsigned short)(pk_bf16(pv, pv) & 0xffffu); } }
        LDS_WAIT();
        f32x4 oacc[8];
#pragma unroll
        for (int c2 = 0; c2 < 8; ++c2) oacc[c2] = (f32x4){0.f, 0.f, 0.f, 0.f};
        for (int ch = 0; ch < nch; ++ch) {
            if (ch + 1 < nch) { V_GATHER(ch + 1, (ch + 1) & 1); asm volatile("s_waitcnt vmcnt(8)" ::: "memory"); }
            else asm volatile("s_waitcnt vmcnt(0)" ::: "memory");
            const bf16x8 pa = *(const LAS bf16x8*)(pT + (fr & 3) * 256 + 32 * ch + 8 * fq);
            const unsigned cb = vb_addr + (unsigned)(ch & 1) * 8192u;
            unsigned ad[8]; s16x4 r0[8], r1[8];
#pragma unroll
            for (int i = 0; i < 8; ++i) ad[i] = cb + tro[i];
            tr_read8(ad, r0);
#pragma unroll
            for (int i = 0; i < 8; ++i) ad[i] = cb + tro[8 + i];
            tr_read8(ad, r1);
#pragma unroll
            for (int c2 = 0; c2 < 4; ++c2) { const bf16x8 vf = __builtin_shufflevector(r0[2 * c2], r0[2 * c2 + 1], 0, 1, 2, 3, 4, 5, 6, 7); oacc[c2] = __builtin_amdgcn_mfma_f32_16x16x32_bf16(pa, vf, oacc[c2], 0, 0, 0); }
#pragma unroll
            for (int c2 = 0; c2 < 4; ++c2) { const bf16x8 vf = __builtin_shufflevector(r1[2 * c2], r1[2 * c2 + 1], 0, 1, 2, 3, 4, 5, 6, 7); oacc[4 + c2] = __builtin_amdgcn_mfma_f32_16x16x32_bf16(pa, vf, oacc[4 + c2], 0, 0, 0); }
        }
        { bf16_t* op = O + (size_t)tg * D + (4 * g + fq) * 128 + fr;
#pragma unroll
          for (int c2 = 0; c2 < 8; ++c2) { const float ov = (fq == 0 ? oacc[c2].x : fq == 1 ? oacc[c2].y : fq == 2 ? oacc[c2].z : oacc[c2].w); op[16 * c2] = (bf16_t)(pk_bf16(ov, ov) & 0xffffu); } }
        LDS_WAIT();
    }
#undef V_GATHER
}

__device__ __forceinline__ void phase_b4(const Ctx& c) {
    const bf16_t* OB = (const bf16_t*)(c.ws + WS_O); const bf16_t* W = (const bf16_t*)(c.ws + WS_WBOUT); float* H = (float*)(c.ws + WS_H);
    const int fr = c.lane & 15, fq = c.lane >> 4, wr = c.wave >> 1, wc = c.wave & 1;
    for (int u = c.vb; u < 128 * 8; u += c.nb) {
        int mt, nt; map_unit(u, 8, mt, nt);
        const bf16_t* ap[4]; const bf16_t* bp[4];
        rows_regular<64>(ap, OB + (size_t)mt * 128 * D, D, c.tid); rows_regular<64>(bp, W + (size_t)nt * 128 * D, D, c.tid);
        f32x4 acc[4][4]; zero_acc(acc);
        gemm_loop<64, 1, true>(c, ap, bp, bp, D, acc, acc);
#pragma unroll
        for (int m = 0; m < 4; ++m)
#pragma unroll
            for (int n = 0; n < 4; ++n) {
                const size_t off = (size_t)(mt * 128 + wr * 64 + m * 16 + fr) * D + nt * 128 + wc * 64 + n * 16 + fq * 4;
                *(f32x4*)(H + off) = *(const f32x4*)(H + off) + acc[m][n];
            }
    }
}

constexpr int NPHASE = 21;
__global__ void __launch_bounds__(NTH, 2) mk_fwd(Args args) {
    extern __shared__ __attribute__((aligned(16))) unsigned char lds_raw[];
    Ctx c;
    c.lds = (LAS unsigned char*)lds_raw; c.tid = threadIdx.x; c.lane = c.tid & 63; c.wave = __builtin_amdgcn_readfirstlane(c.tid >> 6);
    c.nb = gridDim.x; { const int bx = blockIdx.x; c.vb = (c.nb % 8 == 0) ? (bx % 8) * (c.nb / 8) + bx / 8 : bx; }
    c.a = (const __attribute__((address_space(4))) Args*)__builtin_amdgcn_kernarg_segment_ptr(); c.ws = args.ws;
    volatile LAS unsigned* st = (volatile LAS unsigned*)(c.lds + LDS_MAIN + 1008);
    const bool multi = (args.ph_hi - args.ph_lo) > 1;
    XcdBarrier bar; bar.bar = (unsigned*)(c.ws + WS_CTL); bar.x = 0; bar.st = st;
    if (multi) {
        if (c.tid == 0) { st[0] = 0u; st[1] = 0u; }
        __syncthreads();
        bar = xcd_barrier_post((unsigned*)(c.ws + WS_CTL), st);
    }
    const int ph_lo = args.ph_lo, ph_hi = args.ph_hi;
#ifndef PH_MASK
#define PH_MASK 0x1fffff
#endif
#define PHON(k) ((PH_MASK >> (k)) & 1)
#define PHASE(k, body) do { if (PHON(k) && ph_lo <= (k) && (k) < ph_hi) { \
        { int t_ = threadIdx.x, vb_ = __builtin_amdgcn_readfirstlane(c.vb); \
          const __attribute__((address_space(4))) Args* ka = (const __attribute__((address_space(4))) Args*)__builtin_amdgcn_kernarg_segment_ptr(); \
          asm volatile("" : "+v"(t_), "+s"(vb_), "+s"(ka)); \
          c.tid = t_; c.lane = t_ & 63; c.wave = __builtin_amdgcn_readfirstlane(t_ >> 6); c.vb = vb_; c.a = ka; c.ws = ka->ws; } \
        body; \
        if (MK_REP == (k)) { __syncthreads(); body; } \
        if ((k) + 1 < ph_hi) xcd_barrier(bar); \
        if ((k) == 3) { for (int xb_ = 0; xb_ < MK_XBAR; ++xb_) xcd_barrier(bar); } } } while (0)
    PHASE(0, phase_prep(c));
    PHASE(1, phase_a1(c));
    PHASE(2, { if (MK_DRY == 2) { phase_a2(c, true); __syncthreads(); } phase_a2(c); });
    PHASE(3, phase_a3(c));
    PHASE(4, { if (MK_DRY == 4) { phase_route(c, 0, true); __syncthreads(); } phase_route(c, 0); });
    PHASE(5, phase_e1(c, 0));
    PHASE(6, phase_e2(c, 0));
    PHASE(7, { if (MK_DRY == 7) { phase_p1(c, 0, true); __syncthreads(); } phase_p1(c, 0); });
    PHASE(8, phase_p2(c, 0));
    PHASE(9, { phase_norm_bf16(c, (const float*)c.a->in[IN_MIXN] + D); convert_moe_layer(c, 1); });
    PHASE(10, phase_b1(c));
    PHASE(11, phase_rope(c));
    PHASE(12, phase_index(c));
    PHASE(13, phase_attn(c));
    PHASE(14, phase_b4(c));
    PHASE(15, phase_route(c, 1));
    PHASE(16, phase_e1(c, 1));
    PHASE(17, phase_e2(c, 1));
    PHASE(18, phase_p1(c, 1));
    PHASE(19, phase_p2(c, 1));
    PHASE(20, phase_final(c));
}

#ifdef MK_DUMP
__global__ void dump_k(const unsigned char* ws, float* out) {
    const size_t i = (size_t)blockIdx.x * 256 + threadIdx.x;
#if MK_DUMP == 1
    ((f32x4*)out)[i] = ((const f32x4*)(ws + WS_H))[i];
#elif MK_DUMP == 2
    { const u32x2 v = ((const u32x2*)(ws + WS_O))[i]; f32x4 o = {bf_lo(v.x), bf_hi(v.x), bf_lo(v.y), bf_hi(v.y)}; ((f32x4*)out)[i] = o; }
#elif MK_DUMP == 3
    { const int* sp = (const int*)(ws + WS_SEL); f32x4 o = {0.f,0.f,0.f,0.f}; if (i < (size_t)T * 64) { o.x = (float)sp[4*i]; o.y = (float)sp[4*i+1]; o.z = (float)sp[4*i+2]; o.w = (float)sp[4*i+3]; } ((f32x4*)out)[i] = o; }
#elif MK_DUMP == 5
    { const u32x2 v = ((const u32x2*)(ws + WS_XN))[i]; f32x4 o = {bf_lo(v.x), bf_hi(v.x), bf_lo(v.y), bf_hi(v.y)}; ((f32x4*)out)[i] = o; }
#elif MK_DUMP == 6
    { const u32x2 v = ((const u32x2*)(ws + WS_RAW))[i]; f32x4 o = {bf_lo(v.x), bf_hi(v.x), bf_lo(v.y), bf_hi(v.y)}; ((f32x4*)out)[i] = o; }
#elif MK_DUMP == 7
    { f32x4 o = {0.f,0.f,0.f,0.f}; if (i < (size_t)BINP * D / 4) { const u32x2 v = ((const u32x2*)(ws + WS_WBIN))[i]; o = (f32x4){bf_lo(v.x), bf_hi(v.x), bf_lo(v.y), bf_hi(v.y)}; } ((f32x4*)out)[i] = o; }
#elif MK_DUMP == 8
    { const u32x2 v = ((const u32x2*)(ws + WS_RAW))[i], w = ((const u32x2*)(ws + 458 * MB))[i]; f32x4 o = {bf_lo(v.x) - bf_lo(w.x), bf_hi(v.x) - bf_hi(w.x), bf_lo(v.y) - bf_lo(w.y), bf_hi(v.y) - bf_hi(w.y)}; ((f32x4*)out)[i] = o; }
#elif MK_DUMP == 9
    { const u32x2 v = ((const u32x2*)(ws + WS_RAW))[i], w = ((const u32x2*)(ws + 458 * MB))[i]; f32x4 o = {(v.x & 0xffffu) != (w.x & 0xffffu) ? 1.f : 0.f, (v.x >> 16) != (w.x >> 16) ? 1.f : 0.f, (v.y & 0xffffu) != (w.y & 0xffffu) ? 1.f : 0.f, (v.y >> 16) != (w.y >> 16) ? 1.f : 0.f}; ((f32x4*)out)[i] = o; }
#elif MK_DUMP == 4
    { const u32x2 v = ((const u32x2*)(ws + WS_Q))[i]; f32x4 o = {bf_lo(v.x), bf_hi(v.x), bf_lo(v.y), bf_hi(v.y)}; ((f32x4*)out)[i] = o; }
#endif
}
#endif
extern "C" void kernel_launch(void* const* d_in, const int* in_sizes, int n_in, void* d_out, int out_size, void* d_ws, size_t ws_size, hipStream_t stream) {
    static int grid = 0;
    if (grid == 0) {
        if (n_in != 23 || out_size != T * D || ws_size < WS_TOTAL) { fprintf(stderr, "kernel_launch: unexpected sizes n_in %d out %d ws %zu (need %zu)\n", n_in, out_size, ws_size, (size_t)WS_TOTAL); grid = -1; return; }
        int dev = 0, cus = 0, per_cu = 0;
        hipGetDevice(&dev); hipDeviceGetAttribute(&cus, hipDeviceAttributeMultiprocessorCount, dev);
        hipFuncSetAttribute((const void*)mk_fwd, hipFuncAttributeMaxDynamicSharedMemorySize, LDS_BYTES);
        hipOccupancyMaxActiveBlocksPerMultiprocessor(&per_cu, (const void*)mk_fwd, NTH, LDS_BYTES);
        (void)hipGetLastError();
        if (per_cu < 1) per_cu = 1;
        if (per_cu > 2) per_cu = 2;
        grid = cus * per_cu;
    }
    if (grid < 0) return;
    hipMemsetAsync((char*)d_ws + WS_CTL, 0, 16384, stream);
    Args a{};
    for (int i = 0; i < 23; ++i) a.in[i] = d_in[i];
    a.out = (float*)d_out; a.ws = (unsigned char*)d_ws;
#if MK_ONE_LAUNCH
    a.ph_lo = 0; a.ph_hi = NPHASE;
    hipLaunchKernelGGL(mk_fwd, dim3(grid), dim3(NTH), LDS_BYTES, stream, a);
#else
    for (int ph = 0; ph <= MK_LAST_PHASE; ++ph) { a.ph_lo = ph; a.ph_hi = ph + 1; hipLaunchKernelGGL(mk_fwd, dim3(grid), dim3(NTH), LDS_BYTES, stream, a); }
#ifdef MK_DUMP
    hipLaunchKernelGGL(dump_k, dim3(T * D / 4 / 256), dim3(256), 0, stream, (const unsigned char*)d_ws, (float*)d_out);
#endif
#endif
}
```

```cpp
#include <hip/hip_runtime.h>
#include <stdint.h>
#include <stdio.h>

#ifndef MK_LAST_PHASE
#define MK_LAST_PHASE 21
#endif
#ifndef MK_REP
#define MK_REP -1
#endif
#ifndef MK_XBAR
#define MK_XBAR 0
#endif
#ifndef MK_DRY
#define MK_DRY -1
#endif
#ifndef MK_ONE_LAUNCH
#define MK_ONE_LAUNCH 1
#endif

#define LAS __attribute__((address_space(3)))
typedef unsigned short bf16_t;
typedef short bf16x8 __attribute__((ext_vector_type(8)));
typedef float f32x4 __attribute__((ext_vector_type(4)));
typedef float f32x2 __attribute__((ext_vector_type(2)));
typedef float f32x16 __attribute__((ext_vector_type(16)));
typedef unsigned u32x4 __attribute__((ext_vector_type(4)));
typedef unsigned u32x2 __attribute__((ext_vector_type(2)));

constexpr int T = 16384, D = 1024, SEQ = 4096;
constexpr int GW = 2048;
constexpr int BIN = 2120, BINP = 2176;
constexpr int NE = 32, DE = 512;
constexpr int PLE = 256;
constexpr float EPS = 1e-6f;
constexpr int NTH = 256;
constexpr int LDS_MAIN = 4 * 19456;
constexpr int LDS_BYTES = LDS_MAIN + 1024;
constexpr int RPAD = 32768 + NE * 128;

constexpr size_t MB = 1024 * 1024;
constexpr size_t WS_CTL = 0;
constexpr size_t WS_CNT = 16384;
constexpr size_t WS_WR = 32768;
constexpr size_t WS_WAIN = 1 * MB;
constexpr size_t WS_WAOUT = WS_WAIN + 8 * MB;
constexpr size_t WS_WBIN = WS_WAOUT + 4 * MB;
constexpr size_t WS_WBOUT = WS_WBIN + 5 * MB;
constexpr size_t WS_WGATE = WS_WBOUT + 2 * MB;
constexpr size_t WS_WPROJ = WS_WGATE + 4 * MB;
constexpr size_t WS_W1 = WS_WPROJ + 1 * MB;
constexpr size_t WS_W3 = WS_W1 + 32 * MB;
constexpr size_t WS_W2 = WS_W3 + 32 * MB;
constexpr size_t WS_PBF = WS_W2 + 32 * MB;
constexpr size_t WS_XN = WS_PBF + 16 * MB;
constexpr size_t WS_H = WS_XN + 32 * MB;
constexpr size_t WS_LIST = WS_H + 64 * MB;
constexpr size_t WS_GATE = WS_LIST + 2 * MB;
constexpr size_t WS_TOKSLOT = WS_GATE + 2 * MB;
constexpr size_t WS_SCR = WS_TOKSLOT + 1 * MB;
constexpr size_t WS_U = WS_SCR;
constexpr size_t WS_VT = WS_SCR + 64 * MB;
constexpr size_t WS_VSS = WS_SCR + 128 * MB;
constexpr size_t WS_HMID = WS_SCR;
constexpr size_t WS_Y = WS_SCR + 36 * MB;
constexpr size_t WS_RAW = WS_SCR;
constexpr size_t WS_O = WS_SCR;
constexpr size_t WS_Q = WS_SCR + 68 * MB;
constexpr size_t WS_K = WS_Q + 32 * MB;
constexpr size_t WS_V = WS_K + 8 * MB;
constexpr size_t WS_QI = WS_V + 8 * MB;
constexpr size_t WS_KI = WS_QI + 16 * MB;
constexpr size_t WS_WI = WS_KI + 2 * MB;
constexpr size_t WS_SEL = WS_WI + 1 * MB;
constexpr size_t WS_END = WS_SEL + 16 * MB;
static_assert(WS_END <= WS_SCR + 152 * MB, "scratch");
constexpr size_t WS_S = 392 * MB;
constexpr size_t WS_TOTAL = 522 * MB;

typedef __bf16 bf16x2_t __attribute__((ext_vector_type(2)));
__device__ __forceinline__ unsigned pk_bf16(float lo, float hi) { f32x2 v = {lo, hi}; bf16x2_t b = __builtin_convertvector(v, bf16x2_t); return __builtin_bit_cast(unsigned, b); }
__device__ __forceinline__ float bf_lo(unsigned u) { return __uint_as_float(u << 16); }
__device__ __forceinline__ float bf_hi(unsigned u) { return __uint_as_float(u & 0xffff0000u); }
__device__ __forceinline__ float wave_sum(float v) {
#pragma unroll
    for (int o = 1; o < 64; o <<= 1) v += __shfl_xor(v, o);
    return v;
}
__device__ __forceinline__ int lds_inc(LAS int* p) { return __hip_atomic_fetch_add(p, 1, __ATOMIC_RELAXED, __HIP_MEMORY_SCOPE_WORKGROUP); }
#define LDS_WAIT() asm volatile("s_waitcnt lgkmcnt(0)" ::: "memory")
#define VM_WAIT() asm volatile("s_waitcnt vmcnt(0)" ::: "memory")

#define XB_TMO      128
#define XB_XCNT(j)  (256  + 64 * (j))
#define XB_XSUB(j)  (1280 + 64 * (j))
#define XB_XGEN(j)  (2304 + 64 * (j))
#define XB_TOP      3328
#define XB_TOPGEN   3392
#define XCD_BAR_WORDS 3456
#define XB_SPIN_CAP (1u << 20)
__device__ __forceinline__ unsigned xb_ld(unsigned* p)              { return __hip_atomic_load(p, __ATOMIC_RELAXED, __HIP_MEMORY_SCOPE_AGENT); }
__device__ __forceinline__ unsigned xb_add(unsigned* p, unsigned v) { return __hip_atomic_fetch_add(p, v, __ATOMIC_RELAXED, __HIP_MEMORY_SCOPE_AGENT); }
__device__ __forceinline__ unsigned xb_xcc_id() { return (unsigned)__builtin_amdgcn_s_getreg((3 << 11) | 20) & 0xFu; }
#define XB_SPIN(cond, bar) do { unsigned _sp = 0; while (cond) { __builtin_amdgcn_s_sleep(1); \
    if ((++_sp & 255u) == 0u) { if (xb_ld(&(bar)[XB_TMO])) break; if (_sp > XB_SPIN_CAP) { atomicAdd(&(bar)[XB_TMO], 1u); break; } } } } while (0)
struct XcdBarrier { unsigned* bar; unsigned x; volatile LAS unsigned* st; };
__device__ __forceinline__ XcdBarrier xcd_barrier_post(unsigned* bar, volatile LAS unsigned* st) {
    XcdBarrier b; b.bar = bar; b.x = xb_xcc_id(); b.st = st;
    if (threadIdx.x == 0) (void)xb_add(&bar[XB_XCNT(b.x)], 1u);
    return b;
}
__device__ __forceinline__ void xcd_barrier_complete(unsigned* bar, unsigned x, unsigned& nloc, unsigned& nx) {
    const unsigned G = gridDim.x;
    unsigned sum, cnt, mine, sp = 0u;
    for (;;) {
        sum = 0u; cnt = 0u; mine = 0u;
#pragma unroll
        for (unsigned j = 0; j < 16; ++j) { const unsigned c = xb_ld(&bar[XB_XCNT(j)]); sum += c; cnt += (c > 0u) ? 1u : 0u; mine = (j == x) ? c : mine; }
        if (sum == G) break;
        __builtin_amdgcn_s_sleep(1);
        if ((++sp & 255u) == 0u) { if (xb_ld(&bar[XB_TMO])) break; if (sp > XB_SPIN_CAP) { atomicAdd(&bar[XB_TMO], 1u); break; } }
    }
    nloc = mine > 0u ? mine : 1u; nx = cnt > 0u ? cnt : 1u;
}
__device__ __forceinline__ void xcd_barrier(const XcdBarrier& b) {
    asm volatile("s_waitcnt vmcnt(0)" ::: "memory");
    __syncthreads();
    if (threadIdx.x == 0) {
        unsigned* bar = b.bar;
        __builtin_amdgcn_s_waitcnt(0);
        unsigned nloc = b.st[0], nx = b.st[1];
        if (nloc == 0u) { xcd_barrier_complete(bar, b.x, nloc, nx); b.st[0] = nloc; b.st[1] = nx; }
        const unsigned old = xb_add(&bar[XB_XSUB(b.x)], 1u);
        const unsigned gen = old / nloc;
        if (old + 1u == (gen + 1u) * nloc) {
            __builtin_amdgcn_fence(__ATOMIC_RELEASE, "agent");
            asm volatile("s_waitcnt vmcnt(0)" ::: "memory");
            const unsigned og = xb_add(&bar[XB_TOP], 1u);
            const unsigned tg = og / nx;
            if (og + 1u == (tg + 1u) * nx) xb_add(&bar[XB_TOPGEN], 1u);
            else XB_SPIN(xb_ld(&bar[XB_TOPGEN]) == tg, bar);
            __builtin_amdgcn_fence(__ATOMIC_ACQUIRE, "agent");
            xb_add(&bar[XB_XGEN(b.x)], 1u);
            asm volatile("s_waitcnt vmcnt(0)" ::: "memory");
        } else {
            XB_SPIN(xb_ld(&bar[XB_XGEN(b.x)]) == gen, bar);
            __builtin_amdgcn_fence(__ATOMIC_ACQUIRE, "agent");
            asm volatile("s_waitcnt vmcnt(0)" ::: "memory");
        }
    }
    __syncthreads();
}

struct Args { const void* in[23]; float* out; unsigned char* ws; int ph_lo, ph_hi; };
enum { IN_X = 0, IN_P, IN_POS, IN_MIXN, IN_AWIN, IN_AVG, IN_AWS, IN_ABS, IN_AWOUT, IN_BWIN, IN_BWOUT, IN_FFNN, IN_WG, IN_BG, IN_WE, IN_BE,
       IN_W1, IN_W3, IN_W2, IN_PLEN, IN_PLEG, IN_PLEP, IN_FINN };

struct Ctx {
    LAS unsigned char* lds;
    int tid, lane, wave, vb, nb;
    const __attribute__((address_space(4))) Args* a;
    unsigned char* ws;
};

template <int BK> struct TileK { static constexpr int NP = (BK == 64) ? 4 : 2; static constexpr int TB = 128 * BK * 2; };

template <int BK>
__device__ __forceinline__ void stage_tile(LAS unsigned char* tile, const bf16_t* const (&rp)[TileK<BK>::NP], int k0, int tid) {
    const int lc = (BK == 64) ? ((tid & 7) ^ ((tid >> 3) & 7)) : ((tid & 3) ^ ((tid >> 3) & 3));
#pragma unroll
    for (int p = 0; p < TileK<BK>::NP; ++p)
        __builtin_amdgcn_global_load_lds((const unsigned*)(rp[p] + k0 + lc * 8), (LAS unsigned*)(tile + p * 4096 + tid * 16), 16, 0, 0);
}
template <int BK>
__device__ __forceinline__ void rows_regular(const bf16_t* (&rp)[TileK<BK>::NP], const bf16_t* base, size_t ld, int tid) {
#pragma unroll
    for (int p = 0; p < TileK<BK>::NP; ++p) { const int r = (BK == 64) ? (p * 32 + (tid >> 3)) : (p * 64 + (tid >> 2)); rp[p] = base + (size_t)r * ld; }
}
template <int BK>
__device__ __forceinline__ int frag_off(int row, int ks, int fq) {
    return (BK == 64) ? (row * 128 + (((ks * 4 + fq) ^ (row & 7)) << 4)) : (row * 64 + ((fq ^ ((row >> 1) & 3)) << 4));
}

template <int BK, int NBOP, bool SWAP>
__device__ __forceinline__ void gemm_loop(const Ctx& c, const bf16_t* const (&ap)[TileK<BK>::NP], const bf16_t* const (&b0p)[TileK<BK>::NP], const bf16_t* const (&b1p)[TileK<BK>::NP],
                                          int K, f32x4 (&acc0)[4][4], f32x4 (&acc1)[4][4]) {
    constexpr int TB = TileK<BK>::TB, SB = (1 + NBOP) * TB;
    static_assert(2 * SB <= LDS_MAIN, "lds");
    const int nk = K / BK, tid = c.tid;
    const int fr = c.lane & 15, fq = c.lane >> 4, wr = c.wave >> 1, wc = c.wave & 1;
    LAS unsigned char* lds = c.lds;
    stage_tile<BK>(lds, ap, 0, tid); stage_tile<BK>(lds + TB, b0p, 0, tid);
    if (NBOP == 2) stage_tile<BK>(lds + 2 * TB, b1p, 0, tid);
    for (int kt = 0; kt < nk; ++kt) {
        VM_WAIT();
        __syncthreads();
        LAS unsigned char* cur = lds + (kt & 1) * SB;
        if (kt + 1 < nk) {
            LAS unsigned char* nxt = lds + ((kt + 1) & 1) * SB;
            stage_tile<BK>(nxt, ap, (kt + 1) * BK, tid); stage_tile<BK>(nxt + TB, b0p, (kt + 1) * BK, tid);
            if (NBOP == 2) stage_tile<BK>(nxt + 2 * TB, b1p, (kt + 1) * BK, tid);
        }
#pragma unroll
        for (int ks = 0; ks < BK / 32; ++ks) {
            bf16x8 af[4], bf0[4], bf1[4];
#pragma unroll
            for (int m = 0; m < 4; ++m) af[m] = *(const LAS bf16x8*)(cur + frag_off<BK>(wr * 64 + m * 16 + fr, ks, fq));
#pragma unroll
            for (int n = 0; n < 4; ++n) bf0[n] = *(const LAS bf16x8*)(cur + TB + frag_off<BK>(wc * 64 + n * 16 + fr, ks, fq));
            if (NBOP == 2) {
#pragma unroll
                for (int n = 0; n < 4; ++n) bf1[n] = *(const LAS bf16x8*)(cur + 2 * TB + frag_off<BK>(wc * 64 + n * 16 + fr, ks, fq));
            }
#pragma unroll
            for (int m = 0; m < 4; ++m)
#pragma unroll
                for (int n = 0; n < 4; ++n) {
                    if (SWAP) acc0[m][n] = __builtin_amdgcn_mfma_f32_16x16x32_bf16(bf0[n], af[m], acc0[m][n], 0, 0, 0);
                    else      acc0[m][n] = __builtin_amdgcn_mfma_f32_16x16x32_bf16(af[m], bf0[n], acc0[m][n], 0, 0, 0);
                    if (NBOP == 2) {
                        if (SWAP) acc1[m][n] = __builtin_amdgcn_mfma_f32_16x16x32_bf16(bf1[n], af[m], acc1[m][n], 0, 0, 0);
                        else      acc1[m][n] = __builtin_amdgcn_mfma_f32_16x16x32_bf16(af[m], bf1[n], acc1[m][n], 0, 0, 0);
                    }
                }
        }
    }
    __syncthreads();
}
__device__ __forceinline__ void zero_acc(f32x4 (&acc)[4][4]) {
#pragma unroll
    for (int m = 0; m < 4; ++m)
#pragma unroll
        for (int n = 0; n < 4; ++n) acc[m][n] = (f32x4){0.f, 0.f, 0.f, 0.f};
}
__device__ __forceinline__ void map_unit(int u, int nnt, int& mt, int& nt) { const int per = 8 * nnt, band = u / per, r = u - band * per; nt = r >> 3; mt = band * 8 + (r & 7); }


__device__ __forceinline__ float gelu_tanh(float x) {
    const float y2 = 1.5957691216057308f * (x + 0.044715f * x * x * x);
    return x / (1.f + __expf(-y2));
}
__device__ __forceinline__ float sigmoidf_(float x) { return 1.f / (1.f + __expf(-x)); }

__device__ __forceinline__ void row_load(const float* row, int lane, f32x4 (&v)[4]) {
#pragma unroll
    for (int j = 0; j < 4; ++j) v[j] = ((const f32x4*)row)[lane + 64 * j];
}
__device__ __forceinline__ float row_sumsq(const f32x4 (&v)[4]) {
    float s = 0.f;
#pragma unroll
    for (int j = 0; j < 4; ++j) s += (v[j].x * v[j].x + v[j].y * v[j].y) + (v[j].z * v[j].z + v[j].w * v[j].w);
    return wave_sum(s);
}
__device__ __forceinline__ void row_store_norm_bf16(bf16_t* orow, int lane, const f32x4 (&v)[4], float r, const float* gain) {
#pragma unroll
    for (int j = 0; j < 4; ++j) {
        const f32x4 g = ((const f32x4*)gain)[lane + 64 * j];
        u32x2 o; o.x = pk_bf16(v[j].x * r * g.x, v[j].y * r * g.y); o.y = pk_bf16(v[j].z * r * g.z, v[j].w * r * g.w);
        ((u32x2*)orow)[lane + 64 * j] = o;
    }
}

constexpr int TR_SCR = 64 * 136;
__device__ __forceinline__ void transpose_item(const float* W, int K, int N, int nvalid, int ldw, bf16_t* WT, LAS unsigned char* scr, int item, int lane) {
    const int nblk = N / 64, kb = item / nblk, nb = item - kb * nblk, k0 = 64 * kb, n0 = 64 * nb;
    const int n = n0 + 4 * (lane & 15);
    const int nc_ = (n < nvalid) ? n : 0; const float keep = (n < nvalid) ? 1.f : 0.f;
    f32x4 v[16];
#pragma unroll
    for (int i = 0; i < 16; ++i) v[i] = *(const f32x4*)(W + (size_t)(k0 + 4 * i + (lane >> 4)) * ldw + nc_);
#pragma unroll
    for (int i = 0; i < 16; ++i) {
        const int kk = 4 * i + (lane >> 4);
        u32x2 o; o.x = pk_bf16(v[i].x * keep, v[i].y * keep); o.y = pk_bf16(v[i].z * keep, v[i].w * keep);
        *(LAS u32x2*)(scr + kk * 136 + (lane & 15) * 8) = o;
    }
    LDS_WAIT();
    const int cc = lane & 7;
#pragma unroll
    for (int j = 0; j < 8; ++j) {
        const int nn = (lane >> 3) + 8 * j; const LAS unsigned short* sp = (const LAS unsigned short*)(scr + (8 * cc) * 136 + nn * 2);
        u32x4 o;
        o.x = (unsigned)sp[0 * 68] | ((unsigned)sp[1 * 68] << 16); o.y = (unsigned)sp[2 * 68] | ((unsigned)sp[3 * 68] << 16);
        o.z = (unsigned)sp[4 * 68] | ((unsigned)sp[5 * 68] << 16); o.w = (unsigned)sp[6 * 68] | ((unsigned)sp[7 * 68] << 16);
        *(u32x4*)(WT + (size_t)(n0 + nn) * K + k0 + 8 * cc) = o;
    }
    LDS_WAIT();
}
__device__ __forceinline__ void convert_moe_layer(const Ctx& c, int l) {
    LAS unsigned char* scr = c.lds + c.wave * TR_SCR;
    const int gw = c.vb * 4 + c.wave, ngw = c.nb * 4;
    const float* w1 = (const float*)c.a->in[IN_W1] + (size_t)l * NE * D * DE;
    const float* w3 = (const float*)c.a->in[IN_W3] + (size_t)l * NE * D * DE;
    const float* w2 = (const float*)c.a->in[IN_W2] + (size_t)l * NE * DE * D;
    bf16_t* W1 = (bf16_t*)(c.ws + WS_W1); bf16_t* W3 = (bf16_t*)(c.ws + WS_W3); bf16_t* W2 = (bf16_t*)(c.ws + WS_W2);
    for (int it = gw; it < NE * 384; it += ngw) {
        const int e = it / 384, r = it - e * 384;
        if (r < 128)      transpose_item(w1 + (size_t)e * D * DE, D, DE, DE, DE, W1 + (size_t)e * DE * D, scr, r, c.lane);
        else if (r < 256) transpose_item(w3 + (size_t)e * D * DE, D, DE, DE, DE, W3 + (size_t)e * DE * D, scr, r - 128, c.lane);
        else              transpose_item(w2 + (size_t)e * DE * D, DE, D, D, D, W2 + (size_t)e * D * DE, scr, r - 256, c.lane);
    }
}

__device__ __forceinline__ void phase_prep(const Ctx& c) {
    const __attribute__((address_space(4))) Args& a = *c.a;
    LAS unsigned char* scr = c.lds + c.wave * TR_SCR;
    const int gw = c.vb * 4 + c.wave, ngw = c.nb * 4;
    constexpr int I_AIN = 16 * 64, I_AOUT = 32 * 16, I_BIN = 16 * 34, I_BOUT = 16 * 16, I_PG = 16 * 16, I_PP = 4 * 16;
    constexpr int NIT = I_AIN + I_AOUT + I_BIN + I_BOUT + 2 * I_PG + 2 * I_PP;
    for (int it = gw; it < NIT; it += ngw) {
        int r = it;
        if (r < I_AIN) { transpose_item((const float*)a.in[IN_AWIN], D, 4096, 4096, 4096, (bf16_t*)(c.ws + WS_WAIN), scr, r, c.lane); continue; } r -= I_AIN;
        if (r < I_AOUT) { transpose_item((const float*)a.in[IN_AWOUT], GW, D, D, D, (bf16_t*)(c.ws + WS_WAOUT), scr, r, c.lane); continue; } r -= I_AOUT;
        if (r < I_BIN) { transpose_item((const float*)a.in[IN_BWIN], D, BINP, BIN, BIN, (bf16_t*)(c.ws + WS_WBIN), scr, r, c.lane); continue; } r -= I_BIN;
        if (r < I_BOUT) { transpose_item((const float*)a.in[IN_BWOUT], D, D, D, D, (bf16_t*)(c.ws + WS_WBOUT), scr, r, c.lane); continue; } r -= I_BOUT;
        if (r < 2 * I_PG) { const int l = r / I_PG; transpose_item((const float*)a.in[IN_PLEG] + (size_t)l * D * D, D, D, D, D, (bf16_t*)(c.ws + WS_WGATE) + (size_t)l * D * D, scr, r - l * I_PG, c.lane); continue; } r -= 2 * I_PG;
        { const int l = r / I_PP; transpose_item((const float*)a.in[IN_PLEP] + (size_t)l * PLE * D, PLE, D, D, D, (bf16_t*)(c.ws + WS_WPROJ) + (size_t)l * D * PLE, scr, r - l * I_PP, c.lane); }
    }
    convert_moe_layer(c, 0);
    const int gt = c.vb * NTH + c.tid, ngt = c.nb * NTH;
    { const float* p = (const float*)a.in[IN_P]; bf16_t* pb = (bf16_t*)(c.ws + WS_PBF);
      for (int i = gt; i < 2 * T * PLE / 8; i += ngt) {
          const f32x4 v0 = ((const f32x4*)p)[2 * i], v1 = ((const f32x4*)p)[2 * i + 1];
          u32x4 o; o.x = pk_bf16(v0.x, v0.y); o.y = pk_bf16(v0.z, v0.w); o.z = pk_bf16(v1.x, v1.y); o.w = pk_bf16(v1.z, v1.w);
          ((u32x4*)pb)[i] = o; } }
    { float* wr = (float*)(c.ws + WS_WR);
      for (int i = gt; i < 2 * D * 48; i += ngt) {
          const int l = i / (D * 48), r = i - l * D * 48, k = r / 48, o = r - k * 48;
          float w = 0.f;
          if (o < 4) w = ((const float*)a.in[IN_WG])[(size_t)l * D * 4 + k * 4 + o];
          else if (o < 36) w = ((const float*)a.in[IN_WE])[(size_t)l * D * 32 + k * 32 + (o - 4)];
          wr[i] = w * ((const float*)a.in[IN_FFNN])[l * D + k]; } }
    if (c.vb == 0 && c.tid < 128) ((int*)(c.ws + WS_CNT))[c.tid] = 0;
    for (int t = gw; t < T; t += ngw) {
        f32x4 v[4]; row_load((const float*)a.in[IN_X] + (size_t)t * D, c.lane, v);
        const float r = rsqrtf(row_sumsq(v) * (1.f / D) + EPS);
        row_store_norm_bf16((bf16_t*)(c.ws + WS_XN) + (size_t)t * D, c.lane, v, r, (const float*)a.in[IN_MIXN]);
    }
}

__device__ __forceinline__ void phase_a1(const Ctx& c) {
    const bf16_t* XN = (const bf16_t*)(c.ws + WS_XN); const bf16_t* W = (const bf16_t*)(c.ws + WS_WAIN);
    bf16_t* U = (bf16_t*)(c.ws + WS_U); bf16_t* VT = (bf16_t*)(c.ws + WS_VT); float* VSS = (float*)(c.ws + WS_VSS);
    const int fr = c.lane & 15, fq = c.lane >> 4, wr = c.wave >> 1, wc = c.wave & 1;
    for (int u = c.vb; u < 128 * 32; u += c.nb) {
        int mt, nt; map_unit(u, 32, mt, nt);
        const bf16_t* ap[4]; const bf16_t* bp[4];
        rows_regular<64>(ap, XN + (size_t)mt * 128 * D, D, c.tid); rows_regular<64>(bp, W + (size_t)nt * 128 * D, D, c.tid);
        f32x4 acc[4][4]; zero_acc(acc);
        if (nt < 16) {
            gemm_loop<64, 1, true>(c, ap, bp, bp, D, acc, acc);
#pragma unroll
            for (int m = 0; m < 4; ++m)
#pragma unroll
                for (int n = 0; n < 4; ++n) {
                    const int t = mt * 128 + wr * 64 + m * 16 + fr, col = nt * 128 + wc * 64 + n * 16 + fq * 4;
                    const f32x4 v = acc[m][n];
                    u32x2 o; o.x = pk_bf16(gelu_tanh(v.x), gelu_tanh(v.y)); o.y = pk_bf16(gelu_tanh(v.z), gelu_tanh(v.w));
                    *(u32x2*)(U + (size_t)t * GW + col) = o;
                }
        } else {
            gemm_loop<64, 1, false>(c, ap, bp, bp, D, acc, acc);
            const int vn = nt - 16;
#pragma unroll
            for (int m = 0; m < 4; ++m) {
                f32x4 ss = {0.f, 0.f, 0.f, 0.f};
                const int t0 = mt * 128 + wr * 64 + m * 16 + fq * 4;
#pragma unroll
                for (int n = 0; n < 4; ++n) {
                    const int ch = vn * 128 + wc * 64 + n * 16 + fr;
                    f32x4 v = acc[m][n];
                    v.x = gelu_tanh(v.x); v.y = gelu_tanh(v.y); v.z = gelu_tanh(v.z); v.w = gelu_tanh(v.w);
                    ss += v * v;
                    u32x2 o; o.x = pk_bf16(v.x, v.y); o.y = pk_bf16(v.z, v.w);
                    *(u32x2*)(VT + (size_t)ch * T + t0) = o;
                }
#pragma unroll
                for (int o = 1; o < 16; o <<= 1) { ss.x += __shfl_xor(ss.x, o); ss.y += __shfl_xor(ss.y, o); ss.z += __shfl_xor(ss.z, o); ss.w += __shfl_xor(ss.w, o); }
                if (fr == 0) {
                    VSS[(size_t)(t0 + 0) * 32 + vn * 2 + wc] = ss.x; VSS[(size_t)(t0 + 1) * 32 + vn * 2 + wc] = ss.y;
                    VSS[(size_t)(t0 + 2) * 32 + vn * 2 + wc] = ss.z; VSS[(size_t)(t0 + 3) * 32 + vn * 2 + wc] = ss.w;
                }
            }
        }
    }
}

__device__ __forceinline__ void phase_a2(const Ctx& c, bool dry = false) {
    const __attribute__((address_space(4))) Args& a = *c.a;
    bf16_t* U = (bf16_t*)(c.ws + WS_U); const bf16_t* VT = (const bf16_t*)(c.ws + WS_VT); const float* VSS = (const float*)(c.ws + WS_VSS);
    const float* ws_ = (const float*)a.in[IN_AWS]; const float* bs_ = (const float*)a.in[IN_ABS]; const float* vg = (const float*)a.in[IN_AVG];
    const int fr = c.lane & 15, fq = c.lane >> 4, wr = c.wave >> 1, wc = c.wave & 1, tid = c.tid;
    LAS unsigned char* lds = c.lds;
    LAS float* rl = (LAS float*)(lds + LDS_MAIN);
    for (int u = c.vb; u < 128 * 8; u += c.nb) {
        const int ci = u >> 3, g = u & 7, tokbase = ci * 128;
        __syncthreads();
        if (tid < 128) {
            const float* p = VSS + (size_t)(tokbase + tid) * 32; float s = 0.f;
#pragma unroll
            for (int i = 0; i < 8; ++i) { const f32x4 q = ((const f32x4*)p)[i]; s += (q.x + q.y) + (q.z + q.w); }
            rl[tid] = rsqrtf(s * (1.f / GW) + EPS);
        }
        __syncthreads();
        {
            const int t = tid >> 1, half = tid & 1;
            const float* wrow = ws_ + ((size_t)g * 128 + t) * 128 + half * 64;
#pragma unroll
            for (int cc = 0; cc < 8; ++cc) {
                const int s0 = half * 64 + cc * 8;
                u32x4 o;
                {
                    const f32x4 w0 = ((const f32x4*)wrow)[2 * cc], w1 = ((const f32x4*)wrow)[2 * cc + 1];
                    float e[8] = {w0.x, w0.y, w0.z, w0.w, w1.x, w1.y, w1.z, w1.w};
#pragma unroll
                    for (int i = 0; i < 8; ++i) e[i] = (s0 + i <= t) ? e[i] * rl[s0 + i] : 0.f;
                    o.x = pk_bf16(e[0], e[1]); o.y = pk_bf16(e[2], e[3]); o.z = pk_bf16(e[4], e[5]); o.w = pk_bf16(e[6], e[7]);
                }
                *(LAS u32x4*)(lds + half * 16384 + t * 128 + ((cc ^ (t & 7)) << 4)) = o;
            }
        }
        for (int hn = 0; hn < 2; ++hn) {
            const int c0 = g * 256 + hn * 128;
            const bf16_t* bp[4]; rows_regular<64>(bp, VT + (size_t)c0 * T + tokbase, T, tid);
            stage_tile<64>(lds + 32768, bp, 0, tid); stage_tile<64>(lds + 32768 + 16384, bp, 64, tid);
            VM_WAIT();
            __syncthreads();
            f32x4 acc[4][4]; zero_acc(acc);
#pragma unroll 1
            for (int kh = 0; kh < 2; ++kh)
#pragma unroll 1
                for (int ks = 0; ks < 2; ++ks) {
                    bf16x8 af[4], bf[4];
#pragma unroll
                    for (int m = 0; m < 4; ++m) af[m] = *(const LAS bf16x8*)(lds + kh * 16384 + frag_off<64>(wr * 64 + m * 16 + fr, ks, fq));
#pragma unroll
                    for (int n = 0; n < 4; ++n) bf[n] = *(const LAS bf16x8*)(lds + 32768 + kh * 16384 + frag_off<64>(wc * 64 + n * 16 + fr, ks, fq));
#pragma unroll
                    for (int m = 0; m < 4; ++m)
#pragma unroll
                        for (int n = 0; n < 4; ++n) acc[m][n] = __builtin_amdgcn_mfma_f32_16x16x32_bf16(bf[n], af[m], acc[m][n], 0, 0, 0);
                }
            u32x2 uvv[4][4]; float bsvv[4];
#pragma unroll
            for (int m = 0; m < 4; ++m) { const int tl = wr * 64 + m * 16 + fr; bsvv[m] = bs_[g * 128 + tl];
#pragma unroll
                for (int n = 0; n < 4; ++n) uvv[m][n] = *(const u32x2*)(U + (size_t)(tokbase + tl) * GW + c0 + wc * 64 + n * 16 + fq * 4); }
#pragma unroll
            for (int m = 0; m < 4; ++m) {
                const int tl = wr * 64 + m * 16 + fr; const float bsv = bsvv[m];
#pragma unroll
                for (int n = 0; n < 4; ++n) {
                    const int ch = c0 + wc * 64 + n * 16 + fq * 4;
                    const f32x4 gn = *(const f32x4*)(vg + ch);
                    u32x2* up = (u32x2*)(U + (size_t)(tokbase + tl) * GW + ch);
                    const u32x2 uv = uvv[m][n]; const f32x4 v = acc[m][n];
                    u32x2 o;
                    o.x = pk_bf16(bf_lo(uv.x) * (gn.x * v.x + bsv), bf_hi(uv.x) * (gn.y * v.y + bsv));
                    o.y = pk_bf16(bf_lo(uv.y) * (gn.z * v.z + bsv), bf_hi(uv.y) * (gn.w * v.w + bsv));
                    if (dry) *(u32x2*)(c.ws + 440 * MB + ((size_t)(tokbase + tl) * GW + ch) * 2) = o; else *up = o;
                }
            }
            __syncthreads();
        }
    }
}

__device__ __forceinline__ void phase_a3(const Ctx& c) {
    const bf16_t* Z = (const bf16_t*)(c.ws + WS_U); const bf16_t* W = (const bf16_t*)(c.ws + WS_WAOUT);
    const float* X = (const float*)c.a->in[IN_X]; float* H = (float*)(c.ws + WS_H);
    const int fr = c.lane & 15, fq = c.lane >> 4, wr = c.wave >> 1, wc = c.wave & 1;
    for (int u = c.vb; u < 128 * 8; u += c.nb) {
        int mt, nt; map_unit(u, 8, mt, nt);
        const bf16_t* ap[4]; const bf16_t* bp[4];
        rows_regular<64>(ap, Z + (size_t)mt * 128 * GW, GW, c.tid); rows_regular<64>(bp, W + (size_t)nt * 128 * GW, GW, c.tid);
        f32x4 acc[4][4];
#pragma unroll
        for (int m = 0; m < 4; ++m)
#pragma unroll
            for (int n = 0; n < 4; ++n) acc[m][n] = *(const f32x4*)(X + (size_t)(mt * 128 + wr * 64 + m * 16 + fr) * D + nt * 128 + wc * 64 + n * 16 + fq * 4);
        gemm_loop<64, 1, true>(c, ap, bp, bp, GW, acc, acc);
#pragma unroll
        for (int m = 0; m < 4; ++m)
#pragma unroll
            for (int n = 0; n < 4; ++n) *(f32x4*)(H + (size_t)(mt * 128 + wr * 64 + m * 16 + fr) * D + nt * 128 + wc * 64 + n * 16 + fq * 4) = acc[m][n];
    }
}

__device__ __forceinline__ void phase_route(const Ctx& c, int l, bool dry = false) {
    const __attribute__((address_space(4))) Args& a = *c.a;
    const float* H = (const float*)(c.ws + WS_H); bf16_t* XN = (bf16_t*)(c.ws + (dry ? 440 * MB : WS_XN));
    const float* wr_ = (const float*)(c.ws + WS_WR) + (size_t)l * D * 48;
    const float* gain = (const float*)a.in[IN_FFNN] + l * D;
    int* cnt = (int*)(c.ws + WS_CNT) + l * 32 + (dry ? 64 : 0); int* list = (int*)(c.ws + (dry ? 480 * MB : WS_LIST)); float* gatel = (float*)(c.ws + (dry ? 484 * MB : WS_GATE)); int* tokslot = (int*)(c.ws + (dry ? 488 * MB : WS_TOKSLOT));
    LAS float* rl = (LAS float*)(c.lds);
    LAS float* lgl = (LAS float*)(c.lds + 256);
    const int lane = c.lane, w = c.wave;
    for (int unit = c.vb; unit < T / 32; unit += c.nb) {
        const int tok0 = unit * 32;
        __syncthreads();
        for (int i = 0; i < 8; ++i) {
            const int t = tok0 + w * 8 + i;
            f32x4 v[4]; row_load(H + (size_t)t * D, lane, v);
            const float r = rsqrtf(row_sumsq(v) * (1.f / D) + EPS);
            if (lane == 0) rl[w * 8 + i] = r;
            row_store_norm_bf16(XN + (size_t)t * D, lane, v, r, gain);
        }
        {
            const int th = w & 1, kh = w >> 1, m = lane & 15, q = lane >> 4;
            const float* arow = H + (size_t)(tok0 + 16 * th + m) * D + 512 * kh + 128 * q;
            const float* brow = wr_ + (size_t)(512 * kh + 128 * q) * 48 + m;
            f32x4 acc[3]; acc[0] = acc[1] = acc[2] = (f32x4){0.f, 0.f, 0.f, 0.f};
            for (int i = 0; i < 32; ++i) {
                const f32x4 av = ((const f32x4*)arow)[i];
                const float ae[4] = {av.x, av.y, av.z, av.w};
#pragma unroll
                for (int e = 0; e < 4; ++e) {
                    const float* bp = brow + (size_t)(4 * i + e) * 48;
#pragma unroll
                    for (int nt = 0; nt < 3; ++nt) acc[nt] = __builtin_amdgcn_mfma_f32_16x16x4f32(ae[e], bp[nt * 16], acc[nt], 0, 0, 0);
                }
            }
#pragma unroll
            for (int nt = 0; nt < 3; ++nt)
#pragma unroll
                for (int j = 0; j < 4; ++j) lgl[(kh * 32 + th * 16 + 4 * q + j) * 48 + nt * 16 + m] = acc[nt][j];
        }
        __syncthreads();
        if (c.tid < 32) {
            const int tt = c.tid, t = tok0 + tt; const float r = rl[tt];
            const float* bg = (const float*)a.in[IN_BG] + l * 4; const float* be = (const float*)a.in[IN_BE] + l * 32;
            float gl[4];
#pragma unroll
            for (int o = 0; o < 4; ++o) gl[o] = (lgl[tt * 48 + o] + lgl[(32 + tt) * 48 + o]) * r + bg[o];
            int gs = 0; float gm = gl[0];
#pragma unroll
            for (int o = 1; o < 4; ++o) if (gl[o] > gm) { gm = gl[o]; gs = o; }
            float gden = 0.f;
#pragma unroll
            for (int o = 0; o < 4; ++o) gden += __expf(gl[o] - gm);
            const float pg = 1.f / gden;
            float l1 = -INFINITY, l2 = -INFINITY; int i1 = 0, i2 = 0;
            for (int i = 0; i < 8; ++i) {
                const int o = 4 + gs * 8 + i;
                const float v = (lgl[tt * 48 + o] + lgl[(32 + tt) * 48 + o]) * r + be[gs * 8 + i];
                if (v > l1) { l2 = l1; i2 = i1; l1 = v; i1 = i; } else if (v > l2) { l2 = v; i2 = i; }
            }
            const float e2 = __expf(l2 - l1), inv = 1.f / (1.f + e2);
            const float g1 = pg * inv, g2 = pg * e2 * inv;
            const int ea = gs * 8 + i1, eb = gs * 8 + i2;
            const int sa = atomicAdd(&cnt[ea], 1), sb = atomicAdd(&cnt[eb], 1);
            list[ea * T + sa] = t; gatel[ea * T + sa] = g1; tokslot[2 * t] = (ea << 16) | sa;
            list[eb * T + sb] = t; gatel[eb * T + sb] = g2; tokslot[2 * t + 1] = (eb << 16) | sb;
        }
    }
}

__device__ __forceinline__ void moe_table(const Ctx& c, int l, LAS int* pst, LAS int* cn) {
    __syncthreads();
    if (c.tid == 0) {
        const int* cnt = (const int*)(c.ws + WS_CNT) + l * 32; int acc = 0;
        for (int e = 0; e < 32; ++e) { const int n = cnt[e]; cn[e] = n; pst[e] = acc; acc += (n + 127) >> 7; }
        pst[32] = acc;
    }
    __syncthreads();
}
__device__ __forceinline__ int moe_find(LAS const int* pst, int mb) { int e = 0; for (int i = 1; i < 32; ++i) e = (pst[i] <= mb) ? i : e; return e; }

__device__ __forceinline__ void phase_e1(const Ctx& c, int l) {
    const bf16_t* XN = (const bf16_t*)(c.ws + WS_XN); const bf16_t* W1 = (const bf16_t*)(c.ws + WS_W1); const bf16_t* W3 = (const bf16_t*)(c.ws + WS_W3);
    bf16_t* HM = (bf16_t*)(c.ws + WS_HMID); const int* list = (const int*)(c.ws + WS_LIST);
    LAS int* pst = (LAS int*)(c.lds + LDS_MAIN); LAS int* cn = pst + 40;
    moe_table(c, l, pst, cn);
    const int fr = c.lane & 15, fq = c.lane >> 4, wr = c.wave >> 1, wc = c.wave & 1, tid = c.tid;
    const int nunits = pst[32] * 4;
    for (int u = c.vb; u < nunits; u += c.nb) {
        const int mb = u >> 2, nt = u & 3, e = moe_find(pst, mb), row0 = (mb - pst[e]) * 128, count = cn[e];
        const bf16_t* ap[2]; const bf16_t* b0[2]; const bf16_t* b1[2];
#pragma unroll
        for (int p = 0; p < 2; ++p) { int r = row0 + p * 64 + (tid >> 2); r = r < count ? r : row0; ap[p] = XN + (size_t)list[e * T + r] * D; }
        rows_regular<32>(b0, W1 + ((size_t)e * DE + nt * 128) * D, D, tid); rows_regular<32>(b1, W3 + ((size_t)e * DE + nt * 128) * D, D, tid);
        f32x4 a1[4][4], a3[4][4]; zero_acc(a1); zero_acc(a3);
        gemm_loop<32, 2, true>(c, ap, b0, b1, D, a1, a3);
#pragma unroll
        for (int m = 0; m < 4; ++m)
#pragma unroll
            for (int n = 0; n < 4; ++n) {
                const size_t row = (size_t)mb * 128 + wr * 64 + m * 16 + fr; const int col = nt * 128 + wc * 64 + n * 16 + fq * 4;
                const f32x4 x = a1[m][n], y = a3[m][n];
                u32x2 o; o.x = pk_bf16(x.x * sigmoidf_(x.x) * y.x, x.y * sigmoidf_(x.y) * y.y); o.y = pk_bf16(x.z * sigmoidf_(x.z) * y.z, x.w * sigmoidf_(x.w) * y.w);
                *(u32x2*)(HM + row * DE + col) = o;
            }
    }
}
__device__ __forceinline__ void phase_e2(const Ctx& c, int l) {
    const bf16_t* HM = (const bf16_t*)(c.ws + WS_HMID); const bf16_t* W2 = (const bf16_t*)(c.ws + WS_W2);
    bf16_t* Y = (bf16_t*)(c.ws + WS_Y); const float* gatel = (const float*)(c.ws + WS_GATE);
    LAS int* pst = (LAS int*)(c.lds + LDS_MAIN); LAS int* cn = pst + 40;
    moe_table(c, l, pst, cn);
    const int fr = c.lane & 15, fq = c.lane >> 4, wr = c.wave >> 1, wc = c.wave & 1, tid = c.tid;
    const int nunits = pst[32] * 8;
    for (int u = c.vb; u < nunits; u += c.nb) {
        const int mb = u >> 3, nt = u & 7, e = moe_find(pst, mb), row0 = (mb - pst[e]) * 128, count = cn[e];
        const bf16_t* ap[4]; const bf16_t* bp[4];
        rows_regular<64>(ap, HM + (size_t)mb * 128 * DE, DE, tid); rows_regular<64>(bp, W2 + ((size_t)e * D + nt * 128) * DE, DE, tid);
        f32x4 acc[4][4]; zero_acc(acc);
        gemm_loop<64, 1, true>(c, ap, bp, bp, DE, acc, acc);
        float gtv[4];
#pragma unroll
        for (int m = 0; m < 4; ++m) { const int rl_ = wr * 64 + m * 16 + fr; gtv[m] = (row0 + rl_ < count) ? gatel[e * T + row0 + rl_] : 0.f; }
#pragma unroll
        for (int m = 0; m < 4; ++m) {
            const int rl_ = wr * 64 + m * 16 + fr; const float gt = gtv[m];
#pragma unroll
            for (int n = 0; n < 4; ++n) {
                const f32x4 v = acc[m][n] * gt;
                u32x2 o; o.x = pk_bf16(v.x, v.y); o.y = pk_bf16(v.z, v.w);
                *(u32x2*)(Y + ((size_t)mb * 128 + rl_) * D + nt * 128 + wc * 64 + n * 16 + fq * 4) = o;
            }
        }
    }
}
__device__ __forceinline__ void phase_p1(const Ctx& c, int l, bool dry = false) {
    float* H = (float*)(c.ws + WS_H); float* HO = (float*)(c.ws + (dry ? 440 * MB : WS_H)); bf16_t* XN = (bf16_t*)(c.ws + (dry ? 440 * MB : WS_XN)); const bf16_t* Y = (const bf16_t*)(c.ws + WS_Y);
    const int* tokslot = (const int*)(c.ws + WS_TOKSLOT); const float* gain = (const float*)c.a->in[IN_PLEN] + l * D;
    LAS int* pst = (LAS int*)(c.lds + LDS_MAIN); LAS int* cn = pst + 40;
    moe_table(c, l, pst, cn);
    const int gw = c.vb * 4 + c.wave, ngw = c.nb * 4, lane = c.lane;
    for (int t = gw; t < T; t += ngw) {
        const int s0 = tokslot[2 * t], s1 = tokslot[2 * t + 1];
        const bf16_t* y0 = Y + ((size_t)pst[s0 >> 16] * 128 + (s0 & 0xffff)) * D; const bf16_t* y1 = Y + ((size_t)pst[s1 >> 16] * 128 + (s1 & 0xffff)) * D;
        f32x4 v[4]; row_load(H + (size_t)t * D, lane, v);
#pragma unroll
        for (int j = 0; j < 4; ++j) {
            const u32x2 a0 = ((const u32x2*)y0)[lane + 64 * j], a1 = ((const u32x2*)y1)[lane + 64 * j];
            v[j].x += bf_lo(a0.x) + bf_lo(a1.x); v[j].y += bf_hi(a0.x) + bf_hi(a1.x); v[j].z += bf_lo(a0.y) + bf_lo(a1.y); v[j].w += bf_hi(a0.y) + bf_hi(a1.y);
            ((f32x4*)(HO + (size_t)t * D))[lane + 64 * j] = v[j];
        }
        const float r = rsqrtf(row_sumsq(v) * (1.f / D) + EPS);
        row_store_norm_bf16(XN + (size_t)t * D, lane, v, r, gain);
    }
}
__device__ __forceinline__ void phase_p2(const Ctx& c, int l) {
    const bf16_t* XN = (const bf16_t*)(c.ws + WS_XN); const bf16_t* WG = (const bf16_t*)(c.ws + WS_WGATE) + (size_t)l * D * D;
    const bf16_t* PB = (const bf16_t*)(c.ws + WS_PBF) + (size_t)l * T * PLE; const bf16_t* WP = (const bf16_t*)(c.ws + WS_WPROJ) + (size_t)l * D * PLE;
    float* H = (float*)(c.ws + WS_H);
    const int fr = c.lane & 15, fq = c.lane >> 4, wr = c.wave >> 1, wc = c.wave & 1;
    for (int u = c.vb; u < 128 * 8; u += c.nb) {
        int mt, nt; map_unit(u, 8, mt, nt);
        const bf16_t* ap[4]; const bf16_t* bp[4];
        f32x4 ag[4][4], apj[4][4]; zero_acc(ag); zero_acc(apj);
        rows_regular<64>(ap, XN + (size_t)mt * 128 * D, D, c.tid); rows_regular<64>(bp, WG + (size_t)nt * 128 * D, D, c.tid);
        gemm_loop<64, 1, true>(c, ap, bp, bp, D, ag, ag);
        rows_regular<64>(ap, PB + (size_t)mt * 128 * PLE, PLE, c.tid); rows_regular<64>(bp, WP + (size_t)nt * 128 * PLE, PLE, c.tid);
        gemm_loop<64, 1, true>(c, ap, bp, bp, PLE, apj, apj);
        f32x4 hres[4][4];
#pragma unroll
        for (int m = 0; m < 4; ++m)
#pragma unroll
            for (int n = 0; n < 4; ++n) hres[m][n] = *(const f32x4*)(H + (size_t)(mt * 128 + wr * 64 + m * 16 + fr) * D + nt * 128 + wc * 64 + n * 16 + fq * 4);
#pragma unroll
        for (int m = 0; m < 4; ++m)
#pragma unroll
            for (int n = 0; n < 4; ++n) {
                const size_t off = (size_t)(mt * 128 + wr * 64 + m * 16 + fr) * D + nt * 128 + wc * 64 + n * 16 + fq * 4;
                const f32x4 g = ag[m][n], pj = apj[m][n]; f32x4 h = hres[m][n];
                h.x += sigmoidf_(g.x) * pj.x; h.y += sigmoidf_(g.y) * pj.y; h.z += sigmoidf_(g.z) * pj.z; h.w += sigmoidf_(g.w) * pj.w;
                *(f32x4*)(H + off) = h;
            }
    }
}
__device__ __forceinline__ void phase_norm_bf16(const Ctx& c, const float* gain) {
    const float* H = (const float*)(c.ws + WS_H); bf16_t* XN = (bf16_t*)(c.ws + WS_XN);
    const int gw = c.vb * 4 + c.wave, ngw = c.nb * 4;
    for (int t = gw; t < T; t += ngw) {
        f32x4 v[4]; row_load(H + (size_t)t * D, c.lane, v);
        const float r = rsqrtf(row_sumsq(v) * (1.f / D) + EPS);
        row_store_norm_bf16(XN + (size_t)t * D, c.lane, v, r, gain);
    }
}
__device__ __forceinline__ void phase_final(const Ctx& c) {
    const float* H = (const float*)(c.ws + WS_H); float* O = c.a->out; const float* gain = (const float*)c.a->in[IN_FINN];
    const int gw = c.vb * 4 + c.wave, ngw = c.nb * 4;
    for (int t = gw; t < T; t += ngw) {
        f32x4 v[4]; row_load(H + (size_t)t * D, c.lane, v);
        const float r = rsqrtf(row_sumsq(v) * (1.f / D) + EPS);
#pragma unroll
        for (int j = 0; j < 4; ++j) { const f32x4 g = ((const f32x4*)gain)[c.lane + 64 * j]; ((f32x4*)(O + (size_t)t * D))[c.lane + 64 * j] = v[j] * r * g; }
    }
}

__device__ __forceinline__ void phase_b1(const Ctx& c, size_t raw_off = WS_RAW) {
    const bf16_t* XN = (const bf16_t*)(c.ws + WS_XN); const bf16_t* W = (const bf16_t*)(c.ws + WS_WBIN); bf16_t* RAW = (bf16_t*)(c.ws + raw_off);
    const int fr = c.lane & 15, fq = c.lane >> 4, wr = c.wave >> 1, wc = c.wave & 1;
    for (int u = c.vb; u < 128 * 17; u += c.nb) {
        int mt, nt; map_unit(u, 17, mt, nt);
        const bf16_t* ap[4]; const bf16_t* bp[4];
        rows_regular<64>(ap, XN + (size_t)mt * 128 * D, D, c.tid); rows_regular<64>(bp, W + (size_t)nt * 128 * D, D, c.tid);
        f32x4 acc[4][4]; zero_acc(acc);
        gemm_loop<64, 1, true>(c, ap, bp, bp, D, acc, acc);
#pragma unroll
        for (int m = 0; m < 4; ++m)
#pragma unroll
            for (int n = 0; n < 4; ++n) {
                const f32x4 v = acc[m][n]; u32x2 o; o.x = pk_bf16(v.x, v.y); o.y = pk_bf16(v.z, v.w);
                *(u32x2*)(RAW + (size_t)(mt * 128 + wr * 64 + m * 16 + fr) * BINP + nt * 128 + wc * 64 + n * 16 + fq * 4) = o;
            }
    }
}

__device__ __forceinline__ void unpack8(const u32x4 r, float (&e)[8]) { e[0] = bf_lo(r.x); e[1] = bf_hi(r.x); e[2] = bf_lo(r.y); e[3] = bf_hi(r.y); e[4] = bf_lo(r.z); e[5] = bf_hi(r.z); e[6] = bf_lo(r.w); e[7] = bf_hi(r.w); }
__device__ __forceinline__ u32x4 pack8(const float (&e)[8]) { u32x4 o; o.x = pk_bf16(e[0], e[1]); o.y = pk_bf16(e[2], e[3]); o.z = pk_bf16(e[4], e[5]); o.w = pk_bf16(e[6], e[7]); return o; }
__device__ __forceinline__ void phase_rope(const Ctx& c) {
    const bf16_t* RAW = (const bf16_t*)(c.ws + WS_RAW);
    bf16_t* Q = (bf16_t*)(c.ws + WS_Q); bf16_t* K = (bf16_t*)(c.ws + WS_K); bf16_t* V = (bf16_t*)(c.ws + WS_V);
    bf16_t* QI = (bf16_t*)(c.ws + WS_QI); bf16_t* KI = (bf16_t*)(c.ws + WS_KI); float* WI = (float*)(c.ws + WS_WI);
    const int* pos = (const int*)c.a->in[IN_POS];
    LAS float* cs = (LAS float*)(c.lds + c.wave * 256);
    const int gw = c.vb * 4 + c.wave, ngw = c.nb * 4, lane = c.lane;
    for (int t = gw; t < T; t += ngw) {
        if (lane < 24) {
            const double ex = (lane < 16) ? (double)lane * (1.0 / 16.0) : (double)(lane - 16) * (1.0 / 8.0);
            const float invf = (float)exp2(-ex * 18.931568569324174);
            const float ang = (float)pos[t] * invf;
            const double ad = (double)ang; const double n = rint(ad * 0.15915494309189535); const float red = (float)(ad - n * 6.283185307179586);
            cs[lane] = cosf(red); cs[32 + lane] = sinf(red);
        }
        LDS_WAIT();
        const bf16_t* row = RAW + (size_t)t * BINP;
        for (int ch = lane; ch < BINP / 8; ch += 64) {
            const u32x4 own = ((const u32x4*)row)[ch];
            float e[8]; unpack8(own, e);
            if (ch < 160) {
                const int cc = ch & 15;
                if (cc < 4) {
                    const u32x4 oth = ((const u32x4*)row)[ch ^ 2]; float p[8]; unpack8(oth, p);
                    const int f0 = (cc & 1) * 8;
#pragma unroll
                    for (int i = 0; i < 8; ++i) { const float co = cs[f0 + i], si = cs[32 + f0 + i]; e[i] = (cc < 2) ? (e[i] * co - p[i] * si) : (e[i] * co + p[i] * si); }
                }
                if (ch < 128) {
#pragma unroll
                    for (int i = 0; i < 8; ++i) e[i] *= 0.08838834764831845f;
                    ((u32x4*)(Q + (size_t)t * D))[ch] = pack8(e);
                } else ((u32x4*)(K + (size_t)t * 256))[ch - 128] = pack8(e);
            } else if (ch < 192) {
                ((u32x4*)(V + (size_t)t * 256))[ch - 160] = own;
            } else if (ch < 264) {
                const int cc = ch & 7;
                if (cc < 2) {
                    const u32x4 oth = ((const u32x4*)row)[ch ^ 1]; float p[8]; unpack8(oth, p);
#pragma unroll
                    for (int i = 0; i < 8; ++i) { const float co = cs[16 + i], si = cs[32 + 16 + i]; e[i] = (cc == 0) ? (e[i] * co - p[i] * si) : (e[i] * co + p[i] * si); }
                }
                if (ch < 256) ((u32x4*)(QI + (size_t)t * 512))[ch - 192] = pack8(e);
                else ((u32x4*)(KI + (size_t)t * 64))[ch - 256] = pack8(e);
            } else if (ch == 264) {
                f32x4 w0 = {e[0], e[1], e[2], e[3]}, w1 = {e[4], e[5], e[6], e[7]};
                const float sc = 0.044194173824159216f;
                ((f32x4*)(WI + (size_t)t * 8))[0] = w0 * sc; ((f32x4*)(WI + (size_t)t * 8))[1] = w1 * sc;
            }
        }
        LDS_WAIT();
    }
}

__device__ __forceinline__ size_t srow_off(int t) { const int m = t >> 6, r = t & 63; return (size_t)64 * (m + 1) * (32 * m + r); }
constexpr size_t S_BATCH = (size_t)64 * 65 * 2048;
constexpr int SCORE_UNITS = 4 * 312;
__device__ __forceinline__ void phase_score(const Ctx& c) {
    const bf16_t* QI = (const bf16_t*)(c.ws + WS_QI); const bf16_t* KI = (const bf16_t*)(c.ws + WS_KI); const float* WI = (const float*)(c.ws + WS_WI);
    float* S = (float*)(c.ws + WS_S);
    const int lane = c.lane, hf = lane >> 5, col = lane & 31, w = c.wave;
    for (int u = c.vb; u < SCORE_UNITS; u += c.nb) {
        const int b = u & 3, r = u >> 2;
        int kc, qb;
        if (r < 120) { kc = 0; qb = 8 + r; } else if (r < 216) { kc = 1; qb = 32 + (r - 120); } else if (r < 280) { kc = 2; qb = 64 + (r - 216); } else { kc = 3; qb = 96 + (r - 280); }
        const int tb = b * SEQ, t0 = 32 * qb + 8 * w;
        bf16x8 af[2][4]; f32x4 wv[2][4];
        { const int rho = lane & 31, ql = 2 * ((rho >> 2) & 1) + (rho >> 4), hd = 4 * ((rho >> 3) & 1) + (rho & 3);
#pragma unroll
          for (int a = 0; a < 2; ++a) {
              const bf16_t* qp = QI + (size_t)(tb + t0 + 4 * a + ql) * 512 + hd * 64 + 8 * hf;
#pragma unroll
              for (int ks = 0; ks < 4; ++ks) af[a][ks] = *(const bf16x8*)(qp + 16 * ks);
              const float* wp = WI + (size_t)(tb + t0 + 4 * a + 2 * hf) * 8;
#pragma unroll
              for (int i = 0; i < 4; ++i) wv[a][i] = ((const f32x4*)wp)[i];
          } }
        const int ntile = min(32, qb + 1 - 32 * kc), key0 = 1024 * kc;
        float* Sb = S + (size_t)b * S_BATCH;
        size_t ro[2][2];
#pragma unroll
        for (int a = 0; a < 2; ++a) { ro[a][0] = srow_off(t0 + 4 * a + 2 * hf); ro[a][1] = srow_off(t0 + 4 * a + 2 * hf + 1); }
        bf16x8 nbf[4];
        { const bf16_t* kp = KI + (size_t)(tb + key0 + col) * 64 + 8 * hf;
#pragma unroll
          for (int ks = 0; ks < 4; ++ks) nbf[ks] = *(const bf16x8*)(kp + 16 * ks); }
        for (int kt = 0; kt < ntile; ++kt) {
            const int key = key0 + 32 * kt + col;
            bf16x8 cb[4];
#pragma unroll
            for (int ks = 0; ks < 4; ++ks) cb[ks] = nbf[ks];
            { const int nk_ = (kt + 1 < ntile) ? key + 32 : key;
              const bf16_t* kp = KI + (size_t)(tb + nk_) * 64 + 8 * hf;
#pragma unroll
              for (int ks = 0; ks < 4; ++ks) nbf[ks] = *(const bf16x8*)(kp + 16 * ks); }
#pragma unroll
            for (int a = 0; a < 2; ++a) {
                f32x16 acc = {};
#pragma unroll
                for (int ks = 0; ks < 4; ++ks) acc = __builtin_amdgcn_mfma_f32_32x32x16_bf16(af[a][ks], cb[ks], acc, 0, 0, 0);
                float s0 = fmaxf(acc[0], 0.f) * wv[a][0].x; s0 += fmaxf(acc[1], 0.f) * wv[a][0].y; s0 += fmaxf(acc[2], 0.f) * wv[a][0].z; s0 += fmaxf(acc[3], 0.f) * wv[a][0].w;
                s0 += fmaxf(acc[4], 0.f) * wv[a][1].x; s0 += fmaxf(acc[5], 0.f) * wv[a][1].y; s0 += fmaxf(acc[6], 0.f) * wv[a][1].z; s0 += fmaxf(acc[7], 0.f) * wv[a][1].w;
                float s1 = fmaxf(acc[8], 0.f) * wv[a][2].x; s1 += fmaxf(acc[9], 0.f) * wv[a][2].y; s1 += fmaxf(acc[10], 0.f) * wv[a][2].z; s1 += fmaxf(acc[11], 0.f) * wv[a][2].w;
                s1 += fmaxf(acc[12], 0.f) * wv[a][3].x; s1 += fmaxf(acc[13], 0.f) * wv[a][3].y; s1 += fmaxf(acc[14], 0.f) * wv[a][3].z; s1 += fmaxf(acc[15], 0.f) * wv[a][3].w;
                const int tA = t0 + 4 * a + 2 * hf;
                Sb[ro[a][0] + key] = (key <= tA) ? s0 : -INFINITY;
                Sb[ro[a][1] + key] = (key <= tA + 1) ? s1 : -INFINITY;
            }
        }
    }
}

constexpr int NBINS = 2048, CAND_CAP = 256, SEL_WAVE_LDS = 8192 + 2048 + 64;
__device__ __forceinline__ void phase_select(const Ctx& c) {
    const float* S = (const float*)(c.ws + WS_S); int* SEL = (int*)(c.ws + WS_SEL);
    LAS int* hist = (LAS int*)(c.lds + c.wave * SEL_WAVE_LDS);
    LAS float* candv = (LAS float*)(hist + NBINS);
    LAS int* candi = (LAS int*)(candv + CAND_CAP);
    LAS int* thr = candi + CAND_CAP;
    const int gw = c.vb * 4 + c.wave, ngw = c.nb * 4;
    for (int j = gw; j < 4 * 3840; j += ngw) {
        int lane = c.lane;
        asm volatile("" : "+v"(lane));
        const int b = j & 3, t = 4095 - (j >> 2), ni = (t + 64) >> 6;
        const float* row = S + (size_t)b * S_BATCH + srow_off(t);
        float s[64];
#pragma unroll
        for (int g4 = 0; g4 < 4; ++g4) {
            if (16 * g4 < ni) {
#pragma unroll
                for (int i = 16 * g4; i < 16 * g4 + 16; ++i) { const int k = 64 * i + lane; const float v = row[min(k, t)]; s[i] = (k <= t) ? v : -INFINITY; }
            } else {
#pragma unroll
                for (int i = 16 * g4; i < 16 * g4 + 16; ++i) s[i] = -INFINITY;
            }
        }
        asm volatile("" : "+v"(lane));
        float mn = INFINITY, mx = -INFINITY;
#pragma unroll
        for (int i = 0; i < 64; ++i) { mx = fmaxf(mx, s[i]); mn = fminf(mn, (s[i] == -INFINITY) ? INFINITY : s[i]); }
#pragma unroll
        for (int o = 1; o < 64; o <<= 1) { mx = fmaxf(mx, __shfl_xor(mx, o)); mn = fminf(mn, __shfl_xor(mn, o)); }
        const float sc = (mx > mn) ? (float)NBINS / (mx - mn) : 0.f;
#pragma unroll
        for (int i = 0; i < 8; ++i) ((LAS u32x4*)hist)[lane * 8 + i] = (u32x4){0u, 0u, 0u, 0u};
        LDS_WAIT();
#define BINOF(v) min(NBINS - 1, (int)(((v) - mn) * sc))
#pragma unroll
        for (int i = 0; i < 64; ++i) if ((i & ~7) < ni && s[i] != -INFINITY) lds_inc(&hist[BINOF(s[i])]);
        LDS_WAIT();
        int bs, need;
        {
            const LAS int* hq = hist + lane * 32;
            int loc = 0;
#pragma unroll
            for (int i = 0; i < 8; ++i) { const u32x4 h4 = ((const LAS u32x4*)hq)[i]; loc += (int)(h4.x + h4.y + h4.z + h4.w); }
            int suf = loc;
#pragma unroll
            for (int o = 1; o < 64; o <<= 1) { const int v = __shfl_down(suf, o); if (lane + o < 64) suf += v; }
            const int above = suf - loc;
            const bool cross = (above < 256 && suf >= 256);
            int bsl = 0, abl = 0;
            if (cross) { int run = above; for (int i = 31; i >= 0; --i) { const int h = hq[i]; if (run < 256 && run + h >= 256) { bsl = lane * 32 + i; abl = run; } run += h; } }
            const unsigned long long cm = __ballot(cross);
            const int src = cm ? (int)__builtin_ctzll(cm) : 0;
            bs = __shfl(bsl, src); need = 256 - __shfl(abl, src);
        }
        int bs2 = -1;
        if (__shfl(hist[bs], 0) > 32) {
#pragma unroll
            for (int i = 0; i < 8; ++i) ((LAS u32x4*)hist)[lane * 8 + i] = (u32x4){0u, 0u, 0u, 0u};
            LDS_WAIT();
#define SUBOF(v) min(NBINS - 1, (int)((((v) - mn) * sc - (float)bs) * (float)NBINS))
#pragma unroll
            for (int i = 0; i < 64; ++i) if ((i & ~7) < ni && s[i] != -INFINITY && BINOF(s[i]) == bs) lds_inc(&hist[SUBOF(s[i])]);
            LDS_WAIT();
            const LAS int* hq = hist + lane * 32;
            int loc = 0;
#pragma unroll
            for (int i = 0; i < 8; ++i) { const u32x4 h4 = ((const LAS u32x4*)hq)[i]; loc += (int)(h4.x + h4.y + h4.z + h4.w); }
            int suf = loc;
#pragma unroll
            for (int o = 1; o < 64; o <<= 1) { const int v = __shfl_down(suf, o); if (lane + o < 64) suf += v; }
            const int above = suf - loc;
            const bool cross = (above < need && suf >= need);
            int bsl = 0, abl = 0;
            if (cross) { int run = above; for (int i = 31; i >= 0; --i) { const int h = hq[i]; if (run < need && run + h >= need) { bsl = lane * 32 + i; abl = run; } run += h; } }
            const unsigned long long cm = __ballot(cross);
            const int src = cm ? (int)__builtin_ctzll(cm) : 0;
            bs2 = __shfl(bsl, src); need = need - __shfl(abl, src);
        }
        asm volatile("" : "+v"(lane));
        int nc = 0;
#pragma unroll
        for (int i = 0; i < 64; ++i) if ((i & ~7) < ni) {
            bool p = (s[i] != -INFINITY) && (BINOF(s[i]) == bs);
            if (bs2 >= 0) p = p && (SUBOF(s[i]) == bs2);
            const unsigned long long m = __ballot(p);
            const int pos = nc + (int)__builtin_amdgcn_mbcnt_hi((unsigned)(m >> 32), __builtin_amdgcn_mbcnt_lo((unsigned)m, 0u));
            if (p && pos < CAND_CAP) { candv[pos] = s[i]; candi[pos] = 64 * i + lane; }
            nc += (int)__popcll(m);
        }
        nc = min(nc, CAND_CAP);
        LDS_WAIT();
        for (int i = lane; i < nc; i += 64) {
            const float v = candv[i]; const int id = candi[i];
            int rank = 0;
            for (int k = 0; k < nc; ++k) { const float vk = candv[k]; const int ik = candi[k]; rank += (vk > v || (vk == v && ik < id)) ? 1 : 0; }
            if (rank == need - 1) { thr[0] = __float_as_int(v); thr[1] = id; }
        }
        LDS_WAIT();
        const float tv = __int_as_float(thr[0]); const int ti = thr[1];
        asm volatile("" : "+v"(lane));
        int* selr = SEL + ((size_t)b * SEQ + t) * 256;
        int base = 0;
#pragma unroll
        for (int i = 0; i < 64; ++i) if ((i & ~7) < ni) {
            const int key = 64 * i + lane;
            const bool p = (s[i] > tv) || (s[i] == tv && key <= ti);
            const unsigned long long m = __ballot(p);
            const int pos = base + (int)__builtin_amdgcn_mbcnt_hi((unsigned)(m >> 32), __builtin_amdgcn_mbcnt_lo((unsigned)m, 0u));
            if (p && pos < 256) selr[pos] = key;
            base += (int)__popcll(m);
        }
        LDS_WAIT();
#undef BINOF
#undef SUBOF
    }
}

typedef short s16x4 __attribute__((ext_vector_type(4)));
__device__ __forceinline__ unsigned vimg_f(unsigned r) { return ((r & 3u) << 2) | ((r >> 2) & 3u); }
__device__ __forceinline__ void tr_read8(const unsigned (&ad)[8], s16x4 (&r)[8]) {
    asm volatile("ds_read_b64_tr_b16 %0, %8\n\tds_read_b64_tr_b16 %1, %9\n\tds_read_b64_tr_b16 %2, %10\n\tds_read_b64_tr_b16 %3, %11\n\t"
                 "ds_read_b64_tr_b16 %4, %12\n\tds_read_b64_tr_b16 %5, %13\n\tds_read_b64_tr_b16 %6, %14\n\tds_read_b64_tr_b16 %7, %15\n\ts_waitcnt lgkmcnt(0)"
                 : "=&v"(r[0]), "=&v"(r[1]), "=&v"(r[2]), "=&v"(r[3]), "=&v"(r[4]), "=&v"(r[5]), "=&v"(r[6]), "=&v"(r[7])
                 : "v"(ad[0]), "v"(ad[1]), "v"(ad[2]), "v"(ad[3]), "v"(ad[4]), "v"(ad[5]), "v"(ad[6]), "v"(ad[7]) : "memory");
}
constexpr int ATT_WAVE_LDS = 19456;
__device__ __forceinline__ void phase_attn(const Ctx& c) {
    const bf16_t* Q = (const bf16_t*)(c.ws + WS_Q); const bf16_t* K = (const bf16_t*)(c.ws + WS_K); const bf16_t* V = (const bf16_t*)(c.ws + WS_V);
    const int* SEL = (const int*)(c.ws + WS_SEL); bf16_t* O = (bf16_t*)(c.ws + WS_O);
    LAS unsigned char* wl = c.lds + c.wave * ATT_WAVE_LDS;
    LAS int* sl = (LAS int*)wl;
    LAS unsigned short* pT = (LAS unsigned short*)(wl + 1024);
    LAS unsigned char* vb = wl + 3072;
    const int lane = c.lane, fr = lane & 15, fq = lane >> 4;
    const int gw = c.vb * 4 + c.wave, ngw = c.nb * 4;
    unsigned tro[16];
    { const unsigned q = (unsigned)fr >> 2, p = (unsigned)fr & 3u;
#pragma unroll
      for (int c2 = 0; c2 < 8; ++c2)
#pragma unroll
          for (int t = 0; t < 2; ++t) { const unsigned row = 8u * fq + 4u * t + q, ch = 2u * c2 + (p >> 1); tro[c2 * 2 + t] = 256u * row + 16u * (ch ^ vimg_f(row)) + 8u * (p & 1u); } }
    const unsigned vb_addr = (unsigned)(size_t)vb;
    for (int task = gw; task < T * 2; task += ngw) {
        const int tg = task >> 1, g = task & 1, b = tg >> 12, t = tg & 4095, tb = b * SEQ;
        const int nsel = min(256, t + 1), ntile = (nsel + 15) >> 4, nch = (nsel + 31) >> 5;
#pragma unroll
        for (int i = 0; i < 4; ++i) { const int s_ = lane + 64 * i; int idx = 0; if (s_ < nsel) idx = (t < 256) ? s_ : SEL[(size_t)tg * 256 + s_]; idx = ((unsigned)idx <= (unsigned)t) ? idx : 0; sl[s_] = idx; }
        bf16x8 qf[4];
        { const bf16_t* qp = Q + (size_t)tg * D + (4 * g + (fr & 3)) * 128 + 8 * fq;
#pragma unroll
          for (int ks = 0; ks < 4; ++ks) qf[ks] = *(const bf16x8*)(qp + 32 * ks); }
        LDS_WAIT();
        const bf16_t* vbase = V + (size_t)tb * 256 + g * 128;
#define V_GATHER(chk, bufsel) do { _Pragma("unroll") for (int i_ = 0; i_ < 8; ++i_) { const int r_ = 4 * i_ + fq; const int key_ = sl[32 * (chk) + r_]; \
            __builtin_amdgcn_global_load_lds((const unsigned*)(vbase + (size_t)key_ * 256 + (((unsigned)fr ^ vimg_f((unsigned)r_)) << 3)), \
                                             (LAS unsigned*)(vb + (bufsel) * 8192 + i_ * 1024 + lane * 16), 16, 0, 0); } } while (0)
        V_GATHER(0, 0);
        f32x4 lg[16];
#pragma unroll
        for (int kt = 0; kt < 16; ++kt) {
            const int key = sl[kt * 16 + fr];
            const bf16_t* kp = K + (size_t)(tb + key) * 256 + g * 128 + 8 * fq;
            f32x4 acc = {0.f, 0.f, 0.f, 0.f};
#pragma unroll
            for (int ks = 0; ks < 4; ++ks) { const bf16x8 kf = *(const bf16x8*)(kp + 32 * ks); acc = __builtin_amdgcn_mfma_f32_16x16x32_bf16(qf[ks], kf, acc, 0, 0, 0); }
            const bool ok = (kt * 16 + fr < nsel);
            lg[kt].x = ok ? acc.x : -INFINITY; lg[kt].y = ok ? acc.y : -INFINITY; lg[kt].z = ok ? acc.z : -INFINITY; lg[kt].w = ok ? acc.w : -INFINITY;
        }
        f32x4 mx = lg[0];
#pragma unroll
        for (int kt = 1; kt < 16; ++kt) { mx.x = fmaxf(mx.x, lg[kt].x); mx.y = fmaxf(mx.y, lg[kt].y); mx.z = fmaxf(mx.z, lg[kt].z); mx.w = fmaxf(mx.w, lg[kt].w); }
#pragma unroll
        for (int o = 1; o < 16; o <<= 1) { mx.x = fmaxf(mx.x, __shfl_xor(mx.x, o)); mx.y = fmaxf(mx.y, __shfl_xor(mx.y, o)); mx.z = fmaxf(mx.z, __shfl_xor(mx.z, o)); mx.w = fmaxf(mx.w, __shfl_xor(mx.w, o)); }
        f32x4 sm = {0.f, 0.f, 0.f, 0.f};
#pragma unroll
        for (int kt = 0; kt < 16; ++kt) { f32x4 p; p.x = __expf(lg[kt].x - mx.x); p.y = __expf(lg[kt].y - mx.y); p.z = __expf(lg[kt].z - mx.z); p.w = __expf(lg[kt].w - mx.w); lg[kt] = p; sm += p; }
#pragma unroll
        for (int o = 1; o < 16; o <<= 1) { sm.x += __shfl_xor(sm.x, o); sm.y += __shfl_xor(sm.y, o); sm.z += __shfl_xor(sm.z, o); sm.w += __shfl_xor(sm.w, o); }
        { const float inv = 1.f / (fq == 0 ? sm.x : fq == 1 ? sm.y : fq == 2 ? sm.z : sm.w);
#pragma unroll
          for (int kt = 0; kt < 16; ++kt) { const float pv = (fq == 0 ? lg[kt].x : fq == 1 ? lg[kt].y : fq == 2 ? lg[kt].z : lg[kt].w) * inv; pT[fq * 256 + kt * 16 + fr] = (unsigned short)(pk_bf16(pv, pv) & 0xffffu); } }
        LDS_WAIT();
        f32x4 oacc[8];
#pragma unroll
        for (int c2 = 0; c2 < 8; ++c2) oacc[c2] = (f32x4){0.f, 0.f, 0.f, 0.f};
        for (int ch = 0; ch < nch; ++ch) {
            if (ch + 1 < nch) { V_GATHER(ch + 1, (ch + 1) & 1); asm volatile("s_waitcnt vmcnt(8)" ::: "memory"); }
            else asm volatile("s_waitcnt vmcnt(0)" ::: "memory");
            const bf16x8 pa = *(const LAS bf16x8*)(pT + (fr & 3) * 256 + 32 * ch + 8 * fq);
            const unsigned cb = vb_addr + (unsigned)(ch & 1) * 8192u;
            unsigned ad[8]; s16x4 r0[8], r1[8];
#pragma unroll
            for (int i = 0; i < 8; ++i) ad[i] = cb + tro[i];
            tr_read8(ad, r0);
#pragma unroll
            for (int i = 0; i < 8; ++i) ad[i] = cb + tro[8 + i];
            tr_read8(ad, r1);
#pragma unroll
            for (int c2 = 0; c2 < 4; ++c2) { const bf16x8 vf = __builtin_shufflevector(r0[2 * c2], r0[2 * c2 + 1], 0, 1, 2, 3, 4, 5, 6, 7); oacc[c2] = __builtin_amdgcn_mfma_f32_16x16x32_bf16(pa, vf, oacc[c2], 0, 0, 0); }
#pragma unroll
            for (int c2 = 0; c2 < 4; ++c2) { const bf16x8 vf = __builtin_shufflevector(r1[2 * c2], r1[2 * c2 + 1], 0, 1, 2, 3, 4, 5, 6, 7); oacc[4 + c2] = __builtin_amdgcn_mfma_f32_16x16x32_bf16(pa, vf, oacc[4 + c2], 0, 0, 0); }
        }
        { bf16_t* op = O + (size_t)tg * D + (4 * g + fq) * 128 + fr;
#pragma unroll
          for (int c2 = 0; c2 < 8; ++c2) { const float ov = (fq == 0 ? oacc[c2].x : fq == 1 ? oacc[c2].y : fq == 2 ? oacc[c2].z : oacc[c2].w); op[16 * c2] = (bf16_t)(pk_bf16(ov, ov) & 0xffffu); } }
        LDS_WAIT();
    }
#undef V_GATHER
}

__device__ __forceinline__ void phase_b4(const Ctx& c) {
    const bf16_t* OB = (const bf16_t*)(c.ws + WS_O); const bf16_t* W = (const bf16_t*)(c.ws + WS_WBOUT); float* H = (float*)(c.ws + WS_H);
    const int fr = c.lane & 15, fq = c.lane >> 4, wr = c.wave >> 1, wc = c.wave & 1;
    for (int u = c.vb; u < 128 * 8; u += c.nb) {
        int mt, nt; map_unit(u, 8, mt, nt);
        const bf16_t* ap[4]; const bf16_t* bp[4];
        rows_regular<64>(ap, OB + (size_t)mt * 128 * D, D, c.tid); rows_regular<64>(bp, W + (size_t)nt * 128 * D, D, c.tid);
        f32x4 acc[4][4];
#pragma unroll
        for (int m = 0; m < 4; ++m)
#pragma unroll
            for (int n = 0; n < 4; ++n) acc[m][n] = *(const f32x4*)(H + (size_t)(mt * 128 + wr * 64 + m * 16 + fr) * D + nt * 128 + wc * 64 + n * 16 + fq * 4);
        gemm_loop<64, 1, true>(c, ap, bp, bp, D, acc, acc);
#pragma unroll
        for (int m = 0; m < 4; ++m)
#pragma unroll
            for (int n = 0; n < 4; ++n) *(f32x4*)(H + (size_t)(mt * 128 + wr * 64 + m * 16 + fr) * D + nt * 128 + wc * 64 + n * 16 + fq * 4) = acc[m][n];
    }
}

constexpr int NPHASE = 22;
__global__ void __launch_bounds__(NTH, 2) mk_fwd(Args args) {
    extern __shared__ __attribute__((aligned(16))) unsigned char lds_raw[];
    Ctx c;
    c.lds = (LAS unsigned char*)lds_raw; c.tid = threadIdx.x; c.lane = c.tid & 63; c.wave = __builtin_amdgcn_readfirstlane(c.tid >> 6);
    c.nb = gridDim.x; { const int bx = blockIdx.x; c.vb = (c.nb % 8 == 0) ? (bx % 8) * (c.nb / 8) + bx / 8 : bx; }
    c.a = (const __attribute__((address_space(4))) Args*)__builtin_amdgcn_kernarg_segment_ptr(); c.ws = args.ws;
    volatile LAS unsigned* st = (volatile LAS unsigned*)(c.lds + LDS_MAIN + 1008);
    const bool multi = (args.ph_hi - args.ph_lo) > 1;
    XcdBarrier bar; bar.bar = (unsigned*)(c.ws + WS_CTL); bar.x = 0; bar.st = st;
    if (multi) {
        if (c.tid == 0) { st[0] = 0u; st[1] = 0u; }
        __syncthreads();
        bar = xcd_barrier_post((unsigned*)(c.ws + WS_CTL), st);
    }
    const int ph_lo = args.ph_lo, ph_hi = args.ph_hi;
#ifndef PH_MASK
#define PH_MASK 0x3fffff
#endif
#define PHON(k) ((PH_MASK >> (k)) & 1)
#define PHASE(k, body) do { if (PHON(k) && ph_lo <= (k) && (k) < ph_hi) { \
        { int t_ = threadIdx.x, vb_ = __builtin_amdgcn_readfirstlane(c.vb); \
          const __attribute__((address_space(4))) Args* ka = (const __attribute__((address_space(4))) Args*)__builtin_amdgcn_kernarg_segment_ptr(); \
          asm volatile("" : "+v"(t_), "+s"(vb_), "+s"(ka)); \
          c.tid = t_; c.lane = t_ & 63; c.wave = __builtin_amdgcn_readfirstlane(t_ >> 6); c.vb = vb_; c.a = ka; c.ws = ka->ws; } \
        body; \
        if (MK_REP == (k)) { __syncthreads(); body; } \
        if ((k) + 1 < ph_hi) xcd_barrier(bar); \
        if ((k) == 3) { for (int xb_ = 0; xb_ < MK_XBAR; ++xb_) xcd_barrier(bar); } } } while (0)
    PHASE(0, phase_prep(c));
    PHASE(1, phase_a1(c));
    PHASE(2, { if (MK_DRY == 2) { phase_a2(c, true); __syncthreads(); } phase_a2(c); });
    PHASE(3, phase_a3(c));
    PHASE(4, { if (MK_DRY == 4) { phase_route(c, 0, true); __syncthreads(); } phase_route(c, 0); });
    PHASE(5, phase_e1(c, 0));
    PHASE(6, phase_e2(c, 0));
    PHASE(7, { if (MK_DRY == 7) { phase_p1(c, 0, true); __syncthreads(); } phase_p1(c, 0); });
    PHASE(8, phase_p2(c, 0));
    PHASE(9, { phase_norm_bf16(c, (const float*)c.a->in[IN_MIXN] + D); convert_moe_layer(c, 1); });
    PHASE(10, phase_b1(c));
    PHASE(11, phase_rope(c));
    PHASE(12, phase_score(c));
    PHASE(13, phase_select(c));
    PHASE(14, phase_attn(c));
    PHASE(15, phase_b4(c));
    PHASE(16, phase_route(c, 1));
    PHASE(17, phase_e1(c, 1));
    PHASE(18, phase_e2(c, 1));
    PHASE(19, phase_p1(c, 1));
    PHASE(20, phase_p2(c, 1));
    PHASE(21, phase_final(c));
}

#ifdef MK_DUMP
__global__ void dump_k(const unsigned char* ws, float* out) {
    const size_t i = (size_t)blockIdx.x * 256 + threadIdx.x;
#if MK_DUMP == 1
    ((f32x4*)out)[i] = ((const f32x4*)(ws + WS_H))[i];
#elif MK_DUMP == 2
    { const u32x2 v = ((const u32x2*)(ws + WS_O))[i]; f32x4 o = {bf_lo(v.x), bf_hi(v.x), bf_lo(v.y), bf_hi(v.y)}; ((f32x4*)out)[i] = o; }
#elif MK_DUMP == 3
    { const int* sp = (const int*)(ws + WS_SEL); f32x4 o = {0.f,0.f,0.f,0.f}; if (i < (size_t)T * 64) { o.x = (float)sp[4*i]; o.y = (float)sp[4*i+1]; o.z = (float)sp[4*i+2]; o.w = (float)sp[4*i+3]; } ((f32x4*)out)[i] = o; }
#elif MK_DUMP == 5
    { const u32x2 v = ((const u32x2*)(ws + WS_XN))[i]; f32x4 o = {bf_lo(v.x), bf_hi(v.x), bf_lo(v.y), bf_hi(v.y)}; ((f32x4*)out)[i] = o; }
#elif MK_DUMP == 6
    { const u32x2 v = ((const u32x2*)(ws + WS_RAW))[i]; f32x4 o = {bf_lo(v.x), bf_hi(v.x), bf_lo(v.y), bf_hi(v.y)}; ((f32x4*)out)[i] = o; }
#elif MK_DUMP == 7
    { f32x4 o = {0.f,0.f,0.f,0.f}; if (i < (size_t)BINP * D / 4) { const u32x2 v = ((const u32x2*)(ws + WS_WBIN))[i]; o = (f32x4){bf_lo(v.x), bf_hi(v.x), bf_lo(v.y), bf_hi(v.y)}; } ((f32x4*)out)[i] = o; }
#elif MK_DUMP == 8
    { const u32x2 v = ((const u32x2*)(ws + WS_RAW))[i], w = ((const u32x2*)(ws + 458 * MB))[i]; f32x4 o = {bf_lo(v.x) - bf_lo(w.x), bf_hi(v.x) - bf_hi(w.x), bf_lo(v.y) - bf_lo(w.y), bf_hi(v.y) - bf_hi(w.y)}; ((f32x4*)out)[i] = o; }
#elif MK_DUMP == 9
    { const u32x2 v = ((const u32x2*)(ws + WS_RAW))[i], w = ((const u32x2*)(ws + 458 * MB))[i]; f32x4 o = {(v.x & 0xffffu) != (w.x & 0xffffu) ? 1.f : 0.f, (v.x >> 16) != (w.x >> 16) ? 1.f : 0.f, (v.y & 0xffffu) != (w.y & 0xffffu) ? 1.f : 0.f, (v.y >> 16) != (w.y >> 16) ? 1.f : 0.f}; ((f32x4*)out)[i] = o; }
#elif MK_DUMP == 4
    { const u32x2 v = ((const u32x2*)(ws + WS_Q))[i]; f32x4 o = {bf_lo(v.x), bf_hi(v.x), bf_lo(v.y), bf_hi(v.y)}; ((f32x4*)out)[i] = o; }
#endif
}
#endif
extern "C" void kernel_launch(void* const* d_in, const int* in_sizes, int n_in, void* d_out, int out_size, void* d_ws, size_t ws_size, hipStream_t stream) {
    static int grid = 0;
    if (grid == 0) {
        if (n_in != 23 || out_size != T * D || ws_size < WS_TOTAL) { fprintf(stderr, "kernel_launch: unexpected sizes n_in %d out %d ws %zu (need %zu)\n", n_in, out_size, ws_size, (size_t)WS_TOTAL); grid = -1; return; }
        int dev = 0, cus = 0, per_cu = 0;
        hipGetDevice(&dev); hipDeviceGetAttribute(&cus, hipDeviceAttributeMultiprocessorCount, dev);
        hipFuncSetAttribute((const void*)mk_fwd, hipFuncAttributeMaxDynamicSharedMemorySize, LDS_BYTES);
        hipOccupancyMaxActiveBlocksPerMultiprocessor(&per_cu, (const void*)mk_fwd, NTH, LDS_BYTES);
        (void)hipGetLastError();
        if (per_cu < 1) per_cu = 1;
        if (per_cu > 2) per_cu = 2;
        grid = cus * per_cu;
    }
    if (grid < 0) return;
    hipMemsetAsync((char*)d_ws + WS_CTL, 0, 16384, stream);
    Args a{};
    for (int i = 0; i < 23; ++i) a.in[i] = d_in[i];
    a.out = (float*)d_out; a.ws = (unsigned char*)d_ws;
#if MK_ONE_LAUNCH
    a.ph_lo = 0; a.ph_hi = NPHASE;
    hipLaunchKernelGGL(mk_fwd, dim3(grid), dim3(NTH), LDS_BYTES, stream, a);
#else
    for (int ph = 0; ph <= MK_LAST_PHASE; ++ph) { a.ph_lo = ph; a.ph_hi = ph + 1; hipLaunchKernelGGL(mk_fwd, dim3(grid), dim3(NTH), LDS_BYTES, stream, a); }
#ifdef MK_DUMP
    hipLaunchKernelGGL(dump_k, dim3(T * D / 4 / 256), dim3(256), 0, stream, (const unsigned char*)d_ws, (float*)d_out);
#endif
#endif
}
```

```cpp
#include <hip/hip_runtime.h>
#include <stdint.h>
#include <stdio.h>

#ifndef MK_LAST_PHASE
#define MK_LAST_PHASE 21
#endif
#ifndef MK_REP
#define MK_REP -1
#endif
#ifndef MK_XBAR
#define MK_XBAR 0
#endif
#ifndef MK_DRY
#define MK_DRY -1
#endif
#ifndef MK_ONE_LAUNCH
#define MK_ONE_LAUNCH 1
#endif

#define LAS __attribute__((address_space(3)))
typedef unsigned short bf16_t;
typedef short bf16x8 __attribute__((ext_vector_type(8)));
typedef float f32x4 __attribute__((ext_vector_type(4)));
typedef float f32x2 __attribute__((ext_vector_type(2)));
typedef float f32x16 __attribute__((ext_vector_type(16)));
typedef unsigned u32x4 __attribute__((ext_vector_type(4)));
typedef unsigned u32x2 __attribute__((ext_vector_type(2)));

constexpr int T = 16384, D = 1024, SEQ = 4096;
constexpr int GW = 2048;
constexpr int BIN = 2120, BINP = 2176;
constexpr int NE = 32, DE = 512;
constexpr int PLE = 256;
constexpr float EPS = 1e-6f;
constexpr int NTH = 256;
constexpr int LDS_MAIN = 4 * 19456;
constexpr int LDS_BYTES = LDS_MAIN + 1024;
constexpr int RPAD = 32768 + NE * 128;

constexpr size_t MB = 1024 * 1024;
constexpr size_t WS_CTL = 0;
constexpr size_t WS_CNT = 16384;
constexpr size_t WS_WR = 32768;
constexpr size_t WS_WAIN = 1 * MB;
constexpr size_t WS_WAOUT = WS_WAIN + 8 * MB;
constexpr size_t WS_WBIN = WS_WAOUT + 4 * MB;
constexpr size_t WS_WBOUT = WS_WBIN + 5 * MB;
constexpr size_t WS_WGATE = WS_WBOUT + 2 * MB;
constexpr size_t WS_WPROJ = WS_WGATE + 4 * MB;
constexpr size_t WS_W1 = WS_WPROJ + 1 * MB;
constexpr size_t WS_W3 = WS_W1 + 32 * MB;
constexpr size_t WS_W2 = WS_W3 + 32 * MB;
constexpr size_t WS_PBF = WS_W2 + 32 * MB;
constexpr size_t WS_XN = WS_PBF + 16 * MB;
constexpr size_t WS_H = WS_XN + 32 * MB;
constexpr size_t WS_LIST = WS_H + 64 * MB;
constexpr size_t WS_GATE = WS_LIST + 2 * MB;
constexpr size_t WS_TOKSLOT = WS_GATE + 2 * MB;
constexpr size_t WS_SCR = WS_TOKSLOT + 1 * MB;
constexpr size_t WS_U = WS_SCR;
constexpr size_t WS_VT = WS_SCR + 64 * MB;
constexpr size_t WS_VSS = WS_SCR + 128 * MB;
constexpr size_t WS_HMID = WS_SCR;
constexpr size_t WS_Y = WS_SCR + 36 * MB;
constexpr size_t WS_RAW = WS_SCR;
constexpr size_t WS_O = WS_SCR;
constexpr size_t WS_Q = WS_SCR + 68 * MB;
constexpr size_t WS_K = WS_Q + 32 * MB;
constexpr size_t WS_V = WS_K + 8 * MB;
constexpr size_t WS_QI = WS_V + 8 * MB;
constexpr size_t WS_KI = WS_QI + 16 * MB;
constexpr size_t WS_WI = WS_KI + 2 * MB;
constexpr size_t WS_SEL = WS_WI + 1 * MB;
constexpr size_t WS_END = WS_SEL + 16 * MB;
static_assert(WS_END <= WS_SCR + 152 * MB, "scratch");
constexpr size_t WS_S = 392 * MB;
constexpr size_t WS_TOTAL = 522 * MB;

typedef __bf16 bf16x2_t __attribute__((ext_vector_type(2)));
__device__ __forceinline__ unsigned pk_bf16(float lo, float hi) { f32x2 v = {lo, hi}; bf16x2_t b = __builtin_convertvector(v, bf16x2_t); return __builtin_bit_cast(unsigned, b); }
__device__ __forceinline__ float bf_lo(unsigned u) { return __uint_as_float(u << 16); }
__device__ __forceinline__ float bf_hi(unsigned u) { return __uint_as_float(u & 0xffff0000u); }
__device__ __forceinline__ float wave_sum(float v) {
#pragma unroll
    for (int o = 1; o < 64; o <<= 1) v += __shfl_xor(v, o);
    return v;
}
__device__ __forceinline__ int lds_inc(LAS int* p) { return __hip_atomic_fetch_add(p, 1, __ATOMIC_RELAXED, __HIP_MEMORY_SCOPE_WORKGROUP); }
#define LDS_WAIT() asm volatile("s_waitcnt lgkmcnt(0)" ::: "memory")
#define VM_WAIT() asm volatile("s_waitcnt vmcnt(0)" ::: "memory")

#define XB_TMO      128
#define XB_XCNT(j)  (256  + 64 * (j))
#define XB_XSUB(j)  (1280 + 64 * (j))
#define XB_XGEN(j)  (2304 + 64 * (j))
#define XB_TOP      3328
#define XB_TOPGEN   3392
#define XCD_BAR_WORDS 3456
#define XB_SPIN_CAP (1u << 20)
__device__ __forceinline__ unsigned xb_ld(unsigned* p)              { return __hip_atomic_load(p, __ATOMIC_RELAXED, __HIP_MEMORY_SCOPE_AGENT); }
__device__ __forceinline__ unsigned xb_add(unsigned* p, unsigned v) { return __hip_atomic_fetch_add(p, v, __ATOMIC_RELAXED, __HIP_MEMORY_SCOPE_AGENT); }
__device__ __forceinline__ unsigned xb_xcc_id() { return (unsigned)__builtin_amdgcn_s_getreg((3 << 11) | 20) & 0xFu; }
#define XB_SPIN(cond, bar) do { unsigned _sp = 0; while (cond) { __builtin_amdgcn_s_sleep(1); \
    if ((++_sp & 255u) == 0u) { if (xb_ld(&(bar)[XB_TMO])) break; if (_sp > XB_SPIN_CAP) { atomicAdd(&(bar)[XB_TMO], 1u); break; } } } } while (0)
struct XcdBarrier { unsigned* bar; unsigned x; volatile LAS unsigned* st; };
__device__ __forceinline__ XcdBarrier xcd_barrier_post(unsigned* bar, volatile LAS unsigned* st) {
    XcdBarrier b; b.bar = bar; b.x = xb_xcc_id(); b.st = st;
    if (threadIdx.x == 0) (void)xb_add(&bar[XB_XCNT(b.x)], 1u);
    return b;
}
__device__ __forceinline__ void xcd_barrier_complete(unsigned* bar, unsigned x, unsigned& nloc, unsigned& nx) {
    const unsigned G = gridDim.x;
    unsigned sum, cnt, mine, sp = 0u;
    for (;;) {
        sum = 0u; cnt = 0u; mine = 0u;
#pragma unroll
        for (unsigned j = 0; j < 16; ++j) { const unsigned c = xb_ld(&bar[XB_XCNT(j)]); sum += c; cnt += (c > 0u) ? 1u : 0u; mine = (j == x) ? c : mine; }
        if (sum == G) break;
        __builtin_amdgcn_s_sleep(1);
        if ((++sp & 255u) == 0u) { if (xb_ld(&bar[XB_TMO])) break; if (sp > XB_SPIN_CAP) { atomicAdd(&bar[XB_TMO], 1u); break; } }
    }
    nloc = mine > 0u ? mine : 1u; nx = cnt > 0u ? cnt : 1u;
}
__device__ __forceinline__ void xcd_barrier(const XcdBarrier& b) {
    asm volatile("s_waitcnt vmcnt(0)" ::: "memory");
    __syncthreads();
    if (threadIdx.x == 0) {
        unsigned* bar = b.bar;
        __builtin_amdgcn_s_waitcnt(0);
        unsigned nloc = b.st[0], nx = b.st[1];
        if (nloc == 0u) { xcd_barrier_complete(bar, b.x, nloc, nx); b.st[0] = nloc; b.st[1] = nx; }
        const unsigned old = xb_add(&bar[XB_XSUB(b.x)], 1u);
        const unsigned gen = old / nloc;
        if (old + 1u == (gen + 1u) * nloc) {
            __builtin_amdgcn_fence(__ATOMIC_RELEASE, "agent");
            asm volatile("s_waitcnt vmcnt(0)" ::: "memory");
            const unsigned og = xb_add(&bar[XB_TOP], 1u);
            const unsigned tg = og / nx;
            if (og + 1u == (tg + 1u) * nx) xb_add(&bar[XB_TOPGEN], 1u);
            else XB_SPIN(xb_ld(&bar[XB_TOPGEN]) == tg, bar);
            __builtin_amdgcn_fence(__ATOMIC_ACQUIRE, "agent");
            xb_add(&bar[XB_XGEN(b.x)], 1u);
            asm volatile("s_waitcnt vmcnt(0)" ::: "memory");
        } else {
            XB_SPIN(xb_ld(&bar[XB_XGEN(b.x)]) == gen, bar);
            __builtin_amdgcn_fence(__ATOMIC_ACQUIRE, "agent");
            asm volatile("s_waitcnt vmcnt(0)" ::: "memory");
        }
    }
    __syncthreads();
}

struct Args { const void* in[23]; float* out; unsigned char* ws; int ph_lo, ph_hi; };
enum { IN_X = 0, IN_P, IN_POS, IN_MIXN, IN_AWIN, IN_AVG, IN_AWS, IN_ABS, IN_AWOUT, IN_BWIN, IN_BWOUT, IN_FFNN, IN_WG, IN_BG, IN_WE, IN_BE,
       IN_W1, IN_W3, IN_W2, IN_PLEN, IN_PLEG, IN_PLEP, IN_FINN };

struct Ctx {
    LAS unsigned char* lds;
    int tid, lane, wave, vb, nb;
    const __attribute__((address_space(4))) Args* a;
    unsigned char* ws;
};

template <int BK> struct TileK { static constexpr int NP = (BK == 64) ? 4 : 2; static constexpr int TB = 128 * BK * 2; };

template <int BK>
__device__ __forceinline__ void stage_tile(LAS unsigned char* tile, const bf16_t* const (&rp)[TileK<BK>::NP], int k0, int tid) {
    const int lc = (BK == 64) ? ((tid & 7) ^ ((tid >> 3) & 7)) : ((tid & 3) ^ ((tid >> 3) & 3));
#pragma unroll
    for (int p = 0; p < TileK<BK>::NP; ++p)
        __builtin_amdgcn_global_load_lds((const unsigned*)(rp[p] + k0 + lc * 8), (LAS unsigned*)(tile + p * 4096 + tid * 16), 16, 0, 0);
}
template <int BK>
__device__ __forceinline__ void rows_regular(const bf16_t* (&rp)[TileK<BK>::NP], const bf16_t* base, size_t ld, int tid) {
#pragma unroll
    for (int p = 0; p < TileK<BK>::NP; ++p) { const int r = (BK == 64) ? (p * 32 + (tid >> 3)) : (p * 64 + (tid >> 2)); rp[p] = base + (size_t)r * ld; }
}
template <int BK>
__device__ __forceinline__ int frag_off(int row, int ks, int fq) {
    return (BK == 64) ? (row * 128 + (((ks * 4 + fq) ^ (row & 7)) << 4)) : (row * 64 + ((fq ^ ((row >> 1) & 3)) << 4));
}

template <int BK, int NBOP, bool SWAP>
__device__ __forceinline__ void gemm_loop(const Ctx& c, const bf16_t* const (&ap)[TileK<BK>::NP], const bf16_t* const (&b0p)[TileK<BK>::NP], const bf16_t* const (&b1p)[TileK<BK>::NP],
                                          int K, f32x4 (&acc0)[4][4], f32x4 (&acc1)[4][4]) {
    constexpr int TB = TileK<BK>::TB, SB = (1 + NBOP) * TB;
    static_assert(2 * SB <= LDS_MAIN, "lds");
    const int nk = K / BK, tid = c.tid;
    const int fr = c.lane & 15, fq = c.lane >> 4, wr = c.wave >> 1, wc = c.wave & 1;
    LAS unsigned char* lds = c.lds;
    stage_tile<BK>(lds, ap, 0, tid); stage_tile<BK>(lds + TB, b0p, 0, tid);
    if (NBOP == 2) stage_tile<BK>(lds + 2 * TB, b1p, 0, tid);
    for (int kt = 0; kt < nk; ++kt) {
        VM_WAIT();
        __syncthreads();
        LAS unsigned char* cur = lds + (kt & 1) * SB;
        if (kt + 1 < nk) {
            LAS unsigned char* nxt = lds + ((kt + 1) & 1) * SB;
            stage_tile<BK>(nxt, ap, (kt + 1) * BK, tid); stage_tile<BK>(nxt + TB, b0p, (kt + 1) * BK, tid);
            if (NBOP == 2) stage_tile<BK>(nxt + 2 * TB, b1p, (kt + 1) * BK, tid);
        }
#pragma unroll
        for (int ks = 0; ks < BK / 32; ++ks) {
            bf16x8 af[4], bf0[4], bf1[4];
#pragma unroll
            for (int m = 0; m < 4; ++m) af[m] = *(const LAS bf16x8*)(cur + frag_off<BK>(wr * 64 + m * 16 + fr, ks, fq));
#pragma unroll
            for (int n = 0; n < 4; ++n) bf0[n] = *(const LAS bf16x8*)(cur + TB + frag_off<BK>(wc * 64 + n * 16 + fr, ks, fq));
            if (NBOP == 2) {
#pragma unroll
                for (int n = 0; n < 4; ++n) bf1[n] = *(const LAS bf16x8*)(cur + 2 * TB + frag_off<BK>(wc * 64 + n * 16 + fr, ks, fq));
            }
#pragma unroll
            for (int m = 0; m < 4; ++m)
#pragma unroll
                for (int n = 0; n < 4; ++n) {
                    if (SWAP) acc0[m][n] = __builtin_amdgcn_mfma_f32_16x16x32_bf16(bf0[n], af[m], acc0[m][n], 0, 0, 0);
                    else      acc0[m][n] = __builtin_amdgcn_mfma_f32_16x16x32_bf16(af[m], bf0[n], acc0[m][n], 0, 0, 0);
                    if (NBOP == 2) {
                        if (SWAP) acc1[m][n] = __builtin_amdgcn_mfma_f32_16x16x32_bf16(bf1[n], af[m], acc1[m][n], 0, 0, 0);
                        else      acc1[m][n] = __builtin_amdgcn_mfma_f32_16x16x32_bf16(af[m], bf1[n], acc1[m][n], 0, 0, 0);
                    }
                }
        }
    }
    __syncthreads();
}
__device__ __forceinline__ void zero_acc(f32x4 (&acc)[4][4]) {
#pragma unroll
    for (int m = 0; m < 4; ++m)
#pragma unroll
        for (int n = 0; n < 4; ++n) acc[m][n] = (f32x4){0.f, 0.f, 0.f, 0.f};
}
__device__ __forceinline__ void map_unit(int u, int nnt, int& mt, int& nt) { const int per = 8 * nnt, band = u / per, r = u - band * per; nt = r >> 3; mt = band * 8 + (r & 7); }


__device__ __forceinline__ float gelu_tanh(float x) {
    const float y2 = 1.5957691216057308f * (x + 0.044715f * x * x * x);
    return x / (1.f + __expf(-y2));
}
__device__ __forceinline__ float sigmoidf_(float x) { return 1.f / (1.f + __expf(-x)); }

__device__ __forceinline__ void row_load(const float* row, int lane, f32x4 (&v)[4]) {
#pragma unroll
    for (int j = 0; j < 4; ++j) v[j] = ((const f32x4*)row)[lane + 64 * j];
}
__device__ __forceinline__ float row_sumsq(const f32x4 (&v)[4]) {
    float s = 0.f;
#pragma unroll
    for (int j = 0; j < 4; ++j) s += (v[j].x * v[j].x + v[j].y * v[j].y) + (v[j].z * v[j].z + v[j].w * v[j].w);
    return wave_sum(s);
}
__device__ __forceinline__ void gain_load(const float* gain, int lane, f32x4 (&g)[4]) {
#pragma unroll
    for (int j = 0; j < 4; ++j) g[j] = ((const f32x4*)gain)[lane + 64 * j];
}
__device__ __forceinline__ void row_store_norm_bf16(bf16_t* orow, int lane, const f32x4 (&v)[4], float r, const f32x4 (&gv)[4]) {
#pragma unroll
    for (int j = 0; j < 4; ++j) {
        const f32x4 g = gv[j];
        u32x2 o; o.x = pk_bf16(v[j].x * r * g.x, v[j].y * r * g.y); o.y = pk_bf16(v[j].z * r * g.z, v[j].w * r * g.w);
        ((u32x2*)orow)[lane + 64 * j] = o;
    }
}

constexpr int TR_SCR = 64 * 136;
__device__ __forceinline__ void transpose_item(const float* W, int K, int N, int nvalid, int ldw, bf16_t* WT, LAS unsigned char* scr, int item, int lane) {
    const int nblk = N / 64, kb = item / nblk, nb = item - kb * nblk, k0 = 64 * kb, n0 = 64 * nb;
    const int n = n0 + 4 * (lane & 15);
    const int nc_ = (n < nvalid) ? n : 0; const float keep = (n < nvalid) ? 1.f : 0.f;
    f32x4 v[16];
#pragma unroll
    for (int i = 0; i < 16; ++i) v[i] = *(const f32x4*)(W + (size_t)(k0 + 4 * i + (lane >> 4)) * ldw + nc_);
#pragma unroll
    for (int i = 0; i < 16; ++i) {
        const int kk = 4 * i + (lane >> 4);
        u32x2 o; o.x = pk_bf16(v[i].x * keep, v[i].y * keep); o.y = pk_bf16(v[i].z * keep, v[i].w * keep);
        *(LAS u32x2*)(scr + kk * 136 + (lane & 15) * 8) = o;
    }
    LDS_WAIT();
    const int cc = lane & 7;
#pragma unroll
    for (int j = 0; j < 8; ++j) {
        const int nn = (lane >> 3) + 8 * j; const LAS unsigned short* sp = (const LAS unsigned short*)(scr + (8 * cc) * 136 + nn * 2);
        u32x4 o;
        o.x = (unsigned)sp[0 * 68] | ((unsigned)sp[1 * 68] << 16); o.y = (unsigned)sp[2 * 68] | ((unsigned)sp[3 * 68] << 16);
        o.z = (unsigned)sp[4 * 68] | ((unsigned)sp[5 * 68] << 16); o.w = (unsigned)sp[6 * 68] | ((unsigned)sp[7 * 68] << 16);
        *(u32x4*)(WT + (size_t)(n0 + nn) * K + k0 + 8 * cc) = o;
    }
    LDS_WAIT();
}
__device__ __forceinline__ void convert_moe_layer(const Ctx& c, int l) {
    LAS unsigned char* scr = c.lds + c.wave * TR_SCR;
    const int gw = c.vb * 4 + c.wave, ngw = c.nb * 4;
    const float* w1 = (const float*)c.a->in[IN_W1] + (size_t)l * NE * D * DE;
    const float* w3 = (const float*)c.a->in[IN_W3] + (size_t)l * NE * D * DE;
    const float* w2 = (const float*)c.a->in[IN_W2] + (size_t)l * NE * DE * D;
    bf16_t* W1 = (bf16_t*)(c.ws + WS_W1); bf16_t* W3 = (bf16_t*)(c.ws + WS_W3); bf16_t* W2 = (bf16_t*)(c.ws + WS_W2);
    for (int it = gw; it < NE * 384; it += ngw) {
        const int e = it / 384, r = it - e * 384;
        if (r < 128)      transpose_item(w1 + (size_t)e * D * DE, D, DE, DE, DE, W1 + (size_t)e * DE * D, scr, r, c.lane);
        else if (r < 256) transpose_item(w3 + (size_t)e * D * DE, D, DE, DE, DE, W3 + (size_t)e * DE * D, scr, r - 128, c.lane);
        else              transpose_item(w2 + (size_t)e * DE * D, DE, D, D, D, W2 + (size_t)e * D * DE, scr, r - 256, c.lane);
    }
}

__device__ __forceinline__ void phase_prep(const Ctx& c) {
    const __attribute__((address_space(4))) Args& a = *c.a;
    LAS unsigned char* scr = c.lds + c.wave * TR_SCR;
    const int gw = c.vb * 4 + c.wave, ngw = c.nb * 4;
    constexpr int I_AIN = 16 * 64, I_AOUT = 32 * 16, I_BIN = 16 * 34, I_BOUT = 16 * 16, I_PG = 16 * 16, I_PP = 4 * 16;
    constexpr int NIT = I_AIN + I_AOUT + I_BIN + I_BOUT + 2 * I_PG + 2 * I_PP;
    for (int it = gw; it < NIT; it += ngw) {
        int r = it;
        if (r < I_AIN) { transpose_item((const float*)a.in[IN_AWIN], D, 4096, 4096, 4096, (bf16_t*)(c.ws + WS_WAIN), scr, r, c.lane); continue; } r -= I_AIN;
        if (r < I_AOUT) { transpose_item((const float*)a.in[IN_AWOUT], GW, D, D, D, (bf16_t*)(c.ws + WS_WAOUT), scr, r, c.lane); continue; } r -= I_AOUT;
        if (r < I_BIN) { transpose_item((const float*)a.in[IN_BWIN], D, BINP, BIN, BIN, (bf16_t*)(c.ws + WS_WBIN), scr, r, c.lane); continue; } r -= I_BIN;
        if (r < I_BOUT) { transpose_item((const float*)a.in[IN_BWOUT], D, D, D, D, (bf16_t*)(c.ws + WS_WBOUT), scr, r, c.lane); continue; } r -= I_BOUT;
        if (r < 2 * I_PG) { const int l = r / I_PG; transpose_item((const float*)a.in[IN_PLEG] + (size_t)l * D * D, D, D, D, D, (bf16_t*)(c.ws + WS_WGATE) + (size_t)l * D * D, scr, r - l * I_PG, c.lane); continue; } r -= 2 * I_PG;
        { const int l = r / I_PP; transpose_item((const float*)a.in[IN_PLEP] + (size_t)l * PLE * D, PLE, D, D, D, (bf16_t*)(c.ws + WS_WPROJ) + (size_t)l * D * PLE, scr, r - l * I_PP, c.lane); }
    }
    convert_moe_layer(c, 0);
    const int gt = c.vb * NTH + c.tid, ngt = c.nb * NTH;
    { const float* p = (const float*)a.in[IN_P]; bf16_t* pb = (bf16_t*)(c.ws + WS_PBF);
      for (int i = gt; i < 2 * T * PLE / 8; i += ngt) {
          const f32x4 v0 = ((const f32x4*)p)[2 * i], v1 = ((const f32x4*)p)[2 * i + 1];
          u32x4 o; o.x = pk_bf16(v0.x, v0.y); o.y = pk_bf16(v0.z, v0.w); o.z = pk_bf16(v1.x, v1.y); o.w = pk_bf16(v1.z, v1.w);
          ((u32x4*)pb)[i] = o; } }
    { float* wr = (float*)(c.ws + WS_WR);
      for (int i = gt; i < 2 * D * 48; i += ngt) {
          const int l = i / (D * 48), r = i - l * D * 48, k = r / 48, o = r - k * 48;
          float w = 0.f;
          if (o < 4) w = ((const float*)a.in[IN_WG])[(size_t)l * D * 4 + k * 4 + o];
          else if (o < 36) w = ((const float*)a.in[IN_WE])[(size_t)l * D * 32 + k * 32 + (o - 4)];
          wr[i] = w * ((const float*)a.in[IN_FFNN])[l * D + k]; } }
    if (c.vb == 0 && c.tid < 128) ((int*)(c.ws + WS_CNT))[c.tid] = 0;
    f32x4 gv[4]; gain_load((const float*)a.in[IN_MIXN], c.lane, gv);
    for (int t = gw; t < T; t += ngw) {
        f32x4 v[4]; row_load((const float*)a.in[IN_X] + (size_t)t * D, c.lane, v);
        const float r = rsqrtf(row_sumsq(v) * (1.f / D) + EPS);
        row_store_norm_bf16((bf16_t*)(c.ws + WS_XN) + (size_t)t * D, c.lane, v, r, gv);
    }
}

__device__ __forceinline__ void phase_a1(const Ctx& c) {
    const bf16_t* XN = (const bf16_t*)(c.ws + WS_XN); const bf16_t* W = (const bf16_t*)(c.ws + WS_WAIN);
    bf16_t* U = (bf16_t*)(c.ws + WS_U); bf16_t* VT = (bf16_t*)(c.ws + WS_VT); float* VSS = (float*)(c.ws + WS_VSS);
    const int fr = c.lane & 15, fq = c.lane >> 4, wr = c.wave >> 1, wc = c.wave & 1;
    for (int u = c.vb; u < 128 * 32; u += c.nb) {
        int mt, nt; map_unit(u, 32, mt, nt);
        const bf16_t* ap[4]; const bf16_t* bp[4];
        rows_regular<64>(ap, XN + (size_t)mt * 128 * D, D, c.tid); rows_regular<64>(bp, W + (size_t)nt * 128 * D, D, c.tid);
        f32x4 acc[4][4]; zero_acc(acc);
        if (nt < 16) {
            gemm_loop<64, 1, true>(c, ap, bp, bp, D, acc, acc);
#pragma unroll
            for (int m = 0; m < 4; ++m)
#pragma unroll
                for (int n = 0; n < 4; ++n) {
                    const int t = mt * 128 + wr * 64 + m * 16 + fr, col = nt * 128 + wc * 64 + n * 16 + fq * 4;
                    const f32x4 v = acc[m][n];
                    u32x2 o; o.x = pk_bf16(gelu_tanh(v.x), gelu_tanh(v.y)); o.y = pk_bf16(gelu_tanh(v.z), gelu_tanh(v.w));
                    *(u32x2*)(U + (size_t)t * GW + col) = o;
                }
        } else {
            gemm_loop<64, 1, false>(c, ap, bp, bp, D, acc, acc);
            const int vn = nt - 16;
#pragma unroll
            for (int m = 0; m < 4; ++m) {
                f32x4 ss = {0.f, 0.f, 0.f, 0.f};
                const int t0 = mt * 128 + wr * 64 + m * 16 + fq * 4;
#pragma unroll
                for (int n = 0; n < 4; ++n) {
                    const int ch = vn * 128 + wc * 64 + n * 16 + fr;
                    f32x4 v = acc[m][n];
                    v.x = gelu_tanh(v.x); v.y = gelu_tanh(v.y); v.z = gelu_tanh(v.z); v.w = gelu_tanh(v.w);
                    ss += v * v;
                    u32x2 o; o.x = pk_bf16(v.x, v.y); o.y = pk_bf16(v.z, v.w);
                    *(u32x2*)(VT + (size_t)ch * T + t0) = o;
                }
#pragma unroll
                for (int o = 1; o < 16; o <<= 1) { ss.x += __shfl_xor(ss.x, o); ss.y += __shfl_xor(ss.y, o); ss.z += __shfl_xor(ss.z, o); ss.w += __shfl_xor(ss.w, o); }
                if (fr == 0) {
                    VSS[(size_t)(t0 + 0) * 32 + vn * 2 + wc] = ss.x; VSS[(size_t)(t0 + 1) * 32 + vn * 2 + wc] = ss.y;
                    VSS[(size_t)(t0 + 2) * 32 + vn * 2 + wc] = ss.z; VSS[(size_t)(t0 + 3) * 32 + vn * 2 + wc] = ss.w;
                }
            }
        }
    }
}

__device__ __forceinline__ void phase_a2(const Ctx& c, bool dry = false) {
    const __attribute__((address_space(4))) Args& a = *c.a;
    bf16_t* U = (bf16_t*)(c.ws + WS_U); const bf16_t* VT = (const bf16_t*)(c.ws + WS_VT); const float* VSS = (const float*)(c.ws + WS_VSS);
    const float* ws_ = (const float*)a.in[IN_AWS]; const float* bs_ = (const float*)a.in[IN_ABS]; const float* vg = (const float*)a.in[IN_AVG];
    const int fr = c.lane & 15, fq = c.lane >> 4, wr = c.wave >> 1, wc = c.wave & 1, tid = c.tid;
    LAS unsigned char* lds = c.lds;
    LAS float* rl = (LAS float*)(lds + LDS_MAIN);
    for (int u = c.vb; u < 128 * 8; u += c.nb) {
        const int ci = u >> 3, g = u & 7, tokbase = ci * 128;
        __syncthreads();
        if (tid < 128) {
            const float* p = VSS + (size_t)(tokbase + tid) * 32; float s = 0.f;
#pragma unroll
            for (int i = 0; i < 8; ++i) { const f32x4 q = ((const f32x4*)p)[i]; s += (q.x + q.y) + (q.z + q.w); }
            rl[tid] = rsqrtf(s * (1.f / GW) + EPS);
        }
        __syncthreads();
        {
            const int t = tid >> 1, half = tid & 1;
            const float* wrow = ws_ + ((size_t)g * 128 + t) * 128 + half * 64;
#pragma unroll
            for (int cc = 0; cc < 8; ++cc) {
                const int s0 = half * 64 + cc * 8;
                u32x4 o;
                {
                    const f32x4 w0 = ((const f32x4*)wrow)[2 * cc], w1 = ((const f32x4*)wrow)[2 * cc + 1];
                    float e[8] = {w0.x, w0.y, w0.z, w0.w, w1.x, w1.y, w1.z, w1.w};
#pragma unroll
                    for (int i = 0; i < 8; ++i) e[i] = (s0 + i <= t) ? e[i] * rl[s0 + i] : 0.f;
                    o.x = pk_bf16(e[0], e[1]); o.y = pk_bf16(e[2], e[3]); o.z = pk_bf16(e[4], e[5]); o.w = pk_bf16(e[6], e[7]);
                }
                *(LAS u32x4*)(lds + half * 16384 + t * 128 + ((cc ^ (t & 7)) << 4)) = o;
            }
        }
        for (int hn = 0; hn < 2; ++hn) {
            const int c0 = g * 256 + hn * 128;
            const bf16_t* bp[4]; rows_regular<64>(bp, VT + (size_t)c0 * T + tokbase, T, tid);
            stage_tile<64>(lds + 32768, bp, 0, tid); stage_tile<64>(lds + 32768 + 16384, bp, 64, tid);
            VM_WAIT();
            __syncthreads();
            f32x4 acc[4][4]; zero_acc(acc);
#pragma unroll 1
            for (int kh = 0; kh < 2; ++kh)
#pragma unroll 1
                for (int ks = 0; ks < 2; ++ks) {
                    bf16x8 af[4], bf[4];
#pragma unroll
                    for (int m = 0; m < 4; ++m) af[m] = *(const LAS bf16x8*)(lds + kh * 16384 + frag_off<64>(wr * 64 + m * 16 + fr, ks, fq));
#pragma unroll
                    for (int n = 0; n < 4; ++n) bf[n] = *(const LAS bf16x8*)(lds + 32768 + kh * 16384 + frag_off<64>(wc * 64 + n * 16 + fr, ks, fq));
#pragma unroll
                    for (int m = 0; m < 4; ++m)
#pragma unroll
                        for (int n = 0; n < 4; ++n) acc[m][n] = __builtin_amdgcn_mfma_f32_16x16x32_bf16(bf[n], af[m], acc[m][n], 0, 0, 0);
                }
            u32x2 uvv[4][4]; float bsvv[4];
#pragma unroll
            for (int m = 0; m < 4; ++m) { const int tl = wr * 64 + m * 16 + fr; bsvv[m] = bs_[g * 128 + tl];
#pragma unroll
                for (int n = 0; n < 4; ++n) uvv[m][n] = *(const u32x2*)(U + (size_t)(tokbase + tl) * GW + c0 + wc * 64 + n * 16 + fq * 4); }
#pragma unroll
            for (int m = 0; m < 4; ++m) {
                const int tl = wr * 64 + m * 16 + fr; const float bsv = bsvv[m];
#pragma unroll
                for (int n = 0; n < 4; ++n) {
                    const int ch = c0 + wc * 64 + n * 16 + fq * 4;
                    const f32x4 gn = *(const f32x4*)(vg + ch);
                    u32x2* up = (u32x2*)(U + (size_t)(tokbase + tl) * GW + ch);
                    const u32x2 uv = uvv[m][n]; const f32x4 v = acc[m][n];
                    u32x2 o;
                    o.x = pk_bf16(bf_lo(uv.x) * (gn.x * v.x + bsv), bf_hi(uv.x) * (gn.y * v.y + bsv));
                    o.y = pk_bf16(bf_lo(uv.y) * (gn.z * v.z + bsv), bf_hi(uv.y) * (gn.w * v.w + bsv));
                    if (dry) *(u32x2*)(c.ws + 440 * MB + ((size_t)(tokbase + tl) * GW + ch) * 2) = o; else *up = o;
                }
            }
            __syncthreads();
        }
    }
}

__device__ __forceinline__ void phase_a3(const Ctx& c) {
    const bf16_t* Z = (const bf16_t*)(c.ws + WS_U); const bf16_t* W = (const bf16_t*)(c.ws + WS_WAOUT);
    const float* X = (const float*)c.a->in[IN_X]; float* H = (float*)(c.ws + WS_H);
    const int fr = c.lane & 15, fq = c.lane >> 4, wr = c.wave >> 1, wc = c.wave & 1;
    for (int u = c.vb; u < 128 * 8; u += c.nb) {
        int mt, nt; map_unit(u, 8, mt, nt);
        const bf16_t* ap[4]; const bf16_t* bp[4];
        rows_regular<64>(ap, Z + (size_t)mt * 128 * GW, GW, c.tid); rows_regular<64>(bp, W + (size_t)nt * 128 * GW, GW, c.tid);
        f32x4 acc[4][4];
#pragma unroll
        for (int m = 0; m < 4; ++m)
#pragma unroll
            for (int n = 0; n < 4; ++n) acc[m][n] = *(const f32x4*)(X + (size_t)(mt * 128 + wr * 64 + m * 16 + fr) * D + nt * 128 + wc * 64 + n * 16 + fq * 4);
        gemm_loop<64, 1, true>(c, ap, bp, bp, GW, acc, acc);
#pragma unroll
        for (int m = 0; m < 4; ++m)
#pragma unroll
            for (int n = 0; n < 4; ++n) *(f32x4*)(H + (size_t)(mt * 128 + wr * 64 + m * 16 + fr) * D + nt * 128 + wc * 64 + n * 16 + fq * 4) = acc[m][n];
    }
}

__device__ __forceinline__ void phase_route(const Ctx& c, int l, bool dry = false) {
    const __attribute__((address_space(4))) Args& a = *c.a;
    const float* H = (const float*)(c.ws + WS_H); bf16_t* XN = (bf16_t*)(c.ws + (dry ? 440 * MB : WS_XN));
    const float* wr_ = (const float*)(c.ws + WS_WR) + (size_t)l * D * 48;
    const float* gain = (const float*)a.in[IN_FFNN] + l * D;
    int* cnt = (int*)(c.ws + WS_CNT) + l * 32 + (dry ? 64 : 0); int* list = (int*)(c.ws + (dry ? 480 * MB : WS_LIST)); float* gatel = (float*)(c.ws + (dry ? 484 * MB : WS_GATE)); int* tokslot = (int*)(c.ws + (dry ? 488 * MB : WS_TOKSLOT));
    LAS float* rl = (LAS float*)(c.lds);
    LAS float* lgl = (LAS float*)(c.lds + 256);
    const int lane = c.lane, w = c.wave;
    f32x4 gv[4]; gain_load(gain, lane, gv);
    for (int unit = c.vb; unit < T / 32; unit += c.nb) {
        const int tok0 = unit * 32;
        __syncthreads();
        for (int i = 0; i < 8; ++i) {
            const int t = tok0 + w * 8 + i;
            f32x4 v[4]; row_load(H + (size_t)t * D, lane, v);
            const float r = rsqrtf(row_sumsq(v) * (1.f / D) + EPS);
            if (lane == 0) rl[w * 8 + i] = r;
            row_store_norm_bf16(XN + (size_t)t * D, lane, v, r, gv);
        }
        {
            const int th = w & 1, kh = w >> 1, m = lane & 15, q = lane >> 4;
            const float* arow = H + (size_t)(tok0 + 16 * th + m) * D + 512 * kh + 128 * q;
            const float* brow = wr_ + (size_t)(512 * kh + 128 * q) * 48 + m;
            f32x4 acc[3]; acc[0] = acc[1] = acc[2] = (f32x4){0.f, 0.f, 0.f, 0.f};
            for (int i = 0; i < 32; ++i) {
                const f32x4 av = ((const f32x4*)arow)[i];
                const float ae[4] = {av.x, av.y, av.z, av.w};
#pragma unroll
                for (int e = 0; e < 4; ++e) {
                    const float* bp = brow + (size_t)(4 * i + e) * 48;
#pragma unroll
                    for (int nt = 0; nt < 3; ++nt) acc[nt] = __builtin_amdgcn_mfma_f32_16x16x4f32(ae[e], bp[nt * 16], acc[nt], 0, 0, 0);
                }
            }
#pragma unroll
            for (int nt = 0; nt < 3; ++nt)
#pragma unroll
                for (int j = 0; j < 4; ++j) lgl[(kh * 32 + th * 16 + 4 * q + j) * 48 + nt * 16 + m] = acc[nt][j];
        }
        __syncthreads();
        if (c.tid < 32) {
            const int tt = c.tid, t = tok0 + tt; const float r = rl[tt];
            const float* bg = (const float*)a.in[IN_BG] + l * 4; const float* be = (const float*)a.in[IN_BE] + l * 32;
            float gl[4];
#pragma unroll
            for (int o = 0; o < 4; ++o) gl[o] = (lgl[tt * 48 + o] + lgl[(32 + tt) * 48 + o]) * r + bg[o];
            int gs = 0; float gm = gl[0];
#pragma unroll
            for (int o = 1; o < 4; ++o) if (gl[o] > gm) { gm = gl[o]; gs = o; }
            float gden = 0.f;
#pragma unroll
            for (int o = 0; o < 4; ++o) gden += __expf(gl[o] - gm);
            const float pg = 1.f / gden;
            float l1 = -INFINITY, l2 = -INFINITY; int i1 = 0, i2 = 0;
            for (int i = 0; i < 8; ++i) {
                const int o = 4 + gs * 8 + i;
                const float v = (lgl[tt * 48 + o] + lgl[(32 + tt) * 48 + o]) * r + be[gs * 8 + i];
                if (v > l1) { l2 = l1; i2 = i1; l1 = v; i1 = i; } else if (v > l2) { l2 = v; i2 = i; }
            }
            const float e2 = __expf(l2 - l1), inv = 1.f / (1.f + e2);
            const float g1 = pg * inv, g2 = pg * e2 * inv;
            const int ea = gs * 8 + i1, eb = gs * 8 + i2;
            const int sa = atomicAdd(&cnt[ea], 1), sb = atomicAdd(&cnt[eb], 1);
            list[ea * T + sa] = t; gatel[ea * T + sa] = g1; tokslot[2 * t] = (ea << 16) | sa;
            list[eb * T + sb] = t; gatel[eb * T + sb] = g2; tokslot[2 * t + 1] = (eb << 16) | sb;
        }
    }
}

__device__ __forceinline__ void moe_table(const Ctx& c, int l, LAS int* pst, LAS int* cn) {
    __syncthreads();
    if (c.tid == 0) {
        const int* cnt = (const int*)(c.ws + WS_CNT) + l * 32; int acc = 0;
        for (int e = 0; e < 32; ++e) { const int n = cnt[e]; cn[e] = n; pst[e] = acc; acc += (n + 127) >> 7; }
        pst[32] = acc;
    }
    __syncthreads();
}
__device__ __forceinline__ int moe_find(LAS const int* pst, int mb) { int e = 0; for (int i = 1; i < 32; ++i) e = (pst[i] <= mb) ? i : e; return e; }

__device__ __forceinline__ void phase_e1(const Ctx& c, int l) {
    const bf16_t* XN = (const bf16_t*)(c.ws + WS_XN); const bf16_t* W1 = (const bf16_t*)(c.ws + WS_W1); const bf16_t* W3 = (const bf16_t*)(c.ws + WS_W3);
    bf16_t* HM = (bf16_t*)(c.ws + WS_HMID); const int* list = (const int*)(c.ws + WS_LIST);
    LAS int* pst = (LAS int*)(c.lds + LDS_MAIN); LAS int* cn = pst + 40;
    moe_table(c, l, pst, cn);
    const int fr = c.lane & 15, fq = c.lane >> 4, wr = c.wave >> 1, wc = c.wave & 1, tid = c.tid;
    const int nunits = pst[32] * 8;
    for (int u = c.vb; u < nunits; u += c.nb) {
        const int mb = u >> 3, h0 = (u & 7) * 64, e = moe_find(pst, mb), row0 = (mb - pst[e]) * 128, count = cn[e];
        const bf16_t* ap[4]; const bf16_t* bp[4];
#pragma unroll
        for (int p = 0; p < 4; ++p) {
            int r = row0 + p * 32 + (tid >> 3); r = r < count ? r : row0; ap[p] = XN + (size_t)list[e * T + r] * D;
            const int rb = p * 32 + (tid >> 3), hid = h0 + (rb >> 6) * 32 + ((rb >> 4) & 1) * 16 + (rb & 15);
            bp[p] = (((rb >> 5) & 1) ? W3 : W1) + ((size_t)e * DE + hid) * D;
        }
        f32x4 acc[4][4]; zero_acc(acc);
        gemm_loop<64, 1, true>(c, ap, bp, bp, D, acc, acc);
#pragma unroll
        for (int m = 0; m < 4; ++m)
#pragma unroll
            for (int n = 0; n < 2; ++n) {
                const size_t row = (size_t)mb * 128 + wr * 64 + m * 16 + fr; const int col = h0 + wc * 32 + n * 16 + fq * 4;
                const f32x4 x = acc[m][n], y = acc[m][n + 2];
                u32x2 o; o.x = pk_bf16(x.x * sigmoidf_(x.x) * y.x, x.y * sigmoidf_(x.y) * y.y); o.y = pk_bf16(x.z * sigmoidf_(x.z) * y.z, x.w * sigmoidf_(x.w) * y.w);
                *(u32x2*)(HM + row * DE + col) = o;
            }
    }
}
__device__ __forceinline__ void phase_e2(const Ctx& c, int l) {
    const bf16_t* HM = (const bf16_t*)(c.ws + WS_HMID); const bf16_t* W2 = (const bf16_t*)(c.ws + WS_W2);
    bf16_t* Y = (bf16_t*)(c.ws + WS_Y); const float* gatel = (const float*)(c.ws + WS_GATE);
    LAS int* pst = (LAS int*)(c.lds + LDS_MAIN); LAS int* cn = pst + 40;
    moe_table(c, l, pst, cn);
    const int fr = c.lane & 15, fq = c.lane >> 4, wr = c.wave >> 1, wc = c.wave & 1, tid = c.tid;
    const int nunits = pst[32] * 8;
    for (int u = c.vb; u < nunits; u += c.nb) {
        const int mb = u >> 3, nt = u & 7, e = moe_find(pst, mb), row0 = (mb - pst[e]) * 128, count = cn[e];
        const bf16_t* ap[4]; const bf16_t* bp[4];
        rows_regular<64>(ap, HM + (size_t)mb * 128 * DE, DE, tid); rows_regular<64>(bp, W2 + ((size_t)e * D + nt * 128) * DE, DE, tid);
        f32x4 acc[4][4]; zero_acc(acc);
        gemm_loop<64, 1, true>(c, ap, bp, bp, DE, acc, acc);
        float gtv[4];
#pragma unroll
        for (int m = 0; m < 4; ++m) { const int rl_ = wr * 64 + m * 16 + fr; gtv[m] = (row0 + rl_ < count) ? gatel[e * T + row0 + rl_] : 0.f; }
#pragma unroll
        for (int m = 0; m < 4; ++m) {
            const int rl_ = wr * 64 + m * 16 + fr; const float gt = gtv[m];
#pragma unroll
            for (int n = 0; n < 4; ++n) {
                const f32x4 v = acc[m][n] * gt;
                u32x2 o; o.x = pk_bf16(v.x, v.y); o.y = pk_bf16(v.z, v.w);
                *(u32x2*)(Y + ((size_t)mb * 128 + rl_) * D + nt * 128 + wc * 64 + n * 16 + fq * 4) = o;
            }
        }
    }
}
__device__ __forceinline__ void phase_p1(const Ctx& c, int l, bool dry = false) {
    float* H = (float*)(c.ws + WS_H); float* HO = (float*)(c.ws + (dry ? 440 * MB : WS_H)); bf16_t* XN = (bf16_t*)(c.ws + (dry ? 440 * MB : WS_XN)); const bf16_t* Y = (const bf16_t*)(c.ws + WS_Y);
    const int* tokslot = (const int*)(c.ws + WS_TOKSLOT); const float* gain = (const float*)c.a->in[IN_PLEN] + l * D;
    LAS int* pst = (LAS int*)(c.lds + LDS_MAIN); LAS int* cn = pst + 40;
    moe_table(c, l, pst, cn);
    const int gw = c.vb * 4 + c.wave, ngw = c.nb * 4, lane = c.lane;
    f32x4 gv[4]; gain_load(gain, lane, gv);
    for (int t = gw; t < T; t += ngw) {
        const int s0 = tokslot[2 * t], s1 = tokslot[2 * t + 1];
        const bf16_t* y0 = Y + ((size_t)pst[s0 >> 16] * 128 + (s0 & 0xffff)) * D; const bf16_t* y1 = Y + ((size_t)pst[s1 >> 16] * 128 + (s1 & 0xffff)) * D;
        f32x4 v[4]; row_load(H + (size_t)t * D, lane, v);
#pragma unroll
        for (int j = 0; j < 4; ++j) {
            const u32x2 a0 = ((const u32x2*)y0)[lane + 64 * j], a1 = ((const u32x2*)y1)[lane + 64 * j];
            v[j].x += bf_lo(a0.x) + bf_lo(a1.x); v[j].y += bf_hi(a0.x) + bf_hi(a1.x); v[j].z += bf_lo(a0.y) + bf_lo(a1.y); v[j].w += bf_hi(a0.y) + bf_hi(a1.y);
            ((f32x4*)(HO + (size_t)t * D))[lane + 64 * j] = v[j];
        }
        const float r = rsqrtf(row_sumsq(v) * (1.f / D) + EPS);
        row_store_norm_bf16(XN + (size_t)t * D, lane, v, r, gv);
    }
}
__device__ __forceinline__ void phase_p2(const Ctx& c, int l) {
    const bf16_t* XN = (const bf16_t*)(c.ws + WS_XN); const bf16_t* WG = (const bf16_t*)(c.ws + WS_WGATE) + (size_t)l * D * D;
    const bf16_t* PB = (const bf16_t*)(c.ws + WS_PBF) + (size_t)l * T * PLE; const bf16_t* WP = (const bf16_t*)(c.ws + WS_WPROJ) + (size_t)l * D * PLE;
    float* H = (float*)(c.ws + WS_H);
    const int fr = c.lane & 15, fq = c.lane >> 4, wr = c.wave >> 1, wc = c.wave & 1;
    for (int u = c.vb; u < 128 * 8; u += c.nb) {
        int mt, nt; map_unit(u, 8, mt, nt);
        const bf16_t* ap[4]; const bf16_t* bp[4];
        f32x4 ag[4][4], apj[4][4]; zero_acc(ag); zero_acc(apj);
        rows_regular<64>(ap, XN + (size_t)mt * 128 * D, D, c.tid); rows_regular<64>(bp, WG + (size_t)nt * 128 * D, D, c.tid);
        gemm_loop<64, 1, true>(c, ap, bp, bp, D, ag, ag);
        rows_regular<64>(ap, PB + (size_t)mt * 128 * PLE, PLE, c.tid); rows_regular<64>(bp, WP + (size_t)nt * 128 * PLE, PLE, c.tid);
        gemm_loop<64, 1, true>(c, ap, bp, bp, PLE, apj, apj);
        f32x4 hres[4][4];
#pragma unroll
        for (int m = 0; m < 4; ++m)
#pragma unroll
            for (int n = 0; n < 4; ++n) hres[m][n] = *(const f32x4*)(H + (size_t)(mt * 128 + wr * 64 + m * 16 + fr) * D + nt * 128 + wc * 64 + n * 16 + fq * 4);
#pragma unroll
        for (int m = 0; m < 4; ++m)
#pragma unroll
            for (int n = 0; n < 4; ++n) {
                const size_t off = (size_t)(mt * 128 + wr * 64 + m * 16 + fr) * D + nt * 128 + wc * 64 + n * 16 + fq * 4;
                const f32x4 g = ag[m][n], pj = apj[m][n]; f32x4 h = hres[m][n];
                h.x += sigmoidf_(g.x) * pj.x; h.y += sigmoidf_(g.y) * pj.y; h.z += sigmoidf_(g.z) * pj.z; h.w += sigmoidf_(g.w) * pj.w;
                *(f32x4*)(H + off) = h;
            }
    }
}
__device__ __forceinline__ void phase_norm_bf16(const Ctx& c, const float* gain) {
    const float* H = (const float*)(c.ws + WS_H); bf16_t* XN = (bf16_t*)(c.ws + WS_XN);
    const int gw = c.vb * 4 + c.wave, ngw = c.nb * 4;
    f32x4 gv[4]; gain_load(gain, c.lane, gv);
    for (int t = gw; t < T; t += ngw) {
        f32x4 v[4]; row_load(H + (size_t)t * D, c.lane, v);
        const float r = rsqrtf(row_sumsq(v) * (1.f / D) + EPS);
        row_store_norm_bf16(XN + (size_t)t * D, c.lane, v, r, gv);
    }
}
__device__ __forceinline__ void phase_final(const Ctx& c) {
    const float* H = (const float*)(c.ws + WS_H); float* O = c.a->out; const float* gain = (const float*)c.a->in[IN_FINN];
    const int gw = c.vb * 4 + c.wave, ngw = c.nb * 4;
    f32x4 gv[4]; gain_load(gain, c.lane, gv);
    for (int t = gw; t < T; t += ngw) {
        f32x4 v[4]; row_load(H + (size_t)t * D, c.lane, v);
        const float r = rsqrtf(row_sumsq(v) * (1.f / D) + EPS);
#pragma unroll
        for (int j = 0; j < 4; ++j) ((f32x4*)(O + (size_t)t * D))[c.lane + 64 * j] = v[j] * r * gv[j];
    }
}

__device__ __forceinline__ void phase_b1(const Ctx& c, size_t raw_off = WS_RAW) {
    const bf16_t* XN = (const bf16_t*)(c.ws + WS_XN); const bf16_t* W = (const bf16_t*)(c.ws + WS_WBIN); bf16_t* RAW = (bf16_t*)(c.ws + raw_off);
    const int fr = c.lane & 15, fq = c.lane >> 4, wr = c.wave >> 1, wc = c.wave & 1;
    for (int u = c.vb; u < 128 * 17; u += c.nb) {
        int mt, nt; map_unit(u, 17, mt, nt);
        const bf16_t* ap[4]; const bf16_t* bp[4];
        rows_regular<64>(ap, XN + (size_t)mt * 128 * D, D, c.tid); rows_regular<64>(bp, W + (size_t)nt * 128 * D, D, c.tid);
        f32x4 acc[4][4]; zero_acc(acc);
        gemm_loop<64, 1, true>(c, ap, bp, bp, D, acc, acc);
#pragma unroll
        for (int m = 0; m < 4; ++m)
#pragma unroll
            for (int n = 0; n < 4; ++n) {
                const f32x4 v = acc[m][n]; u32x2 o; o.x = pk_bf16(v.x, v.y); o.y = pk_bf16(v.z, v.w);
                *(u32x2*)(RAW + (size_t)(mt * 128 + wr * 64 + m * 16 + fr) * BINP + nt * 128 + wc * 64 + n * 16 + fq * 4) = o;
            }
    }
}

__device__ __forceinline__ void unpack8(const u32x4 r, float (&e)[8]) { e[0] = bf_lo(r.x); e[1] = bf_hi(r.x); e[2] = bf_lo(r.y); e[3] = bf_hi(r.y); e[4] = bf_lo(r.z); e[5] = bf_hi(r.z); e[6] = bf_lo(r.w); e[7] = bf_hi(r.w); }
__device__ __forceinline__ u32x4 pack8(const float (&e)[8]) { u32x4 o; o.x = pk_bf16(e[0], e[1]); o.y = pk_bf16(e[2], e[3]); o.z = pk_bf16(e[4], e[5]); o.w = pk_bf16(e[6], e[7]); return o; }
__device__ __forceinline__ void phase_rope(const Ctx& c) {
    const bf16_t* RAW = (const bf16_t*)(c.ws + WS_RAW);
    bf16_t* Q = (bf16_t*)(c.ws + WS_Q); bf16_t* K = (bf16_t*)(c.ws + WS_K); bf16_t* V = (bf16_t*)(c.ws + WS_V);
    bf16_t* QI = (bf16_t*)(c.ws + WS_QI); bf16_t* KI = (bf16_t*)(c.ws + WS_KI); float* WI = (float*)(c.ws + WS_WI);
    const int* pos = (const int*)c.a->in[IN_POS];
    LAS float* cs = (LAS float*)(c.lds + c.wave * 256);
    const int gw = c.vb * 4 + c.wave, ngw = c.nb * 4, lane = c.lane;
    for (int t = gw; t < T; t += ngw) {
        if (lane < 24) {
            const double ex = (lane < 16) ? (double)lane * (1.0 / 16.0) : (double)(lane - 16) * (1.0 / 8.0);
            const float invf = (float)exp2(-ex * 18.931568569324174);
            const float ang = (float)pos[t] * invf;
            const double ad = (double)ang; const double n = rint(ad * 0.15915494309189535); const float red = (float)(ad - n * 6.283185307179586);
            cs[lane] = cosf(red); cs[32 + lane] = sinf(red);
        }
        LDS_WAIT();
        const bf16_t* row = RAW + (size_t)t * BINP;
        for (int ch = lane; ch < BINP / 8; ch += 64) {
            const u32x4 own = ((const u32x4*)row)[ch];
            float e[8]; unpack8(own, e);
            if (ch < 160) {
                const int cc = ch & 15;
                if (cc < 4) {
                    const u32x4 oth = ((const u32x4*)row)[ch ^ 2]; float p[8]; unpack8(oth, p);
                    const int f0 = (cc & 1) * 8;
#pragma unroll
                    for (int i = 0; i < 8; ++i) { const float co = cs[f0 + i], si = cs[32 + f0 + i]; e[i] = (cc < 2) ? (e[i] * co - p[i] * si) : (e[i] * co + p[i] * si); }
                }
                if (ch < 128) {
#pragma unroll
                    for (int i = 0; i < 8; ++i) e[i] *= 0.08838834764831845f;
                    ((u32x4*)(Q + (size_t)t * D))[ch] = pack8(e);
                } else ((u32x4*)(K + (size_t)t * 256))[ch - 128] = pack8(e);
            } else if (ch < 192) {
                ((u32x4*)(V + (size_t)t * 256))[ch - 160] = own;
            } else if (ch < 264) {
                const int cc = ch & 7;
                if (cc < 2) {
                    const u32x4 oth = ((const u32x4*)row)[ch ^ 1]; float p[8]; unpack8(oth, p);
#pragma unroll
                    for (int i = 0; i < 8; ++i) { const float co = cs[16 + i], si = cs[32 + 16 + i]; e[i] = (cc == 0) ? (e[i] * co - p[i] * si) : (e[i] * co + p[i] * si); }
                }
                if (ch < 256) ((u32x4*)(QI + (size_t)t * 512))[ch - 192] = pack8(e);
                else ((u32x4*)(KI + (size_t)t * 64))[ch - 256] = pack8(e);
            } else if (ch == 264) {
                f32x4 w0 = {e[0], e[1], e[2], e[3]}, w1 = {e[4], e[5], e[6], e[7]};
                const float sc = 0.044194173824159216f;
                ((f32x4*)(WI + (size_t)t * 8))[0] = w0 * sc; ((f32x4*)(WI + (size_t)t * 8))[1] = w1 * sc;
            }
        }
        LDS_WAIT();
    }
}

__device__ __forceinline__ size_t srow_off(int t) { const int m = t >> 6, r = t & 63; return (size_t)64 * (m + 1) * (32 * m + r); }
constexpr size_t S_BATCH = (size_t)64 * 65 * 2048;
constexpr int SCORE_UNITS = 4 * 312;
__device__ __forceinline__ void phase_score(const Ctx& c) {
    const bf16_t* QI = (const bf16_t*)(c.ws + WS_QI); const bf16_t* KI = (const bf16_t*)(c.ws + WS_KI); const float* WI = (const float*)(c.ws + WS_WI);
    float* S = (float*)(c.ws + WS_S);
    const int lane = c.lane, hf = lane >> 5, col = lane & 31, w = c.wave;
    for (int u = c.vb; u < SCORE_UNITS; u += c.nb) {
        const int b = u & 3, r = u >> 2;
        int kc, qb;
        if (r < 120) { kc = 0; qb = 8 + r; } else if (r < 216) { kc = 1; qb = 32 + (r - 120); } else if (r < 280) { kc = 2; qb = 64 + (r - 216); } else { kc = 3; qb = 96 + (r - 280); }
        const int tb = b * SEQ, t0 = 32 * qb + 8 * w;
        bf16x8 af[2][4]; f32x4 wv[2][4];
        { const int rho = lane & 31, ql = 2 * ((rho >> 2) & 1) + (rho >> 4), hd = 4 * ((rho >> 3) & 1) + (rho & 3);
#pragma unroll
          for (int a = 0; a < 2; ++a) {
              const bf16_t* qp = QI + (size_t)(tb + t0 + 4 * a + ql) * 512 + hd * 64 + 8 * hf;
#pragma unroll
              for (int ks = 0; ks < 4; ++ks) af[a][ks] = *(const bf16x8*)(qp + 16 * ks);
              const float* wp = WI + (size_t)(tb + t0 + 4 * a + 2 * hf) * 8;
#pragma unroll
              for (int i = 0; i < 4; ++i) wv[a][i] = ((const f32x4*)wp)[i];
          } }
        const int ntile = min(32, qb + 1 - 32 * kc), key0 = 1024 * kc;
        float* Sb = S + (size_t)b * S_BATCH;
        size_t ro[2][2];
#pragma unroll
        for (int a = 0; a < 2; ++a) { ro[a][0] = srow_off(t0 + 4 * a + 2 * hf); ro[a][1] = srow_off(t0 + 4 * a + 2 * hf + 1); }
        const int nsub = (ntile + 3) >> 2;
        const bf16_t* krp[4];
        rows_regular<64>(krp, KI + (size_t)(tb + key0) * 64, 64, c.tid);
        __syncthreads();
        stage_tile<64>(c.lds, krp, 0, c.tid);
        for (int sc = 0; sc < nsub; ++sc) {
            VM_WAIT();
            __syncthreads();
            const LAS unsigned char* cur = c.lds + (sc & 1) * 16384;
            if (sc + 1 < nsub) stage_tile<64>(c.lds + ((sc + 1) & 1) * 16384, krp, (sc + 1) * 128 * 64, c.tid);
#pragma unroll
            for (int j = 0; j < 4; ++j) {
                const int kt = 4 * sc + j;
                if (kt < ntile) {
                    const int key = key0 + 32 * kt + col, row = 32 * j + col;
                    bf16x8 cb[4];
#pragma unroll
                    for (int ks = 0; ks < 4; ++ks) cb[ks] = *(const LAS bf16x8*)(cur + row * 128 + (((2 * ks + hf) ^ (row & 7)) << 4));
#pragma unroll
                    for (int a = 0; a < 2; ++a) {
                        f32x16 acc = {};
#pragma unroll
                        for (int ks = 0; ks < 4; ++ks) acc = __builtin_amdgcn_mfma_f32_32x32x16_bf16(af[a][ks], cb[ks], acc, 0, 0, 0);
                        float s0 = fmaxf(acc[0], 0.f) * wv[a][0].x; s0 += fmaxf(acc[1], 0.f) * wv[a][0].y; s0 += fmaxf(acc[2], 0.f) * wv[a][0].z; s0 += fmaxf(acc[3], 0.f) * wv[a][0].w;
                        s0 += fmaxf(acc[4], 0.f) * wv[a][1].x; s0 += fmaxf(acc[5], 0.f) * wv[a][1].y; s0 += fmaxf(acc[6], 0.f) * wv[a][1].z; s0 += fmaxf(acc[7], 0.f) * wv[a][1].w;
                        float s1 = fmaxf(acc[8], 0.f) * wv[a][2].x; s1 += fmaxf(acc[9], 0.f) * wv[a][2].y; s1 += fmaxf(acc[10], 0.f) * wv[a][2].z; s1 += fmaxf(acc[11], 0.f) * wv[a][2].w;
                        s1 += fmaxf(acc[12], 0.f) * wv[a][3].x; s1 += fmaxf(acc[13], 0.f) * wv[a][3].y; s1 += fmaxf(acc[14], 0.f) * wv[a][3].z; s1 += fmaxf(acc[15], 0.f) * wv[a][3].w;
                        const int tA = t0 + 4 * a + 2 * hf;
                        Sb[ro[a][0] + key] = (key <= tA) ? s0 : -INFINITY;
                        Sb[ro[a][1] + key] = (key <= tA + 1) ? s1 : -INFINITY;
                    }
                }
            }
        }
    }
}

constexpr int NBINS = 2048, CAND_CAP = 256, SEL_WAVE_LDS = 8192 + 2048 + 64;
__device__ __forceinline__ void phase_select(const Ctx& c) {
    const float* S = (const float*)(c.ws + WS_S); int* SEL = (int*)(c.ws + WS_SEL);
    LAS int* hist = (LAS int*)(c.lds + c.wave * SEL_WAVE_LDS);
    LAS float* candv = (LAS float*)(hist + NBINS);
    LAS int* candi = (LAS int*)(candv + CAND_CAP);
    LAS int* thr = candi + CAND_CAP;
    const int gw = c.vb * 4 + c.wave, ngw = c.nb * 4;
    for (int j = gw; j < 4 * 3840; j += ngw) {
        int lane = c.lane;
        asm volatile("" : "+v"(lane));
        const int b = j & 3, t = 4095 - (j >> 2), ni = (t + 64) >> 6;
        const float* row = S + (size_t)b * S_BATCH + srow_off(t);
        float s[64];
#pragma unroll
        for (int g4 = 0; g4 < 4; ++g4) {
            if (16 * g4 < ni) {
#pragma unroll
                for (int i = 16 * g4; i < 16 * g4 + 16; ++i) { const int k = 64 * i + lane; const float v = row[min(k, t)]; s[i] = (k <= t) ? v : -INFINITY; }
            } else {
#pragma unroll
                for (int i = 16 * g4; i < 16 * g4 + 16; ++i) s[i] = -INFINITY;
            }
        }
        asm volatile("" : "+v"(lane));
        float mn = INFINITY, mx = -INFINITY;
#pragma unroll
        for (int i = 0; i < 64; ++i) { mx = fmaxf(mx, s[i]); mn = fminf(mn, (s[i] == -INFINITY) ? INFINITY : s[i]); }
#pragma unroll
        for (int o = 1; o < 64; o <<= 1) { mx = fmaxf(mx, __shfl_xor(mx, o)); mn = fminf(mn, __shfl_xor(mn, o)); }
        const float sc = (mx > mn) ? (float)NBINS / (mx - mn) : 0.f;
#pragma unroll
        for (int i = 0; i < 8; ++i) ((LAS u32x4*)hist)[lane * 8 + i] = (u32x4){0u, 0u, 0u, 0u};
        LDS_WAIT();
#define BINOF(v) min(NBINS - 1, (int)(((v) - mn) * sc))
#pragma unroll
        for (int i = 0; i < 64; ++i) if ((i & ~7) < ni && s[i] != -INFINITY) lds_inc(&hist[BINOF(s[i])]);
        LDS_WAIT();
        int bs, need;
        {
            const LAS int* hq = hist + lane * 32;
            int loc = 0;
#pragma unroll
            for (int i = 0; i < 8; ++i) { const u32x4 h4 = ((const LAS u32x4*)hq)[i]; loc += (int)(h4.x + h4.y + h4.z + h4.w); }
            int suf = loc;
#pragma unroll
            for (int o = 1; o < 64; o <<= 1) { const int v = __shfl_down(suf, o); if (lane + o < 64) suf += v; }
            const int above = suf - loc;
            const bool cross = (above < 256 && suf >= 256);
            int bsl = 0, abl = 0;
            if (cross) { int run = above; for (int i = 31; i >= 0; --i) { const int h = hq[i]; if (run < 256 && run + h >= 256) { bsl = lane * 32 + i; abl = run; } run += h; } }
            const unsigned long long cm = __ballot(cross);
            const int src = cm ? (int)__builtin_ctzll(cm) : 0;
            bs = __shfl(bsl, src); need = 256 - __shfl(abl, src);
        }
        int bs2 = -1;
        if (__shfl(hist[bs], 0) > 32) {
#pragma unroll
            for (int i = 0; i < 8; ++i) ((LAS u32x4*)hist)[lane * 8 + i] = (u32x4){0u, 0u, 0u, 0u};
            LDS_WAIT();
#define SUBOF(v) min(NBINS - 1, (int)((((v) - mn) * sc - (float)bs) * (float)NBINS))
#pragma unroll
            for (int i = 0; i < 64; ++i) if ((i & ~7) < ni && s[i] != -INFINITY && BINOF(s[i]) == bs) lds_inc(&hist[SUBOF(s[i])]);
            LDS_WAIT();
            const LAS int* hq = hist + lane * 32;
            int loc = 0;
#pragma unroll
            for (int i = 0; i < 8; ++i) { const u32x4 h4 = ((const LAS u32x4*)hq)[i]; loc += (int)(h4.x + h4.y + h4.z + h4.w); }
            int suf = loc;
#pragma unroll
            for (int o = 1; o < 64; o <<= 1) { const int v = __shfl_down(suf, o); if (lane + o < 64) suf += v; }
            const int above = suf - loc;
            const bool cross = (above < need && suf >= need);
            int bsl = 0, abl = 0;
            if (cross) { int run = above; for (int i = 31; i >= 0; --i) { const int h = hq[i]; if (run < need && run + h >= need) { bsl = lane * 32 + i; abl = run; } run += h; } }
            const unsigned long long cm = __ballot(cross);
            const int src = cm ? (int)__builtin_ctzll(cm) : 0;
            bs2 = __shfl(bsl, src); need = need - __shfl(abl, src);
        }
        asm volatile("" : "+v"(lane));
        int nc = 0;
#pragma unroll
        for (int i = 0; i < 64; ++i) if ((i & ~7) < ni) {
            bool p = (s[i] != -INFINITY) && (BINOF(s[i]) == bs);
            if (bs2 >= 0) p = p && (SUBOF(s[i]) == bs2);
            const unsigned long long m = __ballot(p);
            const int pos = nc + (int)__builtin_amdgcn_mbcnt_hi((unsigned)(m >> 32), __builtin_amdgcn_mbcnt_lo((unsigned)m, 0u));
            if (p && pos < CAND_CAP) { candv[pos] = s[i]; candi[pos] = 64 * i + lane; }
            nc += (int)__popcll(m);
        }
        nc = min(nc, CAND_CAP);
        LDS_WAIT();
        for (int i = lane; i < nc; i += 64) {
            const float v = candv[i]; const int id = candi[i];
            int rank = 0;
            for (int k = 0; k < nc; ++k) { const float vk = candv[k]; const int ik = candi[k]; rank += (vk > v || (vk == v && ik < id)) ? 1 : 0; }
            if (rank == need - 1) { thr[0] = __float_as_int(v); thr[1] = id; }
        }
        LDS_WAIT();
        const float tv = __int_as_float(thr[0]); const int ti = thr[1];
        asm volatile("" : "+v"(lane));
        int* selr = SEL + ((size_t)b * SEQ + t) * 256;
        int base = 0;
#pragma unroll
        for (int i = 0; i < 64; ++i) if ((i & ~7) < ni) {
            const int key = 64 * i + lane;
            const bool p = (s[i] > tv) || (s[i] == tv && key <= ti);
            const unsigned long long m = __ballot(p);
            const int pos = base + (int)__builtin_amdgcn_mbcnt_hi((unsigned)(m >> 32), __builtin_amdgcn_mbcnt_lo((unsigned)m, 0u));
            if (p && pos < 256) selr[pos] = key;
            base += (int)__popcll(m);
        }
        LDS_WAIT();
#undef BINOF
#undef SUBOF
    }
}

typedef short s16x4 __attribute__((ext_vector_type(4)));
__device__ __forceinline__ unsigned vimg_f(unsigned r) { return ((r & 3u) << 2) | ((r >> 2) & 3u); }
__device__ __forceinline__ void tr_read8(const unsigned (&ad)[8], s16x4 (&r)[8]) {
    asm volatile("ds_read_b64_tr_b16 %0, %8\n\tds_read_b64_tr_b16 %1, %9\n\tds_read_b64_tr_b16 %2, %10\n\tds_read_b64_tr_b16 %3, %11\n\t"
                 "ds_read_b64_tr_b16 %4, %12\n\tds_read_b64_tr_b16 %5, %13\n\tds_read_b64_tr_b16 %6, %14\n\tds_read_b64_tr_b16 %7, %15\n\ts_waitcnt lgkmcnt(0)"
                 : "=&v"(r[0]), "=&v"(r[1]), "=&v"(r[2]), "=&v"(r[3]), "=&v"(r[4]), "=&v"(r[5]), "=&v"(r[6]), "=&v"(r[7])
                 : "v"(ad[0]), "v"(ad[1]), "v"(ad[2]), "v"(ad[3]), "v"(ad[4]), "v"(ad[5]), "v"(ad[6]), "v"(ad[7]) : "memory");
}
constexpr int ATT_WAVE_LDS = 19456;
__device__ __forceinline__ void phase_attn(const Ctx& c) {
    const bf16_t* Q = (const bf16_t*)(c.ws + WS_Q); const bf16_t* K = (const bf16_t*)(c.ws + WS_K); const bf16_t* V = (const bf16_t*)(c.ws + WS_V);
    const int* SEL = (const int*)(c.ws + WS_SEL); bf16_t* O = (bf16_t*)(c.ws + WS_O);
    LAS unsigned char* wl = c.lds + c.wave * ATT_WAVE_LDS;
    LAS int* sl = (LAS int*)wl;
    LAS unsigned short* pT = (LAS unsigned short*)(wl + 1024);
    LAS unsigned char* vb = wl + 3072;
    const int lane = c.lane, fr = lane & 15, fq = lane >> 4;
    const int gw = c.vb * 4 + c.wave, ngw = c.nb * 4;
    unsigned tro[16];
    { const unsigned q = (unsigned)fr >> 2, p = (unsigned)fr & 3u;
#pragma unroll
      for (int c2 = 0; c2 < 8; ++c2)
#pragma unroll
          for (int t = 0; t < 2; ++t) { const unsigned row = 8u * fq + 4u * t + q, ch = 2u * c2 + (p >> 1); tro[c2 * 2 + t] = 256u * row + 16u * (ch ^ vimg_f(row)) + 8u * (p & 1u); } }
    const unsigned vb_addr = (unsigned)(size_t)vb;
    const bool xsplit = (c.nb % 128) == 0;
    const int xg = (c.vb >> 6) & 1, wi0 = xsplit ? (((c.vb >> 7) * 64 + (c.vb & 63)) * 4 + c.wave) : gw, wstride = xsplit ? ngw / 2 : ngw;
    for (int task = wi0; task < (xsplit ? T : T * 2); task += wstride) {
        const int tg = xsplit ? task : (task >> 1), g = xsplit ? xg : (task & 1), b = tg >> 12, t = tg & 4095, tb = b * SEQ;
        const int nsel = min(256, t + 1), ntile = (nsel + 15) >> 4, nch = (nsel + 31) >> 5;
#pragma unroll
        for (int i = 0; i < 4; ++i) { const int s_ = lane + 64 * i; int idx = SEL[(size_t)tg * 256 + s_]; idx = (t < 256) ? s_ : idx; idx = (s_ < nsel && (unsigned)idx <= (unsigned)t) ? idx : 0; sl[s_] = idx; }
        bf16x8 qf[4];
        { const bf16_t* qp = Q + (size_t)tg * D + (4 * g + (fr & 3)) * 128 + 8 * fq;
#pragma unroll
          for (int ks = 0; ks < 4; ++ks) qf[ks] = *(const bf16x8*)(qp + 32 * ks); }
        LDS_WAIT();
        const bf16_t* vbase = V + (size_t)tb * 256 + g * 128;
#define V_GATHER(chk, bufsel) do { _Pragma("unroll") for (int i_ = 0; i_ < 8; ++i_) { const int r_ = 4 * i_ + fq; const int key_ = sl[32 * (chk) + r_]; \
            __builtin_amdgcn_global_load_lds((const unsigned*)(vbase + (size_t)key_ * 256 + (((unsigned)fr ^ vimg_f((unsigned)r_)) << 3)), \
                                             (LAS unsigned*)(vb + (bufsel) * 8192 + i_ * 1024 + lane * 16), 16, 0, 0); } } while (0)
        f32x4 lg[16];
#pragma unroll
        for (int kg = 0; kg < 4; ++kg) {
            bf16x8 kf[4][4];
#pragma unroll
            for (int k4 = 0; k4 < 4; ++k4) {
                const int key = sl[(kg * 4 + k4) * 16 + fr];
                const bf16_t* kp = K + (size_t)(tb + key) * 256 + g * 128 + 8 * fq;
#pragma unroll
                for (int ks = 0; ks < 4; ++ks) kf[k4][ks] = *(const bf16x8*)(kp + 32 * ks);
            }
            __builtin_amdgcn_sched_barrier(0);
#pragma unroll
            for (int k4 = 0; k4 < 4; ++k4) {
                const int kt = kg * 4 + k4;
                f32x4 acc = {0.f, 0.f, 0.f, 0.f};
#pragma unroll
                for (int ks = 0; ks < 4; ++ks) acc = __builtin_amdgcn_mfma_f32_16x16x32_bf16(qf[ks], kf[k4][ks], acc, 0, 0, 0);
                const bool ok = (kt * 16 + fr < nsel);
                lg[kt].x = ok ? acc.x : -INFINITY; lg[kt].y = ok ? acc.y : -INFINITY; lg[kt].z = ok ? acc.z : -INFINITY; lg[kt].w = ok ? acc.w : -INFINITY;
            }
            __builtin_amdgcn_sched_barrier(0);
        }
        f32x4 mx = lg[0];
#pragma unroll
        for (int kt = 1; kt < 16; ++kt) { mx.x = fmaxf(mx.x, lg[kt].x); mx.y = fmaxf(mx.y, lg[kt].y); mx.z = fmaxf(mx.z, lg[kt].z); mx.w = fmaxf(mx.w, lg[kt].w); }
#pragma unroll
        for (int o = 1; o < 16; o <<= 1) { mx.x = fmaxf(mx.x, __shfl_xor(mx.x, o)); mx.y = fmaxf(mx.y, __shfl_xor(mx.y, o)); mx.z = fmaxf(mx.z, __shfl_xor(mx.z, o)); mx.w = fmaxf(mx.w, __shfl_xor(mx.w, o)); }
        f32x4 sm = {0.f, 0.f, 0.f, 0.f};
#pragma unroll
        for (int kt = 0; kt < 16; ++kt) { f32x4 p; p.x = __expf(lg[kt].x - mx.x); p.y = __expf(lg[kt].y - mx.y); p.z = __expf(lg[kt].z - mx.z); p.w = __expf(lg[kt].w - mx.w); lg[kt] = p; sm += p; }
#pragma unroll
        for (int o = 1; o < 16; o <<= 1) { sm.x += __shfl_xor(sm.x, o); sm.y += __shfl_xor(sm.y, o); sm.z += __shfl_xor(sm.z, o); sm.w += __shfl_xor(sm.w, o); }
        { const float inv = 1.f / (fq == 0 ? sm.x : fq == 1 ? sm.y : fq == 2 ? sm.z : sm.w);
#pragma unroll
          for (int kt = 0; kt < 16; ++kt) { const float pv = (fq == 0 ? lg[kt].x : fq == 1 ? lg[kt].y : fq == 2 ? lg[kt].z : lg[kt].w) * inv; pT[fq * 256 + kt * 16 + fr] = (unsigned short)(pk_bf16(pv, pv) & 0xffffu); } }
        V_GATHER(0, 0);
        LDS_WAIT();
        f32x4 oacc[8];
#pragma unroll
        for (int c2 = 0; c2 < 8; ++c2) oacc[c2] = (f32x4){0.f, 0.f, 0.f, 0.f};
        for (int ch = 0; ch < nch; ++ch) {
            if (ch + 1 < nch) { V_GATHER(ch + 1, (ch + 1) & 1); asm volatile("s_waitcnt vmcnt(8)" ::: "memory"); }
            else asm volatile("s_waitcnt vmcnt(0)" ::: "memory");
            const bf16x8 pa = *(const LAS bf16x8*)(pT + (fr & 3) * 256 + 32 * ch + 8 * fq);
            const unsigned cb = vb_addr + (unsigned)(ch & 1) * 8192u;
            unsigned ad[8]; s16x4 r0[8], r1[8];
#pragma unroll
            for (int i = 0; i < 8; ++i) ad[i] = cb + tro[i];
            tr_read8(ad, r0);
#pragma unroll
            for (int i = 0; i < 8; ++i) ad[i] = cb + tro[8 + i];
            tr_read8(ad, r1);
#pragma unroll
            for (int c2 = 0; c2 < 4; ++c2) { const bf16x8 vf = __builtin_shufflevector(r0[2 * c2], r0[2 * c2 + 1], 0, 1, 2, 3, 4, 5, 6, 7); oacc[c2] = __builtin_amdgcn_mfma_f32_16x16x32_bf16(pa, vf, oacc[c2], 0, 0, 0); }
#pragma unroll
            for (int c2 = 0; c2 < 4; ++c2) { const bf16x8 vf = __builtin_shufflevector(r1[2 * c2], r1[2 * c2 + 1], 0, 1, 2, 3, 4, 5, 6, 7); oacc[4 + c2] = __builtin_amdgcn_mfma_f32_16x16x32_bf16(pa, vf, oacc[4 + c2], 0, 0, 0); }
        }
        { bf16_t* op = O + (size_t)tg * D + (4 * g + fq) * 128 + fr;
#pragma unroll
          for (int c2 = 0; c2 < 8; ++c2) { const float ov = (fq == 0 ? oacc[c2].x : fq == 1 ? oacc[c2].y : fq == 2 ? oacc[c2].z : oacc[c2].w); op[16 * c2] = (bf16_t)(pk_bf16(ov, ov) & 0xffffu); } }
        LDS_WAIT();
    }
#undef V_GATHER
}

__device__ __forceinline__ void phase_b4(const Ctx& c) {
    const bf16_t* OB = (const bf16_t*)(c.ws + WS_O); const bf16_t* W = (const bf16_t*)(c.ws + WS_WBOUT); float* H = (float*)(c.ws + WS_H);
    const int fr = c.lane & 15, fq = c.lane >> 4, wr = c.wave >> 1, wc = c.wave & 1;
    for (int u = c.vb; u < 128 * 8; u += c.nb) {
        int mt, nt; map_unit(u, 8, mt, nt);
        const bf16_t* ap[4]; const bf16_t* bp[4];
        rows_regular<64>(ap, OB + (size_t)mt * 128 * D, D, c.tid); rows_regular<64>(bp, W + (size_t)nt * 128 * D, D, c.tid);
        f32x4 acc[4][4];
#pragma unroll
        for (int m = 0; m < 4; ++m)
#pragma unroll
            for (int n = 0; n < 4; ++n) acc[m][n] = *(const f32x4*)(H + (size_t)(mt * 128 + wr * 64 + m * 16 + fr) * D + nt * 128 + wc * 64 + n * 16 + fq * 4);
        gemm_loop<64, 1, true>(c, ap, bp, bp, D, acc, acc);
#pragma unroll
        for (int m = 0; m < 4; ++m)
#pragma unroll
            for (int n = 0; n < 4; ++n) *(f32x4*)(H + (size_t)(mt * 128 + wr * 64 + m * 16 + fr) * D + nt * 128 + wc * 64 + n * 16 + fq * 4) = acc[m][n];
    }
}

constexpr int NPHASE = 22;
__global__ void __launch_bounds__(NTH, 2) mk_fwd(Args args) {
    extern __shared__ __attribute__((aligned(16))) unsigned char lds_raw[];
    Ctx c;
    c.lds = (LAS unsigned char*)lds_raw; c.tid = threadIdx.x; c.lane = c.tid & 63; c.wave = __builtin_amdgcn_readfirstlane(c.tid >> 6);
    c.nb = gridDim.x; { const int bx = blockIdx.x; c.vb = (c.nb % 8 == 0) ? (bx % 8) * (c.nb / 8) + bx / 8 : bx; }
    c.a = (const __attribute__((address_space(4))) Args*)__builtin_amdgcn_kernarg_segment_ptr(); c.ws = args.ws;
    volatile LAS unsigned* st = (volatile LAS unsigned*)(c.lds + LDS_MAIN + 1008);
    const bool multi = (args.ph_hi - args.ph_lo) > 1;
    XcdBarrier bar; bar.bar = (unsigned*)(c.ws + WS_CTL); bar.x = 0; bar.st = st;
    if (multi) {
        if (c.tid == 0) { st[0] = 0u; st[1] = 0u; }
        __syncthreads();
        bar = xcd_barrier_post((unsigned*)(c.ws + WS_CTL), st);
    }
    const int ph_lo = args.ph_lo, ph_hi = args.ph_hi;
#ifndef PH_MASK
#define PH_MASK 0x3fffff
#endif
#define PHON(k) ((PH_MASK >> (k)) & 1)
#define PHASE(k, body) do { if (PHON(k) && ph_lo <= (k) && (k) < ph_hi) { \
        { int t_ = threadIdx.x, vb_ = __builtin_amdgcn_readfirstlane(c.vb); \
          const __attribute__((address_space(4))) Args* ka = (const __attribute__((address_space(4))) Args*)__builtin_amdgcn_kernarg_segment_ptr(); \
          asm volatile("" : "+v"(t_), "+s"(vb_), "+s"(ka)); \
          c.tid = t_; c.lane = t_ & 63; c.wave = __builtin_amdgcn_readfirstlane(t_ >> 6); c.vb = vb_; c.a = ka; c.ws = ka->ws; } \
        body; \
        if (MK_REP == (k)) { __syncthreads(); body; } \
        if ((k) + 1 < ph_hi) xcd_barrier(bar); \
        if ((k) == 3) { for (int xb_ = 0; xb_ < MK_XBAR; ++xb_) xcd_barrier(bar); } } } while (0)
    PHASE(0, phase_prep(c));
    PHASE(1, phase_a1(c));
    PHASE(2, { if (MK_DRY == 2) { phase_a2(c, true); __syncthreads(); } phase_a2(c); });
    PHASE(3, phase_a3(c));
    PHASE(4, { if (MK_DRY == 4) { phase_route(c, 0, true); __syncthreads(); } phase_route(c, 0); });
    PHASE(5, phase_e1(c, 0));
    PHASE(6, phase_e2(c, 0));
    PHASE(7, { if (MK_DRY == 7) { phase_p1(c, 0, true); __syncthreads(); } phase_p1(c, 0); });
    PHASE(8, phase_p2(c, 0));
    PHASE(9, { phase_norm_bf16(c, (const float*)c.a->in[IN_MIXN] + D); convert_moe_layer(c, 1); });
    PHASE(10, phase_b1(c));
    PHASE(11, phase_rope(c));
    PHASE(12, phase_score(c));
    PHASE(13, phase_select(c));
    PHASE(14, phase_attn(c));
    PHASE(15, phase_b4(c));
    PHASE(16, phase_route(c, 1));
    PHASE(17, phase_e1(c, 1));
    PHASE(18, phase_e2(c, 1));
    PHASE(19, phase_p1(c, 1));
    PHASE(20, phase_p2(c, 1));
    PHASE(21, phase_final(c));
}

#ifdef MK_DUMP
__global__ void dump_k(const unsigned char* ws, float* out) {
    const size_t i = (size_t)blockIdx.x * 256 + threadIdx.x;
#if MK_DUMP == 1
    ((f32x4*)out)[i] = ((const f32x4*)(ws + WS_H))[i];
#elif MK_DUMP == 2
    { const u32x2 v = ((const u32x2*)(ws + WS_O))[i]; f32x4 o = {bf_lo(v.x), bf_hi(v.x), bf_lo(v.y), bf_hi(v.y)}; ((f32x4*)out)[i] = o; }
#elif MK_DUMP == 3
    { const int* sp = (const int*)(ws + WS_SEL); f32x4 o = {0.f,0.f,0.f,0.f}; if (i < (size_t)T * 64) { o.x = (float)sp[4*i]; o.y = (float)sp[4*i+1]; o.z = (float)sp[4*i+2]; o.w = (float)sp[4*i+3]; } ((f32x4*)out)[i] = o; }
#elif MK_DUMP == 5
    { const u32x2 v = ((const u32x2*)(ws + WS_XN))[i]; f32x4 o = {bf_lo(v.x), bf_hi(v.x), bf_lo(v.y), bf_hi(v.y)}; ((f32x4*)out)[i] = o; }
#elif MK_DUMP == 6
    { const u32x2 v = ((const u32x2*)(ws + WS_RAW))[i]; f32x4 o = {bf_lo(v.x), bf_hi(v.x), bf_lo(v.y), bf_hi(v.y)}; ((f32x4*)out)[i] = o; }
#elif MK_DUMP == 7
    { f32x4 o = {0.f,0.f,0.f,0.f}; if (i < (size_t)BINP * D / 4) { const u32x2 v = ((const u32x2*)(ws + WS_WBIN))[i]; o = (f32x4){bf_lo(v.x), bf_hi(v.x), bf_lo(v.y), bf_hi(v.y)}; } ((f32x4*)out)[i] = o; }
#elif MK_DUMP == 8
    { const u32x2 v = ((const u32x2*)(ws + WS_RAW))[i], w = ((const u32x2*)(ws + 458 * MB))[i]; f32x4 o = {bf_lo(v.x) - bf_lo(w.x), bf_hi(v.x) - bf_hi(w.x), bf_lo(v.y) - bf_lo(w.y), bf_hi(v.y) - bf_hi(w.y)}; ((f32x4*)out)[i] = o; }
#elif MK_DUMP == 9
    { const u32x2 v = ((const u32x2*)(ws + WS_RAW))[i], w = ((const u32x2*)(ws + 458 * MB))[i]; f32x4 o = {(v.x & 0xffffu) != (w.x & 0xffffu) ? 1.f : 0.f, (v.x >> 16) != (w.x >> 16) ? 1.f : 0.f, (v.y & 0xffffu) != (w.y & 0xffffu) ? 1.f : 0.f, (v.y >> 16) != (w.y >> 16) ? 1.f : 0.f}; ((f32x4*)out)[i] = o; }
#elif MK_DUMP == 4
    { const u32x2 v = ((const u32x2*)(ws + WS_Q))[i]; f32x4 o = {bf_lo(v.x), bf_hi(v.x), bf_lo(v.y), bf_hi(v.y)}; ((f32x4*)out)[i] = o; }
#endif
}
#endif
extern "C" void kernel_launch(void* const* d_in, const int* in_sizes, int n_in, void* d_out, int out_size, void* d_ws, size_t ws_size, hipStream_t stream) {
    static int grid = 0;
    if (grid == 0) {
        if (n_in != 23 || out_size != T * D || ws_size < WS_TOTAL) { fprintf(stderr, "kernel_launch: unexpected sizes n_in %d out %d ws %zu (need %zu)\n", n_in, out_size, ws_size, (size_t)WS_TOTAL); grid = -1; return; }
        int dev = 0, cus = 0, per_cu = 0;
        hipGetDevice(&dev); hipDeviceGetAttribute(&cus, hipDeviceAttributeMultiprocessorCount, dev);
        hipFuncSetAttribute((const void*)mk_fwd, hipFuncAttributeMaxDynamicSharedMemorySize, LDS_BYTES);
        hipOccupancyMaxActiveBlocksPerMultiprocessor(&per_cu, (const void*)mk_fwd, NTH, LDS_BYTES);
        (void)hipGetLastError();
        if (per_cu < 1) per_cu = 1;
        if (per_cu > 2) per_cu = 2;
        grid = cus * per_cu;
    }
    if (grid < 0) return;
    hipMemsetAsync((char*)d_ws + WS_CTL, 0, 16384, stream);
    Args a{};
    for (int i = 0; i < 23; ++i) a.in[i] = d_in[i];
    a.out = (float*)d_out; a.ws = (unsigned char*)d_ws;
#if MK_ONE_LAUNCH
    a.ph_lo = 0; a.ph_hi = NPHASE;
    hipLaunchKernelGGL(mk_fwd, dim3(grid), dim3(NTH), LDS_BYTES, stream, a);
#else
    for (int ph = 0; ph <= MK_LAST_PHASE; ++ph) { a.ph_lo = ph; a.ph_hi = ph + 1; hipLaunchKernelGGL(mk_fwd, dim3(grid), dim3(NTH), LDS_BYTES, stream, a); }
#ifdef MK_DUMP
    hipLaunchKernelGGL(dump_k, dim3(T * D / 4 / 256), dim3(256), 0, stream, (const unsigned char*)d_ws, (float*)d_out);
#endif
#endif
}
```

```cpp
#include <hip/hip_runtime.h>
#include <stdint.h>
#include <stdio.h>

#ifndef MK_LAST_PHASE
#define MK_LAST_PHASE 21
#endif
#ifndef MK_REP
#define MK_REP -1
#endif
#ifndef MK_XBAR
#define MK_XBAR 0
#endif
#ifndef MK_DRY
#define MK_DRY -1
#endif
#ifndef MK_ONE_LAUNCH
#define MK_ONE_LAUNCH 1
#endif

#define LAS __attribute__((address_space(3)))
typedef unsigned short bf16_t;
typedef short bf16x8 __attribute__((ext_vector_type(8)));
typedef float f32x4 __attribute__((ext_vector_type(4)));
typedef float f32x2 __attribute__((ext_vector_type(2)));
typedef float f32x16 __attribute__((ext_vector_type(16)));
typedef unsigned u32x4 __attribute__((ext_vector_type(4)));
typedef unsigned u32x2 __attribute__((ext_vector_type(2)));

constexpr int T = 16384, D = 1024, SEQ = 4096;
constexpr int GW = 2048;
constexpr int BIN = 2120, BINP = 2176;
constexpr int NE = 32, DE = 512;
constexpr int PLE = 256;
constexpr float EPS = 1e-6f;
constexpr int NTH = 256;
constexpr int LDS_MAIN = 4 * 19456;
constexpr int LDS_BYTES = LDS_MAIN + 1024;
constexpr int RPAD = 32768 + NE * 128;

constexpr size_t MB = 1024 * 1024;
constexpr size_t WS_CTL = 0;
constexpr size_t WS_CNT = 16384;
constexpr size_t WS_WR = 32768;
constexpr size_t WS_WAIN = 1 * MB;
constexpr size_t WS_WAOUT = WS_WAIN + 8 * MB;
constexpr size_t WS_WBIN = WS_WAOUT + 4 * MB;
constexpr size_t WS_WBOUT = WS_WBIN + 5 * MB;
constexpr size_t WS_WGATE = WS_WBOUT + 2 * MB;
constexpr size_t WS_WPROJ = WS_WGATE + 4 * MB;
constexpr size_t WS_W1 = WS_WPROJ + 1 * MB;
constexpr size_t WS_W3 = WS_W1 + 32 * MB;
constexpr size_t WS_W2 = WS_W3 + 32 * MB;
constexpr size_t WS_PBF = WS_W2 + 32 * MB;
constexpr size_t WS_XN = WS_PBF + 16 * MB;
constexpr size_t WS_H = WS_XN + 32 * MB;
constexpr size_t WS_LIST = WS_H + 64 * MB;
constexpr size_t WS_GATE = WS_LIST + 2 * MB;
constexpr size_t WS_TOKSLOT = WS_GATE + 2 * MB;
constexpr size_t WS_SCR = WS_TOKSLOT + 1 * MB;
constexpr size_t WS_U = WS_SCR;
constexpr size_t WS_VT = WS_SCR + 64 * MB;
constexpr size_t WS_VSS = WS_SCR + 128 * MB;
constexpr size_t WS_HMID = WS_SCR;
constexpr size_t WS_Y = WS_SCR + 36 * MB;
constexpr size_t WS_RAW = WS_SCR;
constexpr size_t WS_O = WS_SCR;
constexpr size_t WS_Q = WS_SCR + 68 * MB;
constexpr size_t WS_K = WS_Q + 32 * MB;
constexpr size_t WS_V = WS_K + 8 * MB;
constexpr size_t WS_QI = WS_V + 8 * MB;
constexpr size_t WS_KI = WS_QI + 16 * MB;
constexpr size_t WS_WI = WS_KI + 2 * MB;
constexpr size_t WS_SEL = WS_WI + 1 * MB;
constexpr size_t WS_END = WS_SEL + 16 * MB;
static_assert(WS_END <= WS_SCR + 152 * MB, "scratch");
constexpr size_t WS_S = 392 * MB;
constexpr size_t WS_TOTAL = 522 * MB;

typedef __bf16 bf16x2_t __attribute__((ext_vector_type(2)));
__device__ __forceinline__ unsigned pk_bf16(float lo, float hi) { f32x2 v = {lo, hi}; bf16x2_t b = __builtin_convertvector(v, bf16x2_t); return __builtin_bit_cast(unsigned, b); }
__device__ __forceinline__ float bf_lo(unsigned u) { return __uint_as_float(u << 16); }
__device__ __forceinline__ float bf_hi(unsigned u) { return __uint_as_float(u & 0xffff0000u); }
__device__ __forceinline__ float wave_sum(float v) {
#pragma unroll
    for (int o = 1; o < 64; o <<= 1) v += __shfl_xor(v, o);
    return v;
}
__device__ __forceinline__ int lds_inc(LAS int* p) { return __hip_atomic_fetch_add(p, 1, __ATOMIC_RELAXED, __HIP_MEMORY_SCOPE_WORKGROUP); }
#define LDS_WAIT() asm volatile("s_waitcnt lgkmcnt(0)" ::: "memory")
#define VM_WAIT() asm volatile("s_waitcnt vmcnt(0)" ::: "memory")

#define XB_TMO      128
#define XB_XCNT(j)  (256  + 64 * (j))
#define XB_XSUB(j)  (1280 + 64 * (j))
#define XB_XGEN(j)  (2304 + 64 * (j))
#define XB_TOP      3328
#define XB_TOPGEN   3392
#define XCD_BAR_WORDS 3456
#define XB_SPIN_CAP (1u << 20)
__device__ __forceinline__ unsigned xb_ld(unsigned* p)              { return __hip_atomic_load(p, __ATOMIC_RELAXED, __HIP_MEMORY_SCOPE_AGENT); }
__device__ __forceinline__ unsigned xb_add(unsigned* p, unsigned v) { return __hip_atomic_fetch_add(p, v, __ATOMIC_RELAXED, __HIP_MEMORY_SCOPE_AGENT); }
__device__ __forceinline__ unsigned xb_xcc_id() { return (unsigned)__builtin_amdgcn_s_getreg((3 << 11) | 20) & 0xFu; }
#define XB_SPIN(cond, bar) do { unsigned _sp = 0; while (cond) { __builtin_amdgcn_s_sleep(1); \
    if ((++_sp & 255u) == 0u) { if (xb_ld(&(bar)[XB_TMO])) break; if (_sp > XB_SPIN_CAP) { atomicAdd(&(bar)[XB_TMO], 1u); break; } } } } while (0)
struct XcdBarrier { unsigned* bar; unsigned x; volatile LAS unsigned* st; };
__device__ __forceinline__ XcdBarrier xcd_barrier_post(unsigned* bar, volatile LAS unsigned* st) {
    XcdBarrier b; b.bar = bar; b.x = xb_xcc_id(); b.st = st;
    if (threadIdx.x == 0) (void)xb_add(&bar[XB_XCNT(b.x)], 1u);
    return b;
}
__device__ __forceinline__ void xcd_barrier_complete(unsigned* bar, unsigned x, unsigned& nloc, unsigned& nx) {
    const unsigned G = gridDim.x;
    unsigned sum, cnt, mine, sp = 0u;
    for (;;) {
        sum = 0u; cnt = 0u; mine = 0u;
#pragma unroll
        for (unsigned j = 0; j < 16; ++j) { const unsigned c = xb_ld(&bar[XB_XCNT(j)]); sum += c; cnt += (c > 0u) ? 1u : 0u; mine = (j == x) ? c : mine; }
        if (sum == G) break;
        __builtin_amdgcn_s_sleep(1);
        if ((++sp & 255u) == 0u) { if (xb_ld(&bar[XB_TMO])) break; if (sp > XB_SPIN_CAP) { atomicAdd(&bar[XB_TMO], 1u); break; } }
    }
    nloc = mine > 0u ? mine : 1u; nx = cnt > 0u ? cnt : 1u;
}
__device__ __forceinline__ void xcd_barrier(const XcdBarrier& b) {
    asm volatile("s_waitcnt vmcnt(0)" ::: "memory");
    __syncthreads();
    if (threadIdx.x == 0) {
        unsigned* bar = b.bar;
        __builtin_amdgcn_s_waitcnt(0);
        unsigned nloc = b.st[0], nx = b.st[1];
        if (nloc == 0u) { xcd_barrier_complete(bar, b.x, nloc, nx); b.st[0] = nloc; b.st[1] = nx; }
        const unsigned old = xb_add(&bar[XB_XSUB(b.x)], 1u);
        const unsigned gen = old / nloc;
        if (old + 1u == (gen + 1u) * nloc) {
            __builtin_amdgcn_fence(__ATOMIC_RELEASE, "agent");
            asm volatile("s_waitcnt vmcnt(0)" ::: "memory");
            const unsigned og = xb_add(&bar[XB_TOP], 1u);
            const unsigned tg = og / nx;
            if (og + 1u == (tg + 1u) * nx) xb_add(&bar[XB_TOPGEN], 1u);
            else XB_SPIN(xb_ld(&bar[XB_TOPGEN]) == tg, bar);
            __builtin_amdgcn_fence(__ATOMIC_ACQUIRE, "agent");
            xb_add(&bar[XB_XGEN(b.x)], 1u);
            asm volatile("s_waitcnt vmcnt(0)" ::: "memory");
        } else {
            XB_SPIN(xb_ld(&bar[XB_XGEN(b.x)]) == gen, bar);
            __builtin_amdgcn_fence(__ATOMIC_ACQUIRE, "agent");
            asm volatile("s_waitcnt vmcnt(0)" ::: "memory");
        }
    }
    __syncthreads();
}

struct Args { const void* in[23]; float* out; unsigned char* ws; int ph_lo, ph_hi; };
enum { IN_X = 0, IN_P, IN_POS, IN_MIXN, IN_AWIN, IN_AVG, IN_AWS, IN_ABS, IN_AWOUT, IN_BWIN, IN_BWOUT, IN_FFNN, IN_WG, IN_BG, IN_WE, IN_BE,
       IN_W1, IN_W3, IN_W2, IN_PLEN, IN_PLEG, IN_PLEP, IN_FINN };

struct Ctx {
    LAS unsigned char* lds;
    int tid, lane, wave, vb, nb;
    const __attribute__((address_space(4))) Args* a;
    unsigned char* ws;
};

template <int BK> struct TileK { static constexpr int NP = (BK == 64) ? 4 : 2; static constexpr int TB = 128 * BK * 2; };

template <int BK>
__device__ __forceinline__ void stage_tile(LAS unsigned char* tile, const bf16_t* const (&rp)[TileK<BK>::NP], int k0, int tid) {
    const int lc = (BK == 64) ? ((tid & 7) ^ ((tid >> 3) & 7)) : ((tid & 3) ^ ((tid >> 3) & 3));
#pragma unroll
    for (int p = 0; p < TileK<BK>::NP; ++p)
        __builtin_amdgcn_global_load_lds((const unsigned*)(rp[p] + k0 + lc * 8), (LAS unsigned*)(tile + p * 4096 + tid * 16), 16, 0, 0);
}
template <int BK>
__device__ __forceinline__ void rows_regular(const bf16_t* (&rp)[TileK<BK>::NP], const bf16_t* base, size_t ld, int tid) {
#pragma unroll
    for (int p = 0; p < TileK<BK>::NP; ++p) { const int r = (BK == 64) ? (p * 32 + (tid >> 3)) : (p * 64 + (tid >> 2)); rp[p] = base + (size_t)r * ld; }
}
template <int BK>
__device__ __forceinline__ int frag_off(int row, int ks, int fq) {
    return (BK == 64) ? (row * 128 + (((ks * 4 + fq) ^ (row & 7)) << 4)) : (row * 64 + ((fq ^ ((row >> 1) & 3)) << 4));
}

template <int BK, int NBOP, bool SWAP>
__device__ __forceinline__ void gemm_loop(const Ctx& c, const bf16_t* const (&ap)[TileK<BK>::NP], const bf16_t* const (&b0p)[TileK<BK>::NP], const bf16_t* const (&b1p)[TileK<BK>::NP],
                                          int K, f32x4 (&acc0)[4][4], f32x4 (&acc1)[4][4]) {
    constexpr int TB = TileK<BK>::TB, SB = (1 + NBOP) * TB;
    static_assert(2 * SB <= LDS_MAIN, "lds");
    const int nk = K / BK, tid = c.tid;
    const int fr = c.lane & 15, fq = c.lane >> 4, wr = c.wave >> 1, wc = c.wave & 1;
    LAS unsigned char* lds = c.lds;
    stage_tile<BK>(lds, ap, 0, tid); stage_tile<BK>(lds + TB, b0p, 0, tid);
    if (NBOP == 2) stage_tile<BK>(lds + 2 * TB, b1p, 0, tid);
    for (int kt = 0; kt < nk; ++kt) {
        VM_WAIT();
        __syncthreads();
        LAS unsigned char* cur = lds + (kt & 1) * SB;
        if (kt + 1 < nk) {
            LAS unsigned char* nxt = lds + ((kt + 1) & 1) * SB;
            stage_tile<BK>(nxt, ap, (kt + 1) * BK, tid); stage_tile<BK>(nxt + TB, b0p, (kt + 1) * BK, tid);
            if (NBOP == 2) stage_tile<BK>(nxt + 2 * TB, b1p, (kt + 1) * BK, tid);
        }
#pragma unroll
        for (int ks = 0; ks < BK / 32; ++ks) {
            bf16x8 af[4], bf0[4], bf1[4];
#pragma unroll
            for (int m = 0; m < 4; ++m) af[m] = *(const LAS bf16x8*)(cur + frag_off<BK>(wr * 64 + m * 16 + fr, ks, fq));
#pragma unroll
            for (int n = 0; n < 4; ++n) bf0[n] = *(const LAS bf16x8*)(cur + TB + frag_off<BK>(wc * 64 + n * 16 + fr, ks, fq));
            if (NBOP == 2) {
#pragma unroll
                for (int n = 0; n < 4; ++n) bf1[n] = *(const LAS bf16x8*)(cur + 2 * TB + frag_off<BK>(wc * 64 + n * 16 + fr, ks, fq));
            }
#pragma unroll
            for (int m = 0; m < 4; ++m)
#pragma unroll
                for (int n = 0; n < 4; ++n) {
                    if (SWAP) acc0[m][n] = __builtin_amdgcn_mfma_f32_16x16x32_bf16(bf0[n], af[m], acc0[m][n], 0, 0, 0);
                    else      acc0[m][n] = __builtin_amdgcn_mfma_f32_16x16x32_bf16(af[m], bf0[n], acc0[m][n], 0, 0, 0);
                    if (NBOP == 2) {
                        if (SWAP) acc1[m][n] = __builtin_amdgcn_mfma_f32_16x16x32_bf16(bf1[n], af[m], acc1[m][n], 0, 0, 0);
                        else      acc1[m][n] = __builtin_amdgcn_mfma_f32_16x16x32_bf16(af[m], bf1[n], acc1[m][n], 0, 0, 0);
                    }
                }
        }
    }
    __syncthreads();
}
__device__ __forceinline__ void zero_acc(f32x4 (&acc)[4][4]) {
#pragma unroll
    for (int m = 0; m < 4; ++m)
#pragma unroll
        for (int n = 0; n < 4; ++n) acc[m][n] = (f32x4){0.f, 0.f, 0.f, 0.f};
}
__device__ __forceinline__ void map_unit(int u, int nnt, int& mt, int& nt) { const int per = 8 * nnt, band = u / per, r = u - band * per; nt = r >> 3; mt = band * 8 + (r & 7); }


__device__ __forceinline__ float gelu_tanh(float x) {
    const float y2 = 1.5957691216057308f * (x + 0.044715f * x * x * x);
    return x / (1.f + __expf(-y2));
}
__device__ __forceinline__ float sigmoidf_(float x) { return 1.f / (1.f + __expf(-x)); }

__device__ __forceinline__ void row_load(const float* row, int lane, f32x4 (&v)[4]) {
#pragma unroll
    for (int j = 0; j < 4; ++j) v[j] = ((const f32x4*)row)[lane + 64 * j];
}
__device__ __forceinline__ float row_sumsq(const f32x4 (&v)[4]) {
    float s = 0.f;
#pragma unroll
    for (int j = 0; j < 4; ++j) s += (v[j].x * v[j].x + v[j].y * v[j].y) + (v[j].z * v[j].z + v[j].w * v[j].w);
    return wave_sum(s);
}
__device__ __forceinline__ void gain_load(const float* gain, int lane, f32x4 (&g)[4]) {
#pragma unroll
    for (int j = 0; j < 4; ++j) g[j] = ((const f32x4*)gain)[lane + 64 * j];
}
__device__ __forceinline__ void row_store_norm_bf16(bf16_t* orow, int lane, const f32x4 (&v)[4], float r, const f32x4 (&gv)[4]) {
#pragma unroll
    for (int j = 0; j < 4; ++j) {
        const f32x4 g = gv[j];
        u32x2 o; o.x = pk_bf16(v[j].x * r * g.x, v[j].y * r * g.y); o.y = pk_bf16(v[j].z * r * g.z, v[j].w * r * g.w);
        ((u32x2*)orow)[lane + 64 * j] = o;
    }
}

constexpr int TR_SCR = 64 * 136;
__device__ __forceinline__ void transpose_item(const float* W, int K, int N, int nvalid, int ldw, bf16_t* WT, LAS unsigned char* scr, int item, int lane) {
    const int nblk = N / 64, kb = item / nblk, nb = item - kb * nblk, k0 = 64 * kb, n0 = 64 * nb;
    const int n = n0 + 4 * (lane & 15);
    const int nc_ = (n < nvalid) ? n : 0; const float keep = (n < nvalid) ? 1.f : 0.f;
    f32x4 v[16];
#pragma unroll
    for (int i = 0; i < 16; ++i) v[i] = *(const f32x4*)(W + (size_t)(k0 + 4 * i + (lane >> 4)) * ldw + nc_);
#pragma unroll
    for (int i = 0; i < 16; ++i) {
        const int kk = 4 * i + (lane >> 4);
        u32x2 o; o.x = pk_bf16(v[i].x * keep, v[i].y * keep); o.y = pk_bf16(v[i].z * keep, v[i].w * keep);
        *(LAS u32x2*)(scr + kk * 136 + (lane & 15) * 8) = o;
    }
    LDS_WAIT();
    const int cc = lane & 7;
#pragma unroll
    for (int j = 0; j < 8; ++j) {
        const int nn = (lane >> 3) + 8 * j; const LAS unsigned short* sp = (const LAS unsigned short*)(scr + (8 * cc) * 136 + nn * 2);
        u32x4 o;
        o.x = (unsigned)sp[0 * 68] | ((unsigned)sp[1 * 68] << 16); o.y = (unsigned)sp[2 * 68] | ((unsigned)sp[3 * 68] << 16);
        o.z = (unsigned)sp[4 * 68] | ((unsigned)sp[5 * 68] << 16); o.w = (unsigned)sp[6 * 68] | ((unsigned)sp[7 * 68] << 16);
        *(u32x4*)(WT + (size_t)(n0 + nn) * K + k0 + 8 * cc) = o;
    }
    LDS_WAIT();
}
__device__ __forceinline__ void convert_moe_layer(const Ctx& c, int l) {
    LAS unsigned char* scr = c.lds + c.wave * TR_SCR;
    const int gw = c.vb * 4 + c.wave, ngw = c.nb * 4;
    const float* w1 = (const float*)c.a->in[IN_W1] + (size_t)l * NE * D * DE;
    const float* w3 = (const float*)c.a->in[IN_W3] + (size_t)l * NE * D * DE;
    const float* w2 = (const float*)c.a->in[IN_W2] + (size_t)l * NE * DE * D;
    bf16_t* W1 = (bf16_t*)(c.ws + WS_W1); bf16_t* W3 = (bf16_t*)(c.ws + WS_W3); bf16_t* W2 = (bf16_t*)(c.ws + WS_W2);
    for (int it = gw; it < NE * 384; it += ngw) {
        const int e = it / 384, r = it - e * 384;
        if (r < 128)      transpose_item(w1 + (size_t)e * D * DE, D, DE, DE, DE, W1 + (size_t)e * DE * D, scr, r, c.lane);
        else if (r < 256) transpose_item(w3 + (size_t)e * D * DE, D, DE, DE, DE, W3 + (size_t)e * DE * D, scr, r - 128, c.lane);
        else              transpose_item(w2 + (size_t)e * DE * D, DE, D, D, D, W2 + (size_t)e * D * DE, scr, r - 256, c.lane);
    }
}

__device__ __forceinline__ void phase_prep(const Ctx& c) {
    const __attribute__((address_space(4))) Args& a = *c.a;
    LAS unsigned char* scr = c.lds + c.wave * TR_SCR;
    const int gw = c.vb * 4 + c.wave, ngw = c.nb * 4;
    constexpr int I_AIN = 16 * 64, I_AOUT = 32 * 16, I_BIN = 16 * 34, I_BOUT = 16 * 16, I_PG = 16 * 16, I_PP = 4 * 16;
    constexpr int NIT = I_AIN + I_AOUT + I_BIN + I_BOUT + 2 * I_PG + 2 * I_PP;
    for (int it = gw; it < NIT; it += ngw) {
        int r = it;
        if (r < I_AIN) { transpose_item((const float*)a.in[IN_AWIN], D, 4096, 4096, 4096, (bf16_t*)(c.ws + WS_WAIN), scr, r, c.lane); continue; } r -= I_AIN;
        if (r < I_AOUT) { transpose_item((const float*)a.in[IN_AWOUT], GW, D, D, D, (bf16_t*)(c.ws + WS_WAOUT), scr, r, c.lane); continue; } r -= I_AOUT;
        if (r < I_BIN) { transpose_item((const float*)a.in[IN_BWIN], D, BINP, BIN, BIN, (bf16_t*)(c.ws + WS_WBIN), scr, r, c.lane); continue; } r -= I_BIN;
        if (r < I_BOUT) { transpose_item((const float*)a.in[IN_BWOUT], D, D, D, D, (bf16_t*)(c.ws + WS_WBOUT), scr, r, c.lane); continue; } r -= I_BOUT;
        if (r < 2 * I_PG) { const int l = r / I_PG; transpose_item((const float*)a.in[IN_PLEG] + (size_t)l * D * D, D, D, D, D, (bf16_t*)(c.ws + WS_WGATE) + (size_t)l * D * D, scr, r - l * I_PG, c.lane); continue; } r -= 2 * I_PG;
        { const int l = r / I_PP; transpose_item((const float*)a.in[IN_PLEP] + (size_t)l * PLE * D, PLE, D, D, D, (bf16_t*)(c.ws + WS_WPROJ) + (size_t)l * D * PLE, scr, r - l * I_PP, c.lane); }
    }
    convert_moe_layer(c, 0);
    const int gt = c.vb * NTH + c.tid, ngt = c.nb * NTH;
    { const float* p = (const float*)a.in[IN_P]; bf16_t* pb = (bf16_t*)(c.ws + WS_PBF);
      for (int i = gt; i < 2 * T * PLE / 8; i += ngt) {
          const f32x4 v0 = ((const f32x4*)p)[2 * i], v1 = ((const f32x4*)p)[2 * i + 1];
          u32x4 o; o.x = pk_bf16(v0.x, v0.y); o.y = pk_bf16(v0.z, v0.w); o.z = pk_bf16(v1.x, v1.y); o.w = pk_bf16(v1.z, v1.w);
          ((u32x4*)pb)[i] = o; } }
    { float* wr = (float*)(c.ws + WS_WR);
      for (int i = gt; i < 2 * D * 48; i += ngt) {
          const int l = i / (D * 48), r = i - l * D * 48, k = r / 48, o = r - k * 48;
          float w = 0.f;
          if (o < 4) w = ((const float*)a.in[IN_WG])[(size_t)l * D * 4 + k * 4 + o];
          else if (o < 36) w = ((const float*)a.in[IN_WE])[(size_t)l * D * 32 + k * 32 + (o - 4)];
          wr[i] = w * ((const float*)a.in[IN_FFNN])[l * D + k]; } }
    if (c.vb == 0 && c.tid < 128) ((int*)(c.ws + WS_CNT))[c.tid] = 0;
    f32x4 gv[4]; gain_load((const float*)a.in[IN_MIXN], c.lane, gv);
    for (int t = gw; t < T; t += ngw) {
        f32x4 v[4]; row_load((const float*)a.in[IN_X] + (size_t)t * D, c.lane, v);
        const float r = rsqrtf(row_sumsq(v) * (1.f / D) + EPS);
        row_store_norm_bf16((bf16_t*)(c.ws + WS_XN) + (size_t)t * D, c.lane, v, r, gv);
    }
}

__device__ __forceinline__ void phase_a1(const Ctx& c) {
    const bf16_t* XN = (const bf16_t*)(c.ws + WS_XN); const bf16_t* W = (const bf16_t*)(c.ws + WS_WAIN);
    bf16_t* U = (bf16_t*)(c.ws + WS_U); bf16_t* VT = (bf16_t*)(c.ws + WS_VT); float* VSS = (float*)(c.ws + WS_VSS);
    const int fr = c.lane & 15, fq = c.lane >> 4, wr = c.wave >> 1, wc = c.wave & 1;
    for (int u = c.vb; u < 128 * 32; u += c.nb) {
        int mt, nt; map_unit(u, 32, mt, nt);
        const bf16_t* ap[4]; const bf16_t* bp[4];
        rows_regular<64>(ap, XN + (size_t)mt * 128 * D, D, c.tid); rows_regular<64>(bp, W + (size_t)nt * 128 * D, D, c.tid);
        f32x4 acc[4][4]; zero_acc(acc);
        if (nt < 16) {
            gemm_loop<64, 1, true>(c, ap, bp, bp, D, acc, acc);
#pragma unroll
            for (int m = 0; m < 4; ++m)
#pragma unroll
                for (int n = 0; n < 4; ++n) {
                    const int t = mt * 128 + wr * 64 + m * 16 + fr, col = nt * 128 + wc * 64 + n * 16 + fq * 4;
                    const f32x4 v = acc[m][n];
                    u32x2 o; o.x = pk_bf16(gelu_tanh(v.x), gelu_tanh(v.y)); o.y = pk_bf16(gelu_tanh(v.z), gelu_tanh(v.w));
                    *(u32x2*)(U + (size_t)t * GW + col) = o;
                }
        } else {
            gemm_loop<64, 1, false>(c, ap, bp, bp, D, acc, acc);
            const int vn = nt - 16;
#pragma unroll
            for (int m = 0; m < 4; ++m) {
                f32x4 ss = {0.f, 0.f, 0.f, 0.f};
                const int t0 = mt * 128 + wr * 64 + m * 16 + fq * 4;
#pragma unroll
                for (int n = 0; n < 4; ++n) {
                    const int ch = vn * 128 + wc * 64 + n * 16 + fr;
                    f32x4 v = acc[m][n];
                    v.x = gelu_tanh(v.x); v.y = gelu_tanh(v.y); v.z = gelu_tanh(v.z); v.w = gelu_tanh(v.w);
                    ss += v * v;
                    u32x2 o; o.x = pk_bf16(v.x, v.y); o.y = pk_bf16(v.z, v.w);
                    *(u32x2*)(VT + (size_t)ch * T + t0) = o;
                }
#pragma unroll
                for (int o = 1; o < 16; o <<= 1) { ss.x += __shfl_xor(ss.x, o); ss.y += __shfl_xor(ss.y, o); ss.z += __shfl_xor(ss.z, o); ss.w += __shfl_xor(ss.w, o); }
                if (fr == 0) {
                    VSS[(size_t)(t0 + 0) * 32 + vn * 2 + wc] = ss.x; VSS[(size_t)(t0 + 1) * 32 + vn * 2 + wc] = ss.y;
                    VSS[(size_t)(t0 + 2) * 32 + vn * 2 + wc] = ss.z; VSS[(size_t)(t0 + 3) * 32 + vn * 2 + wc] = ss.w;
                }
            }
        }
    }
}

__device__ __forceinline__ void phase_a2(const Ctx& c, bool dry = false) {
    const __attribute__((address_space(4))) Args& a = *c.a;
    bf16_t* U = (bf16_t*)(c.ws + WS_U); const bf16_t* VT = (const bf16_t*)(c.ws + WS_VT); const float* VSS = (const float*)(c.ws + WS_VSS);
    const float* ws_ = (const float*)a.in[IN_AWS]; const float* bs_ = (const float*)a.in[IN_ABS]; const float* vg = (const float*)a.in[IN_AVG];
    const int fr = c.lane & 15, fq = c.lane >> 4, wr = c.wave >> 1, wc = c.wave & 1, tid = c.tid;
    LAS unsigned char* lds = c.lds;
    LAS float* rl = (LAS float*)(lds + LDS_MAIN);
    for (int u = c.vb; u < 128 * 8; u += c.nb) {
        const int ci = u >> 3, g = u & 7, tokbase = ci * 128;
        __syncthreads();
        if (tid < 128) {
            const float* p = VSS + (size_t)(tokbase + tid) * 32; float s = 0.f;
#pragma unroll
            for (int i = 0; i < 8; ++i) { const f32x4 q = ((const f32x4*)p)[i]; s += (q.x + q.y) + (q.z + q.w); }
            rl[tid] = rsqrtf(s * (1.f / GW) + EPS);
        }
        __syncthreads();
        {
            const int t = tid >> 1, half = tid & 1;
            const float* wrow = ws_ + ((size_t)g * 128 + t) * 128 + half * 64;
#pragma unroll
            for (int cc = 0; cc < 8; ++cc) {
                const int s0 = half * 64 + cc * 8;
                u32x4 o;
                {
                    const f32x4 w0 = ((const f32x4*)wrow)[2 * cc], w1 = ((const f32x4*)wrow)[2 * cc + 1];
                    float e[8] = {w0.x, w0.y, w0.z, w0.w, w1.x, w1.y, w1.z, w1.w};
#pragma unroll
                    for (int i = 0; i < 8; ++i) e[i] = (s0 + i <= t) ? e[i] * rl[s0 + i] : 0.f;
                    o.x = pk_bf16(e[0], e[1]); o.y = pk_bf16(e[2], e[3]); o.z = pk_bf16(e[4], e[5]); o.w = pk_bf16(e[6], e[7]);
                }
                *(LAS u32x4*)(lds + half * 16384 + t * 128 + ((cc ^ (t & 7)) << 4)) = o;
            }
        }
        for (int hn = 0; hn < 2; ++hn) {
            const int c0 = g * 256 + hn * 128;
            const bf16_t* bp[4]; rows_regular<64>(bp, VT + (size_t)c0 * T + tokbase, T, tid);
            stage_tile<64>(lds + 32768, bp, 0, tid); stage_tile<64>(lds + 32768 + 16384, bp, 64, tid);
            VM_WAIT();
            __syncthreads();
            f32x4 acc[4][4]; zero_acc(acc);
#pragma unroll 1
            for (int kh = 0; kh < 2; ++kh)
#pragma unroll 1
                for (int ks = 0; ks < 2; ++ks) {
                    bf16x8 af[4], bf[4];
#pragma unroll
                    for (int m = 0; m < 4; ++m) af[m] = *(const LAS bf16x8*)(lds + kh * 16384 + frag_off<64>(wr * 64 + m * 16 + fr, ks, fq));
#pragma unroll
                    for (int n = 0; n < 4; ++n) bf[n] = *(const LAS bf16x8*)(lds + 32768 + kh * 16384 + frag_off<64>(wc * 64 + n * 16 + fr, ks, fq));
#pragma unroll
                    for (int m = 0; m < 4; ++m)
#pragma unroll
                        for (int n = 0; n < 4; ++n) acc[m][n] = __builtin_amdgcn_mfma_f32_16x16x32_bf16(bf[n], af[m], acc[m][n], 0, 0, 0);
                }
            u32x2 uvv[4][4]; float bsvv[4];
#pragma unroll
            for (int m = 0; m < 4; ++m) { const int tl = wr * 64 + m * 16 + fr; bsvv[m] = bs_[g * 128 + tl];
#pragma unroll
                for (int n = 0; n < 4; ++n) uvv[m][n] = *(const u32x2*)(U + (size_t)(tokbase + tl) * GW + c0 + wc * 64 + n * 16 + fq * 4); }
#pragma unroll
            for (int m = 0; m < 4; ++m) {
                const int tl = wr * 64 + m * 16 + fr; const float bsv = bsvv[m];
#pragma unroll
                for (int n = 0; n < 4; ++n) {
                    const int ch = c0 + wc * 64 + n * 16 + fq * 4;
                    const f32x4 gn = *(const f32x4*)(vg + ch);
                    u32x2* up = (u32x2*)(U + (size_t)(tokbase + tl) * GW + ch);
                    const u32x2 uv = uvv[m][n]; const f32x4 v = acc[m][n];
                    u32x2 o;
                    o.x = pk_bf16(bf_lo(uv.x) * (gn.x * v.x + bsv), bf_hi(uv.x) * (gn.y * v.y + bsv));
                    o.y = pk_bf16(bf_lo(uv.y) * (gn.z * v.z + bsv), bf_hi(uv.y) * (gn.w * v.w + bsv));
                    if (dry) *(u32x2*)(c.ws + 440 * MB + ((size_t)(tokbase + tl) * GW + ch) * 2) = o; else *up = o;
                }
            }
            __syncthreads();
        }
    }
}

__device__ __forceinline__ void phase_a3(const Ctx& c) {
    const bf16_t* Z = (const bf16_t*)(c.ws + WS_U); const bf16_t* W = (const bf16_t*)(c.ws + WS_WAOUT);
    const float* X = (const float*)c.a->in[IN_X]; float* H = (float*)(c.ws + WS_H);
    const int fr = c.lane & 15, fq = c.lane >> 4, wr = c.wave >> 1, wc = c.wave & 1;
    for (int u = c.vb; u < 128 * 8; u += c.nb) {
        int mt, nt; map_unit(u, 8, mt, nt);
        const bf16_t* ap[4]; const bf16_t* bp[4];
        rows_regular<64>(ap, Z + (size_t)mt * 128 * GW, GW, c.tid); rows_regular<64>(bp, W + (size_t)nt * 128 * GW, GW, c.tid);
        f32x4 acc[4][4];
#pragma unroll
        for (int m = 0; m < 4; ++m)
#pragma unroll
            for (int n = 0; n < 4; ++n) acc[m][n] = *(const f32x4*)(X + (size_t)(mt * 128 + wr * 64 + m * 16 + fr) * D + nt * 128 + wc * 64 + n * 16 + fq * 4);
        gemm_loop<64, 1, true>(c, ap, bp, bp, GW, acc, acc);
#pragma unroll
        for (int m = 0; m < 4; ++m)
#pragma unroll
            for (int n = 0; n < 4; ++n) *(f32x4*)(H + (size_t)(mt * 128 + wr * 64 + m * 16 + fr) * D + nt * 128 + wc * 64 + n * 16 + fq * 4) = acc[m][n];
    }
}

__device__ __forceinline__ void phase_route(const Ctx& c, int l, bool dry = false) {
    const __attribute__((address_space(4))) Args& a = *c.a;
    const float* H = (const float*)(c.ws + WS_H); bf16_t* XN = (bf16_t*)(c.ws + (dry ? 440 * MB : WS_XN));
    const float* wr_ = (const float*)(c.ws + WS_WR) + (size_t)l * D * 48;
    const float* gain = (const float*)a.in[IN_FFNN] + l * D;
    int* cnt = (int*)(c.ws + WS_CNT) + l * 32 + (dry ? 64 : 0); int* list = (int*)(c.ws + (dry ? 480 * MB : WS_LIST)); float* gatel = (float*)(c.ws + (dry ? 484 * MB : WS_GATE)); int* tokslot = (int*)(c.ws + (dry ? 488 * MB : WS_TOKSLOT));
    LAS float* rl = (LAS float*)(c.lds);
    LAS float* lgl = (LAS float*)(c.lds + 256);
    const int lane = c.lane, w = c.wave;
    f32x4 gv[4]; gain_load(gain, lane, gv);
    for (int unit = c.vb; unit < T / 32; unit += c.nb) {
        const int tok0 = unit * 32;
        __syncthreads();
        for (int i = 0; i < 8; ++i) {
            const int t = tok0 + w * 8 + i;
            f32x4 v[4]; row_load(H + (size_t)t * D, lane, v);
            const float r = rsqrtf(row_sumsq(v) * (1.f / D) + EPS);
            if (lane == 0) rl[w * 8 + i] = r;
            row_store_norm_bf16(XN + (size_t)t * D, lane, v, r, gv);
        }
        {
            const int th = w & 1, kh = w >> 1, m = lane & 15, q = lane >> 4;
            const float* arow = H + (size_t)(tok0 + 16 * th + m) * D + 512 * kh + 128 * q;
            const float* brow = wr_ + (size_t)(512 * kh + 128 * q) * 48 + m;
            f32x4 acc[3]; acc[0] = acc[1] = acc[2] = (f32x4){0.f, 0.f, 0.f, 0.f};
            for (int i = 0; i < 32; ++i) {
                const f32x4 av = ((const f32x4*)arow)[i];
                const float ae[4] = {av.x, av.y, av.z, av.w};
#pragma unroll
                for (int e = 0; e < 4; ++e) {
                    const float* bp = brow + (size_t)(4 * i + e) * 48;
#pragma unroll
                    for (int nt = 0; nt < 3; ++nt) acc[nt] = __builtin_amdgcn_mfma_f32_16x16x4f32(ae[e], bp[nt * 16], acc[nt], 0, 0, 0);
                }
            }
#pragma unroll
            for (int nt = 0; nt < 3; ++nt)
#pragma unroll
                for (int j = 0; j < 4; ++j) lgl[(kh * 32 + th * 16 + 4 * q + j) * 48 + nt * 16 + m] = acc[nt][j];
        }
        __syncthreads();
        if (c.tid < 32) {
            const int tt = c.tid, t = tok0 + tt; const float r = rl[tt];
            const float* bg = (const float*)a.in[IN_BG] + l * 4; const float* be = (const float*)a.in[IN_BE] + l * 32;
            float gl[4];
#pragma unroll
            for (int o = 0; o < 4; ++o) gl[o] = (lgl[tt * 48 + o] + lgl[(32 + tt) * 48 + o]) * r + bg[o];
            int gs = 0; float gm = gl[0];
#pragma unroll
            for (int o = 1; o < 4; ++o) if (gl[o] > gm) { gm = gl[o]; gs = o; }
            float gden = 0.f;
#pragma unroll
            for (int o = 0; o < 4; ++o) gden += __expf(gl[o] - gm);
            const float pg = 1.f / gden;
            float l1 = -INFINITY, l2 = -INFINITY; int i1 = 0, i2 = 0;
            for (int i = 0; i < 8; ++i) {
                const int o = 4 + gs * 8 + i;
                const float v = (lgl[tt * 48 + o] + lgl[(32 + tt) * 48 + o]) * r + be[gs * 8 + i];
                if (v > l1) { l2 = l1; i2 = i1; l1 = v; i1 = i; } else if (v > l2) { l2 = v; i2 = i; }
            }
            const float e2 = __expf(l2 - l1), inv = 1.f / (1.f + e2);
            const float g1 = pg * inv, g2 = pg * e2 * inv;
            const int ea = gs * 8 + i1, eb = gs * 8 + i2;
            const int sa = atomicAdd(&cnt[ea], 1), sb = atomicAdd(&cnt[eb], 1);
            list[ea * T + sa] = t; gatel[ea * T + sa] = g1; tokslot[2 * t] = (ea << 16) | sa;
            list[eb * T + sb] = t; gatel[eb * T + sb] = g2; tokslot[2 * t + 1] = (eb << 16) | sb;
        }
    }
}

__device__ __forceinline__ void moe_table(const Ctx& c, int l, LAS int* pst, LAS int* cn) {
    __syncthreads();
    if (c.tid == 0) {
        const int* cnt = (const int*)(c.ws + WS_CNT) + l * 32; int acc = 0;
        for (int e = 0; e < 32; ++e) { const int n = cnt[e]; cn[e] = n; pst[e] = acc; acc += (n + 127) >> 7; }
        pst[32] = acc;
    }
    __syncthreads();
}
__device__ __forceinline__ int moe_find(LAS const int* pst, int mb) { int e = 0; for (int i = 1; i < 32; ++i) e = (pst[i] <= mb) ? i : e; return e; }

__device__ __forceinline__ void phase_e1(const Ctx& c, int l) {
    const bf16_t* XN = (const bf16_t*)(c.ws + WS_XN); const bf16_t* W1 = (const bf16_t*)(c.ws + WS_W1); const bf16_t* W3 = (const bf16_t*)(c.ws + WS_W3);
    bf16_t* HM = (bf16_t*)(c.ws + WS_HMID); const int* list = (const int*)(c.ws + WS_LIST);
    LAS int* pst = (LAS int*)(c.lds + LDS_MAIN); LAS int* cn = pst + 40;
    moe_table(c, l, pst, cn);
    const int fr = c.lane & 15, fq = c.lane >> 4, wr = c.wave >> 1, wc = c.wave & 1, tid = c.tid;
    const int nunits = pst[32] * 8;
    for (int u = c.vb; u < nunits; u += c.nb) {
        const int mb = u >> 3, h0 = (u & 7) * 64, e = moe_find(pst, mb), row0 = (mb - pst[e]) * 128, count = cn[e];
        const bf16_t* ap[4]; const bf16_t* bp[4];
#pragma unroll
        for (int p = 0; p < 4; ++p) {
            int r = row0 + p * 32 + (tid >> 3); r = r < count ? r : row0; ap[p] = XN + (size_t)list[e * T + r] * D;
            const int rb = p * 32 + (tid >> 3), hid = h0 + (rb >> 6) * 32 + ((rb >> 4) & 1) * 16 + (rb & 15);
            bp[p] = (((rb >> 5) & 1) ? W3 : W1) + ((size_t)e * DE + hid) * D;
        }
        f32x4 acc[4][4]; zero_acc(acc);
        gemm_loop<64, 1, true>(c, ap, bp, bp, D, acc, acc);
#pragma unroll
        for (int m = 0; m < 4; ++m)
#pragma unroll
            for (int n = 0; n < 2; ++n) {
                const size_t row = (size_t)mb * 128 + wr * 64 + m * 16 + fr; const int col = h0 + wc * 32 + n * 16 + fq * 4;
                const f32x4 x = acc[m][n], y = acc[m][n + 2];
                u32x2 o; o.x = pk_bf16(x.x * sigmoidf_(x.x) * y.x, x.y * sigmoidf_(x.y) * y.y); o.y = pk_bf16(x.z * sigmoidf_(x.z) * y.z, x.w * sigmoidf_(x.w) * y.w);
                *(u32x2*)(HM + row * DE + col) = o;
            }
    }
}
__device__ __forceinline__ void phase_e2(const Ctx& c, int l) {
    const bf16_t* HM = (const bf16_t*)(c.ws + WS_HMID); const bf16_t* W2 = (const bf16_t*)(c.ws + WS_W2);
    bf16_t* Y = (bf16_t*)(c.ws + WS_Y); const float* gatel = (const float*)(c.ws + WS_GATE);
    LAS int* pst = (LAS int*)(c.lds + LDS_MAIN); LAS int* cn = pst + 40;
    moe_table(c, l, pst, cn);
    const int fr = c.lane & 15, fq = c.lane >> 4, wr = c.wave >> 1, wc = c.wave & 1, tid = c.tid;
    const int nunits = pst[32] * 8;
    for (int u = c.vb; u < nunits; u += c.nb) {
        const int mb = u >> 3, nt = u & 7, e = moe_find(pst, mb), row0 = (mb - pst[e]) * 128, count = cn[e];
        const bf16_t* ap[4]; const bf16_t* bp[4];
        rows_regular<64>(ap, HM + (size_t)mb * 128 * DE, DE, tid); rows_regular<64>(bp, W2 + ((size_t)e * D + nt * 128) * DE, DE, tid);
        f32x4 acc[4][4]; zero_acc(acc);
        gemm_loop<64, 1, true>(c, ap, bp, bp, DE, acc, acc);
        float gtv[4];
#pragma unroll
        for (int m = 0; m < 4; ++m) { const int rl_ = wr * 64 + m * 16 + fr; gtv[m] = (row0 + rl_ < count) ? gatel[e * T + row0 + rl_] : 0.f; }
#pragma unroll
        for (int m = 0; m < 4; ++m) {
            const int rl_ = wr * 64 + m * 16 + fr; const float gt = gtv[m];
#pragma unroll
            for (int n = 0; n < 4; ++n) {
                const f32x4 v = acc[m][n] * gt;
                u32x2 o; o.x = pk_bf16(v.x, v.y); o.y = pk_bf16(v.z, v.w);
                *(u32x2*)(Y + ((size_t)mb * 128 + rl_) * D + nt * 128 + wc * 64 + n * 16 + fq * 4) = o;
            }
        }
    }
}
__device__ __forceinline__ void phase_p1(const Ctx& c, int l, bool dry = false) {
    float* H = (float*)(c.ws + WS_H); float* HO = (float*)(c.ws + (dry ? 440 * MB : WS_H)); bf16_t* XN = (bf16_t*)(c.ws + (dry ? 440 * MB : WS_XN)); const bf16_t* Y = (const bf16_t*)(c.ws + WS_Y);
    const int* tokslot = (const int*)(c.ws + WS_TOKSLOT); const float* gain = (const float*)c.a->in[IN_PLEN] + l * D;
    LAS int* pst = (LAS int*)(c.lds + LDS_MAIN); LAS int* cn = pst + 40;
    moe_table(c, l, pst, cn);
    const int gw = c.vb * 4 + c.wave, ngw = c.nb * 4, lane = c.lane;
    f32x4 gv[4]; gain_load(gain, lane, gv);
    for (int t = gw; t < T; t += ngw) {
        const int s0 = tokslot[2 * t], s1 = tokslot[2 * t + 1];
        const bf16_t* y0 = Y + ((size_t)pst[s0 >> 16] * 128 + (s0 & 0xffff)) * D; const bf16_t* y1 = Y + ((size_t)pst[s1 >> 16] * 128 + (s1 & 0xffff)) * D;
        f32x4 v[4]; row_load(H + (size_t)t * D, lane, v);
#pragma unroll
        for (int j = 0; j < 4; ++j) {
            const u32x2 a0 = ((const u32x2*)y0)[lane + 64 * j], a1 = ((const u32x2*)y1)[lane + 64 * j];
            v[j].x += bf_lo(a0.x) + bf_lo(a1.x); v[j].y += bf_hi(a0.x) + bf_hi(a1.x); v[j].z += bf_lo(a0.y) + bf_lo(a1.y); v[j].w += bf_hi(a0.y) + bf_hi(a1.y);
            ((f32x4*)(HO + (size_t)t * D))[lane + 64 * j] = v[j];
        }
        const float r = rsqrtf(row_sumsq(v) * (1.f / D) + EPS);
        row_store_norm_bf16(XN + (size_t)t * D, lane, v, r, gv);
    }
}
__device__ __forceinline__ void phase_p2(const Ctx& c, int l) {
    const bf16_t* XN = (const bf16_t*)(c.ws + WS_XN); const bf16_t* WG = (const bf16_t*)(c.ws + WS_WGATE) + (size_t)l * D * D;
    const bf16_t* PB = (const bf16_t*)(c.ws + WS_PBF) + (size_t)l * T * PLE; const bf16_t* WP = (const bf16_t*)(c.ws + WS_WPROJ) + (size_t)l * D * PLE;
    float* H = (float*)(c.ws + WS_H);
    const int fr = c.lane & 15, fq = c.lane >> 4, wr = c.wave >> 1, wc = c.wave & 1;
    for (int u = c.vb; u < 128 * 8; u += c.nb) {
        int mt, nt; map_unit(u, 8, mt, nt);
        const bf16_t* ap[4]; const bf16_t* bp[4];
        f32x4 ag[4][4], apj[4][4]; zero_acc(ag); zero_acc(apj);
        rows_regular<64>(ap, XN + (size_t)mt * 128 * D, D, c.tid); rows_regular<64>(bp, WG + (size_t)nt * 128 * D, D, c.tid);
        gemm_loop<64, 1, true>(c, ap, bp, bp, D, ag, ag);
        rows_regular<64>(ap, PB + (size_t)mt * 128 * PLE, PLE, c.tid); rows_regular<64>(bp, WP + (size_t)nt * 128 * PLE, PLE, c.tid);
        gemm_loop<64, 1, true>(c, ap, bp, bp, PLE, apj, apj);
        f32x4 hres[4][4];
#pragma unroll
        for (int m = 0; m < 4; ++m)
#pragma unroll
            for (int n = 0; n < 4; ++n) hres[m][n] = *(const f32x4*)(H + (size_t)(mt * 128 + wr * 64 + m * 16 + fr) * D + nt * 128 + wc * 64 + n * 16 + fq * 4);
#pragma unroll
        for (int m = 0; m < 4; ++m)
#pragma unroll
            for (int n = 0; n < 4; ++n) {
                const size_t off = (size_t)(mt * 128 + wr * 64 + m * 16 + fr) * D + nt * 128 + wc * 64 + n * 16 + fq * 4;
                const f32x4 g = ag[m][n], pj = apj[m][n]; f32x4 h = hres[m][n];
                h.x += sigmoidf_(g.x) * pj.x; h.y += sigmoidf_(g.y) * pj.y; h.z += sigmoidf_(g.z) * pj.z; h.w += sigmoidf_(g.w) * pj.w;
                *(f32x4*)(H + off) = h;
            }
    }
}
__device__ __forceinline__ void phase_norm_bf16(const Ctx& c, const float* gain) {
    const float* H = (const float*)(c.ws + WS_H); bf16_t* XN = (bf16_t*)(c.ws + WS_XN);
    const int gw = c.vb * 4 + c.wave, ngw = c.nb * 4;
    f32x4 gv[4]; gain_load(gain, c.lane, gv);
    for (int t = gw; t < T; t += ngw) {
        f32x4 v[4]; row_load(H + (size_t)t * D, c.lane, v);
        const float r = rsqrtf(row_sumsq(v) * (1.f / D) + EPS);
        row_store_norm_bf16(XN + (size_t)t * D, c.lane, v, r, gv);
    }
}
__device__ __forceinline__ void phase_final(const Ctx& c) {
    const float* H = (const float*)(c.ws + WS_H); float* O = c.a->out; const float* gain = (const float*)c.a->in[IN_FINN];
    const int gw = c.vb * 4 + c.wave, ngw = c.nb * 4;
    f32x4 gv[4]; gain_load(gain, c.lane, gv);
    for (int t = gw; t < T; t += ngw) {
        f32x4 v[4]; row_load(H + (size_t)t * D, c.lane, v);
        const float r = rsqrtf(row_sumsq(v) * (1.f / D) + EPS);
#pragma unroll
        for (int j = 0; j < 4; ++j) ((f32x4*)(O + (size_t)t * D))[c.lane + 64 * j] = v[j] * r * gv[j];
    }
}

__device__ __forceinline__ void phase_b1(const Ctx& c, size_t raw_off = WS_RAW) {
    const bf16_t* XN = (const bf16_t*)(c.ws + WS_XN); const bf16_t* W = (const bf16_t*)(c.ws + WS_WBIN); bf16_t* RAW = (bf16_t*)(c.ws + raw_off);
    const int fr = c.lane & 15, fq = c.lane >> 4, wr = c.wave >> 1, wc = c.wave & 1;
    for (int u = c.vb; u < 128 * 17; u += c.nb) {
        int mt, nt; map_unit(u, 17, mt, nt);
        const bf16_t* ap[4]; const bf16_t* bp[4];
        rows_regular<64>(ap, XN + (size_t)mt * 128 * D, D, c.tid); rows_regular<64>(bp, W + (size_t)nt * 128 * D, D, c.tid);
        f32x4 acc[4][4]; zero_acc(acc);
        gemm_loop<64, 1, true>(c, ap, bp, bp, D, acc, acc);
#pragma unroll
        for (int m = 0; m < 4; ++m)
#pragma unroll
            for (int n = 0; n < 4; ++n) {
                const f32x4 v = acc[m][n]; u32x2 o; o.x = pk_bf16(v.x, v.y); o.y = pk_bf16(v.z, v.w);
                *(u32x2*)(RAW + (size_t)(mt * 128 + wr * 64 + m * 16 + fr) * BINP + nt * 128 + wc * 64 + n * 16 + fq * 4) = o;
            }
    }
}

__device__ __forceinline__ void unpack8(const u32x4 r, float (&e)[8]) { e[0] = bf_lo(r.x); e[1] = bf_hi(r.x); e[2] = bf_lo(r.y); e[3] = bf_hi(r.y); e[4] = bf_lo(r.z); e[5] = bf_hi(r.z); e[6] = bf_lo(r.w); e[7] = bf_hi(r.w); }
__device__ __forceinline__ u32x4 pack8(const float (&e)[8]) { u32x4 o; o.x = pk_bf16(e[0], e[1]); o.y = pk_bf16(e[2], e[3]); o.z = pk_bf16(e[4], e[5]); o.w = pk_bf16(e[6], e[7]); return o; }
__device__ __forceinline__ void phase_rope(const Ctx& c) {
    const bf16_t* RAW = (const bf16_t*)(c.ws + WS_RAW);
    bf16_t* Q = (bf16_t*)(c.ws + WS_Q); bf16_t* K = (bf16_t*)(c.ws + WS_K); bf16_t* V = (bf16_t*)(c.ws + WS_V);
    bf16_t* QI = (bf16_t*)(c.ws + WS_QI); bf16_t* KI = (bf16_t*)(c.ws + WS_KI); float* WI = (float*)(c.ws + WS_WI);
    const int* pos = (const int*)c.a->in[IN_POS];
    LAS float* cs = (LAS float*)(c.lds + c.wave * 256);
    const int gw = c.vb * 4 + c.wave, ngw = c.nb * 4, lane = c.lane;
    for (int t = gw; t < T; t += ngw) {
        if (lane < 24) {
            const double ex = (lane < 16) ? (double)lane * (1.0 / 16.0) : (double)(lane - 16) * (1.0 / 8.0);
            const float invf = (float)exp2(-ex * 18.931568569324174);
            const float ang = (float)pos[t] * invf;
            const double ad = (double)ang; const double n = rint(ad * 0.15915494309189535); const float red = (float)(ad - n * 6.283185307179586);
            cs[lane] = cosf(red); cs[32 + lane] = sinf(red);
        }
        LDS_WAIT();
        const bf16_t* row = RAW + (size_t)t * BINP;
        for (int ch = lane; ch < BINP / 8; ch += 64) {
            const u32x4 own = ((const u32x4*)row)[ch];
            float e[8]; unpack8(own, e);
            if (ch < 160) {
                const int cc = ch & 15;
                if (cc < 4) {
                    const u32x4 oth = ((const u32x4*)row)[ch ^ 2]; float p[8]; unpack8(oth, p);
                    const int f0 = (cc & 1) * 8;
#pragma unroll
                    for (int i = 0; i < 8; ++i) { const float co = cs[f0 + i], si = cs[32 + f0 + i]; e[i] = (cc < 2) ? (e[i] * co - p[i] * si) : (e[i] * co + p[i] * si); }
                }
                if (ch < 128) {
#pragma unroll
                    for (int i = 0; i < 8; ++i) e[i] *= 0.08838834764831845f;
                    ((u32x4*)(Q + (size_t)t * D))[ch] = pack8(e);
                } else ((u32x4*)(K + (size_t)t * 256))[ch - 128] = pack8(e);
            } else if (ch < 192) {
                ((u32x4*)(V + (size_t)t * 256))[ch - 160] = own;
            } else if (ch < 264) {
                const int cc = ch & 7;
                if (cc < 2) {
                    const u32x4 oth = ((const u32x4*)row)[ch ^ 1]; float p[8]; unpack8(oth, p);
#pragma unroll
                    for (int i = 0; i < 8; ++i) { const float co = cs[16 + i], si = cs[32 + 16 + i]; e[i] = (cc == 0) ? (e[i] * co - p[i] * si) : (e[i] * co + p[i] * si); }
                }
                if (ch < 256) ((u32x4*)(QI + (size_t)t * 512))[ch - 192] = pack8(e);
                else ((u32x4*)(KI + (size_t)t * 64))[ch - 256] = pack8(e);
            } else if (ch == 264) {
                f32x4 w0 = {e[0], e[1], e[2], e[3]}, w1 = {e[4], e[5], e[6], e[7]};
                const float sc = 0.044194173824159216f;
                ((f32x4*)(WI + (size_t)t * 8))[0] = w0 * sc; ((f32x4*)(WI + (size_t)t * 8))[1] = w1 * sc;
            }
        }
        LDS_WAIT();
    }
}

__device__ __forceinline__ size_t srow_off(int t) { const int m = t >> 6, r = t & 63; return (size_t)64 * (m + 1) * (32 * m + r); }
constexpr size_t S_BATCH = (size_t)64 * 65 * 2048;
constexpr int SCORE_UNITS = 4 * 312;
__device__ __forceinline__ void phase_score(const Ctx& c) {
    const bf16_t* QI = (const bf16_t*)(c.ws + WS_QI); const bf16_t* KI = (const bf16_t*)(c.ws + WS_KI); const float* WI = (const float*)(c.ws + WS_WI);
    float* S = (float*)(c.ws + WS_S);
    const int lane = c.lane, hf = lane >> 5, col = lane & 31, w = c.wave;
    for (int u = c.vb; u < SCORE_UNITS; u += c.nb) {
        const int b = u & 3, r = u >> 2;
        int kc, qb;
        if (r < 120) { kc = 0; qb = 8 + r; } else if (r < 216) { kc = 1; qb = 32 + (r - 120); } else if (r < 280) { kc = 2; qb = 64 + (r - 216); } else { kc = 3; qb = 96 + (r - 280); }
        const int tb = b * SEQ, t0 = 32 * qb + 8 * w;
        bf16x8 af[2][4]; f32x4 wv[2][4];
        { const int rho = lane & 31, ql = 2 * ((rho >> 2) & 1) + (rho >> 4), hd = 4 * ((rho >> 3) & 1) + (rho & 3);
#pragma unroll
          for (int a = 0; a < 2; ++a) {
              const bf16_t* qp = QI + (size_t)(tb + t0 + 4 * a + ql) * 512 + hd * 64 + 8 * hf;
#pragma unroll
              for (int ks = 0; ks < 4; ++ks) af[a][ks] = *(const bf16x8*)(qp + 16 * ks);
              const float* wp = WI + (size_t)(tb + t0 + 4 * a + 2 * hf) * 8;
#pragma unroll
              for (int i = 0; i < 4; ++i) wv[a][i] = ((const f32x4*)wp)[i];
          } }
        const int ntile = min(32, qb + 1 - 32 * kc), key0 = 1024 * kc;
        float* Sb = S + (size_t)b * S_BATCH;
        size_t ro[2][2];
#pragma unroll
        for (int a = 0; a < 2; ++a) { ro[a][0] = srow_off(t0 + 4 * a + 2 * hf); ro[a][1] = srow_off(t0 + 4 * a + 2 * hf + 1); }
        const int nsub = (ntile + 3) >> 2;
        const bf16_t* krp[4];
        rows_regular<64>(krp, KI + (size_t)(tb + key0) * 64, 64, c.tid);
        __syncthreads();
        stage_tile<64>(c.lds, krp, 0, c.tid);
        for (int sc = 0; sc < nsub; ++sc) {
            VM_WAIT();
            __syncthreads();
            const LAS unsigned char* cur = c.lds + (sc & 1) * 16384;
            if (sc + 1 < nsub) stage_tile<64>(c.lds + ((sc + 1) & 1) * 16384, krp, (sc + 1) * 128 * 64, c.tid);
#pragma unroll
            for (int j = 0; j < 4; ++j) {
                const int kt = 4 * sc + j;
                if (kt < ntile) {
                    const int key = key0 + 32 * kt + col, row = 32 * j + col;
                    bf16x8 cb[4];
#pragma unroll
                    for (int ks = 0; ks < 4; ++ks) cb[ks] = *(const LAS bf16x8*)(cur + row * 128 + (((2 * ks + hf) ^ (row & 7)) << 4));
#pragma unroll
                    for (int a = 0; a < 2; ++a) {
                        f32x16 acc = {};
#pragma unroll
                        for (int ks = 0; ks < 4; ++ks) acc = __builtin_amdgcn_mfma_f32_32x32x16_bf16(af[a][ks], cb[ks], acc, 0, 0, 0);
                        float s0 = fmaxf(acc[0], 0.f) * wv[a][0].x; s0 += fmaxf(acc[1], 0.f) * wv[a][0].y; s0 += fmaxf(acc[2], 0.f) * wv[a][0].z; s0 += fmaxf(acc[3], 0.f) * wv[a][0].w;
                        s0 += fmaxf(acc[4], 0.f) * wv[a][1].x; s0 += fmaxf(acc[5], 0.f) * wv[a][1].y; s0 += fmaxf(acc[6], 0.f) * wv[a][1].z; s0 += fmaxf(acc[7], 0.f) * wv[a][1].w;
                        float s1 = fmaxf(acc[8], 0.f) * wv[a][2].x; s1 += fmaxf(acc[9], 0.f) * wv[a][2].y; s1 += fmaxf(acc[10], 0.f) * wv[a][2].z; s1 += fmaxf(acc[11], 0.f) * wv[a][2].w;
                        s1 += fmaxf(acc[12], 0.f) * wv[a][3].x; s1 += fmaxf(acc[13], 0.f) * wv[a][3].y; s1 += fmaxf(acc[14], 0.f) * wv[a][3].z; s1 += fmaxf(acc[15], 0.f) * wv[a][3].w;
                        const int tA = t0 + 4 * a + 2 * hf;
                        Sb[ro[a][0] + key] = (key <= tA) ? s0 : -INFINITY;
                        Sb[ro[a][1] + key] = (key <= tA + 1) ? s1 : -INFINITY;
                    }
                }
            }
        }
    }
}

constexpr int NBINS = 2048, CAND_CAP = 256, SEL_WAVE_LDS = 8192 + 2048 + 64;
__device__ __forceinline__ void phase_select(const Ctx& c) {
    const float* S = (const float*)(c.ws + WS_S); int* SEL = (int*)(c.ws + WS_SEL);
    LAS int* hist = (LAS int*)(c.lds + c.wave * SEL_WAVE_LDS);
    LAS float* candv = (LAS float*)(hist + NBINS);
    LAS int* candi = (LAS int*)(candv + CAND_CAP);
    LAS int* thr = candi + CAND_CAP;
    const int gw = c.vb * 4 + c.wave, ngw = c.nb * 4;
    for (int j = gw; j < 4 * 3840; j += ngw) {
        int lane = c.lane;
        asm volatile("" : "+v"(lane));
        const int b = j & 3, t = 4095 - (j >> 2), ni = (t + 64) >> 6;
        const float* row = S + (size_t)b * S_BATCH + srow_off(t);
        float s[64];
#pragma unroll
        for (int g4 = 0; g4 < 4; ++g4) {
            if (16 * g4 < ni) {
#pragma unroll
                for (int i = 16 * g4; i < 16 * g4 + 16; ++i) { const int k = 64 * i + lane; const float v = row[min(k, t)]; s[i] = (k <= t) ? v : -INFINITY; }
            } else {
#pragma unroll
                for (int i = 16 * g4; i < 16 * g4 + 16; ++i) s[i] = -INFINITY;
            }
        }
        asm volatile("" : "+v"(lane));
        float mn = INFINITY, mx = -INFINITY;
#pragma unroll
        for (int i = 0; i < 64; ++i) { mx = fmaxf(mx, s[i]); mn = fminf(mn, (s[i] == -INFINITY) ? INFINITY : s[i]); }
#pragma unroll
        for (int o = 1; o < 64; o <<= 1) { mx = fmaxf(mx, __shfl_xor(mx, o)); mn = fminf(mn, __shfl_xor(mn, o)); }
        const float sc = (mx > mn) ? (float)NBINS / (mx - mn) : 0.f;
#pragma unroll
        for (int i = 0; i < 8; ++i) ((LAS u32x4*)hist)[lane * 8 + i] = (u32x4){0u, 0u, 0u, 0u};
        LDS_WAIT();
#define BINOF(v) min(NBINS - 1, (int)(((v) - mn) * sc))
#pragma unroll
        for (int i = 0; i < 64; ++i) if ((i & ~7) < ni && s[i] != -INFINITY) lds_inc(&hist[BINOF(s[i])]);
        LDS_WAIT();
        int bs, need;
        {
            const LAS int* hq = hist + lane * 32;
            int loc = 0;
#pragma unroll
            for (int i = 0; i < 8; ++i) { const u32x4 h4 = ((const LAS u32x4*)hq)[i]; loc += (int)(h4.x + h4.y + h4.z + h4.w); }
            int suf = loc;
#pragma unroll
            for (int o = 1; o < 64; o <<= 1) { const int v = __shfl_down(suf, o); if (lane + o < 64) suf += v; }
            const int above = suf - loc;
            const bool cross = (above < 256 && suf >= 256);
            int bsl = 0, abl = 0;
            if (cross) { int run = above; for (int i = 31; i >= 0; --i) { const int h = hq[i]; if (run < 256 && run + h >= 256) { bsl = lane * 32 + i; abl = run; } run += h; } }
            const unsigned long long cm = __ballot(cross);
            const int src = cm ? (int)__builtin_ctzll(cm) : 0;
            bs = __shfl(bsl, src); need = 256 - __shfl(abl, src);
        }
        int bs2 = -1;
        if (__shfl(hist[bs], 0) > 32) {
#pragma unroll
            for (int i = 0; i < 8; ++i) ((LAS u32x4*)hist)[lane * 8 + i] = (u32x4){0u, 0u, 0u, 0u};
            LDS_WAIT();
#define SUBOF(v) min(NBINS - 1, (int)((((v) - mn) * sc - (float)bs) * (float)NBINS))
#pragma unroll
            for (int i = 0; i < 64; ++i) if ((i & ~7) < ni && s[i] != -INFINITY && BINOF(s[i]) == bs) lds_inc(&hist[SUBOF(s[i])]);
            LDS_WAIT();
            const LAS int* hq = hist + lane * 32;
            int loc = 0;
#pragma unroll
            for (int i = 0; i < 8; ++i) { const u32x4 h4 = ((const LAS u32x4*)hq)[i]; loc += (int)(h4.x + h4.y + h4.z + h4.w); }
            int suf = loc;
#pragma unroll
            for (int o = 1; o < 64; o <<= 1) { const int v = __shfl_down(suf, o); if (lane + o < 64) suf += v; }
            const int above = suf - loc;
            const bool cross = (above < need && suf >= need);
            int bsl = 0, abl = 0;
            if (cross) { int run = above; for (int i = 31; i >= 0; --i) { const int h = hq[i]; if (run < need && run + h >= need) { bsl = lane * 32 + i; abl = run; } run += h; } }
            const unsigned long long cm = __ballot(cross);
            const int src = cm ? (int)__builtin_ctzll(cm) : 0;
            bs2 = __shfl(bsl, src); need = need - __shfl(abl, src);
        }
        asm volatile("" : "+v"(lane));
        int nc = 0;
#pragma unroll
        for (int i = 0; i < 64; ++i) if ((i & ~7) < ni) {
            bool p = (s[i] != -INFINITY) && (BINOF(s[i]) == bs);
            if (bs2 >= 0) p = p && (SUBOF(s[i]) == bs2);
            const unsigned long long m = __ballot(p);
            const int pos = nc + (int)__builtin_amdgcn_mbcnt_hi((unsigned)(m >> 32), __builtin_amdgcn_mbcnt_lo((unsigned)m, 0u));
            if (p && pos < CAND_CAP) { candv[pos] = s[i]; candi[pos] = 64 * i + lane; }
            nc += (int)__popcll(m);
        }
        nc = min(nc, CAND_CAP);
        LDS_WAIT();
        for (int i = lane; i < nc; i += 64) {
            const float v = candv[i]; const int id = candi[i];
            int rank = 0;
            for (int k = 0; k < nc; ++k) { const float vk = candv[k]; const int ik = candi[k]; rank += (vk > v || (vk == v && ik < id)) ? 1 : 0; }
            if (rank == need - 1) { thr[0] = __float_as_int(v); thr[1] = id; }
        }
        LDS_WAIT();
        const float tv = __int_as_float(thr[0]); const int ti = thr[1];
        asm volatile("" : "+v"(lane));
        int* selr = SEL + ((size_t)b * SEQ + t) * 256;
        int base = 0;
#pragma unroll
        for (int i = 0; i < 64; ++i) if ((i & ~7) < ni) {
            const int key = 64 * i + lane;
            const bool p = (s[i] > tv) || (s[i] == tv && key <= ti);
            const unsigned long long m = __ballot(p);
            const int pos = base + (int)__builtin_amdgcn_mbcnt_hi((unsigned)(m >> 32), __builtin_amdgcn_mbcnt_lo((unsigned)m, 0u));
            if (p && pos < 256) selr[pos] = key;
            base += (int)__popcll(m);
        }
        LDS_WAIT();
#undef BINOF
#undef SUBOF
    }
}

typedef short s16x4 __attribute__((ext_vector_type(4)));
__device__ __forceinline__ unsigned vimg_f(unsigned r) { return ((r & 3u) << 2) | ((r >> 2) & 3u); }
__device__ __forceinline__ void tr_read8(const unsigned (&ad)[8], s16x4 (&r)[8]) {
    asm volatile("ds_read_b64_tr_b16 %0, %8\n\tds_read_b64_tr_b16 %1, %9\n\tds_read_b64_tr_b16 %2, %10\n\tds_read_b64_tr_b16 %3, %11\n\t"
                 "ds_read_b64_tr_b16 %4, %12\n\tds_read_b64_tr_b16 %5, %13\n\tds_read_b64_tr_b16 %6, %14\n\tds_read_b64_tr_b16 %7, %15\n\ts_waitcnt lgkmcnt(0)"
                 : "=&v"(r[0]), "=&v"(r[1]), "=&v"(r[2]), "=&v"(r[3]), "=&v"(r[4]), "=&v"(r[5]), "=&v"(r[6]), "=&v"(r[7])
                 : "v"(ad[0]), "v"(ad[1]), "v"(ad[2]), "v"(ad[3]), "v"(ad[4]), "v"(ad[5]), "v"(ad[6]), "v"(ad[7]) : "memory");
}
constexpr int ATT_WAVE_LDS = 19456;
__device__ __forceinline__ void phase_attn(const Ctx& c) {
    const bf16_t* Q = (const bf16_t*)(c.ws + WS_Q); const bf16_t* K = (const bf16_t*)(c.ws + WS_K); const bf16_t* V = (const bf16_t*)(c.ws + WS_V);
    const int* SEL = (const int*)(c.ws + WS_SEL); bf16_t* O = (bf16_t*)(c.ws + WS_O);
    LAS unsigned char* wl = c.lds + c.wave * ATT_WAVE_LDS;
    LAS int* sl = (LAS int*)wl;
    LAS unsigned short* pT = (LAS unsigned short*)(wl + 1024);
    LAS unsigned char* vb = wl + 3072;
    const int lane = c.lane, fr = lane & 15, fq = lane >> 4;
    const int gw = c.vb * 4 + c.wave, ngw = c.nb * 4;
    unsigned tro[16];
    { const unsigned q = (unsigned)fr >> 2, p = (unsigned)fr & 3u;
#pragma unroll
      for (int c2 = 0; c2 < 8; ++c2)
#pragma unroll
          for (int t = 0; t < 2; ++t) { const unsigned row = 8u * fq + 4u * t + q, ch = 2u * c2 + (p >> 1); tro[c2 * 2 + t] = 256u * row + 16u * (ch ^ vimg_f(row)) + 8u * (p & 1u); } }
    const unsigned vb_addr = (unsigned)(size_t)vb;
    const bool xsplit = (c.nb % 128) == 0;
    const int xg = (c.vb >> 6) & 1, wi0 = xsplit ? (((c.vb >> 7) * 64 + (c.vb & 63)) * 4 + c.wave) : gw, wstride = xsplit ? ngw / 2 : ngw;
    for (int task = wi0; task < (xsplit ? T : T * 2); task += wstride) {
        const int tg = xsplit ? task : (task >> 1), g = xsplit ? xg : (task & 1), b = tg >> 12, t = tg & 4095, tb = b * SEQ;
        const int nsel = min(256, t + 1), ntile = (nsel + 15) >> 4, nch = (nsel + 31) >> 5;
#pragma unroll
        for (int i = 0; i < 4; ++i) { const int s_ = lane + 64 * i; int idx = SEL[(size_t)tg * 256 + s_]; idx = (t < 256) ? s_ : idx; idx = (s_ < nsel && (unsigned)idx <= (unsigned)t) ? idx : 0; sl[s_] = idx; }
        bf16x8 qf[4];
        { const bf16_t* qp = Q + (size_t)tg * D + (4 * g + (fr & 3)) * 128 + 8 * fq;
#pragma unroll
          for (int ks = 0; ks < 4; ++ks) qf[ks] = *(const bf16x8*)(qp + 32 * ks); }
        LDS_WAIT();
        const bf16_t* kbase = K + (size_t)tb * 256 + g * 128;
        const bf16_t* vbase = V + (size_t)tb * 256 + g * 128;
#define ROW_GATHER(basep, chk, bufsel) do { _Pragma("unroll") for (int i_ = 0; i_ < 8; ++i_) { const int r_ = 4 * i_ + fq; const int key_ = sl[32 * (chk) + r_]; \
            __builtin_amdgcn_global_load_lds((const unsigned*)((basep) + (size_t)key_ * 256 + (((unsigned)fr ^ vimg_f((unsigned)r_)) << 3)), \
                                             (LAS unsigned*)(vb + (bufsel) * 8192 + i_ * 1024 + lane * 16), 16, 0, 0); } } while (0)
#define V_GATHER(chk, bufsel) ROW_GATHER(vbase, chk, bufsel)
        f32x4 lg[16];
        ROW_GATHER(kbase, 0, 0);
#pragma unroll
        for (int ch = 0; ch < 8; ++ch) {
            if (ch < 7) ROW_GATHER(kbase, ch + 1, (ch + 1) & 1); else V_GATHER(0, 0);
            asm volatile("s_waitcnt vmcnt(8)" ::: "memory");
            const LAS unsigned char* kb = vb + (ch & 1) * 8192;
#pragma unroll
            for (int rb = 0; rb < 2; ++rb) {
                const int kt = 2 * ch + rb; const unsigned row = 16u * rb + fr;
                f32x4 acc = {0.f, 0.f, 0.f, 0.f};
#pragma unroll
                for (int ks = 0; ks < 4; ++ks) { const bf16x8 kf = *(const LAS bf16x8*)(kb + 256u * row + 16u * ((4u * ks + fq) ^ vimg_f(row))); acc = __builtin_amdgcn_mfma_f32_16x16x32_bf16(qf[ks], kf, acc, 0, 0, 0); }
                const bool ok = (kt * 16 + fr < nsel);
                lg[kt].x = ok ? acc.x : -INFINITY; lg[kt].y = ok ? acc.y : -INFINITY; lg[kt].z = ok ? acc.z : -INFINITY; lg[kt].w = ok ? acc.w : -INFINITY;
            }
            asm volatile("" ::: "memory");
        }
        f32x4 mx = lg[0];
#pragma unroll
        for (int kt = 1; kt < 16; ++kt) { mx.x = fmaxf(mx.x, lg[kt].x); mx.y = fmaxf(mx.y, lg[kt].y); mx.z = fmaxf(mx.z, lg[kt].z); mx.w = fmaxf(mx.w, lg[kt].w); }
#pragma unroll
        for (int o = 1; o < 16; o <<= 1) { mx.x = fmaxf(mx.x, __shfl_xor(mx.x, o)); mx.y = fmaxf(mx.y, __shfl_xor(mx.y, o)); mx.z = fmaxf(mx.z, __shfl_xor(mx.z, o)); mx.w = fmaxf(mx.w, __shfl_xor(mx.w, o)); }
        f32x4 sm = {0.f, 0.f, 0.f, 0.f};
#pragma unroll
        for (int kt = 0; kt < 16; ++kt) { f32x4 p; p.x = __expf(lg[kt].x - mx.x); p.y = __expf(lg[kt].y - mx.y); p.z = __expf(lg[kt].z - mx.z); p.w = __expf(lg[kt].w - mx.w); lg[kt] = p; sm += p; }
#pragma unroll
        for (int o = 1; o < 16; o <<= 1) { sm.x += __shfl_xor(sm.x, o); sm.y += __shfl_xor(sm.y, o); sm.z += __shfl_xor(sm.z, o); sm.w += __shfl_xor(sm.w, o); }
        { const float inv = 1.f / (fq == 0 ? sm.x : fq == 1 ? sm.y : fq == 2 ? sm.z : sm.w);
#pragma unroll
          for (int kt = 0; kt < 16; ++kt) { const float pv = (fq == 0 ? lg[kt].x : fq == 1 ? lg[kt].y : fq == 2 ? lg[kt].z : lg[kt].w) * inv; pT[fq * 256 + kt * 16 + fr] = (unsigned short)(pk_bf16(pv, pv) & 0xffffu); } }
        LDS_WAIT();
        f32x4 oacc[8];
#pragma unroll
        for (int c2 = 0; c2 < 8; ++c2) oacc[c2] = (f32x4){0.f, 0.f, 0.f, 0.f};
        for (int ch = 0; ch < nch; ++ch) {
            if (ch + 1 < nch) { V_GATHER(ch + 1, (ch + 1) & 1); asm volatile("s_waitcnt vmcnt(8)" ::: "memory"); }
            else asm volatile("s_waitcnt vmcnt(0)" ::: "memory");
            const bf16x8 pa = *(const LAS bf16x8*)(pT + (fr & 3) * 256 + 32 * ch + 8 * fq);
            const unsigned cb = vb_addr + (unsigned)(ch & 1) * 8192u;
            unsigned ad[8]; s16x4 r0[8], r1[8];
#pragma unroll
            for (int i = 0; i < 8; ++i) ad[i] = cb + tro[i];
            tr_read8(ad, r0);
#pragma unroll
            for (int i = 0; i < 8; ++i) ad[i] = cb + tro[8 + i];
            tr_read8(ad, r1);
#pragma unroll
            for (int c2 = 0; c2 < 4; ++c2) { const bf16x8 vf = __builtin_shufflevector(r0[2 * c2], r0[2 * c2 + 1], 0, 1, 2, 3, 4, 5, 6, 7); oacc[c2] = __builtin_amdgcn_mfma_f32_16x16x32_bf16(pa, vf, oacc[c2], 0, 0, 0); }
#pragma unroll
            for (int c2 = 0; c2 < 4; ++c2) { const bf16x8 vf = __builtin_shufflevector(r1[2 * c2], r1[2 * c2 + 1], 0, 1, 2, 3, 4, 5, 6, 7); oacc[4 + c2] = __builtin_amdgcn_mfma_f32_16x16x32_bf16(pa, vf, oacc[4 + c2], 0, 0, 0); }
        }
        { bf16_t* op = O + (size_t)tg * D + (4 * g + fq) * 128 + fr;
#pragma unroll
          for (int c2 = 0; c2 < 8; ++c2) { const float ov = (fq == 0 ? oacc[c2].x : fq == 1 ? oacc[c2].y : fq == 2 ? oacc[c2].z : oacc[c2].w); op[16 * c2] = (bf16_t)(pk_bf16(ov, ov) & 0xffffu); } }
        LDS_WAIT();
    }
#undef V_GATHER
#undef ROW_GATHER
}

__device__ __forceinline__ void phase_b4(const Ctx& c) {
    const bf16_t* OB = (const bf16_t*)(c.ws + WS_O); const bf16_t* W = (const bf16_t*)(c.ws + WS_WBOUT); float* H = (float*)(c.ws + WS_H);
    const int fr = c.lane & 15, fq = c.lane >> 4, wr = c.wave >> 1, wc = c.wave & 1;
    for (int u = c.vb; u < 128 * 8; u += c.nb) {
        int mt, nt; map_unit(u, 8, mt, nt);
        const bf16_t* ap[4]; const bf16_t* bp[4];
        rows_regular<64>(ap, OB + (size_t)mt * 128 * D, D, c.tid); rows_regular<64>(bp, W + (size_t)nt * 128 * D, D, c.tid);
        f32x4 acc[4][4];
#pragma unroll
        for (int m = 0; m < 4; ++m)
#pragma unroll
            for (int n = 0; n < 4; ++n) acc[m][n] = *(const f32x4*)(H + (size_t)(mt * 128 + wr * 64 + m * 16 + fr) * D + nt * 128 + wc * 64 + n * 16 + fq * 4);
        gemm_loop<64, 1, true>(c, ap, bp, bp, D, acc, acc);
#pragma unroll
        for (int m = 0; m < 4; ++m)
#pragma unroll
            for (int n = 0; n < 4; ++n) *(f32x4*)(H + (size_t)(mt * 128 + wr * 64 + m * 16 + fr) * D + nt * 128 + wc * 64 + n * 16 + fq * 4) = acc[m][n];
    }
}

constexpr int NPHASE = 22;
__global__ void __launch_bounds__(NTH, 2) mk_fwd(Args args) {
    extern __shared__ __attribute__((aligned(16))) unsigned char lds_raw[];
    Ctx c;
    c.lds = (LAS unsigned char*)lds_raw; c.tid = threadIdx.x; c.lane = c.tid & 63; c.wave = __builtin_amdgcn_readfirstlane(c.tid >> 6);
    c.nb = gridDim.x; { const int bx = blockIdx.x; c.vb = (c.nb % 8 == 0) ? (bx % 8) * (c.nb / 8) + bx / 8 : bx; }
    c.a = (const __attribute__((address_space(4))) Args*)__builtin_amdgcn_kernarg_segment_ptr(); c.ws = args.ws;
    volatile LAS unsigned* st = (volatile LAS unsigned*)(c.lds + LDS_MAIN + 1008);
    const bool multi = (args.ph_hi - args.ph_lo) > 1;
    XcdBarrier bar; bar.bar = (unsigned*)(c.ws + WS_CTL); bar.x = 0; bar.st = st;
    if (multi) {
        if (c.tid == 0) { st[0] = 0u; st[1] = 0u; }
        __syncthreads();
        bar = xcd_barrier_post((unsigned*)(c.ws + WS_CTL), st);
    }
    const int ph_lo = args.ph_lo, ph_hi = args.ph_hi;
#ifndef PH_MASK
#define PH_MASK 0x3fffff
#endif
#define PHON(k) ((PH_MASK >> (k)) & 1)
#define PHASE(k, body) do { if (PHON(k) && ph_lo <= (k) && (k) < ph_hi) { \
        { int t_ = threadIdx.x, vb_ = __builtin_amdgcn_readfirstlane(c.vb); \
          const __attribute__((address_space(4))) Args* ka = (const __attribute__((address_space(4))) Args*)__builtin_amdgcn_kernarg_segment_ptr(); \
          asm volatile("" : "+v"(t_), "+s"(vb_), "+s"(ka)); \
          c.tid = t_; c.lane = t_ & 63; c.wave = __builtin_amdgcn_readfirstlane(t_ >> 6); c.vb = vb_; c.a = ka; c.ws = ka->ws; } \
        body; \
        if (MK_REP == (k)) { __syncthreads(); body; } \
        if ((k) + 1 < ph_hi) xcd_barrier(bar); \
        if ((k) == 3) { for (int xb_ = 0; xb_ < MK_XBAR; ++xb_) xcd_barrier(bar); } } } while (0)
    PHASE(0, phase_prep(c));
    PHASE(1, phase_a1(c));
    PHASE(2, { if (MK_DRY == 2) { phase_a2(c, true); __syncthreads(); } phase_a2(c); });
    PHASE(3, phase_a3(c));
    PHASE(4, { if (MK_DRY == 4) { phase_route(c, 0, true); __syncthreads(); } phase_route(c, 0); });
    PHASE(5, phase_e1(c, 0));
    PHASE(6, phase_e2(c, 0));
    PHASE(7, { if (MK_DRY == 7) { phase_p1(c, 0, true); __syncthreads(); } phase_p1(c, 0); });
    PHASE(8, phase_p2(c, 0));
    PHASE(9, { phase_norm_bf16(c, (const float*)c.a->in[IN_MIXN] + D); convert_moe_layer(c, 1); });
    PHASE(10, phase_b1(c));
    PHASE(11, phase_rope(c));
    PHASE(12, phase_score(c));
    PHASE(13, phase_select(c));
    PHASE(14, phase_attn(c));
    PHASE(15, phase_b4(c));
    PHASE(16, phase_route(c, 1));
    PHASE(17, phase_e1(c, 1));
    PHASE(18, phase_e2(c, 1));
    PHASE(19, phase_p1(c, 1));
    PHASE(20, phase_p2(c, 1));
    PHASE(21, phase_final(c));
}

#ifdef MK_DUMP
__global__ void dump_k(const unsigned char* ws, float* out) {
    const size_t i = (size_t)blockIdx.x * 256 + threadIdx.x;
#if MK_DUMP == 1
    ((f32x4*)out)[i] = ((const f32x4*)(ws + WS_H))[i];
#elif MK_DUMP == 2
    { const u32x2 v = ((const u32x2*)(ws + WS_O))[i]; f32x4 o = {bf_lo(v.x), bf_hi(v.x), bf_lo(v.y), bf_hi(v.y)}; ((f32x4*)out)[i] = o; }
#elif MK_DUMP == 3
    { const int* sp = (const int*)(ws + WS_SEL); f32x4 o = {0.f,0.f,0.f,0.f}; if (i < (size_t)T * 64) { o.x = (float)sp[4*i]; o.y = (float)sp[4*i+1]; o.z = (float)sp[4*i+2]; o.w = (float)sp[4*i+3]; } ((f32x4*)out)[i] = o; }
#elif MK_DUMP == 5
    { const u32x2 v = ((const u32x2*)(ws + WS_XN))[i]; f32x4 o = {bf_lo(v.x), bf_hi(v.x), bf_lo(v.y), bf_hi(v.y)}; ((f32x4*)out)[i] = o; }
#elif MK_DUMP == 6
    { const u32x2 v = ((const u32x2*)(ws + WS_RAW))[i]; f32x4 o = {bf_lo(v.x), bf_hi(v.x), bf_lo(v.y), bf_hi(v.y)}; ((f32x4*)out)[i] = o; }
#elif MK_DUMP == 7
    { f32x4 o = {0.f,0.f,0.f,0.f}; if (i < (size_t)BINP * D / 4) { const u32x2 v = ((const u32x2*)(ws + WS_WBIN))[i]; o = (f32x4){bf_lo(v.x), bf_hi(v.x), bf_lo(v.y), bf_hi(v.y)}; } ((f32x4*)out)[i] = o; }
#elif MK_DUMP == 8
    { const u32x2 v = ((const u32x2*)(ws + WS_RAW))[i], w = ((const u32x2*)(ws + 458 * MB))[i]; f32x4 o = {bf_lo(v.x) - bf_lo(w.x), bf_hi(v.x) - bf_hi(w.x), bf_lo(v.y) - bf_lo(w.y), bf_hi(v.y) - bf_hi(w.y)}; ((f32x4*)out)[i] = o; }
#elif MK_DUMP == 9
    { const u32x2 v = ((const u32x2*)(ws + WS_RAW))[i], w = ((const u32x2*)(ws + 458 * MB))[i]; f32x4 o = {(v.x & 0xffffu) != (w.x & 0xffffu) ? 1.f : 0.f, (v.x >> 16) != (w.x >> 16) ? 1.f : 0.f, (v.y & 0xffffu) != (w.y & 0xffffu) ? 1.f : 0.f, (v.y >> 16) != (w.y >> 16) ? 1.f : 0.f}; ((f32x4*)out)[i] = o; }
#elif MK_DUMP == 4
    { const u32x2 v = ((const u32x2*)(ws + WS_Q))[i]; f32x4 o = {bf_lo(v.x), bf_hi(v.x), bf_lo(v.y), bf_hi(v.y)}; ((f32x4*)out)[i] = o; }
#endif
}
#endif
extern "C" void kernel_launch(void* const* d_in, const int* in_sizes, int n_in, void* d_out, int out_size, void* d_ws, size_t ws_size, hipStream_t stream) {
    static int grid = 0;
    if (grid == 0) {
        if (n_in != 23 || out_size != T * D || ws_size < WS_TOTAL) { fprintf(stderr, "kernel_launch: unexpected sizes n_in %d out %d ws %zu (need %zu)\n", n_in, out_size, ws_size, (size_t)WS_TOTAL); grid = -1; return; }
        int dev = 0, cus = 0, per_cu = 0;
        hipGetDevice(&dev); hipDeviceGetAttribute(&cus, hipDeviceAttributeMultiprocessorCount, dev);
        hipFuncSetAttribute((const void*)mk_fwd, hipFuncAttributeMaxDynamicSharedMemorySize, LDS_BYTES);
        hipOccupancyMaxActiveBlocksPerMultiprocessor(&per_cu, (const void*)mk_fwd, NTH, LDS_BYTES);
        (void)hipGetLastError();
        if (per_cu < 1) per_cu = 1;
        if (per_cu > 2) per_cu = 2;
        grid = cus * per_cu;
    }
    if (grid < 0) return;
    hipMemsetAsync((char*)d_ws + WS_CTL, 0, 16384, stream);
    Args a{};
    for (int i = 0; i < 23; ++i) a.in[i] = d_in[i];
    a.out = (float*)d_out; a.ws = (unsigned char*)d_ws;
#if MK_ONE_LAUNCH
    a.ph_lo = 0; a.ph_hi = NPHASE;
    hipLaunchKernelGGL(mk_fwd, dim3(grid), dim3(NTH), LDS_BYTES, stream, a);
#else
    for (int ph = 0; ph <= MK_LAST_PHASE; ++ph) { a.ph_lo = ph; a.ph_hi = ph + 1; hipLaunchKernelGGL(mk_fwd, dim3(grid), dim3(NTH), LDS_BYTES, stream, a); }
#ifdef MK_DUMP
    hipLaunchKernelGGL(dump_k, dim3(T * D / 4 / 256), dim3(256), 0, stream, (const unsigned char*)d_ws, (float*)d_out);
#endif
#endif
}
```

```cpp
#include <hip/hip_runtime.h>
#include <stdint.h>
#include <stdio.h>

#ifndef MK_LAST_PHASE
#define MK_LAST_PHASE 21
#endif
#ifndef MK_REP
#define MK_REP -1
#endif
#ifndef MK_XBAR
#define MK_XBAR 0
#endif
#ifndef MK_DRY
#define MK_DRY -1
#endif
#ifndef MK_ONE_LAUNCH
#define MK_ONE_LAUNCH 1
#endif

#define LAS __attribute__((address_space(3)))
typedef unsigned short bf16_t;
typedef short bf16x8 __attribute__((ext_vector_type(8)));
typedef float f32x4 __attribute__((ext_vector_type(4)));
typedef float f32x2 __attribute__((ext_vector_type(2)));
typedef float f32x16 __attribute__((ext_vector_type(16)));
typedef unsigned u32x4 __attribute__((ext_vector_type(4)));
typedef unsigned u32x2 __attribute__((ext_vector_type(2)));
typedef long i64x2 __attribute__((ext_vector_type(2)));

constexpr int T = 16384, D = 1024, SEQ = 4096;
constexpr int GW = 2048;
constexpr int BIN = 2120, BINP = 2176;
constexpr int NE = 32, DE = 512;
constexpr int PLE = 256;
constexpr float EPS = 1e-6f;
constexpr int NTH = 256;
constexpr int LDS_MAIN = 4 * 19456;
constexpr int LDS_BYTES = LDS_MAIN + 1024;
constexpr int RPAD = 32768 + NE * 128;

constexpr size_t MB = 1024 * 1024;
constexpr size_t WS_CTL = 0;
constexpr size_t WS_CNT = 16384;
constexpr size_t WS_WR = 32768;
constexpr size_t WS_WAIN = 1 * MB;
constexpr size_t WS_WAOUT = WS_WAIN + 8 * MB;
constexpr size_t WS_WBIN = WS_WAOUT + 4 * MB;
constexpr size_t WS_WBOUT = WS_WBIN + 5 * MB;
constexpr size_t WS_WGATE = WS_WBOUT + 2 * MB;
constexpr size_t WS_WPROJ = WS_WGATE + 4 * MB;
constexpr size_t WS_W1 = WS_WPROJ + 1 * MB;
constexpr size_t WS_XN8 = WS_W1 + 16 * MB;
constexpr size_t WS_W3 = WS_W1 + 32 * MB;
constexpr size_t WS_W2 = WS_W3 + 32 * MB;
constexpr size_t WS_PBF = WS_W2 + 32 * MB;
constexpr size_t WS_XN = WS_PBF + 16 * MB;
constexpr size_t WS_H = WS_XN + 32 * MB;
constexpr size_t WS_LIST = WS_H + 64 * MB;
constexpr size_t WS_GATE = WS_LIST + 2 * MB;
constexpr size_t WS_TOKSLOT = WS_GATE + 2 * MB;
constexpr size_t WS_SCR = WS_TOKSLOT + 1 * MB;
constexpr size_t WS_U = WS_SCR;
constexpr size_t WS_VT = WS_SCR + 64 * MB;
constexpr size_t WS_VSS = WS_SCR + 128 * MB;
constexpr size_t WS_HMID = WS_SCR;
constexpr size_t WS_Y = WS_SCR + 36 * MB;
constexpr size_t WS_RAW = WS_SCR;
constexpr size_t WS_O = WS_SCR;
constexpr size_t WS_Q = WS_SCR + 68 * MB;
constexpr size_t WS_K = WS_Q + 32 * MB;
constexpr size_t WS_V = WS_K + 8 * MB;
constexpr size_t WS_QI = WS_V + 8 * MB;
constexpr size_t WS_KI = WS_QI + 16 * MB;
constexpr size_t WS_WI = WS_KI + 2 * MB;
constexpr size_t WS_SEL = WS_WI + 1 * MB;
constexpr size_t WS_END = WS_SEL + 16 * MB;
static_assert(WS_END <= WS_SCR + 152 * MB, "scratch");
constexpr size_t WS_S = 392 * MB;
constexpr size_t WS_TOTAL = 522 * MB;

typedef __bf16 bf16x2_t __attribute__((ext_vector_type(2)));
__device__ __forceinline__ unsigned pk_bf16(float lo, float hi) { f32x2 v = {lo, hi}; bf16x2_t b = __builtin_convertvector(v, bf16x2_t); return __builtin_bit_cast(unsigned, b); }
__device__ __forceinline__ float bf_lo(unsigned u) { return __uint_as_float(u << 16); }
__device__ __forceinline__ float bf_hi(unsigned u) { return __uint_as_float(u & 0xffff0000u); }
__device__ __forceinline__ float wave_sum(float v) {
#pragma unroll
    for (int o = 1; o < 64; o <<= 1) v += __shfl_xor(v, o);
    return v;
}
__device__ __forceinline__ int lds_inc(LAS int* p) { return __hip_atomic_fetch_add(p, 1, __ATOMIC_RELAXED, __HIP_MEMORY_SCOPE_WORKGROUP); }
#define LDS_WAIT() asm volatile("s_waitcnt lgkmcnt(0)" ::: "memory")
#define VM_WAIT() asm volatile("s_waitcnt vmcnt(0)" ::: "memory")

#define XB_TMO      128
#define XB_XCNT(j)  (256  + 64 * (j))
#define XB_XSUB(j)  (1280 + 64 * (j))
#define XB_XGEN(j)  (2304 + 64 * (j))
#define XB_TOP      3328
#define XB_TOPGEN   3392
#define XCD_BAR_WORDS 3456
#define XB_SPIN_CAP (1u << 20)
__device__ __forceinline__ unsigned xb_ld(unsigned* p)              { return __hip_atomic_load(p, __ATOMIC_RELAXED, __HIP_MEMORY_SCOPE_AGENT); }
__device__ __forceinline__ unsigned xb_add(unsigned* p, unsigned v) { return __hip_atomic_fetch_add(p, v, __ATOMIC_RELAXED, __HIP_MEMORY_SCOPE_AGENT); }
__device__ __forceinline__ unsigned xb_xcc_id() { return (unsigned)__builtin_amdgcn_s_getreg((3 << 11) | 20) & 0xFu; }
#define XB_SPIN(cond, bar) do { unsigned _sp = 0; while (cond) { __builtin_amdgcn_s_sleep(1); \
    if ((++_sp & 255u) == 0u) { if (xb_ld(&(bar)[XB_TMO])) break; if (_sp > XB_SPIN_CAP) { atomicAdd(&(bar)[XB_TMO], 1u); break; } } } } while (0)
struct XcdBarrier { unsigned* bar; unsigned x; volatile LAS unsigned* st; };
__device__ __forceinline__ XcdBarrier xcd_barrier_post(unsigned* bar, volatile LAS unsigned* st) {
    XcdBarrier b; b.bar = bar; b.x = xb_xcc_id(); b.st = st;
    if (threadIdx.x == 0) (void)xb_add(&bar[XB_XCNT(b.x)], 1u);
    return b;
}
__device__ __forceinline__ void xcd_barrier_complete(unsigned* bar, unsigned x, unsigned& nloc, unsigned& nx) {
    const unsigned G = gridDim.x;
    unsigned sum, cnt, mine, sp = 0u;
    for (;;) {
        sum = 0u; cnt = 0u; mine = 0u;
#pragma unroll
        for (unsigned j = 0; j < 16; ++j) { const unsigned c = xb_ld(&bar[XB_XCNT(j)]); sum += c; cnt += (c > 0u) ? 1u : 0u; mine = (j == x) ? c : mine; }
        if (sum == G) break;
        __builtin_amdgcn_s_sleep(1);
        if ((++sp & 255u) == 0u) { if (xb_ld(&bar[XB_TMO])) break; if (sp > XB_SPIN_CAP) { atomicAdd(&bar[XB_TMO], 1u); break; } }
    }
    nloc = mine > 0u ? mine : 1u; nx = cnt > 0u ? cnt : 1u;
}
__device__ __forceinline__ void xcd_barrier(const XcdBarrier& b) {
    asm volatile("s_waitcnt vmcnt(0)" ::: "memory");
    __syncthreads();
    if (threadIdx.x == 0) {
        unsigned* bar = b.bar;
        __builtin_amdgcn_s_waitcnt(0);
        unsigned nloc = b.st[0], nx = b.st[1];
        if (nloc == 0u) { xcd_barrier_complete(bar, b.x, nloc, nx); b.st[0] = nloc; b.st[1] = nx; }
        const unsigned old = xb_add(&bar[XB_XSUB(b.x)], 1u);
        const unsigned gen = old / nloc;
        if (old + 1u == (gen + 1u) * nloc) {
            __builtin_amdgcn_fence(__ATOMIC_RELEASE, "agent");
            asm volatile("s_waitcnt vmcnt(0)" ::: "memory");
            const unsigned og = xb_add(&bar[XB_TOP], 1u);
            const unsigned tg = og / nx;
            if (og + 1u == (tg + 1u) * nx) xb_add(&bar[XB_TOPGEN], 1u);
            else XB_SPIN(xb_ld(&bar[XB_TOPGEN]) == tg, bar);
            __builtin_amdgcn_fence(__ATOMIC_ACQUIRE, "agent");
            xb_add(&bar[XB_XGEN(b.x)], 1u);
            asm volatile("s_waitcnt vmcnt(0)" ::: "memory");
        } else {
            XB_SPIN(xb_ld(&bar[XB_XGEN(b.x)]) == gen, bar);
            __builtin_amdgcn_fence(__ATOMIC_ACQUIRE, "agent");
            asm volatile("s_waitcnt vmcnt(0)" ::: "memory");
        }
    }
    __syncthreads();
}

struct Args { const void* in[23]; float* out; unsigned char* ws; int ph_lo, ph_hi; };
enum { IN_X = 0, IN_P, IN_POS, IN_MIXN, IN_AWIN, IN_AVG, IN_AWS, IN_ABS, IN_AWOUT, IN_BWIN, IN_BWOUT, IN_FFNN, IN_WG, IN_BG, IN_WE, IN_BE,
       IN_W1, IN_W3, IN_W2, IN_PLEN, IN_PLEG, IN_PLEP, IN_FINN };

struct Ctx {
    LAS unsigned char* lds;
    int tid, lane, wave, vb, nb;
    const __attribute__((address_space(4))) Args* a;
    unsigned char* ws;
};

template <int BK> struct TileK { static constexpr int NP = (BK == 64) ? 4 : 2; static constexpr int TB = 128 * BK * 2; };

template <int BK>
__device__ __forceinline__ void stage_tile(LAS unsigned char* tile, const bf16_t* const (&rp)[TileK<BK>::NP], int k0, int tid) {
    const int lc = (BK == 64) ? ((tid & 7) ^ ((tid >> 3) & 7)) : ((tid & 3) ^ ((tid >> 3) & 3));
#pragma unroll
    for (int p = 0; p < TileK<BK>::NP; ++p)
        __builtin_amdgcn_global_load_lds((const unsigned*)(rp[p] + k0 + lc * 8), (LAS unsigned*)(tile + p * 4096 + tid * 16), 16, 0, 0);
}
template <int BK>
__device__ __forceinline__ void rows_regular(const bf16_t* (&rp)[TileK<BK>::NP], const bf16_t* base, size_t ld, int tid) {
#pragma unroll
    for (int p = 0; p < TileK<BK>::NP; ++p) { const int r = (BK == 64) ? (p * 32 + (tid >> 3)) : (p * 64 + (tid >> 2)); rp[p] = base + (size_t)r * ld; }
}
template <int BK>
__device__ __forceinline__ int frag_off(int row, int ks, int fq) {
    return (BK == 64) ? (row * 128 + (((ks * 4 + fq) ^ (row & 7)) << 4)) : (row * 64 + ((fq ^ ((row >> 1) & 3)) << 4));
}

template <int BK, int NBOP, bool SWAP, bool FP8 = false>
__device__ __forceinline__ void gemm_loop(const Ctx& c, const bf16_t* const (&ap)[TileK<BK>::NP], const bf16_t* const (&b0p)[TileK<BK>::NP], const bf16_t* const (&b1p)[TileK<BK>::NP],
                                          int K, f32x4 (&acc0)[4][4], f32x4 (&acc1)[4][4]) {
    constexpr int TB = TileK<BK>::TB, SB = (1 + NBOP) * TB;
    static_assert(2 * SB <= LDS_MAIN, "lds");
    const int nk = K / BK, tid = c.tid;
    const int fr = c.lane & 15, fq = c.lane >> 4, wr = c.wave >> 1, wc = c.wave & 1;
    LAS unsigned char* lds = c.lds;
    stage_tile<BK>(lds, ap, 0, tid); stage_tile<BK>(lds + TB, b0p, 0, tid);
    if (NBOP == 2) stage_tile<BK>(lds + 2 * TB, b1p, 0, tid);
    for (int kt = 0; kt < nk; ++kt) {
        VM_WAIT();
        __syncthreads();
        LAS unsigned char* cur = lds + (kt & 1) * SB;
        if (kt + 1 < nk) {
            LAS unsigned char* nxt = lds + ((kt + 1) & 1) * SB;
            stage_tile<BK>(nxt, ap, (kt + 1) * BK, tid); stage_tile<BK>(nxt + TB, b0p, (kt + 1) * BK, tid);
            if (NBOP == 2) stage_tile<BK>(nxt + 2 * TB, b1p, (kt + 1) * BK, tid);
        }
#pragma unroll
        for (int ks = 0; ks < BK / 32; ++ks) {
            bf16x8 af[4], bf0[4], bf1[4];
#pragma unroll
            for (int m = 0; m < 4; ++m) af[m] = *(const LAS bf16x8*)(cur + frag_off<BK>(wr * 64 + m * 16 + fr, ks, fq));
#pragma unroll
            for (int n = 0; n < 4; ++n) bf0[n] = *(const LAS bf16x8*)(cur + TB + frag_off<BK>(wc * 64 + n * 16 + fr, ks, fq));
            if (NBOP == 2) {
#pragma unroll
                for (int n = 0; n < 4; ++n) bf1[n] = *(const LAS bf16x8*)(cur + 2 * TB + frag_off<BK>(wc * 64 + n * 16 + fr, ks, fq));
            }
#pragma unroll
            for (int m = 0; m < 4; ++m)
#pragma unroll
                for (int n = 0; n < 4; ++n) {
                    if (FP8) {
                        const i64x2 a2 = __builtin_bit_cast(i64x2, af[m]), b2 = __builtin_bit_cast(i64x2, bf0[n]);
                        if (SWAP) { acc0[m][n] = __builtin_amdgcn_mfma_f32_16x16x32_fp8_fp8(b2.x, a2.x, acc0[m][n], 0, 0, 0); acc0[m][n] = __builtin_amdgcn_mfma_f32_16x16x32_fp8_fp8(b2.y, a2.y, acc0[m][n], 0, 0, 0); }
                        else      { acc0[m][n] = __builtin_amdgcn_mfma_f32_16x16x32_fp8_fp8(a2.x, b2.x, acc0[m][n], 0, 0, 0); acc0[m][n] = __builtin_amdgcn_mfma_f32_16x16x32_fp8_fp8(a2.y, b2.y, acc0[m][n], 0, 0, 0); }
                        continue;
                    }
                    if (SWAP) acc0[m][n] = __builtin_amdgcn_mfma_f32_16x16x32_bf16(bf0[n], af[m], acc0[m][n], 0, 0, 0);
                    else      acc0[m][n] = __builtin_amdgcn_mfma_f32_16x16x32_bf16(af[m], bf0[n], acc0[m][n], 0, 0, 0);
                    if (NBOP == 2) {
                        if (SWAP) acc1[m][n] = __builtin_amdgcn_mfma_f32_16x16x32_bf16(bf1[n], af[m], acc1[m][n], 0, 0, 0);
                        else      acc1[m][n] = __builtin_amdgcn_mfma_f32_16x16x32_bf16(af[m], bf1[n], acc1[m][n], 0, 0, 0);
                    }
                }
        }
    }
    __syncthreads();
}
__device__ __forceinline__ void zero_acc(f32x4 (&acc)[4][4]) {
#pragma unroll
    for (int m = 0; m < 4; ++m)
#pragma unroll
        for (int n = 0; n < 4; ++n) acc[m][n] = (f32x4){0.f, 0.f, 0.f, 0.f};
}
__device__ __forceinline__ void map_unit(int u, int nnt, int& mt, int& nt) { const int per = 8 * nnt, band = u / per, r = u - band * per; nt = r >> 3; mt = band * 8 + (r & 7); }


__device__ __forceinline__ float gelu_tanh(float x) {
    const float y2 = 1.5957691216057308f * (x + 0.044715f * x * x * x);
    return x / (1.f + __expf(-y2));
}
__device__ __forceinline__ float sigmoidf_(float x) { return 1.f / (1.f + __expf(-x)); }

__device__ __forceinline__ void row_load(const float* row, int lane, f32x4 (&v)[4]) {
#pragma unroll
    for (int j = 0; j < 4; ++j) v[j] = ((const f32x4*)row)[lane + 64 * j];
}
__device__ __forceinline__ float row_sumsq(const f32x4 (&v)[4]) {
    float s = 0.f;
#pragma unroll
    for (int j = 0; j < 4; ++j) s += (v[j].x * v[j].x + v[j].y * v[j].y) + (v[j].z * v[j].z + v[j].w * v[j].w);
    return wave_sum(s);
}
__device__ __forceinline__ void gain_load(const float* gain, int lane, f32x4 (&g)[4]) {
#pragma unroll
    for (int j = 0; j < 4; ++j) g[j] = ((const f32x4*)gain)[lane + 64 * j];
}
__device__ __forceinline__ void row_store_norm_bf16(bf16_t* orow, int lane, const f32x4 (&v)[4], float r, const f32x4 (&gv)[4]) {
#pragma unroll
    for (int j = 0; j < 4; ++j) {
        const f32x4 g = gv[j];
        u32x2 o; o.x = pk_bf16(v[j].x * r * g.x, v[j].y * r * g.y); o.y = pk_bf16(v[j].z * r * g.z, v[j].w * r * g.w);
        ((u32x2*)orow)[lane + 64 * j] = o;
    }
}

constexpr int TR_SCR = 64 * 136;
__device__ __forceinline__ void transpose_item(const float* W, int K, int N, int nvalid, int ldw, bf16_t* WT, LAS unsigned char* scr, int item, int lane) {
    const int nblk = N / 64, kb = item / nblk, nb = item - kb * nblk, k0 = 64 * kb, n0 = 64 * nb;
    const int n = n0 + 4 * (lane & 15);
    const int nc_ = (n < nvalid) ? n : 0; const float keep = (n < nvalid) ? 1.f : 0.f;
    f32x4 v[16];
#pragma unroll
    for (int i = 0; i < 16; ++i) v[i] = *(const f32x4*)(W + (size_t)(k0 + 4 * i + (lane >> 4)) * ldw + nc_);
#pragma unroll
    for (int i = 0; i < 16; ++i) {
        const int kk = 4 * i + (lane >> 4);
        u32x2 o; o.x = pk_bf16(v[i].x * keep, v[i].y * keep); o.y = pk_bf16(v[i].z * keep, v[i].w * keep);
        *(LAS u32x2*)(scr + kk * 136 + (lane & 15) * 8) = o;
    }
    LDS_WAIT();
    const int cc = lane & 7;
#pragma unroll
    for (int j = 0; j < 8; ++j) {
        const int nn = (lane >> 3) + 8 * j; const LAS unsigned short* sp = (const LAS unsigned short*)(scr + (8 * cc) * 136 + nn * 2);
        u32x4 o;
        o.x = (unsigned)sp[0 * 68] | ((unsigned)sp[1 * 68] << 16); o.y = (unsigned)sp[2 * 68] | ((unsigned)sp[3 * 68] << 16);
        o.z = (unsigned)sp[4 * 68] | ((unsigned)sp[5 * 68] << 16); o.w = (unsigned)sp[6 * 68] | ((unsigned)sp[7 * 68] << 16);
        *(u32x4*)(WT + (size_t)(n0 + nn) * K + k0 + 8 * cc) = o;
    }
    LDS_WAIT();
}

__device__ __forceinline__ unsigned pk_fp8x4(float a, float b, float c_, float d) {
    a = fminf(fmaxf(a, -448.f), 448.f); b = fminf(fmaxf(b, -448.f), 448.f); c_ = fminf(fmaxf(c_, -448.f), 448.f); d = fminf(fmaxf(d, -448.f), 448.f);
    int p = __builtin_amdgcn_cvt_pk_fp8_f32(a, b, 0, false);
    p = __builtin_amdgcn_cvt_pk_fp8_f32(c_, d, p, true);
    return (unsigned)p;
}
constexpr float W8_SCALE = 64.f, H8_SCALE = 4.f;
__device__ __forceinline__ void transpose_item8(const float* W, int K, int N, unsigned char* WT, LAS unsigned char* scr, int item, int lane) {
    const int nblk = N / 64, kb = item / nblk, nb = item - kb * nblk, k0 = 128 * kb, n0 = 64 * nb;
    const int n = n0 + 4 * (lane & 15);
#pragma unroll 2
    for (int h = 0; h < 2; ++h) {
        f32x4 v[16];
#pragma unroll
        for (int i = 0; i < 16; ++i) v[i] = *(const f32x4*)(W + (size_t)(k0 + 64 * h + 4 * i + (lane >> 4)) * N + n);
#pragma unroll
        for (int i = 0; i < 16; ++i) { const int kk = 64 * h + 4 * i + (lane >> 4);
            *(LAS unsigned*)(scr + kk * 68 + (lane & 15) * 4) = pk_fp8x4(v[i].x * W8_SCALE, v[i].y * W8_SCALE, v[i].z * W8_SCALE, v[i].w * W8_SCALE); }
    }
    LDS_WAIT();
    const int cc = lane & 7;
#pragma unroll
    for (int j = 0; j < 8; ++j) {
        const int nn = (lane >> 3) + 8 * j; const LAS unsigned char* sp = scr + (16 * cc) * 68 + nn;
        unsigned w[4];
#pragma unroll
        for (int q = 0; q < 4; ++q) w[q] = (unsigned)sp[(4 * q + 0) * 68] | ((unsigned)sp[(4 * q + 1) * 68] << 8) | ((unsigned)sp[(4 * q + 2) * 68] << 16) | ((unsigned)sp[(4 * q + 3) * 68] << 24);
        u32x4 o = {w[0], w[1], w[2], w[3]};
        *(u32x4*)(WT + (size_t)(n0 + nn) * K + k0 + 16 * cc) = o;
    }
    LDS_WAIT();
}
__device__ __forceinline__ void convert_moe_layer(const Ctx& c, int l) {
    LAS unsigned char* scr = c.lds + c.wave * TR_SCR;
    const int gw = c.vb * 4 + c.wave, ngw = c.nb * 4;
    const float* w1 = (const float*)c.a->in[IN_W1] + (size_t)l * NE * D * DE;
    const float* w3 = (const float*)c.a->in[IN_W3] + (size_t)l * NE * D * DE;
    const float* w2 = (const float*)c.a->in[IN_W2] + (size_t)l * NE * DE * D;
    unsigned char* W1 = c.ws + WS_W1; unsigned char* W3 = c.ws + WS_W3; unsigned char* W2 = c.ws + WS_W2;
    for (int it = gw; it < NE * 192; it += ngw) {
        const int e = it / 192, r = it - e * 192;
        if (r < 64)       transpose_item8(w1 + (size_t)e * D * DE, D, DE, W1 + (size_t)e * DE * D, scr, r, c.lane);
        else if (r < 128) transpose_item8(w3 + (size_t)e * D * DE, D, DE, W3 + (size_t)e * DE * D, scr, r - 64, c.lane);
        else              transpose_item8(w2 + (size_t)e * DE * D, DE, D, W2 + (size_t)e * D * DE, scr, r - 128, c.lane);
    }
}

__device__ __forceinline__ void phase_prep(const Ctx& c) {
    const __attribute__((address_space(4))) Args& a = *c.a;
    LAS unsigned char* scr = c.lds + c.wave * TR_SCR;
    const int gw = c.vb * 4 + c.wave, ngw = c.nb * 4;
    constexpr int I_AIN = 16 * 64, I_AOUT = 32 * 16, I_BIN = 16 * 34, I_BOUT = 16 * 16, I_PG = 16 * 16, I_PP = 4 * 16;
    constexpr int NIT = I_AIN + I_AOUT + I_BIN + I_BOUT + 2 * I_PG + 2 * I_PP;
    for (int it = gw; it < NIT; it += ngw) {
        int r = it;
        if (r < I_AIN) { transpose_item((const float*)a.in[IN_AWIN], D, 4096, 4096, 4096, (bf16_t*)(c.ws + WS_WAIN), scr, r, c.lane); continue; } r -= I_AIN;
        if (r < I_AOUT) { transpose_item((const float*)a.in[IN_AWOUT], GW, D, D, D, (bf16_t*)(c.ws + WS_WAOUT), scr, r, c.lane); continue; } r -= I_AOUT;
        if (r < I_BIN) { transpose_item((const float*)a.in[IN_BWIN], D, BINP, BIN, BIN, (bf16_t*)(c.ws + WS_WBIN), scr, r, c.lane); continue; } r -= I_BIN;
        if (r < I_BOUT) { transpose_item((const float*)a.in[IN_BWOUT], D, D, D, D, (bf16_t*)(c.ws + WS_WBOUT), scr, r, c.lane); continue; } r -= I_BOUT;
        if (r < 2 * I_PG) { const int l = r / I_PG; transpose_item((const float*)a.in[IN_PLEG] + (size_t)l * D * D, D, D, D, D, (bf16_t*)(c.ws + WS_WGATE) + (size_t)l * D * D, scr, r - l * I_PG, c.lane); continue; } r -= 2 * I_PG;
        { const int l = r / I_PP; transpose_item((const float*)a.in[IN_PLEP] + (size_t)l * PLE * D, PLE, D, D, D, (bf16_t*)(c.ws + WS_WPROJ) + (size_t)l * D * PLE, scr, r - l * I_PP, c.lane); }
    }
    convert_moe_layer(c, 0);
    const int gt = c.vb * NTH + c.tid, ngt = c.nb * NTH;
    { const float* p = (const float*)a.in[IN_P]; bf16_t* pb = (bf16_t*)(c.ws + WS_PBF);
      for (int i = gt; i < 2 * T * PLE / 8; i += ngt) {
          const f32x4 v0 = ((const f32x4*)p)[2 * i], v1 = ((const f32x4*)p)[2 * i + 1];
          u32x4 o; o.x = pk_bf16(v0.x, v0.y); o.y = pk_bf16(v0.z, v0.w); o.z = pk_bf16(v1.x, v1.y); o.w = pk_bf16(v1.z, v1.w);
          ((u32x4*)pb)[i] = o; } }
    { float* wr = (float*)(c.ws + WS_WR);
      for (int i = gt; i < 2 * D * 48; i += ngt) {
          const int l = i / (D * 48), r = i - l * D * 48, k = r / 48, o = r - k * 48;
          float w = 0.f;
          if (o < 4) w = ((const float*)a.in[IN_WG])[(size_t)l * D * 4 + k * 4 + o];
          else if (o < 36) w = ((const float*)a.in[IN_WE])[(size_t)l * D * 32 + k * 32 + (o - 4)];
          wr[i] = w * ((const float*)a.in[IN_FFNN])[l * D + k]; } }
    if (c.vb == 0 && c.tid < 128) ((int*)(c.ws + WS_CNT))[c.tid] = 0;
    f32x4 gv[4]; gain_load((const float*)a.in[IN_MIXN], c.lane, gv);
    for (int t = gw; t < T; t += ngw) {
        f32x4 v[4]; row_load((const float*)a.in[IN_X] + (size_t)t * D, c.lane, v);
        const float r = rsqrtf(row_sumsq(v) * (1.f / D) + EPS);
        row_store_norm_bf16((bf16_t*)(c.ws + WS_XN) + (size_t)t * D, c.lane, v, r, gv);
    }
}

__device__ __forceinline__ void phase_a1(const Ctx& c) {
    const bf16_t* XN = (const bf16_t*)(c.ws + WS_XN); const bf16_t* W = (const bf16_t*)(c.ws + WS_WAIN);
    bf16_t* U = (bf16_t*)(c.ws + WS_U); bf16_t* VT = (bf16_t*)(c.ws + WS_VT); float* VSS = (float*)(c.ws + WS_VSS);
    const int fr = c.lane & 15, fq = c.lane >> 4, wr = c.wave >> 1, wc = c.wave & 1;
    for (int u = c.vb; u < 128 * 32; u += c.nb) {
        int mt, nt; map_unit(u, 32, mt, nt);
        const bf16_t* ap[4]; const bf16_t* bp[4];
        rows_regular<64>(ap, XN + (size_t)mt * 128 * D, D, c.tid); rows_regular<64>(bp, W + (size_t)nt * 128 * D, D, c.tid);
        f32x4 acc[4][4]; zero_acc(acc);
        if (nt < 16) {
            gemm_loop<64, 1, true>(c, ap, bp, bp, D, acc, acc);
#pragma unroll
            for (int m = 0; m < 4; ++m)
#pragma unroll
                for (int n = 0; n < 4; ++n) {
                    const int t = mt * 128 + wr * 64 + m * 16 + fr, col = nt * 128 + wc * 64 + n * 16 + fq * 4;
                    const f32x4 v = acc[m][n];
                    u32x2 o; o.x = pk_bf16(gelu_tanh(v.x), gelu_tanh(v.y)); o.y = pk_bf16(gelu_tanh(v.z), gelu_tanh(v.w));
                    *(u32x2*)(U + (size_t)t * GW + col) = o;
                }
        } else {
            gemm_loop<64, 1, false>(c, ap, bp, bp, D, acc, acc);
            const int vn = nt - 16;
#pragma unroll
            for (int m = 0; m < 4; ++m) {
                f32x4 ss = {0.f, 0.f, 0.f, 0.f};
                const int t0 = mt * 128 + wr * 64 + m * 16 + fq * 4;
#pragma unroll
                for (int n = 0; n < 4; ++n) {
                    const int ch = vn * 128 + wc * 64 + n * 16 + fr;
                    f32x4 v = acc[m][n];
                    v.x = gelu_tanh(v.x); v.y = gelu_tanh(v.y); v.z = gelu_tanh(v.z); v.w = gelu_tanh(v.w);
                    ss += v * v;
                    u32x2 o; o.x = pk_bf16(v.x, v.y); o.y = pk_bf16(v.z, v.w);
                    *(u32x2*)(VT + (size_t)ch * T + t0) = o;
                }
#pragma unroll
                for (int o = 1; o < 16; o <<= 1) { ss.x += __shfl_xor(ss.x, o); ss.y += __shfl_xor(ss.y, o); ss.z += __shfl_xor(ss.z, o); ss.w += __shfl_xor(ss.w, o); }
                if (fr == 0) {
                    VSS[(size_t)(t0 + 0) * 32 + vn * 2 + wc] = ss.x; VSS[(size_t)(t0 + 1) * 32 + vn * 2 + wc] = ss.y;
                    VSS[(size_t)(t0 + 2) * 32 + vn * 2 + wc] = ss.z; VSS[(size_t)(t0 + 3) * 32 + vn * 2 + wc] = ss.w;
                }
            }
        }
    }
}

__device__ __forceinline__ void phase_a2(const Ctx& c, bool dry = false) {
    const __attribute__((address_space(4))) Args& a = *c.a;
    bf16_t* U = (bf16_t*)(c.ws + WS_U); const bf16_t* VT = (const bf16_t*)(c.ws + WS_VT); const float* VSS = (const float*)(c.ws + WS_VSS);
    const float* ws_ = (const float*)a.in[IN_AWS]; const float* bs_ = (const float*)a.in[IN_ABS]; const float* vg = (const float*)a.in[IN_AVG];
    const int fr = c.lane & 15, fq = c.lane >> 4, wr = c.wave >> 1, wc = c.wave & 1, tid = c.tid;
    LAS unsigned char* lds = c.lds;
    LAS float* rl = (LAS float*)(lds + LDS_MAIN);
    for (int u = c.vb; u < 128 * 8; u += c.nb) {
        const int ci = u >> 3, g = u & 7, tokbase = ci * 128;
        __syncthreads();
        if (tid < 128) {
            const float* p = VSS + (size_t)(tokbase + tid) * 32; float s = 0.f;
#pragma unroll
            for (int i = 0; i < 8; ++i) { const f32x4 q = ((const f32x4*)p)[i]; s += (q.x + q.y) + (q.z + q.w); }
            rl[tid] = rsqrtf(s * (1.f / GW) + EPS);
        }
        __syncthreads();
        {
            const int t = tid >> 1, half = tid & 1;
            const float* wrow = ws_ + ((size_t)g * 128 + t) * 128 + half * 64;
#pragma unroll
            for (int cc = 0; cc < 8; ++cc) {
                const int s0 = half * 64 + cc * 8;
                u32x4 o;
                {
                    const f32x4 w0 = ((const f32x4*)wrow)[2 * cc], w1 = ((const f32x4*)wrow)[2 * cc + 1];
                    float e[8] = {w0.x, w0.y, w0.z, w0.w, w1.x, w1.y, w1.z, w1.w};
#pragma unroll
                    for (int i = 0; i < 8; ++i) e[i] = (s0 + i <= t) ? e[i] * rl[s0 + i] : 0.f;
                    o.x = pk_bf16(e[0], e[1]); o.y = pk_bf16(e[2], e[3]); o.z = pk_bf16(e[4], e[5]); o.w = pk_bf16(e[6], e[7]);
                }
                *(LAS u32x4*)(lds + half * 16384 + t * 128 + ((cc ^ (t & 7)) << 4)) = o;
            }
        }
        for (int hn = 0; hn < 2; ++hn) {
            const int c0 = g * 256 + hn * 128;
            const bf16_t* bp[4]; rows_regular<64>(bp, VT + (size_t)c0 * T + tokbase, T, tid);
            stage_tile<64>(lds + 32768, bp, 0, tid); stage_tile<64>(lds + 32768 + 16384, bp, 64, tid);
            VM_WAIT();
            __syncthreads();
            f32x4 acc[4][4]; zero_acc(acc);
#pragma unroll 1
            for (int kh = 0; kh < 2; ++kh)
#pragma unroll 1
                for (int ks = 0; ks < 2; ++ks) {
                    bf16x8 af[4], bf[4];
#pragma unroll
                    for (int m = 0; m < 4; ++m) af[m] = *(const LAS bf16x8*)(lds + kh * 16384 + frag_off<64>(wr * 64 + m * 16 + fr, ks, fq));
#pragma unroll
                    for (int n = 0; n < 4; ++n) bf[n] = *(const LAS bf16x8*)(lds + 32768 + kh * 16384 + frag_off<64>(wc * 64 + n * 16 + fr, ks, fq));
#pragma unroll
                    for (int m = 0; m < 4; ++m)
#pragma unroll
                        for (int n = 0; n < 4; ++n) acc[m][n] = __builtin_amdgcn_mfma_f32_16x16x32_bf16(bf[n], af[m], acc[m][n], 0, 0, 0);
                }
            u32x2 uvv[4][4]; float bsvv[4];
#pragma unroll
            for (int m = 0; m < 4; ++m) { const int tl = wr * 64 + m * 16 + fr; bsvv[m] = bs_[g * 128 + tl];
#pragma unroll
                for (int n = 0; n < 4; ++n) uvv[m][n] = *(const u32x2*)(U + (size_t)(tokbase + tl) * GW + c0 + wc * 64 + n * 16 + fq * 4); }
#pragma unroll
            for (int m = 0; m < 4; ++m) {
                const int tl = wr * 64 + m * 16 + fr; const float bsv = bsvv[m];
#pragma unroll
                for (int n = 0; n < 4; ++n) {
                    const int ch = c0 + wc * 64 + n * 16 + fq * 4;
                    const f32x4 gn = *(const f32x4*)(vg + ch);
                    u32x2* up = (u32x2*)(U + (size_t)(tokbase + tl) * GW + ch);
                    const u32x2 uv = uvv[m][n]; const f32x4 v = acc[m][n];
                    u32x2 o;
                    o.x = pk_bf16(bf_lo(uv.x) * (gn.x * v.x + bsv), bf_hi(uv.x) * (gn.y * v.y + bsv));
                    o.y = pk_bf16(bf_lo(uv.y) * (gn.z * v.z + bsv), bf_hi(uv.y) * (gn.w * v.w + bsv));
                    if (dry) *(u32x2*)(c.ws + 440 * MB + ((size_t)(tokbase + tl) * GW + ch) * 2) = o; else *up = o;
                }
            }
            __syncthreads();
        }
    }
}

__device__ __forceinline__ void phase_a3(const Ctx& c) {
    const bf16_t* Z = (const bf16_t*)(c.ws + WS_U); const bf16_t* W = (const bf16_t*)(c.ws + WS_WAOUT);
    const float* X = (const float*)c.a->in[IN_X]; float* H = (float*)(c.ws + WS_H);
    const int fr = c.lane & 15, fq = c.lane >> 4, wr = c.wave >> 1, wc = c.wave & 1;
    for (int u = c.vb; u < 128 * 8; u += c.nb) {
        int mt, nt; map_unit(u, 8, mt, nt);
        const bf16_t* ap[4]; const bf16_t* bp[4];
        rows_regular<64>(ap, Z + (size_t)mt * 128 * GW, GW, c.tid); rows_regular<64>(bp, W + (size_t)nt * 128 * GW, GW, c.tid);
        f32x4 acc[4][4];
#pragma unroll
        for (int m = 0; m < 4; ++m)
#pragma unroll
            for (int n = 0; n < 4; ++n) acc[m][n] = *(const f32x4*)(X + (size_t)(mt * 128 + wr * 64 + m * 16 + fr) * D + nt * 128 + wc * 64 + n * 16 + fq * 4);
        gemm_loop<64, 1, true>(c, ap, bp, bp, GW, acc, acc);
#pragma unroll
        for (int m = 0; m < 4; ++m)
#pragma unroll
            for (int n = 0; n < 4; ++n) *(f32x4*)(H + (size_t)(mt * 128 + wr * 64 + m * 16 + fr) * D + nt * 128 + wc * 64 + n * 16 + fq * 4) = acc[m][n];
    }
}

__device__ __forceinline__ void phase_route(const Ctx& c, int l, bool dry = false) {
    const __attribute__((address_space(4))) Args& a = *c.a;
    const float* H = (const float*)(c.ws + WS_H); bf16_t* XN = (bf16_t*)(c.ws + (dry ? 440 * MB : WS_XN));
    const float* wr_ = (const float*)(c.ws + WS_WR) + (size_t)l * D * 48;
    const float* gain = (const float*)a.in[IN_FFNN] + l * D;
    int* cnt = (int*)(c.ws + WS_CNT) + l * 32 + (dry ? 64 : 0); int* list = (int*)(c.ws + (dry ? 480 * MB : WS_LIST)); float* gatel = (float*)(c.ws + (dry ? 484 * MB : WS_GATE)); int* tokslot = (int*)(c.ws + (dry ? 488 * MB : WS_TOKSLOT));
    LAS float* rl = (LAS float*)(c.lds);
    LAS float* lgl = (LAS float*)(c.lds + 256);
    const int lane = c.lane, w = c.wave;
    f32x4 gv[4]; gain_load(gain, lane, gv);
    for (int unit = c.vb; unit < T / 32; unit += c.nb) {
        const int tok0 = unit * 32;
        __syncthreads();
        for (int i = 0; i < 8; ++i) {
            const int t = tok0 + w * 8 + i;
            f32x4 v[4]; row_load(H + (size_t)t * D, lane, v);
            const float r = rsqrtf(row_sumsq(v) * (1.f / D) + EPS);
            if (lane == 0) rl[w * 8 + i] = r;
            row_store_norm_bf16(XN + (size_t)t * D, lane, v, r, gv);
            if (!dry) {
#pragma unroll
                for (int j = 0; j < 4; ++j) ((unsigned*)(c.ws + WS_XN8 + (size_t)t * D))[lane + 64 * j] = pk_fp8x4(v[j].x * r * gv[j].x, v[j].y * r * gv[j].y, v[j].z * r * gv[j].z, v[j].w * r * gv[j].w);
            }
        }
        {
            const int th = w & 1, kh = w >> 1, m = lane & 15, q = lane >> 4;
            const float* arow = H + (size_t)(tok0 + 16 * th + m) * D + 512 * kh + 128 * q;
            const float* brow = wr_ + (size_t)(512 * kh + 128 * q) * 48 + m;
            f32x4 acc[3]; acc[0] = acc[1] = acc[2] = (f32x4){0.f, 0.f, 0.f, 0.f};
            for (int i = 0; i < 32; ++i) {
                const f32x4 av = ((const f32x4*)arow)[i];
                const float ae[4] = {av.x, av.y, av.z, av.w};
#pragma unroll
                for (int e = 0; e < 4; ++e) {
                    const float* bp = brow + (size_t)(4 * i + e) * 48;
#pragma unroll
                    for (int nt = 0; nt < 3; ++nt) acc[nt] = __builtin_amdgcn_mfma_f32_16x16x4f32(ae[e], bp[nt * 16], acc[nt], 0, 0, 0);
                }
            }
#pragma unroll
            for (int nt = 0; nt < 3; ++nt)
#pragma unroll
                for (int j = 0; j < 4; ++j) lgl[(kh * 32 + th * 16 + 4 * q + j) * 48 + nt * 16 + m] = acc[nt][j];
        }
        __syncthreads();
        if (c.tid < 32) {
            const int tt = c.tid, t = tok0 + tt; const float r = rl[tt];
            const float* bg = (const float*)a.in[IN_BG] + l * 4; const float* be = (const float*)a.in[IN_BE] + l * 32;
            float gl[4];
#pragma unroll
            for (int o = 0; o < 4; ++o) gl[o] = (lgl[tt * 48 + o] + lgl[(32 + tt) * 48 + o]) * r + bg[o];
            int gs = 0; float gm = gl[0];
#pragma unroll
            for (int o = 1; o < 4; ++o) if (gl[o] > gm) { gm = gl[o]; gs = o; }
            float gden = 0.f;
#pragma unroll
            for (int o = 0; o < 4; ++o) gden += __expf(gl[o] - gm);
            const float pg = 1.f / gden;
            float l1 = -INFINITY, l2 = -INFINITY; int i1 = 0, i2 = 0;
            for (int i = 0; i < 8; ++i) {
                const int o = 4 + gs * 8 + i;
                const float v = (lgl[tt * 48 + o] + lgl[(32 + tt) * 48 + o]) * r + be[gs * 8 + i];
                if (v > l1) { l2 = l1; i2 = i1; l1 = v; i1 = i; } else if (v > l2) { l2 = v; i2 = i; }
            }
            const float e2 = __expf(l2 - l1), inv = 1.f / (1.f + e2);
            const float g1 = pg * inv, g2 = pg * e2 * inv;
            const int ea = gs * 8 + i1, eb = gs * 8 + i2;
            const int sa = atomicAdd(&cnt[ea], 1), sb = atomicAdd(&cnt[eb], 1);
            list[ea * T + sa] = t; gatel[ea * T + sa] = g1; tokslot[2 * t] = (ea << 16) | sa;
            list[eb * T + sb] = t; gatel[eb * T + sb] = g2; tokslot[2 * t + 1] = (eb << 16) | sb;
        }
    }
}

__device__ __forceinline__ void moe_table(const Ctx& c, int l, LAS int* pst, LAS int* cn) {
    __syncthreads();
    if (c.tid == 0) {
        const int* cnt = (const int*)(c.ws + WS_CNT) + l * 32; int acc = 0;
        for (int e = 0; e < 32; ++e) { const int n = cnt[e]; cn[e] = n; pst[e] = acc; acc += (n + 127) >> 7; }
        pst[32] = acc;
    }
    __syncthreads();
}
__device__ __forceinline__ int moe_find(LAS const int* pst, int mb) { int e = 0; for (int i = 1; i < 32; ++i) e = (pst[i] <= mb) ? i : e; return e; }

__device__ __forceinline__ void phase_e1(const Ctx& c, int l) {
    const unsigned char* XN8 = c.ws + WS_XN8; const unsigned char* W1 = c.ws + WS_W1; const unsigned char* W3 = c.ws + WS_W3;
    unsigned char* HM = c.ws + WS_HMID; const int* list = (const int*)(c.ws + WS_LIST);
    LAS int* pst = (LAS int*)(c.lds + LDS_MAIN); LAS int* cn = pst + 40;
    moe_table(c, l, pst, cn);
    const int fr = c.lane & 15, fq = c.lane >> 4, wr = c.wave >> 1, wc = c.wave & 1, tid = c.tid;
    const int nunits = pst[32] * 8;
    for (int u = c.vb; u < nunits; u += c.nb) {
        const int mb = u >> 3, h0 = (u & 7) * 64, e = moe_find(pst, mb), row0 = (mb - pst[e]) * 128, count = cn[e];
        const bf16_t* ap[4]; const bf16_t* bp[4];
#pragma unroll
        for (int p = 0; p < 4; ++p) {
            int r = row0 + p * 32 + (tid >> 3); r = r < count ? r : row0; ap[p] = (const bf16_t*)(XN8 + (size_t)list[e * T + r] * D);
            const int rb = p * 32 + (tid >> 3), hid = h0 + (rb >> 6) * 32 + ((rb >> 4) & 1) * 16 + (rb & 15);
            bp[p] = (const bf16_t*)((((rb >> 5) & 1) ? W3 : W1) + ((size_t)e * DE + hid) * D);
        }
        f32x4 acc[4][4]; zero_acc(acc);
        gemm_loop<64, 1, true, true>(c, ap, bp, bp, D / 2, acc, acc);
        const float ws_ = 1.f / W8_SCALE;
#pragma unroll
        for (int m = 0; m < 4; ++m)
#pragma unroll
            for (int n = 0; n < 2; ++n) {
                const size_t row = (size_t)mb * 128 + wr * 64 + m * 16 + fr; const int col = h0 + wc * 32 + n * 16 + fq * 4;
                const f32x4 x = acc[m][n] * ws_, y = acc[m][n + 2] * (ws_ * H8_SCALE);
                *(unsigned*)(HM + row * DE + col) = pk_fp8x4(x.x * sigmoidf_(x.x) * y.x, x.y * sigmoidf_(x.y) * y.y, x.z * sigmoidf_(x.z) * y.z, x.w * sigmoidf_(x.w) * y.w);
            }
    }
}
__device__ __forceinline__ void phase_e2(const Ctx& c, int l) {
    const unsigned char* HM = c.ws + WS_HMID; const unsigned char* W2 = c.ws + WS_W2;
    bf16_t* Y = (bf16_t*)(c.ws + WS_Y); const float* gatel = (const float*)(c.ws + WS_GATE);
    LAS int* pst = (LAS int*)(c.lds + LDS_MAIN); LAS int* cn = pst + 40;
    moe_table(c, l, pst, cn);
    const int fr = c.lane & 15, fq = c.lane >> 4, wr = c.wave >> 1, wc = c.wave & 1, tid = c.tid;
    const int nunits = pst[32] * 8;
    for (int u = c.vb; u < nunits; u += c.nb) {
        const int mb = u >> 3, nt = u & 7, e = moe_find(pst, mb), row0 = (mb - pst[e]) * 128, count = cn[e];
        const bf16_t* ap[4]; const bf16_t* bp[4];
        rows_regular<64>(ap, (const bf16_t*)(HM + (size_t)mb * 128 * DE), DE / 2, tid); rows_regular<64>(bp, (const bf16_t*)(W2 + ((size_t)e * D + nt * 128) * DE), DE / 2, tid);
        f32x4 acc[4][4]; zero_acc(acc);
        gemm_loop<64, 1, true, true>(c, ap, bp, bp, DE / 2, acc, acc);
        float gtv[4];
#pragma unroll
        for (int m = 0; m < 4; ++m) { const int rl_ = wr * 64 + m * 16 + fr; gtv[m] = (row0 + rl_ < count) ? gatel[e * T + row0 + rl_] * (1.f / (W8_SCALE * H8_SCALE)) : 0.f; }
#pragma unroll
        for (int m = 0; m < 4; ++m) {
            const int rl_ = wr * 64 + m * 16 + fr; const float gt = gtv[m];
#pragma unroll
            for (int n = 0; n < 4; ++n) {
                const f32x4 v = acc[m][n] * gt;
                u32x2 o; o.x = pk_bf16(v.x, v.y); o.y = pk_bf16(v.z, v.w);
                *(u32x2*)(Y + ((size_t)mb * 128 + rl_) * D + nt * 128 + wc * 64 + n * 16 + fq * 4) = o;
            }
        }
    }
}
__device__ __forceinline__ void phase_p1(const Ctx& c, int l, bool dry = false) {
    float* H = (float*)(c.ws + WS_H); float* HO = (float*)(c.ws + (dry ? 440 * MB : WS_H)); bf16_t* XN = (bf16_t*)(c.ws + (dry ? 440 * MB : WS_XN)); const bf16_t* Y = (const bf16_t*)(c.ws + WS_Y);
    const int* tokslot = (const int*)(c.ws + WS_TOKSLOT); const float* gain = (const float*)c.a->in[IN_PLEN] + l * D;
    LAS int* pst = (LAS int*)(c.lds + LDS_MAIN); LAS int* cn = pst + 40;
    moe_table(c, l, pst, cn);
    const int gw = c.vb * 4 + c.wave, ngw = c.nb * 4, lane = c.lane;
    f32x4 gv[4]; gain_load(gain, lane, gv);
    for (int t = gw; t < T; t += ngw) {
        const int s0 = tokslot[2 * t], s1 = tokslot[2 * t + 1];
        const bf16_t* y0 = Y + ((size_t)pst[s0 >> 16] * 128 + (s0 & 0xffff)) * D; const bf16_t* y1 = Y + ((size_t)pst[s1 >> 16] * 128 + (s1 & 0xffff)) * D;
        f32x4 v[4]; row_load(H + (size_t)t * D, lane, v);
#pragma unroll
        for (int j = 0; j < 4; ++j) {
            const u32x2 a0 = ((const u32x2*)y0)[lane + 64 * j], a1 = ((const u32x2*)y1)[lane + 64 * j];
            v[j].x += bf_lo(a0.x) + bf_lo(a1.x); v[j].y += bf_hi(a0.x) + bf_hi(a1.x); v[j].z += bf_lo(a0.y) + bf_lo(a1.y); v[j].w += bf_hi(a0.y) + bf_hi(a1.y);
            ((f32x4*)(HO + (size_t)t * D))[lane + 64 * j] = v[j];
        }
        const float r = rsqrtf(row_sumsq(v) * (1.f / D) + EPS);
        row_store_norm_bf16(XN + (size_t)t * D, lane, v, r, gv);
    }
}
__device__ __forceinline__ void phase_p2(const Ctx& c, int l) {
    const bf16_t* XN = (const bf16_t*)(c.ws + WS_XN); const bf16_t* WG = (const bf16_t*)(c.ws + WS_WGATE) + (size_t)l * D * D;
    const bf16_t* PB = (const bf16_t*)(c.ws + WS_PBF) + (size_t)l * T * PLE; const bf16_t* WP = (const bf16_t*)(c.ws + WS_WPROJ) + (size_t)l * D * PLE;
    float* H = (float*)(c.ws + WS_H);
    const int fr = c.lane & 15, fq = c.lane >> 4, wr = c.wave >> 1, wc = c.wave & 1;
    for (int u = c.vb; u < 128 * 8; u += c.nb) {
        int mt, nt; map_unit(u, 8, mt, nt);
        const bf16_t* ap[4]; const bf16_t* bp[4];
        f32x4 ag[4][4], apj[4][4]; zero_acc(ag); zero_acc(apj);
        rows_regular<64>(ap, XN + (size_t)mt * 128 * D, D, c.tid); rows_regular<64>(bp, WG + (size_t)nt * 128 * D, D, c.tid);
        gemm_loop<64, 1, true>(c, ap, bp, bp, D, ag, ag);
        rows_regular<64>(ap, PB + (size_t)mt * 128 * PLE, PLE, c.tid); rows_regular<64>(bp, WP + (size_t)nt * 128 * PLE, PLE, c.tid);
        gemm_loop<64, 1, true>(c, ap, bp, bp, PLE, apj, apj);
        f32x4 hres[4][4];
#pragma unroll
        for (int m = 0; m < 4; ++m)
#pragma unroll
            for (int n = 0; n < 4; ++n) hres[m][n] = *(const f32x4*)(H + (size_t)(mt * 128 + wr * 64 + m * 16 + fr) * D + nt * 128 + wc * 64 + n * 16 + fq * 4);
#pragma unroll
        for (int m = 0; m < 4; ++m)
#pragma unroll
            for (int n = 0; n < 4; ++n) {
                const size_t off = (size_t)(mt * 128 + wr * 64 + m * 16 + fr) * D + nt * 128 + wc * 64 + n * 16 + fq * 4;
                const f32x4 g = ag[m][n], pj = apj[m][n]; f32x4 h = hres[m][n];
                h.x += sigmoidf_(g.x) * pj.x; h.y += sigmoidf_(g.y) * pj.y; h.z += sigmoidf_(g.z) * pj.z; h.w += sigmoidf_(g.w) * pj.w;
                *(f32x4*)(H + off) = h;
            }
    }
}
__device__ __forceinline__ void phase_norm_bf16(const Ctx& c, const float* gain) {
    const float* H = (const float*)(c.ws + WS_H); bf16_t* XN = (bf16_t*)(c.ws + WS_XN);
    const int gw = c.vb * 4 + c.wave, ngw = c.nb * 4;
    f32x4 gv[4]; gain_load(gain, c.lane, gv);
    for (int t = gw; t < T; t += ngw) {
        f32x4 v[4]; row_load(H + (size_t)t * D, c.lane, v);
        const float r = rsqrtf(row_sumsq(v) * (1.f / D) + EPS);
        row_store_norm_bf16(XN + (size_t)t * D, c.lane, v, r, gv);
    }
}
__device__ __forceinline__ void phase_final(const Ctx& c) {
    const float* H = (const float*)(c.ws + WS_H); float* O = c.a->out; const float* gain = (const float*)c.a->in[IN_FINN];
    const int gw = c.vb * 4 + c.wave, ngw = c.nb * 4;
    f32x4 gv[4]; gain_load(gain, c.lane, gv);
    for (int t = gw; t < T; t += ngw) {
        f32x4 v[4]; row_load(H + (size_t)t * D, c.lane, v);
        const float r = rsqrtf(row_sumsq(v) * (1.f / D) + EPS);
#pragma unroll
        for (int j = 0; j < 4; ++j) ((f32x4*)(O + (size_t)t * D))[c.lane + 64 * j] = v[j] * r * gv[j];
    }
}

__device__ __forceinline__ void phase_b1(const Ctx& c, size_t raw_off = WS_RAW) {
    const bf16_t* XN = (const bf16_t*)(c.ws + WS_XN); const bf16_t* W = (const bf16_t*)(c.ws + WS_WBIN); bf16_t* RAW = (bf16_t*)(c.ws + raw_off);
    const int fr = c.lane & 15, fq = c.lane >> 4, wr = c.wave >> 1, wc = c.wave & 1;
    for (int u = c.vb; u < 128 * 17; u += c.nb) {
        int mt, nt; map_unit(u, 17, mt, nt);
        const bf16_t* ap[4]; const bf16_t* bp[4];
        rows_regular<64>(ap, XN + (size_t)mt * 128 * D, D, c.tid); rows_regular<64>(bp, W + (size_t)nt * 128 * D, D, c.tid);
        f32x4 acc[4][4]; zero_acc(acc);
        gemm_loop<64, 1, true>(c, ap, bp, bp, D, acc, acc);
#pragma unroll
        for (int m = 0; m < 4; ++m)
#pragma unroll
            for (int n = 0; n < 4; ++n) {
                const f32x4 v = acc[m][n]; u32x2 o; o.x = pk_bf16(v.x, v.y); o.y = pk_bf16(v.z, v.w);
                *(u32x2*)(RAW + (size_t)(mt * 128 + wr * 64 + m * 16 + fr) * BINP + nt * 128 + wc * 64 + n * 16 + fq * 4) = o;
            }
    }
}

__device__ __forceinline__ void unpack8(const u32x4 r, float (&e)[8]) { e[0] = bf_lo(r.x); e[1] = bf_hi(r.x); e[2] = bf_lo(r.y); e[3] = bf_hi(r.y); e[4] = bf_lo(r.z); e[5] = bf_hi(r.z); e[6] = bf_lo(r.w); e[7] = bf_hi(r.w); }
__device__ __forceinline__ u32x4 pack8(const float (&e)[8]) { u32x4 o; o.x = pk_bf16(e[0], e[1]); o.y = pk_bf16(e[2], e[3]); o.z = pk_bf16(e[4], e[5]); o.w = pk_bf16(e[6], e[7]); return o; }
__device__ __forceinline__ void phase_rope(const Ctx& c) {
    const bf16_t* RAW = (const bf16_t*)(c.ws + WS_RAW);
    bf16_t* Q = (bf16_t*)(c.ws + WS_Q); bf16_t* K = (bf16_t*)(c.ws + WS_K); bf16_t* V = (bf16_t*)(c.ws + WS_V);
    bf16_t* QI = (bf16_t*)(c.ws + WS_QI); bf16_t* KI = (bf16_t*)(c.ws + WS_KI); float* WI = (float*)(c.ws + WS_WI);
    const int* pos = (const int*)c.a->in[IN_POS];
    LAS float* cs = (LAS float*)(c.lds + c.wave * 256);
    const int gw = c.vb * 4 + c.wave, ngw = c.nb * 4, lane = c.lane;
    for (int t = gw; t < T; t += ngw) {
        if (lane < 24) {
            const double ex = (lane < 16) ? (double)lane * (1.0 / 16.0) : (double)(lane - 16) * (1.0 / 8.0);
            const float invf = (float)exp2(-ex * 18.931568569324174);
            const float ang = (float)pos[t] * invf;
            const double ad = (double)ang; const double n = rint(ad * 0.15915494309189535); const float red = (float)(ad - n * 6.283185307179586);
            cs[lane] = cosf(red); cs[32 + lane] = sinf(red);
        }
        LDS_WAIT();
        const bf16_t* row = RAW + (size_t)t * BINP;
        for (int ch = lane; ch < BINP / 8; ch += 64) {
            const u32x4 own = ((const u32x4*)row)[ch];
            float e[8]; unpack8(own, e);
            if (ch < 160) {
                const int cc = ch & 15;
                if (cc < 4) {
                    const u32x4 oth = ((const u32x4*)row)[ch ^ 2]; float p[8]; unpack8(oth, p);
                    const int f0 = (cc & 1) * 8;
#pragma unroll
                    for (int i = 0; i < 8; ++i) { const float co = cs[f0 + i], si = cs[32 + f0 + i]; e[i] = (cc < 2) ? (e[i] * co - p[i] * si) : (e[i] * co + p[i] * si); }
                }
                if (ch < 128) {
#pragma unroll
                    for (int i = 0; i < 8; ++i) e[i] *= 0.08838834764831845f;
                    ((u32x4*)(Q + (size_t)t * D))[ch] = pack8(e);
                } else ((u32x4*)(K + (size_t)t * 256))[ch - 128] = pack8(e);
            } else if (ch < 192) {
                ((u32x4*)(V + (size_t)t * 256))[ch - 160] = own;
            } else if (ch < 264) {
                const int cc = ch & 7;
                if (cc < 2) {
                    const u32x4 oth = ((const u32x4*)row)[ch ^ 1]; float p[8]; unpack8(oth, p);
#pragma unroll
                    for (int i = 0; i < 8; ++i) { const float co = cs[16 + i], si = cs[32 + 16 + i]; e[i] = (cc == 0) ? (e[i] * co - p[i] * si) : (e[i] * co + p[i] * si); }
                }
                if (ch < 256) ((u32x4*)(QI + (size_t)t * 512))[ch - 192] = pack8(e);
                else ((u32x4*)(KI + (size_t)t * 64))[ch - 256] = pack8(e);
            } else if (ch == 264) {
                f32x4 w0 = {e[0], e[1], e[2], e[3]}, w1 = {e[4], e[5], e[6], e[7]};
                const float sc = 0.044194173824159216f;
                ((f32x4*)(WI + (size_t)t * 8))[0] = w0 * sc; ((f32x4*)(WI + (size_t)t * 8))[1] = w1 * sc;
            }
        }
        LDS_WAIT();
    }
}

__device__ __forceinline__ size_t srow_off(int t) { const int m = t >> 6, r = t & 63; return (size_t)64 * (m + 1) * (32 * m + r); }
constexpr size_t S_BATCH = (size_t)64 * 65 * 2048;
constexpr int SCORE_UNITS = 4 * 312;
__device__ __forceinline__ void phase_score(const Ctx& c) {
    const bf16_t* QI = (const bf16_t*)(c.ws + WS_QI); const bf16_t* KI = (const bf16_t*)(c.ws + WS_KI); const float* WI = (const float*)(c.ws + WS_WI);
    float* S = (float*)(c.ws + WS_S);
    const int lane = c.lane, hf = lane >> 5, col = lane & 31, w = c.wave;
    for (int u = c.vb; u < SCORE_UNITS; u += c.nb) {
        const int b = u & 3, r = u >> 2;
        int kc, qb;
        if (r < 120) { kc = 0; qb = 8 + r; } else if (r < 216) { kc = 1; qb = 32 + (r - 120); } else if (r < 280) { kc = 2; qb = 64 + (r - 216); } else { kc = 3; qb = 96 + (r - 280); }
        const int tb = b * SEQ, t0 = 32 * qb + 8 * w;
        bf16x8 af[2][4]; f32x4 wv[2][4];
        { const int rho = lane & 31, ql = 2 * ((rho >> 2) & 1) + (rho >> 4), hd = 4 * ((rho >> 3) & 1) + (rho & 3);
#pragma unroll
          for (int a = 0; a < 2; ++a) {
              const bf16_t* qp = QI + (size_t)(tb + t0 + 4 * a + ql) * 512 + hd * 64 + 8 * hf;
#pragma unroll
              for (int ks = 0; ks < 4; ++ks) af[a][ks] = *(const bf16x8*)(qp + 16 * ks);
              const float* wp = WI + (size_t)(tb + t0 + 4 * a + 2 * hf) * 8;
#pragma unroll
              for (int i = 0; i < 4; ++i) wv[a][i] = ((const f32x4*)wp)[i];
          } }
        const int ntile = min(32, qb + 1 - 32 * kc), key0 = 1024 * kc;
        float* Sb = S + (size_t)b * S_BATCH;
        size_t ro[2][2];
#pragma unroll
        for (int a = 0; a < 2; ++a) { ro[a][0] = srow_off(t0 + 4 * a + 2 * hf); ro[a][1] = srow_off(t0 + 4 * a + 2 * hf + 1); }
        const int nsub = (ntile + 3) >> 2;
        const bf16_t* krp[4];
        rows_regular<64>(krp, KI + (size_t)(tb + key0) * 64, 64, c.tid);
        __syncthreads();
        stage_tile<64>(c.lds, krp, 0, c.tid);
        for (int sc = 0; sc < nsub; ++sc) {
            VM_WAIT();
            __syncthreads();
            const LAS unsigned char* cur = c.lds + (sc & 1) * 16384;
            if (sc + 1 < nsub) stage_tile<64>(c.lds + ((sc + 1) & 1) * 16384, krp, (sc + 1) * 128 * 64, c.tid);
#pragma unroll
            for (int j = 0; j < 4; ++j) {
                const int kt = 4 * sc + j;
                if (kt < ntile) {
                    const int key = key0 + 32 * kt + col, row = 32 * j + col;
                    bf16x8 cb[4];
#pragma unroll
                    for (int ks = 0; ks < 4; ++ks) cb[ks] = *(const LAS bf16x8*)(cur + row * 128 + (((2 * ks + hf) ^ (row & 7)) << 4));
#pragma unroll
                    for (int a = 0; a < 2; ++a) {
                        f32x16 acc = {};
#pragma unroll
                        for (int ks = 0; ks < 4; ++ks) acc = __builtin_amdgcn_mfma_f32_32x32x16_bf16(af[a][ks], cb[ks], acc, 0, 0, 0);
                        float s0 = fmaxf(acc[0], 0.f) * wv[a][0].x; s0 += fmaxf(acc[1], 0.f) * wv[a][0].y; s0 += fmaxf(acc[2], 0.f) * wv[a][0].z; s0 += fmaxf(acc[3], 0.f) * wv[a][0].w;
                        s0 += fmaxf(acc[4], 0.f) * wv[a][1].x; s0 += fmaxf(acc[5], 0.f) * wv[a][1].y; s0 += fmaxf(acc[6], 0.f) * wv[a][1].z; s0 += fmaxf(acc[7], 0.f) * wv[a][1].w;
                        float s1 = fmaxf(acc[8], 0.f) * wv[a][2].x; s1 += fmaxf(acc[9], 0.f) * wv[a][2].y; s1 += fmaxf(acc[10], 0.f) * wv[a][2].z; s1 += fmaxf(acc[11], 0.f) * wv[a][2].w;
                        s1 += fmaxf(acc[12], 0.f) * wv[a][3].x; s1 += fmaxf(acc[13], 0.f) * wv[a][3].y; s1 += fmaxf(acc[14], 0.f) * wv[a][3].z; s1 += fmaxf(acc[15], 0.f) * wv[a][3].w;
                        const int tA = t0 + 4 * a + 2 * hf;
                        Sb[ro[a][0] + key] = (key <= tA) ? s0 : -INFINITY;
                        Sb[ro[a][1] + key] = (key <= tA + 1) ? s1 : -INFINITY;
                    }
                }
            }
        }
    }
}

constexpr int NBINS = 2048, CAND_CAP = 256, SEL_WAVE_LDS = 8192 + 2048 + 64;
__device__ __forceinline__ void phase_select(const Ctx& c) {
    const float* S = (const float*)(c.ws + WS_S); int* SEL = (int*)(c.ws + WS_SEL);
    LAS int* hist = (LAS int*)(c.lds + c.wave * SEL_WAVE_LDS);
    LAS float* candv = (LAS float*)(hist + NBINS);
    LAS int* candi = (LAS int*)(candv + CAND_CAP);
    LAS int* thr = candi + CAND_CAP;
    const int gw = c.vb * 4 + c.wave, ngw = c.nb * 4;
    for (int j = gw; j < 4 * 3840; j += ngw) {
        int lane = c.lane;
        asm volatile("" : "+v"(lane));
        const int b = j & 3, t = 4095 - (j >> 2), ni = (t + 64) >> 6;
        const float* row = S + (size_t)b * S_BATCH + srow_off(t);
        float s[64];
#pragma unroll
        for (int g4 = 0; g4 < 4; ++g4) {
            if (16 * g4 < ni) {
#pragma unroll
                for (int i = 16 * g4; i < 16 * g4 + 16; ++i) { const int k = 64 * i + lane; const float v = row[min(k, t)]; s[i] = (k <= t) ? v : -INFINITY; }
            } else {
#pragma unroll
                for (int i = 16 * g4; i < 16 * g4 + 16; ++i) s[i] = -INFINITY;
            }
        }
        asm volatile("" : "+v"(lane));
        float mn = INFINITY, mx = -INFINITY;
#pragma unroll
        for (int i = 0; i < 64; ++i) { mx = fmaxf(mx, s[i]); mn = fminf(mn, (s[i] == -INFINITY) ? INFINITY : s[i]); }
#pragma unroll
        for (int o = 1; o < 64; o <<= 1) { mx = fmaxf(mx, __shfl_xor(mx, o)); mn = fminf(mn, __shfl_xor(mn, o)); }
        const float sc = (mx > mn) ? (float)NBINS / (mx - mn) : 0.f;
#pragma unroll
        for (int i = 0; i < 8; ++i) ((LAS u32x4*)hist)[lane * 8 + i] = (u32x4){0u, 0u, 0u, 0u};
        LDS_WAIT();
#define BINOF(v) min(NBINS - 1, (int)(((v) - mn) * sc))
#pragma unroll
        for (int i = 0; i < 64; ++i) if ((i & ~7) < ni && s[i] != -INFINITY) lds_inc(&hist[BINOF(s[i])]);
        LDS_WAIT();
        int bs, need;
        {
            const LAS int* hq = hist + lane * 32;
            int loc = 0;
#pragma unroll
            for (int i = 0; i < 8; ++i) { const u32x4 h4 = ((const LAS u32x4*)hq)[i]; loc += (int)(h4.x + h4.y + h4.z + h4.w); }
            int suf = loc;
#pragma unroll
            for (int o = 1; o < 64; o <<= 1) { const int v = __shfl_down(suf, o); if (lane + o < 64) suf += v; }
            const int above = suf - loc;
            const bool cross = (above < 256 && suf >= 256);
            int bsl = 0, abl = 0;
            if (cross) { int run = above; for (int i = 31; i >= 0; --i) { const int h = hq[i]; if (run < 256 && run + h >= 256) { bsl = lane * 32 + i; abl = run; } run += h; } }
            const unsigned long long cm = __ballot(cross);
            const int src = cm ? (int)__builtin_ctzll(cm) : 0;
            bs = __shfl(bsl, src); need = 256 - __shfl(abl, src);
        }
        int bs2 = -1;
        if (__shfl(hist[bs], 0) > 32) {
#pragma unroll
            for (int i = 0; i < 8; ++i) ((LAS u32x4*)hist)[lane * 8 + i] = (u32x4){0u, 0u, 0u, 0u};
            LDS_WAIT();
#define SUBOF(v) min(NBINS - 1, (int)((((v) - mn) * sc - (float)bs) * (float)NBINS))
#pragma unroll
            for (int i = 0; i < 64; ++i) if ((i & ~7) < ni && s[i] != -INFINITY && BINOF(s[i]) == bs) lds_inc(&hist[SUBOF(s[i])]);
            LDS_WAIT();
            const LAS int* hq = hist + lane * 32;
            int loc = 0;
#pragma unroll
            for (int i = 0; i < 8; ++i) { const u32x4 h4 = ((const LAS u32x4*)hq)[i]; loc += (int)(h4.x + h4.y + h4.z + h4.w); }
            int suf = loc;
#pragma unroll
            for (int o = 1; o < 64; o <<= 1) { const int v = __shfl_down(suf, o); if (lane + o < 64) suf += v; }
            const int above = suf - loc;
            const bool cross = (above < need && suf >= need);
            int bsl = 0, abl = 0;
            if (cross) { int run = above; for (int i = 31; i >= 0; --i) { const int h = hq[i]; if (run < need && run + h >= need) { bsl = lane * 32 + i; abl = run; } run += h; } }
            const unsigned long long cm = __ballot(cross);
            const int src = cm ? (int)__builtin_ctzll(cm) : 0;
            bs2 = __shfl(bsl, src); need = need - __shfl(abl, src);
        }
        asm volatile("" : "+v"(lane));
        int nc = 0;
#pragma unroll
        for (int i = 0; i < 64; ++i) if ((i & ~7) < ni) {
            bool p = (s[i] != -INFINITY) && (BINOF(s[i]) == bs);
            if (bs2 >= 0) p = p && (SUBOF(s[i]) == bs2);
            const unsigned long long m = __ballot(p);
            const int pos = nc + (int)__builtin_amdgcn_mbcnt_hi((unsigned)(m >> 32), __builtin_amdgcn_mbcnt_lo((unsigned)m, 0u));
            if (p && pos < CAND_CAP) { candv[pos] = s[i]; candi[pos] = 64 * i + lane; }
            nc += (int)__popcll(m);
        }
        nc = min(nc, CAND_CAP);
        LDS_WAIT();
        for (int i = lane; i < nc; i += 64) {
            const float v = candv[i]; const int id = candi[i];
            int rank = 0;
            for (int k = 0; k < nc; ++k) { const float vk = candv[k]; const int ik = candi[k]; rank += (vk > v || (vk == v && ik < id)) ? 1 : 0; }
            if (rank == need - 1) { thr[0] = __float_as_int(v); thr[1] = id; }
        }
        LDS_WAIT();
        const float tv = __int_as_float(thr[0]); const int ti = thr[1];
        asm volatile("" : "+v"(lane));
        int* selr = SEL + ((size_t)b * SEQ + t) * 256;
        int base = 0;
#pragma unroll
        for (int i = 0; i < 64; ++i) if ((i & ~7) < ni) {
            const int key = 64 * i + lane;
            const bool p = (s[i] > tv) || (s[i] == tv && key <= ti);
            const unsigned long long m = __ballot(p);
            const int pos = base + (int)__builtin_amdgcn_mbcnt_hi((unsigned)(m >> 32), __builtin_amdgcn_mbcnt_lo((unsigned)m, 0u));
            if (p && pos < 256) selr[pos] = key;
            base += (int)__popcll(m);
        }
        LDS_WAIT();
#undef BINOF
#undef SUBOF
    }
}

typedef short s16x4 __attribute__((ext_vector_type(4)));
__device__ __forceinline__ unsigned vimg_f(unsigned r) { return ((r & 3u) << 2) | ((r >> 2) & 3u); }
__device__ __forceinline__ void tr_read8(const unsigned (&ad)[8], s16x4 (&r)[8]) {
    asm volatile("ds_read_b64_tr_b16 %0, %8\n\tds_read_b64_tr_b16 %1, %9\n\tds_read_b64_tr_b16 %2, %10\n\tds_read_b64_tr_b16 %3, %11\n\t"
                 "ds_read_b64_tr_b16 %4, %12\n\tds_read_b64_tr_b16 %5, %13\n\tds_read_b64_tr_b16 %6, %14\n\tds_read_b64_tr_b16 %7, %15\n\ts_waitcnt lgkmcnt(0)"
                 : "=&v"(r[0]), "=&v"(r[1]), "=&v"(r[2]), "=&v"(r[3]), "=&v"(r[4]), "=&v"(r[5]), "=&v"(r[6]), "=&v"(r[7])
                 : "v"(ad[0]), "v"(ad[1]), "v"(ad[2]), "v"(ad[3]), "v"(ad[4]), "v"(ad[5]), "v"(ad[6]), "v"(ad[7]) : "memory");
}
constexpr int ATT_WAVE_LDS = 19456;
__device__ __forceinline__ void phase_attn(const Ctx& c) {
    const bf16_t* Q = (const bf16_t*)(c.ws + WS_Q); const bf16_t* K = (const bf16_t*)(c.ws + WS_K); const bf16_t* V = (const bf16_t*)(c.ws + WS_V);
    const int* SEL = (const int*)(c.ws + WS_SEL); bf16_t* O = (bf16_t*)(c.ws + WS_O);
    LAS unsigned char* wl = c.lds + c.wave * ATT_WAVE_LDS;
    LAS int* sl = (LAS int*)wl;
    LAS unsigned short* pT = (LAS unsigned short*)(wl + 1024);
    LAS unsigned char* vb = wl + 3072;
    const int lane = c.lane, fr = lane & 15, fq = lane >> 4;
    const int gw = c.vb * 4 + c.wave, ngw = c.nb * 4;
    unsigned tro[16];
    { const unsigned q = (unsigned)fr >> 2, p = (unsigned)fr & 3u;
#pragma unroll
      for (int c2 = 0; c2 < 8; ++c2)
#pragma unroll
          for (int t = 0; t < 2; ++t) { const unsigned row = 8u * fq + 4u * t + q, ch = 2u * c2 + (p >> 1); tro[c2 * 2 + t] = 256u * row + 16u * (ch ^ vimg_f(row)) + 8u * (p & 1u); } }
    const unsigned vb_addr = (unsigned)(size_t)vb;
    const bool xsplit = (c.nb % 128) == 0;
    const int xg = (c.vb >> 6) & 1, wi0 = xsplit ? (((c.vb >> 7) * 64 + (c.vb & 63)) * 4 + c.wave) : gw, wstride = xsplit ? ngw / 2 : ngw;
    for (int task = wi0; task < (xsplit ? T : T * 2); task += wstride) {
        const int tg = xsplit ? task : (task >> 1), g = xsplit ? xg : (task & 1), b = tg >> 12, t = tg & 4095, tb = b * SEQ;
        const int nsel = min(256, t + 1), ntile = (nsel + 15) >> 4, nch = (nsel + 31) >> 5;
#pragma unroll
        for (int i = 0; i < 4; ++i) { const int s_ = lane + 64 * i; int idx = SEL[(size_t)tg * 256 + s_]; idx = (t < 256) ? s_ : idx; idx = (s_ < nsel && (unsigned)idx <= (unsigned)t) ? idx : 0; sl[s_] = idx; }
        bf16x8 qf[4];
        { const bf16_t* qp = Q + (size_t)tg * D + (4 * g + (fr & 3)) * 128 + 8 * fq;
#pragma unroll
          for (int ks = 0; ks < 4; ++ks) qf[ks] = *(const bf16x8*)(qp + 32 * ks); }
        LDS_WAIT();
        const bf16_t* kbase = K + (size_t)tb * 256 + g * 128;
        const bf16_t* vbase = V + (size_t)tb * 256 + g * 128;
#define ROW_GATHER(basep, chk, bufsel) do { _Pragma("unroll") for (int i_ = 0; i_ < 8; ++i_) { const int r_ = 4 * i_ + fq; const int key_ = sl[32 * (chk) + r_]; \
            __builtin_amdgcn_global_load_lds((const unsigned*)((basep) + (size_t)key_ * 256 + (((unsigned)fr ^ vimg_f((unsigned)r_)) << 3)), \
                                             (LAS unsigned*)(vb + (bufsel) * 8192 + i_ * 1024 + lane * 16), 16, 0, 0); } } while (0)
#define V_GATHER(chk, bufsel) ROW_GATHER(vbase, chk, bufsel)
        f32x4 lg[16];
        ROW_GATHER(kbase, 0, 0);
#pragma unroll
        for (int ch = 0; ch < 8; ++ch) {
            if (ch < 7) ROW_GATHER(kbase, ch + 1, (ch + 1) & 1); else V_GATHER(0, 0);
            asm volatile("s_waitcnt vmcnt(8)" ::: "memory");
            const LAS unsigned char* kb = vb + (ch & 1) * 8192;
#pragma unroll
            for (int rb = 0; rb < 2; ++rb) {
                const int kt = 2 * ch + rb; const unsigned row = 16u * rb + fr;
                f32x4 acc = {0.f, 0.f, 0.f, 0.f};
#pragma unroll
                for (int ks = 0; ks < 4; ++ks) { const bf16x8 kf = *(const LAS bf16x8*)(kb + 256u * row + 16u * ((4u * ks + fq) ^ vimg_f(row))); acc = __builtin_amdgcn_mfma_f32_16x16x32_bf16(qf[ks], kf, acc, 0, 0, 0); }
                const bool ok = (kt * 16 + fr < nsel);
                lg[kt].x = ok ? acc.x : -INFINITY; lg[kt].y = ok ? acc.y : -INFINITY; lg[kt].z = ok ? acc.z : -INFINITY; lg[kt].w = ok ? acc.w : -INFINITY;
            }
            asm volatile("" ::: "memory");
        }
        f32x4 mx = lg[0];
#pragma unroll
        for (int kt = 1; kt < 16; ++kt) { mx.x = fmaxf(mx.x, lg[kt].x); mx.y = fmaxf(mx.y, lg[kt].y); mx.z = fmaxf(mx.z, lg[kt].z); mx.w = fmaxf(mx.w, lg[kt].w); }
#pragma unroll
        for (int o = 1; o < 16; o <<= 1) { mx.x = fmaxf(mx.x, __shfl_xor(mx.x, o)); mx.y = fmaxf(mx.y, __shfl_xor(mx.y, o)); mx.z = fmaxf(mx.z, __shfl_xor(mx.z, o)); mx.w = fmaxf(mx.w, __shfl_xor(mx.w, o)); }
        f32x4 sm = {0.f, 0.f, 0.f, 0.f};
#pragma unroll
        for (int kt = 0; kt < 16; ++kt) { f32x4 p; p.x = __expf(lg[kt].x - mx.x); p.y = __expf(lg[kt].y - mx.y); p.z = __expf(lg[kt].z - mx.z); p.w = __expf(lg[kt].w - mx.w); lg[kt] = p; sm += p; }
#pragma unroll
        for (int o = 1; o < 16; o <<= 1) { sm.x += __shfl_xor(sm.x, o); sm.y += __shfl_xor(sm.y, o); sm.z += __shfl_xor(sm.z, o); sm.w += __shfl_xor(sm.w, o); }
        { const float inv = 1.f / (fq == 0 ? sm.x : fq == 1 ? sm.y : fq == 2 ? sm.z : sm.w);
#pragma unroll
          for (int kt = 0; kt < 16; ++kt) { const float pv = (fq == 0 ? lg[kt].x : fq == 1 ? lg[kt].y : fq == 2 ? lg[kt].z : lg[kt].w) * inv; pT[fq * 256 + kt * 16 + fr] = (unsigned short)(pk_bf16(pv, pv) & 0xffffu); } }
        LDS_WAIT();
        f32x4 oacc[8];
#pragma unroll
        for (int c2 = 0; c2 < 8; ++c2) oacc[c2] = (f32x4){0.f, 0.f, 0.f, 0.f};
        for (int ch = 0; ch < nch; ++ch) {
            if (ch + 1 < nch) { V_GATHER(ch + 1, (ch + 1) & 1); asm volatile("s_waitcnt vmcnt(8)" ::: "memory"); }
            else asm volatile("s_waitcnt vmcnt(0)" ::: "memory");
            const bf16x8 pa = *(const LAS bf16x8*)(pT + (fr & 3) * 256 + 32 * ch + 8 * fq);
            const unsigned cb = vb_addr + (unsigned)(ch & 1) * 8192u;
            unsigned ad[8]; s16x4 r0[8], r1[8];
#pragma unroll
            for (int i = 0; i < 8; ++i) ad[i] = cb + tro[i];
            tr_read8(ad, r0);
#pragma unroll
            for (int i = 0; i < 8; ++i) ad[i] = cb + tro[8 + i];
            tr_read8(ad, r1);
#pragma unroll
            for (int c2 = 0; c2 < 4; ++c2) { const bf16x8 vf = __builtin_shufflevector(r0[2 * c2], r0[2 * c2 + 1], 0, 1, 2, 3, 4, 5, 6, 7); oacc[c2] = __builtin_amdgcn_mfma_f32_16x16x32_bf16(pa, vf, oacc[c2], 0, 0, 0); }
#pragma unroll
            for (int c2 = 0; c2 < 4; ++c2) { const bf16x8 vf = __builtin_shufflevector(r1[2 * c2], r1[2 * c2 + 1], 0, 1, 2, 3, 4, 5, 6, 7); oacc[4 + c2] = __builtin_amdgcn_mfma_f32_16x16x32_bf16(pa, vf, oacc[4 + c2], 0, 0, 0); }
        }
        { bf16_t* op = O + (size_t)tg * D + (4 * g + fq) * 128 + fr;
#pragma unroll
          for (int c2 = 0; c2 < 8; ++c2) { const float ov = (fq == 0 ? oacc[c2].x : fq == 1 ? oacc[c2].y : fq == 2 ? oacc[c2].z : oacc[c2].w); op[16 * c2] = (bf16_t)(pk_bf16(ov, ov) & 0xffffu); } }
        LDS_WAIT();
    }
#undef V_GATHER
#undef ROW_GATHER
}

__device__ __forceinline__ void phase_b4(const Ctx& c) {
    const bf16_t* OB = (const bf16_t*)(c.ws + WS_O); const bf16_t* W = (const bf16_t*)(c.ws + WS_WBOUT); float* H = (float*)(c.ws + WS_H);
    const int fr = c.lane & 15, fq = c.lane >> 4, wr = c.wave >> 1, wc = c.wave & 1;
    for (int u = c.vb; u < 128 * 8; u += c.nb) {
        int mt, nt; map_unit(u, 8, mt, nt);
        const bf16_t* ap[4]; const bf16_t* bp[4];
        rows_regular<64>(ap, OB + (size_t)mt * 128 * D, D, c.tid); rows_regular<64>(bp, W + (size_t)nt * 128 * D, D, c.tid);
        f32x4 acc[4][4];
#pragma unroll
        for (int m = 0; m < 4; ++m)
#pragma unroll
            for (int n = 0; n < 4; ++n) acc[m][n] = *(const f32x4*)(H + (size_t)(mt * 128 + wr * 64 + m * 16 + fr) * D + nt * 128 + wc * 64 + n * 16 + fq * 4);
        gemm_loop<64, 1, true>(c, ap, bp, bp, D, acc, acc);
#pragma unroll
        for (int m = 0; m < 4; ++m)
#pragma unroll
            for (int n = 0; n < 4; ++n) *(f32x4*)(H + (size_t)(mt * 128 + wr * 64 + m * 16 + fr) * D + nt * 128 + wc * 64 + n * 16 + fq * 4) = acc[m][n];
    }
}

constexpr int NPHASE = 22;
__global__ void __launch_bounds__(NTH, 2) mk_fwd(Args args) {
    extern __shared__ __attribute__((aligned(16))) unsigned char lds_raw[];
    Ctx c;
    c.lds = (LAS unsigned char*)lds_raw; c.tid = threadIdx.x; c.lane = c.tid & 63; c.wave = __builtin_amdgcn_readfirstlane(c.tid >> 6);
    c.nb = gridDim.x; { const int bx = blockIdx.x; c.vb = (c.nb % 8 == 0) ? (bx % 8) * (c.nb / 8) + bx / 8 : bx; }
    c.a = (const __attribute__((address_space(4))) Args*)__builtin_amdgcn_kernarg_segment_ptr(); c.ws = args.ws;
    volatile LAS unsigned* st = (volatile LAS unsigned*)(c.lds + LDS_MAIN + 1008);
    const bool multi = (args.ph_hi - args.ph_lo) > 1;
    XcdBarrier bar; bar.bar = (unsigned*)(c.ws + WS_CTL); bar.x = 0; bar.st = st;
    if (multi) {
        if (c.tid == 0) { st[0] = 0u; st[1] = 0u; }
        __syncthreads();
        bar = xcd_barrier_post((unsigned*)(c.ws + WS_CTL), st);
    }
    const int ph_lo = args.ph_lo, ph_hi = args.ph_hi;
#ifndef PH_MASK
#define PH_MASK 0x3fffff
#endif
#define PHON(k) ((PH_MASK >> (k)) & 1)
#define PHASE(k, body) do { if (PHON(k) && ph_lo <= (k) && (k) < ph_hi) { \
        { int t_ = threadIdx.x, vb_ = __builtin_amdgcn_readfirstlane(c.vb); \
          const __attribute__((address_space(4))) Args* ka = (const __attribute__((address_space(4))) Args*)__builtin_amdgcn_kernarg_segment_ptr(); \
          asm volatile("" : "+v"(t_), "+s"(vb_), "+s"(ka)); \
          c.tid = t_; c.lane = t_ & 63; c.wave = __builtin_amdgcn_readfirstlane(t_ >> 6); c.vb = vb_; c.a = ka; c.ws = ka->ws; } \
        body; \
        if (MK_REP == (k)) { __syncthreads(); body; } \
        if ((k) + 1 < ph_hi) xcd_barrier(bar); \
        if ((k) == 3) { for (int xb_ = 0; xb_ < MK_XBAR; ++xb_) xcd_barrier(bar); } } } while (0)
    PHASE(0, phase_prep(c));
    PHASE(1, phase_a1(c));
    PHASE(2, { if (MK_DRY == 2) { phase_a2(c, true); __syncthreads(); } phase_a2(c); });
    PHASE(3, phase_a3(c));
    PHASE(4, { if (MK_DRY == 4) { phase_route(c, 0, true); __syncthreads(); } phase_route(c, 0); });
    PHASE(5, phase_e1(c, 0));
    PHASE(6, phase_e2(c, 0));
    PHASE(7, { if (MK_DRY == 7) { phase_p1(c, 0, true); __syncthreads(); } phase_p1(c, 0); });
    PHASE(8, phase_p2(c, 0));
    PHASE(9, { phase_norm_bf16(c, (const float*)c.a->in[IN_MIXN] + D); convert_moe_layer(c, 1); });
    PHASE(10, phase_b1(c));
    PHASE(11, phase_rope(c));
    PHASE(12, phase_score(c));
    PHASE(13, phase_select(c));
    PHASE(14, phase_attn(c));
    PHASE(15, phase_b4(c));
    PHASE(16, phase_route(c, 1));
    PHASE(17, phase_e1(c, 1));
    PHASE(18, phase_e2(c, 1));
    PHASE(19, phase_p1(c, 1));
    PHASE(20, phase_p2(c, 1));
    PHASE(21, phase_final(c));
}

#ifdef MK_DUMP
__global__ void dump_k(const unsigned char* ws, float* out) {
    const size_t i = (size_t)blockIdx.x * 256 + threadIdx.x;
#if MK_DUMP == 1
    ((f32x4*)out)[i] = ((const f32x4*)(ws + WS_H))[i];
#elif MK_DUMP == 2
    { const u32x2 v = ((const u32x2*)(ws + WS_O))[i]; f32x4 o = {bf_lo(v.x), bf_hi(v.x), bf_lo(v.y), bf_hi(v.y)}; ((f32x4*)out)[i] = o; }
#elif MK_DUMP == 3
    { const int* sp = (const int*)(ws + WS_SEL); f32x4 o = {0.f,0.f,0.f,0.f}; if (i < (size_t)T * 64) { o.x = (float)sp[4*i]; o.y = (float)sp[4*i+1]; o.z = (float)sp[4*i+2]; o.w = (float)sp[4*i+3]; } ((f32x4*)out)[i] = o; }
#elif MK_DUMP == 5
    { const u32x2 v = ((const u32x2*)(ws + WS_XN))[i]; f32x4 o = {bf_lo(v.x), bf_hi(v.x), bf_lo(v.y), bf_hi(v.y)}; ((f32x4*)out)[i] = o; }
#elif MK_DUMP == 6
    { const u32x2 v = ((const u32x2*)(ws + WS_RAW))[i]; f32x4 o = {bf_lo(v.x), bf_hi(v.x), bf_lo(v.y), bf_hi(v.y)}; ((f32x4*)out)[i] = o; }
#elif MK_DUMP == 7
    { f32x4 o = {0.f,0.f,0.f,0.f}; if (i < (size_t)BINP * D / 4) { const u32x2 v = ((const u32x2*)(ws + WS_WBIN))[i]; o = (f32x4){bf_lo(v.x), bf_hi(v.x), bf_lo(v.y), bf_hi(v.y)}; } ((f32x4*)out)[i] = o; }
#elif MK_DUMP == 8
    { const u32x2 v = ((const u32x2*)(ws + WS_RAW))[i], w = ((const u32x2*)(ws + 458 * MB))[i]; f32x4 o = {bf_lo(v.x) - bf_lo(w.x), bf_hi(v.x) - bf_hi(w.x), bf_lo(v.y) - bf_lo(w.y), bf_hi(v.y) - bf_hi(w.y)}; ((f32x4*)out)[i] = o; }
#elif MK_DUMP == 9
    { const u32x2 v = ((const u32x2*)(ws + WS_RAW))[i], w = ((const u32x2*)(ws + 458 * MB))[i]; f32x4 o = {(v.x & 0xffffu) != (w.x & 0xffffu) ? 1.f : 0.f, (v.x >> 16) != (w.x >> 16) ? 1.f : 0.f, (v.y & 0xffffu) != (w.y & 0xffffu) ? 1.f : 0.f, (v.y >> 16) != (w.y >> 16) ? 1.f : 0.f}; ((f32x4*)out)[i] = o; }
#elif MK_DUMP == 4
    { const u32x2 v = ((const u32x2*)(ws + WS_Q))[i]; f32x4 o = {bf_lo(v.x), bf_hi(v.x), bf_lo(v.y), bf_hi(v.y)}; ((f32x4*)out)[i] = o; }
#endif
}
#endif
extern "C" void kernel_launch(void* const* d_in, const int* in_sizes, int n_in, void* d_out, int out_size, void* d_ws, size_t ws_size, hipStream_t stream) {
    static int grid = 0;
    if (grid == 0) {
        if (n_in != 23 || out_size != T * D || ws_size < WS_TOTAL) { fprintf(stderr, "kernel_launch: unexpected sizes n_in %d out %d ws %zu (need %zu)\n", n_in, out_size, ws_size, (size_t)WS_TOTAL); grid = -1; return; }
        int dev = 0, cus = 0, per_cu = 0;
        hipGetDevice(&dev); hipDeviceGetAttribute(&cus, hipDeviceAttributeMultiprocessorCount, dev);
        hipFuncSetAttribute((const void*)mk_fwd, hipFuncAttributeMaxDynamicSharedMemorySize, LDS_BYTES);
        hipOccupancyMaxActiveBlocksPerMultiprocessor(&per_cu, (const void*)mk_fwd, NTH, LDS_BYTES);
        (void)hipGetLastError();
        if (per_cu < 1) per_cu = 1;
        if (per_cu > 2) per_cu = 2;
        grid = cus * per_cu;
    }
    if (grid < 0) return;
    hipMemsetAsync((char*)d_ws + WS_CTL, 0, 16384, stream);
    Args a{};
    for (int i = 0; i < 23; ++i) a.in[i] = d_in[i];
    a.out = (float*)d_out; a.ws = (unsigned char*)d_ws;
#if MK_ONE_LAUNCH
    a.ph_lo = 0; a.ph_hi = NPHASE;
    hipLaunchKernelGGL(mk_fwd, dim3(grid), dim3(NTH), LDS_BYTES, stream, a);
#else
    for (int ph = 0; ph <= MK_LAST_PHASE; ++ph) { a.ph_lo = ph; a.ph_hi = ph + 1; hipLaunchKernelGGL(mk_fwd, dim3(grid), dim3(NTH), LDS_BYTES, stream, a); }
#ifdef MK_DUMP
    hipLaunchKernelGGL(dump_k, dim3(T * D / 4 / 256), dim3(256), 0, stream, (const unsigned char*)d_ws, (float*)d_out);
#endif
#endif
}
```

```cpp
#include <hip/hip_runtime.h>
#include <stdint.h>
#include <stdio.h>

#ifndef MK_LAST_PHASE
#define MK_LAST_PHASE 21
#endif
#ifndef MK_REP
#define MK_REP -1
#endif
#ifndef MK_XBAR
#define MK_XBAR 0
#endif
#ifndef MK_DRY
#define MK_DRY -1
#endif
#ifndef MK_ONE_LAUNCH
#define MK_ONE_LAUNCH 1
#endif

#define LAS __attribute__((address_space(3)))
typedef unsigned short bf16_t;
typedef short bf16x8 __attribute__((ext_vector_type(8)));
typedef float f32x4 __attribute__((ext_vector_type(4)));
typedef float f32x2 __attribute__((ext_vector_type(2)));
typedef float f32x16 __attribute__((ext_vector_type(16)));
typedef unsigned u32x4 __attribute__((ext_vector_type(4)));
typedef unsigned u32x2 __attribute__((ext_vector_type(2)));
typedef long i64x2 __attribute__((ext_vector_type(2)));

constexpr int T = 16384, D = 1024, SEQ = 4096;
constexpr int GW = 2048;
constexpr int BIN = 2120, BINP = 2176;
constexpr int NE = 32, DE = 512;
constexpr int PLE = 256;
constexpr float EPS = 1e-6f;
constexpr int NTH = 256;
constexpr int LDS_MAIN = 4 * 19456;
constexpr int LDS_BYTES = LDS_MAIN + 1024;
constexpr int RPAD = 32768 + NE * 128;

constexpr size_t MB = 1024 * 1024;
constexpr size_t WS_CTL = 0;
constexpr size_t WS_CNT = 16384;
constexpr size_t WS_WR = 32768;
constexpr size_t WS_WAIN = 1 * MB;
constexpr size_t WS_WAOUT = WS_WAIN + 8 * MB;
constexpr size_t WS_WBIN = WS_WAOUT + 4 * MB;
constexpr size_t WS_WBOUT = WS_WBIN + 5 * MB;
constexpr size_t WS_WGATE = WS_WBOUT + 2 * MB;
constexpr size_t WS_WPROJ = WS_WGATE + 4 * MB;
constexpr size_t WS_W1 = WS_WPROJ + 1 * MB;
constexpr size_t WS_XN8 = WS_W1 + 16 * MB;
constexpr size_t WS_W3 = WS_W1 + 32 * MB;
constexpr size_t WS_W2 = WS_W3 + 32 * MB;
constexpr size_t WS_PBF = WS_W2 + 32 * MB;
constexpr size_t WS_XN = WS_PBF + 16 * MB;
constexpr size_t WS_H = WS_XN + 32 * MB;
constexpr size_t WS_LIST = WS_H + 64 * MB;
constexpr size_t WS_GATE = WS_LIST + 2 * MB;
constexpr size_t WS_TOKSLOT = WS_GATE + 2 * MB;
constexpr size_t WS_SCR = WS_TOKSLOT + 1 * MB;
constexpr size_t WS_U = WS_SCR;
constexpr size_t WS_VT = WS_SCR + 64 * MB;
constexpr size_t WS_VSS = WS_SCR + 128 * MB;
constexpr size_t WS_HMID = WS_SCR;
constexpr size_t WS_Y = WS_SCR + 36 * MB;
constexpr size_t WS_RAW = WS_SCR;
constexpr size_t WS_O = WS_SCR;
constexpr size_t WS_Q = WS_SCR + 68 * MB;
constexpr size_t WS_K = WS_Q + 32 * MB;
constexpr size_t WS_V = WS_K + 8 * MB;
constexpr size_t WS_QI = WS_V + 8 * MB;
constexpr size_t WS_KI = WS_QI + 16 * MB;
constexpr size_t WS_WI = WS_KI + 2 * MB;
constexpr size_t WS_SEL = WS_WI + 1 * MB;
constexpr size_t WS_END = WS_SEL + 16 * MB;
static_assert(WS_END <= WS_SCR + 152 * MB, "scratch");
constexpr size_t WS_S = 392 * MB;
constexpr size_t WS_TOTAL = 522 * MB;

typedef __bf16 bf16x2_t __attribute__((ext_vector_type(2)));
__device__ __forceinline__ unsigned pk_bf16(float lo, float hi) { f32x2 v = {lo, hi}; bf16x2_t b = __builtin_convertvector(v, bf16x2_t); return __builtin_bit_cast(unsigned, b); }
__device__ __forceinline__ float bf_lo(unsigned u) { return __uint_as_float(u << 16); }
__device__ __forceinline__ float bf_hi(unsigned u) { return __uint_as_float(u & 0xffff0000u); }
__device__ __forceinline__ float wave_sum(float v) {
#pragma unroll
    for (int o = 1; o < 64; o <<= 1) v += __shfl_xor(v, o);
    return v;
}
__device__ __forceinline__ int lds_inc(LAS int* p) { return __hip_atomic_fetch_add(p, 1, __ATOMIC_RELAXED, __HIP_MEMORY_SCOPE_WORKGROUP); }
#define LDS_WAIT() asm volatile("s_waitcnt lgkmcnt(0)" ::: "memory")
#define VM_WAIT() asm volatile("s_waitcnt vmcnt(0)" ::: "memory")

#define XB_TMO      128
#define XB_XCNT(j)  (256  + 64 * (j))
#define XB_XSUB(j)  (1280 + 64 * (j))
#define XB_XGEN(j)  (2304 + 64 * (j))
#define XB_TOP      3328
#define XB_TOPGEN   3392
#define XCD_BAR_WORDS 3456
#define XB_SPIN_CAP (1u << 20)
__device__ __forceinline__ unsigned xb_ld(unsigned* p)              { return __hip_atomic_load(p, __ATOMIC_RELAXED, __HIP_MEMORY_SCOPE_AGENT); }
__device__ __forceinline__ unsigned xb_add(unsigned* p, unsigned v) { return __hip_atomic_fetch_add(p, v, __ATOMIC_RELAXED, __HIP_MEMORY_SCOPE_AGENT); }
__device__ __forceinline__ unsigned xb_xcc_id() { return (unsigned)__builtin_amdgcn_s_getreg((3 << 11) | 20) & 0xFu; }
#define XB_SPIN(cond, bar) do { unsigned _sp = 0; while (cond) { __builtin_amdgcn_s_sleep(1); \
    if ((++_sp & 255u) == 0u) { if (xb_ld(&(bar)[XB_TMO])) break; if (_sp > XB_SPIN_CAP) { atomicAdd(&(bar)[XB_TMO], 1u); break; } } } } while (0)
struct XcdBarrier { unsigned* bar; unsigned x; volatile LAS unsigned* st; };
__device__ __forceinline__ XcdBarrier xcd_barrier_post(unsigned* bar, volatile LAS unsigned* st) {
    XcdBarrier b; b.bar = bar; b.x = xb_xcc_id(); b.st = st;
    if (threadIdx.x == 0) (void)xb_add(&bar[XB_XCNT(b.x)], 1u);
    return b;
}
__device__ __forceinline__ void xcd_barrier_complete(unsigned* bar, unsigned x, unsigned& nloc, unsigned& nx) {
    const unsigned G = gridDim.x;
    unsigned sum, cnt, mine, sp = 0u;
    for (;;) {
        sum = 0u; cnt = 0u; mine = 0u;
#pragma unroll
        for (unsigned j = 0; j < 16; ++j) { const unsigned c = xb_ld(&bar[XB_XCNT(j)]); sum += c; cnt += (c > 0u) ? 1u : 0u; mine = (j == x) ? c : mine; }
        if (sum == G) break;
        __builtin_amdgcn_s_sleep(1);
        if ((++sp & 255u) == 0u) { if (xb_ld(&bar[XB_TMO])) break; if (sp > XB_SPIN_CAP) { atomicAdd(&bar[XB_TMO], 1u); break; } }
    }
    nloc = mine > 0u ? mine : 1u; nx = cnt > 0u ? cnt : 1u;
}
__device__ __forceinline__ void xcd_barrier(const XcdBarrier& b) {
    asm volatile("s_waitcnt vmcnt(0)" ::: "memory");
    __syncthreads();
    if (threadIdx.x == 0) {
        unsigned* bar = b.bar;
        __builtin_amdgcn_s_waitcnt(0);
        unsigned nloc = b.st[0], nx = b.st[1];
        if (nloc == 0u) { xcd_barrier_complete(bar, b.x, nloc, nx); b.st[0] = nloc; b.st[1] = nx; }
        const unsigned old = xb_add(&bar[XB_XSUB(b.x)], 1u);
        const unsigned gen = old / nloc;
        if (old + 1u == (gen + 1u) * nloc) {
            __builtin_amdgcn_fence(__ATOMIC_RELEASE, "agent");
            asm volatile("s_waitcnt vmcnt(0)" ::: "memory");
            const unsigned og = xb_add(&bar[XB_TOP], 1u);
            const unsigned tg = og / nx;
            if (og + 1u == (tg + 1u) * nx) xb_add(&bar[XB_TOPGEN], 1u);
            else XB_SPIN(xb_ld(&bar[XB_TOPGEN]) == tg, bar);
            __builtin_amdgcn_fence(__ATOMIC_ACQUIRE, "agent");
            xb_add(&bar[XB_XGEN(b.x)], 1u);
            asm volatile("s_waitcnt vmcnt(0)" ::: "memory");
        } else {
            XB_SPIN(xb_ld(&bar[XB_XGEN(b.x)]) == gen, bar);
            __builtin_amdgcn_fence(__ATOMIC_ACQUIRE, "agent");
            asm volatile("s_waitcnt vmcnt(0)" ::: "memory");
        }
    }
    __syncthreads();
}

struct Args { const void* in[23]; float* out; unsigned char* ws; int ph_lo, ph_hi; };
enum { IN_X = 0, IN_P, IN_POS, IN_MIXN, IN_AWIN, IN_AVG, IN_AWS, IN_ABS, IN_AWOUT, IN_BWIN, IN_BWOUT, IN_FFNN, IN_WG, IN_BG, IN_WE, IN_BE,
       IN_W1, IN_W3, IN_W2, IN_PLEN, IN_PLEG, IN_PLEP, IN_FINN };

struct Ctx {
    LAS unsigned char* lds;
    int tid, lane, wave, vb, nb;
    const __attribute__((address_space(4))) Args* a;
    unsigned char* ws;
};

template <int BK> struct TileK { static constexpr int NP = (BK == 64) ? 4 : 2; static constexpr int TB = 128 * BK * 2; };

template <int BK>
__device__ __forceinline__ void stage_tile(LAS unsigned char* tile, const bf16_t* const (&rp)[TileK<BK>::NP], int k0, int tid) {
    const int lc = (BK == 64) ? ((tid & 7) ^ ((tid >> 3) & 7)) : ((tid & 3) ^ ((tid >> 3) & 3));
#pragma unroll
    for (int p = 0; p < TileK<BK>::NP; ++p)
        __builtin_amdgcn_global_load_lds((const unsigned*)(rp[p] + k0 + lc * 8), (LAS unsigned*)(tile + p * 4096 + tid * 16), 16, 0, 0);
}
template <int BK>
__device__ __forceinline__ void rows_regular(const bf16_t* (&rp)[TileK<BK>::NP], const bf16_t* base, size_t ld, int tid) {
#pragma unroll
    for (int p = 0; p < TileK<BK>::NP; ++p) { const int r = (BK == 64) ? (p * 32 + (tid >> 3)) : (p * 64 + (tid >> 2)); rp[p] = base + (size_t)r * ld; }
}
template <int BK>
__device__ __forceinline__ int frag_off(int row, int ks, int fq) {
    return (BK == 64) ? (row * 128 + (((ks * 4 + fq) ^ (row & 7)) << 4)) : (row * 64 + ((fq ^ ((row >> 1) & 3)) << 4));
}

template <int BK, int NBOP, bool SWAP, bool FP8 = false>
__device__ __forceinline__ void gemm_loop(const Ctx& c, const bf16_t* const (&ap)[TileK<BK>::NP], const bf16_t* const (&b0p)[TileK<BK>::NP], const bf16_t* const (&b1p)[TileK<BK>::NP],
                                          int K, f32x4 (&acc0)[4][4], f32x4 (&acc1)[4][4]) {
    constexpr int TB = TileK<BK>::TB, SB = (1 + NBOP) * TB;
    static_assert(2 * SB <= LDS_MAIN, "lds");
    const int nk = K / BK, tid = c.tid;
    const int fr = c.lane & 15, fq = c.lane >> 4, wr = c.wave >> 1, wc = c.wave & 1;
    LAS unsigned char* lds = c.lds;
    stage_tile<BK>(lds, ap, 0, tid); stage_tile<BK>(lds + TB, b0p, 0, tid);
    if (NBOP == 2) stage_tile<BK>(lds + 2 * TB, b1p, 0, tid);
    for (int kt = 0; kt < nk; ++kt) {
        VM_WAIT();
        __syncthreads();
        LAS unsigned char* cur = lds + (kt & 1) * SB;
        if (kt + 1 < nk) {
            LAS unsigned char* nxt = lds + ((kt + 1) & 1) * SB;
            stage_tile<BK>(nxt, ap, (kt + 1) * BK, tid); stage_tile<BK>(nxt + TB, b0p, (kt + 1) * BK, tid);
            if (NBOP == 2) stage_tile<BK>(nxt + 2 * TB, b1p, (kt + 1) * BK, tid);
        }
#pragma unroll
        for (int ks = 0; ks < BK / 32; ++ks) {
            bf16x8 af[4], bf0[4], bf1[4];
#pragma unroll
            for (int m = 0; m < 4; ++m) af[m] = *(const LAS bf16x8*)(cur + frag_off<BK>(wr * 64 + m * 16 + fr, ks, fq));
#pragma unroll
            for (int n = 0; n < 4; ++n) bf0[n] = *(const LAS bf16x8*)(cur + TB + frag_off<BK>(wc * 64 + n * 16 + fr, ks, fq));
            if (NBOP == 2) {
#pragma unroll
                for (int n = 0; n < 4; ++n) bf1[n] = *(const LAS bf16x8*)(cur + 2 * TB + frag_off<BK>(wc * 64 + n * 16 + fr, ks, fq));
            }
#pragma unroll
            for (int m = 0; m < 4; ++m)
#pragma unroll
                for (int n = 0; n < 4; ++n) {
                    if (FP8) {
                        const i64x2 a2 = __builtin_bit_cast(i64x2, af[m]), b2 = __builtin_bit_cast(i64x2, bf0[n]);
                        if (SWAP) { acc0[m][n] = __builtin_amdgcn_mfma_f32_16x16x32_fp8_fp8(b2.x, a2.x, acc0[m][n], 0, 0, 0); acc0[m][n] = __builtin_amdgcn_mfma_f32_16x16x32_fp8_fp8(b2.y, a2.y, acc0[m][n], 0, 0, 0); }
                        else      { acc0[m][n] = __builtin_amdgcn_mfma_f32_16x16x32_fp8_fp8(a2.x, b2.x, acc0[m][n], 0, 0, 0); acc0[m][n] = __builtin_amdgcn_mfma_f32_16x16x32_fp8_fp8(a2.y, b2.y, acc0[m][n], 0, 0, 0); }
                        continue;
                    }
                    if (SWAP) acc0[m][n] = __builtin_amdgcn_mfma_f32_16x16x32_bf16(bf0[n], af[m], acc0[m][n], 0, 0, 0);
                    else      acc0[m][n] = __builtin_amdgcn_mfma_f32_16x16x32_bf16(af[m], bf0[n], acc0[m][n], 0, 0, 0);
                    if (NBOP == 2) {
                        if (SWAP) acc1[m][n] = __builtin_amdgcn_mfma_f32_16x16x32_bf16(bf1[n], af[m], acc1[m][n], 0, 0, 0);
                        else      acc1[m][n] = __builtin_amdgcn_mfma_f32_16x16x32_bf16(af[m], bf1[n], acc1[m][n], 0, 0, 0);
                    }
                }
        }
    }
    __syncthreads();
}
__device__ __forceinline__ void zero_acc(f32x4 (&acc)[4][4]) {
#pragma unroll
    for (int m = 0; m < 4; ++m)
#pragma unroll
        for (int n = 0; n < 4; ++n) acc[m][n] = (f32x4){0.f, 0.f, 0.f, 0.f};
}
__device__ __forceinline__ void map_unit(int u, int nnt, int& mt, int& nt) { const int per = 8 * nnt, band = u / per, r = u - band * per; nt = r >> 3; mt = band * 8 + (r & 7); }


__device__ __forceinline__ float gelu_tanh(float x) {
    const float y2 = 1.5957691216057308f * (x + 0.044715f * x * x * x);
    return x / (1.f + __expf(-y2));
}
__device__ __forceinline__ float sigmoidf_(float x) { return 1.f / (1.f + __expf(-x)); }

__device__ __forceinline__ void row_load(const float* row, int lane, f32x4 (&v)[4]) {
#pragma unroll
    for (int j = 0; j < 4; ++j) v[j] = ((const f32x4*)row)[lane + 64 * j];
}
__device__ __forceinline__ float row_sumsq(const f32x4 (&v)[4]) {
    float s = 0.f;
#pragma unroll
    for (int j = 0; j < 4; ++j) s += (v[j].x * v[j].x + v[j].y * v[j].y) + (v[j].z * v[j].z + v[j].w * v[j].w);
    return wave_sum(s);
}
__device__ __forceinline__ void gain_load(const float* gain, int lane, f32x4 (&g)[4]) {
#pragma unroll
    for (int j = 0; j < 4; ++j) g[j] = ((const f32x4*)gain)[lane + 64 * j];
}
__device__ __forceinline__ void row_store_norm_bf16(bf16_t* orow, int lane, const f32x4 (&v)[4], float r, const f32x4 (&gv)[4]) {
#pragma unroll
    for (int j = 0; j < 4; ++j) {
        const f32x4 g = gv[j];
        u32x2 o; o.x = pk_bf16(v[j].x * r * g.x, v[j].y * r * g.y); o.y = pk_bf16(v[j].z * r * g.z, v[j].w * r * g.w);
        ((u32x2*)orow)[lane + 64 * j] = o;
    }
}

__device__ __forceinline__ unsigned pk_fp8x4(float a, float b, float c_, float d);
__device__ __forceinline__ void row_store_norm_fp8(unsigned char* orow, int lane, const f32x4 (&v)[4], float r, const f32x4 (&gv)[4]) {
#pragma unroll
    for (int j = 0; j < 4; ++j) ((unsigned*)orow)[lane + 64 * j] = pk_fp8x4(v[j].x * r * gv[j].x, v[j].y * r * gv[j].y, v[j].z * r * gv[j].z, v[j].w * r * gv[j].w);
}
constexpr int TR_SCR = 64 * 136;
__device__ __forceinline__ void transpose_item(const float* W, int K, int N, int nvalid, int ldw, bf16_t* WT, LAS unsigned char* scr, int item, int lane) {
    const int nblk = N / 64, kb = item / nblk, nb = item - kb * nblk, k0 = 64 * kb, n0 = 64 * nb;
    const int n = n0 + 4 * (lane & 15);
    const int nc_ = (n < nvalid) ? n : 0; const float keep = (n < nvalid) ? 1.f : 0.f;
    f32x4 v[16];
#pragma unroll
    for (int i = 0; i < 16; ++i) v[i] = *(const f32x4*)(W + (size_t)(k0 + 4 * i + (lane >> 4)) * ldw + nc_);
#pragma unroll
    for (int i = 0; i < 16; ++i) {
        const int kk = 4 * i + (lane >> 4);
        u32x2 o; o.x = pk_bf16(v[i].x * keep, v[i].y * keep); o.y = pk_bf16(v[i].z * keep, v[i].w * keep);
        *(LAS u32x2*)(scr + kk * 136 + (lane & 15) * 8) = o;
    }
    LDS_WAIT();
    const int cc = lane & 7;
#pragma unroll
    for (int j = 0; j < 8; ++j) {
        const int nn = (lane >> 3) + 8 * j; const LAS unsigned short* sp = (const LAS unsigned short*)(scr + (8 * cc) * 136 + nn * 2);
        u32x4 o;
        o.x = (unsigned)sp[0 * 68] | ((unsigned)sp[1 * 68] << 16); o.y = (unsigned)sp[2 * 68] | ((unsigned)sp[3 * 68] << 16);
        o.z = (unsigned)sp[4 * 68] | ((unsigned)sp[5 * 68] << 16); o.w = (unsigned)sp[6 * 68] | ((unsigned)sp[7 * 68] << 16);
        *(u32x4*)(WT + (size_t)(n0 + nn) * K + k0 + 8 * cc) = o;
    }
    LDS_WAIT();
}

__device__ __forceinline__ unsigned pk_fp8x4(float a, float b, float c_, float d) {
    a = fminf(fmaxf(a, -448.f), 448.f); b = fminf(fmaxf(b, -448.f), 448.f); c_ = fminf(fmaxf(c_, -448.f), 448.f); d = fminf(fmaxf(d, -448.f), 448.f);
    int p = __builtin_amdgcn_cvt_pk_fp8_f32(a, b, 0, false);
    p = __builtin_amdgcn_cvt_pk_fp8_f32(c_, d, p, true);
    return (unsigned)p;
}
constexpr float W8_SCALE = 64.f, H8_SCALE = 4.f, O8_SCALE = 8.f;
__device__ __forceinline__ void transpose_item8(const float* W, int K, int N, unsigned char* WT, LAS unsigned char* scr, int item, int lane, int nvalid = 1 << 30, int ldw = 0) {
    const int nblk = N / 64, kb = item / nblk, nb = item - kb * nblk, k0 = 128 * kb, n0 = 64 * nb;
    const int n = n0 + 4 * (lane & 15), ld = ldw ? ldw : N, nc_ = (n < nvalid) ? n : 0; const float keep = (n < nvalid) ? W8_SCALE : 0.f;
#pragma unroll 2
    for (int h = 0; h < 2; ++h) {
        f32x4 v[16];
#pragma unroll
        for (int i = 0; i < 16; ++i) v[i] = *(const f32x4*)(W + (size_t)(k0 + 64 * h + 4 * i + (lane >> 4)) * ld + nc_);
#pragma unroll
        for (int i = 0; i < 16; ++i) { const int kk = 64 * h + 4 * i + (lane >> 4);
            *(LAS unsigned*)(scr + kk * 68 + (lane & 15) * 4) = pk_fp8x4(v[i].x * keep, v[i].y * keep, v[i].z * keep, v[i].w * keep); }
    }
    LDS_WAIT();
    const int cc = lane & 7;
#pragma unroll
    for (int j = 0; j < 8; ++j) {
        const int nn = (lane >> 3) + 8 * j; const LAS unsigned char* sp = scr + (16 * cc) * 68 + nn;
        unsigned w[4];
#pragma unroll
        for (int q = 0; q < 4; ++q) w[q] = (unsigned)sp[(4 * q + 0) * 68] | ((unsigned)sp[(4 * q + 1) * 68] << 8) | ((unsigned)sp[(4 * q + 2) * 68] << 16) | ((unsigned)sp[(4 * q + 3) * 68] << 24);
        u32x4 o = {w[0], w[1], w[2], w[3]};
        *(u32x4*)(WT + (size_t)(n0 + nn) * K + k0 + 16 * cc) = o;
    }
    LDS_WAIT();
}
__device__ __forceinline__ void convert_moe_layer(const Ctx& c, int l) {
    LAS unsigned char* scr = c.lds + c.wave * TR_SCR;
    const int gw = c.vb * 4 + c.wave, ngw = c.nb * 4;
    const float* w1 = (const float*)c.a->in[IN_W1] + (size_t)l * NE * D * DE;
    const float* w3 = (const float*)c.a->in[IN_W3] + (size_t)l * NE * D * DE;
    const float* w2 = (const float*)c.a->in[IN_W2] + (size_t)l * NE * DE * D;
    unsigned char* W1 = c.ws + WS_W1; unsigned char* W3 = c.ws + WS_W3; unsigned char* W2 = c.ws + WS_W2;
    for (int it = gw; it < NE * 192; it += ngw) {
        const int e = it / 192, r = it - e * 192;
        if (r < 64)       transpose_item8(w1 + (size_t)e * D * DE, D, DE, W1 + (size_t)e * DE * D, scr, r, c.lane);
        else if (r < 128) transpose_item8(w3 + (size_t)e * D * DE, D, DE, W3 + (size_t)e * DE * D, scr, r - 64, c.lane);
        else              transpose_item8(w2 + (size_t)e * DE * D, DE, D, W2 + (size_t)e * D * DE, scr, r - 128, c.lane);
    }
}

__device__ __forceinline__ void phase_prep(const Ctx& c) {
    const __attribute__((address_space(4))) Args& a = *c.a;
    LAS unsigned char* scr = c.lds + c.wave * TR_SCR;
    const int gw = c.vb * 4 + c.wave, ngw = c.nb * 4;
    constexpr int I_AIN = 16 * 64, I_AOUT = 32 * 16, I_PP = 4 * 16, I_BIN8 = 8 * 34, I_BOUT8 = 8 * 16, I_PG8 = 8 * 16, I_BINI = 16 * 10;
    constexpr int NIT = I_AIN + I_AOUT + 2 * I_PP + I_BIN8 + I_BOUT8 + 2 * I_PG8 + I_BINI;
    for (int it = gw; it < NIT; it += ngw) {
        int r = it;
        if (r < I_AIN) { transpose_item((const float*)a.in[IN_AWIN], D, 4096, 4096, 4096, (bf16_t*)(c.ws + WS_WAIN), scr, r, c.lane); continue; } r -= I_AIN;
        if (r < I_AOUT) { transpose_item((const float*)a.in[IN_AWOUT], GW, D, D, D, (bf16_t*)(c.ws + WS_WAOUT), scr, r, c.lane); continue; } r -= I_AOUT;
        if (r < 2 * I_PP) { const int l = r / I_PP; transpose_item((const float*)a.in[IN_PLEP] + (size_t)l * PLE * D, PLE, D, D, D, (bf16_t*)(c.ws + WS_WPROJ) + (size_t)l * D * PLE, scr, r - l * I_PP, c.lane); continue; } r -= 2 * I_PP;
        if (r < I_BIN8) { transpose_item8((const float*)a.in[IN_BWIN], D, BINP, c.ws + WS_WBIN, scr, r, c.lane, BIN, BIN); continue; } r -= I_BIN8;
        if (r < I_BOUT8) { transpose_item8((const float*)a.in[IN_BWOUT], D, D, c.ws + WS_WBOUT, scr, r, c.lane); continue; } r -= I_BOUT8;
        if (r < 2 * I_PG8) { const int l = r / I_PG8; transpose_item8((const float*)a.in[IN_PLEG] + (size_t)l * D * D, D, D, c.ws + WS_WGATE + (size_t)l * D * D, scr, r - l * I_PG8, c.lane); continue; } r -= 2 * I_PG8;
        transpose_item((const float*)a.in[IN_BWIN] + 1536, D, 640, BIN - 1536, BIN, (bf16_t*)(c.ws + WS_WBIN + 3 * MB), scr, r, c.lane);
    }
    convert_moe_layer(c, 0);
    const int gt = c.vb * NTH + c.tid, ngt = c.nb * NTH;
    { const float* p = (const float*)a.in[IN_P]; bf16_t* pb = (bf16_t*)(c.ws + WS_PBF);
      for (int i = gt; i < 2 * T * PLE / 8; i += ngt) {
          const f32x4 v0 = ((const f32x4*)p)[2 * i], v1 = ((const f32x4*)p)[2 * i + 1];
          u32x4 o; o.x = pk_bf16(v0.x, v0.y); o.y = pk_bf16(v0.z, v0.w); o.z = pk_bf16(v1.x, v1.y); o.w = pk_bf16(v1.z, v1.w);
          ((u32x4*)pb)[i] = o; } }
    { float* wr = (float*)(c.ws + WS_WR);
      for (int i = gt; i < 2 * D * 48; i += ngt) {
          const int l = i / (D * 48), r = i - l * D * 48, k = r / 48, o = r - k * 48;
          float w = 0.f;
          if (o < 4) w = ((const float*)a.in[IN_WG])[(size_t)l * D * 4 + k * 4 + o];
          else if (o < 36) w = ((const float*)a.in[IN_WE])[(size_t)l * D * 32 + k * 32 + (o - 4)];
          wr[i] = w * ((const float*)a.in[IN_FFNN])[l * D + k]; } }
    if (c.vb == 0 && c.tid < 128) ((int*)(c.ws + WS_CNT))[c.tid] = 0;
    f32x4 gv[4]; gain_load((const float*)a.in[IN_MIXN], c.lane, gv);
    for (int t = gw; t < T; t += ngw) {
        f32x4 v[4]; row_load((const float*)a.in[IN_X] + (size_t)t * D, c.lane, v);
        const float r = rsqrtf(row_sumsq(v) * (1.f / D) + EPS);
        row_store_norm_bf16((bf16_t*)(c.ws + WS_XN) + (size_t)t * D, c.lane, v, r, gv);
    }
}

__device__ __forceinline__ void phase_a1(const Ctx& c) {
    const bf16_t* XN = (const bf16_t*)(c.ws + WS_XN); const bf16_t* W = (const bf16_t*)(c.ws + WS_WAIN);
    bf16_t* U = (bf16_t*)(c.ws + WS_U); bf16_t* VT = (bf16_t*)(c.ws + WS_VT); float* VSS = (float*)(c.ws + WS_VSS);
    const int fr = c.lane & 15, fq = c.lane >> 4, wr = c.wave >> 1, wc = c.wave & 1;
    for (int u = c.vb; u < 128 * 32; u += c.nb) {
        int mt, nt; map_unit(u, 32, mt, nt);
        const bf16_t* ap[4]; const bf16_t* bp[4];
        rows_regular<64>(ap, XN + (size_t)mt * 128 * D, D, c.tid); rows_regular<64>(bp, W + (size_t)nt * 128 * D, D, c.tid);
        f32x4 acc[4][4]; zero_acc(acc);
        if (nt < 16) {
            gemm_loop<64, 1, true>(c, ap, bp, bp, D, acc, acc);
#pragma unroll
            for (int m = 0; m < 4; ++m)
#pragma unroll
                for (int n = 0; n < 4; ++n) {
                    const int t = mt * 128 + wr * 64 + m * 16 + fr, col = nt * 128 + wc * 64 + n * 16 + fq * 4;
                    const f32x4 v = acc[m][n];
                    u32x2 o; o.x = pk_bf16(gelu_tanh(v.x), gelu_tanh(v.y)); o.y = pk_bf16(gelu_tanh(v.z), gelu_tanh(v.w));
                    *(u32x2*)(U + (size_t)t * GW + col) = o;
                }
        } else {
            gemm_loop<64, 1, false>(c, ap, bp, bp, D, acc, acc);
            const int vn = nt - 16;
#pragma unroll
            for (int m = 0; m < 4; ++m) {
                f32x4 ss = {0.f, 0.f, 0.f, 0.f};
                const int t0 = mt * 128 + wr * 64 + m * 16 + fq * 4;
#pragma unroll
                for (int n = 0; n < 4; ++n) {
                    const int ch = vn * 128 + wc * 64 + n * 16 + fr;
                    f32x4 v = acc[m][n];
                    v.x = gelu_tanh(v.x); v.y = gelu_tanh(v.y); v.z = gelu_tanh(v.z); v.w = gelu_tanh(v.w);
                    ss += v * v;
                    u32x2 o; o.x = pk_bf16(v.x, v.y); o.y = pk_bf16(v.z, v.w);
                    *(u32x2*)(VT + (size_t)ch * T + t0) = o;
                }
#pragma unroll
                for (int o = 1; o < 16; o <<= 1) { ss.x += __shfl_xor(ss.x, o); ss.y += __shfl_xor(ss.y, o); ss.z += __shfl_xor(ss.z, o); ss.w += __shfl_xor(ss.w, o); }
                if (fr == 0) {
                    VSS[(size_t)(t0 + 0) * 32 + vn * 2 + wc] = ss.x; VSS[(size_t)(t0 + 1) * 32 + vn * 2 + wc] = ss.y;
                    VSS[(size_t)(t0 + 2) * 32 + vn * 2 + wc] = ss.z; VSS[(size_t)(t0 + 3) * 32 + vn * 2 + wc] = ss.w;
                }
            }
        }
    }
}

__device__ __forceinline__ void phase_a2(const Ctx& c, bool dry = false) {
    const __attribute__((address_space(4))) Args& a = *c.a;
    bf16_t* U = (bf16_t*)(c.ws + WS_U); const bf16_t* VT = (const bf16_t*)(c.ws + WS_VT); const float* VSS = (const float*)(c.ws + WS_VSS);
    const float* ws_ = (const float*)a.in[IN_AWS]; const float* bs_ = (const float*)a.in[IN_ABS]; const float* vg = (const float*)a.in[IN_AVG];
    const int fr = c.lane & 15, fq = c.lane >> 4, wr = c.wave >> 1, wc = c.wave & 1, tid = c.tid;
    LAS unsigned char* lds = c.lds;
    LAS float* rl = (LAS float*)(lds + LDS_MAIN);
    for (int u = c.vb; u < 128 * 8; u += c.nb) {
        const int ci = u >> 3, g = u & 7, tokbase = ci * 128;
        __syncthreads();
        if (tid < 128) {
            const float* p = VSS + (size_t)(tokbase + tid) * 32; float s = 0.f;
#pragma unroll
            for (int i = 0; i < 8; ++i) { const f32x4 q = ((const f32x4*)p)[i]; s += (q.x + q.y) + (q.z + q.w); }
            rl[tid] = rsqrtf(s * (1.f / GW) + EPS);
        }
        __syncthreads();
        {
            const int t = tid >> 1, half = tid & 1;
            const float* wrow = ws_ + ((size_t)g * 128 + t) * 128 + half * 64;
#pragma unroll
            for (int cc = 0; cc < 8; ++cc) {
                const int s0 = half * 64 + cc * 8;
                u32x4 o;
                {
                    const f32x4 w0 = ((const f32x4*)wrow)[2 * cc], w1 = ((const f32x4*)wrow)[2 * cc + 1];
                    float e[8] = {w0.x, w0.y, w0.z, w0.w, w1.x, w1.y, w1.z, w1.w};
#pragma unroll
                    for (int i = 0; i < 8; ++i) e[i] = (s0 + i <= t) ? e[i] * rl[s0 + i] : 0.f;
                    o.x = pk_bf16(e[0], e[1]); o.y = pk_bf16(e[2], e[3]); o.z = pk_bf16(e[4], e[5]); o.w = pk_bf16(e[6], e[7]);
                }
                *(LAS u32x4*)(lds + half * 16384 + t * 128 + ((cc ^ (t & 7)) << 4)) = o;
            }
        }
        for (int hn = 0; hn < 2; ++hn) {
            const int c0 = g * 256 + hn * 128;
            const bf16_t* bp[4]; rows_regular<64>(bp, VT + (size_t)c0 * T + tokbase, T, tid);
            stage_tile<64>(lds + 32768, bp, 0, tid); stage_tile<64>(lds + 32768 + 16384, bp, 64, tid);
            VM_WAIT();
            __syncthreads();
            f32x4 acc[4][4]; zero_acc(acc);
#pragma unroll 1
            for (int kh = 0; kh < 2; ++kh)
#pragma unroll 1
                for (int ks = 0; ks < 2; ++ks) {
                    bf16x8 af[4], bf[4];
#pragma unroll
                    for (int m = 0; m < 4; ++m) af[m] = *(const LAS bf16x8*)(lds + kh * 16384 + frag_off<64>(wr * 64 + m * 16 + fr, ks, fq));
#pragma unroll
                    for (int n = 0; n < 4; ++n) bf[n] = *(const LAS bf16x8*)(lds + 32768 + kh * 16384 + frag_off<64>(wc * 64 + n * 16 + fr, ks, fq));
#pragma unroll
                    for (int m = 0; m < 4; ++m)
#pragma unroll
                        for (int n = 0; n < 4; ++n) acc[m][n] = __builtin_amdgcn_mfma_f32_16x16x32_bf16(bf[n], af[m], acc[m][n], 0, 0, 0);
                }
            u32x2 uvv[4][4]; float bsvv[4];
#pragma unroll
            for (int m = 0; m < 4; ++m) { const int tl = wr * 64 + m * 16 + fr; bsvv[m] = bs_[g * 128 + tl];
#pragma unroll
                for (int n = 0; n < 4; ++n) uvv[m][n] = *(const u32x2*)(U + (size_t)(tokbase + tl) * GW + c0 + wc * 64 + n * 16 + fq * 4); }
#pragma unroll
            for (int m = 0; m < 4; ++m) {
                const int tl = wr * 64 + m * 16 + fr; const float bsv = bsvv[m];
#pragma unroll
                for (int n = 0; n < 4; ++n) {
                    const int ch = c0 + wc * 64 + n * 16 + fq * 4;
                    const f32x4 gn = *(const f32x4*)(vg + ch);
                    u32x2* up = (u32x2*)(U + (size_t)(tokbase + tl) * GW + ch);
                    const u32x2 uv = uvv[m][n]; const f32x4 v = acc[m][n];
                    u32x2 o;
                    o.x = pk_bf16(bf_lo(uv.x) * (gn.x * v.x + bsv), bf_hi(uv.x) * (gn.y * v.y + bsv));
                    o.y = pk_bf16(bf_lo(uv.y) * (gn.z * v.z + bsv), bf_hi(uv.y) * (gn.w * v.w + bsv));
                    if (dry) *(u32x2*)(c.ws + 440 * MB + ((size_t)(tokbase + tl) * GW + ch) * 2) = o; else *up = o;
                }
            }
            __syncthreads();
        }
    }
}

__device__ __forceinline__ void phase_a3(const Ctx& c) {
    const bf16_t* Z = (const bf16_t*)(c.ws + WS_U); const bf16_t* W = (const bf16_t*)(c.ws + WS_WAOUT);
    const float* X = (const float*)c.a->in[IN_X]; float* H = (float*)(c.ws + WS_H);
    const int fr = c.lane & 15, fq = c.lane >> 4, wr = c.wave >> 1, wc = c.wave & 1;
    for (int u = c.vb; u < 128 * 8; u += c.nb) {
        int mt, nt; map_unit(u, 8, mt, nt);
        const bf16_t* ap[4]; const bf16_t* bp[4];
        rows_regular<64>(ap, Z + (size_t)mt * 128 * GW, GW, c.tid); rows_regular<64>(bp, W + (size_t)nt * 128 * GW, GW, c.tid);
        f32x4 acc[4][4];
#pragma unroll
        for (int m = 0; m < 4; ++m)
#pragma unroll
            for (int n = 0; n < 4; ++n) acc[m][n] = *(const f32x4*)(X + (size_t)(mt * 128 + wr * 64 + m * 16 + fr) * D + nt * 128 + wc * 64 + n * 16 + fq * 4);
        gemm_loop<64, 1, true>(c, ap, bp, bp, GW, acc, acc);
#pragma unroll
        for (int m = 0; m < 4; ++m)
#pragma unroll
            for (int n = 0; n < 4; ++n) *(f32x4*)(H + (size_t)(mt * 128 + wr * 64 + m * 16 + fr) * D + nt * 128 + wc * 64 + n * 16 + fq * 4) = acc[m][n];
    }
}

__device__ __forceinline__ void phase_route(const Ctx& c, int l, bool dry = false) {
    const __attribute__((address_space(4))) Args& a = *c.a;
    const float* H = (const float*)(c.ws + WS_H); bf16_t* XN = (bf16_t*)(c.ws + (dry ? 440 * MB : WS_XN));
    const float* wr_ = (const float*)(c.ws + WS_WR) + (size_t)l * D * 48;
    const float* gain = (const float*)a.in[IN_FFNN] + l * D;
    int* cnt = (int*)(c.ws + WS_CNT) + l * 32 + (dry ? 64 : 0); int* list = (int*)(c.ws + (dry ? 480 * MB : WS_LIST)); float* gatel = (float*)(c.ws + (dry ? 484 * MB : WS_GATE)); int* tokslot = (int*)(c.ws + (dry ? 488 * MB : WS_TOKSLOT));
    LAS float* rl = (LAS float*)(c.lds);
    LAS float* lgl = (LAS float*)(c.lds + 256);
    const int lane = c.lane, w = c.wave;
    f32x4 gv[4]; gain_load(gain, lane, gv);
    for (int unit = c.vb; unit < T / 32; unit += c.nb) {
        const int tok0 = unit * 32;
        __syncthreads();
        for (int i = 0; i < 8; ++i) {
            const int t = tok0 + w * 8 + i;
            f32x4 v[4]; row_load(H + (size_t)t * D, lane, v);
            const float r = rsqrtf(row_sumsq(v) * (1.f / D) + EPS);
            if (lane == 0) rl[w * 8 + i] = r;
            row_store_norm_fp8(c.ws + (dry ? 440 * MB : WS_XN8) + (size_t)t * D, lane, v, r, gv);
        }
        {
            const int th = w & 1, kh = w >> 1, m = lane & 15, q = lane >> 4;
            const float* arow = H + (size_t)(tok0 + 16 * th + m) * D + 512 * kh + 128 * q;
            const float* brow = wr_ + (size_t)(512 * kh + 128 * q) * 48 + m;
            f32x4 acc[3]; acc[0] = acc[1] = acc[2] = (f32x4){0.f, 0.f, 0.f, 0.f};
            for (int i = 0; i < 32; ++i) {
                const f32x4 av = ((const f32x4*)arow)[i];
                const float ae[4] = {av.x, av.y, av.z, av.w};
#pragma unroll
                for (int e = 0; e < 4; ++e) {
                    const float* bp = brow + (size_t)(4 * i + e) * 48;
#pragma unroll
                    for (int nt = 0; nt < 3; ++nt) acc[nt] = __builtin_amdgcn_mfma_f32_16x16x4f32(ae[e], bp[nt * 16], acc[nt], 0, 0, 0);
                }
            }
#pragma unroll
            for (int nt = 0; nt < 3; ++nt)
#pragma unroll
                for (int j = 0; j < 4; ++j) lgl[(kh * 32 + th * 16 + 4 * q + j) * 48 + nt * 16 + m] = acc[nt][j];
        }
        __syncthreads();
        if (c.tid < 32) {
            const int tt = c.tid, t = tok0 + tt; const float r = rl[tt];
            const float* bg = (const float*)a.in[IN_BG] + l * 4; const float* be = (const float*)a.in[IN_BE] + l * 32;
            float gl[4];
#pragma unroll
            for (int o = 0; o < 4; ++o) gl[o] = (lgl[tt * 48 + o] + lgl[(32 + tt) * 48 + o]) * r + bg[o];
            int gs = 0; float gm = gl[0];
#pragma unroll
            for (int o = 1; o < 4; ++o) if (gl[o] > gm) { gm = gl[o]; gs = o; }
            float gden = 0.f;
#pragma unroll
            for (int o = 0; o < 4; ++o) gden += __expf(gl[o] - gm);
            const float pg = 1.f / gden;
            float l1 = -INFINITY, l2 = -INFINITY; int i1 = 0, i2 = 0;
            for (int i = 0; i < 8; ++i) {
                const int o = 4 + gs * 8 + i;
                const float v = (lgl[tt * 48 + o] + lgl[(32 + tt) * 48 + o]) * r + be[gs * 8 + i];
                if (v > l1) { l2 = l1; i2 = i1; l1 = v; i1 = i; } else if (v > l2) { l2 = v; i2 = i; }
            }
            const float e2 = __expf(l2 - l1), inv = 1.f / (1.f + e2);
            const float g1 = pg * inv, g2 = pg * e2 * inv;
            const int ea = gs * 8 + i1, eb = gs * 8 + i2;
            const int sa = atomicAdd(&cnt[ea], 1), sb = atomicAdd(&cnt[eb], 1);
            list[ea * T + sa] = t; gatel[ea * T + sa] = g1; tokslot[2 * t] = (ea << 16) | sa;
            list[eb * T + sb] = t; gatel[eb * T + sb] = g2; tokslot[2 * t + 1] = (eb << 16) | sb;
        }
    }
}

__device__ __forceinline__ void moe_table(const Ctx& c, int l, LAS int* pst, LAS int* cn) {
    __syncthreads();
    if (c.tid == 0) {
        const int* cnt = (const int*)(c.ws + WS_CNT) + l * 32; int acc = 0;
        for (int e = 0; e < 32; ++e) { const int n = cnt[e]; cn[e] = n; pst[e] = acc; acc += (n + 127) >> 7; }
        pst[32] = acc;
    }
    __syncthreads();
}
__device__ __forceinline__ int moe_find(LAS const int* pst, int mb) { int e = 0; for (int i = 1; i < 32; ++i) e = (pst[i] <= mb) ? i : e; return e; }

__device__ __forceinline__ void phase_e1(const Ctx& c, int l) {
    const unsigned char* XN8 = c.ws + WS_XN8; const unsigned char* W1 = c.ws + WS_W1; const unsigned char* W3 = c.ws + WS_W3;
    unsigned char* HM = c.ws + WS_HMID; const int* list = (const int*)(c.ws + WS_LIST);
    LAS int* pst = (LAS int*)(c.lds + LDS_MAIN); LAS int* cn = pst + 40;
    moe_table(c, l, pst, cn);
    const int fr = c.lane & 15, fq = c.lane >> 4, wr = c.wave >> 1, wc = c.wave & 1, tid = c.tid;
    const int nunits = pst[32] * 8;
    for (int u = c.vb; u < nunits; u += c.nb) {
        const int mb = u >> 3, h0 = (u & 7) * 64, e = moe_find(pst, mb), row0 = (mb - pst[e]) * 128, count = cn[e];
        const bf16_t* ap[4]; const bf16_t* bp[4];
#pragma unroll
        for (int p = 0; p < 4; ++p) {
            int r = row0 + p * 32 + (tid >> 3); r = r < count ? r : row0; ap[p] = (const bf16_t*)(XN8 + (size_t)list[e * T + r] * D);
            const int rb = p * 32 + (tid >> 3), hid = h0 + (rb >> 6) * 32 + ((rb >> 4) & 1) * 16 + (rb & 15);
            bp[p] = (const bf16_t*)((((rb >> 5) & 1) ? W3 : W1) + ((size_t)e * DE + hid) * D);
        }
        f32x4 acc[4][4]; zero_acc(acc);
        gemm_loop<64, 1, true, true>(c, ap, bp, bp, D / 2, acc, acc);
        const float ws_ = 1.f / W8_SCALE;
#pragma unroll
        for (int m = 0; m < 4; ++m)
#pragma unroll
            for (int n = 0; n < 2; ++n) {
                const size_t row = (size_t)mb * 128 + wr * 64 + m * 16 + fr; const int col = h0 + wc * 32 + n * 16 + fq * 4;
                const f32x4 x = acc[m][n] * ws_, y = acc[m][n + 2] * (ws_ * H8_SCALE);
                *(unsigned*)(HM + row * DE + col) = pk_fp8x4(x.x * sigmoidf_(x.x) * y.x, x.y * sigmoidf_(x.y) * y.y, x.z * sigmoidf_(x.z) * y.z, x.w * sigmoidf_(x.w) * y.w);
            }
    }
}
__device__ __forceinline__ void phase_e2(const Ctx& c, int l) {
    const unsigned char* HM = c.ws + WS_HMID; const unsigned char* W2 = c.ws + WS_W2;
    bf16_t* Y = (bf16_t*)(c.ws + WS_Y); const float* gatel = (const float*)(c.ws + WS_GATE);
    LAS int* pst = (LAS int*)(c.lds + LDS_MAIN); LAS int* cn = pst + 40;
    moe_table(c, l, pst, cn);
    const int fr = c.lane & 15, fq = c.lane >> 4, wr = c.wave >> 1, wc = c.wave & 1, tid = c.tid;
    const int nunits = pst[32] * 8;
    for (int u = c.vb; u < nunits; u += c.nb) {
        const int mb = u >> 3, nt = u & 7, e = moe_find(pst, mb), row0 = (mb - pst[e]) * 128, count = cn[e];
        const bf16_t* ap[4]; const bf16_t* bp[4];
        rows_regular<64>(ap, (const bf16_t*)(HM + (size_t)mb * 128 * DE), DE / 2, tid); rows_regular<64>(bp, (const bf16_t*)(W2 + ((size_t)e * D + nt * 128) * DE), DE / 2, tid);
        f32x4 acc[4][4]; zero_acc(acc);
        gemm_loop<64, 1, true, true>(c, ap, bp, bp, DE / 2, acc, acc);
        float gtv[4];
#pragma unroll
        for (int m = 0; m < 4; ++m) { const int rl_ = wr * 64 + m * 16 + fr; gtv[m] = (row0 + rl_ < count) ? gatel[e * T + row0 + rl_] * (1.f / (W8_SCALE * H8_SCALE)) : 0.f; }
#pragma unroll
        for (int m = 0; m < 4; ++m) {
            const int rl_ = wr * 64 + m * 16 + fr; const float gt = gtv[m];
#pragma unroll
            for (int n = 0; n < 4; ++n) {
                const f32x4 v = acc[m][n] * gt;
                u32x2 o; o.x = pk_bf16(v.x, v.y); o.y = pk_bf16(v.z, v.w);
                *(u32x2*)(Y + ((size_t)mb * 128 + rl_) * D + nt * 128 + wc * 64 + n * 16 + fq * 4) = o;
            }
        }
    }
}
__device__ __forceinline__ void phase_p1(const Ctx& c, int l, bool dry = false) {
    float* H = (float*)(c.ws + WS_H); float* HO = (float*)(c.ws + (dry ? 440 * MB : WS_H)); bf16_t* XN = (bf16_t*)(c.ws + (dry ? 440 * MB : WS_XN)); const bf16_t* Y = (const bf16_t*)(c.ws + WS_Y);
    const int* tokslot = (const int*)(c.ws + WS_TOKSLOT); const float* gain = (const float*)c.a->in[IN_PLEN] + l * D;
    LAS int* pst = (LAS int*)(c.lds + LDS_MAIN); LAS int* cn = pst + 40;
    moe_table(c, l, pst, cn);
    const int gw = c.vb * 4 + c.wave, ngw = c.nb * 4, lane = c.lane;
    f32x4 gv[4]; gain_load(gain, lane, gv);
    for (int t = gw; t < T; t += ngw) {
        const int s0 = tokslot[2 * t], s1 = tokslot[2 * t + 1];
        const bf16_t* y0 = Y + ((size_t)pst[s0 >> 16] * 128 + (s0 & 0xffff)) * D; const bf16_t* y1 = Y + ((size_t)pst[s1 >> 16] * 128 + (s1 & 0xffff)) * D;
        f32x4 v[4]; row_load(H + (size_t)t * D, lane, v);
#pragma unroll
        for (int j = 0; j < 4; ++j) {
            const u32x2 a0 = ((const u32x2*)y0)[lane + 64 * j], a1 = ((const u32x2*)y1)[lane + 64 * j];
            v[j].x += bf_lo(a0.x) + bf_lo(a1.x); v[j].y += bf_hi(a0.x) + bf_hi(a1.x); v[j].z += bf_lo(a0.y) + bf_lo(a1.y); v[j].w += bf_hi(a0.y) + bf_hi(a1.y);
            ((f32x4*)(HO + (size_t)t * D))[lane + 64 * j] = v[j];
        }
        const float r = rsqrtf(row_sumsq(v) * (1.f / D) + EPS);
        row_store_norm_fp8(c.ws + (dry ? 440 * MB : WS_XN8) + (size_t)t * D, lane, v, r, gv);
    }
}
__device__ __forceinline__ void phase_p2(const Ctx& c, int l) {
    const bf16_t* XN = (const bf16_t*)(c.ws + WS_XN); const bf16_t* WG = (const bf16_t*)(c.ws + WS_WGATE) + (size_t)l * D * D;
    const bf16_t* PB = (const bf16_t*)(c.ws + WS_PBF) + (size_t)l * T * PLE; const bf16_t* WP = (const bf16_t*)(c.ws + WS_WPROJ) + (size_t)l * D * PLE;
    float* H = (float*)(c.ws + WS_H);
    const int fr = c.lane & 15, fq = c.lane >> 4, wr = c.wave >> 1, wc = c.wave & 1;
    for (int u = c.vb; u < 128 * 8; u += c.nb) {
        int mt, nt; map_unit(u, 8, mt, nt);
        const bf16_t* ap[4]; const bf16_t* bp[4];
        f32x4 ag[4][4], apj[4][4]; zero_acc(ag); zero_acc(apj);
        rows_regular<64>(ap, (const bf16_t*)(c.ws + WS_XN8 + (size_t)mt * 128 * D), D / 2, c.tid); rows_regular<64>(bp, (const bf16_t*)(c.ws + WS_WGATE + ((size_t)l * D + nt * 128) * D), D / 2, c.tid);
        gemm_loop<64, 1, true, true>(c, ap, bp, bp, D / 2, ag, ag);
        rows_regular<64>(ap, PB + (size_t)mt * 128 * PLE, PLE, c.tid); rows_regular<64>(bp, WP + (size_t)nt * 128 * PLE, PLE, c.tid);
        gemm_loop<64, 1, true>(c, ap, bp, bp, PLE, apj, apj);
        f32x4 hres[4][4];
#pragma unroll
        for (int m = 0; m < 4; ++m)
#pragma unroll
            for (int n = 0; n < 4; ++n) hres[m][n] = *(const f32x4*)(H + (size_t)(mt * 128 + wr * 64 + m * 16 + fr) * D + nt * 128 + wc * 64 + n * 16 + fq * 4);
#pragma unroll
        for (int m = 0; m < 4; ++m)
#pragma unroll
            for (int n = 0; n < 4; ++n) {
                const size_t off = (size_t)(mt * 128 + wr * 64 + m * 16 + fr) * D + nt * 128 + wc * 64 + n * 16 + fq * 4;
                const f32x4 g = ag[m][n] * (1.f / W8_SCALE), pj = apj[m][n]; f32x4 h = hres[m][n];
                h.x += sigmoidf_(g.x) * pj.x; h.y += sigmoidf_(g.y) * pj.y; h.z += sigmoidf_(g.z) * pj.z; h.w += sigmoidf_(g.w) * pj.w;
                *(f32x4*)(H + off) = h;
            }
    }
}
__device__ __forceinline__ void phase_norm_bf16(const Ctx& c, const float* gain) {
    const float* H = (const float*)(c.ws + WS_H);
    const int gw = c.vb * 4 + c.wave, ngw = c.nb * 4;
    f32x4 gv[4]; gain_load(gain, c.lane, gv);
    for (int t = gw; t < T; t += ngw) {
        f32x4 v[4]; row_load(H + (size_t)t * D, c.lane, v);
        const float r = rsqrtf(row_sumsq(v) * (1.f / D) + EPS);
        row_store_norm_fp8(c.ws + WS_XN8 + (size_t)t * D, c.lane, v, r, gv);
        row_store_norm_bf16((bf16_t*)(c.ws + WS_XN) + (size_t)t * D, c.lane, v, r, gv);
    }
}
__device__ __forceinline__ void phase_final(const Ctx& c) {
    const float* H = (const float*)(c.ws + WS_H); float* O = c.a->out; const float* gain = (const float*)c.a->in[IN_FINN];
    const int gw = c.vb * 4 + c.wave, ngw = c.nb * 4;
    f32x4 gv[4]; gain_load(gain, c.lane, gv);
    for (int t = gw; t < T; t += ngw) {
        f32x4 v[4]; row_load(H + (size_t)t * D, c.lane, v);
        const float r = rsqrtf(row_sumsq(v) * (1.f / D) + EPS);
#pragma unroll
        for (int j = 0; j < 4; ++j) ((f32x4*)(O + (size_t)t * D))[c.lane + 64 * j] = v[j] * r * gv[j];
    }
}

__device__ __forceinline__ void phase_b1(const Ctx& c, size_t raw_off = WS_RAW) {
    const bf16_t* XN = (const bf16_t*)(c.ws + WS_XN); const bf16_t* W = (const bf16_t*)(c.ws + WS_WBIN); bf16_t* RAW = (bf16_t*)(c.ws + raw_off);
    const int fr = c.lane & 15, fq = c.lane >> 4, wr = c.wave >> 1, wc = c.wave & 1;
    for (int u = c.vb; u < 128 * 17; u += c.nb) {
        int mt, nt; map_unit(u, 17, mt, nt);
        const bf16_t* ap[4]; const bf16_t* bp[4];
        f32x4 acc[4][4]; zero_acc(acc);
        float osc = 1.f;
        if (nt < 12) {
            rows_regular<64>(ap, (const bf16_t*)(c.ws + WS_XN8 + (size_t)mt * 128 * D), D / 2, c.tid); rows_regular<64>(bp, (const bf16_t*)(c.ws + WS_WBIN + (size_t)nt * 128 * D), D / 2, c.tid);
            gemm_loop<64, 1, true, true>(c, ap, bp, bp, D / 2, acc, acc);
            osc = 1.f / W8_SCALE;
        } else {
            rows_regular<64>(ap, XN + (size_t)mt * 128 * D, D, c.tid); rows_regular<64>(bp, (const bf16_t*)(c.ws + WS_WBIN + 3 * MB) + (size_t)(nt - 12) * 128 * D, D, c.tid);
            gemm_loop<64, 1, true>(c, ap, bp, bp, D, acc, acc);
        }
#pragma unroll
        for (int m = 0; m < 4; ++m)
#pragma unroll
            for (int n = 0; n < 4; ++n) {
                const f32x4 v = acc[m][n] * osc; u32x2 o; o.x = pk_bf16(v.x, v.y); o.y = pk_bf16(v.z, v.w);
                *(u32x2*)(RAW + (size_t)(mt * 128 + wr * 64 + m * 16 + fr) * BINP + nt * 128 + wc * 64 + n * 16 + fq * 4) = o;
            }
    }
}

__device__ __forceinline__ void unpack8(const u32x4 r, float (&e)[8]) { e[0] = bf_lo(r.x); e[1] = bf_hi(r.x); e[2] = bf_lo(r.y); e[3] = bf_hi(r.y); e[4] = bf_lo(r.z); e[5] = bf_hi(r.z); e[6] = bf_lo(r.w); e[7] = bf_hi(r.w); }
__device__ __forceinline__ u32x4 pack8(const float (&e)[8]) { u32x4 o; o.x = pk_bf16(e[0], e[1]); o.y = pk_bf16(e[2], e[3]); o.z = pk_bf16(e[4], e[5]); o.w = pk_bf16(e[6], e[7]); return o; }
__device__ __forceinline__ void phase_rope(const Ctx& c) {
    const bf16_t* RAW = (const bf16_t*)(c.ws + WS_RAW);
    bf16_t* Q = (bf16_t*)(c.ws + WS_Q); bf16_t* K = (bf16_t*)(c.ws + WS_K); bf16_t* V = (bf16_t*)(c.ws + WS_V);
    bf16_t* QI = (bf16_t*)(c.ws + WS_QI); bf16_t* KI = (bf16_t*)(c.ws + WS_KI); float* WI = (float*)(c.ws + WS_WI);
    const int* pos = (const int*)c.a->in[IN_POS];
    LAS float* cs = (LAS float*)(c.lds + c.wave * 256);
    const int gw = c.vb * 4 + c.wave, ngw = c.nb * 4, lane = c.lane;
    for (int t = gw; t < T; t += ngw) {
        if (lane < 24) {
            const double ex = (lane < 16) ? (double)lane * (1.0 / 16.0) : (double)(lane - 16) * (1.0 / 8.0);
            const float invf = (float)exp2(-ex * 18.931568569324174);
            const float ang = (float)pos[t] * invf;
            const double ad = (double)ang; const double n = rint(ad * 0.15915494309189535); const float red = (float)(ad - n * 6.283185307179586);
            cs[lane] = cosf(red); cs[32 + lane] = sinf(red);
        }
        LDS_WAIT();
        const bf16_t* row = RAW + (size_t)t * BINP;
        for (int ch = lane; ch < BINP / 8; ch += 64) {
            const u32x4 own = ((const u32x4*)row)[ch];
            float e[8]; unpack8(own, e);
            if (ch < 160) {
                const int cc = ch & 15;
                if (cc < 4) {
                    const u32x4 oth = ((const u32x4*)row)[ch ^ 2]; float p[8]; unpack8(oth, p);
                    const int f0 = (cc & 1) * 8;
#pragma unroll
                    for (int i = 0; i < 8; ++i) { const float co = cs[f0 + i], si = cs[32 + f0 + i]; e[i] = (cc < 2) ? (e[i] * co - p[i] * si) : (e[i] * co + p[i] * si); }
                }
                if (ch < 128) {
#pragma unroll
                    for (int i = 0; i < 8; ++i) e[i] *= 0.08838834764831845f;
                    ((u32x4*)(Q + (size_t)t * D))[ch] = pack8(e);
                } else ((u32x4*)(K + (size_t)t * 256))[ch - 128] = pack8(e);
            } else if (ch < 192) {
                ((u32x4*)(V + (size_t)t * 256))[ch - 160] = own;
            } else if (ch < 264) {
                const int cc = ch & 7;
                if (cc < 2) {
                    const u32x4 oth = ((const u32x4*)row)[ch ^ 1]; float p[8]; unpack8(oth, p);
#pragma unroll
                    for (int i = 0; i < 8; ++i) { const float co = cs[16 + i], si = cs[32 + 16 + i]; e[i] = (cc == 0) ? (e[i] * co - p[i] * si) : (e[i] * co + p[i] * si); }
                }
                if (ch < 256) ((u32x4*)(QI + (size_t)t * 512))[ch - 192] = pack8(e);
                else ((u32x4*)(KI + (size_t)t * 64))[ch - 256] = pack8(e);
            } else if (ch == 264) {
                f32x4 w0 = {e[0], e[1], e[2], e[3]}, w1 = {e[4], e[5], e[6], e[7]};
                const float sc = 0.044194173824159216f;
                ((f32x4*)(WI + (size_t)t * 8))[0] = w0 * sc; ((f32x4*)(WI + (size_t)t * 8))[1] = w1 * sc;
            }
        }
        LDS_WAIT();
    }
}

__device__ __forceinline__ size_t srow_off(int t) { const int m = t >> 6, r = t & 63; return (size_t)64 * (m + 1) * (32 * m + r); }
constexpr size_t S_BATCH = (size_t)64 * 65 * 2048;
constexpr int SCORE_UNITS = 4 * 312;
__device__ __forceinline__ void phase_score(const Ctx& c) {
    const bf16_t* QI = (const bf16_t*)(c.ws + WS_QI); const bf16_t* KI = (const bf16_t*)(c.ws + WS_KI); const float* WI = (const float*)(c.ws + WS_WI);
    float* S = (float*)(c.ws + WS_S);
    const int lane = c.lane, hf = lane >> 5, col = lane & 31, w = c.wave;
    for (int u = c.vb; u < SCORE_UNITS; u += c.nb) {
        const int b = u & 3, r = u >> 2;
        int kc, qb;
        if (r < 120) { kc = 0; qb = 8 + r; } else if (r < 216) { kc = 1; qb = 32 + (r - 120); } else if (r < 280) { kc = 2; qb = 64 + (r - 216); } else { kc = 3; qb = 96 + (r - 280); }
        const int tb = b * SEQ, t0 = 32 * qb + 8 * w;
        bf16x8 af[2][4]; f32x4 wv[2][4];
        { const int rho = lane & 31, ql = 2 * ((rho >> 2) & 1) + (rho >> 4), hd = 4 * ((rho >> 3) & 1) + (rho & 3);
#pragma unroll
          for (int a = 0; a < 2; ++a) {
              const bf16_t* qp = QI + (size_t)(tb + t0 + 4 * a + ql) * 512 + hd * 64 + 8 * hf;
#pragma unroll
              for (int ks = 0; ks < 4; ++ks) af[a][ks] = *(const bf16x8*)(qp + 16 * ks);
              const float* wp = WI + (size_t)(tb + t0 + 4 * a + 2 * hf) * 8;
#pragma unroll
              for (int i = 0; i < 4; ++i) wv[a][i] = ((const f32x4*)wp)[i];
          } }
        const int ntile = min(32, qb + 1 - 32 * kc), key0 = 1024 * kc;
        float* Sb = S + (size_t)b * S_BATCH;
        size_t ro[2][2];
#pragma unroll
        for (int a = 0; a < 2; ++a) { ro[a][0] = srow_off(t0 + 4 * a + 2 * hf); ro[a][1] = srow_off(t0 + 4 * a + 2 * hf + 1); }
        const int nsub = (ntile + 3) >> 2;
        const bf16_t* krp[4];
        rows_regular<64>(krp, KI + (size_t)(tb + key0) * 64, 64, c.tid);
        __syncthreads();
        stage_tile<64>(c.lds, krp, 0, c.tid);
        for (int sc = 0; sc < nsub; ++sc) {
            VM_WAIT();
            __syncthreads();
            const LAS unsigned char* cur = c.lds + (sc & 1) * 16384;
            if (sc + 1 < nsub) stage_tile<64>(c.lds + ((sc + 1) & 1) * 16384, krp, (sc + 1) * 128 * 64, c.tid);
#pragma unroll
            for (int j = 0; j < 4; ++j) {
                const int kt = 4 * sc + j;
                if (kt < ntile) {
                    const int key = key0 + 32 * kt + col, row = 32 * j + col;
                    bf16x8 cb[4];
#pragma unroll
                    for (int ks = 0; ks < 4; ++ks) cb[ks] = *(const LAS bf16x8*)(cur + row * 128 + (((2 * ks + hf) ^ (row & 7)) << 4));
#pragma unroll
                    for (int a = 0; a < 2; ++a) {
                        f32x16 acc = {};
#pragma unroll
                        for (int ks = 0; ks < 4; ++ks) acc = __builtin_amdgcn_mfma_f32_32x32x16_bf16(af[a][ks], cb[ks], acc, 0, 0, 0);
                        float s0 = fmaxf(acc[0], 0.f) * wv[a][0].x; s0 += fmaxf(acc[1], 0.f) * wv[a][0].y; s0 += fmaxf(acc[2], 0.f) * wv[a][0].z; s0 += fmaxf(acc[3], 0.f) * wv[a][0].w;
                        s0 += fmaxf(acc[4], 0.f) * wv[a][1].x; s0 += fmaxf(acc[5], 0.f) * wv[a][1].y; s0 += fmaxf(acc[6], 0.f) * wv[a][1].z; s0 += fmaxf(acc[7], 0.f) * wv[a][1].w;
                        float s1 = fmaxf(acc[8], 0.f) * wv[a][2].x; s1 += fmaxf(acc[9], 0.f) * wv[a][2].y; s1 += fmaxf(acc[10], 0.f) * wv[a][2].z; s1 += fmaxf(acc[11], 0.f) * wv[a][2].w;
                        s1 += fmaxf(acc[12], 0.f) * wv[a][3].x; s1 += fmaxf(acc[13], 0.f) * wv[a][3].y; s1 += fmaxf(acc[14], 0.f) * wv[a][3].z; s1 += fmaxf(acc[15], 0.f) * wv[a][3].w;
                        const int tA = t0 + 4 * a + 2 * hf;
                        Sb[ro[a][0] + key] = (key <= tA) ? s0 : -INFINITY;
                        Sb[ro[a][1] + key] = (key <= tA + 1) ? s1 : -INFINITY;
                    }
                }
            }
        }
    }
}

constexpr int NBINS = 2048, CAND_CAP = 256, SEL_WAVE_LDS = 8192 + 2048 + 64;
__device__ __forceinline__ void phase_select(const Ctx& c) {
    const float* S = (const float*)(c.ws + WS_S); int* SEL = (int*)(c.ws + WS_SEL);
    LAS int* hist = (LAS int*)(c.lds + c.wave * SEL_WAVE_LDS);
    LAS float* candv = (LAS float*)(hist + NBINS);
    LAS int* candi = (LAS int*)(candv + CAND_CAP);
    LAS int* thr = candi + CAND_CAP;
    const int gw = c.vb * 4 + c.wave, ngw = c.nb * 4;
    for (int j = gw; j < 4 * 3840; j += ngw) {
        int lane = c.lane;
        asm volatile("" : "+v"(lane));
        const int b = j & 3, t = 4095 - (j >> 2), ni = (t + 64) >> 6;
        const float* row = S + (size_t)b * S_BATCH + srow_off(t);
        float s[64];
#pragma unroll
        for (int g4 = 0; g4 < 4; ++g4) {
            if (16 * g4 < ni) {
#pragma unroll
                for (int i = 16 * g4; i < 16 * g4 + 16; ++i) { const int k = 64 * i + lane; const float v = row[min(k, t)]; s[i] = (k <= t) ? v : -INFINITY; }
            } else {
#pragma unroll
                for (int i = 16 * g4; i < 16 * g4 + 16; ++i) s[i] = -INFINITY;
            }
        }
        asm volatile("" : "+v"(lane));
        float mn = INFINITY, mx = -INFINITY;
#pragma unroll
        for (int i = 0; i < 64; ++i) { mx = fmaxf(mx, s[i]); mn = fminf(mn, (s[i] == -INFINITY) ? INFINITY : s[i]); }
#pragma unroll
        for (int o = 1; o < 64; o <<= 1) { mx = fmaxf(mx, __shfl_xor(mx, o)); mn = fminf(mn, __shfl_xor(mn, o)); }
        const float sc = (mx > mn) ? (float)NBINS / (mx - mn) : 0.f;
#pragma unroll
        for (int i = 0; i < 8; ++i) ((LAS u32x4*)hist)[lane * 8 + i] = (u32x4){0u, 0u, 0u, 0u};
        LDS_WAIT();
#define BINOF(v) min(NBINS - 1, (int)(((v) - mn) * sc))
#pragma unroll
        for (int i = 0; i < 64; ++i) if ((i & ~7) < ni && s[i] != -INFINITY) lds_inc(&hist[BINOF(s[i])]);
        LDS_WAIT();
        int bs, need;
        {
            const LAS int* hq = hist + lane * 32;
            int loc = 0;
#pragma unroll
            for (int i = 0; i < 8; ++i) { const u32x4 h4 = ((const LAS u32x4*)hq)[i]; loc += (int)(h4.x + h4.y + h4.z + h4.w); }
            int suf = loc;
#pragma unroll
            for (int o = 1; o < 64; o <<= 1) { const int v = __shfl_down(suf, o); if (lane + o < 64) suf += v; }
            const int above = suf - loc;
            const bool cross = (above < 256 && suf >= 256);
            int bsl = 0, abl = 0;
            if (cross) { int run = above; for (int i = 31; i >= 0; --i) { const int h = hq[i]; if (run < 256 && run + h >= 256) { bsl = lane * 32 + i; abl = run; } run += h; } }
            const unsigned long long cm = __ballot(cross);
            const int src = cm ? (int)__builtin_ctzll(cm) : 0;
            bs = __shfl(bsl, src); need = 256 - __shfl(abl, src);
        }
        int bs2 = -1;
        if (__shfl(hist[bs], 0) > 32) {
#pragma unroll
            for (int i = 0; i < 8; ++i) ((LAS u32x4*)hist)[lane * 8 + i] = (u32x4){0u, 0u, 0u, 0u};
            LDS_WAIT();
#define SUBOF(v) min(NBINS - 1, (int)((((v) - mn) * sc - (float)bs) * (float)NBINS))
#pragma unroll
            for (int i = 0; i < 64; ++i) if ((i & ~7) < ni && s[i] != -INFINITY && BINOF(s[i]) == bs) lds_inc(&hist[SUBOF(s[i])]);
            LDS_WAIT();
            const LAS int* hq = hist + lane * 32;
            int loc = 0;
#pragma unroll
            for (int i = 0; i < 8; ++i) { const u32x4 h4 = ((const LAS u32x4*)hq)[i]; loc += (int)(h4.x + h4.y + h4.z + h4.w); }
            int suf = loc;
#pragma unroll
            for (int o = 1; o < 64; o <<= 1) { const int v = __shfl_down(suf, o); if (lane + o < 64) suf += v; }
            const int above = suf - loc;
            const bool cross = (above < need && suf >= need);
            int bsl = 0, abl = 0;
            if (cross) { int run = above; for (int i = 31; i >= 0; --i) { const int h = hq[i]; if (run < need && run + h >= need) { bsl = lane * 32 + i; abl = run; } run += h; } }
            const unsigned long long cm = __ballot(cross);
            const int src = cm ? (int)__builtin_ctzll(cm) : 0;
            bs2 = __shfl(bsl, src); need = need - __shfl(abl, src);
        }
        asm volatile("" : "+v"(lane));
        int nc = 0;
#pragma unroll
        for (int i = 0; i < 64; ++i) if ((i & ~7) < ni) {
            bool p = (s[i] != -INFINITY) && (BINOF(s[i]) == bs);
            if (bs2 >= 0) p = p && (SUBOF(s[i]) == bs2);
            const unsigned long long m = __ballot(p);
            const int pos = nc + (int)__builtin_amdgcn_mbcnt_hi((unsigned)(m >> 32), __builtin_amdgcn_mbcnt_lo((unsigned)m, 0u));
            if (p && pos < CAND_CAP) { candv[pos] = s[i]; candi[pos] = 64 * i + lane; }
            nc += (int)__popcll(m);
        }
        nc = min(nc, CAND_CAP);
        LDS_WAIT();
        for (int i = lane; i < nc; i += 64) {
            const float v = candv[i]; const int id = candi[i];
            int rank = 0;
            for (int k = 0; k < nc; ++k) { const float vk = candv[k]; const int ik = candi[k]; rank += (vk > v || (vk == v && ik < id)) ? 1 : 0; }
            if (rank == need - 1) { thr[0] = __float_as_int(v); thr[1] = id; }
        }
        LDS_WAIT();
        const float tv = __int_as_float(thr[0]); const int ti = thr[1];
        asm volatile("" : "+v"(lane));
        int* selr = SEL + ((size_t)b * SEQ + t) * 256;
        int base = 0;
#pragma unroll
        for (int i = 0; i < 64; ++i) if ((i & ~7) < ni) {
            const int key = 64 * i + lane;
            const bool p = (s[i] > tv) || (s[i] == tv && key <= ti);
            const unsigned long long m = __ballot(p);
            const int pos = base + (int)__builtin_amdgcn_mbcnt_hi((unsigned)(m >> 32), __builtin_amdgcn_mbcnt_lo((unsigned)m, 0u));
            if (p && pos < 256) selr[pos] = key;
            base += (int)__popcll(m);
        }
        LDS_WAIT();
#undef BINOF
#undef SUBOF
    }
}

typedef short s16x4 __attribute__((ext_vector_type(4)));
__device__ __forceinline__ unsigned vimg_f(unsigned r) { return ((r & 3u) << 2) | ((r >> 2) & 3u); }
__device__ __forceinline__ void tr_read8(const unsigned (&ad)[8], s16x4 (&r)[8]) {
    asm volatile("ds_read_b64_tr_b16 %0, %8\n\tds_read_b64_tr_b16 %1, %9\n\tds_read_b64_tr_b16 %2, %10\n\tds_read_b64_tr_b16 %3, %11\n\t"
                 "ds_read_b64_tr_b16 %4, %12\n\tds_read_b64_tr_b16 %5, %13\n\tds_read_b64_tr_b16 %6, %14\n\tds_read_b64_tr_b16 %7, %15\n\ts_waitcnt lgkmcnt(0)"
                 : "=&v"(r[0]), "=&v"(r[1]), "=&v"(r[2]), "=&v"(r[3]), "=&v"(r[4]), "=&v"(r[5]), "=&v"(r[6]), "=&v"(r[7])
                 : "v"(ad[0]), "v"(ad[1]), "v"(ad[2]), "v"(ad[3]), "v"(ad[4]), "v"(ad[5]), "v"(ad[6]), "v"(ad[7]) : "memory");
}
constexpr int ATT_WAVE_LDS = 19456;
__device__ __forceinline__ void phase_attn(const Ctx& c) {
    const bf16_t* Q = (const bf16_t*)(c.ws + WS_Q); const bf16_t* K = (const bf16_t*)(c.ws + WS_K); const bf16_t* V = (const bf16_t*)(c.ws + WS_V);
    const int* SEL = (const int*)(c.ws + WS_SEL); bf16_t* O = (bf16_t*)(c.ws + WS_O);
    LAS unsigned char* wl = c.lds + c.wave * ATT_WAVE_LDS;
    LAS int* sl = (LAS int*)wl;
    LAS unsigned short* pT = (LAS unsigned short*)(wl + 1024);
    LAS unsigned char* vb = wl + 3072;
    const int lane = c.lane, fr = lane & 15, fq = lane >> 4;
    const int gw = c.vb * 4 + c.wave, ngw = c.nb * 4;
    unsigned tro[16];
    { const unsigned q = (unsigned)fr >> 2, p = (unsigned)fr & 3u;
#pragma unroll
      for (int c2 = 0; c2 < 8; ++c2)
#pragma unroll
          for (int t = 0; t < 2; ++t) { const unsigned row = 8u * fq + 4u * t + q, ch = 2u * c2 + (p >> 1); tro[c2 * 2 + t] = 256u * row + 16u * (ch ^ vimg_f(row)) + 8u * (p & 1u); } }
    const unsigned vb_addr = (unsigned)(size_t)vb;
    const bool xsplit = (c.nb % 128) == 0;
    const int xg = (c.vb >> 6) & 1, wi0 = xsplit ? (((c.vb >> 7) * 64 + (c.vb & 63)) * 4 + c.wave) : gw, wstride = xsplit ? ngw / 2 : ngw;
    for (int task = wi0; task < (xsplit ? T : T * 2); task += wstride) {
        const int tg = xsplit ? task : (task >> 1), g = xsplit ? xg : (task & 1), b = tg >> 12, t = tg & 4095, tb = b * SEQ;
        const int nsel = min(256, t + 1), ntile = (nsel + 15) >> 4, nch = (nsel + 31) >> 5;
#pragma unroll
        for (int i = 0; i < 4; ++i) { const int s_ = lane + 64 * i; int idx = SEL[(size_t)tg * 256 + s_]; idx = (t < 256) ? s_ : idx; idx = (s_ < nsel && (unsigned)idx <= (unsigned)t) ? idx : 0; sl[s_] = idx; }
        bf16x8 qf[4];
        { const bf16_t* qp = Q + (size_t)tg * D + (4 * g + (fr & 3)) * 128 + 8 * fq;
#pragma unroll
          for (int ks = 0; ks < 4; ++ks) qf[ks] = *(const bf16x8*)(qp + 32 * ks); }
        LDS_WAIT();
        const bf16_t* kbase = K + (size_t)tb * 256 + g * 128;
        const bf16_t* vbase = V + (size_t)tb * 256 + g * 128;
#define ROW_GATHER(basep, chk, bufsel) do { _Pragma("unroll") for (int i_ = 0; i_ < 8; ++i_) { const int r_ = 4 * i_ + fq; const int key_ = sl[32 * (chk) + r_]; \
            __builtin_amdgcn_global_load_lds((const unsigned*)((basep) + (size_t)key_ * 256 + (((unsigned)fr ^ vimg_f((unsigned)r_)) << 3)), \
                                             (LAS unsigned*)(vb + (bufsel) * 8192 + i_ * 1024 + lane * 16), 16, 0, 0); } } while (0)
#define V_GATHER(chk, bufsel) ROW_GATHER(vbase, chk, bufsel)
        f32x4 lg[16];
        ROW_GATHER(kbase, 0, 0);
#pragma unroll
        for (int ch = 0; ch < 8; ++ch) {
            if (ch < 7) ROW_GATHER(kbase, ch + 1, (ch + 1) & 1); else V_GATHER(0, 0);
            asm volatile("s_waitcnt vmcnt(8)" ::: "memory");
            const LAS unsigned char* kb = vb + (ch & 1) * 8192;
#pragma unroll
            for (int rb = 0; rb < 2; ++rb) {
                const int kt = 2 * ch + rb; const unsigned row = 16u * rb + fr;
                f32x4 acc = {0.f, 0.f, 0.f, 0.f};
#pragma unroll
                for (int ks = 0; ks < 4; ++ks) { const bf16x8 kf = *(const LAS bf16x8*)(kb + 256u * row + 16u * ((4u * ks + fq) ^ vimg_f(row))); acc = __builtin_amdgcn_mfma_f32_16x16x32_bf16(qf[ks], kf, acc, 0, 0, 0); }
                const bool ok = (kt * 16 + fr < nsel);
                lg[kt].x = ok ? acc.x : -INFINITY; lg[kt].y = ok ? acc.y : -INFINITY; lg[kt].z = ok ? acc.z : -INFINITY; lg[kt].w = ok ? acc.w : -INFINITY;
            }
            asm volatile("" ::: "memory");
        }
        f32x4 mx = lg[0];
#pragma unroll
        for (int kt = 1; kt < 16; ++kt) { mx.x = fmaxf(mx.x, lg[kt].x); mx.y = fmaxf(mx.y, lg[kt].y); mx.z = fmaxf(mx.z, lg[kt].z); mx.w = fmaxf(mx.w, lg[kt].w); }
#pragma unroll
        for (int o = 1; o < 16; o <<= 1) { mx.x = fmaxf(mx.x, __shfl_xor(mx.x, o)); mx.y = fmaxf(mx.y, __shfl_xor(mx.y, o)); mx.z = fmaxf(mx.z, __shfl_xor(mx.z, o)); mx.w = fmaxf(mx.w, __shfl_xor(mx.w, o)); }
        f32x4 sm = {0.f, 0.f, 0.f, 0.f};
#pragma unroll
        for (int kt = 0; kt < 16; ++kt) { f32x4 p; p.x = __expf(lg[kt].x - mx.x); p.y = __expf(lg[kt].y - mx.y); p.z = __expf(lg[kt].z - mx.z); p.w = __expf(lg[kt].w - mx.w); lg[kt] = p; sm += p; }
#pragma unroll
        for (int o = 1; o < 16; o <<= 1) { sm.x += __shfl_xor(sm.x, o); sm.y += __shfl_xor(sm.y, o); sm.z += __shfl_xor(sm.z, o); sm.w += __shfl_xor(sm.w, o); }
        { const float inv = 1.f / (fq == 0 ? sm.x : fq == 1 ? sm.y : fq == 2 ? sm.z : sm.w);
#pragma unroll
          for (int kt = 0; kt < 16; ++kt) { const float pv = (fq == 0 ? lg[kt].x : fq == 1 ? lg[kt].y : fq == 2 ? lg[kt].z : lg[kt].w) * inv; pT[fq * 256 + kt * 16 + fr] = (unsigned short)(pk_bf16(pv, pv) & 0xffffu); } }
        LDS_WAIT();
        f32x4 oacc[8];
#pragma unroll
        for (int c2 = 0; c2 < 8; ++c2) oacc[c2] = (f32x4){0.f, 0.f, 0.f, 0.f};
        for (int ch = 0; ch < nch; ++ch) {
            if (ch + 1 < nch) { V_GATHER(ch + 1, (ch + 1) & 1); asm volatile("s_waitcnt vmcnt(8)" ::: "memory"); }
            else asm volatile("s_waitcnt vmcnt(0)" ::: "memory");
            const bf16x8 pa = *(const LAS bf16x8*)(pT + (fr & 3) * 256 + 32 * ch + 8 * fq);
            const unsigned cb = vb_addr + (unsigned)(ch & 1) * 8192u;
            unsigned ad[8]; s16x4 r0[8], r1[8];
#pragma unroll
            for (int i = 0; i < 8; ++i) ad[i] = cb + tro[i];
            tr_read8(ad, r0);
#pragma unroll
            for (int i = 0; i < 8; ++i) ad[i] = cb + tro[8 + i];
            tr_read8(ad, r1);
#pragma unroll
            for (int c2 = 0; c2 < 4; ++c2) { const bf16x8 vf = __builtin_shufflevector(r0[2 * c2], r0[2 * c2 + 1], 0, 1, 2, 3, 4, 5, 6, 7); oacc[c2] = __builtin_amdgcn_mfma_f32_16x16x32_bf16(pa, vf, oacc[c2], 0, 0, 0); }
#pragma unroll
            for (int c2 = 0; c2 < 4; ++c2) { const bf16x8 vf = __builtin_shufflevector(r1[2 * c2], r1[2 * c2 + 1], 0, 1, 2, 3, 4, 5, 6, 7); oacc[4 + c2] = __builtin_amdgcn_mfma_f32_16x16x32_bf16(pa, vf, oacc[4 + c2], 0, 0, 0); }
        }
        { unsigned char* op = (unsigned char*)O + (size_t)tg * D + (4 * g + fq) * 128 + fr;
#pragma unroll
          for (int c2 = 0; c2 < 8; ++c2) { const float ov = (fq == 0 ? oacc[c2].x : fq == 1 ? oacc[c2].y : fq == 2 ? oacc[c2].z : oacc[c2].w) * O8_SCALE; op[16 * c2] = (unsigned char)(pk_fp8x4(ov, ov, ov, ov) & 0xffu); } }
        LDS_WAIT();
    }
#undef V_GATHER
#undef ROW_GATHER
}

__device__ __forceinline__ void phase_b4(const Ctx& c) {
    const bf16_t* OB = (const bf16_t*)(c.ws + WS_O); const bf16_t* W = (const bf16_t*)(c.ws + WS_WBOUT); float* H = (float*)(c.ws + WS_H);
    const int fr = c.lane & 15, fq = c.lane >> 4, wr = c.wave >> 1, wc = c.wave & 1;
    for (int u = c.vb; u < 128 * 8; u += c.nb) {
        int mt, nt; map_unit(u, 8, mt, nt);
        const bf16_t* ap[4]; const bf16_t* bp[4];
        rows_regular<64>(ap, (const bf16_t*)(c.ws + WS_O + (size_t)mt * 128 * D), D / 2, c.tid); rows_regular<64>(bp, (const bf16_t*)(c.ws + WS_WBOUT + (size_t)nt * 128 * D), D / 2, c.tid);
        f32x4 acc[4][4];
#pragma unroll
        for (int m = 0; m < 4; ++m)
#pragma unroll
            for (int n = 0; n < 4; ++n) acc[m][n] = *(const f32x4*)(H + (size_t)(mt * 128 + wr * 64 + m * 16 + fr) * D + nt * 128 + wc * 64 + n * 16 + fq * 4) * (W8_SCALE * O8_SCALE);
        gemm_loop<64, 1, true, true>(c, ap, bp, bp, D / 2, acc, acc);
#pragma unroll
        for (int m = 0; m < 4; ++m)
#pragma unroll
            for (int n = 0; n < 4; ++n) *(f32x4*)(H + (size_t)(mt * 128 + wr * 64 + m * 16 + fr) * D + nt * 128 + wc * 64 + n * 16 + fq * 4) = acc[m][n] * (1.f / (W8_SCALE * O8_SCALE));
    }
}

constexpr int NPHASE = 22;
__global__ void __launch_bounds__(NTH, 2) mk_fwd(Args args) {
    extern __shared__ __attribute__((aligned(16))) unsigned char lds_raw[];
    Ctx c;
    c.lds = (LAS unsigned char*)lds_raw; c.tid = threadIdx.x; c.lane = c.tid & 63; c.wave = __builtin_amdgcn_readfirstlane(c.tid >> 6);
    c.nb = gridDim.x; { const int bx = blockIdx.x; c.vb = (c.nb % 8 == 0) ? (bx % 8) * (c.nb / 8) + bx / 8 : bx; }
    c.a = (const __attribute__((address_space(4))) Args*)__builtin_amdgcn_kernarg_segment_ptr(); c.ws = args.ws;
    volatile LAS unsigned* st = (volatile LAS unsigned*)(c.lds + LDS_MAIN + 1008);
    const bool multi = (args.ph_hi - args.ph_lo) > 1;
    XcdBarrier bar; bar.bar = (unsigned*)(c.ws + WS_CTL); bar.x = 0; bar.st = st;
    if (multi) {
        if (c.tid == 0) { st[0] = 0u; st[1] = 0u; }
        __syncthreads();
        bar = xcd_barrier_post((unsigned*)(c.ws + WS_CTL), st);
    }
    const int ph_lo = args.ph_lo, ph_hi = args.ph_hi;
#ifndef PH_MASK
#define PH_MASK 0x3fffff
#endif
#define PHON(k) ((PH_MASK >> (k)) & 1)
#define PHASE(k, body) do { if (PHON(k) && ph_lo <= (k) && (k) < ph_hi) { \
        { int t_ = threadIdx.x, vb_ = __builtin_amdgcn_readfirstlane(c.vb); \
          const __attribute__((address_space(4))) Args* ka = (const __attribute__((address_space(4))) Args*)__builtin_amdgcn_kernarg_segment_ptr(); \
          asm volatile("" : "+v"(t_), "+s"(vb_), "+s"(ka)); \
          c.tid = t_; c.lane = t_ & 63; c.wave = __builtin_amdgcn_readfirstlane(t_ >> 6); c.vb = vb_; c.a = ka; c.ws = ka->ws; } \
        body; \
        if (MK_REP == (k)) { __syncthreads(); body; } \
        if ((k) + 1 < ph_hi) xcd_barrier(bar); \
        if ((k) == 3) { for (int xb_ = 0; xb_ < MK_XBAR; ++xb_) xcd_barrier(bar); } } } while (0)
    PHASE(0, phase_prep(c));
    PHASE(1, phase_a1(c));
    PHASE(2, { if (MK_DRY == 2) { phase_a2(c, true); __syncthreads(); } phase_a2(c); });
    PHASE(3, phase_a3(c));
    PHASE(4, { if (MK_DRY == 4) { phase_route(c, 0, true); __syncthreads(); } phase_route(c, 0); });
    PHASE(5, phase_e1(c, 0));
    PHASE(6, phase_e2(c, 0));
    PHASE(7, { if (MK_DRY == 7) { phase_p1(c, 0, true); __syncthreads(); } phase_p1(c, 0); });
    PHASE(8, phase_p2(c, 0));
    PHASE(9, { phase_norm_bf16(c, (const float*)c.a->in[IN_MIXN] + D); convert_moe_layer(c, 1); });
    PHASE(10, phase_b1(c));
    PHASE(11, phase_rope(c));
    PHASE(12, phase_score(c));
    PHASE(13, phase_select(c));
    PHASE(14, phase_attn(c));
    PHASE(15, phase_b4(c));
    PHASE(16, phase_route(c, 1));
    PHASE(17, phase_e1(c, 1));
    PHASE(18, phase_e2(c, 1));
    PHASE(19, phase_p1(c, 1));
    PHASE(20, phase_p2(c, 1));
    PHASE(21, phase_final(c));
}

#ifdef MK_DUMP
__global__ void dump_k(const unsigned char* ws, float* out) {
    const size_t i = (size_t)blockIdx.x * 256 + threadIdx.x;
#if MK_DUMP == 1
    ((f32x4*)out)[i] = ((const f32x4*)(ws + WS_H))[i];
#elif MK_DUMP == 2
    { const u32x2 v = ((const u32x2*)(ws + WS_O))[i]; f32x4 o = {bf_lo(v.x), bf_hi(v.x), bf_lo(v.y), bf_hi(v.y)}; ((f32x4*)out)[i] = o; }
#elif MK_DUMP == 3
    { const int* sp = (const int*)(ws + WS_SEL); f32x4 o = {0.f,0.f,0.f,0.f}; if (i < (size_t)T * 64) { o.x = (float)sp[4*i]; o.y = (float)sp[4*i+1]; o.z = (float)sp[4*i+2]; o.w = (float)sp[4*i+3]; } ((f32x4*)out)[i] = o; }
#elif MK_DUMP == 5
    { const u32x2 v = ((const u32x2*)(ws + WS_XN))[i]; f32x4 o = {bf_lo(v.x), bf_hi(v.x), bf_lo(v.y), bf_hi(v.y)}; ((f32x4*)out)[i] = o; }
#elif MK_DUMP == 6
    { const u32x2 v = ((const u32x2*)(ws + WS_RAW))[i]; f32x4 o = {bf_lo(v.x), bf_hi(v.x), bf_lo(v.y), bf_hi(v.y)}; ((f32x4*)out)[i] = o; }
#elif MK_DUMP == 7
    { f32x4 o = {0.f,0.f,0.f,0.f}; if (i < (size_t)BINP * D / 4) { const u32x2 v = ((const u32x2*)(ws + WS_WBIN))[i]; o = (f32x4){bf_lo(v.x), bf_hi(v.x), bf_lo(v.y), bf_hi(v.y)}; } ((f32x4*)out)[i] = o; }
#elif MK_DUMP == 8
    { const u32x2 v = ((const u32x2*)(ws + WS_RAW))[i], w = ((const u32x2*)(ws + 458 * MB))[i]; f32x4 o = {bf_lo(v.x) - bf_lo(w.x), bf_hi(v.x) - bf_hi(w.x), bf_lo(v.y) - bf_lo(w.y), bf_hi(v.y) - bf_hi(w.y)}; ((f32x4*)out)[i] = o; }
#elif MK_DUMP == 9
    { const u32x2 v = ((const u32x2*)(ws + WS_RAW))[i], w = ((const u32x2*)(ws + 458 * MB))[i]; f32x4 o = {(v.x & 0xffffu) != (w.x & 0xffffu) ? 1.f : 0.f, (v.x >> 16) != (w.x >> 16) ? 1.f : 0.f, (v.y & 0xffffu) != (w.y & 0xffffu) ? 1.f : 0.f, (v.y >> 16) != (w.y >> 16) ? 1.f : 0.f}; ((f32x4*)out)[i] = o; }
#elif MK_DUMP == 4
    { const u32x2 v = ((const u32x2*)(ws + WS_Q))[i]; f32x4 o = {bf_lo(v.x), bf_hi(v.x), bf_lo(v.y), bf_hi(v.y)}; ((f32x4*)out)[i] = o; }
#endif
}
#endif
extern "C" void kernel_launch(void* const* d_in, const int* in_sizes, int n_in, void* d_out, int out_size, void* d_ws, size_t ws_size, hipStream_t stream) {
    static int grid = 0;
    if (grid == 0) {
        if (n_in != 23 || out_size != T * D || ws_size < WS_TOTAL) { fprintf(stderr, "kernel_launch: unexpected sizes n_in %d out %d ws %zu (need %zu)\n", n_in, out_size, ws_size, (size_t)WS_TOTAL); grid = -1; return; }
        int dev = 0, cus = 0, per_cu = 0;
        hipGetDevice(&dev); hipDeviceGetAttribute(&cus, hipDeviceAttributeMultiprocessorCount, dev);
        hipFuncSetAttribute((const void*)mk_fwd, hipFuncAttributeMaxDynamicSharedMemorySize, LDS_BYTES);
        hipOccupancyMaxActiveBlocksPerMultiprocessor(&per_cu, (const void*)mk_fwd, NTH, LDS_BYTES);
        (void)hipGetLastError();
        if (per_cu < 1) per_cu = 1;
        if (per_cu > 2) per_cu = 2;
        grid = cus * per_cu;
    }
    if (grid < 0) return;
    hipMemsetAsync((char*)d_ws + WS_CTL, 0, 16384, stream);
    Args a{};
    for (int i = 0; i < 23; ++i) a.in[i] = d_in[i];
    a.out = (float*)d_out; a.ws = (unsigned char*)d_ws;
#if MK_ONE_LAUNCH
    a.ph_lo = 0; a.ph_hi = NPHASE;
    hipLaunchKernelGGL(mk_fwd, dim3(grid), dim3(NTH), LDS_BYTES, stream, a);
#else
    for (int ph = 0; ph <= MK_LAST_PHASE; ++ph) { a.ph_lo = ph; a.ph_hi = ph + 1; hipLaunchKernelGGL(mk_fwd, dim3(grid), dim3(NTH), LDS_BYTES, stream, a); }
#ifdef MK_DUMP
    hipLaunchKernelGGL(dump_k, dim3(T * D / 4 / 256), dim3(256), 0, stream, (const unsigned char*)d_ws, (float*)d_out);
#endif
#endif
}
```

```cpp
#include <hip/hip_runtime.h>
#include <stdint.h>
#include <stdio.h>

#ifndef MK_LAST_PHASE
#define MK_LAST_PHASE 21
#endif
#ifndef MK_REP
#define MK_REP -1
#endif
#ifndef MK_XBAR
#define MK_XBAR 0
#endif
#ifndef MK_DRY
#define MK_DRY -1
#endif
#ifndef MK_ONE_LAUNCH
#define MK_ONE_LAUNCH 1
#endif

#define LAS __attribute__((address_space(3)))
typedef unsigned short bf16_t;
typedef short bf16x8 __attribute__((ext_vector_type(8)));
typedef float f32x4 __attribute__((ext_vector_type(4)));
typedef float f32x2 __attribute__((ext_vector_type(2)));
typedef float f32x16 __attribute__((ext_vector_type(16)));
typedef unsigned u32x4 __attribute__((ext_vector_type(4)));
typedef unsigned u32x2 __attribute__((ext_vector_type(2)));
typedef long i64x2 __attribute__((ext_vector_type(2)));

constexpr int T = 16384, D = 1024, SEQ = 4096;
constexpr int GW = 2048;
constexpr int BIN = 2120, BINP = 2176;
constexpr int NE = 32, DE = 512;
constexpr int PLE = 256;
constexpr float EPS = 1e-6f;
constexpr int NTH = 256;
constexpr int LDS_MAIN = 4 * 19456;
constexpr int LDS_BYTES = LDS_MAIN + 1024;
constexpr int RPAD = 32768 + NE * 128;

constexpr size_t MB = 1024 * 1024;
constexpr size_t WS_CTL = 0;
constexpr size_t WS_CNT = 16384;
constexpr size_t WS_WR = 32768;
constexpr size_t WS_WAIN = 1 * MB;
constexpr size_t WS_WAOUT = WS_WAIN + 8 * MB;
constexpr size_t WS_WBIN = WS_WAOUT + 4 * MB;
constexpr size_t WS_WBOUT = WS_WBIN + 5 * MB;
constexpr size_t WS_WGATE = WS_WBOUT + 2 * MB;
constexpr size_t WS_WPROJ = WS_WGATE + 4 * MB;
constexpr size_t WS_W1 = WS_WPROJ + 1 * MB;
constexpr size_t WS_XN8 = WS_W1 + 16 * MB;
constexpr size_t WS_W3 = WS_W1 + 32 * MB;
constexpr size_t WS_W2 = WS_W3 + 32 * MB;
constexpr size_t WS_PBF = WS_W2 + 32 * MB;
constexpr size_t WS_XN = WS_PBF + 16 * MB;
constexpr size_t WS_H = WS_XN + 32 * MB;
constexpr size_t WS_LIST = WS_H + 64 * MB;
constexpr size_t WS_GATE = WS_LIST + 2 * MB;
constexpr size_t WS_TOKSLOT = WS_GATE + 2 * MB;
constexpr size_t WS_SCR = WS_TOKSLOT + 1 * MB;
constexpr size_t WS_U = WS_SCR;
constexpr size_t WS_VT = WS_SCR + 64 * MB;
constexpr size_t WS_VSS = WS_SCR + 128 * MB;
constexpr size_t WS_HMID = WS_SCR;
constexpr size_t WS_Y = WS_SCR + 36 * MB;
constexpr size_t WS_RAW = WS_SCR;
constexpr size_t WS_O = WS_SCR;
constexpr size_t WS_Q = WS_SCR + 68 * MB;
constexpr size_t WS_K = WS_Q + 32 * MB;
constexpr size_t WS_V = WS_K + 8 * MB;
constexpr size_t WS_QI = WS_V + 8 * MB;
constexpr size_t WS_KI = WS_QI + 16 * MB;
constexpr size_t WS_WI = WS_KI + 2 * MB;
constexpr size_t WS_SEL = WS_WI + 1 * MB;
constexpr size_t WS_END = WS_SEL + 16 * MB;
static_assert(WS_END <= WS_SCR + 152 * MB, "scratch");
constexpr size_t WS_S = 392 * MB;
constexpr size_t WS_TOTAL = 522 * MB;

typedef __bf16 bf16x2_t __attribute__((ext_vector_type(2)));
__device__ __forceinline__ unsigned pk_bf16(float lo, float hi) { f32x2 v = {lo, hi}; bf16x2_t b = __builtin_convertvector(v, bf16x2_t); return __builtin_bit_cast(unsigned, b); }
__device__ __forceinline__ float bf_lo(unsigned u) { return __uint_as_float(u << 16); }
__device__ __forceinline__ float bf_hi(unsigned u) { return __uint_as_float(u & 0xffff0000u); }
__device__ __forceinline__ float wave_sum(float v) {
#pragma unroll
    for (int o = 1; o < 64; o <<= 1) v += __shfl_xor(v, o);
    return v;
}
__device__ __forceinline__ int lds_inc(LAS int* p) { return __hip_atomic_fetch_add(p, 1, __ATOMIC_RELAXED, __HIP_MEMORY_SCOPE_WORKGROUP); }
#define LDS_WAIT() asm volatile("s_waitcnt lgkmcnt(0)" ::: "memory")
#define VM_WAIT() asm volatile("s_waitcnt vmcnt(0)" ::: "memory")

#define XB_TMO      128
#define XB_XCNT(j)  (256  + 64 * (j))
#define XB_XSUB(j)  (1280 + 64 * (j))
#define XB_XGEN(j)  (2304 + 64 * (j))
#define XB_TOP      3328
#define XB_TOPGEN   3392
#define XCD_BAR_WORDS 3456
#define XB_SPIN_CAP (1u << 20)
__device__ __forceinline__ unsigned xb_ld(unsigned* p)              { return __hip_atomic_load(p, __ATOMIC_RELAXED, __HIP_MEMORY_SCOPE_AGENT); }
__device__ __forceinline__ unsigned xb_add(unsigned* p, unsigned v) { return __hip_atomic_fetch_add(p, v, __ATOMIC_RELAXED, __HIP_MEMORY_SCOPE_AGENT); }
__device__ __forceinline__ unsigned xb_xcc_id() { return (unsigned)__builtin_amdgcn_s_getreg((3 << 11) | 20) & 0xFu; }
#define XB_SPIN(cond, bar) do { unsigned _sp = 0; while (cond) { __builtin_amdgcn_s_sleep(1); \
    if ((++_sp & 255u) == 0u) { if (xb_ld(&(bar)[XB_TMO])) break; if (_sp > XB_SPIN_CAP) { atomicAdd(&(bar)[XB_TMO], 1u); break; } } } } while (0)
struct XcdBarrier { unsigned* bar; unsigned x; volatile LAS unsigned* st; };
__device__ __forceinline__ XcdBarrier xcd_barrier_post(unsigned* bar, volatile LAS unsigned* st) {
    XcdBarrier b; b.bar = bar; b.x = xb_xcc_id(); b.st = st;
    if (threadIdx.x == 0) (void)xb_add(&bar[XB_XCNT(b.x)], 1u);
    return b;
}
__device__ __forceinline__ void xcd_barrier_complete(unsigned* bar, unsigned x, unsigned& nloc, unsigned& nx) {
    const unsigned G = gridDim.x;
    unsigned sum, cnt, mine, sp = 0u;
    for (;;) {
        sum = 0u; cnt = 0u; mine = 0u;
#pragma unroll
        for (unsigned j = 0; j < 16; ++j) { const unsigned c = xb_ld(&bar[XB_XCNT(j)]); sum += c; cnt += (c > 0u) ? 1u : 0u; mine = (j == x) ? c : mine; }
        if (sum == G) break;
        __builtin_amdgcn_s_sleep(1);
        if ((++sp & 255u) == 0u) { if (xb_ld(&bar[XB_TMO])) break; if (sp > XB_SPIN_CAP) { atomicAdd(&bar[XB_TMO], 1u); break; } }
    }
    nloc = mine > 0u ? mine : 1u; nx = cnt > 0u ? cnt : 1u;
}
__device__ __forceinline__ void xcd_barrier(const XcdBarrier& b) {
    asm volatile("s_waitcnt vmcnt(0)" ::: "memory");
    __syncthreads();
    if (threadIdx.x == 0) {
        unsigned* bar = b.bar;
        __builtin_amdgcn_s_waitcnt(0);
        unsigned nloc = b.st[0], nx = b.st[1];
        if (nloc == 0u) { xcd_barrier_complete(bar, b.x, nloc, nx); b.st[0] = nloc; b.st[1] = nx; }
        const unsigned old = xb_add(&bar[XB_XSUB(b.x)], 1u);
        const unsigned gen = old / nloc;
        if (old + 1u == (gen + 1u) * nloc) {
            __builtin_amdgcn_fence(__ATOMIC_RELEASE, "agent");
            asm volatile("s_waitcnt vmcnt(0)" ::: "memory");
            const unsigned og = xb_add(&bar[XB_TOP], 1u);
            const unsigned tg = og / nx;
            if (og + 1u == (tg + 1u) * nx) xb_add(&bar[XB_TOPGEN], 1u);
            else XB_SPIN(xb_ld(&bar[XB_TOPGEN]) == tg, bar);
            __builtin_amdgcn_fence(__ATOMIC_ACQUIRE, "agent");
            xb_add(&bar[XB_XGEN(b.x)], 1u);
            asm volatile("s_waitcnt vmcnt(0)" ::: "memory");
        } else {
            XB_SPIN(xb_ld(&bar[XB_XGEN(b.x)]) == gen, bar);
            __builtin_amdgcn_fence(__ATOMIC_ACQUIRE, "agent");
            asm volatile("s_waitcnt vmcnt(0)" ::: "memory");
        }
    }
    __syncthreads();
}

struct Args { const void* in[23]; float* out; unsigned char* ws; int ph_lo, ph_hi; };
enum { IN_X = 0, IN_P, IN_POS, IN_MIXN, IN_AWIN, IN_AVG, IN_AWS, IN_ABS, IN_AWOUT, IN_BWIN, IN_BWOUT, IN_FFNN, IN_WG, IN_BG, IN_WE, IN_BE,
       IN_W1, IN_W3, IN_W2, IN_PLEN, IN_PLEG, IN_PLEP, IN_FINN };

struct Ctx {
    LAS unsigned char* lds;
    int tid, lane, wave, vb, nb;
    const __attribute__((address_space(4))) Args* a;
    unsigned char* ws;
};

template <int BK> struct TileK { static constexpr int NP = (BK == 64) ? 4 : 2; static constexpr int TB = 128 * BK * 2; };

template <int BK>
__device__ __forceinline__ void stage_tile(LAS unsigned char* tile, const bf16_t* const (&rp)[TileK<BK>::NP], int k0, int tid) {
    const int lc = (BK == 64) ? ((tid & 7) ^ ((tid >> 3) & 7)) : ((tid & 3) ^ ((tid >> 3) & 3));
#pragma unroll
    for (int p = 0; p < TileK<BK>::NP; ++p)
        __builtin_amdgcn_global_load_lds((const unsigned*)(rp[p] + k0 + lc * 8), (LAS unsigned*)(tile + p * 4096 + tid * 16), 16, 0, 0);
}
template <int BK>
__device__ __forceinline__ void rows_regular(const bf16_t* (&rp)[TileK<BK>::NP], const bf16_t* base, size_t ld, int tid) {
#pragma unroll
    for (int p = 0; p < TileK<BK>::NP; ++p) { const int r = (BK == 64) ? (p * 32 + (tid >> 3)) : (p * 64 + (tid >> 2)); rp[p] = base + (size_t)r * ld; }
}
template <int BK>
__device__ __forceinline__ int frag_off(int row, int ks, int fq) {
    return (BK == 64) ? (row * 128 + (((ks * 4 + fq) ^ (row & 7)) << 4)) : (row * 64 + ((fq ^ ((row >> 1) & 3)) << 4));
}

template <int BK, int NBOP, bool SWAP, bool FP8 = false>
__device__ __forceinline__ void gemm_loop(const Ctx& c, const bf16_t* const (&ap)[TileK<BK>::NP], const bf16_t* const (&b0p)[TileK<BK>::NP], const bf16_t* const (&b1p)[TileK<BK>::NP],
                                          int K, f32x4 (&acc0)[4][4], f32x4 (&acc1)[4][4]) {
    constexpr int TB = TileK<BK>::TB, SB = (1 + NBOP) * TB;
    static_assert(2 * SB <= LDS_MAIN, "lds");
    const int nk = K / BK, tid = c.tid;
    const int fr = c.lane & 15, fq = c.lane >> 4, wr = c.wave >> 1, wc = c.wave & 1;
    LAS unsigned char* lds = c.lds;
    stage_tile<BK>(lds, ap, 0, tid); stage_tile<BK>(lds + TB, b0p, 0, tid);
    if (NBOP == 2) stage_tile<BK>(lds + 2 * TB, b1p, 0, tid);
    for (int kt = 0; kt < nk; ++kt) {
        VM_WAIT();
        __syncthreads();
        LAS unsigned char* cur = lds + (kt & 1) * SB;
        if (kt + 1 < nk) {
            LAS unsigned char* nxt = lds + ((kt + 1) & 1) * SB;
            stage_tile<BK>(nxt, ap, (kt + 1) * BK, tid); stage_tile<BK>(nxt + TB, b0p, (kt + 1) * BK, tid);
            if (NBOP == 2) stage_tile<BK>(nxt + 2 * TB, b1p, (kt + 1) * BK, tid);
        }
#pragma unroll
        for (int ks = 0; ks < BK / 32; ++ks) {
            bf16x8 af[4], bf0[4], bf1[4];
#pragma unroll
            for (int m = 0; m < 4; ++m) af[m] = *(const LAS bf16x8*)(cur + frag_off<BK>(wr * 64 + m * 16 + fr, ks, fq));
#pragma unroll
            for (int n = 0; n < 4; ++n) bf0[n] = *(const LAS bf16x8*)(cur + TB + frag_off<BK>(wc * 64 + n * 16 + fr, ks, fq));
            if (NBOP == 2) {
#pragma unroll
                for (int n = 0; n < 4; ++n) bf1[n] = *(const LAS bf16x8*)(cur + 2 * TB + frag_off<BK>(wc * 64 + n * 16 + fr, ks, fq));
            }
#pragma unroll
            for (int m = 0; m < 4; ++m)
#pragma unroll
                for (int n = 0; n < 4; ++n) {
                    if (FP8) {
                        const i64x2 a2 = __builtin_bit_cast(i64x2, af[m]), b2 = __builtin_bit_cast(i64x2, bf0[n]);
                        if (SWAP) { acc0[m][n] = __builtin_amdgcn_mfma_f32_16x16x32_fp8_fp8(b2.x, a2.x, acc0[m][n], 0, 0, 0); acc0[m][n] = __builtin_amdgcn_mfma_f32_16x16x32_fp8_fp8(b2.y, a2.y, acc0[m][n], 0, 0, 0); }
                        else      { acc0[m][n] = __builtin_amdgcn_mfma_f32_16x16x32_fp8_fp8(a2.x, b2.x, acc0[m][n], 0, 0, 0); acc0[m][n] = __builtin_amdgcn_mfma_f32_16x16x32_fp8_fp8(a2.y, b2.y, acc0[m][n], 0, 0, 0); }
                        continue;
                    }
                    if (SWAP) acc0[m][n] = __builtin_amdgcn_mfma_f32_16x16x32_bf16(bf0[n], af[m], acc0[m][n], 0, 0, 0);
                    else      acc0[m][n] = __builtin_amdgcn_mfma_f32_16x16x32_bf16(af[m], bf0[n], acc0[m][n], 0, 0, 0);
                    if (NBOP == 2) {
                        if (SWAP) acc1[m][n] = __builtin_amdgcn_mfma_f32_16x16x32_bf16(bf1[n], af[m], acc1[m][n], 0, 0, 0);
                        else      acc1[m][n] = __builtin_amdgcn_mfma_f32_16x16x32_bf16(af[m], bf1[n], acc1[m][n], 0, 0, 0);
                    }
                }
        }
    }
    __syncthreads();
}
__device__ __forceinline__ void zero_acc(f32x4 (&acc)[4][4]) {
#pragma unroll
    for (int m = 0; m < 4; ++m)
#pragma unroll
        for (int n = 0; n < 4; ++n) acc[m][n] = (f32x4){0.f, 0.f, 0.f, 0.f};
}
__device__ __forceinline__ void map_unit(int u, int nnt, int& mt, int& nt) { const int per = 8 * nnt, band = u / per, r = u - band * per; nt = r >> 3; mt = band * 8 + (r & 7); }


__device__ __forceinline__ float gelu_tanh(float x) {
    const float y2 = 1.5957691216057308f * (x + 0.044715f * x * x * x);
    return x / (1.f + __expf(-y2));
}
__device__ __forceinline__ float sigmoidf_(float x) { return 1.f / (1.f + __expf(-x)); }

__device__ __forceinline__ void row_load(const float* row, int lane, f32x4 (&v)[4]) {
#pragma unroll
    for (int j = 0; j < 4; ++j) v[j] = ((const f32x4*)row)[lane + 64 * j];
}
__device__ __forceinline__ float row_sumsq(const f32x4 (&v)[4]) {
    float s = 0.f;
#pragma unroll
    for (int j = 0; j < 4; ++j) s += (v[j].x * v[j].x + v[j].y * v[j].y) + (v[j].z * v[j].z + v[j].w * v[j].w);
    return wave_sum(s);
}
__device__ __forceinline__ void gain_load(const float* gain, int lane, f32x4 (&g)[4]) {
#pragma unroll
    for (int j = 0; j < 4; ++j) g[j] = ((const f32x4*)gain)[lane + 64 * j];
}
__device__ __forceinline__ void row_store_norm_bf16(bf16_t* orow, int lane, const f32x4 (&v)[4], float r, const f32x4 (&gv)[4]) {
#pragma unroll
    for (int j = 0; j < 4; ++j) {
        const f32x4 g = gv[j];
        u32x2 o; o.x = pk_bf16(v[j].x * r * g.x, v[j].y * r * g.y); o.y = pk_bf16(v[j].z * r * g.z, v[j].w * r * g.w);
        ((u32x2*)orow)[lane + 64 * j] = o;
    }
}

__device__ __forceinline__ unsigned pk_fp8x4(float a, float b, float c_, float d);
__device__ __forceinline__ void row_store_norm_fp8(unsigned char* orow, int lane, const f32x4 (&v)[4], float r, const f32x4 (&gv)[4]) {
#pragma unroll
    for (int j = 0; j < 4; ++j) ((unsigned*)orow)[lane + 64 * j] = pk_fp8x4(v[j].x * r * gv[j].x, v[j].y * r * gv[j].y, v[j].z * r * gv[j].z, v[j].w * r * gv[j].w);
}
constexpr int TR_SCR = 64 * 136;
__device__ __forceinline__ void transpose_item(const float* W, int K, int N, int nvalid, int ldw, bf16_t* WT, LAS unsigned char* scr, int item, int lane) {
    const int nblk = N / 64, kb = item / nblk, nb = item - kb * nblk, k0 = 64 * kb, n0 = 64 * nb;
    const int n = n0 + 4 * (lane & 15);
    const int nc_ = (n < nvalid) ? n : 0; const float keep = (n < nvalid) ? 1.f : 0.f;
    f32x4 v[16];
#pragma unroll
    for (int i = 0; i < 16; ++i) v[i] = *(const f32x4*)(W + (size_t)(k0 + 4 * i + (lane >> 4)) * ldw + nc_);
#pragma unroll
    for (int i = 0; i < 16; ++i) {
        const int kk = 4 * i + (lane >> 4);
        u32x2 o; o.x = pk_bf16(v[i].x * keep, v[i].y * keep); o.y = pk_bf16(v[i].z * keep, v[i].w * keep);
        *(LAS u32x2*)(scr + kk * 136 + (lane & 15) * 8) = o;
    }
    LDS_WAIT();
    const int cc = lane & 7;
#pragma unroll
    for (int j = 0; j < 8; ++j) {
        const int nn = (lane >> 3) + 8 * j; const LAS unsigned short* sp = (const LAS unsigned short*)(scr + (8 * cc) * 136 + nn * 2);
        u32x4 o;
        o.x = (unsigned)sp[0 * 68] | ((unsigned)sp[1 * 68] << 16); o.y = (unsigned)sp[2 * 68] | ((unsigned)sp[3 * 68] << 16);
        o.z = (unsigned)sp[4 * 68] | ((unsigned)sp[5 * 68] << 16); o.w = (unsigned)sp[6 * 68] | ((unsigned)sp[7 * 68] << 16);
        *(u32x4*)(WT + (size_t)(n0 + nn) * K + k0 + 8 * cc) = o;
    }
    LDS_WAIT();
}

__device__ __forceinline__ unsigned pk_fp8x4(float a, float b, float c_, float d) {
    a = fminf(fmaxf(a, -448.f), 448.f); b = fminf(fmaxf(b, -448.f), 448.f); c_ = fminf(fmaxf(c_, -448.f), 448.f); d = fminf(fmaxf(d, -448.f), 448.f);
    int p = __builtin_amdgcn_cvt_pk_fp8_f32(a, b, 0, false);
    p = __builtin_amdgcn_cvt_pk_fp8_f32(c_, d, p, true);
    return (unsigned)p;
}
constexpr float W8_SCALE = 64.f, H8_SCALE = 4.f, O8_SCALE = 8.f;
__device__ __forceinline__ void transpose_item8(const float* W, int K, int N, unsigned char* WT, LAS unsigned char* scr, int item, int lane, int nvalid = 1 << 30, int ldw = 0) {
    const int nblk = N / 64, kb = item / nblk, nb = item - kb * nblk, k0 = 128 * kb, n0 = 64 * nb;
    const int n = n0 + 4 * (lane & 15), ld = ldw ? ldw : N, nc_ = (n < nvalid) ? n : 0; const float keep = (n < nvalid) ? W8_SCALE : 0.f;
#pragma unroll 2
    for (int h = 0; h < 2; ++h) {
        f32x4 v[16];
#pragma unroll
        for (int i = 0; i < 16; ++i) v[i] = *(const f32x4*)(W + (size_t)(k0 + 64 * h + 4 * i + (lane >> 4)) * ld + nc_);
#pragma unroll
        for (int i = 0; i < 16; ++i) { const int kk = 64 * h + 4 * i + (lane >> 4);
            *(LAS unsigned*)(scr + kk * 68 + (lane & 15) * 4) = pk_fp8x4(v[i].x * keep, v[i].y * keep, v[i].z * keep, v[i].w * keep); }
    }
    LDS_WAIT();
    const int cc = lane & 7;
#pragma unroll
    for (int j = 0; j < 8; ++j) {
        const int nn = (lane >> 3) + 8 * j; const LAS unsigned char* sp = scr + (16 * cc) * 68 + nn;
        unsigned w[4];
#pragma unroll
        for (int q = 0; q < 4; ++q) w[q] = (unsigned)sp[(4 * q + 0) * 68] | ((unsigned)sp[(4 * q + 1) * 68] << 8) | ((unsigned)sp[(4 * q + 2) * 68] << 16) | ((unsigned)sp[(4 * q + 3) * 68] << 24);
        u32x4 o = {w[0], w[1], w[2], w[3]};
        *(u32x4*)(WT + (size_t)(n0 + nn) * K + k0 + 16 * cc) = o;
    }
    LDS_WAIT();
}
__device__ __forceinline__ void convert_moe_item(const Ctx& c, int l, int it, LAS unsigned char* scr) {
    const float* w1 = (const float*)c.a->in[IN_W1] + (size_t)l * NE * D * DE;
    const float* w3 = (const float*)c.a->in[IN_W3] + (size_t)l * NE * D * DE;
    const float* w2 = (const float*)c.a->in[IN_W2] + (size_t)l * NE * DE * D;
    unsigned char* W1 = c.ws + WS_W1; unsigned char* W3 = c.ws + WS_W3; unsigned char* W2 = c.ws + WS_W2;
    const int e = it / 192, r = it - e * 192;
    if (r < 64)       transpose_item8(w1 + (size_t)e * D * DE, D, DE, W1 + (size_t)e * DE * D, scr, r, c.lane);
    else if (r < 128) transpose_item8(w3 + (size_t)e * D * DE, D, DE, W3 + (size_t)e * DE * D, scr, r - 64, c.lane);
    else              transpose_item8(w2 + (size_t)e * DE * D, DE, D, W2 + (size_t)e * D * DE, scr, r - 128, c.lane);
}
__device__ __forceinline__ void convert_moe_layer(const Ctx& c, int l) {
    LAS unsigned char* scr = c.lds + c.wave * TR_SCR;
    const int gw = c.vb * 4 + c.wave, ngw = c.nb * 4;
    for (int it = gw; it < NE * 192; it += ngw) convert_moe_item(c, l, it, scr);
}

__device__ __forceinline__ void phase_prep(const Ctx& c) {
    const __attribute__((address_space(4))) Args& a = *c.a;
    LAS unsigned char* scr = c.lds + c.wave * TR_SCR;
    const int gw = c.vb * 4 + c.wave, ngw = c.nb * 4;
    constexpr int I_AIN = 16 * 64, I_AOUT = 32 * 16, I_PP = 4 * 16, I_BIN8 = 8 * 34, I_BOUT8 = 8 * 16, I_PG8 = 8 * 16, I_BINI = 16 * 10;
    constexpr int NIT = I_AIN + I_AOUT + 2 * I_PP + I_BIN8 + I_BOUT8 + 2 * I_PG8 + I_BINI;
    for (int it = gw; it < NIT; it += ngw) {
        int r = it;
        if (r < I_AIN) { transpose_item((const float*)a.in[IN_AWIN], D, 4096, 4096, 4096, (bf16_t*)(c.ws + WS_WAIN), scr, r, c.lane); continue; } r -= I_AIN;
        if (r < I_AOUT) { transpose_item((const float*)a.in[IN_AWOUT], GW, D, D, D, (bf16_t*)(c.ws + WS_WAOUT), scr, r, c.lane); continue; } r -= I_AOUT;
        if (r < 2 * I_PP) { const int l = r / I_PP; transpose_item((const float*)a.in[IN_PLEP] + (size_t)l * PLE * D, PLE, D, D, D, (bf16_t*)(c.ws + WS_WPROJ) + (size_t)l * D * PLE, scr, r - l * I_PP, c.lane); continue; } r -= 2 * I_PP;
        if (r < I_BIN8) { transpose_item8((const float*)a.in[IN_BWIN], D, BINP, c.ws + WS_WBIN, scr, r, c.lane, BIN, BIN); continue; } r -= I_BIN8;
        if (r < I_BOUT8) { transpose_item8((const float*)a.in[IN_BWOUT], D, D, c.ws + WS_WBOUT, scr, r, c.lane); continue; } r -= I_BOUT8;
        if (r < 2 * I_PG8) { const int l = r / I_PG8; transpose_item8((const float*)a.in[IN_PLEG] + (size_t)l * D * D, D, D, c.ws + WS_WGATE + (size_t)l * D * D, scr, r - l * I_PG8, c.lane); continue; } r -= 2 * I_PG8;
        transpose_item((const float*)a.in[IN_BWIN] + 1536, D, 640, BIN - 1536, BIN, (bf16_t*)(c.ws + WS_WBIN + 3 * MB), scr, r, c.lane);
    }
    convert_moe_layer(c, 0);
    const int gt = c.vb * NTH + c.tid, ngt = c.nb * NTH;
    { const float* p = (const float*)a.in[IN_P]; bf16_t* pb = (bf16_t*)(c.ws + WS_PBF);
      for (int i = gt; i < 2 * T * PLE / 8; i += ngt) {
          const f32x4 v0 = ((const f32x4*)p)[2 * i], v1 = ((const f32x4*)p)[2 * i + 1];
          u32x4 o; o.x = pk_bf16(v0.x, v0.y); o.y = pk_bf16(v0.z, v0.w); o.z = pk_bf16(v1.x, v1.y); o.w = pk_bf16(v1.z, v1.w);
          ((u32x4*)pb)[i] = o; } }
    { float* wr = (float*)(c.ws + WS_WR);
      for (int i = gt; i < 2 * D * 48; i += ngt) {
          const int l = i / (D * 48), r = i - l * D * 48, k = r / 48, o = r - k * 48;
          float w = 0.f;
          if (o < 4) w = ((const float*)a.in[IN_WG])[(size_t)l * D * 4 + k * 4 + o];
          else if (o < 36) w = ((const float*)a.in[IN_WE])[(size_t)l * D * 32 + k * 32 + (o - 4)];
          wr[i] = w * ((const float*)a.in[IN_FFNN])[l * D + k]; } }
    if (c.vb == 0 && c.tid < 128) ((int*)(c.ws + WS_CNT))[c.tid] = 0;
    f32x4 gv[4]; gain_load((const float*)a.in[IN_MIXN], c.lane, gv);
    for (int t = gw; t < T; t += ngw) {
        f32x4 v[4]; row_load((const float*)a.in[IN_X] + (size_t)t * D, c.lane, v);
        const float r = rsqrtf(row_sumsq(v) * (1.f / D) + EPS);
        row_store_norm_bf16((bf16_t*)(c.ws + WS_XN) + (size_t)t * D, c.lane, v, r, gv);
    }
}

__device__ __forceinline__ void phase_a1(const Ctx& c) {
    const bf16_t* XN = (const bf16_t*)(c.ws + WS_XN); const bf16_t* W = (const bf16_t*)(c.ws + WS_WAIN);
    bf16_t* U = (bf16_t*)(c.ws + WS_U); bf16_t* VT = (bf16_t*)(c.ws + WS_VT); float* VSS = (float*)(c.ws + WS_VSS);
    const int fr = c.lane & 15, fq = c.lane >> 4, wr = c.wave >> 1, wc = c.wave & 1;
    for (int u = c.vb; u < 128 * 32; u += c.nb) {
        int mt, nt; map_unit(u, 32, mt, nt);
        const bf16_t* ap[4]; const bf16_t* bp[4];
        rows_regular<64>(ap, XN + (size_t)mt * 128 * D, D, c.tid); rows_regular<64>(bp, W + (size_t)nt * 128 * D, D, c.tid);
        f32x4 acc[4][4]; zero_acc(acc);
        if (nt < 16) {
            gemm_loop<64, 1, true>(c, ap, bp, bp, D, acc, acc);
#pragma unroll
            for (int m = 0; m < 4; ++m)
#pragma unroll
                for (int n = 0; n < 4; ++n) {
                    const int t = mt * 128 + wr * 64 + m * 16 + fr, col = nt * 128 + wc * 64 + n * 16 + fq * 4;
                    const f32x4 v = acc[m][n];
                    u32x2 o; o.x = pk_bf16(gelu_tanh(v.x), gelu_tanh(v.y)); o.y = pk_bf16(gelu_tanh(v.z), gelu_tanh(v.w));
                    *(u32x2*)(U + (size_t)t * GW + col) = o;
                }
        } else {
            gemm_loop<64, 1, false>(c, ap, bp, bp, D, acc, acc);
            const int vn = nt - 16;
#pragma unroll
            for (int m = 0; m < 4; ++m) {
                f32x4 ss = {0.f, 0.f, 0.f, 0.f};
                const int t0 = mt * 128 + wr * 64 + m * 16 + fq * 4;
#pragma unroll
                for (int n = 0; n < 4; ++n) {
                    const int ch = vn * 128 + wc * 64 + n * 16 + fr;
                    f32x4 v = acc[m][n];
                    v.x = gelu_tanh(v.x); v.y = gelu_tanh(v.y); v.z = gelu_tanh(v.z); v.w = gelu_tanh(v.w);
                    ss += v * v;
                    u32x2 o; o.x = pk_bf16(v.x, v.y); o.y = pk_bf16(v.z, v.w);
                    *(u32x2*)(VT + (size_t)ch * T + t0) = o;
                }
#pragma unroll
                for (int o = 1; o < 16; o <<= 1) { ss.x += __shfl_xor(ss.x, o); ss.y += __shfl_xor(ss.y, o); ss.z += __shfl_xor(ss.z, o); ss.w += __shfl_xor(ss.w, o); }
                if (fr == 0) {
                    VSS[(size_t)(t0 + 0) * 32 + vn * 2 + wc] = ss.x; VSS[(size_t)(t0 + 1) * 32 + vn * 2 + wc] = ss.y;
                    VSS[(size_t)(t0 + 2) * 32 + vn * 2 + wc] = ss.z; VSS[(size_t)(t0 + 3) * 32 + vn * 2 + wc] = ss.w;
                }
            }
        }
    }
}

__device__ __forceinline__ void phase_a2(const Ctx& c, bool dry = false) {
    const __attribute__((address_space(4))) Args& a = *c.a;
    bf16_t* U = (bf16_t*)(c.ws + WS_U); const bf16_t* VT = (const bf16_t*)(c.ws + WS_VT); const float* VSS = (const float*)(c.ws + WS_VSS);
    const float* ws_ = (const float*)a.in[IN_AWS]; const float* bs_ = (const float*)a.in[IN_ABS]; const float* vg = (const float*)a.in[IN_AVG];
    const int fr = c.lane & 15, fq = c.lane >> 4, wr = c.wave >> 1, wc = c.wave & 1, tid = c.tid;
    LAS unsigned char* lds = c.lds;
    LAS float* rl = (LAS float*)(lds + LDS_MAIN);
    for (int u = c.vb; u < 128 * 8; u += c.nb) {
        const int ci = u >> 3, g = u & 7, tokbase = ci * 128;
        __syncthreads();
        if (tid < 128) {
            const float* p = VSS + (size_t)(tokbase + tid) * 32; float s = 0.f;
#pragma unroll
            for (int i = 0; i < 8; ++i) { const f32x4 q = ((const f32x4*)p)[i]; s += (q.x + q.y) + (q.z + q.w); }
            rl[tid] = rsqrtf(s * (1.f / GW) + EPS);
        }
        __syncthreads();
        {
            const int t = tid >> 1, half = tid & 1;
            const float* wrow = ws_ + ((size_t)g * 128 + t) * 128 + half * 64;
#pragma unroll
            for (int cc = 0; cc < 8; ++cc) {
                const int s0 = half * 64 + cc * 8;
                u32x4 o;
                {
                    const f32x4 w0 = ((const f32x4*)wrow)[2 * cc], w1 = ((const f32x4*)wrow)[2 * cc + 1];
                    float e[8] = {w0.x, w0.y, w0.z, w0.w, w1.x, w1.y, w1.z, w1.w};
#pragma unroll
                    for (int i = 0; i < 8; ++i) e[i] = (s0 + i <= t) ? e[i] * rl[s0 + i] : 0.f;
                    o.x = pk_bf16(e[0], e[1]); o.y = pk_bf16(e[2], e[3]); o.z = pk_bf16(e[4], e[5]); o.w = pk_bf16(e[6], e[7]);
                }
                *(LAS u32x4*)(lds + half * 16384 + t * 128 + ((cc ^ (t & 7)) << 4)) = o;
            }
        }
        for (int hn = 0; hn < 2; ++hn) {
            const int c0 = g * 256 + hn * 128;
            const bf16_t* bp[4]; rows_regular<64>(bp, VT + (size_t)c0 * T + tokbase, T, tid);
            stage_tile<64>(lds + 32768, bp, 0, tid); stage_tile<64>(lds + 32768 + 16384, bp, 64, tid);
            VM_WAIT();
            __syncthreads();
            f32x4 acc[4][4]; zero_acc(acc);
#pragma unroll 1
            for (int kh = 0; kh < 2; ++kh)
#pragma unroll 1
                for (int ks = 0; ks < 2; ++ks) {
                    bf16x8 af[4], bf[4];
#pragma unroll
                    for (int m = 0; m < 4; ++m) af[m] = *(const LAS bf16x8*)(lds + kh * 16384 + frag_off<64>(wr * 64 + m * 16 + fr, ks, fq));
#pragma unroll
                    for (int n = 0; n < 4; ++n) bf[n] = *(const LAS bf16x8*)(lds + 32768 + kh * 16384 + frag_off<64>(wc * 64 + n * 16 + fr, ks, fq));
#pragma unroll
                    for (int m = 0; m < 4; ++m)
#pragma unroll
                        for (int n = 0; n < 4; ++n) acc[m][n] = __builtin_amdgcn_mfma_f32_16x16x32_bf16(bf[n], af[m], acc[m][n], 0, 0, 0);
                }
            u32x2 uvv[4][4]; float bsvv[4];
#pragma unroll
            for (int m = 0; m < 4; ++m) { const int tl = wr * 64 + m * 16 + fr; bsvv[m] = bs_[g * 128 + tl];
#pragma unroll
                for (int n = 0; n < 4; ++n) uvv[m][n] = *(const u32x2*)(U + (size_t)(tokbase + tl) * GW + c0 + wc * 64 + n * 16 + fq * 4); }
#pragma unroll
            for (int m = 0; m < 4; ++m) {
                const int tl = wr * 64 + m * 16 + fr; const float bsv = bsvv[m];
#pragma unroll
                for (int n = 0; n < 4; ++n) {
                    const int ch = c0 + wc * 64 + n * 16 + fq * 4;
                    const f32x4 gn = *(const f32x4*)(vg + ch);
                    u32x2* up = (u32x2*)(U + (size_t)(tokbase + tl) * GW + ch);
                    const u32x2 uv = uvv[m][n]; const f32x4 v = acc[m][n];
                    u32x2 o;
                    o.x = pk_bf16(bf_lo(uv.x) * (gn.x * v.x + bsv), bf_hi(uv.x) * (gn.y * v.y + bsv));
                    o.y = pk_bf16(bf_lo(uv.y) * (gn.z * v.z + bsv), bf_hi(uv.y) * (gn.w * v.w + bsv));
                    if (dry) *(u32x2*)(c.ws + 440 * MB + ((size_t)(tokbase + tl) * GW + ch) * 2) = o; else *up = o;
                }
            }
            __syncthreads();
        }
    }
}

__device__ __forceinline__ void phase_a3(const Ctx& c) {
    const bf16_t* Z = (const bf16_t*)(c.ws + WS_U); const bf16_t* W = (const bf16_t*)(c.ws + WS_WAOUT);
    const float* X = (const float*)c.a->in[IN_X]; float* H = (float*)(c.ws + WS_H);
    const int fr = c.lane & 15, fq = c.lane >> 4, wr = c.wave >> 1, wc = c.wave & 1;
    for (int u = c.vb; u < 128 * 8; u += c.nb) {
        int mt, nt; map_unit(u, 8, mt, nt);
        const bf16_t* ap[4]; const bf16_t* bp[4];
        rows_regular<64>(ap, Z + (size_t)mt * 128 * GW, GW, c.tid); rows_regular<64>(bp, W + (size_t)nt * 128 * GW, GW, c.tid);
        f32x4 acc[4][4];
#pragma unroll
        for (int m = 0; m < 4; ++m)
#pragma unroll
            for (int n = 0; n < 4; ++n) acc[m][n] = *(const f32x4*)(X + (size_t)(mt * 128 + wr * 64 + m * 16 + fr) * D + nt * 128 + wc * 64 + n * 16 + fq * 4);
        gemm_loop<64, 1, true>(c, ap, bp, bp, GW, acc, acc);
#pragma unroll
        for (int m = 0; m < 4; ++m)
#pragma unroll
            for (int n = 0; n < 4; ++n) *(f32x4*)(H + (size_t)(mt * 128 + wr * 64 + m * 16 + fr) * D + nt * 128 + wc * 64 + n * 16 + fq * 4) = acc[m][n];
    }
}

__device__ __forceinline__ void phase_route(const Ctx& c, int l, bool dry = false) {
    const __attribute__((address_space(4))) Args& a = *c.a;
    const float* H = (const float*)(c.ws + WS_H); bf16_t* XN = (bf16_t*)(c.ws + (dry ? 440 * MB : WS_XN));
    const float* wr_ = (const float*)(c.ws + WS_WR) + (size_t)l * D * 48;
    const float* gain = (const float*)a.in[IN_FFNN] + l * D;
    int* cnt = (int*)(c.ws + WS_CNT) + l * 32 + (dry ? 64 : 0); int* list = (int*)(c.ws + (dry ? 480 * MB : WS_LIST)); float* gatel = (float*)(c.ws + (dry ? 484 * MB : WS_GATE)); int* tokslot = (int*)(c.ws + (dry ? 488 * MB : WS_TOKSLOT));
    LAS float* rl = (LAS float*)(c.lds);
    LAS float* lgl = (LAS float*)(c.lds + 256);
    const int lane = c.lane, w = c.wave;
    f32x4 gv[4]; gain_load(gain, lane, gv);
    for (int unit = c.vb; unit < T / 32; unit += c.nb) {
        const int tok0 = unit * 32;
        __syncthreads();
        for (int i = 0; i < 8; ++i) {
            const int t = tok0 + w * 8 + i;
            f32x4 v[4]; row_load(H + (size_t)t * D, lane, v);
            const float r = rsqrtf(row_sumsq(v) * (1.f / D) + EPS);
            if (lane == 0) rl[w * 8 + i] = r;
            row_store_norm_fp8(c.ws + (dry ? 440 * MB : WS_XN8) + (size_t)t * D, lane, v, r, gv);
        }
        {
            const int th = w & 1, kh = w >> 1, m = lane & 15, q = lane >> 4;
            const float* arow = H + (size_t)(tok0 + 16 * th + m) * D + 512 * kh + 128 * q;
            const float* brow = wr_ + (size_t)(512 * kh + 128 * q) * 48 + m;
            f32x4 acc[3]; acc[0] = acc[1] = acc[2] = (f32x4){0.f, 0.f, 0.f, 0.f};
            for (int i = 0; i < 32; ++i) {
                const f32x4 av = ((const f32x4*)arow)[i];
                const float ae[4] = {av.x, av.y, av.z, av.w};
#pragma unroll
                for (int e = 0; e < 4; ++e) {
                    const float* bp = brow + (size_t)(4 * i + e) * 48;
#pragma unroll
                    for (int nt = 0; nt < 3; ++nt) acc[nt] = __builtin_amdgcn_mfma_f32_16x16x4f32(ae[e], bp[nt * 16], acc[nt], 0, 0, 0);
                }
            }
#pragma unroll
            for (int nt = 0; nt < 3; ++nt)
#pragma unroll
                for (int j = 0; j < 4; ++j) lgl[(kh * 32 + th * 16 + 4 * q + j) * 48 + nt * 16 + m] = acc[nt][j];
        }
        __syncthreads();
        if (c.tid < 32) {
            const int tt = c.tid, t = tok0 + tt; const float r = rl[tt];
            const float* bg = (const float*)a.in[IN_BG] + l * 4; const float* be = (const float*)a.in[IN_BE] + l * 32;
            float gl[4];
#pragma unroll
            for (int o = 0; o < 4; ++o) gl[o] = (lgl[tt * 48 + o] + lgl[(32 + tt) * 48 + o]) * r + bg[o];
            int gs = 0; float gm = gl[0];
#pragma unroll
            for (int o = 1; o < 4; ++o) if (gl[o] > gm) { gm = gl[o]; gs = o; }
            float gden = 0.f;
#pragma unroll
            for (int o = 0; o < 4; ++o) gden += __expf(gl[o] - gm);
            const float pg = 1.f / gden;
            float l1 = -INFINITY, l2 = -INFINITY; int i1 = 0, i2 = 0;
            for (int i = 0; i < 8; ++i) {
                const int o = 4 + gs * 8 + i;
                const float v = (lgl[tt * 48 + o] + lgl[(32 + tt) * 48 + o]) * r + be[gs * 8 + i];
                if (v > l1) { l2 = l1; i2 = i1; l1 = v; i1 = i; } else if (v > l2) { l2 = v; i2 = i; }
            }
            const float e2 = __expf(l2 - l1), inv = 1.f / (1.f + e2);
            const float g1 = pg * inv, g2 = pg * e2 * inv;
            const int ea = gs * 8 + i1, eb = gs * 8 + i2;
            const int sa = atomicAdd(&cnt[ea], 1), sb = atomicAdd(&cnt[eb], 1);
            list[ea * T + sa] = t; gatel[ea * T + sa] = g1; tokslot[2 * t] = (ea << 16) | sa;
            list[eb * T + sb] = t; gatel[eb * T + sb] = g2; tokslot[2 * t + 1] = (eb << 16) | sb;
        }
    }
}

__device__ __forceinline__ void moe_table(const Ctx& c, int l, LAS int* pst, LAS int* cn) {
    __syncthreads();
    if (c.tid == 0) {
        const int* cnt = (const int*)(c.ws + WS_CNT) + l * 32; int acc = 0;
        for (int e = 0; e < 32; ++e) { const int n = cnt[e]; cn[e] = n; pst[e] = acc; acc += (n + 127) >> 7; }
        pst[32] = acc;
    }
    __syncthreads();
}
__device__ __forceinline__ int moe_find(LAS const int* pst, int mb) { int e = 0; for (int i = 1; i < 32; ++i) e = (pst[i] <= mb) ? i : e; return e; }

__device__ __forceinline__ void phase_e1(const Ctx& c, int l) {
    const unsigned char* XN8 = c.ws + WS_XN8; const unsigned char* W1 = c.ws + WS_W1; const unsigned char* W3 = c.ws + WS_W3;
    unsigned char* HM = c.ws + WS_HMID; const int* list = (const int*)(c.ws + WS_LIST);
    LAS int* pst = (LAS int*)(c.lds + LDS_MAIN); LAS int* cn = pst + 40;
    moe_table(c, l, pst, cn);
    const int fr = c.lane & 15, fq = c.lane >> 4, wr = c.wave >> 1, wc = c.wave & 1, tid = c.tid;
    const int nunits = pst[32] * 8;
    for (int u = c.vb; u < nunits; u += c.nb) {
        const int mb = u >> 3, h0 = (u & 7) * 64, e = moe_find(pst, mb), row0 = (mb - pst[e]) * 128, count = cn[e];
        const bf16_t* ap[4]; const bf16_t* bp[4];
#pragma unroll
        for (int p = 0; p < 4; ++p) {
            int r = row0 + p * 32 + (tid >> 3); r = r < count ? r : row0; ap[p] = (const bf16_t*)(XN8 + (size_t)list[e * T + r] * D);
            const int rb = p * 32 + (tid >> 3), hid = h0 + (rb >> 6) * 32 + ((rb >> 4) & 1) * 16 + (rb & 15);
            bp[p] = (const bf16_t*)((((rb >> 5) & 1) ? W3 : W1) + ((size_t)e * DE + hid) * D);
        }
        f32x4 acc[4][4]; zero_acc(acc);
        gemm_loop<64, 1, true, true>(c, ap, bp, bp, D / 2, acc, acc);
        const float ws_ = 1.f / W8_SCALE;
#pragma unroll
        for (int m = 0; m < 4; ++m)
#pragma unroll
            for (int n = 0; n < 2; ++n) {
                const size_t row = (size_t)mb * 128 + wr * 64 + m * 16 + fr; const int col = h0 + wc * 32 + n * 16 + fq * 4;
                const f32x4 x = acc[m][n] * ws_, y = acc[m][n + 2] * (ws_ * H8_SCALE);
                *(unsigned*)(HM + row * DE + col) = pk_fp8x4(x.x * sigmoidf_(x.x) * y.x, x.y * sigmoidf_(x.y) * y.y, x.z * sigmoidf_(x.z) * y.z, x.w * sigmoidf_(x.w) * y.w);
            }
    }
}
__device__ __forceinline__ void phase_e2(const Ctx& c, int l) {
    const unsigned char* HM = c.ws + WS_HMID; const unsigned char* W2 = c.ws + WS_W2;
    bf16_t* Y = (bf16_t*)(c.ws + WS_Y); const float* gatel = (const float*)(c.ws + WS_GATE);
    LAS int* pst = (LAS int*)(c.lds + LDS_MAIN); LAS int* cn = pst + 40;
    moe_table(c, l, pst, cn);
    const int fr = c.lane & 15, fq = c.lane >> 4, wr = c.wave >> 1, wc = c.wave & 1, tid = c.tid;
    const int nunits = pst[32] * 8;
    for (int u = c.vb; u < nunits; u += c.nb) {
        const int mb = u >> 3, nt = u & 7, e = moe_find(pst, mb), row0 = (mb - pst[e]) * 128, count = cn[e];
        const bf16_t* ap[4]; const bf16_t* bp[4];
        rows_regular<64>(ap, (const bf16_t*)(HM + (size_t)mb * 128 * DE), DE / 2, tid); rows_regular<64>(bp, (const bf16_t*)(W2 + ((size_t)e * D + nt * 128) * DE), DE / 2, tid);
        f32x4 acc[4][4]; zero_acc(acc);
        gemm_loop<64, 1, true, true>(c, ap, bp, bp, DE / 2, acc, acc);
        float gtv[4];
#pragma unroll
        for (int m = 0; m < 4; ++m) { const int rl_ = wr * 64 + m * 16 + fr; gtv[m] = (row0 + rl_ < count) ? gatel[e * T + row0 + rl_] * (1.f / (W8_SCALE * H8_SCALE)) : 0.f; }
#pragma unroll
        for (int m = 0; m < 4; ++m) {
            const int rl_ = wr * 64 + m * 16 + fr; const float gt = gtv[m];
#pragma unroll
            for (int n = 0; n < 4; ++n) {
                const f32x4 v = acc[m][n] * gt;
                u32x2 o; o.x = pk_bf16(v.x, v.y); o.y = pk_bf16(v.z, v.w);
                *(u32x2*)(Y + ((size_t)mb * 128 + rl_) * D + nt * 128 + wc * 64 + n * 16 + fq * 4) = o;
            }
        }
    }
}
__device__ __forceinline__ void phase_p1(const Ctx& c, int l, bool dry = false) {
    float* H = (float*)(c.ws + WS_H); float* HO = (float*)(c.ws + (dry ? 440 * MB : WS_H)); bf16_t* XN = (bf16_t*)(c.ws + (dry ? 440 * MB : WS_XN)); const bf16_t* Y = (const bf16_t*)(c.ws + WS_Y);
    const int* tokslot = (const int*)(c.ws + WS_TOKSLOT); const float* gain = (const float*)c.a->in[IN_PLEN] + l * D;
    LAS int* pst = (LAS int*)(c.lds + LDS_MAIN); LAS int* cn = pst + 40;
    moe_table(c, l, pst, cn);
    const int gw = c.vb * 4 + c.wave, ngw = c.nb * 4, lane = c.lane;
    f32x4 gv[4]; gain_load(gain, lane, gv);
    for (int t = gw; t < T; t += ngw) {
        const int s0 = tokslot[2 * t], s1 = tokslot[2 * t + 1];
        const bf16_t* y0 = Y + ((size_t)pst[s0 >> 16] * 128 + (s0 & 0xffff)) * D; const bf16_t* y1 = Y + ((size_t)pst[s1 >> 16] * 128 + (s1 & 0xffff)) * D;
        f32x4 v[4]; row_load(H + (size_t)t * D, lane, v);
#pragma unroll
        for (int j = 0; j < 4; ++j) {
            const u32x2 a0 = ((const u32x2*)y0)[lane + 64 * j], a1 = ((const u32x2*)y1)[lane + 64 * j];
            v[j].x += bf_lo(a0.x) + bf_lo(a1.x); v[j].y += bf_hi(a0.x) + bf_hi(a1.x); v[j].z += bf_lo(a0.y) + bf_lo(a1.y); v[j].w += bf_hi(a0.y) + bf_hi(a1.y);
            ((f32x4*)(HO + (size_t)t * D))[lane + 64 * j] = v[j];
        }
        const float r = rsqrtf(row_sumsq(v) * (1.f / D) + EPS);
        row_store_norm_fp8(c.ws + (dry ? 440 * MB : WS_XN8) + (size_t)t * D, lane, v, r, gv);
    }
}
__device__ __forceinline__ void phase_p2(const Ctx& c, int l) {
    const bf16_t* XN = (const bf16_t*)(c.ws + WS_XN); const bf16_t* WG = (const bf16_t*)(c.ws + WS_WGATE) + (size_t)l * D * D;
    const bf16_t* PB = (const bf16_t*)(c.ws + WS_PBF) + (size_t)l * T * PLE; const bf16_t* WP = (const bf16_t*)(c.ws + WS_WPROJ) + (size_t)l * D * PLE;
    float* H = (float*)(c.ws + WS_H);
    const int fr = c.lane & 15, fq = c.lane >> 4, wr = c.wave >> 1, wc = c.wave & 1;
    for (int u = c.vb; u < 128 * 8; u += c.nb) {
        int mt, nt; map_unit(u, 8, mt, nt);
        const bf16_t* ap[4]; const bf16_t* bp[4];
        f32x4 ag[4][4], apj[4][4]; zero_acc(ag); zero_acc(apj);
        rows_regular<64>(ap, (const bf16_t*)(c.ws + WS_XN8 + (size_t)mt * 128 * D), D / 2, c.tid); rows_regular<64>(bp, (const bf16_t*)(c.ws + WS_WGATE + ((size_t)l * D + nt * 128) * D), D / 2, c.tid);
        gemm_loop<64, 1, true, true>(c, ap, bp, bp, D / 2, ag, ag);
        rows_regular<64>(ap, PB + (size_t)mt * 128 * PLE, PLE, c.tid); rows_regular<64>(bp, WP + (size_t)nt * 128 * PLE, PLE, c.tid);
        gemm_loop<64, 1, true>(c, ap, bp, bp, PLE, apj, apj);
        f32x4 hres[4][4];
#pragma unroll
        for (int m = 0; m < 4; ++m)
#pragma unroll
            for (int n = 0; n < 4; ++n) hres[m][n] = *(const f32x4*)(H + (size_t)(mt * 128 + wr * 64 + m * 16 + fr) * D + nt * 128 + wc * 64 + n * 16 + fq * 4);
#pragma unroll
        for (int m = 0; m < 4; ++m)
#pragma unroll
            for (int n = 0; n < 4; ++n) {
                const size_t off = (size_t)(mt * 128 + wr * 64 + m * 16 + fr) * D + nt * 128 + wc * 64 + n * 16 + fq * 4;
                const f32x4 g = ag[m][n] * (1.f / W8_SCALE), pj = apj[m][n]; f32x4 h = hres[m][n];
                h.x += sigmoidf_(g.x) * pj.x; h.y += sigmoidf_(g.y) * pj.y; h.z += sigmoidf_(g.z) * pj.z; h.w += sigmoidf_(g.w) * pj.w;
                *(f32x4*)(H + off) = h;
            }
    }
}
__device__ __forceinline__ void phase_norm_bf16(const Ctx& c, const float* gain) {
    const float* H = (const float*)(c.ws + WS_H);
    const int gw = c.vb * 4 + c.wave, ngw = c.nb * 4;
    f32x4 gv[4]; gain_load(gain, c.lane, gv);
    for (int t = gw; t < T; t += ngw) {
        f32x4 v[4]; row_load(H + (size_t)t * D, c.lane, v);
        const float r = rsqrtf(row_sumsq(v) * (1.f / D) + EPS);
        row_store_norm_fp8(c.ws + WS_XN8 + (size_t)t * D, c.lane, v, r, gv);
        row_store_norm_bf16((bf16_t*)(c.ws + WS_XN) + (size_t)t * D, c.lane, v, r, gv);
    }
}
__device__ __forceinline__ void phase_final(const Ctx& c) {
    const float* H = (const float*)(c.ws + WS_H); float* O = c.a->out; const float* gain = (const float*)c.a->in[IN_FINN];
    const int gw = c.vb * 4 + c.wave, ngw = c.nb * 4;
    f32x4 gv[4]; gain_load(gain, c.lane, gv);
    for (int t = gw; t < T; t += ngw) {
        f32x4 v[4]; row_load(H + (size_t)t * D, c.lane, v);
        const float r = rsqrtf(row_sumsq(v) * (1.f / D) + EPS);
#pragma unroll
        for (int j = 0; j < 4; ++j) ((f32x4*)(O + (size_t)t * D))[c.lane + 64 * j] = v[j] * r * gv[j];
    }
}

__device__ __forceinline__ void phase_b1(const Ctx& c, size_t raw_off = WS_RAW) {
    const bf16_t* XN = (const bf16_t*)(c.ws + WS_XN); const bf16_t* W = (const bf16_t*)(c.ws + WS_WBIN); bf16_t* RAW = (bf16_t*)(c.ws + raw_off);
    const int fr = c.lane & 15, fq = c.lane >> 4, wr = c.wave >> 1, wc = c.wave & 1;
    for (int u = c.vb; u < 128 * 17; u += c.nb) {
        int mt, nt; map_unit(u, 17, mt, nt);
        const bf16_t* ap[4]; const bf16_t* bp[4];
        f32x4 acc[4][4]; zero_acc(acc);
        float osc = 1.f;
        if (nt < 12) {
            rows_regular<64>(ap, (const bf16_t*)(c.ws + WS_XN8 + (size_t)mt * 128 * D), D / 2, c.tid); rows_regular<64>(bp, (const bf16_t*)(c.ws + WS_WBIN + (size_t)nt * 128 * D), D / 2, c.tid);
            gemm_loop<64, 1, true, true>(c, ap, bp, bp, D / 2, acc, acc);
            osc = 1.f / W8_SCALE;
        } else {
            rows_regular<64>(ap, XN + (size_t)mt * 128 * D, D, c.tid); rows_regular<64>(bp, (const bf16_t*)(c.ws + WS_WBIN + 3 * MB) + (size_t)(nt - 12) * 128 * D, D, c.tid);
            gemm_loop<64, 1, true>(c, ap, bp, bp, D, acc, acc);
        }
#pragma unroll
        for (int m = 0; m < 4; ++m)
#pragma unroll
            for (int n = 0; n < 4; ++n) {
                const f32x4 v = acc[m][n] * osc; u32x2 o; o.x = pk_bf16(v.x, v.y); o.y = pk_bf16(v.z, v.w);
                *(u32x2*)(RAW + (size_t)(mt * 128 + wr * 64 + m * 16 + fr) * BINP + nt * 128 + wc * 64 + n * 16 + fq * 4) = o;
            }
    }
}

__device__ __forceinline__ void unpack8(const u32x4 r, float (&e)[8]) { e[0] = bf_lo(r.x); e[1] = bf_hi(r.x); e[2] = bf_lo(r.y); e[3] = bf_hi(r.y); e[4] = bf_lo(r.z); e[5] = bf_hi(r.z); e[6] = bf_lo(r.w); e[7] = bf_hi(r.w); }
__device__ __forceinline__ u32x4 pack8(const float (&e)[8]) { u32x4 o; o.x = pk_bf16(e[0], e[1]); o.y = pk_bf16(e[2], e[3]); o.z = pk_bf16(e[4], e[5]); o.w = pk_bf16(e[6], e[7]); return o; }
__device__ __forceinline__ void phase_rope(const Ctx& c) {
    const bf16_t* RAW = (const bf16_t*)(c.ws + WS_RAW);
    bf16_t* Q = (bf16_t*)(c.ws + WS_Q); bf16_t* K = (bf16_t*)(c.ws + WS_K); bf16_t* V = (bf16_t*)(c.ws + WS_V);
    bf16_t* QI = (bf16_t*)(c.ws + WS_QI); bf16_t* KI = (bf16_t*)(c.ws + WS_KI); float* WI = (float*)(c.ws + WS_WI);
    const int* pos = (const int*)c.a->in[IN_POS];
    LAS float* cs = (LAS float*)(c.lds + c.wave * 256);
    const int gw = c.vb * 4 + c.wave, ngw = c.nb * 4, lane = c.lane;
    for (int t = gw; t < T; t += ngw) {
        if (lane < 24) {
            const double ex = (lane < 16) ? (double)lane * (1.0 / 16.0) : (double)(lane - 16) * (1.0 / 8.0);
            const float invf = (float)exp2(-ex * 18.931568569324174);
            const float ang = (float)pos[t] * invf;
            const double ad = (double)ang; const double n = rint(ad * 0.15915494309189535); const float red = (float)(ad - n * 6.283185307179586);
            cs[lane] = cosf(red); cs[32 + lane] = sinf(red);
        }
        LDS_WAIT();
        const bf16_t* row = RAW + (size_t)t * BINP;
        for (int ch = lane; ch < BINP / 8; ch += 64) {
            const u32x4 own = ((const u32x4*)row)[ch];
            float e[8]; unpack8(own, e);
            if (ch < 160) {
                const int cc = ch & 15;
                if (cc < 4) {
                    const u32x4 oth = ((const u32x4*)row)[ch ^ 2]; float p[8]; unpack8(oth, p);
                    const int f0 = (cc & 1) * 8;
#pragma unroll
                    for (int i = 0; i < 8; ++i) { const float co = cs[f0 + i], si = cs[32 + f0 + i]; e[i] = (cc < 2) ? (e[i] * co - p[i] * si) : (e[i] * co + p[i] * si); }
                }
                u32x2 o8; o8.x = pk_fp8x4(e[0], e[1], e[2], e[3]); o8.y = pk_fp8x4(e[4], e[5], e[6], e[7]);
                if (ch < 128) ((u32x2*)((unsigned char*)Q + (size_t)t * D))[ch] = o8;
                else ((u32x2*)((unsigned char*)K + (size_t)t * 256))[ch - 128] = o8;
            } else if (ch < 192) {
                u32x2 o8; o8.x = pk_fp8x4(e[0], e[1], e[2], e[3]); o8.y = pk_fp8x4(e[4], e[5], e[6], e[7]);
                ((u32x2*)((unsigned char*)V + (size_t)t * 256))[ch - 160] = o8;
            } else if (ch < 264) {
                const int cc = ch & 7;
                if (cc < 2) {
                    const u32x4 oth = ((const u32x4*)row)[ch ^ 1]; float p[8]; unpack8(oth, p);
#pragma unroll
                    for (int i = 0; i < 8; ++i) { const float co = cs[16 + i], si = cs[32 + 16 + i]; e[i] = (cc == 0) ? (e[i] * co - p[i] * si) : (e[i] * co + p[i] * si); }
                }
                if (ch < 256) ((u32x4*)(QI + (size_t)t * 512))[ch - 192] = pack8(e);
                else ((u32x4*)(KI + (size_t)t * 64))[ch - 256] = pack8(e);
            } else if (ch == 264) {
                f32x4 w0 = {e[0], e[1], e[2], e[3]}, w1 = {e[4], e[5], e[6], e[7]};
                const float sc = 0.044194173824159216f;
                ((f32x4*)(WI + (size_t)t * 8))[0] = w0 * sc; ((f32x4*)(WI + (size_t)t * 8))[1] = w1 * sc;
            }
        }
        LDS_WAIT();
    }
}

__device__ __forceinline__ size_t srow_off(int t) { const int m = t >> 6, r = t & 63; return (size_t)64 * (m + 1) * (32 * m + r); }
constexpr size_t S_BATCH = (size_t)64 * 65 * 2048;
constexpr int SCORE_UNITS = 4 * 312;
__device__ __forceinline__ void phase_score(const Ctx& c) {
    const bf16_t* QI = (const bf16_t*)(c.ws + WS_QI); const bf16_t* KI = (const bf16_t*)(c.ws + WS_KI); const float* WI = (const float*)(c.ws + WS_WI);
    float* S = (float*)(c.ws + WS_S);
    const int lane = c.lane, hf = lane >> 5, col = lane & 31, w = c.wave;
    for (int u = c.vb; u < SCORE_UNITS; u += c.nb) {
        const int b = u & 3, r = u >> 2;
        int kc, qb;
        if (r < 120) { kc = 0; qb = 8 + r; } else if (r < 216) { kc = 1; qb = 32 + (r - 120); } else if (r < 280) { kc = 2; qb = 64 + (r - 216); } else { kc = 3; qb = 96 + (r - 280); }
        const int tb = b * SEQ, t0 = 32 * qb + 8 * w;
        bf16x8 af[2][4]; f32x4 wv[2][4];
        { const int rho = lane & 31, ql = 2 * ((rho >> 2) & 1) + (rho >> 4), hd = 4 * ((rho >> 3) & 1) + (rho & 3);
#pragma unroll
          for (int a = 0; a < 2; ++a) {
              const bf16_t* qp = QI + (size_t)(tb + t0 + 4 * a + ql) * 512 + hd * 64 + 8 * hf;
#pragma unroll
              for (int ks = 0; ks < 4; ++ks) af[a][ks] = *(const bf16x8*)(qp + 16 * ks);
              const float* wp = WI + (size_t)(tb + t0 + 4 * a + 2 * hf) * 8;
#pragma unroll
              for (int i = 0; i < 4; ++i) wv[a][i] = ((const f32x4*)wp)[i];
          } }
        const int ntile = min(32, qb + 1 - 32 * kc), key0 = 1024 * kc;
        float* Sb = S + (size_t)b * S_BATCH;
        size_t ro[2][2];
#pragma unroll
        for (int a = 0; a < 2; ++a) { ro[a][0] = srow_off(t0 + 4 * a + 2 * hf); ro[a][1] = srow_off(t0 + 4 * a + 2 * hf + 1); }
        const int nsub = (ntile + 3) >> 2;
        const bf16_t* krp[4];
        rows_regular<64>(krp, KI + (size_t)(tb + key0) * 64, 64, c.tid);
        __syncthreads();
        stage_tile<64>(c.lds, krp, 0, c.tid);
        for (int sc = 0; sc < nsub; ++sc) {
            VM_WAIT();
            __syncthreads();
            const LAS unsigned char* cur = c.lds + (sc & 1) * 16384;
            if (sc + 1 < nsub) stage_tile<64>(c.lds + ((sc + 1) & 1) * 16384, krp, (sc + 1) * 128 * 64, c.tid);
#pragma unroll
            for (int j = 0; j < 4; ++j) {
                const int kt = 4 * sc + j;
                if (kt < ntile) {
                    const int key = key0 + 32 * kt + col, row = 32 * j + col;
                    bf16x8 cb[4];
#pragma unroll
                    for (int ks = 0; ks < 4; ++ks) cb[ks] = *(const LAS bf16x8*)(cur + row * 128 + (((2 * ks + hf) ^ (row & 7)) << 4));
#pragma unroll
                    for (int a = 0; a < 2; ++a) {
                        f32x16 acc = {};
#pragma unroll
                        for (int ks = 0; ks < 4; ++ks) acc = __builtin_amdgcn_mfma_f32_32x32x16_bf16(af[a][ks], cb[ks], acc, 0, 0, 0);
                        float s0 = fmaxf(acc[0], 0.f) * wv[a][0].x; s0 += fmaxf(acc[1], 0.f) * wv[a][0].y; s0 += fmaxf(acc[2], 0.f) * wv[a][0].z; s0 += fmaxf(acc[3], 0.f) * wv[a][0].w;
                        s0 += fmaxf(acc[4], 0.f) * wv[a][1].x; s0 += fmaxf(acc[5], 0.f) * wv[a][1].y; s0 += fmaxf(acc[6], 0.f) * wv[a][1].z; s0 += fmaxf(acc[7], 0.f) * wv[a][1].w;
                        float s1 = fmaxf(acc[8], 0.f) * wv[a][2].x; s1 += fmaxf(acc[9], 0.f) * wv[a][2].y; s1 += fmaxf(acc[10], 0.f) * wv[a][2].z; s1 += fmaxf(acc[11], 0.f) * wv[a][2].w;
                        s1 += fmaxf(acc[12], 0.f) * wv[a][3].x; s1 += fmaxf(acc[13], 0.f) * wv[a][3].y; s1 += fmaxf(acc[14], 0.f) * wv[a][3].z; s1 += fmaxf(acc[15], 0.f) * wv[a][3].w;
                        const int tA = t0 + 4 * a + 2 * hf;
                        Sb[ro[a][0] + key] = (key <= tA) ? s0 : -INFINITY;
                        Sb[ro[a][1] + key] = (key <= tA + 1) ? s1 : -INFINITY;
                    }
                }
            }
        }
    }
}

constexpr int NBINS = 2048, CAND_CAP = 256, SEL_WAVE_LDS = 8192 + 2048 + 64;
__device__ __forceinline__ void phase_select(const Ctx& c) {
    const float* S = (const float*)(c.ws + WS_S); int* SEL = (int*)(c.ws + WS_SEL);
    LAS int* hist = (LAS int*)(c.lds + c.wave * SEL_WAVE_LDS);
    LAS float* candv = (LAS float*)(hist + NBINS);
    LAS int* candi = (LAS int*)(candv + CAND_CAP);
    LAS int* thr = candi + CAND_CAP;
    const int gw = c.vb * 4 + c.wave, ngw = c.nb * 4;
    for (int j = gw; j < 4 * 3840; j += ngw) {
        int lane = c.lane;
        asm volatile("" : "+v"(lane));
        const int b = j & 3, t = 4095 - (j >> 2), ni = (t + 64) >> 6;
        const float* row = S + (size_t)b * S_BATCH + srow_off(t);
        float s[64];
#pragma unroll
        for (int g4 = 0; g4 < 4; ++g4) {
            if (16 * g4 < ni) {
#pragma unroll
                for (int i = 16 * g4; i < 16 * g4 + 16; ++i) { const int k = 64 * i + lane; const float v = row[min(k, t)]; s[i] = (k <= t) ? v : -INFINITY; }
            } else {
#pragma unroll
                for (int i = 16 * g4; i < 16 * g4 + 16; ++i) s[i] = -INFINITY;
            }
        }
        asm volatile("" : "+v"(lane));
        float mn = INFINITY, mx = -INFINITY;
#pragma unroll
        for (int i = 0; i < 64; ++i) { mx = fmaxf(mx, s[i]); mn = fminf(mn, (s[i] == -INFINITY) ? INFINITY : s[i]); }
#pragma unroll
        for (int o = 1; o < 64; o <<= 1) { mx = fmaxf(mx, __shfl_xor(mx, o)); mn = fminf(mn, __shfl_xor(mn, o)); }
        const float sc = (mx > mn) ? (float)NBINS / (mx - mn) : 0.f;
#pragma unroll
        for (int i = 0; i < 8; ++i) ((LAS u32x4*)hist)[lane * 8 + i] = (u32x4){0u, 0u, 0u, 0u};
        LDS_WAIT();
#define BINOF(v) min(NBINS - 1, (int)(((v) - mn) * sc))
#pragma unroll
        for (int i = 0; i < 64; ++i) if ((i & ~7) < ni && s[i] != -INFINITY) lds_inc(&hist[BINOF(s[i])]);
        LDS_WAIT();
        int bs, need;
        {
            const LAS int* hq = hist + lane * 32;
            int loc = 0;
#pragma unroll
            for (int i = 0; i < 8; ++i) { const u32x4 h4 = ((const LAS u32x4*)hq)[i]; loc += (int)(h4.x + h4.y + h4.z + h4.w); }
            int suf = loc;
#pragma unroll
            for (int o = 1; o < 64; o <<= 1) { const int v = __shfl_down(suf, o); if (lane + o < 64) suf += v; }
            const int above = suf - loc;
            const bool cross = (above < 256 && suf >= 256);
            int bsl = 0, abl = 0;
            if (cross) { int run = above; for (int i = 31; i >= 0; --i) { const int h = hq[i]; if (run < 256 && run + h >= 256) { bsl = lane * 32 + i; abl = run; } run += h; } }
            const unsigned long long cm = __ballot(cross);
            const int src = cm ? (int)__builtin_ctzll(cm) : 0;
            bs = __shfl(bsl, src); need = 256 - __shfl(abl, src);
        }
        int bs2 = -1;
        if (__shfl(hist[bs], 0) > 32) {
#pragma unroll
            for (int i = 0; i < 8; ++i) ((LAS u32x4*)hist)[lane * 8 + i] = (u32x4){0u, 0u, 0u, 0u};
            LDS_WAIT();
#define SUBOF(v) min(NBINS - 1, (int)((((v) - mn) * sc - (float)bs) * (float)NBINS))
#pragma unroll
            for (int i = 0; i < 64; ++i) if ((i & ~7) < ni && s[i] != -INFINITY && BINOF(s[i]) == bs) lds_inc(&hist[SUBOF(s[i])]);
            LDS_WAIT();
            const LAS int* hq = hist + lane * 32;
            int loc = 0;
#pragma unroll
            for (int i = 0; i < 8; ++i) { const u32x4 h4 = ((const LAS u32x4*)hq)[i]; loc += (int)(h4.x + h4.y + h4.z + h4.w); }
            int suf = loc;
#pragma unroll
            for (int o = 1; o < 64; o <<= 1) { const int v = __shfl_down(suf, o); if (lane + o < 64) suf += v; }
            const int above = suf - loc;
            const bool cross = (above < need && suf >= need);
            int bsl = 0, abl = 0;
            if (cross) { int run = above; for (int i = 31; i >= 0; --i) { const int h = hq[i]; if (run < need && run + h >= need) { bsl = lane * 32 + i; abl = run; } run += h; } }
            const unsigned long long cm = __ballot(cross);
            const int src = cm ? (int)__builtin_ctzll(cm) : 0;
            bs2 = __shfl(bsl, src); need = need - __shfl(abl, src);
        }
        asm volatile("" : "+v"(lane));
        int nc = 0;
#pragma unroll
        for (int i = 0; i < 64; ++i) if ((i & ~7) < ni) {
            bool p = (s[i] != -INFINITY) && (BINOF(s[i]) == bs);
            if (bs2 >= 0) p = p && (SUBOF(s[i]) == bs2);
            const unsigned long long m = __ballot(p);
            const int pos = nc + (int)__builtin_amdgcn_mbcnt_hi((unsigned)(m >> 32), __builtin_amdgcn_mbcnt_lo((unsigned)m, 0u));
            if (p && pos < CAND_CAP) { candv[pos] = s[i]; candi[pos] = 64 * i + lane; }
            nc += (int)__popcll(m);
        }
        nc = min(nc, CAND_CAP);
        LDS_WAIT();
        for (int i = lane; i < nc; i += 64) {
            const float v = candv[i]; const int id = candi[i];
            int rank = 0;
            for (int k = 0; k < nc; ++k) { const float vk = candv[k]; const int ik = candi[k]; rank += (vk > v || (vk == v && ik < id)) ? 1 : 0; }
            if (rank == need - 1) { thr[0] = __float_as_int(v); thr[1] = id; }
        }
        LDS_WAIT();
        const float tv = __int_as_float(thr[0]); const int ti = thr[1];
        asm volatile("" : "+v"(lane));
        int* selr = SEL + ((size_t)b * SEQ + t) * 256;
        int base = 0;
#pragma unroll
        for (int i = 0; i < 64; ++i) if ((i & ~7) < ni) {
            const int key = 64 * i + lane;
            const bool p = (s[i] > tv) || (s[i] == tv && key <= ti);
            const unsigned long long m = __ballot(p);
            const int pos = base + (int)__builtin_amdgcn_mbcnt_hi((unsigned)(m >> 32), __builtin_amdgcn_mbcnt_lo((unsigned)m, 0u));
            if (p && pos < 256) selr[pos] = key;
            base += (int)__popcll(m);
        }
        LDS_WAIT();
#undef BINOF
#undef SUBOF
    }
}

typedef short s16x4 __attribute__((ext_vector_type(4)));
__device__ __forceinline__ unsigned vimg_f(unsigned r) { return ((r & 3u) << 2) | ((r >> 2) & 3u); }
__device__ __forceinline__ void tr_read8(const unsigned (&ad)[8], s16x4 (&r)[8]) {
    asm volatile("ds_read_b64_tr_b16 %0, %8\n\tds_read_b64_tr_b16 %1, %9\n\tds_read_b64_tr_b16 %2, %10\n\tds_read_b64_tr_b16 %3, %11\n\t"
                 "ds_read_b64_tr_b16 %4, %12\n\tds_read_b64_tr_b16 %5, %13\n\tds_read_b64_tr_b16 %6, %14\n\tds_read_b64_tr_b16 %7, %15\n\ts_waitcnt lgkmcnt(0)"
                 : "=&v"(r[0]), "=&v"(r[1]), "=&v"(r[2]), "=&v"(r[3]), "=&v"(r[4]), "=&v"(r[5]), "=&v"(r[6]), "=&v"(r[7])
                 : "v"(ad[0]), "v"(ad[1]), "v"(ad[2]), "v"(ad[3]), "v"(ad[4]), "v"(ad[5]), "v"(ad[6]), "v"(ad[7]) : "memory");
}
__device__ __forceinline__ void tr_read8_b8(const unsigned (&ad)[8], s16x4 (&r)[8]) {
    asm volatile("ds_read_b64_tr_b8 %0, %8\n\tds_read_b64_tr_b8 %1, %9\n\tds_read_b64_tr_b8 %2, %10\n\tds_read_b64_tr_b8 %3, %11\n\t"
                 "ds_read_b64_tr_b8 %4, %12\n\tds_read_b64_tr_b8 %5, %13\n\tds_read_b64_tr_b8 %6, %14\n\tds_read_b64_tr_b8 %7, %15\n\ts_waitcnt lgkmcnt(0)"
                 : "=&v"(r[0]), "=&v"(r[1]), "=&v"(r[2]), "=&v"(r[3]), "=&v"(r[4]), "=&v"(r[5]), "=&v"(r[6]), "=&v"(r[7])
                 : "v"(ad[0]), "v"(ad[1]), "v"(ad[2]), "v"(ad[3]), "v"(ad[4]), "v"(ad[5]), "v"(ad[6]), "v"(ad[7]) : "memory");
}
constexpr int ATT_WAVE_LDS = 19456;
__device__ __forceinline__ void phase_attn(const Ctx& c) {
    const bf16_t* Q = (const bf16_t*)(c.ws + WS_Q); const bf16_t* K = (const bf16_t*)(c.ws + WS_K); const bf16_t* V = (const bf16_t*)(c.ws + WS_V);
    const int* SEL = (const int*)(c.ws + WS_SEL); bf16_t* O = (bf16_t*)(c.ws + WS_O);
    LAS unsigned char* wl = c.lds + c.wave * ATT_WAVE_LDS;
    LAS int* sl = (LAS int*)wl;
    LAS unsigned short* pT = (LAS unsigned short*)(wl + 1024);
    LAS unsigned char* vb = wl + 3072;
    const int lane = c.lane, fr = lane & 15, fq = lane >> 4;
    const int gw = c.vb * 4 + c.wave, ngw = c.nb * 4;
    unsigned tro[8];
    { const unsigned row = 8u * fq + ((unsigned)fr >> 1);
#pragma unroll
      for (int c2 = 0; c2 < 8; ++c2) tro[c2] = 128u * row + 16u * ((unsigned)c2 ^ (row & 7u)) + 8u * ((unsigned)fr & 1u); }
    const unsigned vb_addr = (unsigned)(size_t)vb;
    int tcount = 0, cit = gw;
    const bool xsplit = (c.nb % 128) == 0;
    const int xg = (c.vb >> 6) & 1, wi0 = xsplit ? (((c.vb >> 7) * 64 + (c.vb & 63)) * 4 + c.wave) : gw, wstride = xsplit ? ngw / 2 : ngw;
    for (int task = wi0; task < (xsplit ? T : T * 2); task += wstride) {
        const int tg = xsplit ? task : (task >> 1), g = xsplit ? xg : (task & 1), b = tg >> 12, t = tg & 4095, tb = b * SEQ;
        const int nsel = min(256, t + 1), ntile = (nsel + 15) >> 4, nch = (nsel + 31) >> 5;
#pragma unroll
        for (int i = 0; i < 4; ++i) { const int s_ = lane + 64 * i; int idx = SEL[(size_t)tg * 256 + s_]; idx = (t < 256) ? s_ : idx; idx = (s_ < nsel && (unsigned)idx <= (unsigned)t) ? idx : 0; sl[s_] = idx; }
        i64x2 qf[2];
        { const unsigned char* qp = (const unsigned char*)Q + (size_t)tg * D + (4 * g + (fr & 3)) * 128 + 16 * fq;
#pragma unroll
          for (int i = 0; i < 2; ++i) qf[i] = *(const i64x2*)(qp + 64 * i); }
        LDS_WAIT();
        const unsigned char* kbase = (const unsigned char*)K + (size_t)tb * 256 + g * 128;
#define K_GATHER(chk, bufsel) do { _Pragma("unroll") for (int i_ = 0; i_ < 4; ++i_) { const int r_ = 8 * i_ + (lane >> 3); const int key_ = sl[32 * (chk) + r_]; \
            __builtin_amdgcn_global_load_lds((const unsigned*)(kbase + (size_t)key_ * 256 + ((((unsigned)lane & 7u) ^ ((unsigned)r_ & 7u)) << 4)), \
                                             (LAS unsigned*)(vb + (bufsel) * 8192 + i_ * 1024 + lane * 16), 16, 0, 0); } } while (0)
        const unsigned char* vbase = (const unsigned char*)V + (size_t)tb * 256 + g * 128;
#define ROW_GATHER(basep, chk, bufsel) do { _Pragma("unroll") for (int i_ = 0; i_ < 8; ++i_) { const int r_ = 4 * i_ + fq; const int key_ = sl[32 * (chk) + r_]; \
            __builtin_amdgcn_global_load_lds((const unsigned*)((basep) + (size_t)key_ * 256 + (((unsigned)fr ^ vimg_f((unsigned)r_)) << 3)), \
                                             (LAS unsigned*)(vb + (bufsel) * 8192 + i_ * 1024 + lane * 16), 16, 0, 0); } } while (0)
#define V_GATHER(chk, bufsel) do { _Pragma("unroll") for (int i_ = 0; i_ < 4; ++i_) { const int r_ = 8 * i_ + (lane >> 3); const int key_ = sl[32 * (chk) + r_]; \
            __builtin_amdgcn_global_load_lds((const unsigned*)(vbase + (size_t)key_ * 256 + ((((unsigned)lane & 7u) ^ ((unsigned)r_ & 7u)) << 4)), \
                                             (LAS unsigned*)(vb + (bufsel) * 8192 + i_ * 1024 + lane * 16), 16, 0, 0); } } while (0)
        f32x4 lg[16];
        K_GATHER(0, 0);
#pragma unroll
        for (int ch = 0; ch < 8; ++ch) {
            if (ch < 7) { K_GATHER(ch + 1, (ch + 1) & 1); asm volatile("s_waitcnt vmcnt(4)" ::: "memory"); }
            else { V_GATHER(0, 0); asm volatile("s_waitcnt vmcnt(4)" ::: "memory"); }
            const LAS unsigned char* kb = vb + (ch & 1) * 8192;
#pragma unroll
            for (int rb = 0; rb < 2; ++rb) {
                const int kt = 2 * ch + rb; const unsigned row = 16u * rb + fr;
                f32x4 acc = {0.f, 0.f, 0.f, 0.f};
#pragma unroll
                for (int i = 0; i < 2; ++i) { const i64x2 kf = *(const LAS i64x2*)(kb + 128u * row + 16u * ((4u * i + fq) ^ (row & 7u)));
                    acc = __builtin_amdgcn_mfma_f32_16x16x32_fp8_fp8(qf[i].x, kf.x, acc, 0, 0, 0); acc = __builtin_amdgcn_mfma_f32_16x16x32_fp8_fp8(qf[i].y, kf.y, acc, 0, 0, 0); }
                acc = acc * 0.08838834764831845f;
                const bool ok = (kt * 16 + fr < nsel);
                lg[kt].x = ok ? acc.x : -INFINITY; lg[kt].y = ok ? acc.y : -INFINITY; lg[kt].z = ok ? acc.z : -INFINITY; lg[kt].w = ok ? acc.w : -INFINITY;
            }
            asm volatile("" ::: "memory");
        }
        f32x4 mx = lg[0];
#pragma unroll
        for (int kt = 1; kt < 16; ++kt) { mx.x = fmaxf(mx.x, lg[kt].x); mx.y = fmaxf(mx.y, lg[kt].y); mx.z = fmaxf(mx.z, lg[kt].z); mx.w = fmaxf(mx.w, lg[kt].w); }
#pragma unroll
        for (int o = 1; o < 16; o <<= 1) { mx.x = fmaxf(mx.x, __shfl_xor(mx.x, o)); mx.y = fmaxf(mx.y, __shfl_xor(mx.y, o)); mx.z = fmaxf(mx.z, __shfl_xor(mx.z, o)); mx.w = fmaxf(mx.w, __shfl_xor(mx.w, o)); }
        f32x4 sm = {0.f, 0.f, 0.f, 0.f};
#pragma unroll
        for (int kt = 0; kt < 16; ++kt) { f32x4 p; p.x = __expf(lg[kt].x - mx.x); p.y = __expf(lg[kt].y - mx.y); p.z = __expf(lg[kt].z - mx.z); p.w = __expf(lg[kt].w - mx.w); lg[kt] = p; sm += p; }
#pragma unroll
        for (int o = 1; o < 16; o <<= 1) { sm.x += __shfl_xor(sm.x, o); sm.y += __shfl_xor(sm.y, o); sm.z += __shfl_xor(sm.z, o); sm.w += __shfl_xor(sm.w, o); }
        { const float inv = 1.f / (fq == 0 ? sm.x : fq == 1 ? sm.y : fq == 2 ? sm.z : sm.w);
#pragma unroll
          for (int kt = 0; kt < 16; ++kt) { const float pv = (fq == 0 ? lg[kt].x : fq == 1 ? lg[kt].y : fq == 2 ? lg[kt].z : lg[kt].w) * (inv * 256.f); ((LAS unsigned char*)pT)[fq * 256 + kt * 16 + fr] = (unsigned char)(pk_fp8x4(pv, pv, pv, pv) & 0xffu); } }
        LDS_WAIT();
        f32x4 oacc[8];
#pragma unroll
        for (int c2 = 0; c2 < 8; ++c2) oacc[c2] = (f32x4){0.f, 0.f, 0.f, 0.f};
        for (int ch = 0; ch < nch; ++ch) {
            if (ch + 1 < nch) { V_GATHER(ch + 1, (ch + 1) & 1); asm volatile("s_waitcnt vmcnt(4)" ::: "memory"); }
            else asm volatile("s_waitcnt vmcnt(0)" ::: "memory");
            const long pa = *(const LAS long*)((const LAS unsigned char*)pT + (fr & 3) * 256 + 32 * ch + 8 * fq);
            const unsigned cb = vb_addr + (unsigned)(ch & 1) * 8192u;
            unsigned ad[8]; s16x4 r0[8];
#pragma unroll
            for (int i = 0; i < 8; ++i) ad[i] = cb + tro[i];
            tr_read8_b8(ad, r0);
#pragma unroll
            for (int c2 = 0; c2 < 8; ++c2) oacc[c2] = __builtin_amdgcn_mfma_f32_16x16x32_fp8_fp8(pa, __builtin_bit_cast(long, r0[c2]), oacc[c2], 0, 0, 0);
        }
        { unsigned char* op = (unsigned char*)O + (size_t)tg * D + (4 * g + fq) * 128 + fr;
#pragma unroll
          for (int c2 = 0; c2 < 8; ++c2) { const float ov = (fq == 0 ? oacc[c2].x : fq == 1 ? oacc[c2].y : fq == 2 ? oacc[c2].z : oacc[c2].w) * (O8_SCALE / 256.f); op[16 * c2] = (unsigned char)(pk_fp8x4(ov, ov, ov, ov) & 0xffu); } }
        LDS_WAIT();
        if ((tcount & 1) && cit < NE * 192) { convert_moe_item(c, 1, cit, vb); cit += ngw; }
        ++tcount;
    }
    for (; cit < NE * 192; cit += ngw) convert_moe_item(c, 1, cit, vb);
#undef V_GATHER
#undef ROW_GATHER
#undef K_GATHER
}

__device__ __forceinline__ void phase_b4(const Ctx& c) {
    const bf16_t* OB = (const bf16_t*)(c.ws + WS_O); const bf16_t* W = (const bf16_t*)(c.ws + WS_WBOUT); float* H = (float*)(c.ws + WS_H);
    const int fr = c.lane & 15, fq = c.lane >> 4, wr = c.wave >> 1, wc = c.wave & 1;
    for (int u = c.vb; u < 128 * 8; u += c.nb) {
        int mt, nt; map_unit(u, 8, mt, nt);
        const bf16_t* ap[4]; const bf16_t* bp[4];
        rows_regular<64>(ap, (const bf16_t*)(c.ws + WS_O + (size_t)mt * 128 * D), D / 2, c.tid); rows_regular<64>(bp, (const bf16_t*)(c.ws + WS_WBOUT + (size_t)nt * 128 * D), D / 2, c.tid);
        f32x4 acc[4][4];
#pragma unroll
        for (int m = 0; m < 4; ++m)
#pragma unroll
            for (int n = 0; n < 4; ++n) acc[m][n] = *(const f32x4*)(H + (size_t)(mt * 128 + wr * 64 + m * 16 + fr) * D + nt * 128 + wc * 64 + n * 16 + fq * 4) * (W8_SCALE * O8_SCALE);
        gemm_loop<64, 1, true, true>(c, ap, bp, bp, D / 2, acc, acc);
#pragma unroll
        for (int m = 0; m < 4; ++m)
#pragma unroll
            for (int n = 0; n < 4; ++n) *(f32x4*)(H + (size_t)(mt * 128 + wr * 64 + m * 16 + fr) * D + nt * 128 + wc * 64 + n * 16 + fq * 4) = acc[m][n] * (1.f / (W8_SCALE * O8_SCALE));
    }
}

constexpr int NPHASE = 22;
__global__ void __launch_bounds__(NTH, 2) mk_fwd(Args args) {
    extern __shared__ __attribute__((aligned(16))) unsigned char lds_raw[];
    Ctx c;
    c.lds = (LAS unsigned char*)lds_raw; c.tid = threadIdx.x; c.lane = c.tid & 63; c.wave = __builtin_amdgcn_readfirstlane(c.tid >> 6);
    c.nb = gridDim.x; { const int bx = blockIdx.x; c.vb = (c.nb % 8 == 0) ? (bx % 8) * (c.nb / 8) + bx / 8 : bx; }
    c.a = (const __attribute__((address_space(4))) Args*)__builtin_amdgcn_kernarg_segment_ptr(); c.ws = args.ws;
    volatile LAS unsigned* st = (volatile LAS unsigned*)(c.lds + LDS_MAIN + 1008);
    const bool multi = (args.ph_hi - args.ph_lo) > 1;
    XcdBarrier bar; bar.bar = (unsigned*)(c.ws + WS_CTL); bar.x = 0; bar.st = st;
    if (multi) {
        if (c.tid == 0) { st[0] = 0u; st[1] = 0u; }
        __syncthreads();
        bar = xcd_barrier_post((unsigned*)(c.ws + WS_CTL), st);
    }
    const int ph_lo = args.ph_lo, ph_hi = args.ph_hi;
#ifndef PH_MASK
#define PH_MASK 0x3fffff
#endif
#define PHON(k) ((PH_MASK >> (k)) & 1)
#define PHASE(k, body) do { if (PHON(k) && ph_lo <= (k) && (k) < ph_hi) { \
        { int t_ = threadIdx.x, vb_ = __builtin_amdgcn_readfirstlane(c.vb); \
          const __attribute__((address_space(4))) Args* ka = (const __attribute__((address_space(4))) Args*)__builtin_amdgcn_kernarg_segment_ptr(); \
          asm volatile("" : "+v"(t_), "+s"(vb_), "+s"(ka)); \
          c.tid = t_; c.lane = t_ & 63; c.wave = __builtin_amdgcn_readfirstlane(t_ >> 6); c.vb = vb_; c.a = ka; c.ws = ka->ws; } \
        body; \
        if (MK_REP == (k)) { __syncthreads(); body; } \
        if ((k) + 1 < ph_hi) xcd_barrier(bar); \
        if ((k) == 3) { for (int xb_ = 0; xb_ < MK_XBAR; ++xb_) xcd_barrier(bar); } } } while (0)
    PHASE(0, phase_prep(c));
    PHASE(1, phase_a1(c));
    PHASE(2, { if (MK_DRY == 2) { phase_a2(c, true); __syncthreads(); } phase_a2(c); });
    PHASE(3, phase_a3(c));
    PHASE(4, { if (MK_DRY == 4) { phase_route(c, 0, true); __syncthreads(); } phase_route(c, 0); });
    PHASE(5, phase_e1(c, 0));
    PHASE(6, phase_e2(c, 0));
    PHASE(7, { if (MK_DRY == 7) { phase_p1(c, 0, true); __syncthreads(); } phase_p1(c, 0); });
    PHASE(8, phase_p2(c, 0));
    PHASE(9, phase_norm_bf16(c, (const float*)c.a->in[IN_MIXN] + D));
    PHASE(10, phase_b1(c));
    PHASE(11, phase_rope(c));
    PHASE(12, phase_score(c));
    PHASE(13, phase_select(c));
    PHASE(14, phase_attn(c));
    PHASE(15, phase_b4(c));
    PHASE(16, phase_route(c, 1));
    PHASE(17, phase_e1(c, 1));
    PHASE(18, phase_e2(c, 1));
    PHASE(19, phase_p1(c, 1));
    PHASE(20, phase_p2(c, 1));
    PHASE(21, phase_final(c));
}

#ifdef MK_DUMP
__global__ void dump_k(const unsigned char* ws, float* out) {
    const size_t i = (size_t)blockIdx.x * 256 + threadIdx.x;
#if MK_DUMP == 1
    ((f32x4*)out)[i] = ((const f32x4*)(ws + WS_H))[i];
#elif MK_DUMP == 2
    { const u32x2 v = ((const u32x2*)(ws + WS_O))[i]; f32x4 o = {bf_lo(v.x), bf_hi(v.x), bf_lo(v.y), bf_hi(v.y)}; ((f32x4*)out)[i] = o; }
#elif MK_DUMP == 3
    { const int* sp = (const int*)(ws + WS_SEL); f32x4 o = {0.f,0.f,0.f,0.f}; if (i < (size_t)T * 64) { o.x = (float)sp[4*i]; o.y = (float)sp[4*i+1]; o.z = (float)sp[4*i+2]; o.w = (float)sp[4*i+3]; } ((f32x4*)out)[i] = o; }
#elif MK_DUMP == 5
    { const u32x2 v = ((const u32x2*)(ws + WS_XN))[i]; f32x4 o = {bf_lo(v.x), bf_hi(v.x), bf_lo(v.y), bf_hi(v.y)}; ((f32x4*)out)[i] = o; }
#elif MK_DUMP == 6
    { const u32x2 v = ((const u32x2*)(ws + WS_RAW))[i]; f32x4 o = {bf_lo(v.x), bf_hi(v.x), bf_lo(v.y), bf_hi(v.y)}; ((f32x4*)out)[i] = o; }
#elif MK_DUMP == 7
    { f32x4 o = {0.f,0.f,0.f,0.f}; if (i < (size_t)BINP * D / 4) { const u32x2 v = ((const u32x2*)(ws + WS_WBIN))[i]; o = (f32x4){bf_lo(v.x), bf_hi(v.x), bf_lo(v.y), bf_hi(v.y)}; } ((f32x4*)out)[i] = o; }
#elif MK_DUMP == 8
    { const u32x2 v = ((const u32x2*)(ws + WS_RAW))[i], w = ((const u32x2*)(ws + 458 * MB))[i]; f32x4 o = {bf_lo(v.x) - bf_lo(w.x), bf_hi(v.x) - bf_hi(w.x), bf_lo(v.y) - bf_lo(w.y), bf_hi(v.y) - bf_hi(w.y)}; ((f32x4*)out)[i] = o; }
#elif MK_DUMP == 9
    { const u32x2 v = ((const u32x2*)(ws + WS_RAW))[i], w = ((const u32x2*)(ws + 458 * MB))[i]; f32x4 o = {(v.x & 0xffffu) != (w.x & 0xffffu) ? 1.f : 0.f, (v.x >> 16) != (w.x >> 16) ? 1.f : 0.f, (v.y & 0xffffu) != (w.y & 0xffffu) ? 1.f : 0.f, (v.y >> 16) != (w.y >> 16) ? 1.f : 0.f}; ((f32x4*)out)[i] = o; }
#elif MK_DUMP == 4
    { const u32x2 v = ((const u32x2*)(ws + WS_Q))[i]; f32x4 o = {bf_lo(v.x), bf_hi(v.x), bf_lo(v.y), bf_hi(v.y)}; ((f32x4*)out)[i] = o; }
#endif
}
#endif
extern "C" void kernel_launch(void* const* d_in, const int* in_sizes, int n_in, void* d_out, int out_size, void* d_ws, size_t ws_size, hipStream_t stream) {
    static int grid = 0;
    if (grid == 0) {
        if (n_in != 23 || out_size != T * D || ws_size < WS_TOTAL) { fprintf(stderr, "kernel_launch: unexpected sizes n_in %d out %d ws %zu (need %zu)\n", n_in, out_size, ws_size, (size_t)WS_TOTAL); grid = -1; return; }
        int dev = 0, cus = 0, per_cu = 0;
        hipGetDevice(&dev); hipDeviceGetAttribute(&cus, hipDeviceAttributeMultiprocessorCount, dev);
        hipFuncSetAttribute((const void*)mk_fwd, hipFuncAttributeMaxDynamicSharedMemorySize, LDS_BYTES);
        hipOccupancyMaxActiveBlocksPerMultiprocessor(&per_cu, (const void*)mk_fwd, NTH, LDS_BYTES);
        (void)hipGetLastError();
        if (per_cu < 1) per_cu = 1;
        if (per_cu > 2) per_cu = 2;
        grid = cus * per_cu;
    }
    if (grid < 0) return;
    hipMemsetAsync((char*)d_ws + WS_CTL, 0, 16384, stream);
    Args a{};
    for (int i = 0; i < 23; ++i) a.in[i] = d_in[i];
    a.out = (float*)d_out; a.ws = (unsigned char*)d_ws;
#if MK_ONE_LAUNCH
    a.ph_lo = 0; a.ph_hi = NPHASE;
    hipLaunchKernelGGL(mk_fwd, dim3(grid), dim3(NTH), LDS_BYTES, stream, a);
#else
    for (int ph = 0; ph <= MK_LAST_PHASE; ++ph) { a.ph_lo = ph; a.ph_hi = ph + 1; hipLaunchKernelGGL(mk_fwd, dim3(grid), dim3(NTH), LDS_BYTES, stream, a); }
#ifdef MK_DUMP
    hipLaunchKernelGGL(dump_k, dim3(T * D / 4 / 256), dim3(256), 0, stream, (const unsigned char*)d_ws, (float*)d_out);
#endif
#endif
}
```

```cpp
#include <hip/hip_runtime.h>
#include <stdint.h>
#include <stdio.h>

#ifndef MK_LAST_PHASE
#define MK_LAST_PHASE 21
#endif
#ifndef MK_REP
#define MK_REP -1
#endif
#ifndef MK_XBAR
#define MK_XBAR 0
#endif
#ifndef MK_DRY
#define MK_DRY -1
#endif
#ifndef MK_ONE_LAUNCH
#define MK_ONE_LAUNCH 1
#endif

#define LAS __attribute__((address_space(3)))
typedef unsigned short bf16_t;
typedef short bf16x8 __attribute__((ext_vector_type(8)));
typedef float f32x4 __attribute__((ext_vector_type(4)));
typedef float f32x2 __attribute__((ext_vector_type(2)));
typedef float f32x16 __attribute__((ext_vector_type(16)));
typedef unsigned u32x4 __attribute__((ext_vector_type(4)));
typedef unsigned u32x2 __attribute__((ext_vector_type(2)));
typedef long i64x2 __attribute__((ext_vector_type(2)));

constexpr int T = 16384, D = 1024, SEQ = 4096;
constexpr int GW = 2048;
constexpr int BIN = 2120, BINP = 2176;
constexpr int NE = 32, DE = 512;
constexpr int PLE = 256;
constexpr float EPS = 1e-6f;
constexpr int NTH = 256;
constexpr int LDS_MAIN = 4 * 19456;
constexpr int LDS_BYTES = LDS_MAIN + 1024;
constexpr int RPAD = 32768 + NE * 128;

constexpr size_t MB = 1024 * 1024;
constexpr size_t WS_CTL = 0;
constexpr size_t WS_CNT = 16384;
constexpr size_t WS_WR = 32768;
constexpr size_t WS_WAIN = 1 * MB;
constexpr size_t WS_WAOUT = WS_WAIN + 8 * MB;
constexpr size_t WS_WBIN = WS_WAOUT + 4 * MB;
constexpr size_t WS_WBOUT = WS_WBIN + 5 * MB;
constexpr size_t WS_WGATE = WS_WBOUT + 2 * MB;
constexpr size_t WS_WPROJ = WS_WGATE + 4 * MB;
constexpr size_t WS_W1 = WS_WPROJ + 1 * MB;
constexpr size_t WS_XN8 = WS_W1 + 16 * MB;
constexpr size_t WS_W3 = WS_W1 + 32 * MB;
constexpr size_t WS_W2 = WS_W3 + 32 * MB;
constexpr size_t WS_PBF = WS_W2 + 32 * MB;
constexpr size_t WS_XN = WS_PBF + 16 * MB;
constexpr size_t WS_H = WS_XN + 32 * MB;
constexpr size_t WS_LIST = WS_H + 64 * MB;
constexpr size_t WS_GATE = WS_LIST + 2 * MB;
constexpr size_t WS_TOKSLOT = WS_GATE + 2 * MB;
constexpr size_t WS_SCR = WS_TOKSLOT + 1 * MB;
constexpr size_t WS_U = WS_SCR;
constexpr size_t WS_VT = WS_SCR + 64 * MB;
constexpr size_t WS_VSS = WS_SCR + 128 * MB;
constexpr size_t WS_HMID = WS_SCR;
constexpr size_t WS_Y = WS_SCR + 36 * MB;
constexpr size_t WS_RAW = WS_SCR;
constexpr size_t WS_O = WS_SCR;
constexpr size_t WS_Q = WS_SCR + 68 * MB;
constexpr size_t WS_K = WS_Q + 32 * MB;
constexpr size_t WS_V = WS_K + 8 * MB;
constexpr size_t WS_QI = WS_V + 8 * MB;
constexpr size_t WS_KI = WS_QI + 16 * MB;
constexpr size_t WS_WI = WS_KI + 2 * MB;
constexpr size_t WS_SEL = WS_WI + 1 * MB;
constexpr size_t WS_END = WS_SEL + 16 * MB;
static_assert(WS_END <= WS_SCR + 152 * MB, "scratch");
constexpr size_t WS_S = 392 * MB;
constexpr size_t WS_TOTAL = 522 * MB;

typedef __bf16 bf16x2_t __attribute__((ext_vector_type(2)));
__device__ __forceinline__ unsigned pk_bf16(float lo, float hi) { f32x2 v = {lo, hi}; bf16x2_t b = __builtin_convertvector(v, bf16x2_t); return __builtin_bit_cast(unsigned, b); }
__device__ __forceinline__ float bf_lo(unsigned u) { return __uint_as_float(u << 16); }
__device__ __forceinline__ float bf_hi(unsigned u) { return __uint_as_float(u & 0xffff0000u); }
__device__ __forceinline__ float wave_sum(float v) {
#pragma unroll
    for (int o = 1; o < 64; o <<= 1) v += __shfl_xor(v, o);
    return v;
}
__device__ __forceinline__ int lds_inc(LAS int* p) { return __hip_atomic_fetch_add(p, 1, __ATOMIC_RELAXED, __HIP_MEMORY_SCOPE_WORKGROUP); }
#define LDS_WAIT() asm volatile("s_waitcnt lgkmcnt(0)" ::: "memory")
#define VM_WAIT() asm volatile("s_waitcnt vmcnt(0)" ::: "memory")

#define XB_TMO      128
#define XB_XCNT(j)  (256  + 64 * (j))
#define XB_XSUB(j)  (1280 + 64 * (j))
#define XB_XGEN(j)  (2304 + 64 * (j))
#define XB_TOP      3328
#define XB_TOPGEN   3392
#define XCD_BAR_WORDS 3456
#define XB_SPIN_CAP (1u << 20)
__device__ __forceinline__ unsigned xb_ld(unsigned* p)              { return __hip_atomic_load(p, __ATOMIC_RELAXED, __HIP_MEMORY_SCOPE_AGENT); }
__device__ __forceinline__ unsigned xb_add(unsigned* p, unsigned v) { return __hip_atomic_fetch_add(p, v, __ATOMIC_RELAXED, __HIP_MEMORY_SCOPE_AGENT); }
__device__ __forceinline__ unsigned xb_xcc_id() { return (unsigned)__builtin_amdgcn_s_getreg((3 << 11) | 20) & 0xFu; }
#define XB_SPIN(cond, bar) do { unsigned _sp = 0; while (cond) { __builtin_amdgcn_s_sleep(1); \
    if ((++_sp & 255u) == 0u) { if (xb_ld(&(bar)[XB_TMO])) break; if (_sp > XB_SPIN_CAP) { atomicAdd(&(bar)[XB_TMO], 1u); break; } } } } while (0)
struct XcdBarrier { unsigned* bar; unsigned x; volatile LAS unsigned* st; };
__device__ __forceinline__ XcdBarrier xcd_barrier_post(unsigned* bar, volatile LAS unsigned* st) {
    XcdBarrier b; b.bar = bar; b.x = xb_xcc_id(); b.st = st;
    if (threadIdx.x == 0) (void)xb_add(&bar[XB_XCNT(b.x)], 1u);
    return b;
}
__device__ __forceinline__ void xcd_barrier_complete(unsigned* bar, unsigned x, unsigned& nloc, unsigned& nx) {
    const unsigned G = gridDim.x;
    unsigned sum, cnt, mine, sp = 0u;
    for (;;) {
        sum = 0u; cnt = 0u; mine = 0u;
#pragma unroll
        for (unsigned j = 0; j < 16; ++j) { const unsigned c = xb_ld(&bar[XB_XCNT(j)]); sum += c; cnt += (c > 0u) ? 1u : 0u; mine = (j == x) ? c : mine; }
        if (sum == G) break;
        __builtin_amdgcn_s_sleep(1);
        if ((++sp & 255u) == 0u) { if (xb_ld(&bar[XB_TMO])) break; if (sp > XB_SPIN_CAP) { atomicAdd(&bar[XB_TMO], 1u); break; } }
    }
    nloc = mine > 0u ? mine : 1u; nx = cnt > 0u ? cnt : 1u;
}
__device__ __forceinline__ void xcd_barrier(const XcdBarrier& b) {
    asm volatile("s_waitcnt vmcnt(0)" ::: "memory");
    __syncthreads();
    if (threadIdx.x == 0) {
        unsigned* bar = b.bar;
        __builtin_amdgcn_s_waitcnt(0);
        unsigned nloc = b.st[0], nx = b.st[1];
        if (nloc == 0u) { xcd_barrier_complete(bar, b.x, nloc, nx); b.st[0] = nloc; b.st[1] = nx; }
        const unsigned old = xb_add(&bar[XB_XSUB(b.x)], 1u);
        const unsigned gen = old / nloc;
        if (old + 1u == (gen + 1u) * nloc) {
            __builtin_amdgcn_fence(__ATOMIC_RELEASE, "agent");
            asm volatile("s_waitcnt vmcnt(0)" ::: "memory");
            const unsigned og = xb_add(&bar[XB_TOP], 1u);
            const unsigned tg = og / nx;
            if (og + 1u == (tg + 1u) * nx) xb_add(&bar[XB_TOPGEN], 1u);
            else XB_SPIN(xb_ld(&bar[XB_TOPGEN]) == tg, bar);
            __builtin_amdgcn_fence(__ATOMIC_ACQUIRE, "agent");
            xb_add(&bar[XB_XGEN(b.x)], 1u);
            asm volatile("s_waitcnt vmcnt(0)" ::: "memory");
        } else {
            XB_SPIN(xb_ld(&bar[XB_XGEN(b.x)]) == gen, bar);
            __builtin_amdgcn_fence(__ATOMIC_ACQUIRE, "agent");
            asm volatile("s_waitcnt vmcnt(0)" ::: "memory");
        }
    }
    __syncthreads();
}

struct Args { const void* in[23]; float* out; unsigned char* ws; int ph_lo, ph_hi; };
enum { IN_X = 0, IN_P, IN_POS, IN_MIXN, IN_AWIN, IN_AVG, IN_AWS, IN_ABS, IN_AWOUT, IN_BWIN, IN_BWOUT, IN_FFNN, IN_WG, IN_BG, IN_WE, IN_BE,
       IN_W1, IN_W3, IN_W2, IN_PLEN, IN_PLEG, IN_PLEP, IN_FINN };

struct Ctx {
    LAS unsigned char* lds;
    int tid, lane, wave, vb, nb;
    const __attribute__((address_space(4))) Args* a;
    unsigned char* ws;
};

template <int BK> struct TileK { static constexpr int NP = (BK == 64) ? 4 : 2; static constexpr int TB = 128 * BK * 2; };

template <int BK>
__device__ __forceinline__ void stage_tile(LAS unsigned char* tile, const bf16_t* const (&rp)[TileK<BK>::NP], int k0, int tid) {
    const int lc = (BK == 64) ? ((tid & 7) ^ ((tid >> 3) & 7)) : ((tid & 3) ^ ((tid >> 3) & 3));
#pragma unroll
    for (int p = 0; p < TileK<BK>::NP; ++p)
        __builtin_amdgcn_global_load_lds((const unsigned*)(rp[p] + k0 + lc * 8), (LAS unsigned*)(tile + p * 4096 + tid * 16), 16, 0, 0);
}
template <int BK>
__device__ __forceinline__ void rows_regular(const bf16_t* (&rp)[TileK<BK>::NP], const bf16_t* base, size_t ld, int tid) {
#pragma unroll
    for (int p = 0; p < TileK<BK>::NP; ++p) { const int r = (BK == 64) ? (p * 32 + (tid >> 3)) : (p * 64 + (tid >> 2)); rp[p] = base + (size_t)r * ld; }
}
template <int BK>
__device__ __forceinline__ int frag_off(int row, int ks, int fq) {
    return (BK == 64) ? (row * 128 + (((ks * 4 + fq) ^ (row & 7)) << 4)) : (row * 64 + ((fq ^ ((row >> 1) & 3)) << 4));
}

template <int BK, int NBOP, bool SWAP, bool FP8 = false>
__device__ __forceinline__ void gemm_loop(const Ctx& c, const bf16_t* const (&ap)[TileK<BK>::NP], const bf16_t* const (&b0p)[TileK<BK>::NP], const bf16_t* const (&b1p)[TileK<BK>::NP],
                                          int K, f32x4 (&acc0)[4][4], f32x4 (&acc1)[4][4]) {
    constexpr int TB = TileK<BK>::TB, SB = (1 + NBOP) * TB;
    static_assert(2 * SB <= LDS_MAIN, "lds");
    const int nk = K / BK, tid = c.tid;
    const int fr = c.lane & 15, fq = c.lane >> 4, wr = c.wave >> 1, wc = c.wave & 1;
    LAS unsigned char* lds = c.lds;
    stage_tile<BK>(lds, ap, 0, tid); stage_tile<BK>(lds + TB, b0p, 0, tid);
    if (NBOP == 2) stage_tile<BK>(lds + 2 * TB, b1p, 0, tid);
    for (int kt = 0; kt < nk; ++kt) {
        VM_WAIT();
        __syncthreads();
        LAS unsigned char* cur = lds + (kt & 1) * SB;
        if (kt + 1 < nk) {
            LAS unsigned char* nxt = lds + ((kt + 1) & 1) * SB;
            stage_tile<BK>(nxt, ap, (kt + 1) * BK, tid); stage_tile<BK>(nxt + TB, b0p, (kt + 1) * BK, tid);
            if (NBOP == 2) stage_tile<BK>(nxt + 2 * TB, b1p, (kt + 1) * BK, tid);
        }
#pragma unroll
        for (int ks = 0; ks < BK / 32; ++ks) {
            bf16x8 af[4], bf0[4], bf1[4];
#pragma unroll
            for (int m = 0; m < 4; ++m) af[m] = *(const LAS bf16x8*)(cur + frag_off<BK>(wr * 64 + m * 16 + fr, ks, fq));
#pragma unroll
            for (int n = 0; n < 4; ++n) bf0[n] = *(const LAS bf16x8*)(cur + TB + frag_off<BK>(wc * 64 + n * 16 + fr, ks, fq));
            if (NBOP == 2) {
#pragma unroll
                for (int n = 0; n < 4; ++n) bf1[n] = *(const LAS bf16x8*)(cur + 2 * TB + frag_off<BK>(wc * 64 + n * 16 + fr, ks, fq));
            }
#pragma unroll
            for (int m = 0; m < 4; ++m)
#pragma unroll
                for (int n = 0; n < 4; ++n) {
                    if (FP8) {
                        const i64x2 a2 = __builtin_bit_cast(i64x2, af[m]), b2 = __builtin_bit_cast(i64x2, bf0[n]);
                        if (SWAP) { acc0[m][n] = __builtin_amdgcn_mfma_f32_16x16x32_fp8_fp8(b2.x, a2.x, acc0[m][n], 0, 0, 0); acc0[m][n] = __builtin_amdgcn_mfma_f32_16x16x32_fp8_fp8(b2.y, a2.y, acc0[m][n], 0, 0, 0); }
                        else      { acc0[m][n] = __builtin_amdgcn_mfma_f32_16x16x32_fp8_fp8(a2.x, b2.x, acc0[m][n], 0, 0, 0); acc0[m][n] = __builtin_amdgcn_mfma_f32_16x16x32_fp8_fp8(a2.y, b2.y, acc0[m][n], 0, 0, 0); }
                        continue;
                    }
                    if (SWAP) acc0[m][n] = __builtin_amdgcn_mfma_f32_16x16x32_bf16(bf0[n], af[m], acc0[m][n], 0, 0, 0);
                    else      acc0[m][n] = __builtin_amdgcn_mfma_f32_16x16x32_bf16(af[m], bf0[n], acc0[m][n], 0, 0, 0);
                    if (NBOP == 2) {
                        if (SWAP) acc1[m][n] = __builtin_amdgcn_mfma_f32_16x16x32_bf16(bf1[n], af[m], acc1[m][n], 0, 0, 0);
                        else      acc1[m][n] = __builtin_amdgcn_mfma_f32_16x16x32_bf16(af[m], bf1[n], acc1[m][n], 0, 0, 0);
                    }
                }
        }
    }
    __syncthreads();
}
__device__ __forceinline__ void zero_acc(f32x4 (&acc)[4][4]) {
#pragma unroll
    for (int m = 0; m < 4; ++m)
#pragma unroll
        for (int n = 0; n < 4; ++n) acc[m][n] = (f32x4){0.f, 0.f, 0.f, 0.f};
}
__device__ __forceinline__ void map_unit(int u, int nnt, int& mt, int& nt) { const int per = 8 * nnt, band = u / per, r = u - band * per; nt = r >> 3; mt = band * 8 + (r & 7); }


__device__ __forceinline__ float gelu_tanh(float x) {
    const float y2 = 1.5957691216057308f * (x + 0.044715f * x * x * x);
    return x / (1.f + __expf(-y2));
}
__device__ __forceinline__ float sigmoidf_(float x) { return 1.f / (1.f + __expf(-x)); }

__device__ __forceinline__ void row_load(const float* row, int lane, f32x4 (&v)[4]) {
#pragma unroll
    for (int j = 0; j < 4; ++j) v[j] = ((const f32x4*)row)[lane + 64 * j];
}
__device__ __forceinline__ float row_sumsq(const f32x4 (&v)[4]) {
    float s = 0.f;
#pragma unroll
    for (int j = 0; j < 4; ++j) s += (v[j].x * v[j].x + v[j].y * v[j].y) + (v[j].z * v[j].z + v[j].w * v[j].w);
    return wave_sum(s);
}
__device__ __forceinline__ void gain_load(const float* gain, int lane, f32x4 (&g)[4]) {
#pragma unroll
    for (int j = 0; j < 4; ++j) g[j] = ((const f32x4*)gain)[lane + 64 * j];
}
__device__ __forceinline__ void row_store_norm_bf16(bf16_t* orow, int lane, const f32x4 (&v)[4], float r, const f32x4 (&gv)[4]) {
#pragma unroll
    for (int j = 0; j < 4; ++j) {
        const f32x4 g = gv[j];
        u32x2 o; o.x = pk_bf16(v[j].x * r * g.x, v[j].y * r * g.y); o.y = pk_bf16(v[j].z * r * g.z, v[j].w * r * g.w);
        ((u32x2*)orow)[lane + 64 * j] = o;
    }
}

__device__ __forceinline__ unsigned pk_fp8x4(float a, float b, float c_, float d);
__device__ __forceinline__ void row_store_norm_fp8(unsigned char* orow, int lane, const f32x4 (&v)[4], float r, const f32x4 (&gv)[4]) {
#pragma unroll
    for (int j = 0; j < 4; ++j) ((unsigned*)orow)[lane + 64 * j] = pk_fp8x4(v[j].x * r * gv[j].x, v[j].y * r * gv[j].y, v[j].z * r * gv[j].z, v[j].w * r * gv[j].w);
}
constexpr int TR_SCR = 64 * 136;
__device__ __forceinline__ void transpose_item(const float* W, int K, int N, int nvalid, int ldw, bf16_t* WT, LAS unsigned char* scr, int item, int lane) {
    const int nblk = N / 64, kb = item / nblk, nb = item - kb * nblk, k0 = 64 * kb, n0 = 64 * nb;
    const int n = n0 + 4 * (lane & 15);
    const int nc_ = (n < nvalid) ? n : 0; const float keep = (n < nvalid) ? 1.f : 0.f;
    f32x4 v[16];
#pragma unroll
    for (int i = 0; i < 16; ++i) v[i] = *(const f32x4*)(W + (size_t)(k0 + 4 * i + (lane >> 4)) * ldw + nc_);
#pragma unroll
    for (int i = 0; i < 16; ++i) {
        const int kk = 4 * i + (lane >> 4);
        u32x2 o; o.x = pk_bf16(v[i].x * keep, v[i].y * keep); o.y = pk_bf16(v[i].z * keep, v[i].w * keep);
        *(LAS u32x2*)(scr + kk * 136 + (lane & 15) * 8) = o;
    }
    LDS_WAIT();
    const int cc = lane & 7;
#pragma unroll
    for (int j = 0; j < 8; ++j) {
        const int nn = (lane >> 3) + 8 * j; const LAS unsigned short* sp = (const LAS unsigned short*)(scr + (8 * cc) * 136 + nn * 2);
        u32x4 o;
        o.x = (unsigned)sp[0 * 68] | ((unsigned)sp[1 * 68] << 16); o.y = (unsigned)sp[2 * 68] | ((unsigned)sp[3 * 68] << 16);
        o.z = (unsigned)sp[4 * 68] | ((unsigned)sp[5 * 68] << 16); o.w = (unsigned)sp[6 * 68] | ((unsigned)sp[7 * 68] << 16);
        *(u32x4*)(WT + (size_t)(n0 + nn) * K + k0 + 8 * cc) = o;
    }
    LDS_WAIT();
}

__device__ __forceinline__ unsigned pk_fp8x4(float a, float b, float c_, float d) {
    a = fminf(fmaxf(a, -448.f), 448.f); b = fminf(fmaxf(b, -448.f), 448.f); c_ = fminf(fmaxf(c_, -448.f), 448.f); d = fminf(fmaxf(d, -448.f), 448.f);
    int p = __builtin_amdgcn_cvt_pk_fp8_f32(a, b, 0, false);
    p = __builtin_amdgcn_cvt_pk_fp8_f32(c_, d, p, true);
    return (unsigned)p;
}
constexpr float W8_SCALE = 64.f, H8_SCALE = 4.f, O8_SCALE = 8.f;
__device__ __forceinline__ void transpose_item8(const float* W, int K, int N, unsigned char* WT, LAS unsigned char* scr, int item, int lane, int nvalid = 1 << 30, int ldw = 0) {
    const int nblk = N / 64, kb = item / nblk, nb = item - kb * nblk, k0 = 128 * kb, n0 = 64 * nb;
    const int n = n0 + 4 * (lane & 15), ld = ldw ? ldw : N, nc_ = (n < nvalid) ? n : 0; const float keep = (n < nvalid) ? W8_SCALE : 0.f;
#pragma unroll 2
    for (int h = 0; h < 2; ++h) {
        f32x4 v[16];
#pragma unroll
        for (int i = 0; i < 16; ++i) v[i] = *(const f32x4*)(W + (size_t)(k0 + 64 * h + 4 * i + (lane >> 4)) * ld + nc_);
#pragma unroll
        for (int i = 0; i < 16; ++i) { const int kk = 64 * h + 4 * i + (lane >> 4);
            *(LAS unsigned*)(scr + kk * 68 + (lane & 15) * 4) = pk_fp8x4(v[i].x * keep, v[i].y * keep, v[i].z * keep, v[i].w * keep); }
    }
    LDS_WAIT();
    const int cc = lane & 7;
#pragma unroll
    for (int j = 0; j < 8; ++j) {
        const int nn = (lane >> 3) + 8 * j; const LAS unsigned char* sp = scr + (16 * cc) * 68 + nn;
        unsigned w[4];
#pragma unroll
        for (int q = 0; q < 4; ++q) w[q] = (unsigned)sp[(4 * q + 0) * 68] | ((unsigned)sp[(4 * q + 1) * 68] << 8) | ((unsigned)sp[(4 * q + 2) * 68] << 16) | ((unsigned)sp[(4 * q + 3) * 68] << 24);
        u32x4 o = {w[0], w[1], w[2], w[3]};
        *(u32x4*)(WT + (size_t)(n0 + nn) * K + k0 + 16 * cc) = o;
    }
    LDS_WAIT();
}
__device__ __forceinline__ void convert_moe_item(const Ctx& c, int l, int it, LAS unsigned char* scr) {
    const float* w1 = (const float*)c.a->in[IN_W1] + (size_t)l * NE * D * DE;
    const float* w3 = (const float*)c.a->in[IN_W3] + (size_t)l * NE * D * DE;
    const float* w2 = (const float*)c.a->in[IN_W2] + (size_t)l * NE * DE * D;
    unsigned char* W1 = c.ws + WS_W1; unsigned char* W3 = c.ws + WS_W3; unsigned char* W2 = c.ws + WS_W2;
    const int e = it / 192, r = it - e * 192;
    if (r < 64)       transpose_item8(w1 + (size_t)e * D * DE, D, DE, W1 + (size_t)e * DE * D, scr, r, c.lane);
    else if (r < 128) transpose_item8(w3 + (size_t)e * D * DE, D, DE, W3 + (size_t)e * DE * D, scr, r - 64, c.lane);
    else              transpose_item8(w2 + (size_t)e * DE * D, DE, D, W2 + (size_t)e * D * DE, scr, r - 128, c.lane);
}
__device__ __forceinline__ void convert_moe_layer(const Ctx& c, int l) {
    LAS unsigned char* scr = c.lds + c.wave * TR_SCR;
    const int gw = c.vb * 4 + c.wave, ngw = c.nb * 4;
    for (int it = gw; it < NE * 192; it += ngw) convert_moe_item(c, l, it, scr);
}

__device__ __forceinline__ void phase_prep(const Ctx& c) {
    const __attribute__((address_space(4))) Args& a = *c.a;
    LAS unsigned char* scr = c.lds + c.wave * TR_SCR;
    const int gw = c.vb * 4 + c.wave, ngw = c.nb * 4;
    constexpr int I_AIN = 16 * 64, I_AOUT = 32 * 16, I_PP = 4 * 16, I_BIN8 = 8 * 34, I_BOUT8 = 8 * 16, I_PG8 = 8 * 16, I_BINI = 16 * 10;
    constexpr int NIT = I_AIN + I_AOUT + 2 * I_PP + I_BIN8 + I_BOUT8 + 2 * I_PG8 + I_BINI;
    for (int it = gw; it < NIT; it += ngw) {
        int r = it;
        if (r < I_AIN) { transpose_item((const float*)a.in[IN_AWIN], D, 4096, 4096, 4096, (bf16_t*)(c.ws + WS_WAIN), scr, r, c.lane); continue; } r -= I_AIN;
        if (r < I_AOUT) { transpose_item((const float*)a.in[IN_AWOUT], GW, D, D, D, (bf16_t*)(c.ws + WS_WAOUT), scr, r, c.lane); continue; } r -= I_AOUT;
        if (r < 2 * I_PP) { const int l = r / I_PP; transpose_item((const float*)a.in[IN_PLEP] + (size_t)l * PLE * D, PLE, D, D, D, (bf16_t*)(c.ws + WS_WPROJ) + (size_t)l * D * PLE, scr, r - l * I_PP, c.lane); continue; } r -= 2 * I_PP;
        if (r < I_BIN8) { transpose_item8((const float*)a.in[IN_BWIN], D, BINP, c.ws + WS_WBIN, scr, r, c.lane, BIN, BIN); continue; } r -= I_BIN8;
        if (r < I_BOUT8) { transpose_item8((const float*)a.in[IN_BWOUT], D, D, c.ws + WS_WBOUT, scr, r, c.lane); continue; } r -= I_BOUT8;
        if (r < 2 * I_PG8) { const int l = r / I_PG8; transpose_item8((const float*)a.in[IN_PLEG] + (size_t)l * D * D, D, D, c.ws + WS_WGATE + (size_t)l * D * D, scr, r - l * I_PG8, c.lane); continue; } r -= 2 * I_PG8;
        transpose_item((const float*)a.in[IN_BWIN] + 1536, D, 640, BIN - 1536, BIN, (bf16_t*)(c.ws + WS_WBIN + 3 * MB), scr, r, c.lane);
    }
    convert_moe_layer(c, 0);
    const int gt = c.vb * NTH + c.tid, ngt = c.nb * NTH;
    { const float* p = (const float*)a.in[IN_P]; bf16_t* pb = (bf16_t*)(c.ws + WS_PBF);
      for (int i = gt; i < 2 * T * PLE / 8; i += ngt) {
          const f32x4 v0 = ((const f32x4*)p)[2 * i], v1 = ((const f32x4*)p)[2 * i + 1];
          u32x4 o; o.x = pk_bf16(v0.x, v0.y); o.y = pk_bf16(v0.z, v0.w); o.z = pk_bf16(v1.x, v1.y); o.w = pk_bf16(v1.z, v1.w);
          ((u32x4*)pb)[i] = o; } }
    { float* wr = (float*)(c.ws + WS_WR);
      for (int i = gt; i < 2 * D * 48; i += ngt) {
          const int l = i / (D * 48), r = i - l * D * 48, k = r / 48, o = r - k * 48;
          float w = 0.f;
          if (o < 4) w = ((const float*)a.in[IN_WG])[(size_t)l * D * 4 + k * 4 + o];
          else if (o < 36) w = ((const float*)a.in[IN_WE])[(size_t)l * D * 32 + k * 32 + (o - 4)];
          wr[i] = w * ((const float*)a.in[IN_FFNN])[l * D + k]; } }
    if (c.vb == 0 && c.tid < 128) ((int*)(c.ws + WS_CNT))[c.tid] = 0;
    f32x4 gv[4]; gain_load((const float*)a.in[IN_MIXN], c.lane, gv);
    for (int t = gw; t < T; t += ngw) {
        f32x4 v[4]; row_load((const float*)a.in[IN_X] + (size_t)t * D, c.lane, v);
        const float r = rsqrtf(row_sumsq(v) * (1.f / D) + EPS);
        row_store_norm_bf16((bf16_t*)(c.ws + WS_XN) + (size_t)t * D, c.lane, v, r, gv);
    }
}

__device__ __forceinline__ void phase_a1(const Ctx& c) {
    const bf16_t* XN = (const bf16_t*)(c.ws + WS_XN); const bf16_t* W = (const bf16_t*)(c.ws + WS_WAIN);
    bf16_t* U = (bf16_t*)(c.ws + WS_U); bf16_t* VT = (bf16_t*)(c.ws + WS_VT); float* VSS = (float*)(c.ws + WS_VSS);
    const int fr = c.lane & 15, fq = c.lane >> 4, wr = c.wave >> 1, wc = c.wave & 1;
    for (int u = c.vb; u < 128 * 32; u += c.nb) {
        int mt, nt; map_unit(u, 32, mt, nt);
        const bf16_t* ap[4]; const bf16_t* bp[4];
        rows_regular<64>(ap, XN + (size_t)mt * 128 * D, D, c.tid); rows_regular<64>(bp, W + (size_t)nt * 128 * D, D, c.tid);
        f32x4 acc[4][4]; zero_acc(acc);
        if (nt < 16) {
            gemm_loop<64, 1, true>(c, ap, bp, bp, D, acc, acc);
#pragma unroll
            for (int m = 0; m < 4; ++m)
#pragma unroll
                for (int n = 0; n < 4; ++n) {
                    const int t = mt * 128 + wr * 64 + m * 16 + fr, col = nt * 128 + wc * 64 + n * 16 + fq * 4;
                    const f32x4 v = acc[m][n];
                    u32x2 o; o.x = pk_bf16(gelu_tanh(v.x), gelu_tanh(v.y)); o.y = pk_bf16(gelu_tanh(v.z), gelu_tanh(v.w));
                    *(u32x2*)(U + (size_t)t * GW + col) = o;
                }
        } else {
            gemm_loop<64, 1, false>(c, ap, bp, bp, D, acc, acc);
            const int vn = nt - 16;
#pragma unroll
            for (int m = 0; m < 4; ++m) {
                f32x4 ss = {0.f, 0.f, 0.f, 0.f};
                const int t0 = mt * 128 + wr * 64 + m * 16 + fq * 4;
#pragma unroll
                for (int n = 0; n < 4; ++n) {
                    const int ch = vn * 128 + wc * 64 + n * 16 + fr;
                    f32x4 v = acc[m][n];
                    v.x = gelu_tanh(v.x); v.y = gelu_tanh(v.y); v.z = gelu_tanh(v.z); v.w = gelu_tanh(v.w);
                    ss += v * v;
                    u32x2 o; o.x = pk_bf16(v.x, v.y); o.y = pk_bf16(v.z, v.w);
                    *(u32x2*)(VT + (size_t)ch * T + t0) = o;
                }
#pragma unroll
                for (int o = 1; o < 16; o <<= 1) { ss.x += __shfl_xor(ss.x, o); ss.y += __shfl_xor(ss.y, o); ss.z += __shfl_xor(ss.z, o); ss.w += __shfl_xor(ss.w, o); }
                if (fr == 0) {
                    VSS[(size_t)(t0 + 0) * 32 + vn * 2 + wc] = ss.x; VSS[(size_t)(t0 + 1) * 32 + vn * 2 + wc] = ss.y;
                    VSS[(size_t)(t0 + 2) * 32 + vn * 2 + wc] = ss.z; VSS[(size_t)(t0 + 3) * 32 + vn * 2 + wc] = ss.w;
                }
            }
        }
    }
}

__device__ __forceinline__ void phase_a2(const Ctx& c, bool dry = false) {
    const __attribute__((address_space(4))) Args& a = *c.a;
    bf16_t* U = (bf16_t*)(c.ws + WS_U); const bf16_t* VT = (const bf16_t*)(c.ws + WS_VT); const float* VSS = (const float*)(c.ws + WS_VSS);
    const float* ws_ = (const float*)a.in[IN_AWS]; const float* bs_ = (const float*)a.in[IN_ABS]; const float* vg = (const float*)a.in[IN_AVG];
    const int fr = c.lane & 15, fq = c.lane >> 4, wr = c.wave >> 1, wc = c.wave & 1, tid = c.tid;
    LAS unsigned char* lds = c.lds;
    LAS float* rl = (LAS float*)(lds + LDS_MAIN);
    for (int u = c.vb; u < 128 * 8; u += c.nb) {
        const int ci = u >> 3, g = u & 7, tokbase = ci * 128;
        __syncthreads();
        if (tid < 128) {
            const float* p = VSS + (size_t)(tokbase + tid) * 32; float s = 0.f;
#pragma unroll
            for (int i = 0; i < 8; ++i) { const f32x4 q = ((const f32x4*)p)[i]; s += (q.x + q.y) + (q.z + q.w); }
            rl[tid] = rsqrtf(s * (1.f / GW) + EPS);
        }
        __syncthreads();
        {
            const int t = tid >> 1, half = tid & 1;
            const float* wrow = ws_ + ((size_t)g * 128 + t) * 128 + half * 64;
#pragma unroll
            for (int cc = 0; cc < 8; ++cc) {
                const int s0 = half * 64 + cc * 8;
                u32x4 o;
                {
                    const f32x4 w0 = ((const f32x4*)wrow)[2 * cc], w1 = ((const f32x4*)wrow)[2 * cc + 1];
                    float e[8] = {w0.x, w0.y, w0.z, w0.w, w1.x, w1.y, w1.z, w1.w};
#pragma unroll
                    for (int i = 0; i < 8; ++i) e[i] = (s0 + i <= t) ? e[i] * rl[s0 + i] : 0.f;
                    o.x = pk_bf16(e[0], e[1]); o.y = pk_bf16(e[2], e[3]); o.z = pk_bf16(e[4], e[5]); o.w = pk_bf16(e[6], e[7]);
                }
                *(LAS u32x4*)(lds + half * 16384 + t * 128 + ((cc ^ (t & 7)) << 4)) = o;
            }
        }
        for (int hn = 0; hn < 2; ++hn) {
            const int c0 = g * 256 + hn * 128;
            const bf16_t* bp[4]; rows_regular<64>(bp, VT + (size_t)c0 * T + tokbase, T, tid);
            stage_tile<64>(lds + 32768, bp, 0, tid); stage_tile<64>(lds + 32768 + 16384, bp, 64, tid);
            VM_WAIT();
            __syncthreads();
            f32x4 acc[4][4]; zero_acc(acc);
#pragma unroll 1
            for (int kh = 0; kh < 2; ++kh)
#pragma unroll 1
                for (int ks = 0; ks < 2; ++ks) {
                    bf16x8 af[4], bf[4];
#pragma unroll
                    for (int m = 0; m < 4; ++m) af[m] = *(const LAS bf16x8*)(lds + kh * 16384 + frag_off<64>(wr * 64 + m * 16 + fr, ks, fq));
#pragma unroll
                    for (int n = 0; n < 4; ++n) bf[n] = *(const LAS bf16x8*)(lds + 32768 + kh * 16384 + frag_off<64>(wc * 64 + n * 16 + fr, ks, fq));
#pragma unroll
                    for (int m = 0; m < 4; ++m)
#pragma unroll
                        for (int n = 0; n < 4; ++n) acc[m][n] = __builtin_amdgcn_mfma_f32_16x16x32_bf16(bf[n], af[m], acc[m][n], 0, 0, 0);
                }
            u32x2 uvv[4][4]; float bsvv[4];
#pragma unroll
            for (int m = 0; m < 4; ++m) { const int tl = wr * 64 + m * 16 + fr; bsvv[m] = bs_[g * 128 + tl];
#pragma unroll
                for (int n = 0; n < 4; ++n) uvv[m][n] = *(const u32x2*)(U + (size_t)(tokbase + tl) * GW + c0 + wc * 64 + n * 16 + fq * 4); }
#pragma unroll
            for (int m = 0; m < 4; ++m) {
                const int tl = wr * 64 + m * 16 + fr; const float bsv = bsvv[m];
#pragma unroll
                for (int n = 0; n < 4; ++n) {
                    const int ch = c0 + wc * 64 + n * 16 + fq * 4;
                    const f32x4 gn = *(const f32x4*)(vg + ch);
                    u32x2* up = (u32x2*)(U + (size_t)(tokbase + tl) * GW + ch);
                    const u32x2 uv = uvv[m][n]; const f32x4 v = acc[m][n];
                    u32x2 o;
                    o.x = pk_bf16(bf_lo(uv.x) * (gn.x * v.x + bsv), bf_hi(uv.x) * (gn.y * v.y + bsv));
                    o.y = pk_bf16(bf_lo(uv.y) * (gn.z * v.z + bsv), bf_hi(uv.y) * (gn.w * v.w + bsv));
                    if (dry) *(u32x2*)(c.ws + 440 * MB + ((size_t)(tokbase + tl) * GW + ch) * 2) = o; else *up = o;
                }
            }
            __syncthreads();
        }
    }
}

__device__ __forceinline__ void phase_a3(const Ctx& c) {
    const bf16_t* Z = (const bf16_t*)(c.ws + WS_U); const bf16_t* W = (const bf16_t*)(c.ws + WS_WAOUT);
    const float* X = (const float*)c.a->in[IN_X]; float* H = (float*)(c.ws + WS_H);
    const int fr = c.lane & 15, fq = c.lane >> 4, wr = c.wave >> 1, wc = c.wave & 1;
    for (int u = c.vb; u < 128 * 8; u += c.nb) {
        int mt, nt; map_unit(u, 8, mt, nt);
        const bf16_t* ap[4]; const bf16_t* bp[4];
        rows_regular<64>(ap, Z + (size_t)mt * 128 * GW, GW, c.tid); rows_regular<64>(bp, W + (size_t)nt * 128 * GW, GW, c.tid);
        f32x4 acc[4][4];
#pragma unroll
        for (int m = 0; m < 4; ++m)
#pragma unroll
            for (int n = 0; n < 4; ++n) acc[m][n] = *(const f32x4*)(X + (size_t)(mt * 128 + wr * 64 + m * 16 + fr) * D + nt * 128 + wc * 64 + n * 16 + fq * 4);
        gemm_loop<64, 1, true>(c, ap, bp, bp, GW, acc, acc);
#pragma unroll
        for (int m = 0; m < 4; ++m)
#pragma unroll
            for (int n = 0; n < 4; ++n) *(f32x4*)(H + (size_t)(mt * 128 + wr * 64 + m * 16 + fr) * D + nt * 128 + wc * 64 + n * 16 + fq * 4) = acc[m][n];
    }
}

__device__ __forceinline__ void phase_route(const Ctx& c, int l, bool dry = false) {
    const __attribute__((address_space(4))) Args& a = *c.a;
    const float* H = (const float*)(c.ws + WS_H); bf16_t* XN = (bf16_t*)(c.ws + (dry ? 440 * MB : WS_XN));
    const float* wr_ = (const float*)(c.ws + WS_WR) + (size_t)l * D * 48;
    const float* gain = (const float*)a.in[IN_FFNN] + l * D;
    int* cnt = (int*)(c.ws + WS_CNT) + l * 32 + (dry ? 64 : 0); int* list = (int*)(c.ws + (dry ? 480 * MB : WS_LIST)); float* gatel = (float*)(c.ws + (dry ? 484 * MB : WS_GATE)); int* tokslot = (int*)(c.ws + (dry ? 488 * MB : WS_TOKSLOT));
    LAS float* rl = (LAS float*)(c.lds);
    LAS float* lgl = (LAS float*)(c.lds + 256);
    const int lane = c.lane, w = c.wave;
    f32x4 gv[4]; gain_load(gain, lane, gv);
    for (int unit = c.vb; unit < T / 32; unit += c.nb) {
        const int tok0 = unit * 32;
        __syncthreads();
        for (int i = 0; i < 8; ++i) {
            const int t = tok0 + w * 8 + i;
            f32x4 v[4]; row_load(H + (size_t)t * D, lane, v);
            const float r = rsqrtf(row_sumsq(v) * (1.f / D) + EPS);
            if (lane == 0) rl[w * 8 + i] = r;
            row_store_norm_fp8(c.ws + (dry ? 440 * MB : WS_XN8) + (size_t)t * D, lane, v, r, gv);
        }
        {
            const int th = w & 1, kh = w >> 1, m = lane & 15, q = lane >> 4;
            const float* arow = H + (size_t)(tok0 + 16 * th + m) * D + 512 * kh + 128 * q;
            const float* brow = wr_ + (size_t)(512 * kh + 128 * q) * 48 + m;
            f32x4 acc[3]; acc[0] = acc[1] = acc[2] = (f32x4){0.f, 0.f, 0.f, 0.f};
            for (int i = 0; i < 32; ++i) {
                const f32x4 av = ((const f32x4*)arow)[i];
                const float ae[4] = {av.x, av.y, av.z, av.w};
#pragma unroll
                for (int e = 0; e < 4; ++e) {
                    const float* bp = brow + (size_t)(4 * i + e) * 48;
#pragma unroll
                    for (int nt = 0; nt < 3; ++nt) acc[nt] = __builtin_amdgcn_mfma_f32_16x16x4f32(ae[e], bp[nt * 16], acc[nt], 0, 0, 0);
                }
            }
#pragma unroll
            for (int nt = 0; nt < 3; ++nt)
#pragma unroll
                for (int j = 0; j < 4; ++j) lgl[(kh * 32 + th * 16 + 4 * q + j) * 48 + nt * 16 + m] = acc[nt][j];
        }
        __syncthreads();
        if (c.tid < 32) {
            const int tt = c.tid, t = tok0 + tt; const float r = rl[tt];
            const float* bg = (const float*)a.in[IN_BG] + l * 4; const float* be = (const float*)a.in[IN_BE] + l * 32;
            float gl[4];
#pragma unroll
            for (int o = 0; o < 4; ++o) gl[o] = (lgl[tt * 48 + o] + lgl[(32 + tt) * 48 + o]) * r + bg[o];
            int gs = 0; float gm = gl[0];
#pragma unroll
            for (int o = 1; o < 4; ++o) if (gl[o] > gm) { gm = gl[o]; gs = o; }
            float gden = 0.f;
#pragma unroll
            for (int o = 0; o < 4; ++o) gden += __expf(gl[o] - gm);
            const float pg = 1.f / gden;
            float l1 = -INFINITY, l2 = -INFINITY; int i1 = 0, i2 = 0;
            for (int i = 0; i < 8; ++i) {
                const int o = 4 + gs * 8 + i;
                const float v = (lgl[tt * 48 + o] + lgl[(32 + tt) * 48 + o]) * r + be[gs * 8 + i];
                if (v > l1) { l2 = l1; i2 = i1; l1 = v; i1 = i; } else if (v > l2) { l2 = v; i2 = i; }
            }
            const float e2 = __expf(l2 - l1), inv = 1.f / (1.f + e2);
            const float g1 = pg * inv, g2 = pg * e2 * inv;
            const int ea = gs * 8 + i1, eb = gs * 8 + i2;
            const int sa = atomicAdd(&cnt[ea], 1), sb = atomicAdd(&cnt[eb], 1);
            list[ea * T + sa] = t; gatel[ea * T + sa] = g1; tokslot[2 * t] = (ea << 16) | sa;
            list[eb * T + sb] = t; gatel[eb * T + sb] = g2; tokslot[2 * t + 1] = (eb << 16) | sb;
        }
    }
}

__device__ __forceinline__ void moe_table(const Ctx& c, int l, LAS int* pst, LAS int* cn) {
    __syncthreads();
    if (c.tid == 0) {
        const int* cnt = (const int*)(c.ws + WS_CNT) + l * 32; int acc = 0;
        for (int e = 0; e < 32; ++e) { const int n = cnt[e]; cn[e] = n; pst[e] = acc; acc += (n + 127) >> 7; }
        pst[32] = acc;
    }
    __syncthreads();
}
__device__ __forceinline__ int moe_find(LAS const int* pst, int mb) { int e = 0; for (int i = 1; i < 32; ++i) e = (pst[i] <= mb) ? i : e; return e; }

__device__ __forceinline__ void phase_e1(const Ctx& c, int l) {
    const unsigned char* XN8 = c.ws + WS_XN8; const unsigned char* W1 = c.ws + WS_W1; const unsigned char* W3 = c.ws + WS_W3;
    unsigned char* HM = c.ws + WS_HMID; const int* list = (const int*)(c.ws + WS_LIST);
    LAS int* pst = (LAS int*)(c.lds + LDS_MAIN); LAS int* cn = pst + 40;
    moe_table(c, l, pst, cn);
    const int fr = c.lane & 15, fq = c.lane >> 4, wr = c.wave >> 1, wc = c.wave & 1, tid = c.tid;
    const int nunits = pst[32] * 8;
    for (int u = c.vb; u < nunits; u += c.nb) {
        const int mb = u >> 3, h0 = (u & 7) * 64, e = moe_find(pst, mb), row0 = (mb - pst[e]) * 128, count = cn[e];
        const bf16_t* ap[4]; const bf16_t* bp[4];
#pragma unroll
        for (int p = 0; p < 4; ++p) {
            int r = row0 + p * 32 + (tid >> 3); r = r < count ? r : row0; ap[p] = (const bf16_t*)(XN8 + (size_t)list[e * T + r] * D);
            const int rb = p * 32 + (tid >> 3), hid = h0 + (rb >> 6) * 32 + ((rb >> 4) & 1) * 16 + (rb & 15);
            bp[p] = (const bf16_t*)((((rb >> 5) & 1) ? W3 : W1) + ((size_t)e * DE + hid) * D);
        }
        f32x4 acc[4][4]; zero_acc(acc);
        gemm_loop<64, 1, true, true>(c, ap, bp, bp, D / 2, acc, acc);
        const float ws_ = 1.f / W8_SCALE;
#pragma unroll
        for (int m = 0; m < 4; ++m)
#pragma unroll
            for (int n = 0; n < 2; ++n) {
                const size_t row = (size_t)mb * 128 + wr * 64 + m * 16 + fr; const int col = h0 + wc * 32 + n * 16 + fq * 4;
                const f32x4 x = acc[m][n] * ws_, y = acc[m][n + 2] * (ws_ * H8_SCALE);
                *(unsigned*)(HM + row * DE + col) = pk_fp8x4(x.x * sigmoidf_(x.x) * y.x, x.y * sigmoidf_(x.y) * y.y, x.z * sigmoidf_(x.z) * y.z, x.w * sigmoidf_(x.w) * y.w);
            }
    }
}
__device__ __forceinline__ void phase_e2(const Ctx& c, int l) {
    const unsigned char* HM = c.ws + WS_HMID; const unsigned char* W2 = c.ws + WS_W2;
    bf16_t* Y = (bf16_t*)(c.ws + WS_Y); const float* gatel = (const float*)(c.ws + WS_GATE);
    LAS int* pst = (LAS int*)(c.lds + LDS_MAIN); LAS int* cn = pst + 40;
    moe_table(c, l, pst, cn);
    const int fr = c.lane & 15, fq = c.lane >> 4, wr = c.wave >> 1, wc = c.wave & 1, tid = c.tid;
    const int nunits = pst[32] * 8;
    for (int u = c.vb; u < nunits; u += c.nb) {
        const int mb = u >> 3, nt = u & 7, e = moe_find(pst, mb), row0 = (mb - pst[e]) * 128, count = cn[e];
        const bf16_t* ap[4]; const bf16_t* bp[4];
        rows_regular<64>(ap, (const bf16_t*)(HM + (size_t)mb * 128 * DE), DE / 2, tid); rows_regular<64>(bp, (const bf16_t*)(W2 + ((size_t)e * D + nt * 128) * DE), DE / 2, tid);
        f32x4 acc[4][4]; zero_acc(acc);
        gemm_loop<64, 1, true, true>(c, ap, bp, bp, DE / 2, acc, acc);
        float gtv[4];
#pragma unroll
        for (int m = 0; m < 4; ++m) { const int rl_ = wr * 64 + m * 16 + fr; gtv[m] = (row0 + rl_ < count) ? gatel[e * T + row0 + rl_] * (1.f / (W8_SCALE * H8_SCALE)) : 0.f; }
#pragma unroll
        for (int m = 0; m < 4; ++m) {
            const int rl_ = wr * 64 + m * 16 + fr; const float gt = gtv[m];
#pragma unroll
            for (int n = 0; n < 4; ++n) {
                const f32x4 v = acc[m][n] * gt;
                u32x2 o; o.x = pk_bf16(v.x, v.y); o.y = pk_bf16(v.z, v.w);
                *(u32x2*)(Y + ((size_t)mb * 128 + rl_) * D + nt * 128 + wc * 64 + n * 16 + fq * 4) = o;
            }
        }
    }
}
__device__ __forceinline__ void phase_p1(const Ctx& c, int l, bool dry = false) {
    float* H = (float*)(c.ws + WS_H); float* HO = (float*)(c.ws + (dry ? 440 * MB : WS_H)); bf16_t* XN = (bf16_t*)(c.ws + (dry ? 440 * MB : WS_XN)); const bf16_t* Y = (const bf16_t*)(c.ws + WS_Y);
    const int* tokslot = (const int*)(c.ws + WS_TOKSLOT); const float* gain = (const float*)c.a->in[IN_PLEN] + l * D;
    LAS int* pst = (LAS int*)(c.lds + LDS_MAIN); LAS int* cn = pst + 40;
    moe_table(c, l, pst, cn);
    const int gw = c.vb * 4 + c.wave, ngw = c.nb * 4, lane = c.lane;
    f32x4 gv[4]; gain_load(gain, lane, gv);
    for (int t = gw; t < T; t += ngw) {
        const int s0 = tokslot[2 * t], s1 = tokslot[2 * t + 1];
        const bf16_t* y0 = Y + ((size_t)pst[s0 >> 16] * 128 + (s0 & 0xffff)) * D; const bf16_t* y1 = Y + ((size_t)pst[s1 >> 16] * 128 + (s1 & 0xffff)) * D;
        f32x4 v[4]; row_load(H + (size_t)t * D, lane, v);
#pragma unroll
        for (int j = 0; j < 4; ++j) {
            const u32x2 a0 = ((const u32x2*)y0)[lane + 64 * j], a1 = ((const u32x2*)y1)[lane + 64 * j];
            v[j].x += bf_lo(a0.x) + bf_lo(a1.x); v[j].y += bf_hi(a0.x) + bf_hi(a1.x); v[j].z += bf_lo(a0.y) + bf_lo(a1.y); v[j].w += bf_hi(a0.y) + bf_hi(a1.y);
            ((f32x4*)(HO + (size_t)t * D))[lane + 64 * j] = v[j];
        }
        const float r = rsqrtf(row_sumsq(v) * (1.f / D) + EPS);
        row_store_norm_fp8(c.ws + (dry ? 440 * MB : WS_XN8) + (size_t)t * D, lane, v, r, gv);
    }
}
__device__ __forceinline__ void phase_p2(const Ctx& c, int l) {
    const bf16_t* XN = (const bf16_t*)(c.ws + WS_XN); const bf16_t* WG = (const bf16_t*)(c.ws + WS_WGATE) + (size_t)l * D * D;
    const bf16_t* PB = (const bf16_t*)(c.ws + WS_PBF) + (size_t)l * T * PLE; const bf16_t* WP = (const bf16_t*)(c.ws + WS_WPROJ) + (size_t)l * D * PLE;
    float* H = (float*)(c.ws + WS_H);
    const int fr = c.lane & 15, fq = c.lane >> 4, wr = c.wave >> 1, wc = c.wave & 1;
    for (int u = c.vb; u < 128 * 8; u += c.nb) {
        int mt, nt; map_unit(u, 8, mt, nt);
        const bf16_t* ap[4]; const bf16_t* bp[4];
        f32x4 ag[4][4], apj[4][4]; zero_acc(ag); zero_acc(apj);
        rows_regular<64>(ap, (const bf16_t*)(c.ws + WS_XN8 + (size_t)mt * 128 * D), D / 2, c.tid); rows_regular<64>(bp, (const bf16_t*)(c.ws + WS_WGATE + ((size_t)l * D + nt * 128) * D), D / 2, c.tid);
        gemm_loop<64, 1, true, true>(c, ap, bp, bp, D / 2, ag, ag);
        rows_regular<64>(ap, PB + (size_t)mt * 128 * PLE, PLE, c.tid); rows_regular<64>(bp, WP + (size_t)nt * 128 * PLE, PLE, c.tid);
        gemm_loop<64, 1, true>(c, ap, bp, bp, PLE, apj, apj);
        f32x4 hres[4][4];
#pragma unroll
        for (int m = 0; m < 4; ++m)
#pragma unroll
            for (int n = 0; n < 4; ++n) hres[m][n] = *(const f32x4*)(H + (size_t)(mt * 128 + wr * 64 + m * 16 + fr) * D + nt * 128 + wc * 64 + n * 16 + fq * 4);
#pragma unroll
        for (int m = 0; m < 4; ++m)
#pragma unroll
            for (int n = 0; n < 4; ++n) {
                const size_t off = (size_t)(mt * 128 + wr * 64 + m * 16 + fr) * D + nt * 128 + wc * 64 + n * 16 + fq * 4;
                const f32x4 g = ag[m][n] * (1.f / W8_SCALE), pj = apj[m][n]; f32x4 h = hres[m][n];
                h.x += sigmoidf_(g.x) * pj.x; h.y += sigmoidf_(g.y) * pj.y; h.z += sigmoidf_(g.z) * pj.z; h.w += sigmoidf_(g.w) * pj.w;
                *(f32x4*)(H + off) = h;
            }
    }
}
__device__ __forceinline__ void phase_norm_bf16(const Ctx& c, const float* gain) {
    const float* H = (const float*)(c.ws + WS_H);
    const int gw = c.vb * 4 + c.wave, ngw = c.nb * 4;
    f32x4 gv[4]; gain_load(gain, c.lane, gv);
    for (int t = gw; t < T; t += ngw) {
        f32x4 v[4]; row_load(H + (size_t)t * D, c.lane, v);
        const float r = rsqrtf(row_sumsq(v) * (1.f / D) + EPS);
        row_store_norm_fp8(c.ws + WS_XN8 + (size_t)t * D, c.lane, v, r, gv);
        row_store_norm_bf16((bf16_t*)(c.ws + WS_XN) + (size_t)t * D, c.lane, v, r, gv);
    }
}
__device__ __forceinline__ void phase_final(const Ctx& c) {
    const float* H = (const float*)(c.ws + WS_H); float* O = c.a->out; const float* gain = (const float*)c.a->in[IN_FINN];
    const int gw = c.vb * 4 + c.wave, ngw = c.nb * 4;
    f32x4 gv[4]; gain_load(gain, c.lane, gv);
    for (int t = gw; t < T; t += ngw) {
        f32x4 v[4]; row_load(H + (size_t)t * D, c.lane, v);
        const float r = rsqrtf(row_sumsq(v) * (1.f / D) + EPS);
#pragma unroll
        for (int j = 0; j < 4; ++j) ((f32x4*)(O + (size_t)t * D))[c.lane + 64 * j] = v[j] * r * gv[j];
    }
}

__device__ __forceinline__ void phase_b1(const Ctx& c, size_t raw_off = WS_RAW) {
    const bf16_t* XN = (const bf16_t*)(c.ws + WS_XN); const bf16_t* W = (const bf16_t*)(c.ws + WS_WBIN); bf16_t* RAW = (bf16_t*)(c.ws + raw_off);
    const int fr = c.lane & 15, fq = c.lane >> 4, wr = c.wave >> 1, wc = c.wave & 1;
    for (int u = c.vb; u < 128 * 17; u += c.nb) {
        int mt, nt; map_unit(u, 17, mt, nt);
        const bf16_t* ap[4]; const bf16_t* bp[4];
        f32x4 acc[4][4]; zero_acc(acc);
        float osc = 1.f;
        if (nt < 12) {
            rows_regular<64>(ap, (const bf16_t*)(c.ws + WS_XN8 + (size_t)mt * 128 * D), D / 2, c.tid); rows_regular<64>(bp, (const bf16_t*)(c.ws + WS_WBIN + (size_t)nt * 128 * D), D / 2, c.tid);
            gemm_loop<64, 1, true, true>(c, ap, bp, bp, D / 2, acc, acc);
            osc = 1.f / W8_SCALE;
        } else {
            rows_regular<64>(ap, XN + (size_t)mt * 128 * D, D, c.tid); rows_regular<64>(bp, (const bf16_t*)(c.ws + WS_WBIN + 3 * MB) + (size_t)(nt - 12) * 128 * D, D, c.tid);
            gemm_loop<64, 1, true>(c, ap, bp, bp, D, acc, acc);
        }
#pragma unroll
        for (int m = 0; m < 4; ++m)
#pragma unroll
            for (int n = 0; n < 4; ++n) {
                const f32x4 v = acc[m][n] * osc; u32x2 o; o.x = pk_bf16(v.x, v.y); o.y = pk_bf16(v.z, v.w);
                *(u32x2*)(RAW + (size_t)(mt * 128 + wr * 64 + m * 16 + fr) * BINP + nt * 128 + wc * 64 + n * 16 + fq * 4) = o;
            }
    }
}

__device__ __forceinline__ void unpack8(const u32x4 r, float (&e)[8]) { e[0] = bf_lo(r.x); e[1] = bf_hi(r.x); e[2] = bf_lo(r.y); e[3] = bf_hi(r.y); e[4] = bf_lo(r.z); e[5] = bf_hi(r.z); e[6] = bf_lo(r.w); e[7] = bf_hi(r.w); }
__device__ __forceinline__ u32x4 pack8(const float (&e)[8]) { u32x4 o; o.x = pk_bf16(e[0], e[1]); o.y = pk_bf16(e[2], e[3]); o.z = pk_bf16(e[4], e[5]); o.w = pk_bf16(e[6], e[7]); return o; }
__device__ __forceinline__ void phase_rope(const Ctx& c) {
    const bf16_t* RAW = (const bf16_t*)(c.ws + WS_RAW);
    bf16_t* Q = (bf16_t*)(c.ws + WS_Q); bf16_t* K = (bf16_t*)(c.ws + WS_K); bf16_t* V = (bf16_t*)(c.ws + WS_V);
    bf16_t* QI = (bf16_t*)(c.ws + WS_QI); bf16_t* KI = (bf16_t*)(c.ws + WS_KI); float* WI = (float*)(c.ws + WS_WI);
    const int* pos = (const int*)c.a->in[IN_POS];
    LAS float* cs = (LAS float*)(c.lds + c.wave * 256);
    const int gw = c.vb * 4 + c.wave, ngw = c.nb * 4, lane = c.lane;
    for (int t = gw; t < T; t += ngw) {
        if (lane < 24) {
            const double ex = (lane < 16) ? (double)lane * (1.0 / 16.0) : (double)(lane - 16) * (1.0 / 8.0);
            const float invf = (float)exp2(-ex * 18.931568569324174);
            const float ang = (float)pos[t] * invf;
            const double ad = (double)ang; const double n = rint(ad * 0.15915494309189535); const float red = (float)(ad - n * 6.283185307179586);
            cs[lane] = cosf(red); cs[32 + lane] = sinf(red);
        }
        LDS_WAIT();
        const bf16_t* row = RAW + (size_t)t * BINP;
        for (int ch = lane; ch < BINP / 8; ch += 64) {
            const u32x4 own = ((const u32x4*)row)[ch];
            float e[8]; unpack8(own, e);
            if (ch < 160) {
                const int cc = ch & 15;
                if (cc < 4) {
                    const u32x4 oth = ((const u32x4*)row)[ch ^ 2]; float p[8]; unpack8(oth, p);
                    const int f0 = (cc & 1) * 8;
#pragma unroll
                    for (int i = 0; i < 8; ++i) { const float co = cs[f0 + i], si = cs[32 + f0 + i]; e[i] = (cc < 2) ? (e[i] * co - p[i] * si) : (e[i] * co + p[i] * si); }
                }
                u32x2 o8; o8.x = pk_fp8x4(e[0], e[1], e[2], e[3]); o8.y = pk_fp8x4(e[4], e[5], e[6], e[7]);
                if (ch < 128) ((u32x2*)((unsigned char*)Q + (size_t)t * D))[ch] = o8;
                else ((u32x2*)((unsigned char*)K + (size_t)t * 256))[ch - 128] = o8;
            } else if (ch < 192) {
                u32x2 o8; o8.x = pk_fp8x4(e[0], e[1], e[2], e[3]); o8.y = pk_fp8x4(e[4], e[5], e[6], e[7]);
                ((u32x2*)((unsigned char*)V + (size_t)t * 256))[ch - 160] = o8;
            } else if (ch < 264) {
                const int cc = ch & 7;
                if (cc < 2) {
                    const u32x4 oth = ((const u32x4*)row)[ch ^ 1]; float p[8]; unpack8(oth, p);
#pragma unroll
                    for (int i = 0; i < 8; ++i) { const float co = cs[16 + i], si = cs[32 + 16 + i]; e[i] = (cc == 0) ? (e[i] * co - p[i] * si) : (e[i] * co + p[i] * si); }
                }
                if (ch < 256) ((u32x4*)(QI + (size_t)t * 512))[ch - 192] = pack8(e);
                else ((u32x4*)(KI + (size_t)t * 64))[ch - 256] = pack8(e);
            } else if (ch == 264) {
                f32x4 w0 = {e[0], e[1], e[2], e[3]}, w1 = {e[4], e[5], e[6], e[7]};
                const float sc = 0.044194173824159216f;
                ((f32x4*)(WI + (size_t)t * 8))[0] = w0 * sc; ((f32x4*)(WI + (size_t)t * 8))[1] = w1 * sc;
            }
        }
        LDS_WAIT();
    }
}

__device__ __forceinline__ size_t srow_off(int t) { const int m = t >> 6, r = t & 63; return (size_t)64 * (m + 1) * (32 * m + r); }
constexpr size_t S_BATCH = (size_t)64 * 65 * 2048;
constexpr int SCORE_UNITS = 4 * 312;
__device__ __forceinline__ void phase_score(const Ctx& c) {
    const bf16_t* QI = (const bf16_t*)(c.ws + WS_QI); const bf16_t* KI = (const bf16_t*)(c.ws + WS_KI); const float* WI = (const float*)(c.ws + WS_WI);
    float* S = (float*)(c.ws + WS_S);
    const int lane = c.lane, hf = lane >> 5, col = lane & 31, w = c.wave;
    for (int u = c.vb; u < SCORE_UNITS; u += c.nb) {
        const int b = u & 3, r = u >> 2;
        int kc, qb;
        if (r < 120) { kc = 0; qb = 8 + r; } else if (r < 216) { kc = 1; qb = 32 + (r - 120); } else if (r < 280) { kc = 2; qb = 64 + (r - 216); } else { kc = 3; qb = 96 + (r - 280); }
        const int tb = b * SEQ, t0 = 32 * qb + 8 * w;
        bf16x8 af[2][4]; f32x4 wv[2][4];
        { const int rho = lane & 31, ql = 2 * ((rho >> 2) & 1) + (rho >> 4), hd = 4 * ((rho >> 3) & 1) + (rho & 3);
#pragma unroll
          for (int a = 0; a < 2; ++a) {
              const bf16_t* qp = QI + (size_t)(tb + t0 + 4 * a + ql) * 512 + hd * 64 + 8 * hf;
#pragma unroll
              for (int ks = 0; ks < 4; ++ks) af[a][ks] = *(const bf16x8*)(qp + 16 * ks);
              const float* wp = WI + (size_t)(tb + t0 + 4 * a + 2 * hf) * 8;
#pragma unroll
              for (int i = 0; i < 4; ++i) wv[a][i] = ((const f32x4*)wp)[i];
          } }
        const int ntile = min(32, qb + 1 - 32 * kc), key0 = 1024 * kc;
        float* Sb = S + (size_t)b * S_BATCH;
        size_t ro[2][2];
#pragma unroll
        for (int a = 0; a < 2; ++a) { ro[a][0] = srow_off(t0 + 4 * a + 2 * hf); ro[a][1] = srow_off(t0 + 4 * a + 2 * hf + 1); }
        const int nsub = (ntile + 3) >> 2;
        const bf16_t* krp[4];
        rows_regular<64>(krp, KI + (size_t)(tb + key0) * 64, 64, c.tid);
        __syncthreads();
        stage_tile<64>(c.lds, krp, 0, c.tid);
        for (int sc = 0; sc < nsub; ++sc) {
            VM_WAIT();
            __syncthreads();
            const LAS unsigned char* cur = c.lds + (sc & 1) * 16384;
            if (sc + 1 < nsub) stage_tile<64>(c.lds + ((sc + 1) & 1) * 16384, krp, (sc + 1) * 128 * 64, c.tid);
#pragma unroll
            for (int j = 0; j < 4; ++j) {
                const int kt = 4 * sc + j;
                if (kt < ntile) {
                    const int key = key0 + 32 * kt + col, row = 32 * j + col;
                    bf16x8 cb[4];
#pragma unroll
                    for (int ks = 0; ks < 4; ++ks) cb[ks] = *(const LAS bf16x8*)(cur + row * 128 + (((2 * ks + hf) ^ (row & 7)) << 4));
#pragma unroll
                    for (int a = 0; a < 2; ++a) {
                        f32x16 acc = {};
#pragma unroll
                        for (int ks = 0; ks < 4; ++ks) acc = __builtin_amdgcn_mfma_f32_32x32x16_bf16(af[a][ks], cb[ks], acc, 0, 0, 0);
                        float s0 = fmaxf(acc[0], 0.f) * wv[a][0].x; s0 += fmaxf(acc[1], 0.f) * wv[a][0].y; s0 += fmaxf(acc[2], 0.f) * wv[a][0].z; s0 += fmaxf(acc[3], 0.f) * wv[a][0].w;
                        s0 += fmaxf(acc[4], 0.f) * wv[a][1].x; s0 += fmaxf(acc[5], 0.f) * wv[a][1].y; s0 += fmaxf(acc[6], 0.f) * wv[a][1].z; s0 += fmaxf(acc[7], 0.f) * wv[a][1].w;
                        float s1 = fmaxf(acc[8], 0.f) * wv[a][2].x; s1 += fmaxf(acc[9], 0.f) * wv[a][2].y; s1 += fmaxf(acc[10], 0.f) * wv[a][2].z; s1 += fmaxf(acc[11], 0.f) * wv[a][2].w;
                        s1 += fmaxf(acc[12], 0.f) * wv[a][3].x; s1 += fmaxf(acc[13], 0.f) * wv[a][3].y; s1 += fmaxf(acc[14], 0.f) * wv[a][3].z; s1 += fmaxf(acc[15], 0.f) * wv[a][3].w;
                        const int tA = t0 + 4 * a + 2 * hf;
                        Sb[ro[a][0] + key] = (key <= tA) ? s0 : -INFINITY;
                        Sb[ro[a][1] + key] = (key <= tA + 1) ? s1 : -INFINITY;
                    }
                }
            }
        }
    }
}

constexpr int NBINS = 2048, CAND_CAP = 256, SEL_WAVE_LDS = 8192 + 2048 + 64;
__device__ __forceinline__ int clamp_bin(int x) { return min(max(x, 0), NBINS - 1); }
__device__ __forceinline__ void phase_select(const Ctx& c) {
    const float* S = (const float*)(c.ws + WS_S); int* SEL = (int*)(c.ws + WS_SEL);
    LAS int* hist = (LAS int*)(c.lds + c.wave * SEL_WAVE_LDS);
    LAS float* candv = (LAS float*)(hist + NBINS);
    LAS int* candi = (LAS int*)(candv + CAND_CAP);
    LAS int* thr = candi + CAND_CAP;
    const int gw = c.vb * 4 + c.wave, ngw = c.nb * 4;
    for (int j = gw; j < 4 * 3840; j += ngw) {
        int lane = c.lane;
        asm volatile("" : "+v"(lane));
        const int b = j & 3, t = 4095 - (j >> 2), ni = (t + 64) >> 6;
        const float* row = S + (size_t)b * S_BATCH + srow_off(t);
        float s[64];
#pragma unroll
        for (int g4 = 0; g4 < 4; ++g4) {
            if (16 * g4 < ni) {
#pragma unroll
                for (int i = 16 * g4; i < 16 * g4 + 16; ++i) { const int k = 64 * i + lane; const float v = row[min(k, t)]; s[i] = (k <= t) ? v : -INFINITY; }
            } else {
#pragma unroll
                for (int i = 16 * g4; i < 16 * g4 + 16; ++i) s[i] = -INFINITY;
            }
        }
        float mn = INFINITY, mx = -INFINITY;
#pragma unroll
        for (int i = 0; i < 64; ++i) { mx = fmaxf(mx, s[i]); mn = fminf(mn, (s[i] == -INFINITY) ? INFINITY : s[i]); }
#pragma unroll
        for (int o = 1; o < 64; o <<= 1) { mx = fmaxf(mx, __shfl_xor(mx, o)); mn = fminf(mn, __shfl_xor(mn, o)); }
        const float sc = (mx > mn) ? (float)NBINS / (mx - mn) : 0.f, a0 = -mn * sc;
#pragma unroll
        for (int i = 0; i < 8; ++i) ((LAS u32x4*)hist)[lane * 8 + i] = (u32x4){0u, 0u, 0u, 0u};
        LDS_WAIT();
#define BINOF(v) clamp_bin((int)__builtin_fmaf((v), sc, a0))
#pragma unroll
        for (int g4 = 0; g4 < 4; ++g4) if (16 * g4 < ni) {
#pragma unroll
            for (int i = 16 * g4; i < 16 * g4 + 16; ++i) lds_inc(&hist[BINOF(s[i])]);
        }
        LDS_WAIT();
        int bs, need;
        {
            const LAS int* hq = hist + lane * 32;
            u32x4 hr[8];
            int loc = 0;
#pragma unroll
            for (int i = 0; i < 8; ++i) { hr[i] = ((const LAS u32x4*)hq)[i]; loc += (int)(hr[i].x + hr[i].y + hr[i].z + hr[i].w); }
            int suf = loc;
#pragma unroll
            for (int o = 1; o < 64; o <<= 1) { const int v = __shfl_down(suf, o); if (lane + o < 64) suf += v; }
            const int above = suf - loc;
            const bool cross = (above < 256 && suf >= 256);
            int bsl = 0, abl = 0;
            { int run = above;
#pragma unroll
              for (int i = 31; i >= 0; --i) { const int h = (int)hr[i >> 2][i & 3]; const bool hit = (run < 256 && run + h >= 256); bsl = hit ? lane * 32 + i : bsl; abl = hit ? run : abl; run += h; } }
            const unsigned long long cm = __ballot(cross);
            const int src = cm ? (int)__builtin_ctzll(cm) : 0;
            bs = __shfl(bsl, src); need = 256 - __shfl(abl, src);
        }
        int bs2 = -1;
#define SUBOF(v) clamp_bin((int)((__builtin_fmaf((v), sc, a0) - (float)bs) * (float)NBINS))
        if (__shfl(hist[bs], 0) > 48) {
#pragma unroll
            for (int i = 0; i < 8; ++i) ((LAS u32x4*)hist)[lane * 8 + i] = (u32x4){0u, 0u, 0u, 0u};
            LDS_WAIT();
#pragma unroll
            for (int i = 0; i < 64; ++i) if (s[i] != -INFINITY && BINOF(s[i]) == bs) lds_inc(&hist[SUBOF(s[i])]);
            LDS_WAIT();
            const LAS int* hq = hist + lane * 32;
            int loc = 0;
#pragma unroll
            for (int i = 0; i < 8; ++i) { const u32x4 h4 = ((const LAS u32x4*)hq)[i]; loc += (int)(h4.x + h4.y + h4.z + h4.w); }
            int suf = loc;
#pragma unroll
            for (int o = 1; o < 64; o <<= 1) { const int v = __shfl_down(suf, o); if (lane + o < 64) suf += v; }
            const int above = suf - loc;
            const bool cross = (above < need && suf >= need);
            int bsl = 0, abl = 0;
            if (cross) { int run = above; for (int i = 31; i >= 0; --i) { const int h = hq[i]; if (run < need && run + h >= need) { bsl = lane * 32 + i; abl = run; } run += h; } }
            const unsigned long long cm = __ballot(cross);
            const int src = cm ? (int)__builtin_ctzll(cm) : 0;
            bs2 = __shfl(bsl, src); need = need - __shfl(abl, src);
        }
        asm volatile("" : "+v"(lane));
        float sc2 = sc, a02 = a0;
        asm volatile("" : "+v"(sc2), "+v"(a02));
#undef BINOF
#define BINOF(v) clamp_bin((int)__builtin_fmaf((v), sc2, a02))
        int* selr = SEL + ((size_t)b * SEQ + t) * 256;
        int nc = 0, base = 0;
#pragma unroll
        for (int g4 = 0; g4 < 4; ++g4) if (16 * g4 < ni) {
#pragma unroll
            for (int i = 16 * g4; i < 16 * g4 + 16; ++i) {
                const int bn = BINOF(s[i]);
                bool pc = (bn == bs) && (s[i] != -INFINITY), pd = (bn > bs);
                if (bs2 >= 0) { const int sb = SUBOF(s[i]); pd = pd || (pc && sb > bs2); pc = pc && (sb == bs2); }
                const unsigned long long md = __ballot(pd), mc = __ballot(pc);
                const int posd = base + (int)__builtin_amdgcn_mbcnt_hi((unsigned)(md >> 32), __builtin_amdgcn_mbcnt_lo((unsigned)md, 0u));
                const int posc = nc + (int)__builtin_amdgcn_mbcnt_hi((unsigned)(mc >> 32), __builtin_amdgcn_mbcnt_lo((unsigned)mc, 0u));
                if (pd && posd < 256) selr[posd] = 64 * i + lane;
                if (pc && posc < CAND_CAP) { candv[posc] = s[i]; candi[posc] = 64 * i + lane; }
                base += (int)__popcll(md); nc += (int)__popcll(mc);
            }
        }
        nc = min(nc, CAND_CAP);
        LDS_WAIT();
        for (int i = lane; i < nc; i += 64) {
            const float v = candv[i]; const int id = candi[i];
            int rank = 0;
            for (int k = 0; k < nc; ++k) { const float vk = candv[k]; const int ik = candi[k]; rank += (vk > v || (vk == v && ik < id)) ? 1 : 0; }
            if (rank < need && base + rank < 256) selr[base + rank] = id;
        }
        LDS_WAIT();
#undef BINOF
#undef SUBOF
    }
}

typedef short s16x4 __attribute__((ext_vector_type(4)));
__device__ __forceinline__ unsigned vimg_f(unsigned r) { return ((r & 3u) << 2) | ((r >> 2) & 3u); }
__device__ __forceinline__ void tr_read8(const unsigned (&ad)[8], s16x4 (&r)[8]) {
    asm volatile("ds_read_b64_tr_b16 %0, %8\n\tds_read_b64_tr_b16 %1, %9\n\tds_read_b64_tr_b16 %2, %10\n\tds_read_b64_tr_b16 %3, %11\n\t"
                 "ds_read_b64_tr_b16 %4, %12\n\tds_read_b64_tr_b16 %5, %13\n\tds_read_b64_tr_b16 %6, %14\n\tds_read_b64_tr_b16 %7, %15\n\ts_waitcnt lgkmcnt(0)"
                 : "=&v"(r[0]), "=&v"(r[1]), "=&v"(r[2]), "=&v"(r[3]), "=&v"(r[4]), "=&v"(r[5]), "=&v"(r[6]), "=&v"(r[7])
                 : "v"(ad[0]), "v"(ad[1]), "v"(ad[2]), "v"(ad[3]), "v"(ad[4]), "v"(ad[5]), "v"(ad[6]), "v"(ad[7]) : "memory");
}
__device__ __forceinline__ void tr_read8_b8(const unsigned (&ad)[8], s16x4 (&r)[8]) {
    asm volatile("ds_read_b64_tr_b8 %0, %8\n\tds_read_b64_tr_b8 %1, %9\n\tds_read_b64_tr_b8 %2, %10\n\tds_read_b64_tr_b8 %3, %11\n\t"
                 "ds_read_b64_tr_b8 %4, %12\n\tds_read_b64_tr_b8 %5, %13\n\tds_read_b64_tr_b8 %6, %14\n\tds_read_b64_tr_b8 %7, %15\n\ts_waitcnt lgkmcnt(0)"
                 : "=&v"(r[0]), "=&v"(r[1]), "=&v"(r[2]), "=&v"(r[3]), "=&v"(r[4]), "=&v"(r[5]), "=&v"(r[6]), "=&v"(r[7])
                 : "v"(ad[0]), "v"(ad[1]), "v"(ad[2]), "v"(ad[3]), "v"(ad[4]), "v"(ad[5]), "v"(ad[6]), "v"(ad[7]) : "memory");
}
constexpr int ATT_WAVE_LDS = 19456;
__device__ __forceinline__ void phase_attn(const Ctx& c) {
    const bf16_t* Q = (const bf16_t*)(c.ws + WS_Q); const bf16_t* K = (const bf16_t*)(c.ws + WS_K); const bf16_t* V = (const bf16_t*)(c.ws + WS_V);
    const int* SEL = (const int*)(c.ws + WS_SEL); bf16_t* O = (bf16_t*)(c.ws + WS_O);
    LAS unsigned char* wl = c.lds + c.wave * ATT_WAVE_LDS;
    LAS int* sl = (LAS int*)wl;
    LAS unsigned short* pT = (LAS unsigned short*)(wl + 1024);
    LAS unsigned char* vb = wl + 3072;
    const int lane = c.lane, fr = lane & 15, fq = lane >> 4;
    const int gw = c.vb * 4 + c.wave, ngw = c.nb * 4;
    unsigned tro[8];
    { const unsigned row = 8u * fq + ((unsigned)fr >> 1);
#pragma unroll
      for (int c2 = 0; c2 < 8; ++c2) tro[c2] = 128u * row + 16u * ((unsigned)c2 ^ (row & 7u)) + 8u * ((unsigned)fr & 1u); }
    const unsigned vb_addr = (unsigned)(size_t)vb;
    int tcount = 0, cit = gw;
    const bool xsplit = (c.nb % 128) == 0;
    const int xg = (c.vb >> 6) & 1, wi0 = xsplit ? (((c.vb >> 7) * 64 + (c.vb & 63)) * 4 + c.wave) : gw, wstride = xsplit ? ngw / 2 : ngw;
    const unsigned chunkoff = (((unsigned)lane & 7u) ^ (((unsigned)lane >> 3) & 7u)) << 4;
    unsigned trh[8];
    { const unsigned row = 8u * (fq & 1) + ((unsigned)fr >> 1);
#pragma unroll
      for (int c2 = 0; c2 < 8; ++c2) trh[c2] = 128u * row + 16u * ((unsigned)c2 ^ (row & 7u)) + 8u * ((unsigned)fr & 1u); }
#define SEL_PREFETCH(tg_) __builtin_amdgcn_global_load_lds((const unsigned*)(SEL + (size_t)(tg_) * 256 + lane * 4), (LAS unsigned*)((LAS unsigned char*)sl + lane * 16), 16, 0, 0)
    const int task_end = xsplit ? T : T * 2;
    if (wi0 < task_end) { SEL_PREFETCH(xsplit ? wi0 : (wi0 >> 1)); }
    for (int task = wi0; task < task_end; task += wstride) {
        const int tg = xsplit ? task : (task >> 1), g = xsplit ? xg : (task & 1), b = tg >> 12, t = tg & 4095, tb = b * SEQ;
        const int nsel = min(256, t + 1), nch = (nsel + 31) >> 5;
        asm volatile("s_waitcnt vmcnt(0)" ::: "memory");
        unsigned koff[32];
#pragma unroll
        for (int q = 0; q < 32; ++q) { const int s_ = 8 * q + (lane >> 3); int idx = sl[s_]; idx = (t < 256) ? s_ : idx; idx = (s_ < nsel && (unsigned)idx <= (unsigned)t) ? idx : 0; koff[q] = (unsigned)idx * 256u + chunkoff; }
        i64x2 qf[2];
        { const unsigned char* qp = (const unsigned char*)Q + (size_t)tg * D + (4 * g + (fr >> 2)) * 128 + 16 * fq;
#pragma unroll
          for (int i = 0; i < 2; ++i) qf[i] = *(const i64x2*)(qp + 64 * i); }
        asm volatile("s_waitcnt vmcnt(0) lgkmcnt(0)" ::: "memory");
        asm volatile("" : "+v"(qf[0]), "+v"(qf[1]));
        { const int tn = task + wstride; if (tn < task_end) SEL_PREFETCH(xsplit ? tn : (tn >> 1)); }
        const unsigned char* kbase = (const unsigned char*)K + (size_t)tb * 256 + g * 128;
        const unsigned char* vbase = (const unsigned char*)V + (size_t)tb * 256 + g * 128;
#define CH_GATHER(cidx) do { const unsigned char* bp_ = ((cidx) < 16) ? kbase : vbase; _Pragma("unroll") for (int i_ = 0; i_ < 2; ++i_) { \
            unsigned o_ = koff[2 * ((cidx) & 15) + i_]; asm volatile("" : "+v"(o_));     \
            __builtin_amdgcn_global_load_lds((const unsigned*)(bp_ + o_), (LAS unsigned*)(vb + ((cidx) & 7) * 2048 + i_ * 1024 + lane * 16), 16, 0, 0); } } while (0)
        float lg[16];
#pragma unroll
        for (int c0 = 0; c0 < 6; ++c0) CH_GATHER(c0);
#pragma unroll
        for (int ch = 0; ch < 16; ++ch) {
            asm volatile("s_waitcnt lgkmcnt(0)" ::: "memory");
            CH_GATHER(ch + 6);
            asm volatile("s_waitcnt vmcnt(12)" ::: "memory");
            const LAS unsigned char* kb = vb + (ch & 7) * 2048;
            f32x4 acc = {0.f, 0.f, 0.f, 0.f};
#pragma unroll
            for (int i = 0; i < 2; ++i) { const i64x2 kf = *(const LAS i64x2*)(kb + 128u * fr + 16u * ((4u * i + fq) ^ ((unsigned)fr & 7u)));
                acc = __builtin_amdgcn_mfma_f32_16x16x32_fp8_fp8(qf[i].x, kf.x, acc, 0, 0, 0); acc = __builtin_amdgcn_mfma_f32_16x16x32_fp8_fp8(qf[i].y, kf.y, acc, 0, 0, 0); }
            lg[ch] = (ch * 16 + fr < nsel) ? acc.x * 0.08838834764831845f : -INFINITY;
        }
        float mx = lg[0];
#pragma unroll
        for (int kt = 1; kt < 16; ++kt) mx = fmaxf(mx, lg[kt]);
#pragma unroll
        for (int o = 1; o < 16; o <<= 1) mx = fmaxf(mx, __shfl_xor(mx, o));
        float sm = 0.f;
#pragma unroll
        for (int kt = 0; kt < 16; ++kt) { lg[kt] = __expf(lg[kt] - mx); sm += lg[kt]; }
#pragma unroll
        for (int o = 1; o < 16; o <<= 1) sm += __shfl_xor(sm, o);
        { const float inv = 256.f / sm;
#pragma unroll
          for (int kt = 0; kt < 16; ++kt) { const float pv = lg[kt] * inv; ((LAS unsigned char*)pT)[fq * 256 + kt * 16 + fr] = (unsigned char)(pk_fp8x4(pv, pv, pv, pv) & 0xffu); } }
        f32x4 oacc[8];
#pragma unroll
        for (int c2 = 0; c2 < 8; ++c2) oacc[c2] = (f32x4){0.f, 0.f, 0.f, 0.f};
#pragma unroll
        for (int p = 0; p < 8; ++p) {
            asm volatile("s_waitcnt lgkmcnt(0)" ::: "memory");
            if (16 + 2 * p + 6 < 32) { CH_GATHER(16 + 2 * p + 6); CH_GATHER(16 + 2 * p + 7); }
            if (p < 5) asm volatile("s_waitcnt vmcnt(12)" ::: "memory"); else if (p == 5) asm volatile("s_waitcnt vmcnt(8)" ::: "memory");
            else if (p == 6) asm volatile("s_waitcnt vmcnt(4)" ::: "memory"); else asm volatile("s_waitcnt vmcnt(0)" ::: "memory");
            if (p < nch) {
                const long pa = *(const LAS long*)((const LAS unsigned char*)pT + (fr >> 2) * 256 + 32 * p + 8 * fq);
                const unsigned cb = vb_addr + (unsigned)(((16 + 2 * p) & 7) + (fq >> 1)) * 2048u;
                unsigned ad[8]; s16x4 r0[8];
#pragma unroll
                for (int i = 0; i < 8; ++i) ad[i] = cb + trh[i];
                tr_read8_b8(ad, r0);
#pragma unroll
                for (int c2 = 0; c2 < 8; ++c2) oacc[c2] = __builtin_amdgcn_mfma_f32_16x16x32_fp8_fp8(pa, __builtin_bit_cast(long, r0[c2]), oacc[c2], 0, 0, 0);
            }
        }
        { unsigned char* op = (unsigned char*)O + (size_t)tg * D + (4 * g + fq) * 128 + fr;
#pragma unroll
          for (int c2 = 0; c2 < 8; ++c2) { const float ov = oacc[c2].x * (O8_SCALE / 256.f); op[16 * c2] = (unsigned char)(pk_fp8x4(ov, ov, ov, ov) & 0xffu); } }
        LDS_WAIT();
#undef CH_GATHER
        if ((tcount & 1) && cit < NE * 192) { convert_moe_item(c, 1, cit, vb); cit += ngw; }
        ++tcount;
    }
    for (; cit < NE * 192; cit += ngw) convert_moe_item(c, 1, cit, vb);
}

__device__ __forceinline__ void phase_b4(const Ctx& c) {
    const bf16_t* OB = (const bf16_t*)(c.ws + WS_O); const bf16_t* W = (const bf16_t*)(c.ws + WS_WBOUT); float* H = (float*)(c.ws + WS_H);
    const int fr = c.lane & 15, fq = c.lane >> 4, wr = c.wave >> 1, wc = c.wave & 1;
    for (int u = c.vb; u < 128 * 8; u += c.nb) {
        int mt, nt; map_unit(u, 8, mt, nt);
        const bf16_t* ap[4]; const bf16_t* bp[4];
        rows_regular<64>(ap, (const bf16_t*)(c.ws + WS_O + (size_t)mt * 128 * D), D / 2, c.tid); rows_regular<64>(bp, (const bf16_t*)(c.ws + WS_WBOUT + (size_t)nt * 128 * D), D / 2, c.tid);
        f32x4 acc[4][4];
#pragma unroll
        for (int m = 0; m < 4; ++m)
#pragma unroll
            for (int n = 0; n < 4; ++n) acc[m][n] = *(const f32x4*)(H + (size_t)(mt * 128 + wr * 64 + m * 16 + fr) * D + nt * 128 + wc * 64 + n * 16 + fq * 4) * (W8_SCALE * O8_SCALE);
        gemm_loop<64, 1, true, true>(c, ap, bp, bp, D / 2, acc, acc);
#pragma unroll
        for (int m = 0; m < 4; ++m)
#pragma unroll
            for (int n = 0; n < 4; ++n) *(f32x4*)(H + (size_t)(mt * 128 + wr * 64 + m * 16 + fr) * D + nt * 128 + wc * 64 + n * 16 + fq * 4) = acc[m][n] * (1.f / (W8_SCALE * O8_SCALE));
    }
}

constexpr int NPHASE = 22;
__global__ void __launch_bounds__(NTH, 2) mk_fwd(Args args) {
    extern __shared__ __attribute__((aligned(16))) unsigned char lds_raw[];
    Ctx c;
    c.lds = (LAS unsigned char*)lds_raw; c.tid = threadIdx.x; c.lane = c.tid & 63; c.wave = __builtin_amdgcn_readfirstlane(c.tid >> 6);
    c.nb = gridDim.x; { const int bx = blockIdx.x; c.vb = (c.nb % 8 == 0) ? (bx % 8) * (c.nb / 8) + bx / 8 : bx; }
    c.a = (const __attribute__((address_space(4))) Args*)__builtin_amdgcn_kernarg_segment_ptr(); c.ws = args.ws;
    volatile LAS unsigned* st = (volatile LAS unsigned*)(c.lds + LDS_MAIN + 1008);
    const bool multi = (args.ph_hi - args.ph_lo) > 1;
    XcdBarrier bar; bar.bar = (unsigned*)(c.ws + WS_CTL); bar.x = 0; bar.st = st;
    if (multi) {
        if (c.tid == 0) { st[0] = 0u; st[1] = 0u; }
        __syncthreads();
        bar = xcd_barrier_post((unsigned*)(c.ws + WS_CTL), st);
    }
    const int ph_lo = args.ph_lo, ph_hi = args.ph_hi;
#ifndef PH_MASK
#define PH_MASK 0x3fffff
#endif
#define PHON(k) ((PH_MASK >> (k)) & 1)
#define PHASE(k, body) do { if (PHON(k) && ph_lo <= (k) && (k) < ph_hi) { \
        { int t_ = threadIdx.x, vb_ = __builtin_amdgcn_readfirstlane(c.vb); \
          const __attribute__((address_space(4))) Args* ka = (const __attribute__((address_space(4))) Args*)__builtin_amdgcn_kernarg_segment_ptr(); \
          asm volatile("" : "+v"(t_), "+s"(vb_), "+s"(ka)); \
          c.tid = t_; c.lane = t_ & 63; c.wave = __builtin_amdgcn_readfirstlane(t_ >> 6); c.vb = vb_; c.a = ka; c.ws = ka->ws; } \
        body; \
        if (MK_REP == (k)) { __syncthreads(); body; } \
        if ((k) + 1 < ph_hi) xcd_barrier(bar); \
        if ((k) == 3) { for (int xb_ = 0; xb_ < MK_XBAR; ++xb_) xcd_barrier(bar); } } } while (0)
    PHASE(0, phase_prep(c));
    PHASE(1, phase_a1(c));
    PHASE(2, { if (MK_DRY == 2) { phase_a2(c, true); __syncthreads(); } phase_a2(c); });
    PHASE(3, phase_a3(c));
    PHASE(4, { if (MK_DRY == 4) { phase_route(c, 0, true); __syncthreads(); } phase_route(c, 0); });
    PHASE(5, phase_e1(c, 0));
    PHASE(6, phase_e2(c, 0));
    PHASE(7, { if (MK_DRY == 7) { phase_p1(c, 0, true); __syncthreads(); } phase_p1(c, 0); });
    PHASE(8, phase_p2(c, 0));
    PHASE(9, phase_norm_bf16(c, (const float*)c.a->in[IN_MIXN] + D));
    PHASE(10, phase_b1(c));
    PHASE(11, phase_rope(c));
    PHASE(12, phase_score(c));
    PHASE(13, phase_select(c));
    PHASE(14, phase_attn(c));
    PHASE(15, phase_b4(c));
    PHASE(16, phase_route(c, 1));
    PHASE(17, phase_e1(c, 1));
    PHASE(18, phase_e2(c, 1));
    PHASE(19, phase_p1(c, 1));
    PHASE(20, phase_p2(c, 1));
    PHASE(21, phase_final(c));
}

#ifdef MK_DUMP
__global__ void dump_k(const unsigned char* ws, float* out) {
    const size_t i = (size_t)blockIdx.x * 256 + threadIdx.x;
#if MK_DUMP == 1
    ((f32x4*)out)[i] = ((const f32x4*)(ws + WS_H))[i];
#elif MK_DUMP == 2
    { const u32x2 v = ((const u32x2*)(ws + WS_O))[i]; f32x4 o = {bf_lo(v.x), bf_hi(v.x), bf_lo(v.y), bf_hi(v.y)}; ((f32x4*)out)[i] = o; }
#elif MK_DUMP == 3
    { const int* sp = (const int*)(ws + WS_SEL); f32x4 o = {0.f,0.f,0.f,0.f}; if (i < (size_t)T * 64) { o.x = (float)sp[4*i]; o.y = (float)sp[4*i+1]; o.z = (float)sp[4*i+2]; o.w = (float)sp[4*i+3]; } ((f32x4*)out)[i] = o; }
#elif MK_DUMP == 5
    { const u32x2 v = ((const u32x2*)(ws + WS_XN))[i]; f32x4 o = {bf_lo(v.x), bf_hi(v.x), bf_lo(v.y), bf_hi(v.y)}; ((f32x4*)out)[i] = o; }
#elif MK_DUMP == 6
    { const u32x2 v = ((const u32x2*)(ws + WS_RAW))[i]; f32x4 o = {bf_lo(v.x), bf_hi(v.x), bf_lo(v.y), bf_hi(v.y)}; ((f32x4*)out)[i] = o; }
#elif MK_DUMP == 7
    { f32x4 o = {0.f,0.f,0.f,0.f}; if (i < (size_t)BINP * D / 4) { const u32x2 v = ((const u32x2*)(ws + WS_WBIN))[i]; o = (f32x4){bf_lo(v.x), bf_hi(v.x), bf_lo(v.y), bf_hi(v.y)}; } ((f32x4*)out)[i] = o; }
#elif MK_DUMP == 8
    { const u32x2 v = ((const u32x2*)(ws + WS_RAW))[i], w = ((const u32x2*)(ws + 458 * MB))[i]; f32x4 o = {bf_lo(v.x) - bf_lo(w.x), bf_hi(v.x) - bf_hi(w.x), bf_lo(v.y) - bf_lo(w.y), bf_hi(v.y) - bf_hi(w.y)}; ((f32x4*)out)[i] = o; }
#elif MK_DUMP == 9
    { const u32x2 v = ((const u32x2*)(ws + WS_RAW))[i], w = ((const u32x2*)(ws + 458 * MB))[i]; f32x4 o = {(v.x & 0xffffu) != (w.x & 0xffffu) ? 1.f : 0.f, (v.x >> 16) != (w.x >> 16) ? 1.f : 0.f, (v.y & 0xffffu) != (w.y & 0xffffu) ? 1.f : 0.f, (v.y >> 16) != (w.y >> 16) ? 1.f : 0.f}; ((f32x4*)out)[i] = o; }
#elif MK_DUMP == 4
    { const u32x2 v = ((const u32x2*)(ws + WS_Q))[i]; f32x4 o = {bf_lo(v.x), bf_hi(v.x), bf_lo(v.y), bf_hi(v.y)}; ((f32x4*)out)[i] = o; }
#endif
}
#endif
extern "C" void kernel_launch(void* const* d_in, const int* in_sizes, int n_in, void* d_out, int out_size, void* d_ws, size_t ws_size, hipStream_t stream) {
    static int grid = 0;
    if (grid == 0) {
        if (n_in != 23 || out_size != T * D || ws_size < WS_TOTAL) { fprintf(stderr, "kernel_launch: unexpected sizes n_in %d out %d ws %zu (need %zu)\n", n_in, out_size, ws_size, (size_t)WS_TOTAL); grid = -1; return; }
        int dev = 0, cus = 0, per_cu = 0;
        hipGetDevice(&dev); hipDeviceGetAttribute(&cus, hipDeviceAttributeMultiprocessorCount, dev);
        hipFuncSetAttribute((const void*)mk_fwd, hipFuncAttributeMaxDynamicSharedMemorySize, LDS_BYTES);
        hipOccupancyMaxActiveBlocksPerMultiprocessor(&per_cu, (const void*)mk_fwd, NTH, LDS_BYTES);
        (void)hipGetLastError();
        if (per_cu < 1) per_cu = 1;
        if (per_cu > 2) per_cu = 2;
        grid = cus * per_cu;
    }
    if (grid < 0) return;
    hipMemsetAsync((char*)d_ws + WS_CTL, 0, 16384, stream);
    Args a{};
    for (int i = 0; i < 23; ++i) a.in[i] = d_in[i];
    a.out = (float*)d_out; a.ws = (unsigned char*)d_ws;
#if MK_ONE_LAUNCH
    a.ph_lo = 0; a.ph_hi = NPHASE;
    hipLaunchKernelGGL(mk_fwd, dim3(grid), dim3(NTH), LDS_BYTES, stream, a);
#else
    for (int ph = 0; ph <= MK_LAST_PHASE; ++ph) { a.ph_lo = ph; a.ph_hi = ph + 1; hipLaunchKernelGGL(mk_fwd, dim3(grid), dim3(NTH), LDS_BYTES, stream, a); }
#ifdef MK_DUMP
    hipLaunchKernelGGL(dump_k, dim3(T * D / 4 / 256), dim3(256), 0, stream, (const unsigned char*)d_ws, (float*)d_out);
#endif
#endif
}
```

```cpp
#include <hip/hip_runtime.h>
#include <stdint.h>
#include <stdio.h>

#ifndef MK_LAST_PHASE
#define MK_LAST_PHASE 21
#endif
#ifndef MK_REP
#define MK_REP -1
#endif
#ifndef MK_XBAR
#define MK_XBAR 0
#endif
#ifndef MK_DRY
#define MK_DRY -1
#endif
#ifndef MK_ONE_LAUNCH
#define MK_ONE_LAUNCH 1
#endif

#define LAS __attribute__((address_space(3)))
typedef unsigned short bf16_t;
typedef short bf16x8 __attribute__((ext_vector_type(8)));
typedef float f32x4 __attribute__((ext_vector_type(4)));
typedef float f32x2 __attribute__((ext_vector_type(2)));
typedef float f32x16 __attribute__((ext_vector_type(16)));
typedef unsigned u32x4 __attribute__((ext_vector_type(4)));
typedef unsigned u32x2 __attribute__((ext_vector_type(2)));
typedef long i64x2 __attribute__((ext_vector_type(2)));

constexpr int T = 16384, D = 1024, SEQ = 4096;
constexpr int GW = 2048;
constexpr int BIN = 2120, BINP = 2176;
constexpr int NE = 32, DE = 512;
constexpr int PLE = 256;
constexpr float EPS = 1e-6f;
constexpr int NTH = 256;
constexpr int LDS_MAIN = 4 * 19456;
constexpr int LDS_BYTES = LDS_MAIN + 1024;
constexpr int RPAD = 32768 + NE * 128;

constexpr size_t MB = 1024 * 1024;
constexpr size_t WS_CTL = 0;
constexpr size_t WS_CNT = 16384;
constexpr size_t WS_WR = 32768;
constexpr size_t WS_WAIN = 1 * MB;
constexpr size_t WS_WAOUT = WS_WAIN + 8 * MB;
constexpr size_t WS_WBIN = WS_WAOUT + 4 * MB;
constexpr size_t WS_WBOUT = WS_WBIN + 5 * MB;
constexpr size_t WS_WGATE = WS_WBOUT + 2 * MB;
constexpr size_t WS_WPROJ = WS_WGATE + 4 * MB;
constexpr size_t WS_W1 = WS_WPROJ + 1 * MB;
constexpr size_t WS_XN8 = WS_W1 + 16 * MB;
constexpr size_t WS_W3 = WS_W1 + 32 * MB;
constexpr size_t WS_W2 = WS_W3 + 32 * MB;
constexpr size_t WS_PBF = WS_W2 + 32 * MB;
constexpr size_t WS_XN = WS_PBF + 16 * MB;
constexpr size_t WS_H = WS_XN + 32 * MB;
constexpr size_t WS_LIST = WS_H + 64 * MB;
constexpr size_t WS_GATE = WS_LIST + 2 * MB;
constexpr size_t WS_TOKSLOT = WS_GATE + 2 * MB;
constexpr size_t WS_SCR = WS_TOKSLOT + 1 * MB;
constexpr size_t WS_U = WS_SCR;
constexpr size_t WS_VT = WS_SCR + 64 * MB;
constexpr size_t WS_VSS = WS_SCR + 128 * MB;
constexpr size_t WS_HMID = WS_SCR;
constexpr size_t WS_Y = WS_SCR + 36 * MB;
constexpr size_t WS_RAW = WS_SCR;
constexpr size_t WS_O = WS_SCR;
constexpr size_t WS_Q = WS_SCR + 68 * MB;
constexpr size_t WS_K = WS_Q + 32 * MB;
constexpr size_t WS_V = WS_K + 8 * MB;
constexpr size_t WS_QI = WS_V + 8 * MB;
constexpr size_t WS_KI = WS_QI + 16 * MB;
constexpr size_t WS_WI = WS_KI + 2 * MB;
constexpr size_t WS_SEL = WS_WI + 1 * MB;
constexpr size_t WS_END = WS_SEL + 16 * MB;
static_assert(WS_END <= WS_SCR + 152 * MB, "scratch");
constexpr size_t WS_S = 392 * MB;
constexpr size_t WS_TOTAL = 522 * MB;

typedef __bf16 bf16x2_t __attribute__((ext_vector_type(2)));
__device__ __forceinline__ unsigned pk_bf16(float lo, float hi) { f32x2 v = {lo, hi}; bf16x2_t b = __builtin_convertvector(v, bf16x2_t); return __builtin_bit_cast(unsigned, b); }
__device__ __forceinline__ float bf_lo(unsigned u) { return __uint_as_float(u << 16); }
__device__ __forceinline__ float bf_hi(unsigned u) { return __uint_as_float(u & 0xffff0000u); }
__device__ __forceinline__ float wave_sum(float v) {
#pragma unroll
    for (int o = 1; o < 64; o <<= 1) v += __shfl_xor(v, o);
    return v;
}
__device__ __forceinline__ int lds_inc(LAS int* p) { return __hip_atomic_fetch_add(p, 1, __ATOMIC_RELAXED, __HIP_MEMORY_SCOPE_WORKGROUP); }
#define LDS_WAIT() asm volatile("s_waitcnt lgkmcnt(0)" ::: "memory")
#define VM_WAIT() asm volatile("s_waitcnt vmcnt(0)" ::: "memory")

#define XB_TMO      128
#define XB_XCNT(j)  (256  + 64 * (j))
#define XB_XSUB(j)  (1280 + 64 * (j))
#define XB_XGEN(j)  (2304 + 64 * (j))
#define XB_TOP      3328
#define XB_TOPGEN   3392
#define XCD_BAR_WORDS 3456
#define XB_SPIN_CAP (1u << 20)
__device__ __forceinline__ unsigned xb_ld(unsigned* p)              { return __hip_atomic_load(p, __ATOMIC_RELAXED, __HIP_MEMORY_SCOPE_AGENT); }
__device__ __forceinline__ unsigned xb_add(unsigned* p, unsigned v) { return __hip_atomic_fetch_add(p, v, __ATOMIC_RELAXED, __HIP_MEMORY_SCOPE_AGENT); }
__device__ __forceinline__ unsigned xb_xcc_id() { return (unsigned)__builtin_amdgcn_s_getreg((3 << 11) | 20) & 0xFu; }
#define XB_SPIN(cond, bar) do { unsigned _sp = 0; while (cond) { __builtin_amdgcn_s_sleep(1); \
    if ((++_sp & 255u) == 0u) { if (xb_ld(&(bar)[XB_TMO])) break; if (_sp > XB_SPIN_CAP) { atomicAdd(&(bar)[XB_TMO], 1u); break; } } } } while (0)
struct XcdBarrier { unsigned* bar; unsigned x; volatile LAS unsigned* st; };
__device__ __forceinline__ XcdBarrier xcd_barrier_post(unsigned* bar, volatile LAS unsigned* st) {
    XcdBarrier b; b.bar = bar; b.x = xb_xcc_id(); b.st = st;
    if (threadIdx.x == 0) (void)xb_add(&bar[XB_XCNT(b.x)], 1u);
    return b;
}
__device__ __forceinline__ void xcd_barrier_complete(unsigned* bar, unsigned x, unsigned& nloc, unsigned& nx) {
    const unsigned G = gridDim.x;
    unsigned sum, cnt, mine, sp = 0u;
    for (;;) {
        sum = 0u; cnt = 0u; mine = 0u;
#pragma unroll
        for (unsigned j = 0; j < 16; ++j) { const unsigned c = xb_ld(&bar[XB_XCNT(j)]); sum += c; cnt += (c > 0u) ? 1u : 0u; mine = (j == x) ? c : mine; }
        if (sum == G) break;
        __builtin_amdgcn_s_sleep(1);
        if ((++sp & 255u) == 0u) { if (xb_ld(&bar[XB_TMO])) break; if (sp > XB_SPIN_CAP) { atomicAdd(&bar[XB_TMO], 1u); break; } }
    }
    nloc = mine > 0u ? mine : 1u; nx = cnt > 0u ? cnt : 1u;
}
__device__ __forceinline__ void xcd_barrier(const XcdBarrier& b) {
    asm volatile("s_waitcnt vmcnt(0)" ::: "memory");
    __syncthreads();
    if (threadIdx.x == 0) {
        unsigned* bar = b.bar;
        __builtin_amdgcn_s_waitcnt(0);
        unsigned nloc = b.st[0], nx = b.st[1];
        if (nloc == 0u) { xcd_barrier_complete(bar, b.x, nloc, nx); b.st[0] = nloc; b.st[1] = nx; }
        const unsigned old = xb_add(&bar[XB_XSUB(b.x)], 1u);
        const unsigned gen = old / nloc;
        if (old + 1u == (gen + 1u) * nloc) {
            __builtin_amdgcn_fence(__ATOMIC_RELEASE, "agent");
            asm volatile("s_waitcnt vmcnt(0)" ::: "memory");
            const unsigned og = xb_add(&bar[XB_TOP], 1u);
            const unsigned tg = og / nx;
            if (og + 1u == (tg + 1u) * nx) xb_add(&bar[XB_TOPGEN], 1u);
            else XB_SPIN(xb_ld(&bar[XB_TOPGEN]) == tg, bar);
            __builtin_amdgcn_fence(__ATOMIC_ACQUIRE, "agent");
            xb_add(&bar[XB_XGEN(b.x)], 1u);
            asm volatile("s_waitcnt vmcnt(0)" ::: "memory");
        } else {
            XB_SPIN(xb_ld(&bar[XB_XGEN(b.x)]) == gen, bar);
            __builtin_amdgcn_fence(__ATOMIC_ACQUIRE, "agent");
            asm volatile("s_waitcnt vmcnt(0)" ::: "memory");
        }
    }
    __syncthreads();
}

struct Args { const void* in[23]; float* out; unsigned char* ws; int ph_lo, ph_hi; };
enum { IN_X = 0, IN_P, IN_POS, IN_MIXN, IN_AWIN, IN_AVG, IN_AWS, IN_ABS, IN_AWOUT, IN_BWIN, IN_BWOUT, IN_FFNN, IN_WG, IN_BG, IN_WE, IN_BE,
       IN_W1, IN_W3, IN_W2, IN_PLEN, IN_PLEG, IN_PLEP, IN_FINN };

struct Ctx {
    LAS unsigned char* lds;
    int tid, lane, wave, vb, nb;
    const __attribute__((address_space(4))) Args* a;
    unsigned char* ws;
};

template <int BK> struct TileK { static constexpr int NP = (BK == 64) ? 4 : 2; static constexpr int TB = 128 * BK * 2; };

template <int BK>
__device__ __forceinline__ void stage_tile(LAS unsigned char* tile, const bf16_t* const (&rp)[TileK<BK>::NP], int k0, int tid) {
    const int lc = (BK == 64) ? ((tid & 7) ^ ((tid >> 3) & 7)) : ((tid & 3) ^ ((tid >> 3) & 3));
#pragma unroll
    for (int p = 0; p < TileK<BK>::NP; ++p)
        __builtin_amdgcn_global_load_lds((const unsigned*)(rp[p] + k0 + lc * 8), (LAS unsigned*)(tile + p * 4096 + tid * 16), 16, 0, 0);
}
template <int BK>
__device__ __forceinline__ void rows_regular(const bf16_t* (&rp)[TileK<BK>::NP], const bf16_t* base, size_t ld, int tid) {
#pragma unroll
    for (int p = 0; p < TileK<BK>::NP; ++p) { const int r = (BK == 64) ? (p * 32 + (tid >> 3)) : (p * 64 + (tid >> 2)); rp[p] = base + (size_t)r * ld; }
}
template <int BK>
__device__ __forceinline__ int frag_off(int row, int ks, int fq) {
    return (BK == 64) ? (row * 128 + (((ks * 4 + fq) ^ (row & 7)) << 4)) : (row * 64 + ((fq ^ ((row >> 1) & 3)) << 4));
}

template <int BK, int NBOP, bool SWAP, bool FP8 = false>
__device__ __forceinline__ void gemm_loop(const Ctx& c, const bf16_t* const (&ap)[TileK<BK>::NP], const bf16_t* const (&b0p)[TileK<BK>::NP], const bf16_t* const (&b1p)[TileK<BK>::NP],
                                          int K, f32x4 (&acc0)[4][4], f32x4 (&acc1)[4][4]) {
    constexpr int TB = TileK<BK>::TB, SB = (1 + NBOP) * TB;
    static_assert(2 * SB <= LDS_MAIN, "lds");
    const int nk = K / BK, tid = c.tid;
    const int fr = c.lane & 15, fq = c.lane >> 4, wr = c.wave >> 1, wc = c.wave & 1;
    LAS unsigned char* lds = c.lds;
    stage_tile<BK>(lds, ap, 0, tid); stage_tile<BK>(lds + TB, b0p, 0, tid);
    if (NBOP == 2) stage_tile<BK>(lds + 2 * TB, b1p, 0, tid);
    for (int kt = 0; kt < nk; ++kt) {
        VM_WAIT();
        __syncthreads();
        LAS unsigned char* cur = lds + (kt & 1) * SB;
        if (kt + 1 < nk) {
            LAS unsigned char* nxt = lds + ((kt + 1) & 1) * SB;
            stage_tile<BK>(nxt, ap, (kt + 1) * BK, tid); stage_tile<BK>(nxt + TB, b0p, (kt + 1) * BK, tid);
            if (NBOP == 2) stage_tile<BK>(nxt + 2 * TB, b1p, (kt + 1) * BK, tid);
        }
#pragma unroll
        for (int ks = 0; ks < BK / 32; ++ks) {
            bf16x8 af[4], bf0[4], bf1[4];
#pragma unroll
            for (int m = 0; m < 4; ++m) af[m] = *(const LAS bf16x8*)(cur + frag_off<BK>(wr * 64 + m * 16 + fr, ks, fq));
#pragma unroll
            for (int n = 0; n < 4; ++n) bf0[n] = *(const LAS bf16x8*)(cur + TB + frag_off<BK>(wc * 64 + n * 16 + fr, ks, fq));
            if (NBOP == 2) {
#pragma unroll
                for (int n = 0; n < 4; ++n) bf1[n] = *(const LAS bf16x8*)(cur + 2 * TB + frag_off<BK>(wc * 64 + n * 16 + fr, ks, fq));
            }
#pragma unroll
            for (int m = 0; m < 4; ++m)
#pragma unroll
                for (int n = 0; n < 4; ++n) {
                    if (FP8) {
                        const i64x2 a2 = __builtin_bit_cast(i64x2, af[m]), b2 = __builtin_bit_cast(i64x2, bf0[n]);
                        if (SWAP) { acc0[m][n] = __builtin_amdgcn_mfma_f32_16x16x32_fp8_fp8(b2.x, a2.x, acc0[m][n], 0, 0, 0); acc0[m][n] = __builtin_amdgcn_mfma_f32_16x16x32_fp8_fp8(b2.y, a2.y, acc0[m][n], 0, 0, 0); }
                        else      { acc0[m][n] = __builtin_amdgcn_mfma_f32_16x16x32_fp8_fp8(a2.x, b2.x, acc0[m][n], 0, 0, 0); acc0[m][n] = __builtin_amdgcn_mfma_f32_16x16x32_fp8_fp8(a2.y, b2.y, acc0[m][n], 0, 0, 0); }
                        continue;
                    }
                    if (SWAP) acc0[m][n] = __builtin_amdgcn_mfma_f32_16x16x32_bf16(bf0[n], af[m], acc0[m][n], 0, 0, 0);
                    else      acc0[m][n] = __builtin_amdgcn_mfma_f32_16x16x32_bf16(af[m], bf0[n], acc0[m][n], 0, 0, 0);
                    if (NBOP == 2) {
                        if (SWAP) acc1[m][n] = __builtin_amdgcn_mfma_f32_16x16x32_bf16(bf1[n], af[m], acc1[m][n], 0, 0, 0);
                        else      acc1[m][n] = __builtin_amdgcn_mfma_f32_16x16x32_bf16(af[m], bf1[n], acc1[m][n], 0, 0, 0);
                    }
                }
        }
    }
    __syncthreads();
}
__device__ __forceinline__ void zero_acc(f32x4 (&acc)[4][4]) {
#pragma unroll
    for (int m = 0; m < 4; ++m)
#pragma unroll
        for (int n = 0; n < 4; ++n) acc[m][n] = (f32x4){0.f, 0.f, 0.f, 0.f};
}
__device__ __forceinline__ void map_unit(int u, int nnt, int& mt, int& nt) { const int per = 8 * nnt, band = u / per, r = u - band * per; nt = r >> 3; mt = band * 8 + (r & 7); }


__device__ __forceinline__ float gelu_tanh(float x) {
    const float y2 = 1.5957691216057308f * (x + 0.044715f * x * x * x);
    return x / (1.f + __expf(-y2));
}
__device__ __forceinline__ float sigmoidf_(float x) { return 1.f / (1.f + __expf(-x)); }

__device__ __forceinline__ void row_load(const float* row, int lane, f32x4 (&v)[4]) {
#pragma unroll
    for (int j = 0; j < 4; ++j) v[j] = ((const f32x4*)row)[lane + 64 * j];
}
__device__ __forceinline__ float row_sumsq(const f32x4 (&v)[4]) {
    float s = 0.f;
#pragma unroll
    for (int j = 0; j < 4; ++j) s += (v[j].x * v[j].x + v[j].y * v[j].y) + (v[j].z * v[j].z + v[j].w * v[j].w);
    return wave_sum(s);
}
__device__ __forceinline__ void gain_load(const float* gain, int lane, f32x4 (&g)[4]) {
#pragma unroll
    for (int j = 0; j < 4; ++j) g[j] = ((const f32x4*)gain)[lane + 64 * j];
}
__device__ __forceinline__ void row_store_norm_bf16(bf16_t* orow, int lane, const f32x4 (&v)[4], float r, const f32x4 (&gv)[4]) {
#pragma unroll
    for (int j = 0; j < 4; ++j) {
        const f32x4 g = gv[j];
        u32x2 o; o.x = pk_bf16(v[j].x * r * g.x, v[j].y * r * g.y); o.y = pk_bf16(v[j].z * r * g.z, v[j].w * r * g.w);
        ((u32x2*)orow)[lane + 64 * j] = o;
    }
}

__device__ __forceinline__ unsigned pk_fp8x4(float a, float b, float c_, float d);
__device__ __forceinline__ void row_store_norm_fp8(unsigned char* orow, int lane, const f32x4 (&v)[4], float r, const f32x4 (&gv)[4]) {
#pragma unroll
    for (int j = 0; j < 4; ++j) ((unsigned*)orow)[lane + 64 * j] = pk_fp8x4(v[j].x * r * gv[j].x, v[j].y * r * gv[j].y, v[j].z * r * gv[j].z, v[j].w * r * gv[j].w);
}
constexpr int TR_SCR = 64 * 136;
__device__ __forceinline__ void transpose_item(const float* W, int K, int N, int nvalid, int ldw, bf16_t* WT, LAS unsigned char* scr, int item, int lane) {
    const int nblk = N / 64, kb = item / nblk, nb = item - kb * nblk, k0 = 64 * kb, n0 = 64 * nb;
    const int n = n0 + 4 * (lane & 15);
    const int nc_ = (n < nvalid) ? n : 0; const float keep = (n < nvalid) ? 1.f : 0.f;
    f32x4 v[16];
#pragma unroll
    for (int i = 0; i < 16; ++i) v[i] = *(const f32x4*)(W + (size_t)(k0 + 4 * i + (lane >> 4)) * ldw + nc_);
#pragma unroll
    for (int i = 0; i < 16; ++i) {
        const int kk = 4 * i + (lane >> 4);
        u32x2 o; o.x = pk_bf16(v[i].x * keep, v[i].y * keep); o.y = pk_bf16(v[i].z * keep, v[i].w * keep);
        *(LAS u32x2*)(scr + kk * 136 + (lane & 15) * 8) = o;
    }
    LDS_WAIT();
    const int cc = lane & 7;
#pragma unroll
    for (int j = 0; j < 8; ++j) {
        const int nn = (lane >> 3) + 8 * j; const LAS unsigned short* sp = (const LAS unsigned short*)(scr + (8 * cc) * 136 + nn * 2);
        u32x4 o;
        o.x = (unsigned)sp[0 * 68] | ((unsigned)sp[1 * 68] << 16); o.y = (unsigned)sp[2 * 68] | ((unsigned)sp[3 * 68] << 16);
        o.z = (unsigned)sp[4 * 68] | ((unsigned)sp[5 * 68] << 16); o.w = (unsigned)sp[6 * 68] | ((unsigned)sp[7 * 68] << 16);
        *(u32x4*)(WT + (size_t)(n0 + nn) * K + k0 + 8 * cc) = o;
    }
    LDS_WAIT();
}

__device__ __forceinline__ unsigned pk_fp8x4(float a, float b, float c_, float d) {
    a = fminf(fmaxf(a, -448.f), 448.f); b = fminf(fmaxf(b, -448.f), 448.f); c_ = fminf(fmaxf(c_, -448.f), 448.f); d = fminf(fmaxf(d, -448.f), 448.f);
    int p = __builtin_amdgcn_cvt_pk_fp8_f32(a, b, 0, false);
    p = __builtin_amdgcn_cvt_pk_fp8_f32(c_, d, p, true);
    return (unsigned)p;
}
constexpr float W8_SCALE = 64.f, H8_SCALE = 4.f, O8_SCALE = 8.f;
__device__ __forceinline__ void transpose_item8(const float* W, int K, int N, unsigned char* WT, LAS unsigned char* scr, int item, int lane, int nvalid = 1 << 30, int ldw = 0) {
    const int nblk = N / 64, kb = item / nblk, nb = item - kb * nblk, k0 = 128 * kb, n0 = 64 * nb;
    const int n = n0 + 4 * (lane & 15), ld = ldw ? ldw : N, nc_ = (n < nvalid) ? n : 0; const float keep = (n < nvalid) ? W8_SCALE : 0.f;
#pragma unroll 2
    for (int h = 0; h < 2; ++h) {
        f32x4 v[16];
#pragma unroll
        for (int i = 0; i < 16; ++i) v[i] = *(const f32x4*)(W + (size_t)(k0 + 64 * h + 4 * i + (lane >> 4)) * ld + nc_);
#pragma unroll
        for (int i = 0; i < 16; ++i) { const int kk = 64 * h + 4 * i + (lane >> 4);
            *(LAS unsigned*)(scr + kk * 68 + (lane & 15) * 4) = pk_fp8x4(v[i].x * keep, v[i].y * keep, v[i].z * keep, v[i].w * keep); }
    }
    LDS_WAIT();
    const int cc = lane & 7;
#pragma unroll
    for (int j = 0; j < 8; ++j) {
        const int nn = (lane >> 3) + 8 * j; const LAS unsigned char* sp = scr + (16 * cc) * 68 + nn;
        unsigned w[4];
#pragma unroll
        for (int q = 0; q < 4; ++q) w[q] = (unsigned)sp[(4 * q + 0) * 68] | ((unsigned)sp[(4 * q + 1) * 68] << 8) | ((unsigned)sp[(4 * q + 2) * 68] << 16) | ((unsigned)sp[(4 * q + 3) * 68] << 24);
        u32x4 o = {w[0], w[1], w[2], w[3]};
        *(u32x4*)(WT + (size_t)(n0 + nn) * K + k0 + 16 * cc) = o;
    }
    LDS_WAIT();
}
__device__ __forceinline__ void convert_moe_item(const Ctx& c, int l, int it, LAS unsigned char* scr) {
    const float* w1 = (const float*)c.a->in[IN_W1] + (size_t)l * NE * D * DE;
    const float* w3 = (const float*)c.a->in[IN_W3] + (size_t)l * NE * D * DE;
    const float* w2 = (const float*)c.a->in[IN_W2] + (size_t)l * NE * DE * D;
    unsigned char* W1 = c.ws + WS_W1; unsigned char* W3 = c.ws + WS_W3; unsigned char* W2 = c.ws + WS_W2;
    const int e = it / 192, r = it - e * 192;
    if (r < 64)       transpose_item8(w1 + (size_t)e * D * DE, D, DE, W1 + (size_t)e * DE * D, scr, r, c.lane);
    else if (r < 128) transpose_item8(w3 + (size_t)e * D * DE, D, DE, W3 + (size_t)e * DE * D, scr, r - 64, c.lane);
    else              transpose_item8(w2 + (size_t)e * DE * D, DE, D, W2 + (size_t)e * D * DE, scr, r - 128, c.lane);
}
__device__ __forceinline__ void convert_moe_layer(const Ctx& c, int l) {
    LAS unsigned char* scr = c.lds + c.wave * TR_SCR;
    const int gw = c.vb * 4 + c.wave, ngw = c.nb * 4;
    for (int it = gw; it < NE * 192; it += ngw) convert_moe_item(c, l, it, scr);
}

__device__ __forceinline__ void phase_prep(const Ctx& c) {
    const __attribute__((address_space(4))) Args& a = *c.a;
    LAS unsigned char* scr = c.lds + c.wave * TR_SCR;
    const int gw = c.vb * 4 + c.wave, ngw = c.nb * 4;
    constexpr int I_AIN = 16 * 64, I_AOUT = 32 * 16, I_PP = 4 * 16, I_BIN8 = 8 * 34, I_BOUT8 = 8 * 16, I_PG8 = 8 * 16, I_BINI = 16 * 10;
    constexpr int NIT = I_AIN + I_AOUT + 2 * I_PP + I_BIN8 + I_BOUT8 + 2 * I_PG8 + I_BINI;
    for (int it = gw; it < NIT; it += ngw) {
        int r = it;
        if (r < I_AIN) { transpose_item((const float*)a.in[IN_AWIN], D, 4096, 4096, 4096, (bf16_t*)(c.ws + WS_WAIN), scr, r, c.lane); continue; } r -= I_AIN;
        if (r < I_AOUT) { transpose_item((const float*)a.in[IN_AWOUT], GW, D, D, D, (bf16_t*)(c.ws + WS_WAOUT), scr, r, c.lane); continue; } r -= I_AOUT;
        if (r < 2 * I_PP) { const int l = r / I_PP; transpose_item((const float*)a.in[IN_PLEP] + (size_t)l * PLE * D, PLE, D, D, D, (bf16_t*)(c.ws + WS_WPROJ) + (size_t)l * D * PLE, scr, r - l * I_PP, c.lane); continue; } r -= 2 * I_PP;
        if (r < I_BIN8) { transpose_item8((const float*)a.in[IN_BWIN], D, BINP, c.ws + WS_WBIN, scr, r, c.lane, BIN, BIN); continue; } r -= I_BIN8;
        if (r < I_BOUT8) { transpose_item8((const float*)a.in[IN_BWOUT], D, D, c.ws + WS_WBOUT, scr, r, c.lane); continue; } r -= I_BOUT8;
        if (r < 2 * I_PG8) { const int l = r / I_PG8; transpose_item8((const float*)a.in[IN_PLEG] + (size_t)l * D * D, D, D, c.ws + WS_WGATE + (size_t)l * D * D, scr, r - l * I_PG8, c.lane); continue; } r -= 2 * I_PG8;
        transpose_item((const float*)a.in[IN_BWIN] + 1536, D, 640, BIN - 1536, BIN, (bf16_t*)(c.ws + WS_WBIN + 3 * MB), scr, r, c.lane);
    }
    convert_moe_layer(c, 0);
    const int gt = c.vb * NTH + c.tid, ngt = c.nb * NTH;
    { const float* p = (const float*)a.in[IN_P]; bf16_t* pb = (bf16_t*)(c.ws + WS_PBF);
      for (int i = gt; i < 2 * T * PLE / 8; i += ngt) {
          const f32x4 v0 = ((const f32x4*)p)[2 * i], v1 = ((const f32x4*)p)[2 * i + 1];
          u32x4 o; o.x = pk_bf16(v0.x, v0.y); o.y = pk_bf16(v0.z, v0.w); o.z = pk_bf16(v1.x, v1.y); o.w = pk_bf16(v1.z, v1.w);
          ((u32x4*)pb)[i] = o; } }
    { float* wr = (float*)(c.ws + WS_WR);
      for (int i = gt; i < 2 * D * 48; i += ngt) {
          const int l = i / (D * 48), r = i - l * D * 48, k = r / 48, o = r - k * 48;
          float w = 0.f;
          if (o < 4) w = ((const float*)a.in[IN_WG])[(size_t)l * D * 4 + k * 4 + o];
          else if (o < 36) w = ((const float*)a.in[IN_WE])[(size_t)l * D * 32 + k * 32 + (o - 4)];
          wr[i] = w * ((const float*)a.in[IN_FFNN])[l * D + k]; } }
    if (c.vb == 0 && c.tid < 128) ((int*)(c.ws + WS_CNT))[c.tid] = 0;
    f32x4 gv[4]; gain_load((const float*)a.in[IN_MIXN], c.lane, gv);
    for (int t = gw; t < T; t += ngw) {
        f32x4 v[4]; row_load((const float*)a.in[IN_X] + (size_t)t * D, c.lane, v);
        const float r = rsqrtf(row_sumsq(v) * (1.f / D) + EPS);
        row_store_norm_bf16((bf16_t*)(c.ws + WS_XN) + (size_t)t * D, c.lane, v, r, gv);
    }
}

__device__ __forceinline__ void phase_a1(const Ctx& c) {
    const bf16_t* XN = (const bf16_t*)(c.ws + WS_XN); const bf16_t* W = (const bf16_t*)(c.ws + WS_WAIN);
    bf16_t* U = (bf16_t*)(c.ws + WS_U); bf16_t* VT = (bf16_t*)(c.ws + WS_VT); float* VSS = (float*)(c.ws + WS_VSS);
    const int fr = c.lane & 15, fq = c.lane >> 4, wr = c.wave >> 1, wc = c.wave & 1;
    for (int u = c.vb; u < 128 * 32; u += c.nb) {
        int mt, nt; map_unit(u, 32, mt, nt);
        const bf16_t* ap[4]; const bf16_t* bp[4];
        rows_regular<64>(ap, XN + (size_t)mt * 128 * D, D, c.tid); rows_regular<64>(bp, W + (size_t)nt * 128 * D, D, c.tid);
        f32x4 acc[4][4]; zero_acc(acc);
        if (nt < 16) {
            gemm_loop<64, 1, true>(c, ap, bp, bp, D, acc, acc);
#pragma unroll
            for (int m = 0; m < 4; ++m)
#pragma unroll
                for (int n = 0; n < 4; ++n) {
                    const int t = mt * 128 + wr * 64 + m * 16 + fr, col = nt * 128 + wc * 64 + n * 16 + fq * 4;
                    const f32x4 v = acc[m][n];
                    u32x2 o; o.x = pk_bf16(gelu_tanh(v.x), gelu_tanh(v.y)); o.y = pk_bf16(gelu_tanh(v.z), gelu_tanh(v.w));
                    *(u32x2*)(U + (size_t)t * GW + col) = o;
                }
        } else {
            gemm_loop<64, 1, false>(c, ap, bp, bp, D, acc, acc);
            const int vn = nt - 16;
#pragma unroll
            for (int m = 0; m < 4; ++m) {
                f32x4 ss = {0.f, 0.f, 0.f, 0.f};
                const int t0 = mt * 128 + wr * 64 + m * 16 + fq * 4;
#pragma unroll
                for (int n = 0; n < 4; ++n) {
                    const int ch = vn * 128 + wc * 64 + n * 16 + fr;
                    f32x4 v = acc[m][n];
                    v.x = gelu_tanh(v.x); v.y = gelu_tanh(v.y); v.z = gelu_tanh(v.z); v.w = gelu_tanh(v.w);
                    ss += v * v;
                    u32x2 o; o.x = pk_bf16(v.x, v.y); o.y = pk_bf16(v.z, v.w);
                    *(u32x2*)(VT + (size_t)ch * T + t0) = o;
                }
#pragma unroll
                for (int o = 1; o < 16; o <<= 1) { ss.x += __shfl_xor(ss.x, o); ss.y += __shfl_xor(ss.y, o); ss.z += __shfl_xor(ss.z, o); ss.w += __shfl_xor(ss.w, o); }
                if (fr == 0) {
                    VSS[(size_t)(t0 + 0) * 32 + vn * 2 + wc] = ss.x; VSS[(size_t)(t0 + 1) * 32 + vn * 2 + wc] = ss.y;
                    VSS[(size_t)(t0 + 2) * 32 + vn * 2 + wc] = ss.z; VSS[(size_t)(t0 + 3) * 32 + vn * 2 + wc] = ss.w;
                }
            }
        }
    }
}

__device__ __forceinline__ void phase_a2(const Ctx& c, bool dry = false) {
    const __attribute__((address_space(4))) Args& a = *c.a;
    bf16_t* U = (bf16_t*)(c.ws + WS_U); const bf16_t* VT = (const bf16_t*)(c.ws + WS_VT); const float* VSS = (const float*)(c.ws + WS_VSS);
    const float* ws_ = (const float*)a.in[IN_AWS]; const float* bs_ = (const float*)a.in[IN_ABS]; const float* vg = (const float*)a.in[IN_AVG];
    const int fr = c.lane & 15, fq = c.lane >> 4, wr = c.wave >> 1, wc = c.wave & 1, tid = c.tid;
    LAS unsigned char* lds = c.lds;
    LAS float* rl = (LAS float*)(lds + LDS_MAIN);
    for (int u = c.vb; u < 128 * 8; u += c.nb) {
        const int ci = u >> 3, g = u & 7, tokbase = ci * 128;
        __syncthreads();
        if (tid < 128) {
            const float* p = VSS + (size_t)(tokbase + tid) * 32; float s = 0.f;
#pragma unroll
            for (int i = 0; i < 8; ++i) { const f32x4 q = ((const f32x4*)p)[i]; s += (q.x + q.y) + (q.z + q.w); }
            rl[tid] = rsqrtf(s * (1.f / GW) + EPS);
        }
        __syncthreads();
        {
            const int t = tid >> 1, half = tid & 1;
            const float* wrow = ws_ + ((size_t)g * 128 + t) * 128 + half * 64;
#pragma unroll
            for (int cc = 0; cc < 8; ++cc) {
                const int s0 = half * 64 + cc * 8;
                u32x4 o;
                {
                    const f32x4 w0 = ((const f32x4*)wrow)[2 * cc], w1 = ((const f32x4*)wrow)[2 * cc + 1];
                    float e[8] = {w0.x, w0.y, w0.z, w0.w, w1.x, w1.y, w1.z, w1.w};
#pragma unroll
                    for (int i = 0; i < 8; ++i) e[i] = (s0 + i <= t) ? e[i] * rl[s0 + i] : 0.f;
                    o.x = pk_bf16(e[0], e[1]); o.y = pk_bf16(e[2], e[3]); o.z = pk_bf16(e[4], e[5]); o.w = pk_bf16(e[6], e[7]);
                }
                *(LAS u32x4*)(lds + half * 16384 + t * 128 + ((cc ^ (t & 7)) << 4)) = o;
            }
        }
        for (int hn = 0; hn < 2; ++hn) {
            const int c0 = g * 256 + hn * 128;
            const bf16_t* bp[4]; rows_regular<64>(bp, VT + (size_t)c0 * T + tokbase, T, tid);
            stage_tile<64>(lds + 32768, bp, 0, tid); stage_tile<64>(lds + 32768 + 16384, bp, 64, tid);
            VM_WAIT();
            __syncthreads();
            f32x4 acc[4][4]; zero_acc(acc);
#pragma unroll 1
            for (int kh = 0; kh < 2; ++kh)
#pragma unroll 1
                for (int ks = 0; ks < 2; ++ks) {
                    bf16x8 af[4], bf[4];
#pragma unroll
                    for (int m = 0; m < 4; ++m) af[m] = *(const LAS bf16x8*)(lds + kh * 16384 + frag_off<64>(wr * 64 + m * 16 + fr, ks, fq));
#pragma unroll
                    for (int n = 0; n < 4; ++n) bf[n] = *(const LAS bf16x8*)(lds + 32768 + kh * 16384 + frag_off<64>(wc * 64 + n * 16 + fr, ks, fq));
#pragma unroll
                    for (int m = 0; m < 4; ++m)
#pragma unroll
                        for (int n = 0; n < 4; ++n) acc[m][n] = __builtin_amdgcn_mfma_f32_16x16x32_bf16(bf[n], af[m], acc[m][n], 0, 0, 0);
                }
            u32x2 uvv[4][4]; float bsvv[4];
#pragma unroll
            for (int m = 0; m < 4; ++m) { const int tl = wr * 64 + m * 16 + fr; bsvv[m] = bs_[g * 128 + tl];
#pragma unroll
                for (int n = 0; n < 4; ++n) uvv[m][n] = *(const u32x2*)(U + (size_t)(tokbase + tl) * GW + c0 + wc * 64 + n * 16 + fq * 4); }
#pragma unroll
            for (int m = 0; m < 4; ++m) {
                const int tl = wr * 64 + m * 16 + fr; const float bsv = bsvv[m];
#pragma unroll
                for (int n = 0; n < 4; ++n) {
                    const int ch = c0 + wc * 64 + n * 16 + fq * 4;
                    const f32x4 gn = *(const f32x4*)(vg + ch);
                    u32x2* up = (u32x2*)(U + (size_t)(tokbase + tl) * GW + ch);
                    const u32x2 uv = uvv[m][n]; const f32x4 v = acc[m][n];
                    u32x2 o;
                    o.x = pk_bf16(bf_lo(uv.x) * (gn.x * v.x + bsv), bf_hi(uv.x) * (gn.y * v.y + bsv));
                    o.y = pk_bf16(bf_lo(uv.y) * (gn.z * v.z + bsv), bf_hi(uv.y) * (gn.w * v.w + bsv));
                    if (dry) *(u32x2*)(c.ws + 440 * MB + ((size_t)(tokbase + tl) * GW + ch) * 2) = o; else *up = o;
                }
            }
            __syncthreads();
        }
    }
}

__device__ __forceinline__ void phase_a3(const Ctx& c) {
    const bf16_t* Z = (const bf16_t*)(c.ws + WS_U); const bf16_t* W = (const bf16_t*)(c.ws + WS_WAOUT);
    const float* X = (const float*)c.a->in[IN_X]; float* H = (float*)(c.ws + WS_H);
    const int fr = c.lane & 15, fq = c.lane >> 4, wr = c.wave >> 1, wc = c.wave & 1;
    for (int u = c.vb; u < 128 * 8; u += c.nb) {
        int mt, nt; map_unit(u, 8, mt, nt);
        const bf16_t* ap[4]; const bf16_t* bp[4];
        rows_regular<64>(ap, Z + (size_t)mt * 128 * GW, GW, c.tid); rows_regular<64>(bp, W + (size_t)nt * 128 * GW, GW, c.tid);
        f32x4 acc[4][4];
#pragma unroll
        for (int m = 0; m < 4; ++m)
#pragma unroll
            for (int n = 0; n < 4; ++n) acc[m][n] = *(const f32x4*)(X + (size_t)(mt * 128 + wr * 64 + m * 16 + fr) * D + nt * 128 + wc * 64 + n * 16 + fq * 4);
        gemm_loop<64, 1, true>(c, ap, bp, bp, GW, acc, acc);
#pragma unroll
        for (int m = 0; m < 4; ++m)
#pragma unroll
            for (int n = 0; n < 4; ++n) *(f32x4*)(H + (size_t)(mt * 128 + wr * 64 + m * 16 + fr) * D + nt * 128 + wc * 64 + n * 16 + fq * 4) = acc[m][n];
    }
}

__device__ __forceinline__ void phase_route(const Ctx& c, int l, bool dry = false) {
    const __attribute__((address_space(4))) Args& a = *c.a;
    const float* H = (const float*)(c.ws + WS_H); bf16_t* XN = (bf16_t*)(c.ws + (dry ? 440 * MB : WS_XN));
    const float* wr_ = (const float*)(c.ws + WS_WR) + (size_t)l * D * 48;
    const float* gain = (const float*)a.in[IN_FFNN] + l * D;
    int* cnt = (int*)(c.ws + WS_CNT) + l * 32 + (dry ? 64 : 0); int* list = (int*)(c.ws + (dry ? 480 * MB : WS_LIST)); float* gatel = (float*)(c.ws + (dry ? 484 * MB : WS_GATE)); int* tokslot = (int*)(c.ws + (dry ? 488 * MB : WS_TOKSLOT));
    LAS float* rl = (LAS float*)(c.lds);
    LAS float* lgl = (LAS float*)(c.lds + 256);
    const int lane = c.lane, w = c.wave;
    f32x4 gv[4]; gain_load(gain, lane, gv);
    for (int unit = c.vb; unit < T / 32; unit += c.nb) {
        const int tok0 = unit * 32;
        __syncthreads();
        for (int i = 0; i < 8; ++i) {
            const int t = tok0 + w * 8 + i;
            f32x4 v[4]; row_load(H + (size_t)t * D, lane, v);
            const float r = rsqrtf(row_sumsq(v) * (1.f / D) + EPS);
            if (lane == 0) rl[w * 8 + i] = r;
            row_store_norm_fp8(c.ws + (dry ? 440 * MB : WS_XN8) + (size_t)t * D, lane, v, r, gv);
        }
        {
            const int th = w & 1, kh = w >> 1, m = lane & 15, q = lane >> 4;
            const float* arow = H + (size_t)(tok0 + 16 * th + m) * D + 512 * kh + 128 * q;
            const float* brow = wr_ + (size_t)(512 * kh + 128 * q) * 48 + m;
            f32x4 acc[3]; acc[0] = acc[1] = acc[2] = (f32x4){0.f, 0.f, 0.f, 0.f};
            for (int i = 0; i < 32; ++i) {
                const f32x4 av = ((const f32x4*)arow)[i];
                const float ae[4] = {av.x, av.y, av.z, av.w};
#pragma unroll
                for (int e = 0; e < 4; ++e) {
                    const float* bp = brow + (size_t)(4 * i + e) * 48;
#pragma unroll
                    for (int nt = 0; nt < 3; ++nt) acc[nt] = __builtin_amdgcn_mfma_f32_16x16x4f32(ae[e], bp[nt * 16], acc[nt], 0, 0, 0);
                }
            }
#pragma unroll
            for (int nt = 0; nt < 3; ++nt)
#pragma unroll
                for (int j = 0; j < 4; ++j) lgl[(kh * 32 + th * 16 + 4 * q + j) * 48 + nt * 16 + m] = acc[nt][j];
        }
        __syncthreads();
        if (c.tid < 32) {
            const int tt = c.tid, t = tok0 + tt; const float r = rl[tt];
            const float* bg = (const float*)a.in[IN_BG] + l * 4; const float* be = (const float*)a.in[IN_BE] + l * 32;
            float gl[4];
#pragma unroll
            for (int o = 0; o < 4; ++o) gl[o] = (lgl[tt * 48 + o] + lgl[(32 + tt) * 48 + o]) * r + bg[o];
            int gs = 0; float gm = gl[0];
#pragma unroll
            for (int o = 1; o < 4; ++o) if (gl[o] > gm) { gm = gl[o]; gs = o; }
            float gden = 0.f;
#pragma unroll
            for (int o = 0; o < 4; ++o) gden += __expf(gl[o] - gm);
            const float pg = 1.f / gden;
            float l1 = -INFINITY, l2 = -INFINITY; int i1 = 0, i2 = 0;
            for (int i = 0; i < 8; ++i) {
                const int o = 4 + gs * 8 + i;
                const float v = (lgl[tt * 48 + o] + lgl[(32 + tt) * 48 + o]) * r + be[gs * 8 + i];
                if (v > l1) { l2 = l1; i2 = i1; l1 = v; i1 = i; } else if (v > l2) { l2 = v; i2 = i; }
            }
            const float e2 = __expf(l2 - l1), inv = 1.f / (1.f + e2);
            const float g1 = pg * inv, g2 = pg * e2 * inv;
            const int ea = gs * 8 + i1, eb = gs * 8 + i2;
            const int sa = atomicAdd(&cnt[ea], 1), sb = atomicAdd(&cnt[eb], 1);
            list[ea * T + sa] = t; gatel[ea * T + sa] = g1; tokslot[2 * t] = (ea << 16) | sa;
            list[eb * T + sb] = t; gatel[eb * T + sb] = g2; tokslot[2 * t + 1] = (eb << 16) | sb;
        }
    }
}

__device__ __forceinline__ void moe_table(const Ctx& c, int l, LAS int* pst, LAS int* cn) {
    __syncthreads();
    if (c.tid == 0) {
        const int* cnt = (const int*)(c.ws + WS_CNT) + l * 32; int acc = 0;
        for (int e = 0; e < 32; ++e) { const int n = cnt[e]; cn[e] = n; pst[e] = acc; acc += (n + 127) >> 7; }
        pst[32] = acc;
    }
    __syncthreads();
}
__device__ __forceinline__ int moe_find(LAS const int* pst, int mb) { int e = 0; for (int i = 1; i < 32; ++i) e = (pst[i] <= mb) ? i : e; return e; }

__device__ __forceinline__ void phase_e1(const Ctx& c, int l) {
    const unsigned char* XN8 = c.ws + WS_XN8; const unsigned char* W1 = c.ws + WS_W1; const unsigned char* W3 = c.ws + WS_W3;
    unsigned char* HM = c.ws + WS_HMID; const int* list = (const int*)(c.ws + WS_LIST);
    LAS int* pst = (LAS int*)(c.lds + LDS_MAIN); LAS int* cn = pst + 40;
    moe_table(c, l, pst, cn);
    const int fr = c.lane & 15, fq = c.lane >> 4, wr = c.wave >> 1, wc = c.wave & 1, tid = c.tid;
    const int nunits = pst[32] * 8;
    for (int u = c.vb; u < nunits; u += c.nb) {
        const int mb = u >> 3, h0 = (u & 7) * 64, e = moe_find(pst, mb), row0 = (mb - pst[e]) * 128, count = cn[e];
        const bf16_t* ap[4]; const bf16_t* bp[4];
#pragma unroll
        for (int p = 0; p < 4; ++p) {
            int r = row0 + p * 32 + (tid >> 3); r = r < count ? r : row0; ap[p] = (const bf16_t*)(XN8 + (size_t)list[e * T + r] * D);
            const int rb = p * 32 + (tid >> 3), hid = h0 + (rb >> 6) * 32 + ((rb >> 4) & 1) * 16 + (rb & 15);
            bp[p] = (const bf16_t*)((((rb >> 5) & 1) ? W3 : W1) + ((size_t)e * DE + hid) * D);
        }
        f32x4 acc[4][4]; zero_acc(acc);
        gemm_loop<64, 1, true, true>(c, ap, bp, bp, D / 2, acc, acc);
        const float ws_ = 1.f / W8_SCALE;
#pragma unroll
        for (int m = 0; m < 4; ++m)
#pragma unroll
            for (int n = 0; n < 2; ++n) {
                const size_t row = (size_t)mb * 128 + wr * 64 + m * 16 + fr; const int col = h0 + wc * 32 + n * 16 + fq * 4;
                const f32x4 x = acc[m][n] * ws_, y = acc[m][n + 2] * (ws_ * H8_SCALE);
                *(unsigned*)(HM + row * DE + col) = pk_fp8x4(x.x * sigmoidf_(x.x) * y.x, x.y * sigmoidf_(x.y) * y.y, x.z * sigmoidf_(x.z) * y.z, x.w * sigmoidf_(x.w) * y.w);
            }
    }
}
__device__ __forceinline__ void phase_e2(const Ctx& c, int l) {
    const unsigned char* HM = c.ws + WS_HMID; const unsigned char* W2 = c.ws + WS_W2;
    bf16_t* Y = (bf16_t*)(c.ws + WS_Y); const float* gatel = (const float*)(c.ws + WS_GATE);
    LAS int* pst = (LAS int*)(c.lds + LDS_MAIN); LAS int* cn = pst + 40;
    moe_table(c, l, pst, cn);
    const int fr = c.lane & 15, fq = c.lane >> 4, wr = c.wave >> 1, wc = c.wave & 1, tid = c.tid;
    const int nunits = pst[32] * 8;
    for (int u = c.vb; u < nunits; u += c.nb) {
        const int mb = u >> 3, nt = u & 7, e = moe_find(pst, mb), row0 = (mb - pst[e]) * 128, count = cn[e];
        const bf16_t* ap[4]; const bf16_t* bp[4];
        rows_regular<64>(ap, (const bf16_t*)(HM + (size_t)mb * 128 * DE), DE / 2, tid); rows_regular<64>(bp, (const bf16_t*)(W2 + ((size_t)e * D + nt * 128) * DE), DE / 2, tid);
        f32x4 acc[4][4]; zero_acc(acc);
        gemm_loop<64, 1, true, true>(c, ap, bp, bp, DE / 2, acc, acc);
        float gtv[4];
#pragma unroll
        for (int m = 0; m < 4; ++m) { const int rl_ = wr * 64 + m * 16 + fr; gtv[m] = (row0 + rl_ < count) ? gatel[e * T + row0 + rl_] * (1.f / (W8_SCALE * H8_SCALE)) : 0.f; }
#pragma unroll
        for (int m = 0; m < 4; ++m) {
            const int rl_ = wr * 64 + m * 16 + fr; const float gt = gtv[m];
#pragma unroll
            for (int n = 0; n < 4; ++n) {
                const f32x4 v = acc[m][n] * gt;
                u32x2 o; o.x = pk_bf16(v.x, v.y); o.y = pk_bf16(v.z, v.w);
                *(u32x2*)(Y + ((size_t)mb * 128 + rl_) * D + nt * 128 + wc * 64 + n * 16 + fq * 4) = o;
            }
        }
    }
}
__device__ __forceinline__ void phase_p1(const Ctx& c, int l, bool dry = false) {
    float* H = (float*)(c.ws + WS_H); float* HO = (float*)(c.ws + (dry ? 440 * MB : WS_H)); bf16_t* XN = (bf16_t*)(c.ws + (dry ? 440 * MB : WS_XN)); const bf16_t* Y = (const bf16_t*)(c.ws + WS_Y);
    const int* tokslot = (const int*)(c.ws + WS_TOKSLOT); const float* gain = (const float*)c.a->in[IN_PLEN] + l * D;
    LAS int* pst = (LAS int*)(c.lds + LDS_MAIN); LAS int* cn = pst + 40;
    moe_table(c, l, pst, cn);
    const int gw = c.vb * 4 + c.wave, ngw = c.nb * 4, lane = c.lane;
    f32x4 gv[4]; gain_load(gain, lane, gv);
    for (int t = gw; t < T; t += ngw) {
        const int s0 = tokslot[2 * t], s1 = tokslot[2 * t + 1];
        const bf16_t* y0 = Y + ((size_t)pst[s0 >> 16] * 128 + (s0 & 0xffff)) * D; const bf16_t* y1 = Y + ((size_t)pst[s1 >> 16] * 128 + (s1 & 0xffff)) * D;
        f32x4 v[4]; row_load(H + (size_t)t * D, lane, v);
#pragma unroll
        for (int j = 0; j < 4; ++j) {
            const u32x2 a0 = ((const u32x2*)y0)[lane + 64 * j], a1 = ((const u32x2*)y1)[lane + 64 * j];
            v[j].x += bf_lo(a0.x) + bf_lo(a1.x); v[j].y += bf_hi(a0.x) + bf_hi(a1.x); v[j].z += bf_lo(a0.y) + bf_lo(a1.y); v[j].w += bf_hi(a0.y) + bf_hi(a1.y);
            ((f32x4*)(HO + (size_t)t * D))[lane + 64 * j] = v[j];
        }
        const float r = rsqrtf(row_sumsq(v) * (1.f / D) + EPS);
        row_store_norm_fp8(c.ws + (dry ? 440 * MB : WS_XN8) + (size_t)t * D, lane, v, r, gv);
    }
}
__device__ __forceinline__ void phase_p2(const Ctx& c, int l) {
    const bf16_t* XN = (const bf16_t*)(c.ws + WS_XN); const bf16_t* WG = (const bf16_t*)(c.ws + WS_WGATE) + (size_t)l * D * D;
    const bf16_t* PB = (const bf16_t*)(c.ws + WS_PBF) + (size_t)l * T * PLE; const bf16_t* WP = (const bf16_t*)(c.ws + WS_WPROJ) + (size_t)l * D * PLE;
    float* H = (float*)(c.ws + WS_H);
    const int fr = c.lane & 15, fq = c.lane >> 4, wr = c.wave >> 1, wc = c.wave & 1;
    for (int u = c.vb; u < 128 * 8; u += c.nb) {
        int mt, nt; map_unit(u, 8, mt, nt);
        const bf16_t* ap[4]; const bf16_t* bp[4];
        f32x4 ag[4][4], apj[4][4]; zero_acc(ag); zero_acc(apj);
        rows_regular<64>(ap, (const bf16_t*)(c.ws + WS_XN8 + (size_t)mt * 128 * D), D / 2, c.tid); rows_regular<64>(bp, (const bf16_t*)(c.ws + WS_WGATE + ((size_t)l * D + nt * 128) * D), D / 2, c.tid);
        gemm_loop<64, 1, true, true>(c, ap, bp, bp, D / 2, ag, ag);
        rows_regular<64>(ap, PB + (size_t)mt * 128 * PLE, PLE, c.tid); rows_regular<64>(bp, WP + (size_t)nt * 128 * PLE, PLE, c.tid);
        gemm_loop<64, 1, true>(c, ap, bp, bp, PLE, apj, apj);
        f32x4 hres[4][4];
#pragma unroll
        for (int m = 0; m < 4; ++m)
#pragma unroll
            for (int n = 0; n < 4; ++n) hres[m][n] = *(const f32x4*)(H + (size_t)(mt * 128 + wr * 64 + m * 16 + fr) * D + nt * 128 + wc * 64 + n * 16 + fq * 4);
#pragma unroll
        for (int m = 0; m < 4; ++m)
#pragma unroll
            for (int n = 0; n < 4; ++n) {
                const size_t off = (size_t)(mt * 128 + wr * 64 + m * 16 + fr) * D + nt * 128 + wc * 64 + n * 16 + fq * 4;
                const f32x4 g = ag[m][n] * (1.f / W8_SCALE), pj = apj[m][n]; f32x4 h = hres[m][n];
                h.x += sigmoidf_(g.x) * pj.x; h.y += sigmoidf_(g.y) * pj.y; h.z += sigmoidf_(g.z) * pj.z; h.w += sigmoidf_(g.w) * pj.w;
                *(f32x4*)(H + off) = h;
            }
    }
}
__device__ __forceinline__ void phase_norm_bf16(const Ctx& c, const float* gain) {
    const float* H = (const float*)(c.ws + WS_H);
    const int gw = c.vb * 4 + c.wave, ngw = c.nb * 4;
    f32x4 gv[4]; gain_load(gain, c.lane, gv);
    for (int t = gw; t < T; t += ngw) {
        f32x4 v[4]; row_load(H + (size_t)t * D, c.lane, v);
        const float r = rsqrtf(row_sumsq(v) * (1.f / D) + EPS);
        row_store_norm_fp8(c.ws + WS_XN8 + (size_t)t * D, c.lane, v, r, gv);
        row_store_norm_bf16((bf16_t*)(c.ws + WS_XN) + (size_t)t * D, c.lane, v, r, gv);
    }
}
__device__ __forceinline__ void phase_final(const Ctx& c) {
    const float* H = (const float*)(c.ws + WS_H); float* O = c.a->out; const float* gain = (const float*)c.a->in[IN_FINN];
    const int gw = c.vb * 4 + c.wave, ngw = c.nb * 4;
    f32x4 gv[4]; gain_load(gain, c.lane, gv);
    for (int t = gw; t < T; t += ngw) {
        f32x4 v[4]; row_load(H + (size_t)t * D, c.lane, v);
        const float r = rsqrtf(row_sumsq(v) * (1.f / D) + EPS);
#pragma unroll
        for (int j = 0; j < 4; ++j) ((f32x4*)(O + (size_t)t * D))[c.lane + 64 * j] = v[j] * r * gv[j];
    }
}

__device__ __forceinline__ void phase_b1(const Ctx& c, size_t raw_off = WS_RAW) {
    const bf16_t* XN = (const bf16_t*)(c.ws + WS_XN); const bf16_t* W = (const bf16_t*)(c.ws + WS_WBIN); bf16_t* RAW = (bf16_t*)(c.ws + raw_off);
    const int fr = c.lane & 15, fq = c.lane >> 4, wr = c.wave >> 1, wc = c.wave & 1;
    for (int u = c.vb; u < 128 * 17; u += c.nb) {
        int mt, nt; map_unit(u, 17, mt, nt);
        const bf16_t* ap[4]; const bf16_t* bp[4];
        f32x4 acc[4][4]; zero_acc(acc);
        float osc = 1.f;
        if (nt < 12) {
            rows_regular<64>(ap, (const bf16_t*)(c.ws + WS_XN8 + (size_t)mt * 128 * D), D / 2, c.tid); rows_regular<64>(bp, (const bf16_t*)(c.ws + WS_WBIN + (size_t)nt * 128 * D), D / 2, c.tid);
            gemm_loop<64, 1, true, true>(c, ap, bp, bp, D / 2, acc, acc);
            osc = 1.f / W8_SCALE;
        } else {
            rows_regular<64>(ap, XN + (size_t)mt * 128 * D, D, c.tid); rows_regular<64>(bp, (const bf16_t*)(c.ws + WS_WBIN + 3 * MB) + (size_t)(nt - 12) * 128 * D, D, c.tid);
            gemm_loop<64, 1, true>(c, ap, bp, bp, D, acc, acc);
        }
#pragma unroll
        for (int m = 0; m < 4; ++m)
#pragma unroll
            for (int n = 0; n < 4; ++n) {
                const f32x4 v = acc[m][n] * osc; u32x2 o; o.x = pk_bf16(v.x, v.y); o.y = pk_bf16(v.z, v.w);
                *(u32x2*)(RAW + (size_t)(mt * 128 + wr * 64 + m * 16 + fr) * BINP + nt * 128 + wc * 64 + n * 16 + fq * 4) = o;
            }
    }
}

__device__ __forceinline__ void unpack8(const u32x4 r, float (&e)[8]) { e[0] = bf_lo(r.x); e[1] = bf_hi(r.x); e[2] = bf_lo(r.y); e[3] = bf_hi(r.y); e[4] = bf_lo(r.z); e[5] = bf_hi(r.z); e[6] = bf_lo(r.w); e[7] = bf_hi(r.w); }
__device__ __forceinline__ u32x4 pack8(const float (&e)[8]) { u32x4 o; o.x = pk_bf16(e[0], e[1]); o.y = pk_bf16(e[2], e[3]); o.z = pk_bf16(e[4], e[5]); o.w = pk_bf16(e[6], e[7]); return o; }
__device__ __forceinline__ void phase_rope(const Ctx& c) {
    const bf16_t* RAW = (const bf16_t*)(c.ws + WS_RAW);
    bf16_t* Q = (bf16_t*)(c.ws + WS_Q); bf16_t* K = (bf16_t*)(c.ws + WS_K); bf16_t* V = (bf16_t*)(c.ws + WS_V);
    bf16_t* QI = (bf16_t*)(c.ws + WS_QI); bf16_t* KI = (bf16_t*)(c.ws + WS_KI); float* WI = (float*)(c.ws + WS_WI);
    const int* pos = (const int*)c.a->in[IN_POS];
    LAS float* cs = (LAS float*)(c.lds + c.wave * 256);
    const int gw = c.vb * 4 + c.wave, ngw = c.nb * 4, lane = c.lane;
    for (int t = gw; t < T; t += ngw) {
        if (lane < 24) {
            const double ex = (lane < 16) ? (double)lane * (1.0 / 16.0) : (double)(lane - 16) * (1.0 / 8.0);
            const float invf = (float)exp2(-ex * 18.931568569324174);
            const float ang = (float)pos[t] * invf;
            const double ad = (double)ang; const double n = rint(ad * 0.15915494309189535); const float red = (float)(ad - n * 6.283185307179586);
            cs[lane] = cosf(red); cs[32 + lane] = sinf(red);
        }
        LDS_WAIT();
        const bf16_t* row = RAW + (size_t)t * BINP;
        for (int ch = lane; ch < BINP / 8; ch += 64) {
            const u32x4 own = ((const u32x4*)row)[ch];
            float e[8]; unpack8(own, e);
            if (ch < 160) {
                const int cc = ch & 15;
                if (cc < 4) {
                    const u32x4 oth = ((const u32x4*)row)[ch ^ 2]; float p[8]; unpack8(oth, p);
                    const int f0 = (cc & 1) * 8;
#pragma unroll
                    for (int i = 0; i < 8; ++i) { const float co = cs[f0 + i], si = cs[32 + f0 + i]; e[i] = (cc < 2) ? (e[i] * co - p[i] * si) : (e[i] * co + p[i] * si); }
                }
                u32x2 o8; o8.x = pk_fp8x4(e[0], e[1], e[2], e[3]); o8.y = pk_fp8x4(e[4], e[5], e[6], e[7]);
                if (ch < 128) ((u32x2*)((unsigned char*)Q + (size_t)t * D))[ch] = o8;
                else ((u32x2*)((unsigned char*)K + (size_t)t * 256))[ch - 128] = o8;
            } else if (ch < 192) {
                u32x2 o8; o8.x = pk_fp8x4(e[0], e[1], e[2], e[3]); o8.y = pk_fp8x4(e[4], e[5], e[6], e[7]);
                ((u32x2*)((unsigned char*)V + (size_t)t * 256))[ch - 160] = o8;
            } else if (ch < 264) {
                const int cc = ch & 7;
                if (cc < 2) {
                    const u32x4 oth = ((const u32x4*)row)[ch ^ 1]; float p[8]; unpack8(oth, p);
#pragma unroll
                    for (int i = 0; i < 8; ++i) { const float co = cs[16 + i], si = cs[32 + 16 + i]; e[i] = (cc == 0) ? (e[i] * co - p[i] * si) : (e[i] * co + p[i] * si); }
                }
                if (ch < 256) ((u32x4*)(QI + (size_t)t * 512))[ch - 192] = pack8(e);
                else ((u32x4*)(KI + (size_t)t * 64))[ch - 256] = pack8(e);
            } else if (ch == 264) {
                f32x4 w0 = {e[0], e[1], e[2], e[3]}, w1 = {e[4], e[5], e[6], e[7]};
                const float sc = 0.044194173824159216f;
                ((f32x4*)(WI + (size_t)t * 8))[0] = w0 * sc; ((f32x4*)(WI + (size_t)t * 8))[1] = w1 * sc;
            }
        }
        LDS_WAIT();
    }
}

__device__ __forceinline__ size_t srow_off(int t) { const int m = t >> 6, r = t & 63; return (size_t)64 * (m + 1) * (32 * m + r); }
constexpr size_t S_BATCH = (size_t)64 * 65 * 2048;
constexpr int SCORE_UNITS = 4 * 312;
__device__ __forceinline__ void phase_score(const Ctx& c) {
    const bf16_t* QI = (const bf16_t*)(c.ws + WS_QI); const bf16_t* KI = (const bf16_t*)(c.ws + WS_KI); const float* WI = (const float*)(c.ws + WS_WI);
    float* S = (float*)(c.ws + WS_S);
    const int lane = c.lane, hf = lane >> 5, col = lane & 31, w = c.wave;
    for (int u = c.vb; u < SCORE_UNITS; u += c.nb) {
        const int b = u & 3, r = u >> 2;
        int kc, qb;
        if (r < 120) { kc = 0; qb = 8 + r; } else if (r < 216) { kc = 1; qb = 32 + (r - 120); } else if (r < 280) { kc = 2; qb = 64 + (r - 216); } else { kc = 3; qb = 96 + (r - 280); }
        const int tb = b * SEQ, t0 = 32 * qb + 8 * w;
        bf16x8 af[2][4]; f32x4 wv[2][4];
        { const int rho = lane & 31, ql = 2 * ((rho >> 2) & 1) + (rho >> 4), hd = 4 * ((rho >> 3) & 1) + (rho & 3);
#pragma unroll
          for (int a = 0; a < 2; ++a) {
              const bf16_t* qp = QI + (size_t)(tb + t0 + 4 * a + ql) * 512 + hd * 64 + 8 * hf;
#pragma unroll
              for (int ks = 0; ks < 4; ++ks) af[a][ks] = *(const bf16x8*)(qp + 16 * ks);
              const float* wp = WI + (size_t)(tb + t0 + 4 * a + 2 * hf) * 8;
#pragma unroll
              for (int i = 0; i < 4; ++i) wv[a][i] = ((const f32x4*)wp)[i];
          } }
        const int ntile = min(32, qb + 1 - 32 * kc), key0 = 1024 * kc;
        float* Sb = S + (size_t)b * S_BATCH;
        size_t ro[2][2];
#pragma unroll
        for (int a = 0; a < 2; ++a) { ro[a][0] = srow_off(t0 + 4 * a + 2 * hf); ro[a][1] = srow_off(t0 + 4 * a + 2 * hf + 1); }
        const int nsub = (ntile + 3) >> 2;
        const bf16_t* krp[4];
        rows_regular<64>(krp, KI + (size_t)(tb + key0) * 64, 64, c.tid);
        __syncthreads();
        stage_tile<64>(c.lds, krp, 0, c.tid);
        for (int sc = 0; sc < nsub; ++sc) {
            VM_WAIT();
            __syncthreads();
            const LAS unsigned char* cur = c.lds + (sc & 1) * 16384;
            if (sc + 1 < nsub) stage_tile<64>(c.lds + ((sc + 1) & 1) * 16384, krp, (sc + 1) * 128 * 64, c.tid);
#pragma unroll
            for (int j = 0; j < 4; ++j) {
                const int kt = 4 * sc + j;
                if (kt < ntile) {
                    const int key = key0 + 32 * kt + col, row = 32 * j + col;
                    bf16x8 cb[4];
#pragma unroll
                    for (int ks = 0; ks < 4; ++ks) cb[ks] = *(const LAS bf16x8*)(cur + row * 128 + (((2 * ks + hf) ^ (row & 7)) << 4));
#pragma unroll
                    for (int a = 0; a < 2; ++a) {
                        f32x16 acc = {};
#pragma unroll
                        for (int ks = 0; ks < 4; ++ks) acc = __builtin_amdgcn_mfma_f32_32x32x16_bf16(af[a][ks], cb[ks], acc, 0, 0, 0);
                        float s0 = fmaxf(acc[0], 0.f) * wv[a][0].x; s0 += fmaxf(acc[1], 0.f) * wv[a][0].y; s0 += fmaxf(acc[2], 0.f) * wv[a][0].z; s0 += fmaxf(acc[3], 0.f) * wv[a][0].w;
                        s0 += fmaxf(acc[4], 0.f) * wv[a][1].x; s0 += fmaxf(acc[5], 0.f) * wv[a][1].y; s0 += fmaxf(acc[6], 0.f) * wv[a][1].z; s0 += fmaxf(acc[7], 0.f) * wv[a][1].w;
                        float s1 = fmaxf(acc[8], 0.f) * wv[a][2].x; s1 += fmaxf(acc[9], 0.f) * wv[a][2].y; s1 += fmaxf(acc[10], 0.f) * wv[a][2].z; s1 += fmaxf(acc[11], 0.f) * wv[a][2].w;
                        s1 += fmaxf(acc[12], 0.f) * wv[a][3].x; s1 += fmaxf(acc[13], 0.f) * wv[a][3].y; s1 += fmaxf(acc[14], 0.f) * wv[a][3].z; s1 += fmaxf(acc[15], 0.f) * wv[a][3].w;
                        const int tA = t0 + 4 * a + 2 * hf;
                        Sb[ro[a][0] + key] = (key <= tA) ? s0 : -INFINITY;
                        Sb[ro[a][1] + key] = (key <= tA + 1) ? s1 : -INFINITY;
                    }
                }
            }
        }
    }
}

constexpr int NBINS = 2048, CAND_CAP = 256, SEL_WAVE_LDS = 8192 + 2048 + 64;
__device__ __forceinline__ int clamp_bin(int x) { return min(max(x, 0), NBINS - 1); }
__device__ __forceinline__ void phase_select(const Ctx& c) {
    const float* S = (const float*)(c.ws + WS_S); int* SEL = (int*)(c.ws + WS_SEL);
    LAS int* hist = (LAS int*)(c.lds + c.wave * SEL_WAVE_LDS);
    LAS float* candv = (LAS float*)(hist + NBINS);
    LAS int* candi = (LAS int*)(candv + CAND_CAP);
    LAS int* thr = candi + CAND_CAP;
    const int gw = c.vb * 4 + c.wave, ngw = c.nb * 4;
    for (int j = gw; j < 4 * 3840; j += ngw) {
        int lane = c.lane;
        asm volatile("" : "+v"(lane));
        const int b = j & 3, t = 4095 - (j >> 2), ni = (t + 64) >> 6;
        const float* row = S + (size_t)b * S_BATCH + srow_off(t);
        float s[64];
#pragma unroll
        for (int g4 = 0; g4 < 4; ++g4) {
            if (16 * g4 < ni) {
#pragma unroll
                for (int i = 16 * g4; i < 16 * g4 + 16; ++i) { const int k = 64 * i + lane; const float v = row[min(k, t)]; s[i] = (k <= t) ? v : -INFINITY; }
            } else {
#pragma unroll
                for (int i = 16 * g4; i < 16 * g4 + 16; ++i) s[i] = -INFINITY;
            }
        }
        float mn = INFINITY, mx = -INFINITY;
#pragma unroll
        for (int g8 = 0; g8 < 8; ++g8) if (8 * g8 < ni) {
#pragma unroll
            for (int i = 8 * g8; i < 8 * g8 + 8; ++i) { mx = fmaxf(mx, s[i]); mn = fminf(mn, (s[i] == -INFINITY) ? INFINITY : s[i]); }
        }
#pragma unroll
        for (int o = 1; o < 64; o <<= 1) { mx = fmaxf(mx, __shfl_xor(mx, o)); mn = fminf(mn, __shfl_xor(mn, o)); }
        const float sc = (mx > mn) ? (float)NBINS / (mx - mn) : 0.f, a0 = -mn * sc;
#pragma unroll
        for (int i = 0; i < 8; ++i) ((LAS u32x4*)hist)[lane * 8 + i] = (u32x4){0u, 0u, 0u, 0u};
        LDS_WAIT();
#define BINOF(v) clamp_bin((int)__builtin_fmaf((v), sc, a0))
#pragma unroll
        for (int g8 = 0; g8 < 8; ++g8) if (8 * g8 < ni) {
#pragma unroll
            for (int i = 8 * g8; i < 8 * g8 + 8; ++i) lds_inc(&hist[BINOF(s[i])]);
        }
        LDS_WAIT();
        int bs, need;
        {
            const LAS int* hq = hist + lane * 32;
            u32x4 hr[8];
            int loc = 0;
#pragma unroll
            for (int i = 0; i < 8; ++i) { hr[i] = ((const LAS u32x4*)hq)[i]; loc += (int)(hr[i].x + hr[i].y + hr[i].z + hr[i].w); }
            int suf = loc;
#pragma unroll
            for (int o = 1; o < 64; o <<= 1) { const int v = __shfl_down(suf, o); if (lane + o < 64) suf += v; }
            const int above = suf - loc;
            const bool cross = (above < 256 && suf >= 256);
            int bsl = 0, abl = 0;
            { int run = above;
#pragma unroll
              for (int i = 31; i >= 0; --i) { const int h = (int)hr[i >> 2][i & 3]; const bool hit = (run < 256 && run + h >= 256); bsl = hit ? lane * 32 + i : bsl; abl = hit ? run : abl; run += h; } }
            const unsigned long long cm = __ballot(cross);
            const int src = cm ? (int)__builtin_ctzll(cm) : 0;
            bs = __shfl(bsl, src); need = 256 - __shfl(abl, src);
        }
        int bs2 = -1;
#define SUBOF(v) clamp_bin((int)((__builtin_fmaf((v), sc, a0) - (float)bs) * (float)NBINS))
        if (__shfl(hist[bs], 0) > 48) {
#pragma unroll
            for (int i = 0; i < 8; ++i) ((LAS u32x4*)hist)[lane * 8 + i] = (u32x4){0u, 0u, 0u, 0u};
            LDS_WAIT();
#pragma unroll
            for (int i = 0; i < 64; ++i) if (s[i] != -INFINITY && BINOF(s[i]) == bs) lds_inc(&hist[SUBOF(s[i])]);
            LDS_WAIT();
            const LAS int* hq = hist + lane * 32;
            int loc = 0;
#pragma unroll
            for (int i = 0; i < 8; ++i) { const u32x4 h4 = ((const LAS u32x4*)hq)[i]; loc += (int)(h4.x + h4.y + h4.z + h4.w); }
            int suf = loc;
#pragma unroll
            for (int o = 1; o < 64; o <<= 1) { const int v = __shfl_down(suf, o); if (lane + o < 64) suf += v; }
            const int above = suf - loc;
            const bool cross = (above < need && suf >= need);
            int bsl = 0, abl = 0;
            if (cross) { int run = above; for (int i = 31; i >= 0; --i) { const int h = hq[i]; if (run < need && run + h >= need) { bsl = lane * 32 + i; abl = run; } run += h; } }
            const unsigned long long cm = __ballot(cross);
            const int src = cm ? (int)__builtin_ctzll(cm) : 0;
            bs2 = __shfl(bsl, src); need = need - __shfl(abl, src);
        }
        asm volatile("" : "+v"(lane));
        float sc2 = sc, a02 = a0;
        asm volatile("" : "+v"(sc2), "+v"(a02));
#undef BINOF
#define BINOF(v) clamp_bin((int)__builtin_fmaf((v), sc2, a02))
        int* selr = SEL + ((size_t)b * SEQ + t) * 256;
        int nc = 0, base = 0;
#pragma unroll
        for (int g4 = 0; g4 < 4; ++g4) if (16 * g4 < ni) {
#pragma unroll
            for (int i = 16 * g4; i < 16 * g4 + 16; ++i) {
                const int bn = BINOF(s[i]);
                bool pc = (bn == bs) && (s[i] != -INFINITY), pd = (bn > bs);
                if (bs2 >= 0) { const int sb = SUBOF(s[i]); pd = pd || (pc && sb > bs2); pc = pc && (sb == bs2); }
                const unsigned long long md = __ballot(pd), mc = __ballot(pc);
                const int posd = base + (int)__builtin_amdgcn_mbcnt_hi((unsigned)(md >> 32), __builtin_amdgcn_mbcnt_lo((unsigned)md, 0u));
                const int posc = nc + (int)__builtin_amdgcn_mbcnt_hi((unsigned)(mc >> 32), __builtin_amdgcn_mbcnt_lo((unsigned)mc, 0u));
                if (pd && posd < 256) selr[posd] = 64 * i + lane;
                if (pc && posc < CAND_CAP) { candv[posc] = s[i]; candi[posc] = 64 * i + lane; }
                base += (int)__popcll(md); nc += (int)__popcll(mc);
            }
        }
        nc = min(nc, CAND_CAP);
        LDS_WAIT();
        for (int i = lane; i < nc; i += 64) {
            const float v = candv[i]; const int id = candi[i];
            int rank = 0;
            for (int k = 0; k < nc; ++k) { const float vk = candv[k]; const int ik = candi[k]; rank += (vk > v || (vk == v && ik < id)) ? 1 : 0; }
            if (rank < need && base + rank < 256) selr[base + rank] = id;
        }
        LDS_WAIT();
#undef BINOF
#undef SUBOF
    }
}

typedef short s16x4 __attribute__((ext_vector_type(4)));
__device__ __forceinline__ unsigned vimg_f(unsigned r) { return ((r & 3u) << 2) | ((r >> 2) & 3u); }
__device__ __forceinline__ void tr_read8(const unsigned (&ad)[8], s16x4 (&r)[8]) {
    asm volatile("ds_read_b64_tr_b16 %0, %8\n\tds_read_b64_tr_b16 %1, %9\n\tds_read_b64_tr_b16 %2, %10\n\tds_read_b64_tr_b16 %3, %11\n\t"
                 "ds_read_b64_tr_b16 %4, %12\n\tds_read_b64_tr_b16 %5, %13\n\tds_read_b64_tr_b16 %6, %14\n\tds_read_b64_tr_b16 %7, %15\n\ts_waitcnt lgkmcnt(0)"
                 : "=&v"(r[0]), "=&v"(r[1]), "=&v"(r[2]), "=&v"(r[3]), "=&v"(r[4]), "=&v"(r[5]), "=&v"(r[6]), "=&v"(r[7])
                 : "v"(ad[0]), "v"(ad[1]), "v"(ad[2]), "v"(ad[3]), "v"(ad[4]), "v"(ad[5]), "v"(ad[6]), "v"(ad[7]) : "memory");
}
__device__ __forceinline__ void tr_read8_b8(const unsigned (&ad)[8], s16x4 (&r)[8]) {
    asm volatile("ds_read_b64_tr_b8 %0, %8\n\tds_read_b64_tr_b8 %1, %9\n\tds_read_b64_tr_b8 %2, %10\n\tds_read_b64_tr_b8 %3, %11\n\t"
                 "ds_read_b64_tr_b8 %4, %12\n\tds_read_b64_tr_b8 %5, %13\n\tds_read_b64_tr_b8 %6, %14\n\tds_read_b64_tr_b8 %7, %15\n\ts_waitcnt lgkmcnt(0)"
                 : "=&v"(r[0]), "=&v"(r[1]), "=&v"(r[2]), "=&v"(r[3]), "=&v"(r[4]), "=&v"(r[5]), "=&v"(r[6]), "=&v"(r[7])
                 : "v"(ad[0]), "v"(ad[1]), "v"(ad[2]), "v"(ad[3]), "v"(ad[4]), "v"(ad[5]), "v"(ad[6]), "v"(ad[7]) : "memory");
}
constexpr int ATT_WAVE_LDS = 19456;
__device__ __forceinline__ void phase_attn(const Ctx& c) {
    const bf16_t* Q = (const bf16_t*)(c.ws + WS_Q); const bf16_t* K = (const bf16_t*)(c.ws + WS_K); const bf16_t* V = (const bf16_t*)(c.ws + WS_V);
    const int* SEL = (const int*)(c.ws + WS_SEL); bf16_t* O = (bf16_t*)(c.ws + WS_O);
    LAS unsigned char* wl = c.lds + c.wave * ATT_WAVE_LDS;
    LAS int* sl = (LAS int*)wl;
    LAS unsigned short* pT = (LAS unsigned short*)(wl + 1024);
    LAS unsigned char* vb = wl + 3072;
    const int lane = c.lane, fr = lane & 15, fq = lane >> 4;
    const int gw = c.vb * 4 + c.wave, ngw = c.nb * 4;
    unsigned tro[8];
    { const unsigned row = 8u * fq + ((unsigned)fr >> 1);
#pragma unroll
      for (int c2 = 0; c2 < 8; ++c2) tro[c2] = 128u * row + 16u * ((unsigned)c2 ^ (row & 7u)) + 8u * ((unsigned)fr & 1u); }
    const unsigned vb_addr = (unsigned)(size_t)vb;
    int tcount = 0, cit = gw;
    const bool xsplit = (c.nb % 128) == 0;
    const int xg = (c.vb >> 6) & 1, wi0 = xsplit ? (((c.vb >> 7) * 64 + (c.vb & 63)) * 4 + c.wave) : gw, wstride = xsplit ? ngw / 2 : ngw;
    const unsigned chunkoff = (((unsigned)lane & 7u) ^ (((unsigned)lane >> 3) & 7u)) << 4;
    unsigned trh[8];
    { const unsigned row = 8u * (fq & 1) + ((unsigned)fr >> 1);
#pragma unroll
      for (int c2 = 0; c2 < 8; ++c2) trh[c2] = 128u * row + 16u * ((unsigned)c2 ^ (row & 7u)) + 8u * ((unsigned)fr & 1u); }
#define SEL_PREFETCH(tg_) __builtin_amdgcn_global_load_lds((const unsigned*)(SEL + (size_t)(tg_) * 256 + lane * 4), (LAS unsigned*)((LAS unsigned char*)sl + lane * 16), 16, 0, 0)
    const int task_end = xsplit ? T : T * 2;
    if (wi0 < task_end) { SEL_PREFETCH(xsplit ? wi0 : (wi0 >> 1)); }
    for (int task = wi0; task < task_end; task += wstride) {
        const int tg = xsplit ? task : (task >> 1), g = xsplit ? xg : (task & 1), b = tg >> 12, t = tg & 4095, tb = b * SEQ;
        const int nsel = min(256, t + 1), nch = (nsel + 31) >> 5;
        asm volatile("s_waitcnt vmcnt(0)" ::: "memory");
        unsigned koff[32];
#pragma unroll
        for (int q = 0; q < 32; ++q) { const int s_ = 8 * q + (lane >> 3); int idx = sl[s_]; idx = (t < 256) ? s_ : idx; idx = (s_ < nsel && (unsigned)idx <= (unsigned)t) ? idx : 0; koff[q] = (unsigned)idx * 256u + chunkoff; }
        i64x2 qf[2];
        { const unsigned char* qp = (const unsigned char*)Q + (size_t)tg * D + (4 * g + (fr >> 2)) * 128 + 16 * fq;
#pragma unroll
          for (int i = 0; i < 2; ++i) qf[i] = *(const i64x2*)(qp + 64 * i); }
        asm volatile("s_waitcnt vmcnt(0) lgkmcnt(0)" ::: "memory");
        asm volatile("" : "+v"(qf[0]), "+v"(qf[1]));
        { const int tn = task + wstride; if (tn < task_end) SEL_PREFETCH(xsplit ? tn : (tn >> 1)); }
        const unsigned char* kbase = (const unsigned char*)K + (size_t)tb * 256 + g * 128;
        const unsigned char* vbase = (const unsigned char*)V + (size_t)tb * 256 + g * 128;
#define CH_GATHER(cidx) do { const unsigned char* bp_ = ((cidx) < 16) ? kbase : vbase; _Pragma("unroll") for (int i_ = 0; i_ < 2; ++i_) { \
            unsigned o_ = koff[2 * ((cidx) & 15) + i_]; asm volatile("" : "+v"(o_));     \
            __builtin_amdgcn_global_load_lds((const unsigned*)(bp_ + o_), (LAS unsigned*)(vb + ((cidx) & 7) * 2048 + i_ * 1024 + lane * 16), 16, 0, 0); } } while (0)
        float lg[16];
#pragma unroll
        for (int c0 = 0; c0 < 6; ++c0) CH_GATHER(c0);
#pragma unroll
        for (int ch = 0; ch < 16; ++ch) {
            asm volatile("s_waitcnt lgkmcnt(0)" ::: "memory");
            CH_GATHER(ch + 6);
            asm volatile("s_waitcnt vmcnt(12)" ::: "memory");
            const LAS unsigned char* kb = vb + (ch & 7) * 2048;
            f32x4 acc = {0.f, 0.f, 0.f, 0.f};
#pragma unroll
            for (int i = 0; i < 2; ++i) { const i64x2 kf = *(const LAS i64x2*)(kb + 128u * fr + 16u * ((4u * i + fq) ^ ((unsigned)fr & 7u)));
                acc = __builtin_amdgcn_mfma_f32_16x16x32_fp8_fp8(qf[i].x, kf.x, acc, 0, 0, 0); acc = __builtin_amdgcn_mfma_f32_16x16x32_fp8_fp8(qf[i].y, kf.y, acc, 0, 0, 0); }
            lg[ch] = (ch * 16 + fr < nsel) ? acc.x * 0.08838834764831845f : -INFINITY;
        }
        float mx = lg[0];
#pragma unroll
        for (int kt = 1; kt < 16; ++kt) mx = fmaxf(mx, lg[kt]);
#pragma unroll
        for (int o = 1; o < 16; o <<= 1) mx = fmaxf(mx, __shfl_xor(mx, o));
        float sm = 0.f;
#pragma unroll
        for (int kt = 0; kt < 16; ++kt) { lg[kt] = __expf(lg[kt] - mx); sm += lg[kt]; }
#pragma unroll
        for (int o = 1; o < 16; o <<= 1) sm += __shfl_xor(sm, o);
        { const float inv = 256.f / sm;
#pragma unroll
          for (int kt = 0; kt < 16; ++kt) { const float pv = lg[kt] * inv; ((LAS unsigned char*)pT)[fq * 256 + kt * 16 + fr] = (unsigned char)(pk_fp8x4(pv, pv, pv, pv) & 0xffu); } }
        f32x4 oacc[8];
#pragma unroll
        for (int c2 = 0; c2 < 8; ++c2) oacc[c2] = (f32x4){0.f, 0.f, 0.f, 0.f};
#pragma unroll
        for (int p = 0; p < 8; ++p) {
            asm volatile("s_waitcnt lgkmcnt(0)" ::: "memory");
            if (16 + 2 * p + 6 < 32) { CH_GATHER(16 + 2 * p + 6); CH_GATHER(16 + 2 * p + 7); }
            if (p < 5) asm volatile("s_waitcnt vmcnt(12)" ::: "memory"); else if (p == 5) asm volatile("s_waitcnt vmcnt(8)" ::: "memory");
            else if (p == 6) asm volatile("s_waitcnt vmcnt(4)" ::: "memory"); else asm volatile("s_waitcnt vmcnt(0)" ::: "memory");
            if (p < nch) {
                const long pa = *(const LAS long*)((const LAS unsigned char*)pT + (fr >> 2) * 256 + 32 * p + 8 * fq);
                const unsigned cb = vb_addr + (unsigned)(((16 + 2 * p) & 7) + (fq >> 1)) * 2048u;
                unsigned ad[8]; s16x4 r0[8];
#pragma unroll
                for (int i = 0; i < 8; ++i) ad[i] = cb + trh[i];
                tr_read8_b8(ad, r0);
#pragma unroll
                for (int c2 = 0; c2 < 8; ++c2) oacc[c2] = __builtin_amdgcn_mfma_f32_16x16x32_fp8_fp8(pa, __builtin_bit_cast(long, r0[c2]), oacc[c2], 0, 0, 0);
            }
        }
        { unsigned char* op = (unsigned char*)O + (size_t)tg * D + (4 * g + fq) * 128 + fr;
#pragma unroll
          for (int c2 = 0; c2 < 8; ++c2) { const float ov = oacc[c2].x * (O8_SCALE / 256.f); op[16 * c2] = (unsigned char)(pk_fp8x4(ov, ov, ov, ov) & 0xffu); } }
        LDS_WAIT();
#undef CH_GATHER
        if ((tcount & 1) && cit < NE * 192) { convert_moe_item(c, 1, cit, vb); cit += ngw; }
        ++tcount;
    }
    for (; cit < NE * 192; cit += ngw) convert_moe_item(c, 1, cit, vb);
}

__device__ __forceinline__ void phase_b4(const Ctx& c) {
    const bf16_t* OB = (const bf16_t*)(c.ws + WS_O); const bf16_t* W = (const bf16_t*)(c.ws + WS_WBOUT); float* H = (float*)(c.ws + WS_H);
    const int fr = c.lane & 15, fq = c.lane >> 4, wr = c.wave >> 1, wc = c.wave & 1;
    for (int u = c.vb; u < 128 * 8; u += c.nb) {
        int mt, nt; map_unit(u, 8, mt, nt);
        const bf16_t* ap[4]; const bf16_t* bp[4];
        rows_regular<64>(ap, (const bf16_t*)(c.ws + WS_O + (size_t)mt * 128 * D), D / 2, c.tid); rows_regular<64>(bp, (const bf16_t*)(c.ws + WS_WBOUT + (size_t)nt * 128 * D), D / 2, c.tid);
        f32x4 acc[4][4];
#pragma unroll
        for (int m = 0; m < 4; ++m)
#pragma unroll
            for (int n = 0; n < 4; ++n) acc[m][n] = *(const f32x4*)(H + (size_t)(mt * 128 + wr * 64 + m * 16 + fr) * D + nt * 128 + wc * 64 + n * 16 + fq * 4) * (W8_SCALE * O8_SCALE);
        gemm_loop<64, 1, true, true>(c, ap, bp, bp, D / 2, acc, acc);
#pragma unroll
        for (int m = 0; m < 4; ++m)
#pragma unroll
            for (int n = 0; n < 4; ++n) *(f32x4*)(H + (size_t)(mt * 128 + wr * 64 + m * 16 + fr) * D + nt * 128 + wc * 64 + n * 16 + fq * 4) = acc[m][n] * (1.f / (W8_SCALE * O8_SCALE));
    }
}

constexpr int NPHASE = 22;
__global__ void __launch_bounds__(NTH, 2) mk_fwd(Args args) {
    extern __shared__ __attribute__((aligned(16))) unsigned char lds_raw[];
    Ctx c;
    c.lds = (LAS unsigned char*)lds_raw; c.tid = threadIdx.x; c.lane = c.tid & 63; c.wave = __builtin_amdgcn_readfirstlane(c.tid >> 6);
    c.nb = gridDim.x; { const int bx = blockIdx.x; c.vb = (c.nb % 8 == 0) ? (bx % 8) * (c.nb / 8) + bx / 8 : bx; }
    c.a = (const __attribute__((address_space(4))) Args*)__builtin_amdgcn_kernarg_segment_ptr(); c.ws = args.ws;
    volatile LAS unsigned* st = (volatile LAS unsigned*)(c.lds + LDS_MAIN + 1008);
    const bool multi = (args.ph_hi - args.ph_lo) > 1;
    XcdBarrier bar; bar.bar = (unsigned*)(c.ws + WS_CTL); bar.x = 0; bar.st = st;
    if (multi) {
        if (c.tid == 0) { st[0] = 0u; st[1] = 0u; }
        __syncthreads();
        bar = xcd_barrier_post((unsigned*)(c.ws + WS_CTL), st);
    }
    const int ph_lo = args.ph_lo, ph_hi = args.ph_hi;
#ifndef PH_MASK
#define PH_MASK 0x3fffff
#endif
#define PHON(k) ((PH_MASK >> (k)) & 1)
#define PHASE(k, body) do { if (PHON(k) && ph_lo <= (k) && (k) < ph_hi) { \
        { int t_ = threadIdx.x, vb_ = __builtin_amdgcn_readfirstlane(c.vb); \
          const __attribute__((address_space(4))) Args* ka = (const __attribute__((address_space(4))) Args*)__builtin_amdgcn_kernarg_segment_ptr(); \
          asm volatile("" : "+v"(t_), "+s"(vb_), "+s"(ka)); \
          c.tid = t_; c.lane = t_ & 63; c.wave = __builtin_amdgcn_readfirstlane(t_ >> 6); c.vb = vb_; c.a = ka; c.ws = ka->ws; } \
        body; \
        if (MK_REP == (k)) { __syncthreads(); body; } \
        if ((k) + 1 < ph_hi) xcd_barrier(bar); \
        if ((k) == 3) { for (int xb_ = 0; xb_ < MK_XBAR; ++xb_) xcd_barrier(bar); } } } while (0)
    PHASE(0, phase_prep(c));
    PHASE(1, phase_a1(c));
    PHASE(2, { if (MK_DRY == 2) { phase_a2(c, true); __syncthreads(); } phase_a2(c); });
    PHASE(3, phase_a3(c));
    PHASE(4, { if (MK_DRY == 4) { phase_route(c, 0, true); __syncthreads(); } phase_route(c, 0); });
    PHASE(5, phase_e1(c, 0));
    PHASE(6, phase_e2(c, 0));
    PHASE(7, { if (MK_DRY == 7) { phase_p1(c, 0, true); __syncthreads(); } phase_p1(c, 0); });
    PHASE(8, phase_p2(c, 0));
    PHASE(9, phase_norm_bf16(c, (const float*)c.a->in[IN_MIXN] + D));
    PHASE(10, phase_b1(c));
    PHASE(11, phase_rope(c));
    PHASE(12, phase_score(c));
    PHASE(13, phase_select(c));
    PHASE(14, phase_attn(c));
    PHASE(15, phase_b4(c));
    PHASE(16, phase_route(c, 1));
    PHASE(17, phase_e1(c, 1));
    PHASE(18, phase_e2(c, 1));
    PHASE(19, phase_p1(c, 1));
    PHASE(20, phase_p2(c, 1));
    PHASE(21, phase_final(c));
}

#ifdef MK_DUMP
__global__ void dump_k(const unsigned char* ws, float* out) {
    const size_t i = (size_t)blockIdx.x * 256 + threadIdx.x;
#if MK_DUMP == 1
    ((f32x4*)out)[i] = ((const f32x4*)(ws + WS_H))[i];
#elif MK_DUMP == 2
    { const u32x2 v = ((const u32x2*)(ws + WS_O))[i]; f32x4 o = {bf_lo(v.x), bf_hi(v.x), bf_lo(v.y), bf_hi(v.y)}; ((f32x4*)out)[i] = o; }
#elif MK_DUMP == 3
    { const int* sp = (const int*)(ws + WS_SEL); f32x4 o = {0.f,0.f,0.f,0.f}; if (i < (size_t)T * 64) { o.x = (float)sp[4*i]; o.y = (float)sp[4*i+1]; o.z = (float)sp[4*i+2]; o.w = (float)sp[4*i+3]; } ((f32x4*)out)[i] = o; }
#elif MK_DUMP == 5
    { const u32x2 v = ((const u32x2*)(ws + WS_XN))[i]; f32x4 o = {bf_lo(v.x), bf_hi(v.x), bf_lo(v.y), bf_hi(v.y)}; ((f32x4*)out)[i] = o; }
#elif MK_DUMP == 6
    { const u32x2 v = ((const u32x2*)(ws + WS_RAW))[i]; f32x4 o = {bf_lo(v.x), bf_hi(v.x), bf_lo(v.y), bf_hi(v.y)}; ((f32x4*)out)[i] = o; }
#elif MK_DUMP == 7
    { f32x4 o = {0.f,0.f,0.f,0.f}; if (i < (size_t)BINP * D / 4) { const u32x2 v = ((const u32x2*)(ws + WS_WBIN))[i]; o = (f32x4){bf_lo(v.x), bf_hi(v.x), bf_lo(v.y), bf_hi(v.y)}; } ((f32x4*)out)[i] = o; }
#elif MK_DUMP == 8
    { const u32x2 v = ((const u32x2*)(ws + WS_RAW))[i], w = ((const u32x2*)(ws + 458 * MB))[i]; f32x4 o = {bf_lo(v.x) - bf_lo(w.x), bf_hi(v.x) - bf_hi(w.x), bf_lo(v.y) - bf_lo(w.y), bf_hi(v.y) - bf_hi(w.y)}; ((f32x4*)out)[i] = o; }
#elif MK_DUMP == 9
    { const u32x2 v = ((const u32x2*)(ws + WS_RAW))[i], w = ((const u32x2*)(ws + 458 * MB))[i]; f32x4 o = {(v.x & 0xffffu) != (w.x & 0xffffu) ? 1.f : 0.f, (v.x >> 16) != (w.x >> 16) ? 1.f : 0.f, (v.y & 0xffffu) != (w.y & 0xffffu) ? 1.f : 0.f, (v.y >> 16) != (w.y >> 16) ? 1.f : 0.f}; ((f32x4*)out)[i] = o; }
#elif MK_DUMP == 4
    { const u32x2 v = ((const u32x2*)(ws + WS_Q))[i]; f32x4 o = {bf_lo(v.x), bf_hi(v.x), bf_lo(v.y), bf_hi(v.y)}; ((f32x4*)out)[i] = o; }
#endif
}
#endif
extern "C" void kernel_launch(void* const* d_in, const int* in_sizes, int n_in, void* d_out, int out_size, void* d_ws, size_t ws_size, hipStream_t stream) {
    static int grid = 0;
    if (grid == 0) {
        if (n_in != 23 || out_size != T * D || ws_size < WS_TOTAL) { fprintf(stderr, "kernel_launch: unexpected sizes n_in %d out %d ws %zu (need %zu)\n", n_in, out_size, ws_size, (size_t)WS_TOTAL); grid = -1; return; }
        int dev = 0, cus = 0, per_cu = 0;
        hipGetDevice(&dev); hipDeviceGetAttribute(&cus, hipDeviceAttributeMultiprocessorCount, dev);
        hipFuncSetAttribute((const void*)mk_fwd, hipFuncAttributeMaxDynamicSharedMemorySize, LDS_BYTES);
        hipOccupancyMaxActiveBlocksPerMultiprocessor(&per_cu, (const void*)mk_fwd, NTH, LDS_BYTES);
        (void)hipGetLastError();
        if (per_cu < 1) per_cu = 1;
        if (per_cu > 2) per_cu = 2;
        grid = cus * per_cu;
    }
    if (grid < 0) return;
    hipMemsetAsync((char*)d_ws + WS_CTL, 0, 16384, stream);
    Args a{};
    for (int i = 0; i < 23; ++i) a.in[i] = d_in[i];
    a.out = (float*)d_out; a.ws = (unsigned char*)d_ws;
#if MK_ONE_LAUNCH
    a.ph_lo = 0; a.ph_hi = NPHASE;
    hipLaunchKernelGGL(mk_fwd, dim3(grid), dim3(NTH), LDS_BYTES, stream, a);
#else
    for (int ph = 0; ph <= MK_LAST_PHASE; ++ph) { a.ph_lo = ph; a.ph_hi = ph + 1; hipLaunchKernelGGL(mk_fwd, dim3(grid), dim3(NTH), LDS_BYTES, stream, a); }
#ifdef MK_DUMP
    hipLaunchKernelGGL(dump_k, dim3(T * D / 4 / 256), dim3(256), 0, stream, (const unsigned char*)d_ws, (float*)d_out);
#endif
#endif
}
```

```cpp
#include <hip/hip_runtime.h>
#include <stdint.h>
#include <stdio.h>

#ifndef MK_LAST_PHASE
#define MK_LAST_PHASE 21
#endif
#ifndef MK_REP
#define MK_REP -1
#endif
#ifndef MK_XBAR
#define MK_XBAR 0
#endif
#ifndef MK_DRY
#define MK_DRY -1
#endif
#ifndef MK_ONE_LAUNCH
#define MK_ONE_LAUNCH 1
#endif

#define LAS __attribute__((address_space(3)))
typedef unsigned short bf16_t;
typedef short bf16x8 __attribute__((ext_vector_type(8)));
typedef float f32x4 __attribute__((ext_vector_type(4)));
typedef float f32x2 __attribute__((ext_vector_type(2)));
typedef float f32x16 __attribute__((ext_vector_type(16)));
typedef unsigned u32x4 __attribute__((ext_vector_type(4)));
typedef unsigned u32x2 __attribute__((ext_vector_type(2)));
typedef long i64x2 __attribute__((ext_vector_type(2)));

constexpr int T = 16384, D = 1024, SEQ = 4096;
constexpr int GW = 2048;
constexpr int BIN = 2120, BINP = 2176;
constexpr int NE = 32, DE = 512;
constexpr int PLE = 256;
constexpr float EPS = 1e-6f;
constexpr int NTH = 256;
constexpr int LDS_MAIN = 4 * 19456;
constexpr int LDS_BYTES = LDS_MAIN + 1024;
constexpr int RPAD = 32768 + NE * 128;

constexpr size_t MB = 1024 * 1024;
constexpr size_t WS_CTL = 0;
constexpr size_t WS_CNT = 16384;
constexpr size_t WS_WR = 32768;
constexpr size_t WS_WAIN = 1 * MB;
constexpr size_t WS_WAOUT = WS_WAIN + 8 * MB;
constexpr size_t WS_WBIN = WS_WAOUT + 4 * MB;
constexpr size_t WS_WBOUT = WS_WBIN + 5 * MB;
constexpr size_t WS_WGATE = WS_WBOUT + 2 * MB;
constexpr size_t WS_WPROJ = WS_WGATE + 4 * MB;
constexpr size_t WS_W1 = WS_WPROJ + 1 * MB;
constexpr size_t WS_XN8 = WS_W1 + 16 * MB;
constexpr size_t WS_W3 = WS_W1 + 32 * MB;
constexpr size_t WS_W2 = WS_W3 + 32 * MB;
constexpr size_t WS_PBF = WS_W2 + 32 * MB;
constexpr size_t WS_XN = WS_PBF + 16 * MB;
constexpr size_t WS_H = WS_XN + 32 * MB;
constexpr size_t WS_LIST = WS_H + 64 * MB;
constexpr size_t WS_GATE = WS_LIST + 2 * MB;
constexpr size_t WS_TOKSLOT = WS_GATE + 2 * MB;
constexpr size_t WS_SCR = WS_TOKSLOT + 1 * MB;
constexpr size_t WS_U = WS_SCR;
constexpr size_t WS_VT = WS_SCR + 64 * MB;
constexpr size_t WS_VSS = WS_SCR + 128 * MB;
constexpr size_t WS_HMID = WS_SCR;
constexpr size_t WS_Y = WS_SCR + 36 * MB;
constexpr size_t WS_RAW = WS_SCR;
constexpr size_t WS_O = WS_SCR;
constexpr size_t WS_Q = WS_SCR + 68 * MB;
constexpr size_t WS_K = WS_Q + 32 * MB;
constexpr size_t WS_V = WS_K + 8 * MB;
constexpr size_t WS_QI = WS_V + 8 * MB;
constexpr size_t WS_KI = WS_QI + 16 * MB;
constexpr size_t WS_WI = WS_KI + 2 * MB;
constexpr size_t WS_SEL = WS_WI + 1 * MB;
constexpr size_t WS_END = WS_SEL + 16 * MB;
static_assert(WS_END <= WS_SCR + 152 * MB, "scratch");
constexpr size_t WS_S = 392 * MB;
constexpr size_t WS_TOTAL = 522 * MB;

typedef __bf16 bf16x2_t __attribute__((ext_vector_type(2)));
__device__ __forceinline__ unsigned pk_bf16(float lo, float hi) { f32x2 v = {lo, hi}; bf16x2_t b = __builtin_convertvector(v, bf16x2_t); return __builtin_bit_cast(unsigned, b); }
__device__ __forceinline__ float bf_lo(unsigned u) { return __uint_as_float(u << 16); }
__device__ __forceinline__ float bf_hi(unsigned u) { return __uint_as_float(u & 0xffff0000u); }
__device__ __forceinline__ float wave_sum(float v) {
#pragma unroll
    for (int o = 1; o < 64; o <<= 1) v += __shfl_xor(v, o);
    return v;
}
__device__ __forceinline__ int lds_inc(LAS int* p) { return __hip_atomic_fetch_add(p, 1, __ATOMIC_RELAXED, __HIP_MEMORY_SCOPE_WORKGROUP); }
#define LDS_WAIT() asm volatile("s_waitcnt lgkmcnt(0)" ::: "memory")
#define VM_WAIT() asm volatile("s_waitcnt vmcnt(0)" ::: "memory")

#define XB_TMO      128
#define XB_XCNT(j)  (256  + 64 * (j))
#define XB_XSUB(j)  (1280 + 64 * (j))
#define XB_XGEN(j)  (2304 + 64 * (j))
#define XB_TOP      3328
#define XB_TOPGEN   3392
#define XCD_BAR_WORDS 3456
#define XB_SPIN_CAP (1u << 20)
__device__ __forceinline__ unsigned xb_ld(unsigned* p)              { return __hip_atomic_load(p, __ATOMIC_RELAXED, __HIP_MEMORY_SCOPE_AGENT); }
__device__ __forceinline__ unsigned xb_add(unsigned* p, unsigned v) { return __hip_atomic_fetch_add(p, v, __ATOMIC_RELAXED, __HIP_MEMORY_SCOPE_AGENT); }
__device__ __forceinline__ unsigned xb_xcc_id() { return (unsigned)__builtin_amdgcn_s_getreg((3 << 11) | 20) & 0xFu; }
#define XB_SPIN(cond, bar) do { unsigned _sp = 0; while (cond) { __builtin_amdgcn_s_sleep(1); \
    if ((++_sp & 255u) == 0u) { if (xb_ld(&(bar)[XB_TMO])) break; if (_sp > XB_SPIN_CAP) { atomicAdd(&(bar)[XB_TMO], 1u); break; } } } } while (0)
struct XcdBarrier { unsigned* bar; unsigned x; volatile LAS unsigned* st; };
__device__ __forceinline__ XcdBarrier xcd_barrier_post(unsigned* bar, volatile LAS unsigned* st) {
    XcdBarrier b; b.bar = bar; b.x = xb_xcc_id(); b.st = st;
    if (threadIdx.x == 0) (void)xb_add(&bar[XB_XCNT(b.x)], 1u);
    return b;
}
__device__ __forceinline__ void xcd_barrier_complete(unsigned* bar, unsigned x, unsigned& nloc, unsigned& nx) {
    const unsigned G = gridDim.x;
    unsigned sum, cnt, mine, sp = 0u;
    for (;;) {
        sum = 0u; cnt = 0u; mine = 0u;
#pragma unroll
        for (unsigned j = 0; j < 16; ++j) { const unsigned c = xb_ld(&bar[XB_XCNT(j)]); sum += c; cnt += (c > 0u) ? 1u : 0u; mine = (j == x) ? c : mine; }
        if (sum == G) break;
        __builtin_amdgcn_s_sleep(1);
        if ((++sp & 255u) == 0u) { if (xb_ld(&bar[XB_TMO])) break; if (sp > XB_SPIN_CAP) { atomicAdd(&bar[XB_TMO], 1u); break; } }
    }
    nloc = mine > 0u ? mine : 1u; nx = cnt > 0u ? cnt : 1u;
}
__device__ __forceinline__ void xcd_barrier(const XcdBarrier& b) {
    asm volatile("s_waitcnt vmcnt(0)" ::: "memory");
    __syncthreads();
    if (threadIdx.x == 0) {
        unsigned* bar = b.bar;
        __builtin_amdgcn_s_waitcnt(0);
        unsigned nloc = b.st[0], nx = b.st[1];
        if (nloc == 0u) { xcd_barrier_complete(bar, b.x, nloc, nx); b.st[0] = nloc; b.st[1] = nx; }
        const unsigned old = xb_add(&bar[XB_XSUB(b.x)], 1u);
        const unsigned gen = old / nloc;
        if (old + 1u == (gen + 1u) * nloc) {
            __builtin_amdgcn_fence(__ATOMIC_RELEASE, "agent");
            asm volatile("s_waitcnt vmcnt(0)" ::: "memory");
            const unsigned og = xb_add(&bar[XB_TOP], 1u);
            const unsigned tg = og / nx;
            if (og + 1u == (tg + 1u) * nx) xb_add(&bar[XB_TOPGEN], 1u);
            else XB_SPIN(xb_ld(&bar[XB_TOPGEN]) == tg, bar);
            __builtin_amdgcn_fence(__ATOMIC_ACQUIRE, "agent");
            xb_add(&bar[XB_XGEN(b.x)], 1u);
            asm volatile("s_waitcnt vmcnt(0)" ::: "memory");
        } else {
            XB_SPIN(xb_ld(&bar[XB_XGEN(b.x)]) == gen, bar);
            __builtin_amdgcn_fence(__ATOMIC_ACQUIRE, "agent");
            asm volatile("s_waitcnt vmcnt(0)" ::: "memory");
        }
    }
    __syncthreads();
}

struct Args { const void* in[23]; float* out; unsigned char* ws; int ph_lo, ph_hi; };
enum { IN_X = 0, IN_P, IN_POS, IN_MIXN, IN_AWIN, IN_AVG, IN_AWS, IN_ABS, IN_AWOUT, IN_BWIN, IN_BWOUT, IN_FFNN, IN_WG, IN_BG, IN_WE, IN_BE,
       IN_W1, IN_W3, IN_W2, IN_PLEN, IN_PLEG, IN_PLEP, IN_FINN };

struct Ctx {
    LAS unsigned char* lds;
    int tid, lane, wave, vb, nb;
    const __attribute__((address_space(4))) Args* a;
    unsigned char* ws;
};

template <int BK> struct TileK { static constexpr int NP = (BK == 64) ? 4 : 2; static constexpr int TB = 128 * BK * 2; };

template <int BK>
__device__ __forceinline__ void stage_tile(LAS unsigned char* tile, const bf16_t* const (&rp)[TileK<BK>::NP], int k0, int tid) {
    const int lc = (BK == 64) ? ((tid & 7) ^ ((tid >> 3) & 7)) : ((tid & 3) ^ ((tid >> 3) & 3));
#pragma unroll
    for (int p = 0; p < TileK<BK>::NP; ++p)
        __builtin_amdgcn_global_load_lds((const unsigned*)(rp[p] + k0 + lc * 8), (LAS unsigned*)(tile + p * 4096 + tid * 16), 16, 0, 0);
}
template <int BK>
__device__ __forceinline__ void rows_regular(const bf16_t* (&rp)[TileK<BK>::NP], const bf16_t* base, size_t ld, int tid) {
#pragma unroll
    for (int p = 0; p < TileK<BK>::NP; ++p) { const int r = (BK == 64) ? (p * 32 + (tid >> 3)) : (p * 64 + (tid >> 2)); rp[p] = base + (size_t)r * ld; }
}
template <int BK>
__device__ __forceinline__ int frag_off(int row, int ks, int fq) {
    return (BK == 64) ? (row * 128 + (((ks * 4 + fq) ^ (row & 7)) << 4)) : (row * 64 + ((fq ^ ((row >> 1) & 3)) << 4));
}

template <int BK, int NBOP, bool SWAP, bool FP8 = false>
__device__ __forceinline__ void gemm_loop(const Ctx& c, const bf16_t* const (&ap)[TileK<BK>::NP], const bf16_t* const (&b0p)[TileK<BK>::NP], const bf16_t* const (&b1p)[TileK<BK>::NP],
                                          int K, f32x4 (&acc0)[4][4], f32x4 (&acc1)[4][4]) {
    constexpr int TB = TileK<BK>::TB, SB = (1 + NBOP) * TB;
    static_assert(2 * SB <= LDS_MAIN, "lds");
    const int nk = K / BK, tid = c.tid;
    const int fr = c.lane & 15, fq = c.lane >> 4, wr = c.wave >> 1, wc = c.wave & 1;
    LAS unsigned char* lds = c.lds;
    stage_tile<BK>(lds, ap, 0, tid); stage_tile<BK>(lds + TB, b0p, 0, tid);
    if (NBOP == 2) stage_tile<BK>(lds + 2 * TB, b1p, 0, tid);
    for (int kt = 0; kt < nk; ++kt) {
        VM_WAIT();
        __syncthreads();
        LAS unsigned char* cur = lds + (kt & 1) * SB;
        if (kt + 1 < nk) {
            LAS unsigned char* nxt = lds + ((kt + 1) & 1) * SB;
            stage_tile<BK>(nxt, ap, (kt + 1) * BK, tid); stage_tile<BK>(nxt + TB, b0p, (kt + 1) * BK, tid);
            if (NBOP == 2) stage_tile<BK>(nxt + 2 * TB, b1p, (kt + 1) * BK, tid);
        }
#pragma unroll
        for (int ks = 0; ks < BK / 32; ++ks) {
            bf16x8 af[4], bf0[4], bf1[4];
#pragma unroll
            for (int m = 0; m < 4; ++m) af[m] = *(const LAS bf16x8*)(cur + frag_off<BK>(wr * 64 + m * 16 + fr, ks, fq));
#pragma unroll
            for (int n = 0; n < 4; ++n) bf0[n] = *(const LAS bf16x8*)(cur + TB + frag_off<BK>(wc * 64 + n * 16 + fr, ks, fq));
            if (NBOP == 2) {
#pragma unroll
                for (int n = 0; n < 4; ++n) bf1[n] = *(const LAS bf16x8*)(cur + 2 * TB + frag_off<BK>(wc * 64 + n * 16 + fr, ks, fq));
            }
#pragma unroll
            for (int m = 0; m < 4; ++m)
#pragma unroll
                for (int n = 0; n < 4; ++n) {
                    if (FP8) {
                        const i64x2 a2 = __builtin_bit_cast(i64x2, af[m]), b2 = __builtin_bit_cast(i64x2, bf0[n]);
                        if (SWAP) { acc0[m][n] = __builtin_amdgcn_mfma_f32_16x16x32_fp8_fp8(b2.x, a2.x, acc0[m][n], 0, 0, 0); acc0[m][n] = __builtin_amdgcn_mfma_f32_16x16x32_fp8_fp8(b2.y, a2.y, acc0[m][n], 0, 0, 0); }
                        else      { acc0[m][n] = __builtin_amdgcn_mfma_f32_16x16x32_fp8_fp8(a2.x, b2.x, acc0[m][n], 0, 0, 0); acc0[m][n] = __builtin_amdgcn_mfma_f32_16x16x32_fp8_fp8(a2.y, b2.y, acc0[m][n], 0, 0, 0); }
                        continue;
                    }
                    if (SWAP) acc0[m][n] = __builtin_amdgcn_mfma_f32_16x16x32_bf16(bf0[n], af[m], acc0[m][n], 0, 0, 0);
                    else      acc0[m][n] = __builtin_amdgcn_mfma_f32_16x16x32_bf16(af[m], bf0[n], acc0[m][n], 0, 0, 0);
                    if (NBOP == 2) {
                        if (SWAP) acc1[m][n] = __builtin_amdgcn_mfma_f32_16x16x32_bf16(bf1[n], af[m], acc1[m][n], 0, 0, 0);
                        else      acc1[m][n] = __builtin_amdgcn_mfma_f32_16x16x32_bf16(af[m], bf1[n], acc1[m][n], 0, 0, 0);
                    }
                }
        }
    }
    __syncthreads();
}
__device__ __forceinline__ void zero_acc(f32x4 (&acc)[4][4]) {
#pragma unroll
    for (int m = 0; m < 4; ++m)
#pragma unroll
        for (int n = 0; n < 4; ++n) acc[m][n] = (f32x4){0.f, 0.f, 0.f, 0.f};
}
__device__ __forceinline__ void map_unit(int u, int nnt, int& mt, int& nt) { const int per = 8 * nnt, band = u / per, r = u - band * per; nt = r >> 3; mt = band * 8 + (r & 7); }


__device__ __forceinline__ float gelu_tanh(float x) {
    const float y2 = 1.5957691216057308f * (x + 0.044715f * x * x * x);
    return x * __builtin_amdgcn_rcpf(1.f + __expf(-y2));
}
__device__ __forceinline__ float sigmoidf_(float x) { return __builtin_amdgcn_rcpf(1.f + __expf(-x)); }

__device__ __forceinline__ void row_load(const float* row, int lane, f32x4 (&v)[4]) {
#pragma unroll
    for (int j = 0; j < 4; ++j) v[j] = ((const f32x4*)row)[lane + 64 * j];
}
__device__ __forceinline__ float row_sumsq(const f32x4 (&v)[4]) {
    float s = 0.f;
#pragma unroll
    for (int j = 0; j < 4; ++j) s += (v[j].x * v[j].x + v[j].y * v[j].y) + (v[j].z * v[j].z + v[j].w * v[j].w);
    return wave_sum(s);
}
__device__ __forceinline__ void gain_load(const float* gain, int lane, f32x4 (&g)[4]) {
#pragma unroll
    for (int j = 0; j < 4; ++j) g[j] = ((const f32x4*)gain)[lane + 64 * j];
}
__device__ __forceinline__ void row_store_norm_bf16(bf16_t* orow, int lane, const f32x4 (&v)[4], float r, const f32x4 (&gv)[4]) {
#pragma unroll
    for (int j = 0; j < 4; ++j) {
        const f32x4 g = gv[j];
        u32x2 o; o.x = pk_bf16(v[j].x * r * g.x, v[j].y * r * g.y); o.y = pk_bf16(v[j].z * r * g.z, v[j].w * r * g.w);
        ((u32x2*)orow)[lane + 64 * j] = o;
    }
}

__device__ __forceinline__ unsigned pk_fp8x4(float a, float b, float c_, float d);
__device__ __forceinline__ void row_store_norm_fp8(unsigned char* orow, int lane, const f32x4 (&v)[4], float r, const f32x4 (&gv)[4]) {
#pragma unroll
    for (int j = 0; j < 4; ++j) ((unsigned*)orow)[lane + 64 * j] = pk_fp8x4(v[j].x * r * gv[j].x, v[j].y * r * gv[j].y, v[j].z * r * gv[j].z, v[j].w * r * gv[j].w);
}
constexpr int TR_SCR = 64 * 136;
__device__ __forceinline__ void transpose_item(const float* W, int K, int N, int nvalid, int ldw, bf16_t* WT, LAS unsigned char* scr, int item, int lane) {
    const int nblk = N / 64, kb = item / nblk, nb = item - kb * nblk, k0 = 64 * kb, n0 = 64 * nb;
    const int n = n0 + 4 * (lane & 15);
    const int nc_ = (n < nvalid) ? n : 0; const float keep = (n < nvalid) ? 1.f : 0.f;
    f32x4 v[16];
#pragma unroll
    for (int i = 0; i < 16; ++i) v[i] = *(const f32x4*)(W + (size_t)(k0 + 4 * i + (lane >> 4)) * ldw + nc_);
#pragma unroll
    for (int i = 0; i < 16; ++i) {
        const int kk = 4 * i + (lane >> 4);
        u32x2 o; o.x = pk_bf16(v[i].x * keep, v[i].y * keep); o.y = pk_bf16(v[i].z * keep, v[i].w * keep);
        *(LAS u32x2*)(scr + kk * 136 + (lane & 15) * 8) = o;
    }
    LDS_WAIT();
    const int cc = lane & 7;
#pragma unroll
    for (int j = 0; j < 8; ++j) {
        const int nn = (lane >> 3) + 8 * j; const LAS unsigned short* sp = (const LAS unsigned short*)(scr + (8 * cc) * 136 + nn * 2);
        u32x4 o;
        o.x = (unsigned)sp[0 * 68] | ((unsigned)sp[1 * 68] << 16); o.y = (unsigned)sp[2 * 68] | ((unsigned)sp[3 * 68] << 16);
        o.z = (unsigned)sp[4 * 68] | ((unsigned)sp[5 * 68] << 16); o.w = (unsigned)sp[6 * 68] | ((unsigned)sp[7 * 68] << 16);
        *(u32x4*)(WT + (size_t)(n0 + nn) * K + k0 + 8 * cc) = o;
    }
    LDS_WAIT();
}

__device__ __forceinline__ unsigned pk_fp8x4(float a, float b, float c_, float d) {
    a = fminf(fmaxf(a, -448.f), 448.f); b = fminf(fmaxf(b, -448.f), 448.f); c_ = fminf(fmaxf(c_, -448.f), 448.f); d = fminf(fmaxf(d, -448.f), 448.f);
    int p = __builtin_amdgcn_cvt_pk_fp8_f32(a, b, 0, false);
    p = __builtin_amdgcn_cvt_pk_fp8_f32(c_, d, p, true);
    return (unsigned)p;
}
__device__ __forceinline__ unsigned pk_fp8x4_nc(float a, float b, float c_, float d) {
    int p = __builtin_amdgcn_cvt_pk_fp8_f32(a, b, 0, false);
    p = __builtin_amdgcn_cvt_pk_fp8_f32(c_, d, p, true);
    return (unsigned)p;
}
constexpr float W8_SCALE = 64.f, H8_SCALE = 4.f, O8_SCALE = 8.f;
__device__ __forceinline__ void transpose_item8(const float* W, int K, int N, unsigned char* WT, LAS unsigned char* scr, int item, int lane, int nvalid = 1 << 30, int ldw = 0) {
    const int nblk = N / 64, kb = item / nblk, nb = item - kb * nblk, k0 = 128 * kb, n0 = 64 * nb;
    const int n = n0 + 4 * (lane & 15), ld = ldw ? ldw : N, nc_ = (n < nvalid) ? n : 0; const float keep = (n < nvalid) ? W8_SCALE : 0.f;
#pragma unroll 2
    for (int h = 0; h < 2; ++h) {
        f32x4 v[16];
#pragma unroll
        for (int i = 0; i < 16; ++i) v[i] = *(const f32x4*)(W + (size_t)(k0 + 64 * h + 4 * i + (lane >> 4)) * ld + nc_);
#pragma unroll
        for (int i = 0; i < 16; ++i) { const int kk = 64 * h + 4 * i + (lane >> 4);
            *(LAS unsigned*)(scr + kk * 68 + (lane & 15) * 4) = pk_fp8x4_nc(v[i].x * keep, v[i].y * keep, v[i].z * keep, v[i].w * keep); }
    }
    LDS_WAIT();
    const int cc = lane & 7;
#pragma unroll
    for (int j = 0; j < 8; ++j) {
        const int nn = (lane >> 3) + 8 * j; const LAS unsigned char* sp = scr + (16 * cc) * 68 + nn;
        unsigned w[4];
#pragma unroll
        for (int q = 0; q < 4; ++q) w[q] = (unsigned)sp[(4 * q + 0) * 68] | ((unsigned)sp[(4 * q + 1) * 68] << 8) | ((unsigned)sp[(4 * q + 2) * 68] << 16) | ((unsigned)sp[(4 * q + 3) * 68] << 24);
        u32x4 o = {w[0], w[1], w[2], w[3]};
        *(u32x4*)(WT + (size_t)(n0 + nn) * K + k0 + 16 * cc) = o;
    }
    LDS_WAIT();
}
__device__ __forceinline__ void convert_moe_item(const Ctx& c, int l, int it, LAS unsigned char* scr) {
    const float* w1 = (const float*)c.a->in[IN_W1] + (size_t)l * NE * D * DE;
    const float* w3 = (const float*)c.a->in[IN_W3] + (size_t)l * NE * D * DE;
    const float* w2 = (const float*)c.a->in[IN_W2] + (size_t)l * NE * DE * D;
    unsigned char* W1 = c.ws + WS_W1; unsigned char* W3 = c.ws + WS_W3; unsigned char* W2 = c.ws + WS_W2;
    const int e = it / 192, r = it - e * 192;
    if (r < 64)       transpose_item8(w1 + (size_t)e * D * DE, D, DE, W1 + (size_t)e * DE * D, scr, r, c.lane);
    else if (r < 128) transpose_item8(w3 + (size_t)e * D * DE, D, DE, W3 + (size_t)e * DE * D, scr, r - 64, c.lane);
    else              transpose_item8(w2 + (size_t)e * DE * D, DE, D, W2 + (size_t)e * D * DE, scr, r - 128, c.lane);
}
__device__ __forceinline__ void convert_moe_layer(const Ctx& c, int l) {
    LAS unsigned char* scr = c.lds + c.wave * TR_SCR;
    const int gw = c.vb * 4 + c.wave, ngw = c.nb * 4;
    for (int it = gw; it < NE * 192; it += ngw) convert_moe_item(c, l, it, scr);
}

__device__ __forceinline__ void phase_prep(const Ctx& c) {
    const __attribute__((address_space(4))) Args& a = *c.a;
    LAS unsigned char* scr = c.lds + c.wave * TR_SCR;
    const int gw = c.vb * 4 + c.wave, ngw = c.nb * 4;
    constexpr int I_AIN = 16 * 64, I_AOUT = 32 * 16, I_PP = 4 * 16, I_BIN8 = 8 * 34, I_BOUT8 = 8 * 16, I_PG8 = 8 * 16, I_BINI = 16 * 10;
    constexpr int NIT = I_AIN + I_AOUT + 2 * I_PP + I_BIN8 + I_BOUT8 + 2 * I_PG8 + I_BINI;
    for (int it = gw; it < NIT; it += ngw) {
        int r = it;
        if (r < I_AIN) { transpose_item((const float*)a.in[IN_AWIN], D, 4096, 4096, 4096, (bf16_t*)(c.ws + WS_WAIN), scr, r, c.lane); continue; } r -= I_AIN;
        if (r < I_AOUT) { transpose_item((const float*)a.in[IN_AWOUT], GW, D, D, D, (bf16_t*)(c.ws + WS_WAOUT), scr, r, c.lane); continue; } r -= I_AOUT;
        if (r < 2 * I_PP) { const int l = r / I_PP; transpose_item((const float*)a.in[IN_PLEP] + (size_t)l * PLE * D, PLE, D, D, D, (bf16_t*)(c.ws + WS_WPROJ) + (size_t)l * D * PLE, scr, r - l * I_PP, c.lane); continue; } r -= 2 * I_PP;
        if (r < I_BIN8) { transpose_item8((const float*)a.in[IN_BWIN], D, BINP, c.ws + WS_WBIN, scr, r, c.lane, BIN, BIN); continue; } r -= I_BIN8;
        if (r < I_BOUT8) { transpose_item8((const float*)a.in[IN_BWOUT], D, D, c.ws + WS_WBOUT, scr, r, c.lane); continue; } r -= I_BOUT8;
        if (r < 2 * I_PG8) { const int l = r / I_PG8; transpose_item8((const float*)a.in[IN_PLEG] + (size_t)l * D * D, D, D, c.ws + WS_WGATE + (size_t)l * D * D, scr, r - l * I_PG8, c.lane); continue; } r -= 2 * I_PG8;
        transpose_item((const float*)a.in[IN_BWIN] + 1536, D, 640, BIN - 1536, BIN, (bf16_t*)(c.ws + WS_WBIN + 3 * MB), scr, r, c.lane);
    }
    convert_moe_layer(c, 0);
    const int gt = c.vb * NTH + c.tid, ngt = c.nb * NTH;
    { const float* p = (const float*)a.in[IN_P]; bf16_t* pb = (bf16_t*)(c.ws + WS_PBF);
      for (int i = gt; i < 2 * T * PLE / 8; i += ngt) {
          const f32x4 v0 = ((const f32x4*)p)[2 * i], v1 = ((const f32x4*)p)[2 * i + 1];
          u32x4 o; o.x = pk_bf16(v0.x, v0.y); o.y = pk_bf16(v0.z, v0.w); o.z = pk_bf16(v1.x, v1.y); o.w = pk_bf16(v1.z, v1.w);
          ((u32x4*)pb)[i] = o; } }
    { float* wr = (float*)(c.ws + WS_WR);
      for (int i = gt; i < 2 * D * 48; i += ngt) {
          const int l = i / (D * 48), r = i - l * D * 48, k = r / 48, o = r - k * 48;
          float w = 0.f;
          if (o < 4) w = ((const float*)a.in[IN_WG])[(size_t)l * D * 4 + k * 4 + o];
          else if (o < 36) w = ((const float*)a.in[IN_WE])[(size_t)l * D * 32 + k * 32 + (o - 4)];
          wr[i] = w * ((const float*)a.in[IN_FFNN])[l * D + k]; } }
    if (c.vb == 0 && c.tid < 128) ((int*)(c.ws + WS_CNT))[c.tid] = 0;
    f32x4 gv[4]; gain_load((const float*)a.in[IN_MIXN], c.lane, gv);
    for (int t = gw; t < T; t += ngw) {
        f32x4 v[4]; row_load((const float*)a.in[IN_X] + (size_t)t * D, c.lane, v);
        const float r = rsqrtf(row_sumsq(v) * (1.f / D) + EPS);
        row_store_norm_bf16((bf16_t*)(c.ws + WS_XN) + (size_t)t * D, c.lane, v, r, gv);
    }
}

__device__ __forceinline__ void phase_a1(const Ctx& c) {
    const bf16_t* XN = (const bf16_t*)(c.ws + WS_XN); const bf16_t* W = (const bf16_t*)(c.ws + WS_WAIN);
    bf16_t* U = (bf16_t*)(c.ws + WS_U); bf16_t* VT = (bf16_t*)(c.ws + WS_VT); float* VSS = (float*)(c.ws + WS_VSS);
    const int fr = c.lane & 15, fq = c.lane >> 4, wr = c.wave >> 1, wc = c.wave & 1;
    for (int u = c.vb; u < 128 * 32; u += c.nb) {
        int mt, nt; map_unit(u, 32, mt, nt);
        const bf16_t* ap[4]; const bf16_t* bp[4];
        rows_regular<64>(ap, XN + (size_t)mt * 128 * D, D, c.tid); rows_regular<64>(bp, W + (size_t)nt * 128 * D, D, c.tid);
        f32x4 acc[4][4]; zero_acc(acc);
        if (nt < 16) {
            gemm_loop<64, 1, true>(c, ap, bp, bp, D, acc, acc);
#pragma unroll
            for (int m = 0; m < 4; ++m)
#pragma unroll
                for (int n = 0; n < 4; ++n) {
                    const int t = mt * 128 + wr * 64 + m * 16 + fr, col = nt * 128 + wc * 64 + n * 16 + fq * 4;
                    const f32x4 v = acc[m][n];
                    u32x2 o; o.x = pk_bf16(gelu_tanh(v.x), gelu_tanh(v.y)); o.y = pk_bf16(gelu_tanh(v.z), gelu_tanh(v.w));
                    *(u32x2*)(U + (size_t)t * GW + col) = o;
                }
        } else {
            gemm_loop<64, 1, false>(c, ap, bp, bp, D, acc, acc);
            const int vn = nt - 16;
#pragma unroll
            for (int m = 0; m < 4; ++m) {
                f32x4 ss = {0.f, 0.f, 0.f, 0.f};
                const int t0 = mt * 128 + wr * 64 + m * 16 + fq * 4;
#pragma unroll
                for (int n = 0; n < 4; ++n) {
                    const int ch = vn * 128 + wc * 64 + n * 16 + fr;
                    f32x4 v = acc[m][n];
                    v.x = gelu_tanh(v.x); v.y = gelu_tanh(v.y); v.z = gelu_tanh(v.z); v.w = gelu_tanh(v.w);
                    ss += v * v;
                    u32x2 o; o.x = pk_bf16(v.x, v.y); o.y = pk_bf16(v.z, v.w);
                    *(u32x2*)(VT + (size_t)ch * T + t0) = o;
                }
#pragma unroll
                for (int o = 1; o < 16; o <<= 1) { ss.x += __shfl_xor(ss.x, o); ss.y += __shfl_xor(ss.y, o); ss.z += __shfl_xor(ss.z, o); ss.w += __shfl_xor(ss.w, o); }
                if (fr == 0) {
                    VSS[(size_t)(t0 + 0) * 32 + vn * 2 + wc] = ss.x; VSS[(size_t)(t0 + 1) * 32 + vn * 2 + wc] = ss.y;
                    VSS[(size_t)(t0 + 2) * 32 + vn * 2 + wc] = ss.z; VSS[(size_t)(t0 + 3) * 32 + vn * 2 + wc] = ss.w;
                }
            }
        }
    }
}

__device__ __forceinline__ void phase_a2(const Ctx& c, bool dry = false) {
    const __attribute__((address_space(4))) Args& a = *c.a;
    bf16_t* U = (bf16_t*)(c.ws + WS_U); const bf16_t* VT = (const bf16_t*)(c.ws + WS_VT); const float* VSS = (const float*)(c.ws + WS_VSS);
    const float* ws_ = (const float*)a.in[IN_AWS]; const float* bs_ = (const float*)a.in[IN_ABS]; const float* vg = (const float*)a.in[IN_AVG];
    const int fr = c.lane & 15, fq = c.lane >> 4, wr = c.wave >> 1, wc = c.wave & 1, tid = c.tid;
    LAS unsigned char* lds = c.lds;
    LAS float* rl = (LAS float*)(lds + LDS_MAIN);
    for (int u = c.vb; u < 128 * 8; u += c.nb) {
        const int ci = u >> 3, g = u & 7, tokbase = ci * 128;
        __syncthreads();
        if (tid < 128) {
            const float* p = VSS + (size_t)(tokbase + tid) * 32; float s = 0.f;
#pragma unroll
            for (int i = 0; i < 8; ++i) { const f32x4 q = ((const f32x4*)p)[i]; s += (q.x + q.y) + (q.z + q.w); }
            rl[tid] = rsqrtf(s * (1.f / GW) + EPS);
        }
        __syncthreads();
        {
            const int t = tid >> 1, half = tid & 1;
            const float* wrow = ws_ + ((size_t)g * 128 + t) * 128 + half * 64;
#pragma unroll
            for (int cc = 0; cc < 8; ++cc) {
                const int s0 = half * 64 + cc * 8;
                u32x4 o;
                {
                    const f32x4 w0 = ((const f32x4*)wrow)[2 * cc], w1 = ((const f32x4*)wrow)[2 * cc + 1];
                    float e[8] = {w0.x, w0.y, w0.z, w0.w, w1.x, w1.y, w1.z, w1.w};
                    const f32x4 r0_ = *(const LAS f32x4*)(rl + s0), r1_ = *(const LAS f32x4*)(rl + s0 + 4);
                    const float rr[8] = {r0_.x, r0_.y, r0_.z, r0_.w, r1_.x, r1_.y, r1_.z, r1_.w};
#pragma unroll
                    for (int i = 0; i < 8; ++i) e[i] = (s0 + i <= t) ? e[i] * rr[i] : 0.f;
                    o.x = pk_bf16(e[0], e[1]); o.y = pk_bf16(e[2], e[3]); o.z = pk_bf16(e[4], e[5]); o.w = pk_bf16(e[6], e[7]);
                }
                *(LAS u32x4*)(lds + half * 16384 + t * 128 + ((cc ^ (t & 7)) << 4)) = o;
            }
        }
        for (int hn = 0; hn < 2; ++hn) {
            const int c0 = g * 256 + hn * 128;
            const bf16_t* bp[4]; rows_regular<64>(bp, VT + (size_t)c0 * T + tokbase, T, tid);
            stage_tile<64>(lds + 32768, bp, 0, tid); stage_tile<64>(lds + 32768 + 16384, bp, 64, tid);
            VM_WAIT();
            __syncthreads();
            f32x4 acc[4][4]; zero_acc(acc);
#pragma unroll 1
            for (int kh = 0; kh < 2; ++kh)
#pragma unroll 1
                for (int ks = 0; ks < 2; ++ks) {
                    bf16x8 af[4], bf[4];
#pragma unroll
                    for (int m = 0; m < 4; ++m) af[m] = *(const LAS bf16x8*)(lds + kh * 16384 + frag_off<64>(wr * 64 + m * 16 + fr, ks, fq));
#pragma unroll
                    for (int n = 0; n < 4; ++n) bf[n] = *(const LAS bf16x8*)(lds + 32768 + kh * 16384 + frag_off<64>(wc * 64 + n * 16 + fr, ks, fq));
#pragma unroll
                    for (int m = 0; m < 4; ++m)
#pragma unroll
                        for (int n = 0; n < 4; ++n) acc[m][n] = __builtin_amdgcn_mfma_f32_16x16x32_bf16(bf[n], af[m], acc[m][n], 0, 0, 0);
                }
            u32x2 uvv[4][4]; float bsvv[4];
#pragma unroll
            for (int m = 0; m < 4; ++m) { const int tl = wr * 64 + m * 16 + fr; bsvv[m] = bs_[g * 128 + tl];
#pragma unroll
                for (int n = 0; n < 4; ++n) uvv[m][n] = *(const u32x2*)(U + (size_t)(tokbase + tl) * GW + c0 + wc * 64 + n * 16 + fq * 4); }
#pragma unroll
            for (int m = 0; m < 4; ++m) {
                const int tl = wr * 64 + m * 16 + fr; const float bsv = bsvv[m];
#pragma unroll
                for (int n = 0; n < 4; ++n) {
                    const int ch = c0 + wc * 64 + n * 16 + fq * 4;
                    const f32x4 gn = *(const f32x4*)(vg + ch);
                    u32x2* up = (u32x2*)(U + (size_t)(tokbase + tl) * GW + ch);
                    const u32x2 uv = uvv[m][n]; const f32x4 v = acc[m][n];
                    u32x2 o;
                    o.x = pk_bf16(bf_lo(uv.x) * (gn.x * v.x + bsv), bf_hi(uv.x) * (gn.y * v.y + bsv));
                    o.y = pk_bf16(bf_lo(uv.y) * (gn.z * v.z + bsv), bf_hi(uv.y) * (gn.w * v.w + bsv));
                    if (dry) *(u32x2*)(c.ws + 440 * MB + ((size_t)(tokbase + tl) * GW + ch) * 2) = o; else *up = o;
                }
            }
            __syncthreads();
        }
    }
}

__device__ __forceinline__ void phase_a3(const Ctx& c) {
    const bf16_t* Z = (const bf16_t*)(c.ws + WS_U); const bf16_t* W = (const bf16_t*)(c.ws + WS_WAOUT);
    const float* X = (const float*)c.a->in[IN_X]; float* H = (float*)(c.ws + WS_H);
    const int fr = c.lane & 15, fq = c.lane >> 4, wr = c.wave >> 1, wc = c.wave & 1;
    for (int u = c.vb; u < 128 * 8; u += c.nb) {
        int mt, nt; map_unit(u, 8, mt, nt);
        const bf16_t* ap[4]; const bf16_t* bp[4];
        rows_regular<64>(ap, Z + (size_t)mt * 128 * GW, GW, c.tid); rows_regular<64>(bp, W + (size_t)nt * 128 * GW, GW, c.tid);
        f32x4 acc[4][4];
#pragma unroll
        for (int m = 0; m < 4; ++m)
#pragma unroll
            for (int n = 0; n < 4; ++n) acc[m][n] = *(const f32x4*)(X + (size_t)(mt * 128 + wr * 64 + m * 16 + fr) * D + nt * 128 + wc * 64 + n * 16 + fq * 4);
        gemm_loop<64, 1, true>(c, ap, bp, bp, GW, acc, acc);
#pragma unroll
        for (int m = 0; m < 4; ++m)
#pragma unroll
            for (int n = 0; n < 4; ++n) *(f32x4*)(H + (size_t)(mt * 128 + wr * 64 + m * 16 + fr) * D + nt * 128 + wc * 64 + n * 16 + fq * 4) = acc[m][n];
    }
}

__device__ __forceinline__ void phase_route(const Ctx& c, int l, bool dry = false) {
    const __attribute__((address_space(4))) Args& a = *c.a;
    const float* H = (const float*)(c.ws + WS_H); bf16_t* XN = (bf16_t*)(c.ws + (dry ? 440 * MB : WS_XN));
    const float* wr_ = (const float*)(c.ws + WS_WR) + (size_t)l * D * 48;
    const float* gain = (const float*)a.in[IN_FFNN] + l * D;
    int* cnt = (int*)(c.ws + WS_CNT) + l * 32 + (dry ? 64 : 0); int* list = (int*)(c.ws + (dry ? 480 * MB : WS_LIST)); float* gatel = (float*)(c.ws + (dry ? 484 * MB : WS_GATE)); int* tokslot = (int*)(c.ws + (dry ? 488 * MB : WS_TOKSLOT));
    LAS float* rl = (LAS float*)(c.lds);
    LAS float* lgl = (LAS float*)(c.lds + 256);
    const int lane = c.lane, w = c.wave;
    f32x4 gv[4]; gain_load(gain, lane, gv);
    for (int unit = c.vb; unit < T / 32; unit += c.nb) {
        const int tok0 = unit * 32;
        __syncthreads();
        for (int i = 0; i < 8; ++i) {
            const int t = tok0 + w * 8 + i;
            f32x4 v[4]; row_load(H + (size_t)t * D, lane, v);
            const float r = rsqrtf(row_sumsq(v) * (1.f / D) + EPS);
            if (lane == 0) rl[w * 8 + i] = r;
            row_store_norm_fp8(c.ws + (dry ? 440 * MB : WS_XN8) + (size_t)t * D, lane, v, r, gv);
        }
        {
            const int th = w & 1, kh = w >> 1, m = lane & 15, q = lane >> 4;
            const float* arow = H + (size_t)(tok0 + 16 * th + m) * D + 512 * kh + 128 * q;
            const float* brow = wr_ + (size_t)(512 * kh + 128 * q) * 48 + m;
            f32x4 acc[3]; acc[0] = acc[1] = acc[2] = (f32x4){0.f, 0.f, 0.f, 0.f};
            for (int i = 0; i < 32; ++i) {
                const f32x4 av = ((const f32x4*)arow)[i];
                const float ae[4] = {av.x, av.y, av.z, av.w};
#pragma unroll
                for (int e = 0; e < 4; ++e) {
                    const float* bp = brow + (size_t)(4 * i + e) * 48;
#pragma unroll
                    for (int nt = 0; nt < 3; ++nt) acc[nt] = __builtin_amdgcn_mfma_f32_16x16x4f32(ae[e], bp[nt * 16], acc[nt], 0, 0, 0);
                }
            }
#pragma unroll
            for (int nt = 0; nt < 3; ++nt)
#pragma unroll
                for (int j = 0; j < 4; ++j) lgl[(kh * 32 + th * 16 + 4 * q + j) * 48 + nt * 16 + m] = acc[nt][j];
        }
        __syncthreads();
        if (c.tid < 32) {
            const int tt = c.tid, t = tok0 + tt; const float r = rl[tt];
            const float* bg = (const float*)a.in[IN_BG] + l * 4; const float* be = (const float*)a.in[IN_BE] + l * 32;
            float gl[4];
#pragma unroll
            for (int o = 0; o < 4; ++o) gl[o] = (lgl[tt * 48 + o] + lgl[(32 + tt) * 48 + o]) * r + bg[o];
            int gs = 0; float gm = gl[0];
#pragma unroll
            for (int o = 1; o < 4; ++o) if (gl[o] > gm) { gm = gl[o]; gs = o; }
            float gden = 0.f;
#pragma unroll
            for (int o = 0; o < 4; ++o) gden += __expf(gl[o] - gm);
            const float pg = 1.f / gden;
            float l1 = -INFINITY, l2 = -INFINITY; int i1 = 0, i2 = 0;
            for (int i = 0; i < 8; ++i) {
                const int o = 4 + gs * 8 + i;
                const float v = (lgl[tt * 48 + o] + lgl[(32 + tt) * 48 + o]) * r + be[gs * 8 + i];
                if (v > l1) { l2 = l1; i2 = i1; l1 = v; i1 = i; } else if (v > l2) { l2 = v; i2 = i; }
            }
            const float e2 = __expf(l2 - l1), inv = 1.f / (1.f + e2);
            const float g1 = pg * inv, g2 = pg * e2 * inv;
            const int ea = gs * 8 + i1, eb = gs * 8 + i2;
            const int sa = atomicAdd(&cnt[ea], 1), sb = atomicAdd(&cnt[eb], 1);
            list[ea * T + sa] = t; gatel[ea * T + sa] = g1; tokslot[2 * t] = (ea << 16) | sa;
            list[eb * T + sb] = t; gatel[eb * T + sb] = g2; tokslot[2 * t + 1] = (eb << 16) | sb;
        }
    }
}

__device__ __forceinline__ void moe_table(const Ctx& c, int l, LAS int* pst, LAS int* cn) {
    __syncthreads();
    if (c.tid == 0) {
        const int* cnt = (const int*)(c.ws + WS_CNT) + l * 32; int acc = 0;
        for (int e = 0; e < 32; ++e) { const int n = cnt[e]; cn[e] = n; pst[e] = acc; acc += (n + 127) >> 7; }
        pst[32] = acc;
    }
    __syncthreads();
}
__device__ __forceinline__ int moe_find(LAS const int* pst, int mb) { int e = 0; for (int i = 1; i < 32; ++i) e = (pst[i] <= mb) ? i : e; return e; }

__device__ __forceinline__ void phase_e1(const Ctx& c, int l) {
    const unsigned char* XN8 = c.ws + WS_XN8; const unsigned char* W1 = c.ws + WS_W1; const unsigned char* W3 = c.ws + WS_W3;
    unsigned char* HM = c.ws + WS_HMID; const int* list = (const int*)(c.ws + WS_LIST);
    LAS int* pst = (LAS int*)(c.lds + LDS_MAIN); LAS int* cn = pst + 40;
    moe_table(c, l, pst, cn);
    const int fr = c.lane & 15, fq = c.lane >> 4, wr = c.wave >> 1, wc = c.wave & 1, tid = c.tid;
    const int nunits = pst[32] * 8;
    for (int u = c.vb; u < nunits; u += c.nb) {
        const int mb = u >> 3, h0 = (u & 7) * 64, e = moe_find(pst, mb), row0 = (mb - pst[e]) * 128, count = cn[e];
        const bf16_t* ap[4]; const bf16_t* bp[4];
#pragma unroll
        for (int p = 0; p < 4; ++p) {
            int r = row0 + p * 32 + (tid >> 3); r = r < count ? r : row0; ap[p] = (const bf16_t*)(XN8 + (size_t)list[e * T + r] * D);
            const int rb = p * 32 + (tid >> 3), hid = h0 + (rb >> 6) * 32 + ((rb >> 4) & 1) * 16 + (rb & 15);
            bp[p] = (const bf16_t*)((((rb >> 5) & 1) ? W3 : W1) + ((size_t)e * DE + hid) * D);
        }
        f32x4 acc[4][4]; zero_acc(acc);
        gemm_loop<64, 1, true, true>(c, ap, bp, bp, D / 2, acc, acc);
        const float ws_ = 1.f / W8_SCALE;
#pragma unroll
        for (int m = 0; m < 4; ++m)
#pragma unroll
            for (int n = 0; n < 2; ++n) {
                const size_t row = (size_t)mb * 128 + wr * 64 + m * 16 + fr; const int col = h0 + wc * 32 + n * 16 + fq * 4;
                const f32x4 x = acc[m][n] * ws_, y = acc[m][n + 2] * (ws_ * H8_SCALE);
                *(unsigned*)(HM + row * DE + col) = pk_fp8x4(x.x * sigmoidf_(x.x) * y.x, x.y * sigmoidf_(x.y) * y.y, x.z * sigmoidf_(x.z) * y.z, x.w * sigmoidf_(x.w) * y.w);
            }
    }
}
__device__ __forceinline__ void phase_e2(const Ctx& c, int l) {
    const unsigned char* HM = c.ws + WS_HMID; const unsigned char* W2 = c.ws + WS_W2;
    bf16_t* Y = (bf16_t*)(c.ws + WS_Y); const float* gatel = (const float*)(c.ws + WS_GATE);
    LAS int* pst = (LAS int*)(c.lds + LDS_MAIN); LAS int* cn = pst + 40;
    moe_table(c, l, pst, cn);
    const int fr = c.lane & 15, fq = c.lane >> 4, wr = c.wave >> 1, wc = c.wave & 1, tid = c.tid;
    const int nunits = pst[32] * 8;
    for (int u = c.vb; u < nunits; u += c.nb) {
        const int mb = u >> 3, nt = u & 7, e = moe_find(pst, mb), row0 = (mb - pst[e]) * 128, count = cn[e];
        const bf16_t* ap[4]; const bf16_t* bp[4];
        rows_regular<64>(ap, (const bf16_t*)(HM + (size_t)mb * 128 * DE), DE / 2, tid); rows_regular<64>(bp, (const bf16_t*)(W2 + ((size_t)e * D + nt * 128) * DE), DE / 2, tid);
        f32x4 acc[4][4]; zero_acc(acc);
        gemm_loop<64, 1, true, true>(c, ap, bp, bp, DE / 2, acc, acc);
        float gtv[4];
#pragma unroll
        for (int m = 0; m < 4; ++m) { const int rl_ = wr * 64 + m * 16 + fr; gtv[m] = (row0 + rl_ < count) ? gatel[e * T + row0 + rl_] * (1.f / (W8_SCALE * H8_SCALE)) : 0.f; }
#pragma unroll
        for (int m = 0; m < 4; ++m) {
            const int rl_ = wr * 64 + m * 16 + fr; const float gt = gtv[m];
#pragma unroll
            for (int n = 0; n < 4; ++n) {
                const f32x4 v = acc[m][n] * gt;
                u32x2 o; o.x = pk_bf16(v.x, v.y); o.y = pk_bf16(v.z, v.w);
                *(u32x2*)(Y + ((size_t)mb * 128 + rl_) * D + nt * 128 + wc * 64 + n * 16 + fq * 4) = o;
            }
        }
    }
}
__device__ __forceinline__ void phase_p1(const Ctx& c, int l, bool dry = false) {
    float* H = (float*)(c.ws + WS_H); float* HO = (float*)(c.ws + (dry ? 440 * MB : WS_H)); bf16_t* XN = (bf16_t*)(c.ws + (dry ? 440 * MB : WS_XN)); const bf16_t* Y = (const bf16_t*)(c.ws + WS_Y);
    const int* tokslot = (const int*)(c.ws + WS_TOKSLOT); const float* gain = (const float*)c.a->in[IN_PLEN] + l * D;
    LAS int* pst = (LAS int*)(c.lds + LDS_MAIN); LAS int* cn = pst + 40;
    moe_table(c, l, pst, cn);
    const int gw = c.vb * 4 + c.wave, ngw = c.nb * 4, lane = c.lane;
    f32x4 gv[4]; gain_load(gain, lane, gv);
    int s0n = 0, s1n = 0;
    if (gw < T) { s0n = tokslot[2 * gw]; s1n = tokslot[2 * gw + 1]; }
    for (int t = gw; t < T; t += ngw) {
        const int s0 = s0n, s1 = s1n;
        { const int tn = (t + ngw < T) ? t + ngw : t; s0n = tokslot[2 * tn]; s1n = tokslot[2 * tn + 1]; }
        const bf16_t* y0 = Y + ((size_t)pst[s0 >> 16] * 128 + (s0 & 0xffff)) * D; const bf16_t* y1 = Y + ((size_t)pst[s1 >> 16] * 128 + (s1 & 0xffff)) * D;
        f32x4 v[4]; u32x2 a0[4], a1[4];
        row_load(H + (size_t)t * D, lane, v);
#pragma unroll
        for (int j = 0; j < 4; ++j) { a0[j] = ((const u32x2*)y0)[lane + 64 * j]; a1[j] = ((const u32x2*)y1)[lane + 64 * j]; }
#pragma unroll
        for (int j = 0; j < 4; ++j) {
            v[j].x += bf_lo(a0[j].x) + bf_lo(a1[j].x); v[j].y += bf_hi(a0[j].x) + bf_hi(a1[j].x); v[j].z += bf_lo(a0[j].y) + bf_lo(a1[j].y); v[j].w += bf_hi(a0[j].y) + bf_hi(a1[j].y);
        }
#pragma unroll
        for (int j = 0; j < 4; ++j) ((f32x4*)(HO + (size_t)t * D))[lane + 64 * j] = v[j];
        const float r = rsqrtf(row_sumsq(v) * (1.f / D) + EPS);
        row_store_norm_fp8(c.ws + (dry ? 440 * MB : WS_XN8) + (size_t)t * D, lane, v, r, gv);
    }
}
__device__ __forceinline__ void phase_p2(const Ctx& c, int l) {
    const bf16_t* XN = (const bf16_t*)(c.ws + WS_XN); const bf16_t* WG = (const bf16_t*)(c.ws + WS_WGATE) + (size_t)l * D * D;
    const bf16_t* PB = (const bf16_t*)(c.ws + WS_PBF) + (size_t)l * T * PLE; const bf16_t* WP = (const bf16_t*)(c.ws + WS_WPROJ) + (size_t)l * D * PLE;
    float* H = (float*)(c.ws + WS_H);
    const int fr = c.lane & 15, fq = c.lane >> 4, wr = c.wave >> 1, wc = c.wave & 1;
    for (int u = c.vb; u < 128 * 8; u += c.nb) {
        int mt, nt; map_unit(u, 8, mt, nt);
        const bf16_t* ap[4]; const bf16_t* bp[4];
        f32x4 ag[4][4], apj[4][4]; zero_acc(ag); zero_acc(apj);
        rows_regular<64>(ap, (const bf16_t*)(c.ws + WS_XN8 + (size_t)mt * 128 * D), D / 2, c.tid); rows_regular<64>(bp, (const bf16_t*)(c.ws + WS_WGATE + ((size_t)l * D + nt * 128) * D), D / 2, c.tid);
        gemm_loop<64, 1, true, true>(c, ap, bp, bp, D / 2, ag, ag);
        rows_regular<64>(ap, PB + (size_t)mt * 128 * PLE, PLE, c.tid); rows_regular<64>(bp, WP + (size_t)nt * 128 * PLE, PLE, c.tid);
        gemm_loop<64, 1, true>(c, ap, bp, bp, PLE, apj, apj);
        f32x4 hres[4][4];
#pragma unroll
        for (int m = 0; m < 4; ++m)
#pragma unroll
            for (int n = 0; n < 4; ++n) hres[m][n] = *(const f32x4*)(H + (size_t)(mt * 128 + wr * 64 + m * 16 + fr) * D + nt * 128 + wc * 64 + n * 16 + fq * 4);
#pragma unroll
        for (int m = 0; m < 4; ++m)
#pragma unroll
            for (int n = 0; n < 4; ++n) {
                const size_t off = (size_t)(mt * 128 + wr * 64 + m * 16 + fr) * D + nt * 128 + wc * 64 + n * 16 + fq * 4;
                const f32x4 g = ag[m][n] * (1.f / W8_SCALE), pj = apj[m][n]; f32x4 h = hres[m][n];
                h.x += sigmoidf_(g.x) * pj.x; h.y += sigmoidf_(g.y) * pj.y; h.z += sigmoidf_(g.z) * pj.z; h.w += sigmoidf_(g.w) * pj.w;
                *(f32x4*)(H + off) = h;
            }
    }
}
__device__ __forceinline__ void phase_norm_bf16(const Ctx& c, const float* gain) {
    const float* H = (const float*)(c.ws + WS_H);
    const int gw = c.vb * 4 + c.wave, ngw = c.nb * 4;
    f32x4 gv[4]; gain_load(gain, c.lane, gv);
    for (int t = gw; t < T; t += ngw) {
        f32x4 v[4]; row_load(H + (size_t)t * D, c.lane, v);
        const float r = rsqrtf(row_sumsq(v) * (1.f / D) + EPS);
        row_store_norm_fp8(c.ws + WS_XN8 + (size_t)t * D, c.lane, v, r, gv);
        row_store_norm_bf16((bf16_t*)(c.ws + WS_XN) + (size_t)t * D, c.lane, v, r, gv);
    }
}
__device__ __forceinline__ void phase_final(const Ctx& c) {
    const float* H = (const float*)(c.ws + WS_H); float* O = c.a->out; const float* gain = (const float*)c.a->in[IN_FINN];
    const int gw = c.vb * 4 + c.wave, ngw = c.nb * 4;
    f32x4 gv[4]; gain_load(gain, c.lane, gv);
    for (int t = gw; t < T; t += ngw) {
        f32x4 v[4]; row_load(H + (size_t)t * D, c.lane, v);
        const float r = rsqrtf(row_sumsq(v) * (1.f / D) + EPS);
#pragma unroll
        for (int j = 0; j < 4; ++j) ((f32x4*)(O + (size_t)t * D))[c.lane + 64 * j] = v[j] * r * gv[j];
    }
}

__device__ __forceinline__ void phase_b1(const Ctx& c, size_t raw_off = WS_RAW) {
    const bf16_t* XN = (const bf16_t*)(c.ws + WS_XN); const bf16_t* W = (const bf16_t*)(c.ws + WS_WBIN); bf16_t* RAW = (bf16_t*)(c.ws + raw_off);
    const int fr = c.lane & 15, fq = c.lane >> 4, wr = c.wave >> 1, wc = c.wave & 1;
    for (int u = c.vb; u < 128 * 17; u += c.nb) {
        int mt, nt; map_unit(u, 17, mt, nt);
        const bf16_t* ap[4]; const bf16_t* bp[4];
        f32x4 acc[4][4]; zero_acc(acc);
        float osc = 1.f;
        if (nt < 12) {
            rows_regular<64>(ap, (const bf16_t*)(c.ws + WS_XN8 + (size_t)mt * 128 * D), D / 2, c.tid); rows_regular<64>(bp, (const bf16_t*)(c.ws + WS_WBIN + (size_t)nt * 128 * D), D / 2, c.tid);
            gemm_loop<64, 1, true, true>(c, ap, bp, bp, D / 2, acc, acc);
            osc = 1.f / W8_SCALE;
        } else {
            rows_regular<64>(ap, XN + (size_t)mt * 128 * D, D, c.tid); rows_regular<64>(bp, (const bf16_t*)(c.ws + WS_WBIN + 3 * MB) + (size_t)(nt - 12) * 128 * D, D, c.tid);
            gemm_loop<64, 1, true>(c, ap, bp, bp, D, acc, acc);
        }
#pragma unroll
        for (int m = 0; m < 4; ++m)
#pragma unroll
            for (int n = 0; n < 4; ++n) {
                const f32x4 v = acc[m][n] * osc; u32x2 o; o.x = pk_bf16(v.x, v.y); o.y = pk_bf16(v.z, v.w);
                *(u32x2*)(RAW + (size_t)(mt * 128 + wr * 64 + m * 16 + fr) * BINP + nt * 128 + wc * 64 + n * 16 + fq * 4) = o;
            }
    }
}

__device__ __forceinline__ void unpack8(const u32x4 r, float (&e)[8]) { e[0] = bf_lo(r.x); e[1] = bf_hi(r.x); e[2] = bf_lo(r.y); e[3] = bf_hi(r.y); e[4] = bf_lo(r.z); e[5] = bf_hi(r.z); e[6] = bf_lo(r.w); e[7] = bf_hi(r.w); }
__device__ __forceinline__ u32x4 pack8(const float (&e)[8]) { u32x4 o; o.x = pk_bf16(e[0], e[1]); o.y = pk_bf16(e[2], e[3]); o.z = pk_bf16(e[4], e[5]); o.w = pk_bf16(e[6], e[7]); return o; }
__device__ __forceinline__ void phase_rope(const Ctx& c) {
    const bf16_t* RAW = (const bf16_t*)(c.ws + WS_RAW);
    bf16_t* Q = (bf16_t*)(c.ws + WS_Q); bf16_t* K = (bf16_t*)(c.ws + WS_K); bf16_t* V = (bf16_t*)(c.ws + WS_V);
    bf16_t* QI = (bf16_t*)(c.ws + WS_QI); bf16_t* KI = (bf16_t*)(c.ws + WS_KI); float* WI = (float*)(c.ws + WS_WI);
    const int* pos = (const int*)c.a->in[IN_POS];
    LAS float* cs = (LAS float*)(c.lds + c.wave * 256);
    const int gw = c.vb * 4 + c.wave, ngw = c.nb * 4, lane = c.lane;
    const double ex = (lane < 16) ? (double)lane * (1.0 / 16.0) : (double)((lane - 16) & 7) * (1.0 / 8.0);
    const float invf = (float)exp2(-ex * 18.931568569324174);
    for (int t = gw; t < T; t += ngw) {
        if (lane < 24) {
            const float ang = (float)pos[t] * invf;
            const double ad = (double)ang; const double n = rint(ad * 0.15915494309189535); const float red = (float)(ad - n * 6.283185307179586);
            cs[lane] = __cosf(red); cs[32 + lane] = __sinf(red);
        }
        LDS_WAIT();
        const bf16_t* row = RAW + (size_t)t * BINP;
        for (int ch = lane; ch < BINP / 8; ch += 64) {
            const u32x4 own = ((const u32x4*)row)[ch];
            float e[8]; unpack8(own, e);
            if (ch < 160) {
                const int cc = ch & 15;
                if (cc < 4) {
                    const u32x4 oth = ((const u32x4*)row)[ch ^ 2]; float p[8]; unpack8(oth, p);
                    const int f0 = (cc & 1) * 8;
#pragma unroll
                    for (int i = 0; i < 8; ++i) { const float co = cs[f0 + i], si = cs[32 + f0 + i]; e[i] = (cc < 2) ? (e[i] * co - p[i] * si) : (e[i] * co + p[i] * si); }
                }
                u32x2 o8; o8.x = pk_fp8x4(e[0], e[1], e[2], e[3]); o8.y = pk_fp8x4(e[4], e[5], e[6], e[7]);
                if (ch < 128) ((u32x2*)((unsigned char*)Q + (size_t)t * D))[ch] = o8;
                else ((u32x2*)((unsigned char*)K + (size_t)t * 256))[ch - 128] = o8;
            } else if (ch < 192) {
                u32x2 o8; o8.x = pk_fp8x4(e[0], e[1], e[2], e[3]); o8.y = pk_fp8x4(e[4], e[5], e[6], e[7]);
                ((u32x2*)((unsigned char*)V + (size_t)t * 256))[ch - 160] = o8;
            } else if (ch < 264) {
                const int cc = ch & 7;
                if (cc < 2) {
                    const u32x4 oth = ((const u32x4*)row)[ch ^ 1]; float p[8]; unpack8(oth, p);
#pragma unroll
                    for (int i = 0; i < 8; ++i) { const float co = cs[16 + i], si = cs[32 + 16 + i]; e[i] = (cc == 0) ? (e[i] * co - p[i] * si) : (e[i] * co + p[i] * si); }
                }
                if (ch < 256) ((u32x4*)(QI + (size_t)t * 512))[ch - 192] = pack8(e);
                else ((u32x4*)(KI + (size_t)t * 64))[ch - 256] = pack8(e);
            } else if (ch == 264) {
                f32x4 w0 = {e[0], e[1], e[2], e[3]}, w1 = {e[4], e[5], e[6], e[7]};
                const float sc = 0.044194173824159216f;
                ((f32x4*)(WI + (size_t)t * 8))[0] = w0 * sc; ((f32x4*)(WI + (size_t)t * 8))[1] = w1 * sc;
            }
        }
        LDS_WAIT();
    }
}

__device__ __forceinline__ size_t srow_off(int t) { const int m = t >> 6, r = t & 63; return (size_t)64 * (m + 1) * (32 * m + r); }
constexpr size_t S_BATCH = (size_t)64 * 65 * 2048;
constexpr int SCORE_UNITS = 4 * 312;
__device__ __forceinline__ void phase_score(const Ctx& c) {
    const bf16_t* QI = (const bf16_t*)(c.ws + WS_QI); const bf16_t* KI = (const bf16_t*)(c.ws + WS_KI); const float* WI = (const float*)(c.ws + WS_WI);
    float* S = (float*)(c.ws + WS_S);
    const int lane = c.lane, hf = lane >> 5, col = lane & 31, w = c.wave;
    for (int u = c.vb; u < SCORE_UNITS; u += c.nb) {
        const int b = u & 3, r = u >> 2;
        int kc, qb;
        if (r < 120) { kc = 0; qb = 8 + r; } else if (r < 216) { kc = 1; qb = 32 + (r - 120); } else if (r < 280) { kc = 2; qb = 64 + (r - 216); } else { kc = 3; qb = 96 + (r - 280); }
        const int tb = b * SEQ, t0 = 32 * qb + 8 * w;
        bf16x8 af[2][4]; f32x4 wv[2][4];
        { const int rho = lane & 31, ql = 2 * ((rho >> 2) & 1) + (rho >> 4), hd = 4 * ((rho >> 3) & 1) + (rho & 3);
#pragma unroll
          for (int a = 0; a < 2; ++a) {
              const bf16_t* qp = QI + (size_t)(tb + t0 + 4 * a + ql) * 512 + hd * 64 + 8 * hf;
#pragma unroll
              for (int ks = 0; ks < 4; ++ks) af[a][ks] = *(const bf16x8*)(qp + 16 * ks);
              const float* wp = WI + (size_t)(tb + t0 + 4 * a + 2 * hf) * 8;
#pragma unroll
              for (int i = 0; i < 4; ++i) wv[a][i] = ((const f32x4*)wp)[i];
          } }
        const int ntile = min(32, qb + 1 - 32 * kc), key0 = 1024 * kc;
        float* Sb = S + (size_t)b * S_BATCH;
        size_t ro[2][2];
#pragma unroll
        for (int a = 0; a < 2; ++a) { ro[a][0] = srow_off(t0 + 4 * a + 2 * hf); ro[a][1] = srow_off(t0 + 4 * a + 2 * hf + 1); }
        const int nsub = (ntile + 3) >> 2;
        const bf16_t* krp[4];
        rows_regular<64>(krp, KI + (size_t)(tb + key0) * 64, 64, c.tid);
        __syncthreads();
        stage_tile<64>(c.lds, krp, 0, c.tid);
        for (int sc = 0; sc < nsub; ++sc) {
            VM_WAIT();
            __syncthreads();
            const LAS unsigned char* cur = c.lds + (sc & 1) * 16384;
            if (sc + 1 < nsub) stage_tile<64>(c.lds + ((sc + 1) & 1) * 16384, krp, (sc + 1) * 128 * 64, c.tid);
#pragma unroll
            for (int j = 0; j < 4; ++j) {
                const int kt = 4 * sc + j;
                if (kt < ntile) {
                    const int key = key0 + 32 * kt + col, row = 32 * j + col;
                    bf16x8 cb[4];
#pragma unroll
                    for (int ks = 0; ks < 4; ++ks) cb[ks] = *(const LAS bf16x8*)(cur + row * 128 + (((2 * ks + hf) ^ (row & 7)) << 4));
#pragma unroll
                    for (int a = 0; a < 2; ++a) {
                        f32x16 acc = {};
#pragma unroll
                        for (int ks = 0; ks < 4; ++ks) acc = __builtin_amdgcn_mfma_f32_32x32x16_bf16(af[a][ks], cb[ks], acc, 0, 0, 0);
                        float s0 = fmaxf(acc[0], 0.f) * wv[a][0].x; s0 += fmaxf(acc[1], 0.f) * wv[a][0].y; s0 += fmaxf(acc[2], 0.f) * wv[a][0].z; s0 += fmaxf(acc[3], 0.f) * wv[a][0].w;
                        s0 += fmaxf(acc[4], 0.f) * wv[a][1].x; s0 += fmaxf(acc[5], 0.f) * wv[a][1].y; s0 += fmaxf(acc[6], 0.f) * wv[a][1].z; s0 += fmaxf(acc[7], 0.f) * wv[a][1].w;
                        float s1 = fmaxf(acc[8], 0.f) * wv[a][2].x; s1 += fmaxf(acc[9], 0.f) * wv[a][2].y; s1 += fmaxf(acc[10], 0.f) * wv[a][2].z; s1 += fmaxf(acc[11], 0.f) * wv[a][2].w;
                        s1 += fmaxf(acc[12], 0.f) * wv[a][3].x; s1 += fmaxf(acc[13], 0.f) * wv[a][3].y; s1 += fmaxf(acc[14], 0.f) * wv[a][3].z; s1 += fmaxf(acc[15], 0.f) * wv[a][3].w;
                        const int tA = t0 + 4 * a + 2 * hf;
                        Sb[ro[a][0] + key] = (key <= tA) ? s0 : -INFINITY;
                        Sb[ro[a][1] + key] = (key <= tA + 1) ? s1 : -INFINITY;
                    }
                }
            }
        }
    }
}

constexpr int NBINS = 2048, CAND_CAP = 256, SEL_WAVE_LDS = 8192 + 2048 + 64;
__device__ __forceinline__ int clamp_bin(int x) { return min(max(x, 0), NBINS - 1); }
__device__ __forceinline__ void phase_select(const Ctx& c) {
    const float* S = (const float*)(c.ws + WS_S); int* SEL = (int*)(c.ws + WS_SEL);
    LAS int* hist = (LAS int*)(c.lds + c.wave * SEL_WAVE_LDS);
    LAS float* candv = (LAS float*)(hist + NBINS);
    LAS int* candi = (LAS int*)(candv + CAND_CAP);
    LAS int* thr = candi + CAND_CAP;
    const int gw = c.vb * 4 + c.wave, ngw = c.nb * 4;
    for (int j = gw; j < 4 * 3840; j += ngw) {
        int lane = c.lane;
        asm volatile("" : "+v"(lane));
        const int b = j & 3, t = 4095 - (j >> 2), ni = (t + 64) >> 6;
        const float* row = S + (size_t)b * S_BATCH + srow_off(t);
        float s[64];
#pragma unroll
        for (int g4 = 0; g4 < 4; ++g4) {
            if (16 * g4 < ni) {
#pragma unroll
                for (int i = 16 * g4; i < 16 * g4 + 16; ++i) { const int k = 64 * i + lane; const float v = row[min(k, t)]; s[i] = (k <= t) ? v : -INFINITY; }
            } else {
#pragma unroll
                for (int i = 16 * g4; i < 16 * g4 + 16; ++i) s[i] = -INFINITY;
            }
        }
        float mn = INFINITY, mx = -INFINITY;
#pragma unroll
        for (int g8 = 0; g8 < 8; ++g8) if (8 * g8 < ni) {
#pragma unroll
            for (int i = 8 * g8; i < 8 * g8 + 8; ++i) { mx = fmaxf(mx, s[i]); mn = fminf(mn, (s[i] == -INFINITY) ? INFINITY : s[i]); }
        }
#pragma unroll
        for (int o = 1; o < 64; o <<= 1) { mx = fmaxf(mx, __shfl_xor(mx, o)); mn = fminf(mn, __shfl_xor(mn, o)); }
        const float sc = (mx > mn) ? (float)NBINS / (mx - mn) : 0.f, a0 = -mn * sc;
#pragma unroll
        for (int i = 0; i < 8; ++i) ((LAS u32x4*)hist)[lane * 8 + i] = (u32x4){0u, 0u, 0u, 0u};
        LDS_WAIT();
#define BINOF(v) clamp_bin((int)__builtin_fmaf((v), sc, a0))
#pragma unroll
        for (int g8 = 0; g8 < 8; ++g8) if (8 * g8 < ni) {
#pragma unroll
            for (int i = 8 * g8; i < 8 * g8 + 8; ++i) lds_inc(&hist[BINOF(s[i])]);
        }
        LDS_WAIT();
        int bs, need;
        {
            const LAS int* hq = hist + lane * 32;
            u32x4 hr[8];
            int loc = 0;
#pragma unroll
            for (int i = 0; i < 8; ++i) { hr[i] = ((const LAS u32x4*)hq)[i]; loc += (int)(hr[i].x + hr[i].y + hr[i].z + hr[i].w); }
            int suf = loc;
#pragma unroll
            for (int o = 1; o < 64; o <<= 1) { const int v = __shfl_down(suf, o); if (lane + o < 64) suf += v; }
            const int above = suf - loc;
            const bool cross = (above < 256 && suf >= 256);
            int bsl = 0, abl = 0;
            { int run = above;
#pragma unroll
              for (int i = 31; i >= 0; --i) { const int h = (int)hr[i >> 2][i & 3]; const bool hit = (run < 256 && run + h >= 256); bsl = hit ? lane * 32 + i : bsl; abl = hit ? run : abl; run += h; } }
            const unsigned long long cm = __ballot(cross);
            const int src = cm ? (int)__builtin_ctzll(cm) : 0;
            bs = __shfl(bsl, src); need = 256 - __shfl(abl, src);
        }
        int bs2 = -1;
#define SUBOF(v) clamp_bin((int)((__builtin_fmaf((v), sc, a0) - (float)bs) * (float)NBINS))
        if (__shfl(hist[bs], 0) > 48) {
#pragma unroll
            for (int i = 0; i < 8; ++i) ((LAS u32x4*)hist)[lane * 8 + i] = (u32x4){0u, 0u, 0u, 0u};
            LDS_WAIT();
#pragma unroll
            for (int i = 0; i < 64; ++i) if (s[i] != -INFINITY && BINOF(s[i]) == bs) lds_inc(&hist[SUBOF(s[i])]);
            LDS_WAIT();
            const LAS int* hq = hist + lane * 32;
            int loc = 0;
#pragma unroll
            for (int i = 0; i < 8; ++i) { const u32x4 h4 = ((const LAS u32x4*)hq)[i]; loc += (int)(h4.x + h4.y + h4.z + h4.w); }
            int suf = loc;
#pragma unroll
            for (int o = 1; o < 64; o <<= 1) { const int v = __shfl_down(suf, o); if (lane + o < 64) suf += v; }
            const int above = suf - loc;
            const bool cross = (above < need && suf >= need);
            int bsl = 0, abl = 0;
            if (cross) { int run = above; for (int i = 31; i >= 0; --i) { const int h = hq[i]; if (run < need && run + h >= need) { bsl = lane * 32 + i; abl = run; } run += h; } }
            const unsigned long long cm = __ballot(cross);
            const int src = cm ? (int)__builtin_ctzll(cm) : 0;
            bs2 = __shfl(bsl, src); need = need - __shfl(abl, src);
        }
        asm volatile("" : "+v"(lane));
        float sc2 = sc, a02 = a0;
        asm volatile("" : "+v"(sc2), "+v"(a02));
#undef BINOF
#define BINOF(v) clamp_bin((int)__builtin_fmaf((v), sc2, a02))
        int* selr = SEL + ((size_t)b * SEQ + t) * 256;
        int nc = 0, base = 0;
#pragma unroll
        for (int g4 = 0; g4 < 4; ++g4) if (16 * g4 < ni) {
#pragma unroll
            for (int i = 16 * g4; i < 16 * g4 + 16; ++i) {
                const int bn = BINOF(s[i]);
                bool pc = (bn == bs) && (s[i] != -INFINITY), pd = (bn > bs);
                if (bs2 >= 0) { const int sb = SUBOF(s[i]); pd = pd || (pc && sb > bs2); pc = pc && (sb == bs2); }
                const unsigned long long md = __ballot(pd), mc = __ballot(pc);
                const int posd = base + (int)__builtin_amdgcn_mbcnt_hi((unsigned)(md >> 32), __builtin_amdgcn_mbcnt_lo((unsigned)md, 0u));
                const int posc = nc + (int)__builtin_amdgcn_mbcnt_hi((unsigned)(mc >> 32), __builtin_amdgcn_mbcnt_lo((unsigned)mc, 0u));
                if (pd && posd < 256) selr[posd] = 64 * i + lane;
                if (pc && posc < CAND_CAP) { candv[posc] = s[i]; candi[posc] = 64 * i + lane; }
                base += (int)__popcll(md); nc += (int)__popcll(mc);
            }
        }
        nc = min(nc, CAND_CAP);
        LDS_WAIT();
        for (int i = lane; i < nc; i += 64) {
            const float v = candv[i]; const int id = candi[i];
            int rank = 0;
            for (int k = 0; k < nc; ++k) { const float vk = candv[k]; const int ik = candi[k]; rank += (vk > v || (vk == v && ik < id)) ? 1 : 0; }
            if (rank < need && base + rank < 256) selr[base + rank] = id;
        }
        LDS_WAIT();
#undef BINOF
#undef SUBOF
    }
}

typedef short s16x4 __attribute__((ext_vector_type(4)));
__device__ __forceinline__ unsigned vimg_f(unsigned r) { return ((r & 3u) << 2) | ((r >> 2) & 3u); }
__device__ __forceinline__ void tr_read8(const unsigned (&ad)[8], s16x4 (&r)[8]) {
    asm volatile("ds_read_b64_tr_b16 %0, %8\n\tds_read_b64_tr_b16 %1, %9\n\tds_read_b64_tr_b16 %2, %10\n\tds_read_b64_tr_b16 %3, %11\n\t"
                 "ds_read_b64_tr_b16 %4, %12\n\tds_read_b64_tr_b16 %5, %13\n\tds_read_b64_tr_b16 %6, %14\n\tds_read_b64_tr_b16 %7, %15\n\ts_waitcnt lgkmcnt(0)"
                 : "=&v"(r[0]), "=&v"(r[1]), "=&v"(r[2]), "=&v"(r[3]), "=&v"(r[4]), "=&v"(r[5]), "=&v"(r[6]), "=&v"(r[7])
                 : "v"(ad[0]), "v"(ad[1]), "v"(ad[2]), "v"(ad[3]), "v"(ad[4]), "v"(ad[5]), "v"(ad[6]), "v"(ad[7]) : "memory");
}
__device__ __forceinline__ void tr_read8_b8(const unsigned (&ad)[8], s16x4 (&r)[8]) {
    asm volatile("ds_read_b64_tr_b8 %0, %8\n\tds_read_b64_tr_b8 %1, %9\n\tds_read_b64_tr_b8 %2, %10\n\tds_read_b64_tr_b8 %3, %11\n\t"
                 "ds_read_b64_tr_b8 %4, %12\n\tds_read_b64_tr_b8 %5, %13\n\tds_read_b64_tr_b8 %6, %14\n\tds_read_b64_tr_b8 %7, %15\n\ts_waitcnt lgkmcnt(0)"
                 : "=&v"(r[0]), "=&v"(r[1]), "=&v"(r[2]), "=&v"(r[3]), "=&v"(r[4]), "=&v"(r[5]), "=&v"(r[6]), "=&v"(r[7])
                 : "v"(ad[0]), "v"(ad[1]), "v"(ad[2]), "v"(ad[3]), "v"(ad[4]), "v"(ad[5]), "v"(ad[6]), "v"(ad[7]) : "memory");
}
constexpr int ATT_WAVE_LDS = 19456;
__device__ __forceinline__ void phase_attn(const Ctx& c) {
    const bf16_t* Q = (const bf16_t*)(c.ws + WS_Q); const bf16_t* K = (const bf16_t*)(c.ws + WS_K); const bf16_t* V = (const bf16_t*)(c.ws + WS_V);
    const int* SEL = (const int*)(c.ws + WS_SEL); bf16_t* O = (bf16_t*)(c.ws + WS_O);
    LAS unsigned char* wl = c.lds + c.wave * ATT_WAVE_LDS;
    LAS int* sl = (LAS int*)wl;
    LAS unsigned short* pT = (LAS unsigned short*)(wl + 1024);
    LAS unsigned char* vb = wl + 3072;
    const int lane = c.lane, fr = lane & 15, fq = lane >> 4;
    const int gw = c.vb * 4 + c.wave, ngw = c.nb * 4;
    unsigned tro[8];
    { const unsigned row = 8u * fq + ((unsigned)fr >> 1);
#pragma unroll
      for (int c2 = 0; c2 < 8; ++c2) tro[c2] = 128u * row + 16u * ((unsigned)c2 ^ (row & 7u)) + 8u * ((unsigned)fr & 1u); }
    const unsigned vb_addr = (unsigned)(size_t)vb;
    int tcount = 0, cit = gw;
    const bool xsplit = (c.nb % 128) == 0;
    const int xg = (c.vb >> 6) & 1, wi0 = xsplit ? (((c.vb >> 7) * 64 + (c.vb & 63)) * 4 + c.wave) : gw, wstride = xsplit ? ngw / 2 : ngw;
    const unsigned chunkoff = (((unsigned)lane & 7u) ^ (((unsigned)lane >> 3) & 7u)) << 4;
    unsigned trh[8];
    { const unsigned row = 8u * (fq & 1) + ((unsigned)fr >> 1);
#pragma unroll
      for (int c2 = 0; c2 < 8; ++c2) trh[c2] = 128u * row + 16u * ((unsigned)c2 ^ (row & 7u)) + 8u * ((unsigned)fr & 1u); }
#define SEL_PREFETCH(tg_) __builtin_amdgcn_global_load_lds((const unsigned*)(SEL + (size_t)(tg_) * 256 + lane * 4), (LAS unsigned*)((LAS unsigned char*)sl + lane * 16), 16, 0, 0)
    const int task_end = xsplit ? T : T * 2;
    if (wi0 < task_end) { SEL_PREFETCH(xsplit ? wi0 : (wi0 >> 1)); }
    for (int task = wi0; task < task_end; task += wstride) {
        const int tg = xsplit ? task : (task >> 1), g = xsplit ? xg : (task & 1), b = tg >> 12, t = tg & 4095, tb = b * SEQ;
        const int nsel = min(256, t + 1), nch = (nsel + 31) >> 5;
        asm volatile("s_waitcnt vmcnt(0)" ::: "memory");
        unsigned koff[32];
#pragma unroll
        for (int q = 0; q < 32; ++q) { const int s_ = 8 * q + (lane >> 3); int idx = sl[s_]; idx = (t < 256) ? s_ : idx; idx = (s_ < nsel && (unsigned)idx <= (unsigned)t) ? idx : 0; koff[q] = (unsigned)idx * 256u + chunkoff; }
        i64x2 qf[2];
        { const unsigned char* qp = (const unsigned char*)Q + (size_t)tg * D + (4 * g + (fr >> 2)) * 128 + 16 * fq;
#pragma unroll
          for (int i = 0; i < 2; ++i) qf[i] = *(const i64x2*)(qp + 64 * i); }
        asm volatile("s_waitcnt vmcnt(0) lgkmcnt(0)" ::: "memory");
        asm volatile("" : "+v"(qf[0]), "+v"(qf[1]));
        { const int tn = task + wstride; if (tn < task_end) SEL_PREFETCH(xsplit ? tn : (tn >> 1)); }
        const unsigned char* kbase = (const unsigned char*)K + (size_t)tb * 256 + g * 128;
        const unsigned char* vbase = (const unsigned char*)V + (size_t)tb * 256 + g * 128;
#define CH_GATHER(cidx) do { const unsigned char* bp_ = ((cidx) < 16) ? kbase : vbase; _Pragma("unroll") for (int i_ = 0; i_ < 2; ++i_) { \
            unsigned o_ = koff[2 * ((cidx) & 15) + i_]; asm volatile("" : "+v"(o_));     \
            __builtin_amdgcn_global_load_lds((const unsigned*)(bp_ + o_), (LAS unsigned*)(vb + ((cidx) & 7) * 2048 + i_ * 1024 + lane * 16), 16, 0, 0); } } while (0)
        float lg[16];
#pragma unroll
        for (int c0 = 0; c0 < 6; ++c0) CH_GATHER(c0);
#pragma unroll
        for (int ch = 0; ch < 16; ++ch) {
            asm volatile("s_waitcnt lgkmcnt(0)" ::: "memory");
            CH_GATHER(ch + 6);
            asm volatile("s_waitcnt vmcnt(12)" ::: "memory");
            const LAS unsigned char* kb = vb + (ch & 7) * 2048;
            f32x4 acc = {0.f, 0.f, 0.f, 0.f};
#pragma unroll
            for (int i = 0; i < 2; ++i) { const i64x2 kf = *(const LAS i64x2*)(kb + 128u * fr + 16u * ((4u * i + fq) ^ ((unsigned)fr & 7u)));
                acc = __builtin_amdgcn_mfma_f32_16x16x32_fp8_fp8(qf[i].x, kf.x, acc, 0, 0, 0); acc = __builtin_amdgcn_mfma_f32_16x16x32_fp8_fp8(qf[i].y, kf.y, acc, 0, 0, 0); }
            lg[ch] = (ch * 16 + fr < nsel) ? acc.x * 0.08838834764831845f : -INFINITY;
        }
        float mx = lg[0];
#pragma unroll
        for (int kt = 1; kt < 16; ++kt) mx = fmaxf(mx, lg[kt]);
#pragma unroll
        for (int o = 1; o < 16; o <<= 1) mx = fmaxf(mx, __shfl_xor(mx, o));
        float sm = 0.f;
#pragma unroll
        for (int kt = 0; kt < 16; ++kt) { lg[kt] = __expf(lg[kt] - mx); sm += lg[kt]; }
#pragma unroll
        for (int o = 1; o < 16; o <<= 1) sm += __shfl_xor(sm, o);
        { const float inv = 256.f / sm;
#pragma unroll
          for (int kt = 0; kt < 16; ++kt) { const float pv = lg[kt] * inv; ((LAS unsigned char*)pT)[fq * 256 + kt * 16 + fr] = (unsigned char)(pk_fp8x4_nc(pv, pv, pv, pv) & 0xffu); } }
        f32x4 oacc[8];
#pragma unroll
        for (int c2 = 0; c2 < 8; ++c2) oacc[c2] = (f32x4){0.f, 0.f, 0.f, 0.f};
#pragma unroll
        for (int p = 0; p < 8; ++p) {
            asm volatile("s_waitcnt lgkmcnt(0)" ::: "memory");
            if (16 + 2 * p + 6 < 32) { CH_GATHER(16 + 2 * p + 6); CH_GATHER(16 + 2 * p + 7); }
            if (p < 5) asm volatile("s_waitcnt vmcnt(12)" ::: "memory"); else if (p == 5) asm volatile("s_waitcnt vmcnt(8)" ::: "memory");
            else if (p == 6) asm volatile("s_waitcnt vmcnt(4)" ::: "memory"); else asm volatile("s_waitcnt vmcnt(0)" ::: "memory");
            if (p < nch) {
                const long pa = *(const LAS long*)((const LAS unsigned char*)pT + (fr >> 2) * 256 + 32 * p + 8 * fq);
                const unsigned cb = vb_addr + (unsigned)(((16 + 2 * p) & 7) + (fq >> 1)) * 2048u;
                unsigned ad[8]; s16x4 r0[8];
#pragma unroll
                for (int i = 0; i < 8; ++i) ad[i] = cb + trh[i];
                tr_read8_b8(ad, r0);
#pragma unroll
                for (int c2 = 0; c2 < 8; ++c2) oacc[c2] = __builtin_amdgcn_mfma_f32_16x16x32_fp8_fp8(pa, __builtin_bit_cast(long, r0[c2]), oacc[c2], 0, 0, 0);
            }
        }
        { unsigned char* op = (unsigned char*)O + (size_t)tg * D + (4 * g + fq) * 128 + fr;
#pragma unroll
          for (int c2 = 0; c2 < 8; ++c2) { const float ov = oacc[c2].x * (O8_SCALE / 256.f); op[16 * c2] = (unsigned char)(pk_fp8x4(ov, ov, ov, ov) & 0xffu); } }
        LDS_WAIT();
#undef CH_GATHER
        if ((tcount & 1) && cit < NE * 192) { convert_moe_item(c, 1, cit, vb); cit += ngw; }
        ++tcount;
    }
    for (; cit < NE * 192; cit += ngw) convert_moe_item(c, 1, cit, vb);
}

__device__ __forceinline__ void phase_b4(const Ctx& c) {
    const bf16_t* OB = (const bf16_t*)(c.ws + WS_O); const bf16_t* W = (const bf16_t*)(c.ws + WS_WBOUT); float* H = (float*)(c.ws + WS_H);
    const int fr = c.lane & 15, fq = c.lane >> 4, wr = c.wave >> 1, wc = c.wave & 1;
    for (int u = c.vb; u < 128 * 8; u += c.nb) {
        int mt, nt; map_unit(u, 8, mt, nt);
        const bf16_t* ap[4]; const bf16_t* bp[4];
        rows_regular<64>(ap, (const bf16_t*)(c.ws + WS_O + (size_t)mt * 128 * D), D / 2, c.tid); rows_regular<64>(bp, (const bf16_t*)(c.ws + WS_WBOUT + (size_t)nt * 128 * D), D / 2, c.tid);
        f32x4 acc[4][4];
#pragma unroll
        for (int m = 0; m < 4; ++m)
#pragma unroll
            for (int n = 0; n < 4; ++n) acc[m][n] = *(const f32x4*)(H + (size_t)(mt * 128 + wr * 64 + m * 16 + fr) * D + nt * 128 + wc * 64 + n * 16 + fq * 4) * (W8_SCALE * O8_SCALE);
        gemm_loop<64, 1, true, true>(c, ap, bp, bp, D / 2, acc, acc);
#pragma unroll
        for (int m = 0; m < 4; ++m)
#pragma unroll
            for (int n = 0; n < 4; ++n) *(f32x4*)(H + (size_t)(mt * 128 + wr * 64 + m * 16 + fr) * D + nt * 128 + wc * 64 + n * 16 + fq * 4) = acc[m][n] * (1.f / (W8_SCALE * O8_SCALE));
    }
}

constexpr int NPHASE = 22;
__global__ void __launch_bounds__(NTH, 2) mk_fwd(Args args) {
    extern __shared__ __attribute__((aligned(16))) unsigned char lds_raw[];
    Ctx c;
    c.lds = (LAS unsigned char*)lds_raw; c.tid = threadIdx.x; c.lane = c.tid & 63; c.wave = __builtin_amdgcn_readfirstlane(c.tid >> 6);
    c.nb = gridDim.x; { const int bx = blockIdx.x; c.vb = (c.nb % 8 == 0) ? (bx % 8) * (c.nb / 8) + bx / 8 : bx; }
    c.a = (const __attribute__((address_space(4))) Args*)__builtin_amdgcn_kernarg_segment_ptr(); c.ws = args.ws;
    volatile LAS unsigned* st = (volatile LAS unsigned*)(c.lds + LDS_MAIN + 1008);
    const bool multi = (args.ph_hi - args.ph_lo) > 1;
    XcdBarrier bar; bar.bar = (unsigned*)(c.ws + WS_CTL); bar.x = 0; bar.st = st;
    if (multi) {
        if (c.tid == 0) { st[0] = 0u; st[1] = 0u; }
        __syncthreads();
        bar = xcd_barrier_post((unsigned*)(c.ws + WS_CTL), st);
    }
    const int ph_lo = args.ph_lo, ph_hi = args.ph_hi;
#ifndef PH_MASK
#define PH_MASK 0x3fffff
#endif
#define PHON(k) ((PH_MASK >> (k)) & 1)
#define PHASE(k, body) do { if (PHON(k) && ph_lo <= (k) && (k) < ph_hi) { \
        { int t_ = threadIdx.x, vb_ = __builtin_amdgcn_readfirstlane(c.vb); \
          const __attribute__((address_space(4))) Args* ka = (const __attribute__((address_space(4))) Args*)__builtin_amdgcn_kernarg_segment_ptr(); \
          asm volatile("" : "+v"(t_), "+s"(vb_), "+s"(ka)); \
          c.tid = t_; c.lane = t_ & 63; c.wave = __builtin_amdgcn_readfirstlane(t_ >> 6); c.vb = vb_; c.a = ka; c.ws = ka->ws; } \
        body; \
        if (MK_REP == (k)) { __syncthreads(); body; } \
        if ((k) + 1 < ph_hi) xcd_barrier(bar); \
        if ((k) == 3) { for (int xb_ = 0; xb_ < MK_XBAR; ++xb_) xcd_barrier(bar); } } } while (0)
    PHASE(0, phase_prep(c));
    PHASE(1, phase_a1(c));
    PHASE(2, { if (MK_DRY == 2) { phase_a2(c, true); __syncthreads(); } phase_a2(c); });
    PHASE(3, phase_a3(c));
    PHASE(4, { if (MK_DRY == 4) { phase_route(c, 0, true); __syncthreads(); } phase_route(c, 0); });
    PHASE(5, phase_e1(c, 0));
    PHASE(6, phase_e2(c, 0));
    PHASE(7, { if (MK_DRY == 7) { phase_p1(c, 0, true); __syncthreads(); } phase_p1(c, 0); });
    PHASE(8, phase_p2(c, 0));
    PHASE(9, phase_norm_bf16(c, (const float*)c.a->in[IN_MIXN] + D));
    PHASE(10, phase_b1(c));
    PHASE(11, phase_rope(c));
    PHASE(12, phase_score(c));
    PHASE(13, phase_select(c));
    PHASE(14, phase_attn(c));
    PHASE(15, phase_b4(c));
    PHASE(16, phase_route(c, 1));
    PHASE(17, phase_e1(c, 1));
    PHASE(18, phase_e2(c, 1));
    PHASE(19, phase_p1(c, 1));
    PHASE(20, phase_p2(c, 1));
    PHASE(21, phase_final(c));
}

#ifdef MK_DUMP
__global__ void dump_k(const unsigned char* ws, float* out) {
    const size_t i = (size_t)blockIdx.x * 256 + threadIdx.x;
#if MK_DUMP == 1
    ((f32x4*)out)[i] = ((const f32x4*)(ws + WS_H))[i];
#elif MK_DUMP == 2
    { const u32x2 v = ((const u32x2*)(ws + WS_O))[i]; f32x4 o = {bf_lo(v.x), bf_hi(v.x), bf_lo(v.y), bf_hi(v.y)}; ((f32x4*)out)[i] = o; }
#elif MK_DUMP == 3
    { const int* sp = (const int*)(ws + WS_SEL); f32x4 o = {0.f,0.f,0.f,0.f}; if (i < (size_t)T * 64) { o.x = (float)sp[4*i]; o.y = (float)sp[4*i+1]; o.z = (float)sp[4*i+2]; o.w = (float)sp[4*i+3]; } ((f32x4*)out)[i] = o; }
#elif MK_DUMP == 5
    { const u32x2 v = ((const u32x2*)(ws + WS_XN))[i]; f32x4 o = {bf_lo(v.x), bf_hi(v.x), bf_lo(v.y), bf_hi(v.y)}; ((f32x4*)out)[i] = o; }
#elif MK_DUMP == 6
    { const u32x2 v = ((const u32x2*)(ws + WS_RAW))[i]; f32x4 o = {bf_lo(v.x), bf_hi(v.x), bf_lo(v.y), bf_hi(v.y)}; ((f32x4*)out)[i] = o; }
#elif MK_DUMP == 7
    { f32x4 o = {0.f,0.f,0.f,0.f}; if (i < (size_t)BINP * D / 4) { const u32x2 v = ((const u32x2*)(ws + WS_WBIN))[i]; o = (f32x4){bf_lo(v.x), bf_hi(v.x), bf_lo(v.y), bf_hi(v.y)}; } ((f32x4*)out)[i] = o; }
#elif MK_DUMP == 8
    { const u32x2 v = ((const u32x2*)(ws + WS_RAW))[i], w = ((const u32x2*)(ws + 458 * MB))[i]; f32x4 o = {bf_lo(v.x) - bf_lo(w.x), bf_hi(v.x) - bf_hi(w.x), bf_lo(v.y) - bf_lo(w.y), bf_hi(v.y) - bf_hi(w.y)}; ((f32x4*)out)[i] = o; }
#elif MK_DUMP == 9
    { const u32x2 v = ((const u32x2*)(ws + WS_RAW))[i], w = ((const u32x2*)(ws + 458 * MB))[i]; f32x4 o = {(v.x & 0xffffu) != (w.x & 0xffffu) ? 1.f : 0.f, (v.x >> 16) != (w.x >> 16) ? 1.f : 0.f, (v.y & 0xffffu) != (w.y & 0xffffu) ? 1.f : 0.f, (v.y >> 16) != (w.y >> 16) ? 1.f : 0.f}; ((f32x4*)out)[i] = o; }
#elif MK_DUMP == 4
    { const u32x2 v = ((const u32x2*)(ws + WS_Q))[i]; f32x4 o = {bf_lo(v.x), bf_hi(v.x), bf_lo(v.y), bf_hi(v.y)}; ((f32x4*)out)[i] = o; }
#endif
}
#endif
extern "C" void kernel_launch(void* const* d_in, const int* in_sizes, int n_in, void* d_out, int out_size, void* d_ws, size_t ws_size, hipStream_t stream) {
    static int grid = 0;
    if (grid == 0) {
        if (n_in != 23 || out_size != T * D || ws_size < WS_TOTAL) { fprintf(stderr, "kernel_launch: unexpected sizes n_in %d out %d ws %zu (need %zu)\n", n_in, out_size, ws_size, (size_t)WS_TOTAL); grid = -1; return; }
        int dev = 0, cus = 0, per_cu = 0;
        hipGetDevice(&dev); hipDeviceGetAttribute(&cus, hipDeviceAttributeMultiprocessorCount, dev);
        hipFuncSetAttribute((const void*)mk_fwd, hipFuncAttributeMaxDynamicSharedMemorySize, LDS_BYTES);
        hipOccupancyMaxActiveBlocksPerMultiprocessor(&per_cu, (const void*)mk_fwd, NTH, LDS_BYTES);
        (void)hipGetLastError();
        if (per_cu < 1) per_cu = 1;
        if (per_cu > 2) per_cu = 2;
        grid = cus * per_cu;
    }
    if (grid < 0) return;
    hipMemsetAsync((char*)d_ws + WS_CTL, 0, 16384, stream);
    Args a{};
    for (int i = 0; i < 23; ++i) a.in[i] = d_in[i];
    a.out = (float*)d_out; a.ws = (unsigned char*)d_ws;
#if MK_ONE_LAUNCH
    a.ph_lo = 0; a.ph_hi = NPHASE;
    hipLaunchKernelGGL(mk_fwd, dim3(grid), dim3(NTH), LDS_BYTES, stream, a);
#else
    for (int ph = 0; ph <= MK_LAST_PHASE; ++ph) { a.ph_lo = ph; a.ph_hi = ph + 1; hipLaunchKernelGGL(mk_fwd, dim3(grid), dim3(NTH), LDS_BYTES, stream, a); }
#ifdef MK_DUMP
    hipLaunchKernelGGL(dump_k, dim3(T * D / 4 / 256), dim3(256), 0, stream, (const unsigned char*)d_ws, (float*)d_out);
#endif
#endif
}
```

```cpp
#include <hip/hip_runtime.h>
#include <stdint.h>
#include <stdio.h>

#ifndef MK_LAST_PHASE
#define MK_LAST_PHASE 21
#endif
#ifndef MK_REP
#define MK_REP -1
#endif
#ifndef MK_XBAR
#define MK_XBAR 0
#endif
#ifndef MK_DRY
#define MK_DRY -1
#endif
#ifndef MK_ONE_LAUNCH
#define MK_ONE_LAUNCH 1
#endif

#define LAS __attribute__((address_space(3)))
typedef unsigned short bf16_t;
typedef short bf16x8 __attribute__((ext_vector_type(8)));
typedef float f32x4 __attribute__((ext_vector_type(4)));
typedef float f32x2 __attribute__((ext_vector_type(2)));
typedef float f32x16 __attribute__((ext_vector_type(16)));
typedef unsigned u32x4 __attribute__((ext_vector_type(4)));
typedef unsigned u32x2 __attribute__((ext_vector_type(2)));
typedef long i64x2 __attribute__((ext_vector_type(2)));
typedef int i32x4 __attribute__((ext_vector_type(4)));
typedef int i32x8 __attribute__((ext_vector_type(8)));

constexpr int T = 16384, D = 1024, SEQ = 4096;
constexpr int GW = 2048;
constexpr int BIN = 2120, BINP = 2176;
constexpr int NE = 32, DE = 512;
constexpr int PLE = 256;
constexpr float EPS = 1e-6f;
constexpr int NTH = 256;
constexpr int LDS_MAIN = 4 * 19456;
constexpr int LDS_HALF = LDS_MAIN + 1024;
constexpr int LDS_BYTES = 2 * LDS_HALF;
constexpr int NTHP = 512;
constexpr int RPAD = 32768 + NE * 256;

constexpr size_t MB = 1024 * 1024;
constexpr size_t WS_CTL = 0;
constexpr size_t WS_CNT = 16384;
constexpr size_t WS_WR = 32768;
constexpr size_t WS_WAIN = 1 * MB;
constexpr size_t WS_WAOUT = WS_WAIN + 8 * MB;
constexpr size_t WS_WBIN = WS_WAOUT + 4 * MB;
constexpr size_t WS_WBOUT = WS_WBIN + 5 * MB;
constexpr size_t WS_WGATE = WS_WBOUT + 2 * MB;
constexpr size_t WS_WPROJ = WS_WGATE + 4 * MB;
constexpr size_t WS_W1 = WS_WPROJ + 1 * MB;
constexpr size_t WS_XN8 = WS_W1 + 16 * MB;
constexpr size_t WS_W3 = WS_W1 + 32 * MB;
constexpr size_t WS_W2 = WS_W3 + 32 * MB;
constexpr size_t WS_PBF = WS_W2 + 32 * MB;
constexpr size_t WS_XN = WS_PBF + 16 * MB;
constexpr size_t WS_H = WS_XN + 32 * MB;
constexpr size_t WS_LIST = WS_H + 64 * MB;
constexpr size_t WS_GATE = WS_LIST + 2 * MB;
constexpr size_t WS_TOKSLOT = WS_GATE + 2 * MB;
constexpr size_t WS_SCR = WS_TOKSLOT + 1 * MB;
constexpr size_t WS_U = WS_SCR;
constexpr size_t WS_VT = WS_SCR + 64 * MB;
constexpr size_t WS_VSS = WS_SCR + 128 * MB;
constexpr size_t WS_HMID = WS_SCR;
constexpr size_t WS_Y = WS_SCR + 36 * MB;
constexpr size_t WS_RAW = WS_SCR;
constexpr size_t WS_O = WS_SCR;
constexpr size_t WS_Q = WS_SCR + 68 * MB;
constexpr size_t WS_K = WS_Q + 32 * MB;
constexpr size_t WS_V = WS_K + 8 * MB;
constexpr size_t WS_QI = WS_V + 8 * MB;
constexpr size_t WS_KI = WS_QI + 16 * MB;
constexpr size_t WS_WI = WS_KI + 2 * MB;
constexpr size_t WS_SEL = WS_WI + 1 * MB;
constexpr size_t WS_END = WS_SEL + 16 * MB;
static_assert(WS_END <= WS_SCR + 152 * MB, "scratch");
constexpr size_t WS_S = 392 * MB;
constexpr size_t WS_TOTAL = 522 * MB;

typedef __bf16 bf16x2_t __attribute__((ext_vector_type(2)));
__device__ __forceinline__ unsigned pk_bf16(float lo, float hi) { f32x2 v = {lo, hi}; bf16x2_t b = __builtin_convertvector(v, bf16x2_t); return __builtin_bit_cast(unsigned, b); }
__device__ __forceinline__ float bf_lo(unsigned u) { return __uint_as_float(u << 16); }
__device__ __forceinline__ float bf_hi(unsigned u) { return __uint_as_float(u & 0xffff0000u); }
__device__ __forceinline__ float wave_sum(float v) {
#pragma unroll
    for (int o = 1; o < 64; o <<= 1) v += __shfl_xor(v, o);
    return v;
}
__device__ __forceinline__ int lds_inc(LAS int* p) { return __hip_atomic_fetch_add(p, 1, __ATOMIC_RELAXED, __HIP_MEMORY_SCOPE_WORKGROUP); }
#define LDS_WAIT() asm volatile("s_waitcnt lgkmcnt(0)" ::: "memory")
#define VM_WAIT() asm volatile("s_waitcnt vmcnt(0)" ::: "memory")

#define XB_TMO      128
#define XB_XCNT(j)  (256  + 64 * (j))
#define XB_XSUB(j)  (1280 + 64 * (j))
#define XB_XGEN(j)  (2304 + 64 * (j))
#define XB_TOP      3328
#define XB_TOPGEN   3392
#define XCD_BAR_WORDS 3456
#define XB_SPIN_CAP (1u << 20)
__device__ __forceinline__ unsigned xb_ld(unsigned* p)              { return __hip_atomic_load(p, __ATOMIC_RELAXED, __HIP_MEMORY_SCOPE_AGENT); }
__device__ __forceinline__ unsigned xb_add(unsigned* p, unsigned v) { return __hip_atomic_fetch_add(p, v, __ATOMIC_RELAXED, __HIP_MEMORY_SCOPE_AGENT); }
__device__ __forceinline__ unsigned xb_xcc_id() { return (unsigned)__builtin_amdgcn_s_getreg((3 << 11) | 20) & 0xFu; }
#define XB_SPIN(cond, bar) do { unsigned _sp = 0; while (cond) { __builtin_amdgcn_s_sleep(1); \
    if ((++_sp & 255u) == 0u) { if (xb_ld(&(bar)[XB_TMO])) break; if (_sp > XB_SPIN_CAP) { atomicAdd(&(bar)[XB_TMO], 1u); break; } } } } while (0)
struct XcdBarrier { unsigned* bar; unsigned x; volatile LAS unsigned* st; };
__device__ __forceinline__ XcdBarrier xcd_barrier_post(unsigned* bar, volatile LAS unsigned* st) {
    XcdBarrier b; b.bar = bar; b.x = xb_xcc_id(); b.st = st;
    if (threadIdx.x == 0) (void)xb_add(&bar[XB_XCNT(b.x)], 1u);
    return b;
}
__device__ __forceinline__ void xcd_barrier_complete(unsigned* bar, unsigned x, unsigned& nloc, unsigned& nx) {
    const unsigned G = gridDim.x;
    unsigned sum, cnt, mine, sp = 0u;
    for (;;) {
        sum = 0u; cnt = 0u; mine = 0u;
#pragma unroll
        for (unsigned j = 0; j < 16; ++j) { const unsigned c = xb_ld(&bar[XB_XCNT(j)]); sum += c; cnt += (c > 0u) ? 1u : 0u; mine = (j == x) ? c : mine; }
        if (sum == G) break;
        __builtin_amdgcn_s_sleep(1);
        if ((++sp & 255u) == 0u) { if (xb_ld(&bar[XB_TMO])) break; if (sp > XB_SPIN_CAP) { atomicAdd(&bar[XB_TMO], 1u); break; } }
    }
    nloc = mine > 0u ? mine : 1u; nx = cnt > 0u ? cnt : 1u;
}
__device__ __forceinline__ void xcd_barrier(const XcdBarrier& b) {
    asm volatile("s_waitcnt vmcnt(0)" ::: "memory");
    __syncthreads();
    if (threadIdx.x == 0) {
        unsigned* bar = b.bar;
        __builtin_amdgcn_s_waitcnt(0);
        unsigned nloc = b.st[0], nx = b.st[1];
        if (nloc == 0u) { xcd_barrier_complete(bar, b.x, nloc, nx); b.st[0] = nloc; b.st[1] = nx; }
        const unsigned old = xb_add(&bar[XB_XSUB(b.x)], 1u);
        const unsigned gen = old / nloc;
        if (old + 1u == (gen + 1u) * nloc) {
            __builtin_amdgcn_fence(__ATOMIC_RELEASE, "agent");
            asm volatile("s_waitcnt vmcnt(0)" ::: "memory");
            const unsigned og = xb_add(&bar[XB_TOP], 1u);
            const unsigned tg = og / nx;
            if (og + 1u == (tg + 1u) * nx) xb_add(&bar[XB_TOPGEN], 1u);
            else XB_SPIN(xb_ld(&bar[XB_TOPGEN]) == tg, bar);
            __builtin_amdgcn_fence(__ATOMIC_ACQUIRE, "agent");
            xb_add(&bar[XB_XGEN(b.x)], 1u);
            asm volatile("s_waitcnt vmcnt(0)" ::: "memory");
        } else {
            XB_SPIN(xb_ld(&bar[XB_XGEN(b.x)]) == gen, bar);
            __builtin_amdgcn_fence(__ATOMIC_ACQUIRE, "agent");
            asm volatile("s_waitcnt vmcnt(0)" ::: "memory");
        }
    }
    __syncthreads();
}

struct Args { const void* in[23]; float* out; unsigned char* ws; int ph_lo, ph_hi; };
enum { IN_X = 0, IN_P, IN_POS, IN_MIXN, IN_AWIN, IN_AVG, IN_AWS, IN_ABS, IN_AWOUT, IN_BWIN, IN_BWOUT, IN_FFNN, IN_WG, IN_BG, IN_WE, IN_BE,
       IN_W1, IN_W3, IN_W2, IN_PLEN, IN_PLEG, IN_PLEP, IN_FINN };

struct Ctx {
    LAS unsigned char* lds;
    int tid, lane, wave, vb, nb, half;
    LAS unsigned char* ldsp;
    const __attribute__((address_space(4))) Args* a;
    unsigned char* ws;
};

template <int BK> struct TileK { static constexpr int NP = (BK == 64) ? 4 : 2; static constexpr int TB = 128 * BK * 2; };

template <int BK>
__device__ __forceinline__ void stage_tile(LAS unsigned char* tile, const bf16_t* const (&rp)[TileK<BK>::NP], int k0, int tid) {
    const int lc = (BK == 64) ? ((tid & 7) ^ ((tid >> 3) & 7)) : ((tid & 3) ^ ((tid >> 3) & 3));
#pragma unroll
    for (int p = 0; p < TileK<BK>::NP; ++p)
        __builtin_amdgcn_global_load_lds((const unsigned*)(rp[p] + k0 + lc * 8), (LAS unsigned*)(tile + p * 4096 + tid * 16), 16, 0, 0);
}
template <int BK>
__device__ __forceinline__ void rows_regular(const bf16_t* (&rp)[TileK<BK>::NP], const bf16_t* base, size_t ld, int tid) {
#pragma unroll
    for (int p = 0; p < TileK<BK>::NP; ++p) { const int r = (BK == 64) ? (p * 32 + (tid >> 3)) : (p * 64 + (tid >> 2)); rp[p] = base + (size_t)r * ld; }
}
template <int BK>
__device__ __forceinline__ int frag_off(int row, int ks, int fq) {
    return (BK == 64) ? (row * 128 + (((ks * 4 + fq) ^ (row & 7)) << 4)) : (row * 64 + ((fq ^ ((row >> 1) & 3)) << 4));
}

template <int BK, int NBOP, bool SWAP, bool FP8 = false>
__device__ __forceinline__ void gemm_loop(const Ctx& c, const bf16_t* const (&ap)[TileK<BK>::NP], const bf16_t* const (&b0p)[TileK<BK>::NP], const bf16_t* const (&b1p)[TileK<BK>::NP],
                                          int K, f32x4 (&acc0)[4][4], f32x4 (&acc1)[4][4]) {
    constexpr int TB = TileK<BK>::TB, SB = (1 + NBOP) * TB;
    static_assert(2 * SB <= LDS_MAIN, "lds");
    const int nk = K / BK, tid = c.tid;
    const int fr = c.lane & 15, fq = c.lane >> 4, wr = c.wave >> 1, wc = c.wave & 1;
    LAS unsigned char* lds = c.lds;
    stage_tile<BK>(lds, ap, 0, tid); stage_tile<BK>(lds + TB, b0p, 0, tid);
    if (NBOP == 2) stage_tile<BK>(lds + 2 * TB, b1p, 0, tid);
    for (int kt = 0; kt < nk; ++kt) {
        VM_WAIT();
        __syncthreads();
        LAS unsigned char* cur = lds + (kt & 1) * SB;
        if (kt + 1 < nk) {
            LAS unsigned char* nxt = lds + ((kt + 1) & 1) * SB;
            stage_tile<BK>(nxt, ap, (kt + 1) * BK, tid); stage_tile<BK>(nxt + TB, b0p, (kt + 1) * BK, tid);
            if (NBOP == 2) stage_tile<BK>(nxt + 2 * TB, b1p, (kt + 1) * BK, tid);
        }
#pragma unroll
        for (int ks = 0; ks < BK / 32; ++ks) {
            bf16x8 af[4], bf0[4], bf1[4];
#pragma unroll
            for (int m = 0; m < 4; ++m) af[m] = *(const LAS bf16x8*)(cur + frag_off<BK>(wr * 64 + m * 16 + fr, ks, fq));
#pragma unroll
            for (int n = 0; n < 4; ++n) bf0[n] = *(const LAS bf16x8*)(cur + TB + frag_off<BK>(wc * 64 + n * 16 + fr, ks, fq));
            if (NBOP == 2) {
#pragma unroll
                for (int n = 0; n < 4; ++n) bf1[n] = *(const LAS bf16x8*)(cur + 2 * TB + frag_off<BK>(wc * 64 + n * 16 + fr, ks, fq));
            }
#pragma unroll
            for (int m = 0; m < 4; ++m)
#pragma unroll
                for (int n = 0; n < 4; ++n) {
                    if (FP8) {
                        const i64x2 a2 = __builtin_bit_cast(i64x2, af[m]), b2 = __builtin_bit_cast(i64x2, bf0[n]);
                        if (SWAP) { acc0[m][n] = __builtin_amdgcn_mfma_f32_16x16x32_fp8_fp8(b2.x, a2.x, acc0[m][n], 0, 0, 0); acc0[m][n] = __builtin_amdgcn_mfma_f32_16x16x32_fp8_fp8(b2.y, a2.y, acc0[m][n], 0, 0, 0); }
                        else      { acc0[m][n] = __builtin_amdgcn_mfma_f32_16x16x32_fp8_fp8(a2.x, b2.x, acc0[m][n], 0, 0, 0); acc0[m][n] = __builtin_amdgcn_mfma_f32_16x16x32_fp8_fp8(a2.y, b2.y, acc0[m][n], 0, 0, 0); }
                        continue;
                    }
                    if (SWAP) acc0[m][n] = __builtin_amdgcn_mfma_f32_16x16x32_bf16(bf0[n], af[m], acc0[m][n], 0, 0, 0);
                    else      acc0[m][n] = __builtin_amdgcn_mfma_f32_16x16x32_bf16(af[m], bf0[n], acc0[m][n], 0, 0, 0);
                    if (NBOP == 2) {
                        if (SWAP) acc1[m][n] = __builtin_amdgcn_mfma_f32_16x16x32_bf16(bf1[n], af[m], acc1[m][n], 0, 0, 0);
                        else      acc1[m][n] = __builtin_amdgcn_mfma_f32_16x16x32_bf16(af[m], bf1[n], acc1[m][n], 0, 0, 0);
                    }
                }
        }
    }
    __syncthreads();
}
__device__ __forceinline__ void zero_acc(f32x4 (&acc)[4][4]) {
#pragma unroll
    for (int m = 0; m < 4; ++m)
#pragma unroll
        for (int n = 0; n < 4; ++n) acc[m][n] = (f32x4){0.f, 0.f, 0.f, 0.f};
}
__device__ __forceinline__ void map_unit(int u, int nnt, int& mt, int& nt) { const int per = 8 * nnt, band = u / per, r = u - band * per; nt = r >> 3; mt = band * 8 + (r & 7); }


__device__ __forceinline__ float gelu_tanh(float x) {
    const float y2 = 1.5957691216057308f * (x + 0.044715f * x * x * x);
    return x * __builtin_amdgcn_rcpf(1.f + __expf(-y2));
}
__device__ __forceinline__ float sigmoidf_(float x) { return __builtin_amdgcn_rcpf(1.f + __expf(-x)); }

__device__ __forceinline__ void row_load(const float* row, int lane, f32x4 (&v)[4]) {
#pragma unroll
    for (int j = 0; j < 4; ++j) v[j] = ((const f32x4*)row)[lane + 64 * j];
}
__device__ __forceinline__ float row_sumsq(const f32x4 (&v)[4]) {
    float s = 0.f;
#pragma unroll
    for (int j = 0; j < 4; ++j) s += (v[j].x * v[j].x + v[j].y * v[j].y) + (v[j].z * v[j].z + v[j].w * v[j].w);
    return wave_sum(s);
}
__device__ __forceinline__ void gain_load(const float* gain, int lane, f32x4 (&g)[4]) {
#pragma unroll
    for (int j = 0; j < 4; ++j) g[j] = ((const f32x4*)gain)[lane + 64 * j];
}
__device__ __forceinline__ void row_store_norm_bf16(bf16_t* orow, int lane, const f32x4 (&v)[4], float r, const f32x4 (&gv)[4]) {
#pragma unroll
    for (int j = 0; j < 4; ++j) {
        const f32x4 g = gv[j];
        u32x2 o; o.x = pk_bf16(v[j].x * r * g.x, v[j].y * r * g.y); o.y = pk_bf16(v[j].z * r * g.z, v[j].w * r * g.w);
        ((u32x2*)orow)[lane + 64 * j] = o;
    }
}

__device__ __forceinline__ unsigned pk_fp8x4(float a, float b, float c_, float d);
__device__ __forceinline__ void row_store_norm_fp8(unsigned char* orow, int lane, const f32x4 (&v)[4], float r, const f32x4 (&gv)[4]) {
#pragma unroll
    for (int j = 0; j < 4; ++j) ((unsigned*)orow)[lane + 64 * j] = pk_fp8x4(v[j].x * r * gv[j].x, v[j].y * r * gv[j].y, v[j].z * r * gv[j].z, v[j].w * r * gv[j].w);
}
constexpr int TR_SCR = 64 * 136;
__device__ __forceinline__ void transpose_item(const float* W, int K, int N, int nvalid, int ldw, bf16_t* WT, LAS unsigned char* scr, int item, int lane) {
    const int nblk = N / 64, kb = item / nblk, nb = item - kb * nblk, k0 = 64 * kb, n0 = 64 * nb;
    const int n = n0 + 4 * (lane & 15);
    const int nc_ = (n < nvalid) ? n : 0; const float keep = (n < nvalid) ? 1.f : 0.f;
    f32x4 v[16];
#pragma unroll
    for (int i = 0; i < 16; ++i) v[i] = *(const f32x4*)(W + (size_t)(k0 + 4 * i + (lane >> 4)) * ldw + nc_);
#pragma unroll
    for (int i = 0; i < 16; ++i) {
        const int kk = 4 * i + (lane >> 4);
        u32x2 o; o.x = pk_bf16(v[i].x * keep, v[i].y * keep); o.y = pk_bf16(v[i].z * keep, v[i].w * keep);
        *(LAS u32x2*)(scr + kk * 136 + (lane & 15) * 8) = o;
    }
    LDS_WAIT();
    const int cc = lane & 7;
#pragma unroll
    for (int j = 0; j < 8; ++j) {
        const int nn = (lane >> 3) + 8 * j; const LAS unsigned short* sp = (const LAS unsigned short*)(scr + (8 * cc) * 136 + nn * 2);
        u32x4 o;
        o.x = (unsigned)sp[0 * 68] | ((unsigned)sp[1 * 68] << 16); o.y = (unsigned)sp[2 * 68] | ((unsigned)sp[3 * 68] << 16);
        o.z = (unsigned)sp[4 * 68] | ((unsigned)sp[5 * 68] << 16); o.w = (unsigned)sp[6 * 68] | ((unsigned)sp[7 * 68] << 16);
        *(u32x4*)(WT + (size_t)(n0 + nn) * K + k0 + 8 * cc) = o;
    }
    LDS_WAIT();
}

__device__ __forceinline__ unsigned pk_fp8x4(float a, float b, float c_, float d) {
    a = fminf(fmaxf(a, -448.f), 448.f); b = fminf(fmaxf(b, -448.f), 448.f); c_ = fminf(fmaxf(c_, -448.f), 448.f); d = fminf(fmaxf(d, -448.f), 448.f);
    int p = __builtin_amdgcn_cvt_pk_fp8_f32(a, b, 0, false);
    p = __builtin_amdgcn_cvt_pk_fp8_f32(c_, d, p, true);
    return (unsigned)p;
}
__device__ __forceinline__ unsigned pk_fp8x4_nc(float a, float b, float c_, float d) {
    int p = __builtin_amdgcn_cvt_pk_fp8_f32(a, b, 0, false);
    p = __builtin_amdgcn_cvt_pk_fp8_f32(c_, d, p, true);
    return (unsigned)p;
}
constexpr float W8_SCALE = 64.f, H8_SCALE = 4.f, O8_SCALE = 8.f;
__device__ __forceinline__ void transpose_item8(const float* W, int K, int N, unsigned char* WT, LAS unsigned char* scr, int item, int lane, int nvalid = 1 << 30, int ldw = 0) {
    const int nblk = N / 64, kb = item / nblk, nb = item - kb * nblk, k0 = 128 * kb, n0 = 64 * nb;
    const int n = n0 + 4 * (lane & 15), ld = ldw ? ldw : N, nc_ = (n < nvalid) ? n : 0; const float keep = (n < nvalid) ? W8_SCALE : 0.f;
#pragma unroll 2
    for (int h = 0; h < 2; ++h) {
        f32x4 v[16];
#pragma unroll
        for (int i = 0; i < 16; ++i) v[i] = *(const f32x4*)(W + (size_t)(k0 + 64 * h + 4 * i + (lane >> 4)) * ld + nc_);
#pragma unroll
        for (int i = 0; i < 16; ++i) { const int kk = 64 * h + 4 * i + (lane >> 4);
            *(LAS unsigned*)(scr + kk * 68 + (lane & 15) * 4) = pk_fp8x4_nc(v[i].x * keep, v[i].y * keep, v[i].z * keep, v[i].w * keep); }
    }
    LDS_WAIT();
    const int cc = lane & 7;
#pragma unroll
    for (int j = 0; j < 8; ++j) {
        const int nn = (lane >> 3) + 8 * j; const LAS unsigned char* sp = scr + (16 * cc) * 68 + nn;
        unsigned w[4];
#pragma unroll
        for (int q = 0; q < 4; ++q) w[q] = (unsigned)sp[(4 * q + 0) * 68] | ((unsigned)sp[(4 * q + 1) * 68] << 8) | ((unsigned)sp[(4 * q + 2) * 68] << 16) | ((unsigned)sp[(4 * q + 3) * 68] << 24);
        u32x4 o = {w[0], w[1], w[2], w[3]};
        *(u32x4*)(WT + (size_t)(n0 + nn) * K + k0 + 16 * cc) = o;
    }
    LDS_WAIT();
}
__device__ __forceinline__ void convert_moe_item(const Ctx& c, int l, int it, LAS unsigned char* scr) {
    const float* w1 = (const float*)c.a->in[IN_W1] + (size_t)l * NE * D * DE;
    const float* w3 = (const float*)c.a->in[IN_W3] + (size_t)l * NE * D * DE;
    const float* w2 = (const float*)c.a->in[IN_W2] + (size_t)l * NE * DE * D;
    unsigned char* W3 = c.ws + WS_W3; unsigned char* W2 = c.ws + WS_W2;
    const int e = it / 192, r = it - e * 192;
    if (r < 64)       transpose_item8(w1 + (size_t)e * D * DE, D, DE, W3 + ((size_t)e * 1024 + ((r & 7) >> 1) * 128) * D, scr, r, c.lane);
    else if (r < 128) transpose_item8(w3 + (size_t)e * D * DE, D, DE, W3 + ((size_t)e * 1024 + ((r & 7) >> 1) * 128 + 128) * D, scr, r - 64, c.lane);
    else              transpose_item8(w2 + (size_t)e * DE * D, DE, D, W2 + (size_t)e * D * DE, scr, r - 128, c.lane);
}
__device__ __forceinline__ void convert_moe_layer(const Ctx& c, int l) {
    LAS unsigned char* scr = c.lds + c.wave * TR_SCR;
    const int gw = c.vb * 4 + c.wave, ngw = c.nb * 4;
    for (int it = gw; it < NE * 192; it += ngw) convert_moe_item(c, l, it, scr);
}

__device__ __forceinline__ void phase_prep(const Ctx& c) {
    const __attribute__((address_space(4))) Args& a = *c.a;
    LAS unsigned char* scr = c.lds + c.wave * TR_SCR;
    const int gw = c.vb * 4 + c.wave, ngw = c.nb * 4;
    constexpr int I_AIN = 16 * 64, I_AOUT = 32 * 16, I_PP = 4 * 16, I_BIN8 = 8 * 34, I_BOUT8 = 8 * 16, I_PG8 = 8 * 16, I_BINI = 16 * 10;
    constexpr int NIT = I_AIN + I_AOUT + 2 * I_PP + I_BIN8 + I_BOUT8 + 2 * I_PG8 + I_BINI;
    for (int it = gw; it < NIT; it += ngw) {
        int r = it;
        if (r < I_AIN) { transpose_item((const float*)a.in[IN_AWIN], D, 4096, 4096, 4096, (bf16_t*)(c.ws + WS_WAIN), scr, r, c.lane); continue; } r -= I_AIN;
        if (r < I_AOUT) { transpose_item((const float*)a.in[IN_AWOUT], GW, D, D, D, (bf16_t*)(c.ws + WS_WAOUT), scr, r, c.lane); continue; } r -= I_AOUT;
        if (r < 2 * I_PP) { const int l = r / I_PP; transpose_item((const float*)a.in[IN_PLEP] + (size_t)l * PLE * D, PLE, D, D, D, (bf16_t*)(c.ws + WS_WPROJ) + (size_t)l * D * PLE, scr, r - l * I_PP, c.lane); continue; } r -= 2 * I_PP;
        if (r < I_BIN8) { transpose_item8((const float*)a.in[IN_BWIN], D, BINP, c.ws + WS_WBIN, scr, r, c.lane, BIN, BIN); continue; } r -= I_BIN8;
        if (r < I_BOUT8) { transpose_item8((const float*)a.in[IN_BWOUT], D, D, c.ws + WS_WBOUT, scr, r, c.lane); continue; } r -= I_BOUT8;
        if (r < 2 * I_PG8) { const int l = r / I_PG8; transpose_item8((const float*)a.in[IN_PLEG] + (size_t)l * D * D, D, D, c.ws + WS_WGATE + (size_t)l * D * D, scr, r - l * I_PG8, c.lane); continue; } r -= 2 * I_PG8;
        transpose_item((const float*)a.in[IN_BWIN] + 1536, D, 640, BIN - 1536, BIN, (bf16_t*)(c.ws + WS_WBIN + 3 * MB), scr, r, c.lane);
    }
    convert_moe_layer(c, 0);
    const int gt = c.vb * NTH + c.tid, ngt = c.nb * NTH;
    { const float* p = (const float*)a.in[IN_P]; bf16_t* pb = (bf16_t*)(c.ws + WS_PBF);
      for (int i = gt; i < 2 * T * PLE / 8; i += ngt) {
          const f32x4 v0 = ((const f32x4*)p)[2 * i], v1 = ((const f32x4*)p)[2 * i + 1];
          u32x4 o; o.x = pk_bf16(v0.x, v0.y); o.y = pk_bf16(v0.z, v0.w); o.z = pk_bf16(v1.x, v1.y); o.w = pk_bf16(v1.z, v1.w);
          ((u32x4*)pb)[i] = o; } }
    { float* wr = (float*)(c.ws + WS_WR);
      for (int i = gt; i < 2 * D * 48; i += ngt) {
          const int l = i / (D * 48), r = i - l * D * 48, k = r / 48, o = r - k * 48;
          float w = 0.f;
          if (o < 4) w = ((const float*)a.in[IN_WG])[(size_t)l * D * 4 + k * 4 + o];
          else if (o < 36) w = ((const float*)a.in[IN_WE])[(size_t)l * D * 32 + k * 32 + (o - 4)];
          wr[i] = w * ((const float*)a.in[IN_FFNN])[l * D + k]; } }
    if (c.vb == 0 && c.tid < 128) ((int*)(c.ws + WS_CNT))[c.tid] = 0;
    f32x4 gv[4]; gain_load((const float*)a.in[IN_MIXN], c.lane, gv);
    for (int t = gw; t < T; t += ngw) {
        f32x4 v[4]; row_load((const float*)a.in[IN_X] + (size_t)t * D, c.lane, v);
        const float r = rsqrtf(row_sumsq(v) * (1.f / D) + EPS);
        row_store_norm_bf16((bf16_t*)(c.ws + WS_XN) + (size_t)t * D, c.lane, v, r, gv);
    }
}

namespace pg8 {
#define PG8_LAS __attribute__((address_space(3)))
typedef unsigned short bf16_t;
typedef short bf16x8 __attribute__((ext_vector_type(8)));
typedef float f32x4 __attribute__((ext_vector_type(4)));
typedef unsigned u32x4 __attribute__((ext_vector_type(4)));
constexpr int BM = 256, BK = 64, HALF = 128, HTB = HALF * BK * 2  , STAGE_BYTES = 8 * HTB, NXCD = 8, WGM = 8;

__host__ __device__ __forceinline__ int lds_byte(int r, int c) { const int st = (r >> 4) * 2 + (c >> 5), rr = r & 15, cc = c & 31, ob = rr * 64 + cc * 2; return st * 1024 + (ob ^ (((ob >> 9) & 1) << 5)); }
__host__ __device__ __forceinline__ void stage_rc(int b, int& R, int& C) { const int st = b / 1024, sb = b % 1024, swz = sb ^ (((sb >> 9) & 1) << 5); R = (st >> 1) * 16 + swz / 64; C = (st & 1) * 32 + (swz % 64) / 2; }
__host__ __device__ __forceinline__ int perm32(int rho) { const int n = rho >> 4, i = rho & 15; return 8 * (i >> 2) + 4 * n + (i & 3); }

struct Unit { int pm, pn, aux; };
struct Gemm { const bf16_t* A; const bf16_t* Bt; int M, N, K; };

struct StaticOrder {
    int nM, nN, nwg, G, c;
    __host__ __device__ void init(int M, int N, int G_, int c_) { nM = M / BM; nN = N / BM; nwg = nM * nN; G = G_; c = c_; }
    __host__ __device__ bool next(int i, Unit& u) const {
        const long L = (long)i * G + c; if (L >= nwg) return false;
        int wgid = (int)L; { const int q = nwg / NXCD, r = nwg % NXCD, xcd = wgid % NXCD, off = wgid / NXCD; wgid = (xcd < r ? xcd * (q + 1) : r * (q + 1) + (xcd - r) * q) + off; }
        const int nig = WGM * nN, gid = wgid / nig, fm = gid * WGM, gsz = (nM - fm) < WGM ? (nM - fm) : WGM;
        u.pm = fm + ((wgid % nig) % gsz); u.pn = (wgid % nig) / gsz; return true;
    }
    __device__ __forceinline__ void a_ready(const Unit&) const {}
    __device__ __forceinline__ void done(const Unit&) const {}
};


template <class Epi, class Sched, bool ALIGN_EPI = false, bool SP2 = false, bool FP8 = false, bool GATHER = false>
__device__ __forceinline__ void gemm_phase(PG8_LAS unsigned char* lds, const Gemm g, const Sched& S, const Epi& E, const PG8_LAS unsigned* gtab = nullptr) {
    int tido_ = threadIdx.x; asm volatile("" : "+v"(tido_));
    const int tid = tido_, wid = __builtin_amdgcn_readfirstlane(tid >> 6), lane = tid & 63, wr = wid >> 2, wc = wid & 3, fr = lane & 15, fq = lane >> 4;
    int Kop_ = g.K; asm volatile("" : "+s"(Kop_));
    const int K = Kop_, nt = K / BK;
    unsigned voffA[2], voffB[2];
#pragma unroll
    for (int i = 0; i < 2; ++i) { int R, C; stage_rc(tid * 16 + i * 8192, R, C); const int Rb = Epi::PERM ? ((R & ~31) + perm32(R & 31)) : R;
        voffA[i] = GATHER ? (unsigned)(R * 4 + C * 2 * 65536) : (unsigned)(R * K + C) * 2u; voffB[i] = (unsigned)(Rb * K + C) * 2u; }
    unsigned gA[2][2] = {{0u, 0u}, {0u, 0u}};
#define PG8_GLOAD(slot) do { _Pragma("unroll") for (int h_ = 0; h_ < 2; ++h_) _Pragma("unroll") for (int i_ = 0; i_ < 2; ++i_) \
        gA[h_][i_] = *(const PG8_LAS unsigned*)((const PG8_LAS unsigned char*)gtab + (slot) * 1024 + h_ * 512 + (voffA[i_] & 0xffffu)) + (voffA[i_] >> 16); } while (0)
#define PG8_STA(bufoff, base, h) do { if constexpr (GATHER) PG8_STAGE(bufoff, base, gA[h]); else PG8_STAGE(bufoff, (base) + (h) * hstep, voffA); } while (0)
    const size_t kstep = (size_t)(BK * 2);
    const size_t hstep = (size_t)HALF * K * 2;
    const size_t tstep = 2 * hstep;
    const unsigned ldsw = (unsigned)wid * 1024u;
    const int aoff = lds_byte(wr * 64 + fr, fq * 8), boff = lds_byte(wc * 32 + fr, fq * 8);
#define PG8_SA(b, h) (((b) * 2 + (h)) * HTB)
#define PG8_SB(b, h) ((4 + (b) * 2 + (h)) * HTB)
#define PG8_STAGE(bufoff, gbase, voff) do { _Pragma("unroll") for (int _i = 0; _i < 2; ++_i) \
        __builtin_amdgcn_global_load_lds((const unsigned*)((const char*)(gbase) + (voff)[_i]), (PG8_LAS unsigned*)(lds + (bufoff) + ldsw + _i * 8192), 16, 0, 0); } while (0)
#define PG8_LDA(dst, b, h) do { _Pragma("unroll") for (int m = 0; m < 4; ++m) dst[m] = __builtin_shufflevector(*(const PG8_LAS i32x4*)(lds + PG8_SA(b, h) + aoff + m * 2048), *(const PG8_LAS i32x4*)(lds + PG8_SA(b, h) + aoff + m * 2048 + 1024), 0, 1, 2, 3, 4, 5, 6, 7); } while (0)
#define PG8_LDB(dst, b, h) do { _Pragma("unroll") for (int n = 0; n < 2; ++n) dst[n] = __builtin_shufflevector(*(const PG8_LAS i32x4*)(lds + PG8_SB(b, h) + boff + n * 2048), *(const PG8_LAS i32x4*)(lds + PG8_SB(b, h) + boff + n * 2048 + 1024), 0, 1, 2, 3, 4, 5, 6, 7); } while (0)
#define PG8_MMA(ai, bj, At, Bt) do { __builtin_amdgcn_s_setprio(1); _Pragma("unroll") for (int m = 0; m < 4; ++m) _Pragma("unroll") for (int n = 0; n < 2; ++n) { \
        if constexpr (FP8)      \
            asm volatile("v_mfma_scale_f32_16x16x128_f8f6f4 %0, %1, %2, %0, %3, %3 op_sel_hi:[0,0,0]" : "+v"(acc[ai][bj][m][n]) : "v"(Bt[n]), "v"(At[m]), "v"(one8_)); \
        else { acc[ai][bj][m][n] = __builtin_amdgcn_mfma_f32_16x16x32_bf16(__builtin_bit_cast(bf16x8, __builtin_shufflevector(Bt[n], Bt[n], 0, 1, 2, 3)), __builtin_bit_cast(bf16x8, __builtin_shufflevector(At[m], At[m], 0, 1, 2, 3)), acc[ai][bj][m][n], 0, 0, 0); \
               acc[ai][bj][m][n] = __builtin_amdgcn_mfma_f32_16x16x32_bf16(__builtin_bit_cast(bf16x8, __builtin_shufflevector(Bt[n], Bt[n], 4, 5, 6, 7)), __builtin_bit_cast(bf16x8, __builtin_shufflevector(At[m], At[m], 4, 5, 6, 7)), acc[ai][bj][m][n], 0, 0, 0); } } __builtin_amdgcn_s_setprio(0); } while (0)
#define PG8_WAIT_V(n) asm volatile("s_waitcnt vmcnt(" #n ")" ::: "memory")
#define PG8_WAIT_L(n) asm volatile("s_waitcnt lgkmcnt(" #n ")" ::: "memory")
#define PG8_BAR __builtin_amdgcn_s_barrier()
#define PG8_SCHED __builtin_amdgcn_sched_barrier(0)
    Unit cur, nxt; int ui = 0;
    if (!S.next(0, cur)) return;
    int one8_ = 0x7f7f7f7f; asm volatile("" : "+v"(one8_));
    f32x4 acc[2][2][4][2];
    float zf_ = 0.f; asm volatile("" : "+v"(zf_));
#pragma unroll
    for (int a = 0; a < 2; ++a)
#pragma unroll
        for (int b = 0; b < 2; ++b)
#pragma unroll
            for (int m = 0; m < 4; ++m)
#pragma unroll
                for (int n = 0; n < 2; ++n) acc[a][b][m][n] = (f32x4){zf_, zf_, zf_, zf_};
    i32x8 At[4], B0[2], B1[2];
    const char* cA = (const char*)g.A + (GATHER ? (size_t)0 : (size_t)cur.pm * tstep); const char* cB = (const char*)g.Bt + (size_t)cur.pn * tstep;
    S.a_ready(cur);
    if constexpr (GATHER) PG8_GLOAD(cur.pm);
    if constexpr (SP2) {
        PG8_STAGE(PG8_SB(0, 0), cB, voffB); PG8_STAGE(PG8_SB(0, 1), cB + hstep, voffB); PG8_STA(PG8_SA(0, 0), cA, 0); PG8_STA(PG8_SA(0, 1), cA, 1);
        if (wr == 1) PG8_BAR;
        PG8_WAIT_V(2); PG8_BAR;
        PG8_STAGE(PG8_SB(1, 0), cB + kstep, voffB); PG8_STA(PG8_SA(1, 0), cA + kstep, 0); PG8_STAGE(PG8_SB(1, 1), cB + hstep + kstep, voffB);
        PG8_WAIT_V(6); PG8_BAR;
    } else {
        PG8_STAGE(PG8_SB(0, 0), cB, voffB); PG8_STA(PG8_SA(0, 0), cA, 0); PG8_STAGE(PG8_SB(0, 1), cB + hstep, voffB); PG8_STA(PG8_SA(0, 1), cA, 1);
        if (wr == 1) PG8_BAR;
        PG8_WAIT_V(4); PG8_BAR;
        PG8_STAGE(PG8_SB(1, 0), cB + kstep, voffB); PG8_STA(PG8_SA(1, 0), cA + kstep, 0); PG8_STAGE(PG8_SB(1, 1), cB + hstep + kstep, voffB);
        PG8_WAIT_V(6); PG8_BAR;
    }
    for (;;) {
        const bool has_next = S.next(ui + 1, nxt);
        const char* nA = (has_next && !GATHER) ? (const char*)g.A + (size_t)nxt.pm * tstep : cA; const char* nB = has_next ? (const char*)g.Bt + (size_t)nxt.pn * tstep : cB;
        for (int t = 0; t < nt; t += 2) {
            const bool last = (t == nt - 2);
            const char* a1 = cA + (size_t)(t + 1) * kstep;
            const char* a2 = last ? nA : cA + (size_t)(t + 2) * kstep; const char* b2 = last ? nB : cB + (size_t)(t + 2) * kstep;
            const char* a3 = a2 + kstep; const char* b3 = b2 + kstep;
            if (last && has_next) S.a_ready(nxt);
            if constexpr (SP2) {
            PG8_LDB(B0, 0, 0); PG8_LDB(B1, 0, 1); PG8_SCHED; PG8_LDA(At, 0, 0); PG8_STA(PG8_SA(1, 1), a1, 1);
            if constexpr (GATHER) { if (last && has_next) PG8_GLOAD(nxt.pm); }
            PG8_WAIT_V(8); PG8_WAIT_L(0); PG8_BAR; PG8_MMA(0, 0, At, B0); PG8_MMA(0, 1, At, B1); PG8_BAR; PG8_SCHED;
            PG8_LDA(At, 0, 1); PG8_STAGE(PG8_SB(0, 0), b2, voffB); PG8_STAGE(PG8_SB(0, 1), b2 + hstep, voffB); PG8_STA(PG8_SA(0, 0), a2, 0);
            PG8_WAIT_V(8); PG8_WAIT_L(0); PG8_BAR; PG8_MMA(1, 0, At, B0); PG8_MMA(1, 1, At, B1); PG8_BAR; PG8_SCHED;
            PG8_LDB(B0, 1, 0); PG8_LDB(B1, 1, 1); PG8_SCHED; PG8_LDA(At, 1, 0); PG8_STA(PG8_SA(0, 1), a2, 1);
            PG8_WAIT_V(8); PG8_WAIT_L(0); PG8_BAR; PG8_MMA(0, 0, At, B0); PG8_MMA(0, 1, At, B1); PG8_BAR; PG8_SCHED;
            PG8_LDA(At, 1, 1); PG8_STAGE(PG8_SB(1, 0), b3, voffB); PG8_STAGE(PG8_SB(1, 1), b3 + hstep, voffB); PG8_STA(PG8_SA(1, 0), a3, 0);
            PG8_WAIT_V(8); PG8_WAIT_L(0); PG8_BAR; PG8_MMA(1, 0, At, B0); PG8_MMA(1, 1, At, B1); PG8_BAR; PG8_SCHED;
            } else {
            static_assert(SP2 || !GATHER, "GATHER is wired into the SP2 loop only");
            PG8_LDB(B0, 0, 0); PG8_SCHED; PG8_LDA(At, 0, 0); PG8_STAGE(PG8_SA(1, 1), a1 + hstep, voffA);
            PG8_WAIT_L(8); PG8_BAR; PG8_WAIT_L(0); PG8_MMA(0, 0, At, B0); PG8_BAR; PG8_SCHED;
            PG8_LDB(B1, 0, 1); PG8_STAGE(PG8_SB(0, 0), b2, voffB);
            PG8_BAR; PG8_WAIT_L(0); PG8_MMA(0, 1, At, B1); PG8_BAR;
            PG8_LDA(At, 0, 1); PG8_STAGE(PG8_SA(0, 0), a2, voffA);
            PG8_BAR; PG8_WAIT_L(0); PG8_MMA(1, 0, At, B0); PG8_BAR; PG8_SCHED;
            PG8_STAGE(PG8_SB(0, 1), b2 + hstep, voffB);
            PG8_WAIT_V(6); PG8_BAR; PG8_MMA(1, 1, At, B1); PG8_BAR;
            PG8_LDB(B0, 1, 0); PG8_SCHED; PG8_LDA(At, 1, 0); PG8_STAGE(PG8_SA(0, 1), a2 + hstep, voffA);
            PG8_WAIT_L(8); PG8_BAR; PG8_WAIT_L(0); PG8_MMA(0, 0, At, B0); PG8_BAR; PG8_SCHED;
            PG8_LDB(B1, 1, 1); PG8_STAGE(PG8_SB(1, 0), b3, voffB);
            PG8_BAR; PG8_WAIT_L(0); PG8_MMA(0, 1, At, B1); PG8_BAR;
            PG8_LDA(At, 1, 1); PG8_STAGE(PG8_SA(1, 0), a3, voffA);
            PG8_BAR; PG8_WAIT_L(0); PG8_MMA(1, 0, At, B0); PG8_BAR; PG8_SCHED;
            PG8_STAGE(PG8_SB(1, 1), b3 + hstep, voffB);
            PG8_WAIT_V(6); PG8_BAR; PG8_MMA(1, 1, At, B1); PG8_BAR;
            }
        }
        if constexpr (ALIGN_EPI) { if (wr == 0) PG8_BAR; }
        if constexpr (FP8) asm volatile("s_nop 15\n\ts_nop 15" ::: "memory");
        if constexpr (!Epi::AFTER_DRAIN) { int le_ = lane; asm volatile("" : "+v"(le_));
            E(acc, cur, wr, wc, le_ & 15, le_ >> 4); S.done(cur); }
        if (!has_next) break;
        asm volatile("v_mov_b32 %0, 0" : "=v"(zf_));
#pragma unroll
        for (int a = 0; a < 2; ++a)
#pragma unroll
            for (int b = 0; b < 2; ++b)
#pragma unroll
                for (int m = 0; m < 4; ++m)
#pragma unroll
                    for (int n = 0; n < 2; ++n) acc[a][b][m][n] = (f32x4){zf_, zf_, zf_, zf_};
        cur = nxt; cA = nA; cB = nB; ++ui;
        if constexpr (ALIGN_EPI) { if (wr == 1) PG8_BAR; }
    }
    PG8_WAIT_V(0);
    if constexpr (!ALIGN_EPI) { if (wr == 0) PG8_BAR; }
    PG8_BAR;
    if constexpr (Epi::AFTER_DRAIN) { E.fused(acc, cur, wr, wc, fr, fq, lds, wid, lane); S.done(cur); }
#undef PG8_SA
#undef PG8_STA
#undef PG8_GLOAD
#undef PG8_SB
#undef PG8_STAGE
#undef PG8_LDA
#undef PG8_LDB
#undef PG8_MMA
#undef PG8_WAIT_V
#undef PG8_WAIT_L
#undef PG8_BAR
#undef PG8_SCHED
}

}

__device__ __forceinline__ void phase_a1(const Ctx& c) {
    const bf16_t* XN = (const bf16_t*)(c.ws + WS_XN); const bf16_t* W = (const bf16_t*)(c.ws + WS_WAIN);
    bf16_t* U = (bf16_t*)(c.ws + WS_U); bf16_t* VT = (bf16_t*)(c.ws + WS_VT); float* VSS = (float*)(c.ws + WS_VSS);
    const int fr = c.lane & 15, fq = c.lane >> 4, wr = c.wave >> 1, wc = c.wave & 1;
    for (int u = c.vb; u < 128 * 32; u += c.nb) {
        int mt, nt; map_unit(u, 32, mt, nt);
        const bf16_t* ap[4]; const bf16_t* bp[4];
        rows_regular<64>(ap, XN + (size_t)mt * 128 * D, D, c.tid); rows_regular<64>(bp, W + (size_t)nt * 128 * D, D, c.tid);
        f32x4 acc[4][4]; zero_acc(acc);
        if (nt < 16) {
            gemm_loop<64, 1, true>(c, ap, bp, bp, D, acc, acc);
#pragma unroll
            for (int m = 0; m < 4; ++m)
#pragma unroll
                for (int n = 0; n < 4; ++n) {
                    const int t = mt * 128 + wr * 64 + m * 16 + fr, col = nt * 128 + wc * 64 + n * 16 + fq * 4;
                    const f32x4 v = acc[m][n];
                    u32x2 o; o.x = pk_bf16(gelu_tanh(v.x), gelu_tanh(v.y)); o.y = pk_bf16(gelu_tanh(v.z), gelu_tanh(v.w));
                    *(u32x2*)(U + (size_t)t * GW + col) = o;
                }
        } else {
            gemm_loop<64, 1, false>(c, ap, bp, bp, D, acc, acc);
            const int vn = nt - 16;
#pragma unroll
            for (int m = 0; m < 4; ++m) {
                f32x4 ss = {0.f, 0.f, 0.f, 0.f};
                const int t0 = mt * 128 + wr * 64 + m * 16 + fq * 4;
#pragma unroll
                for (int n = 0; n < 4; ++n) {
                    const int ch = vn * 128 + wc * 64 + n * 16 + fr;
                    f32x4 v = acc[m][n];
                    v.x = gelu_tanh(v.x); v.y = gelu_tanh(v.y); v.z = gelu_tanh(v.z); v.w = gelu_tanh(v.w);
                    ss += v * v;
                    u32x2 o; o.x = pk_bf16(v.x, v.y); o.y = pk_bf16(v.z, v.w);
                    *(u32x2*)(VT + (size_t)ch * T + t0) = o;
                }
#pragma unroll
                for (int o = 1; o < 16; o <<= 1) { ss.x += __shfl_xor(ss.x, o); ss.y += __shfl_xor(ss.y, o); ss.z += __shfl_xor(ss.z, o); ss.w += __shfl_xor(ss.w, o); }
                if (fr == 0) {
                    VSS[(size_t)(t0 + 0) * 32 + vn * 2 + wc] = ss.x; VSS[(size_t)(t0 + 1) * 32 + vn * 2 + wc] = ss.y;
                    VSS[(size_t)(t0 + 2) * 32 + vn * 2 + wc] = ss.z; VSS[(size_t)(t0 + 3) * 32 + vn * 2 + wc] = ss.w;
                }
            }
        }
    }
}

__device__ __forceinline__ void phase_a2(const Ctx& c, bool dry = false) {
    const __attribute__((address_space(4))) Args& a = *c.a;
    bf16_t* U = (bf16_t*)(c.ws + WS_U); const bf16_t* VT = (const bf16_t*)(c.ws + WS_VT); const float* VSS = (const float*)(c.ws + WS_VSS);
    const float* ws_ = (const float*)a.in[IN_AWS]; const float* bs_ = (const float*)a.in[IN_ABS]; const float* vg = (const float*)a.in[IN_AVG];
    const int fr = c.lane & 15, fq = c.lane >> 4, wr = c.wave >> 1, wc = c.wave & 1, tid = c.tid;
    LAS unsigned char* lds = c.lds;
    LAS float* rl = (LAS float*)(lds + LDS_MAIN);
    for (int u = c.vb; u < 128 * 8; u += c.nb) {
        const int ci = u >> 3, g = u & 7, tokbase = ci * 128;
        __syncthreads();
        if (tid < 128) {
            const float* p = VSS + (size_t)(tokbase + tid) * 32; float s = 0.f;
#pragma unroll
            for (int i = 0; i < 8; ++i) { const f32x4 q = ((const f32x4*)p)[i]; s += (q.x + q.y) + (q.z + q.w); }
            rl[tid] = rsqrtf(s * (1.f / GW) + EPS);
        }
        __syncthreads();
        {
            const int t = tid >> 1, half = tid & 1;
            const float* wrow = ws_ + ((size_t)g * 128 + t) * 128 + half * 64;
#pragma unroll
            for (int cc = 0; cc < 8; ++cc) {
                const int s0 = half * 64 + cc * 8;
                u32x4 o;
                {
                    const f32x4 w0 = ((const f32x4*)wrow)[2 * cc], w1 = ((const f32x4*)wrow)[2 * cc + 1];
                    float e[8] = {w0.x, w0.y, w0.z, w0.w, w1.x, w1.y, w1.z, w1.w};
                    const f32x4 r0_ = *(const LAS f32x4*)(rl + s0), r1_ = *(const LAS f32x4*)(rl + s0 + 4);
                    const float rr[8] = {r0_.x, r0_.y, r0_.z, r0_.w, r1_.x, r1_.y, r1_.z, r1_.w};
#pragma unroll
                    for (int i = 0; i < 8; ++i) e[i] = (s0 + i <= t) ? e[i] * rr[i] : 0.f;
                    o.x = pk_bf16(e[0], e[1]); o.y = pk_bf16(e[2], e[3]); o.z = pk_bf16(e[4], e[5]); o.w = pk_bf16(e[6], e[7]);
                }
                *(LAS u32x4*)(lds + half * 16384 + t * 128 + ((cc ^ (t & 7)) << 4)) = o;
            }
        }
        for (int hn = 0; hn < 2; ++hn) {
            const int c0 = g * 256 + hn * 128;
            const bf16_t* bp[4]; rows_regular<64>(bp, VT + (size_t)c0 * T + tokbase, T, tid);
            stage_tile<64>(lds + 32768, bp, 0, tid); stage_tile<64>(lds + 32768 + 16384, bp, 64, tid);
            VM_WAIT();
            __syncthreads();
            f32x4 acc[4][4]; zero_acc(acc);
#pragma unroll 1
            for (int kh = 0; kh < 2; ++kh)
#pragma unroll 1
                for (int ks = 0; ks < 2; ++ks) {
                    bf16x8 af[4], bf[4];
#pragma unroll
                    for (int m = 0; m < 4; ++m) af[m] = *(const LAS bf16x8*)(lds + kh * 16384 + frag_off<64>(wr * 64 + m * 16 + fr, ks, fq));
#pragma unroll
                    for (int n = 0; n < 4; ++n) bf[n] = *(const LAS bf16x8*)(lds + 32768 + kh * 16384 + frag_off<64>(wc * 64 + n * 16 + fr, ks, fq));
#pragma unroll
                    for (int m = 0; m < 4; ++m)
#pragma unroll
                        for (int n = 0; n < 4; ++n) acc[m][n] = __builtin_amdgcn_mfma_f32_16x16x32_bf16(bf[n], af[m], acc[m][n], 0, 0, 0);
                }
            u32x2 uvv[4][4]; float bsvv[4];
#pragma unroll
            for (int m = 0; m < 4; ++m) { const int tl = wr * 64 + m * 16 + fr; bsvv[m] = bs_[g * 128 + tl];
#pragma unroll
                for (int n = 0; n < 4; ++n) uvv[m][n] = *(const u32x2*)(U + (size_t)(tokbase + tl) * GW + c0 + wc * 64 + n * 16 + fq * 4); }
#pragma unroll
            for (int m = 0; m < 4; ++m) {
                const int tl = wr * 64 + m * 16 + fr; const float bsv = bsvv[m];
#pragma unroll
                for (int n = 0; n < 4; ++n) {
                    const int ch = c0 + wc * 64 + n * 16 + fq * 4;
                    const f32x4 gn = *(const f32x4*)(vg + ch);
                    u32x2* up = (u32x2*)(U + (size_t)(tokbase + tl) * GW + ch);
                    const u32x2 uv = uvv[m][n]; const f32x4 v = acc[m][n];
                    u32x2 o;
                    o.x = pk_bf16(bf_lo(uv.x) * (gn.x * v.x + bsv), bf_hi(uv.x) * (gn.y * v.y + bsv));
                    o.y = pk_bf16(bf_lo(uv.y) * (gn.z * v.z + bsv), bf_hi(uv.y) * (gn.w * v.w + bsv));
                    if (dry) *(u32x2*)(c.ws + 440 * MB + ((size_t)(tokbase + tl) * GW + ch) * 2) = o; else *up = o;
                }
            }
            __syncthreads();
        }
    }
}

struct EpiResF32 {
    static constexpr bool PERM = false, AFTER_DRAIN = false;
    const float* base; float* out; int ldc; float ascale;
    __device__ __forceinline__ void operator()(const pg8::f32x4 (&acc)[2][2][4][2], const pg8::Unit& u, int wr, int wc, int fr, int fq) const {
#pragma unroll
        for (int ai = 0; ai < 2; ++ai)
#pragma unroll
            for (int m = 0; m < 4; ++m) {
                const size_t ro = (size_t)(u.pm * 256 + ai * 128 + wr * 64 + m * 16 + fr) * ldc + u.pn * 256 + wc * 32 + 4 * fq;
                f32x4 bv[2][2];
#pragma unroll
                for (int bj = 0; bj < 2; ++bj)
#pragma unroll
                    for (int n = 0; n < 2; ++n) bv[bj][n] = *(const f32x4*)(base + ro + bj * 128 + n * 16);
#pragma unroll
                for (int bj = 0; bj < 2; ++bj)
#pragma unroll
                    for (int n = 0; n < 2; ++n) *(f32x4*)(out + ro + bj * 128 + n * 16) = bv[bj][n] + acc[ai][bj][m][n] * ascale;
            }
    }
};
__device__ __forceinline__ void phase_a3(const Ctx& c) {
    pg8::Gemm g{(const pg8::bf16_t*)(c.ws + WS_U), (const pg8::bf16_t*)(c.ws + WS_WAOUT), T, D, GW};
    pg8::StaticOrder S; S.init(T, D, (int)gridDim.x, (int)blockIdx.x);
    EpiResF32 E{(const float*)c.a->in[IN_X], (float*)(c.ws + WS_H), D, 1.f};
    pg8::gemm_phase<EpiResF32, pg8::StaticOrder, false, true, false>(c.ldsp, g, S, E);
}

__device__ __forceinline__ void phase_route(const Ctx& c, int l, bool dry = false) {
    const __attribute__((address_space(4))) Args& a = *c.a;
    const float* H = (const float*)(c.ws + WS_H); bf16_t* XN = (bf16_t*)(c.ws + (dry ? 440 * MB : WS_XN));
    const float* wr_ = (const float*)(c.ws + WS_WR) + (size_t)l * D * 48;
    const float* gain = (const float*)a.in[IN_FFNN] + l * D;
    int* cnt = (int*)(c.ws + WS_CNT) + l * 32 + (dry ? 64 : 0); int* list = (int*)(c.ws + (dry ? 480 * MB : WS_LIST)); float* gatel = (float*)(c.ws + (dry ? 484 * MB : WS_GATE)); int* tokslot = (int*)(c.ws + (dry ? 488 * MB : WS_TOKSLOT));
    LAS float* rl = (LAS float*)(c.lds);
    LAS float* lgl = (LAS float*)(c.lds + 256);
    const int lane = c.lane, w = c.wave;
    f32x4 gv[4]; gain_load(gain, lane, gv);
    for (int unit = c.vb; unit < T / 32; unit += c.nb) {
        const int tok0 = unit * 32;
        __syncthreads();
        for (int i = 0; i < 8; ++i) {
            const int t = tok0 + w * 8 + i;
            f32x4 v[4]; row_load(H + (size_t)t * D, lane, v);
            const float r = rsqrtf(row_sumsq(v) * (1.f / D) + EPS);
            if (lane == 0) rl[w * 8 + i] = r;
            row_store_norm_fp8(c.ws + (dry ? 440 * MB : WS_XN8) + (size_t)t * D, lane, v, r, gv);
        }
        {
            const int th = w & 1, kh = w >> 1, m = lane & 15, q = lane >> 4;
            const float* arow = H + (size_t)(tok0 + 16 * th + m) * D + 512 * kh + 128 * q;
            const float* brow = wr_ + (size_t)(512 * kh + 128 * q) * 48 + m;
            f32x4 acc[3]; acc[0] = acc[1] = acc[2] = (f32x4){0.f, 0.f, 0.f, 0.f};
            for (int i = 0; i < 32; ++i) {
                const f32x4 av = ((const f32x4*)arow)[i];
                const float ae[4] = {av.x, av.y, av.z, av.w};
#pragma unroll
                for (int e = 0; e < 4; ++e) {
                    const float* bp = brow + (size_t)(4 * i + e) * 48;
#pragma unroll
                    for (int nt = 0; nt < 3; ++nt) acc[nt] = __builtin_amdgcn_mfma_f32_16x16x4f32(ae[e], bp[nt * 16], acc[nt], 0, 0, 0);
                }
            }
#pragma unroll
            for (int nt = 0; nt < 3; ++nt)
#pragma unroll
                for (int j = 0; j < 4; ++j) lgl[(kh * 32 + th * 16 + 4 * q + j) * 48 + nt * 16 + m] = acc[nt][j];
        }
        __syncthreads();
        if (c.tid < 32) {
            const int tt = c.tid, t = tok0 + tt; const float r = rl[tt];
            const float* bg = (const float*)a.in[IN_BG] + l * 4; const float* be = (const float*)a.in[IN_BE] + l * 32;
            float gl[4];
#pragma unroll
            for (int o = 0; o < 4; ++o) gl[o] = (lgl[tt * 48 + o] + lgl[(32 + tt) * 48 + o]) * r + bg[o];
            int gs = 0; float gm = gl[0];
#pragma unroll
            for (int o = 1; o < 4; ++o) if (gl[o] > gm) { gm = gl[o]; gs = o; }
            float gden = 0.f;
#pragma unroll
            for (int o = 0; o < 4; ++o) gden += __expf(gl[o] - gm);
            const float pg = 1.f / gden;
            float l1 = -INFINITY, l2 = -INFINITY; int i1 = 0, i2 = 0;
            for (int i = 0; i < 8; ++i) {
                const int o = 4 + gs * 8 + i;
                const float v = (lgl[tt * 48 + o] + lgl[(32 + tt) * 48 + o]) * r + be[gs * 8 + i];
                if (v > l1) { l2 = l1; i2 = i1; l1 = v; i1 = i; } else if (v > l2) { l2 = v; i2 = i; }
            }
            const float e2 = __expf(l2 - l1), inv = 1.f / (1.f + e2);
            const float g1 = pg * inv, g2 = pg * e2 * inv;
            const int ea = gs * 8 + i1, eb = gs * 8 + i2;
            const int sa = atomicAdd(&cnt[ea], 1), sb = atomicAdd(&cnt[eb], 1);
            list[ea * T + sa] = t; gatel[ea * T + sa] = g1; tokslot[2 * t] = (ea << 16) | sa;
            list[eb * T + sb] = t; gatel[eb * T + sb] = g2; tokslot[2 * t + 1] = (eb << 16) | sb;
        }
    }
}

__device__ __forceinline__ void moe_table(const Ctx& c, int l, LAS int* pst, LAS int* cn) {
    __syncthreads();
    if (c.tid == 0) {
        const int* cnt = (const int*)(c.ws + WS_CNT) + l * 32; int acc = 0;
        for (int e = 0; e < 32; ++e) { const int n = cnt[e]; cn[e] = n; pst[e] = acc; acc += (n + 255) >> 8; }
        pst[32] = acc;
    }
    __syncthreads();
}
__device__ __forceinline__ int moe_find(LAS const int* pst, int mb) { int e = 0; for (int i = 1; i < 32; ++i) e = (pst[i] <= mb) ? i : e; return e; }

constexpr int MOE_LDS = 131072;
constexpr int CAPU = 16;
static_assert(MOE_LDS + 1024 + CAPU * 1024 <= LDS_BYTES - 16, "moe lds");
__device__ __forceinline__ void moe_table_wg(const Ctx& c, int l, LAS int* pst, LAS int* cn) {
    __syncthreads();
    if (threadIdx.x == 0) {
        const int* cnt = (const int*)(c.ws + WS_CNT) + l * 32; int acc = 0;
        for (int e = 0; e < 32; ++e) { const int n = cnt[e]; cn[e] = n; pst[e] = acc; acc += (n + 255) >> 8; }
        pst[32] = acc;
    }
    __syncthreads();
}
struct MoeOrder {
    LAS const int* pst; int nunits, G, c, i0; bool gather;
    __device__ __forceinline__ bool next(int i, pg8::Unit& u) const {
        if (i >= CAPU) return false;
        const long L = (long)(i0 + i) * G + c; if (L >= nunits) return false;
        int wgid = (int)L; { const int q = nunits / 8, r = nunits % 8, xcd = wgid % 8, off = wgid / 8; wgid = (xcd < r ? xcd * (q + 1) : r * (q + 1) + (xcd - r) * q) + off; }
        const int mb = wgid >> 2, e = __builtin_amdgcn_readfirstlane(moe_find(pst, mb));
        u.pm = gather ? i : mb; u.pn = e * 4 + (wgid & 3); u.aux = mb; return true;
    }
    __device__ __forceinline__ void a_ready(const pg8::Unit&) const {}
    __device__ __forceinline__ void done(const pg8::Unit&) const {}
};
struct EpiE1 {
    static constexpr bool PERM = true, AFTER_DRAIN = false;
    unsigned char* HM;
    __device__ __forceinline__ void operator()(const pg8::f32x4 (&acc)[2][2][4][2], const pg8::Unit& u, int wr, int wc, int fr, int fq) const {
        const float ws_ = 1.f / W8_SCALE;
        unsigned char* hp = HM + ((size_t)u.aux * 256 + wr * 64 + fr) * DE + (u.pn & 3) * 128 + wc * 32 + 8 * fq;
#pragma unroll
        for (int ai = 0; ai < 2; ++ai)
#pragma unroll
            for (int m = 0; m < 4; ++m) {
                u32x2 o;
#pragma unroll
                for (int n = 0; n < 2; ++n) {
                    const f32x4 x = acc[ai][0][m][n] * ws_, y = acc[ai][1][m][n] * (ws_ * H8_SCALE);
                    const unsigned w = pk_fp8x4(x.x * sigmoidf_(x.x) * y.x, x.y * sigmoidf_(x.y) * y.y, x.z * sigmoidf_(x.z) * y.z, x.w * sigmoidf_(x.w) * y.w);
                    if (n == 0) o.x = w; else o.y = w;
                }
                *(u32x2*)(hp + (size_t)(ai * 128 + m * 16) * DE) = o;
            }
    }
};
__device__ __forceinline__ void phase_e1(const Ctx& c, int l) {
    LAS int* pst = (LAS int*)(c.ldsp + MOE_LDS); LAS int* cn = pst + 40; LAS unsigned* gtab = (LAS unsigned*)(c.ldsp + MOE_LDS + 1024);
    moe_table_wg(c, l, pst, cn);
    const int* list = (const int*)(c.ws + WS_LIST);
    pg8::Gemm g{(const pg8::bf16_t*)(c.ws + WS_XN8), (const pg8::bf16_t*)(c.ws + WS_W3), RPAD, 1024, D / 2};
    MoeOrder S{pst, __builtin_amdgcn_readfirstlane(pst[32]) * 4, (int)gridDim.x, (int)blockIdx.x, 0, true};
    EpiE1 E{c.ws + WS_HMID};
    for (;; S.i0 += CAPU) {
        pg8::Unit u; if (!S.next(0, u)) break;
        for (int i = 0; i < CAPU; ++i) {
            if (!S.next(i, u)) break;
            const int e = u.pn >> 2, row0 = (u.aux - __builtin_amdgcn_readfirstlane(pst[e])) * 256, count = __builtin_amdgcn_readfirstlane(cn[e]);
            if (threadIdx.x < 256) { int r = row0 + (int)threadIdx.x; r = r < count ? r : row0; gtab[i * 256 + threadIdx.x] = (unsigned)list[e * T + r] * (unsigned)D; }
        }
        __syncthreads();
        pg8::gemm_phase<EpiE1, MoeOrder, false, true, true, true>(c.ldsp, g, S, E, gtab);
        __syncthreads();
    }
}
struct EpiE2 {
    static constexpr bool PERM = true, AFTER_DRAIN = false;
    bf16_t* Y; const float* gatel; LAS const int* pst; LAS const int* cn;
    __device__ __forceinline__ void operator()(const pg8::f32x4 (&acc)[2][2][4][2], const pg8::Unit& u, int wr, int wc, int fr, int fq) const {
        const int mb = u.aux, e = u.pn >> 2, row0 = (mb - __builtin_amdgcn_readfirstlane(pst[e])) * 256, count = __builtin_amdgcn_readfirstlane(cn[e]);
        bf16_t* yp = Y + ((size_t)mb * 256 + wr * 64 + fr) * D + (u.pn & 3) * 256 + wc * 32 + 8 * fq;
        const float* gp = gatel + e * T + row0 + wr * 64 + fr; const int rl0 = row0 + wr * 64 + fr;
#pragma unroll
        for (int ai = 0; ai < 2; ++ai) {
            float gt[4];
#pragma unroll
            for (int m = 0; m < 4; ++m) { const float gv_ = gp[ai * 128 + m * 16]; gt[m] = (rl0 + ai * 128 + m * 16 < count) ? gv_ * (1.f / (W8_SCALE * H8_SCALE)) : 0.f; }
#pragma unroll
            for (int m = 0; m < 4; ++m)
#pragma unroll
                for (int bj = 0; bj < 2; ++bj) {
                    const f32x4 v0 = acc[ai][bj][m][0] * gt[m], v1 = acc[ai][bj][m][1] * gt[m];
                    u32x4 w; w.x = pk_bf16(v0.x, v0.y); w.y = pk_bf16(v0.z, v0.w); w.z = pk_bf16(v1.x, v1.y); w.w = pk_bf16(v1.z, v1.w);
                    *(u32x4*)(yp + (size_t)(ai * 128 + m * 16) * D + bj * 128) = w;
                }
        }
    }
};
__device__ __forceinline__ void phase_e2(const Ctx& c, int l) {
    LAS int* pst = (LAS int*)(c.ldsp + MOE_LDS); LAS int* cn = pst + 40;
    moe_table_wg(c, l, pst, cn);
    int kq = DE / 2; asm volatile("" : "+s"(kq));
    pg8::Gemm g{(const pg8::bf16_t*)(c.ws + WS_HMID), (const pg8::bf16_t*)(c.ws + WS_W2), RPAD, 1024, kq};
    MoeOrder S{pst, __builtin_amdgcn_readfirstlane(pst[32]) * 4, (int)gridDim.x, (int)blockIdx.x, 0, false};
    EpiE2 E{(bf16_t*)(c.ws + WS_Y), (const float*)(c.ws + WS_GATE), pst, cn};
    for (;; S.i0 += CAPU) {
        pg8::Unit u; if (!S.next(0, u)) break;
        pg8::gemm_phase<EpiE2, MoeOrder, false, true, true, false>(c.ldsp, g, S, E);
        __syncthreads();
    }
}
__device__ __forceinline__ void phase_p1(const Ctx& c, int l, bool dry = false) {
    float* H = (float*)(c.ws + WS_H); float* HO = (float*)(c.ws + (dry ? 440 * MB : WS_H)); bf16_t* XN = (bf16_t*)(c.ws + (dry ? 440 * MB : WS_XN)); const bf16_t* Y = (const bf16_t*)(c.ws + WS_Y);
    const int* tokslot = (const int*)(c.ws + WS_TOKSLOT); const float* gain = (const float*)c.a->in[IN_PLEN] + l * D;
    LAS int* pst = (LAS int*)(c.lds + LDS_MAIN); LAS int* cn = pst + 40;
    moe_table(c, l, pst, cn);
    const int gw = c.vb * 4 + c.wave, ngw = c.nb * 4, lane = c.lane;
    f32x4 gv[4]; gain_load(gain, lane, gv);
    int s0n = 0, s1n = 0;
    if (gw < T) { s0n = tokslot[2 * gw]; s1n = tokslot[2 * gw + 1]; }
    for (int t = gw; t < T; t += ngw) {
        const int s0 = s0n, s1 = s1n;
        { const int tn = (t + ngw < T) ? t + ngw : t; s0n = tokslot[2 * tn]; s1n = tokslot[2 * tn + 1]; }
        const bf16_t* y0 = Y + ((size_t)pst[s0 >> 16] * 256 + (s0 & 0xffff)) * D; const bf16_t* y1 = Y + ((size_t)pst[s1 >> 16] * 256 + (s1 & 0xffff)) * D;
        f32x4 v[4]; u32x2 a0[4], a1[4];
        row_load(H + (size_t)t * D, lane, v);
#pragma unroll
        for (int j = 0; j < 4; ++j) { a0[j] = ((const u32x2*)y0)[lane + 64 * j]; a1[j] = ((const u32x2*)y1)[lane + 64 * j]; }
#pragma unroll
        for (int j = 0; j < 4; ++j) {
            v[j].x += bf_lo(a0[j].x) + bf_lo(a1[j].x); v[j].y += bf_hi(a0[j].x) + bf_hi(a1[j].x); v[j].z += bf_lo(a0[j].y) + bf_lo(a1[j].y); v[j].w += bf_hi(a0[j].y) + bf_hi(a1[j].y);
        }
#pragma unroll
        for (int j = 0; j < 4; ++j) ((f32x4*)(HO + (size_t)t * D))[lane + 64 * j] = v[j];
        const float r = rsqrtf(row_sumsq(v) * (1.f / D) + EPS);
        row_store_norm_fp8(c.ws + (dry ? 440 * MB : WS_XN8) + (size_t)t * D, lane, v, r, gv);
    }
}
__device__ __forceinline__ void phase_p2(const Ctx& c, int l) {
    const bf16_t* XN = (const bf16_t*)(c.ws + WS_XN); const bf16_t* WG = (const bf16_t*)(c.ws + WS_WGATE) + (size_t)l * D * D;
    const bf16_t* PB = (const bf16_t*)(c.ws + WS_PBF) + (size_t)l * T * PLE; const bf16_t* WP = (const bf16_t*)(c.ws + WS_WPROJ) + (size_t)l * D * PLE;
    float* H = (float*)(c.ws + WS_H);
    const int fr = c.lane & 15, fq = c.lane >> 4, wr = c.wave >> 1, wc = c.wave & 1;
    for (int u = c.vb; u < 128 * 8; u += c.nb) {
        int mt, nt; map_unit(u, 8, mt, nt);
        const bf16_t* ap[4]; const bf16_t* bp[4];
        f32x4 ag[4][4], apj[4][4]; zero_acc(ag); zero_acc(apj);
        rows_regular<64>(ap, (const bf16_t*)(c.ws + WS_XN8 + (size_t)mt * 128 * D), D / 2, c.tid); rows_regular<64>(bp, (const bf16_t*)(c.ws + WS_WGATE + ((size_t)l * D + nt * 128) * D), D / 2, c.tid);
        gemm_loop<64, 1, true, true>(c, ap, bp, bp, D / 2, ag, ag);
        rows_regular<64>(ap, PB + (size_t)mt * 128 * PLE, PLE, c.tid); rows_regular<64>(bp, WP + (size_t)nt * 128 * PLE, PLE, c.tid);
        gemm_loop<64, 1, true>(c, ap, bp, bp, PLE, apj, apj);
        f32x4 hres[4][4];
#pragma unroll
        for (int m = 0; m < 4; ++m)
#pragma unroll
            for (int n = 0; n < 4; ++n) hres[m][n] = *(const f32x4*)(H + (size_t)(mt * 128 + wr * 64 + m * 16 + fr) * D + nt * 128 + wc * 64 + n * 16 + fq * 4);
#pragma unroll
        for (int m = 0; m < 4; ++m)
#pragma unroll
            for (int n = 0; n < 4; ++n) {
                const size_t off = (size_t)(mt * 128 + wr * 64 + m * 16 + fr) * D + nt * 128 + wc * 64 + n * 16 + fq * 4;
                const f32x4 g = ag[m][n] * (1.f / W8_SCALE), pj = apj[m][n]; f32x4 h = hres[m][n];
                h.x += sigmoidf_(g.x) * pj.x; h.y += sigmoidf_(g.y) * pj.y; h.z += sigmoidf_(g.z) * pj.z; h.w += sigmoidf_(g.w) * pj.w;
                *(f32x4*)(H + off) = h;
            }
    }
}
__device__ __forceinline__ void phase_norm_bf16(const Ctx& c, const float* gain) {
    const float* H = (const float*)(c.ws + WS_H);
    const int gw = c.vb * 4 + c.wave, ngw = c.nb * 4;
    f32x4 gv[4]; gain_load(gain, c.lane, gv);
    for (int t = gw; t < T; t += ngw) {
        f32x4 v[4]; row_load(H + (size_t)t * D, c.lane, v);
        const float r = rsqrtf(row_sumsq(v) * (1.f / D) + EPS);
        row_store_norm_fp8(c.ws + WS_XN8 + (size_t)t * D, c.lane, v, r, gv);
        row_store_norm_bf16((bf16_t*)(c.ws + WS_XN) + (size_t)t * D, c.lane, v, r, gv);
    }
}
__device__ __forceinline__ void phase_final(const Ctx& c) {
    const float* H = (const float*)(c.ws + WS_H); float* O = c.a->out; const float* gain = (const float*)c.a->in[IN_FINN];
    const int gw = c.vb * 4 + c.wave, ngw = c.nb * 4;
    f32x4 gv[4]; gain_load(gain, c.lane, gv);
    for (int t = gw; t < T; t += ngw) {
        f32x4 v[4]; row_load(H + (size_t)t * D, c.lane, v);
        const float r = rsqrtf(row_sumsq(v) * (1.f / D) + EPS);
#pragma unroll
        for (int j = 0; j < 4; ++j) ((f32x4*)(O + (size_t)t * D))[c.lane + 64 * j] = v[j] * r * gv[j];
    }
}

__device__ __forceinline__ void phase_b1(const Ctx& c, size_t raw_off = WS_RAW) {
    const bf16_t* XN = (const bf16_t*)(c.ws + WS_XN); const bf16_t* W = (const bf16_t*)(c.ws + WS_WBIN); bf16_t* RAW = (bf16_t*)(c.ws + raw_off);
    const int fr = c.lane & 15, fq = c.lane >> 4, wr = c.wave >> 1, wc = c.wave & 1;
    for (int u = c.vb; u < 128 * 17; u += c.nb) {
        int mt, nt; map_unit(u, 17, mt, nt);
        const bf16_t* ap[4]; const bf16_t* bp[4];
        f32x4 acc[4][4]; zero_acc(acc);
        float osc = 1.f;
        if (nt < 12) {
            rows_regular<64>(ap, (const bf16_t*)(c.ws + WS_XN8 + (size_t)mt * 128 * D), D / 2, c.tid); rows_regular<64>(bp, (const bf16_t*)(c.ws + WS_WBIN + (size_t)nt * 128 * D), D / 2, c.tid);
            gemm_loop<64, 1, true, true>(c, ap, bp, bp, D / 2, acc, acc);
            osc = 1.f / W8_SCALE;
        } else {
            rows_regular<64>(ap, XN + (size_t)mt * 128 * D, D, c.tid); rows_regular<64>(bp, (const bf16_t*)(c.ws + WS_WBIN + 3 * MB) + (size_t)(nt - 12) * 128 * D, D, c.tid);
            gemm_loop<64, 1, true>(c, ap, bp, bp, D, acc, acc);
        }
#pragma unroll
        for (int m = 0; m < 4; ++m)
#pragma unroll
            for (int n = 0; n < 4; ++n) {
                const f32x4 v = acc[m][n] * osc; u32x2 o; o.x = pk_bf16(v.x, v.y); o.y = pk_bf16(v.z, v.w);
                *(u32x2*)(RAW + (size_t)(mt * 128 + wr * 64 + m * 16 + fr) * BINP + nt * 128 + wc * 64 + n * 16 + fq * 4) = o;
            }
    }
}

__device__ __forceinline__ void unpack8(const u32x4 r, float (&e)[8]) { e[0] = bf_lo(r.x); e[1] = bf_hi(r.x); e[2] = bf_lo(r.y); e[3] = bf_hi(r.y); e[4] = bf_lo(r.z); e[5] = bf_hi(r.z); e[6] = bf_lo(r.w); e[7] = bf_hi(r.w); }
__device__ __forceinline__ u32x4 pack8(const float (&e)[8]) { u32x4 o; o.x = pk_bf16(e[0], e[1]); o.y = pk_bf16(e[2], e[3]); o.z = pk_bf16(e[4], e[5]); o.w = pk_bf16(e[6], e[7]); return o; }
__device__ __forceinline__ void phase_rope(const Ctx& c) {
    const bf16_t* RAW = (const bf16_t*)(c.ws + WS_RAW);
    bf16_t* Q = (bf16_t*)(c.ws + WS_Q); bf16_t* K = (bf16_t*)(c.ws + WS_K); bf16_t* V = (bf16_t*)(c.ws + WS_V);
    bf16_t* QI = (bf16_t*)(c.ws + WS_QI); bf16_t* KI = (bf16_t*)(c.ws + WS_KI); float* WI = (float*)(c.ws + WS_WI);
    const int* pos = (const int*)c.a->in[IN_POS];
    LAS float* cs = (LAS float*)(c.lds + c.wave * 256);
    const int gw = c.vb * 4 + c.wave, ngw = c.nb * 4, lane = c.lane;
    const double ex = (lane < 16) ? (double)lane * (1.0 / 16.0) : (double)((lane - 16) & 7) * (1.0 / 8.0);
    const float invf = (float)exp2(-ex * 18.931568569324174);
    for (int t = gw; t < T; t += ngw) {
        if (lane < 24) {
            const float ang = (float)pos[t] * invf;
            const double ad = (double)ang; const double n = rint(ad * 0.15915494309189535); const float red = (float)(ad - n * 6.283185307179586);
            cs[lane] = __cosf(red); cs[32 + lane] = __sinf(red);
        }
        LDS_WAIT();
        const bf16_t* row = RAW + (size_t)t * BINP;
        for (int ch = lane; ch < BINP / 8; ch += 64) {
            const u32x4 own = ((const u32x4*)row)[ch];
            float e[8]; unpack8(own, e);
            if (ch < 160) {
                const int cc = ch & 15;
                if (cc < 4) {
                    const u32x4 oth = ((const u32x4*)row)[ch ^ 2]; float p[8]; unpack8(oth, p);
                    const int f0 = (cc & 1) * 8;
#pragma unroll
                    for (int i = 0; i < 8; ++i) { const float co = cs[f0 + i], si = cs[32 + f0 + i]; e[i] = (cc < 2) ? (e[i] * co - p[i] * si) : (e[i] * co + p[i] * si); }
                }
                u32x2 o8; o8.x = pk_fp8x4(e[0], e[1], e[2], e[3]); o8.y = pk_fp8x4(e[4], e[5], e[6], e[7]);
                if (ch < 128) ((u32x2*)((unsigned char*)Q + (size_t)t * D))[ch] = o8;
                else ((u32x2*)((unsigned char*)K + (size_t)t * 256))[ch - 128] = o8;
            } else if (ch < 192) {
                u32x2 o8; o8.x = pk_fp8x4(e[0], e[1], e[2], e[3]); o8.y = pk_fp8x4(e[4], e[5], e[6], e[7]);
                ((u32x2*)((unsigned char*)V + (size_t)t * 256))[ch - 160] = o8;
            } else if (ch < 264) {
                const int cc = ch & 7;
                if (cc < 2) {
                    const u32x4 oth = ((const u32x4*)row)[ch ^ 1]; float p[8]; unpack8(oth, p);
#pragma unroll
                    for (int i = 0; i < 8; ++i) { const float co = cs[16 + i], si = cs[32 + 16 + i]; e[i] = (cc == 0) ? (e[i] * co - p[i] * si) : (e[i] * co + p[i] * si); }
                }
                if (ch < 256) ((u32x4*)(QI + (size_t)t * 512))[ch - 192] = pack8(e);
                else ((u32x4*)(KI + (size_t)t * 64))[ch - 256] = pack8(e);
            } else if (ch == 264) {
                f32x4 w0 = {e[0], e[1], e[2], e[3]}, w1 = {e[4], e[5], e[6], e[7]};
                const float sc = 0.044194173824159216f;
                ((f32x4*)(WI + (size_t)t * 8))[0] = w0 * sc; ((f32x4*)(WI + (size_t)t * 8))[1] = w1 * sc;
            }
        }
        LDS_WAIT();
    }
}

__device__ __forceinline__ size_t srow_off(int t) { const int m = t >> 6, r = t & 63; return (size_t)64 * (m + 1) * (32 * m + r); }
constexpr size_t S_BATCH = (size_t)64 * 65 * 2048;
constexpr int SCORE_UNITS = 4 * 312;
__device__ __forceinline__ void phase_score(const Ctx& c) {
    const bf16_t* QI = (const bf16_t*)(c.ws + WS_QI); const bf16_t* KI = (const bf16_t*)(c.ws + WS_KI); const float* WI = (const float*)(c.ws + WS_WI);
    float* S = (float*)(c.ws + WS_S);
    const int lane = c.lane, hf = lane >> 5, col = lane & 31, w = c.wave;
    for (int u = c.vb; u < SCORE_UNITS; u += c.nb) {
        const int b = u & 3, r = u >> 2;
        int kc, qb;
        if (r < 120) { kc = 0; qb = 8 + r; } else if (r < 216) { kc = 1; qb = 32 + (r - 120); } else if (r < 280) { kc = 2; qb = 64 + (r - 216); } else { kc = 3; qb = 96 + (r - 280); }
        const int tb = b * SEQ, t0 = 32 * qb + 8 * w;
        bf16x8 af[2][4]; f32x4 wv[2][4];
        { const int rho = lane & 31, ql = 2 * ((rho >> 2) & 1) + (rho >> 4), hd = 4 * ((rho >> 3) & 1) + (rho & 3);
#pragma unroll
          for (int a = 0; a < 2; ++a) {
              const bf16_t* qp = QI + (size_t)(tb + t0 + 4 * a + ql) * 512 + hd * 64 + 8 * hf;
#pragma unroll
              for (int ks = 0; ks < 4; ++ks) af[a][ks] = *(const bf16x8*)(qp + 16 * ks);
              const float* wp = WI + (size_t)(tb + t0 + 4 * a + 2 * hf) * 8;
#pragma unroll
              for (int i = 0; i < 4; ++i) wv[a][i] = ((const f32x4*)wp)[i];
          } }
        const int ntile = min(32, qb + 1 - 32 * kc), key0 = 1024 * kc;
        float* Sb = S + (size_t)b * S_BATCH;
        size_t ro[2][2];
#pragma unroll
        for (int a = 0; a < 2; ++a) { ro[a][0] = srow_off(t0 + 4 * a + 2 * hf); ro[a][1] = srow_off(t0 + 4 * a + 2 * hf + 1); }
        const int nsub = (ntile + 3) >> 2;
        const bf16_t* krp[4];
        rows_regular<64>(krp, KI + (size_t)(tb + key0) * 64, 64, c.tid);
        __syncthreads();
        stage_tile<64>(c.lds, krp, 0, c.tid);
        for (int sc = 0; sc < 8; ++sc) {
            VM_WAIT();
            __syncthreads();
            const LAS unsigned char* cur = c.lds + (sc & 1) * 16384;
            if (sc + 1 < nsub) stage_tile<64>(c.lds + ((sc + 1) & 1) * 16384, krp, (sc + 1) * 128 * 64, c.tid);
#pragma unroll
            for (int j = 0; j < 4; ++j) {
                const int kt = 4 * sc + j;
                if (sc < nsub && kt < ntile) {
                    const int key = key0 + 32 * kt + col, row = 32 * j + col;
                    bf16x8 cb[4];
#pragma unroll
                    for (int ks = 0; ks < 4; ++ks) cb[ks] = *(const LAS bf16x8*)(cur + row * 128 + (((2 * ks + hf) ^ (row & 7)) << 4));
#pragma unroll
                    for (int a = 0; a < 2; ++a) {
                        f32x16 acc = {};
#pragma unroll
                        for (int ks = 0; ks < 4; ++ks) acc = __builtin_amdgcn_mfma_f32_32x32x16_bf16(af[a][ks], cb[ks], acc, 0, 0, 0);
                        float s0 = fmaxf(acc[0], 0.f) * wv[a][0].x; s0 += fmaxf(acc[1], 0.f) * wv[a][0].y; s0 += fmaxf(acc[2], 0.f) * wv[a][0].z; s0 += fmaxf(acc[3], 0.f) * wv[a][0].w;
                        s0 += fmaxf(acc[4], 0.f) * wv[a][1].x; s0 += fmaxf(acc[5], 0.f) * wv[a][1].y; s0 += fmaxf(acc[6], 0.f) * wv[a][1].z; s0 += fmaxf(acc[7], 0.f) * wv[a][1].w;
                        float s1 = fmaxf(acc[8], 0.f) * wv[a][2].x; s1 += fmaxf(acc[9], 0.f) * wv[a][2].y; s1 += fmaxf(acc[10], 0.f) * wv[a][2].z; s1 += fmaxf(acc[11], 0.f) * wv[a][2].w;
                        s1 += fmaxf(acc[12], 0.f) * wv[a][3].x; s1 += fmaxf(acc[13], 0.f) * wv[a][3].y; s1 += fmaxf(acc[14], 0.f) * wv[a][3].z; s1 += fmaxf(acc[15], 0.f) * wv[a][3].w;
                        const int tA = t0 + 4 * a + 2 * hf;
                        Sb[ro[a][0] + key] = (key <= tA) ? s0 : -INFINITY;
                        Sb[ro[a][1] + key] = (key <= tA + 1) ? s1 : -INFINITY;
                    }
                }
            }
        }
    }
}

constexpr int NBINS = 2048, CAND_CAP = 256, SEL_WAVE_LDS = 8192 + 2048 + 64;
__device__ __forceinline__ int clamp_bin(int x) { return min(max(x, 0), NBINS - 1); }
__device__ __forceinline__ void phase_select(const Ctx& c) {
    const float* S = (const float*)(c.ws + WS_S); int* SEL = (int*)(c.ws + WS_SEL);
    LAS int* hist = (LAS int*)(c.lds + c.wave * SEL_WAVE_LDS);
    LAS float* candv = (LAS float*)(hist + NBINS);
    LAS int* candi = (LAS int*)(candv + CAND_CAP);
    LAS int* thr = candi + CAND_CAP;
    const int gw = c.vb * 4 + c.wave, ngw = c.nb * 4;
    for (int j = gw; j < 4 * 3840; j += ngw) {
        int lane = c.lane;
        asm volatile("" : "+v"(lane));
        const int b = j & 3, t = 4095 - (j >> 2), ni = (t + 64) >> 6;
        const float* row = S + (size_t)b * S_BATCH + srow_off(t);
        float s[64];
#pragma unroll
        for (int g4 = 0; g4 < 4; ++g4) {
            if (16 * g4 < ni) {
#pragma unroll
                for (int i = 16 * g4; i < 16 * g4 + 16; ++i) { const int k = 64 * i + lane; const float v = row[min(k, t)]; s[i] = (k <= t) ? v : -INFINITY; }
            } else {
#pragma unroll
                for (int i = 16 * g4; i < 16 * g4 + 16; ++i) s[i] = -INFINITY;
            }
        }
        float mn = INFINITY, mx = -INFINITY;
#pragma unroll
        for (int g8 = 0; g8 < 8; ++g8) if (8 * g8 < ni) {
#pragma unroll
            for (int i = 8 * g8; i < 8 * g8 + 8; ++i) { mx = fmaxf(mx, s[i]); mn = fminf(mn, (s[i] == -INFINITY) ? INFINITY : s[i]); }
        }
#pragma unroll
        for (int o = 1; o < 64; o <<= 1) { mx = fmaxf(mx, __shfl_xor(mx, o)); mn = fminf(mn, __shfl_xor(mn, o)); }
        const float sc = (mx > mn) ? (float)NBINS / (mx - mn) : 0.f, a0 = -mn * sc;
#pragma unroll
        for (int i = 0; i < 8; ++i) ((LAS u32x4*)hist)[lane * 8 + i] = (u32x4){0u, 0u, 0u, 0u};
        LDS_WAIT();
#define BINOF(v) clamp_bin((int)__builtin_fmaf((v), sc, a0))
#pragma unroll
        for (int g8 = 0; g8 < 8; ++g8) if (8 * g8 < ni) {
#pragma unroll
            for (int i = 8 * g8; i < 8 * g8 + 8; ++i) lds_inc(&hist[BINOF(s[i])]);
        }
        LDS_WAIT();
        int bs, need;
        {
            const LAS int* hq = hist + lane * 32;
            u32x4 hr[8];
            int loc = 0;
#pragma unroll
            for (int i = 0; i < 8; ++i) { hr[i] = ((const LAS u32x4*)hq)[i]; loc += (int)(hr[i].x + hr[i].y + hr[i].z + hr[i].w); }
            int suf = loc;
#pragma unroll
            for (int o = 1; o < 64; o <<= 1) { const int v = __shfl_down(suf, o); if (lane + o < 64) suf += v; }
            const int above = suf - loc;
            const bool cross = (above < 256 && suf >= 256);
            int bsl = 0, abl = 0;
            { int run = above;
#pragma unroll
              for (int i = 31; i >= 0; --i) { const int h = (int)hr[i >> 2][i & 3]; const bool hit = (run < 256 && run + h >= 256); bsl = hit ? lane * 32 + i : bsl; abl = hit ? run : abl; run += h; } }
            const unsigned long long cm = __ballot(cross);
            const int src = cm ? (int)__builtin_ctzll(cm) : 0;
            bs = __shfl(bsl, src); need = 256 - __shfl(abl, src);
        }
        int bs2 = -1;
#define SUBOF(v) clamp_bin((int)((__builtin_fmaf((v), sc, a0) - (float)bs) * (float)NBINS))
        if (__shfl(hist[bs], 0) > 48) {
#pragma unroll
            for (int i = 0; i < 8; ++i) ((LAS u32x4*)hist)[lane * 8 + i] = (u32x4){0u, 0u, 0u, 0u};
            LDS_WAIT();
#pragma unroll
            for (int i = 0; i < 64; ++i) if (s[i] != -INFINITY && BINOF(s[i]) == bs) lds_inc(&hist[SUBOF(s[i])]);
            LDS_WAIT();
            const LAS int* hq = hist + lane * 32;
            int loc = 0;
#pragma unroll
            for (int i = 0; i < 8; ++i) { const u32x4 h4 = ((const LAS u32x4*)hq)[i]; loc += (int)(h4.x + h4.y + h4.z + h4.w); }
            int suf = loc;
#pragma unroll
            for (int o = 1; o < 64; o <<= 1) { const int v = __shfl_down(suf, o); if (lane + o < 64) suf += v; }
            const int above = suf - loc;
            const bool cross = (above < need && suf >= need);
            int bsl = 0, abl = 0;
            if (cross) { int run = above; for (int i = 31; i >= 0; --i) { const int h = hq[i]; if (run < need && run + h >= need) { bsl = lane * 32 + i; abl = run; } run += h; } }
            const unsigned long long cm = __ballot(cross);
            const int src = cm ? (int)__builtin_ctzll(cm) : 0;
            bs2 = __shfl(bsl, src); need = need - __shfl(abl, src);
        }
        asm volatile("" : "+v"(lane));
        float sc2 = sc, a02 = a0;
        asm volatile("" : "+v"(sc2), "+v"(a02));
#undef BINOF
#define BINOF(v) clamp_bin((int)__builtin_fmaf((v), sc2, a02))
        int* selr = SEL + ((size_t)b * SEQ + t) * 256;
        int nc = 0, base = 0;
#pragma unroll
        for (int g4 = 0; g4 < 4; ++g4) if (16 * g4 < ni) {
#pragma unroll
            for (int i = 16 * g4; i < 16 * g4 + 16; ++i) {
                const int bn = BINOF(s[i]);
                bool pc = (bn == bs) && (s[i] != -INFINITY), pd = (bn > bs);
                if (bs2 >= 0) { const int sb = SUBOF(s[i]); pd = pd || (pc && sb > bs2); pc = pc && (sb == bs2); }
                const unsigned long long md = __ballot(pd), mc = __ballot(pc);
                const int posd = base + (int)__builtin_amdgcn_mbcnt_hi((unsigned)(md >> 32), __builtin_amdgcn_mbcnt_lo((unsigned)md, 0u));
                const int posc = nc + (int)__builtin_amdgcn_mbcnt_hi((unsigned)(mc >> 32), __builtin_amdgcn_mbcnt_lo((unsigned)mc, 0u));
                if (pd && posd < 256) selr[posd] = 64 * i + lane;
                if (pc && posc < CAND_CAP) { candv[posc] = s[i]; candi[posc] = 64 * i + lane; }
                base += (int)__popcll(md); nc += (int)__popcll(mc);
            }
        }
        nc = min(nc, CAND_CAP);
        LDS_WAIT();
        for (int i = lane; i < nc; i += 64) {
            const float v = candv[i]; const int id = candi[i];
            int rank = 0;
            for (int k = 0; k < nc; ++k) { const float vk = candv[k]; const int ik = candi[k]; rank += (vk > v || (vk == v && ik < id)) ? 1 : 0; }
            if (rank < need && base + rank < 256) selr[base + rank] = id;
        }
        LDS_WAIT();
#undef BINOF
#undef SUBOF
    }
}

typedef short s16x4 __attribute__((ext_vector_type(4)));
__device__ __forceinline__ unsigned vimg_f(unsigned r) { return ((r & 3u) << 2) | ((r >> 2) & 3u); }
__device__ __forceinline__ void tr_read8(const unsigned (&ad)[8], s16x4 (&r)[8]) {
    asm volatile("ds_read_b64_tr_b16 %0, %8\n\tds_read_b64_tr_b16 %1, %9\n\tds_read_b64_tr_b16 %2, %10\n\tds_read_b64_tr_b16 %3, %11\n\t"
                 "ds_read_b64_tr_b16 %4, %12\n\tds_read_b64_tr_b16 %5, %13\n\tds_read_b64_tr_b16 %6, %14\n\tds_read_b64_tr_b16 %7, %15\n\ts_waitcnt lgkmcnt(0)"
                 : "=&v"(r[0]), "=&v"(r[1]), "=&v"(r[2]), "=&v"(r[3]), "=&v"(r[4]), "=&v"(r[5]), "=&v"(r[6]), "=&v"(r[7])
                 : "v"(ad[0]), "v"(ad[1]), "v"(ad[2]), "v"(ad[3]), "v"(ad[4]), "v"(ad[5]), "v"(ad[6]), "v"(ad[7]) : "memory");
}
__device__ __forceinline__ void tr_read8_b8(const unsigned (&ad)[8], s16x4 (&r)[8]) {
    asm volatile("ds_read_b64_tr_b8 %0, %8\n\tds_read_b64_tr_b8 %1, %9\n\tds_read_b64_tr_b8 %2, %10\n\tds_read_b64_tr_b8 %3, %11\n\t"
                 "ds_read_b64_tr_b8 %4, %12\n\tds_read_b64_tr_b8 %5, %13\n\tds_read_b64_tr_b8 %6, %14\n\tds_read_b64_tr_b8 %7, %15\n\ts_waitcnt lgkmcnt(0)"
                 : "=&v"(r[0]), "=&v"(r[1]), "=&v"(r[2]), "=&v"(r[3]), "=&v"(r[4]), "=&v"(r[5]), "=&v"(r[6]), "=&v"(r[7])
                 : "v"(ad[0]), "v"(ad[1]), "v"(ad[2]), "v"(ad[3]), "v"(ad[4]), "v"(ad[5]), "v"(ad[6]), "v"(ad[7]) : "memory");
}
constexpr int ATT_WAVE_LDS = 19456;
__device__ __forceinline__ void phase_attn(const Ctx& c) {
    const bf16_t* Q = (const bf16_t*)(c.ws + WS_Q); const bf16_t* K = (const bf16_t*)(c.ws + WS_K); const bf16_t* V = (const bf16_t*)(c.ws + WS_V);
    const int* SEL = (const int*)(c.ws + WS_SEL); bf16_t* O = (bf16_t*)(c.ws + WS_O);
    LAS unsigned char* wl = c.lds + c.wave * ATT_WAVE_LDS;
    LAS int* sl = (LAS int*)wl;
    LAS unsigned short* pT = (LAS unsigned short*)(wl + 1024);
    LAS unsigned char* vb = wl + 3072;
    const int lane = c.lane, fr = lane & 15, fq = lane >> 4;
    const int gw = c.vb * 4 + c.wave, ngw = c.nb * 4;
    unsigned tro[8];
    { const unsigned row = 8u * fq + ((unsigned)fr >> 1);
#pragma unroll
      for (int c2 = 0; c2 < 8; ++c2) tro[c2] = 128u * row + 16u * ((unsigned)c2 ^ (row & 7u)) + 8u * ((unsigned)fr & 1u); }
    const unsigned vb_addr = (unsigned)(size_t)vb;
    int tcount = 0, cit = gw;
    const bool xsplit = (c.nb % 128) == 0;
    const int xg = (c.vb >> 6) & 1, wi0 = xsplit ? (((c.vb >> 7) * 64 + (c.vb & 63)) * 4 + c.wave) : gw, wstride = xsplit ? ngw / 2 : ngw;
    const unsigned chunkoff = (((unsigned)lane & 7u) ^ (((unsigned)lane >> 3) & 7u)) << 4;
    unsigned trh[8];
    { const unsigned row = 8u * (fq & 1) + ((unsigned)fr >> 1);
#pragma unroll
      for (int c2 = 0; c2 < 8; ++c2) trh[c2] = 128u * row + 16u * ((unsigned)c2 ^ (row & 7u)) + 8u * ((unsigned)fr & 1u); }
#define SEL_PREFETCH(tg_) __builtin_amdgcn_global_load_lds((const unsigned*)(SEL + (size_t)(tg_) * 256 + lane * 4), (LAS unsigned*)((LAS unsigned char*)sl + lane * 16), 16, 0, 0)
    const int task_end = xsplit ? T : T * 2;
    if (wi0 < task_end) { SEL_PREFETCH(xsplit ? wi0 : (wi0 >> 1)); }
    for (int task = wi0; task < task_end; task += wstride) {
        const int tg = xsplit ? task : (task >> 1), g = xsplit ? xg : (task & 1), b = tg >> 12, t = tg & 4095, tb = b * SEQ;
        const int nsel = min(256, t + 1), nch = (nsel + 31) >> 5;
        asm volatile("s_waitcnt vmcnt(0)" ::: "memory");
        unsigned koff[32];
#pragma unroll
        for (int q = 0; q < 32; ++q) { const int s_ = 8 * q + (lane >> 3); int idx = sl[s_]; idx = (t < 256) ? s_ : idx; idx = (s_ < nsel && (unsigned)idx <= (unsigned)t) ? idx : 0; koff[q] = (unsigned)idx * 256u + chunkoff; }
        i64x2 qf[2];
        { const unsigned char* qp = (const unsigned char*)Q + (size_t)tg * D + (4 * g + (fr >> 2)) * 128 + 16 * fq;
#pragma unroll
          for (int i = 0; i < 2; ++i) qf[i] = *(const i64x2*)(qp + 64 * i); }
        asm volatile("s_waitcnt vmcnt(0) lgkmcnt(0)" ::: "memory");
        asm volatile("" : "+v"(qf[0]), "+v"(qf[1]));
        { const int tn = task + wstride; if (tn < task_end) SEL_PREFETCH(xsplit ? tn : (tn >> 1)); }
        const unsigned char* kbase = (const unsigned char*)K + (size_t)tb * 256 + g * 128;
        const unsigned char* vbase = (const unsigned char*)V + (size_t)tb * 256 + g * 128;
#define CH_GATHER(cidx) do { const unsigned char* bp_ = ((cidx) < 16) ? kbase : vbase; _Pragma("unroll") for (int i_ = 0; i_ < 2; ++i_) { \
            unsigned o_ = koff[2 * ((cidx) & 15) + i_]; asm volatile("" : "+v"(o_));     \
            __builtin_amdgcn_global_load_lds((const unsigned*)(bp_ + o_), (LAS unsigned*)(vb + ((cidx) & 7) * 2048 + i_ * 1024 + lane * 16), 16, 0, 0); } } while (0)
        float lg[16];
#pragma unroll
        for (int c0 = 0; c0 < 6; ++c0) CH_GATHER(c0);
#pragma unroll
        for (int ch = 0; ch < 16; ++ch) {
            asm volatile("s_waitcnt lgkmcnt(0)" ::: "memory");
            CH_GATHER(ch + 6);
            asm volatile("s_waitcnt vmcnt(12)" ::: "memory");
            const LAS unsigned char* kb = vb + (ch & 7) * 2048;
            f32x4 acc = {0.f, 0.f, 0.f, 0.f};
#pragma unroll
            for (int i = 0; i < 2; ++i) { const i64x2 kf = *(const LAS i64x2*)(kb + 128u * fr + 16u * ((4u * i + fq) ^ ((unsigned)fr & 7u)));
                acc = __builtin_amdgcn_mfma_f32_16x16x32_fp8_fp8(qf[i].x, kf.x, acc, 0, 0, 0); acc = __builtin_amdgcn_mfma_f32_16x16x32_fp8_fp8(qf[i].y, kf.y, acc, 0, 0, 0); }
            lg[ch] = (ch * 16 + fr < nsel) ? acc.x * 0.08838834764831845f : -INFINITY;
        }
        float mx = lg[0];
#pragma unroll
        for (int kt = 1; kt < 16; ++kt) mx = fmaxf(mx, lg[kt]);
#pragma unroll
        for (int o = 1; o < 16; o <<= 1) mx = fmaxf(mx, __shfl_xor(mx, o));
        float sm = 0.f;
#pragma unroll
        for (int kt = 0; kt < 16; ++kt) { lg[kt] = __expf(lg[kt] - mx); sm += lg[kt]; }
#pragma unroll
        for (int o = 1; o < 16; o <<= 1) sm += __shfl_xor(sm, o);
        { const float inv = 256.f / sm;
#pragma unroll
          for (int kt = 0; kt < 16; ++kt) { const float pv = lg[kt] * inv; ((LAS unsigned char*)pT)[fq * 256 + kt * 16 + fr] = (unsigned char)(pk_fp8x4_nc(pv, pv, pv, pv) & 0xffu); } }
        f32x4 oacc[8];
#pragma unroll
        for (int c2 = 0; c2 < 8; ++c2) oacc[c2] = (f32x4){0.f, 0.f, 0.f, 0.f};
#pragma unroll
        for (int p = 0; p < 8; ++p) {
            asm volatile("s_waitcnt lgkmcnt(0)" ::: "memory");
            if (16 + 2 * p + 6 < 32) { CH_GATHER(16 + 2 * p + 6); CH_GATHER(16 + 2 * p + 7); }
            if (p < 5) asm volatile("s_waitcnt vmcnt(12)" ::: "memory"); else if (p == 5) asm volatile("s_waitcnt vmcnt(8)" ::: "memory");
            else if (p == 6) asm volatile("s_waitcnt vmcnt(4)" ::: "memory"); else asm volatile("s_waitcnt vmcnt(0)" ::: "memory");
            if (p < nch) {
                const long pa = *(const LAS long*)((const LAS unsigned char*)pT + (fr >> 2) * 256 + 32 * p + 8 * fq);
                const unsigned cb = vb_addr + (unsigned)(((16 + 2 * p) & 7) + (fq >> 1)) * 2048u;
                unsigned ad[8]; s16x4 r0[8];
#pragma unroll
                for (int i = 0; i < 8; ++i) ad[i] = cb + trh[i];
                tr_read8_b8(ad, r0);
#pragma unroll
                for (int c2 = 0; c2 < 8; ++c2) oacc[c2] = __builtin_amdgcn_mfma_f32_16x16x32_fp8_fp8(pa, __builtin_bit_cast(long, r0[c2]), oacc[c2], 0, 0, 0);
            }
        }
        { unsigned char* op = (unsigned char*)O + (size_t)tg * D + (4 * g + fq) * 128 + fr;
#pragma unroll
          for (int c2 = 0; c2 < 8; ++c2) { const float ov = oacc[c2].x * (O8_SCALE / 256.f); op[16 * c2] = (unsigned char)(pk_fp8x4(ov, ov, ov, ov) & 0xffu); } }
        LDS_WAIT();
#undef CH_GATHER
        if ((tcount & 1) && cit < NE * 192) { convert_moe_item(c, 1, cit, vb); cit += ngw; }
        ++tcount;
    }
    for (; cit < NE * 192; cit += ngw) convert_moe_item(c, 1, cit, vb);
}

__device__ __forceinline__ void phase_b4(const Ctx& c) {
    float* H = (float*)(c.ws + WS_H);
    pg8::Gemm g{(const pg8::bf16_t*)(c.ws + WS_O), (const pg8::bf16_t*)(c.ws + WS_WBOUT), T, D, D / 2};
    pg8::StaticOrder S; S.init(T, D, (int)gridDim.x, (int)blockIdx.x);
    EpiResF32 E{H, H, D, 1.f / (W8_SCALE * O8_SCALE)};
    pg8::gemm_phase<EpiResF32, pg8::StaticOrder, false, true, true>(c.ldsp, g, S, E);
}

constexpr int NPHASE = 22;
__global__ void __launch_bounds__(NTHP, 2) mk_fwd(Args args) {
    extern __shared__ __attribute__((aligned(16))) unsigned char lds_raw[];
    Ctx c;
    { const int pt = threadIdx.x; c.half = __builtin_amdgcn_readfirstlane(pt >> 8); c.tid = pt & 255; c.lane = pt & 63; c.wave = __builtin_amdgcn_readfirstlane(pt >> 6) & 3; }
    c.ldsp = (LAS unsigned char*)lds_raw; c.lds = c.ldsp + c.half * LDS_HALF;
    c.nb = 2 * gridDim.x; { const int bx = blockIdx.x, G = gridDim.x; c.vb = 2 * ((G % 8 == 0) ? (bx % 8) * (G / 8) + bx / 8 : bx) + c.half; }
    c.a = (const __attribute__((address_space(4))) Args*)__builtin_amdgcn_kernarg_segment_ptr(); c.ws = args.ws;
    volatile LAS unsigned* st = (volatile LAS unsigned*)((LAS unsigned char*)lds_raw + LDS_BYTES - 16);
    const bool multi = (args.ph_hi - args.ph_lo) > 1;
    XcdBarrier bar; bar.bar = (unsigned*)(c.ws + WS_CTL); bar.x = 0; bar.st = st;
    if (multi) {
        if (threadIdx.x == 0) { st[0] = 0u; st[1] = 0u; }
        __syncthreads();
        bar = xcd_barrier_post((unsigned*)(c.ws + WS_CTL), st);
    }
    const int ph_lo = args.ph_lo, ph_hi = args.ph_hi;
#ifndef PH_MASK
#define PH_MASK 0x3fffff
#endif
#define PHON(k) ((PH_MASK >> (k)) & 1)
#define PHASE(k, body) do { if (PHON(k) && ph_lo <= (k) && (k) < ph_hi) { \
        { int t_ = threadIdx.x, vb_ = __builtin_amdgcn_readfirstlane(c.vb); \
          const __attribute__((address_space(4))) Args* ka = (const __attribute__((address_space(4))) Args*)__builtin_amdgcn_kernarg_segment_ptr(); \
          asm volatile("" : "+v"(t_), "+s"(vb_), "+s"(ka)); \
          c.tid = t_ & 255; c.lane = t_ & 63; c.wave = __builtin_amdgcn_readfirstlane(t_ >> 6) & 3; c.vb = vb_; c.a = ka; c.ws = ka->ws; } \
        body; \
        if (MK_REP == (k)) { __syncthreads(); body; } \
        if ((k) + 1 < ph_hi) xcd_barrier(bar); \
        if ((k) == 3) { for (int xb_ = 0; xb_ < MK_XBAR; ++xb_) xcd_barrier(bar); } } } while (0)
    PHASE(0, phase_prep(c));
    PHASE(1, phase_a1(c));
    PHASE(2, { if (MK_DRY == 2) { phase_a2(c, true); __syncthreads(); } phase_a2(c); });
    PHASE(3, phase_a3(c));
    PHASE(4, { if (MK_DRY == 4) { phase_route(c, 0, true); __syncthreads(); } phase_route(c, 0); });
    PHASE(5, phase_e1(c, 0));
    PHASE(6, phase_e2(c, 0));
    PHASE(7, { if (MK_DRY == 7) { phase_p1(c, 0, true); __syncthreads(); } phase_p1(c, 0); });
    PHASE(8, phase_p2(c, 0));
    PHASE(9, phase_norm_bf16(c, (const float*)c.a->in[IN_MIXN] + D));
    PHASE(10, phase_b1(c));
    PHASE(11, phase_rope(c));
    PHASE(12, phase_score(c));
    PHASE(13, phase_select(c));
    PHASE(14, phase_attn(c));
    PHASE(15, phase_b4(c));
    PHASE(16, phase_route(c, 1));
    PHASE(17, phase_e1(c, 1));
    PHASE(18, phase_e2(c, 1));
    PHASE(19, phase_p1(c, 1));
    PHASE(20, phase_p2(c, 1));
    PHASE(21, phase_final(c));
}

#ifdef MK_DUMP
__global__ void dump_k(const unsigned char* ws, float* out) {
    const size_t i = (size_t)blockIdx.x * 256 + threadIdx.x;
#if MK_DUMP == 1
    ((f32x4*)out)[i] = ((const f32x4*)(ws + WS_H))[i];
#elif MK_DUMP == 2
    { const u32x2 v = ((const u32x2*)(ws + WS_O))[i]; f32x4 o = {bf_lo(v.x), bf_hi(v.x), bf_lo(v.y), bf_hi(v.y)}; ((f32x4*)out)[i] = o; }
#elif MK_DUMP == 3
    { const int* sp = (const int*)(ws + WS_SEL); f32x4 o = {0.f,0.f,0.f,0.f}; if (i < (size_t)T * 64) { o.x = (float)sp[4*i]; o.y = (float)sp[4*i+1]; o.z = (float)sp[4*i+2]; o.w = (float)sp[4*i+3]; } ((f32x4*)out)[i] = o; }
#elif MK_DUMP == 5
    { const u32x2 v = ((const u32x2*)(ws + WS_XN))[i]; f32x4 o = {bf_lo(v.x), bf_hi(v.x), bf_lo(v.y), bf_hi(v.y)}; ((f32x4*)out)[i] = o; }
#elif MK_DUMP == 6
    { const u32x2 v = ((const u32x2*)(ws + WS_RAW))[i]; f32x4 o = {bf_lo(v.x), bf_hi(v.x), bf_lo(v.y), bf_hi(v.y)}; ((f32x4*)out)[i] = o; }
#elif MK_DUMP == 7
    { f32x4 o = {0.f,0.f,0.f,0.f}; if (i < (size_t)BINP * D / 4) { const u32x2 v = ((const u32x2*)(ws + WS_WBIN))[i]; o = (f32x4){bf_lo(v.x), bf_hi(v.x), bf_lo(v.y), bf_hi(v.y)}; } ((f32x4*)out)[i] = o; }
#elif MK_DUMP == 8
    { const u32x2 v = ((const u32x2*)(ws + WS_RAW))[i], w = ((const u32x2*)(ws + 458 * MB))[i]; f32x4 o = {bf_lo(v.x) - bf_lo(w.x), bf_hi(v.x) - bf_hi(w.x), bf_lo(v.y) - bf_lo(w.y), bf_hi(v.y) - bf_hi(w.y)}; ((f32x4*)out)[i] = o; }
#elif MK_DUMP == 9
    { const u32x2 v = ((const u32x2*)(ws + WS_RAW))[i], w = ((const u32x2*)(ws + 458 * MB))[i]; f32x4 o = {(v.x & 0xffffu) != (w.x & 0xffffu) ? 1.f : 0.f, (v.x >> 16) != (w.x >> 16) ? 1.f : 0.f, (v.y & 0xffffu) != (w.y & 0xffffu) ? 1.f : 0.f, (v.y >> 16) != (w.y >> 16) ? 1.f : 0.f}; ((f32x4*)out)[i] = o; }
#elif MK_DUMP == 4
    { const u32x2 v = ((const u32x2*)(ws + WS_Q))[i]; f32x4 o = {bf_lo(v.x), bf_hi(v.x), bf_lo(v.y), bf_hi(v.y)}; ((f32x4*)out)[i] = o; }
#endif
}
#endif
extern "C" void kernel_launch(void* const* d_in, const int* in_sizes, int n_in, void* d_out, int out_size, void* d_ws, size_t ws_size, hipStream_t stream) {
    static int grid = 0;
    if (grid == 0) {
        if (n_in != 23 || out_size != T * D || ws_size < WS_TOTAL) { fprintf(stderr, "kernel_launch: unexpected sizes n_in %d out %d ws %zu (need %zu)\n", n_in, out_size, ws_size, (size_t)WS_TOTAL); grid = -1; return; }
        int dev = 0, cus = 0, per_cu = 0;
        hipGetDevice(&dev); hipDeviceGetAttribute(&cus, hipDeviceAttributeMultiprocessorCount, dev);
        hipFuncSetAttribute((const void*)mk_fwd, hipFuncAttributeMaxDynamicSharedMemorySize, LDS_BYTES);
        hipOccupancyMaxActiveBlocksPerMultiprocessor(&per_cu, (const void*)mk_fwd, NTHP, LDS_BYTES);
        (void)hipGetLastError();
        if (per_cu < 1) per_cu = 1;
        if (per_cu > 1) per_cu = 1;
        grid = cus * per_cu;
    }
    if (grid < 0) return;
    hipMemsetAsync((char*)d_ws + WS_CTL, 0, 16384, stream);
    Args a{};
    for (int i = 0; i < 23; ++i) a.in[i] = d_in[i];
    a.out = (float*)d_out; a.ws = (unsigned char*)d_ws;
#if MK_ONE_LAUNCH
    a.ph_lo = 0; a.ph_hi = NPHASE;
    hipLaunchKernelGGL(mk_fwd, dim3(grid), dim3(NTHP), LDS_BYTES, stream, a);
#else
    for (int ph = 0; ph <= MK_LAST_PHASE; ++ph) { a.ph_lo = ph; a.ph_hi = ph + 1; hipLaunchKernelGGL(mk_fwd, dim3(grid), dim3(NTHP), LDS_BYTES, stream, a); }
#ifdef MK_DUMP
    hipLaunchKernelGGL(dump_k, dim3(T * D / 4 / 256), dim3(256), 0, stream, (const unsigned char*)d_ws, (float*)d_out);
#endif
#endif
}
```

```cpp
#include <hip/hip_runtime.h>
#include <stdint.h>
#include <stdio.h>

#ifndef MK_LAST_PHASE
#define MK_LAST_PHASE 21
#endif
#ifndef MK_REP
#define MK_REP -1
#endif
#ifndef MK_XBAR
#define MK_XBAR 0
#endif
#ifndef MK_DRY
#define MK_DRY -1
#endif
#ifndef MK_ONE_LAUNCH
#define MK_ONE_LAUNCH 1
#endif

#define LAS __attribute__((address_space(3)))
typedef unsigned short bf16_t;
typedef short bf16x8 __attribute__((ext_vector_type(8)));
typedef float f32x4 __attribute__((ext_vector_type(4)));
typedef float f32x2 __attribute__((ext_vector_type(2)));
typedef float f32x16 __attribute__((ext_vector_type(16)));
typedef unsigned u32x4 __attribute__((ext_vector_type(4)));
typedef unsigned u32x2 __attribute__((ext_vector_type(2)));
typedef long i64x2 __attribute__((ext_vector_type(2)));
typedef int i32x4 __attribute__((ext_vector_type(4)));
typedef int i32x8 __attribute__((ext_vector_type(8)));

constexpr int T = 16384, D = 1024, SEQ = 4096;
constexpr int GW = 2048;
constexpr int BIN = 2120, BINP = 2176;
constexpr int NE = 32, DE = 512;
constexpr int PLE = 256;
constexpr float EPS = 1e-6f;
constexpr int NTH = 256;
constexpr int LDS_MAIN = 4 * 19456;
constexpr int LDS_HALF = LDS_MAIN + 1024;
constexpr int LDS_BYTES = 2 * LDS_HALF;
constexpr int NTHP = 512;
constexpr int RPAD = 32768 + NE * 256;

constexpr size_t MB = 1024 * 1024;
constexpr size_t WS_CTL = 0;
constexpr size_t WS_CNT = 16384;
constexpr size_t WS_WR = 32768;
constexpr size_t WS_WAIN = 1 * MB;
constexpr size_t WS_WAOUT = WS_WAIN + 8 * MB;
constexpr size_t WS_WBIN = WS_WAOUT + 4 * MB;
constexpr size_t WS_WBOUT = WS_WBIN + 5 * MB;
constexpr size_t WS_WGATE = WS_WBOUT + 2 * MB;
constexpr size_t WS_WPROJ = WS_WGATE + 4 * MB;
constexpr size_t WS_W1 = WS_WPROJ + 1 * MB;
constexpr size_t WS_XN8 = WS_W1 + 16 * MB;
constexpr size_t WS_W3 = WS_W1 + 32 * MB;
constexpr size_t WS_W2 = WS_W3 + 32 * MB;
constexpr size_t WS_PBF = WS_W2 + 32 * MB;
constexpr size_t WS_XN = WS_PBF + 16 * MB;
constexpr size_t WS_H = WS_XN + 32 * MB;
constexpr size_t WS_LIST = WS_H + 64 * MB;
constexpr size_t WS_GATE = WS_LIST + 2 * MB;
constexpr size_t WS_TOKSLOT = WS_GATE + 2 * MB;
constexpr size_t WS_SCR = WS_TOKSLOT + 1 * MB;
constexpr size_t WS_U = WS_SCR;
constexpr size_t WS_VT = WS_SCR + 64 * MB;
constexpr size_t WS_VSS = WS_SCR + 128 * MB;
constexpr size_t WS_HMID = WS_SCR;
constexpr size_t WS_Y = WS_SCR + 36 * MB;
constexpr size_t WS_RAW = WS_SCR;
constexpr size_t WS_O = WS_SCR;
constexpr size_t WS_Q = WS_SCR + 68 * MB;
constexpr size_t WS_K = WS_Q + 32 * MB;
constexpr size_t WS_V = WS_K + 8 * MB;
constexpr size_t WS_QI = WS_V + 8 * MB;
constexpr size_t WS_KI = WS_QI + 16 * MB;
constexpr size_t WS_WI = WS_KI + 2 * MB;
constexpr size_t WS_SEL = WS_WI + 1 * MB;
constexpr size_t WS_END = WS_SEL + 16 * MB;
static_assert(WS_END <= WS_SCR + 152 * MB, "scratch");
constexpr size_t WS_S = 392 * MB;
constexpr size_t WS_TOTAL = 522 * MB;

typedef __bf16 bf16x2_t __attribute__((ext_vector_type(2)));
__device__ __forceinline__ unsigned pk_bf16(float lo, float hi) { f32x2 v = {lo, hi}; bf16x2_t b = __builtin_convertvector(v, bf16x2_t); return __builtin_bit_cast(unsigned, b); }
__device__ __forceinline__ float bf_lo(unsigned u) { return __uint_as_float(u << 16); }
__device__ __forceinline__ float bf_hi(unsigned u) { return __uint_as_float(u & 0xffff0000u); }
__device__ __forceinline__ float wave_sum(float v) {
#pragma unroll
    for (int o = 1; o < 64; o <<= 1) v += __shfl_xor(v, o);
    return v;
}
__device__ __forceinline__ int lds_inc(LAS int* p) { return __hip_atomic_fetch_add(p, 1, __ATOMIC_RELAXED, __HIP_MEMORY_SCOPE_WORKGROUP); }
#define LDS_WAIT() asm volatile("s_waitcnt lgkmcnt(0)" ::: "memory")
#define VM_WAIT() asm volatile("s_waitcnt vmcnt(0)" ::: "memory")

#define XB_TMO      128
#define XB_XCNT(j)  (256  + 64 * (j))
#define XB_XSUB(j)  (1280 + 64 * (j))
#define XB_XGEN(j)  (2304 + 64 * (j))
#define XB_TOP      3328
#define XB_TOPGEN   3392
#define XCD_BAR_WORDS 3456
#define XB_SPIN_CAP (1u << 20)
__device__ __forceinline__ unsigned xb_ld(unsigned* p)              { return __hip_atomic_load(p, __ATOMIC_RELAXED, __HIP_MEMORY_SCOPE_AGENT); }
__device__ __forceinline__ unsigned xb_add(unsigned* p, unsigned v) { return __hip_atomic_fetch_add(p, v, __ATOMIC_RELAXED, __HIP_MEMORY_SCOPE_AGENT); }
__device__ __forceinline__ unsigned xb_xcc_id() { return (unsigned)__builtin_amdgcn_s_getreg((3 << 11) | 20) & 0xFu; }
#define XB_SPIN(cond, bar) do { unsigned _sp = 0; while (cond) { __builtin_amdgcn_s_sleep(1); \
    if ((++_sp & 255u) == 0u) { if (xb_ld(&(bar)[XB_TMO])) break; if (_sp > XB_SPIN_CAP) { atomicAdd(&(bar)[XB_TMO], 1u); break; } } } } while (0)
struct XcdBarrier { unsigned* bar; unsigned x; volatile LAS unsigned* st; };
__device__ __forceinline__ XcdBarrier xcd_barrier_post(unsigned* bar, volatile LAS unsigned* st) {
    XcdBarrier b; b.bar = bar; b.x = xb_xcc_id(); b.st = st;
    if (threadIdx.x == 0) (void)xb_add(&bar[XB_XCNT(b.x)], 1u);
    return b;
}
__device__ __forceinline__ void xcd_barrier_complete(unsigned* bar, unsigned x, unsigned& nloc, unsigned& nx) {
    const unsigned G = gridDim.x;
    unsigned sum, cnt, mine, sp = 0u;
    for (;;) {
        sum = 0u; cnt = 0u; mine = 0u;
#pragma unroll
        for (unsigned j = 0; j < 16; ++j) { const unsigned c = xb_ld(&bar[XB_XCNT(j)]); sum += c; cnt += (c > 0u) ? 1u : 0u; mine = (j == x) ? c : mine; }
        if (sum == G) break;
        __builtin_amdgcn_s_sleep(1);
        if ((++sp & 255u) == 0u) { if (xb_ld(&bar[XB_TMO])) break; if (sp > XB_SPIN_CAP) { atomicAdd(&bar[XB_TMO], 1u); break; } }
    }
    nloc = mine > 0u ? mine : 1u; nx = cnt > 0u ? cnt : 1u;
}
__device__ __forceinline__ void xcd_barrier(const XcdBarrier& b) {
    asm volatile("s_waitcnt vmcnt(0)" ::: "memory");
    __syncthreads();
    if (threadIdx.x == 0) {
        unsigned* bar = b.bar;
        __builtin_amdgcn_s_waitcnt(0);
        unsigned nloc = b.st[0], nx = b.st[1];
        if (nloc == 0u) { xcd_barrier_complete(bar, b.x, nloc, nx); b.st[0] = nloc; b.st[1] = nx; }
        const unsigned old = xb_add(&bar[XB_XSUB(b.x)], 1u);
        const unsigned gen = old / nloc;
        if (old + 1u == (gen + 1u) * nloc) {
            __builtin_amdgcn_fence(__ATOMIC_RELEASE, "agent");
            asm volatile("s_waitcnt vmcnt(0)" ::: "memory");
            const unsigned og = xb_add(&bar[XB_TOP], 1u);
            const unsigned tg = og / nx;
            if (og + 1u == (tg + 1u) * nx) xb_add(&bar[XB_TOPGEN], 1u);
            else XB_SPIN(xb_ld(&bar[XB_TOPGEN]) == tg, bar);
            __builtin_amdgcn_fence(__ATOMIC_ACQUIRE, "agent");
            xb_add(&bar[XB_XGEN(b.x)], 1u);
            asm volatile("s_waitcnt vmcnt(0)" ::: "memory");
        } else {
            XB_SPIN(xb_ld(&bar[XB_XGEN(b.x)]) == gen, bar);
            __builtin_amdgcn_fence(__ATOMIC_ACQUIRE, "agent");
            asm volatile("s_waitcnt vmcnt(0)" ::: "memory");
        }
    }
    __syncthreads();
}

struct Args { const void* in[23]; float* out; unsigned char* ws; int ph_lo, ph_hi; };
enum { IN_X = 0, IN_P, IN_POS, IN_MIXN, IN_AWIN, IN_AVG, IN_AWS, IN_ABS, IN_AWOUT, IN_BWIN, IN_BWOUT, IN_FFNN, IN_WG, IN_BG, IN_WE, IN_BE,
       IN_W1, IN_W3, IN_W2, IN_PLEN, IN_PLEG, IN_PLEP, IN_FINN };

struct Ctx {
    LAS unsigned char* lds;
    int tid, lane, wave, vb, nb, half;
    LAS unsigned char* ldsp;
    const __attribute__((address_space(4))) Args* a;
    unsigned char* ws;
};

template <int BK> struct TileK { static constexpr int NP = (BK == 64) ? 4 : 2; static constexpr int TB = 128 * BK * 2; };

template <int BK>
__device__ __forceinline__ void stage_tile(LAS unsigned char* tile, const bf16_t* const (&rp)[TileK<BK>::NP], int k0, int tid) {
    const int lc = (BK == 64) ? ((tid & 7) ^ ((tid >> 3) & 7)) : ((tid & 3) ^ ((tid >> 3) & 3));
#pragma unroll
    for (int p = 0; p < TileK<BK>::NP; ++p)
        __builtin_amdgcn_global_load_lds((const unsigned*)(rp[p] + k0 + lc * 8), (LAS unsigned*)(tile + p * 4096 + tid * 16), 16, 0, 0);
}
template <int BK>
__device__ __forceinline__ void rows_regular(const bf16_t* (&rp)[TileK<BK>::NP], const bf16_t* base, size_t ld, int tid) {
#pragma unroll
    for (int p = 0; p < TileK<BK>::NP; ++p) { const int r = (BK == 64) ? (p * 32 + (tid >> 3)) : (p * 64 + (tid >> 2)); rp[p] = base + (size_t)r * ld; }
}
template <int BK>
__device__ __forceinline__ int frag_off(int row, int ks, int fq) {
    return (BK == 64) ? (row * 128 + (((ks * 4 + fq) ^ (row & 7)) << 4)) : (row * 64 + ((fq ^ ((row >> 1) & 3)) << 4));
}

template <int BK, int NBOP, bool SWAP, bool FP8 = false>
__device__ __forceinline__ void gemm_loop(const Ctx& c, const bf16_t* const (&ap)[TileK<BK>::NP], const bf16_t* const (&b0p)[TileK<BK>::NP], const bf16_t* const (&b1p)[TileK<BK>::NP],
                                          int K, f32x4 (&acc0)[4][4], f32x4 (&acc1)[4][4]) {
    constexpr int TB = TileK<BK>::TB, SB = (1 + NBOP) * TB;
    static_assert(2 * SB <= LDS_MAIN, "lds");
    const int nk = K / BK, tid = c.tid;
    const int fr = c.lane & 15, fq = c.lane >> 4, wr = c.wave >> 1, wc = c.wave & 1;
    LAS unsigned char* lds = c.lds;
    stage_tile<BK>(lds, ap, 0, tid); stage_tile<BK>(lds + TB, b0p, 0, tid);
    if (NBOP == 2) stage_tile<BK>(lds + 2 * TB, b1p, 0, tid);
    for (int kt = 0; kt < nk; ++kt) {
        VM_WAIT();
        __syncthreads();
        LAS unsigned char* cur = lds + (kt & 1) * SB;
        if (kt + 1 < nk) {
            LAS unsigned char* nxt = lds + ((kt + 1) & 1) * SB;
            stage_tile<BK>(nxt, ap, (kt + 1) * BK, tid); stage_tile<BK>(nxt + TB, b0p, (kt + 1) * BK, tid);
            if (NBOP == 2) stage_tile<BK>(nxt + 2 * TB, b1p, (kt + 1) * BK, tid);
        }
#pragma unroll
        for (int ks = 0; ks < BK / 32; ++ks) {
            bf16x8 af[4], bf0[4], bf1[4];
#pragma unroll
            for (int m = 0; m < 4; ++m) af[m] = *(const LAS bf16x8*)(cur + frag_off<BK>(wr * 64 + m * 16 + fr, ks, fq));
#pragma unroll
            for (int n = 0; n < 4; ++n) bf0[n] = *(const LAS bf16x8*)(cur + TB + frag_off<BK>(wc * 64 + n * 16 + fr, ks, fq));
            if (NBOP == 2) {
#pragma unroll
                for (int n = 0; n < 4; ++n) bf1[n] = *(const LAS bf16x8*)(cur + 2 * TB + frag_off<BK>(wc * 64 + n * 16 + fr, ks, fq));
            }
#pragma unroll
            for (int m = 0; m < 4; ++m)
#pragma unroll
                for (int n = 0; n < 4; ++n) {
                    if (FP8) {
                        const i64x2 a2 = __builtin_bit_cast(i64x2, af[m]), b2 = __builtin_bit_cast(i64x2, bf0[n]);
                        if (SWAP) { acc0[m][n] = __builtin_amdgcn_mfma_f32_16x16x32_fp8_fp8(b2.x, a2.x, acc0[m][n], 0, 0, 0); acc0[m][n] = __builtin_amdgcn_mfma_f32_16x16x32_fp8_fp8(b2.y, a2.y, acc0[m][n], 0, 0, 0); }
                        else      { acc0[m][n] = __builtin_amdgcn_mfma_f32_16x16x32_fp8_fp8(a2.x, b2.x, acc0[m][n], 0, 0, 0); acc0[m][n] = __builtin_amdgcn_mfma_f32_16x16x32_fp8_fp8(a2.y, b2.y, acc0[m][n], 0, 0, 0); }
                        continue;
                    }
                    if (SWAP) acc0[m][n] = __builtin_amdgcn_mfma_f32_16x16x32_bf16(bf0[n], af[m], acc0[m][n], 0, 0, 0);
                    else      acc0[m][n] = __builtin_amdgcn_mfma_f32_16x16x32_bf16(af[m], bf0[n], acc0[m][n], 0, 0, 0);
                    if (NBOP == 2) {
                        if (SWAP) acc1[m][n] = __builtin_amdgcn_mfma_f32_16x16x32_bf16(bf1[n], af[m], acc1[m][n], 0, 0, 0);
                        else      acc1[m][n] = __builtin_amdgcn_mfma_f32_16x16x32_bf16(af[m], bf1[n], acc1[m][n], 0, 0, 0);
                    }
                }
        }
    }
    __syncthreads();
}
__device__ __forceinline__ void zero_acc(f32x4 (&acc)[4][4]) {
#pragma unroll
    for (int m = 0; m < 4; ++m)
#pragma unroll
        for (int n = 0; n < 4; ++n) acc[m][n] = (f32x4){0.f, 0.f, 0.f, 0.f};
}
__device__ __forceinline__ void map_unit(int u, int nnt, int& mt, int& nt) { const int per = 8 * nnt, band = u / per, r = u - band * per; nt = r >> 3; mt = band * 8 + (r & 7); }


__device__ __forceinline__ float gelu_tanh(float x) {
    const float y2 = 1.5957691216057308f * (x + 0.044715f * x * x * x);
    return x * __builtin_amdgcn_rcpf(1.f + __expf(-y2));
}
__device__ __forceinline__ float sigmoidf_(float x) { return __builtin_amdgcn_rcpf(1.f + __expf(-x)); }

__device__ __forceinline__ void row_load(const float* row, int lane, f32x4 (&v)[4]) {
#pragma unroll
    for (int j = 0; j < 4; ++j) v[j] = ((const f32x4*)row)[lane + 64 * j];
}
__device__ __forceinline__ float row_sumsq(const f32x4 (&v)[4]) {
    float s = 0.f;
#pragma unroll
    for (int j = 0; j < 4; ++j) s += (v[j].x * v[j].x + v[j].y * v[j].y) + (v[j].z * v[j].z + v[j].w * v[j].w);
    return wave_sum(s);
}
__device__ __forceinline__ void gain_load(const float* gain, int lane, f32x4 (&g)[4]) {
#pragma unroll
    for (int j = 0; j < 4; ++j) g[j] = ((const f32x4*)gain)[lane + 64 * j];
}
__device__ __forceinline__ void row_store_norm_bf16(bf16_t* orow, int lane, const f32x4 (&v)[4], float r, const f32x4 (&gv)[4]) {
#pragma unroll
    for (int j = 0; j < 4; ++j) {
        const f32x4 g = gv[j];
        u32x2 o; o.x = pk_bf16(v[j].x * r * g.x, v[j].y * r * g.y); o.y = pk_bf16(v[j].z * r * g.z, v[j].w * r * g.w);
        ((u32x2*)orow)[lane + 64 * j] = o;
    }
}

__device__ __forceinline__ unsigned pk_fp8x4(float a, float b, float c_, float d);
__device__ __forceinline__ void row_store_norm_fp8(unsigned char* orow, int lane, const f32x4 (&v)[4], float r, const f32x4 (&gv)[4]) {
#pragma unroll
    for (int j = 0; j < 4; ++j) ((unsigned*)orow)[lane + 64 * j] = pk_fp8x4(v[j].x * r * gv[j].x, v[j].y * r * gv[j].y, v[j].z * r * gv[j].z, v[j].w * r * gv[j].w);
}
constexpr int TR_SCR = 64 * 136;
__device__ __forceinline__ void transpose_item(const float* W, int K, int N, int nvalid, int ldw, bf16_t* WT, LAS unsigned char* scr, int item, int lane) {
    const int nblk = N / 64, kb = item / nblk, nb = item - kb * nblk, k0 = 64 * kb, n0 = 64 * nb;
    const int n = n0 + 4 * (lane & 15);
    const int nc_ = (n < nvalid) ? n : 0; const float keep = (n < nvalid) ? 1.f : 0.f;
    f32x4 v[16];
#pragma unroll
    for (int i = 0; i < 16; ++i) v[i] = *(const f32x4*)(W + (size_t)(k0 + 4 * i + (lane >> 4)) * ldw + nc_);
#pragma unroll
    for (int i = 0; i < 16; ++i) {
        const int kk = 4 * i + (lane >> 4);
        u32x2 o; o.x = pk_bf16(v[i].x * keep, v[i].y * keep); o.y = pk_bf16(v[i].z * keep, v[i].w * keep);
        *(LAS u32x2*)(scr + kk * 136 + (lane & 15) * 8) = o;
    }
    LDS_WAIT();
    const int cc = lane & 7;
#pragma unroll
    for (int j = 0; j < 8; ++j) {
        const int nn = (lane >> 3) + 8 * j; const LAS unsigned short* sp = (const LAS unsigned short*)(scr + (8 * cc) * 136 + nn * 2);
        u32x4 o;
        o.x = (unsigned)sp[0 * 68] | ((unsigned)sp[1 * 68] << 16); o.y = (unsigned)sp[2 * 68] | ((unsigned)sp[3 * 68] << 16);
        o.z = (unsigned)sp[4 * 68] | ((unsigned)sp[5 * 68] << 16); o.w = (unsigned)sp[6 * 68] | ((unsigned)sp[7 * 68] << 16);
        *(u32x4*)(WT + (size_t)(n0 + nn) * K + k0 + 8 * cc) = o;
    }
    LDS_WAIT();
}

__device__ __forceinline__ unsigned pk_fp8x4(float a, float b, float c_, float d) {
    a = fminf(fmaxf(a, -448.f), 448.f); b = fminf(fmaxf(b, -448.f), 448.f); c_ = fminf(fmaxf(c_, -448.f), 448.f); d = fminf(fmaxf(d, -448.f), 448.f);
    int p = __builtin_amdgcn_cvt_pk_fp8_f32(a, b, 0, false);
    p = __builtin_amdgcn_cvt_pk_fp8_f32(c_, d, p, true);
    return (unsigned)p;
}
__device__ __forceinline__ unsigned pk_fp8x4_nc(float a, float b, float c_, float d) {
    int p = __builtin_amdgcn_cvt_pk_fp8_f32(a, b, 0, false);
    p = __builtin_amdgcn_cvt_pk_fp8_f32(c_, d, p, true);
    return (unsigned)p;
}
constexpr float W8_SCALE = 64.f, H8_SCALE = 4.f, O8_SCALE = 8.f;
__device__ __forceinline__ void transpose_item8(const float* W, int K, int N, unsigned char* WT, LAS unsigned char* scr, int item, int lane, int nvalid = 1 << 30, int ldw = 0) {
    const int nblk = N / 64, kb = item / nblk, nb = item - kb * nblk, k0 = 128 * kb, n0 = 64 * nb;
    const int n = n0 + 4 * (lane & 15), ld = ldw ? ldw : N, nc_ = (n < nvalid) ? n : 0; const float keep = (n < nvalid) ? W8_SCALE : 0.f;
#pragma unroll 2
    for (int h = 0; h < 2; ++h) {
        f32x4 v[16];
#pragma unroll
        for (int i = 0; i < 16; ++i) v[i] = *(const f32x4*)(W + (size_t)(k0 + 64 * h + 4 * i + (lane >> 4)) * ld + nc_);
#pragma unroll
        for (int i = 0; i < 16; ++i) { const int kk = 64 * h + 4 * i + (lane >> 4);
            *(LAS unsigned*)(scr + kk * 68 + (lane & 15) * 4) = pk_fp8x4_nc(v[i].x * keep, v[i].y * keep, v[i].z * keep, v[i].w * keep); }
    }
    LDS_WAIT();
    const int cc = lane & 7;
#pragma unroll
    for (int j = 0; j < 8; ++j) {
        const int nn = (lane >> 3) + 8 * j; const LAS unsigned char* sp = scr + (16 * cc) * 68 + nn;
        unsigned w[4];
#pragma unroll
        for (int q = 0; q < 4; ++q) w[q] = (unsigned)sp[(4 * q + 0) * 68] | ((unsigned)sp[(4 * q + 1) * 68] << 8) | ((unsigned)sp[(4 * q + 2) * 68] << 16) | ((unsigned)sp[(4 * q + 3) * 68] << 24);
        u32x4 o = {w[0], w[1], w[2], w[3]};
        *(u32x4*)(WT + (size_t)(n0 + nn) * K + k0 + 16 * cc) = o;
    }
    LDS_WAIT();
}
__device__ __forceinline__ void convert_moe_item(const Ctx& c, int l, int it, LAS unsigned char* scr) {
    const float* w1 = (const float*)c.a->in[IN_W1] + (size_t)l * NE * D * DE;
    const float* w3 = (const float*)c.a->in[IN_W3] + (size_t)l * NE * D * DE;
    const float* w2 = (const float*)c.a->in[IN_W2] + (size_t)l * NE * DE * D;
    unsigned char* W3 = c.ws + WS_W3; unsigned char* W2 = c.ws + WS_W2;
    const int e = it / 192, r = it - e * 192;
    if (r < 64)       transpose_item8(w1 + (size_t)e * D * DE, D, DE, W3 + ((size_t)e * 1024 + ((r & 7) >> 1) * 128) * D, scr, r, c.lane);
    else if (r < 128) transpose_item8(w3 + (size_t)e * D * DE, D, DE, W3 + ((size_t)e * 1024 + ((r & 7) >> 1) * 128 + 128) * D, scr, r - 64, c.lane);
    else              transpose_item8(w2 + (size_t)e * DE * D, DE, D, W2 + (size_t)e * D * DE, scr, r - 128, c.lane);
}
__device__ __forceinline__ void convert_moe_layer(const Ctx& c, int l) {
    LAS unsigned char* scr = c.lds + c.wave * TR_SCR;
    const int gw = c.vb * 4 + c.wave, ngw = c.nb * 4;
    for (int it = gw; it < NE * 192; it += ngw) convert_moe_item(c, l, it, scr);
}

__device__ __forceinline__ void phase_prep(const Ctx& c) {
    const __attribute__((address_space(4))) Args& a = *c.a;
    LAS unsigned char* scr = c.lds + c.wave * TR_SCR;
    const int gw = c.vb * 4 + c.wave, ngw = c.nb * 4;
    constexpr int I_AIN = 16 * 64, I_AOUT = 32 * 16, I_PP = 4 * 16, I_BIN8 = 8 * 34, I_BOUT8 = 8 * 16, I_PG8 = 8 * 16, I_BINI = 16 * 10;
    constexpr int NIT = I_AIN + I_AOUT + 2 * I_PP + I_BIN8 + I_BOUT8 + 2 * I_PG8 + I_BINI;
    for (int it = gw; it < NIT; it += ngw) {
        int r = it;
        if (r < I_AIN) { transpose_item((const float*)a.in[IN_AWIN], D, 4096, 4096, 4096, (bf16_t*)(c.ws + WS_WAIN), scr, r, c.lane); continue; } r -= I_AIN;
        if (r < I_AOUT) { transpose_item((const float*)a.in[IN_AWOUT], GW, D, D, D, (bf16_t*)(c.ws + WS_WAOUT), scr, r, c.lane); continue; } r -= I_AOUT;
        if (r < 2 * I_PP) { const int l = r / I_PP; transpose_item((const float*)a.in[IN_PLEP] + (size_t)l * PLE * D, PLE, D, D, D, (bf16_t*)(c.ws + WS_WPROJ) + (size_t)l * D * PLE, scr, r - l * I_PP, c.lane); continue; } r -= 2 * I_PP;
        if (r < I_BIN8) { transpose_item8((const float*)a.in[IN_BWIN], D, BINP, c.ws + WS_WBIN, scr, r, c.lane, BIN, BIN); continue; } r -= I_BIN8;
        if (r < I_BOUT8) { transpose_item8((const float*)a.in[IN_BWOUT], D, D, c.ws + WS_WBOUT, scr, r, c.lane); continue; } r -= I_BOUT8;
        if (r < 2 * I_PG8) { const int l = r / I_PG8; transpose_item8((const float*)a.in[IN_PLEG] + (size_t)l * D * D, D, D, c.ws + WS_WGATE + (size_t)l * D * D, scr, r - l * I_PG8, c.lane); continue; } r -= 2 * I_PG8;
        transpose_item((const float*)a.in[IN_BWIN] + 1536, D, 640, BIN - 1536, BIN, (bf16_t*)(c.ws + WS_WBIN + 3 * MB), scr, r, c.lane);
    }
    convert_moe_layer(c, 0);
    const int gt = c.vb * NTH + c.tid, ngt = c.nb * NTH;
    { const float* p = (const float*)a.in[IN_P]; bf16_t* pb = (bf16_t*)(c.ws + WS_PBF);
      for (int i = gt; i < 2 * T * PLE / 8; i += ngt) {
          const f32x4 v0 = ((const f32x4*)p)[2 * i], v1 = ((const f32x4*)p)[2 * i + 1];
          u32x4 o; o.x = pk_bf16(v0.x, v0.y); o.y = pk_bf16(v0.z, v0.w); o.z = pk_bf16(v1.x, v1.y); o.w = pk_bf16(v1.z, v1.w);
          ((u32x4*)pb)[i] = o; } }
    { float* wr = (float*)(c.ws + WS_WR);
      for (int i = gt; i < 2 * D * 48; i += ngt) {
          const int l = i / (D * 48), r = i - l * D * 48, k = r / 48, o = r - k * 48;
          float w = 0.f;
          if (o < 4) w = ((const float*)a.in[IN_WG])[(size_t)l * D * 4 + k * 4 + o];
          else if (o < 36) w = ((const float*)a.in[IN_WE])[(size_t)l * D * 32 + k * 32 + (o - 4)];
          wr[i] = w * ((const float*)a.in[IN_FFNN])[l * D + k]; } }
    if (c.vb == 0 && c.tid < 128) ((int*)(c.ws + WS_CNT))[c.tid] = 0;
    f32x4 gv[4]; gain_load((const float*)a.in[IN_MIXN], c.lane, gv);
    for (int t = gw; t < T; t += ngw) {
        f32x4 v[4]; row_load((const float*)a.in[IN_X] + (size_t)t * D, c.lane, v);
        const float r = rsqrtf(row_sumsq(v) * (1.f / D) + EPS);
        row_store_norm_bf16((bf16_t*)(c.ws + WS_XN) + (size_t)t * D, c.lane, v, r, gv);
    }
}

namespace pg8 {
#define PG8_LAS __attribute__((address_space(3)))
typedef unsigned short bf16_t;
typedef short bf16x8 __attribute__((ext_vector_type(8)));
typedef float f32x4 __attribute__((ext_vector_type(4)));
typedef unsigned u32x4 __attribute__((ext_vector_type(4)));
constexpr int BM = 256, BK = 64, HALF = 128, HTB = HALF * BK * 2  , STAGE_BYTES = 8 * HTB, NXCD = 8, WGM = 8;

__host__ __device__ __forceinline__ int lds_byte(int r, int c) { const int st = (r >> 4) * 2 + (c >> 5), rr = r & 15, cc = c & 31, ob = rr * 64 + cc * 2; return st * 1024 + (ob ^ (((ob >> 9) & 1) << 5)); }
__host__ __device__ __forceinline__ void stage_rc(int b, int& R, int& C) { const int st = b / 1024, sb = b % 1024, swz = sb ^ (((sb >> 9) & 1) << 5); R = (st >> 1) * 16 + swz / 64; C = (st & 1) * 32 + (swz % 64) / 2; }
__host__ __device__ __forceinline__ int perm32(int rho) { const int n = rho >> 4, i = rho & 15; return 8 * (i >> 2) + 4 * n + (i & 3); }

struct Unit { int pm, pn, aux; };
struct Gemm { const bf16_t* A; const bf16_t* Bt; int M, N, K; };

struct StaticOrder {
    int nM, nN, nwg, G, c;
    __host__ __device__ void init(int M, int N, int G_, int c_) { nM = M / BM; nN = N / BM; nwg = nM * nN; G = G_; c = c_; }
    __host__ __device__ bool next(int i, Unit& u) const {
        const long L = (long)i * G + c; if (L >= nwg) return false;
        int wgid = (int)L; { const int q = nwg / NXCD, r = nwg % NXCD, xcd = wgid % NXCD, off = wgid / NXCD; wgid = (xcd < r ? xcd * (q + 1) : r * (q + 1) + (xcd - r) * q) + off; }
        const int nig = WGM * nN, gid = wgid / nig, fm = gid * WGM, gsz = (nM - fm) < WGM ? (nM - fm) : WGM;
        u.pm = fm + ((wgid % nig) % gsz); u.pn = (wgid % nig) / gsz; return true;
    }
    __device__ __forceinline__ void a_ready(const Unit&) const {}
    __device__ __forceinline__ void done(const Unit&) const {}
};


template <class Epi, class Sched, bool ALIGN_EPI = false, bool SP2 = false, bool FP8 = false, bool GATHER = false>
__device__ __forceinline__ void gemm_phase(PG8_LAS unsigned char* lds, const Gemm g, const Sched& S, const Epi& E, const PG8_LAS unsigned* gtab = nullptr) {
    int tido_ = threadIdx.x; asm volatile("" : "+v"(tido_));
    const int tid = tido_, wid = __builtin_amdgcn_readfirstlane(tid >> 6), lane = tid & 63, wr = wid >> 2, wc = wid & 3, fr = lane & 15, fq = lane >> 4;
    int Kop_ = g.K; asm volatile("" : "+s"(Kop_));
    const int K = Kop_, nt = K / BK;
    unsigned voffA[2], voffB[2];
#pragma unroll
    for (int i = 0; i < 2; ++i) { int R, C; stage_rc(tid * 16 + i * 8192, R, C); const int Rb = Epi::PERM ? ((R & ~31) + perm32(R & 31)) : R;
        voffA[i] = GATHER ? (unsigned)(R * 4 + C * 2 * 65536) : (unsigned)(R * K + C) * 2u; voffB[i] = (unsigned)(Rb * K + C) * 2u; }
    unsigned gA[2][2] = {{0u, 0u}, {0u, 0u}};
#define PG8_GLOAD(slot) do { _Pragma("unroll") for (int h_ = 0; h_ < 2; ++h_) _Pragma("unroll") for (int i_ = 0; i_ < 2; ++i_) \
        gA[h_][i_] = *(const PG8_LAS unsigned*)((const PG8_LAS unsigned char*)gtab + (slot) * 1024 + h_ * 512 + (voffA[i_] & 0xffffu)) + (voffA[i_] >> 16); } while (0)
#define PG8_STA(bufoff, base, h) do { if constexpr (GATHER) PG8_STAGE(bufoff, base, gA[h]); else PG8_STAGE(bufoff, (base) + (h) * hstep, voffA); } while (0)
    const size_t kstep = (size_t)(BK * 2);
    const size_t hstep = (size_t)HALF * K * 2;
    const size_t tstep = 2 * hstep;
    const unsigned ldsw = (unsigned)wid * 1024u;
    const int aoff = lds_byte(wr * 64 + fr, fq * 8), boff = lds_byte(wc * 32 + fr, fq * 8);
#define PG8_SA(b, h) (((b) * 2 + (h)) * HTB)
#define PG8_SB(b, h) ((4 + (b) * 2 + (h)) * HTB)
#define PG8_STAGE(bufoff, gbase, voff) do { _Pragma("unroll") for (int _i = 0; _i < 2; ++_i) \
        __builtin_amdgcn_global_load_lds((const unsigned*)((const char*)(gbase) + (voff)[_i]), (PG8_LAS unsigned*)(lds + (bufoff) + ldsw + _i * 8192), 16, 0, 0); } while (0)
#define PG8_LDA(dst, b, h) do { _Pragma("unroll") for (int m = 0; m < 4; ++m) dst[m] = __builtin_shufflevector(*(const PG8_LAS i32x4*)(lds + PG8_SA(b, h) + aoff + m * 2048), *(const PG8_LAS i32x4*)(lds + PG8_SA(b, h) + aoff + m * 2048 + 1024), 0, 1, 2, 3, 4, 5, 6, 7); } while (0)
#define PG8_LDB(dst, b, h) do { _Pragma("unroll") for (int n = 0; n < 2; ++n) dst[n] = __builtin_shufflevector(*(const PG8_LAS i32x4*)(lds + PG8_SB(b, h) + boff + n * 2048), *(const PG8_LAS i32x4*)(lds + PG8_SB(b, h) + boff + n * 2048 + 1024), 0, 1, 2, 3, 4, 5, 6, 7); } while (0)
#define PG8_MMA(ai, bj, At, Bt) do { __builtin_amdgcn_s_setprio(1); _Pragma("unroll") for (int m = 0; m < 4; ++m) _Pragma("unroll") for (int n = 0; n < 2; ++n) { \
        if constexpr (FP8)      \
            asm volatile("v_mfma_scale_f32_16x16x128_f8f6f4 %0, %1, %2, %0, %3, %3 op_sel_hi:[0,0,0]" : "+v"(acc[ai][bj][m][n]) : "v"(Bt[n]), "v"(At[m]), "v"(one8_)); \
        else { acc[ai][bj][m][n] = __builtin_amdgcn_mfma_f32_16x16x32_bf16(__builtin_bit_cast(bf16x8, __builtin_shufflevector(Bt[n], Bt[n], 0, 1, 2, 3)), __builtin_bit_cast(bf16x8, __builtin_shufflevector(At[m], At[m], 0, 1, 2, 3)), acc[ai][bj][m][n], 0, 0, 0); \
               acc[ai][bj][m][n] = __builtin_amdgcn_mfma_f32_16x16x32_bf16(__builtin_bit_cast(bf16x8, __builtin_shufflevector(Bt[n], Bt[n], 4, 5, 6, 7)), __builtin_bit_cast(bf16x8, __builtin_shufflevector(At[m], At[m], 4, 5, 6, 7)), acc[ai][bj][m][n], 0, 0, 0); } } __builtin_amdgcn_s_setprio(0); } while (0)
#define PG8_WAIT_V(n) asm volatile("s_waitcnt vmcnt(" #n ")" ::: "memory")
#define PG8_WAIT_L(n) asm volatile("s_waitcnt lgkmcnt(" #n ")" ::: "memory")
#define PG8_BAR __builtin_amdgcn_s_barrier()
#define PG8_SCHED __builtin_amdgcn_sched_barrier(0)
    Unit cur, nxt; int ui = 0;
    if (!S.next(0, cur)) return;
    int one8_ = 0x7f7f7f7f; asm volatile("" : "+v"(one8_));
    f32x4 acc[2][2][4][2];
    float zf_ = 0.f; asm volatile("" : "+v"(zf_));
#pragma unroll
    for (int a = 0; a < 2; ++a)
#pragma unroll
        for (int b = 0; b < 2; ++b)
#pragma unroll
            for (int m = 0; m < 4; ++m)
#pragma unroll
                for (int n = 0; n < 2; ++n) acc[a][b][m][n] = (f32x4){zf_, zf_, zf_, zf_};
    i32x8 At[4], B0[2], B1[2];
    const char* cA = (const char*)g.A + (GATHER ? (size_t)0 : (size_t)cur.pm * tstep); const char* cB = (const char*)g.Bt + (size_t)cur.pn * tstep;
    S.a_ready(cur);
    if constexpr (GATHER) PG8_GLOAD(cur.pm);
    if constexpr (SP2) {
        PG8_STAGE(PG8_SB(0, 0), cB, voffB); PG8_STAGE(PG8_SB(0, 1), cB + hstep, voffB); PG8_STA(PG8_SA(0, 0), cA, 0); PG8_STA(PG8_SA(0, 1), cA, 1);
        if (wr == 1) PG8_BAR;
        PG8_WAIT_V(2); PG8_BAR;
        PG8_STAGE(PG8_SB(1, 0), cB + kstep, voffB); PG8_STA(PG8_SA(1, 0), cA + kstep, 0); PG8_STAGE(PG8_SB(1, 1), cB + hstep + kstep, voffB);
        PG8_WAIT_V(6); PG8_BAR;
    } else {
        PG8_STAGE(PG8_SB(0, 0), cB, voffB); PG8_STA(PG8_SA(0, 0), cA, 0); PG8_STAGE(PG8_SB(0, 1), cB + hstep, voffB); PG8_STA(PG8_SA(0, 1), cA, 1);
        if (wr == 1) PG8_BAR;
        PG8_WAIT_V(4); PG8_BAR;
        PG8_STAGE(PG8_SB(1, 0), cB + kstep, voffB); PG8_STA(PG8_SA(1, 0), cA + kstep, 0); PG8_STAGE(PG8_SB(1, 1), cB + hstep + kstep, voffB);
        PG8_WAIT_V(6); PG8_BAR;
    }
    for (;;) {
        const bool has_next = S.next(ui + 1, nxt);
        const char* nA = (has_next && !GATHER) ? (const char*)g.A + (size_t)nxt.pm * tstep : cA; const char* nB = has_next ? (const char*)g.Bt + (size_t)nxt.pn * tstep : cB;
        for (int t = 0; t < nt; t += 2) {
            const bool last = (t == nt - 2);
            const char* a1 = cA + (size_t)(t + 1) * kstep;
            const char* a2 = last ? nA : cA + (size_t)(t + 2) * kstep; const char* b2 = last ? nB : cB + (size_t)(t + 2) * kstep;
            const char* a3 = a2 + kstep; const char* b3 = b2 + kstep;
            if (last && has_next) S.a_ready(nxt);
            if constexpr (SP2) {
            PG8_LDB(B0, 0, 0); PG8_LDB(B1, 0, 1); PG8_SCHED; PG8_LDA(At, 0, 0); PG8_STA(PG8_SA(1, 1), a1, 1);
            if constexpr (GATHER) { if (last && has_next) PG8_GLOAD(nxt.pm); }
            PG8_WAIT_V(8); PG8_WAIT_L(0); PG8_BAR; PG8_MMA(0, 0, At, B0); PG8_MMA(0, 1, At, B1); PG8_BAR; PG8_SCHED;
            PG8_LDA(At, 0, 1); PG8_STAGE(PG8_SB(0, 0), b2, voffB); PG8_STAGE(PG8_SB(0, 1), b2 + hstep, voffB); PG8_STA(PG8_SA(0, 0), a2, 0);
            PG8_WAIT_V(8); PG8_WAIT_L(0); PG8_BAR; PG8_MMA(1, 0, At, B0); PG8_MMA(1, 1, At, B1); PG8_BAR; PG8_SCHED;
            PG8_LDB(B0, 1, 0); PG8_LDB(B1, 1, 1); PG8_SCHED; PG8_LDA(At, 1, 0); PG8_STA(PG8_SA(0, 1), a2, 1);
            PG8_WAIT_V(8); PG8_WAIT_L(0); PG8_BAR; PG8_MMA(0, 0, At, B0); PG8_MMA(0, 1, At, B1); PG8_BAR; PG8_SCHED;
            PG8_LDA(At, 1, 1); PG8_STAGE(PG8_SB(1, 0), b3, voffB); PG8_STAGE(PG8_SB(1, 1), b3 + hstep, voffB); PG8_STA(PG8_SA(1, 0), a3, 0);
            PG8_WAIT_V(8); PG8_WAIT_L(0); PG8_BAR; PG8_MMA(1, 0, At, B0); PG8_MMA(1, 1, At, B1); PG8_BAR; PG8_SCHED;
            } else {
            static_assert(SP2 || !GATHER, "GATHER is wired into the SP2 loop only");
            PG8_LDB(B0, 0, 0); PG8_SCHED; PG8_LDA(At, 0, 0); PG8_STAGE(PG8_SA(1, 1), a1 + hstep, voffA);
            PG8_WAIT_L(8); PG8_BAR; PG8_WAIT_L(0); PG8_MMA(0, 0, At, B0); PG8_BAR; PG8_SCHED;
            PG8_LDB(B1, 0, 1); PG8_STAGE(PG8_SB(0, 0), b2, voffB);
            PG8_BAR; PG8_WAIT_L(0); PG8_MMA(0, 1, At, B1); PG8_BAR;
            PG8_LDA(At, 0, 1); PG8_STAGE(PG8_SA(0, 0), a2, voffA);
            PG8_BAR; PG8_WAIT_L(0); PG8_MMA(1, 0, At, B0); PG8_BAR; PG8_SCHED;
            PG8_STAGE(PG8_SB(0, 1), b2 + hstep, voffB);
            PG8_WAIT_V(6); PG8_BAR; PG8_MMA(1, 1, At, B1); PG8_BAR;
            PG8_LDB(B0, 1, 0); PG8_SCHED; PG8_LDA(At, 1, 0); PG8_STAGE(PG8_SA(0, 1), a2 + hstep, voffA);
            PG8_WAIT_L(8); PG8_BAR; PG8_WAIT_L(0); PG8_MMA(0, 0, At, B0); PG8_BAR; PG8_SCHED;
            PG8_LDB(B1, 1, 1); PG8_STAGE(PG8_SB(1, 0), b3, voffB);
            PG8_BAR; PG8_WAIT_L(0); PG8_MMA(0, 1, At, B1); PG8_BAR;
            PG8_LDA(At, 1, 1); PG8_STAGE(PG8_SA(1, 0), a3, voffA);
            PG8_BAR; PG8_WAIT_L(0); PG8_MMA(1, 0, At, B0); PG8_BAR; PG8_SCHED;
            PG8_STAGE(PG8_SB(1, 1), b3 + hstep, voffB);
            PG8_WAIT_V(6); PG8_BAR; PG8_MMA(1, 1, At, B1); PG8_BAR;
            }
        }
        if constexpr (ALIGN_EPI) { if (wr == 0) PG8_BAR; }
        if constexpr (FP8) asm volatile("s_nop 15\n\ts_nop 15" ::: "memory");
        if constexpr (!Epi::AFTER_DRAIN) { int le_ = lane; asm volatile("" : "+v"(le_));
            E(acc, cur, wr, wc, le_ & 15, le_ >> 4); S.done(cur); }
        if (!has_next) break;
        asm volatile("v_mov_b32 %0, 0" : "=v"(zf_));
#pragma unroll
        for (int a = 0; a < 2; ++a)
#pragma unroll
            for (int b = 0; b < 2; ++b)
#pragma unroll
                for (int m = 0; m < 4; ++m)
#pragma unroll
                    for (int n = 0; n < 2; ++n) acc[a][b][m][n] = (f32x4){zf_, zf_, zf_, zf_};
        cur = nxt; cA = nA; cB = nB; ++ui;
        if constexpr (ALIGN_EPI) { if (wr == 1) PG8_BAR; }
    }
    PG8_WAIT_V(0);
    if constexpr (!ALIGN_EPI) { if (wr == 0) PG8_BAR; }
    PG8_BAR;
    if constexpr (Epi::AFTER_DRAIN) { E.fused(acc, cur, wr, wc, fr, fq, lds, wid, lane); S.done(cur); }
#undef PG8_SA
#undef PG8_STA
#undef PG8_GLOAD
#undef PG8_SB
#undef PG8_STAGE
#undef PG8_LDA
#undef PG8_LDB
#undef PG8_MMA
#undef PG8_WAIT_V
#undef PG8_WAIT_L
#undef PG8_BAR
#undef PG8_SCHED
}

}

struct EpiA1U {
    static constexpr bool PERM = true, AFTER_DRAIN = false;
    bf16_t* U;
    __device__ __forceinline__ void operator()(const pg8::f32x4 (&acc)[2][2][4][2], const pg8::Unit& u, int wr, int wc, int fr, int fq) const {
        bf16_t* up = U + (size_t)(u.pm * 256 + wr * 64 + fr) * GW + u.pn * 256 + wc * 32 + 8 * fq;
#pragma unroll
        for (int ai = 0; ai < 2; ++ai)
#pragma unroll
            for (int m = 0; m < 4; ++m)
#pragma unroll
                for (int bj = 0; bj < 2; ++bj) {
                    const f32x4 v0 = acc[ai][bj][m][0], v1 = acc[ai][bj][m][1];
                    u32x4 w; w.x = pk_bf16(gelu_tanh(v0.x), gelu_tanh(v0.y)); w.y = pk_bf16(gelu_tanh(v0.z), gelu_tanh(v0.w)); w.z = pk_bf16(gelu_tanh(v1.x), gelu_tanh(v1.y)); w.w = pk_bf16(gelu_tanh(v1.z), gelu_tanh(v1.w));
                    *(u32x4*)(up + (size_t)(ai * 128 + m * 16) * GW + bj * 128) = w;
                }
    }
};
struct EpiA1V {
    static constexpr bool PERM = true, AFTER_DRAIN = false;
    bf16_t* VT; float* VSS;
    __device__ __forceinline__ void operator()(const pg8::f32x4 (&acc)[2][2][4][2], const pg8::Unit& u, int wr, int wc, int fr, int fq) const {
        const int tok0 = u.pn * 256 + wc * 32 + 8 * fq;
        bf16_t* vp = VT + (size_t)(u.pm * 256 + wr * 64 + fr) * T + tok0;
        f32x4 ss[2][2];
#pragma unroll
        for (int bj = 0; bj < 2; ++bj) { ss[bj][0] = (f32x4){0.f, 0.f, 0.f, 0.f}; ss[bj][1] = (f32x4){0.f, 0.f, 0.f, 0.f}; }
#pragma unroll
        for (int ai = 0; ai < 2; ++ai)
#pragma unroll
            for (int m = 0; m < 4; ++m)
#pragma unroll
                for (int bj = 0; bj < 2; ++bj) {
                    f32x4 v0 = acc[ai][bj][m][0], v1 = acc[ai][bj][m][1];
                    v0.x = gelu_tanh(v0.x); v0.y = gelu_tanh(v0.y); v0.z = gelu_tanh(v0.z); v0.w = gelu_tanh(v0.w);
                    v1.x = gelu_tanh(v1.x); v1.y = gelu_tanh(v1.y); v1.z = gelu_tanh(v1.z); v1.w = gelu_tanh(v1.w);
                    ss[bj][0] += v0 * v0; ss[bj][1] += v1 * v1;
                    u32x4 w; w.x = pk_bf16(v0.x, v0.y); w.y = pk_bf16(v0.z, v0.w); w.z = pk_bf16(v1.x, v1.y); w.w = pk_bf16(v1.z, v1.w);
                    *(u32x4*)(vp + (size_t)(ai * 128 + m * 16) * T + bj * 128) = w;
                }
#pragma unroll
        for (int bj = 0; bj < 2; ++bj)
#pragma unroll
            for (int n = 0; n < 2; ++n) {
                f32x4 q = ss[bj][n];
#pragma unroll
                for (int o = 1; o < 16; o <<= 1) { q.x += __shfl_xor(q.x, o); q.y += __shfl_xor(q.y, o); q.z += __shfl_xor(q.z, o); q.w += __shfl_xor(q.w, o); }
                if (fr == 0) *(f32x4*)(VSS + (size_t)(u.pm * 2 + wr) * T + tok0 + bj * 128 + 4 * n) = q;
            }
    }
};
__device__ __forceinline__ void phase_a1(const Ctx& c) {
    const pg8::bf16_t* XN = (const pg8::bf16_t*)(c.ws + WS_XN); const pg8::bf16_t* W = (const pg8::bf16_t*)(c.ws + WS_WAIN);
    {
        pg8::Gemm g{XN, W, T, GW, D}; pg8::StaticOrder S; S.init(T, GW, (int)gridDim.x, (int)blockIdx.x);
        EpiA1U E{(bf16_t*)(c.ws + WS_U)};
        pg8::gemm_phase<EpiA1U, pg8::StaticOrder, false, true, false>(c.ldsp, g, S, E);
    }
    __syncthreads();
    {
        pg8::Gemm g{W + (size_t)GW * D, XN, GW, T, D}; pg8::StaticOrder S; S.init(GW, T, (int)gridDim.x, (int)blockIdx.x);
        EpiA1V E{(bf16_t*)(c.ws + WS_VT), (float*)(c.ws + WS_VSS)};
        pg8::gemm_phase<EpiA1V, pg8::StaticOrder, false, true, false>(c.ldsp, g, S, E);
    }
}

__device__ __forceinline__ void phase_a2(const Ctx& c, bool dry = false) {
    const __attribute__((address_space(4))) Args& a = *c.a;
    bf16_t* U = (bf16_t*)(c.ws + WS_U); const bf16_t* VT = (const bf16_t*)(c.ws + WS_VT); const float* VSS = (const float*)(c.ws + WS_VSS);
    const float* ws_ = (const float*)a.in[IN_AWS]; const float* bs_ = (const float*)a.in[IN_ABS]; const float* vg = (const float*)a.in[IN_AVG];
    const int fr = c.lane & 15, fq = c.lane >> 4, wr = c.wave >> 1, wc = c.wave & 1, tid = c.tid;
    LAS unsigned char* lds = c.lds;
    LAS float* rl = (LAS float*)(lds + LDS_MAIN);
    for (int u = c.vb; u < 128 * 8; u += c.nb) {
        const int ci = u >> 3, g = u & 7, tokbase = ci * 128;
        __syncthreads();
        if (tid < 128) {
            const float* p = VSS + tokbase + tid; float s = 0.f;
#pragma unroll
            for (int i = 0; i < 16; ++i) s += p[(size_t)i * T];
            rl[tid] = rsqrtf(s * (1.f / GW) + EPS);
        }
        __syncthreads();
        {
            const int t = tid >> 1, half = tid & 1;
            const float* wrow = ws_ + ((size_t)g * 128 + t) * 128 + half * 64;
#pragma unroll
            for (int cc = 0; cc < 8; ++cc) {
                const int s0 = half * 64 + cc * 8;
                u32x4 o;
                {
                    const f32x4 w0 = ((const f32x4*)wrow)[2 * cc], w1 = ((const f32x4*)wrow)[2 * cc + 1];
                    float e[8] = {w0.x, w0.y, w0.z, w0.w, w1.x, w1.y, w1.z, w1.w};
                    const f32x4 r0_ = *(const LAS f32x4*)(rl + s0), r1_ = *(const LAS f32x4*)(rl + s0 + 4);
                    const float rr[8] = {r0_.x, r0_.y, r0_.z, r0_.w, r1_.x, r1_.y, r1_.z, r1_.w};
#pragma unroll
                    for (int i = 0; i < 8; ++i) e[i] = (s0 + i <= t) ? e[i] * rr[i] : 0.f;
                    o.x = pk_bf16(e[0], e[1]); o.y = pk_bf16(e[2], e[3]); o.z = pk_bf16(e[4], e[5]); o.w = pk_bf16(e[6], e[7]);
                }
                *(LAS u32x4*)(lds + half * 16384 + t * 128 + ((cc ^ (t & 7)) << 4)) = o;
            }
        }
        for (int hn = 0; hn < 2; ++hn) {
            const int c0 = g * 256 + hn * 128;
            const bf16_t* bp[4]; rows_regular<64>(bp, VT + (size_t)c0 * T + tokbase, T, tid);
            stage_tile<64>(lds + 32768, bp, 0, tid); stage_tile<64>(lds + 32768 + 16384, bp, 64, tid);
            VM_WAIT();
            __syncthreads();
            f32x4 acc[4][4]; zero_acc(acc);
#pragma unroll 1
            for (int kh = 0; kh < 2; ++kh)
#pragma unroll 1
                for (int ks = 0; ks < 2; ++ks) {
                    bf16x8 af[4], bf[4];
#pragma unroll
                    for (int m = 0; m < 4; ++m) af[m] = *(const LAS bf16x8*)(lds + kh * 16384 + frag_off<64>(wr * 64 + m * 16 + fr, ks, fq));
#pragma unroll
                    for (int n = 0; n < 4; ++n) bf[n] = *(const LAS bf16x8*)(lds + 32768 + kh * 16384 + frag_off<64>(wc * 64 + n * 16 + fr, ks, fq));
#pragma unroll
                    for (int m = 0; m < 4; ++m)
#pragma unroll
                        for (int n = 0; n < 4; ++n) acc[m][n] = __builtin_amdgcn_mfma_f32_16x16x32_bf16(bf[n], af[m], acc[m][n], 0, 0, 0);
                }
            u32x2 uvv[4][4]; float bsvv[4];
#pragma unroll
            for (int m = 0; m < 4; ++m) { const int tl = wr * 64 + m * 16 + fr; bsvv[m] = bs_[g * 128 + tl];
#pragma unroll
                for (int n = 0; n < 4; ++n) uvv[m][n] = *(const u32x2*)(U + (size_t)(tokbase + tl) * GW + c0 + wc * 64 + n * 16 + fq * 4); }
#pragma unroll
            for (int m = 0; m < 4; ++m) {
                const int tl = wr * 64 + m * 16 + fr; const float bsv = bsvv[m];
#pragma unroll
                for (int n = 0; n < 4; ++n) {
                    const int ch = c0 + wc * 64 + n * 16 + fq * 4;
                    const f32x4 gn = *(const f32x4*)(vg + ch);
                    u32x2* up = (u32x2*)(U + (size_t)(tokbase + tl) * GW + ch);
                    const u32x2 uv = uvv[m][n]; const f32x4 v = acc[m][n];
                    u32x2 o;
                    o.x = pk_bf16(bf_lo(uv.x) * (gn.x * v.x + bsv), bf_hi(uv.x) * (gn.y * v.y + bsv));
                    o.y = pk_bf16(bf_lo(uv.y) * (gn.z * v.z + bsv), bf_hi(uv.y) * (gn.w * v.w + bsv));
                    if (dry) *(u32x2*)(c.ws + 440 * MB + ((size_t)(tokbase + tl) * GW + ch) * 2) = o; else *up = o;
                }
            }
            __syncthreads();
        }
    }
}

struct EpiResF32 {
    static constexpr bool PERM = false, AFTER_DRAIN = false;
    const float* base; float* out; int ldc; float ascale;
    __device__ __forceinline__ void operator()(const pg8::f32x4 (&acc)[2][2][4][2], const pg8::Unit& u, int wr, int wc, int fr, int fq) const {
#pragma unroll
        for (int ai = 0; ai < 2; ++ai)
#pragma unroll
            for (int m = 0; m < 4; ++m) {
                const size_t ro = (size_t)(u.pm * 256 + ai * 128 + wr * 64 + m * 16 + fr) * ldc + u.pn * 256 + wc * 32 + 4 * fq;
                f32x4 bv[2][2];
#pragma unroll
                for (int bj = 0; bj < 2; ++bj)
#pragma unroll
                    for (int n = 0; n < 2; ++n) bv[bj][n] = *(const f32x4*)(base + ro + bj * 128 + n * 16);
#pragma unroll
                for (int bj = 0; bj < 2; ++bj)
#pragma unroll
                    for (int n = 0; n < 2; ++n) *(f32x4*)(out + ro + bj * 128 + n * 16) = bv[bj][n] + acc[ai][bj][m][n] * ascale;
            }
    }
};
__device__ __forceinline__ void phase_a3(const Ctx& c) {
    pg8::Gemm g{(const pg8::bf16_t*)(c.ws + WS_U), (const pg8::bf16_t*)(c.ws + WS_WAOUT), T, D, GW};
    pg8::StaticOrder S; S.init(T, D, (int)gridDim.x, (int)blockIdx.x);
    EpiResF32 E{(const float*)c.a->in[IN_X], (float*)(c.ws + WS_H), D, 1.f};
    pg8::gemm_phase<EpiResF32, pg8::StaticOrder, false, true, false>(c.ldsp, g, S, E);
}

__device__ __forceinline__ void phase_route(const Ctx& c, int l, bool dry = false) {
    const __attribute__((address_space(4))) Args& a = *c.a;
    const float* H = (const float*)(c.ws + WS_H); bf16_t* XN = (bf16_t*)(c.ws + (dry ? 440 * MB : WS_XN));
    const float* wr_ = (const float*)(c.ws + WS_WR) + (size_t)l * D * 48;
    const float* gain = (const float*)a.in[IN_FFNN] + l * D;
    int* cnt = (int*)(c.ws + WS_CNT) + l * 32 + (dry ? 64 : 0); int* list = (int*)(c.ws + (dry ? 480 * MB : WS_LIST)); float* gatel = (float*)(c.ws + (dry ? 484 * MB : WS_GATE)); int* tokslot = (int*)(c.ws + (dry ? 488 * MB : WS_TOKSLOT));
    LAS float* rl = (LAS float*)(c.lds);
    LAS float* lgl = (LAS float*)(c.lds + 256);
    const int lane = c.lane, w = c.wave;
    f32x4 gv[4]; gain_load(gain, lane, gv);
    for (int unit = c.vb; unit < T / 32; unit += c.nb) {
        const int tok0 = unit * 32;
        __syncthreads();
        for (int i = 0; i < 8; ++i) {
            const int t = tok0 + w * 8 + i;
            f32x4 v[4]; row_load(H + (size_t)t * D, lane, v);
            const float r = rsqrtf(row_sumsq(v) * (1.f / D) + EPS);
            if (lane == 0) rl[w * 8 + i] = r;
            row_store_norm_fp8(c.ws + (dry ? 440 * MB : WS_XN8) + (size_t)t * D, lane, v, r, gv);
        }
        {
            const int th = w & 1, kh = w >> 1, m = lane & 15, q = lane >> 4;
            const float* arow = H + (size_t)(tok0 + 16 * th + m) * D + 512 * kh + 128 * q;
            const float* brow = wr_ + (size_t)(512 * kh + 128 * q) * 48 + m;
            f32x4 acc[3]; acc[0] = acc[1] = acc[2] = (f32x4){0.f, 0.f, 0.f, 0.f};
            for (int i = 0; i < 32; ++i) {
                const f32x4 av = ((const f32x4*)arow)[i];
                const float ae[4] = {av.x, av.y, av.z, av.w};
#pragma unroll
                for (int e = 0; e < 4; ++e) {
                    const float* bp = brow + (size_t)(4 * i + e) * 48;
#pragma unroll
                    for (int nt = 0; nt < 3; ++nt) acc[nt] = __builtin_amdgcn_mfma_f32_16x16x4f32(ae[e], bp[nt * 16], acc[nt], 0, 0, 0);
                }
            }
#pragma unroll
            for (int nt = 0; nt < 3; ++nt)
#pragma unroll
                for (int j = 0; j < 4; ++j) lgl[(kh * 32 + th * 16 + 4 * q + j) * 48 + nt * 16 + m] = acc[nt][j];
        }
        __syncthreads();
        if (c.tid < 32) {
            const int tt = c.tid, t = tok0 + tt; const float r = rl[tt];
            const float* bg = (const float*)a.in[IN_BG] + l * 4; const float* be = (const float*)a.in[IN_BE] + l * 32;
            float gl[4];
#pragma unroll
            for (int o = 0; o < 4; ++o) gl[o] = (lgl[tt * 48 + o] + lgl[(32 + tt) * 48 + o]) * r + bg[o];
            int gs = 0; float gm = gl[0];
#pragma unroll
            for (int o = 1; o < 4; ++o) if (gl[o] > gm) { gm = gl[o]; gs = o; }
            float gden = 0.f;
#pragma unroll
            for (int o = 0; o < 4; ++o) gden += __expf(gl[o] - gm);
            const float pg = 1.f / gden;
            float l1 = -INFINITY, l2 = -INFINITY; int i1 = 0, i2 = 0;
            for (int i = 0; i < 8; ++i) {
                const int o = 4 + gs * 8 + i;
                const float v = (lgl[tt * 48 + o] + lgl[(32 + tt) * 48 + o]) * r + be[gs * 8 + i];
                if (v > l1) { l2 = l1; i2 = i1; l1 = v; i1 = i; } else if (v > l2) { l2 = v; i2 = i; }
            }
            const float e2 = __expf(l2 - l1), inv = 1.f / (1.f + e2);
            const float g1 = pg * inv, g2 = pg * e2 * inv;
            const int ea = gs * 8 + i1, eb = gs * 8 + i2;
            const int sa = atomicAdd(&cnt[ea], 1), sb = atomicAdd(&cnt[eb], 1);
            list[ea * T + sa] = t; gatel[ea * T + sa] = g1; tokslot[2 * t] = (ea << 16) | sa;
            list[eb * T + sb] = t; gatel[eb * T + sb] = g2; tokslot[2 * t + 1] = (eb << 16) | sb;
        }
    }
}

__device__ __forceinline__ void moe_table(const Ctx& c, int l, LAS int* pst, LAS int* cn) {
    __syncthreads();
    if (c.tid == 0) {
        const int* cnt = (const int*)(c.ws + WS_CNT) + l * 32; int acc = 0;
        for (int e = 0; e < 32; ++e) { const int n = cnt[e]; cn[e] = n; pst[e] = acc; acc += (n + 255) >> 8; }
        pst[32] = acc;
    }
    __syncthreads();
}
__device__ __forceinline__ int moe_find(LAS const int* pst, int mb) { int e = 0; for (int i = 1; i < 32; ++i) e = (pst[i] <= mb) ? i : e; return e; }

constexpr int MOE_LDS = 131072;
constexpr int CAPU = 16;
static_assert(MOE_LDS + 1024 + CAPU * 1024 <= LDS_BYTES - 16, "moe lds");
__device__ __forceinline__ void moe_table_wg(const Ctx& c, int l, LAS int* pst, LAS int* cn) {
    __syncthreads();
    if (threadIdx.x == 0) {
        const int* cnt = (const int*)(c.ws + WS_CNT) + l * 32; int acc = 0;
        for (int e = 0; e < 32; ++e) { const int n = cnt[e]; cn[e] = n; pst[e] = acc; acc += (n + 255) >> 8; }
        pst[32] = acc;
    }
    __syncthreads();
}
struct MoeOrder {
    LAS const int* pst; int nunits, G, c, i0; bool gather;
    __device__ __forceinline__ bool next(int i, pg8::Unit& u) const {
        if (i >= CAPU) return false;
        const long L = (long)(i0 + i) * G + c; if (L >= nunits) return false;
        int wgid = (int)L; { const int q = nunits / 8, r = nunits % 8, xcd = wgid % 8, off = wgid / 8; wgid = (xcd < r ? xcd * (q + 1) : r * (q + 1) + (xcd - r) * q) + off; }
        const int mb = wgid >> 2, e = __builtin_amdgcn_readfirstlane(moe_find(pst, mb));
        u.pm = gather ? i : mb; u.pn = e * 4 + (wgid & 3); u.aux = mb; return true;
    }
    __device__ __forceinline__ void a_ready(const pg8::Unit&) const {}
    __device__ __forceinline__ void done(const pg8::Unit&) const {}
};
struct EpiE1 {
    static constexpr bool PERM = true, AFTER_DRAIN = false;
    unsigned char* HM;
    __device__ __forceinline__ void operator()(const pg8::f32x4 (&acc)[2][2][4][2], const pg8::Unit& u, int wr, int wc, int fr, int fq) const {
        const float ws_ = 1.f / W8_SCALE;
        unsigned char* hp = HM + ((size_t)u.aux * 256 + wr * 64 + fr) * DE + (u.pn & 3) * 128 + wc * 32 + 8 * fq;
#pragma unroll
        for (int ai = 0; ai < 2; ++ai)
#pragma unroll
            for (int m = 0; m < 4; ++m) {
                u32x2 o;
#pragma unroll
                for (int n = 0; n < 2; ++n) {
                    const f32x4 x = acc[ai][0][m][n] * ws_, y = acc[ai][1][m][n] * (ws_ * H8_SCALE);
                    const unsigned w = pk_fp8x4(x.x * sigmoidf_(x.x) * y.x, x.y * sigmoidf_(x.y) * y.y, x.z * sigmoidf_(x.z) * y.z, x.w * sigmoidf_(x.w) * y.w);
                    if (n == 0) o.x = w; else o.y = w;
                }
                *(u32x2*)(hp + (size_t)(ai * 128 + m * 16) * DE) = o;
            }
    }
};
__device__ __forceinline__ void phase_e1(const Ctx& c, int l) {
    LAS int* pst = (LAS int*)(c.ldsp + MOE_LDS); LAS int* cn = pst + 40; LAS unsigned* gtab = (LAS unsigned*)(c.ldsp + MOE_LDS + 1024);
    moe_table_wg(c, l, pst, cn);
    const int* list = (const int*)(c.ws + WS_LIST);
    pg8::Gemm g{(const pg8::bf16_t*)(c.ws + WS_XN8), (const pg8::bf16_t*)(c.ws + WS_W3), RPAD, 1024, D / 2};
    MoeOrder S{pst, __builtin_amdgcn_readfirstlane(pst[32]) * 4, (int)gridDim.x, (int)blockIdx.x, 0, true};
    EpiE1 E{c.ws + WS_HMID};
    for (;; S.i0 += CAPU) {
        pg8::Unit u; if (!S.next(0, u)) break;
        for (int i = 0; i < CAPU; ++i) {
            if (!S.next(i, u)) break;
            const int e = u.pn >> 2, row0 = (u.aux - __builtin_amdgcn_readfirstlane(pst[e])) * 256, count = __builtin_amdgcn_readfirstlane(cn[e]);
            if (threadIdx.x < 256) { int r = row0 + (int)threadIdx.x; r = r < count ? r : row0; gtab[i * 256 + threadIdx.x] = (unsigned)list[e * T + r] * (unsigned)D; }
        }
        __syncthreads();
        pg8::gemm_phase<EpiE1, MoeOrder, false, true, true, true>(c.ldsp, g, S, E, gtab);
        __syncthreads();
    }
}
struct EpiE2 {
    static constexpr bool PERM = true, AFTER_DRAIN = false;
    bf16_t* Y; const float* gatel; LAS const int* pst; LAS const int* cn;
    __device__ __forceinline__ void operator()(const pg8::f32x4 (&acc)[2][2][4][2], const pg8::Unit& u, int wr, int wc, int fr, int fq) const {
        const int mb = u.aux, e = u.pn >> 2, row0 = (mb - __builtin_amdgcn_readfirstlane(pst[e])) * 256, count = __builtin_amdgcn_readfirstlane(cn[e]);
        bf16_t* yp = Y + ((size_t)mb * 256 + wr * 64 + fr) * D + (u.pn & 3) * 256 + wc * 32 + 8 * fq;
        const float* gp = gatel + e * T + row0 + wr * 64 + fr; const int rl0 = row0 + wr * 64 + fr;
#pragma unroll
        for (int ai = 0; ai < 2; ++ai) {
            float gt[4];
#pragma unroll
            for (int m = 0; m < 4; ++m) { const float gv_ = gp[ai * 128 + m * 16]; gt[m] = (rl0 + ai * 128 + m * 16 < count) ? gv_ * (1.f / (W8_SCALE * H8_SCALE)) : 0.f; }
#pragma unroll
            for (int m = 0; m < 4; ++m)
#pragma unroll
                for (int bj = 0; bj < 2; ++bj) {
                    const f32x4 v0 = acc[ai][bj][m][0] * gt[m], v1 = acc[ai][bj][m][1] * gt[m];
                    u32x4 w; w.x = pk_bf16(v0.x, v0.y); w.y = pk_bf16(v0.z, v0.w); w.z = pk_bf16(v1.x, v1.y); w.w = pk_bf16(v1.z, v1.w);
                    *(u32x4*)(yp + (size_t)(ai * 128 + m * 16) * D + bj * 128) = w;
                }
        }
    }
};
__device__ __forceinline__ void phase_e2(const Ctx& c, int l) {
    LAS int* pst = (LAS int*)(c.ldsp + MOE_LDS); LAS int* cn = pst + 40;
    moe_table_wg(c, l, pst, cn);
    int kq = DE / 2; asm volatile("" : "+s"(kq));
    pg8::Gemm g{(const pg8::bf16_t*)(c.ws + WS_HMID), (const pg8::bf16_t*)(c.ws + WS_W2), RPAD, 1024, kq};
    MoeOrder S{pst, __builtin_amdgcn_readfirstlane(pst[32]) * 4, (int)gridDim.x, (int)blockIdx.x, 0, false};
    EpiE2 E{(bf16_t*)(c.ws + WS_Y), (const float*)(c.ws + WS_GATE), pst, cn};
    for (;; S.i0 += CAPU) {
        pg8::Unit u; if (!S.next(0, u)) break;
        pg8::gemm_phase<EpiE2, MoeOrder, false, true, true, false>(c.ldsp, g, S, E);
        __syncthreads();
    }
}
__device__ __forceinline__ void phase_p1(const Ctx& c, int l, bool dry = false) {
    float* H = (float*)(c.ws + WS_H); float* HO = (float*)(c.ws + (dry ? 440 * MB : WS_H)); bf16_t* XN = (bf16_t*)(c.ws + (dry ? 440 * MB : WS_XN)); const bf16_t* Y = (const bf16_t*)(c.ws + WS_Y);
    const int* tokslot = (const int*)(c.ws + WS_TOKSLOT); const float* gain = (const float*)c.a->in[IN_PLEN] + l * D;
    LAS int* pst = (LAS int*)(c.lds + LDS_MAIN); LAS int* cn = pst + 40;
    moe_table(c, l, pst, cn);
    const int gw = c.vb * 4 + c.wave, ngw = c.nb * 4, lane = c.lane;
    f32x4 gv[4]; gain_load(gain, lane, gv);
    int s0n = 0, s1n = 0;
    if (gw < T) { s0n = tokslot[2 * gw]; s1n = tokslot[2 * gw + 1]; }
    for (int t = gw; t < T; t += ngw) {
        const int s0 = s0n, s1 = s1n;
        { const int tn = (t + ngw < T) ? t + ngw : t; s0n = tokslot[2 * tn]; s1n = tokslot[2 * tn + 1]; }
        const bf16_t* y0 = Y + ((size_t)pst[s0 >> 16] * 256 + (s0 & 0xffff)) * D; const bf16_t* y1 = Y + ((size_t)pst[s1 >> 16] * 256 + (s1 & 0xffff)) * D;
        f32x4 v[4]; u32x2 a0[4], a1[4];
        row_load(H + (size_t)t * D, lane, v);
#pragma unroll
        for (int j = 0; j < 4; ++j) { a0[j] = ((const u32x2*)y0)[lane + 64 * j]; a1[j] = ((const u32x2*)y1)[lane + 64 * j]; }
#pragma unroll
        for (int j = 0; j < 4; ++j) {
            v[j].x += bf_lo(a0[j].x) + bf_lo(a1[j].x); v[j].y += bf_hi(a0[j].x) + bf_hi(a1[j].x); v[j].z += bf_lo(a0[j].y) + bf_lo(a1[j].y); v[j].w += bf_hi(a0[j].y) + bf_hi(a1[j].y);
        }
#pragma unroll
        for (int j = 0; j < 4; ++j) ((f32x4*)(HO + (size_t)t * D))[lane + 64 * j] = v[j];
        const float r = rsqrtf(row_sumsq(v) * (1.f / D) + EPS);
        row_store_norm_fp8(c.ws + (dry ? 440 * MB : WS_XN8) + (size_t)t * D, lane, v, r, gv);
    }
}
struct EpiPJ {
    static constexpr bool PERM = true, AFTER_DRAIN = false;
    bf16_t* PJ;
    __device__ __forceinline__ void operator()(const pg8::f32x4 (&acc)[2][2][4][2], const pg8::Unit& u, int wr, int wc, int fr, int fq) const {
        bf16_t* pp = PJ + (size_t)(u.pm * 256 + wr * 64 + fr) * D + u.pn * 256 + wc * 32 + 8 * fq;
#pragma unroll
        for (int ai = 0; ai < 2; ++ai)
#pragma unroll
            for (int m = 0; m < 4; ++m)
#pragma unroll
                for (int bj = 0; bj < 2; ++bj) {
                    const f32x4 v0 = acc[ai][bj][m][0], v1 = acc[ai][bj][m][1];
                    u32x4 w; w.x = pk_bf16(v0.x, v0.y); w.y = pk_bf16(v0.z, v0.w); w.z = pk_bf16(v1.x, v1.y); w.w = pk_bf16(v1.z, v1.w);
                    *(u32x4*)(pp + (size_t)(ai * 128 + m * 16) * D + bj * 128) = w;
                }
    }
};
struct EpiP2 {
    static constexpr bool PERM = true, AFTER_DRAIN = false;
    const bf16_t* PJ; float* H;
    __device__ __forceinline__ void operator()(const pg8::f32x4 (&acc)[2][2][4][2], const pg8::Unit& u, int wr, int wc, int fr, int fq) const {
        const size_t o0 = (size_t)(u.pm * 256 + wr * 64 + fr) * D + u.pn * 256 + wc * 32 + 8 * fq;
#pragma unroll
        for (int ai = 0; ai < 2; ++ai)
#pragma unroll
            for (int m = 0; m < 4; ++m) {
                u32x4 pj[2]; f32x4 h[2][2];
#pragma unroll
                for (int bj = 0; bj < 2; ++bj) { const size_t o = o0 + (size_t)(ai * 128 + m * 16) * D + bj * 128;
                    pj[bj] = *(const u32x4*)(PJ + o); h[bj][0] = *(const f32x4*)(H + o); h[bj][1] = *(const f32x4*)(H + o + 4); }
#pragma unroll
                for (int bj = 0; bj < 2; ++bj) { const size_t o = o0 + (size_t)(ai * 128 + m * 16) * D + bj * 128;
                    const f32x4 g0 = acc[ai][bj][m][0] * (1.f / W8_SCALE), g1 = acc[ai][bj][m][1] * (1.f / W8_SCALE);
                    f32x4 a0 = h[bj][0], a1 = h[bj][1];
                    a0.x += sigmoidf_(g0.x) * bf_lo(pj[bj].x); a0.y += sigmoidf_(g0.y) * bf_hi(pj[bj].x); a0.z += sigmoidf_(g0.z) * bf_lo(pj[bj].y); a0.w += sigmoidf_(g0.w) * bf_hi(pj[bj].y);
                    a1.x += sigmoidf_(g1.x) * bf_lo(pj[bj].z); a1.y += sigmoidf_(g1.y) * bf_hi(pj[bj].z); a1.z += sigmoidf_(g1.z) * bf_lo(pj[bj].w); a1.w += sigmoidf_(g1.w) * bf_hi(pj[bj].w);
                    *(f32x4*)(H + o) = a0; *(f32x4*)(H + o + 4) = a1; }
            }
    }
};
__device__ __forceinline__ void phase_p2(const Ctx& c, int l) {
    bf16_t* PJ = (bf16_t*)(c.ws + WS_Y);
    pg8::StaticOrder S; S.init(T, D, (int)gridDim.x, (int)blockIdx.x);
    {
        pg8::Gemm g{(const pg8::bf16_t*)(c.ws + WS_PBF) + (size_t)l * T * PLE, (const pg8::bf16_t*)(c.ws + WS_WPROJ) + (size_t)l * D * PLE, T, D, PLE};
        EpiPJ E{PJ};
        pg8::gemm_phase<EpiPJ, pg8::StaticOrder, false, true, false>(c.ldsp, g, S, E);
    }
    __syncthreads();
    {
        pg8::Gemm g{(const pg8::bf16_t*)(c.ws + WS_XN8), (const pg8::bf16_t*)(c.ws + WS_WGATE + (size_t)l * D * D), T, D, D / 2};
        EpiP2 E{PJ, (float*)(c.ws + WS_H)};
        pg8::gemm_phase<EpiP2, pg8::StaticOrder, false, true, true>(c.ldsp, g, S, E);
    }
}
__device__ __forceinline__ void phase_norm_bf16(const Ctx& c, const float* gain) {
    const float* H = (const float*)(c.ws + WS_H);
    const int gw = c.vb * 4 + c.wave, ngw = c.nb * 4;
    f32x4 gv[4]; gain_load(gain, c.lane, gv);
    for (int t = gw; t < T; t += ngw) {
        f32x4 v[4]; row_load(H + (size_t)t * D, c.lane, v);
        const float r = rsqrtf(row_sumsq(v) * (1.f / D) + EPS);
        row_store_norm_fp8(c.ws + WS_XN8 + (size_t)t * D, c.lane, v, r, gv);
        row_store_norm_bf16((bf16_t*)(c.ws + WS_XN) + (size_t)t * D, c.lane, v, r, gv);
    }
}
__device__ __forceinline__ void phase_final(const Ctx& c) {
    const float* H = (const float*)(c.ws + WS_H); float* O = c.a->out; const float* gain = (const float*)c.a->in[IN_FINN];
    const int gw = c.vb * 4 + c.wave, ngw = c.nb * 4;
    f32x4 gv[4]; gain_load(gain, c.lane, gv);
    for (int t = gw; t < T; t += ngw) {
        f32x4 v[4]; row_load(H + (size_t)t * D, c.lane, v);
        const float r = rsqrtf(row_sumsq(v) * (1.f / D) + EPS);
#pragma unroll
        for (int j = 0; j < 4; ++j) ((f32x4*)(O + (size_t)t * D))[c.lane + 64 * j] = v[j] * r * gv[j];
    }
}

struct B1Order {
    int G, c, nN, mode;
    __device__ __forceinline__ bool next(int i, pg8::Unit& u) const {
        int L;
        if (G == 256) {
            if (mode == 0) { if (c < 64) { if (i >= 3) return false; L = c * 3 + i; } else { if (i >= 1) return false; L = 192 + (c - 64); } }
            else { if (c < 64 || i >= 1) return false; L = c - 64; }
        } else { L = i * G + c; if (L >= 64 * nN) return false; }
        u.pm = L / nN; u.pn = L - u.pm * nN; u.aux = 0; return true;
    }
    __device__ __forceinline__ void a_ready(const pg8::Unit&) const {}
    __device__ __forceinline__ void done(const pg8::Unit&) const {}
};
struct EpiRaw {
    static constexpr bool PERM = true, AFTER_DRAIN = false;
    bf16_t* RAW; int col_off; float sc;
    __device__ __forceinline__ void operator()(const pg8::f32x4 (&acc)[2][2][4][2], const pg8::Unit& u, int wr, int wc, int fr, int fq) const {
        const int col0 = col_off + u.pn * 256 + wc * 32 + 8 * fq;
        bf16_t* rp = RAW + (size_t)(u.pm * 256 + wr * 64 + fr) * BINP + col0;
#pragma unroll
        for (int bj = 0; bj < 2; ++bj) {
            if (col0 + bj * 128 >= BINP) continue;
#pragma unroll
            for (int ai = 0; ai < 2; ++ai)
#pragma unroll
                for (int m = 0; m < 4; ++m) {
                    const f32x4 v0 = acc[ai][bj][m][0] * sc, v1 = acc[ai][bj][m][1] * sc;
                    u32x4 w; w.x = pk_bf16(v0.x, v0.y); w.y = pk_bf16(v0.z, v0.w); w.z = pk_bf16(v1.x, v1.y); w.w = pk_bf16(v1.z, v1.w);
                    *(u32x4*)(rp + (size_t)(ai * 128 + m * 16) * BINP + bj * 128) = w;
                }
        }
    }
};
__device__ __forceinline__ void phase_b1(const Ctx& c, size_t raw_off = WS_RAW) {
    bf16_t* RAW = (bf16_t*)(c.ws + raw_off);
    {
        pg8::Gemm g{(const pg8::bf16_t*)(c.ws + WS_XN8), (const pg8::bf16_t*)(c.ws + WS_WBIN), T, 1536, D / 2};
        B1Order S{(int)gridDim.x, (int)blockIdx.x, 6, 0}; EpiRaw E{RAW, 0, 1.f / W8_SCALE};
        pg8::gemm_phase<EpiRaw, B1Order, false, true, true>(c.ldsp, g, S, E);
    }
    __syncthreads();
    {
        pg8::Gemm g{(const pg8::bf16_t*)(c.ws + WS_XN), (const pg8::bf16_t*)(c.ws + WS_WBIN + 3 * MB), T, 768, D};
        B1Order S{(int)gridDim.x, (int)blockIdx.x, 3, 1}; EpiRaw E{RAW, 1536, 1.f};
        pg8::gemm_phase<EpiRaw, B1Order, false, true, false>(c.ldsp, g, S, E);
    }
}
__device__ __forceinline__ void unpack8(const u32x4 r, float (&e)[8]) { e[0] = bf_lo(r.x); e[1] = bf_hi(r.x); e[2] = bf_lo(r.y); e[3] = bf_hi(r.y); e[4] = bf_lo(r.z); e[5] = bf_hi(r.z); e[6] = bf_lo(r.w); e[7] = bf_hi(r.w); }
__device__ __forceinline__ u32x4 pack8(const float (&e)[8]) { u32x4 o; o.x = pk_bf16(e[0], e[1]); o.y = pk_bf16(e[2], e[3]); o.z = pk_bf16(e[4], e[5]); o.w = pk_bf16(e[6], e[7]); return o; }
__device__ __forceinline__ void phase_rope(const Ctx& c) {
    const bf16_t* RAW = (const bf16_t*)(c.ws + WS_RAW);
    bf16_t* Q = (bf16_t*)(c.ws + WS_Q); bf16_t* K = (bf16_t*)(c.ws + WS_K); bf16_t* V = (bf16_t*)(c.ws + WS_V);
    bf16_t* QI = (bf16_t*)(c.ws + WS_QI); bf16_t* KI = (bf16_t*)(c.ws + WS_KI); float* WI = (float*)(c.ws + WS_WI);
    const int* pos = (const int*)c.a->in[IN_POS];
    LAS float* cs = (LAS float*)(c.lds + c.wave * 256);
    const int gw = c.vb * 4 + c.wave, ngw = c.nb * 4, lane = c.lane;
    const double ex = (lane < 16) ? (double)lane * (1.0 / 16.0) : (double)((lane - 16) & 7) * (1.0 / 8.0);
    const float invf = (float)exp2(-ex * 18.931568569324174);
    for (int t = gw; t < T; t += ngw) {
        if (lane < 24) {
            const float ang = (float)pos[t] * invf;
            const double ad = (double)ang; const double n = rint(ad * 0.15915494309189535); const float red = (float)(ad - n * 6.283185307179586);
            cs[lane] = __cosf(red); cs[32 + lane] = __sinf(red);
        }
        LDS_WAIT();
        const bf16_t* row = RAW + (size_t)t * BINP;
        for (int ch = lane; ch < BINP / 8; ch += 64) {
            const u32x4 own = ((const u32x4*)row)[ch];
            float e[8]; unpack8(own, e);
            if (ch < 160) {
                const int cc = ch & 15;
                if (cc < 4) {
                    const u32x4 oth = ((const u32x4*)row)[ch ^ 2]; float p[8]; unpack8(oth, p);
                    const int f0 = (cc & 1) * 8;
#pragma unroll
                    for (int i = 0; i < 8; ++i) { const float co = cs[f0 + i], si = cs[32 + f0 + i]; e[i] = (cc < 2) ? (e[i] * co - p[i] * si) : (e[i] * co + p[i] * si); }
                }
                u32x2 o8; o8.x = pk_fp8x4(e[0], e[1], e[2], e[3]); o8.y = pk_fp8x4(e[4], e[5], e[6], e[7]);
                if (ch < 128) ((u32x2*)((unsigned char*)Q + (size_t)t * D))[ch] = o8;
                else ((u32x2*)((unsigned char*)K + (size_t)t * 256))[ch - 128] = o8;
            } else if (ch < 192) {
                u32x2 o8; o8.x = pk_fp8x4(e[0], e[1], e[2], e[3]); o8.y = pk_fp8x4(e[4], e[5], e[6], e[7]);
                ((u32x2*)((unsigned char*)V + (size_t)t * 256))[ch - 160] = o8;
            } else if (ch < 264) {
                const int cc = ch & 7;
                if (cc < 2) {
                    const u32x4 oth = ((const u32x4*)row)[ch ^ 1]; float p[8]; unpack8(oth, p);
#pragma unroll
                    for (int i = 0; i < 8; ++i) { const float co = cs[16 + i], si = cs[32 + 16 + i]; e[i] = (cc == 0) ? (e[i] * co - p[i] * si) : (e[i] * co + p[i] * si); }
                }
                if (ch < 256) ((u32x4*)(QI + (size_t)t * 512))[ch - 192] = pack8(e);
                else ((u32x4*)(KI + (size_t)t * 64))[ch - 256] = pack8(e);
            } else if (ch == 264) {
                f32x4 w0 = {e[0], e[1], e[2], e[3]}, w1 = {e[4], e[5], e[6], e[7]};
                const float sc = 0.044194173824159216f;
                ((f32x4*)(WI + (size_t)t * 8))[0] = w0 * sc; ((f32x4*)(WI + (size_t)t * 8))[1] = w1 * sc;
            }
        }
        LDS_WAIT();
    }
}

__device__ __forceinline__ size_t srow_off(int t) { const int m = t >> 6, r = t & 63; return (size_t)64 * (m + 1) * (32 * m + r); }
constexpr size_t S_BATCH = (size_t)64 * 65 * 2048;
constexpr int SCORE_UNITS = 4 * 312;
__device__ __forceinline__ void phase_score(const Ctx& c) {
    const bf16_t* QI = (const bf16_t*)(c.ws + WS_QI); const bf16_t* KI = (const bf16_t*)(c.ws + WS_KI); const float* WI = (const float*)(c.ws + WS_WI);
    float* S = (float*)(c.ws + WS_S);
    const int lane = c.lane, hf = lane >> 5, col = lane & 31, w = c.wave;
    for (int u = c.vb; u < SCORE_UNITS; u += c.nb) {
        const int b = u & 3, r = u >> 2;
        int kc, qb;
        if (r < 120) { kc = 0; qb = 8 + r; } else if (r < 216) { kc = 1; qb = 32 + (r - 120); } else if (r < 280) { kc = 2; qb = 64 + (r - 216); } else { kc = 3; qb = 96 + (r - 280); }
        const int tb = b * SEQ, t0 = 32 * qb + 8 * w;
        bf16x8 af[2][4]; f32x4 wv[2][4];
        { const int rho = lane & 31, ql = 2 * ((rho >> 2) & 1) + (rho >> 4), hd = 4 * ((rho >> 3) & 1) + (rho & 3);
#pragma unroll
          for (int a = 0; a < 2; ++a) {
              const bf16_t* qp = QI + (size_t)(tb + t0 + 4 * a + ql) * 512 + hd * 64 + 8 * hf;
#pragma unroll
              for (int ks = 0; ks < 4; ++ks) af[a][ks] = *(const bf16x8*)(qp + 16 * ks);
              const float* wp = WI + (size_t)(tb + t0 + 4 * a + 2 * hf) * 8;
#pragma unroll
              for (int i = 0; i < 4; ++i) wv[a][i] = ((const f32x4*)wp)[i];
          } }
        const int ntile = min(32, qb + 1 - 32 * kc), key0 = 1024 * kc;
        float* Sb = S + (size_t)b * S_BATCH;
        size_t ro[2][2];
#pragma unroll
        for (int a = 0; a < 2; ++a) { ro[a][0] = srow_off(t0 + 4 * a + 2 * hf); ro[a][1] = srow_off(t0 + 4 * a + 2 * hf + 1); }
        const int nsub = (ntile + 3) >> 2;
        const bf16_t* krp[4];
        rows_regular<64>(krp, KI + (size_t)(tb + key0) * 64, 64, c.tid);
        __syncthreads();
        stage_tile<64>(c.lds, krp, 0, c.tid);
        for (int sc = 0; sc < 8; ++sc) {
            VM_WAIT();
            __syncthreads();
            const LAS unsigned char* cur = c.lds + (sc & 1) * 16384;
            if (sc + 1 < nsub) stage_tile<64>(c.lds + ((sc + 1) & 1) * 16384, krp, (sc + 1) * 128 * 64, c.tid);
#pragma unroll
            for (int j = 0; j < 4; ++j) {
                const int kt = 4 * sc + j;
                if (sc < nsub && kt < ntile) {
                    const int key = key0 + 32 * kt + col, row = 32 * j + col;
                    bf16x8 cb[4];
#pragma unroll
                    for (int ks = 0; ks < 4; ++ks) cb[ks] = *(const LAS bf16x8*)(cur + row * 128 + (((2 * ks + hf) ^ (row & 7)) << 4));
#pragma unroll
                    for (int a = 0; a < 2; ++a) {
                        f32x16 acc = {};
#pragma unroll
                        for (int ks = 0; ks < 4; ++ks) acc = __builtin_amdgcn_mfma_f32_32x32x16_bf16(af[a][ks], cb[ks], acc, 0, 0, 0);
                        float s0 = fmaxf(acc[0], 0.f) * wv[a][0].x; s0 += fmaxf(acc[1], 0.f) * wv[a][0].y; s0 += fmaxf(acc[2], 0.f) * wv[a][0].z; s0 += fmaxf(acc[3], 0.f) * wv[a][0].w;
                        s0 += fmaxf(acc[4], 0.f) * wv[a][1].x; s0 += fmaxf(acc[5], 0.f) * wv[a][1].y; s0 += fmaxf(acc[6], 0.f) * wv[a][1].z; s0 += fmaxf(acc[7], 0.f) * wv[a][1].w;
                        float s1 = fmaxf(acc[8], 0.f) * wv[a][2].x; s1 += fmaxf(acc[9], 0.f) * wv[a][2].y; s1 += fmaxf(acc[10], 0.f) * wv[a][2].z; s1 += fmaxf(acc[11], 0.f) * wv[a][2].w;
                        s1 += fmaxf(acc[12], 0.f) * wv[a][3].x; s1 += fmaxf(acc[13], 0.f) * wv[a][3].y; s1 += fmaxf(acc[14], 0.f) * wv[a][3].z; s1 += fmaxf(acc[15], 0.f) * wv[a][3].w;
                        const int tA = t0 + 4 * a + 2 * hf;
                        Sb[ro[a][0] + key] = (key <= tA) ? s0 : -INFINITY;
                        Sb[ro[a][1] + key] = (key <= tA + 1) ? s1 : -INFINITY;
                    }
                }
            }
        }
    }
}

constexpr int NBINS = 2048, CAND_CAP = 256, SEL_WAVE_LDS = 8192 + 2048 + 64;
__device__ __forceinline__ int clamp_bin(int x) { return min(max(x, 0), NBINS - 1); }
__device__ __forceinline__ void phase_select(const Ctx& c) {
    const float* S = (const float*)(c.ws + WS_S); int* SEL = (int*)(c.ws + WS_SEL);
    LAS int* hist = (LAS int*)(c.lds + c.wave * SEL_WAVE_LDS);
    LAS float* candv = (LAS float*)(hist + NBINS);
    LAS int* candi = (LAS int*)(candv + CAND_CAP);
    LAS int* thr = candi + CAND_CAP;
    const int gw = c.vb * 4 + c.wave, ngw = c.nb * 4;
    for (int j = gw; j < 4 * 3840; j += ngw) {
        int lane = c.lane;
        asm volatile("" : "+v"(lane));
        const int b = j & 3, t = 4095 - (j >> 2), ni = (t + 64) >> 6;
        const float* row = S + (size_t)b * S_BATCH + srow_off(t);
        float s[64];
#pragma unroll
        for (int g4 = 0; g4 < 4; ++g4) {
            if (16 * g4 < ni) {
#pragma unroll
                for (int i = 16 * g4; i < 16 * g4 + 16; ++i) { const int k = 64 * i + lane; const float v = row[min(k, t)]; s[i] = (k <= t) ? v : -INFINITY; }
            } else {
#pragma unroll
                for (int i = 16 * g4; i < 16 * g4 + 16; ++i) s[i] = -INFINITY;
            }
        }
        float mn = INFINITY, mx = -INFINITY;
#pragma unroll
        for (int g8 = 0; g8 < 8; ++g8) if (8 * g8 < ni) {
#pragma unroll
            for (int i = 8 * g8; i < 8 * g8 + 8; ++i) { mx = fmaxf(mx, s[i]); mn = fminf(mn, (s[i] == -INFINITY) ? INFINITY : s[i]); }
        }
#pragma unroll
        for (int o = 1; o < 64; o <<= 1) { mx = fmaxf(mx, __shfl_xor(mx, o)); mn = fminf(mn, __shfl_xor(mn, o)); }
        const float sc = (mx > mn) ? (float)NBINS / (mx - mn) : 0.f, a0 = -mn * sc;
#pragma unroll
        for (int i = 0; i < 8; ++i) ((LAS u32x4*)hist)[lane * 8 + i] = (u32x4){0u, 0u, 0u, 0u};
        LDS_WAIT();
#define BINOF(v) clamp_bin((int)__builtin_fmaf((v), sc, a0))
#pragma unroll
        for (int g8 = 0; g8 < 8; ++g8) if (8 * g8 < ni) {
#pragma unroll
            for (int i = 8 * g8; i < 8 * g8 + 8; ++i) lds_inc(&hist[BINOF(s[i])]);
        }
        LDS_WAIT();
        int bs, need;
        {
            const LAS int* hq = hist + lane * 32;
            u32x4 hr[8];
            int loc = 0;
#pragma unroll
            for (int i = 0; i < 8; ++i) { hr[i] = ((const LAS u32x4*)hq)[i]; loc += (int)(hr[i].x + hr[i].y + hr[i].z + hr[i].w); }
            int suf = loc;
#pragma unroll
            for (int o = 1; o < 64; o <<= 1) { const int v = __shfl_down(suf, o); if (lane + o < 64) suf += v; }
            const int above = suf - loc;
            const bool cross = (above < 256 && suf >= 256);
            int bsl = 0, abl = 0;
            { int run = above;
#pragma unroll
              for (int i = 31; i >= 0; --i) { const int h = (int)hr[i >> 2][i & 3]; const bool hit = (run < 256 && run + h >= 256); bsl = hit ? lane * 32 + i : bsl; abl = hit ? run : abl; run += h; } }
            const unsigned long long cm = __ballot(cross);
            const int src = cm ? (int)__builtin_ctzll(cm) : 0;
            bs = __shfl(bsl, src); need = 256 - __shfl(abl, src);
        }
        int bs2 = -1;
#define SUBOF(v) clamp_bin((int)((__builtin_fmaf((v), sc, a0) - (float)bs) * (float)NBINS))
        if (__shfl(hist[bs], 0) > 48) {
#pragma unroll
            for (int i = 0; i < 8; ++i) ((LAS u32x4*)hist)[lane * 8 + i] = (u32x4){0u, 0u, 0u, 0u};
            LDS_WAIT();
#pragma unroll
            for (int i = 0; i < 64; ++i) if (s[i] != -INFINITY && BINOF(s[i]) == bs) lds_inc(&hist[SUBOF(s[i])]);
            LDS_WAIT();
            const LAS int* hq = hist + lane * 32;
            int loc = 0;
#pragma unroll
            for (int i = 0; i < 8; ++i) { const u32x4 h4 = ((const LAS u32x4*)hq)[i]; loc += (int)(h4.x + h4.y + h4.z + h4.w); }
            int suf = loc;
#pragma unroll
            for (int o = 1; o < 64; o <<= 1) { const int v = __shfl_down(suf, o); if (lane + o < 64) suf += v; }
            const int above = suf - loc;
            const bool cross = (above < need && suf >= need);
            int bsl = 0, abl = 0;
            if (cross) { int run = above; for (int i = 31; i >= 0; --i) { const int h = hq[i]; if (run < need && run + h >= need) { bsl = lane * 32 + i; abl = run; } run += h; } }
            const unsigned long long cm = __ballot(cross);
            const int src = cm ? (int)__builtin_ctzll(cm) : 0;
            bs2 = __shfl(bsl, src); need = need - __shfl(abl, src);
        }
        asm volatile("" : "+v"(lane));
        float sc2 = sc, a02 = a0;
        asm volatile("" : "+v"(sc2), "+v"(a02));
#undef BINOF
#define BINOF(v) clamp_bin((int)__builtin_fmaf((v), sc2, a02))
        int* selr = SEL + ((size_t)b * SEQ + t) * 256;
        int nc = 0, base = 0;
#pragma unroll
        for (int g4 = 0; g4 < 4; ++g4) if (16 * g4 < ni) {
#pragma unroll
            for (int i = 16 * g4; i < 16 * g4 + 16; ++i) {
                const int bn = BINOF(s[i]);
                bool pc = (bn == bs) && (s[i] != -INFINITY), pd = (bn > bs);
                if (bs2 >= 0) { const int sb = SUBOF(s[i]); pd = pd || (pc && sb > bs2); pc = pc && (sb == bs2); }
                const unsigned long long md = __ballot(pd), mc = __ballot(pc);
                const int posd = base + (int)__builtin_amdgcn_mbcnt_hi((unsigned)(md >> 32), __builtin_amdgcn_mbcnt_lo((unsigned)md, 0u));
                const int posc = nc + (int)__builtin_amdgcn_mbcnt_hi((unsigned)(mc >> 32), __builtin_amdgcn_mbcnt_lo((unsigned)mc, 0u));
                if (pd && posd < 256) selr[posd] = 64 * i + lane;
                if (pc && posc < CAND_CAP) { candv[posc] = s[i]; candi[posc] = 64 * i + lane; }
                base += (int)__popcll(md); nc += (int)__popcll(mc);
            }
        }
        nc = min(nc, CAND_CAP);
        LDS_WAIT();
        for (int i = lane; i < nc; i += 64) {
            const float v = candv[i]; const int id = candi[i];
            int rank = 0;
            for (int k = 0; k < nc; ++k) { const float vk = candv[k]; const int ik = candi[k]; rank += (vk > v || (vk == v && ik < id)) ? 1 : 0; }
            if (rank < need && base + rank < 256) selr[base + rank] = id;
        }
        LDS_WAIT();
#undef BINOF
#undef SUBOF
    }
}

typedef short s16x4 __attribute__((ext_vector_type(4)));
__device__ __forceinline__ unsigned vimg_f(unsigned r) { return ((r & 3u) << 2) | ((r >> 2) & 3u); }
__device__ __forceinline__ void tr_read8(const unsigned (&ad)[8], s16x4 (&r)[8]) {
    asm volatile("ds_read_b64_tr_b16 %0, %8\n\tds_read_b64_tr_b16 %1, %9\n\tds_read_b64_tr_b16 %2, %10\n\tds_read_b64_tr_b16 %3, %11\n\t"
                 "ds_read_b64_tr_b16 %4, %12\n\tds_read_b64_tr_b16 %5, %13\n\tds_read_b64_tr_b16 %6, %14\n\tds_read_b64_tr_b16 %7, %15\n\ts_waitcnt lgkmcnt(0)"
                 : "=&v"(r[0]), "=&v"(r[1]), "=&v"(r[2]), "=&v"(r[3]), "=&v"(r[4]), "=&v"(r[5]), "=&v"(r[6]), "=&v"(r[7])
                 : "v"(ad[0]), "v"(ad[1]), "v"(ad[2]), "v"(ad[3]), "v"(ad[4]), "v"(ad[5]), "v"(ad[6]), "v"(ad[7]) : "memory");
}
__device__ __forceinline__ void tr_read8_b8(const unsigned (&ad)[8], s16x4 (&r)[8]) {
    asm volatile("ds_read_b64_tr_b8 %0, %8\n\tds_read_b64_tr_b8 %1, %9\n\tds_read_b64_tr_b8 %2, %10\n\tds_read_b64_tr_b8 %3, %11\n\t"
                 "ds_read_b64_tr_b8 %4, %12\n\tds_read_b64_tr_b8 %5, %13\n\tds_read_b64_tr_b8 %6, %14\n\tds_read_b64_tr_b8 %7, %15\n\ts_waitcnt lgkmcnt(0)"
                 : "=&v"(r[0]), "=&v"(r[1]), "=&v"(r[2]), "=&v"(r[3]), "=&v"(r[4]), "=&v"(r[5]), "=&v"(r[6]), "=&v"(r[7])
                 : "v"(ad[0]), "v"(ad[1]), "v"(ad[2]), "v"(ad[3]), "v"(ad[4]), "v"(ad[5]), "v"(ad[6]), "v"(ad[7]) : "memory");
}
constexpr int ATT_WAVE_LDS = 19456;
__device__ __forceinline__ void phase_attn(const Ctx& c) {
    const bf16_t* Q = (const bf16_t*)(c.ws + WS_Q); const bf16_t* K = (const bf16_t*)(c.ws + WS_K); const bf16_t* V = (const bf16_t*)(c.ws + WS_V);
    const int* SEL = (const int*)(c.ws + WS_SEL); bf16_t* O = (bf16_t*)(c.ws + WS_O);
    LAS unsigned char* wl = c.lds + c.wave * ATT_WAVE_LDS;
    LAS int* sl = (LAS int*)wl;
    LAS unsigned short* pT = (LAS unsigned short*)(wl + 1024);
    LAS unsigned char* vb = wl + 3072;
    const int lane = c.lane, fr = lane & 15, fq = lane >> 4;
    const int gw = c.vb * 4 + c.wave, ngw = c.nb * 4;
    unsigned tro[8];
    { const unsigned row = 8u * fq + ((unsigned)fr >> 1);
#pragma unroll
      for (int c2 = 0; c2 < 8; ++c2) tro[c2] = 128u * row + 16u * ((unsigned)c2 ^ (row & 7u)) + 8u * ((unsigned)fr & 1u); }
    const unsigned vb_addr = (unsigned)(size_t)vb;
    int tcount = 0, cit = gw;
    const bool xsplit = (c.nb % 128) == 0;
    const int xg = (c.vb >> 6) & 1, wi0 = xsplit ? (((c.vb >> 7) * 64 + (c.vb & 63)) * 4 + c.wave) : gw, wstride = xsplit ? ngw / 2 : ngw;
    const unsigned chunkoff = (((unsigned)lane & 7u) ^ (((unsigned)lane >> 3) & 7u)) << 4;
    unsigned trh[8];
    { const unsigned row = 8u * (fq & 1) + ((unsigned)fr >> 1);
#pragma unroll
      for (int c2 = 0; c2 < 8; ++c2) trh[c2] = 128u * row + 16u * ((unsigned)c2 ^ (row & 7u)) + 8u * ((unsigned)fr & 1u); }
#define SEL_PREFETCH(tg_) __builtin_amdgcn_global_load_lds((const unsigned*)(SEL + (size_t)(tg_) * 256 + lane * 4), (LAS unsigned*)((LAS unsigned char*)sl + lane * 16), 16, 0, 0)
    const int task_end = xsplit ? T : T * 2;
    if (wi0 < task_end) { SEL_PREFETCH(xsplit ? wi0 : (wi0 >> 1)); }
    for (int task = wi0; task < task_end; task += wstride) {
        const int tg = xsplit ? task : (task >> 1), g = xsplit ? xg : (task & 1), b = tg >> 12, t = tg & 4095, tb = b * SEQ;
        const int nsel = min(256, t + 1), nch = (nsel + 31) >> 5;
        asm volatile("s_waitcnt vmcnt(0)" ::: "memory");
        unsigned koff[32];
#pragma unroll
        for (int q = 0; q < 32; ++q) { const int s_ = 8 * q + (lane >> 3); int idx = sl[s_]; idx = (t < 256) ? s_ : idx; idx = (s_ < nsel && (unsigned)idx <= (unsigned)t) ? idx : 0; koff[q] = (unsigned)idx * 256u + chunkoff; }
        i64x2 qf[2];
        { const unsigned char* qp = (const unsigned char*)Q + (size_t)tg * D + (4 * g + (fr >> 2)) * 128 + 16 * fq;
#pragma unroll
          for (int i = 0; i < 2; ++i) qf[i] = *(const i64x2*)(qp + 64 * i); }
        asm volatile("s_waitcnt vmcnt(0) lgkmcnt(0)" ::: "memory");
        asm volatile("" : "+v"(qf[0]), "+v"(qf[1]));
        { const int tn = task + wstride; if (tn < task_end) SEL_PREFETCH(xsplit ? tn : (tn >> 1)); }
        const unsigned char* kbase = (const unsigned char*)K + (size_t)tb * 256 + g * 128;
        const unsigned char* vbase = (const unsigned char*)V + (size_t)tb * 256 + g * 128;
#define CH_GATHER(cidx) do { const unsigned char* bp_ = ((cidx) < 16) ? kbase : vbase; _Pragma("unroll") for (int i_ = 0; i_ < 2; ++i_) { \
            unsigned o_ = koff[2 * ((cidx) & 15) + i_]; asm volatile("" : "+v"(o_));     \
            __builtin_amdgcn_global_load_lds((const unsigned*)(bp_ + o_), (LAS unsigned*)(vb + ((cidx) & 7) * 2048 + i_ * 1024 + lane * 16), 16, 0, 0); } } while (0)
        float lg[16];
#pragma unroll
        for (int c0 = 0; c0 < 6; ++c0) CH_GATHER(c0);
#pragma unroll
        for (int ch = 0; ch < 16; ++ch) {
            asm volatile("s_waitcnt lgkmcnt(0)" ::: "memory");
            CH_GATHER(ch + 6);
            asm volatile("s_waitcnt vmcnt(12)" ::: "memory");
            const LAS unsigned char* kb = vb + (ch & 7) * 2048;
            f32x4 acc = {0.f, 0.f, 0.f, 0.f};
#pragma unroll
            for (int i = 0; i < 2; ++i) { const i64x2 kf = *(const LAS i64x2*)(kb + 128u * fr + 16u * ((4u * i + fq) ^ ((unsigned)fr & 7u)));
                acc = __builtin_amdgcn_mfma_f32_16x16x32_fp8_fp8(qf[i].x, kf.x, acc, 0, 0, 0); acc = __builtin_amdgcn_mfma_f32_16x16x32_fp8_fp8(qf[i].y, kf.y, acc, 0, 0, 0); }
            lg[ch] = (ch * 16 + fr < nsel) ? acc.x * 0.08838834764831845f : -INFINITY;
        }
        float mx = lg[0];
#pragma unroll
        for (int kt = 1; kt < 16; ++kt) mx = fmaxf(mx, lg[kt]);
#pragma unroll
        for (int o = 1; o < 16; o <<= 1) mx = fmaxf(mx, __shfl_xor(mx, o));
        float sm = 0.f;
#pragma unroll
        for (int kt = 0; kt < 16; ++kt) { lg[kt] = __expf(lg[kt] - mx); sm += lg[kt]; }
#pragma unroll
        for (int o = 1; o < 16; o <<= 1) sm += __shfl_xor(sm, o);
        { const float inv = 256.f / sm;
#pragma unroll
          for (int kt = 0; kt < 16; ++kt) { const float pv = lg[kt] * inv; ((LAS unsigned char*)pT)[fq * 256 + kt * 16 + fr] = (unsigned char)(pk_fp8x4_nc(pv, pv, pv, pv) & 0xffu); } }
        f32x4 oacc[8];
#pragma unroll
        for (int c2 = 0; c2 < 8; ++c2) oacc[c2] = (f32x4){0.f, 0.f, 0.f, 0.f};
#pragma unroll
        for (int p = 0; p < 8; ++p) {
            asm volatile("s_waitcnt lgkmcnt(0)" ::: "memory");
            if (16 + 2 * p + 6 < 32) { CH_GATHER(16 + 2 * p + 6); CH_GATHER(16 + 2 * p + 7); }
            if (p < 5) asm volatile("s_waitcnt vmcnt(12)" ::: "memory"); else if (p == 5) asm volatile("s_waitcnt vmcnt(8)" ::: "memory");
            else if (p == 6) asm volatile("s_waitcnt vmcnt(4)" ::: "memory"); else asm volatile("s_waitcnt vmcnt(0)" ::: "memory");
            if (p < nch) {
                const long pa = *(const LAS long*)((const LAS unsigned char*)pT + (fr >> 2) * 256 + 32 * p + 8 * fq);
                const unsigned cb = vb_addr + (unsigned)(((16 + 2 * p) & 7) + (fq >> 1)) * 2048u;
                unsigned ad[8]; s16x4 r0[8];
#pragma unroll
                for (int i = 0; i < 8; ++i) ad[i] = cb + trh[i];
                tr_read8_b8(ad, r0);
#pragma unroll
                for (int c2 = 0; c2 < 8; ++c2) oacc[c2] = __builtin_amdgcn_mfma_f32_16x16x32_fp8_fp8(pa, __builtin_bit_cast(long, r0[c2]), oacc[c2], 0, 0, 0);
            }
        }
        { unsigned char* op = (unsigned char*)O + (size_t)tg * D + (4 * g + fq) * 128 + fr;
#pragma unroll
          for (int c2 = 0; c2 < 8; ++c2) { const float ov = oacc[c2].x * (O8_SCALE / 256.f); op[16 * c2] = (unsigned char)(pk_fp8x4(ov, ov, ov, ov) & 0xffu); } }
        LDS_WAIT();
#undef CH_GATHER
        if ((tcount & 1) && cit < NE * 192) { convert_moe_item(c, 1, cit, vb); cit += ngw; }
        ++tcount;
    }
    for (; cit < NE * 192; cit += ngw) convert_moe_item(c, 1, cit, vb);
}

__device__ __forceinline__ void phase_b4(const Ctx& c) {
    float* H = (float*)(c.ws + WS_H);
    pg8::Gemm g{(const pg8::bf16_t*)(c.ws + WS_O), (const pg8::bf16_t*)(c.ws + WS_WBOUT), T, D, D / 2};
    pg8::StaticOrder S; S.init(T, D, (int)gridDim.x, (int)blockIdx.x);
    EpiResF32 E{H, H, D, 1.f / (W8_SCALE * O8_SCALE)};
    pg8::gemm_phase<EpiResF32, pg8::StaticOrder, false, true, true>(c.ldsp, g, S, E);
}

constexpr int NPHASE = 22;
__global__ void __launch_bounds__(NTHP, 2) mk_fwd(Args args) {
    extern __shared__ __attribute__((aligned(16))) unsigned char lds_raw[];
    Ctx c;
    { const int pt = threadIdx.x; c.half = __builtin_amdgcn_readfirstlane(pt >> 8); c.tid = pt & 255; c.lane = pt & 63; c.wave = __builtin_amdgcn_readfirstlane(pt >> 6) & 3; }
    c.ldsp = (LAS unsigned char*)lds_raw; c.lds = c.ldsp + c.half * LDS_HALF;
    c.nb = 2 * gridDim.x; { const int bx = blockIdx.x, G = gridDim.x; c.vb = 2 * ((G % 8 == 0) ? (bx % 8) * (G / 8) + bx / 8 : bx) + c.half; }
    c.a = (const __attribute__((address_space(4))) Args*)__builtin_amdgcn_kernarg_segment_ptr(); c.ws = args.ws;
    volatile LAS unsigned* st = (volatile LAS unsigned*)((LAS unsigned char*)lds_raw + LDS_BYTES - 16);
    const bool multi = (args.ph_hi - args.ph_lo) > 1;
    XcdBarrier bar; bar.bar = (unsigned*)(c.ws + WS_CTL); bar.x = 0; bar.st = st;
    if (multi) {
        if (threadIdx.x == 0) { st[0] = 0u; st[1] = 0u; }
        __syncthreads();
        bar = xcd_barrier_post((unsigned*)(c.ws + WS_CTL), st);
    }
    const int ph_lo = args.ph_lo, ph_hi = args.ph_hi;
#ifndef PH_MASK
#define PH_MASK 0x3fffff
#endif
#define PHON(k) ((PH_MASK >> (k)) & 1)
#define PHASE(k, body) do { if (PHON(k) && ph_lo <= (k) && (k) < ph_hi) { \
        { int t_ = threadIdx.x, vb_ = __builtin_amdgcn_readfirstlane(c.vb); \
          const __attribute__((address_space(4))) Args* ka = (const __attribute__((address_space(4))) Args*)__builtin_amdgcn_kernarg_segment_ptr(); \
          asm volatile("" : "+v"(t_), "+s"(vb_), "+s"(ka)); \
          c.tid = t_ & 255; c.lane = t_ & 63; c.wave = __builtin_amdgcn_readfirstlane(t_ >> 6) & 3; c.vb = vb_; c.a = ka; c.ws = ka->ws; } \
        body; \
        if (MK_REP == (k)) { __syncthreads(); body; } \
        if ((k) + 1 < ph_hi) xcd_barrier(bar); \
        if ((k) == 3) { for (int xb_ = 0; xb_ < MK_XBAR; ++xb_) xcd_barrier(bar); } } } while (0)
    PHASE(0, phase_prep(c));
    PHASE(1, phase_a1(c));
    PHASE(2, { if (MK_DRY == 2) { phase_a2(c, true); __syncthreads(); } phase_a2(c); });
    PHASE(3, phase_a3(c));
    PHASE(4, { if (MK_DRY == 4) { phase_route(c, 0, true); __syncthreads(); } phase_route(c, 0); });
    PHASE(5, phase_e1(c, 0));
    PHASE(6, phase_e2(c, 0));
    PHASE(7, { if (MK_DRY == 7) { phase_p1(c, 0, true); __syncthreads(); } phase_p1(c, 0); });
    PHASE(8, phase_p2(c, 0));
    PHASE(9, phase_norm_bf16(c, (const float*)c.a->in[IN_MIXN] + D));
    PHASE(10, phase_b1(c));
    PHASE(11, phase_rope(c));
    PHASE(12, phase_score(c));
    PHASE(13, phase_select(c));
    PHASE(14, phase_attn(c));
    PHASE(15, phase_b4(c));
    PHASE(16, phase_route(c, 1));
    PHASE(17, phase_e1(c, 1));
    PHASE(18, phase_e2(c, 1));
    PHASE(19, phase_p1(c, 1));
    PHASE(20, phase_p2(c, 1));
    PHASE(21, phase_final(c));
}

#ifdef MK_DUMP
__global__ void dump_k(const unsigned char* ws, float* out) {
    const size_t i = (size_t)blockIdx.x * 256 + threadIdx.x;
#if MK_DUMP == 1
    ((f32x4*)out)[i] = ((const f32x4*)(ws + WS_H))[i];
#elif MK_DUMP == 2
    { const u32x2 v = ((const u32x2*)(ws + WS_O))[i]; f32x4 o = {bf_lo(v.x), bf_hi(v.x), bf_lo(v.y), bf_hi(v.y)}; ((f32x4*)out)[i] = o; }
#elif MK_DUMP == 3
    { const int* sp = (const int*)(ws + WS_SEL); f32x4 o = {0.f,0.f,0.f,0.f}; if (i < (size_t)T * 64) { o.x = (float)sp[4*i]; o.y = (float)sp[4*i+1]; o.z = (float)sp[4*i+2]; o.w = (float)sp[4*i+3]; } ((f32x4*)out)[i] = o; }
#elif MK_DUMP == 5
    { const u32x2 v = ((const u32x2*)(ws + WS_XN))[i]; f32x4 o = {bf_lo(v.x), bf_hi(v.x), bf_lo(v.y), bf_hi(v.y)}; ((f32x4*)out)[i] = o; }
#elif MK_DUMP == 6
    { const u32x2 v = ((const u32x2*)(ws + WS_RAW))[i]; f32x4 o = {bf_lo(v.x), bf_hi(v.x), bf_lo(v.y), bf_hi(v.y)}; ((f32x4*)out)[i] = o; }
#elif MK_DUMP == 7
    { f32x4 o = {0.f,0.f,0.f,0.f}; if (i < (size_t)BINP * D / 4) { const u32x2 v = ((const u32x2*)(ws + WS_WBIN))[i]; o = (f32x4){bf_lo(v.x), bf_hi(v.x), bf_lo(v.y), bf_hi(v.y)}; } ((f32x4*)out)[i] = o; }
#elif MK_DUMP == 8
    { const u32x2 v = ((const u32x2*)(ws + WS_RAW))[i], w = ((const u32x2*)(ws + 458 * MB))[i]; f32x4 o = {bf_lo(v.x) - bf_lo(w.x), bf_hi(v.x) - bf_hi(w.x), bf_lo(v.y) - bf_lo(w.y), bf_hi(v.y) - bf_hi(w.y)}; ((f32x4*)out)[i] = o; }
#elif MK_DUMP == 9
    { const u32x2 v = ((const u32x2*)(ws + WS_RAW))[i], w = ((const u32x2*)(ws + 458 * MB))[i]; f32x4 o = {(v.x & 0xffffu) != (w.x & 0xffffu) ? 1.f : 0.f, (v.x >> 16) != (w.x >> 16) ? 1.f : 0.f, (v.y & 0xffffu) != (w.y & 0xffffu) ? 1.f : 0.f, (v.y >> 16) != (w.y >> 16) ? 1.f : 0.f}; ((f32x4*)out)[i] = o; }
#elif MK_DUMP == 4
    { const u32x2 v = ((const u32x2*)(ws + WS_Q))[i]; f32x4 o = {bf_lo(v.x), bf_hi(v.x), bf_lo(v.y), bf_hi(v.y)}; ((f32x4*)out)[i] = o; }
#endif
}
#endif
extern "C" void kernel_launch(void* const* d_in, const int* in_sizes, int n_in, void* d_out, int out_size, void* d_ws, size_t ws_size, hipStream_t stream) {
    static int grid = 0;
    if (grid == 0) {
        if (n_in != 23 || out_size != T * D || ws_size < WS_TOTAL) { fprintf(stderr, "kernel_launch: unexpected sizes n_in %d out %d ws %zu (need %zu)\n", n_in, out_size, ws_size, (size_t)WS_TOTAL); grid = -1; return; }
        int dev = 0, cus = 0, per_cu = 0;
        hipGetDevice(&dev); hipDeviceGetAttribute(&cus, hipDeviceAttributeMultiprocessorCount, dev);
        hipFuncSetAttribute((const void*)mk_fwd, hipFuncAttributeMaxDynamicSharedMemorySize, LDS_BYTES);
        hipOccupancyMaxActiveBlocksPerMultiprocessor(&per_cu, (const void*)mk_fwd, NTHP, LDS_BYTES);
        (void)hipGetLastError();
        if (per_cu < 1) per_cu = 1;
        if (per_cu > 1) per_cu = 1;
        grid = cus * per_cu;
    }
    if (grid < 0) return;
    hipMemsetAsync((char*)d_ws + WS_CTL, 0, 16384, stream);
    Args a{};
    for (int i = 0; i < 23; ++i) a.in[i] = d_in[i];
    a.out = (float*)d_out; a.ws = (unsigned char*)d_ws;
#if MK_ONE_LAUNCH
    a.ph_lo = 0; a.ph_hi = NPHASE;
    hipLaunchKernelGGL(mk_fwd, dim3(grid), dim3(NTHP), LDS_BYTES, stream, a);
#else
    for (int ph = 0; ph <= MK_LAST_PHASE; ++ph) { a.ph_lo = ph; a.ph_hi = ph + 1; hipLaunchKernelGGL(mk_fwd, dim3(grid), dim3(NTHP), LDS_BYTES, stream, a); }
#ifdef MK_DUMP
    hipLaunchKernelGGL(dump_k, dim3(T * D / 4 / 256), dim3(256), 0, stream, (const unsigned char*)d_ws, (float*)d_out);
#endif
#endif
}
```

```cpp
#include <hip/hip_runtime.h>
#include <stdint.h>
#include <stdio.h>

#ifndef MK_LAST_PHASE
#define MK_LAST_PHASE 21
#endif
#ifndef MK_REP
#define MK_REP -1
#endif
#ifndef MK_XBAR
#define MK_XBAR 0
#endif
#ifndef MK_DRY
#define MK_DRY -1
#endif
#ifndef MK_ONE_LAUNCH
#define MK_ONE_LAUNCH 1
#endif

#define LAS __attribute__((address_space(3)))
typedef unsigned short bf16_t;
typedef short bf16x8 __attribute__((ext_vector_type(8)));
typedef float f32x4 __attribute__((ext_vector_type(4)));
typedef float f32x2 __attribute__((ext_vector_type(2)));
typedef float f32x16 __attribute__((ext_vector_type(16)));
typedef unsigned u32x4 __attribute__((ext_vector_type(4)));
typedef unsigned u32x2 __attribute__((ext_vector_type(2)));
typedef long i64x2 __attribute__((ext_vector_type(2)));
typedef int i32x4 __attribute__((ext_vector_type(4)));
typedef int i32x8 __attribute__((ext_vector_type(8)));

constexpr int T = 16384, D = 1024, SEQ = 4096;
constexpr int GW = 2048;
constexpr int BIN = 2120, BINP = 2176;
constexpr int NE = 32, DE = 512;
constexpr int PLE = 256;
constexpr float EPS = 1e-6f;
constexpr int NTH = 256;
constexpr int LDS_MAIN = 4 * 19456;
constexpr int LDS_HALF = LDS_MAIN + 1024;
constexpr int LDS_BYTES = 2 * LDS_HALF;
constexpr int NTHP = 512;
constexpr int RPAD = 32768 + NE * 256;

constexpr size_t MB = 1024 * 1024;
constexpr size_t WS_CTL = 0;
constexpr size_t WS_CNT = 448 * 1024;
constexpr int NSUB = 32, SUBCAP = T / NSUB, CNT_STRIDE = 32;
static_assert(WS_CNT >= 32768 + 2 * 1024 * 48 * 4 && WS_CNT + (size_t)4 * NSUB * 32 * CNT_STRIDE * 4 <= 1024 * 1024, "cnt");
constexpr size_t WS_WR = 32768;
constexpr size_t WS_WAIN = 1 * MB;
constexpr size_t WS_WAOUT = WS_WAIN + 8 * MB;
constexpr size_t WS_WBIN = WS_WAOUT + 4 * MB;
constexpr size_t WS_WBOUT = WS_WBIN + 5 * MB;
constexpr size_t WS_WGATE = WS_WBOUT + 2 * MB;
constexpr size_t WS_WPROJ = WS_WGATE + 4 * MB;
constexpr size_t WS_W1 = WS_WPROJ + 1 * MB;
constexpr size_t WS_XN8 = WS_W1 + 16 * MB;
constexpr size_t WS_W3 = WS_W1 + 32 * MB;
constexpr size_t WS_W2 = WS_W3 + 32 * MB;
constexpr size_t WS_PBF = WS_W2 + 32 * MB;
constexpr size_t WS_XN = WS_PBF + 16 * MB;
constexpr size_t WS_H = WS_XN + 32 * MB;
constexpr size_t WS_LIST = WS_H + 64 * MB;
constexpr size_t WS_GATE = WS_LIST + 2 * MB;
constexpr size_t WS_TOKSLOT = WS_GATE + 2 * MB;
constexpr size_t WS_GROW = WS_TOKSLOT + 512 * 1024;
constexpr size_t WS_SCR = WS_TOKSLOT + 1 * MB;
constexpr size_t WS_U = WS_SCR;
constexpr size_t WS_VT = WS_SCR + 64 * MB;
constexpr size_t WS_VSS = WS_SCR + 128 * MB;
constexpr size_t WS_HMID = WS_SCR;
constexpr size_t WS_Y = WS_SCR + 36 * MB;
constexpr size_t WS_RAW = WS_SCR;
constexpr size_t WS_O = WS_SCR;
constexpr size_t WS_Q = WS_SCR + 68 * MB;
constexpr size_t WS_K = WS_Q + 32 * MB;
constexpr size_t WS_V = WS_K + 8 * MB;
constexpr size_t WS_QI = WS_V + 8 * MB;
constexpr size_t WS_KI = WS_QI + 16 * MB;
constexpr size_t WS_WI = WS_KI + 2 * MB;
constexpr size_t WS_SEL = WS_WI + 1 * MB;
constexpr size_t WS_END = WS_SEL + 16 * MB;
static_assert(WS_END <= WS_SCR + 152 * MB, "scratch");
constexpr size_t WS_S = 392 * MB;
constexpr size_t WS_TOTAL = 522 * MB;

typedef __bf16 bf16x2_t __attribute__((ext_vector_type(2)));
__device__ __forceinline__ unsigned pk_bf16(float lo, float hi) { f32x2 v = {lo, hi}; bf16x2_t b = __builtin_convertvector(v, bf16x2_t); return __builtin_bit_cast(unsigned, b); }
__device__ __forceinline__ float bf_lo(unsigned u) { return __uint_as_float(u << 16); }
__device__ __forceinline__ float bf_hi(unsigned u) { return __uint_as_float(u & 0xffff0000u); }
__device__ __forceinline__ float wave_sum(float v) {
#pragma unroll
    for (int o = 1; o < 64; o <<= 1) v += __shfl_xor(v, o);
    return v;
}
__device__ __forceinline__ int lds_inc(LAS int* p) { return __hip_atomic_fetch_add(p, 1, __ATOMIC_RELAXED, __HIP_MEMORY_SCOPE_WORKGROUP); }
#define LDS_WAIT() asm volatile("s_waitcnt lgkmcnt(0)" ::: "memory")
#define VM_WAIT() asm volatile("s_waitcnt vmcnt(0)" ::: "memory")

#define XB_TMO      128
#define XB_XCNT(j)  (256  + 64 * (j))
#define XB_XSUB(j)  (1280 + 64 * (j))
#define XB_XGEN(j)  (2304 + 64 * (j))
#define XB_TOP      3328
#define XB_TOPGEN   3392
#define XCD_BAR_WORDS 3456
#define XB_SPIN_CAP (1u << 20)
__device__ __forceinline__ unsigned xb_ld(unsigned* p)              { return __hip_atomic_load(p, __ATOMIC_RELAXED, __HIP_MEMORY_SCOPE_AGENT); }
__device__ __forceinline__ unsigned xb_add(unsigned* p, unsigned v) { return __hip_atomic_fetch_add(p, v, __ATOMIC_RELAXED, __HIP_MEMORY_SCOPE_AGENT); }
__device__ __forceinline__ unsigned xb_xcc_id() { return (unsigned)__builtin_amdgcn_s_getreg((3 << 11) | 20) & 0xFu; }
#define XB_SPIN(cond, bar) do { unsigned _sp = 0; while (cond) { __builtin_amdgcn_s_sleep(1); \
    if ((++_sp & 255u) == 0u) { if (xb_ld(&(bar)[XB_TMO])) break; if (_sp > XB_SPIN_CAP) { atomicAdd(&(bar)[XB_TMO], 1u); break; } } } } while (0)
struct XcdBarrier { unsigned* bar; unsigned x; volatile LAS unsigned* st; };
__device__ __forceinline__ XcdBarrier xcd_barrier_post(unsigned* bar, volatile LAS unsigned* st) {
    XcdBarrier b; b.bar = bar; b.x = xb_xcc_id(); b.st = st;
    if (threadIdx.x == 0) (void)xb_add(&bar[XB_XCNT(b.x)], 1u);
    return b;
}
__device__ __forceinline__ void xcd_barrier_complete(unsigned* bar, unsigned x, unsigned& nloc, unsigned& nx) {
    const unsigned G = gridDim.x;
    unsigned sum, cnt, mine, sp = 0u;
    for (;;) {
        sum = 0u; cnt = 0u; mine = 0u;
#pragma unroll
        for (unsigned j = 0; j < 16; ++j) { const unsigned c = xb_ld(&bar[XB_XCNT(j)]); sum += c; cnt += (c > 0u) ? 1u : 0u; mine = (j == x) ? c : mine; }
        if (sum == G) break;
        __builtin_amdgcn_s_sleep(1);
        if ((++sp & 255u) == 0u) { if (xb_ld(&bar[XB_TMO])) break; if (sp > XB_SPIN_CAP) { atomicAdd(&bar[XB_TMO], 1u); break; } }
    }
    nloc = mine > 0u ? mine : 1u; nx = cnt > 0u ? cnt : 1u;
}
__device__ __forceinline__ void xcd_barrier(const XcdBarrier& b) {
    asm volatile("s_waitcnt vmcnt(0)" ::: "memory");
    __syncthreads();
    if (threadIdx.x == 0) {
        unsigned* bar = b.bar;
        __builtin_amdgcn_s_waitcnt(0);
        unsigned nloc = b.st[0], nx = b.st[1];
        if (nloc == 0u) { xcd_barrier_complete(bar, b.x, nloc, nx); b.st[0] = nloc; b.st[1] = nx; }
        const unsigned old = xb_add(&bar[XB_XSUB(b.x)], 1u);
        const unsigned gen = old / nloc;
        if (old + 1u == (gen + 1u) * nloc) {
            __builtin_amdgcn_fence(__ATOMIC_RELEASE, "agent");
            asm volatile("s_waitcnt vmcnt(0)" ::: "memory");
            const unsigned og = xb_add(&bar[XB_TOP], 1u);
            const unsigned tg = og / nx;
            if (og + 1u == (tg + 1u) * nx) xb_add(&bar[XB_TOPGEN], 1u);
            else XB_SPIN(xb_ld(&bar[XB_TOPGEN]) == tg, bar);
            __builtin_amdgcn_fence(__ATOMIC_ACQUIRE, "agent");
            xb_add(&bar[XB_XGEN(b.x)], 1u);
            asm volatile("s_waitcnt vmcnt(0)" ::: "memory");
        } else {
            XB_SPIN(xb_ld(&bar[XB_XGEN(b.x)]) == gen, bar);
            __builtin_amdgcn_fence(__ATOMIC_ACQUIRE, "agent");
            asm volatile("s_waitcnt vmcnt(0)" ::: "memory");
        }
    }
    __syncthreads();
}

struct Args { const void* in[23]; float* out; unsigned char* ws; int ph_lo, ph_hi; };
enum { IN_X = 0, IN_P, IN_POS, IN_MIXN, IN_AWIN, IN_AVG, IN_AWS, IN_ABS, IN_AWOUT, IN_BWIN, IN_BWOUT, IN_FFNN, IN_WG, IN_BG, IN_WE, IN_BE,
       IN_W1, IN_W3, IN_W2, IN_PLEN, IN_PLEG, IN_PLEP, IN_FINN };

struct Ctx {
    LAS unsigned char* lds;
    int tid, lane, wave, vb, nb, half;
    LAS unsigned char* ldsp;
    const __attribute__((address_space(4))) Args* a;
    unsigned char* ws;
};

template <int BK> struct TileK { static constexpr int NP = (BK == 64) ? 4 : 2; static constexpr int TB = 128 * BK * 2; };

template <int BK>
__device__ __forceinline__ void stage_tile(LAS unsigned char* tile, const bf16_t* const (&rp)[TileK<BK>::NP], int k0, int tid) {
    const int lc = (BK == 64) ? ((tid & 7) ^ ((tid >> 3) & 7)) : ((tid & 3) ^ ((tid >> 3) & 3));
#pragma unroll
    for (int p = 0; p < TileK<BK>::NP; ++p)
        __builtin_amdgcn_global_load_lds((const unsigned*)(rp[p] + k0 + lc * 8), (LAS unsigned*)(tile + p * 4096 + tid * 16), 16, 0, 0);
}
template <int BK>
__device__ __forceinline__ void rows_regular(const bf16_t* (&rp)[TileK<BK>::NP], const bf16_t* base, size_t ld, int tid) {
#pragma unroll
    for (int p = 0; p < TileK<BK>::NP; ++p) { const int r = (BK == 64) ? (p * 32 + (tid >> 3)) : (p * 64 + (tid >> 2)); rp[p] = base + (size_t)r * ld; }
}
template <int BK>
__device__ __forceinline__ int frag_off(int row, int ks, int fq) {
    return (BK == 64) ? (row * 128 + (((ks * 4 + fq) ^ (row & 7)) << 4)) : (row * 64 + ((fq ^ ((row >> 1) & 3)) << 4));
}

template <int BK, int NBOP, bool SWAP, bool FP8 = false>
__device__ __forceinline__ void gemm_loop(const Ctx& c, const bf16_t* const (&ap)[TileK<BK>::NP], const bf16_t* const (&b0p)[TileK<BK>::NP], const bf16_t* const (&b1p)[TileK<BK>::NP],
                                          int K, f32x4 (&acc0)[4][4], f32x4 (&acc1)[4][4]) {
    constexpr int TB = TileK<BK>::TB, SB = (1 + NBOP) * TB;
    static_assert(2 * SB <= LDS_MAIN, "lds");
    const int nk = K / BK, tid = c.tid;
    const int fr = c.lane & 15, fq = c.lane >> 4, wr = c.wave >> 1, wc = c.wave & 1;
    LAS unsigned char* lds = c.lds;
    stage_tile<BK>(lds, ap, 0, tid); stage_tile<BK>(lds + TB, b0p, 0, tid);
    if (NBOP == 2) stage_tile<BK>(lds + 2 * TB, b1p, 0, tid);
    for (int kt = 0; kt < nk; ++kt) {
        VM_WAIT();
        __syncthreads();
        LAS unsigned char* cur = lds + (kt & 1) * SB;
        if (kt + 1 < nk) {
            LAS unsigned char* nxt = lds + ((kt + 1) & 1) * SB;
            stage_tile<BK>(nxt, ap, (kt + 1) * BK, tid); stage_tile<BK>(nxt + TB, b0p, (kt + 1) * BK, tid);
            if (NBOP == 2) stage_tile<BK>(nxt + 2 * TB, b1p, (kt + 1) * BK, tid);
        }
#pragma unroll
        for (int ks = 0; ks < BK / 32; ++ks) {
            bf16x8 af[4], bf0[4], bf1[4];
#pragma unroll
            for (int m = 0; m < 4; ++m) af[m] = *(const LAS bf16x8*)(cur + frag_off<BK>(wr * 64 + m * 16 + fr, ks, fq));
#pragma unroll
            for (int n = 0; n < 4; ++n) bf0[n] = *(const LAS bf16x8*)(cur + TB + frag_off<BK>(wc * 64 + n * 16 + fr, ks, fq));
            if (NBOP == 2) {
#pragma unroll
                for (int n = 0; n < 4; ++n) bf1[n] = *(const LAS bf16x8*)(cur + 2 * TB + frag_off<BK>(wc * 64 + n * 16 + fr, ks, fq));
            }
#pragma unroll
            for (int m = 0; m < 4; ++m)
#pragma unroll
                for (int n = 0; n < 4; ++n) {
                    if (FP8) {
                        const i64x2 a2 = __builtin_bit_cast(i64x2, af[m]), b2 = __builtin_bit_cast(i64x2, bf0[n]);
                        if (SWAP) { acc0[m][n] = __builtin_amdgcn_mfma_f32_16x16x32_fp8_fp8(b2.x, a2.x, acc0[m][n], 0, 0, 0); acc0[m][n] = __builtin_amdgcn_mfma_f32_16x16x32_fp8_fp8(b2.y, a2.y, acc0[m][n], 0, 0, 0); }
                        else      { acc0[m][n] = __builtin_amdgcn_mfma_f32_16x16x32_fp8_fp8(a2.x, b2.x, acc0[m][n], 0, 0, 0); acc0[m][n] = __builtin_amdgcn_mfma_f32_16x16x32_fp8_fp8(a2.y, b2.y, acc0[m][n], 0, 0, 0); }
                        continue;
                    }
                    if (SWAP) acc0[m][n] = __builtin_amdgcn_mfma_f32_16x16x32_bf16(bf0[n], af[m], acc0[m][n], 0, 0, 0);
                    else      acc0[m][n] = __builtin_amdgcn_mfma_f32_16x16x32_bf16(af[m], bf0[n], acc0[m][n], 0, 0, 0);
                    if (NBOP == 2) {
                        if (SWAP) acc1[m][n] = __builtin_amdgcn_mfma_f32_16x16x32_bf16(bf1[n], af[m], acc1[m][n], 0, 0, 0);
                        else      acc1[m][n] = __builtin_amdgcn_mfma_f32_16x16x32_bf16(af[m], bf1[n], acc1[m][n], 0, 0, 0);
                    }
                }
        }
    }
    __syncthreads();
}
__device__ __forceinline__ void zero_acc(f32x4 (&acc)[4][4]) {
#pragma unroll
    for (int m = 0; m < 4; ++m)
#pragma unroll
        for (int n = 0; n < 4; ++n) acc[m][n] = (f32x4){0.f, 0.f, 0.f, 0.f};
}
__device__ __forceinline__ void map_unit(int u, int nnt, int& mt, int& nt) { const int per = 8 * nnt, band = u / per, r = u - band * per; nt = r >> 3; mt = band * 8 + (r & 7); }


__device__ __forceinline__ float gelu_tanh(float x) {
    const float y2 = 1.5957691216057308f * (x + 0.044715f * x * x * x);
    return x * __builtin_amdgcn_rcpf(1.f + __expf(-y2));
}
__device__ __forceinline__ float sigmoidf_(float x) { return __builtin_amdgcn_rcpf(1.f + __expf(-x)); }

__device__ __forceinline__ void row_load(const float* row, int lane, f32x4 (&v)[4]) {
#pragma unroll
    for (int j = 0; j < 4; ++j) v[j] = ((const f32x4*)row)[lane + 64 * j];
}
__device__ __forceinline__ float row_sumsq(const f32x4 (&v)[4]) {
    float s = 0.f;
#pragma unroll
    for (int j = 0; j < 4; ++j) s += (v[j].x * v[j].x + v[j].y * v[j].y) + (v[j].z * v[j].z + v[j].w * v[j].w);
    return wave_sum(s);
}
__device__ __forceinline__ void gain_load(const float* gain, int lane, f32x4 (&g)[4]) {
#pragma unroll
    for (int j = 0; j < 4; ++j) g[j] = ((const f32x4*)gain)[lane + 64 * j];
}
__device__ __forceinline__ void row_store_norm_bf16(bf16_t* orow, int lane, const f32x4 (&v)[4], float r, const f32x4 (&gv)[4]) {
#pragma unroll
    for (int j = 0; j < 4; ++j) {
        const f32x4 g = gv[j];
        u32x2 o; o.x = pk_bf16(v[j].x * r * g.x, v[j].y * r * g.y); o.y = pk_bf16(v[j].z * r * g.z, v[j].w * r * g.w);
        ((u32x2*)orow)[lane + 64 * j] = o;
    }
}

__device__ __forceinline__ unsigned pk_fp8x4(float a, float b, float c_, float d);
__device__ __forceinline__ void row_store_norm_fp8(unsigned char* orow, int lane, const f32x4 (&v)[4], float r, const f32x4 (&gv)[4]) {
#pragma unroll
    for (int j = 0; j < 4; ++j) ((unsigned*)orow)[lane + 64 * j] = pk_fp8x4(v[j].x * r * gv[j].x, v[j].y * r * gv[j].y, v[j].z * r * gv[j].z, v[j].w * r * gv[j].w);
}
constexpr int TR_SCR = 64 * 136;
__device__ __forceinline__ void transpose_item(const float* W, int K, int N, int nvalid, int ldw, bf16_t* WT, LAS unsigned char* scr, int item, int lane) {
    const int nblk = N / 64, kb = item / nblk, nb = item - kb * nblk, k0 = 64 * kb, n0 = 64 * nb;
    const int n = n0 + 4 * (lane & 15);
    const int nc_ = (n < nvalid) ? n : 0; const float keep = (n < nvalid) ? 1.f : 0.f;
    f32x4 v[16];
#pragma unroll
    for (int i = 0; i < 16; ++i) v[i] = *(const f32x4*)(W + (size_t)(k0 + 4 * i + (lane >> 4)) * ldw + nc_);
#pragma unroll
    for (int i = 0; i < 16; ++i) {
        const int kk = 4 * i + (lane >> 4);
        u32x2 o; o.x = pk_bf16(v[i].x * keep, v[i].y * keep); o.y = pk_bf16(v[i].z * keep, v[i].w * keep);
        *(LAS u32x2*)(scr + kk * 136 + (lane & 15) * 8) = o;
    }
    LDS_WAIT();
    const int cc = lane & 7;
#pragma unroll
    for (int j = 0; j < 8; ++j) {
        const int nn = (lane >> 3) + 8 * j; const LAS unsigned short* sp = (const LAS unsigned short*)(scr + (8 * cc) * 136 + nn * 2);
        u32x4 o;
        o.x = (unsigned)sp[0 * 68] | ((unsigned)sp[1 * 68] << 16); o.y = (unsigned)sp[2 * 68] | ((unsigned)sp[3 * 68] << 16);
        o.z = (unsigned)sp[4 * 68] | ((unsigned)sp[5 * 68] << 16); o.w = (unsigned)sp[6 * 68] | ((unsigned)sp[7 * 68] << 16);
        *(u32x4*)(WT + (size_t)(n0 + nn) * K + k0 + 8 * cc) = o;
    }
    LDS_WAIT();
}

__device__ __forceinline__ unsigned pk_fp8x4(float a, float b, float c_, float d) {
    a = fminf(fmaxf(a, -448.f), 448.f); b = fminf(fmaxf(b, -448.f), 448.f); c_ = fminf(fmaxf(c_, -448.f), 448.f); d = fminf(fmaxf(d, -448.f), 448.f);
    int p = __builtin_amdgcn_cvt_pk_fp8_f32(a, b, 0, false);
    p = __builtin_amdgcn_cvt_pk_fp8_f32(c_, d, p, true);
    return (unsigned)p;
}
__device__ __forceinline__ unsigned pk_fp8x4_nc(float a, float b, float c_, float d) {
    int p = __builtin_amdgcn_cvt_pk_fp8_f32(a, b, 0, false);
    p = __builtin_amdgcn_cvt_pk_fp8_f32(c_, d, p, true);
    return (unsigned)p;
}
constexpr float W8_SCALE = 64.f, H8_SCALE = 4.f, O8_SCALE = 8.f;
__device__ __forceinline__ void transpose_item8(const float* W, int K, int N, unsigned char* WT, LAS unsigned char* scr, int item, int lane, int nvalid = 1 << 30, int ldw = 0) {
    const int nblk = N / 64, kb = item / nblk, nb = item - kb * nblk, k0 = 128 * kb, n0 = 64 * nb;
    const int n = n0 + 4 * (lane & 15), ld = ldw ? ldw : N, nc_ = (n < nvalid) ? n : 0; const float keep = (n < nvalid) ? W8_SCALE : 0.f;
#pragma unroll 2
    for (int h = 0; h < 2; ++h) {
        f32x4 v[16];
#pragma unroll
        for (int i = 0; i < 16; ++i) v[i] = *(const f32x4*)(W + (size_t)(k0 + 64 * h + 4 * i + (lane >> 4)) * ld + nc_);
#pragma unroll
        for (int i = 0; i < 16; ++i) { const int kk = 64 * h + 4 * i + (lane >> 4);
            *(LAS unsigned*)(scr + kk * 68 + (lane & 15) * 4) = pk_fp8x4_nc(v[i].x * keep, v[i].y * keep, v[i].z * keep, v[i].w * keep); }
    }
    LDS_WAIT();
    const int cc = lane & 7;
#pragma unroll
    for (int j = 0; j < 8; ++j) {
        const int nn = (lane >> 3) + 8 * j; const LAS unsigned char* sp = scr + (16 * cc) * 68 + nn;
        unsigned w[4];
#pragma unroll
        for (int q = 0; q < 4; ++q) w[q] = (unsigned)sp[(4 * q + 0) * 68] | ((unsigned)sp[(4 * q + 1) * 68] << 8) | ((unsigned)sp[(4 * q + 2) * 68] << 16) | ((unsigned)sp[(4 * q + 3) * 68] << 24);
        u32x4 o = {w[0], w[1], w[2], w[3]};
        *(u32x4*)(WT + (size_t)(n0 + nn) * K + k0 + 16 * cc) = o;
    }
    LDS_WAIT();
}
__device__ __forceinline__ void convert_moe_item(const Ctx& c, int l, int it, LAS unsigned char* scr) {
    const float* w1 = (const float*)c.a->in[IN_W1] + (size_t)l * NE * D * DE;
    const float* w3 = (const float*)c.a->in[IN_W3] + (size_t)l * NE * D * DE;
    const float* w2 = (const float*)c.a->in[IN_W2] + (size_t)l * NE * DE * D;
    unsigned char* W3 = c.ws + WS_W3; unsigned char* W2 = c.ws + WS_W2;
    const int e = it / 192, r = it - e * 192;
    if (r < 64)       transpose_item8(w1 + (size_t)e * D * DE, D, DE, W3 + ((size_t)e * 1024 + ((r & 7) >> 1) * 128) * D, scr, r, c.lane);
    else if (r < 128) transpose_item8(w3 + (size_t)e * D * DE, D, DE, W3 + ((size_t)e * 1024 + ((r & 7) >> 1) * 128 + 128) * D, scr, r - 64, c.lane);
    else              transpose_item8(w2 + (size_t)e * DE * D, DE, D, W2 + (size_t)e * D * DE, scr, r - 128, c.lane);
}
__device__ __forceinline__ void convert_moe_layer(const Ctx& c, int l) {
    LAS unsigned char* scr = c.lds + c.wave * TR_SCR;
    const int gw = c.vb * 4 + c.wave, ngw = c.nb * 4;
    for (int it = gw; it < NE * 192; it += ngw) convert_moe_item(c, l, it, scr);
}

__device__ __forceinline__ void phase_prep(const Ctx& c) {
    const __attribute__((address_space(4))) Args& a = *c.a;
    LAS unsigned char* scr = c.lds + c.wave * TR_SCR;
    const int gw = c.vb * 4 + c.wave, ngw = c.nb * 4;
    constexpr int I_AIN = 16 * 64, I_AOUT = 32 * 16, I_PP = 4 * 16, I_BIN8 = 8 * 34, I_BOUT8 = 8 * 16, I_PG8 = 8 * 16, I_BINI = 16 * 10;
    constexpr int NIT = I_AIN + I_AOUT + 2 * I_PP + I_BIN8 + I_BOUT8 + 2 * I_PG8 + I_BINI;
    for (int it = gw; it < NIT; it += ngw) {
        int r = it;
        if (r < I_AIN) { transpose_item((const float*)a.in[IN_AWIN], D, 4096, 4096, 4096, (bf16_t*)(c.ws + WS_WAIN), scr, r, c.lane); continue; } r -= I_AIN;
        if (r < I_AOUT) { transpose_item((const float*)a.in[IN_AWOUT], GW, D, D, D, (bf16_t*)(c.ws + WS_WAOUT), scr, r, c.lane); continue; } r -= I_AOUT;
        if (r < 2 * I_PP) { const int l = r / I_PP; transpose_item((const float*)a.in[IN_PLEP] + (size_t)l * PLE * D, PLE, D, D, D, (bf16_t*)(c.ws + WS_WPROJ) + (size_t)l * D * PLE, scr, r - l * I_PP, c.lane); continue; } r -= 2 * I_PP;
        if (r < I_BIN8) { transpose_item8((const float*)a.in[IN_BWIN], D, BINP, c.ws + WS_WBIN, scr, r, c.lane, BIN, BIN); continue; } r -= I_BIN8;
        if (r < I_BOUT8) { transpose_item8((const float*)a.in[IN_BWOUT], D, D, c.ws + WS_WBOUT, scr, r, c.lane); continue; } r -= I_BOUT8;
        if (r < 2 * I_PG8) { const int l = r / I_PG8; transpose_item8((const float*)a.in[IN_PLEG] + (size_t)l * D * D, D, D, c.ws + WS_WGATE + (size_t)l * D * D, scr, r - l * I_PG8, c.lane); continue; } r -= 2 * I_PG8;
        transpose_item((const float*)a.in[IN_BWIN] + 1536, D, 640, BIN - 1536, BIN, (bf16_t*)(c.ws + WS_WBIN + 3 * MB), scr, r, c.lane);
    }
    convert_moe_layer(c, 0);
    const int gt = c.vb * NTH + c.tid, ngt = c.nb * NTH;
    { const float* p = (const float*)a.in[IN_P]; bf16_t* pb = (bf16_t*)(c.ws + WS_PBF);
      for (int i = gt; i < 2 * T * PLE / 8; i += ngt) {
          const f32x4 v0 = ((const f32x4*)p)[2 * i], v1 = ((const f32x4*)p)[2 * i + 1];
          u32x4 o; o.x = pk_bf16(v0.x, v0.y); o.y = pk_bf16(v0.z, v0.w); o.z = pk_bf16(v1.x, v1.y); o.w = pk_bf16(v1.z, v1.w);
          ((u32x4*)pb)[i] = o; } }
    { float* wr = (float*)(c.ws + WS_WR);
      for (int i = gt; i < 2 * D * 48; i += ngt) {
          const int l = i / (D * 48), r = i - l * D * 48, k = r / 48, o = r - k * 48;
          float w = 0.f;
          if (o < 4) w = ((const float*)a.in[IN_WG])[(size_t)l * D * 4 + k * 4 + o];
          else if (o < 36) w = ((const float*)a.in[IN_WE])[(size_t)l * D * 32 + k * 32 + (o - 4)];
          const int kh = k >> 9, q = (k >> 7) & 3, ii = (k >> 2) & 31, e = k & 3, nt = o >> 4, m = o & 15;
          wr[(size_t)l * D * 48 + ((((kh * 32 + ii) * 3 + nt) * 64 + q * 16 + m) << 2) + e] = w * ((const float*)a.in[IN_FFNN])[l * D + k]; } }
    if (c.vb == 0) for (int i = c.tid; i < 4 * NSUB * 32; i += 256) ((int*)(c.ws + WS_CNT))[i * CNT_STRIDE] = 0;
    f32x4 gv[4]; gain_load((const float*)a.in[IN_MIXN], c.lane, gv);
    for (int t = gw; t < T; t += ngw) {
        f32x4 v[4]; row_load((const float*)a.in[IN_X] + (size_t)t * D, c.lane, v);
        const float r = rsqrtf(row_sumsq(v) * (1.f / D) + EPS);
        row_store_norm_bf16((bf16_t*)(c.ws + WS_XN) + (size_t)t * D, c.lane, v, r, gv);
    }
}

namespace pg8 {
#define PG8_LAS __attribute__((address_space(3)))
typedef unsigned short bf16_t;
typedef short bf16x8 __attribute__((ext_vector_type(8)));
typedef float f32x4 __attribute__((ext_vector_type(4)));
typedef unsigned u32x4 __attribute__((ext_vector_type(4)));
constexpr int BM = 256, BK = 64, HALF = 128, HTB = HALF * BK * 2  , STAGE_BYTES = 8 * HTB, NXCD = 8, WGM = 8;

__host__ __device__ __forceinline__ int lds_byte(int r, int c) { const int st = (r >> 4) * 2 + (c >> 5), rr = r & 15, cc = c & 31, ob = rr * 64 + cc * 2; return st * 1024 + (ob ^ (((ob >> 9) & 1) << 5)); }
__host__ __device__ __forceinline__ void stage_rc(int b, int& R, int& C) { const int st = b / 1024, sb = b % 1024, swz = sb ^ (((sb >> 9) & 1) << 5); R = (st >> 1) * 16 + swz / 64; C = (st & 1) * 32 + (swz % 64) / 2; }
__host__ __device__ __forceinline__ int perm32(int rho) { const int n = rho >> 4, i = rho & 15; return 8 * (i >> 2) + 4 * n + (i & 3); }

struct Unit { int pm, pn, aux; };
struct Gemm { const bf16_t* A; const bf16_t* Bt; int M, N, K; };

struct StaticOrder {
    int nM, nN, nwg, G, c;
    __host__ __device__ void init(int M, int N, int G_, int c_) { nM = M / BM; nN = N / BM; nwg = nM * nN; G = G_; c = c_; }
    __host__ __device__ bool next(int i, Unit& u) const {
        const long L = (long)i * G + c; if (L >= nwg) return false;
        int wgid = (int)L; { const int q = nwg / NXCD, r = nwg % NXCD, xcd = wgid % NXCD, off = wgid / NXCD; wgid = (xcd < r ? xcd * (q + 1) : r * (q + 1) + (xcd - r) * q) + off; }
        const int nig = WGM * nN, gid = wgid / nig, fm = gid * WGM, gsz = (nM - fm) < WGM ? (nM - fm) : WGM;
        u.pm = fm + ((wgid % nig) % gsz); u.pn = (wgid % nig) / gsz; return true;
    }
    __device__ __forceinline__ void a_ready(const Unit&) const {}
    __device__ __forceinline__ void done(const Unit&) const {}
};


template <class Epi, class Sched, bool ALIGN_EPI = false, bool SP2 = false, bool FP8 = false, bool GATHER = false>
__device__ __forceinline__ void gemm_phase(PG8_LAS unsigned char* lds, const Gemm g, const Sched& S, const Epi& E, const PG8_LAS unsigned* gtab = nullptr) {
    int tido_ = threadIdx.x; asm volatile("" : "+v"(tido_));
    const int tid = tido_, wid = __builtin_amdgcn_readfirstlane(tid >> 6), lane = tid & 63, wr = wid >> 2, wc = wid & 3, fr = lane & 15, fq = lane >> 4;
    int Kop_ = g.K; asm volatile("" : "+s"(Kop_));
    const int K = Kop_, nt = K / BK;
    unsigned voffA[2], voffB[2];
#pragma unroll
    for (int i = 0; i < 2; ++i) { int R, C; stage_rc(tid * 16 + i * 8192, R, C); const int Rb = Epi::PERM ? ((R & ~31) + perm32(R & 31)) : R;
        voffA[i] = GATHER ? (unsigned)(R * 4 + C * 2 * 65536) : (unsigned)(R * K + C) * 2u; voffB[i] = (unsigned)(Rb * K + C) * 2u; }
    unsigned gA[2][2] = {{0u, 0u}, {0u, 0u}};
#define PG8_GLOAD(slot) do { _Pragma("unroll") for (int h_ = 0; h_ < 2; ++h_) _Pragma("unroll") for (int i_ = 0; i_ < 2; ++i_) \
        gA[h_][i_] = *(const PG8_LAS unsigned*)((const PG8_LAS unsigned char*)gtab + (slot) * 1024 + h_ * 512 + (voffA[i_] & 0xffffu)) + (voffA[i_] >> 16); } while (0)
#define PG8_STA(bufoff, base, h) do { if constexpr (GATHER) PG8_STAGE(bufoff, base, gA[h]); else PG8_STAGE(bufoff, (base) + (h) * hstep, voffA); } while (0)
    const size_t kstep = (size_t)(BK * 2);
    const size_t hstep = (size_t)HALF * K * 2;
    const size_t tstep = 2 * hstep;
    const unsigned ldsw = (unsigned)wid * 1024u;
    const int aoff = lds_byte(wr * 64 + fr, fq * 8), boff = lds_byte(wc * 32 + fr, fq * 8);
#define PG8_SA(b, h) (((b) * 2 + (h)) * HTB)
#define PG8_SB(b, h) ((4 + (b) * 2 + (h)) * HTB)
#define PG8_STAGE(bufoff, gbase, voff) do { _Pragma("unroll") for (int _i = 0; _i < 2; ++_i) \
        __builtin_amdgcn_global_load_lds((const unsigned*)((const char*)(gbase) + (voff)[_i]), (PG8_LAS unsigned*)(lds + (bufoff) + ldsw + _i * 8192), 16, 0, 0); } while (0)
#define PG8_LDA(dst, b, h) do { _Pragma("unroll") for (int m = 0; m < 4; ++m) dst[m] = __builtin_shufflevector(*(const PG8_LAS i32x4*)(lds + PG8_SA(b, h) + aoff + m * 2048), *(const PG8_LAS i32x4*)(lds + PG8_SA(b, h) + aoff + m * 2048 + 1024), 0, 1, 2, 3, 4, 5, 6, 7); } while (0)
#define PG8_LDB(dst, b, h) do { _Pragma("unroll") for (int n = 0; n < 2; ++n) dst[n] = __builtin_shufflevector(*(const PG8_LAS i32x4*)(lds + PG8_SB(b, h) + boff + n * 2048), *(const PG8_LAS i32x4*)(lds + PG8_SB(b, h) + boff + n * 2048 + 1024), 0, 1, 2, 3, 4, 5, 6, 7); } while (0)
#define PG8_MMA(ai, bj, At, Bt) do { __builtin_amdgcn_s_setprio(1); _Pragma("unroll") for (int m = 0; m < 4; ++m) _Pragma("unroll") for (int n = 0; n < 2; ++n) { \
        if constexpr (FP8)      \
            asm volatile("v_mfma_scale_f32_16x16x128_f8f6f4 %0, %1, %2, %0, %3, %3 op_sel_hi:[0,0,0]" : "+v"(acc[ai][bj][m][n]) : "v"(Bt[n]), "v"(At[m]), "v"(one8_)); \
        else { acc[ai][bj][m][n] = __builtin_amdgcn_mfma_f32_16x16x32_bf16(__builtin_bit_cast(bf16x8, __builtin_shufflevector(Bt[n], Bt[n], 0, 1, 2, 3)), __builtin_bit_cast(bf16x8, __builtin_shufflevector(At[m], At[m], 0, 1, 2, 3)), acc[ai][bj][m][n], 0, 0, 0); \
               acc[ai][bj][m][n] = __builtin_amdgcn_mfma_f32_16x16x32_bf16(__builtin_bit_cast(bf16x8, __builtin_shufflevector(Bt[n], Bt[n], 4, 5, 6, 7)), __builtin_bit_cast(bf16x8, __builtin_shufflevector(At[m], At[m], 4, 5, 6, 7)), acc[ai][bj][m][n], 0, 0, 0); } } __builtin_amdgcn_s_setprio(0); } while (0)
#define PG8_WAIT_V(n) asm volatile("s_waitcnt vmcnt(" #n ")" ::: "memory")
#define PG8_WAIT_L(n) asm volatile("s_waitcnt lgkmcnt(" #n ")" ::: "memory")
#define PG8_BAR __builtin_amdgcn_s_barrier()
#define PG8_SCHED __builtin_amdgcn_sched_barrier(0)
    Unit cur, nxt; int ui = 0;
    if (!S.next(0, cur)) return;
    int one8_ = 0x7f7f7f7f; asm volatile("" : "+v"(one8_));
    f32x4 acc[2][2][4][2];
    float zf_ = 0.f; asm volatile("" : "+v"(zf_));
#pragma unroll
    for (int a = 0; a < 2; ++a)
#pragma unroll
        for (int b = 0; b < 2; ++b)
#pragma unroll
            for (int m = 0; m < 4; ++m)
#pragma unroll
                for (int n = 0; n < 2; ++n) acc[a][b][m][n] = (f32x4){zf_, zf_, zf_, zf_};
    i32x8 At[4], B0[2], B1[2];
    const char* cA = (const char*)g.A + (GATHER ? (size_t)0 : (size_t)cur.pm * tstep); const char* cB = (const char*)g.Bt + (size_t)cur.pn * tstep;
    S.a_ready(cur);
    if constexpr (GATHER) PG8_GLOAD(cur.pm);
    if constexpr (SP2) {
        PG8_STAGE(PG8_SB(0, 0), cB, voffB); PG8_STAGE(PG8_SB(0, 1), cB + hstep, voffB); PG8_STA(PG8_SA(0, 0), cA, 0); PG8_STA(PG8_SA(0, 1), cA, 1);
        if (wr == 1) PG8_BAR;
        PG8_WAIT_V(2); PG8_BAR;
        PG8_STAGE(PG8_SB(1, 0), cB + kstep, voffB); PG8_STA(PG8_SA(1, 0), cA + kstep, 0); PG8_STAGE(PG8_SB(1, 1), cB + hstep + kstep, voffB);
        PG8_WAIT_V(6); PG8_BAR;
    } else {
        PG8_STAGE(PG8_SB(0, 0), cB, voffB); PG8_STA(PG8_SA(0, 0), cA, 0); PG8_STAGE(PG8_SB(0, 1), cB + hstep, voffB); PG8_STA(PG8_SA(0, 1), cA, 1);
        if (wr == 1) PG8_BAR;
        PG8_WAIT_V(4); PG8_BAR;
        PG8_STAGE(PG8_SB(1, 0), cB + kstep, voffB); PG8_STA(PG8_SA(1, 0), cA + kstep, 0); PG8_STAGE(PG8_SB(1, 1), cB + hstep + kstep, voffB);
        PG8_WAIT_V(6); PG8_BAR;
    }
    for (;;) {
        const bool has_next = S.next(ui + 1, nxt);
        const char* nA = (has_next && !GATHER) ? (const char*)g.A + (size_t)nxt.pm * tstep : cA; const char* nB = has_next ? (const char*)g.Bt + (size_t)nxt.pn * tstep : cB;
        for (int t = 0; t < nt; t += 2) {
            const bool last = (t == nt - 2);
            const char* a1 = cA + (size_t)(t + 1) * kstep;
            const char* a2 = last ? nA : cA + (size_t)(t + 2) * kstep; const char* b2 = last ? nB : cB + (size_t)(t + 2) * kstep;
            const char* a3 = a2 + kstep; const char* b3 = b2 + kstep;
            if (last && has_next) S.a_ready(nxt);
            if constexpr (SP2) {
            PG8_LDB(B0, 0, 0); PG8_LDB(B1, 0, 1); PG8_SCHED; PG8_LDA(At, 0, 0); PG8_STA(PG8_SA(1, 1), a1, 1);
            if constexpr (GATHER) { if (last && has_next) PG8_GLOAD(nxt.pm); }
            PG8_WAIT_V(8); PG8_WAIT_L(0); PG8_BAR; PG8_MMA(0, 0, At, B0); PG8_MMA(0, 1, At, B1); PG8_BAR; PG8_SCHED;
            PG8_LDA(At, 0, 1); PG8_STAGE(PG8_SB(0, 0), b2, voffB); PG8_STAGE(PG8_SB(0, 1), b2 + hstep, voffB); PG8_STA(PG8_SA(0, 0), a2, 0);
            PG8_WAIT_V(8); PG8_WAIT_L(0); PG8_BAR; PG8_MMA(1, 0, At, B0); PG8_MMA(1, 1, At, B1); PG8_BAR; PG8_SCHED;
            PG8_LDB(B0, 1, 0); PG8_LDB(B1, 1, 1); PG8_SCHED; PG8_LDA(At, 1, 0); PG8_STA(PG8_SA(0, 1), a2, 1);
            PG8_WAIT_V(8); PG8_WAIT_L(0); PG8_BAR; PG8_MMA(0, 0, At, B0); PG8_MMA(0, 1, At, B1); PG8_BAR; PG8_SCHED;
            PG8_LDA(At, 1, 1); PG8_STAGE(PG8_SB(1, 0), b3, voffB); PG8_STAGE(PG8_SB(1, 1), b3 + hstep, voffB); PG8_STA(PG8_SA(1, 0), a3, 0);
            PG8_WAIT_V(8); PG8_WAIT_L(0); PG8_BAR; PG8_MMA(1, 0, At, B0); PG8_MMA(1, 1, At, B1); PG8_BAR; PG8_SCHED;
            } else {
            static_assert(SP2 || !GATHER, "GATHER is wired into the SP2 loop only");
            PG8_LDB(B0, 0, 0); PG8_SCHED; PG8_LDA(At, 0, 0); PG8_STAGE(PG8_SA(1, 1), a1 + hstep, voffA);
            PG8_WAIT_L(8); PG8_BAR; PG8_WAIT_L(0); PG8_MMA(0, 0, At, B0); PG8_BAR; PG8_SCHED;
            PG8_LDB(B1, 0, 1); PG8_STAGE(PG8_SB(0, 0), b2, voffB);
            PG8_BAR; PG8_WAIT_L(0); PG8_MMA(0, 1, At, B1); PG8_BAR;
            PG8_LDA(At, 0, 1); PG8_STAGE(PG8_SA(0, 0), a2, voffA);
            PG8_BAR; PG8_WAIT_L(0); PG8_MMA(1, 0, At, B0); PG8_BAR; PG8_SCHED;
            PG8_STAGE(PG8_SB(0, 1), b2 + hstep, voffB);
            PG8_WAIT_V(6); PG8_BAR; PG8_MMA(1, 1, At, B1); PG8_BAR;
            PG8_LDB(B0, 1, 0); PG8_SCHED; PG8_LDA(At, 1, 0); PG8_STAGE(PG8_SA(0, 1), a2 + hstep, voffA);
            PG8_WAIT_L(8); PG8_BAR; PG8_WAIT_L(0); PG8_MMA(0, 0, At, B0); PG8_BAR; PG8_SCHED;
            PG8_LDB(B1, 1, 1); PG8_STAGE(PG8_SB(1, 0), b3, voffB);
            PG8_BAR; PG8_WAIT_L(0); PG8_MMA(0, 1, At, B1); PG8_BAR;
            PG8_LDA(At, 1, 1); PG8_STAGE(PG8_SA(1, 0), a3, voffA);
            PG8_BAR; PG8_WAIT_L(0); PG8_MMA(1, 0, At, B0); PG8_BAR; PG8_SCHED;
            PG8_STAGE(PG8_SB(1, 1), b3 + hstep, voffB);
            PG8_WAIT_V(6); PG8_BAR; PG8_MMA(1, 1, At, B1); PG8_BAR;
            }
        }
        if constexpr (ALIGN_EPI) { if (wr == 0) PG8_BAR; }
        if constexpr (FP8) asm volatile("s_nop 15\n\ts_nop 15" ::: "memory");
        if constexpr (!Epi::AFTER_DRAIN) { int le_ = lane; asm volatile("" : "+v"(le_));
            E(acc, cur, wr, wc, le_ & 15, le_ >> 4); S.done(cur); }
        if (!has_next) break;
        asm volatile("v_mov_b32 %0, 0" : "=v"(zf_));
#pragma unroll
        for (int a = 0; a < 2; ++a)
#pragma unroll
            for (int b = 0; b < 2; ++b)
#pragma unroll
                for (int m = 0; m < 4; ++m)
#pragma unroll
                    for (int n = 0; n < 2; ++n) acc[a][b][m][n] = (f32x4){zf_, zf_, zf_, zf_};
        cur = nxt; cA = nA; cB = nB; ++ui;
        if constexpr (ALIGN_EPI) { if (wr == 1) PG8_BAR; }
    }
    PG8_WAIT_V(0);
    if constexpr (!ALIGN_EPI) { if (wr == 0) PG8_BAR; }
    PG8_BAR;
    if constexpr (Epi::AFTER_DRAIN) { E.fused(acc, cur, wr, wc, fr, fq, lds, wid, lane); S.done(cur); }
#undef PG8_SA
#undef PG8_STA
#undef PG8_GLOAD
#undef PG8_SB
#undef PG8_STAGE
#undef PG8_LDA
#undef PG8_LDB
#undef PG8_MMA
#undef PG8_WAIT_V
#undef PG8_WAIT_L
#undef PG8_BAR
#undef PG8_SCHED
}

}

struct EpiA1U {
    static constexpr bool PERM = true, AFTER_DRAIN = false;
    bf16_t* U;
    __device__ __forceinline__ void operator()(const pg8::f32x4 (&acc)[2][2][4][2], const pg8::Unit& u, int wr, int wc, int fr, int fq) const {
        bf16_t* up = U + (size_t)(u.pm * 256 + wr * 64 + fr) * GW + u.pn * 256 + wc * 32 + 8 * fq;
#pragma unroll
        for (int ai = 0; ai < 2; ++ai)
#pragma unroll
            for (int m = 0; m < 4; ++m)
#pragma unroll
                for (int bj = 0; bj < 2; ++bj) {
                    const f32x4 v0 = acc[ai][bj][m][0], v1 = acc[ai][bj][m][1];
                    u32x4 w; w.x = pk_bf16(gelu_tanh(v0.x), gelu_tanh(v0.y)); w.y = pk_bf16(gelu_tanh(v0.z), gelu_tanh(v0.w)); w.z = pk_bf16(gelu_tanh(v1.x), gelu_tanh(v1.y)); w.w = pk_bf16(gelu_tanh(v1.z), gelu_tanh(v1.w));
                    *(u32x4*)(up + (size_t)(ai * 128 + m * 16) * GW + bj * 128) = w;
                }
    }
};
struct EpiA1V {
    static constexpr bool PERM = true, AFTER_DRAIN = false;
    bf16_t* VT; float* VSS;
    __device__ __forceinline__ void operator()(const pg8::f32x4 (&acc)[2][2][4][2], const pg8::Unit& u, int wr, int wc, int fr, int fq) const {
        const int tok0 = u.pn * 256 + wc * 32 + 8 * fq;
        bf16_t* vp = VT + (size_t)(u.pm * 256 + wr * 64 + fr) * T + tok0;
        f32x4 ss[2][2];
#pragma unroll
        for (int bj = 0; bj < 2; ++bj) { ss[bj][0] = (f32x4){0.f, 0.f, 0.f, 0.f}; ss[bj][1] = (f32x4){0.f, 0.f, 0.f, 0.f}; }
#pragma unroll
        for (int ai = 0; ai < 2; ++ai)
#pragma unroll
            for (int m = 0; m < 4; ++m)
#pragma unroll
                for (int bj = 0; bj < 2; ++bj) {
                    f32x4 v0 = acc[ai][bj][m][0], v1 = acc[ai][bj][m][1];
                    v0.x = gelu_tanh(v0.x); v0.y = gelu_tanh(v0.y); v0.z = gelu_tanh(v0.z); v0.w = gelu_tanh(v0.w);
                    v1.x = gelu_tanh(v1.x); v1.y = gelu_tanh(v1.y); v1.z = gelu_tanh(v1.z); v1.w = gelu_tanh(v1.w);
                    ss[bj][0] += v0 * v0; ss[bj][1] += v1 * v1;
                    u32x4 w; w.x = pk_bf16(v0.x, v0.y); w.y = pk_bf16(v0.z, v0.w); w.z = pk_bf16(v1.x, v1.y); w.w = pk_bf16(v1.z, v1.w);
                    *(u32x4*)(vp + (size_t)(ai * 128 + m * 16) * T + bj * 128) = w;
                }
#pragma unroll
        for (int bj = 0; bj < 2; ++bj)
#pragma unroll
            for (int n = 0; n < 2; ++n) {
                f32x4 q = ss[bj][n];
#pragma unroll
                for (int o = 1; o < 16; o <<= 1) { q.x += __shfl_xor(q.x, o); q.y += __shfl_xor(q.y, o); q.z += __shfl_xor(q.z, o); q.w += __shfl_xor(q.w, o); }
                if (fr == 0) *(f32x4*)(VSS + (size_t)(u.pm * 2 + wr) * T + tok0 + bj * 128 + 4 * n) = q;
            }
    }
};
__device__ __forceinline__ void phase_a1(const Ctx& c) {
    const pg8::bf16_t* XN = (const pg8::bf16_t*)(c.ws + WS_XN); const pg8::bf16_t* W = (const pg8::bf16_t*)(c.ws + WS_WAIN);
    {
        pg8::Gemm g{XN, W, T, GW, D}; pg8::StaticOrder S; S.init(T, GW, (int)gridDim.x, (int)blockIdx.x);
        EpiA1U E{(bf16_t*)(c.ws + WS_U)};
        pg8::gemm_phase<EpiA1U, pg8::StaticOrder, false, true, false>(c.ldsp, g, S, E);
    }
    __syncthreads();
    {
        pg8::Gemm g{W + (size_t)GW * D, XN, GW, T, D}; pg8::StaticOrder S; S.init(GW, T, (int)gridDim.x, (int)blockIdx.x);
        EpiA1V E{(bf16_t*)(c.ws + WS_VT), (float*)(c.ws + WS_VSS)};
        pg8::gemm_phase<EpiA1V, pg8::StaticOrder, false, true, false>(c.ldsp, g, S, E);
    }
}

__device__ __forceinline__ void phase_a2(const Ctx& c, bool dry = false) {
    const __attribute__((address_space(4))) Args& a = *c.a;
    bf16_t* U = (bf16_t*)(c.ws + WS_U); const bf16_t* VT = (const bf16_t*)(c.ws + WS_VT); const float* VSS = (const float*)(c.ws + WS_VSS);
    const float* ws_ = (const float*)a.in[IN_AWS]; const float* bs_ = (const float*)a.in[IN_ABS]; const float* vg = (const float*)a.in[IN_AVG];
    const int fr = c.lane & 15, fq = c.lane >> 4, wr = c.wave >> 1, wc = c.wave & 1, tid = c.tid;
    LAS unsigned char* lds = c.lds;
    LAS float* rl = (LAS float*)(lds + LDS_MAIN);
    for (int u = c.vb; u < 128 * 8; u += c.nb) {
        const int ci = u >> 3, g = u & 7, tokbase = ci * 128;
        __syncthreads();
        if (tid < 128) {
            const float* p = VSS + tokbase + tid; float s = 0.f;
#pragma unroll
            for (int i = 0; i < 16; ++i) s += p[(size_t)i * T];
            rl[tid] = rsqrtf(s * (1.f / GW) + EPS);
        }
        __syncthreads();
        {
            const int t = tid >> 1, half = tid & 1;
            const float* wrow = ws_ + ((size_t)g * 128 + t) * 128 + half * 64;
#pragma unroll
            for (int cc = 0; cc < 8; ++cc) {
                const int s0 = half * 64 + cc * 8;
                u32x4 o;
                {
                    const f32x4 w0 = ((const f32x4*)wrow)[2 * cc], w1 = ((const f32x4*)wrow)[2 * cc + 1];
                    float e[8] = {w0.x, w0.y, w0.z, w0.w, w1.x, w1.y, w1.z, w1.w};
                    const f32x4 r0_ = *(const LAS f32x4*)(rl + s0), r1_ = *(const LAS f32x4*)(rl + s0 + 4);
                    const float rr[8] = {r0_.x, r0_.y, r0_.z, r0_.w, r1_.x, r1_.y, r1_.z, r1_.w};
#pragma unroll
                    for (int i = 0; i < 8; ++i) e[i] = (s0 + i <= t) ? e[i] * rr[i] : 0.f;
                    o.x = pk_bf16(e[0], e[1]); o.y = pk_bf16(e[2], e[3]); o.z = pk_bf16(e[4], e[5]); o.w = pk_bf16(e[6], e[7]);
                }
                *(LAS u32x4*)(lds + half * 16384 + t * 128 + ((cc ^ (t & 7)) << 4)) = o;
            }
        }
        for (int hn = 0; hn < 2; ++hn) {
            const int c0 = g * 256 + hn * 128;
            const bf16_t* bp[4]; rows_regular<64>(bp, VT + (size_t)c0 * T + tokbase, T, tid);
            stage_tile<64>(lds + 32768, bp, 0, tid); stage_tile<64>(lds + 32768 + 16384, bp, 64, tid);
            VM_WAIT();
            __syncthreads();
            f32x4 acc[4][4]; zero_acc(acc);
#pragma unroll 1
            for (int kh = 0; kh < 2; ++kh)
#pragma unroll 1
                for (int ks = 0; ks < 2; ++ks) {
                    bf16x8 af[4], bf[4];
#pragma unroll
                    for (int m = 0; m < 4; ++m) af[m] = *(const LAS bf16x8*)(lds + kh * 16384 + frag_off<64>(wr * 64 + m * 16 + fr, ks, fq));
#pragma unroll
                    for (int n = 0; n < 4; ++n) bf[n] = *(const LAS bf16x8*)(lds + 32768 + kh * 16384 + frag_off<64>(wc * 64 + n * 16 + fr, ks, fq));
#pragma unroll
                    for (int m = 0; m < 4; ++m)
#pragma unroll
                        for (int n = 0; n < 4; ++n) acc[m][n] = __builtin_amdgcn_mfma_f32_16x16x32_bf16(bf[n], af[m], acc[m][n], 0, 0, 0);
                }
            u32x2 uvv[4][4]; float bsvv[4];
#pragma unroll
            for (int m = 0; m < 4; ++m) { const int tl = wr * 64 + m * 16 + fr; bsvv[m] = bs_[g * 128 + tl];
#pragma unroll
                for (int n = 0; n < 4; ++n) uvv[m][n] = *(const u32x2*)(U + (size_t)(tokbase + tl) * GW + c0 + wc * 64 + n * 16 + fq * 4); }
#pragma unroll
            for (int m = 0; m < 4; ++m) {
                const int tl = wr * 64 + m * 16 + fr; const float bsv = bsvv[m];
#pragma unroll
                for (int n = 0; n < 4; ++n) {
                    const int ch = c0 + wc * 64 + n * 16 + fq * 4;
                    const f32x4 gn = *(const f32x4*)(vg + ch);
                    u32x2* up = (u32x2*)(U + (size_t)(tokbase + tl) * GW + ch);
                    const u32x2 uv = uvv[m][n]; const f32x4 v = acc[m][n];
                    u32x2 o;
                    o.x = pk_bf16(bf_lo(uv.x) * (gn.x * v.x + bsv), bf_hi(uv.x) * (gn.y * v.y + bsv));
                    o.y = pk_bf16(bf_lo(uv.y) * (gn.z * v.z + bsv), bf_hi(uv.y) * (gn.w * v.w + bsv));
                    if (dry) *(u32x2*)(c.ws + 440 * MB + ((size_t)(tokbase + tl) * GW + ch) * 2) = o; else *up = o;
                }
            }
            __syncthreads();
        }
    }
}

struct EpiResF32 {
    static constexpr bool PERM = false, AFTER_DRAIN = false;
    const float* base; float* out; int ldc; float ascale;
    __device__ __forceinline__ void operator()(const pg8::f32x4 (&acc)[2][2][4][2], const pg8::Unit& u, int wr, int wc, int fr, int fq) const {
#pragma unroll
        for (int ai = 0; ai < 2; ++ai)
#pragma unroll
            for (int m = 0; m < 4; ++m) {
                const size_t ro = (size_t)(u.pm * 256 + ai * 128 + wr * 64 + m * 16 + fr) * ldc + u.pn * 256 + wc * 32 + 4 * fq;
                f32x4 bv[2][2];
#pragma unroll
                for (int bj = 0; bj < 2; ++bj)
#pragma unroll
                    for (int n = 0; n < 2; ++n) bv[bj][n] = *(const f32x4*)(base + ro + bj * 128 + n * 16);
#pragma unroll
                for (int bj = 0; bj < 2; ++bj)
#pragma unroll
                    for (int n = 0; n < 2; ++n) *(f32x4*)(out + ro + bj * 128 + n * 16) = bv[bj][n] + acc[ai][bj][m][n] * ascale;
            }
    }
};
__device__ __forceinline__ void phase_a3(const Ctx& c) {
    pg8::Gemm g{(const pg8::bf16_t*)(c.ws + WS_U), (const pg8::bf16_t*)(c.ws + WS_WAOUT), T, D, GW};
    pg8::StaticOrder S; S.init(T, D, (int)gridDim.x, (int)blockIdx.x);
    EpiResF32 E{(const float*)c.a->in[IN_X], (float*)(c.ws + WS_H), D, 1.f};
    pg8::gemm_phase<EpiResF32, pg8::StaticOrder, false, true, false>(c.ldsp, g, S, E);
}

__device__ __forceinline__ void phase_route(const Ctx& c, int l, bool dry = false) {
    const __attribute__((address_space(4))) Args& a = *c.a;
    const float* H = (const float*)(c.ws + WS_H); bf16_t* XN = (bf16_t*)(c.ws + (dry ? 440 * MB : WS_XN));
    const float* wr_ = (const float*)(c.ws + WS_WR) + (size_t)l * D * 48;
    const float* gain = (const float*)a.in[IN_FFNN] + l * D;
    int* cnt = (int*)(c.ws + WS_CNT) + (size_t)(l + (dry ? 2 : 0)) * NSUB * 32 * CNT_STRIDE; int* list = (int*)(c.ws + (dry ? 480 * MB : WS_LIST)); float* gatel = (float*)(c.ws + (dry ? 484 * MB : WS_GATE)); int* tokslot = (int*)(c.ws + (dry ? 488 * MB : WS_TOKSLOT));
    LAS float* rl = (LAS float*)(c.lds);
    LAS float* lgl = (LAS float*)(c.lds + 256);
    const int lane = c.lane, w = c.wave;
    f32x4 gv[4]; gain_load(gain, lane, gv);
    for (int unit = c.vb; unit < T / 32; unit += c.nb) {
        const int tok0 = unit * 32;
        __syncthreads();
#pragma unroll 1
        for (int i0 = 0; i0 < 8; i0 += 4) {
            f32x4 v[4][4];
#pragma unroll
            for (int i = 0; i < 4; ++i) row_load(H + (size_t)(tok0 + w * 8 + i0 + i) * D, lane, v[i]);
#pragma unroll
            for (int i = 0; i < 4; ++i) {
                const int t = tok0 + w * 8 + i0 + i;
                const float r = rsqrtf(row_sumsq(v[i]) * (1.f / D) + EPS);
                if (lane == 0) rl[w * 8 + i0 + i] = r;
                row_store_norm_fp8(c.ws + (dry ? 440 * MB : WS_XN8) + (size_t)t * D, lane, v[i], r, gv);
            }
        }
#ifndef MK_DRYPART
#define MK_DRYPART 3
#endif
        if (!(dry && MK_DRYPART < 2))
        {
            const int th = w & 1, kh = w >> 1, m = lane & 15, q = lane >> 4;
            const f32x4* ap = (const f32x4*)(H + (size_t)(tok0 + 16 * th + m) * D + 512 * kh + 128 * q);
            const f32x4* bp = (const f32x4*)wr_ + (size_t)kh * 32 * 3 * 64 + lane;
            f32x4 acc[3]; acc[0] = acc[1] = acc[2] = (f32x4){0.f, 0.f, 0.f, 0.f};
#pragma unroll 1
            for (int i0 = 0; i0 < 32; i0 += 4) {
                f32x4 av[4], bv[4][3];
#pragma unroll
                for (int i = 0; i < 4; ++i) { av[i] = ap[i0 + i];
#pragma unroll
                    for (int nt = 0; nt < 3; ++nt) bv[i][nt] = bp[((i0 + i) * 3 + nt) * 64]; }
#pragma unroll
                for (int i = 0; i < 4; ++i)
#pragma unroll
                    for (int e = 0; e < 4; ++e)
#pragma unroll
                        for (int nt = 0; nt < 3; ++nt) acc[nt] = __builtin_amdgcn_mfma_f32_16x16x4f32(av[i][e], bv[i][nt][e], acc[nt], 0, 0, 0);
            }
#pragma unroll
            for (int nt = 0; nt < 3; ++nt)
#pragma unroll
                for (int j = 0; j < 4; ++j) lgl[(kh * 32 + th * 16 + 4 * q + j) * 48 + nt * 16 + m] = acc[nt][j];
        }
        __syncthreads();
        if (c.tid < 32 && !(dry && MK_DRYPART < 3)) {
            const int tt = c.tid, t = tok0 + tt; const float r = rl[tt];
            const float* bg = (const float*)a.in[IN_BG] + l * 4; const float* be = (const float*)a.in[IN_BE] + l * 32;
            float gl[4];
#pragma unroll
            for (int o = 0; o < 4; ++o) gl[o] = (lgl[tt * 48 + o] + lgl[(32 + tt) * 48 + o]) * r + bg[o];
            int gs = 0; float gm = gl[0];
#pragma unroll
            for (int o = 1; o < 4; ++o) if (gl[o] > gm) { gm = gl[o]; gs = o; }
            float gden = 0.f;
#pragma unroll
            for (int o = 0; o < 4; ++o) gden += __expf(gl[o] - gm);
            const float pg = 1.f / gden;
            float l1 = -INFINITY, l2 = -INFINITY; int i1 = 0, i2 = 0;
            for (int i = 0; i < 8; ++i) {
                const int o = 4 + gs * 8 + i;
                const float v = (lgl[tt * 48 + o] + lgl[(32 + tt) * 48 + o]) * r + be[gs * 8 + i];
                if (v > l1) { l2 = l1; i2 = i1; l1 = v; i1 = i; } else if (v > l2) { l2 = v; i2 = i; }
            }
            const float e2 = __expf(l2 - l1), inv = 1.f / (1.f + e2);
            const float g1 = pg * inv, g2 = pg * e2 * inv;
            const int ea = gs * 8 + i1, eb = gs * 8 + i2;
            const int sub = unit & (NSUB - 1);
            const int sa = sub * SUBCAP + atomicAdd(&cnt[(sub * 32 + ea) * CNT_STRIDE], 1), sb = sub * SUBCAP + atomicAdd(&cnt[(sub * 32 + eb) * CNT_STRIDE], 1);
            list[ea * T + sa] = t; gatel[ea * T + sa] = g1; tokslot[2 * t] = (ea << 16) | sa;
            list[eb * T + sb] = t; gatel[eb * T + sb] = g2; tokslot[2 * t + 1] = (eb << 16) | sb;
        }
    }
}

__device__ __forceinline__ void moe_table_build(const unsigned char* ws, int l, int tl, LAS int* pst, LAS int* cn, LAS int* sub) {
    if (tl < 32) {
        const int* cnt = (const int*)(ws + WS_CNT) + (size_t)l * NSUB * 32 * CNT_STRIDE + tl * CNT_STRIDE;
        int v[NSUB];
#pragma unroll
        for (int s2 = 0; s2 < NSUB; ++s2) v[s2] = cnt[(size_t)s2 * 32 * CNT_STRIDE];
        int acc = 0;
#pragma unroll
        for (int s2 = 0; s2 < NSUB; ++s2) { sub[tl * 33 + s2] = acc; acc += v[s2]; }
        sub[tl * 33 + NSUB] = acc; cn[tl] = acc;
        const int nb = (acc + 255) >> 8; int inc = nb;
#pragma unroll
        for (int o = 1; o < 32; o <<= 1) { const int t2 = __shfl_up(inc, o); if (tl >= o) inc += t2; }
        pst[tl] = inc - nb; if (tl == 31) pst[32] = inc;
    }
}
__device__ __forceinline__ void moe_table(const Ctx& c, int l, LAS int* pst, LAS int* cn, LAS int* sub) {
    __syncthreads();
    moe_table_build(c.ws, l, c.tid, pst, cn, sub);
    __syncthreads();
}
__device__ __forceinline__ void moe_table_wg(const Ctx& c, int l, LAS int* pst, LAS int* cn, LAS int* sub) {
    __syncthreads();
    moe_table_build(c.ws, l, (int)threadIdx.x, pst, cn, sub);
    __syncthreads();
}
__device__ __forceinline__ int moe_row_idx(LAS const int* sub, int e, int r) {
    int s2 = 0;
    for (int i = 1; i < NSUB; ++i) s2 = (sub[e * 33 + i] <= r) ? i : s2;
    return s2 * SUBCAP + (r - sub[e * 33 + s2]);
}
__device__ __forceinline__ int moe_find(LAS const int* pst, int mb) { int e = 0; for (int i = 1; i < 32; ++i) e = (pst[i] <= mb) ? i : e; return e; }

constexpr int MOE_LDS = 131072;
constexpr int CAPU = 16;
constexpr int MOE_SUB = MOE_LDS + 1024 + CAPU * 1024;
static_assert(MOE_SUB + 32 * 33 * 4 <= LDS_BYTES - 16, "moe lds");
__device__ __forceinline__ void moe_table_wg(const Ctx& c, int l, LAS int* pst, LAS int* cn) {
    __syncthreads();
    if (threadIdx.x == 0) {
        const int* cnt = (const int*)(c.ws + WS_CNT) + l * 32 * CNT_STRIDE; int acc = 0;
        for (int e = 0; e < 32; ++e) { const int n = cnt[e * CNT_STRIDE]; cn[e] = n; pst[e] = acc; acc += (n + 255) >> 8; }
        pst[32] = acc;
    }
    __syncthreads();
}
struct MoeOrder {
    LAS const int* pst; int nunits, G, c, i0; bool gather;
    __device__ __forceinline__ bool next(int i, pg8::Unit& u) const {
        if (i >= CAPU) return false;
        const long L = (long)(i0 + i) * G + c; if (L >= nunits) return false;
        int wgid = (int)L; { const int q = nunits / 8, r = nunits % 8, xcd = wgid % 8, off = wgid / 8; wgid = (xcd < r ? xcd * (q + 1) : r * (q + 1) + (xcd - r) * q) + off; }
        const int mb = wgid >> 2, e = __builtin_amdgcn_readfirstlane(moe_find(pst, mb));
        u.pm = gather ? i : mb; u.pn = e * 4 + (wgid & 3); u.aux = mb; return true;
    }
    __device__ __forceinline__ void a_ready(const pg8::Unit&) const {}
    __device__ __forceinline__ void done(const pg8::Unit&) const {}
};
struct EpiE1 {
    static constexpr bool PERM = true, AFTER_DRAIN = false;
    unsigned char* HM;
    __device__ __forceinline__ void operator()(const pg8::f32x4 (&acc)[2][2][4][2], const pg8::Unit& u, int wr, int wc, int fr, int fq) const {
        const float ws_ = 1.f / W8_SCALE;
        unsigned char* hp = HM + ((size_t)u.aux * 256 + wr * 64 + fr) * DE + (u.pn & 3) * 128 + wc * 32 + 8 * fq;
#pragma unroll
        for (int ai = 0; ai < 2; ++ai)
#pragma unroll
            for (int m = 0; m < 4; ++m) {
                u32x2 o;
#pragma unroll
                for (int n = 0; n < 2; ++n) {
                    const f32x4 x = acc[ai][0][m][n] * ws_, y = acc[ai][1][m][n] * (ws_ * H8_SCALE);
                    const unsigned w = pk_fp8x4(x.x * sigmoidf_(x.x) * y.x, x.y * sigmoidf_(x.y) * y.y, x.z * sigmoidf_(x.z) * y.z, x.w * sigmoidf_(x.w) * y.w);
                    if (n == 0) o.x = w; else o.y = w;
                }
                *(u32x2*)(hp + (size_t)(ai * 128 + m * 16) * DE) = o;
            }
    }
};
__device__ __forceinline__ void phase_e1(const Ctx& c, int l) {
    LAS int* pst = (LAS int*)(c.ldsp + MOE_LDS); LAS int* cn = pst + 40; LAS unsigned* gtab = (LAS unsigned*)(c.ldsp + MOE_LDS + 1024); LAS int* sub = (LAS int*)(c.ldsp + MOE_SUB);
    moe_table_wg(c, l, pst, cn, sub);
    const float* gatel = (const float*)(c.ws + WS_GATE); float* grow = (float*)(c.ws + WS_GROW);
    const int* list = (const int*)(c.ws + WS_LIST);
    pg8::Gemm g{(const pg8::bf16_t*)(c.ws + WS_XN8), (const pg8::bf16_t*)(c.ws + WS_W3), RPAD, 1024, D / 2};
    MoeOrder S{pst, __builtin_amdgcn_readfirstlane(pst[32]) * 4, (int)gridDim.x, (int)blockIdx.x, 0, true};
    EpiE1 E{c.ws + WS_HMID};
    for (;; S.i0 += CAPU) {
        pg8::Unit u; if (!S.next(0, u)) break;
        for (int i = 0; i < CAPU; ++i) {
            if (!S.next(i, u)) break;
            const int e = u.pn >> 2, row0 = (u.aux - __builtin_amdgcn_readfirstlane(pst[e])) * 256, count = __builtin_amdgcn_readfirstlane(cn[e]);
            if (threadIdx.x < 256) {
                const int r = row0 + (int)threadIdx.x, idx = moe_row_idx(sub, e, r < count ? r : row0);
                gtab[i * 256 + threadIdx.x] = (unsigned)list[e * T + idx] * (unsigned)D;
                if ((u.pn & 3) == 0) grow[(size_t)u.aux * 256 + threadIdx.x] = (r < count) ? gatel[e * T + idx] : 0.f;
            }
        }
        __syncthreads();
        pg8::gemm_phase<EpiE1, MoeOrder, false, true, true, true>(c.ldsp, g, S, E, gtab);
        __syncthreads();
    }
}
struct EpiE2 {
    static constexpr bool PERM = true, AFTER_DRAIN = false;
    bf16_t* Y; const float* grow;
    __device__ __forceinline__ void operator()(const pg8::f32x4 (&acc)[2][2][4][2], const pg8::Unit& u, int wr, int wc, int fr, int fq) const {
        const int mb = u.aux;
        bf16_t* yp = Y + ((size_t)mb * 256 + wr * 64 + fr) * D + (u.pn & 3) * 256 + wc * 32 + 8 * fq;
        const float* gp = grow + (size_t)mb * 256 + wr * 64 + fr;
#pragma unroll
        for (int ai = 0; ai < 2; ++ai) {
            float gt[4];
#pragma unroll
            for (int m = 0; m < 4; ++m) gt[m] = gp[ai * 128 + m * 16] * (1.f / (W8_SCALE * H8_SCALE));
#pragma unroll
            for (int m = 0; m < 4; ++m)
#pragma unroll
                for (int bj = 0; bj < 2; ++bj) {
                    const f32x4 v0 = acc[ai][bj][m][0] * gt[m], v1 = acc[ai][bj][m][1] * gt[m];
                    u32x4 w; w.x = pk_bf16(v0.x, v0.y); w.y = pk_bf16(v0.z, v0.w); w.z = pk_bf16(v1.x, v1.y); w.w = pk_bf16(v1.z, v1.w);
                    *(u32x4*)(yp + (size_t)(ai * 128 + m * 16) * D + bj * 128) = w;
                }
        }
    }
};
__device__ __forceinline__ void phase_e2(const Ctx& c, int l) {
    LAS int* pst = (LAS int*)(c.ldsp + MOE_LDS); LAS int* cn = pst + 40; LAS int* sub = (LAS int*)(c.ldsp + MOE_SUB);
    moe_table_wg(c, l, pst, cn, sub);
    int kq = DE / 2; asm volatile("" : "+s"(kq));
    pg8::Gemm g{(const pg8::bf16_t*)(c.ws + WS_HMID), (const pg8::bf16_t*)(c.ws + WS_W2), RPAD, 1024, kq};
    MoeOrder S{pst, __builtin_amdgcn_readfirstlane(pst[32]) * 4, (int)gridDim.x, (int)blockIdx.x, 0, false};
    EpiE2 E{(bf16_t*)(c.ws + WS_Y), (const float*)(c.ws + WS_GROW)};
    for (;; S.i0 += CAPU) {
        pg8::Unit u; if (!S.next(0, u)) break;
        pg8::gemm_phase<EpiE2, MoeOrder, false, true, true, false>(c.ldsp, g, S, E);
        __syncthreads();
    }
}
__device__ __forceinline__ void phase_p1(const Ctx& c, int l, bool dry = false) {
    float* H = (float*)(c.ws + WS_H); float* HO = (float*)(c.ws + (dry ? 440 * MB : WS_H)); bf16_t* XN = (bf16_t*)(c.ws + (dry ? 440 * MB : WS_XN)); const bf16_t* Y = (const bf16_t*)(c.ws + WS_Y);
    const int* tokslot = (const int*)(c.ws + WS_TOKSLOT); const float* gain = (const float*)c.a->in[IN_PLEN] + l * D;
    LAS int* pst = (LAS int*)(c.lds + LDS_MAIN); LAS int* cn = pst + 40; LAS int* sub = (LAS int*)c.lds;
    moe_table(c, l, pst, cn, sub);
    const int gw = c.vb * 4 + c.wave, ngw = c.nb * 4, lane = c.lane;
    f32x4 gv[4]; gain_load(gain, lane, gv);
    int s0n = 0, s1n = 0;
    if (gw < T) { s0n = tokslot[2 * gw]; s1n = tokslot[2 * gw + 1]; }
    for (int t = gw; t < T; t += ngw) {
        const int s0 = s0n, s1 = s1n;
        { const int tn = (t + ngw < T) ? t + ngw : t; s0n = tokslot[2 * tn]; s1n = tokslot[2 * tn + 1]; }
        const int e0 = s0 >> 16, i0 = s0 & 0xffff, e1 = s1 >> 16, i1 = s1 & 0xffff;
        const bf16_t* y0 = Y + ((size_t)pst[e0] * 256 + sub[e0 * 33 + i0 / SUBCAP] + (i0 % SUBCAP)) * D; const bf16_t* y1 = Y + ((size_t)pst[e1] * 256 + sub[e1 * 33 + i1 / SUBCAP] + (i1 % SUBCAP)) * D;
        f32x4 v[4]; u32x2 a0[4], a1[4];
        row_load(H + (size_t)t * D, lane, v);
#pragma unroll
        for (int j = 0; j < 4; ++j) { a0[j] = ((const u32x2*)y0)[lane + 64 * j]; a1[j] = ((const u32x2*)y1)[lane + 64 * j]; }
#pragma unroll
        for (int j = 0; j < 4; ++j) {
            v[j].x += bf_lo(a0[j].x) + bf_lo(a1[j].x); v[j].y += bf_hi(a0[j].x) + bf_hi(a1[j].x); v[j].z += bf_lo(a0[j].y) + bf_lo(a1[j].y); v[j].w += bf_hi(a0[j].y) + bf_hi(a1[j].y);
        }
#pragma unroll
        for (int j = 0; j < 4; ++j) ((f32x4*)(HO + (size_t)t * D))[lane + 64 * j] = v[j];
        const float r = rsqrtf(row_sumsq(v) * (1.f / D) + EPS);
        row_store_norm_fp8(c.ws + (dry ? 440 * MB : WS_XN8) + (size_t)t * D, lane, v, r, gv);
    }
}
struct EpiPJ {
    static constexpr bool PERM = true, AFTER_DRAIN = false;
    bf16_t* PJ;
    __device__ __forceinline__ void operator()(const pg8::f32x4 (&acc)[2][2][4][2], const pg8::Unit& u, int wr, int wc, int fr, int fq) const {
        bf16_t* pp = PJ + (size_t)(u.pm * 256 + wr * 64 + fr) * D + u.pn * 256 + wc * 32 + 8 * fq;
#pragma unroll
        for (int ai = 0; ai < 2; ++ai)
#pragma unroll
            for (int m = 0; m < 4; ++m)
#pragma unroll
                for (int bj = 0; bj < 2; ++bj) {
                    const f32x4 v0 = acc[ai][bj][m][0], v1 = acc[ai][bj][m][1];
                    u32x4 w; w.x = pk_bf16(v0.x, v0.y); w.y = pk_bf16(v0.z, v0.w); w.z = pk_bf16(v1.x, v1.y); w.w = pk_bf16(v1.z, v1.w);
                    *(u32x4*)(pp + (size_t)(ai * 128 + m * 16) * D + bj * 128) = w;
                }
    }
};
struct EpiP2 {
    static constexpr bool PERM = true, AFTER_DRAIN = false;
    const bf16_t* PJ; const float* H; float* HO;
    __device__ __forceinline__ void operator()(const pg8::f32x4 (&acc)[2][2][4][2], const pg8::Unit& u, int wr, int wc, int fr, int fq) const {
        const size_t o0 = (size_t)(u.pm * 256 + wr * 64 + fr) * D + u.pn * 256 + wc * 32 + 8 * fq;
#pragma unroll
        for (int ai = 0; ai < 2; ++ai)
#pragma unroll
            for (int m = 0; m < 4; ++m) {
                u32x4 pj[2]; f32x4 h[2][2];
#pragma unroll
                for (int bj = 0; bj < 2; ++bj) { const size_t o = o0 + (size_t)(ai * 128 + m * 16) * D + bj * 128;
                    pj[bj] = *(const u32x4*)(PJ + o); h[bj][0] = *(const f32x4*)(H + o); h[bj][1] = *(const f32x4*)(H + o + 4); }
#pragma unroll
                for (int bj = 0; bj < 2; ++bj) { const size_t o = o0 + (size_t)(ai * 128 + m * 16) * D + bj * 128;
                    const f32x4 g0 = acc[ai][bj][m][0] * (1.f / W8_SCALE), g1 = acc[ai][bj][m][1] * (1.f / W8_SCALE);
                    f32x4 a0 = h[bj][0], a1 = h[bj][1];
                    a0.x += sigmoidf_(g0.x) * bf_lo(pj[bj].x); a0.y += sigmoidf_(g0.y) * bf_hi(pj[bj].x); a0.z += sigmoidf_(g0.z) * bf_lo(pj[bj].y); a0.w += sigmoidf_(g0.w) * bf_hi(pj[bj].y);
                    a1.x += sigmoidf_(g1.x) * bf_lo(pj[bj].z); a1.y += sigmoidf_(g1.y) * bf_hi(pj[bj].z); a1.z += sigmoidf_(g1.z) * bf_lo(pj[bj].w); a1.w += sigmoidf_(g1.w) * bf_hi(pj[bj].w);
                    *(f32x4*)(HO + o) = a0; *(f32x4*)(HO + o + 4) = a1; }
            }
    }
};
__device__ __forceinline__ void phase_p2(const Ctx& c, int l, bool dry = false) {
    bf16_t* PJ = (bf16_t*)(c.ws + WS_Y);
    pg8::StaticOrder S; S.init(T, D, (int)gridDim.x, (int)blockIdx.x);
    {
        pg8::Gemm g{(const pg8::bf16_t*)(c.ws + WS_PBF) + (size_t)l * T * PLE, (const pg8::bf16_t*)(c.ws + WS_WPROJ) + (size_t)l * D * PLE, T, D, PLE};
        EpiPJ E{PJ};
        pg8::gemm_phase<EpiPJ, pg8::StaticOrder, false, true, false>(c.ldsp, g, S, E);
    }
    __syncthreads();
    {
        pg8::Gemm g{(const pg8::bf16_t*)(c.ws + WS_XN8), (const pg8::bf16_t*)(c.ws + WS_WGATE + (size_t)l * D * D), T, D, D / 2};
        EpiP2 E{PJ, (const float*)(c.ws + WS_H), (float*)(c.ws + (dry ? 440 * MB : WS_H))};
        pg8::gemm_phase<EpiP2, pg8::StaticOrder, false, true, true>(c.ldsp, g, S, E);
    }
}
__device__ __forceinline__ void phase_norm_bf16(const Ctx& c, const float* gain) {
    const float* H = (const float*)(c.ws + WS_H);
    const int gw = c.vb * 4 + c.wave, ngw = c.nb * 4;
    f32x4 gv[4]; gain_load(gain, c.lane, gv);
    for (int t = gw; t < T; t += ngw) {
        f32x4 v[4]; row_load(H + (size_t)t * D, c.lane, v);
        const float r = rsqrtf(row_sumsq(v) * (1.f / D) + EPS);
        row_store_norm_fp8(c.ws + WS_XN8 + (size_t)t * D, c.lane, v, r, gv);
        row_store_norm_bf16((bf16_t*)(c.ws + WS_XN) + (size_t)t * D, c.lane, v, r, gv);
    }
}
__device__ __forceinline__ void phase_final(const Ctx& c) {
    const float* H = (const float*)(c.ws + WS_H); float* O = c.a->out; const float* gain = (const float*)c.a->in[IN_FINN];
    const int gw = c.vb * 4 + c.wave, ngw = c.nb * 4;
    f32x4 gv[4]; gain_load(gain, c.lane, gv);
    for (int t = gw; t < T; t += ngw) {
        f32x4 v[4]; row_load(H + (size_t)t * D, c.lane, v);
        const float r = rsqrtf(row_sumsq(v) * (1.f / D) + EPS);
#pragma unroll
        for (int j = 0; j < 4; ++j) ((f32x4*)(O + (size_t)t * D))[c.lane + 64 * j] = v[j] * r * gv[j];
    }
}

struct B1Order {
    int G, c, nN, mode;
    __device__ __forceinline__ bool next(int i, pg8::Unit& u) const {
        int L;
        if (G == 256) {
            if (mode == 0) { if (c < 64) { if (i >= 3) return false; L = c * 3 + i; } else { if (i >= 1) return false; L = 192 + (c - 64); } }
            else { if (c < 64 || i >= 1) return false; L = c - 64; }
        } else { L = i * G + c; if (L >= 64 * nN) return false; }
        u.pm = L / nN; u.pn = L - u.pm * nN; u.aux = 0; return true;
    }
    __device__ __forceinline__ void a_ready(const pg8::Unit&) const {}
    __device__ __forceinline__ void done(const pg8::Unit&) const {}
};
struct EpiRaw {
    static constexpr bool PERM = true, AFTER_DRAIN = false;
    bf16_t* RAW; int col_off; float sc;
    __device__ __forceinline__ void operator()(const pg8::f32x4 (&acc)[2][2][4][2], const pg8::Unit& u, int wr, int wc, int fr, int fq) const {
        const int col0 = col_off + u.pn * 256 + wc * 32 + 8 * fq;
        bf16_t* rp = RAW + (size_t)(u.pm * 256 + wr * 64 + fr) * BINP + col0;
#pragma unroll
        for (int bj = 0; bj < 2; ++bj) {
            if (col0 + bj * 128 >= BINP) continue;
#pragma unroll
            for (int ai = 0; ai < 2; ++ai)
#pragma unroll
                for (int m = 0; m < 4; ++m) {
                    const f32x4 v0 = acc[ai][bj][m][0] * sc, v1 = acc[ai][bj][m][1] * sc;
                    u32x4 w; w.x = pk_bf16(v0.x, v0.y); w.y = pk_bf16(v0.z, v0.w); w.z = pk_bf16(v1.x, v1.y); w.w = pk_bf16(v1.z, v1.w);
                    *(u32x4*)(rp + (size_t)(ai * 128 + m * 16) * BINP + bj * 128) = w;
                }
        }
    }
};
__device__ __forceinline__ void phase_b1(const Ctx& c, size_t raw_off = WS_RAW) {
    bf16_t* RAW = (bf16_t*)(c.ws + raw_off);
    {
        pg8::Gemm g{(const pg8::bf16_t*)(c.ws + WS_XN8), (const pg8::bf16_t*)(c.ws + WS_WBIN), T, 1536, D / 2};
        B1Order S{(int)gridDim.x, (int)blockIdx.x, 6, 0}; EpiRaw E{RAW, 0, 1.f / W8_SCALE};
        pg8::gemm_phase<EpiRaw, B1Order, false, true, true>(c.ldsp, g, S, E);
    }
    __syncthreads();
    {
        pg8::Gemm g{(const pg8::bf16_t*)(c.ws + WS_XN), (const pg8::bf16_t*)(c.ws + WS_WBIN + 3 * MB), T, 768, D};
        B1Order S{(int)gridDim.x, (int)blockIdx.x, 3, 1}; EpiRaw E{RAW, 1536, 1.f};
        pg8::gemm_phase<EpiRaw, B1Order, false, true, false>(c.ldsp, g, S, E);
    }
}
__device__ __forceinline__ void unpack8(const u32x4 r, float (&e)[8]) { e[0] = bf_lo(r.x); e[1] = bf_hi(r.x); e[2] = bf_lo(r.y); e[3] = bf_hi(r.y); e[4] = bf_lo(r.z); e[5] = bf_hi(r.z); e[6] = bf_lo(r.w); e[7] = bf_hi(r.w); }
__device__ __forceinline__ u32x4 pack8(const float (&e)[8]) { u32x4 o; o.x = pk_bf16(e[0], e[1]); o.y = pk_bf16(e[2], e[3]); o.z = pk_bf16(e[4], e[5]); o.w = pk_bf16(e[6], e[7]); return o; }
__device__ __forceinline__ void phase_rope(const Ctx& c) {
    const bf16_t* RAW = (const bf16_t*)(c.ws + WS_RAW);
    bf16_t* Q = (bf16_t*)(c.ws + WS_Q); bf16_t* K = (bf16_t*)(c.ws + WS_K); bf16_t* V = (bf16_t*)(c.ws + WS_V);
    bf16_t* QI = (bf16_t*)(c.ws + WS_QI); bf16_t* KI = (bf16_t*)(c.ws + WS_KI); float* WI = (float*)(c.ws + WS_WI);
    const int* pos = (const int*)c.a->in[IN_POS];
    LAS float* cs = (LAS float*)(c.lds + c.wave * 256);
    const int gw = c.vb * 4 + c.wave, ngw = c.nb * 4, lane = c.lane;
    const double ex = (lane < 16) ? (double)lane * (1.0 / 16.0) : (double)((lane - 16) & 7) * (1.0 / 8.0);
    const float invf = (float)exp2(-ex * 18.931568569324174);
    for (int t = gw; t < T; t += ngw) {
        if (lane < 24) {
            const float ang = (float)pos[t] * invf;
            const double ad = (double)ang; const double n = rint(ad * 0.15915494309189535); const float red = (float)(ad - n * 6.283185307179586);
            cs[lane] = __cosf(red); cs[32 + lane] = __sinf(red);
        }
        LDS_WAIT();
        const bf16_t* row = RAW + (size_t)t * BINP;
        for (int ch = lane; ch < BINP / 8; ch += 64) {
            const u32x4 own = ((const u32x4*)row)[ch];
            float e[8]; unpack8(own, e);
            if (ch < 160) {
                const int cc = ch & 15;
                if (cc < 4) {
                    const u32x4 oth = ((const u32x4*)row)[ch ^ 2]; float p[8]; unpack8(oth, p);
                    const int f0 = (cc & 1) * 8;
#pragma unroll
                    for (int i = 0; i < 8; ++i) { const float co = cs[f0 + i], si = cs[32 + f0 + i]; e[i] = (cc < 2) ? (e[i] * co - p[i] * si) : (e[i] * co + p[i] * si); }
                }
                u32x2 o8; o8.x = pk_fp8x4(e[0], e[1], e[2], e[3]); o8.y = pk_fp8x4(e[4], e[5], e[6], e[7]);
                if (ch < 128) ((u32x2*)((unsigned char*)Q + (size_t)t * D))[ch] = o8;
                else ((u32x2*)((unsigned char*)K + (size_t)t * 256))[ch - 128] = o8;
            } else if (ch < 192) {
                u32x2 o8; o8.x = pk_fp8x4(e[0], e[1], e[2], e[3]); o8.y = pk_fp8x4(e[4], e[5], e[6], e[7]);
                ((u32x2*)((unsigned char*)V + (size_t)t * 256))[ch - 160] = o8;
            } else if (ch < 264) {
                const int cc = ch & 7;
                if (cc < 2) {
                    const u32x4 oth = ((const u32x4*)row)[ch ^ 1]; float p[8]; unpack8(oth, p);
#pragma unroll
                    for (int i = 0; i < 8; ++i) { const float co = cs[16 + i], si = cs[32 + 16 + i]; e[i] = (cc == 0) ? (e[i] * co - p[i] * si) : (e[i] * co + p[i] * si); }
                }
                if (ch < 256) ((u32x4*)(QI + (size_t)t * 512))[ch - 192] = pack8(e);
                else ((u32x4*)(KI + (size_t)t * 64))[ch - 256] = pack8(e);
            } else if (ch == 264) {
                f32x4 w0 = {e[0], e[1], e[2], e[3]}, w1 = {e[4], e[5], e[6], e[7]};
                const float sc = 0.044194173824159216f;
                ((f32x4*)(WI + (size_t)t * 8))[0] = w0 * sc; ((f32x4*)(WI + (size_t)t * 8))[1] = w1 * sc;
            }
        }
        LDS_WAIT();
    }
}

__device__ __forceinline__ size_t srow_off(int t) { const int m = t >> 6, r = t & 63; return (size_t)64 * (m + 1) * (32 * m + r); }
constexpr size_t S_BATCH = (size_t)64 * 65 * 2048;
constexpr int SCORE_UNITS = 4 * 312;
__device__ __forceinline__ void phase_score(const Ctx& c) {
    const bf16_t* QI = (const bf16_t*)(c.ws + WS_QI); const bf16_t* KI = (const bf16_t*)(c.ws + WS_KI); const float* WI = (const float*)(c.ws + WS_WI);
    float* S = (float*)(c.ws + WS_S);
    const int lane = c.lane, hf = lane >> 5, col = lane & 31, w = c.wave;
    for (int u = c.vb; u < SCORE_UNITS; u += c.nb) {
        const int b = u & 3, r = u >> 2;
        int kc, qb;
        if (r < 120) { kc = 0; qb = 8 + r; } else if (r < 216) { kc = 1; qb = 32 + (r - 120); } else if (r < 280) { kc = 2; qb = 64 + (r - 216); } else { kc = 3; qb = 96 + (r - 280); }
        const int tb = b * SEQ, t0 = 32 * qb + 8 * w;
        bf16x8 af[2][4]; f32x4 wv[2][4];
        { const int rho = lane & 31, ql = 2 * ((rho >> 2) & 1) + (rho >> 4), hd = 4 * ((rho >> 3) & 1) + (rho & 3);
#pragma unroll
          for (int a = 0; a < 2; ++a) {
              const bf16_t* qp = QI + (size_t)(tb + t0 + 4 * a + ql) * 512 + hd * 64 + 8 * hf;
#pragma unroll
              for (int ks = 0; ks < 4; ++ks) af[a][ks] = *(const bf16x8*)(qp + 16 * ks);
              const float* wp = WI + (size_t)(tb + t0 + 4 * a + 2 * hf) * 8;
#pragma unroll
              for (int i = 0; i < 4; ++i) wv[a][i] = ((const f32x4*)wp)[i];
          } }
        const int ntile = min(32, qb + 1 - 32 * kc), key0 = 1024 * kc;
        float* Sb = S + (size_t)b * S_BATCH;
        size_t ro[2][2];
#pragma unroll
        for (int a = 0; a < 2; ++a) { ro[a][0] = srow_off(t0 + 4 * a + 2 * hf); ro[a][1] = srow_off(t0 + 4 * a + 2 * hf + 1); }
        const int nsub = (ntile + 3) >> 2;
        const bf16_t* krp[4];
        rows_regular<64>(krp, KI + (size_t)(tb + key0) * 64, 64, c.tid);
        __syncthreads();
        stage_tile<64>(c.lds, krp, 0, c.tid);
        for (int sc = 0; sc < 8; ++sc) {
            VM_WAIT();
            __syncthreads();
            const LAS unsigned char* cur = c.lds + (sc & 1) * 16384;
            if (sc + 1 < nsub) stage_tile<64>(c.lds + ((sc + 1) & 1) * 16384, krp, (sc + 1) * 128 * 64, c.tid);
#pragma unroll
            for (int j = 0; j < 4; ++j) {
                const int kt = 4 * sc + j;
                if (sc < nsub && kt < ntile) {
                    const int key = key0 + 32 * kt + col, row = 32 * j + col;
                    bf16x8 cb[4];
#pragma unroll
                    for (int ks = 0; ks < 4; ++ks) cb[ks] = *(const LAS bf16x8*)(cur + row * 128 + (((2 * ks + hf) ^ (row & 7)) << 4));
#pragma unroll
                    for (int a = 0; a < 2; ++a) {
                        f32x16 acc = {};
#pragma unroll
                        for (int ks = 0; ks < 4; ++ks) acc = __builtin_amdgcn_mfma_f32_32x32x16_bf16(af[a][ks], cb[ks], acc, 0, 0, 0);
                        float s0 = fmaxf(acc[0], 0.f) * wv[a][0].x; s0 += fmaxf(acc[1], 0.f) * wv[a][0].y; s0 += fmaxf(acc[2], 0.f) * wv[a][0].z; s0 += fmaxf(acc[3], 0.f) * wv[a][0].w;
                        s0 += fmaxf(acc[4], 0.f) * wv[a][1].x; s0 += fmaxf(acc[5], 0.f) * wv[a][1].y; s0 += fmaxf(acc[6], 0.f) * wv[a][1].z; s0 += fmaxf(acc[7], 0.f) * wv[a][1].w;
                        float s1 = fmaxf(acc[8], 0.f) * wv[a][2].x; s1 += fmaxf(acc[9], 0.f) * wv[a][2].y; s1 += fmaxf(acc[10], 0.f) * wv[a][2].z; s1 += fmaxf(acc[11], 0.f) * wv[a][2].w;
                        s1 += fmaxf(acc[12], 0.f) * wv[a][3].x; s1 += fmaxf(acc[13], 0.f) * wv[a][3].y; s1 += fmaxf(acc[14], 0.f) * wv[a][3].z; s1 += fmaxf(acc[15], 0.f) * wv[a][3].w;
                        const int tA = t0 + 4 * a + 2 * hf;
                        Sb[ro[a][0] + key] = (key <= tA) ? s0 : -INFINITY;
                        Sb[ro[a][1] + key] = (key <= tA + 1) ? s1 : -INFINITY;
                    }
                }
            }
        }
    }
}

constexpr int NBINS = 2048, CAND_CAP = 256, SEL_WAVE_LDS = 8192 + 2048 + 64;
__device__ __forceinline__ int clamp_bin(int x) { return min(max(x, 0), NBINS - 1); }
__device__ __forceinline__ void phase_select(const Ctx& c) {
    const float* S = (const float*)(c.ws + WS_S); int* SEL = (int*)(c.ws + WS_SEL);
    LAS int* hist = (LAS int*)(c.lds + c.wave * SEL_WAVE_LDS);
    LAS float* candv = (LAS float*)(hist + NBINS);
    LAS int* candi = (LAS int*)(candv + CAND_CAP);
    LAS int* thr = candi + CAND_CAP;
    const int gw = c.vb * 4 + c.wave, ngw = c.nb * 4;
    for (int j = gw; j < 4 * 3840; j += ngw) {
        int lane = c.lane;
        asm volatile("" : "+v"(lane));
        const int b = j & 3, t = 4095 - (j >> 2), ni = (t + 64) >> 6;
        const float* row = S + (size_t)b * S_BATCH + srow_off(t);
        float s[64];
#pragma unroll
        for (int g4 = 0; g4 < 4; ++g4) {
            if (16 * g4 < ni) {
#pragma unroll
                for (int i = 16 * g4; i < 16 * g4 + 16; ++i) { const int k = 64 * i + lane; const float v = row[min(k, t)]; s[i] = (k <= t) ? v : -INFINITY; }
            } else {
#pragma unroll
                for (int i = 16 * g4; i < 16 * g4 + 16; ++i) s[i] = -INFINITY;
            }
        }
        float mn = INFINITY, mx = -INFINITY;
#pragma unroll
        for (int g8 = 0; g8 < 8; ++g8) if (8 * g8 < ni) {
#pragma unroll
            for (int i = 8 * g8; i < 8 * g8 + 8; ++i) { mx = fmaxf(mx, s[i]); mn = fminf(mn, (s[i] == -INFINITY) ? INFINITY : s[i]); }
        }
#pragma unroll
        for (int o = 1; o < 64; o <<= 1) { mx = fmaxf(mx, __shfl_xor(mx, o)); mn = fminf(mn, __shfl_xor(mn, o)); }
        const float sc = (mx > mn) ? (float)NBINS / (mx - mn) : 0.f, a0 = -mn * sc;
#pragma unroll
        for (int i = 0; i < 8; ++i) ((LAS u32x4*)hist)[lane * 8 + i] = (u32x4){0u, 0u, 0u, 0u};
        LDS_WAIT();
#define BINOF(v) clamp_bin((int)__builtin_fmaf((v), sc, a0))
#pragma unroll
        for (int g8 = 0; g8 < 8; ++g8) if (8 * g8 < ni) {
#pragma unroll
            for (int i = 8 * g8; i < 8 * g8 + 8; ++i) lds_inc(&hist[BINOF(s[i])]);
        }
        LDS_WAIT();
        int bs, need;
        {
            const LAS int* hq = hist + lane * 32;
            u32x4 hr[8];
            int loc = 0;
#pragma unroll
            for (int i = 0; i < 8; ++i) { hr[i] = ((const LAS u32x4*)hq)[i]; loc += (int)(hr[i].x + hr[i].y + hr[i].z + hr[i].w); }
            int suf = loc;
#pragma unroll
            for (int o = 1; o < 64; o <<= 1) { const int v = __shfl_down(suf, o); if (lane + o < 64) suf += v; }
            const int above = suf - loc;
            const bool cross = (above < 256 && suf >= 256);
            int bsl = 0, abl = 0;
            { int run = above;
#pragma unroll
              for (int i = 31; i >= 0; --i) { const int h = (int)hr[i >> 2][i & 3]; const bool hit = (run < 256 && run + h >= 256); bsl = hit ? lane * 32 + i : bsl; abl = hit ? run : abl; run += h; } }
            const unsigned long long cm = __ballot(cross);
            const int src = cm ? (int)__builtin_ctzll(cm) : 0;
            bs = __shfl(bsl, src); need = 256 - __shfl(abl, src);
        }
        int bs2 = -1;
#define SUBOF(v) clamp_bin((int)((__builtin_fmaf((v), sc, a0) - (float)bs) * (float)NBINS))
        if (__shfl(hist[bs], 0) > 48) {
#pragma unroll
            for (int i = 0; i < 8; ++i) ((LAS u32x4*)hist)[lane * 8 + i] = (u32x4){0u, 0u, 0u, 0u};
            LDS_WAIT();
#pragma unroll
            for (int i = 0; i < 64; ++i) if (s[i] != -INFINITY && BINOF(s[i]) == bs) lds_inc(&hist[SUBOF(s[i])]);
            LDS_WAIT();
            const LAS int* hq = hist + lane * 32;
            int loc = 0;
#pragma unroll
            for (int i = 0; i < 8; ++i) { const u32x4 h4 = ((const LAS u32x4*)hq)[i]; loc += (int)(h4.x + h4.y + h4.z + h4.w); }
            int suf = loc;
#pragma unroll
            for (int o = 1; o < 64; o <<= 1) { const int v = __shfl_down(suf, o); if (lane + o < 64) suf += v; }
            const int above = suf - loc;
            const bool cross = (above < need && suf >= need);
            int bsl = 0, abl = 0;
            if (cross) { int run = above; for (int i = 31; i >= 0; --i) { const int h = hq[i]; if (run < need && run + h >= need) { bsl = lane * 32 + i; abl = run; } run += h; } }
            const unsigned long long cm = __ballot(cross);
            const int src = cm ? (int)__builtin_ctzll(cm) : 0;
            bs2 = __shfl(bsl, src); need = need - __shfl(abl, src);
        }
        asm volatile("" : "+v"(lane));
        float sc2 = sc, a02 = a0;
        asm volatile("" : "+v"(sc2), "+v"(a02));
#undef BINOF
#define BINOF(v) clamp_bin((int)__builtin_fmaf((v), sc2, a02))
        int* selr = SEL + ((size_t)b * SEQ + t) * 256;
        int nc = 0, base = 0;
#pragma unroll
        for (int g4 = 0; g4 < 4; ++g4) if (16 * g4 < ni) {
#pragma unroll
            for (int i = 16 * g4; i < 16 * g4 + 16; ++i) {
                const int bn = BINOF(s[i]);
                bool pc = (bn == bs) && (s[i] != -INFINITY), pd = (bn > bs);
                if (bs2 >= 0) { const int sb = SUBOF(s[i]); pd = pd || (pc && sb > bs2); pc = pc && (sb == bs2); }
                const unsigned long long md = __ballot(pd), mc = __ballot(pc);
                const int posd = base + (int)__builtin_amdgcn_mbcnt_hi((unsigned)(md >> 32), __builtin_amdgcn_mbcnt_lo((unsigned)md, 0u));
                const int posc = nc + (int)__builtin_amdgcn_mbcnt_hi((unsigned)(mc >> 32), __builtin_amdgcn_mbcnt_lo((unsigned)mc, 0u));
                if (pd && posd < 256) selr[posd] = 64 * i + lane;
                if (pc && posc < CAND_CAP) { candv[posc] = s[i]; candi[posc] = 64 * i + lane; }
                base += (int)__popcll(md); nc += (int)__popcll(mc);
            }
        }
        nc = min(nc, CAND_CAP);
        LDS_WAIT();
        for (int i = lane; i < nc; i += 64) {
            const float v = candv[i]; const int id = candi[i];
            int rank = 0;
            for (int k = 0; k < nc; ++k) { const float vk = candv[k]; const int ik = candi[k]; rank += (vk > v || (vk == v && ik < id)) ? 1 : 0; }
            if (rank < need && base + rank < 256) selr[base + rank] = id;
        }
        LDS_WAIT();
#undef BINOF
#undef SUBOF
    }
}

typedef short s16x4 __attribute__((ext_vector_type(4)));
__device__ __forceinline__ unsigned vimg_f(unsigned r) { return ((r & 3u) << 2) | ((r >> 2) & 3u); }
__device__ __forceinline__ void tr_read8(const unsigned (&ad)[8], s16x4 (&r)[8]) {
    asm volatile("ds_read_b64_tr_b16 %0, %8\n\tds_read_b64_tr_b16 %1, %9\n\tds_read_b64_tr_b16 %2, %10\n\tds_read_b64_tr_b16 %3, %11\n\t"
                 "ds_read_b64_tr_b16 %4, %12\n\tds_read_b64_tr_b16 %5, %13\n\tds_read_b64_tr_b16 %6, %14\n\tds_read_b64_tr_b16 %7, %15\n\ts_waitcnt lgkmcnt(0)"
                 : "=&v"(r[0]), "=&v"(r[1]), "=&v"(r[2]), "=&v"(r[3]), "=&v"(r[4]), "=&v"(r[5]), "=&v"(r[6]), "=&v"(r[7])
                 : "v"(ad[0]), "v"(ad[1]), "v"(ad[2]), "v"(ad[3]), "v"(ad[4]), "v"(ad[5]), "v"(ad[6]), "v"(ad[7]) : "memory");
}
__device__ __forceinline__ void tr_read8_b8(const unsigned (&ad)[8], s16x4 (&r)[8]) {
    asm volatile("ds_read_b64_tr_b8 %0, %8\n\tds_read_b64_tr_b8 %1, %9\n\tds_read_b64_tr_b8 %2, %10\n\tds_read_b64_tr_b8 %3, %11\n\t"
                 "ds_read_b64_tr_b8 %4, %12\n\tds_read_b64_tr_b8 %5, %13\n\tds_read_b64_tr_b8 %6, %14\n\tds_read_b64_tr_b8 %7, %15\n\ts_waitcnt lgkmcnt(0)"
                 : "=&v"(r[0]), "=&v"(r[1]), "=&v"(r[2]), "=&v"(r[3]), "=&v"(r[4]), "=&v"(r[5]), "=&v"(r[6]), "=&v"(r[7])
                 : "v"(ad[0]), "v"(ad[1]), "v"(ad[2]), "v"(ad[3]), "v"(ad[4]), "v"(ad[5]), "v"(ad[6]), "v"(ad[7]) : "memory");
}
constexpr int ATT_WAVE_LDS = 19456;
__device__ __forceinline__ void phase_attn(const Ctx& c) {
    const bf16_t* Q = (const bf16_t*)(c.ws + WS_Q); const bf16_t* K = (const bf16_t*)(c.ws + WS_K); const bf16_t* V = (const bf16_t*)(c.ws + WS_V);
    const int* SEL = (const int*)(c.ws + WS_SEL); bf16_t* O = (bf16_t*)(c.ws + WS_O);
    LAS unsigned char* wl = c.lds + c.wave * ATT_WAVE_LDS;
    LAS int* sl = (LAS int*)wl;
    LAS unsigned short* pT = (LAS unsigned short*)(wl + 1024);
    LAS unsigned char* vb = wl + 3072;
    const int lane = c.lane, fr = lane & 15, fq = lane >> 4;
    const int gw = c.vb * 4 + c.wave, ngw = c.nb * 4;
    unsigned tro[8];
    { const unsigned row = 8u * fq + ((unsigned)fr >> 1);
#pragma unroll
      for (int c2 = 0; c2 < 8; ++c2) tro[c2] = 128u * row + 16u * ((unsigned)c2 ^ (row & 7u)) + 8u * ((unsigned)fr & 1u); }
    const unsigned vb_addr = (unsigned)(size_t)vb;
    int tcount = 0, cit = gw;
    const bool xsplit = (c.nb % 128) == 0;
    const int xg = (c.vb >> 6) & 1, wi0 = xsplit ? (((c.vb >> 7) * 64 + (c.vb & 63)) * 4 + c.wave) : gw, wstride = xsplit ? ngw / 2 : ngw;
    const unsigned chunkoff = (((unsigned)lane & 7u) ^ (((unsigned)lane >> 3) & 7u)) << 4;
    unsigned trh[8];
    { const unsigned row = 8u * (fq & 1) + ((unsigned)fr >> 1);
#pragma unroll
      for (int c2 = 0; c2 < 8; ++c2) trh[c2] = 128u * row + 16u * ((unsigned)c2 ^ (row & 7u)) + 8u * ((unsigned)fr & 1u); }
#define SEL_PREFETCH(tg_) __builtin_amdgcn_global_load_lds((const unsigned*)(SEL + (size_t)(tg_) * 256 + lane * 4), (LAS unsigned*)((LAS unsigned char*)sl + lane * 16), 16, 0, 0)
    const int task_end = xsplit ? T : T * 2;
    if (wi0 < task_end) { SEL_PREFETCH(xsplit ? wi0 : (wi0 >> 1)); }
    for (int task = wi0; task < task_end; task += wstride) {
        const int tg = xsplit ? task : (task >> 1), g = xsplit ? xg : (task & 1), b = tg >> 12, t = tg & 4095, tb = b * SEQ;
        const int nsel = min(256, t + 1), nch = (nsel + 31) >> 5;
        asm volatile("s_waitcnt vmcnt(0)" ::: "memory");
        unsigned koff[32];
#pragma unroll
        for (int q = 0; q < 32; ++q) { const int s_ = 8 * q + (lane >> 3); int idx = sl[s_]; idx = (t < 256) ? s_ : idx; idx = (s_ < nsel && (unsigned)idx <= (unsigned)t) ? idx : 0; koff[q] = (unsigned)idx * 256u + chunkoff; }
        i64x2 qf[2];
        { const unsigned char* qp = (const unsigned char*)Q + (size_t)tg * D + (4 * g + (fr >> 2)) * 128 + 16 * fq;
#pragma unroll
          for (int i = 0; i < 2; ++i) qf[i] = *(const i64x2*)(qp + 64 * i); }
        asm volatile("s_waitcnt vmcnt(0) lgkmcnt(0)" ::: "memory");
        asm volatile("" : "+v"(qf[0]), "+v"(qf[1]));
        { const int tn = task + wstride; if (tn < task_end) SEL_PREFETCH(xsplit ? tn : (tn >> 1)); }
        const unsigned char* kbase = (const unsigned char*)K + (size_t)tb * 256 + g * 128;
        const unsigned char* vbase = (const unsigned char*)V + (size_t)tb * 256 + g * 128;
#define CH_GATHER(cidx) do { const unsigned char* bp_ = ((cidx) < 16) ? kbase : vbase; _Pragma("unroll") for (int i_ = 0; i_ < 2; ++i_) { \
            unsigned o_ = koff[2 * ((cidx) & 15) + i_]; asm volatile("" : "+v"(o_));     \
            __builtin_amdgcn_global_load_lds((const unsigned*)(bp_ + o_), (LAS unsigned*)(vb + ((cidx) & 7) * 2048 + i_ * 1024 + lane * 16), 16, 0, 0); } } while (0)
        float lg[16];
#pragma unroll
        for (int c0 = 0; c0 < 6; ++c0) CH_GATHER(c0);
#pragma unroll
        for (int ch = 0; ch < 16; ++ch) {
            asm volatile("s_waitcnt lgkmcnt(0)" ::: "memory");
            CH_GATHER(ch + 6);
            asm volatile("s_waitcnt vmcnt(12)" ::: "memory");
            const LAS unsigned char* kb = vb + (ch & 7) * 2048;
            f32x4 acc = {0.f, 0.f, 0.f, 0.f};
#pragma unroll
            for (int i = 0; i < 2; ++i) { const i64x2 kf = *(const LAS i64x2*)(kb + 128u * fr + 16u * ((4u * i + fq) ^ ((unsigned)fr & 7u)));
                acc = __builtin_amdgcn_mfma_f32_16x16x32_fp8_fp8(qf[i].x, kf.x, acc, 0, 0, 0); acc = __builtin_amdgcn_mfma_f32_16x16x32_fp8_fp8(qf[i].y, kf.y, acc, 0, 0, 0); }
            lg[ch] = (ch * 16 + fr < nsel) ? acc.x * 0.08838834764831845f : -INFINITY;
        }
        float mx = lg[0];
#pragma unroll
        for (int kt = 1; kt < 16; ++kt) mx = fmaxf(mx, lg[kt]);
#pragma unroll
        for (int o = 1; o < 16; o <<= 1) mx = fmaxf(mx, __shfl_xor(mx, o));
        float sm = 0.f;
#pragma unroll
        for (int kt = 0; kt < 16; ++kt) { lg[kt] = __expf(lg[kt] - mx); sm += lg[kt]; }
#pragma unroll
        for (int o = 1; o < 16; o <<= 1) sm += __shfl_xor(sm, o);
        { const float inv = 256.f / sm;
#pragma unroll
          for (int kt = 0; kt < 16; ++kt) { const float pv = lg[kt] * inv; ((LAS unsigned char*)pT)[fq * 256 + kt * 16 + fr] = (unsigned char)(pk_fp8x4_nc(pv, pv, pv, pv) & 0xffu); } }
        f32x4 oacc[8];
#pragma unroll
        for (int c2 = 0; c2 < 8; ++c2) oacc[c2] = (f32x4){0.f, 0.f, 0.f, 0.f};
#pragma unroll
        for (int p = 0; p < 8; ++p) {
            asm volatile("s_waitcnt lgkmcnt(0)" ::: "memory");
            if (16 + 2 * p + 6 < 32) { CH_GATHER(16 + 2 * p + 6); CH_GATHER(16 + 2 * p + 7); }
            if (p < 5) asm volatile("s_waitcnt vmcnt(12)" ::: "memory"); else if (p == 5) asm volatile("s_waitcnt vmcnt(8)" ::: "memory");
            else if (p == 6) asm volatile("s_waitcnt vmcnt(4)" ::: "memory"); else asm volatile("s_waitcnt vmcnt(0)" ::: "memory");
            if (p < nch) {
                const long pa = *(const LAS long*)((const LAS unsigned char*)pT + (fr >> 2) * 256 + 32 * p + 8 * fq);
                const unsigned cb = vb_addr + (unsigned)(((16 + 2 * p) & 7) + (fq >> 1)) * 2048u;
                unsigned ad[8]; s16x4 r0[8];
#pragma unroll
                for (int i = 0; i < 8; ++i) ad[i] = cb + trh[i];
                tr_read8_b8(ad, r0);
#pragma unroll
                for (int c2 = 0; c2 < 8; ++c2) oacc[c2] = __builtin_amdgcn_mfma_f32_16x16x32_fp8_fp8(pa, __builtin_bit_cast(long, r0[c2]), oacc[c2], 0, 0, 0);
            }
        }
        { unsigned char* op = (unsigned char*)O + (size_t)tg * D + (4 * g + fq) * 128 + fr;
#pragma unroll
          for (int c2 = 0; c2 < 8; ++c2) { const float ov = oacc[c2].x * (O8_SCALE / 256.f); op[16 * c2] = (unsigned char)(pk_fp8x4(ov, ov, ov, ov) & 0xffu); } }
        LDS_WAIT();
#undef CH_GATHER
        if ((tcount & 1) && cit < NE * 192) { convert_moe_item(c, 1, cit, vb); cit += ngw; }
        ++tcount;
    }
    for (; cit < NE * 192; cit += ngw) convert_moe_item(c, 1, cit, vb);
}

__device__ __forceinline__ void phase_b4(const Ctx& c, bool dry = false) {
    float* H = (float*)(c.ws + WS_H);
    pg8::Gemm g{(const pg8::bf16_t*)(c.ws + WS_O), (const pg8::bf16_t*)(c.ws + WS_WBOUT), T, D, D / 2};
    pg8::StaticOrder S; S.init(T, D, (int)gridDim.x, (int)blockIdx.x);
    EpiResF32 E{H, dry ? (float*)(c.ws + 440 * MB) : H, D, 1.f / (W8_SCALE * O8_SCALE)};
    pg8::gemm_phase<EpiResF32, pg8::StaticOrder, false, true, true>(c.ldsp, g, S, E);
}

constexpr int NPHASE = 22;
__global__ void __launch_bounds__(NTHP, 2) mk_fwd(Args args) {
    extern __shared__ __attribute__((aligned(16))) unsigned char lds_raw[];
    Ctx c;
    { const int pt = threadIdx.x; c.half = __builtin_amdgcn_readfirstlane(pt >> 8); c.tid = pt & 255; c.lane = pt & 63; c.wave = __builtin_amdgcn_readfirstlane(pt >> 6) & 3; }
    c.ldsp = (LAS unsigned char*)lds_raw; c.lds = c.ldsp + c.half * LDS_HALF;
    c.nb = 2 * gridDim.x; { const int bx = blockIdx.x, G = gridDim.x; c.vb = 2 * ((G % 8 == 0) ? (bx % 8) * (G / 8) + bx / 8 : bx) + c.half; }
    c.a = (const __attribute__((address_space(4))) Args*)__builtin_amdgcn_kernarg_segment_ptr(); c.ws = args.ws;
    volatile LAS unsigned* st = (volatile LAS unsigned*)((LAS unsigned char*)lds_raw + LDS_BYTES - 16);
    const bool multi = (args.ph_hi - args.ph_lo) > 1;
    XcdBarrier bar; bar.bar = (unsigned*)(c.ws + WS_CTL); bar.x = 0; bar.st = st;
    if (multi) {
        if (threadIdx.x == 0) { st[0] = 0u; st[1] = 0u; }
        __syncthreads();
        bar = xcd_barrier_post((unsigned*)(c.ws + WS_CTL), st);
    }
    const int ph_lo = args.ph_lo, ph_hi = args.ph_hi;
#ifndef PH_MASK
#define PH_MASK 0x3fffff
#endif
#define PHON(k) ((PH_MASK >> (k)) & 1)
#define PHASE(k, body) do { if (PHON(k) && ph_lo <= (k) && (k) < ph_hi) { \
        { int t_ = threadIdx.x, vb_ = __builtin_amdgcn_readfirstlane(c.vb); \
          const __attribute__((address_space(4))) Args* ka = (const __attribute__((address_space(4))) Args*)__builtin_amdgcn_kernarg_segment_ptr(); \
          asm volatile("" : "+v"(t_), "+s"(vb_), "+s"(ka)); \
          c.tid = t_ & 255; c.lane = t_ & 63; c.wave = __builtin_amdgcn_readfirstlane(t_ >> 6) & 3; c.vb = vb_; c.a = ka; c.ws = ka->ws; } \
        body; \
        if (MK_REP == (k)) { __syncthreads(); body; } \
        if ((k) + 1 < ph_hi) xcd_barrier(bar); \
        if ((k) == 3) { for (int xb_ = 0; xb_ < MK_XBAR; ++xb_) xcd_barrier(bar); } } } while (0)
    PHASE(0, phase_prep(c));
    PHASE(1, phase_a1(c));
    PHASE(2, { if (MK_DRY == 2) { phase_a2(c, true); __syncthreads(); } phase_a2(c); });
    PHASE(3, phase_a3(c));
    PHASE(4, { if (MK_DRY == 4) { phase_route(c, 0, true); __syncthreads(); } phase_route(c, 0); });
    PHASE(5, phase_e1(c, 0));
    PHASE(6, phase_e2(c, 0));
    PHASE(7, { if (MK_DRY == 7) { phase_p1(c, 0, true); __syncthreads(); } phase_p1(c, 0); });
    PHASE(8, { if (MK_DRY == 8) { phase_p2(c, 0, true); __syncthreads(); } phase_p2(c, 0); });
    PHASE(9, phase_norm_bf16(c, (const float*)c.a->in[IN_MIXN] + D));
    PHASE(10, phase_b1(c));
    PHASE(11, phase_rope(c));
    PHASE(12, phase_score(c));
    PHASE(13, phase_select(c));
    PHASE(14, phase_attn(c));
    PHASE(15, { if (MK_DRY == 15) { phase_b4(c, true); __syncthreads(); } phase_b4(c); });
    PHASE(16, phase_route(c, 1));
    PHASE(17, phase_e1(c, 1));
    PHASE(18, phase_e2(c, 1));
    PHASE(19, phase_p1(c, 1));
    PHASE(20, phase_p2(c, 1));
    PHASE(21, phase_final(c));
}

#ifdef MK_DUMP
__global__ void dump_k(const unsigned char* ws, float* out) {
    const size_t i = (size_t)blockIdx.x * 256 + threadIdx.x;
#if MK_DUMP == 1
    ((f32x4*)out)[i] = ((const f32x4*)(ws + WS_H))[i];
#elif MK_DUMP == 2
    { const u32x2 v = ((const u32x2*)(ws + WS_O))[i]; f32x4 o = {bf_lo(v.x), bf_hi(v.x), bf_lo(v.y), bf_hi(v.y)}; ((f32x4*)out)[i] = o; }
#elif MK_DUMP == 3
    { const int* sp = (const int*)(ws + WS_SEL); f32x4 o = {0.f,0.f,0.f,0.f}; if (i < (size_t)T * 64) { o.x = (float)sp[4*i]; o.y = (float)sp[4*i+1]; o.z = (float)sp[4*i+2]; o.w = (float)sp[4*i+3]; } ((f32x4*)out)[i] = o; }
#elif MK_DUMP == 5
    { const u32x2 v = ((const u32x2*)(ws + WS_XN))[i]; f32x4 o = {bf_lo(v.x), bf_hi(v.x), bf_lo(v.y), bf_hi(v.y)}; ((f32x4*)out)[i] = o; }
#elif MK_DUMP == 6
    { const u32x2 v = ((const u32x2*)(ws + WS_RAW))[i]; f32x4 o = {bf_lo(v.x), bf_hi(v.x), bf_lo(v.y), bf_hi(v.y)}; ((f32x4*)out)[i] = o; }
#elif MK_DUMP == 7
    { f32x4 o = {0.f,0.f,0.f,0.f}; if (i < (size_t)BINP * D / 4) { const u32x2 v = ((const u32x2*)(ws + WS_WBIN))[i]; o = (f32x4){bf_lo(v.x), bf_hi(v.x), bf_lo(v.y), bf_hi(v.y)}; } ((f32x4*)out)[i] = o; }
#elif MK_DUMP == 8
    { const u32x2 v = ((const u32x2*)(ws + WS_RAW))[i], w = ((const u32x2*)(ws + 458 * MB))[i]; f32x4 o = {bf_lo(v.x) - bf_lo(w.x), bf_hi(v.x) - bf_hi(w.x), bf_lo(v.y) - bf_lo(w.y), bf_hi(v.y) - bf_hi(w.y)}; ((f32x4*)out)[i] = o; }
#elif MK_DUMP == 9
    { const u32x2 v = ((const u32x2*)(ws + WS_RAW))[i], w = ((const u32x2*)(ws + 458 * MB))[i]; f32x4 o = {(v.x & 0xffffu) != (w.x & 0xffffu) ? 1.f : 0.f, (v.x >> 16) != (w.x >> 16) ? 1.f : 0.f, (v.y & 0xffffu) != (w.y & 0xffffu) ? 1.f : 0.f, (v.y >> 16) != (w.y >> 16) ? 1.f : 0.f}; ((f32x4*)out)[i] = o; }
#elif MK_DUMP == 4
    { const u32x2 v = ((const u32x2*)(ws + WS_Q))[i]; f32x4 o = {bf_lo(v.x), bf_hi(v.x), bf_lo(v.y), bf_hi(v.y)}; ((f32x4*)out)[i] = o; }
#endif
}
#endif
extern "C" void kernel_launch(void* const* d_in, const int* in_sizes, int n_in, void* d_out, int out_size, void* d_ws, size_t ws_size, hipStream_t stream) {
    static int grid = 0;
    if (grid == 0) {
        if (n_in != 23 || out_size != T * D || ws_size < WS_TOTAL) { fprintf(stderr, "kernel_launch: unexpected sizes n_in %d out %d ws %zu (need %zu)\n", n_in, out_size, ws_size, (size_t)WS_TOTAL); grid = -1; return; }
        int dev = 0, cus = 0, per_cu = 0;
        hipGetDevice(&dev); hipDeviceGetAttribute(&cus, hipDeviceAttributeMultiprocessorCount, dev);
        hipFuncSetAttribute((const void*)mk_fwd, hipFuncAttributeMaxDynamicSharedMemorySize, LDS_BYTES);
        hipOccupancyMaxActiveBlocksPerMultiprocessor(&per_cu, (const void*)mk_fwd, NTHP, LDS_BYTES);
        (void)hipGetLastError();
        if (per_cu < 1) per_cu = 1;
        if (per_cu > 1) per_cu = 1;
        grid = cus * per_cu;
    }
    if (grid < 0) return;
    hipMemsetAsync((char*)d_ws + WS_CTL, 0, 16384, stream);
    Args a{};
    for (int i = 0; i < 23; ++i) a.in[i] = d_in[i];
    a.out = (float*)d_out; a.ws = (unsigned char*)d_ws;
#if MK_ONE_LAUNCH
    a.ph_lo = 0; a.ph_hi = NPHASE;
    hipLaunchKernelGGL(mk_fwd, dim3(grid), dim3(NTHP), LDS_BYTES, stream, a);
#else
    for (int ph = 0; ph <= MK_LAST_PHASE; ++ph) { a.ph_lo = ph; a.ph_hi = ph + 1; hipLaunchKernelGGL(mk_fwd, dim3(grid), dim3(NTHP), LDS_BYTES, stream, a); }
#ifdef MK_DUMP
    hipLaunchKernelGGL(dump_k, dim3(T * D / 4 / 256), dim3(256), 0, stream, (const unsigned char*)d_ws, (float*)d_out);
#endif
#endif
}
```

```cpp
#include <hip/hip_runtime.h>
#include <stdint.h>
#include <stdio.h>

#ifndef MK_LAST_PHASE
#define MK_LAST_PHASE 21
#endif
#ifndef MK_REP
#define MK_REP -1
#endif
#ifndef MK_XBAR
#define MK_XBAR 0
#endif
#ifndef MK_DRY
#define MK_DRY -1
#endif
#ifndef MK_ONE_LAUNCH
#define MK_ONE_LAUNCH 1
#endif

#define LAS __attribute__((address_space(3)))
typedef unsigned short bf16_t;
typedef short bf16x8 __attribute__((ext_vector_type(8)));
typedef float f32x4 __attribute__((ext_vector_type(4)));
typedef float f32x2 __attribute__((ext_vector_type(2)));
typedef float f32x16 __attribute__((ext_vector_type(16)));
typedef unsigned u32x4 __attribute__((ext_vector_type(4)));
typedef unsigned u32x2 __attribute__((ext_vector_type(2)));
typedef long i64x2 __attribute__((ext_vector_type(2)));
typedef int i32x4 __attribute__((ext_vector_type(4)));
typedef int i32x8 __attribute__((ext_vector_type(8)));

constexpr int T = 16384, D = 1024, SEQ = 4096;
constexpr int GW = 2048;
constexpr int BIN = 2120, BINP = 2176;
constexpr int NE = 32, DE = 512;
constexpr int PLE = 256;
constexpr float EPS = 1e-6f;
constexpr int NTH = 256;
constexpr int LDS_MAIN = 4 * 19456;
constexpr int LDS_HALF = LDS_MAIN + 1024;
constexpr int LDS_BYTES = 2 * LDS_HALF;
constexpr int NTHP = 512;
constexpr int RPAD = 32768 + NE * 256;

constexpr size_t MB = 1024 * 1024;
constexpr size_t WS_CTL = 0;
constexpr size_t WS_CNT = 448 * 1024;
constexpr int NSUB = 32, SUBCAP = T / NSUB, CNT_STRIDE = 32;
static_assert(WS_CNT >= 32768 + 2 * 1024 * 48 * 4 && WS_CNT + (size_t)4 * NSUB * 32 * CNT_STRIDE * 4 <= 1024 * 1024, "cnt");
constexpr size_t WS_WR = 32768;
constexpr size_t WS_WAIN = 1 * MB;
constexpr size_t WS_WAOUT = WS_WAIN + 8 * MB;
constexpr size_t WS_WBIN = WS_WAOUT + 4 * MB;
constexpr size_t WS_WBOUT = WS_WBIN + 5 * MB;
constexpr size_t WS_WGATE = WS_WBOUT + 2 * MB;
constexpr size_t WS_WPROJ = WS_WGATE + 4 * MB;
constexpr size_t WS_W1 = WS_WPROJ + 1 * MB;
constexpr size_t WS_XN8 = WS_W1 + 16 * MB;
constexpr size_t WS_W3 = WS_W1 + 32 * MB;
constexpr size_t WS_W2 = WS_W3 + 32 * MB;
constexpr size_t WS_PBF = WS_W2 + 32 * MB;
constexpr size_t WS_XN = WS_PBF + 16 * MB;
constexpr size_t WS_H = WS_XN + 32 * MB;
constexpr size_t WS_LIST = WS_H + 64 * MB;
constexpr size_t WS_GATE = WS_LIST + 2 * MB;
constexpr size_t WS_TOKSLOT = WS_GATE + 2 * MB;
constexpr size_t WS_GROW = WS_TOKSLOT + 512 * 1024;
constexpr size_t WS_SCR = WS_TOKSLOT + 1 * MB;
constexpr size_t WS_U = WS_SCR;
constexpr size_t WS_VT = WS_SCR + 64 * MB;
constexpr size_t WS_VSS = WS_SCR + 128 * MB;
constexpr size_t WS_HMID = WS_SCR;
constexpr size_t WS_Y = WS_SCR + 36 * MB;
constexpr size_t WS_RAW = WS_SCR;
constexpr size_t WS_O = WS_SCR;
constexpr size_t WS_Q = WS_SCR + 68 * MB;
constexpr size_t WS_K = WS_Q + 32 * MB;
constexpr size_t WS_V = WS_K + 8 * MB;
constexpr size_t WS_QI = WS_V + 8 * MB;
constexpr size_t WS_KI = WS_QI + 16 * MB;
constexpr size_t WS_WI = WS_KI + 2 * MB;
constexpr size_t WS_SEL = WS_WI + 1 * MB;
constexpr size_t WS_END = WS_SEL + 16 * MB;
static_assert(WS_END <= WS_SCR + 152 * MB, "scratch");
constexpr size_t WS_S = 392 * MB;
constexpr size_t WS_TOTAL = 522 * MB;

typedef __bf16 bf16x2_t __attribute__((ext_vector_type(2)));
__device__ __forceinline__ unsigned pk_bf16(float lo, float hi) { f32x2 v = {lo, hi}; bf16x2_t b = __builtin_convertvector(v, bf16x2_t); return __builtin_bit_cast(unsigned, b); }
__device__ __forceinline__ float bf_lo(unsigned u) { return __uint_as_float(u << 16); }
__device__ __forceinline__ float bf_hi(unsigned u) { return __uint_as_float(u & 0xffff0000u); }
__device__ __forceinline__ float wave_sum(float v) {
#pragma unroll
    for (int o = 1; o < 64; o <<= 1) v += __shfl_xor(v, o);
    return v;
}
__device__ __forceinline__ int lds_inc(LAS int* p) { return __hip_atomic_fetch_add(p, 1, __ATOMIC_RELAXED, __HIP_MEMORY_SCOPE_WORKGROUP); }
#define LDS_WAIT() asm volatile("s_waitcnt lgkmcnt(0)" ::: "memory")
#define VM_WAIT() asm volatile("s_waitcnt vmcnt(0)" ::: "memory")

#define XB_TMO      128
#define XB_XCNT(j)  (256  + 64 * (j))
#define XB_XSUB(j)  (1280 + 64 * (j))
#define XB_XGEN(j)  (2304 + 64 * (j))
#define XB_TOP      3328
#define XB_TOPGEN   3392
#define XCD_BAR_WORDS 3456
#define XB_SPIN_CAP (1u << 20)
__device__ __forceinline__ unsigned xb_ld(unsigned* p)              { return __hip_atomic_load(p, __ATOMIC_RELAXED, __HIP_MEMORY_SCOPE_AGENT); }
__device__ __forceinline__ unsigned xb_add(unsigned* p, unsigned v) { return __hip_atomic_fetch_add(p, v, __ATOMIC_RELAXED, __HIP_MEMORY_SCOPE_AGENT); }
__device__ __forceinline__ unsigned xb_xcc_id() { return (unsigned)__builtin_amdgcn_s_getreg((3 << 11) | 20) & 0xFu; }
#define XB_SPIN(cond, bar) do { unsigned _sp = 0; while (cond) { __builtin_amdgcn_s_sleep(1); \
    if ((++_sp & 255u) == 0u) { if (xb_ld(&(bar)[XB_TMO])) break; if (_sp > XB_SPIN_CAP) { atomicAdd(&(bar)[XB_TMO], 1u); break; } } } } while (0)
struct XcdBarrier { unsigned* bar; unsigned x; volatile LAS unsigned* st; };
__device__ __forceinline__ XcdBarrier xcd_barrier_post(unsigned* bar, volatile LAS unsigned* st) {
    XcdBarrier b; b.bar = bar; b.x = xb_xcc_id(); b.st = st;
    if (threadIdx.x == 0) (void)xb_add(&bar[XB_XCNT(b.x)], 1u);
    return b;
}
__device__ __forceinline__ void xcd_barrier_complete(unsigned* bar, unsigned x, unsigned& nloc, unsigned& nx) {
    const unsigned G = gridDim.x;
    unsigned sum, cnt, mine, sp = 0u;
    for (;;) {
        sum = 0u; cnt = 0u; mine = 0u;
#pragma unroll
        for (unsigned j = 0; j < 16; ++j) { const unsigned c = xb_ld(&bar[XB_XCNT(j)]); sum += c; cnt += (c > 0u) ? 1u : 0u; mine = (j == x) ? c : mine; }
        if (sum == G) break;
        __builtin_amdgcn_s_sleep(1);
        if ((++sp & 255u) == 0u) { if (xb_ld(&bar[XB_TMO])) break; if (sp > XB_SPIN_CAP) { atomicAdd(&bar[XB_TMO], 1u); break; } }
    }
    nloc = mine > 0u ? mine : 1u; nx = cnt > 0u ? cnt : 1u;
}
__device__ __forceinline__ void xcd_barrier(const XcdBarrier& b) {
    asm volatile("s_waitcnt vmcnt(0)" ::: "memory");
    __syncthreads();
    if (threadIdx.x == 0) {
        unsigned* bar = b.bar;
        __builtin_amdgcn_s_waitcnt(0);
        unsigned nloc = b.st[0], nx = b.st[1];
        if (nloc == 0u) { xcd_barrier_complete(bar, b.x, nloc, nx); b.st[0] = nloc; b.st[1] = nx; }
        const unsigned old = xb_add(&bar[XB_XSUB(b.x)], 1u);
        const unsigned gen = old / nloc;
        if (old + 1u == (gen + 1u) * nloc) {
            __builtin_amdgcn_fence(__ATOMIC_RELEASE, "agent");
            asm volatile("s_waitcnt vmcnt(0)" ::: "memory");
            const unsigned og = xb_add(&bar[XB_TOP], 1u);
            const unsigned tg = og / nx;
            if (og + 1u == (tg + 1u) * nx) xb_add(&bar[XB_TOPGEN], 1u);
            else XB_SPIN(xb_ld(&bar[XB_TOPGEN]) == tg, bar);
            __builtin_amdgcn_fence(__ATOMIC_ACQUIRE, "agent");
            xb_add(&bar[XB_XGEN(b.x)], 1u);
            asm volatile("s_waitcnt vmcnt(0)" ::: "memory");
        } else {
            XB_SPIN(xb_ld(&bar[XB_XGEN(b.x)]) == gen, bar);
            __builtin_amdgcn_fence(__ATOMIC_ACQUIRE, "agent");
            asm volatile("s_waitcnt vmcnt(0)" ::: "memory");
        }
    }
    __syncthreads();
}

struct Args { const void* in[23]; float* out; unsigned char* ws; int ph_lo, ph_hi; };
enum { IN_X = 0, IN_P, IN_POS, IN_MIXN, IN_AWIN, IN_AVG, IN_AWS, IN_ABS, IN_AWOUT, IN_BWIN, IN_BWOUT, IN_FFNN, IN_WG, IN_BG, IN_WE, IN_BE,
       IN_W1, IN_W3, IN_W2, IN_PLEN, IN_PLEG, IN_PLEP, IN_FINN };

struct Ctx {
    LAS unsigned char* lds;
    int tid, lane, wave, vb, nb, half;
    LAS unsigned char* ldsp;
    const __attribute__((address_space(4))) Args* a;
    unsigned char* ws;
};

template <int BK> struct TileK { static constexpr int NP = (BK == 64) ? 4 : 2; static constexpr int TB = 128 * BK * 2; };

template <int BK>
__device__ __forceinline__ void stage_tile(LAS unsigned char* tile, const bf16_t* const (&rp)[TileK<BK>::NP], int k0, int tid) {
    const int lc = (BK == 64) ? ((tid & 7) ^ ((tid >> 3) & 7)) : ((tid & 3) ^ ((tid >> 3) & 3));
#pragma unroll
    for (int p = 0; p < TileK<BK>::NP; ++p)
        __builtin_amdgcn_global_load_lds((const unsigned*)(rp[p] + k0 + lc * 8), (LAS unsigned*)(tile + p * 4096 + tid * 16), 16, 0, 0);
}
template <int BK>
__device__ __forceinline__ void rows_regular(const bf16_t* (&rp)[TileK<BK>::NP], const bf16_t* base, size_t ld, int tid) {
#pragma unroll
    for (int p = 0; p < TileK<BK>::NP; ++p) { const int r = (BK == 64) ? (p * 32 + (tid >> 3)) : (p * 64 + (tid >> 2)); rp[p] = base + (size_t)r * ld; }
}
template <int BK>
__device__ __forceinline__ int frag_off(int row, int ks, int fq) {
    return (BK == 64) ? (row * 128 + (((ks * 4 + fq) ^ (row & 7)) << 4)) : (row * 64 + ((fq ^ ((row >> 1) & 3)) << 4));
}

template <int BK, int NBOP, bool SWAP, bool FP8 = false>
__device__ __forceinline__ void gemm_loop(const Ctx& c, const bf16_t* const (&ap)[TileK<BK>::NP], const bf16_t* const (&b0p)[TileK<BK>::NP], const bf16_t* const (&b1p)[TileK<BK>::NP],
                                          int K, f32x4 (&acc0)[4][4], f32x4 (&acc1)[4][4]) {
    constexpr int TB = TileK<BK>::TB, SB = (1 + NBOP) * TB;
    static_assert(2 * SB <= LDS_MAIN, "lds");
    const int nk = K / BK, tid = c.tid;
    const int fr = c.lane & 15, fq = c.lane >> 4, wr = c.wave >> 1, wc = c.wave & 1;
    LAS unsigned char* lds = c.lds;
    stage_tile<BK>(lds, ap, 0, tid); stage_tile<BK>(lds + TB, b0p, 0, tid);
    if (NBOP == 2) stage_tile<BK>(lds + 2 * TB, b1p, 0, tid);
    for (int kt = 0; kt < nk; ++kt) {
        VM_WAIT();
        __syncthreads();
        LAS unsigned char* cur = lds + (kt & 1) * SB;
        if (kt + 1 < nk) {
            LAS unsigned char* nxt = lds + ((kt + 1) & 1) * SB;
            stage_tile<BK>(nxt, ap, (kt + 1) * BK, tid); stage_tile<BK>(nxt + TB, b0p, (kt + 1) * BK, tid);
            if (NBOP == 2) stage_tile<BK>(nxt + 2 * TB, b1p, (kt + 1) * BK, tid);
        }
#pragma unroll
        for (int ks = 0; ks < BK / 32; ++ks) {
            bf16x8 af[4], bf0[4], bf1[4];
#pragma unroll
            for (int m = 0; m < 4; ++m) af[m] = *(const LAS bf16x8*)(cur + frag_off<BK>(wr * 64 + m * 16 + fr, ks, fq));
#pragma unroll
            for (int n = 0; n < 4; ++n) bf0[n] = *(const LAS bf16x8*)(cur + TB + frag_off<BK>(wc * 64 + n * 16 + fr, ks, fq));
            if (NBOP == 2) {
#pragma unroll
                for (int n = 0; n < 4; ++n) bf1[n] = *(const LAS bf16x8*)(cur + 2 * TB + frag_off<BK>(wc * 64 + n * 16 + fr, ks, fq));
            }
#pragma unroll
            for (int m = 0; m < 4; ++m)
#pragma unroll
                for (int n = 0; n < 4; ++n) {
                    if (FP8) {
                        const i64x2 a2 = __builtin_bit_cast(i64x2, af[m]), b2 = __builtin_bit_cast(i64x2, bf0[n]);
                        if (SWAP) { acc0[m][n] = __builtin_amdgcn_mfma_f32_16x16x32_fp8_fp8(b2.x, a2.x, acc0[m][n], 0, 0, 0); acc0[m][n] = __builtin_amdgcn_mfma_f32_16x16x32_fp8_fp8(b2.y, a2.y, acc0[m][n], 0, 0, 0); }
                        else      { acc0[m][n] = __builtin_amdgcn_mfma_f32_16x16x32_fp8_fp8(a2.x, b2.x, acc0[m][n], 0, 0, 0); acc0[m][n] = __builtin_amdgcn_mfma_f32_16x16x32_fp8_fp8(a2.y, b2.y, acc0[m][n], 0, 0, 0); }
                        continue;
                    }
                    if (SWAP) acc0[m][n] = __builtin_amdgcn_mfma_f32_16x16x32_bf16(bf0[n], af[m], acc0[m][n], 0, 0, 0);
                    else      acc0[m][n] = __builtin_amdgcn_mfma_f32_16x16x32_bf16(af[m], bf0[n], acc0[m][n], 0, 0, 0);
                    if (NBOP == 2) {
                        if (SWAP) acc1[m][n] = __builtin_amdgcn_mfma_f32_16x16x32_bf16(bf1[n], af[m], acc1[m][n], 0, 0, 0);
                        else      acc1[m][n] = __builtin_amdgcn_mfma_f32_16x16x32_bf16(af[m], bf1[n], acc1[m][n], 0, 0, 0);
                    }
                }
        }
    }
    __syncthreads();
}
__device__ __forceinline__ void zero_acc(f32x4 (&acc)[4][4]) {
#pragma unroll
    for (int m = 0; m < 4; ++m)
#pragma unroll
        for (int n = 0; n < 4; ++n) acc[m][n] = (f32x4){0.f, 0.f, 0.f, 0.f};
}
__device__ __forceinline__ void map_unit(int u, int nnt, int& mt, int& nt) { const int per = 8 * nnt, band = u / per, r = u - band * per; nt = r >> 3; mt = band * 8 + (r & 7); }


__device__ __forceinline__ float gelu_tanh(float x) {
    const float y2 = 1.5957691216057308f * (x + 0.044715f * x * x * x);
    return x * __builtin_amdgcn_rcpf(1.f + __expf(-y2));
}
__device__ __forceinline__ float sigmoidf_(float x) { return __builtin_amdgcn_rcpf(1.f + __expf(-x)); }

__device__ __forceinline__ void row_load(const float* row, int lane, f32x4 (&v)[4]) {
#pragma unroll
    for (int j = 0; j < 4; ++j) v[j] = ((const f32x4*)row)[lane + 64 * j];
}
__device__ __forceinline__ void row_load_h(const bf16_t* row, int lane, f32x4 (&v)[4]) {
#pragma unroll
    for (int j = 0; j < 4; ++j) { const u32x2 w = ((const u32x2*)row)[lane + 64 * j]; v[j] = (f32x4){bf_lo(w.x), bf_hi(w.x), bf_lo(w.y), bf_hi(w.y)}; }
}
__device__ __forceinline__ float row_sumsq(const f32x4 (&v)[4]) {
    float s = 0.f;
#pragma unroll
    for (int j = 0; j < 4; ++j) s += (v[j].x * v[j].x + v[j].y * v[j].y) + (v[j].z * v[j].z + v[j].w * v[j].w);
    return wave_sum(s);
}
__device__ __forceinline__ void gain_load(const float* gain, int lane, f32x4 (&g)[4]) {
#pragma unroll
    for (int j = 0; j < 4; ++j) g[j] = ((const f32x4*)gain)[lane + 64 * j];
}
__device__ __forceinline__ void row_store_norm_bf16(bf16_t* orow, int lane, const f32x4 (&v)[4], float r, const f32x4 (&gv)[4]) {
#pragma unroll
    for (int j = 0; j < 4; ++j) {
        const f32x4 g = gv[j];
        u32x2 o; o.x = pk_bf16(v[j].x * r * g.x, v[j].y * r * g.y); o.y = pk_bf16(v[j].z * r * g.z, v[j].w * r * g.w);
        ((u32x2*)orow)[lane + 64 * j] = o;
    }
}

__device__ __forceinline__ void row_store_h(bf16_t* orow, int lane, const f32x4 (&v)[4]) {
#pragma unroll
    for (int j = 0; j < 4; ++j) { u32x2 o; o.x = pk_bf16(v[j].x, v[j].y); o.y = pk_bf16(v[j].z, v[j].w); ((u32x2*)orow)[lane + 64 * j] = o; }
}
__device__ __forceinline__ unsigned pk_fp8x4(float a, float b, float c_, float d);
__device__ __forceinline__ void row_store_norm_fp8(unsigned char* orow, int lane, const f32x4 (&v)[4], float r, const f32x4 (&gv)[4]) {
#pragma unroll
    for (int j = 0; j < 4; ++j) ((unsigned*)orow)[lane + 64 * j] = pk_fp8x4(v[j].x * r * gv[j].x, v[j].y * r * gv[j].y, v[j].z * r * gv[j].z, v[j].w * r * gv[j].w);
}
constexpr int TR_SCR = 64 * 136;
__device__ __forceinline__ void transpose_item(const float* W, int K, int N, int nvalid, int ldw, bf16_t* WT, LAS unsigned char* scr, int item, int lane) {
    const int nblk = N / 64, kb = item / nblk, nb = item - kb * nblk, k0 = 64 * kb, n0 = 64 * nb;
    const int n = n0 + 4 * (lane & 15);
    const int nc_ = (n < nvalid) ? n : 0; const float keep = (n < nvalid) ? 1.f : 0.f;
    f32x4 v[16];
#pragma unroll
    for (int i = 0; i < 16; ++i) v[i] = *(const f32x4*)(W + (size_t)(k0 + 4 * i + (lane >> 4)) * ldw + nc_);
#pragma unroll
    for (int i = 0; i < 16; ++i) {
        const int kk = 4 * i + (lane >> 4);
        u32x2 o; o.x = pk_bf16(v[i].x * keep, v[i].y * keep); o.y = pk_bf16(v[i].z * keep, v[i].w * keep);
        *(LAS u32x2*)(scr + kk * 136 + (lane & 15) * 8) = o;
    }
    LDS_WAIT();
    const int cc = lane & 7;
#pragma unroll
    for (int j = 0; j < 8; ++j) {
        const int nn = (lane >> 3) + 8 * j; const LAS unsigned short* sp = (const LAS unsigned short*)(scr + (8 * cc) * 136 + nn * 2);
        u32x4 o;
        o.x = (unsigned)sp[0 * 68] | ((unsigned)sp[1 * 68] << 16); o.y = (unsigned)sp[2 * 68] | ((unsigned)sp[3 * 68] << 16);
        o.z = (unsigned)sp[4 * 68] | ((unsigned)sp[5 * 68] << 16); o.w = (unsigned)sp[6 * 68] | ((unsigned)sp[7 * 68] << 16);
        *(u32x4*)(WT + (size_t)(n0 + nn) * K + k0 + 8 * cc) = o;
    }
    LDS_WAIT();
}

__device__ __forceinline__ unsigned pk_fp8x4(float a, float b, float c_, float d) {
    a = fminf(fmaxf(a, -448.f), 448.f); b = fminf(fmaxf(b, -448.f), 448.f); c_ = fminf(fmaxf(c_, -448.f), 448.f); d = fminf(fmaxf(d, -448.f), 448.f);
    int p = __builtin_amdgcn_cvt_pk_fp8_f32(a, b, 0, false);
    p = __builtin_amdgcn_cvt_pk_fp8_f32(c_, d, p, true);
    return (unsigned)p;
}
__device__ __forceinline__ unsigned pk_fp8x4_nc(float a, float b, float c_, float d) {
    int p = __builtin_amdgcn_cvt_pk_fp8_f32(a, b, 0, false);
    p = __builtin_amdgcn_cvt_pk_fp8_f32(c_, d, p, true);
    return (unsigned)p;
}
constexpr float W8_SCALE = 64.f, H8_SCALE = 4.f, O8_SCALE = 8.f;
__device__ __forceinline__ void transpose_item8(const float* W, int K, int N, unsigned char* WT, LAS unsigned char* scr, int item, int lane, int nvalid = 1 << 30, int ldw = 0) {
    const int nblk = N / 64, kb = item / nblk, nb = item - kb * nblk, k0 = 128 * kb, n0 = 64 * nb;
    const int n = n0 + 4 * (lane & 15), ld = ldw ? ldw : N, nc_ = (n < nvalid) ? n : 0; const float keep = (n < nvalid) ? W8_SCALE : 0.f;
#pragma unroll 2
    for (int h = 0; h < 2; ++h) {
        f32x4 v[16];
#pragma unroll
        for (int i = 0; i < 16; ++i) v[i] = *(const f32x4*)(W + (size_t)(k0 + 64 * h + 4 * i + (lane >> 4)) * ld + nc_);
#pragma unroll
        for (int i = 0; i < 16; ++i) { const int kk = 64 * h + 4 * i + (lane >> 4);
            *(LAS unsigned*)(scr + kk * 68 + (lane & 15) * 4) = pk_fp8x4_nc(v[i].x * keep, v[i].y * keep, v[i].z * keep, v[i].w * keep); }
    }
    LDS_WAIT();
    const int cc = lane & 7;
#pragma unroll
    for (int j = 0; j < 8; ++j) {
        const int nn = (lane >> 3) + 8 * j; const LAS unsigned char* sp = scr + (16 * cc) * 68 + nn;
        unsigned w[4];
#pragma unroll
        for (int q = 0; q < 4; ++q) w[q] = (unsigned)sp[(4 * q + 0) * 68] | ((unsigned)sp[(4 * q + 1) * 68] << 8) | ((unsigned)sp[(4 * q + 2) * 68] << 16) | ((unsigned)sp[(4 * q + 3) * 68] << 24);
        u32x4 o = {w[0], w[1], w[2], w[3]};
        *(u32x4*)(WT + (size_t)(n0 + nn) * K + k0 + 16 * cc) = o;
    }
    LDS_WAIT();
}
__device__ __forceinline__ void convert_moe_item(const Ctx& c, int l, int it, LAS unsigned char* scr) {
    const float* w1 = (const float*)c.a->in[IN_W1] + (size_t)l * NE * D * DE;
    const float* w3 = (const float*)c.a->in[IN_W3] + (size_t)l * NE * D * DE;
    const float* w2 = (const float*)c.a->in[IN_W2] + (size_t)l * NE * DE * D;
    unsigned char* W3 = c.ws + WS_W3; unsigned char* W2 = c.ws + WS_W2;
    const int e = it / 192, r = it - e * 192;
    if (r < 64)       transpose_item8(w1 + (size_t)e * D * DE, D, DE, W3 + ((size_t)e * 1024 + ((r & 7) >> 1) * 128) * D, scr, r, c.lane);
    else if (r < 128) transpose_item8(w3 + (size_t)e * D * DE, D, DE, W3 + ((size_t)e * 1024 + ((r & 7) >> 1) * 128 + 128) * D, scr, r - 64, c.lane);
    else              transpose_item8(w2 + (size_t)e * DE * D, DE, D, W2 + (size_t)e * D * DE, scr, r - 128, c.lane);
}
__device__ __forceinline__ void convert_moe_layer(const Ctx& c, int l) {
    LAS unsigned char* scr = c.lds + c.wave * TR_SCR;
    const int gw = c.vb * 4 + c.wave, ngw = c.nb * 4;
    for (int it = gw; it < NE * 192; it += ngw) convert_moe_item(c, l, it, scr);
}

__device__ __forceinline__ void phase_prep(const Ctx& c) {
    const __attribute__((address_space(4))) Args& a = *c.a;
    LAS unsigned char* scr = c.lds + c.wave * TR_SCR;
    const int gw = c.vb * 4 + c.wave, ngw = c.nb * 4;
    constexpr int I_AIN = 16 * 64, I_AOUT = 32 * 16, I_PP = 4 * 16, I_BIN8 = 8 * 34, I_BOUT8 = 8 * 16, I_PG8 = 8 * 16, I_BINI = 16 * 10;
    constexpr int NIT = I_AIN + I_AOUT + 2 * I_PP + I_BIN8 + I_BOUT8 + 2 * I_PG8 + I_BINI;
    for (int it = gw; it < NIT; it += ngw) {
        int r = it;
        if (r < I_AIN) { transpose_item((const float*)a.in[IN_AWIN], D, 4096, 4096, 4096, (bf16_t*)(c.ws + WS_WAIN), scr, r, c.lane); continue; } r -= I_AIN;
        if (r < I_AOUT) { transpose_item((const float*)a.in[IN_AWOUT], GW, D, D, D, (bf16_t*)(c.ws + WS_WAOUT), scr, r, c.lane); continue; } r -= I_AOUT;
        if (r < 2 * I_PP) { const int l = r / I_PP; transpose_item((const float*)a.in[IN_PLEP] + (size_t)l * PLE * D, PLE, D, D, D, (bf16_t*)(c.ws + WS_WPROJ) + (size_t)l * D * PLE, scr, r - l * I_PP, c.lane); continue; } r -= 2 * I_PP;
        if (r < I_BIN8) { transpose_item8((const float*)a.in[IN_BWIN], D, BINP, c.ws + WS_WBIN, scr, r, c.lane, BIN, BIN); continue; } r -= I_BIN8;
        if (r < I_BOUT8) { transpose_item8((const float*)a.in[IN_BWOUT], D, D, c.ws + WS_WBOUT, scr, r, c.lane); continue; } r -= I_BOUT8;
        if (r < 2 * I_PG8) { const int l = r / I_PG8; transpose_item8((const float*)a.in[IN_PLEG] + (size_t)l * D * D, D, D, c.ws + WS_WGATE + (size_t)l * D * D, scr, r - l * I_PG8, c.lane); continue; } r -= 2 * I_PG8;
        transpose_item((const float*)a.in[IN_BWIN] + 1536, D, 640, BIN - 1536, BIN, (bf16_t*)(c.ws + WS_WBIN + 3 * MB), scr, r, c.lane);
    }
    convert_moe_layer(c, 0);
    const int gt = c.vb * NTH + c.tid, ngt = c.nb * NTH;
    { const float* p = (const float*)a.in[IN_P]; bf16_t* pb = (bf16_t*)(c.ws + WS_PBF);
      for (int i = gt; i < 2 * T * PLE / 8; i += ngt) {
          const f32x4 v0 = ((const f32x4*)p)[2 * i], v1 = ((const f32x4*)p)[2 * i + 1];
          u32x4 o; o.x = pk_bf16(v0.x, v0.y); o.y = pk_bf16(v0.z, v0.w); o.z = pk_bf16(v1.x, v1.y); o.w = pk_bf16(v1.z, v1.w);
          ((u32x4*)pb)[i] = o; } }
    { float* wr = (float*)(c.ws + WS_WR);
      for (int i = gt; i < 2 * D * 48; i += ngt) {
          const int l = i / (D * 48), r = i - l * D * 48, k = r / 48, o = r - k * 48;
          float w = 0.f;
          if (o < 4) w = ((const float*)a.in[IN_WG])[(size_t)l * D * 4 + k * 4 + o];
          else if (o < 36) w = ((const float*)a.in[IN_WE])[(size_t)l * D * 32 + k * 32 + (o - 4)];
          const int kh = k >> 9, q = (k >> 7) & 3, ii = (k >> 2) & 31, e = k & 3, nt = o >> 4, m = o & 15;
          wr[(size_t)l * D * 48 + ((((kh * 32 + ii) * 3 + nt) * 64 + q * 16 + m) << 2) + e] = w * ((const float*)a.in[IN_FFNN])[l * D + k]; } }
    if (c.vb == 0) for (int i = c.tid; i < 4 * NSUB * 32; i += 256) ((int*)(c.ws + WS_CNT))[i * CNT_STRIDE] = 0;
    f32x4 gv[4]; gain_load((const float*)a.in[IN_MIXN], c.lane, gv);
    for (int t = gw; t < T; t += ngw) {
        f32x4 v[4]; row_load((const float*)a.in[IN_X] + (size_t)t * D, c.lane, v);
        const float r = rsqrtf(row_sumsq(v) * (1.f / D) + EPS);
        row_store_norm_bf16((bf16_t*)(c.ws + WS_XN) + (size_t)t * D, c.lane, v, r, gv);
    }
}

namespace pg8 {
#define PG8_LAS __attribute__((address_space(3)))
typedef unsigned short bf16_t;
typedef short bf16x8 __attribute__((ext_vector_type(8)));
typedef float f32x4 __attribute__((ext_vector_type(4)));
typedef unsigned u32x4 __attribute__((ext_vector_type(4)));
constexpr int BM = 256, BK = 64, HALF = 128, HTB = HALF * BK * 2  , STAGE_BYTES = 8 * HTB, NXCD = 8, WGM = 8;

__host__ __device__ __forceinline__ int lds_byte(int r, int c) { const int st = (r >> 4) * 2 + (c >> 5), rr = r & 15, cc = c & 31, ob = rr * 64 + cc * 2; return st * 1024 + (ob ^ (((ob >> 9) & 1) << 5)); }
__host__ __device__ __forceinline__ void stage_rc(int b, int& R, int& C) { const int st = b / 1024, sb = b % 1024, swz = sb ^ (((sb >> 9) & 1) << 5); R = (st >> 1) * 16 + swz / 64; C = (st & 1) * 32 + (swz % 64) / 2; }
__host__ __device__ __forceinline__ int perm32(int rho) { const int n = rho >> 4, i = rho & 15; return 8 * (i >> 2) + 4 * n + (i & 3); }

struct Unit { int pm, pn, aux; };
struct Gemm { const bf16_t* A; const bf16_t* Bt; int M, N, K; };

struct StaticOrder {
    int nM, nN, nwg, G, c;
    __host__ __device__ void init(int M, int N, int G_, int c_) { nM = M / BM; nN = N / BM; nwg = nM * nN; G = G_; c = c_; }
    __host__ __device__ bool next(int i, Unit& u) const {
        const long L = (long)i * G + c; if (L >= nwg) return false;
        int wgid = (int)L; { const int q = nwg / NXCD, r = nwg % NXCD, xcd = wgid % NXCD, off = wgid / NXCD; wgid = (xcd < r ? xcd * (q + 1) : r * (q + 1) + (xcd - r) * q) + off; }
        const int nig = WGM * nN, gid = wgid / nig, fm = gid * WGM, gsz = (nM - fm) < WGM ? (nM - fm) : WGM;
        u.pm = fm + ((wgid % nig) % gsz); u.pn = (wgid % nig) / gsz; return true;
    }
    __device__ __forceinline__ void a_ready(const Unit&) const {}
    __device__ __forceinline__ void done(const Unit&) const {}
};


template <class Epi, class Sched, bool ALIGN_EPI = false, bool SP2 = false, bool FP8 = false, bool GATHER = false>
__device__ __forceinline__ void gemm_phase(PG8_LAS unsigned char* lds, const Gemm g, const Sched& S, const Epi& E, const PG8_LAS unsigned* gtab = nullptr) {
    int tido_ = threadIdx.x; asm volatile("" : "+v"(tido_));
    const int tid = tido_, wid = __builtin_amdgcn_readfirstlane(tid >> 6), lane = tid & 63, wr = wid >> 2, wc = wid & 3, fr = lane & 15, fq = lane >> 4;
    int Kop_ = g.K; asm volatile("" : "+s"(Kop_));
    const int K = Kop_, nt = K / BK;
    unsigned voffA[2], voffB[2];
#pragma unroll
    for (int i = 0; i < 2; ++i) { int R, C; stage_rc(tid * 16 + i * 8192, R, C); const int Rb = Epi::PERM ? ((R & ~31) + perm32(R & 31)) : R;
        voffA[i] = GATHER ? (unsigned)(R * 4 + C * 2 * 65536) : (unsigned)(R * K + C) * 2u; voffB[i] = (unsigned)(Rb * K + C) * 2u; }
    unsigned gA[2][2] = {{0u, 0u}, {0u, 0u}};
#define PG8_GLOAD(slot) do { _Pragma("unroll") for (int h_ = 0; h_ < 2; ++h_) _Pragma("unroll") for (int i_ = 0; i_ < 2; ++i_) \
        gA[h_][i_] = *(const PG8_LAS unsigned*)((const PG8_LAS unsigned char*)gtab + (slot) * 1024 + h_ * 512 + (voffA[i_] & 0xffffu)) + (voffA[i_] >> 16); } while (0)
#define PG8_STA(bufoff, base, h) do { if constexpr (GATHER) PG8_STAGE(bufoff, base, gA[h]); else PG8_STAGE(bufoff, (base) + (h) * hstep, voffA); } while (0)
    const size_t kstep = (size_t)(BK * 2);
    const size_t hstep = (size_t)HALF * K * 2;
    const size_t tstep = 2 * hstep;
    const unsigned ldsw = (unsigned)wid * 1024u;
    const int aoff = lds_byte(wr * 64 + fr, fq * 8), boff = lds_byte(wc * 32 + fr, fq * 8);
#define PG8_SA(b, h) (((b) * 2 + (h)) * HTB)
#define PG8_SB(b, h) ((4 + (b) * 2 + (h)) * HTB)
#define PG8_STAGE(bufoff, gbase, voff) do { _Pragma("unroll") for (int _i = 0; _i < 2; ++_i) \
        __builtin_amdgcn_global_load_lds((const unsigned*)((const char*)(gbase) + (voff)[_i]), (PG8_LAS unsigned*)(lds + (bufoff) + ldsw + _i * 8192), 16, 0, 0); } while (0)
#define PG8_LDA(dst, b, h) do { _Pragma("unroll") for (int m = 0; m < 4; ++m) dst[m] = __builtin_shufflevector(*(const PG8_LAS i32x4*)(lds + PG8_SA(b, h) + aoff + m * 2048), *(const PG8_LAS i32x4*)(lds + PG8_SA(b, h) + aoff + m * 2048 + 1024), 0, 1, 2, 3, 4, 5, 6, 7); } while (0)
#define PG8_LDB(dst, b, h) do { _Pragma("unroll") for (int n = 0; n < 2; ++n) dst[n] = __builtin_shufflevector(*(const PG8_LAS i32x4*)(lds + PG8_SB(b, h) + boff + n * 2048), *(const PG8_LAS i32x4*)(lds + PG8_SB(b, h) + boff + n * 2048 + 1024), 0, 1, 2, 3, 4, 5, 6, 7); } while (0)
#define PG8_MMA(ai, bj, At, Bt) do { __builtin_amdgcn_s_setprio(1); _Pragma("unroll") for (int m = 0; m < 4; ++m) _Pragma("unroll") for (int n = 0; n < 2; ++n) { \
        if constexpr (FP8)      \
            asm volatile("v_mfma_scale_f32_16x16x128_f8f6f4 %0, %1, %2, %0, %3, %3 op_sel_hi:[0,0,0]" : "+v"(acc[ai][bj][m][n]) : "v"(Bt[n]), "v"(At[m]), "v"(one8_)); \
        else { acc[ai][bj][m][n] = __builtin_amdgcn_mfma_f32_16x16x32_bf16(__builtin_bit_cast(bf16x8, __builtin_shufflevector(Bt[n], Bt[n], 0, 1, 2, 3)), __builtin_bit_cast(bf16x8, __builtin_shufflevector(At[m], At[m], 0, 1, 2, 3)), acc[ai][bj][m][n], 0, 0, 0); \
               acc[ai][bj][m][n] = __builtin_amdgcn_mfma_f32_16x16x32_bf16(__builtin_bit_cast(bf16x8, __builtin_shufflevector(Bt[n], Bt[n], 4, 5, 6, 7)), __builtin_bit_cast(bf16x8, __builtin_shufflevector(At[m], At[m], 4, 5, 6, 7)), acc[ai][bj][m][n], 0, 0, 0); } } __builtin_amdgcn_s_setprio(0); } while (0)
#define PG8_WAIT_V(n) asm volatile("s_waitcnt vmcnt(" #n ")" ::: "memory")
#define PG8_WAIT_L(n) asm volatile("s_waitcnt lgkmcnt(" #n ")" ::: "memory")
#define PG8_BAR __builtin_amdgcn_s_barrier()
#define PG8_SCHED __builtin_amdgcn_sched_barrier(0)
    Unit cur, nxt; int ui = 0;
    if (!S.next(0, cur)) return;
    int one8_ = 0x7f7f7f7f; asm volatile("" : "+v"(one8_));
    f32x4 acc[2][2][4][2];
    float zf_ = 0.f; asm volatile("" : "+v"(zf_));
#pragma unroll
    for (int a = 0; a < 2; ++a)
#pragma unroll
        for (int b = 0; b < 2; ++b)
#pragma unroll
            for (int m = 0; m < 4; ++m)
#pragma unroll
                for (int n = 0; n < 2; ++n) acc[a][b][m][n] = (f32x4){zf_, zf_, zf_, zf_};
    i32x8 At[4], B0[2], B1[2];
    const char* cA = (const char*)g.A + (GATHER ? (size_t)0 : (size_t)cur.pm * tstep); const char* cB = (const char*)g.Bt + (size_t)cur.pn * tstep;
    S.a_ready(cur);
    if constexpr (GATHER) PG8_GLOAD(cur.pm);
    if constexpr (SP2) {
        PG8_STAGE(PG8_SB(0, 0), cB, voffB); PG8_STAGE(PG8_SB(0, 1), cB + hstep, voffB); PG8_STA(PG8_SA(0, 0), cA, 0); PG8_STA(PG8_SA(0, 1), cA, 1);
        if (wr == 1) PG8_BAR;
        PG8_WAIT_V(2); PG8_BAR;
        PG8_STAGE(PG8_SB(1, 0), cB + kstep, voffB); PG8_STA(PG8_SA(1, 0), cA + kstep, 0); PG8_STAGE(PG8_SB(1, 1), cB + hstep + kstep, voffB);
        PG8_WAIT_V(6); PG8_BAR;
    } else {
        PG8_STAGE(PG8_SB(0, 0), cB, voffB); PG8_STA(PG8_SA(0, 0), cA, 0); PG8_STAGE(PG8_SB(0, 1), cB + hstep, voffB); PG8_STA(PG8_SA(0, 1), cA, 1);
        if (wr == 1) PG8_BAR;
        PG8_WAIT_V(4); PG8_BAR;
        PG8_STAGE(PG8_SB(1, 0), cB + kstep, voffB); PG8_STA(PG8_SA(1, 0), cA + kstep, 0); PG8_STAGE(PG8_SB(1, 1), cB + hstep + kstep, voffB);
        PG8_WAIT_V(6); PG8_BAR;
    }
    for (;;) {
        const bool has_next = S.next(ui + 1, nxt);
        const char* nA = (has_next && !GATHER) ? (const char*)g.A + (size_t)nxt.pm * tstep : cA; const char* nB = has_next ? (const char*)g.Bt + (size_t)nxt.pn * tstep : cB;
        for (int t = 0; t < nt; t += 2) {
            const bool last = (t == nt - 2);
            const char* a1 = cA + (size_t)(t + 1) * kstep;
            const char* a2 = last ? nA : cA + (size_t)(t + 2) * kstep; const char* b2 = last ? nB : cB + (size_t)(t + 2) * kstep;
            const char* a3 = a2 + kstep; const char* b3 = b2 + kstep;
            if (last && has_next) S.a_ready(nxt);
            if constexpr (SP2) {
            PG8_LDB(B0, 0, 0); PG8_LDB(B1, 0, 1); PG8_SCHED; PG8_LDA(At, 0, 0); PG8_STA(PG8_SA(1, 1), a1, 1);
            if constexpr (GATHER) { if (last && has_next) PG8_GLOAD(nxt.pm); }
            PG8_WAIT_V(8); PG8_WAIT_L(0); PG8_BAR; PG8_MMA(0, 0, At, B0); PG8_MMA(0, 1, At, B1); PG8_BAR; PG8_SCHED;
            PG8_LDA(At, 0, 1); PG8_STAGE(PG8_SB(0, 0), b2, voffB); PG8_STAGE(PG8_SB(0, 1), b2 + hstep, voffB); PG8_STA(PG8_SA(0, 0), a2, 0);
            PG8_WAIT_V(8); PG8_WAIT_L(0); PG8_BAR; PG8_MMA(1, 0, At, B0); PG8_MMA(1, 1, At, B1); PG8_BAR; PG8_SCHED;
            PG8_LDB(B0, 1, 0); PG8_LDB(B1, 1, 1); PG8_SCHED; PG8_LDA(At, 1, 0); PG8_STA(PG8_SA(0, 1), a2, 1);
            PG8_WAIT_V(8); PG8_WAIT_L(0); PG8_BAR; PG8_MMA(0, 0, At, B0); PG8_MMA(0, 1, At, B1); PG8_BAR; PG8_SCHED;
            PG8_LDA(At, 1, 1); PG8_STAGE(PG8_SB(1, 0), b3, voffB); PG8_STAGE(PG8_SB(1, 1), b3 + hstep, voffB); PG8_STA(PG8_SA(1, 0), a3, 0);
            PG8_WAIT_V(8); PG8_WAIT_L(0); PG8_BAR; PG8_MMA(1, 0, At, B0); PG8_MMA(1, 1, At, B1); PG8_BAR; PG8_SCHED;
            } else {
            static_assert(SP2 || !GATHER, "GATHER is wired into the SP2 loop only");
            PG8_LDB(B0, 0, 0); PG8_SCHED; PG8_LDA(At, 0, 0); PG8_STAGE(PG8_SA(1, 1), a1 + hstep, voffA);
            PG8_WAIT_L(8); PG8_BAR; PG8_WAIT_L(0); PG8_MMA(0, 0, At, B0); PG8_BAR; PG8_SCHED;
            PG8_LDB(B1, 0, 1); PG8_STAGE(PG8_SB(0, 0), b2, voffB);
            PG8_BAR; PG8_WAIT_L(0); PG8_MMA(0, 1, At, B1); PG8_BAR;
            PG8_LDA(At, 0, 1); PG8_STAGE(PG8_SA(0, 0), a2, voffA);
            PG8_BAR; PG8_WAIT_L(0); PG8_MMA(1, 0, At, B0); PG8_BAR; PG8_SCHED;
            PG8_STAGE(PG8_SB(0, 1), b2 + hstep, voffB);
            PG8_WAIT_V(6); PG8_BAR; PG8_MMA(1, 1, At, B1); PG8_BAR;
            PG8_LDB(B0, 1, 0); PG8_SCHED; PG8_LDA(At, 1, 0); PG8_STAGE(PG8_SA(0, 1), a2 + hstep, voffA);
            PG8_WAIT_L(8); PG8_BAR; PG8_WAIT_L(0); PG8_MMA(0, 0, At, B0); PG8_BAR; PG8_SCHED;
            PG8_LDB(B1, 1, 1); PG8_STAGE(PG8_SB(1, 0), b3, voffB);
            PG8_BAR; PG8_WAIT_L(0); PG8_MMA(0, 1, At, B1); PG8_BAR;
            PG8_LDA(At, 1, 1); PG8_STAGE(PG8_SA(1, 0), a3, voffA);
            PG8_BAR; PG8_WAIT_L(0); PG8_MMA(1, 0, At, B0); PG8_BAR; PG8_SCHED;
            PG8_STAGE(PG8_SB(1, 1), b3 + hstep, voffB);
            PG8_WAIT_V(6); PG8_BAR; PG8_MMA(1, 1, At, B1); PG8_BAR;
            }
        }
        if constexpr (ALIGN_EPI) { if (wr == 0) PG8_BAR; }
        if constexpr (FP8) asm volatile("s_nop 15\n\ts_nop 15" ::: "memory");
        if constexpr (!Epi::AFTER_DRAIN) { int le_ = lane; asm volatile("" : "+v"(le_));
            E(acc, cur, wr, wc, le_ & 15, le_ >> 4); S.done(cur); }
        if (!has_next) break;
        asm volatile("v_mov_b32 %0, 0" : "=v"(zf_));
#pragma unroll
        for (int a = 0; a < 2; ++a)
#pragma unroll
            for (int b = 0; b < 2; ++b)
#pragma unroll
                for (int m = 0; m < 4; ++m)
#pragma unroll
                    for (int n = 0; n < 2; ++n) acc[a][b][m][n] = (f32x4){zf_, zf_, zf_, zf_};
        cur = nxt; cA = nA; cB = nB; ++ui;
        if constexpr (ALIGN_EPI) { if (wr == 1) PG8_BAR; }
    }
    PG8_WAIT_V(0);
    if constexpr (!ALIGN_EPI) { if (wr == 0) PG8_BAR; }
    PG8_BAR;
    if constexpr (Epi::AFTER_DRAIN) { E.fused(acc, cur, wr, wc, fr, fq, lds, wid, lane); S.done(cur); }
#undef PG8_SA
#undef PG8_STA
#undef PG8_GLOAD
#undef PG8_SB
#undef PG8_STAGE
#undef PG8_LDA
#undef PG8_LDB
#undef PG8_MMA
#undef PG8_WAIT_V
#undef PG8_WAIT_L
#undef PG8_BAR
#undef PG8_SCHED
}

}

struct EpiA1U {
    static constexpr bool PERM = true, AFTER_DRAIN = false;
    bf16_t* U;
    __device__ __forceinline__ void operator()(const pg8::f32x4 (&acc)[2][2][4][2], const pg8::Unit& u, int wr, int wc, int fr, int fq) const {
        bf16_t* up = U + (size_t)(u.pm * 256 + wr * 64 + fr) * GW + u.pn * 256 + wc * 32 + 8 * fq;
#pragma unroll
        for (int ai = 0; ai < 2; ++ai)
#pragma unroll
            for (int m = 0; m < 4; ++m)
#pragma unroll
                for (int bj = 0; bj < 2; ++bj) {
                    const f32x4 v0 = acc[ai][bj][m][0], v1 = acc[ai][bj][m][1];
                    u32x4 w; w.x = pk_bf16(gelu_tanh(v0.x), gelu_tanh(v0.y)); w.y = pk_bf16(gelu_tanh(v0.z), gelu_tanh(v0.w)); w.z = pk_bf16(gelu_tanh(v1.x), gelu_tanh(v1.y)); w.w = pk_bf16(gelu_tanh(v1.z), gelu_tanh(v1.w));
                    *(u32x4*)(up + (size_t)(ai * 128 + m * 16) * GW + bj * 128) = w;
                }
    }
};
struct EpiA1V {
    static constexpr bool PERM = true, AFTER_DRAIN = false;
    bf16_t* VT; float* VSS;
    __device__ __forceinline__ void operator()(const pg8::f32x4 (&acc)[2][2][4][2], const pg8::Unit& u, int wr, int wc, int fr, int fq) const {
        const int tok0 = u.pn * 256 + wc * 32 + 8 * fq;
        bf16_t* vp = VT + (size_t)(u.pm * 256 + wr * 64 + fr) * T + tok0;
        f32x4 ss[2][2];
#pragma unroll
        for (int bj = 0; bj < 2; ++bj) { ss[bj][0] = (f32x4){0.f, 0.f, 0.f, 0.f}; ss[bj][1] = (f32x4){0.f, 0.f, 0.f, 0.f}; }
#pragma unroll
        for (int ai = 0; ai < 2; ++ai)
#pragma unroll
            for (int m = 0; m < 4; ++m)
#pragma unroll
                for (int bj = 0; bj < 2; ++bj) {
                    f32x4 v0 = acc[ai][bj][m][0], v1 = acc[ai][bj][m][1];
                    v0.x = gelu_tanh(v0.x); v0.y = gelu_tanh(v0.y); v0.z = gelu_tanh(v0.z); v0.w = gelu_tanh(v0.w);
                    v1.x = gelu_tanh(v1.x); v1.y = gelu_tanh(v1.y); v1.z = gelu_tanh(v1.z); v1.w = gelu_tanh(v1.w);
                    ss[bj][0] += v0 * v0; ss[bj][1] += v1 * v1;
                    u32x4 w; w.x = pk_bf16(v0.x, v0.y); w.y = pk_bf16(v0.z, v0.w); w.z = pk_bf16(v1.x, v1.y); w.w = pk_bf16(v1.z, v1.w);
                    *(u32x4*)(vp + (size_t)(ai * 128 + m * 16) * T + bj * 128) = w;
                }
#pragma unroll
        for (int bj = 0; bj < 2; ++bj)
#pragma unroll
            for (int n = 0; n < 2; ++n) {
                f32x4 q = ss[bj][n];
#pragma unroll
                for (int o = 1; o < 16; o <<= 1) { q.x += __shfl_xor(q.x, o); q.y += __shfl_xor(q.y, o); q.z += __shfl_xor(q.z, o); q.w += __shfl_xor(q.w, o); }
                if (fr == 0) *(f32x4*)(VSS + (size_t)(u.pm * 2 + wr) * T + tok0 + bj * 128 + 4 * n) = q;
            }
    }
};
__device__ __forceinline__ void phase_a1(const Ctx& c) {
    const pg8::bf16_t* XN = (const pg8::bf16_t*)(c.ws + WS_XN); const pg8::bf16_t* W = (const pg8::bf16_t*)(c.ws + WS_WAIN);
    {
        pg8::Gemm g{XN, W, T, GW, D}; pg8::StaticOrder S; S.init(T, GW, (int)gridDim.x, (int)blockIdx.x);
        EpiA1U E{(bf16_t*)(c.ws + WS_U)};
        pg8::gemm_phase<EpiA1U, pg8::StaticOrder, false, true, false>(c.ldsp, g, S, E);
    }
    __syncthreads();
    {
        pg8::Gemm g{W + (size_t)GW * D, XN, GW, T, D}; pg8::StaticOrder S; S.init(GW, T, (int)gridDim.x, (int)blockIdx.x);
        EpiA1V E{(bf16_t*)(c.ws + WS_VT), (float*)(c.ws + WS_VSS)};
        pg8::gemm_phase<EpiA1V, pg8::StaticOrder, false, true, false>(c.ldsp, g, S, E);
    }
}

__device__ __forceinline__ void phase_a2(const Ctx& c, bool dry = false) {
    const __attribute__((address_space(4))) Args& a = *c.a;
    bf16_t* U = (bf16_t*)(c.ws + WS_U); const bf16_t* VT = (const bf16_t*)(c.ws + WS_VT); const float* VSS = (const float*)(c.ws + WS_VSS);
    const float* ws_ = (const float*)a.in[IN_AWS]; const float* bs_ = (const float*)a.in[IN_ABS]; const float* vg = (const float*)a.in[IN_AVG];
    const int fr = c.lane & 15, fq = c.lane >> 4, wr = c.wave >> 1, wc = c.wave & 1, tid = c.tid;
    LAS unsigned char* lds = c.lds;
    LAS float* rl = (LAS float*)(lds + LDS_MAIN);
    for (int u = c.vb; u < 128 * 8; u += c.nb) {
        const int ci = u >> 3, g = u & 7, tokbase = ci * 128;
        __syncthreads();
        if (tid < 128) {
            const float* p = VSS + tokbase + tid; float s = 0.f;
#pragma unroll
            for (int i = 0; i < 16; ++i) s += p[(size_t)i * T];
            rl[tid] = rsqrtf(s * (1.f / GW) + EPS);
        }
        __syncthreads();
        {
            const int t = tid >> 1, half = tid & 1;
            const float* wrow = ws_ + ((size_t)g * 128 + t) * 128 + half * 64;
#pragma unroll
            for (int cc = 0; cc < 8; ++cc) {
                const int s0 = half * 64 + cc * 8;
                u32x4 o;
                {
                    const f32x4 w0 = ((const f32x4*)wrow)[2 * cc], w1 = ((const f32x4*)wrow)[2 * cc + 1];
                    float e[8] = {w0.x, w0.y, w0.z, w0.w, w1.x, w1.y, w1.z, w1.w};
                    const f32x4 r0_ = *(const LAS f32x4*)(rl + s0), r1_ = *(const LAS f32x4*)(rl + s0 + 4);
                    const float rr[8] = {r0_.x, r0_.y, r0_.z, r0_.w, r1_.x, r1_.y, r1_.z, r1_.w};
#pragma unroll
                    for (int i = 0; i < 8; ++i) e[i] = (s0 + i <= t) ? e[i] * rr[i] : 0.f;
                    o.x = pk_bf16(e[0], e[1]); o.y = pk_bf16(e[2], e[3]); o.z = pk_bf16(e[4], e[5]); o.w = pk_bf16(e[6], e[7]);
                }
                *(LAS u32x4*)(lds + half * 16384 + t * 128 + ((cc ^ (t & 7)) << 4)) = o;
            }
        }
        for (int hn = 0; hn < 2; ++hn) {
            const int c0 = g * 256 + hn * 128;
            const bf16_t* bp[4]; rows_regular<64>(bp, VT + (size_t)c0 * T + tokbase, T, tid);
            stage_tile<64>(lds + 32768, bp, 0, tid); stage_tile<64>(lds + 32768 + 16384, bp, 64, tid);
            VM_WAIT();
            __syncthreads();
            f32x4 acc[4][4]; zero_acc(acc);
#pragma unroll 1
            for (int kh = 0; kh < 2; ++kh)
#pragma unroll 1
                for (int ks = 0; ks < 2; ++ks) {
                    bf16x8 af[4], bf[4];
#pragma unroll
                    for (int m = 0; m < 4; ++m) af[m] = *(const LAS bf16x8*)(lds + kh * 16384 + frag_off<64>(wr * 64 + m * 16 + fr, ks, fq));
#pragma unroll
                    for (int n = 0; n < 4; ++n) bf[n] = *(const LAS bf16x8*)(lds + 32768 + kh * 16384 + frag_off<64>(wc * 64 + n * 16 + fr, ks, fq));
#pragma unroll
                    for (int m = 0; m < 4; ++m)
#pragma unroll
                        for (int n = 0; n < 4; ++n) acc[m][n] = __builtin_amdgcn_mfma_f32_16x16x32_bf16(bf[n], af[m], acc[m][n], 0, 0, 0);
                }
            u32x2 uvv[4][4]; float bsvv[4];
#pragma unroll
            for (int m = 0; m < 4; ++m) { const int tl = wr * 64 + m * 16 + fr; bsvv[m] = bs_[g * 128 + tl];
#pragma unroll
                for (int n = 0; n < 4; ++n) uvv[m][n] = *(const u32x2*)(U + (size_t)(tokbase + tl) * GW + c0 + wc * 64 + n * 16 + fq * 4); }
#pragma unroll
            for (int m = 0; m < 4; ++m) {
                const int tl = wr * 64 + m * 16 + fr; const float bsv = bsvv[m];
#pragma unroll
                for (int n = 0; n < 4; ++n) {
                    const int ch = c0 + wc * 64 + n * 16 + fq * 4;
                    const f32x4 gn = *(const f32x4*)(vg + ch);
                    u32x2* up = (u32x2*)(U + (size_t)(tokbase + tl) * GW + ch);
                    const u32x2 uv = uvv[m][n]; const f32x4 v = acc[m][n];
                    u32x2 o;
                    o.x = pk_bf16(bf_lo(uv.x) * (gn.x * v.x + bsv), bf_hi(uv.x) * (gn.y * v.y + bsv));
                    o.y = pk_bf16(bf_lo(uv.y) * (gn.z * v.z + bsv), bf_hi(uv.y) * (gn.w * v.w + bsv));
                    if (dry) *(u32x2*)(c.ws + 440 * MB + ((size_t)(tokbase + tl) * GW + ch) * 2) = o; else *up = o;
                }
            }
            __syncthreads();
        }
    }
}

template <bool BASE_F32> struct EpiResH {
    static constexpr bool PERM = true, AFTER_DRAIN = false;
    const void* base; bf16_t* out; float ascale;
    __device__ __forceinline__ void operator()(const pg8::f32x4 (&acc)[2][2][4][2], const pg8::Unit& u, int wr, int wc, int fr, int fq) const {
        const size_t o0 = (size_t)(u.pm * 256 + wr * 64 + fr) * D + u.pn * 256 + wc * 32 + 8 * fq;
#pragma unroll
        for (int ai = 0; ai < 2; ++ai)
#pragma unroll
            for (int m = 0; m < 4; ++m) {
                f32x4 b0[2], b1[2];
#pragma unroll
                for (int bj = 0; bj < 2; ++bj) { const size_t o = o0 + (size_t)(ai * 128 + m * 16) * D + bj * 128;
                    if (BASE_F32) { b0[bj] = *(const f32x4*)((const float*)base + o); b1[bj] = *(const f32x4*)((const float*)base + o + 4); }
                    else { const u32x4 w = *(const u32x4*)((const bf16_t*)base + o); b0[bj] = (f32x4){bf_lo(w.x), bf_hi(w.x), bf_lo(w.y), bf_hi(w.y)}; b1[bj] = (f32x4){bf_lo(w.z), bf_hi(w.z), bf_lo(w.w), bf_hi(w.w)}; } }
#pragma unroll
                for (int bj = 0; bj < 2; ++bj) { const size_t o = o0 + (size_t)(ai * 128 + m * 16) * D + bj * 128;
                    const f32x4 v0 = b0[bj] + acc[ai][bj][m][0] * ascale, v1 = b1[bj] + acc[ai][bj][m][1] * ascale;
                    u32x4 w; w.x = pk_bf16(v0.x, v0.y); w.y = pk_bf16(v0.z, v0.w); w.z = pk_bf16(v1.x, v1.y); w.w = pk_bf16(v1.z, v1.w);
                    *(u32x4*)(out + o) = w; }
            }
    }
};
__device__ __forceinline__ void phase_a3(const Ctx& c) {
    pg8::Gemm g{(const pg8::bf16_t*)(c.ws + WS_U), (const pg8::bf16_t*)(c.ws + WS_WAOUT), T, D, GW};
    pg8::StaticOrder S; S.init(T, D, (int)gridDim.x, (int)blockIdx.x);
    EpiResH<true> E{c.a->in[IN_X], (bf16_t*)(c.ws + WS_H), 1.f};
    pg8::gemm_phase<EpiResH<true>, pg8::StaticOrder, false, true, false>(c.ldsp, g, S, E);
}

__device__ __forceinline__ void phase_route(const Ctx& c, int l, bool dry = false) {
    const __attribute__((address_space(4))) Args& a = *c.a;
    const bf16_t* H = (const bf16_t*)(c.ws + WS_H);
    const float* wr_ = (const float*)(c.ws + WS_WR) + (size_t)l * D * 48;
    const float* gain = (const float*)a.in[IN_FFNN] + l * D;
    int* cnt = (int*)(c.ws + WS_CNT) + (size_t)(l + (dry ? 2 : 0)) * NSUB * 32 * CNT_STRIDE; int* list = (int*)(c.ws + (dry ? 480 * MB : WS_LIST)); float* gatel = (float*)(c.ws + (dry ? 484 * MB : WS_GATE)); int* tokslot = (int*)(c.ws + (dry ? 488 * MB : WS_TOKSLOT));
    LAS float* rl = (LAS float*)(c.lds);
    LAS float* lgl = (LAS float*)(c.lds + 256);
    const int lane = c.lane, w = c.wave;
    f32x4 gv[4]; gain_load(gain, lane, gv);
    for (int unit = c.vb; unit < T / 32; unit += c.nb) {
        const int tok0 = unit * 32;
        __syncthreads();
#pragma unroll 1
        for (int i0 = 0; i0 < 8; i0 += 4) {
            f32x4 v[4][4];
#pragma unroll
            for (int i = 0; i < 4; ++i) row_load_h(H + (size_t)(tok0 + w * 8 + i0 + i) * D, lane, v[i]);
#pragma unroll
            for (int i = 0; i < 4; ++i) {
                const int t = tok0 + w * 8 + i0 + i;
                const float r = rsqrtf(row_sumsq(v[i]) * (1.f / D) + EPS);
                if (lane == 0) rl[w * 8 + i0 + i] = r;
                row_store_norm_fp8(c.ws + (dry ? 440 * MB : WS_XN8) + (size_t)t * D, lane, v[i], r, gv);
            }
        }
#ifndef MK_DRYPART
#define MK_DRYPART 3
#endif
        if (!(dry && MK_DRYPART < 2))
        {
            const int th = w & 1, kh = w >> 1, m = lane & 15, q = lane >> 4;
            const u32x2* ap = (const u32x2*)(H + (size_t)(tok0 + 16 * th + m) * D + 512 * kh + 128 * q);
            const f32x4* bp = (const f32x4*)wr_ + (size_t)kh * 32 * 3 * 64 + lane;
            f32x4 acc[3]; acc[0] = acc[1] = acc[2] = (f32x4){0.f, 0.f, 0.f, 0.f};
#pragma unroll 1
            for (int i0 = 0; i0 < 32; i0 += 4) {
                f32x4 av[4], bv[4][3];
#pragma unroll
                for (int i = 0; i < 4; ++i) { { const u32x2 hw = ap[i0 + i]; av[i] = (f32x4){bf_lo(hw.x), bf_hi(hw.x), bf_lo(hw.y), bf_hi(hw.y)}; }
#pragma unroll
                    for (int nt = 0; nt < 3; ++nt) bv[i][nt] = bp[((i0 + i) * 3 + nt) * 64]; }
#pragma unroll
                for (int i = 0; i < 4; ++i)
#pragma unroll
                    for (int e = 0; e < 4; ++e)
#pragma unroll
                        for (int nt = 0; nt < 3; ++nt) acc[nt] = __builtin_amdgcn_mfma_f32_16x16x4f32(av[i][e], bv[i][nt][e], acc[nt], 0, 0, 0);
            }
#pragma unroll
            for (int nt = 0; nt < 3; ++nt)
#pragma unroll
                for (int j = 0; j < 4; ++j) lgl[(kh * 32 + th * 16 + 4 * q + j) * 48 + nt * 16 + m] = acc[nt][j];
        }
        __syncthreads();
        if (c.tid < 32 && !(dry && MK_DRYPART < 3)) {
            const int tt = c.tid, t = tok0 + tt; const float r = rl[tt];
            const float* bg = (const float*)a.in[IN_BG] + l * 4; const float* be = (const float*)a.in[IN_BE] + l * 32;
            float gl[4];
#pragma unroll
            for (int o = 0; o < 4; ++o) gl[o] = (lgl[tt * 48 + o] + lgl[(32 + tt) * 48 + o]) * r + bg[o];
            int gs = 0; float gm = gl[0];
#pragma unroll
            for (int o = 1; o < 4; ++o) if (gl[o] > gm) { gm = gl[o]; gs = o; }
            float gden = 0.f;
#pragma unroll
            for (int o = 0; o < 4; ++o) gden += __expf(gl[o] - gm);
            const float pg = 1.f / gden;
            float l1 = -INFINITY, l2 = -INFINITY; int i1 = 0, i2 = 0;
            for (int i = 0; i < 8; ++i) {
                const int o = 4 + gs * 8 + i;
                const float v = (lgl[tt * 48 + o] + lgl[(32 + tt) * 48 + o]) * r + be[gs * 8 + i];
                if (v > l1) { l2 = l1; i2 = i1; l1 = v; i1 = i; } else if (v > l2) { l2 = v; i2 = i; }
            }
            const float e2 = __expf(l2 - l1), inv = 1.f / (1.f + e2);
            const float g1 = pg * inv, g2 = pg * e2 * inv;
            const int ea = gs * 8 + i1, eb = gs * 8 + i2;
            const int sub = unit & (NSUB - 1);
            const int sa = sub * SUBCAP + atomicAdd(&cnt[(sub * 32 + ea) * CNT_STRIDE], 1), sb = sub * SUBCAP + atomicAdd(&cnt[(sub * 32 + eb) * CNT_STRIDE], 1);
            list[ea * T + sa] = t; gatel[ea * T + sa] = g1; tokslot[2 * t] = (ea << 16) | sa;
            list[eb * T + sb] = t; gatel[eb * T + sb] = g2; tokslot[2 * t + 1] = (eb << 16) | sb;
        }
    }
}

__device__ __forceinline__ void moe_table_build(const unsigned char* ws, int l, int tl, LAS int* pst, LAS int* cn, LAS int* sub) {
    if (tl < 32) {
        const int* cnt = (const int*)(ws + WS_CNT) + (size_t)l * NSUB * 32 * CNT_STRIDE + tl * CNT_STRIDE;
        int v[NSUB];
#pragma unroll
        for (int s2 = 0; s2 < NSUB; ++s2) v[s2] = cnt[(size_t)s2 * 32 * CNT_STRIDE];
        int acc = 0;
#pragma unroll
        for (int s2 = 0; s2 < NSUB; ++s2) { sub[tl * 33 + s2] = acc; acc += v[s2]; }
        sub[tl * 33 + NSUB] = acc; cn[tl] = acc;
        const int nb = (acc + 255) >> 8; int inc = nb;
#pragma unroll
        for (int o = 1; o < 32; o <<= 1) { const int t2 = __shfl_up(inc, o); if (tl >= o) inc += t2; }
        pst[tl] = inc - nb; if (tl == 31) pst[32] = inc;
    }
}
__device__ __forceinline__ void moe_table(const Ctx& c, int l, LAS int* pst, LAS int* cn, LAS int* sub) {
    __syncthreads();
    moe_table_build(c.ws, l, c.tid, pst, cn, sub);
    __syncthreads();
}
__device__ __forceinline__ void moe_table_wg(const Ctx& c, int l, LAS int* pst, LAS int* cn, LAS int* sub) {
    __syncthreads();
    moe_table_build(c.ws, l, (int)threadIdx.x, pst, cn, sub);
    __syncthreads();
}
__device__ __forceinline__ int moe_row_idx(LAS const int* sub, int e, int r) {
    int s2 = 0;
    for (int i = 1; i < NSUB; ++i) s2 = (sub[e * 33 + i] <= r) ? i : s2;
    return s2 * SUBCAP + (r - sub[e * 33 + s2]);
}
__device__ __forceinline__ int moe_find(LAS const int* pst, int mb) { int e = 0; for (int i = 1; i < 32; ++i) e = (pst[i] <= mb) ? i : e; return e; }

constexpr int MOE_LDS = 131072;
constexpr int CAPU = 16;
constexpr int MOE_SUB = MOE_LDS + 1024 + CAPU * 1024;
static_assert(MOE_SUB + 32 * 33 * 4 <= LDS_BYTES - 16, "moe lds");
__device__ __forceinline__ void moe_table_wg(const Ctx& c, int l, LAS int* pst, LAS int* cn) {
    __syncthreads();
    if (threadIdx.x == 0) {
        const int* cnt = (const int*)(c.ws + WS_CNT) + l * 32 * CNT_STRIDE; int acc = 0;
        for (int e = 0; e < 32; ++e) { const int n = cnt[e * CNT_STRIDE]; cn[e] = n; pst[e] = acc; acc += (n + 255) >> 8; }
        pst[32] = acc;
    }
    __syncthreads();
}
struct MoeOrder {
    LAS const int* pst; int nunits, G, c, i0; bool gather;
    __device__ __forceinline__ bool next(int i, pg8::Unit& u) const {
        if (i >= CAPU) return false;
        const long L = (long)(i0 + i) * G + c; if (L >= nunits) return false;
        int wgid = (int)L; { const int q = nunits / 8, r = nunits % 8, xcd = wgid % 8, off = wgid / 8; wgid = (xcd < r ? xcd * (q + 1) : r * (q + 1) + (xcd - r) * q) + off; }
        const int mb = wgid >> 2, e = __builtin_amdgcn_readfirstlane(moe_find(pst, mb));
        u.pm = gather ? i : mb; u.pn = e * 4 + (wgid & 3); u.aux = mb; return true;
    }
    __device__ __forceinline__ void a_ready(const pg8::Unit&) const {}
    __device__ __forceinline__ void done(const pg8::Unit&) const {}
};
struct EpiE1 {
    static constexpr bool PERM = true, AFTER_DRAIN = false;
    unsigned char* HM;
    __device__ __forceinline__ void operator()(const pg8::f32x4 (&acc)[2][2][4][2], const pg8::Unit& u, int wr, int wc, int fr, int fq) const {
        const float ws_ = 1.f / W8_SCALE;
        unsigned char* hp = HM + ((size_t)u.aux * 256 + wr * 64 + fr) * DE + (u.pn & 3) * 128 + wc * 32 + 8 * fq;
#pragma unroll
        for (int ai = 0; ai < 2; ++ai)
#pragma unroll
            for (int m = 0; m < 4; ++m) {
                u32x2 o;
#pragma unroll
                for (int n = 0; n < 2; ++n) {
                    const f32x4 x = acc[ai][0][m][n] * ws_, y = acc[ai][1][m][n] * (ws_ * H8_SCALE);
                    const unsigned w = pk_fp8x4(x.x * sigmoidf_(x.x) * y.x, x.y * sigmoidf_(x.y) * y.y, x.z * sigmoidf_(x.z) * y.z, x.w * sigmoidf_(x.w) * y.w);
                    if (n == 0) o.x = w; else o.y = w;
                }
                *(u32x2*)(hp + (size_t)(ai * 128 + m * 16) * DE) = o;
            }
    }
};
__device__ __forceinline__ void phase_e1(const Ctx& c, int l) {
    LAS int* pst = (LAS int*)(c.ldsp + MOE_LDS); LAS int* cn = pst + 40; LAS unsigned* gtab = (LAS unsigned*)(c.ldsp + MOE_LDS + 1024); LAS int* sub = (LAS int*)(c.ldsp + MOE_SUB);
    moe_table_wg(c, l, pst, cn, sub);
    const float* gatel = (const float*)(c.ws + WS_GATE); float* grow = (float*)(c.ws + WS_GROW);
    const int* list = (const int*)(c.ws + WS_LIST);
    pg8::Gemm g{(const pg8::bf16_t*)(c.ws + WS_XN8), (const pg8::bf16_t*)(c.ws + WS_W3), RPAD, 1024, D / 2};
    MoeOrder S{pst, __builtin_amdgcn_readfirstlane(pst[32]) * 4, (int)gridDim.x, (int)blockIdx.x, 0, true};
    EpiE1 E{c.ws + WS_HMID};
    for (;; S.i0 += CAPU) {
        pg8::Unit u; if (!S.next(0, u)) break;
        for (int i = 0; i < CAPU; ++i) {
            if (!S.next(i, u)) break;
            const int e = u.pn >> 2, row0 = (u.aux - __builtin_amdgcn_readfirstlane(pst[e])) * 256, count = __builtin_amdgcn_readfirstlane(cn[e]);
            if (threadIdx.x < 256) {
                const int r = row0 + (int)threadIdx.x, idx = moe_row_idx(sub, e, r < count ? r : row0);
                gtab[i * 256 + threadIdx.x] = (unsigned)list[e * T + idx] * (unsigned)D;
                if ((u.pn & 3) == 0) grow[(size_t)u.aux * 256 + threadIdx.x] = (r < count) ? gatel[e * T + idx] : 0.f;
            }
        }
        __syncthreads();
        pg8::gemm_phase<EpiE1, MoeOrder, false, true, true, true>(c.ldsp, g, S, E, gtab);
        __syncthreads();
    }
}
struct EpiE2 {
    static constexpr bool PERM = true, AFTER_DRAIN = false;
    bf16_t* Y; const float* grow;
    __device__ __forceinline__ void operator()(const pg8::f32x4 (&acc)[2][2][4][2], const pg8::Unit& u, int wr, int wc, int fr, int fq) const {
        const int mb = u.aux;
        bf16_t* yp = Y + ((size_t)mb * 256 + wr * 64 + fr) * D + (u.pn & 3) * 256 + wc * 32 + 8 * fq;
        const float* gp = grow + (size_t)mb * 256 + wr * 64 + fr;
#pragma unroll
        for (int ai = 0; ai < 2; ++ai) {
            float gt[4];
#pragma unroll
            for (int m = 0; m < 4; ++m) gt[m] = gp[ai * 128 + m * 16] * (1.f / (W8_SCALE * H8_SCALE));
#pragma unroll
            for (int m = 0; m < 4; ++m)
#pragma unroll
                for (int bj = 0; bj < 2; ++bj) {
                    const f32x4 v0 = acc[ai][bj][m][0] * gt[m], v1 = acc[ai][bj][m][1] * gt[m];
                    u32x4 w; w.x = pk_bf16(v0.x, v0.y); w.y = pk_bf16(v0.z, v0.w); w.z = pk_bf16(v1.x, v1.y); w.w = pk_bf16(v1.z, v1.w);
                    *(u32x4*)(yp + (size_t)(ai * 128 + m * 16) * D + bj * 128) = w;
                }
        }
    }
};
__device__ __forceinline__ void phase_e2(const Ctx& c, int l) {
    LAS int* pst = (LAS int*)(c.ldsp + MOE_LDS); LAS int* cn = pst + 40; LAS int* sub = (LAS int*)(c.ldsp + MOE_SUB);
    moe_table_wg(c, l, pst, cn, sub);
    int kq = DE / 2; asm volatile("" : "+s"(kq));
    pg8::Gemm g{(const pg8::bf16_t*)(c.ws + WS_HMID), (const pg8::bf16_t*)(c.ws + WS_W2), RPAD, 1024, kq};
    MoeOrder S{pst, __builtin_amdgcn_readfirstlane(pst[32]) * 4, (int)gridDim.x, (int)blockIdx.x, 0, false};
    EpiE2 E{(bf16_t*)(c.ws + WS_Y), (const float*)(c.ws + WS_GROW)};
    for (;; S.i0 += CAPU) {
        pg8::Unit u; if (!S.next(0, u)) break;
        pg8::gemm_phase<EpiE2, MoeOrder, false, true, true, false>(c.ldsp, g, S, E);
        __syncthreads();
    }
}
__device__ __forceinline__ void phase_p1(const Ctx& c, int l, bool dry = false) {
    const bf16_t* H = (const bf16_t*)(c.ws + WS_H); bf16_t* HO = (bf16_t*)(c.ws + (dry ? 440 * MB : WS_H)); const bf16_t* Y = (const bf16_t*)(c.ws + WS_Y);
    const int* tokslot = (const int*)(c.ws + WS_TOKSLOT); const float* gain = (const float*)c.a->in[IN_PLEN] + l * D;
    LAS int* pst = (LAS int*)(c.lds + LDS_MAIN); LAS int* cn = pst + 40; LAS int* sub = (LAS int*)c.lds;
    moe_table(c, l, pst, cn, sub);
    const int gw = c.vb * 4 + c.wave, ngw = c.nb * 4, lane = c.lane;
    f32x4 gv[4]; gain_load(gain, lane, gv);
    int s0n = 0, s1n = 0;
    if (gw < T) { s0n = tokslot[2 * gw]; s1n = tokslot[2 * gw + 1]; }
    for (int t = gw; t < T; t += ngw) {
        const int s0 = s0n, s1 = s1n;
        { const int tn = (t + ngw < T) ? t + ngw : t; s0n = tokslot[2 * tn]; s1n = tokslot[2 * tn + 1]; }
        const int e0 = s0 >> 16, i0 = s0 & 0xffff, e1 = s1 >> 16, i1 = s1 & 0xffff;
        const bf16_t* y0 = Y + ((size_t)pst[e0] * 256 + sub[e0 * 33 + i0 / SUBCAP] + (i0 % SUBCAP)) * D; const bf16_t* y1 = Y + ((size_t)pst[e1] * 256 + sub[e1 * 33 + i1 / SUBCAP] + (i1 % SUBCAP)) * D;
        f32x4 v[4]; u32x2 a0[4], a1[4];
        row_load_h(H + (size_t)t * D, lane, v);
#pragma unroll
        for (int j = 0; j < 4; ++j) { a0[j] = ((const u32x2*)y0)[lane + 64 * j]; a1[j] = ((const u32x2*)y1)[lane + 64 * j]; }
#pragma unroll
        for (int j = 0; j < 4; ++j) {
            v[j].x += bf_lo(a0[j].x) + bf_lo(a1[j].x); v[j].y += bf_hi(a0[j].x) + bf_hi(a1[j].x); v[j].z += bf_lo(a0[j].y) + bf_lo(a1[j].y); v[j].w += bf_hi(a0[j].y) + bf_hi(a1[j].y);
        }
        row_store_h(HO + (size_t)t * D, lane, v);
        const float r = rsqrtf(row_sumsq(v) * (1.f / D) + EPS);
        row_store_norm_fp8(c.ws + (dry ? 440 * MB : WS_XN8) + (size_t)t * D, lane, v, r, gv);
    }
}
struct EpiPJ {
    static constexpr bool PERM = true, AFTER_DRAIN = false;
    bf16_t* PJ;
    __device__ __forceinline__ void operator()(const pg8::f32x4 (&acc)[2][2][4][2], const pg8::Unit& u, int wr, int wc, int fr, int fq) const {
        bf16_t* pp = PJ + (size_t)(u.pm * 256 + wr * 64 + fr) * D + u.pn * 256 + wc * 32 + 8 * fq;
#pragma unroll
        for (int ai = 0; ai < 2; ++ai)
#pragma unroll
            for (int m = 0; m < 4; ++m)
#pragma unroll
                for (int bj = 0; bj < 2; ++bj) {
                    const f32x4 v0 = acc[ai][bj][m][0], v1 = acc[ai][bj][m][1];
                    u32x4 w; w.x = pk_bf16(v0.x, v0.y); w.y = pk_bf16(v0.z, v0.w); w.z = pk_bf16(v1.x, v1.y); w.w = pk_bf16(v1.z, v1.w);
                    *(u32x4*)(pp + (size_t)(ai * 128 + m * 16) * D + bj * 128) = w;
                }
    }
};
struct EpiP2 {
    static constexpr bool PERM = true, AFTER_DRAIN = false;
    const bf16_t* PJ; const bf16_t* H; bf16_t* HO;
    __device__ __forceinline__ void operator()(const pg8::f32x4 (&acc)[2][2][4][2], const pg8::Unit& u, int wr, int wc, int fr, int fq) const {
        const size_t o0 = (size_t)(u.pm * 256 + wr * 64 + fr) * D + u.pn * 256 + wc * 32 + 8 * fq;
#pragma unroll
        for (int ai = 0; ai < 2; ++ai)
#pragma unroll
            for (int m = 0; m < 4; ++m) {
                u32x4 pj[2], hw[2];
#pragma unroll
                for (int bj = 0; bj < 2; ++bj) { const size_t o = o0 + (size_t)(ai * 128 + m * 16) * D + bj * 128;
                    pj[bj] = *(const u32x4*)(PJ + o); hw[bj] = *(const u32x4*)(H + o); }
#pragma unroll
                for (int bj = 0; bj < 2; ++bj) { const size_t o = o0 + (size_t)(ai * 128 + m * 16) * D + bj * 128;
                    const f32x4 g0 = acc[ai][bj][m][0] * (1.f / W8_SCALE), g1 = acc[ai][bj][m][1] * (1.f / W8_SCALE);
                    f32x4 a0 = {bf_lo(hw[bj].x), bf_hi(hw[bj].x), bf_lo(hw[bj].y), bf_hi(hw[bj].y)}, a1 = {bf_lo(hw[bj].z), bf_hi(hw[bj].z), bf_lo(hw[bj].w), bf_hi(hw[bj].w)};
                    a0.x += sigmoidf_(g0.x) * bf_lo(pj[bj].x); a0.y += sigmoidf_(g0.y) * bf_hi(pj[bj].x); a0.z += sigmoidf_(g0.z) * bf_lo(pj[bj].y); a0.w += sigmoidf_(g0.w) * bf_hi(pj[bj].y);
                    a1.x += sigmoidf_(g1.x) * bf_lo(pj[bj].z); a1.y += sigmoidf_(g1.y) * bf_hi(pj[bj].z); a1.z += sigmoidf_(g1.z) * bf_lo(pj[bj].w); a1.w += sigmoidf_(g1.w) * bf_hi(pj[bj].w);
                    u32x4 ow; ow.x = pk_bf16(a0.x, a0.y); ow.y = pk_bf16(a0.z, a0.w); ow.z = pk_bf16(a1.x, a1.y); ow.w = pk_bf16(a1.z, a1.w);
                    *(u32x4*)(HO + o) = ow; }
            }
    }
};
__device__ __forceinline__ void phase_p2(const Ctx& c, int l, bool dry = false) {
    bf16_t* PJ = (bf16_t*)(c.ws + WS_Y);
    pg8::StaticOrder S; S.init(T, D, (int)gridDim.x, (int)blockIdx.x);
    {
        pg8::Gemm g{(const pg8::bf16_t*)(c.ws + WS_PBF) + (size_t)l * T * PLE, (const pg8::bf16_t*)(c.ws + WS_WPROJ) + (size_t)l * D * PLE, T, D, PLE};
        EpiPJ E{PJ};
        pg8::gemm_phase<EpiPJ, pg8::StaticOrder, false, true, false>(c.ldsp, g, S, E);
    }
    __syncthreads();
    {
        pg8::Gemm g{(const pg8::bf16_t*)(c.ws + WS_XN8), (const pg8::bf16_t*)(c.ws + WS_WGATE + (size_t)l * D * D), T, D, D / 2};
        EpiP2 E{PJ, (const bf16_t*)(c.ws + WS_H), (bf16_t*)(c.ws + (dry ? 440 * MB : WS_H))};
        pg8::gemm_phase<EpiP2, pg8::StaticOrder, false, true, true>(c.ldsp, g, S, E);
    }
}
__device__ __forceinline__ void phase_norm_bf16(const Ctx& c, const float* gain) {
    const bf16_t* H = (const bf16_t*)(c.ws + WS_H);
    const int gw = c.vb * 4 + c.wave, ngw = c.nb * 4;
    f32x4 gv[4]; gain_load(gain, c.lane, gv);
    for (int t = gw; t < T; t += ngw) {
        f32x4 v[4]; row_load_h(H + (size_t)t * D, c.lane, v);
        const float r = rsqrtf(row_sumsq(v) * (1.f / D) + EPS);
        row_store_norm_fp8(c.ws + WS_XN8 + (size_t)t * D, c.lane, v, r, gv);
        row_store_norm_bf16((bf16_t*)(c.ws + WS_XN) + (size_t)t * D, c.lane, v, r, gv);
    }
}
__device__ __forceinline__ void phase_final(const Ctx& c) {
    const bf16_t* H = (const bf16_t*)(c.ws + WS_H); float* O = c.a->out; const float* gain = (const float*)c.a->in[IN_FINN];
    const int gw = c.vb * 4 + c.wave, ngw = c.nb * 4;
    f32x4 gv[4]; gain_load(gain, c.lane, gv);
    for (int t = gw; t < T; t += ngw) {
        f32x4 v[4]; row_load_h(H + (size_t)t * D, c.lane, v);
        const float r = rsqrtf(row_sumsq(v) * (1.f / D) + EPS);
#pragma unroll
        for (int j = 0; j < 4; ++j) ((f32x4*)(O + (size_t)t * D))[c.lane + 64 * j] = v[j] * r * gv[j];
    }
}

struct B1Order {
    int G, c, nN, mode;
    __device__ __forceinline__ bool next(int i, pg8::Unit& u) const {
        int L;
        if (G == 256) {
            if (mode == 0) { if (c < 64) { if (i >= 3) return false; L = c * 3 + i; } else { if (i >= 1) return false; L = 192 + (c - 64); } }
            else { if (c < 64 || i >= 1) return false; L = c - 64; }
        } else { L = i * G + c; if (L >= 64 * nN) return false; }
        u.pm = L / nN; u.pn = L - u.pm * nN; u.aux = 0; return true;
    }
    __device__ __forceinline__ void a_ready(const pg8::Unit&) const {}
    __device__ __forceinline__ void done(const pg8::Unit&) const {}
};
struct EpiRaw {
    static constexpr bool PERM = true, AFTER_DRAIN = false;
    bf16_t* RAW; int col_off; float sc;
    __device__ __forceinline__ void operator()(const pg8::f32x4 (&acc)[2][2][4][2], const pg8::Unit& u, int wr, int wc, int fr, int fq) const {
        const int col0 = col_off + u.pn * 256 + wc * 32 + 8 * fq;
        bf16_t* rp = RAW + (size_t)(u.pm * 256 + wr * 64 + fr) * BINP + col0;
#pragma unroll
        for (int bj = 0; bj < 2; ++bj) {
            if (col0 + bj * 128 >= BINP) continue;
#pragma unroll
            for (int ai = 0; ai < 2; ++ai)
#pragma unroll
                for (int m = 0; m < 4; ++m) {
                    const f32x4 v0 = acc[ai][bj][m][0] * sc, v1 = acc[ai][bj][m][1] * sc;
                    u32x4 w; w.x = pk_bf16(v0.x, v0.y); w.y = pk_bf16(v0.z, v0.w); w.z = pk_bf16(v1.x, v1.y); w.w = pk_bf16(v1.z, v1.w);
                    *(u32x4*)(rp + (size_t)(ai * 128 + m * 16) * BINP + bj * 128) = w;
                }
        }
    }
};
__device__ __forceinline__ void phase_b1(const Ctx& c, size_t raw_off = WS_RAW) {
    bf16_t* RAW = (bf16_t*)(c.ws + raw_off);
    {
        pg8::Gemm g{(const pg8::bf16_t*)(c.ws + WS_XN8), (const pg8::bf16_t*)(c.ws + WS_WBIN), T, 1536, D / 2};
        B1Order S{(int)gridDim.x, (int)blockIdx.x, 6, 0}; EpiRaw E{RAW, 0, 1.f / W8_SCALE};
        pg8::gemm_phase<EpiRaw, B1Order, false, true, true>(c.ldsp, g, S, E);
    }
    __syncthreads();
    {
        pg8::Gemm g{(const pg8::bf16_t*)(c.ws + WS_XN), (const pg8::bf16_t*)(c.ws + WS_WBIN + 3 * MB), T, 768, D};
        B1Order S{(int)gridDim.x, (int)blockIdx.x, 3, 1}; EpiRaw E{RAW, 1536, 1.f};
        pg8::gemm_phase<EpiRaw, B1Order, false, true, false>(c.ldsp, g, S, E);
    }
}
__device__ __forceinline__ void unpack8(const u32x4 r, float (&e)[8]) { e[0] = bf_lo(r.x); e[1] = bf_hi(r.x); e[2] = bf_lo(r.y); e[3] = bf_hi(r.y); e[4] = bf_lo(r.z); e[5] = bf_hi(r.z); e[6] = bf_lo(r.w); e[7] = bf_hi(r.w); }
__device__ __forceinline__ u32x4 pack8(const float (&e)[8]) { u32x4 o; o.x = pk_bf16(e[0], e[1]); o.y = pk_bf16(e[2], e[3]); o.z = pk_bf16(e[4], e[5]); o.w = pk_bf16(e[6], e[7]); return o; }
__device__ __forceinline__ void phase_rope(const Ctx& c) {
    const bf16_t* RAW = (const bf16_t*)(c.ws + WS_RAW);
    bf16_t* Q = (bf16_t*)(c.ws + WS_Q); bf16_t* K = (bf16_t*)(c.ws + WS_K); bf16_t* V = (bf16_t*)(c.ws + WS_V);
    bf16_t* QI = (bf16_t*)(c.ws + WS_QI); bf16_t* KI = (bf16_t*)(c.ws + WS_KI); float* WI = (float*)(c.ws + WS_WI);
    const int* pos = (const int*)c.a->in[IN_POS];
    LAS float* cs = (LAS float*)(c.lds + c.wave * 256);
    const int gw = c.vb * 4 + c.wave, ngw = c.nb * 4, lane = c.lane;
    const double ex = (lane < 16) ? (double)lane * (1.0 / 16.0) : (double)((lane - 16) & 7) * (1.0 / 8.0);
    const float invf = (float)exp2(-ex * 18.931568569324174);
    for (int t = gw; t < T; t += ngw) {
        if (lane < 24) {
            const float ang = (float)pos[t] * invf;
            const double ad = (double)ang; const double n = rint(ad * 0.15915494309189535); const float red = (float)(ad - n * 6.283185307179586);
            cs[lane] = __cosf(red); cs[32 + lane] = __sinf(red);
        }
        LDS_WAIT();
        const bf16_t* row = RAW + (size_t)t * BINP;
        for (int ch = lane; ch < BINP / 8; ch += 64) {
            const u32x4 own = ((const u32x4*)row)[ch];
            float e[8]; unpack8(own, e);
            if (ch < 160) {
                const int cc = ch & 15;
                if (cc < 4) {
                    const u32x4 oth = ((const u32x4*)row)[ch ^ 2]; float p[8]; unpack8(oth, p);
                    const int f0 = (cc & 1) * 8;
#pragma unroll
                    for (int i = 0; i < 8; ++i) { const float co = cs[f0 + i], si = cs[32 + f0 + i]; e[i] = (cc < 2) ? (e[i] * co - p[i] * si) : (e[i] * co + p[i] * si); }
                }
                u32x2 o8; o8.x = pk_fp8x4(e[0], e[1], e[2], e[3]); o8.y = pk_fp8x4(e[4], e[5], e[6], e[7]);
                if (ch < 128) ((u32x2*)((unsigned char*)Q + (size_t)t * D))[ch] = o8;
                else ((u32x2*)((unsigned char*)K + (size_t)t * 256))[ch - 128] = o8;
            } else if (ch < 192) {
                u32x2 o8; o8.x = pk_fp8x4(e[0], e[1], e[2], e[3]); o8.y = pk_fp8x4(e[4], e[5], e[6], e[7]);
                ((u32x2*)((unsigned char*)V + (size_t)t * 256))[ch - 160] = o8;
            } else if (ch < 264) {
                const int cc = ch & 7;
                if (cc < 2) {
                    const u32x4 oth = ((const u32x4*)row)[ch ^ 1]; float p[8]; unpack8(oth, p);
#pragma unroll
                    for (int i = 0; i < 8; ++i) { const float co = cs[16 + i], si = cs[32 + 16 + i]; e[i] = (cc == 0) ? (e[i] * co - p[i] * si) : (e[i] * co + p[i] * si); }
                }
                if (ch < 256) ((u32x4*)(QI + (size_t)t * 512))[ch - 192] = pack8(e);
                else ((u32x4*)(KI + (size_t)t * 64))[ch - 256] = pack8(e);
            } else if (ch == 264) {
                f32x4 w0 = {e[0], e[1], e[2], e[3]}, w1 = {e[4], e[5], e[6], e[7]};
                const float sc = 0.044194173824159216f;
                ((f32x4*)(WI + (size_t)t * 8))[0] = w0 * sc; ((f32x4*)(WI + (size_t)t * 8))[1] = w1 * sc;
            }
        }
        LDS_WAIT();
    }
}

__device__ __forceinline__ size_t srow_off(int t) { const int m = t >> 6, r = t & 63; return (size_t)64 * (m + 1) * (32 * m + r); }
constexpr size_t S_BATCH = (size_t)64 * 65 * 2048;
constexpr int SCORE_UNITS = 4 * 312;
__device__ __forceinline__ void phase_score(const Ctx& c) {
    const bf16_t* QI = (const bf16_t*)(c.ws + WS_QI); const bf16_t* KI = (const bf16_t*)(c.ws + WS_KI); const float* WI = (const float*)(c.ws + WS_WI);
    float* S = (float*)(c.ws + WS_S);
    const int lane = c.lane, hf = lane >> 5, col = lane & 31, w = c.wave;
    for (int u = c.vb; u < SCORE_UNITS; u += c.nb) {
        const int b = u & 3, r = u >> 2;
        int kc, qb;
        if (r < 120) { kc = 0; qb = 8 + r; } else if (r < 216) { kc = 1; qb = 32 + (r - 120); } else if (r < 280) { kc = 2; qb = 64 + (r - 216); } else { kc = 3; qb = 96 + (r - 280); }
        const int tb = b * SEQ, t0 = 32 * qb + 8 * w;
        bf16x8 af[2][4]; f32x4 wv[2][4];
        { const int rho = lane & 31, ql = 2 * ((rho >> 2) & 1) + (rho >> 4), hd = 4 * ((rho >> 3) & 1) + (rho & 3);
#pragma unroll
          for (int a = 0; a < 2; ++a) {
              const bf16_t* qp = QI + (size_t)(tb + t0 + 4 * a + ql) * 512 + hd * 64 + 8 * hf;
#pragma unroll
              for (int ks = 0; ks < 4; ++ks) af[a][ks] = *(const bf16x8*)(qp + 16 * ks);
              const float* wp = WI + (size_t)(tb + t0 + 4 * a + 2 * hf) * 8;
#pragma unroll
              for (int i = 0; i < 4; ++i) wv[a][i] = ((const f32x4*)wp)[i];
          } }
        const int ntile = min(32, qb + 1 - 32 * kc), key0 = 1024 * kc;
        float* Sb = S + (size_t)b * S_BATCH;
        size_t ro[2][2];
#pragma unroll
        for (int a = 0; a < 2; ++a) { ro[a][0] = srow_off(t0 + 4 * a + 2 * hf); ro[a][1] = srow_off(t0 + 4 * a + 2 * hf + 1); }
        const int nsub = (ntile + 3) >> 2;
        const bf16_t* krp[4];
        rows_regular<64>(krp, KI + (size_t)(tb + key0) * 64, 64, c.tid);
        __syncthreads();
        stage_tile<64>(c.lds, krp, 0, c.tid);
        for (int sc = 0; sc < 8; ++sc) {
            VM_WAIT();
            __syncthreads();
            const LAS unsigned char* cur = c.lds + (sc & 1) * 16384;
            if (sc + 1 < nsub) stage_tile<64>(c.lds + ((sc + 1) & 1) * 16384, krp, (sc + 1) * 128 * 64, c.tid);
#pragma unroll
            for (int j = 0; j < 4; ++j) {
                const int kt = 4 * sc + j;
                if (sc < nsub && kt < ntile) {
                    const int key = key0 + 32 * kt + col, row = 32 * j + col;
                    bf16x8 cb[4];
#pragma unroll
                    for (int ks = 0; ks < 4; ++ks) cb[ks] = *(const LAS bf16x8*)(cur + row * 128 + (((2 * ks + hf) ^ (row & 7)) << 4));
#pragma unroll
                    for (int a = 0; a < 2; ++a) {
                        f32x16 acc = {};
#pragma unroll
                        for (int ks = 0; ks < 4; ++ks) acc = __builtin_amdgcn_mfma_f32_32x32x16_bf16(af[a][ks], cb[ks], acc, 0, 0, 0);
                        float s0 = fmaxf(acc[0], 0.f) * wv[a][0].x; s0 += fmaxf(acc[1], 0.f) * wv[a][0].y; s0 += fmaxf(acc[2], 0.f) * wv[a][0].z; s0 += fmaxf(acc[3], 0.f) * wv[a][0].w;
                        s0 += fmaxf(acc[4], 0.f) * wv[a][1].x; s0 += fmaxf(acc[5], 0.f) * wv[a][1].y; s0 += fmaxf(acc[6], 0.f) * wv[a][1].z; s0 += fmaxf(acc[7], 0.f) * wv[a][1].w;
                        float s1 = fmaxf(acc[8], 0.f) * wv[a][2].x; s1 += fmaxf(acc[9], 0.f) * wv[a][2].y; s1 += fmaxf(acc[10], 0.f) * wv[a][2].z; s1 += fmaxf(acc[11], 0.f) * wv[a][2].w;
                        s1 += fmaxf(acc[12], 0.f) * wv[a][3].x; s1 += fmaxf(acc[13], 0.f) * wv[a][3].y; s1 += fmaxf(acc[14], 0.f) * wv[a][3].z; s1 += fmaxf(acc[15], 0.f) * wv[a][3].w;
                        const int tA = t0 + 4 * a + 2 * hf;
                        Sb[ro[a][0] + key] = (key <= tA) ? s0 : -INFINITY;
                        Sb[ro[a][1] + key] = (key <= tA + 1) ? s1 : -INFINITY;
                    }
                }
            }
        }
    }
}

constexpr int NBINS = 2048, CAND_CAP = 256, SEL_WAVE_LDS = 8192 + 2048 + 64;
__device__ __forceinline__ int clamp_bin(int x) { return min(max(x, 0), NBINS - 1); }
__device__ __forceinline__ void phase_select(const Ctx& c) {
    const float* S = (const float*)(c.ws + WS_S); int* SEL = (int*)(c.ws + WS_SEL);
    LAS int* hist = (LAS int*)(c.lds + c.wave * SEL_WAVE_LDS);
    LAS float* candv = (LAS float*)(hist + NBINS);
    LAS int* candi = (LAS int*)(candv + CAND_CAP);
    LAS int* thr = candi + CAND_CAP;
    const int gw = c.vb * 4 + c.wave, ngw = c.nb * 4;
    for (int j = gw; j < 4 * 3840; j += ngw) {
        int lane = c.lane;
        asm volatile("" : "+v"(lane));
        const int b = j & 3, t = 4095 - (j >> 2), ni = (t + 64) >> 6;
        const float* row = S + (size_t)b * S_BATCH + srow_off(t);
        float s[64];
#pragma unroll
        for (int g4 = 0; g4 < 4; ++g4) {
            if (16 * g4 < ni) {
#pragma unroll
                for (int i = 16 * g4; i < 16 * g4 + 16; ++i) { const int k = 64 * i + lane; const float v = row[min(k, t)]; s[i] = (k <= t) ? v : -INFINITY; }
            } else {
#pragma unroll
                for (int i = 16 * g4; i < 16 * g4 + 16; ++i) s[i] = -INFINITY;
            }
        }
        float mn = INFINITY, mx = -INFINITY;
#pragma unroll
        for (int g8 = 0; g8 < 8; ++g8) if (8 * g8 < ni) {
#pragma unroll
            for (int i = 8 * g8; i < 8 * g8 + 8; ++i) { mx = fmaxf(mx, s[i]); mn = fminf(mn, (s[i] == -INFINITY) ? INFINITY : s[i]); }
        }
#pragma unroll
        for (int o = 1; o < 64; o <<= 1) { mx = fmaxf(mx, __shfl_xor(mx, o)); mn = fminf(mn, __shfl_xor(mn, o)); }
        const float sc = (mx > mn) ? (float)NBINS / (mx - mn) : 0.f, a0 = -mn * sc;
#pragma unroll
        for (int i = 0; i < 8; ++i) ((LAS u32x4*)hist)[lane * 8 + i] = (u32x4){0u, 0u, 0u, 0u};
        LDS_WAIT();
#define BINOF(v) clamp_bin((int)__builtin_fmaf((v), sc, a0))
#pragma unroll
        for (int g8 = 0; g8 < 8; ++g8) if (8 * g8 < ni) {
#pragma unroll
            for (int i = 8 * g8; i < 8 * g8 + 8; ++i) lds_inc(&hist[BINOF(s[i])]);
        }
        LDS_WAIT();
        int bs, need;
        {
            const LAS int* hq = hist + lane * 32;
            u32x4 hr[8];
            int loc = 0;
#pragma unroll
            for (int i = 0; i < 8; ++i) { hr[i] = ((const LAS u32x4*)hq)[i]; loc += (int)(hr[i].x + hr[i].y + hr[i].z + hr[i].w); }
            int suf = loc;
#pragma unroll
            for (int o = 1; o < 64; o <<= 1) { const int v = __shfl_down(suf, o); if (lane + o < 64) suf += v; }
            const int above = suf - loc;
            const bool cross = (above < 256 && suf >= 256);
            int bsl = 0, abl = 0;
            { int run = above;
#pragma unroll
              for (int i = 31; i >= 0; --i) { const int h = (int)hr[i >> 2][i & 3]; const bool hit = (run < 256 && run + h >= 256); bsl = hit ? lane * 32 + i : bsl; abl = hit ? run : abl; run += h; } }
            const unsigned long long cm = __ballot(cross);
            const int src = cm ? (int)__builtin_ctzll(cm) : 0;
            bs = __shfl(bsl, src); need = 256 - __shfl(abl, src);
        }
        int bs2 = -1;
#define SUBOF(v) clamp_bin((int)((__builtin_fmaf((v), sc, a0) - (float)bs) * (float)NBINS))
        if (__shfl(hist[bs], 0) > 48) {
#pragma unroll
            for (int i = 0; i < 8; ++i) ((LAS u32x4*)hist)[lane * 8 + i] = (u32x4){0u, 0u, 0u, 0u};
            LDS_WAIT();
#pragma unroll
            for (int i = 0; i < 64; ++i) if (s[i] != -INFINITY && BINOF(s[i]) == bs) lds_inc(&hist[SUBOF(s[i])]);
            LDS_WAIT();
            const LAS int* hq = hist + lane * 32;
            int loc = 0;
#pragma unroll
            for (int i = 0; i < 8; ++i) { const u32x4 h4 = ((const LAS u32x4*)hq)[i]; loc += (int)(h4.x + h4.y + h4.z + h4.w); }
            int suf = loc;
#pragma unroll
            for (int o = 1; o < 64; o <<= 1) { const int v = __shfl_down(suf, o); if (lane + o < 64) suf += v; }
            const int above = suf - loc;
            const bool cross = (above < need && suf >= need);
            int bsl = 0, abl = 0;
            if (cross) { int run = above; for (int i = 31; i >= 0; --i) { const int h = hq[i]; if (run < need && run + h >= need) { bsl = lane * 32 + i; abl = run; } run += h; } }
            const unsigned long long cm = __ballot(cross);
            const int src = cm ? (int)__builtin_ctzll(cm) : 0;
            bs2 = __shfl(bsl, src); need = need - __shfl(abl, src);
        }
        asm volatile("" : "+v"(lane));
        float sc2 = sc, a02 = a0;
        asm volatile("" : "+v"(sc2), "+v"(a02));
#undef BINOF
#define BINOF(v) clamp_bin((int)__builtin_fmaf((v), sc2, a02))
        int* selr = SEL + ((size_t)b * SEQ + t) * 256;
        int nc = 0, base = 0;
#pragma unroll
        for (int g4 = 0; g4 < 4; ++g4) if (16 * g4 < ni) {
#pragma unroll
            for (int i = 16 * g4; i < 16 * g4 + 16; ++i) {
                const int bn = BINOF(s[i]);
                bool pc = (bn == bs) && (s[i] != -INFINITY), pd = (bn > bs);
                if (bs2 >= 0) { const int sb = SUBOF(s[i]); pd = pd || (pc && sb > bs2); pc = pc && (sb == bs2); }
                const unsigned long long md = __ballot(pd), mc = __ballot(pc);
                const int posd = base + (int)__builtin_amdgcn_mbcnt_hi((unsigned)(md >> 32), __builtin_amdgcn_mbcnt_lo((unsigned)md, 0u));
                const int posc = nc + (int)__builtin_amdgcn_mbcnt_hi((unsigned)(mc >> 32), __builtin_amdgcn_mbcnt_lo((unsigned)mc, 0u));
                if (pd && posd < 256) selr[posd] = 64 * i + lane;
                if (pc && posc < CAND_CAP) { candv[posc] = s[i]; candi[posc] = 64 * i + lane; }
                base += (int)__popcll(md); nc += (int)__popcll(mc);
            }
        }
        nc = min(nc, CAND_CAP);
        LDS_WAIT();
        for (int i = lane; i < nc; i += 64) {
            const float v = candv[i]; const int id = candi[i];
            int rank = 0;
            for (int k = 0; k < nc; ++k) { const float vk = candv[k]; const int ik = candi[k]; rank += (vk > v || (vk == v && ik < id)) ? 1 : 0; }
            if (rank < need && base + rank < 256) selr[base + rank] = id;
        }
        LDS_WAIT();
#undef BINOF
#undef SUBOF
    }
}

typedef short s16x4 __attribute__((ext_vector_type(4)));
__device__ __forceinline__ unsigned vimg_f(unsigned r) { return ((r & 3u) << 2) | ((r >> 2) & 3u); }
__device__ __forceinline__ void tr_read8(const unsigned (&ad)[8], s16x4 (&r)[8]) {
    asm volatile("ds_read_b64_tr_b16 %0, %8\n\tds_read_b64_tr_b16 %1, %9\n\tds_read_b64_tr_b16 %2, %10\n\tds_read_b64_tr_b16 %3, %11\n\t"
                 "ds_read_b64_tr_b16 %4, %12\n\tds_read_b64_tr_b16 %5, %13\n\tds_read_b64_tr_b16 %6, %14\n\tds_read_b64_tr_b16 %7, %15\n\ts_waitcnt lgkmcnt(0)"
                 : "=&v"(r[0]), "=&v"(r[1]), "=&v"(r[2]), "=&v"(r[3]), "=&v"(r[4]), "=&v"(r[5]), "=&v"(r[6]), "=&v"(r[7])
                 : "v"(ad[0]), "v"(ad[1]), "v"(ad[2]), "v"(ad[3]), "v"(ad[4]), "v"(ad[5]), "v"(ad[6]), "v"(ad[7]) : "memory");
}
__device__ __forceinline__ void tr_read8_b8(const unsigned (&ad)[8], s16x4 (&r)[8]) {
    asm volatile("ds_read_b64_tr_b8 %0, %8\n\tds_read_b64_tr_b8 %1, %9\n\tds_read_b64_tr_b8 %2, %10\n\tds_read_b64_tr_b8 %3, %11\n\t"
                 "ds_read_b64_tr_b8 %4, %12\n\tds_read_b64_tr_b8 %5, %13\n\tds_read_b64_tr_b8 %6, %14\n\tds_read_b64_tr_b8 %7, %15\n\ts_waitcnt lgkmcnt(0)"
                 : "=&v"(r[0]), "=&v"(r[1]), "=&v"(r[2]), "=&v"(r[3]), "=&v"(r[4]), "=&v"(r[5]), "=&v"(r[6]), "=&v"(r[7])
                 : "v"(ad[0]), "v"(ad[1]), "v"(ad[2]), "v"(ad[3]), "v"(ad[4]), "v"(ad[5]), "v"(ad[6]), "v"(ad[7]) : "memory");
}
constexpr int ATT_WAVE_LDS = 19456;
__device__ __forceinline__ void phase_attn(const Ctx& c) {
    const bf16_t* Q = (const bf16_t*)(c.ws + WS_Q); const bf16_t* K = (const bf16_t*)(c.ws + WS_K); const bf16_t* V = (const bf16_t*)(c.ws + WS_V);
    const int* SEL = (const int*)(c.ws + WS_SEL); bf16_t* O = (bf16_t*)(c.ws + WS_O);
    LAS unsigned char* wl = c.lds + c.wave * ATT_WAVE_LDS;
    LAS int* sl = (LAS int*)wl;
    LAS unsigned short* pT = (LAS unsigned short*)(wl + 1024);
    LAS unsigned char* vb = wl + 3072;
    const int lane = c.lane, fr = lane & 15, fq = lane >> 4;
    const int gw = c.vb * 4 + c.wave, ngw = c.nb * 4;
    unsigned tro[8];
    { const unsigned row = 8u * fq + ((unsigned)fr >> 1);
#pragma unroll
      for (int c2 = 0; c2 < 8; ++c2) tro[c2] = 128u * row + 16u * ((unsigned)c2 ^ (row & 7u)) + 8u * ((unsigned)fr & 1u); }
    const unsigned vb_addr = (unsigned)(size_t)vb;
    int tcount = 0, cit = gw;
    const bool xsplit = (c.nb % 128) == 0;
    const int xg = (c.vb >> 6) & 1, wi0 = xsplit ? (((c.vb >> 7) * 64 + (c.vb & 63)) * 4 + c.wave) : gw, wstride = xsplit ? ngw / 2 : ngw;
    const unsigned chunkoff = (((unsigned)lane & 7u) ^ (((unsigned)lane >> 3) & 7u)) << 4;
    unsigned trh[8];
    { const unsigned row = 8u * (fq & 1) + ((unsigned)fr >> 1);
#pragma unroll
      for (int c2 = 0; c2 < 8; ++c2) trh[c2] = 128u * row + 16u * ((unsigned)c2 ^ (row & 7u)) + 8u * ((unsigned)fr & 1u); }
#define SEL_PREFETCH(tg_) __builtin_amdgcn_global_load_lds((const unsigned*)(SEL + (size_t)(tg_) * 256 + lane * 4), (LAS unsigned*)((LAS unsigned char*)sl + lane * 16), 16, 0, 0)
    const int task_end = xsplit ? T : T * 2;
    if (wi0 < task_end) { SEL_PREFETCH(xsplit ? wi0 : (wi0 >> 1)); }
    for (int task = wi0; task < task_end; task += wstride) {
        const int tg = xsplit ? task : (task >> 1), g = xsplit ? xg : (task & 1), b = tg >> 12, t = tg & 4095, tb = b * SEQ;
        const int nsel = min(256, t + 1), nch = (nsel + 31) >> 5;
        asm volatile("s_waitcnt vmcnt(0)" ::: "memory");
        unsigned koff[32];
#pragma unroll
        for (int q = 0; q < 32; ++q) { const int s_ = 8 * q + (lane >> 3); int idx = sl[s_]; idx = (t < 256) ? s_ : idx; idx = (s_ < nsel && (unsigned)idx <= (unsigned)t) ? idx : 0; koff[q] = (unsigned)idx * 256u + chunkoff; }
        i64x2 qf[2];
        { const unsigned char* qp = (const unsigned char*)Q + (size_t)tg * D + (4 * g + (fr >> 2)) * 128 + 16 * fq;
#pragma unroll
          for (int i = 0; i < 2; ++i) qf[i] = *(const i64x2*)(qp + 64 * i); }
        asm volatile("s_waitcnt vmcnt(0) lgkmcnt(0)" ::: "memory");
        asm volatile("" : "+v"(qf[0]), "+v"(qf[1]));
        { const int tn = task + wstride; if (tn < task_end) SEL_PREFETCH(xsplit ? tn : (tn >> 1)); }
        const unsigned char* kbase = (const unsigned char*)K + (size_t)tb * 256 + g * 128;
        const unsigned char* vbase = (const unsigned char*)V + (size_t)tb * 256 + g * 128;
#define CH_GATHER(cidx) do { const unsigned char* bp_ = ((cidx) < 16) ? kbase : vbase; _Pragma("unroll") for (int i_ = 0; i_ < 2; ++i_) { \
            unsigned o_ = koff[2 * ((cidx) & 15) + i_]; asm volatile("" : "+v"(o_));     \
            __builtin_amdgcn_global_load_lds((const unsigned*)(bp_ + o_), (LAS unsigned*)(vb + ((cidx) & 7) * 2048 + i_ * 1024 + lane * 16), 16, 0, 0); } } while (0)
        float lg[16];
#pragma unroll
        for (int c0 = 0; c0 < 6; ++c0) CH_GATHER(c0);
#pragma unroll
        for (int ch = 0; ch < 16; ++ch) {
            asm volatile("s_waitcnt lgkmcnt(0)" ::: "memory");
            CH_GATHER(ch + 6);
            asm volatile("s_waitcnt vmcnt(12)" ::: "memory");
            const LAS unsigned char* kb = vb + (ch & 7) * 2048;
            f32x4 acc = {0.f, 0.f, 0.f, 0.f};
#pragma unroll
            for (int i = 0; i < 2; ++i) { const i64x2 kf = *(const LAS i64x2*)(kb + 128u * fr + 16u * ((4u * i + fq) ^ ((unsigned)fr & 7u)));
                acc = __builtin_amdgcn_mfma_f32_16x16x32_fp8_fp8(qf[i].x, kf.x, acc, 0, 0, 0); acc = __builtin_amdgcn_mfma_f32_16x16x32_fp8_fp8(qf[i].y, kf.y, acc, 0, 0, 0); }
            lg[ch] = (ch * 16 + fr < nsel) ? acc.x * 0.08838834764831845f : -INFINITY;
        }
        float mx = lg[0];
#pragma unroll
        for (int kt = 1; kt < 16; ++kt) mx = fmaxf(mx, lg[kt]);
#pragma unroll
        for (int o = 1; o < 16; o <<= 1) mx = fmaxf(mx, __shfl_xor(mx, o));
        float sm = 0.f;
#pragma unroll
        for (int kt = 0; kt < 16; ++kt) { lg[kt] = __expf(lg[kt] - mx); sm += lg[kt]; }
#pragma unroll
        for (int o = 1; o < 16; o <<= 1) sm += __shfl_xor(sm, o);
        { const float inv = 256.f / sm;
#pragma unroll
          for (int kt = 0; kt < 16; ++kt) { const float pv = lg[kt] * inv; ((LAS unsigned char*)pT)[fq * 256 + kt * 16 + fr] = (unsigned char)(pk_fp8x4_nc(pv, pv, pv, pv) & 0xffu); } }
        f32x4 oacc[8];
#pragma unroll
        for (int c2 = 0; c2 < 8; ++c2) oacc[c2] = (f32x4){0.f, 0.f, 0.f, 0.f};
#pragma unroll
        for (int p = 0; p < 8; ++p) {
            asm volatile("s_waitcnt lgkmcnt(0)" ::: "memory");
            if (16 + 2 * p + 6 < 32) { CH_GATHER(16 + 2 * p + 6); CH_GATHER(16 + 2 * p + 7); }
            if (p < 5) asm volatile("s_waitcnt vmcnt(12)" ::: "memory"); else if (p == 5) asm volatile("s_waitcnt vmcnt(8)" ::: "memory");
            else if (p == 6) asm volatile("s_waitcnt vmcnt(4)" ::: "memory"); else asm volatile("s_waitcnt vmcnt(0)" ::: "memory");
            if (p < nch) {
                const long pa = *(const LAS long*)((const LAS unsigned char*)pT + (fr >> 2) * 256 + 32 * p + 8 * fq);
                const unsigned cb = vb_addr + (unsigned)(((16 + 2 * p) & 7) + (fq >> 1)) * 2048u;
                unsigned ad[8]; s16x4 r0[8];
#pragma unroll
                for (int i = 0; i < 8; ++i) ad[i] = cb + trh[i];
                tr_read8_b8(ad, r0);
#pragma unroll
                for (int c2 = 0; c2 < 8; ++c2) oacc[c2] = __builtin_amdgcn_mfma_f32_16x16x32_fp8_fp8(pa, __builtin_bit_cast(long, r0[c2]), oacc[c2], 0, 0, 0);
            }
        }
        { unsigned char* op = (unsigned char*)O + (size_t)tg * D + (4 * g + fq) * 128 + fr;
#pragma unroll
          for (int c2 = 0; c2 < 8; ++c2) { const float ov = oacc[c2].x * (O8_SCALE / 256.f); op[16 * c2] = (unsigned char)(pk_fp8x4(ov, ov, ov, ov) & 0xffu); } }
        LDS_WAIT();
#undef CH_GATHER
        if ((tcount & 1) && cit < NE * 192) { convert_moe_item(c, 1, cit, vb); cit += ngw; }
        ++tcount;
    }
    for (; cit < NE * 192; cit += ngw) convert_moe_item(c, 1, cit, vb);
}

__device__ __forceinline__ void phase_b4(const Ctx& c, bool dry = false) {
    bf16_t* H = (bf16_t*)(c.ws + WS_H);
    pg8::Gemm g{(const pg8::bf16_t*)(c.ws + WS_O), (const pg8::bf16_t*)(c.ws + WS_WBOUT), T, D, D / 2};
    pg8::StaticOrder S; S.init(T, D, (int)gridDim.x, (int)blockIdx.x);
    EpiResH<false> E{H, dry ? (bf16_t*)(c.ws + 440 * MB) : H, 1.f / (W8_SCALE * O8_SCALE)};
    pg8::gemm_phase<EpiResH<false>, pg8::StaticOrder, false, true, true>(c.ldsp, g, S, E);
}

constexpr int NPHASE = 22;
__global__ void __launch_bounds__(NTHP, 2) mk_fwd(Args args) {
    extern __shared__ __attribute__((aligned(16))) unsigned char lds_raw[];
    Ctx c;
    { const int pt = threadIdx.x; c.half = __builtin_amdgcn_readfirstlane(pt >> 8); c.tid = pt & 255; c.lane = pt & 63; c.wave = __builtin_amdgcn_readfirstlane(pt >> 6) & 3; }
    c.ldsp = (LAS unsigned char*)lds_raw; c.lds = c.ldsp + c.half * LDS_HALF;
    c.nb = 2 * gridDim.x; { const int bx = blockIdx.x, G = gridDim.x; c.vb = 2 * ((G % 8 == 0) ? (bx % 8) * (G / 8) + bx / 8 : bx) + c.half; }
    c.a = (const __attribute__((address_space(4))) Args*)__builtin_amdgcn_kernarg_segment_ptr(); c.ws = args.ws;
    volatile LAS unsigned* st = (volatile LAS unsigned*)((LAS unsigned char*)lds_raw + LDS_BYTES - 16);
    const bool multi = (args.ph_hi - args.ph_lo) > 1;
    XcdBarrier bar; bar.bar = (unsigned*)(c.ws + WS_CTL); bar.x = 0; bar.st = st;
    if (multi) {
        if (threadIdx.x == 0) { st[0] = 0u; st[1] = 0u; }
        __syncthreads();
        bar = xcd_barrier_post((unsigned*)(c.ws + WS_CTL), st);
    }
    const int ph_lo = args.ph_lo, ph_hi = args.ph_hi;
#ifndef PH_MASK
#define PH_MASK 0x3fffff
#endif
#define PHON(k) ((PH_MASK >> (k)) & 1)
#define PHASE(k, body) do { if (PHON(k) && ph_lo <= (k) && (k) < ph_hi) { \
        { int t_ = threadIdx.x, vb_ = __builtin_amdgcn_readfirstlane(c.vb); \
          const __attribute__((address_space(4))) Args* ka = (const __attribute__((address_space(4))) Args*)__builtin_amdgcn_kernarg_segment_ptr(); \
          asm volatile("" : "+v"(t_), "+s"(vb_), "+s"(ka)); \
          c.tid = t_ & 255; c.lane = t_ & 63; c.wave = __builtin_amdgcn_readfirstlane(t_ >> 6) & 3; c.vb = vb_; c.a = ka; c.ws = ka->ws; } \
        body; \
        if (MK_REP == (k)) { __syncthreads(); body; } \
        if ((k) + 1 < ph_hi) xcd_barrier(bar); \
        if ((k) == 3) { for (int xb_ = 0; xb_ < MK_XBAR; ++xb_) xcd_barrier(bar); } } } while (0)
    PHASE(0, phase_prep(c));
    PHASE(1, phase_a1(c));
    PHASE(2, { if (MK_DRY == 2) { phase_a2(c, true); __syncthreads(); } phase_a2(c); });
    PHASE(3, phase_a3(c));
    PHASE(4, { if (MK_DRY == 4) { phase_route(c, 0, true); __syncthreads(); } phase_route(c, 0); });
    PHASE(5, phase_e1(c, 0));
    PHASE(6, phase_e2(c, 0));
    PHASE(7, { if (MK_DRY == 7) { phase_p1(c, 0, true); __syncthreads(); } phase_p1(c, 0); });
    PHASE(8, { if (MK_DRY == 8) { phase_p2(c, 0, true); __syncthreads(); } phase_p2(c, 0); });
    PHASE(9, phase_norm_bf16(c, (const float*)c.a->in[IN_MIXN] + D));
    PHASE(10, phase_b1(c));
    PHASE(11, phase_rope(c));
    PHASE(12, phase_score(c));
    PHASE(13, phase_select(c));
    PHASE(14, phase_attn(c));
    PHASE(15, { if (MK_DRY == 15) { phase_b4(c, true); __syncthreads(); } phase_b4(c); });
    PHASE(16, phase_route(c, 1));
    PHASE(17, phase_e1(c, 1));
    PHASE(18, phase_e2(c, 1));
    PHASE(19, phase_p1(c, 1));
    PHASE(20, phase_p2(c, 1));
    PHASE(21, phase_final(c));
}

#ifdef MK_DUMP
__global__ void dump_k(const unsigned char* ws, float* out) {
    const size_t i = (size_t)blockIdx.x * 256 + threadIdx.x;
#if MK_DUMP == 1
    ((f32x4*)out)[i] = ((const f32x4*)(ws + WS_H))[i];
#elif MK_DUMP == 2
    { const u32x2 v = ((const u32x2*)(ws + WS_O))[i]; f32x4 o = {bf_lo(v.x), bf_hi(v.x), bf_lo(v.y), bf_hi(v.y)}; ((f32x4*)out)[i] = o; }
#elif MK_DUMP == 3
    { const int* sp = (const int*)(ws + WS_SEL); f32x4 o = {0.f,0.f,0.f,0.f}; if (i < (size_t)T * 64) { o.x = (float)sp[4*i]; o.y = (float)sp[4*i+1]; o.z = (float)sp[4*i+2]; o.w = (float)sp[4*i+3]; } ((f32x4*)out)[i] = o; }
#elif MK_DUMP == 5
    { const u32x2 v = ((const u32x2*)(ws + WS_XN))[i]; f32x4 o = {bf_lo(v.x), bf_hi(v.x), bf_lo(v.y), bf_hi(v.y)}; ((f32x4*)out)[i] = o; }
#elif MK_DUMP == 6
    { const u32x2 v = ((const u32x2*)(ws + WS_RAW))[i]; f32x4 o = {bf_lo(v.x), bf_hi(v.x), bf_lo(v.y), bf_hi(v.y)}; ((f32x4*)out)[i] = o; }
#elif MK_DUMP == 7
    { f32x4 o = {0.f,0.f,0.f,0.f}; if (i < (size_t)BINP * D / 4) { const u32x2 v = ((const u32x2*)(ws + WS_WBIN))[i]; o = (f32x4){bf_lo(v.x), bf_hi(v.x), bf_lo(v.y), bf_hi(v.y)}; } ((f32x4*)out)[i] = o; }
#elif MK_DUMP == 8
    { const u32x2 v = ((const u32x2*)(ws + WS_RAW))[i], w = ((const u32x2*)(ws + 458 * MB))[i]; f32x4 o = {bf_lo(v.x) - bf_lo(w.x), bf_hi(v.x) - bf_hi(w.x), bf_lo(v.y) - bf_lo(w.y), bf_hi(v.y) - bf_hi(w.y)}; ((f32x4*)out)[i] = o; }
#elif MK_DUMP == 9
    { const u32x2 v = ((const u32x2*)(ws + WS_RAW))[i], w = ((const u32x2*)(ws + 458 * MB))[i]; f32x4 o = {(v.x & 0xffffu) != (w.x & 0xffffu) ? 1.f : 0.f, (v.x >> 16) != (w.x >> 16) ? 1.f : 0.f, (v.y & 0xffffu) != (w.y & 0xffffu) ? 1.f : 0.f, (v.y >> 16) != (w.y >> 16) ? 1.f : 0.f}; ((f32x4*)out)[i] = o; }
#elif MK_DUMP == 4
    { const u32x2 v = ((const u32x2*)(ws + WS_Q))[i]; f32x4 o = {bf_lo(v.x), bf_hi(v.x), bf_lo(v.y), bf_hi(v.y)}; ((f32x4*)out)[i] = o; }
#endif
}
#endif
extern "C" void kernel_launch(void* const* d_in, const int* in_sizes, int n_in, void* d_out, int out_size, void* d_ws, size_t ws_size, hipStream_t stream) {
    static int grid = 0;
    if (grid == 0) {
        if (n_in != 23 || out_size != T * D || ws_size < WS_TOTAL) { fprintf(stderr, "kernel_launch: unexpected sizes n_in %d out %d ws %zu (need %zu)\n", n_in, out_size, ws_size, (size_t)WS_TOTAL); grid = -1; return; }
        int dev = 0, cus = 0, per_cu = 0;
        hipGetDevice(&dev); hipDeviceGetAttribute(&cus, hipDeviceAttributeMultiprocessorCount, dev);
        hipFuncSetAttribute((const void*)mk_fwd, hipFuncAttributeMaxDynamicSharedMemorySize, LDS_BYTES);
        hipOccupancyMaxActiveBlocksPerMultiprocessor(&per_cu, (const void*)mk_fwd, NTHP, LDS_BYTES);
        (void)hipGetLastError();
        if (per_cu < 1) per_cu = 1;
        if (per_cu > 1) per_cu = 1;
        grid = cus * per_cu;
    }
    if (grid < 0) return;
    hipMemsetAsync((char*)d_ws + WS_CTL, 0, 16384, stream);
    Args a{};
    for (int i = 0; i < 23; ++i) a.in[i] = d_in[i];
    a.out = (float*)d_out; a.ws = (unsigned char*)d_ws;
#if MK_ONE_LAUNCH
    a.ph_lo = 0; a.ph_hi = NPHASE;
    hipLaunchKernelGGL(mk_fwd, dim3(grid), dim3(NTHP), LDS_BYTES, stream, a);
#else
    for (int ph = 0; ph <= MK_LAST_PHASE; ++ph) { a.ph_lo = ph; a.ph_hi = ph + 1; hipLaunchKernelGGL(mk_fwd, dim3(grid), dim3(NTHP), LDS_BYTES, stream, a); }
#ifdef MK_DUMP
    hipLaunchKernelGGL(dump_k, dim3(T * D / 4 / 256), dim3(256), 0, stream, (const unsigned char*)d_ws, (float*)d_out);
#endif
#endif
}
```

```cpp
#include <hip/hip_runtime.h>
#include <stdint.h>
#include <stdio.h>

#ifndef MK_LAST_PHASE
#define MK_LAST_PHASE 21
#endif
#ifndef MK_REP
#define MK_REP -1
#endif
#ifndef MK_XBAR
#define MK_XBAR 0
#endif
#ifndef MK_DRY
#define MK_DRY -1
#endif
#ifndef MK_ONE_LAUNCH
#define MK_ONE_LAUNCH 1
#endif

#define LAS __attribute__((address_space(3)))
typedef unsigned short bf16_t;
typedef short bf16x8 __attribute__((ext_vector_type(8)));
typedef float f32x4 __attribute__((ext_vector_type(4)));
typedef float f32x2 __attribute__((ext_vector_type(2)));
typedef float f32x16 __attribute__((ext_vector_type(16)));
typedef unsigned u32x4 __attribute__((ext_vector_type(4)));
typedef unsigned u32x2 __attribute__((ext_vector_type(2)));
typedef long i64x2 __attribute__((ext_vector_type(2)));
typedef int i32x4 __attribute__((ext_vector_type(4)));
typedef int i32x8 __attribute__((ext_vector_type(8)));

constexpr int T = 16384, D = 1024, SEQ = 4096;
constexpr int GW = 2048;
constexpr int BIN = 2120, BINP = 2176;
constexpr int NE = 32, DE = 512;
constexpr int PLE = 256;
constexpr float EPS = 1e-6f;
constexpr int NTH = 256;
constexpr int LDS_MAIN = 4 * 19456;
constexpr int LDS_HALF = LDS_MAIN + 1024;
constexpr int LDS_BYTES = 2 * LDS_HALF;
constexpr int NTHP = 512;
constexpr int RPAD = 32768 + NE * 256;

constexpr size_t MB = 1024 * 1024;
constexpr size_t WS_CTL = 0;
constexpr size_t WS_CNT = 448 * 1024;
constexpr int NSUB = 32, SUBCAP = T / NSUB, CNT_STRIDE = 32;
static_assert(WS_CNT >= 32768 + 2 * 1024 * 48 * 4 && WS_CNT + (size_t)4 * NSUB * 32 * CNT_STRIDE * 4 <= 1024 * 1024, "cnt");
constexpr size_t WS_WR = 32768;
constexpr size_t WS_WAIN = 1 * MB;
constexpr size_t WS_WAOUT = WS_WAIN + 8 * MB;
constexpr size_t WS_WBIN = WS_WAOUT + 4 * MB;
constexpr size_t WS_WBOUT = WS_WBIN + 5 * MB;
constexpr size_t WS_WGATE = WS_WBOUT + 2 * MB;
constexpr size_t WS_WPROJ = WS_WGATE + 4 * MB;
constexpr size_t WS_W1 = WS_WPROJ + 1 * MB;
constexpr size_t WS_H8 = WS_W1;
constexpr size_t WS_XN8 = WS_W1 + 16 * MB;
constexpr size_t WS_W3 = WS_W1 + 32 * MB;
constexpr size_t WS_W2 = WS_W3 + 32 * MB;
constexpr size_t WS_PBF = WS_W2 + 32 * MB;
constexpr size_t WS_XN = WS_PBF + 16 * MB;
constexpr size_t WS_H = WS_XN + 32 * MB;
constexpr size_t WS_LIST = WS_H + 64 * MB;
constexpr size_t WS_GATE = WS_LIST + 2 * MB;
constexpr size_t WS_TOKSLOT = WS_GATE + 2 * MB;
constexpr size_t WS_GROW = WS_TOKSLOT + 512 * 1024;
constexpr size_t WS_SCR = WS_TOKSLOT + 1 * MB;
constexpr size_t WS_U = WS_SCR;
constexpr size_t WS_VT = WS_SCR + 64 * MB;
constexpr size_t WS_VSS = WS_SCR + 128 * MB;
constexpr size_t WS_HMID = WS_SCR;
constexpr size_t WS_Y = WS_SCR + 36 * MB;
constexpr size_t WS_RAW = WS_SCR;
constexpr size_t WS_O = WS_SCR;
constexpr size_t WS_Q = WS_SCR + 68 * MB;
constexpr size_t WS_K = WS_Q + 32 * MB;
constexpr size_t WS_V = WS_K + 8 * MB;
constexpr size_t WS_QI = WS_V + 8 * MB;
constexpr size_t WS_KI = WS_QI + 16 * MB;
constexpr size_t WS_WI = WS_KI + 2 * MB;
constexpr size_t WS_SEL = WS_WI + 1 * MB;
constexpr size_t WS_END = WS_SEL + 16 * MB;
constexpr size_t WS_RSS = WS_END;
static_assert(WS_RSS + 1 * MB <= WS_SCR + 152 * MB, "scratch");
constexpr size_t WS_S = 392 * MB;
constexpr size_t WS_TOTAL = 522 * MB;

typedef __bf16 bf16x2_t __attribute__((ext_vector_type(2)));
__device__ __forceinline__ unsigned pk_bf16(float lo, float hi) { f32x2 v = {lo, hi}; bf16x2_t b = __builtin_convertvector(v, bf16x2_t); return __builtin_bit_cast(unsigned, b); }
__device__ __forceinline__ float bf_lo(unsigned u) { return __uint_as_float(u << 16); }
__device__ __forceinline__ float bf_hi(unsigned u) { return __uint_as_float(u & 0xffff0000u); }
__device__ __forceinline__ float wave_sum(float v) {
#pragma unroll
    for (int o = 1; o < 64; o <<= 1) v += __shfl_xor(v, o);
    return v;
}
__device__ __forceinline__ int lds_inc(LAS int* p) { return __hip_atomic_fetch_add(p, 1, __ATOMIC_RELAXED, __HIP_MEMORY_SCOPE_WORKGROUP); }
#define LDS_WAIT() asm volatile("s_waitcnt lgkmcnt(0)" ::: "memory")
#define VM_WAIT() asm volatile("s_waitcnt vmcnt(0)" ::: "memory")

#define XB_TMO      128
#define XB_XCNT(j)  (256  + 64 * (j))
#define XB_XSUB(j)  (1280 + 64 * (j))
#define XB_XGEN(j)  (2304 + 64 * (j))
#define XB_TOP      3328
#define XB_TOPGEN   3392
#define XCD_BAR_WORDS 3456
#define XB_SPIN_CAP (1u << 20)
__device__ __forceinline__ unsigned xb_ld(unsigned* p)              { return __hip_atomic_load(p, __ATOMIC_RELAXED, __HIP_MEMORY_SCOPE_AGENT); }
__device__ __forceinline__ unsigned xb_add(unsigned* p, unsigned v) { return __hip_atomic_fetch_add(p, v, __ATOMIC_RELAXED, __HIP_MEMORY_SCOPE_AGENT); }
__device__ __forceinline__ unsigned xb_xcc_id() { return (unsigned)__builtin_amdgcn_s_getreg((3 << 11) | 20) & 0xFu; }
#define XB_SPIN(cond, bar) do { unsigned _sp = 0; while (cond) { __builtin_amdgcn_s_sleep(1); \
    if ((++_sp & 255u) == 0u) { if (xb_ld(&(bar)[XB_TMO])) break; if (_sp > XB_SPIN_CAP) { atomicAdd(&(bar)[XB_TMO], 1u); break; } } } } while (0)
struct XcdBarrier { unsigned* bar; unsigned x; volatile LAS unsigned* st; };
__device__ __forceinline__ XcdBarrier xcd_barrier_post(unsigned* bar, volatile LAS unsigned* st) {
    XcdBarrier b; b.bar = bar; b.x = xb_xcc_id(); b.st = st;
    if (threadIdx.x == 0) (void)xb_add(&bar[XB_XCNT(b.x)], 1u);
    return b;
}
__device__ __forceinline__ void xcd_barrier_complete(unsigned* bar, unsigned x, unsigned& nloc, unsigned& nx) {
    const unsigned G = gridDim.x;
    unsigned sum, cnt, mine, sp = 0u;
    for (;;) {
        sum = 0u; cnt = 0u; mine = 0u;
#pragma unroll
        for (unsigned j = 0; j < 16; ++j) { const unsigned c = xb_ld(&bar[XB_XCNT(j)]); sum += c; cnt += (c > 0u) ? 1u : 0u; mine = (j == x) ? c : mine; }
        if (sum == G) break;
        __builtin_amdgcn_s_sleep(1);
        if ((++sp & 255u) == 0u) { if (xb_ld(&bar[XB_TMO])) break; if (sp > XB_SPIN_CAP) { atomicAdd(&bar[XB_TMO], 1u); break; } }
    }
    nloc = mine > 0u ? mine : 1u; nx = cnt > 0u ? cnt : 1u;
}
__device__ __forceinline__ void xcd_barrier(const XcdBarrier& b) {
    asm volatile("s_waitcnt vmcnt(0)" ::: "memory");
    __syncthreads();
    if (threadIdx.x == 0) {
        unsigned* bar = b.bar;
        __builtin_amdgcn_s_waitcnt(0);
        unsigned nloc = b.st[0], nx = b.st[1];
        if (nloc == 0u) { xcd_barrier_complete(bar, b.x, nloc, nx); b.st[0] = nloc; b.st[1] = nx; }
        const unsigned old = xb_add(&bar[XB_XSUB(b.x)], 1u);
        const unsigned gen = old / nloc;
        if (old + 1u == (gen + 1u) * nloc) {
            __builtin_amdgcn_fence(__ATOMIC_RELEASE, "agent");
            asm volatile("s_waitcnt vmcnt(0)" ::: "memory");
            const unsigned og = xb_add(&bar[XB_TOP], 1u);
            const unsigned tg = og / nx;
            if (og + 1u == (tg + 1u) * nx) xb_add(&bar[XB_TOPGEN], 1u);
            else XB_SPIN(xb_ld(&bar[XB_TOPGEN]) == tg, bar);
            __builtin_amdgcn_fence(__ATOMIC_ACQUIRE, "agent");
            xb_add(&bar[XB_XGEN(b.x)], 1u);
            asm volatile("s_waitcnt vmcnt(0)" ::: "memory");
        } else {
            XB_SPIN(xb_ld(&bar[XB_XGEN(b.x)]) == gen, bar);
            __builtin_amdgcn_fence(__ATOMIC_ACQUIRE, "agent");
            asm volatile("s_waitcnt vmcnt(0)" ::: "memory");
        }
    }
    __syncthreads();
}

struct Args { const void* in[23]; float* out; unsigned char* ws; int ph_lo, ph_hi; };
enum { IN_X = 0, IN_P, IN_POS, IN_MIXN, IN_AWIN, IN_AVG, IN_AWS, IN_ABS, IN_AWOUT, IN_BWIN, IN_BWOUT, IN_FFNN, IN_WG, IN_BG, IN_WE, IN_BE,
       IN_W1, IN_W3, IN_W2, IN_PLEN, IN_PLEG, IN_PLEP, IN_FINN };

struct Ctx {
    LAS unsigned char* lds;
    int tid, lane, wave, vb, nb, half;
    LAS unsigned char* ldsp;
    const __attribute__((address_space(4))) Args* a;
    unsigned char* ws;
};

template <int BK> struct TileK { static constexpr int NP = (BK == 64) ? 4 : 2; static constexpr int TB = 128 * BK * 2; };

template <int BK>
__device__ __forceinline__ void stage_tile(LAS unsigned char* tile, const bf16_t* const (&rp)[TileK<BK>::NP], int k0, int tid) {
    const int lc = (BK == 64) ? ((tid & 7) ^ ((tid >> 3) & 7)) : ((tid & 3) ^ ((tid >> 3) & 3));
#pragma unroll
    for (int p = 0; p < TileK<BK>::NP; ++p)
        __builtin_amdgcn_global_load_lds((const unsigned*)(rp[p] + k0 + lc * 8), (LAS unsigned*)(tile + p * 4096 + tid * 16), 16, 0, 0);
}
template <int BK>
__device__ __forceinline__ void rows_regular(const bf16_t* (&rp)[TileK<BK>::NP], const bf16_t* base, size_t ld, int tid) {
#pragma unroll
    for (int p = 0; p < TileK<BK>::NP; ++p) { const int r = (BK == 64) ? (p * 32 + (tid >> 3)) : (p * 64 + (tid >> 2)); rp[p] = base + (size_t)r * ld; }
}
template <int BK>
__device__ __forceinline__ int frag_off(int row, int ks, int fq) {
    return (BK == 64) ? (row * 128 + (((ks * 4 + fq) ^ (row & 7)) << 4)) : (row * 64 + ((fq ^ ((row >> 1) & 3)) << 4));
}

template <int BK, int NBOP, bool SWAP, bool FP8 = false>
__device__ __forceinline__ void gemm_loop(const Ctx& c, const bf16_t* const (&ap)[TileK<BK>::NP], const bf16_t* const (&b0p)[TileK<BK>::NP], const bf16_t* const (&b1p)[TileK<BK>::NP],
                                          int K, f32x4 (&acc0)[4][4], f32x4 (&acc1)[4][4]) {
    constexpr int TB = TileK<BK>::TB, SB = (1 + NBOP) * TB;
    static_assert(2 * SB <= LDS_MAIN, "lds");
    const int nk = K / BK, tid = c.tid;
    const int fr = c.lane & 15, fq = c.lane >> 4, wr = c.wave >> 1, wc = c.wave & 1;
    LAS unsigned char* lds = c.lds;
    stage_tile<BK>(lds, ap, 0, tid); stage_tile<BK>(lds + TB, b0p, 0, tid);
    if (NBOP == 2) stage_tile<BK>(lds + 2 * TB, b1p, 0, tid);
    for (int kt = 0; kt < nk; ++kt) {
        VM_WAIT();
        __syncthreads();
        LAS unsigned char* cur = lds + (kt & 1) * SB;
        if (kt + 1 < nk) {
            LAS unsigned char* nxt = lds + ((kt + 1) & 1) * SB;
            stage_tile<BK>(nxt, ap, (kt + 1) * BK, tid); stage_tile<BK>(nxt + TB, b0p, (kt + 1) * BK, tid);
            if (NBOP == 2) stage_tile<BK>(nxt + 2 * TB, b1p, (kt + 1) * BK, tid);
        }
#pragma unroll
        for (int ks = 0; ks < BK / 32; ++ks) {
            bf16x8 af[4], bf0[4], bf1[4];
#pragma unroll
            for (int m = 0; m < 4; ++m) af[m] = *(const LAS bf16x8*)(cur + frag_off<BK>(wr * 64 + m * 16 + fr, ks, fq));
#pragma unroll
            for (int n = 0; n < 4; ++n) bf0[n] = *(const LAS bf16x8*)(cur + TB + frag_off<BK>(wc * 64 + n * 16 + fr, ks, fq));
            if (NBOP == 2) {
#pragma unroll
                for (int n = 0; n < 4; ++n) bf1[n] = *(const LAS bf16x8*)(cur + 2 * TB + frag_off<BK>(wc * 64 + n * 16 + fr, ks, fq));
            }
#pragma unroll
            for (int m = 0; m < 4; ++m)
#pragma unroll
                for (int n = 0; n < 4; ++n) {
                    if (FP8) {
                        const i64x2 a2 = __builtin_bit_cast(i64x2, af[m]), b2 = __builtin_bit_cast(i64x2, bf0[n]);
                        if (SWAP) { acc0[m][n] = __builtin_amdgcn_mfma_f32_16x16x32_fp8_fp8(b2.x, a2.x, acc0[m][n], 0, 0, 0); acc0[m][n] = __builtin_amdgcn_mfma_f32_16x16x32_fp8_fp8(b2.y, a2.y, acc0[m][n], 0, 0, 0); }
                        else      { acc0[m][n] = __builtin_amdgcn_mfma_f32_16x16x32_fp8_fp8(a2.x, b2.x, acc0[m][n], 0, 0, 0); acc0[m][n] = __builtin_amdgcn_mfma_f32_16x16x32_fp8_fp8(a2.y, b2.y, acc0[m][n], 0, 0, 0); }
                        continue;
                    }
                    if (SWAP) acc0[m][n] = __builtin_amdgcn_mfma_f32_16x16x32_bf16(bf0[n], af[m], acc0[m][n], 0, 0, 0);
                    else      acc0[m][n] = __builtin_amdgcn_mfma_f32_16x16x32_bf16(af[m], bf0[n], acc0[m][n], 0, 0, 0);
                    if (NBOP == 2) {
                        if (SWAP) acc1[m][n] = __builtin_amdgcn_mfma_f32_16x16x32_bf16(bf1[n], af[m], acc1[m][n], 0, 0, 0);
                        else      acc1[m][n] = __builtin_amdgcn_mfma_f32_16x16x32_bf16(af[m], bf1[n], acc1[m][n], 0, 0, 0);
                    }
                }
        }
    }
    __syncthreads();
}
__device__ __forceinline__ void zero_acc(f32x4 (&acc)[4][4]) {
#pragma unroll
    for (int m = 0; m < 4; ++m)
#pragma unroll
        for (int n = 0; n < 4; ++n) acc[m][n] = (f32x4){0.f, 0.f, 0.f, 0.f};
}
__device__ __forceinline__ void map_unit(int u, int nnt, int& mt, int& nt) { const int per = 8 * nnt, band = u / per, r = u - band * per; nt = r >> 3; mt = band * 8 + (r & 7); }


__device__ __forceinline__ float gelu_tanh(float x) {
    const float y2 = 1.5957691216057308f * (x + 0.044715f * x * x * x);
    return x * __builtin_amdgcn_rcpf(1.f + __expf(-y2));
}
__device__ __forceinline__ float sigmoidf_(float x) { return __builtin_amdgcn_rcpf(1.f + __expf(-x)); }

__device__ __forceinline__ void row_load(const float* row, int lane, f32x4 (&v)[4]) {
#pragma unroll
    for (int j = 0; j < 4; ++j) v[j] = ((const f32x4*)row)[lane + 64 * j];
}
__device__ __forceinline__ void row_load_h(const bf16_t* row, int lane, f32x4 (&v)[4]) {
#pragma unroll
    for (int j = 0; j < 4; ++j) { const u32x2 w = ((const u32x2*)row)[lane + 64 * j]; v[j] = (f32x4){bf_lo(w.x), bf_hi(w.x), bf_lo(w.y), bf_hi(w.y)}; }
}
__device__ __forceinline__ float row_sumsq(const f32x4 (&v)[4]) {
    float s = 0.f;
#pragma unroll
    for (int j = 0; j < 4; ++j) s += (v[j].x * v[j].x + v[j].y * v[j].y) + (v[j].z * v[j].z + v[j].w * v[j].w);
    return wave_sum(s);
}
__device__ __forceinline__ void gain_load(const float* gain, int lane, f32x4 (&g)[4]) {
#pragma unroll
    for (int j = 0; j < 4; ++j) g[j] = ((const f32x4*)gain)[lane + 64 * j];
}
__device__ __forceinline__ void row_store_norm_bf16(bf16_t* orow, int lane, const f32x4 (&v)[4], float r, const f32x4 (&gv)[4]) {
#pragma unroll
    for (int j = 0; j < 4; ++j) {
        const f32x4 g = gv[j];
        u32x2 o; o.x = pk_bf16(v[j].x * r * g.x, v[j].y * r * g.y); o.y = pk_bf16(v[j].z * r * g.z, v[j].w * r * g.w);
        ((u32x2*)orow)[lane + 64 * j] = o;
    }
}

__device__ __forceinline__ void row_store_h(bf16_t* orow, int lane, const f32x4 (&v)[4]) {
#pragma unroll
    for (int j = 0; j < 4; ++j) { u32x2 o; o.x = pk_bf16(v[j].x, v[j].y); o.y = pk_bf16(v[j].z, v[j].w); ((u32x2*)orow)[lane + 64 * j] = o; }
}
__device__ __forceinline__ unsigned pk_fp8x4(float a, float b, float c_, float d);
__device__ __forceinline__ void row_store_norm_fp8(unsigned char* orow, int lane, const f32x4 (&v)[4], float r, const f32x4 (&gv)[4]) {
#pragma unroll
    for (int j = 0; j < 4; ++j) ((unsigned*)orow)[lane + 64 * j] = pk_fp8x4(v[j].x * r * gv[j].x, v[j].y * r * gv[j].y, v[j].z * r * gv[j].z, v[j].w * r * gv[j].w);
}
constexpr int TR_SCR = 64 * 136;
__device__ __forceinline__ void transpose_item(const float* W, int K, int N, int nvalid, int ldw, bf16_t* WT, LAS unsigned char* scr, int item, int lane, const float* kg = nullptr) {
    const int nblk = N / 64, kb = item / nblk, nb = item - kb * nblk, k0 = 64 * kb, n0 = 64 * nb;
    const int n = n0 + 4 * (lane & 15);
    const int nc_ = (n < nvalid) ? n : 0; const float keep = (n < nvalid) ? 1.f : 0.f;
    f32x4 v[16];
#pragma unroll
    for (int i = 0; i < 16; ++i) v[i] = *(const f32x4*)(W + (size_t)(k0 + 4 * i + (lane >> 4)) * ldw + nc_);
#pragma unroll
    for (int i = 0; i < 16; ++i) {
        const int kk = 4 * i + (lane >> 4); const float kp = kg ? keep * kg[k0 + kk] : keep;
        u32x2 o; o.x = pk_bf16(v[i].x * kp, v[i].y * kp); o.y = pk_bf16(v[i].z * kp, v[i].w * kp);
        *(LAS u32x2*)(scr + kk * 136 + (lane & 15) * 8) = o;
    }
    LDS_WAIT();
    const int cc = lane & 7;
#pragma unroll
    for (int j = 0; j < 8; ++j) {
        const int nn = (lane >> 3) + 8 * j; const LAS unsigned short* sp = (const LAS unsigned short*)(scr + (8 * cc) * 136 + nn * 2);
        u32x4 o;
        o.x = (unsigned)sp[0 * 68] | ((unsigned)sp[1 * 68] << 16); o.y = (unsigned)sp[2 * 68] | ((unsigned)sp[3 * 68] << 16);
        o.z = (unsigned)sp[4 * 68] | ((unsigned)sp[5 * 68] << 16); o.w = (unsigned)sp[6 * 68] | ((unsigned)sp[7 * 68] << 16);
        *(u32x4*)(WT + (size_t)(n0 + nn) * K + k0 + 8 * cc) = o;
    }
    LDS_WAIT();
}

__device__ __forceinline__ unsigned pk_fp8x4(float a, float b, float c_, float d) {
    a = fminf(fmaxf(a, -448.f), 448.f); b = fminf(fmaxf(b, -448.f), 448.f); c_ = fminf(fmaxf(c_, -448.f), 448.f); d = fminf(fmaxf(d, -448.f), 448.f);
    int p = __builtin_amdgcn_cvt_pk_fp8_f32(a, b, 0, false);
    p = __builtin_amdgcn_cvt_pk_fp8_f32(c_, d, p, true);
    return (unsigned)p;
}
__device__ __forceinline__ unsigned pk_fp8x4_nc(float a, float b, float c_, float d) {
    int p = __builtin_amdgcn_cvt_pk_fp8_f32(a, b, 0, false);
    p = __builtin_amdgcn_cvt_pk_fp8_f32(c_, d, p, true);
    return (unsigned)p;
}
constexpr float W8_SCALE = 64.f, H8_SCALE = 4.f, O8_SCALE = 8.f;
__device__ __forceinline__ void transpose_item8(const float* W, int K, int N, unsigned char* WT, LAS unsigned char* scr, int item, int lane, int nvalid = 1 << 30, int ldw = 0, const float* kg = nullptr) {
    const int nblk = N / 64, kb = item / nblk, nb = item - kb * nblk, k0 = 128 * kb, n0 = 64 * nb;
    const int n = n0 + 4 * (lane & 15), ld = ldw ? ldw : N, nc_ = (n < nvalid) ? n : 0; const float keep = (n < nvalid) ? W8_SCALE : 0.f;
#pragma unroll 2
    for (int h = 0; h < 2; ++h) {
        f32x4 v[16];
#pragma unroll
        for (int i = 0; i < 16; ++i) v[i] = *(const f32x4*)(W + (size_t)(k0 + 64 * h + 4 * i + (lane >> 4)) * ld + nc_);
#pragma unroll
        for (int i = 0; i < 16; ++i) { const int kk = 64 * h + 4 * i + (lane >> 4); const float kp = kg ? keep * kg[k0 + kk] : keep;
            *(LAS unsigned*)(scr + kk * 68 + (lane & 15) * 4) = (kg ? pk_fp8x4(v[i].x * kp, v[i].y * kp, v[i].z * kp, v[i].w * kp) : pk_fp8x4_nc(v[i].x * kp, v[i].y * kp, v[i].z * kp, v[i].w * kp)); }
    }
    LDS_WAIT();
    const int cc = lane & 7;
#pragma unroll
    for (int j = 0; j < 8; ++j) {
        const int nn = (lane >> 3) + 8 * j; const LAS unsigned char* sp = scr + (16 * cc) * 68 + nn;
        unsigned w[4];
#pragma unroll
        for (int q = 0; q < 4; ++q) w[q] = (unsigned)sp[(4 * q + 0) * 68] | ((unsigned)sp[(4 * q + 1) * 68] << 8) | ((unsigned)sp[(4 * q + 2) * 68] << 16) | ((unsigned)sp[(4 * q + 3) * 68] << 24);
        u32x4 o = {w[0], w[1], w[2], w[3]};
        *(u32x4*)(WT + (size_t)(n0 + nn) * K + k0 + 16 * cc) = o;
    }
    LDS_WAIT();
}
__device__ __forceinline__ void convert_moe_item(const Ctx& c, int l, int it, LAS unsigned char* scr) {
    const float* w1 = (const float*)c.a->in[IN_W1] + (size_t)l * NE * D * DE;
    const float* w3 = (const float*)c.a->in[IN_W3] + (size_t)l * NE * D * DE;
    const float* w2 = (const float*)c.a->in[IN_W2] + (size_t)l * NE * DE * D;
    unsigned char* W3 = c.ws + WS_W3; unsigned char* W2 = c.ws + WS_W2;
    const int e = it / 192, r = it - e * 192;
    if (r < 64)       transpose_item8(w1 + (size_t)e * D * DE, D, DE, W3 + ((size_t)e * 1024 + ((r & 7) >> 1) * 128) * D, scr, r, c.lane);
    else if (r < 128) transpose_item8(w3 + (size_t)e * D * DE, D, DE, W3 + ((size_t)e * 1024 + ((r & 7) >> 1) * 128 + 128) * D, scr, r - 64, c.lane);
    else              transpose_item8(w2 + (size_t)e * DE * D, DE, D, W2 + (size_t)e * D * DE, scr, r - 128, c.lane);
}
__device__ __forceinline__ void convert_moe_layer(const Ctx& c, int l) {
    LAS unsigned char* scr = c.lds + c.wave * TR_SCR;
    const int gw = c.vb * 4 + c.wave, ngw = c.nb * 4;
    for (int it = gw; it < NE * 192; it += ngw) convert_moe_item(c, l, it, scr);
}

__device__ __forceinline__ void phase_prep(const Ctx& c) {
    const __attribute__((address_space(4))) Args& a = *c.a;
    LAS unsigned char* scr = c.lds + c.wave * TR_SCR;
    const int gw = c.vb * 4 + c.wave, ngw = c.nb * 4;
    constexpr int I_AIN = 16 * 64, I_AOUT = 32 * 16, I_PP = 4 * 16, I_BIN8 = 8 * 34, I_BOUT8 = 8 * 16, I_PG8 = 8 * 16, I_BINI = 16 * 10;
    constexpr int NIT = I_AIN + I_AOUT + 2 * I_PP + I_BIN8 + I_BOUT8 + 2 * I_PG8 + I_BINI;
    for (int it = gw; it < NIT; it += ngw) {
        int r = it;
        if (r < I_AIN) { transpose_item((const float*)a.in[IN_AWIN], D, 4096, 4096, 4096, (bf16_t*)(c.ws + WS_WAIN), scr, r, c.lane); continue; } r -= I_AIN;
        if (r < I_AOUT) { transpose_item((const float*)a.in[IN_AWOUT], GW, D, D, D, (bf16_t*)(c.ws + WS_WAOUT), scr, r, c.lane); continue; } r -= I_AOUT;
        if (r < 2 * I_PP) { const int l = r / I_PP; transpose_item((const float*)a.in[IN_PLEP] + (size_t)l * PLE * D, PLE, D, D, D, (bf16_t*)(c.ws + WS_WPROJ) + (size_t)l * D * PLE, scr, r - l * I_PP, c.lane); continue; } r -= 2 * I_PP;
        if (r < I_BIN8) { transpose_item8((const float*)a.in[IN_BWIN], D, BINP, c.ws + WS_WBIN, scr, r, c.lane, BIN, BIN, (const float*)a.in[IN_MIXN] + D); continue; } r -= I_BIN8;
        if (r < I_BOUT8) { transpose_item8((const float*)a.in[IN_BWOUT], D, D, c.ws + WS_WBOUT, scr, r, c.lane); continue; } r -= I_BOUT8;
        if (r < 2 * I_PG8) { const int l = r / I_PG8; transpose_item8((const float*)a.in[IN_PLEG] + (size_t)l * D * D, D, D, c.ws + WS_WGATE + (size_t)l * D * D, scr, r - l * I_PG8, c.lane); continue; } r -= 2 * I_PG8;
        transpose_item((const float*)a.in[IN_BWIN] + 1536, D, 640, BIN - 1536, BIN, (bf16_t*)(c.ws + WS_WBIN + 3 * MB), scr, r, c.lane, (const float*)a.in[IN_MIXN] + D);
    }
    convert_moe_layer(c, 0);
    const int gt = c.vb * NTH + c.tid, ngt = c.nb * NTH;
    { const float* p = (const float*)a.in[IN_P]; bf16_t* pb = (bf16_t*)(c.ws + WS_PBF);
      for (int i = gt; i < 2 * T * PLE / 8; i += ngt) {
          const f32x4 v0 = ((const f32x4*)p)[2 * i], v1 = ((const f32x4*)p)[2 * i + 1];
          u32x4 o; o.x = pk_bf16(v0.x, v0.y); o.y = pk_bf16(v0.z, v0.w); o.z = pk_bf16(v1.x, v1.y); o.w = pk_bf16(v1.z, v1.w);
          ((u32x4*)pb)[i] = o; } }
    { float* wr = (float*)(c.ws + WS_WR);
      for (int i = gt; i < 2 * D * 48; i += ngt) {
          const int l = i / (D * 48), r = i - l * D * 48, k = r / 48, o = r - k * 48;
          float w = 0.f;
          if (o < 4) w = ((const float*)a.in[IN_WG])[(size_t)l * D * 4 + k * 4 + o];
          else if (o < 36) w = ((const float*)a.in[IN_WE])[(size_t)l * D * 32 + k * 32 + (o - 4)];
          const int kh = k >> 9, q = (k >> 7) & 3, ii = (k >> 2) & 31, e = k & 3, nt = o >> 4, m = o & 15;
          wr[(size_t)l * D * 48 + ((((kh * 32 + ii) * 3 + nt) * 64 + q * 16 + m) << 2) + e] = w * ((const float*)a.in[IN_FFNN])[l * D + k]; } }
    if (c.vb == 0) for (int i = c.tid; i < 4 * NSUB * 32; i += 256) ((int*)(c.ws + WS_CNT))[i * CNT_STRIDE] = 0;
    f32x4 gv[4]; gain_load((const float*)a.in[IN_MIXN], c.lane, gv);
    for (int t = gw; t < T; t += ngw) {
        f32x4 v[4]; row_load((const float*)a.in[IN_X] + (size_t)t * D, c.lane, v);
        const float r = rsqrtf(row_sumsq(v) * (1.f / D) + EPS);
        row_store_norm_bf16((bf16_t*)(c.ws + WS_XN) + (size_t)t * D, c.lane, v, r, gv);
    }
}

namespace pg8 {
#define PG8_LAS __attribute__((address_space(3)))
typedef unsigned short bf16_t;
typedef short bf16x8 __attribute__((ext_vector_type(8)));
typedef float f32x4 __attribute__((ext_vector_type(4)));
typedef unsigned u32x4 __attribute__((ext_vector_type(4)));
constexpr int BM = 256, BK = 64, HALF = 128, HTB = HALF * BK * 2  , STAGE_BYTES = 8 * HTB, NXCD = 8, WGM = 8;

__host__ __device__ __forceinline__ int lds_byte(int r, int c) { const int st = (r >> 4) * 2 + (c >> 5), rr = r & 15, cc = c & 31, ob = rr * 64 + cc * 2; return st * 1024 + (ob ^ (((ob >> 9) & 1) << 5)); }
__host__ __device__ __forceinline__ void stage_rc(int b, int& R, int& C) { const int st = b / 1024, sb = b % 1024, swz = sb ^ (((sb >> 9) & 1) << 5); R = (st >> 1) * 16 + swz / 64; C = (st & 1) * 32 + (swz % 64) / 2; }
__host__ __device__ __forceinline__ int perm32(int rho) { const int n = rho >> 4, i = rho & 15; return 8 * (i >> 2) + 4 * n + (i & 3); }

struct Unit { int pm, pn, aux; };
struct Gemm { const bf16_t* A; const bf16_t* Bt; int M, N, K; };

struct StaticOrder {
    int nM, nN, nwg, G, c;
    __host__ __device__ void init(int M, int N, int G_, int c_) { nM = M / BM; nN = N / BM; nwg = nM * nN; G = G_; c = c_; }
    __host__ __device__ bool next(int i, Unit& u) const {
        const long L = (long)i * G + c; if (L >= nwg) return false;
        int wgid = (int)L; { const int q = nwg / NXCD, r = nwg % NXCD, xcd = wgid % NXCD, off = wgid / NXCD; wgid = (xcd < r ? xcd * (q + 1) : r * (q + 1) + (xcd - r) * q) + off; }
        const int nig = WGM * nN, gid = wgid / nig, fm = gid * WGM, gsz = (nM - fm) < WGM ? (nM - fm) : WGM;
        u.pm = fm + ((wgid % nig) % gsz); u.pn = (wgid % nig) / gsz; return true;
    }
    __device__ __forceinline__ void a_ready(const Unit&) const {}
    __device__ __forceinline__ void done(const Unit&) const {}
};


template <class Epi, class Sched, bool ALIGN_EPI = false, bool SP2 = false, bool FP8 = false, bool GATHER = false>
__device__ __forceinline__ void gemm_phase(PG8_LAS unsigned char* lds, const Gemm g, const Sched& S, const Epi& E, const PG8_LAS unsigned* gtab = nullptr) {
    int tido_ = threadIdx.x; asm volatile("" : "+v"(tido_));
    const int tid = tido_, wid = __builtin_amdgcn_readfirstlane(tid >> 6), lane = tid & 63, wr = wid >> 2, wc = wid & 3, fr = lane & 15, fq = lane >> 4;
    int Kop_ = g.K; asm volatile("" : "+s"(Kop_));
    const int K = Kop_, nt = K / BK;
    unsigned voffA[2], voffB[2];
#pragma unroll
    for (int i = 0; i < 2; ++i) { int R, C; stage_rc(tid * 16 + i * 8192, R, C); const int Rb = Epi::PERM ? ((R & ~31) + perm32(R & 31)) : R;
        voffA[i] = GATHER ? (unsigned)(R * 4 + C * 2 * 65536) : (unsigned)(R * K + C) * 2u; voffB[i] = (unsigned)(Rb * K + C) * 2u; }
    unsigned gA[2][2] = {{0u, 0u}, {0u, 0u}};
#define PG8_GLOAD(slot) do { _Pragma("unroll") for (int h_ = 0; h_ < 2; ++h_) _Pragma("unroll") for (int i_ = 0; i_ < 2; ++i_) \
        gA[h_][i_] = *(const PG8_LAS unsigned*)((const PG8_LAS unsigned char*)gtab + (slot) * 1024 + h_ * 512 + (voffA[i_] & 0xffffu)) + (voffA[i_] >> 16); } while (0)
#define PG8_STA(bufoff, base, h) do { if constexpr (GATHER) PG8_STAGE(bufoff, base, gA[h]); else PG8_STAGE(bufoff, (base) + (h) * hstep, voffA); } while (0)
    const size_t kstep = (size_t)(BK * 2);
    const size_t hstep = (size_t)HALF * K * 2;
    const size_t tstep = 2 * hstep;
    const unsigned ldsw = (unsigned)wid * 1024u;
    const int aoff = lds_byte(wr * 64 + fr, fq * 8), boff = lds_byte(wc * 32 + fr, fq * 8);
#define PG8_SA(b, h) (((b) * 2 + (h)) * HTB)
#define PG8_SB(b, h) ((4 + (b) * 2 + (h)) * HTB)
#define PG8_STAGE(bufoff, gbase, voff) do { _Pragma("unroll") for (int _i = 0; _i < 2; ++_i) \
        __builtin_amdgcn_global_load_lds((const unsigned*)((const char*)(gbase) + (voff)[_i]), (PG8_LAS unsigned*)(lds + (bufoff) + ldsw + _i * 8192), 16, 0, 0); } while (0)
#define PG8_LDA(dst, b, h) do { _Pragma("unroll") for (int m = 0; m < 4; ++m) dst[m] = __builtin_shufflevector(*(const PG8_LAS i32x4*)(lds + PG8_SA(b, h) + aoff + m * 2048), *(const PG8_LAS i32x4*)(lds + PG8_SA(b, h) + aoff + m * 2048 + 1024), 0, 1, 2, 3, 4, 5, 6, 7); } while (0)
#define PG8_LDB(dst, b, h) do { _Pragma("unroll") for (int n = 0; n < 2; ++n) dst[n] = __builtin_shufflevector(*(const PG8_LAS i32x4*)(lds + PG8_SB(b, h) + boff + n * 2048), *(const PG8_LAS i32x4*)(lds + PG8_SB(b, h) + boff + n * 2048 + 1024), 0, 1, 2, 3, 4, 5, 6, 7); } while (0)
#define PG8_MMA(ai, bj, At, Bt) do { __builtin_amdgcn_s_setprio(1); _Pragma("unroll") for (int m = 0; m < 4; ++m) _Pragma("unroll") for (int n = 0; n < 2; ++n) { \
        if constexpr (FP8)      \
            asm volatile("v_mfma_scale_f32_16x16x128_f8f6f4 %0, %1, %2, %0, %3, %3 op_sel_hi:[0,0,0]" : "+v"(acc[ai][bj][m][n]) : "v"(Bt[n]), "v"(At[m]), "v"(one8_)); \
        else { acc[ai][bj][m][n] = __builtin_amdgcn_mfma_f32_16x16x32_bf16(__builtin_bit_cast(bf16x8, __builtin_shufflevector(Bt[n], Bt[n], 0, 1, 2, 3)), __builtin_bit_cast(bf16x8, __builtin_shufflevector(At[m], At[m], 0, 1, 2, 3)), acc[ai][bj][m][n], 0, 0, 0); \
               acc[ai][bj][m][n] = __builtin_amdgcn_mfma_f32_16x16x32_bf16(__builtin_bit_cast(bf16x8, __builtin_shufflevector(Bt[n], Bt[n], 4, 5, 6, 7)), __builtin_bit_cast(bf16x8, __builtin_shufflevector(At[m], At[m], 4, 5, 6, 7)), acc[ai][bj][m][n], 0, 0, 0); } } __builtin_amdgcn_s_setprio(0); } while (0)
#define PG8_WAIT_V(n) asm volatile("s_waitcnt vmcnt(" #n ")" ::: "memory")
#define PG8_WAIT_L(n) asm volatile("s_waitcnt lgkmcnt(" #n ")" ::: "memory")
#define PG8_BAR __builtin_amdgcn_s_barrier()
#define PG8_SCHED __builtin_amdgcn_sched_barrier(0)
    Unit cur, nxt; int ui = 0;
    if (!S.next(0, cur)) return;
    int one8_ = 0x7f7f7f7f; asm volatile("" : "+v"(one8_));
    f32x4 acc[2][2][4][2];
    float zf_ = 0.f; asm volatile("" : "+v"(zf_));
#pragma unroll
    for (int a = 0; a < 2; ++a)
#pragma unroll
        for (int b = 0; b < 2; ++b)
#pragma unroll
            for (int m = 0; m < 4; ++m)
#pragma unroll
                for (int n = 0; n < 2; ++n) acc[a][b][m][n] = (f32x4){zf_, zf_, zf_, zf_};
    i32x8 At[4], B0[2], B1[2];
    const char* cA = (const char*)g.A + (GATHER ? (size_t)0 : (size_t)cur.pm * tstep); const char* cB = (const char*)g.Bt + (size_t)cur.pn * tstep;
    S.a_ready(cur);
    if constexpr (GATHER) PG8_GLOAD(cur.pm);
    if constexpr (SP2) {
        PG8_STAGE(PG8_SB(0, 0), cB, voffB); PG8_STAGE(PG8_SB(0, 1), cB + hstep, voffB); PG8_STA(PG8_SA(0, 0), cA, 0); PG8_STA(PG8_SA(0, 1), cA, 1);
        if (wr == 1) PG8_BAR;
        PG8_WAIT_V(2); PG8_BAR;
        PG8_STAGE(PG8_SB(1, 0), cB + kstep, voffB); PG8_STA(PG8_SA(1, 0), cA + kstep, 0); PG8_STAGE(PG8_SB(1, 1), cB + hstep + kstep, voffB);
        PG8_WAIT_V(6); PG8_BAR;
    } else {
        PG8_STAGE(PG8_SB(0, 0), cB, voffB); PG8_STA(PG8_SA(0, 0), cA, 0); PG8_STAGE(PG8_SB(0, 1), cB + hstep, voffB); PG8_STA(PG8_SA(0, 1), cA, 1);
        if (wr == 1) PG8_BAR;
        PG8_WAIT_V(4); PG8_BAR;
        PG8_STAGE(PG8_SB(1, 0), cB + kstep, voffB); PG8_STA(PG8_SA(1, 0), cA + kstep, 0); PG8_STAGE(PG8_SB(1, 1), cB + hstep + kstep, voffB);
        PG8_WAIT_V(6); PG8_BAR;
    }
    for (;;) {
        const bool has_next = S.next(ui + 1, nxt);
        const char* nA = (has_next && !GATHER) ? (const char*)g.A + (size_t)nxt.pm * tstep : cA; const char* nB = has_next ? (const char*)g.Bt + (size_t)nxt.pn * tstep : cB;
        for (int t = 0; t < nt; t += 2) {
            const bool last = (t == nt - 2);
            const char* a1 = cA + (size_t)(t + 1) * kstep;
            const char* a2 = last ? nA : cA + (size_t)(t + 2) * kstep; const char* b2 = last ? nB : cB + (size_t)(t + 2) * kstep;
            const char* a3 = a2 + kstep; const char* b3 = b2 + kstep;
            if (last && has_next) S.a_ready(nxt);
            if constexpr (SP2) {
            PG8_LDB(B0, 0, 0); PG8_LDB(B1, 0, 1); PG8_SCHED; PG8_LDA(At, 0, 0); PG8_STA(PG8_SA(1, 1), a1, 1);
            if constexpr (GATHER) { if (last && has_next) PG8_GLOAD(nxt.pm); }
            PG8_WAIT_V(8); PG8_WAIT_L(0); PG8_BAR; PG8_MMA(0, 0, At, B0); PG8_MMA(0, 1, At, B1); PG8_BAR; PG8_SCHED;
            PG8_LDA(At, 0, 1); PG8_STAGE(PG8_SB(0, 0), b2, voffB); PG8_STAGE(PG8_SB(0, 1), b2 + hstep, voffB); PG8_STA(PG8_SA(0, 0), a2, 0);
            PG8_WAIT_V(8); PG8_WAIT_L(0); PG8_BAR; PG8_MMA(1, 0, At, B0); PG8_MMA(1, 1, At, B1); PG8_BAR; PG8_SCHED;
            PG8_LDB(B0, 1, 0); PG8_LDB(B1, 1, 1); PG8_SCHED; PG8_LDA(At, 1, 0); PG8_STA(PG8_SA(0, 1), a2, 1);
            PG8_WAIT_V(8); PG8_WAIT_L(0); PG8_BAR; PG8_MMA(0, 0, At, B0); PG8_MMA(0, 1, At, B1); PG8_BAR; PG8_SCHED;
            PG8_LDA(At, 1, 1); PG8_STAGE(PG8_SB(1, 0), b3, voffB); PG8_STAGE(PG8_SB(1, 1), b3 + hstep, voffB); PG8_STA(PG8_SA(1, 0), a3, 0);
            PG8_WAIT_V(8); PG8_WAIT_L(0); PG8_BAR; PG8_MMA(1, 0, At, B0); PG8_MMA(1, 1, At, B1); PG8_BAR; PG8_SCHED;
            } else {
            static_assert(SP2 || !GATHER, "GATHER is wired into the SP2 loop only");
            PG8_LDB(B0, 0, 0); PG8_SCHED; PG8_LDA(At, 0, 0); PG8_STAGE(PG8_SA(1, 1), a1 + hstep, voffA);
            PG8_WAIT_L(8); PG8_BAR; PG8_WAIT_L(0); PG8_MMA(0, 0, At, B0); PG8_BAR; PG8_SCHED;
            PG8_LDB(B1, 0, 1); PG8_STAGE(PG8_SB(0, 0), b2, voffB);
            PG8_BAR; PG8_WAIT_L(0); PG8_MMA(0, 1, At, B1); PG8_BAR;
            PG8_LDA(At, 0, 1); PG8_STAGE(PG8_SA(0, 0), a2, voffA);
            PG8_BAR; PG8_WAIT_L(0); PG8_MMA(1, 0, At, B0); PG8_BAR; PG8_SCHED;
            PG8_STAGE(PG8_SB(0, 1), b2 + hstep, voffB);
            PG8_WAIT_V(6); PG8_BAR; PG8_MMA(1, 1, At, B1); PG8_BAR;
            PG8_LDB(B0, 1, 0); PG8_SCHED; PG8_LDA(At, 1, 0); PG8_STAGE(PG8_SA(0, 1), a2 + hstep, voffA);
            PG8_WAIT_L(8); PG8_BAR; PG8_WAIT_L(0); PG8_MMA(0, 0, At, B0); PG8_BAR; PG8_SCHED;
            PG8_LDB(B1, 1, 1); PG8_STAGE(PG8_SB(1, 0), b3, voffB);
            PG8_BAR; PG8_WAIT_L(0); PG8_MMA(0, 1, At, B1); PG8_BAR;
            PG8_LDA(At, 1, 1); PG8_STAGE(PG8_SA(1, 0), a3, voffA);
            PG8_BAR; PG8_WAIT_L(0); PG8_MMA(1, 0, At, B0); PG8_BAR; PG8_SCHED;
            PG8_STAGE(PG8_SB(1, 1), b3 + hstep, voffB);
            PG8_WAIT_V(6); PG8_BAR; PG8_MMA(1, 1, At, B1); PG8_BAR;
            }
        }
        if constexpr (ALIGN_EPI) { if (wr == 0) PG8_BAR; }
        if constexpr (FP8) asm volatile("s_nop 15\n\ts_nop 15" ::: "memory");
        if constexpr (!Epi::AFTER_DRAIN) { int le_ = lane; asm volatile("" : "+v"(le_));
            E(acc, cur, wr, wc, le_ & 15, le_ >> 4); S.done(cur); }
        if (!has_next) break;
        asm volatile("v_mov_b32 %0, 0" : "=v"(zf_));
#pragma unroll
        for (int a = 0; a < 2; ++a)
#pragma unroll
            for (int b = 0; b < 2; ++b)
#pragma unroll
                for (int m = 0; m < 4; ++m)
#pragma unroll
                    for (int n = 0; n < 2; ++n) acc[a][b][m][n] = (f32x4){zf_, zf_, zf_, zf_};
        cur = nxt; cA = nA; cB = nB; ++ui;
        if constexpr (ALIGN_EPI) { if (wr == 1) PG8_BAR; }
    }
    PG8_WAIT_V(0);
    if constexpr (!ALIGN_EPI) { if (wr == 0) PG8_BAR; }
    PG8_BAR;
    if constexpr (Epi::AFTER_DRAIN) { E.fused(acc, cur, wr, wc, fr, fq, lds, wid, lane); S.done(cur); }
#undef PG8_SA
#undef PG8_STA
#undef PG8_GLOAD
#undef PG8_SB
#undef PG8_STAGE
#undef PG8_LDA
#undef PG8_LDB
#undef PG8_MMA
#undef PG8_WAIT_V
#undef PG8_WAIT_L
#undef PG8_BAR
#undef PG8_SCHED
}

}

struct EpiA1U {
    static constexpr bool PERM = true, AFTER_DRAIN = false;
    bf16_t* U;
    __device__ __forceinline__ void operator()(const pg8::f32x4 (&acc)[2][2][4][2], const pg8::Unit& u, int wr, int wc, int fr, int fq) const {
        bf16_t* up = U + (size_t)(u.pm * 256 + wr * 64 + fr) * GW + u.pn * 256 + wc * 32 + 8 * fq;
#pragma unroll
        for (int ai = 0; ai < 2; ++ai)
#pragma unroll
            for (int m = 0; m < 4; ++m)
#pragma unroll
                for (int bj = 0; bj < 2; ++bj) {
                    const f32x4 v0 = acc[ai][bj][m][0], v1 = acc[ai][bj][m][1];
                    u32x4 w; w.x = pk_bf16(gelu_tanh(v0.x), gelu_tanh(v0.y)); w.y = pk_bf16(gelu_tanh(v0.z), gelu_tanh(v0.w)); w.z = pk_bf16(gelu_tanh(v1.x), gelu_tanh(v1.y)); w.w = pk_bf16(gelu_tanh(v1.z), gelu_tanh(v1.w));
                    *(u32x4*)(up + (size_t)(ai * 128 + m * 16) * GW + bj * 128) = w;
                }
    }
};
struct EpiA1V {
    static constexpr bool PERM = true, AFTER_DRAIN = false;
    bf16_t* VT; float* VSS;
    __device__ __forceinline__ void operator()(const pg8::f32x4 (&acc)[2][2][4][2], const pg8::Unit& u, int wr, int wc, int fr, int fq) const {
        const int tok0 = u.pn * 256 + wc * 32 + 8 * fq;
        bf16_t* vp = VT + (size_t)(u.pm * 256 + wr * 64 + fr) * T + tok0;
        f32x4 ss[2][2];
#pragma unroll
        for (int bj = 0; bj < 2; ++bj) { ss[bj][0] = (f32x4){0.f, 0.f, 0.f, 0.f}; ss[bj][1] = (f32x4){0.f, 0.f, 0.f, 0.f}; }
#pragma unroll
        for (int ai = 0; ai < 2; ++ai)
#pragma unroll
            for (int m = 0; m < 4; ++m)
#pragma unroll
                for (int bj = 0; bj < 2; ++bj) {
                    f32x4 v0 = acc[ai][bj][m][0], v1 = acc[ai][bj][m][1];
                    v0.x = gelu_tanh(v0.x); v0.y = gelu_tanh(v0.y); v0.z = gelu_tanh(v0.z); v0.w = gelu_tanh(v0.w);
                    v1.x = gelu_tanh(v1.x); v1.y = gelu_tanh(v1.y); v1.z = gelu_tanh(v1.z); v1.w = gelu_tanh(v1.w);
                    ss[bj][0] += v0 * v0; ss[bj][1] += v1 * v1;
                    u32x4 w; w.x = pk_bf16(v0.x, v0.y); w.y = pk_bf16(v0.z, v0.w); w.z = pk_bf16(v1.x, v1.y); w.w = pk_bf16(v1.z, v1.w);
                    *(u32x4*)(vp + (size_t)(ai * 128 + m * 16) * T + bj * 128) = w;
                }
#pragma unroll
        for (int bj = 0; bj < 2; ++bj)
#pragma unroll
            for (int n = 0; n < 2; ++n) {
                f32x4 q = ss[bj][n];
#pragma unroll
                for (int o = 1; o < 16; o <<= 1) { q.x += __shfl_xor(q.x, o); q.y += __shfl_xor(q.y, o); q.z += __shfl_xor(q.z, o); q.w += __shfl_xor(q.w, o); }
                if (fr == 0) *(f32x4*)(VSS + (size_t)(u.pm * 2 + wr) * T + tok0 + bj * 128 + 4 * n) = q;
            }
    }
};
__device__ __forceinline__ void phase_a1(const Ctx& c) {
    const pg8::bf16_t* XN = (const pg8::bf16_t*)(c.ws + WS_XN); const pg8::bf16_t* W = (const pg8::bf16_t*)(c.ws + WS_WAIN);
    {
        pg8::Gemm g{XN, W, T, GW, D}; pg8::StaticOrder S; S.init(T, GW, (int)gridDim.x, (int)blockIdx.x);
        EpiA1U E{(bf16_t*)(c.ws + WS_U)};
        pg8::gemm_phase<EpiA1U, pg8::StaticOrder, true, true, false>(c.ldsp, g, S, E);
    }
    __syncthreads();
    {
        pg8::Gemm g{W + (size_t)GW * D, XN, GW, T, D}; pg8::StaticOrder S; S.init(GW, T, (int)gridDim.x, (int)blockIdx.x);
        EpiA1V E{(bf16_t*)(c.ws + WS_VT), (float*)(c.ws + WS_VSS)};
        pg8::gemm_phase<EpiA1V, pg8::StaticOrder, true, true, false>(c.ldsp, g, S, E);
    }
}

__device__ __forceinline__ void phase_a2(const Ctx& c, bool dry = false) {
    const __attribute__((address_space(4))) Args& a = *c.a;
    bf16_t* U = (bf16_t*)(c.ws + WS_U); const bf16_t* VT = (const bf16_t*)(c.ws + WS_VT); const float* VSS = (const float*)(c.ws + WS_VSS);
    const float* ws_ = (const float*)a.in[IN_AWS]; const float* bs_ = (const float*)a.in[IN_ABS]; const float* vg = (const float*)a.in[IN_AVG];
    const int fr = c.lane & 15, fq = c.lane >> 4, wr = c.wave >> 1, wc = c.wave & 1, tid = c.tid;
    LAS unsigned char* lds = c.lds;
    LAS float* rl = (LAS float*)(lds + LDS_MAIN);
    for (int u = c.vb; u < 128 * 8; u += c.nb) {
        const int ci = u >> 3, g = u & 7, tokbase = ci * 128;
        __syncthreads();
        if (tid < 128) {
            const float* p = VSS + tokbase + tid; float s = 0.f;
#pragma unroll
            for (int i = 0; i < 16; ++i) s += p[(size_t)i * T];
            rl[tid] = rsqrtf(s * (1.f / GW) + EPS);
        }
        __syncthreads();
        {
            const int t = tid >> 1, half = tid & 1;
            const float* wrow = ws_ + ((size_t)g * 128 + t) * 128 + half * 64;
#pragma unroll
            for (int cc = 0; cc < 8; ++cc) {
                const int s0 = half * 64 + cc * 8;
                u32x4 o;
                {
                    const f32x4 w0 = ((const f32x4*)wrow)[2 * cc], w1 = ((const f32x4*)wrow)[2 * cc + 1];
                    float e[8] = {w0.x, w0.y, w0.z, w0.w, w1.x, w1.y, w1.z, w1.w};
                    const f32x4 r0_ = *(const LAS f32x4*)(rl + s0), r1_ = *(const LAS f32x4*)(rl + s0 + 4);
                    const float rr[8] = {r0_.x, r0_.y, r0_.z, r0_.w, r1_.x, r1_.y, r1_.z, r1_.w};
#pragma unroll
                    for (int i = 0; i < 8; ++i) e[i] = (s0 + i <= t) ? e[i] * rr[i] : 0.f;
                    o.x = pk_bf16(e[0], e[1]); o.y = pk_bf16(e[2], e[3]); o.z = pk_bf16(e[4], e[5]); o.w = pk_bf16(e[6], e[7]);
                }
                *(LAS u32x4*)(lds + half * 16384 + t * 128 + ((cc ^ (t & 7)) << 4)) = o;
            }
        }
        for (int hn = 0; hn < 2; ++hn) {
            const int c0 = g * 256 + hn * 128;
            const bf16_t* bp[4]; rows_regular<64>(bp, VT + (size_t)c0 * T + tokbase, T, tid);
            stage_tile<64>(lds + 32768, bp, 0, tid); stage_tile<64>(lds + 32768 + 16384, bp, 64, tid);
            VM_WAIT();
            __syncthreads();
            f32x4 acc[4][4]; zero_acc(acc);
#pragma unroll 1
            for (int kh = 0; kh < 2; ++kh)
#pragma unroll 1
                for (int ks = 0; ks < 2; ++ks) {
                    bf16x8 af[4], bf[4];
#pragma unroll
                    for (int m = 0; m < 4; ++m) af[m] = *(const LAS bf16x8*)(lds + kh * 16384 + frag_off<64>(wr * 64 + m * 16 + fr, ks, fq));
#pragma unroll
                    for (int n = 0; n < 4; ++n) bf[n] = *(const LAS bf16x8*)(lds + 32768 + kh * 16384 + frag_off<64>(wc * 64 + n * 16 + fr, ks, fq));
#pragma unroll
                    for (int m = 0; m < 4; ++m)
#pragma unroll
                        for (int n = 0; n < 4; ++n) acc[m][n] = __builtin_amdgcn_mfma_f32_16x16x32_bf16(bf[n], af[m], acc[m][n], 0, 0, 0);
                }
            u32x2 uvv[4][4]; float bsvv[4];
#pragma unroll
            for (int m = 0; m < 4; ++m) { const int tl = wr * 64 + m * 16 + fr; bsvv[m] = bs_[g * 128 + tl];
#pragma unroll
                for (int n = 0; n < 4; ++n) uvv[m][n] = *(const u32x2*)(U + (size_t)(tokbase + tl) * GW + c0 + wc * 64 + n * 16 + fq * 4); }
#pragma unroll
            for (int m = 0; m < 4; ++m) {
                const int tl = wr * 64 + m * 16 + fr; const float bsv = bsvv[m];
#pragma unroll
                for (int n = 0; n < 4; ++n) {
                    const int ch = c0 + wc * 64 + n * 16 + fq * 4;
                    const f32x4 gn = *(const f32x4*)(vg + ch);
                    u32x2* up = (u32x2*)(U + (size_t)(tokbase + tl) * GW + ch);
                    const u32x2 uv = uvv[m][n]; const f32x4 v = acc[m][n];
                    u32x2 o;
                    o.x = pk_bf16(bf_lo(uv.x) * (gn.x * v.x + bsv), bf_hi(uv.x) * (gn.y * v.y + bsv));
                    o.y = pk_bf16(bf_lo(uv.y) * (gn.z * v.z + bsv), bf_hi(uv.y) * (gn.w * v.w + bsv));
                    if (dry) *(u32x2*)(c.ws + 440 * MB + ((size_t)(tokbase + tl) * GW + ch) * 2) = o; else *up = o;
                }
            }
            __syncthreads();
        }
    }
}

template <bool BASE_F32> struct EpiResH {
    static constexpr bool PERM = true, AFTER_DRAIN = false;
    const void* base; bf16_t* out; float ascale;
    __device__ __forceinline__ void operator()(const pg8::f32x4 (&acc)[2][2][4][2], const pg8::Unit& u, int wr, int wc, int fr, int fq) const {
        const size_t o0 = (size_t)(u.pm * 256 + wr * 64 + fr) * D + u.pn * 256 + wc * 32 + 8 * fq;
#pragma unroll
        for (int ai = 0; ai < 2; ++ai)
#pragma unroll
            for (int m = 0; m < 4; ++m) {
                f32x4 b0[2], b1[2];
#pragma unroll
                for (int bj = 0; bj < 2; ++bj) { const size_t o = o0 + (size_t)(ai * 128 + m * 16) * D + bj * 128;
                    if (BASE_F32) { b0[bj] = *(const f32x4*)((const float*)base + o); b1[bj] = *(const f32x4*)((const float*)base + o + 4); }
                    else { const u32x4 w = *(const u32x4*)((const bf16_t*)base + o); b0[bj] = (f32x4){bf_lo(w.x), bf_hi(w.x), bf_lo(w.y), bf_hi(w.y)}; b1[bj] = (f32x4){bf_lo(w.z), bf_hi(w.z), bf_lo(w.w), bf_hi(w.w)}; } }
#pragma unroll
                for (int bj = 0; bj < 2; ++bj) { const size_t o = o0 + (size_t)(ai * 128 + m * 16) * D + bj * 128;
                    const f32x4 v0 = b0[bj] + acc[ai][bj][m][0] * ascale, v1 = b1[bj] + acc[ai][bj][m][1] * ascale;
                    u32x4 w; w.x = pk_bf16(v0.x, v0.y); w.y = pk_bf16(v0.z, v0.w); w.z = pk_bf16(v1.x, v1.y); w.w = pk_bf16(v1.z, v1.w);
                    *(u32x4*)(out + o) = w; }
            }
    }
};
__device__ __forceinline__ void phase_a3(const Ctx& c) {
    pg8::Gemm g{(const pg8::bf16_t*)(c.ws + WS_U), (const pg8::bf16_t*)(c.ws + WS_WAOUT), T, D, GW};
    pg8::StaticOrder S; S.init(T, D, (int)gridDim.x, (int)blockIdx.x);
    EpiResH<true> E{c.a->in[IN_X], (bf16_t*)(c.ws + WS_H), 1.f};
    pg8::gemm_phase<EpiResH<true>, pg8::StaticOrder, true, true, false>(c.ldsp, g, S, E);
}

__device__ __forceinline__ void phase_route(const Ctx& c, int l, bool dry = false) {
    const __attribute__((address_space(4))) Args& a = *c.a;
    const bf16_t* H = (const bf16_t*)(c.ws + WS_H);
    const float* wr_ = (const float*)(c.ws + WS_WR) + (size_t)l * D * 48;
    const float* gain = (const float*)a.in[IN_FFNN] + l * D;
    int* cnt = (int*)(c.ws + WS_CNT) + (size_t)(l + (dry ? 2 : 0)) * NSUB * 32 * CNT_STRIDE; int* list = (int*)(c.ws + (dry ? 480 * MB : WS_LIST)); float* gatel = (float*)(c.ws + (dry ? 484 * MB : WS_GATE)); int* tokslot = (int*)(c.ws + (dry ? 488 * MB : WS_TOKSLOT));
    LAS float* rl = (LAS float*)(c.lds);
    LAS float* lgl = (LAS float*)(c.lds + 256);
    const int lane = c.lane, w = c.wave;
    f32x4 gv[4]; gain_load(gain, lane, gv);
    for (int unit = c.vb; unit < T / 32; unit += c.nb) {
        const int tok0 = unit * 32;
        __syncthreads();
#pragma unroll 1
        for (int i0 = 0; i0 < 8; i0 += 4) {
            f32x4 v[4][4];
#pragma unroll
            for (int i = 0; i < 4; ++i) row_load_h(H + (size_t)(tok0 + w * 8 + i0 + i) * D, lane, v[i]);
#pragma unroll
            for (int i = 0; i < 4; ++i) {
                const int t = tok0 + w * 8 + i0 + i;
                const float r = rsqrtf(row_sumsq(v[i]) * (1.f / D) + EPS);
                if (lane == 0) rl[w * 8 + i0 + i] = r;
                row_store_norm_fp8(c.ws + (dry ? 440 * MB : WS_XN8) + (size_t)t * D, lane, v[i], r, gv);
            }
        }
#ifndef MK_DRYPART
#define MK_DRYPART 3
#endif
        if (!(dry && MK_DRYPART < 2))
        {
            const int th = w & 1, kh = w >> 1, m = lane & 15, q = lane >> 4;
            const u32x2* ap = (const u32x2*)(H + (size_t)(tok0 + 16 * th + m) * D + 512 * kh + 128 * q);
            const f32x4* bp = (const f32x4*)wr_ + (size_t)kh * 32 * 3 * 64 + lane;
            f32x4 acc[3]; acc[0] = acc[1] = acc[2] = (f32x4){0.f, 0.f, 0.f, 0.f};
#pragma unroll 1
            for (int i0 = 0; i0 < 32; i0 += 4) {
                f32x4 av[4], bv[4][3];
#pragma unroll
                for (int i = 0; i < 4; ++i) { { const u32x2 hw = ap[i0 + i]; av[i] = (f32x4){bf_lo(hw.x), bf_hi(hw.x), bf_lo(hw.y), bf_hi(hw.y)}; }
#pragma unroll
                    for (int nt = 0; nt < 3; ++nt) bv[i][nt] = bp[((i0 + i) * 3 + nt) * 64]; }
#pragma unroll
                for (int i = 0; i < 4; ++i)
#pragma unroll
                    for (int e = 0; e < 4; ++e)
#pragma unroll
                        for (int nt = 0; nt < 3; ++nt) acc[nt] = __builtin_amdgcn_mfma_f32_16x16x4f32(av[i][e], bv[i][nt][e], acc[nt], 0, 0, 0);
            }
#pragma unroll
            for (int nt = 0; nt < 3; ++nt)
#pragma unroll
                for (int j = 0; j < 4; ++j) lgl[(kh * 32 + th * 16 + 4 * q + j) * 48 + nt * 16 + m] = acc[nt][j];
        }
        __syncthreads();
        if (c.tid < 32 && !(dry && MK_DRYPART < 3)) {
            const int tt = c.tid, t = tok0 + tt; const float r = rl[tt];
            const float* bg = (const float*)a.in[IN_BG] + l * 4; const float* be = (const float*)a.in[IN_BE] + l * 32;
            float gl[4];
#pragma unroll
            for (int o = 0; o < 4; ++o) gl[o] = (lgl[tt * 48 + o] + lgl[(32 + tt) * 48 + o]) * r + bg[o];
            int gs = 0; float gm = gl[0];
#pragma unroll
            for (int o = 1; o < 4; ++o) if (gl[o] > gm) { gm = gl[o]; gs = o; }
            float gden = 0.f;
#pragma unroll
            for (int o = 0; o < 4; ++o) gden += __expf(gl[o] - gm);
            const float pg = 1.f / gden;
            float l1 = -INFINITY, l2 = -INFINITY; int i1 = 0, i2 = 0;
            for (int i = 0; i < 8; ++i) {
                const int o = 4 + gs * 8 + i;
                const float v = (lgl[tt * 48 + o] + lgl[(32 + tt) * 48 + o]) * r + be[gs * 8 + i];
                if (v > l1) { l2 = l1; i2 = i1; l1 = v; i1 = i; } else if (v > l2) { l2 = v; i2 = i; }
            }
            const float e2 = __expf(l2 - l1), inv = 1.f / (1.f + e2);
            const float g1 = pg * inv, g2 = pg * e2 * inv;
            const int ea = gs * 8 + i1, eb = gs * 8 + i2;
            const int sub = unit & (NSUB - 1);
            const int sa = sub * SUBCAP + atomicAdd(&cnt[(sub * 32 + ea) * CNT_STRIDE], 1), sb = sub * SUBCAP + atomicAdd(&cnt[(sub * 32 + eb) * CNT_STRIDE], 1);
            list[ea * T + sa] = t; gatel[ea * T + sa] = g1; tokslot[2 * t] = (ea << 16) | sa;
            list[eb * T + sb] = t; gatel[eb * T + sb] = g2; tokslot[2 * t + 1] = (eb << 16) | sb;
        }
    }
}

__device__ __forceinline__ void moe_table_build(const unsigned char* ws, int l, int tl, LAS int* pst, LAS int* cn, LAS int* sub) {
    if (tl < 32) {
        const int* cnt = (const int*)(ws + WS_CNT) + (size_t)l * NSUB * 32 * CNT_STRIDE + tl * CNT_STRIDE;
        int v[NSUB];
#pragma unroll
        for (int s2 = 0; s2 < NSUB; ++s2) v[s2] = cnt[(size_t)s2 * 32 * CNT_STRIDE];
        int acc = 0;
#pragma unroll
        for (int s2 = 0; s2 < NSUB; ++s2) { sub[tl * 33 + s2] = acc; acc += v[s2]; }
        sub[tl * 33 + NSUB] = acc; cn[tl] = acc;
        const int nb = (acc + 255) >> 8; int inc = nb;
#pragma unroll
        for (int o = 1; o < 32; o <<= 1) { const int t2 = __shfl_up(inc, o); if (tl >= o) inc += t2; }
        pst[tl] = inc - nb; if (tl == 31) pst[32] = inc;
    }
}
__device__ __forceinline__ void moe_table(const Ctx& c, int l, LAS int* pst, LAS int* cn, LAS int* sub) {
    __syncthreads();
    moe_table_build(c.ws, l, c.tid, pst, cn, sub);
    __syncthreads();
}
__device__ __forceinline__ void moe_table_wg(const Ctx& c, int l, LAS int* pst, LAS int* cn, LAS int* sub) {
    __syncthreads();
    moe_table_build(c.ws, l, (int)threadIdx.x, pst, cn, sub);
    __syncthreads();
}
__device__ __forceinline__ int moe_row_idx(LAS const int* sub, int e, int r) {
    int s2 = 0;
    for (int i = 1; i < NSUB; ++i) s2 = (sub[e * 33 + i] <= r) ? i : s2;
    return s2 * SUBCAP + (r - sub[e * 33 + s2]);
}
__device__ __forceinline__ int moe_find(LAS const int* pst, int mb) { int e = 0; for (int i = 1; i < 32; ++i) e = (pst[i] <= mb) ? i : e; return e; }

constexpr int MOE_LDS = 131072;
constexpr int CAPU = 16;
constexpr int MOE_SUB = MOE_LDS + 1024 + CAPU * 1024;
static_assert(MOE_SUB + 32 * 33 * 4 <= LDS_BYTES - 16, "moe lds");
__device__ __forceinline__ void moe_table_wg(const Ctx& c, int l, LAS int* pst, LAS int* cn) {
    __syncthreads();
    if (threadIdx.x == 0) {
        const int* cnt = (const int*)(c.ws + WS_CNT) + l * 32 * CNT_STRIDE; int acc = 0;
        for (int e = 0; e < 32; ++e) { const int n = cnt[e * CNT_STRIDE]; cn[e] = n; pst[e] = acc; acc += (n + 255) >> 8; }
        pst[32] = acc;
    }
    __syncthreads();
}
struct MoeOrder {
    LAS const int* pst; int nunits, G, c, i0; bool gather;
    __device__ __forceinline__ bool next(int i, pg8::Unit& u) const {
        if (i >= CAPU) return false;
        const long L = (long)(i0 + i) * G + c; if (L >= nunits) return false;
        int wgid = (int)L; { const int q = nunits / 8, r = nunits % 8, xcd = wgid % 8, off = wgid / 8; wgid = (xcd < r ? xcd * (q + 1) : r * (q + 1) + (xcd - r) * q) + off; }
        const int mb = wgid >> 2, e = __builtin_amdgcn_readfirstlane(moe_find(pst, mb));
        u.pm = gather ? i : mb; u.pn = e * 4 + (wgid & 3); u.aux = mb; return true;
    }
    __device__ __forceinline__ void a_ready(const pg8::Unit&) const {}
    __device__ __forceinline__ void done(const pg8::Unit&) const {}
};
struct EpiE1 {
    static constexpr bool PERM = true, AFTER_DRAIN = false;
    unsigned char* HM;
    __device__ __forceinline__ void operator()(const pg8::f32x4 (&acc)[2][2][4][2], const pg8::Unit& u, int wr, int wc, int fr, int fq) const {
        const float ws_ = 1.f / W8_SCALE;
        unsigned char* hp = HM + ((size_t)u.aux * 256 + wr * 64 + fr) * DE + (u.pn & 3) * 128 + wc * 32 + 8 * fq;
#pragma unroll
        for (int ai = 0; ai < 2; ++ai)
#pragma unroll
            for (int m = 0; m < 4; ++m) {
                u32x2 o;
#pragma unroll
                for (int n = 0; n < 2; ++n) {
                    const f32x4 x = acc[ai][0][m][n] * ws_, y = acc[ai][1][m][n] * (ws_ * H8_SCALE);
                    const unsigned w = pk_fp8x4(x.x * sigmoidf_(x.x) * y.x, x.y * sigmoidf_(x.y) * y.y, x.z * sigmoidf_(x.z) * y.z, x.w * sigmoidf_(x.w) * y.w);
                    if (n == 0) o.x = w; else o.y = w;
                }
                *(u32x2*)(hp + (size_t)(ai * 128 + m * 16) * DE) = o;
            }
    }
};
__device__ __forceinline__ void phase_e1(const Ctx& c, int l) {
    LAS int* pst = (LAS int*)(c.ldsp + MOE_LDS); LAS int* cn = pst + 40; LAS unsigned* gtab = (LAS unsigned*)(c.ldsp + MOE_LDS + 1024); LAS int* sub = (LAS int*)(c.ldsp + MOE_SUB);
    moe_table_wg(c, l, pst, cn, sub);
    const float* gatel = (const float*)(c.ws + WS_GATE); float* grow = (float*)(c.ws + WS_GROW);
    const int* list = (const int*)(c.ws + WS_LIST);
    pg8::Gemm g{(const pg8::bf16_t*)(c.ws + WS_XN8), (const pg8::bf16_t*)(c.ws + WS_W3), RPAD, 1024, D / 2};
    MoeOrder S{pst, __builtin_amdgcn_readfirstlane(pst[32]) * 4, (int)gridDim.x, (int)blockIdx.x, 0, true};
    EpiE1 E{c.ws + WS_HMID};
    for (;; S.i0 += CAPU) {
        pg8::Unit u; if (!S.next(0, u)) break;
        for (int i = 0; i < CAPU; ++i) {
            if (!S.next(i, u)) break;
            const int e = u.pn >> 2, row0 = (u.aux - __builtin_amdgcn_readfirstlane(pst[e])) * 256, count = __builtin_amdgcn_readfirstlane(cn[e]);
            if (threadIdx.x < 256) {
                const int r = row0 + (int)threadIdx.x, idx = moe_row_idx(sub, e, r < count ? r : row0);
                gtab[i * 256 + threadIdx.x] = (unsigned)list[e * T + idx] * (unsigned)D;
                if ((u.pn & 3) == 0) grow[(size_t)u.aux * 256 + threadIdx.x] = (r < count) ? gatel[e * T + idx] : 0.f;
            }
        }
        __syncthreads();
        pg8::gemm_phase<EpiE1, MoeOrder, true, true, true, true>(c.ldsp, g, S, E, gtab);
        __syncthreads();
    }
}
struct EpiE2 {
    static constexpr bool PERM = true, AFTER_DRAIN = false;
    bf16_t* Y; const float* grow;
    __device__ __forceinline__ void operator()(const pg8::f32x4 (&acc)[2][2][4][2], const pg8::Unit& u, int wr, int wc, int fr, int fq) const {
        const int mb = u.aux;
        bf16_t* yp = Y + ((size_t)mb * 256 + wr * 64 + fr) * D + (u.pn & 3) * 256 + wc * 32 + 8 * fq;
        const float* gp = grow + (size_t)mb * 256 + wr * 64 + fr;
#pragma unroll
        for (int ai = 0; ai < 2; ++ai) {
            float gt[4];
#pragma unroll
            for (int m = 0; m < 4; ++m) gt[m] = gp[ai * 128 + m * 16] * (1.f / (W8_SCALE * H8_SCALE));
#pragma unroll
            for (int m = 0; m < 4; ++m)
#pragma unroll
                for (int bj = 0; bj < 2; ++bj) {
                    const f32x4 v0 = acc[ai][bj][m][0] * gt[m], v1 = acc[ai][bj][m][1] * gt[m];
                    u32x4 w; w.x = pk_bf16(v0.x, v0.y); w.y = pk_bf16(v0.z, v0.w); w.z = pk_bf16(v1.x, v1.y); w.w = pk_bf16(v1.z, v1.w);
                    *(u32x4*)(yp + (size_t)(ai * 128 + m * 16) * D + bj * 128) = w;
                }
        }
    }
};
__device__ __forceinline__ void phase_e2(const Ctx& c, int l) {
    LAS int* pst = (LAS int*)(c.ldsp + MOE_LDS); LAS int* cn = pst + 40; LAS int* sub = (LAS int*)(c.ldsp + MOE_SUB);
    moe_table_wg(c, l, pst, cn, sub);
    int kq = DE / 2; asm volatile("" : "+s"(kq));
    pg8::Gemm g{(const pg8::bf16_t*)(c.ws + WS_HMID), (const pg8::bf16_t*)(c.ws + WS_W2), RPAD, 1024, kq};
    MoeOrder S{pst, __builtin_amdgcn_readfirstlane(pst[32]) * 4, (int)gridDim.x, (int)blockIdx.x, 0, false};
    EpiE2 E{(bf16_t*)(c.ws + WS_Y), (const float*)(c.ws + WS_GROW)};
    for (;; S.i0 += CAPU) {
        pg8::Unit u; if (!S.next(0, u)) break;
        pg8::gemm_phase<EpiE2, MoeOrder, true, true, true, false>(c.ldsp, g, S, E);
        __syncthreads();
    }
}
__device__ __forceinline__ void phase_p1(const Ctx& c, int l, bool dry = false) {
    const bf16_t* H = (const bf16_t*)(c.ws + WS_H); bf16_t* HO = (bf16_t*)(c.ws + (dry ? 440 * MB : WS_H)); const bf16_t* Y = (const bf16_t*)(c.ws + WS_Y);
    const int* tokslot = (const int*)(c.ws + WS_TOKSLOT); const float* gain = (const float*)c.a->in[IN_PLEN] + l * D;
    LAS int* pst = (LAS int*)(c.lds + LDS_MAIN); LAS int* cn = pst + 40; LAS int* sub = (LAS int*)c.lds;
    moe_table(c, l, pst, cn, sub);
    const int gw = c.vb * 4 + c.wave, ngw = c.nb * 4, lane = c.lane;
    f32x4 gv[4]; gain_load(gain, lane, gv);
    int s0n = 0, s1n = 0;
    if (gw < T) { s0n = tokslot[2 * gw]; s1n = tokslot[2 * gw + 1]; }
    for (int t = gw; t < T; t += ngw) {
        const int s0 = s0n, s1 = s1n;
        { const int tn = (t + ngw < T) ? t + ngw : t; s0n = tokslot[2 * tn]; s1n = tokslot[2 * tn + 1]; }
        const int e0 = s0 >> 16, i0 = s0 & 0xffff, e1 = s1 >> 16, i1 = s1 & 0xffff;
        const bf16_t* y0 = Y + ((size_t)pst[e0] * 256 + sub[e0 * 33 + i0 / SUBCAP] + (i0 % SUBCAP)) * D; const bf16_t* y1 = Y + ((size_t)pst[e1] * 256 + sub[e1 * 33 + i1 / SUBCAP] + (i1 % SUBCAP)) * D;
        f32x4 v[4]; u32x2 a0[4], a1[4];
        row_load_h(H + (size_t)t * D, lane, v);
#pragma unroll
        for (int j = 0; j < 4; ++j) { a0[j] = ((const u32x2*)y0)[lane + 64 * j]; a1[j] = ((const u32x2*)y1)[lane + 64 * j]; }
#pragma unroll
        for (int j = 0; j < 4; ++j) {
            v[j].x += bf_lo(a0[j].x) + bf_lo(a1[j].x); v[j].y += bf_hi(a0[j].x) + bf_hi(a1[j].x); v[j].z += bf_lo(a0[j].y) + bf_lo(a1[j].y); v[j].w += bf_hi(a0[j].y) + bf_hi(a1[j].y);
        }
        row_store_h(HO + (size_t)t * D, lane, v);
        const float r = rsqrtf(row_sumsq(v) * (1.f / D) + EPS);
        row_store_norm_fp8(c.ws + (dry ? 440 * MB : WS_XN8) + (size_t)t * D, lane, v, r, gv);
    }
}
struct EpiPJ {
    static constexpr bool PERM = true, AFTER_DRAIN = false;
    bf16_t* PJ;
    __device__ __forceinline__ void operator()(const pg8::f32x4 (&acc)[2][2][4][2], const pg8::Unit& u, int wr, int wc, int fr, int fq) const {
        bf16_t* pp = PJ + (size_t)(u.pm * 256 + wr * 64 + fr) * D + u.pn * 256 + wc * 32 + 8 * fq;
#pragma unroll
        for (int ai = 0; ai < 2; ++ai)
#pragma unroll
            for (int m = 0; m < 4; ++m)
#pragma unroll
                for (int bj = 0; bj < 2; ++bj) {
                    const f32x4 v0 = acc[ai][bj][m][0], v1 = acc[ai][bj][m][1];
                    u32x4 w; w.x = pk_bf16(v0.x, v0.y); w.y = pk_bf16(v0.z, v0.w); w.z = pk_bf16(v1.x, v1.y); w.w = pk_bf16(v1.z, v1.w);
                    *(u32x4*)(pp + (size_t)(ai * 128 + m * 16) * D + bj * 128) = w;
                }
    }
};
template <bool EMIT> struct EpiP2 {
    static constexpr bool PERM = true, AFTER_DRAIN = false;
    const bf16_t* PJ; const bf16_t* H; bf16_t* HO; unsigned char* H8; float* RSS;
    __device__ __forceinline__ void operator()(const pg8::f32x4 (&acc)[2][2][4][2], const pg8::Unit& u, int wr, int wc, int fr, int fq) const {
        const size_t o0 = (size_t)(u.pm * 256 + wr * 64 + fr) * D + u.pn * 256 + wc * 32 + 8 * fq;
#pragma unroll
        for (int ai = 0; ai < 2; ++ai)
#pragma unroll
            for (int m = 0; m < 4; ++m) {
                float ssq = 0.f;
                u32x4 pj[2], hw[2];
#pragma unroll
                for (int bj = 0; bj < 2; ++bj) { const size_t o = o0 + (size_t)(ai * 128 + m * 16) * D + bj * 128;
                    pj[bj] = *(const u32x4*)(PJ + o); hw[bj] = *(const u32x4*)(H + o); }
#pragma unroll
                for (int bj = 0; bj < 2; ++bj) { const size_t o = o0 + (size_t)(ai * 128 + m * 16) * D + bj * 128;
                    const f32x4 g0 = acc[ai][bj][m][0] * (1.f / W8_SCALE), g1 = acc[ai][bj][m][1] * (1.f / W8_SCALE);
                    f32x4 a0 = {bf_lo(hw[bj].x), bf_hi(hw[bj].x), bf_lo(hw[bj].y), bf_hi(hw[bj].y)}, a1 = {bf_lo(hw[bj].z), bf_hi(hw[bj].z), bf_lo(hw[bj].w), bf_hi(hw[bj].w)};
                    a0.x += sigmoidf_(g0.x) * bf_lo(pj[bj].x); a0.y += sigmoidf_(g0.y) * bf_hi(pj[bj].x); a0.z += sigmoidf_(g0.z) * bf_lo(pj[bj].y); a0.w += sigmoidf_(g0.w) * bf_hi(pj[bj].y);
                    a1.x += sigmoidf_(g1.x) * bf_lo(pj[bj].z); a1.y += sigmoidf_(g1.y) * bf_hi(pj[bj].z); a1.z += sigmoidf_(g1.z) * bf_lo(pj[bj].w); a1.w += sigmoidf_(g1.w) * bf_hi(pj[bj].w);
                    u32x4 ow; ow.x = pk_bf16(a0.x, a0.y); ow.y = pk_bf16(a0.z, a0.w); ow.z = pk_bf16(a1.x, a1.y); ow.w = pk_bf16(a1.z, a1.w);
                    *(u32x4*)(HO + o) = ow;
                    if (EMIT) { u32x2 o8; o8.x = pk_fp8x4(a0.x, a0.y, a0.z, a0.w); o8.y = pk_fp8x4(a1.x, a1.y, a1.z, a1.w); *(u32x2*)(H8 + o) = o8;
                        ssq += (a0.x * a0.x + a0.y * a0.y) + (a0.z * a0.z + a0.w * a0.w) + (a1.x * a1.x + a1.y * a1.y) + (a1.z * a1.z + a1.w * a1.w); } }
                if (EMIT) { ssq += __shfl_xor(ssq, 16); ssq += __shfl_xor(ssq, 32);
                    if (fq == 0) RSS[(size_t)(u.pm * 256 + ai * 128 + wr * 64 + m * 16 + fr) * 16 + u.pn * 4 + wc] = ssq; }
            }
    }
};
__device__ __forceinline__ void phase_p2(const Ctx& c, int l, bool dry = false) {
    bf16_t* PJ = (bf16_t*)(c.ws + WS_Y);
    pg8::StaticOrder S; S.init(T, D, (int)gridDim.x, (int)blockIdx.x);
    {
        pg8::Gemm g{(const pg8::bf16_t*)(c.ws + WS_PBF) + (size_t)l * T * PLE, (const pg8::bf16_t*)(c.ws + WS_WPROJ) + (size_t)l * D * PLE, T, D, PLE};
        EpiPJ E{PJ};
        pg8::gemm_phase<EpiPJ, pg8::StaticOrder, true, true, false>(c.ldsp, g, S, E);
    }
    __syncthreads();
    {
        pg8::Gemm g{(const pg8::bf16_t*)(c.ws + WS_XN8), (const pg8::bf16_t*)(c.ws + WS_WGATE + (size_t)l * D * D), T, D, D / 2};
        if (l == 0) { EpiP2<true> E{PJ, (const bf16_t*)(c.ws + WS_H), (bf16_t*)(c.ws + (dry ? 440 * MB : WS_H)), c.ws + (dry ? 440 * MB + 64 * MB : WS_H8), (float*)(c.ws + (dry ? 440 * MB + 80 * MB : WS_RSS))};
            pg8::gemm_phase<EpiP2<true>, pg8::StaticOrder, true, true, true>(c.ldsp, g, S, E); }
        else { EpiP2<false> E{PJ, (const bf16_t*)(c.ws + WS_H), (bf16_t*)(c.ws + (dry ? 440 * MB : WS_H)), nullptr, nullptr};
            pg8::gemm_phase<EpiP2<false>, pg8::StaticOrder, true, true, true>(c.ldsp, g, S, E); }
    }
}
__device__ __forceinline__ void phase_norm_bf16(const Ctx& c, const float* gain) {
    const bf16_t* H = (const bf16_t*)(c.ws + WS_H);
    const int gw = c.vb * 4 + c.wave, ngw = c.nb * 4;
    f32x4 gv[4]; gain_load(gain, c.lane, gv);
    for (int t = gw; t < T; t += ngw) {
        f32x4 v[4]; row_load_h(H + (size_t)t * D, c.lane, v);
        const float r = rsqrtf(row_sumsq(v) * (1.f / D) + EPS);
        row_store_norm_fp8(c.ws + WS_XN8 + (size_t)t * D, c.lane, v, r, gv);
        row_store_norm_bf16((bf16_t*)(c.ws + WS_XN) + (size_t)t * D, c.lane, v, r, gv);
    }
}
__device__ __forceinline__ void phase_final(const Ctx& c) {
    const bf16_t* H = (const bf16_t*)(c.ws + WS_H); float* O = c.a->out; const float* gain = (const float*)c.a->in[IN_FINN];
    const int gw = c.vb * 4 + c.wave, ngw = c.nb * 4;
    f32x4 gv[4]; gain_load(gain, c.lane, gv);
    for (int t = gw; t < T; t += ngw) {
        f32x4 v[4]; row_load_h(H + (size_t)t * D, c.lane, v);
        const float r = rsqrtf(row_sumsq(v) * (1.f / D) + EPS);
#pragma unroll
        for (int j = 0; j < 4; ++j) ((f32x4*)(O + (size_t)t * D))[c.lane + 64 * j] = v[j] * r * gv[j];
    }
}

struct B1Order {
    int G, c, nN, mode;
    __device__ __forceinline__ bool next(int i, pg8::Unit& u) const {
        int L;
        if (G == 256) {
            if (mode == 0) { if (c < 64) { if (i >= 3) return false; L = c * 3 + i; } else { if (i >= 1) return false; L = 192 + (c - 64); } }
            else { if (c < 64 || i >= 1) return false; L = c - 64; }
        } else { L = i * G + c; if (L >= 64 * nN) return false; }
        u.pm = L / nN; u.pn = L - u.pm * nN; u.aux = 0; return true;
    }
    __device__ __forceinline__ void a_ready(const pg8::Unit&) const {}
    __device__ __forceinline__ void done(const pg8::Unit&) const {}
};
struct EpiRaw {
    static constexpr bool PERM = true, AFTER_DRAIN = false;
    bf16_t* RAW; int col_off; float sc;
    __device__ __forceinline__ void operator()(const pg8::f32x4 (&acc)[2][2][4][2], const pg8::Unit& u, int wr, int wc, int fr, int fq) const {
        const int col0 = col_off + u.pn * 256 + wc * 32 + 8 * fq;
        bf16_t* rp = RAW + (size_t)(u.pm * 256 + wr * 64 + fr) * BINP + col0;
#pragma unroll
        for (int bj = 0; bj < 2; ++bj) {
            if (col0 + bj * 128 >= BINP) continue;
#pragma unroll
            for (int ai = 0; ai < 2; ++ai)
#pragma unroll
                for (int m = 0; m < 4; ++m) {
                    const f32x4 v0 = acc[ai][bj][m][0] * sc, v1 = acc[ai][bj][m][1] * sc;
                    u32x4 w; w.x = pk_bf16(v0.x, v0.y); w.y = pk_bf16(v0.z, v0.w); w.z = pk_bf16(v1.x, v1.y); w.w = pk_bf16(v1.z, v1.w);
                    *(u32x4*)(rp + (size_t)(ai * 128 + m * 16) * BINP + bj * 128) = w;
                }
        }
    }
};
__device__ __forceinline__ void phase_b1(const Ctx& c, size_t raw_off = WS_RAW) {
    bf16_t* RAW = (bf16_t*)(c.ws + raw_off);
    {
        pg8::Gemm g{(const pg8::bf16_t*)(c.ws + WS_H8), (const pg8::bf16_t*)(c.ws + WS_WBIN), T, 1536, D / 2};
        B1Order S{(int)gridDim.x, (int)blockIdx.x, 6, 0}; EpiRaw E{RAW, 0, 1.f / W8_SCALE};
        pg8::gemm_phase<EpiRaw, B1Order, true, true, true>(c.ldsp, g, S, E);
    }
    __syncthreads();
    {
        pg8::Gemm g{(const pg8::bf16_t*)(c.ws + WS_H), (const pg8::bf16_t*)(c.ws + WS_WBIN + 3 * MB), T, 768, D};
        B1Order S{(int)gridDim.x, (int)blockIdx.x, 3, 1}; EpiRaw E{RAW, 1536, 1.f};
        pg8::gemm_phase<EpiRaw, B1Order, true, true, false>(c.ldsp, g, S, E);
    }
}
__device__ __forceinline__ void unpack8(const u32x4 r, float (&e)[8]) { e[0] = bf_lo(r.x); e[1] = bf_hi(r.x); e[2] = bf_lo(r.y); e[3] = bf_hi(r.y); e[4] = bf_lo(r.z); e[5] = bf_hi(r.z); e[6] = bf_lo(r.w); e[7] = bf_hi(r.w); }
__device__ __forceinline__ u32x4 pack8(const float (&e)[8]) { u32x4 o; o.x = pk_bf16(e[0], e[1]); o.y = pk_bf16(e[2], e[3]); o.z = pk_bf16(e[4], e[5]); o.w = pk_bf16(e[6], e[7]); return o; }
__device__ __forceinline__ void phase_rope(const Ctx& c) {
    const bf16_t* RAW = (const bf16_t*)(c.ws + WS_RAW);
    bf16_t* Q = (bf16_t*)(c.ws + WS_Q); bf16_t* K = (bf16_t*)(c.ws + WS_K); bf16_t* V = (bf16_t*)(c.ws + WS_V);
    bf16_t* QI = (bf16_t*)(c.ws + WS_QI); bf16_t* KI = (bf16_t*)(c.ws + WS_KI); float* WI = (float*)(c.ws + WS_WI);
    const int* pos = (const int*)c.a->in[IN_POS];
    LAS float* cs = (LAS float*)(c.lds + c.wave * 256);
    const int gw = c.vb * 4 + c.wave, ngw = c.nb * 4, lane = c.lane;
    const double ex = (lane < 16) ? (double)lane * (1.0 / 16.0) : (double)((lane - 16) & 7) * (1.0 / 8.0);
    const float invf = (float)exp2(-ex * 18.931568569324174);
    for (int t = gw; t < T; t += ngw) {
        if (lane < 24) {
            const float ang = (float)pos[t] * invf;
            const double ad = (double)ang; const double n = rint(ad * 0.15915494309189535); const float red = (float)(ad - n * 6.283185307179586);
            cs[lane] = __cosf(red); cs[32 + lane] = __sinf(red);
        }
        LDS_WAIT();
        const bf16_t* row = RAW + (size_t)t * BINP;
        float rn;
        { const f32x4* pp = (const f32x4*)((const float*)(c.ws + WS_RSS) + (size_t)t * 16); const f32x4 q0 = pp[0], q1 = pp[1], q2 = pp[2], q3 = pp[3];
          const f32x4 qs = (q0 + q1) + (q2 + q3); rn = rsqrtf(((qs.x + qs.y) + (qs.z + qs.w)) * (1.f / D) + EPS); }
        for (int ch = lane; ch < BINP / 8; ch += 64) {
            const u32x4 own = ((const u32x4*)row)[ch];
            float e[8]; unpack8(own, e);
#pragma unroll
            for (int i = 0; i < 8; ++i) e[i] *= rn;
            if (ch < 160) {
                const int cc = ch & 15;
                if (cc < 4) {
                    const u32x4 oth = ((const u32x4*)row)[ch ^ 2]; float p[8]; unpack8(oth, p);
#pragma unroll
                    for (int i = 0; i < 8; ++i) p[i] *= rn;
                    const int f0 = (cc & 1) * 8;
#pragma unroll
                    for (int i = 0; i < 8; ++i) { const float co = cs[f0 + i], si = cs[32 + f0 + i]; e[i] = (cc < 2) ? (e[i] * co - p[i] * si) : (e[i] * co + p[i] * si); }
                }
                u32x2 o8; o8.x = pk_fp8x4(e[0], e[1], e[2], e[3]); o8.y = pk_fp8x4(e[4], e[5], e[6], e[7]);
                if (ch < 128) ((u32x2*)((unsigned char*)Q + (size_t)t * D))[ch] = o8;
                else ((u32x2*)((unsigned char*)K + (size_t)t * 256))[ch - 128] = o8;
            } else if (ch < 192) {
                u32x2 o8; o8.x = pk_fp8x4(e[0], e[1], e[2], e[3]); o8.y = pk_fp8x4(e[4], e[5], e[6], e[7]);
                ((u32x2*)((unsigned char*)V + (size_t)t * 256))[ch - 160] = o8;
            } else if (ch < 264) {
                const int cc = ch & 7;
                if (cc < 2) {
                    const u32x4 oth = ((const u32x4*)row)[ch ^ 1]; float p[8]; unpack8(oth, p);
#pragma unroll
                    for (int i = 0; i < 8; ++i) p[i] *= rn;
#pragma unroll
                    for (int i = 0; i < 8; ++i) { const float co = cs[16 + i], si = cs[32 + 16 + i]; e[i] = (cc == 0) ? (e[i] * co - p[i] * si) : (e[i] * co + p[i] * si); }
                }
                if (ch < 256) ((u32x4*)(QI + (size_t)t * 512))[ch - 192] = pack8(e);
                else ((u32x4*)(KI + (size_t)t * 64))[ch - 256] = pack8(e);
            } else if (ch == 264) {
                f32x4 w0 = {e[0], e[1], e[2], e[3]}, w1 = {e[4], e[5], e[6], e[7]};
                const float sc = 0.044194173824159216f;
                ((f32x4*)(WI + (size_t)t * 8))[0] = w0 * sc; ((f32x4*)(WI + (size_t)t * 8))[1] = w1 * sc;
            }
        }
        LDS_WAIT();
    }
}

__device__ __forceinline__ size_t srow_off(int t) { const int m = t >> 6, r = t & 63; return (size_t)64 * (m + 1) * (32 * m + r); }
constexpr size_t S_BATCH = (size_t)64 * 65 * 2048;
constexpr int SCORE_UNITS = 4 * 312;
__device__ __forceinline__ void phase_score(const Ctx& c) {
    const bf16_t* QI = (const bf16_t*)(c.ws + WS_QI); const bf16_t* KI = (const bf16_t*)(c.ws + WS_KI); const float* WI = (const float*)(c.ws + WS_WI);
    float* S = (float*)(c.ws + WS_S);
    const int lane = c.lane, hf = lane >> 5, col = lane & 31, w = c.wave;
    for (int u = c.vb; u < SCORE_UNITS; u += c.nb) {
        const int b = u & 3, r = u >> 2;
        int kc, qb;
        if (r < 120) { kc = 0; qb = 8 + r; } else if (r < 216) { kc = 1; qb = 32 + (r - 120); } else if (r < 280) { kc = 2; qb = 64 + (r - 216); } else { kc = 3; qb = 96 + (r - 280); }
        const int tb = b * SEQ, t0 = 32 * qb + 8 * w;
        bf16x8 af[2][4]; f32x4 wv[2][4];
        { const int rho = lane & 31, ql = 2 * ((rho >> 2) & 1) + (rho >> 4), hd = 4 * ((rho >> 3) & 1) + (rho & 3);
#pragma unroll
          for (int a = 0; a < 2; ++a) {
              const bf16_t* qp = QI + (size_t)(tb + t0 + 4 * a + ql) * 512 + hd * 64 + 8 * hf;
#pragma unroll
              for (int ks = 0; ks < 4; ++ks) af[a][ks] = *(const bf16x8*)(qp + 16 * ks);
              const float* wp = WI + (size_t)(tb + t0 + 4 * a + 2 * hf) * 8;
#pragma unroll
              for (int i = 0; i < 4; ++i) wv[a][i] = ((const f32x4*)wp)[i];
          } }
        const int ntile = min(32, qb + 1 - 32 * kc), key0 = 1024 * kc;
        float* Sb = S + (size_t)b * S_BATCH;
        size_t ro[2][2];
#pragma unroll
        for (int a = 0; a < 2; ++a) { ro[a][0] = srow_off(t0 + 4 * a + 2 * hf); ro[a][1] = srow_off(t0 + 4 * a + 2 * hf + 1); }
        const int nsub = (ntile + 3) >> 2;
        const bf16_t* krp[4];
        rows_regular<64>(krp, KI + (size_t)(tb + key0) * 64, 64, c.tid);
        __syncthreads();
        stage_tile<64>(c.lds, krp, 0, c.tid);
        for (int sc = 0; sc < 8; ++sc) {
            VM_WAIT();
            __syncthreads();
            const LAS unsigned char* cur = c.lds + (sc & 1) * 16384;
            if (sc + 1 < nsub) stage_tile<64>(c.lds + ((sc + 1) & 1) * 16384, krp, (sc + 1) * 128 * 64, c.tid);
#pragma unroll
            for (int j = 0; j < 4; ++j) {
                const int kt = 4 * sc + j;
                if (sc < nsub && kt < ntile) {
                    const int key = key0 + 32 * kt + col, row = 32 * j + col;
                    bf16x8 cb[4];
#pragma unroll
                    for (int ks = 0; ks < 4; ++ks) cb[ks] = *(const LAS bf16x8*)(cur + row * 128 + (((2 * ks + hf) ^ (row & 7)) << 4));
#pragma unroll
                    for (int a = 0; a < 2; ++a) {
                        f32x16 acc = {};
#pragma unroll
                        for (int ks = 0; ks < 4; ++ks) acc = __builtin_amdgcn_mfma_f32_32x32x16_bf16(af[a][ks], cb[ks], acc, 0, 0, 0);
                        float s0 = fmaxf(acc[0], 0.f) * wv[a][0].x; s0 += fmaxf(acc[1], 0.f) * wv[a][0].y; s0 += fmaxf(acc[2], 0.f) * wv[a][0].z; s0 += fmaxf(acc[3], 0.f) * wv[a][0].w;
                        s0 += fmaxf(acc[4], 0.f) * wv[a][1].x; s0 += fmaxf(acc[5], 0.f) * wv[a][1].y; s0 += fmaxf(acc[6], 0.f) * wv[a][1].z; s0 += fmaxf(acc[7], 0.f) * wv[a][1].w;
                        float s1 = fmaxf(acc[8], 0.f) * wv[a][2].x; s1 += fmaxf(acc[9], 0.f) * wv[a][2].y; s1 += fmaxf(acc[10], 0.f) * wv[a][2].z; s1 += fmaxf(acc[11], 0.f) * wv[a][2].w;
                        s1 += fmaxf(acc[12], 0.f) * wv[a][3].x; s1 += fmaxf(acc[13], 0.f) * wv[a][3].y; s1 += fmaxf(acc[14], 0.f) * wv[a][3].z; s1 += fmaxf(acc[15], 0.f) * wv[a][3].w;
                        const int tA = t0 + 4 * a + 2 * hf;
                        Sb[ro[a][0] + key] = (key <= tA) ? s0 : -INFINITY;
                        Sb[ro[a][1] + key] = (key <= tA + 1) ? s1 : -INFINITY;
                    }
                }
            }
        }
    }
}

constexpr int NBINS = 2048, CAND_CAP = 256, SEL_WAVE_LDS = 8192 + 2048 + 64;
__device__ __forceinline__ int clamp_bin(int x) { return min(max(x, 0), NBINS - 1); }
__device__ __forceinline__ void phase_select(const Ctx& c) {
    const float* S = (const float*)(c.ws + WS_S); int* SEL = (int*)(c.ws + WS_SEL);
    LAS int* hist = (LAS int*)(c.lds + c.wave * SEL_WAVE_LDS);
    LAS float* candv = (LAS float*)(hist + NBINS);
    LAS int* candi = (LAS int*)(candv + CAND_CAP);
    LAS int* thr = candi + CAND_CAP;
    const int gw = c.vb * 4 + c.wave, ngw = c.nb * 4;
    LAS unsigned char* cscr = c.lds + 4 * SEL_WAVE_LDS + c.wave * TR_SCR; static_assert(4 * SEL_WAVE_LDS + 4 * TR_SCR <= LDS_MAIN, "select lds");
    int cit = gw, rcount = 0;
    for (int j = gw; j < 4 * 3840; j += ngw) {
        int lane = c.lane;
        asm volatile("" : "+v"(lane));
        const int b = j & 3, t = 4095 - (j >> 2), ni = (t + 64) >> 6;
        const float* row = S + (size_t)b * S_BATCH + srow_off(t);
        float s[64];
#pragma unroll
        for (int g4 = 0; g4 < 4; ++g4) {
            if (16 * g4 < ni) {
#pragma unroll
                for (int i = 16 * g4; i < 16 * g4 + 16; ++i) { const int k = 64 * i + lane; const float v = row[min(k, t)]; s[i] = (k <= t) ? v : -INFINITY; }
            } else {
#pragma unroll
                for (int i = 16 * g4; i < 16 * g4 + 16; ++i) s[i] = -INFINITY;
            }
        }
        float mn = INFINITY, mx = -INFINITY;
#pragma unroll
        for (int g8 = 0; g8 < 8; ++g8) if (8 * g8 < ni) {
#pragma unroll
            for (int i = 8 * g8; i < 8 * g8 + 8; ++i) { mx = fmaxf(mx, s[i]); mn = fminf(mn, (s[i] == -INFINITY) ? INFINITY : s[i]); }
        }
#pragma unroll
        for (int o = 1; o < 64; o <<= 1) { mx = fmaxf(mx, __shfl_xor(mx, o)); mn = fminf(mn, __shfl_xor(mn, o)); }
        const float sc = (mx > mn) ? (float)NBINS / (mx - mn) : 0.f, a0 = -mn * sc;
#pragma unroll
        for (int i = 0; i < 8; ++i) ((LAS u32x4*)hist)[lane * 8 + i] = (u32x4){0u, 0u, 0u, 0u};
        LDS_WAIT();
#define BINOF(v) clamp_bin((int)__builtin_fmaf((v), sc, a0))
#pragma unroll
        for (int g8 = 0; g8 < 8; ++g8) if (8 * g8 < ni) {
#pragma unroll
            for (int i = 8 * g8; i < 8 * g8 + 8; ++i) lds_inc(&hist[BINOF(s[i])]);
        }
        LDS_WAIT();
        int bs, need;
        {
            const LAS int* hq = hist + lane * 32;
            u32x4 hr[8];
            int loc = 0;
#pragma unroll
            for (int i = 0; i < 8; ++i) { hr[i] = ((const LAS u32x4*)hq)[i]; loc += (int)(hr[i].x + hr[i].y + hr[i].z + hr[i].w); }
            int suf = loc;
#pragma unroll
            for (int o = 1; o < 64; o <<= 1) { const int v = __shfl_down(suf, o); if (lane + o < 64) suf += v; }
            const int above = suf - loc;
            const bool cross = (above < 256 && suf >= 256);
            int bsl = 0, abl = 0;
            { int run = above;
#pragma unroll
              for (int i = 31; i >= 0; --i) { const int h = (int)hr[i >> 2][i & 3]; const bool hit = (run < 256 && run + h >= 256); bsl = hit ? lane * 32 + i : bsl; abl = hit ? run : abl; run += h; } }
            const unsigned long long cm = __ballot(cross);
            const int src = cm ? (int)__builtin_ctzll(cm) : 0;
            bs = __shfl(bsl, src); need = 256 - __shfl(abl, src);
        }
        int bs2 = -1;
#define SUBOF(v) clamp_bin((int)((__builtin_fmaf((v), sc, a0) - (float)bs) * (float)NBINS))
        if (__shfl(hist[bs], 0) > 48) {
#pragma unroll
            for (int i = 0; i < 8; ++i) ((LAS u32x4*)hist)[lane * 8 + i] = (u32x4){0u, 0u, 0u, 0u};
            LDS_WAIT();
#pragma unroll
            for (int i = 0; i < 64; ++i) if (s[i] != -INFINITY && BINOF(s[i]) == bs) lds_inc(&hist[SUBOF(s[i])]);
            LDS_WAIT();
            const LAS int* hq = hist + lane * 32;
            int loc = 0;
#pragma unroll
            for (int i = 0; i < 8; ++i) { const u32x4 h4 = ((const LAS u32x4*)hq)[i]; loc += (int)(h4.x + h4.y + h4.z + h4.w); }
            int suf = loc;
#pragma unroll
            for (int o = 1; o < 64; o <<= 1) { const int v = __shfl_down(suf, o); if (lane + o < 64) suf += v; }
            const int above = suf - loc;
            const bool cross = (above < need && suf >= need);
            int bsl = 0, abl = 0;
            if (cross) { int run = above; for (int i = 31; i >= 0; --i) { const int h = hq[i]; if (run < need && run + h >= need) { bsl = lane * 32 + i; abl = run; } run += h; } }
            const unsigned long long cm = __ballot(cross);
            const int src = cm ? (int)__builtin_ctzll(cm) : 0;
            bs2 = __shfl(bsl, src); need = need - __shfl(abl, src);
        }
        asm volatile("" : "+v"(lane));
        float sc2 = sc, a02 = a0;
        asm volatile("" : "+v"(sc2), "+v"(a02));
#undef BINOF
#define BINOF(v) clamp_bin((int)__builtin_fmaf((v), sc2, a02))
        int* selr = SEL + ((size_t)b * SEQ + t) * 256;
        int nc = 0, base = 0;
#pragma unroll
        for (int g4 = 0; g4 < 4; ++g4) if (16 * g4 < ni) {
#pragma unroll
            for (int i = 16 * g4; i < 16 * g4 + 16; ++i) {
                const int bn = BINOF(s[i]);
                bool pc = (bn == bs) && (s[i] != -INFINITY), pd = (bn > bs);
                if (bs2 >= 0) { const int sb = SUBOF(s[i]); pd = pd || (pc && sb > bs2); pc = pc && (sb == bs2); }
                const unsigned long long md = __ballot(pd), mc = __ballot(pc);
                const int posd = base + (int)__builtin_amdgcn_mbcnt_hi((unsigned)(md >> 32), __builtin_amdgcn_mbcnt_lo((unsigned)md, 0u));
                const int posc = nc + (int)__builtin_amdgcn_mbcnt_hi((unsigned)(mc >> 32), __builtin_amdgcn_mbcnt_lo((unsigned)mc, 0u));
                if (pd && posd < 256) selr[posd] = 64 * i + lane;
                if (pc && posc < CAND_CAP) { candv[posc] = s[i]; candi[posc] = 64 * i + lane; }
                base += (int)__popcll(md); nc += (int)__popcll(mc);
            }
        }
        nc = min(nc, CAND_CAP);
        LDS_WAIT();
        for (int i = lane; i < nc; i += 64) {
            const float v = candv[i]; const int id = candi[i];
            int rank = 0;
            for (int k = 0; k < nc; ++k) { const float vk = candv[k]; const int ik = candi[k]; rank += (vk > v || (vk == v && ik < id)) ? 1 : 0; }
            if (rank < need && base + rank < 256) selr[base + rank] = id;
        }
        LDS_WAIT();
#undef BINOF
#undef SUBOF
        if ((rcount & 1) && cit < NE * 192) { convert_moe_item(c, 1, cit, cscr); cit += ngw; }
        ++rcount;
    }
    for (; cit < NE * 192; cit += ngw) convert_moe_item(c, 1, cit, cscr);
}

typedef short s16x4 __attribute__((ext_vector_type(4)));
__device__ __forceinline__ unsigned vimg_f(unsigned r) { return ((r & 3u) << 2) | ((r >> 2) & 3u); }
__device__ __forceinline__ void tr_read8(const unsigned (&ad)[8], s16x4 (&r)[8]) {
    asm volatile("ds_read_b64_tr_b16 %0, %8\n\tds_read_b64_tr_b16 %1, %9\n\tds_read_b64_tr_b16 %2, %10\n\tds_read_b64_tr_b16 %3, %11\n\t"
                 "ds_read_b64_tr_b16 %4, %12\n\tds_read_b64_tr_b16 %5, %13\n\tds_read_b64_tr_b16 %6, %14\n\tds_read_b64_tr_b16 %7, %15\n\ts_waitcnt lgkmcnt(0)"
                 : "=&v"(r[0]), "=&v"(r[1]), "=&v"(r[2]), "=&v"(r[3]), "=&v"(r[4]), "=&v"(r[5]), "=&v"(r[6]), "=&v"(r[7])
                 : "v"(ad[0]), "v"(ad[1]), "v"(ad[2]), "v"(ad[3]), "v"(ad[4]), "v"(ad[5]), "v"(ad[6]), "v"(ad[7]) : "memory");
}
__device__ __forceinline__ void tr_read8_b8(const unsigned (&ad)[8], s16x4 (&r)[8]) {
    asm volatile("ds_read_b64_tr_b8 %0, %8\n\tds_read_b64_tr_b8 %1, %9\n\tds_read_b64_tr_b8 %2, %10\n\tds_read_b64_tr_b8 %3, %11\n\t"
                 "ds_read_b64_tr_b8 %4, %12\n\tds_read_b64_tr_b8 %5, %13\n\tds_read_b64_tr_b8 %6, %14\n\tds_read_b64_tr_b8 %7, %15\n\ts_waitcnt lgkmcnt(0)"
                 : "=&v"(r[0]), "=&v"(r[1]), "=&v"(r[2]), "=&v"(r[3]), "=&v"(r[4]), "=&v"(r[5]), "=&v"(r[6]), "=&v"(r[7])
                 : "v"(ad[0]), "v"(ad[1]), "v"(ad[2]), "v"(ad[3]), "v"(ad[4]), "v"(ad[5]), "v"(ad[6]), "v"(ad[7]) : "memory");
}
constexpr int ATT_WAVE_LDS = 19456;
__device__ __forceinline__ void phase_attn(const Ctx& c) {
    const bf16_t* Q = (const bf16_t*)(c.ws + WS_Q); const bf16_t* K = (const bf16_t*)(c.ws + WS_K); const bf16_t* V = (const bf16_t*)(c.ws + WS_V);
    const int* SEL = (const int*)(c.ws + WS_SEL); bf16_t* O = (bf16_t*)(c.ws + WS_O);
    LAS unsigned char* wl = c.lds + c.wave * ATT_WAVE_LDS;
    LAS int* sl = (LAS int*)wl;
    LAS unsigned short* pT = (LAS unsigned short*)(wl + 1024);
    LAS unsigned char* vb = wl + 3072;
    const int lane = c.lane, fr = lane & 15, fq = lane >> 4;
    const int gw = c.vb * 4 + c.wave, ngw = c.nb * 4;
    unsigned tro[8];
    { const unsigned row = 8u * fq + ((unsigned)fr >> 1);
#pragma unroll
      for (int c2 = 0; c2 < 8; ++c2) tro[c2] = 128u * row + 16u * ((unsigned)c2 ^ (row & 7u)) + 8u * ((unsigned)fr & 1u); }
    const unsigned vb_addr = (unsigned)(size_t)vb;
    int tcount = 0, cit = gw;
    const bool xsplit = (c.nb % 128) == 0;
    const int xg = (c.vb >> 6) & 1, wi0 = xsplit ? (((c.vb >> 7) * 64 + (c.vb & 63)) * 4 + c.wave) : gw, wstride = xsplit ? ngw / 2 : ngw;
    const unsigned chunkoff = (((unsigned)lane & 7u) ^ (((unsigned)lane >> 3) & 7u)) << 4;
    unsigned trh[8];
    { const unsigned row = 8u * (fq & 1) + ((unsigned)fr >> 1);
#pragma unroll
      for (int c2 = 0; c2 < 8; ++c2) trh[c2] = 128u * row + 16u * ((unsigned)c2 ^ (row & 7u)) + 8u * ((unsigned)fr & 1u); }
#define SEL_PREFETCH(tg_) __builtin_amdgcn_global_load_lds((const unsigned*)(SEL + (size_t)(tg_) * 256 + lane * 4), (LAS unsigned*)((LAS unsigned char*)sl + lane * 16), 16, 0, 0)
    const int task_end = xsplit ? T : T * 2;
    if (wi0 < task_end) { SEL_PREFETCH(xsplit ? wi0 : (wi0 >> 1)); }
    for (int task = wi0; task < task_end; task += wstride) {
        const int tg = xsplit ? task : (task >> 1), g = xsplit ? xg : (task & 1), b = tg >> 12, t = tg & 4095, tb = b * SEQ;
        const int nsel = min(256, t + 1), nch = (nsel + 31) >> 5;
        asm volatile("s_waitcnt vmcnt(0)" ::: "memory");
        unsigned koff[32];
#pragma unroll
        for (int q = 0; q < 32; ++q) { const int s_ = 8 * q + (lane >> 3); int idx = sl[s_]; idx = (t < 256) ? s_ : idx; idx = (s_ < nsel && (unsigned)idx <= (unsigned)t) ? idx : 0; koff[q] = (unsigned)idx * 256u + chunkoff; }
        i64x2 qf[2];
        { const unsigned char* qp = (const unsigned char*)Q + (size_t)tg * D + (4 * g + (fr >> 2)) * 128 + 16 * fq;
#pragma unroll
          for (int i = 0; i < 2; ++i) qf[i] = *(const i64x2*)(qp + 64 * i); }
        asm volatile("s_waitcnt vmcnt(0) lgkmcnt(0)" ::: "memory");
        asm volatile("" : "+v"(qf[0]), "+v"(qf[1]));
        { const int tn = task + wstride; if (tn < task_end) SEL_PREFETCH(xsplit ? tn : (tn >> 1)); }
        const unsigned char* kbase = (const unsigned char*)K + (size_t)tb * 256 + g * 128;
        const unsigned char* vbase = (const unsigned char*)V + (size_t)tb * 256 + g * 128;
#define CH_GATHER(cidx) do { const unsigned char* bp_ = ((cidx) < 16) ? kbase : vbase; _Pragma("unroll") for (int i_ = 0; i_ < 2; ++i_) { \
            unsigned o_ = koff[2 * ((cidx) & 15) + i_]; asm volatile("" : "+v"(o_));     \
            __builtin_amdgcn_global_load_lds((const unsigned*)(bp_ + o_), (LAS unsigned*)(vb + ((cidx) & 7) * 2048 + i_ * 1024 + lane * 16), 16, 0, 0); } } while (0)
        float lg[16];
#pragma unroll
        for (int c0 = 0; c0 < 6; ++c0) CH_GATHER(c0);
#pragma unroll
        for (int ch = 0; ch < 16; ++ch) {
            asm volatile("s_waitcnt lgkmcnt(0)" ::: "memory");
            CH_GATHER(ch + 6);
            asm volatile("s_waitcnt vmcnt(12)" ::: "memory");
            const LAS unsigned char* kb = vb + (ch & 7) * 2048;
            f32x4 acc = {0.f, 0.f, 0.f, 0.f};
#pragma unroll
            for (int i = 0; i < 2; ++i) { const i64x2 kf = *(const LAS i64x2*)(kb + 128u * fr + 16u * ((4u * i + fq) ^ ((unsigned)fr & 7u)));
                acc = __builtin_amdgcn_mfma_f32_16x16x32_fp8_fp8(qf[i].x, kf.x, acc, 0, 0, 0); acc = __builtin_amdgcn_mfma_f32_16x16x32_fp8_fp8(qf[i].y, kf.y, acc, 0, 0, 0); }
            lg[ch] = (ch * 16 + fr < nsel) ? acc.x * 0.08838834764831845f : -INFINITY;
        }
        float mx = lg[0];
#pragma unroll
        for (int kt = 1; kt < 16; ++kt) mx = fmaxf(mx, lg[kt]);
#pragma unroll
        for (int o = 1; o < 16; o <<= 1) mx = fmaxf(mx, __shfl_xor(mx, o));
        float sm = 0.f;
#pragma unroll
        for (int kt = 0; kt < 16; ++kt) { lg[kt] = __expf(lg[kt] - mx); sm += lg[kt]; }
#pragma unroll
        for (int o = 1; o < 16; o <<= 1) sm += __shfl_xor(sm, o);
        { const float inv = 256.f / sm;
#pragma unroll
          for (int kt = 0; kt < 16; ++kt) { const float pv = lg[kt] * inv; ((LAS unsigned char*)pT)[fq * 256 + kt * 16 + fr] = (unsigned char)(pk_fp8x4_nc(pv, pv, pv, pv) & 0xffu); } }
        f32x4 oacc[8];
#pragma unroll
        for (int c2 = 0; c2 < 8; ++c2) oacc[c2] = (f32x4){0.f, 0.f, 0.f, 0.f};
#pragma unroll
        for (int p = 0; p < 8; ++p) {
            asm volatile("s_waitcnt lgkmcnt(0)" ::: "memory");
            if (16 + 2 * p + 6 < 32) { CH_GATHER(16 + 2 * p + 6); CH_GATHER(16 + 2 * p + 7); }
            if (p < 5) asm volatile("s_waitcnt vmcnt(12)" ::: "memory"); else if (p == 5) asm volatile("s_waitcnt vmcnt(8)" ::: "memory");
            else if (p == 6) asm volatile("s_waitcnt vmcnt(4)" ::: "memory"); else asm volatile("s_waitcnt vmcnt(0)" ::: "memory");
            if (p < nch) {
                const long pa = *(const LAS long*)((const LAS unsigned char*)pT + (fr >> 2) * 256 + 32 * p + 8 * fq);
                const unsigned cb = vb_addr + (unsigned)(((16 + 2 * p) & 7) + (fq >> 1)) * 2048u;
                unsigned ad[8]; s16x4 r0[8];
#pragma unroll
                for (int i = 0; i < 8; ++i) ad[i] = cb + trh[i];
                tr_read8_b8(ad, r0);
#pragma unroll
                for (int c2 = 0; c2 < 8; ++c2) oacc[c2] = __builtin_amdgcn_mfma_f32_16x16x32_fp8_fp8(pa, __builtin_bit_cast(long, r0[c2]), oacc[c2], 0, 0, 0);
            }
        }
        { unsigned char* op = (unsigned char*)O + (size_t)tg * D + (4 * g + fq) * 128 + fr;
#pragma unroll
          for (int c2 = 0; c2 < 8; ++c2) { const float ov = oacc[c2].x * (O8_SCALE / 256.f); op[16 * c2] = (unsigned char)(pk_fp8x4(ov, ov, ov, ov) & 0xffu); } }
        LDS_WAIT();
#undef CH_GATHER
        ++tcount;
    }
}

__device__ __forceinline__ void phase_b4(const Ctx& c, bool dry = false) {
    bf16_t* H = (bf16_t*)(c.ws + WS_H);
    pg8::Gemm g{(const pg8::bf16_t*)(c.ws + WS_O), (const pg8::bf16_t*)(c.ws + WS_WBOUT), T, D, D / 2};
    pg8::StaticOrder S; S.init(T, D, (int)gridDim.x, (int)blockIdx.x);
    EpiResH<false> E{H, dry ? (bf16_t*)(c.ws + 440 * MB) : H, 1.f / (W8_SCALE * O8_SCALE)};
    pg8::gemm_phase<EpiResH<false>, pg8::StaticOrder, true, true, true>(c.ldsp, g, S, E);
}

constexpr int NPHASE = 22;
__global__ void __launch_bounds__(NTHP, 2) mk_fwd(Args args) {
    extern __shared__ __attribute__((aligned(16))) unsigned char lds_raw[];
    Ctx c;
    { const int pt = threadIdx.x; c.half = __builtin_amdgcn_readfirstlane(pt >> 8); c.tid = pt & 255; c.lane = pt & 63; c.wave = __builtin_amdgcn_readfirstlane(pt >> 6) & 3; }
    c.ldsp = (LAS unsigned char*)lds_raw; c.lds = c.ldsp + c.half * LDS_HALF;
    c.nb = 2 * gridDim.x; { const int bx = blockIdx.x, G = gridDim.x; c.vb = 2 * ((G % 8 == 0) ? (bx % 8) * (G / 8) + bx / 8 : bx) + c.half; }
    c.a = (const __attribute__((address_space(4))) Args*)__builtin_amdgcn_kernarg_segment_ptr(); c.ws = args.ws;
    volatile LAS unsigned* st = (volatile LAS unsigned*)((LAS unsigned char*)lds_raw + LDS_BYTES - 16);
    const bool multi = (args.ph_hi - args.ph_lo) > 1;
    XcdBarrier bar; bar.bar = (unsigned*)(c.ws + WS_CTL); bar.x = 0; bar.st = st;
    if (multi) {
        if (threadIdx.x == 0) { st[0] = 0u; st[1] = 0u; }
        __syncthreads();
        bar = xcd_barrier_post((unsigned*)(c.ws + WS_CTL), st);
    }
    const int ph_lo = args.ph_lo, ph_hi = args.ph_hi;
#ifndef PH_MASK
#define PH_MASK 0x3fffff
#endif
#define PHON(k) ((PH_MASK >> (k)) & 1)
#define PHASE(k, body) do { if (PHON(k) && ph_lo <= (k) && (k) < ph_hi) { \
        { int t_ = threadIdx.x, vb_ = __builtin_amdgcn_readfirstlane(c.vb); \
          const __attribute__((address_space(4))) Args* ka = (const __attribute__((address_space(4))) Args*)__builtin_amdgcn_kernarg_segment_ptr(); \
          asm volatile("" : "+v"(t_), "+s"(vb_), "+s"(ka)); \
          c.tid = t_ & 255; c.lane = t_ & 63; c.wave = __builtin_amdgcn_readfirstlane(t_ >> 6) & 3; c.vb = vb_; c.a = ka; c.ws = ka->ws; } \
        body; \
        if (MK_REP == (k)) { __syncthreads(); body; } \
        if ((k) + 1 < ph_hi) xcd_barrier(bar); \
        if ((k) == 3) { for (int xb_ = 0; xb_ < MK_XBAR; ++xb_) xcd_barrier(bar); } } } while (0)
    PHASE(0, phase_prep(c));
    PHASE(1, phase_a1(c));
    PHASE(2, { if (MK_DRY == 2) { phase_a2(c, true); __syncthreads(); } phase_a2(c); });
    PHASE(3, phase_a3(c));
    PHASE(4, { if (MK_DRY == 4) { phase_route(c, 0, true); __syncthreads(); } phase_route(c, 0); });
    PHASE(5, phase_e1(c, 0));
    PHASE(6, phase_e2(c, 0));
    PHASE(7, { if (MK_DRY == 7) { phase_p1(c, 0, true); __syncthreads(); } phase_p1(c, 0); });
    PHASE(8, { if (MK_DRY == 8) { phase_p2(c, 0, true); __syncthreads(); } phase_p2(c, 0); });
    PHASE(10, phase_b1(c));
    PHASE(11, phase_rope(c));
    PHASE(12, phase_score(c));
    PHASE(13, phase_select(c));
    PHASE(14, phase_attn(c));
    PHASE(15, { if (MK_DRY == 15) { phase_b4(c, true); __syncthreads(); } phase_b4(c); });
    PHASE(16, phase_route(c, 1));
    PHASE(17, phase_e1(c, 1));
    PHASE(18, phase_e2(c, 1));
    PHASE(19, phase_p1(c, 1));
    PHASE(20, phase_p2(c, 1));
    PHASE(21, phase_final(c));
}

#ifdef MK_DUMP
__global__ void dump_k(const unsigned char* ws, float* out) {
    const size_t i = (size_t)blockIdx.x * 256 + threadIdx.x;
#if MK_DUMP == 1
    ((f32x4*)out)[i] = ((const f32x4*)(ws + WS_H))[i];
#elif MK_DUMP == 2
    { const u32x2 v = ((const u32x2*)(ws + WS_O))[i]; f32x4 o = {bf_lo(v.x), bf_hi(v.x), bf_lo(v.y), bf_hi(v.y)}; ((f32x4*)out)[i] = o; }
#elif MK_DUMP == 3
    { const int* sp = (const int*)(ws + WS_SEL); f32x4 o = {0.f,0.f,0.f,0.f}; if (i < (size_t)T * 64) { o.x = (float)sp[4*i]; o.y = (float)sp[4*i+1]; o.z = (float)sp[4*i+2]; o.w = (float)sp[4*i+3]; } ((f32x4*)out)[i] = o; }
#elif MK_DUMP == 5
    { const u32x2 v = ((const u32x2*)(ws + WS_XN))[i]; f32x4 o = {bf_lo(v.x), bf_hi(v.x), bf_lo(v.y), bf_hi(v.y)}; ((f32x4*)out)[i] = o; }
#elif MK_DUMP == 6
    { const u32x2 v = ((const u32x2*)(ws + WS_RAW))[i]; f32x4 o = {bf_lo(v.x), bf_hi(v.x), bf_lo(v.y), bf_hi(v.y)}; ((f32x4*)out)[i] = o; }
#elif MK_DUMP == 7
    { f32x4 o = {0.f,0.f,0.f,0.f}; if (i < (size_t)BINP * D / 4) { const u32x2 v = ((const u32x2*)(ws + WS_WBIN))[i]; o = (f32x4){bf_lo(v.x), bf_hi(v.x), bf_lo(v.y), bf_hi(v.y)}; } ((f32x4*)out)[i] = o; }
#elif MK_DUMP == 8
    { const u32x2 v = ((const u32x2*)(ws + WS_RAW))[i], w = ((const u32x2*)(ws + 458 * MB))[i]; f32x4 o = {bf_lo(v.x) - bf_lo(w.x), bf_hi(v.x) - bf_hi(w.x), bf_lo(v.y) - bf_lo(w.y), bf_hi(v.y) - bf_hi(w.y)}; ((f32x4*)out)[i] = o; }
#elif MK_DUMP == 9
    { const u32x2 v = ((const u32x2*)(ws + WS_RAW))[i], w = ((const u32x2*)(ws + 458 * MB))[i]; f32x4 o = {(v.x & 0xffffu) != (w.x & 0xffffu) ? 1.f : 0.f, (v.x >> 16) != (w.x >> 16) ? 1.f : 0.f, (v.y & 0xffffu) != (w.y & 0xffffu) ? 1.f : 0.f, (v.y >> 16) != (w.y >> 16) ? 1.f : 0.f}; ((f32x4*)out)[i] = o; }
#elif MK_DUMP == 4
    { const u32x2 v = ((const u32x2*)(ws + WS_Q))[i]; f32x4 o = {bf_lo(v.x), bf_hi(v.x), bf_lo(v.y), bf_hi(v.y)}; ((f32x4*)out)[i] = o; }
#endif
}
#endif
extern "C" void kernel_launch(void* const* d_in, const int* in_sizes, int n_in, void* d_out, int out_size, void* d_ws, size_t ws_size, hipStream_t stream) {
    static int grid = 0;
    if (grid == 0) {
        if (n_in != 23 || out_size != T * D || ws_size < WS_TOTAL) { fprintf(stderr, "kernel_launch: unexpected sizes n_in %d out %d ws %zu (need %zu)\n", n_in, out_size, ws_size, (size_t)WS_TOTAL); grid = -1; return; }
        int dev = 0, cus = 0, per_cu = 0;
        hipGetDevice(&dev); hipDeviceGetAttribute(&cus, hipDeviceAttributeMultiprocessorCount, dev);
        hipFuncSetAttribute((const void*)mk_fwd, hipFuncAttributeMaxDynamicSharedMemorySize, LDS_BYTES);
        hipOccupancyMaxActiveBlocksPerMultiprocessor(&per_cu, (const void*)mk_fwd, NTHP, LDS_BYTES);
        (void)hipGetLastError();
        if (per_cu < 1) per_cu = 1;
        if (per_cu > 1) per_cu = 1;
        grid = cus * per_cu;
    }
    if (grid < 0) return;
    hipMemsetAsync((char*)d_ws + WS_CTL, 0, 16384, stream);
    Args a{};
    for (int i = 0; i < 23; ++i) a.in[i] = d_in[i];
    a.out = (float*)d_out; a.ws = (unsigned char*)d_ws;
#if MK_ONE_LAUNCH
    a.ph_lo = 0; a.ph_hi = NPHASE;
    hipLaunchKernelGGL(mk_fwd, dim3(grid), dim3(NTHP), LDS_BYTES, stream, a);
#else
    for (int ph = 0; ph <= MK_LAST_PHASE; ++ph) { a.ph_lo = ph; a.ph_hi = ph + 1; hipLaunchKernelGGL(mk_fwd, dim3(grid), dim3(NTHP), LDS_BYTES, stream, a); }
#ifdef MK_DUMP
    hipLaunchKernelGGL(dump_k, dim3(T * D / 4 / 256), dim3(256), 0, stream, (const unsigned char*)d_ws, (float*)d_out);
#endif
#endif
}
```

```cpp
#include <hip/hip_runtime.h>
#include <stdint.h>
#include <stdio.h>

#ifndef MK_LAST_PHASE
#define MK_LAST_PHASE 21
#endif
#ifndef MK_REP
#define MK_REP -1
#endif
#ifndef MK_XBAR
#define MK_XBAR 0
#endif
#ifndef MK_DRY
#define MK_DRY -1
#endif
#ifndef MK_ONE_LAUNCH
#define MK_ONE_LAUNCH 1
#endif

#define LAS __attribute__((address_space(3)))
typedef unsigned short bf16_t;
typedef short bf16x8 __attribute__((ext_vector_type(8)));
typedef float f32x4 __attribute__((ext_vector_type(4)));
typedef float f32x2 __attribute__((ext_vector_type(2)));
typedef float f32x16 __attribute__((ext_vector_type(16)));
typedef unsigned u32x4 __attribute__((ext_vector_type(4)));
typedef unsigned u32x2 __attribute__((ext_vector_type(2)));
typedef long i64x2 __attribute__((ext_vector_type(2)));
typedef int i32x4 __attribute__((ext_vector_type(4)));
typedef int i32x8 __attribute__((ext_vector_type(8)));

constexpr int T = 16384, D = 1024, SEQ = 4096;
constexpr int GW = 2048;
constexpr int BIN = 2120, BINP = 2176;
constexpr int NE = 32, DE = 512;
constexpr int PLE = 256;
constexpr float EPS = 1e-6f;
constexpr int NTH = 256;
constexpr int LDS_MAIN = 4 * 19456;
constexpr int LDS_HALF = LDS_MAIN + 1024;
constexpr int LDS_BYTES = 2 * LDS_HALF;
constexpr int NTHP = 512;
constexpr int RPAD = 32768 + NE * 256;

constexpr size_t MB = 1024 * 1024;
constexpr size_t WS_CTL = 0;
constexpr size_t WS_CNT = 448 * 1024;
constexpr int NSUB = 32, SUBCAP = T / NSUB, CNT_STRIDE = 32;
static_assert(WS_CNT >= 32768 + 2 * 1024 * 48 * 4 && WS_CNT + (size_t)4 * NSUB * 32 * CNT_STRIDE * 4 <= 1024 * 1024, "cnt");
constexpr size_t WS_WR = 32768;
constexpr size_t WS_WAIN = 1 * MB;
constexpr size_t WS_WAOUT = WS_WAIN + 8 * MB;
constexpr size_t WS_WBIN = WS_WAOUT + 4 * MB;
constexpr size_t WS_WBOUT = WS_WBIN + 5 * MB;
constexpr size_t WS_WGATE = WS_WBOUT + 2 * MB;
constexpr size_t WS_WPROJ = WS_WGATE + 4 * MB;
constexpr size_t WS_W1 = WS_WPROJ + 1 * MB;
constexpr size_t WS_H8 = WS_W1;
constexpr size_t WS_XN8 = WS_W1 + 16 * MB;
constexpr size_t WS_W3 = WS_W1 + 32 * MB;
constexpr size_t WS_W2 = WS_W3 + 32 * MB;
constexpr size_t WS_PBF = WS_W2 + 32 * MB;
constexpr size_t WS_XN = WS_PBF + 16 * MB;
constexpr size_t WS_H = WS_XN + 32 * MB;
constexpr size_t WS_LIST = WS_H + 64 * MB;
constexpr size_t WS_GATE = WS_LIST + 2 * MB;
constexpr size_t WS_TOKSLOT = WS_GATE + 2 * MB;
constexpr size_t WS_GROW = WS_TOKSLOT + 512 * 1024;
constexpr size_t WS_SCR = WS_TOKSLOT + 1 * MB;
constexpr size_t WS_U = WS_SCR;
constexpr size_t WS_VT = WS_SCR + 64 * MB;
constexpr size_t WS_VSS = WS_SCR + 128 * MB;
constexpr size_t WS_HMID = WS_SCR;
constexpr size_t WS_Y = WS_SCR + 36 * MB;
constexpr size_t WS_RAW = WS_SCR;
constexpr size_t WS_O = WS_SCR;
constexpr size_t WS_Q = WS_SCR + 68 * MB;
constexpr size_t WS_K = WS_Q + 32 * MB;
constexpr size_t WS_V = WS_K + 8 * MB;
constexpr size_t WS_QI = WS_V + 8 * MB;
constexpr size_t WS_KI = WS_QI + 16 * MB;
constexpr size_t WS_WI = WS_KI + 2 * MB;
constexpr size_t WS_SEL = WS_WI + 1 * MB;
constexpr size_t WS_END = WS_SEL + 16 * MB;
constexpr size_t WS_RSS = WS_END;
static_assert(WS_RSS + 1 * MB <= WS_SCR + 152 * MB, "scratch");
constexpr size_t WS_S = 392 * MB;
constexpr size_t WS_TOTAL = 522 * MB;

typedef __bf16 bf16x2_t __attribute__((ext_vector_type(2)));
__device__ __forceinline__ unsigned pk_bf16(float lo, float hi) { f32x2 v = {lo, hi}; bf16x2_t b = __builtin_convertvector(v, bf16x2_t); return __builtin_bit_cast(unsigned, b); }
__device__ __forceinline__ float bf_lo(unsigned u) { return __uint_as_float(u << 16); }
__device__ __forceinline__ float bf_hi(unsigned u) { return __uint_as_float(u & 0xffff0000u); }
__device__ __forceinline__ float wave_sum(float v) {
#pragma unroll
    for (int o = 1; o < 64; o <<= 1) v += __shfl_xor(v, o);
    return v;
}
__device__ __forceinline__ int lds_inc(LAS int* p) { return __hip_atomic_fetch_add(p, 1, __ATOMIC_RELAXED, __HIP_MEMORY_SCOPE_WORKGROUP); }
#define LDS_WAIT() asm volatile("s_waitcnt lgkmcnt(0)" ::: "memory")
#define VM_WAIT() asm volatile("s_waitcnt vmcnt(0)" ::: "memory")

#define XB_TMO      128
#define XB_XCNT(j)  (256  + 64 * (j))
#define XB_XSUB(j)  (1280 + 64 * (j))
#define XB_XGEN(j)  (2304 + 64 * (j))
#define XB_TOP      3328
#define XB_TOPGEN   3392
#define XCD_BAR_WORDS 3456
#define XB_SPIN_CAP (1u << 20)
__device__ __forceinline__ unsigned xb_ld(unsigned* p)              { return __hip_atomic_load(p, __ATOMIC_RELAXED, __HIP_MEMORY_SCOPE_AGENT); }
__device__ __forceinline__ unsigned xb_add(unsigned* p, unsigned v) { return __hip_atomic_fetch_add(p, v, __ATOMIC_RELAXED, __HIP_MEMORY_SCOPE_AGENT); }
__device__ __forceinline__ unsigned xb_xcc_id() { return (unsigned)__builtin_amdgcn_s_getreg((3 << 11) | 20) & 0xFu; }
#define XB_SPIN(cond, bar) do { unsigned _sp = 0; while (cond) { __builtin_amdgcn_s_sleep(1); \
    if ((++_sp & 255u) == 0u) { if (xb_ld(&(bar)[XB_TMO])) break; if (_sp > XB_SPIN_CAP) { atomicAdd(&(bar)[XB_TMO], 1u); break; } } } } while (0)
struct XcdBarrier { unsigned* bar; unsigned x; volatile LAS unsigned* st; };
__device__ __forceinline__ XcdBarrier xcd_barrier_post(unsigned* bar, volatile LAS unsigned* st) {
    XcdBarrier b; b.bar = bar; b.x = xb_xcc_id(); b.st = st;
    if (threadIdx.x == 0) (void)xb_add(&bar[XB_XCNT(b.x)], 1u);
    return b;
}
__device__ __forceinline__ void xcd_barrier_complete(unsigned* bar, unsigned x, unsigned& nloc, unsigned& nx) {
    const unsigned G = gridDim.x;
    unsigned sum, cnt, mine, sp = 0u;
    for (;;) {
        sum = 0u; cnt = 0u; mine = 0u;
#pragma unroll
        for (unsigned j = 0; j < 16; ++j) { const unsigned c = xb_ld(&bar[XB_XCNT(j)]); sum += c; cnt += (c > 0u) ? 1u : 0u; mine = (j == x) ? c : mine; }
        if (sum == G) break;
        __builtin_amdgcn_s_sleep(1);
        if ((++sp & 255u) == 0u) { if (xb_ld(&bar[XB_TMO])) break; if (sp > XB_SPIN_CAP) { atomicAdd(&bar[XB_TMO], 1u); break; } }
    }
    nloc = mine > 0u ? mine : 1u; nx = cnt > 0u ? cnt : 1u;
}
__device__ __forceinline__ void xcd_barrier(const XcdBarrier& b) {
    asm volatile("s_waitcnt vmcnt(0)" ::: "memory");
    __syncthreads();
    if (threadIdx.x == 0) {
        unsigned* bar = b.bar;
        __builtin_amdgcn_s_waitcnt(0);
        unsigned nloc = b.st[0], nx = b.st[1];
        if (nloc == 0u) { xcd_barrier_complete(bar, b.x, nloc, nx); b.st[0] = nloc; b.st[1] = nx; }
        const unsigned old = xb_add(&bar[XB_XSUB(b.x)], 1u);
        const unsigned gen = old / nloc;
        if (old + 1u == (gen + 1u) * nloc) {
            __builtin_amdgcn_fence(__ATOMIC_RELEASE, "agent");
            asm volatile("s_waitcnt vmcnt(0)" ::: "memory");
            const unsigned og = xb_add(&bar[XB_TOP], 1u);
            const unsigned tg = og / nx;
            if (og + 1u == (tg + 1u) * nx) xb_add(&bar[XB_TOPGEN], 1u);
            else XB_SPIN(xb_ld(&bar[XB_TOPGEN]) == tg, bar);
            __builtin_amdgcn_fence(__ATOMIC_ACQUIRE, "agent");
            xb_add(&bar[XB_XGEN(b.x)], 1u);
            asm volatile("s_waitcnt vmcnt(0)" ::: "memory");
        } else {
            XB_SPIN(xb_ld(&bar[XB_XGEN(b.x)]) == gen, bar);
            __builtin_amdgcn_fence(__ATOMIC_ACQUIRE, "agent");
            asm volatile("s_waitcnt vmcnt(0)" ::: "memory");
        }
    }
    __syncthreads();
}

struct Args { const void* in[23]; float* out; unsigned char* ws; int ph_lo, ph_hi; };
enum { IN_X = 0, IN_P, IN_POS, IN_MIXN, IN_AWIN, IN_AVG, IN_AWS, IN_ABS, IN_AWOUT, IN_BWIN, IN_BWOUT, IN_FFNN, IN_WG, IN_BG, IN_WE, IN_BE,
       IN_W1, IN_W3, IN_W2, IN_PLEN, IN_PLEG, IN_PLEP, IN_FINN };

struct Ctx {
    LAS unsigned char* lds;
    int tid, lane, wave, vb, nb, half;
    LAS unsigned char* ldsp;
    const __attribute__((address_space(4))) Args* a;
    unsigned char* ws;
};

template <int BK> struct TileK { static constexpr int NP = (BK == 64) ? 4 : 2; static constexpr int TB = 128 * BK * 2; };

template <int BK>
__device__ __forceinline__ void stage_tile(LAS unsigned char* tile, const bf16_t* const (&rp)[TileK<BK>::NP], int k0, int tid) {
    const int lc = (BK == 64) ? ((tid & 7) ^ ((tid >> 3) & 7)) : ((tid & 3) ^ ((tid >> 3) & 3));
#pragma unroll
    for (int p = 0; p < TileK<BK>::NP; ++p)
        __builtin_amdgcn_global_load_lds((const unsigned*)(rp[p] + k0 + lc * 8), (LAS unsigned*)(tile + p * 4096 + tid * 16), 16, 0, 0);
}
template <int BK>
__device__ __forceinline__ void rows_regular(const bf16_t* (&rp)[TileK<BK>::NP], const bf16_t* base, size_t ld, int tid) {
#pragma unroll
    for (int p = 0; p < TileK<BK>::NP; ++p) { const int r = (BK == 64) ? (p * 32 + (tid >> 3)) : (p * 64 + (tid >> 2)); rp[p] = base + (size_t)r * ld; }
}
template <int BK>
__device__ __forceinline__ int frag_off(int row, int ks, int fq) {
    return (BK == 64) ? (row * 128 + (((ks * 4 + fq) ^ (row & 7)) << 4)) : (row * 64 + ((fq ^ ((row >> 1) & 3)) << 4));
}

template <int BK, int NBOP, bool SWAP, bool FP8 = false>
__device__ __forceinline__ void gemm_loop(const Ctx& c, const bf16_t* const (&ap)[TileK<BK>::NP], const bf16_t* const (&b0p)[TileK<BK>::NP], const bf16_t* const (&b1p)[TileK<BK>::NP],
                                          int K, f32x4 (&acc0)[4][4], f32x4 (&acc1)[4][4]) {
    constexpr int TB = TileK<BK>::TB, SB = (1 + NBOP) * TB;
    static_assert(2 * SB <= LDS_MAIN, "lds");
    const int nk = K / BK, tid = c.tid;
    const int fr = c.lane & 15, fq = c.lane >> 4, wr = c.wave >> 1, wc = c.wave & 1;
    LAS unsigned char* lds = c.lds;
    stage_tile<BK>(lds, ap, 0, tid); stage_tile<BK>(lds + TB, b0p, 0, tid);
    if (NBOP == 2) stage_tile<BK>(lds + 2 * TB, b1p, 0, tid);
    for (int kt = 0; kt < nk; ++kt) {
        VM_WAIT();
        __syncthreads();
        LAS unsigned char* cur = lds + (kt & 1) * SB;
        if (kt + 1 < nk) {
            LAS unsigned char* nxt = lds + ((kt + 1) & 1) * SB;
            stage_tile<BK>(nxt, ap, (kt + 1) * BK, tid); stage_tile<BK>(nxt + TB, b0p, (kt + 1) * BK, tid);
            if (NBOP == 2) stage_tile<BK>(nxt + 2 * TB, b1p, (kt + 1) * BK, tid);
        }
#pragma unroll
        for (int ks = 0; ks < BK / 32; ++ks) {
            bf16x8 af[4], bf0[4], bf1[4];
#pragma unroll
            for (int m = 0; m < 4; ++m) af[m] = *(const LAS bf16x8*)(cur + frag_off<BK>(wr * 64 + m * 16 + fr, ks, fq));
#pragma unroll
            for (int n = 0; n < 4; ++n) bf0[n] = *(const LAS bf16x8*)(cur + TB + frag_off<BK>(wc * 64 + n * 16 + fr, ks, fq));
            if (NBOP == 2) {
#pragma unroll
                for (int n = 0; n < 4; ++n) bf1[n] = *(const LAS bf16x8*)(cur + 2 * TB + frag_off<BK>(wc * 64 + n * 16 + fr, ks, fq));
            }
#pragma unroll
            for (int m = 0; m < 4; ++m)
#pragma unroll
                for (int n = 0; n < 4; ++n) {
                    if (FP8) {
                        const i64x2 a2 = __builtin_bit_cast(i64x2, af[m]), b2 = __builtin_bit_cast(i64x2, bf0[n]);
                        if (SWAP) { acc0[m][n] = __builtin_amdgcn_mfma_f32_16x16x32_fp8_fp8(b2.x, a2.x, acc0[m][n], 0, 0, 0); acc0[m][n] = __builtin_amdgcn_mfma_f32_16x16x32_fp8_fp8(b2.y, a2.y, acc0[m][n], 0, 0, 0); }
                        else      { acc0[m][n] = __builtin_amdgcn_mfma_f32_16x16x32_fp8_fp8(a2.x, b2.x, acc0[m][n], 0, 0, 0); acc0[m][n] = __builtin_amdgcn_mfma_f32_16x16x32_fp8_fp8(a2.y, b2.y, acc0[m][n], 0, 0, 0); }
                        continue;
                    }
                    if (SWAP) acc0[m][n] = __builtin_amdgcn_mfma_f32_16x16x32_bf16(bf0[n], af[m], acc0[m][n], 0, 0, 0);
                    else      acc0[m][n] = __builtin_amdgcn_mfma_f32_16x16x32_bf16(af[m], bf0[n], acc0[m][n], 0, 0, 0);
                    if (NBOP == 2) {
                        if (SWAP) acc1[m][n] = __builtin_amdgcn_mfma_f32_16x16x32_bf16(bf1[n], af[m], acc1[m][n], 0, 0, 0);
                        else      acc1[m][n] = __builtin_amdgcn_mfma_f32_16x16x32_bf16(af[m], bf1[n], acc1[m][n], 0, 0, 0);
                    }
                }
        }
    }
    __syncthreads();
}
__device__ __forceinline__ void zero_acc(f32x4 (&acc)[4][4]) {
#pragma unroll
    for (int m = 0; m < 4; ++m)
#pragma unroll
        for (int n = 0; n < 4; ++n) acc[m][n] = (f32x4){0.f, 0.f, 0.f, 0.f};
}
__device__ __forceinline__ void map_unit(int u, int nnt, int& mt, int& nt) { const int per = 8 * nnt, band = u / per, r = u - band * per; nt = r >> 3; mt = band * 8 + (r & 7); }


__device__ __forceinline__ float gelu_tanh(float x) {
    const float y2 = 1.5957691216057308f * (x + 0.044715f * x * x * x);
    return x * __builtin_amdgcn_rcpf(1.f + __expf(-y2));
}
__device__ __forceinline__ float sigmoidf_(float x) { return __builtin_amdgcn_rcpf(1.f + __expf(-x)); }
__device__ __forceinline__ f32x4 sigmoid4(f32x4 x) {
    const f32x4 t = x * (-1.4426950408889634f);
    f32x4 e; e.x = __builtin_amdgcn_exp2f(t.x); e.y = __builtin_amdgcn_exp2f(t.y); e.z = __builtin_amdgcn_exp2f(t.z); e.w = __builtin_amdgcn_exp2f(t.w);
    const f32x4 d = e + 1.f;
    f32x4 r; r.x = __builtin_amdgcn_rcpf(d.x); r.y = __builtin_amdgcn_rcpf(d.y); r.z = __builtin_amdgcn_rcpf(d.z); r.w = __builtin_amdgcn_rcpf(d.w);
    return r;
}
__device__ __forceinline__ f32x4 gelu_tanh4(f32x4 x) {
    const f32x4 t = ((x * x) * (-1.5957691216057308f * 0.044715f * 1.4426950408889634f) + (-1.5957691216057308f * 1.4426950408889634f)) * x;
    f32x4 e; e.x = __builtin_amdgcn_exp2f(t.x); e.y = __builtin_amdgcn_exp2f(t.y); e.z = __builtin_amdgcn_exp2f(t.z); e.w = __builtin_amdgcn_exp2f(t.w);
    const f32x4 d = e + 1.f;
    f32x4 r; r.x = __builtin_amdgcn_rcpf(d.x); r.y = __builtin_amdgcn_rcpf(d.y); r.z = __builtin_amdgcn_rcpf(d.z); r.w = __builtin_amdgcn_rcpf(d.w);
    return x * r;
}

__device__ __forceinline__ void row_load(const float* row, int lane, f32x4 (&v)[4]) {
#pragma unroll
    for (int j = 0; j < 4; ++j) v[j] = ((const f32x4*)row)[lane + 64 * j];
}
__device__ __forceinline__ void row_load_h(const bf16_t* row, int lane, f32x4 (&v)[4]) {
#pragma unroll
    for (int j = 0; j < 4; ++j) { const u32x2 w = ((const u32x2*)row)[lane + 64 * j]; v[j] = (f32x4){bf_lo(w.x), bf_hi(w.x), bf_lo(w.y), bf_hi(w.y)}; }
}
__device__ __forceinline__ float row_sumsq(const f32x4 (&v)[4]) {
    float s = 0.f;
#pragma unroll
    for (int j = 0; j < 4; ++j) s += (v[j].x * v[j].x + v[j].y * v[j].y) + (v[j].z * v[j].z + v[j].w * v[j].w);
    return wave_sum(s);
}
__device__ __forceinline__ void gain_load(const float* gain, int lane, f32x4 (&g)[4]) {
#pragma unroll
    for (int j = 0; j < 4; ++j) g[j] = ((const f32x4*)gain)[lane + 64 * j];
}
__device__ __forceinline__ void row_store_norm_bf16(bf16_t* orow, int lane, const f32x4 (&v)[4], float r, const f32x4 (&gv)[4]) {
#pragma unroll
    for (int j = 0; j < 4; ++j) {
        const f32x4 g = gv[j];
        u32x2 o; o.x = pk_bf16(v[j].x * r * g.x, v[j].y * r * g.y); o.y = pk_bf16(v[j].z * r * g.z, v[j].w * r * g.w);
        ((u32x2*)orow)[lane + 64 * j] = o;
    }
}

__device__ __forceinline__ void row_store_h(bf16_t* orow, int lane, const f32x4 (&v)[4]) {
#pragma unroll
    for (int j = 0; j < 4; ++j) { u32x2 o; o.x = pk_bf16(v[j].x, v[j].y); o.y = pk_bf16(v[j].z, v[j].w); ((u32x2*)orow)[lane + 64 * j] = o; }
}
__device__ __forceinline__ unsigned pk_fp8x4(float a, float b, float c_, float d);
__device__ __forceinline__ void row_store_norm_fp8(unsigned char* orow, int lane, const f32x4 (&v)[4], float r, const f32x4 (&gv)[4]) {
#pragma unroll
    for (int j = 0; j < 4; ++j) ((unsigned*)orow)[lane + 64 * j] = pk_fp8x4(v[j].x * r * gv[j].x, v[j].y * r * gv[j].y, v[j].z * r * gv[j].z, v[j].w * r * gv[j].w);
}
constexpr int TR_SCR = 64 * 136;
__device__ __forceinline__ void transpose_item(const float* W, int K, int N, int nvalid, int ldw, bf16_t* WT, LAS unsigned char* scr, int item, int lane, const float* kg = nullptr) {
    const int nblk = N / 64, kb = item / nblk, nb = item - kb * nblk, k0 = 64 * kb, n0 = 64 * nb;
    const int n = n0 + 4 * (lane & 15);
    const int nc_ = (n < nvalid) ? n : 0; const float keep = (n < nvalid) ? 1.f : 0.f;
    f32x4 v[16];
#pragma unroll
    for (int i = 0; i < 16; ++i) v[i] = *(const f32x4*)(W + (size_t)(k0 + 4 * i + (lane >> 4)) * ldw + nc_);
#pragma unroll
    for (int i = 0; i < 16; ++i) {
        const int kk = 4 * i + (lane >> 4); const float kp = kg ? keep * kg[k0 + kk] : keep;
        u32x2 o; o.x = pk_bf16(v[i].x * kp, v[i].y * kp); o.y = pk_bf16(v[i].z * kp, v[i].w * kp);
        *(LAS u32x2*)(scr + kk * 136 + (lane & 15) * 8) = o;
    }
    LDS_WAIT();
    const int cc = lane & 7;
#pragma unroll
    for (int j = 0; j < 8; ++j) {
        const int nn = (lane >> 3) + 8 * j; const LAS unsigned short* sp = (const LAS unsigned short*)(scr + (8 * cc) * 136 + nn * 2);
        u32x4 o;
        o.x = (unsigned)sp[0 * 68] | ((unsigned)sp[1 * 68] << 16); o.y = (unsigned)sp[2 * 68] | ((unsigned)sp[3 * 68] << 16);
        o.z = (unsigned)sp[4 * 68] | ((unsigned)sp[5 * 68] << 16); o.w = (unsigned)sp[6 * 68] | ((unsigned)sp[7 * 68] << 16);
        *(u32x4*)(WT + (size_t)(n0 + nn) * K + k0 + 8 * cc) = o;
    }
    LDS_WAIT();
}

__device__ __forceinline__ unsigned pk_fp8x4(float a, float b, float c_, float d) {
    a = fminf(fmaxf(a, -448.f), 448.f); b = fminf(fmaxf(b, -448.f), 448.f); c_ = fminf(fmaxf(c_, -448.f), 448.f); d = fminf(fmaxf(d, -448.f), 448.f);
    int p = __builtin_amdgcn_cvt_pk_fp8_f32(a, b, 0, false);
    p = __builtin_amdgcn_cvt_pk_fp8_f32(c_, d, p, true);
    return (unsigned)p;
}
__device__ __forceinline__ unsigned pk_fp8x4_nc(float a, float b, float c_, float d) {
    int p = __builtin_amdgcn_cvt_pk_fp8_f32(a, b, 0, false);
    p = __builtin_amdgcn_cvt_pk_fp8_f32(c_, d, p, true);
    return (unsigned)p;
}
constexpr float W8_SCALE = 64.f, H8_SCALE = 4.f, O8_SCALE = 8.f;
__device__ __forceinline__ void transpose_item8(const float* W, int K, int N, unsigned char* WT, LAS unsigned char* scr, int item, int lane, int nvalid = 1 << 30, int ldw = 0, const float* kg = nullptr) {
    const int nblk = N / 64, kb = item / nblk, nb = item - kb * nblk, k0 = 128 * kb, n0 = 64 * nb;
    const int n = n0 + 4 * (lane & 15), ld = ldw ? ldw : N, nc_ = (n < nvalid) ? n : 0; const float keep = (n < nvalid) ? W8_SCALE : 0.f;
#pragma unroll 2
    for (int h = 0; h < 2; ++h) {
        f32x4 v[16];
#pragma unroll
        for (int i = 0; i < 16; ++i) v[i] = *(const f32x4*)(W + (size_t)(k0 + 64 * h + 4 * i + (lane >> 4)) * ld + nc_);
#pragma unroll
        for (int i = 0; i < 16; ++i) { const int kk = 64 * h + 4 * i + (lane >> 4); const float kp = kg ? keep * kg[k0 + kk] : keep;
            *(LAS unsigned*)(scr + kk * 68 + (lane & 15) * 4) = (kg ? pk_fp8x4(v[i].x * kp, v[i].y * kp, v[i].z * kp, v[i].w * kp) : pk_fp8x4_nc(v[i].x * kp, v[i].y * kp, v[i].z * kp, v[i].w * kp)); }
    }
    LDS_WAIT();
    const int cc = lane & 7;
#pragma unroll
    for (int j = 0; j < 8; ++j) {
        const int nn = (lane >> 3) + 8 * j; const LAS unsigned char* sp = scr + (16 * cc) * 68 + nn;
        unsigned w[4];
#pragma unroll
        for (int q = 0; q < 4; ++q) w[q] = (unsigned)sp[(4 * q + 0) * 68] | ((unsigned)sp[(4 * q + 1) * 68] << 8) | ((unsigned)sp[(4 * q + 2) * 68] << 16) | ((unsigned)sp[(4 * q + 3) * 68] << 24);
        u32x4 o = {w[0], w[1], w[2], w[3]};
        *(u32x4*)(WT + (size_t)(n0 + nn) * K + k0 + 16 * cc) = o;
    }
    LDS_WAIT();
}
__device__ __forceinline__ void convert_moe_item(const Ctx& c, int l, int it, LAS unsigned char* scr) {
    const float* w1 = (const float*)c.a->in[IN_W1] + (size_t)l * NE * D * DE;
    const float* w3 = (const float*)c.a->in[IN_W3] + (size_t)l * NE * D * DE;
    const float* w2 = (const float*)c.a->in[IN_W2] + (size_t)l * NE * DE * D;
    unsigned char* W3 = c.ws + WS_W3; unsigned char* W2 = c.ws + WS_W2;
    const int e = it / 192, r = it - e * 192;
    if (r < 64)       transpose_item8(w1 + (size_t)e * D * DE, D, DE, W3 + ((size_t)e * 1024 + ((r & 7) >> 1) * 128) * D, scr, r, c.lane);
    else if (r < 128) transpose_item8(w3 + (size_t)e * D * DE, D, DE, W3 + ((size_t)e * 1024 + ((r & 7) >> 1) * 128 + 128) * D, scr, r - 64, c.lane);
    else              transpose_item8(w2 + (size_t)e * DE * D, DE, D, W2 + (size_t)e * D * DE, scr, r - 128, c.lane);
}
__device__ __forceinline__ void convert_moe_layer(const Ctx& c, int l) {
    LAS unsigned char* scr = c.lds + c.wave * TR_SCR;
    const int gw = c.vb * 4 + c.wave, ngw = c.nb * 4;
    for (int it = gw; it < NE * 192; it += ngw) convert_moe_item(c, l, it, scr);
}

__device__ __forceinline__ void phase_prep(const Ctx& c) {
    const __attribute__((address_space(4))) Args& a = *c.a;
    LAS unsigned char* scr = c.lds + c.wave * TR_SCR;
    const int gw = c.vb * 4 + c.wave, ngw = c.nb * 4;
    constexpr int I_AIN = 16 * 64, I_AOUT = 32 * 16, I_PP = 4 * 16, I_BIN8 = 8 * 34, I_BOUT8 = 8 * 16, I_PG8 = 8 * 16, I_BINI = 16 * 10;
    constexpr int NIT = I_AIN + I_AOUT + 2 * I_PP + I_BIN8 + I_BOUT8 + 2 * I_PG8 + I_BINI;
    for (int it = gw; it < NIT; it += ngw) {
        int r = it;
        if (r < I_AIN) { transpose_item((const float*)a.in[IN_AWIN], D, 4096, 4096, 4096, (bf16_t*)(c.ws + WS_WAIN), scr, r, c.lane); continue; } r -= I_AIN;
        if (r < I_AOUT) { transpose_item((const float*)a.in[IN_AWOUT], GW, D, D, D, (bf16_t*)(c.ws + WS_WAOUT), scr, r, c.lane); continue; } r -= I_AOUT;
        if (r < 2 * I_PP) { const int l = r / I_PP; transpose_item((const float*)a.in[IN_PLEP] + (size_t)l * PLE * D, PLE, D, D, D, (bf16_t*)(c.ws + WS_WPROJ) + (size_t)l * D * PLE, scr, r - l * I_PP, c.lane); continue; } r -= 2 * I_PP;
        if (r < I_BIN8) { transpose_item8((const float*)a.in[IN_BWIN], D, BINP, c.ws + WS_WBIN, scr, r, c.lane, BIN, BIN, (const float*)a.in[IN_MIXN] + D); continue; } r -= I_BIN8;
        if (r < I_BOUT8) { transpose_item8((const float*)a.in[IN_BWOUT], D, D, c.ws + WS_WBOUT, scr, r, c.lane); continue; } r -= I_BOUT8;
        if (r < 2 * I_PG8) { const int l = r / I_PG8; transpose_item8((const float*)a.in[IN_PLEG] + (size_t)l * D * D, D, D, c.ws + WS_WGATE + (size_t)l * D * D, scr, r - l * I_PG8, c.lane); continue; } r -= 2 * I_PG8;
        transpose_item((const float*)a.in[IN_BWIN] + 1536, D, 640, BIN - 1536, BIN, (bf16_t*)(c.ws + WS_WBIN + 3 * MB), scr, r, c.lane, (const float*)a.in[IN_MIXN] + D);
    }
    const int gt = c.vb * NTH + c.tid, ngt = c.nb * NTH;
    { const float* p = (const float*)a.in[IN_P]; bf16_t* pb = (bf16_t*)(c.ws + WS_PBF);
      for (int i = gt; i < 2 * T * PLE / 8; i += ngt) {
          const f32x4 v0 = ((const f32x4*)p)[2 * i], v1 = ((const f32x4*)p)[2 * i + 1];
          u32x4 o; o.x = pk_bf16(v0.x, v0.y); o.y = pk_bf16(v0.z, v0.w); o.z = pk_bf16(v1.x, v1.y); o.w = pk_bf16(v1.z, v1.w);
          ((u32x4*)pb)[i] = o; } }
    { float* wr = (float*)(c.ws + WS_WR);
      for (int i = gt; i < 2 * D * 48; i += ngt) {
          const int l = i / (D * 48), r = i - l * D * 48, k = r / 48, o = r - k * 48;
          float w = 0.f;
          if (o < 4) w = ((const float*)a.in[IN_WG])[(size_t)l * D * 4 + k * 4 + o];
          else if (o < 36) w = ((const float*)a.in[IN_WE])[(size_t)l * D * 32 + k * 32 + (o - 4)];
          const int kh = k >> 9, q = (k >> 7) & 3, ii = (k >> 2) & 31, e = k & 3, nt = o >> 4, m = o & 15;
          wr[(size_t)l * D * 48 + ((((kh * 32 + ii) * 3 + nt) * 64 + q * 16 + m) << 2) + e] = w * ((const float*)a.in[IN_FFNN])[l * D + k]; } }
    if (c.vb == 0) for (int i = c.tid; i < 4 * NSUB * 32; i += 256) ((int*)(c.ws + WS_CNT))[i * CNT_STRIDE] = 0;
    f32x4 gv[4]; gain_load((const float*)a.in[IN_MIXN], c.lane, gv);
    for (int t = gw; t < T; t += ngw) {
        f32x4 v[4]; row_load((const float*)a.in[IN_X] + (size_t)t * D, c.lane, v);
        const float r = rsqrtf(row_sumsq(v) * (1.f / D) + EPS);
        row_store_norm_bf16((bf16_t*)(c.ws + WS_XN) + (size_t)t * D, c.lane, v, r, gv);
    }
}

namespace pg8 {
#define PG8_LAS __attribute__((address_space(3)))
typedef unsigned short bf16_t;
typedef short bf16x8 __attribute__((ext_vector_type(8)));
typedef float f32x4 __attribute__((ext_vector_type(4)));
typedef unsigned u32x4 __attribute__((ext_vector_type(4)));
constexpr int BM = 256, BK = 64, HALF = 128, HTB = HALF * BK * 2  , STAGE_BYTES = 8 * HTB, NXCD = 8, WGM = 8;

__host__ __device__ __forceinline__ int lds_byte(int r, int c) { const int st = (r >> 4) * 2 + (c >> 5), rr = r & 15, cc = c & 31, ob = rr * 64 + cc * 2; return st * 1024 + (ob ^ (((ob >> 9) & 1) << 5)); }
__host__ __device__ __forceinline__ void stage_rc(int b, int& R, int& C) { const int st = b / 1024, sb = b % 1024, swz = sb ^ (((sb >> 9) & 1) << 5); R = (st >> 1) * 16 + swz / 64; C = (st & 1) * 32 + (swz % 64) / 2; }
__host__ __device__ __forceinline__ int perm32(int rho) { const int n = rho >> 4, i = rho & 15; return 8 * (i >> 2) + 4 * n + (i & 3); }

struct Unit { int pm, pn, aux; };
struct Gemm { const bf16_t* A; const bf16_t* Bt; int M, N, K; };

struct StaticOrder {
    int nM, nN, nwg, G, c;
    __host__ __device__ void init(int M, int N, int G_, int c_) { nM = M / BM; nN = N / BM; nwg = nM * nN; G = G_; c = c_; }
    __host__ __device__ bool next(int i, Unit& u) const {
        const long L = (long)i * G + c; if (L >= nwg) return false;
        int wgid = (int)L; { const int q = nwg / NXCD, r = nwg % NXCD, xcd = wgid % NXCD, off = wgid / NXCD; wgid = (xcd < r ? xcd * (q + 1) : r * (q + 1) + (xcd - r) * q) + off; }
        const int nig = WGM * nN, gid = wgid / nig, fm = gid * WGM, gsz = (nM - fm) < WGM ? (nM - fm) : WGM;
        u.pm = fm + ((wgid % nig) % gsz); u.pn = (wgid % nig) / gsz; return true;
    }
    __device__ __forceinline__ void a_ready(const Unit&) const {}
    __device__ __forceinline__ void done(const Unit&) const {}
};


template <class Epi, class Sched, bool ALIGN_EPI = false, bool SP2 = false, bool FP8 = false, bool GATHER = false>
__device__ __forceinline__ void gemm_phase(PG8_LAS unsigned char* lds, const Gemm g, const Sched& S, const Epi& E, const PG8_LAS unsigned* gtab = nullptr) {
    int tido_ = threadIdx.x; asm volatile("" : "+v"(tido_));
    const int tid = tido_, wid = __builtin_amdgcn_readfirstlane(tid >> 6), lane = tid & 63, wr = wid >> 2, wc = wid & 3, fr = lane & 15, fq = lane >> 4;
    int Kop_ = g.K; asm volatile("" : "+s"(Kop_));
    const int K = Kop_, nt = K / BK;
    unsigned voffA[2], voffB[2];
#pragma unroll
    for (int i = 0; i < 2; ++i) { int R, C; stage_rc(tid * 16 + i * 8192, R, C); const int Rb = Epi::PERM ? ((R & ~31) + perm32(R & 31)) : R;
        voffA[i] = GATHER ? (unsigned)(R * 4 + C * 2 * 65536) : (unsigned)(R * K + C) * 2u; voffB[i] = (unsigned)(Rb * K + C) * 2u; }
    unsigned gA[2][2] = {{0u, 0u}, {0u, 0u}};
#define PG8_GLOAD(slot) do { _Pragma("unroll") for (int h_ = 0; h_ < 2; ++h_) _Pragma("unroll") for (int i_ = 0; i_ < 2; ++i_) \
        gA[h_][i_] = *(const PG8_LAS unsigned*)((const PG8_LAS unsigned char*)gtab + (slot) * 1024 + h_ * 512 + (voffA[i_] & 0xffffu)) + (voffA[i_] >> 16); } while (0)
#define PG8_STA(bufoff, base, h) do { if constexpr (GATHER) PG8_STAGE(bufoff, base, gA[h]); else PG8_STAGE(bufoff, (base) + (h) * hstep, voffA); } while (0)
    const size_t kstep = (size_t)(BK * 2);
    const size_t hstep = (size_t)HALF * K * 2;
    const size_t tstep = 2 * hstep;
    const unsigned ldsw = (unsigned)wid * 1024u;
    const int aoff = lds_byte(wr * 64 + fr, fq * 8), boff = lds_byte(wc * 32 + fr, fq * 8);
#define PG8_SA(b, h) (((b) * 2 + (h)) * HTB)
#define PG8_SB(b, h) ((4 + (b) * 2 + (h)) * HTB)
#define PG8_STAGE(bufoff, gbase, voff) do { _Pragma("unroll") for (int _i = 0; _i < 2; ++_i) \
        __builtin_amdgcn_global_load_lds((const unsigned*)((const char*)(gbase) + (voff)[_i]), (PG8_LAS unsigned*)(lds + (bufoff) + ldsw + _i * 8192), 16, 0, 0); } while (0)
#define PG8_LDA(dst, b, h) do { _Pragma("unroll") for (int m = 0; m < 4; ++m) dst[m] = __builtin_shufflevector(*(const PG8_LAS i32x4*)(lds + PG8_SA(b, h) + aoff + m * 2048), *(const PG8_LAS i32x4*)(lds + PG8_SA(b, h) + aoff + m * 2048 + 1024), 0, 1, 2, 3, 4, 5, 6, 7); } while (0)
#define PG8_LDB(dst, b, h) do { _Pragma("unroll") for (int n = 0; n < 2; ++n) dst[n] = __builtin_shufflevector(*(const PG8_LAS i32x4*)(lds + PG8_SB(b, h) + boff + n * 2048), *(const PG8_LAS i32x4*)(lds + PG8_SB(b, h) + boff + n * 2048 + 1024), 0, 1, 2, 3, 4, 5, 6, 7); } while (0)
#define PG8_MMA(ai, bj, At, Bt) do { __builtin_amdgcn_s_setprio(1); _Pragma("unroll") for (int m = 0; m < 4; ++m) _Pragma("unroll") for (int n = 0; n < 2; ++n) { \
        if constexpr (FP8)      \
            asm volatile("v_mfma_scale_f32_16x16x128_f8f6f4 %0, %1, %2, %0, %3, %3 op_sel_hi:[0,0,0]" : "+v"(acc[ai][bj][m][n]) : "v"(Bt[n]), "v"(At[m]), "v"(one8_)); \
        else { acc[ai][bj][m][n] = __builtin_amdgcn_mfma_f32_16x16x32_bf16(__builtin_bit_cast(bf16x8, __builtin_shufflevector(Bt[n], Bt[n], 0, 1, 2, 3)), __builtin_bit_cast(bf16x8, __builtin_shufflevector(At[m], At[m], 0, 1, 2, 3)), acc[ai][bj][m][n], 0, 0, 0); \
               acc[ai][bj][m][n] = __builtin_amdgcn_mfma_f32_16x16x32_bf16(__builtin_bit_cast(bf16x8, __builtin_shufflevector(Bt[n], Bt[n], 4, 5, 6, 7)), __builtin_bit_cast(bf16x8, __builtin_shufflevector(At[m], At[m], 4, 5, 6, 7)), acc[ai][bj][m][n], 0, 0, 0); } } __builtin_amdgcn_s_setprio(0); } while (0)
#define PG8_WAIT_V(n) asm volatile("s_waitcnt vmcnt(" #n ")" ::: "memory")
#define PG8_WAIT_L(n) asm volatile("s_waitcnt lgkmcnt(" #n ")" ::: "memory")
#define PG8_BAR __builtin_amdgcn_s_barrier()
#define PG8_SCHED __builtin_amdgcn_sched_barrier(0)
    Unit cur, nxt; int ui = 0;
    if (!S.next(0, cur)) return;
    int one8_ = 0x7f7f7f7f; asm volatile("" : "+v"(one8_));
    f32x4 acc[2][2][4][2];
    float zf_ = 0.f; asm volatile("" : "+v"(zf_));
#pragma unroll
    for (int a = 0; a < 2; ++a)
#pragma unroll
        for (int b = 0; b < 2; ++b)
#pragma unroll
            for (int m = 0; m < 4; ++m)
#pragma unroll
                for (int n = 0; n < 2; ++n) acc[a][b][m][n] = (f32x4){zf_, zf_, zf_, zf_};
    i32x8 At[4], B0[2], B1[2];
    const char* cA = (const char*)g.A + (GATHER ? (size_t)0 : (size_t)cur.pm * tstep); const char* cB = (const char*)g.Bt + (size_t)cur.pn * tstep;
    S.a_ready(cur);
    if constexpr (GATHER) PG8_GLOAD(cur.pm);
    if constexpr (SP2) {
        PG8_STAGE(PG8_SB(0, 0), cB, voffB); PG8_STAGE(PG8_SB(0, 1), cB + hstep, voffB); PG8_STA(PG8_SA(0, 0), cA, 0); PG8_STA(PG8_SA(0, 1), cA, 1);
        if (wr == 1) PG8_BAR;
        PG8_WAIT_V(2); PG8_BAR;
        PG8_STAGE(PG8_SB(1, 0), cB + kstep, voffB); PG8_STA(PG8_SA(1, 0), cA + kstep, 0); PG8_STAGE(PG8_SB(1, 1), cB + hstep + kstep, voffB);
        PG8_WAIT_V(6); PG8_BAR;
    } else {
        PG8_STAGE(PG8_SB(0, 0), cB, voffB); PG8_STA(PG8_SA(0, 0), cA, 0); PG8_STAGE(PG8_SB(0, 1), cB + hstep, voffB); PG8_STA(PG8_SA(0, 1), cA, 1);
        if (wr == 1) PG8_BAR;
        PG8_WAIT_V(4); PG8_BAR;
        PG8_STAGE(PG8_SB(1, 0), cB + kstep, voffB); PG8_STA(PG8_SA(1, 0), cA + kstep, 0); PG8_STAGE(PG8_SB(1, 1), cB + hstep + kstep, voffB);
        PG8_WAIT_V(6); PG8_BAR;
    }
    for (;;) {
        const bool has_next = S.next(ui + 1, nxt);
        const char* nA = (has_next && !GATHER) ? (const char*)g.A + (size_t)nxt.pm * tstep : cA; const char* nB = has_next ? (const char*)g.Bt + (size_t)nxt.pn * tstep : cB;
        for (int t = 0; t < nt; t += 2) {
            const bool last = (t == nt - 2);
            const char* a1 = cA + (size_t)(t + 1) * kstep;
            const char* a2 = last ? nA : cA + (size_t)(t + 2) * kstep; const char* b2 = last ? nB : cB + (size_t)(t + 2) * kstep;
            const char* a3 = a2 + kstep; const char* b3 = b2 + kstep;
            if (last && has_next) S.a_ready(nxt);
            if constexpr (SP2) {
            PG8_LDB(B0, 0, 0); PG8_LDB(B1, 0, 1); PG8_SCHED; PG8_LDA(At, 0, 0); PG8_STA(PG8_SA(1, 1), a1, 1);
            if constexpr (GATHER) { if (last && has_next) PG8_GLOAD(nxt.pm); }
            PG8_WAIT_V(8); PG8_WAIT_L(0); PG8_BAR; PG8_MMA(0, 0, At, B0); PG8_MMA(0, 1, At, B1); PG8_BAR; PG8_SCHED;
            PG8_LDA(At, 0, 1); PG8_STAGE(PG8_SB(0, 0), b2, voffB); PG8_STAGE(PG8_SB(0, 1), b2 + hstep, voffB); PG8_STA(PG8_SA(0, 0), a2, 0);
            PG8_WAIT_V(8); PG8_WAIT_L(0); PG8_BAR; PG8_MMA(1, 0, At, B0); PG8_MMA(1, 1, At, B1); PG8_BAR; PG8_SCHED;
            PG8_LDB(B0, 1, 0); PG8_LDB(B1, 1, 1); PG8_SCHED; PG8_LDA(At, 1, 0); PG8_STA(PG8_SA(0, 1), a2, 1);
            PG8_WAIT_V(8); PG8_WAIT_L(0); PG8_BAR; PG8_MMA(0, 0, At, B0); PG8_MMA(0, 1, At, B1); PG8_BAR; PG8_SCHED;
            PG8_LDA(At, 1, 1); PG8_STAGE(PG8_SB(1, 0), b3, voffB); PG8_STAGE(PG8_SB(1, 1), b3 + hstep, voffB); PG8_STA(PG8_SA(1, 0), a3, 0);
            PG8_WAIT_V(8); PG8_WAIT_L(0); PG8_BAR; PG8_MMA(1, 0, At, B0); PG8_MMA(1, 1, At, B1); PG8_BAR; PG8_SCHED;
            } else {
            static_assert(SP2 || !GATHER, "GATHER is wired into the SP2 loop only");
            PG8_LDB(B0, 0, 0); PG8_SCHED; PG8_LDA(At, 0, 0); PG8_STAGE(PG8_SA(1, 1), a1 + hstep, voffA);
            PG8_WAIT_L(8); PG8_BAR; PG8_WAIT_L(0); PG8_MMA(0, 0, At, B0); PG8_BAR; PG8_SCHED;
            PG8_LDB(B1, 0, 1); PG8_STAGE(PG8_SB(0, 0), b2, voffB);
            PG8_BAR; PG8_WAIT_L(0); PG8_MMA(0, 1, At, B1); PG8_BAR;
            PG8_LDA(At, 0, 1); PG8_STAGE(PG8_SA(0, 0), a2, voffA);
            PG8_BAR; PG8_WAIT_L(0); PG8_MMA(1, 0, At, B0); PG8_BAR; PG8_SCHED;
            PG8_STAGE(PG8_SB(0, 1), b2 + hstep, voffB);
            PG8_WAIT_V(6); PG8_BAR; PG8_MMA(1, 1, At, B1); PG8_BAR;
            PG8_LDB(B0, 1, 0); PG8_SCHED; PG8_LDA(At, 1, 0); PG8_STAGE(PG8_SA(0, 1), a2 + hstep, voffA);
            PG8_WAIT_L(8); PG8_BAR; PG8_WAIT_L(0); PG8_MMA(0, 0, At, B0); PG8_BAR; PG8_SCHED;
            PG8_LDB(B1, 1, 1); PG8_STAGE(PG8_SB(1, 0), b3, voffB);
            PG8_BAR; PG8_WAIT_L(0); PG8_MMA(0, 1, At, B1); PG8_BAR;
            PG8_LDA(At, 1, 1); PG8_STAGE(PG8_SA(1, 0), a3, voffA);
            PG8_BAR; PG8_WAIT_L(0); PG8_MMA(1, 0, At, B0); PG8_BAR; PG8_SCHED;
            PG8_STAGE(PG8_SB(1, 1), b3 + hstep, voffB);
            PG8_WAIT_V(6); PG8_BAR; PG8_MMA(1, 1, At, B1); PG8_BAR;
            }
        }
        if constexpr (ALIGN_EPI) { if (wr == 0) PG8_BAR; }
        if constexpr (FP8) asm volatile("s_nop 15\n\ts_nop 15" ::: "memory");
        if constexpr (!Epi::AFTER_DRAIN) { int le_ = lane; asm volatile("" : "+v"(le_));
            E(acc, cur, wr, wc, le_ & 15, le_ >> 4); S.done(cur); }
        if (!has_next) break;
        asm volatile("v_mov_b32 %0, 0" : "=v"(zf_));
#pragma unroll
        for (int a = 0; a < 2; ++a)
#pragma unroll
            for (int b = 0; b < 2; ++b)
#pragma unroll
                for (int m = 0; m < 4; ++m)
#pragma unroll
                    for (int n = 0; n < 2; ++n) acc[a][b][m][n] = (f32x4){zf_, zf_, zf_, zf_};
        cur = nxt; cA = nA; cB = nB; ++ui;
        if constexpr (ALIGN_EPI) { if (wr == 1) PG8_BAR; }
    }
    PG8_WAIT_V(0);
    if constexpr (!ALIGN_EPI) { if (wr == 0) PG8_BAR; }
    PG8_BAR;
    if constexpr (Epi::AFTER_DRAIN) { E.fused(acc, cur, wr, wc, fr, fq, lds, wid, lane); S.done(cur); }
#undef PG8_SA
#undef PG8_STA
#undef PG8_GLOAD
#undef PG8_SB
#undef PG8_STAGE
#undef PG8_LDA
#undef PG8_LDB
#undef PG8_MMA
#undef PG8_WAIT_V
#undef PG8_WAIT_L
#undef PG8_BAR
#undef PG8_SCHED
}

}

struct EpiA1U {
    static constexpr bool PERM = true, AFTER_DRAIN = false;
    bf16_t* U;
    __device__ __forceinline__ void operator()(const pg8::f32x4 (&acc)[2][2][4][2], const pg8::Unit& u, int wr, int wc, int fr, int fq) const {
        bf16_t* up = U + (size_t)(u.pm * 256 + wr * 64 + fr) * GW + u.pn * 256 + wc * 32 + 8 * fq;
#pragma unroll
        for (int ai = 0; ai < 2; ++ai)
#pragma unroll
            for (int m = 0; m < 4; ++m)
#pragma unroll
                for (int bj = 0; bj < 2; ++bj) {
                    const f32x4 v0 = gelu_tanh4(acc[ai][bj][m][0]), v1 = gelu_tanh4(acc[ai][bj][m][1]);
                    u32x4 w; w.x = pk_bf16(v0.x, v0.y); w.y = pk_bf16(v0.z, v0.w); w.z = pk_bf16(v1.x, v1.y); w.w = pk_bf16(v1.z, v1.w);
                    *(u32x4*)(up + (size_t)(ai * 128 + m * 16) * GW + bj * 128) = w;
                }
    }
};
struct EpiA1V {
    static constexpr bool PERM = true, AFTER_DRAIN = false;
    bf16_t* VT; float* VSS;
    __device__ __forceinline__ void operator()(const pg8::f32x4 (&acc)[2][2][4][2], const pg8::Unit& u, int wr, int wc, int fr, int fq) const {
        const int tok0 = u.pn * 256 + wc * 32 + 8 * fq;
        bf16_t* vp = VT + (size_t)(u.pm * 256 + wr * 64 + fr) * T + tok0;
        f32x4 ss[2][2];
#pragma unroll
        for (int bj = 0; bj < 2; ++bj) { ss[bj][0] = (f32x4){0.f, 0.f, 0.f, 0.f}; ss[bj][1] = (f32x4){0.f, 0.f, 0.f, 0.f}; }
#pragma unroll
        for (int ai = 0; ai < 2; ++ai)
#pragma unroll
            for (int m = 0; m < 4; ++m)
#pragma unroll
                for (int bj = 0; bj < 2; ++bj) {
                    f32x4 v0 = acc[ai][bj][m][0], v1 = acc[ai][bj][m][1];
                    v0 = gelu_tanh4(v0); v1 = gelu_tanh4(v1);
                    ss[bj][0] += v0 * v0; ss[bj][1] += v1 * v1;
                    u32x4 w; w.x = pk_bf16(v0.x, v0.y); w.y = pk_bf16(v0.z, v0.w); w.z = pk_bf16(v1.x, v1.y); w.w = pk_bf16(v1.z, v1.w);
                    *(u32x4*)(vp + (size_t)(ai * 128 + m * 16) * T + bj * 128) = w;
                }
#pragma unroll
        for (int bj = 0; bj < 2; ++bj)
#pragma unroll
            for (int n = 0; n < 2; ++n) {
                f32x4 q = ss[bj][n];
#pragma unroll
                for (int o = 1; o < 16; o <<= 1) { q.x += __shfl_xor(q.x, o); q.y += __shfl_xor(q.y, o); q.z += __shfl_xor(q.z, o); q.w += __shfl_xor(q.w, o); }
                if (fr == 0) *(f32x4*)(VSS + (size_t)(u.pm * 2 + wr) * T + tok0 + bj * 128 + 4 * n) = q;
            }
    }
};
__device__ __forceinline__ void phase_a1(const Ctx& c) {
    const pg8::bf16_t* XN = (const pg8::bf16_t*)(c.ws + WS_XN); const pg8::bf16_t* W = (const pg8::bf16_t*)(c.ws + WS_WAIN);
    {
        pg8::Gemm g{XN, W, T, GW, D}; pg8::StaticOrder S; S.init(T, GW, (int)gridDim.x, (int)blockIdx.x);
        EpiA1U E{(bf16_t*)(c.ws + WS_U)};
        pg8::gemm_phase<EpiA1U, pg8::StaticOrder, true, true, false>(c.ldsp, g, S, E);
    }
    __syncthreads();
    {
        pg8::Gemm g{W + (size_t)GW * D, XN, GW, T, D}; pg8::StaticOrder S; S.init(GW, T, (int)gridDim.x, (int)blockIdx.x);
        EpiA1V E{(bf16_t*)(c.ws + WS_VT), (float*)(c.ws + WS_VSS)};
        pg8::gemm_phase<EpiA1V, pg8::StaticOrder, true, true, false>(c.ldsp, g, S, E);
    }
}

__device__ __forceinline__ void phase_a2(const Ctx& c, bool dry = false) {
    const __attribute__((address_space(4))) Args& a = *c.a;
    bf16_t* U = (bf16_t*)(c.ws + WS_U); const bf16_t* VT = (const bf16_t*)(c.ws + WS_VT); const float* VSS = (const float*)(c.ws + WS_VSS);
    const float* ws_ = (const float*)a.in[IN_AWS]; const float* bs_ = (const float*)a.in[IN_ABS]; const float* vg = (const float*)a.in[IN_AVG];
    const int fr = c.lane & 15, fq = c.lane >> 4, wr = c.wave >> 1, wc = c.wave & 1, tid = c.tid;
    LAS unsigned char* lds = c.lds;
    LAS float* rl = (LAS float*)(lds + LDS_MAIN);
    for (int u = c.vb; u < 128 * 8; u += c.nb) {
        const int ci = u >> 3, g = u & 7, tokbase = ci * 128;
        __syncthreads();
        if (tid < 128) {
            const float* p = VSS + tokbase + tid; float s = 0.f;
#pragma unroll
            for (int i = 0; i < 16; ++i) s += p[(size_t)i * T];
            rl[tid] = rsqrtf(s * (1.f / GW) + EPS);
        }
        __syncthreads();
        {
            const int t = tid >> 1, half = tid & 1;
            const float* wrow = ws_ + ((size_t)g * 128 + t) * 128 + half * 64;
#pragma unroll
            for (int cc = 0; cc < 8; ++cc) {
                const int s0 = half * 64 + cc * 8;
                u32x4 o;
                {
                    const f32x4 w0 = ((const f32x4*)wrow)[2 * cc], w1 = ((const f32x4*)wrow)[2 * cc + 1];
                    float e[8] = {w0.x, w0.y, w0.z, w0.w, w1.x, w1.y, w1.z, w1.w};
                    const f32x4 r0_ = *(const LAS f32x4*)(rl + s0), r1_ = *(const LAS f32x4*)(rl + s0 + 4);
                    const float rr[8] = {r0_.x, r0_.y, r0_.z, r0_.w, r1_.x, r1_.y, r1_.z, r1_.w};
#pragma unroll
                    for (int i = 0; i < 8; ++i) e[i] = (s0 + i <= t) ? e[i] * rr[i] : 0.f;
                    o.x = pk_bf16(e[0], e[1]); o.y = pk_bf16(e[2], e[3]); o.z = pk_bf16(e[4], e[5]); o.w = pk_bf16(e[6], e[7]);
                }
                *(LAS u32x4*)(lds + half * 16384 + t * 128 + ((cc ^ (t & 7)) << 4)) = o;
            }
        }
        for (int hn = 0; hn < 2; ++hn) {
            const int c0 = g * 256 + hn * 128;
            const bf16_t* bp[4]; rows_regular<64>(bp, VT + (size_t)c0 * T + tokbase, T, tid);
            stage_tile<64>(lds + 32768, bp, 0, tid); stage_tile<64>(lds + 32768 + 16384, bp, 64, tid);
            VM_WAIT();
            __syncthreads();
            f32x4 acc[4][4]; zero_acc(acc);
#pragma unroll 1
            for (int kh = 0; kh < 2; ++kh)
#pragma unroll 1
                for (int ks = 0; ks < 2; ++ks) {
                    bf16x8 af[4], bf[4];
#pragma unroll
                    for (int m = 0; m < 4; ++m) af[m] = *(const LAS bf16x8*)(lds + kh * 16384 + frag_off<64>(wr * 64 + m * 16 + fr, ks, fq));
#pragma unroll
                    for (int n = 0; n < 4; ++n) bf[n] = *(const LAS bf16x8*)(lds + 32768 + kh * 16384 + frag_off<64>(wc * 64 + n * 16 + fr, ks, fq));
#pragma unroll
                    for (int m = 0; m < 4; ++m)
#pragma unroll
                        for (int n = 0; n < 4; ++n) acc[m][n] = __builtin_amdgcn_mfma_f32_16x16x32_bf16(bf[n], af[m], acc[m][n], 0, 0, 0);
                }
            u32x2 uvv[4][4]; float bsvv[4];
#pragma unroll
            for (int m = 0; m < 4; ++m) { const int tl = wr * 64 + m * 16 + fr; bsvv[m] = bs_[g * 128 + tl];
#pragma unroll
                for (int n = 0; n < 4; ++n) uvv[m][n] = *(const u32x2*)(U + (size_t)(tokbase + tl) * GW + c0 + wc * 64 + n * 16 + fq * 4); }
#pragma unroll
            for (int m = 0; m < 4; ++m) {
                const int tl = wr * 64 + m * 16 + fr; const float bsv = bsvv[m];
#pragma unroll
                for (int n = 0; n < 4; ++n) {
                    const int ch = c0 + wc * 64 + n * 16 + fq * 4;
                    const f32x4 gn = *(const f32x4*)(vg + ch);
                    u32x2* up = (u32x2*)(U + (size_t)(tokbase + tl) * GW + ch);
                    const u32x2 uv = uvv[m][n]; const f32x4 v = acc[m][n];
                    u32x2 o;
                    o.x = pk_bf16(bf_lo(uv.x) * (gn.x * v.x + bsv), bf_hi(uv.x) * (gn.y * v.y + bsv));
                    o.y = pk_bf16(bf_lo(uv.y) * (gn.z * v.z + bsv), bf_hi(uv.y) * (gn.w * v.w + bsv));
                    if (dry) *(u32x2*)(c.ws + 440 * MB + ((size_t)(tokbase + tl) * GW + ch) * 2) = o; else *up = o;
                }
            }
            __syncthreads();
        }
    }
}

template <bool BASE_F32> struct EpiResH {
    static constexpr bool PERM = true, AFTER_DRAIN = false;
    const void* base; bf16_t* out; float ascale;
    __device__ __forceinline__ void operator()(const pg8::f32x4 (&acc)[2][2][4][2], const pg8::Unit& u, int wr, int wc, int fr, int fq) const {
        const size_t o0 = (size_t)(u.pm * 256 + wr * 64 + fr) * D + u.pn * 256 + wc * 32 + 8 * fq;
#pragma unroll
        for (int ai = 0; ai < 2; ++ai)
#pragma unroll
            for (int m = 0; m < 4; ++m) {
                f32x4 b0[2], b1[2];
#pragma unroll
                for (int bj = 0; bj < 2; ++bj) { const size_t o = o0 + (size_t)(ai * 128 + m * 16) * D + bj * 128;
                    if (BASE_F32) { b0[bj] = *(const f32x4*)((const float*)base + o); b1[bj] = *(const f32x4*)((const float*)base + o + 4); }
                    else { const u32x4 w = *(const u32x4*)((const bf16_t*)base + o); b0[bj] = (f32x4){bf_lo(w.x), bf_hi(w.x), bf_lo(w.y), bf_hi(w.y)}; b1[bj] = (f32x4){bf_lo(w.z), bf_hi(w.z), bf_lo(w.w), bf_hi(w.w)}; } }
#pragma unroll
                for (int bj = 0; bj < 2; ++bj) { const size_t o = o0 + (size_t)(ai * 128 + m * 16) * D + bj * 128;
                    const f32x4 v0 = b0[bj] + acc[ai][bj][m][0] * ascale, v1 = b1[bj] + acc[ai][bj][m][1] * ascale;
                    u32x4 w; w.x = pk_bf16(v0.x, v0.y); w.y = pk_bf16(v0.z, v0.w); w.z = pk_bf16(v1.x, v1.y); w.w = pk_bf16(v1.z, v1.w);
                    *(u32x4*)(out + o) = w; }
            }
    }
};
__device__ __forceinline__ void phase_a3(const Ctx& c) {
    pg8::Gemm g{(const pg8::bf16_t*)(c.ws + WS_U), (const pg8::bf16_t*)(c.ws + WS_WAOUT), T, D, GW};
    pg8::StaticOrder S; S.init(T, D, (int)gridDim.x, (int)blockIdx.x);
    EpiResH<true> E{c.a->in[IN_X], (bf16_t*)(c.ws + WS_H), 1.f};
    pg8::gemm_phase<EpiResH<true>, pg8::StaticOrder, true, true, false>(c.ldsp, g, S, E);
}

__device__ __forceinline__ void phase_route(const Ctx& c, int l, bool dry = false) {
    const __attribute__((address_space(4))) Args& a = *c.a;
    const bf16_t* H = (const bf16_t*)(c.ws + WS_H);
    const float* wr_ = (const float*)(c.ws + WS_WR) + (size_t)l * D * 48;
    const float* gain = (const float*)a.in[IN_FFNN] + l * D;
    int* cnt = (int*)(c.ws + WS_CNT) + (size_t)(l + (dry ? 2 : 0)) * NSUB * 32 * CNT_STRIDE; int* list = (int*)(c.ws + (dry ? 480 * MB : WS_LIST)); float* gatel = (float*)(c.ws + (dry ? 484 * MB : WS_GATE)); int* tokslot = (int*)(c.ws + (dry ? 488 * MB : WS_TOKSLOT));
    LAS float* rl = (LAS float*)(c.lds);
    LAS float* lgl = (LAS float*)(c.lds + 256);
    const int lane = c.lane, w = c.wave;
    f32x4 gv[4]; gain_load(gain, lane, gv);
    LAS unsigned char* cscr = c.lds + 16384 + c.wave * TR_SCR; static_assert(16384 + 4 * TR_SCR <= LDS_MAIN, "route lds");
    const bool conv = (l == 0) && !dry;
    if (conv && c.half == 1) for (int it = c.vb * 4 + c.wave; it < NE * 192; it += c.nb * 4) convert_moe_item(c, 0, it, cscr);
    for (int unit = c.vb; unit < T / 32; unit += c.nb) {
        const int tok0 = unit * 32;
        __syncthreads();
#pragma unroll 1
        for (int i0 = 0; i0 < 8; i0 += 4) {
            f32x4 v[4][4];
#pragma unroll
            for (int i = 0; i < 4; ++i) row_load_h(H + (size_t)(tok0 + w * 8 + i0 + i) * D, lane, v[i]);
#pragma unroll
            for (int i = 0; i < 4; ++i) {
                const int t = tok0 + w * 8 + i0 + i;
                const float r = rsqrtf(row_sumsq(v[i]) * (1.f / D) + EPS);
                if (lane == 0) rl[w * 8 + i0 + i] = r;
                row_store_norm_fp8(c.ws + (dry ? 440 * MB : WS_XN8) + (size_t)t * D, lane, v[i], r, gv);
            }
        }
#ifndef MK_DRYPART
#define MK_DRYPART 3
#endif
        if (!(dry && MK_DRYPART < 2))
        {
            const int th = w & 1, kh = w >> 1, m = lane & 15, q = lane >> 4;
            const u32x2* ap = (const u32x2*)(H + (size_t)(tok0 + 16 * th + m) * D + 512 * kh + 128 * q);
            const f32x4* bp = (const f32x4*)wr_ + (size_t)kh * 32 * 3 * 64 + lane;
            f32x4 acc[3]; acc[0] = acc[1] = acc[2] = (f32x4){0.f, 0.f, 0.f, 0.f};
#pragma unroll 1
            for (int i0 = 0; i0 < 32; i0 += 4) {
                f32x4 av[4], bv[4][3];
#pragma unroll
                for (int i = 0; i < 4; ++i) { { const u32x2 hw = ap[i0 + i]; av[i] = (f32x4){bf_lo(hw.x), bf_hi(hw.x), bf_lo(hw.y), bf_hi(hw.y)}; }
#pragma unroll
                    for (int nt = 0; nt < 3; ++nt) bv[i][nt] = bp[((i0 + i) * 3 + nt) * 64]; }
#pragma unroll
                for (int i = 0; i < 4; ++i)
#pragma unroll
                    for (int e = 0; e < 4; ++e)
#pragma unroll
                        for (int nt = 0; nt < 3; ++nt) acc[nt] = __builtin_amdgcn_mfma_f32_16x16x4f32(av[i][e], bv[i][nt][e], acc[nt], 0, 0, 0);
            }
#pragma unroll
            for (int nt = 0; nt < 3; ++nt)
#pragma unroll
                for (int j = 0; j < 4; ++j) lgl[(kh * 32 + th * 16 + 4 * q + j) * 48 + nt * 16 + m] = acc[nt][j];
        }
        __syncthreads();
        if (c.tid < 32 && !(dry && MK_DRYPART < 3)) {
            const int tt = c.tid, t = tok0 + tt; const float r = rl[tt];
            const float* bg = (const float*)a.in[IN_BG] + l * 4; const float* be = (const float*)a.in[IN_BE] + l * 32;
            float gl[4];
#pragma unroll
            for (int o = 0; o < 4; ++o) gl[o] = (lgl[tt * 48 + o] + lgl[(32 + tt) * 48 + o]) * r + bg[o];
            int gs = 0; float gm = gl[0];
#pragma unroll
            for (int o = 1; o < 4; ++o) if (gl[o] > gm) { gm = gl[o]; gs = o; }
            float gden = 0.f;
#pragma unroll
            for (int o = 0; o < 4; ++o) gden += __expf(gl[o] - gm);
            const float pg = 1.f / gden;
            float l1 = -INFINITY, l2 = -INFINITY; int i1 = 0, i2 = 0;
            for (int i = 0; i < 8; ++i) {
                const int o = 4 + gs * 8 + i;
                const float v = (lgl[tt * 48 + o] + lgl[(32 + tt) * 48 + o]) * r + be[gs * 8 + i];
                if (v > l1) { l2 = l1; i2 = i1; l1 = v; i1 = i; } else if (v > l2) { l2 = v; i2 = i; }
            }
            const float e2 = __expf(l2 - l1), inv = 1.f / (1.f + e2);
            const float g1 = pg * inv, g2 = pg * e2 * inv;
            const int ea = gs * 8 + i1, eb = gs * 8 + i2;
            const int sub = unit & (NSUB - 1);
            const int sa = sub * SUBCAP + atomicAdd(&cnt[(sub * 32 + ea) * CNT_STRIDE], 1), sb = sub * SUBCAP + atomicAdd(&cnt[(sub * 32 + eb) * CNT_STRIDE], 1);
            list[ea * T + sa] = t; gatel[ea * T + sa] = g1; tokslot[2 * t] = (ea << 16) | sa;
            list[eb * T + sb] = t; gatel[eb * T + sb] = g2; tokslot[2 * t + 1] = (eb << 16) | sb;
        }
    }
    if (conv && c.half == 0) for (int it = c.vb * 4 + c.wave; it < NE * 192; it += c.nb * 4) convert_moe_item(c, 0, it, cscr);
}

__device__ __forceinline__ void moe_table_build(const unsigned char* ws, int l, int tl, LAS int* pst, LAS int* cn, LAS int* sub) {
    if (tl < 32) {
        const int* cnt = (const int*)(ws + WS_CNT) + (size_t)l * NSUB * 32 * CNT_STRIDE + tl * CNT_STRIDE;
        int v[NSUB];
#pragma unroll
        for (int s2 = 0; s2 < NSUB; ++s2) v[s2] = cnt[(size_t)s2 * 32 * CNT_STRIDE];
        int acc = 0;
#pragma unroll
        for (int s2 = 0; s2 < NSUB; ++s2) { sub[tl * 33 + s2] = acc; acc += v[s2]; }
        sub[tl * 33 + NSUB] = acc; cn[tl] = acc;
        const int nb = (acc + 255) >> 8; int inc = nb;
#pragma unroll
        for (int o = 1; o < 32; o <<= 1) { const int t2 = __shfl_up(inc, o); if (tl >= o) inc += t2; }
        pst[tl] = inc - nb; if (tl == 31) pst[32] = inc;
    }
}
__device__ __forceinline__ void moe_table(const Ctx& c, int l, LAS int* pst, LAS int* cn, LAS int* sub) {
    __syncthreads();
    moe_table_build(c.ws, l, c.tid, pst, cn, sub);
    __syncthreads();
}
__device__ __forceinline__ void moe_table_wg(const Ctx& c, int l, LAS int* pst, LAS int* cn, LAS int* sub) {
    __syncthreads();
    moe_table_build(c.ws, l, (int)threadIdx.x, pst, cn, sub);
    __syncthreads();
}
__device__ __forceinline__ int moe_row_idx(LAS const int* sub, int e, int r) {
    int s2 = 0;
    for (int i = 1; i < NSUB; ++i) s2 = (sub[e * 33 + i] <= r) ? i : s2;
    return s2 * SUBCAP + (r - sub[e * 33 + s2]);
}
__device__ __forceinline__ int moe_find(LAS const int* pst, int mb) { int e = 0; for (int i = 1; i < 32; ++i) e = (pst[i] <= mb) ? i : e; return e; }

constexpr int MOE_LDS = 131072;
constexpr int CAPU = 16;
constexpr int MOE_SUB = MOE_LDS + 1024 + CAPU * 1024;
static_assert(MOE_SUB + 32 * 33 * 4 <= LDS_BYTES - 16, "moe lds");
__device__ __forceinline__ void moe_table_wg(const Ctx& c, int l, LAS int* pst, LAS int* cn) {
    __syncthreads();
    if (threadIdx.x == 0) {
        const int* cnt = (const int*)(c.ws + WS_CNT) + l * 32 * CNT_STRIDE; int acc = 0;
        for (int e = 0; e < 32; ++e) { const int n = cnt[e * CNT_STRIDE]; cn[e] = n; pst[e] = acc; acc += (n + 255) >> 8; }
        pst[32] = acc;
    }
    __syncthreads();
}
struct MoeOrder {
    LAS const int* pst; int nunits, G, c, i0; bool gather;
    __device__ __forceinline__ bool next(int i, pg8::Unit& u) const {
        if (i >= CAPU) return false;
        const long L = (long)(i0 + i) * G + c; if (L >= nunits) return false;
        int wgid = (int)L; { const int q = nunits / 8, r = nunits % 8, xcd = wgid % 8, off = wgid / 8; wgid = (xcd < r ? xcd * (q + 1) : r * (q + 1) + (xcd - r) * q) + off; }
        const int mb = wgid >> 2, e = __builtin_amdgcn_readfirstlane(moe_find(pst, mb));
        u.pm = gather ? i : mb; u.pn = e * 4 + (wgid & 3); u.aux = mb; return true;
    }
    __device__ __forceinline__ void a_ready(const pg8::Unit&) const {}
    __device__ __forceinline__ void done(const pg8::Unit&) const {}
};
struct EpiE1 {
    static constexpr bool PERM = true, AFTER_DRAIN = false;
    unsigned char* HM;
    __device__ __forceinline__ void operator()(const pg8::f32x4 (&acc)[2][2][4][2], const pg8::Unit& u, int wr, int wc, int fr, int fq) const {
        const float ws_ = 1.f / W8_SCALE;
        unsigned char* hp = HM + ((size_t)u.aux * 256 + wr * 64 + fr) * DE + (u.pn & 3) * 128 + wc * 32 + 8 * fq;
#pragma unroll
        for (int ai = 0; ai < 2; ++ai)
#pragma unroll
            for (int m = 0; m < 4; ++m) {
                u32x2 o;
#pragma unroll
                for (int n = 0; n < 2; ++n) {
                    const f32x4 x = acc[ai][0][m][n] * ws_, y = acc[ai][1][m][n] * (ws_ * H8_SCALE);
                    const f32x4 hv = (x * sigmoid4(x)) * y;
                    const unsigned w = pk_fp8x4(hv.x, hv.y, hv.z, hv.w);
                    if (n == 0) o.x = w; else o.y = w;
                }
                *(u32x2*)(hp + (size_t)(ai * 128 + m * 16) * DE) = o;
            }
    }
};
__device__ __forceinline__ void phase_e1(const Ctx& c, int l) {
    LAS int* pst = (LAS int*)(c.ldsp + MOE_LDS); LAS int* cn = pst + 40; LAS unsigned* gtab = (LAS unsigned*)(c.ldsp + MOE_LDS + 1024); LAS int* sub = (LAS int*)(c.ldsp + MOE_SUB);
    moe_table_wg(c, l, pst, cn, sub);
    const float* gatel = (const float*)(c.ws + WS_GATE); float* grow = (float*)(c.ws + WS_GROW);
    const int* list = (const int*)(c.ws + WS_LIST);
    pg8::Gemm g{(const pg8::bf16_t*)(c.ws + WS_XN8), (const pg8::bf16_t*)(c.ws + WS_W3), RPAD, 1024, D / 2};
    MoeOrder S{pst, __builtin_amdgcn_readfirstlane(pst[32]) * 4, (int)gridDim.x, (int)blockIdx.x, 0, true};
    EpiE1 E{c.ws + WS_HMID};
    for (;; S.i0 += CAPU) {
        pg8::Unit u; if (!S.next(0, u)) break;
        for (int i = 0; i < CAPU; ++i) {
            if (!S.next(i, u)) break;
            const int e = u.pn >> 2, row0 = (u.aux - __builtin_amdgcn_readfirstlane(pst[e])) * 256, count = __builtin_amdgcn_readfirstlane(cn[e]);
            if (threadIdx.x < 256) {
                const int r = row0 + (int)threadIdx.x, idx = moe_row_idx(sub, e, r < count ? r : row0);
                gtab[i * 256 + threadIdx.x] = (unsigned)list[e * T + idx] * (unsigned)D;
                if ((u.pn & 3) == 0) grow[(size_t)u.aux * 256 + threadIdx.x] = (r < count) ? gatel[e * T + idx] : 0.f;
            }
        }
        __syncthreads();
        pg8::gemm_phase<EpiE1, MoeOrder, true, true, true, true>(c.ldsp, g, S, E, gtab);
        __syncthreads();
    }
}
struct EpiE2 {
    static constexpr bool PERM = true, AFTER_DRAIN = false;
    bf16_t* Y; const float* grow;
    __device__ __forceinline__ void operator()(const pg8::f32x4 (&acc)[2][2][4][2], const pg8::Unit& u, int wr, int wc, int fr, int fq) const {
        const int mb = u.aux;
        bf16_t* yp = Y + ((size_t)mb * 256 + wr * 64 + fr) * D + (u.pn & 3) * 256 + wc * 32 + 8 * fq;
        const float* gp = grow + (size_t)mb * 256 + wr * 64 + fr;
#pragma unroll
        for (int ai = 0; ai < 2; ++ai) {
            float gt[4];
#pragma unroll
            for (int m = 0; m < 4; ++m) gt[m] = gp[ai * 128 + m * 16] * (1.f / (W8_SCALE * H8_SCALE));
#pragma unroll
            for (int m = 0; m < 4; ++m)
#pragma unroll
                for (int bj = 0; bj < 2; ++bj) {
                    const f32x4 v0 = acc[ai][bj][m][0] * gt[m], v1 = acc[ai][bj][m][1] * gt[m];
                    u32x4 w; w.x = pk_bf16(v0.x, v0.y); w.y = pk_bf16(v0.z, v0.w); w.z = pk_bf16(v1.x, v1.y); w.w = pk_bf16(v1.z, v1.w);
                    *(u32x4*)(yp + (size_t)(ai * 128 + m * 16) * D + bj * 128) = w;
                }
        }
    }
};
__device__ __forceinline__ void phase_e2(const Ctx& c, int l) {
    LAS int* pst = (LAS int*)(c.ldsp + MOE_LDS); LAS int* cn = pst + 40; LAS int* sub = (LAS int*)(c.ldsp + MOE_SUB);
    moe_table_wg(c, l, pst, cn, sub);
    int kq = DE / 2; asm volatile("" : "+s"(kq));
    pg8::Gemm g{(const pg8::bf16_t*)(c.ws + WS_HMID), (const pg8::bf16_t*)(c.ws + WS_W2), RPAD, 1024, kq};
    MoeOrder S{pst, __builtin_amdgcn_readfirstlane(pst[32]) * 4, (int)gridDim.x, (int)blockIdx.x, 0, false};
    EpiE2 E{(bf16_t*)(c.ws + WS_Y), (const float*)(c.ws + WS_GROW)};
    for (;; S.i0 += CAPU) {
        pg8::Unit u; if (!S.next(0, u)) break;
        pg8::gemm_phase<EpiE2, MoeOrder, true, true, true, false>(c.ldsp, g, S, E);
        __syncthreads();
    }
}
__device__ __forceinline__ void phase_p1(const Ctx& c, int l, bool dry = false) {
    const bf16_t* H = (const bf16_t*)(c.ws + WS_H); bf16_t* HO = (bf16_t*)(c.ws + (dry ? 440 * MB : WS_H)); const bf16_t* Y = (const bf16_t*)(c.ws + WS_Y);
    const int* tokslot = (const int*)(c.ws + WS_TOKSLOT); const float* gain = (const float*)c.a->in[IN_PLEN] + l * D;
    LAS int* pst = (LAS int*)(c.lds + LDS_MAIN); LAS int* cn = pst + 40; LAS int* sub = (LAS int*)c.lds;
    moe_table(c, l, pst, cn, sub);
    const int gw = c.vb * 4 + c.wave, ngw = c.nb * 4, lane = c.lane;
    f32x4 gv[4]; gain_load(gain, lane, gv);
    int s0n = 0, s1n = 0;
    if (gw < T) { s0n = tokslot[2 * gw]; s1n = tokslot[2 * gw + 1]; }
    for (int t = gw; t < T; t += ngw) {
        const int s0 = s0n, s1 = s1n;
        { const int tn = (t + ngw < T) ? t + ngw : t; s0n = tokslot[2 * tn]; s1n = tokslot[2 * tn + 1]; }
        const int e0 = s0 >> 16, i0 = s0 & 0xffff, e1 = s1 >> 16, i1 = s1 & 0xffff;
        const bf16_t* y0 = Y + ((size_t)pst[e0] * 256 + sub[e0 * 33 + i0 / SUBCAP] + (i0 % SUBCAP)) * D; const bf16_t* y1 = Y + ((size_t)pst[e1] * 256 + sub[e1 * 33 + i1 / SUBCAP] + (i1 % SUBCAP)) * D;
        f32x4 v[4]; u32x2 a0[4], a1[4];
        row_load_h(H + (size_t)t * D, lane, v);
#pragma unroll
        for (int j = 0; j < 4; ++j) { a0[j] = ((const u32x2*)y0)[lane + 64 * j]; a1[j] = ((const u32x2*)y1)[lane + 64 * j]; }
#pragma unroll
        for (int j = 0; j < 4; ++j) {
            v[j].x += bf_lo(a0[j].x) + bf_lo(a1[j].x); v[j].y += bf_hi(a0[j].x) + bf_hi(a1[j].x); v[j].z += bf_lo(a0[j].y) + bf_lo(a1[j].y); v[j].w += bf_hi(a0[j].y) + bf_hi(a1[j].y);
        }
        row_store_h(HO + (size_t)t * D, lane, v);
        const float r = rsqrtf(row_sumsq(v) * (1.f / D) + EPS);
        row_store_norm_fp8(c.ws + (dry ? 440 * MB : WS_XN8) + (size_t)t * D, lane, v, r, gv);
    }
}
struct EpiPJ {
    static constexpr bool PERM = true, AFTER_DRAIN = false;
    bf16_t* PJ;
    __device__ __forceinline__ void operator()(const pg8::f32x4 (&acc)[2][2][4][2], const pg8::Unit& u, int wr, int wc, int fr, int fq) const {
        bf16_t* pp = PJ + (size_t)(u.pm * 256 + wr * 64 + fr) * D + u.pn * 256 + wc * 32 + 8 * fq;
#pragma unroll
        for (int ai = 0; ai < 2; ++ai)
#pragma unroll
            for (int m = 0; m < 4; ++m)
#pragma unroll
                for (int bj = 0; bj < 2; ++bj) {
                    const f32x4 v0 = acc[ai][bj][m][0], v1 = acc[ai][bj][m][1];
                    u32x4 w; w.x = pk_bf16(v0.x, v0.y); w.y = pk_bf16(v0.z, v0.w); w.z = pk_bf16(v1.x, v1.y); w.w = pk_bf16(v1.z, v1.w);
                    *(u32x4*)(pp + (size_t)(ai * 128 + m * 16) * D + bj * 128) = w;
                }
    }
};
template <bool EMIT> struct EpiP2 {
    static constexpr bool PERM = true, AFTER_DRAIN = false;
    const bf16_t* PJ; const bf16_t* H; bf16_t* HO; unsigned char* H8; float* RSS;
    __device__ __forceinline__ void operator()(const pg8::f32x4 (&acc)[2][2][4][2], const pg8::Unit& u, int wr, int wc, int fr, int fq) const {
        const size_t o0 = (size_t)(u.pm * 256 + wr * 64 + fr) * D + u.pn * 256 + wc * 32 + 8 * fq;
#pragma unroll
        for (int ai = 0; ai < 2; ++ai)
#pragma unroll
            for (int m = 0; m < 4; ++m) {
                float ssq = 0.f;
                u32x4 pj[2], hw[2];
#pragma unroll
                for (int bj = 0; bj < 2; ++bj) { const size_t o = o0 + (size_t)(ai * 128 + m * 16) * D + bj * 128;
                    pj[bj] = *(const u32x4*)(PJ + o); hw[bj] = *(const u32x4*)(H + o); }
#pragma unroll
                for (int bj = 0; bj < 2; ++bj) { const size_t o = o0 + (size_t)(ai * 128 + m * 16) * D + bj * 128;
                    const f32x4 g0 = acc[ai][bj][m][0] * (1.f / W8_SCALE), g1 = acc[ai][bj][m][1] * (1.f / W8_SCALE);
                    f32x4 a0 = {bf_lo(hw[bj].x), bf_hi(hw[bj].x), bf_lo(hw[bj].y), bf_hi(hw[bj].y)}, a1 = {bf_lo(hw[bj].z), bf_hi(hw[bj].z), bf_lo(hw[bj].w), bf_hi(hw[bj].w)};
                    a0 += sigmoid4(g0) * (f32x4){bf_lo(pj[bj].x), bf_hi(pj[bj].x), bf_lo(pj[bj].y), bf_hi(pj[bj].y)};
                    a1 += sigmoid4(g1) * (f32x4){bf_lo(pj[bj].z), bf_hi(pj[bj].z), bf_lo(pj[bj].w), bf_hi(pj[bj].w)};
                    u32x4 ow; ow.x = pk_bf16(a0.x, a0.y); ow.y = pk_bf16(a0.z, a0.w); ow.z = pk_bf16(a1.x, a1.y); ow.w = pk_bf16(a1.z, a1.w);
                    *(u32x4*)(HO + o) = ow;
                    if (EMIT) { u32x2 o8; o8.x = pk_fp8x4(a0.x, a0.y, a0.z, a0.w); o8.y = pk_fp8x4(a1.x, a1.y, a1.z, a1.w); *(u32x2*)(H8 + o) = o8;
                        ssq += (a0.x * a0.x + a0.y * a0.y) + (a0.z * a0.z + a0.w * a0.w) + (a1.x * a1.x + a1.y * a1.y) + (a1.z * a1.z + a1.w * a1.w); } }
                if (EMIT) { ssq += __shfl_xor(ssq, 16); ssq += __shfl_xor(ssq, 32);
                    if (fq == 0) RSS[(size_t)(u.pm * 256 + ai * 128 + wr * 64 + m * 16 + fr) * 16 + u.pn * 4 + wc] = ssq; }
            }
    }
};
__device__ __forceinline__ void phase_p2(const Ctx& c, int l, bool dry = false) {
    bf16_t* PJ = (bf16_t*)(c.ws + WS_Y);
    pg8::StaticOrder S; S.init(T, D, (int)gridDim.x, (int)blockIdx.x);
    {
        pg8::Gemm g{(const pg8::bf16_t*)(c.ws + WS_PBF) + (size_t)l * T * PLE, (const pg8::bf16_t*)(c.ws + WS_WPROJ) + (size_t)l * D * PLE, T, D, PLE};
        EpiPJ E{PJ};
        pg8::gemm_phase<EpiPJ, pg8::StaticOrder, true, true, false>(c.ldsp, g, S, E);
    }
    __syncthreads();
    {
        pg8::Gemm g{(const pg8::bf16_t*)(c.ws + WS_XN8), (const pg8::bf16_t*)(c.ws + WS_WGATE + (size_t)l * D * D), T, D, D / 2};
        if (l == 0) { EpiP2<true> E{PJ, (const bf16_t*)(c.ws + WS_H), (bf16_t*)(c.ws + (dry ? 440 * MB : WS_H)), c.ws + (dry ? 440 * MB + 64 * MB : WS_H8), (float*)(c.ws + (dry ? 440 * MB + 80 * MB : WS_RSS))};
            pg8::gemm_phase<EpiP2<true>, pg8::StaticOrder, true, true, true>(c.ldsp, g, S, E); }
        else { EpiP2<false> E{PJ, (const bf16_t*)(c.ws + WS_H), (bf16_t*)(c.ws + (dry ? 440 * MB : WS_H)), nullptr, nullptr};
            pg8::gemm_phase<EpiP2<false>, pg8::StaticOrder, true, true, true>(c.ldsp, g, S, E); }
    }
}
__device__ __forceinline__ void phase_norm_bf16(const Ctx& c, const float* gain) {
    const bf16_t* H = (const bf16_t*)(c.ws + WS_H);
    const int gw = c.vb * 4 + c.wave, ngw = c.nb * 4;
    f32x4 gv[4]; gain_load(gain, c.lane, gv);
    for (int t = gw; t < T; t += ngw) {
        f32x4 v[4]; row_load_h(H + (size_t)t * D, c.lane, v);
        const float r = rsqrtf(row_sumsq(v) * (1.f / D) + EPS);
        row_store_norm_fp8(c.ws + WS_XN8 + (size_t)t * D, c.lane, v, r, gv);
        row_store_norm_bf16((bf16_t*)(c.ws + WS_XN) + (size_t)t * D, c.lane, v, r, gv);
    }
}
__device__ __forceinline__ void phase_final(const Ctx& c) {
    const bf16_t* H = (const bf16_t*)(c.ws + WS_H); float* O = c.a->out; const float* gain = (const float*)c.a->in[IN_FINN];
    const int gw = c.vb * 4 + c.wave, ngw = c.nb * 4;
    f32x4 gv[4]; gain_load(gain, c.lane, gv);
    for (int t = gw; t < T; t += ngw) {
        f32x4 v[4]; row_load_h(H + (size_t)t * D, c.lane, v);
        const float r = rsqrtf(row_sumsq(v) * (1.f / D) + EPS);
#pragma unroll
        for (int j = 0; j < 4; ++j) ((f32x4*)(O + (size_t)t * D))[c.lane + 64 * j] = v[j] * r * gv[j];
    }
}

struct B1Order {
    int G, c, nN, mode;
    __device__ __forceinline__ bool next(int i, pg8::Unit& u) const {
        int L;
        if (G == 256) {
            if (mode == 0) { if (c < 64) { if (i >= 3) return false; L = c * 3 + i; } else { if (i >= 1) return false; L = 192 + (c - 64); } }
            else { if (c < 64 || i >= 1) return false; L = c - 64; }
        } else { L = i * G + c; if (L >= 64 * nN) return false; }
        u.pm = L / nN; u.pn = L - u.pm * nN; u.aux = 0; return true;
    }
    __device__ __forceinline__ void a_ready(const pg8::Unit&) const {}
    __device__ __forceinline__ void done(const pg8::Unit&) const {}
};
struct EpiRaw {
    static constexpr bool PERM = true, AFTER_DRAIN = false;
    bf16_t* RAW; int col_off; float sc;
    __device__ __forceinline__ void operator()(const pg8::f32x4 (&acc)[2][2][4][2], const pg8::Unit& u, int wr, int wc, int fr, int fq) const {
        const int col0 = col_off + u.pn * 256 + wc * 32 + 8 * fq;
        bf16_t* rp = RAW + (size_t)(u.pm * 256 + wr * 64 + fr) * BINP + col0;
#pragma unroll
        for (int bj = 0; bj < 2; ++bj) {
            if (col0 + bj * 128 >= BINP) continue;
#pragma unroll
            for (int ai = 0; ai < 2; ++ai)
#pragma unroll
                for (int m = 0; m < 4; ++m) {
                    const f32x4 v0 = acc[ai][bj][m][0] * sc, v1 = acc[ai][bj][m][1] * sc;
                    u32x4 w; w.x = pk_bf16(v0.x, v0.y); w.y = pk_bf16(v0.z, v0.w); w.z = pk_bf16(v1.x, v1.y); w.w = pk_bf16(v1.z, v1.w);
                    *(u32x4*)(rp + (size_t)(ai * 128 + m * 16) * BINP + bj * 128) = w;
                }
        }
    }
};
__device__ __forceinline__ void phase_b1(const Ctx& c, size_t raw_off = WS_RAW) {
    bf16_t* RAW = (bf16_t*)(c.ws + raw_off);
    {
        pg8::Gemm g{(const pg8::bf16_t*)(c.ws + WS_H8), (const pg8::bf16_t*)(c.ws + WS_WBIN), T, 1536, D / 2};
        B1Order S{(int)gridDim.x, (int)blockIdx.x, 6, 0}; EpiRaw E{RAW, 0, 1.f / W8_SCALE};
        pg8::gemm_phase<EpiRaw, B1Order, true, true, true>(c.ldsp, g, S, E);
    }
    __syncthreads();
    {
        pg8::Gemm g{(const pg8::bf16_t*)(c.ws + WS_H), (const pg8::bf16_t*)(c.ws + WS_WBIN + 3 * MB), T, 768, D};
        B1Order S{(int)gridDim.x, (int)blockIdx.x, 3, 1}; EpiRaw E{RAW, 1536, 1.f};
        pg8::gemm_phase<EpiRaw, B1Order, true, true, false>(c.ldsp, g, S, E);
    }
}
__device__ __forceinline__ void unpack8(const u32x4 r, float (&e)[8]) { e[0] = bf_lo(r.x); e[1] = bf_hi(r.x); e[2] = bf_lo(r.y); e[3] = bf_hi(r.y); e[4] = bf_lo(r.z); e[5] = bf_hi(r.z); e[6] = bf_lo(r.w); e[7] = bf_hi(r.w); }
__device__ __forceinline__ u32x4 pack8(const float (&e)[8]) { u32x4 o; o.x = pk_bf16(e[0], e[1]); o.y = pk_bf16(e[2], e[3]); o.z = pk_bf16(e[4], e[5]); o.w = pk_bf16(e[6], e[7]); return o; }
__device__ __forceinline__ void phase_rope(const Ctx& c) {
    const bf16_t* RAW = (const bf16_t*)(c.ws + WS_RAW);
    bf16_t* Q = (bf16_t*)(c.ws + WS_Q); bf16_t* K = (bf16_t*)(c.ws + WS_K); bf16_t* V = (bf16_t*)(c.ws + WS_V);
    bf16_t* QI = (bf16_t*)(c.ws + WS_QI); bf16_t* KI = (bf16_t*)(c.ws + WS_KI); float* WI = (float*)(c.ws + WS_WI);
    const int* pos = (const int*)c.a->in[IN_POS];
    LAS float* cs = (LAS float*)(c.lds + c.wave * 256);
    const int gw = c.vb * 4 + c.wave, ngw = c.nb * 4, lane = c.lane;
    const double ex = (lane < 16) ? (double)lane * (1.0 / 16.0) : (double)((lane - 16) & 7) * (1.0 / 8.0);
    const float invf = (float)exp2(-ex * 18.931568569324174);
    for (int t = gw; t < T; t += ngw) {
        if (lane < 24) {
            const float ang = (float)pos[t] * invf;
            const double ad = (double)ang; const double n = rint(ad * 0.15915494309189535); const float red = (float)(ad - n * 6.283185307179586);
            cs[lane] = __cosf(red); cs[32 + lane] = __sinf(red);
        }
        LDS_WAIT();
        const bf16_t* row = RAW + (size_t)t * BINP;
        float rn;
        { const f32x4* pp = (const f32x4*)((const float*)(c.ws + WS_RSS) + (size_t)t * 16); const f32x4 q0 = pp[0], q1 = pp[1], q2 = pp[2], q3 = pp[3];
          const f32x4 qs = (q0 + q1) + (q2 + q3); rn = rsqrtf(((qs.x + qs.y) + (qs.z + qs.w)) * (1.f / D) + EPS); }
        for (int ch = lane; ch < BINP / 8; ch += 64) {
            const u32x4 own = ((const u32x4*)row)[ch];
            float e[8]; unpack8(own, e);
#pragma unroll
            for (int i = 0; i < 8; ++i) e[i] *= rn;
            if (ch < 160) {
                const int cc = ch & 15;
                if (cc < 4) {
                    const u32x4 oth = ((const u32x4*)row)[ch ^ 2]; float p[8]; unpack8(oth, p);
#pragma unroll
                    for (int i = 0; i < 8; ++i) p[i] *= rn;
                    const int f0 = (cc & 1) * 8;
#pragma unroll
                    for (int i = 0; i < 8; ++i) { const float co = cs[f0 + i], si = cs[32 + f0 + i]; e[i] = (cc < 2) ? (e[i] * co - p[i] * si) : (e[i] * co + p[i] * si); }
                }
                u32x2 o8; o8.x = pk_fp8x4(e[0], e[1], e[2], e[3]); o8.y = pk_fp8x4(e[4], e[5], e[6], e[7]);
                if (ch < 128) ((u32x2*)((unsigned char*)Q + (size_t)t * D))[ch] = o8;
                else ((u32x2*)((unsigned char*)K + (size_t)t * 256))[ch - 128] = o8;
            } else if (ch < 192) {
                u32x2 o8; o8.x = pk_fp8x4(e[0], e[1], e[2], e[3]); o8.y = pk_fp8x4(e[4], e[5], e[6], e[7]);
                ((u32x2*)((unsigned char*)V + (size_t)t * 256))[ch - 160] = o8;
            } else if (ch < 264) {
                const int cc = ch & 7;
                if (cc < 2) {
                    const u32x4 oth = ((const u32x4*)row)[ch ^ 1]; float p[8]; unpack8(oth, p);
#pragma unroll
                    for (int i = 0; i < 8; ++i) p[i] *= rn;
#pragma unroll
                    for (int i = 0; i < 8; ++i) { const float co = cs[16 + i], si = cs[32 + 16 + i]; e[i] = (cc == 0) ? (e[i] * co - p[i] * si) : (e[i] * co + p[i] * si); }
                }
                if (ch < 256) ((u32x4*)(QI + (size_t)t * 512))[ch - 192] = pack8(e);
                else ((u32x4*)(KI + (size_t)t * 64))[ch - 256] = pack8(e);
            } else if (ch == 264) {
                f32x4 w0 = {e[0], e[1], e[2], e[3]}, w1 = {e[4], e[5], e[6], e[7]};
                const float sc = 0.044194173824159216f;
                ((f32x4*)(WI + (size_t)t * 8))[0] = w0 * sc; ((f32x4*)(WI + (size_t)t * 8))[1] = w1 * sc;
            }
        }
        LDS_WAIT();
    }
}

__device__ __forceinline__ size_t srow_off(int t) { const int m = t >> 6, r = t & 63; return (size_t)64 * (m + 1) * (32 * m + r); }
constexpr size_t S_BATCH = (size_t)64 * 65 * 2048;
constexpr int SCORE_UNITS = 4 * 312;
__device__ __forceinline__ void phase_score(const Ctx& c) {
    const bf16_t* QI = (const bf16_t*)(c.ws + WS_QI); const bf16_t* KI = (const bf16_t*)(c.ws + WS_KI); const float* WI = (const float*)(c.ws + WS_WI);
    float* S = (float*)(c.ws + WS_S);
    const int lane = c.lane, hf = lane >> 5, col = lane & 31, w = c.wave;
    for (int u = c.vb; u < SCORE_UNITS; u += c.nb) {
        const int b = u & 3, r = u >> 2;
        int kc, qb;
        if (r < 120) { kc = 0; qb = 8 + r; } else if (r < 216) { kc = 1; qb = 32 + (r - 120); } else if (r < 280) { kc = 2; qb = 64 + (r - 216); } else { kc = 3; qb = 96 + (r - 280); }
        const int tb = b * SEQ, t0 = 32 * qb + 8 * w;
        bf16x8 af[2][4]; f32x4 wv[2][4];
        { const int rho = lane & 31, ql = 2 * ((rho >> 2) & 1) + (rho >> 4), hd = 4 * ((rho >> 3) & 1) + (rho & 3);
#pragma unroll
          for (int a = 0; a < 2; ++a) {
              const bf16_t* qp = QI + (size_t)(tb + t0 + 4 * a + ql) * 512 + hd * 64 + 8 * hf;
#pragma unroll
              for (int ks = 0; ks < 4; ++ks) af[a][ks] = *(const bf16x8*)(qp + 16 * ks);
              const float* wp = WI + (size_t)(tb + t0 + 4 * a + 2 * hf) * 8;
#pragma unroll
              for (int i = 0; i < 4; ++i) wv[a][i] = ((const f32x4*)wp)[i];
          } }
        const int ntile = min(32, qb + 1 - 32 * kc), key0 = 1024 * kc;
        float* Sb = S + (size_t)b * S_BATCH;
        size_t ro[2][2];
#pragma unroll
        for (int a = 0; a < 2; ++a) { ro[a][0] = srow_off(t0 + 4 * a + 2 * hf); ro[a][1] = srow_off(t0 + 4 * a + 2 * hf + 1); }
        const int nsub = (ntile + 3) >> 2;
        const bf16_t* krp[4];
        rows_regular<64>(krp, KI + (size_t)(tb + key0) * 64, 64, c.tid);
        __syncthreads();
        stage_tile<64>(c.lds, krp, 0, c.tid);
        for (int sc = 0; sc < 8; ++sc) {
            VM_WAIT();
            __syncthreads();
            const LAS unsigned char* cur = c.lds + (sc & 1) * 16384;
            if (sc + 1 < nsub) stage_tile<64>(c.lds + ((sc + 1) & 1) * 16384, krp, (sc + 1) * 128 * 64, c.tid);
#pragma unroll
            for (int j = 0; j < 4; ++j) {
                const int kt = 4 * sc + j;
                if (sc < nsub && kt < ntile) {
                    const int key = key0 + 32 * kt + col, row = 32 * j + col;
                    bf16x8 cb[4];
#pragma unroll
                    for (int ks = 0; ks < 4; ++ks) cb[ks] = *(const LAS bf16x8*)(cur + row * 128 + (((2 * ks + hf) ^ (row & 7)) << 4));
#pragma unroll
                    for (int a = 0; a < 2; ++a) {
                        f32x16 acc = {};
#pragma unroll
                        for (int ks = 0; ks < 4; ++ks) acc = __builtin_amdgcn_mfma_f32_32x32x16_bf16(af[a][ks], cb[ks], acc, 0, 0, 0);
                        float s0 = fmaxf(acc[0], 0.f) * wv[a][0].x; s0 += fmaxf(acc[1], 0.f) * wv[a][0].y; s0 += fmaxf(acc[2], 0.f) * wv[a][0].z; s0 += fmaxf(acc[3], 0.f) * wv[a][0].w;
                        s0 += fmaxf(acc[4], 0.f) * wv[a][1].x; s0 += fmaxf(acc[5], 0.f) * wv[a][1].y; s0 += fmaxf(acc[6], 0.f) * wv[a][1].z; s0 += fmaxf(acc[7], 0.f) * wv[a][1].w;
                        float s1 = fmaxf(acc[8], 0.f) * wv[a][2].x; s1 += fmaxf(acc[9], 0.f) * wv[a][2].y; s1 += fmaxf(acc[10], 0.f) * wv[a][2].z; s1 += fmaxf(acc[11], 0.f) * wv[a][2].w;
                        s1 += fmaxf(acc[12], 0.f) * wv[a][3].x; s1 += fmaxf(acc[13], 0.f) * wv[a][3].y; s1 += fmaxf(acc[14], 0.f) * wv[a][3].z; s1 += fmaxf(acc[15], 0.f) * wv[a][3].w;
                        const int tA = t0 + 4 * a + 2 * hf;
                        Sb[ro[a][0] + key] = (key <= tA) ? s0 : -INFINITY;
                        Sb[ro[a][1] + key] = (key <= tA + 1) ? s1 : -INFINITY;
                    }
                }
            }
        }
    }
}

constexpr int NBINS = 2048, CAND_CAP = 256, SEL_WAVE_LDS = 8192 + 2048 + 64;
__device__ __forceinline__ int clamp_bin(int x) { return min(max(x, 0), NBINS - 1); }
__device__ __forceinline__ void phase_select(const Ctx& c) {
    const float* S = (const float*)(c.ws + WS_S); int* SEL = (int*)(c.ws + WS_SEL);
    LAS int* hist = (LAS int*)(c.lds + c.wave * SEL_WAVE_LDS);
    LAS float* candv = (LAS float*)(hist + NBINS);
    LAS int* candi = (LAS int*)(candv + CAND_CAP);
    LAS int* thr = candi + CAND_CAP;
    const int gw = c.vb * 4 + c.wave, ngw = c.nb * 4;
    LAS unsigned char* cscr = c.lds + 4 * SEL_WAVE_LDS + c.wave * TR_SCR; static_assert(4 * SEL_WAVE_LDS + 4 * TR_SCR <= LDS_MAIN, "select lds");
    int cit = gw, rcount = 0;
    for (int j = gw; j < 4 * 3840; j += ngw) {
        int lane = c.lane;
        asm volatile("" : "+v"(lane));
        const int b = j & 3, t = 4095 - (j >> 2), ni = (t + 64) >> 6;
        const float* row = S + (size_t)b * S_BATCH + srow_off(t);
        float s[64];
#pragma unroll
        for (int g4 = 0; g4 < 4; ++g4) {
            if (16 * g4 < ni) {
#pragma unroll
                for (int i = 16 * g4; i < 16 * g4 + 16; ++i) { const int k = 64 * i + lane; const float v = row[min(k, t)]; s[i] = (k <= t) ? v : -INFINITY; }
            } else {
#pragma unroll
                for (int i = 16 * g4; i < 16 * g4 + 16; ++i) s[i] = -INFINITY;
            }
        }
        float mn = INFINITY, mx = -INFINITY;
#pragma unroll
        for (int g8 = 0; g8 < 8; ++g8) if (8 * g8 < ni) {
#pragma unroll
            for (int i = 8 * g8; i < 8 * g8 + 8; ++i) { mx = fmaxf(mx, s[i]); mn = fminf(mn, (s[i] == -INFINITY) ? INFINITY : s[i]); }
        }
#pragma unroll
        for (int o = 1; o < 64; o <<= 1) { mx = fmaxf(mx, __shfl_xor(mx, o)); mn = fminf(mn, __shfl_xor(mn, o)); }
        const float sc = (mx > mn) ? (float)NBINS / (mx - mn) : 0.f, a0 = -mn * sc;
#pragma unroll
        for (int i = 0; i < 8; ++i) ((LAS u32x4*)hist)[lane * 8 + i] = (u32x4){0u, 0u, 0u, 0u};
        LDS_WAIT();
#define BINOF(v) clamp_bin((int)__builtin_fmaf((v), sc, a0))
#pragma unroll
        for (int g8 = 0; g8 < 8; ++g8) if (8 * g8 < ni) {
#pragma unroll
            for (int i = 8 * g8; i < 8 * g8 + 8; ++i) lds_inc(&hist[BINOF(s[i])]);
        }
        LDS_WAIT();
        int bs, need;
        {
            const LAS int* hq = hist + lane * 32;
            u32x4 hr[8];
            int loc = 0;
#pragma unroll
            for (int i = 0; i < 8; ++i) { hr[i] = ((const LAS u32x4*)hq)[i]; loc += (int)(hr[i].x + hr[i].y + hr[i].z + hr[i].w); }
            int suf = loc;
#pragma unroll
            for (int o = 1; o < 64; o <<= 1) { const int v = __shfl_down(suf, o); if (lane + o < 64) suf += v; }
            const int above = suf - loc;
            const bool cross = (above < 256 && suf >= 256);
            int bsl = 0, abl = 0;
            { int run = above;
#pragma unroll
              for (int i = 31; i >= 0; --i) { const int h = (int)hr[i >> 2][i & 3]; const bool hit = (run < 256 && run + h >= 256); bsl = hit ? lane * 32 + i : bsl; abl = hit ? run : abl; run += h; } }
            const unsigned long long cm = __ballot(cross);
            const int src = cm ? (int)__builtin_ctzll(cm) : 0;
            bs = __shfl(bsl, src); need = 256 - __shfl(abl, src);
        }
        int bs2 = -1;
#define SUBOF(v) clamp_bin((int)((__builtin_fmaf((v), sc, a0) - (float)bs) * (float)NBINS))
        if (__shfl(hist[bs], 0) > 48) {
#pragma unroll
            for (int i = 0; i < 8; ++i) ((LAS u32x4*)hist)[lane * 8 + i] = (u32x4){0u, 0u, 0u, 0u};
            LDS_WAIT();
#pragma unroll
            for (int i = 0; i < 64; ++i) if (s[i] != -INFINITY && BINOF(s[i]) == bs) lds_inc(&hist[SUBOF(s[i])]);
            LDS_WAIT();
            const LAS int* hq = hist + lane * 32;
            int loc = 0;
#pragma unroll
            for (int i = 0; i < 8; ++i) { const u32x4 h4 = ((const LAS u32x4*)hq)[i]; loc += (int)(h4.x + h4.y + h4.z + h4.w); }
            int suf = loc;
#pragma unroll
            for (int o = 1; o < 64; o <<= 1) { const int v = __shfl_down(suf, o); if (lane + o < 64) suf += v; }
            const int above = suf - loc;
            const bool cross = (above < need && suf >= need);
            int bsl = 0, abl = 0;
            if (cross) { int run = above; for (int i = 31; i >= 0; --i) { const int h = hq[i]; if (run < need && run + h >= need) { bsl = lane * 32 + i; abl = run; } run += h; } }
            const unsigned long long cm = __ballot(cross);
            const int src = cm ? (int)__builtin_ctzll(cm) : 0;
            bs2 = __shfl(bsl, src); need = need - __shfl(abl, src);
        }
        asm volatile("" : "+v"(lane));
        float sc2 = sc, a02 = a0;
        asm volatile("" : "+v"(sc2), "+v"(a02));
#undef BINOF
#define BINOF(v) clamp_bin((int)__builtin_fmaf((v), sc2, a02))
        int* selr = SEL + ((size_t)b * SEQ + t) * 256;
        int nc = 0, base = 0;
#pragma unroll
        for (int g4 = 0; g4 < 4; ++g4) if (16 * g4 < ni) {
#pragma unroll
            for (int i = 16 * g4; i < 16 * g4 + 16; ++i) {
                const int bn = BINOF(s[i]);
                bool pc = (bn == bs) && (s[i] != -INFINITY), pd = (bn > bs);
                if (bs2 >= 0) { const int sb = SUBOF(s[i]); pd = pd || (pc && sb > bs2); pc = pc && (sb == bs2); }
                const unsigned long long md = __ballot(pd), mc = __ballot(pc);
                const int posd = base + (int)__builtin_amdgcn_mbcnt_hi((unsigned)(md >> 32), __builtin_amdgcn_mbcnt_lo((unsigned)md, 0u));
                const int posc = nc + (int)__builtin_amdgcn_mbcnt_hi((unsigned)(mc >> 32), __builtin_amdgcn_mbcnt_lo((unsigned)mc, 0u));
                if (pd && posd < 256) selr[posd] = 64 * i + lane;
                if (pc && posc < CAND_CAP) { candv[posc] = s[i]; candi[posc] = 64 * i + lane; }
                base += (int)__popcll(md); nc += (int)__popcll(mc);
            }
        }
        nc = min(nc, CAND_CAP);
        LDS_WAIT();
        for (int i = lane; i < nc; i += 64) {
            const float v = candv[i]; const int id = candi[i];
            int rank = 0;
            for (int k = 0; k < nc; ++k) { const float vk = candv[k]; const int ik = candi[k]; rank += (vk > v || (vk == v && ik < id)) ? 1 : 0; }
            if (rank < need && base + rank < 256) selr[base + rank] = id;
        }
        LDS_WAIT();
#undef BINOF
#undef SUBOF
        if ((rcount & 1) && cit < NE * 192) { convert_moe_item(c, 1, cit, cscr); cit += ngw; }
        ++rcount;
    }
    for (; cit < NE * 192; cit += ngw) convert_moe_item(c, 1, cit, cscr);
}

typedef short s16x4 __attribute__((ext_vector_type(4)));
__device__ __forceinline__ unsigned vimg_f(unsigned r) { return ((r & 3u) << 2) | ((r >> 2) & 3u); }
__device__ __forceinline__ void tr_read8(const unsigned (&ad)[8], s16x4 (&r)[8]) {
    asm volatile("ds_read_b64_tr_b16 %0, %8\n\tds_read_b64_tr_b16 %1, %9\n\tds_read_b64_tr_b16 %2, %10\n\tds_read_b64_tr_b16 %3, %11\n\t"
                 "ds_read_b64_tr_b16 %4, %12\n\tds_read_b64_tr_b16 %5, %13\n\tds_read_b64_tr_b16 %6, %14\n\tds_read_b64_tr_b16 %7, %15\n\ts_waitcnt lgkmcnt(0)"
                 : "=&v"(r[0]), "=&v"(r[1]), "=&v"(r[2]), "=&v"(r[3]), "=&v"(r[4]), "=&v"(r[5]), "=&v"(r[6]), "=&v"(r[7])
                 : "v"(ad[0]), "v"(ad[1]), "v"(ad[2]), "v"(ad[3]), "v"(ad[4]), "v"(ad[5]), "v"(ad[6]), "v"(ad[7]) : "memory");
}
__device__ __forceinline__ void tr_read8_b8(const unsigned (&ad)[8], s16x4 (&r)[8]) {
    asm volatile("ds_read_b64_tr_b8 %0, %8\n\tds_read_b64_tr_b8 %1, %9\n\tds_read_b64_tr_b8 %2, %10\n\tds_read_b64_tr_b8 %3, %11\n\t"
                 "ds_read_b64_tr_b8 %4, %12\n\tds_read_b64_tr_b8 %5, %13\n\tds_read_b64_tr_b8 %6, %14\n\tds_read_b64_tr_b8 %7, %15\n\ts_waitcnt lgkmcnt(0)"
                 : "=&v"(r[0]), "=&v"(r[1]), "=&v"(r[2]), "=&v"(r[3]), "=&v"(r[4]), "=&v"(r[5]), "=&v"(r[6]), "=&v"(r[7])
                 : "v"(ad[0]), "v"(ad[1]), "v"(ad[2]), "v"(ad[3]), "v"(ad[4]), "v"(ad[5]), "v"(ad[6]), "v"(ad[7]) : "memory");
}
constexpr int ATT_WAVE_LDS = 19456;
__device__ __forceinline__ void phase_attn(const Ctx& c) {
    const bf16_t* Q = (const bf16_t*)(c.ws + WS_Q); const bf16_t* K = (const bf16_t*)(c.ws + WS_K); const bf16_t* V = (const bf16_t*)(c.ws + WS_V);
    const int* SEL = (const int*)(c.ws + WS_SEL); bf16_t* O = (bf16_t*)(c.ws + WS_O);
    LAS unsigned char* wl = c.lds + c.wave * ATT_WAVE_LDS;
    LAS int* sl = (LAS int*)wl;
    LAS unsigned short* pT = (LAS unsigned short*)(wl + 1024);
    LAS unsigned char* vb = wl + 3072;
    const int lane = c.lane, fr = lane & 15, fq = lane >> 4;
    const int gw = c.vb * 4 + c.wave, ngw = c.nb * 4;
    unsigned tro[8];
    { const unsigned row = 8u * fq + ((unsigned)fr >> 1);
#pragma unroll
      for (int c2 = 0; c2 < 8; ++c2) tro[c2] = 128u * row + 16u * ((unsigned)c2 ^ (row & 7u)) + 8u * ((unsigned)fr & 1u); }
    const unsigned vb_addr = (unsigned)(size_t)vb;
    int tcount = 0, cit = gw;
    const bool xsplit = (c.nb % 128) == 0;
    const int xg = (c.vb >> 6) & 1, wi0 = xsplit ? (((c.vb >> 7) * 64 + (c.vb & 63)) * 4 + c.wave) : gw, wstride = xsplit ? ngw / 2 : ngw;
    const unsigned chunkoff = (((unsigned)lane & 7u) ^ (((unsigned)lane >> 3) & 7u)) << 4;
    unsigned trh[8];
    { const unsigned row = 8u * (fq & 1) + ((unsigned)fr >> 1);
#pragma unroll
      for (int c2 = 0; c2 < 8; ++c2) trh[c2] = 128u * row + 16u * ((unsigned)c2 ^ (row & 7u)) + 8u * ((unsigned)fr & 1u); }
#define SEL_PREFETCH(tg_) __builtin_amdgcn_global_load_lds((const unsigned*)(SEL + (size_t)(tg_) * 256 + lane * 4), (LAS unsigned*)((LAS unsigned char*)sl + lane * 16), 16, 0, 0)
    const int task_end = xsplit ? T : T * 2;
    if (wi0 < task_end) { SEL_PREFETCH(xsplit ? wi0 : (wi0 >> 1)); }
    for (int task = wi0; task < task_end; task += wstride) {
        const int tg = xsplit ? task : (task >> 1), g = xsplit ? xg : (task & 1), b = tg >> 12, t = tg & 4095, tb = b * SEQ;
        const int nsel = min(256, t + 1), nch = (nsel + 31) >> 5;
        asm volatile("s_waitcnt vmcnt(0)" ::: "memory");
        unsigned koff[32];
#pragma unroll
        for (int q = 0; q < 32; ++q) { const int s_ = 8 * q + (lane >> 3); int idx = sl[s_]; idx = (t < 256) ? s_ : idx; idx = (s_ < nsel && (unsigned)idx <= (unsigned)t) ? idx : 0; koff[q] = (unsigned)idx * 256u + chunkoff; }
        i64x2 qf[2];
        { const unsigned char* qp = (const unsigned char*)Q + (size_t)tg * D + (4 * g + (fr >> 2)) * 128 + 16 * fq;
#pragma unroll
          for (int i = 0; i < 2; ++i) qf[i] = *(const i64x2*)(qp + 64 * i); }
        asm volatile("s_waitcnt vmcnt(0) lgkmcnt(0)" ::: "memory");
        asm volatile("" : "+v"(qf[0]), "+v"(qf[1]));
        { const int tn = task + wstride; if (tn < task_end) SEL_PREFETCH(xsplit ? tn : (tn >> 1)); }
        const unsigned char* kbase = (const unsigned char*)K + (size_t)tb * 256 + g * 128;
        const unsigned char* vbase = (const unsigned char*)V + (size_t)tb * 256 + g * 128;
#define CH_GATHER(cidx) do { const unsigned char* bp_ = ((cidx) < 16) ? kbase : vbase; _Pragma("unroll") for (int i_ = 0; i_ < 2; ++i_) { \
            unsigned o_ = koff[2 * ((cidx) & 15) + i_]; asm volatile("" : "+v"(o_));     \
            __builtin_amdgcn_global_load_lds((const unsigned*)(bp_ + o_), (LAS unsigned*)(vb + ((cidx) & 7) * 2048 + i_ * 1024 + lane * 16), 16, 0, 0); } } while (0)
        float lg[16];
#pragma unroll
        for (int c0 = 0; c0 < 6; ++c0) CH_GATHER(c0);
#pragma unroll
        for (int ch = 0; ch < 16; ++ch) {
            asm volatile("s_waitcnt lgkmcnt(0)" ::: "memory");
            CH_GATHER(ch + 6);
            asm volatile("s_waitcnt vmcnt(12)" ::: "memory");
            const LAS unsigned char* kb = vb + (ch & 7) * 2048;
            f32x4 acc = {0.f, 0.f, 0.f, 0.f};
#pragma unroll
            for (int i = 0; i < 2; ++i) { const i64x2 kf = *(const LAS i64x2*)(kb + 128u * fr + 16u * ((4u * i + fq) ^ ((unsigned)fr & 7u)));
                acc = __builtin_amdgcn_mfma_f32_16x16x32_fp8_fp8(qf[i].x, kf.x, acc, 0, 0, 0); acc = __builtin_amdgcn_mfma_f32_16x16x32_fp8_fp8(qf[i].y, kf.y, acc, 0, 0, 0); }
            lg[ch] = (ch * 16 + fr < nsel) ? acc.x * 0.08838834764831845f : -INFINITY;
        }
        float mx = lg[0];
#pragma unroll
        for (int kt = 1; kt < 16; ++kt) mx = fmaxf(mx, lg[kt]);
#pragma unroll
        for (int o = 1; o < 16; o <<= 1) mx = fmaxf(mx, __shfl_xor(mx, o));
        float sm = 0.f;
#pragma unroll
        for (int kt = 0; kt < 16; ++kt) { lg[kt] = __expf(lg[kt] - mx); sm += lg[kt]; }
#pragma unroll
        for (int o = 1; o < 16; o <<= 1) sm += __shfl_xor(sm, o);
        { const float inv = 256.f / sm;
#pragma unroll
          for (int kt = 0; kt < 16; ++kt) { const float pv = lg[kt] * inv; ((LAS unsigned char*)pT)[fq * 256 + kt * 16 + fr] = (unsigned char)(pk_fp8x4_nc(pv, pv, pv, pv) & 0xffu); } }
        f32x4 oacc[8];
#pragma unroll
        for (int c2 = 0; c2 < 8; ++c2) oacc[c2] = (f32x4){0.f, 0.f, 0.f, 0.f};
#pragma unroll
        for (int p = 0; p < 8; ++p) {
            asm volatile("s_waitcnt lgkmcnt(0)" ::: "memory");
            if (16 + 2 * p + 6 < 32) { CH_GATHER(16 + 2 * p + 6); CH_GATHER(16 + 2 * p + 7); }
            if (p < 5) asm volatile("s_waitcnt vmcnt(12)" ::: "memory"); else if (p == 5) asm volatile("s_waitcnt vmcnt(8)" ::: "memory");
            else if (p == 6) asm volatile("s_waitcnt vmcnt(4)" ::: "memory"); else asm volatile("s_waitcnt vmcnt(0)" ::: "memory");
            if (p < nch) {
                const long pa = *(const LAS long*)((const LAS unsigned char*)pT + (fr >> 2) * 256 + 32 * p + 8 * fq);
                const unsigned cb = vb_addr + (unsigned)(((16 + 2 * p) & 7) + (fq >> 1)) * 2048u;
                unsigned ad[8]; s16x4 r0[8];
#pragma unroll
                for (int i = 0; i < 8; ++i) ad[i] = cb + trh[i];
                tr_read8_b8(ad, r0);
#pragma unroll
                for (int c2 = 0; c2 < 8; ++c2) oacc[c2] = __builtin_amdgcn_mfma_f32_16x16x32_fp8_fp8(pa, __builtin_bit_cast(long, r0[c2]), oacc[c2], 0, 0, 0);
            }
        }
        { unsigned char* op = (unsigned char*)O + (size_t)tg * D + (4 * g + fq) * 128 + fr;
#pragma unroll
          for (int c2 = 0; c2 < 8; ++c2) { const float ov = oacc[c2].x * (O8_SCALE / 256.f); op[16 * c2] = (unsigned char)(pk_fp8x4(ov, ov, ov, ov) & 0xffu); } }
        LDS_WAIT();
#undef CH_GATHER
        ++tcount;
    }
}

__device__ __forceinline__ void phase_b4(const Ctx& c, bool dry = false) {
    bf16_t* H = (bf16_t*)(c.ws + WS_H);
    pg8::Gemm g{(const pg8::bf16_t*)(c.ws + WS_O), (const pg8::bf16_t*)(c.ws + WS_WBOUT), T, D, D / 2};
    pg8::StaticOrder S; S.init(T, D, (int)gridDim.x, (int)blockIdx.x);
    EpiResH<false> E{H, dry ? (bf16_t*)(c.ws + 440 * MB) : H, 1.f / (W8_SCALE * O8_SCALE)};
    pg8::gemm_phase<EpiResH<false>, pg8::StaticOrder, true, true, true>(c.ldsp, g, S, E);
}

constexpr int NPHASE = 22;
__global__ void __launch_bounds__(NTHP, 2) mk_fwd(Args args) {
    extern __shared__ __attribute__((aligned(16))) unsigned char lds_raw[];
    Ctx c;
    { const int pt = threadIdx.x; c.half = __builtin_amdgcn_readfirstlane(pt >> 8); c.tid = pt & 255; c.lane = pt & 63; c.wave = __builtin_amdgcn_readfirstlane(pt >> 6) & 3; }
    c.ldsp = (LAS unsigned char*)lds_raw; c.lds = c.ldsp + c.half * LDS_HALF;
    c.nb = 2 * gridDim.x; { const int bx = blockIdx.x, G = gridDim.x; c.vb = 2 * ((G % 8 == 0) ? (bx % 8) * (G / 8) + bx / 8 : bx) + c.half; }
    c.a = (const __attribute__((address_space(4))) Args*)__builtin_amdgcn_kernarg_segment_ptr(); c.ws = args.ws;
    volatile LAS unsigned* st = (volatile LAS unsigned*)((LAS unsigned char*)lds_raw + LDS_BYTES - 16);
    const bool multi = (args.ph_hi - args.ph_lo) > 1;
    XcdBarrier bar; bar.bar = (unsigned*)(c.ws + WS_CTL); bar.x = 0; bar.st = st;
    if (multi) {
        if (threadIdx.x == 0) { st[0] = 0u; st[1] = 0u; }
        __syncthreads();
        bar = xcd_barrier_post((unsigned*)(c.ws + WS_CTL), st);
    }
    const int ph_lo = args.ph_lo, ph_hi = args.ph_hi;
#ifndef PH_MASK
#define PH_MASK 0x3fffff
#endif
#define PHON(k) ((PH_MASK >> (k)) & 1)
#define PHASE(k, body) do { if (PHON(k) && ph_lo <= (k) && (k) < ph_hi) { \
        { int t_ = threadIdx.x, vb_ = __builtin_amdgcn_readfirstlane(c.vb); \
          const __attribute__((address_space(4))) Args* ka = (const __attribute__((address_space(4))) Args*)__builtin_amdgcn_kernarg_segment_ptr(); \
          asm volatile("" : "+v"(t_), "+s"(vb_), "+s"(ka)); \
          c.tid = t_ & 255; c.lane = t_ & 63; c.wave = __builtin_amdgcn_readfirstlane(t_ >> 6) & 3; c.vb = vb_; c.a = ka; c.ws = ka->ws; } \
        body; \
        if (MK_REP == (k)) { __syncthreads(); body; } \
        if ((k) + 1 < ph_hi) xcd_barrier(bar); \
        if ((k) == 3) { for (int xb_ = 0; xb_ < MK_XBAR; ++xb_) xcd_barrier(bar); } } } while (0)
    PHASE(0, phase_prep(c));
    PHASE(1, phase_a1(c));
    PHASE(2, { if (MK_DRY == 2) { phase_a2(c, true); __syncthreads(); } phase_a2(c); });
    PHASE(3, phase_a3(c));
    PHASE(4, { if (MK_DRY == 4) { phase_route(c, 0, true); __syncthreads(); } phase_route(c, 0); });
    PHASE(5, phase_e1(c, 0));
    PHASE(6, phase_e2(c, 0));
    PHASE(7, { if (MK_DRY == 7) { phase_p1(c, 0, true); __syncthreads(); } phase_p1(c, 0); });
    PHASE(8, { if (MK_DRY == 8) { phase_p2(c, 0, true); __syncthreads(); } phase_p2(c, 0); });
    PHASE(10, phase_b1(c));
    PHASE(11, phase_rope(c));
    PHASE(12, phase_score(c));
    PHASE(13, phase_select(c));
    PHASE(14, phase_attn(c));
    PHASE(15, { if (MK_DRY == 15) { phase_b4(c, true); __syncthreads(); } phase_b4(c); });
    PHASE(16, phase_route(c, 1));
    PHASE(17, phase_e1(c, 1));
    PHASE(18, phase_e2(c, 1));
    PHASE(19, phase_p1(c, 1));
    PHASE(20, phase_p2(c, 1));
    PHASE(21, phase_final(c));
}

#ifdef MK_DUMP
__global__ void dump_k(const unsigned char* ws, float* out) {
    const size_t i = (size_t)blockIdx.x * 256 + threadIdx.x;
#if MK_DUMP == 1
    ((f32x4*)out)[i] = ((const f32x4*)(ws + WS_H))[i];
#elif MK_DUMP == 2
    { const u32x2 v = ((const u32x2*)(ws + WS_O))[i]; f32x4 o = {bf_lo(v.x), bf_hi(v.x), bf_lo(v.y), bf_hi(v.y)}; ((f32x4*)out)[i] = o; }
#elif MK_DUMP == 3
    { const int* sp = (const int*)(ws + WS_SEL); f32x4 o = {0.f,0.f,0.f,0.f}; if (i < (size_t)T * 64) { o.x = (float)sp[4*i]; o.y = (float)sp[4*i+1]; o.z = (float)sp[4*i+2]; o.w = (float)sp[4*i+3]; } ((f32x4*)out)[i] = o; }
#elif MK_DUMP == 5
    { const u32x2 v = ((const u32x2*)(ws + WS_XN))[i]; f32x4 o = {bf_lo(v.x), bf_hi(v.x), bf_lo(v.y), bf_hi(v.y)}; ((f32x4*)out)[i] = o; }
#elif MK_DUMP == 6
    { const u32x2 v = ((const u32x2*)(ws + WS_RAW))[i]; f32x4 o = {bf_lo(v.x), bf_hi(v.x), bf_lo(v.y), bf_hi(v.y)}; ((f32x4*)out)[i] = o; }
#elif MK_DUMP == 7
    { f32x4 o = {0.f,0.f,0.f,0.f}; if (i < (size_t)BINP * D / 4) { const u32x2 v = ((const u32x2*)(ws + WS_WBIN))[i]; o = (f32x4){bf_lo(v.x), bf_hi(v.x), bf_lo(v.y), bf_hi(v.y)}; } ((f32x4*)out)[i] = o; }
#elif MK_DUMP == 8
    { const u32x2 v = ((const u32x2*)(ws + WS_RAW))[i], w = ((const u32x2*)(ws + 458 * MB))[i]; f32x4 o = {bf_lo(v.x) - bf_lo(w.x), bf_hi(v.x) - bf_hi(w.x), bf_lo(v.y) - bf_lo(w.y), bf_hi(v.y) - bf_hi(w.y)}; ((f32x4*)out)[i] = o; }
#elif MK_DUMP == 9
    { const u32x2 v = ((const u32x2*)(ws + WS_RAW))[i], w = ((const u32x2*)(ws + 458 * MB))[i]; f32x4 o = {(v.x & 0xffffu) != (w.x & 0xffffu) ? 1.f : 0.f, (v.x >> 16) != (w.x >> 16) ? 1.f : 0.f, (v.y & 0xffffu) != (w.y & 0xffffu) ? 1.f : 0.f, (v.y >> 16) != (w.y >> 16) ? 1.f : 0.f}; ((f32x4*)out)[i] = o; }
#elif MK_DUMP == 4
    { const u32x2 v = ((const u32x2*)(ws + WS_Q))[i]; f32x4 o = {bf_lo(v.x), bf_hi(v.x), bf_lo(v.y), bf_hi(v.y)}; ((f32x4*)out)[i] = o; }
#endif
}
#endif
extern "C" void kernel_launch(void* const* d_in, const int* in_sizes, int n_in, void* d_out, int out_size, void* d_ws, size_t ws_size, hipStream_t stream) {
    static int grid = 0;
    if (grid == 0) {
        if (n_in != 23 || out_size != T * D || ws_size < WS_TOTAL) { fprintf(stderr, "kernel_launch: unexpected sizes n_in %d out %d ws %zu (need %zu)\n", n_in, out_size, ws_size, (size_t)WS_TOTAL); grid = -1; return; }
        int dev = 0, cus = 0, per_cu = 0;
        hipGetDevice(&dev); hipDeviceGetAttribute(&cus, hipDeviceAttributeMultiprocessorCount, dev);
        hipFuncSetAttribute((const void*)mk_fwd, hipFuncAttributeMaxDynamicSharedMemorySize, LDS_BYTES);
        hipOccupancyMaxActiveBlocksPerMultiprocessor(&per_cu, (const void*)mk_fwd, NTHP, LDS_BYTES);
        (void)hipGetLastError();
        if (per_cu < 1) per_cu = 1;
        if (per_cu > 1) per_cu = 1;
        grid = cus * per_cu;
    }
    if (grid < 0) return;
    hipMemsetAsync((char*)d_ws + WS_CTL, 0, 16384, stream);
    Args a{};
    for (int i = 0; i < 23; ++i) a.in[i] = d_in[i];
    a.out = (float*)d_out; a.ws = (unsigned char*)d_ws;
#if MK_ONE_LAUNCH
    a.ph_lo = 0; a.ph_hi = NPHASE;
    hipLaunchKernelGGL(mk_fwd, dim3(grid), dim3(NTHP), LDS_BYTES, stream, a);
#else
    for (int ph = 0; ph <= MK_LAST_PHASE; ++ph) { a.ph_lo = ph; a.ph_hi = ph + 1; hipLaunchKernelGGL(mk_fwd, dim3(grid), dim3(NTHP), LDS_BYTES, stream, a); }
#ifdef MK_DUMP
    hipLaunchKernelGGL(dump_k, dim3(T * D / 4 / 256), dim3(256), 0, stream, (const unsigned char*)d_ws, (float*)d_out);
#endif
#endif
}
```

```cpp
#include <hip/hip_runtime.h>
#include <stdint.h>
#include <stdio.h>

#ifndef MK_LAST_PHASE
#define MK_LAST_PHASE 21
#endif
#ifndef MK_REP
#define MK_REP -1
#endif
#ifndef MK_XBAR
#define MK_XBAR 0
#endif
#ifndef MK_DRY
#define MK_DRY -1
#endif
#ifndef MK_ONE_LAUNCH
#define MK_ONE_LAUNCH 1
#endif

#define LAS __attribute__((address_space(3)))
typedef unsigned short bf16_t;
typedef short bf16x8 __attribute__((ext_vector_type(8)));
typedef float f32x4 __attribute__((ext_vector_type(4)));
typedef float f32x2 __attribute__((ext_vector_type(2)));
typedef float f32x16 __attribute__((ext_vector_type(16)));
typedef unsigned u32x4 __attribute__((ext_vector_type(4)));
typedef unsigned u32x2 __attribute__((ext_vector_type(2)));
typedef long i64x2 __attribute__((ext_vector_type(2)));
typedef int i32x4 __attribute__((ext_vector_type(4)));
typedef int i32x8 __attribute__((ext_vector_type(8)));

constexpr int T = 16384, D = 1024, SEQ = 4096;
constexpr int GW = 2048;
constexpr int BIN = 2120, BINP = 2176;
constexpr int NE = 32, DE = 512;
constexpr int PLE = 256;
constexpr float EPS = 1e-6f;
constexpr int NTH = 256;
constexpr int LDS_MAIN = 4 * 19456;
constexpr int LDS_HALF = LDS_MAIN + 1024;
constexpr int LDS_BYTES = 2 * LDS_HALF;
constexpr int NTHP = 512;
constexpr int RPAD = 32768 + NE * 256;

constexpr size_t MB = 1024 * 1024;
constexpr size_t WS_CTL = 0;
constexpr size_t WS_TAB = 416 * 1024;
constexpr size_t WS_CNT = 448 * 1024;
constexpr int NSUB = 32, SUBCAP = T / NSUB, CNT_STRIDE = 32;
static_assert(WS_CNT >= 32768 + 2 * 1024 * 48 * 4 && WS_CNT + (size_t)4 * NSUB * 32 * CNT_STRIDE * 4 <= 1024 * 1024, "cnt");
constexpr size_t WS_WR = 32768;
constexpr size_t WS_WAIN = 1 * MB;
constexpr size_t WS_WAOUT = WS_WAIN + 8 * MB;
constexpr size_t WS_WBIN = WS_WAOUT + 4 * MB;
constexpr size_t WS_WBOUT = WS_WBIN + 5 * MB;
constexpr size_t WS_WGATE = WS_WBOUT + 2 * MB;
constexpr size_t WS_WPROJ = WS_WGATE + 4 * MB;
constexpr size_t WS_W1 = WS_WPROJ + 1 * MB;
constexpr size_t WS_H8 = WS_W1;
constexpr size_t WS_XN8 = WS_W1 + 16 * MB;
constexpr size_t WS_W3 = WS_W1 + 32 * MB;
constexpr size_t WS_W2 = WS_W3 + 32 * MB;
constexpr size_t WS_PBF = WS_W2 + 32 * MB;
constexpr size_t WS_XN = WS_PBF + 16 * MB;
constexpr size_t WS_H = WS_XN + 32 * MB;
constexpr size_t WS_LIST = WS_H + 64 * MB;
constexpr size_t WS_GATE = WS_LIST + 2 * MB;
constexpr size_t WS_TOKSLOT = WS_GATE + 2 * MB;
constexpr size_t WS_GROW = WS_TOKSLOT + 512 * 1024;
constexpr size_t WS_SCR = WS_TOKSLOT + 1 * MB;
constexpr size_t WS_U = WS_SCR;
constexpr size_t WS_VT = WS_SCR + 64 * MB;
constexpr size_t WS_VSS = WS_SCR + 128 * MB;
constexpr size_t WS_HMID = WS_SCR;
constexpr size_t WS_Y = WS_SCR + 36 * MB;
constexpr size_t WS_RAW = WS_SCR;
constexpr size_t WS_O = WS_SCR;
constexpr size_t WS_Q = WS_SCR + 68 * MB;
constexpr size_t WS_K = WS_Q + 32 * MB;
constexpr size_t WS_V = WS_K + 8 * MB;
constexpr size_t WS_QI = WS_V + 8 * MB;
constexpr size_t WS_KI = WS_QI + 16 * MB;
constexpr size_t WS_WI = WS_KI + 2 * MB;
constexpr size_t WS_SEL = WS_WI + 1 * MB;
constexpr size_t WS_END = WS_SEL + 16 * MB;
constexpr size_t WS_RSS = WS_END;
static_assert(WS_RSS + 1 * MB <= WS_SCR + 152 * MB, "scratch");
constexpr size_t WS_CST = 392 * MB;
constexpr size_t WS_S = 392 * MB;
constexpr size_t WS_TOTAL = 522 * MB;

typedef __bf16 bf16x2_t __attribute__((ext_vector_type(2)));
__device__ __forceinline__ unsigned pk_bf16(float lo, float hi) { f32x2 v = {lo, hi}; bf16x2_t b = __builtin_convertvector(v, bf16x2_t); return __builtin_bit_cast(unsigned, b); }
__device__ __forceinline__ float bf_lo(unsigned u) { return __uint_as_float(u << 16); }
__device__ __forceinline__ float bf_hi(unsigned u) { return __uint_as_float(u & 0xffff0000u); }
__device__ __forceinline__ float wave_sum(float v) {
#pragma unroll
    for (int o = 1; o < 64; o <<= 1) v += __shfl_xor(v, o);
    return v;
}
__device__ __forceinline__ int lds_inc(LAS int* p) { return __hip_atomic_fetch_add(p, 1, __ATOMIC_RELAXED, __HIP_MEMORY_SCOPE_WORKGROUP); }
#define LDS_WAIT() asm volatile("s_waitcnt lgkmcnt(0)" ::: "memory")
#define VM_WAIT() asm volatile("s_waitcnt vmcnt(0)" ::: "memory")

#define XB_TMO      128
#define XB_XCNT(j)  (256  + 64 * (j))
#define XB_XSUB(j)  (1280 + 64 * (j))
#define XB_XGEN(j)  (2304 + 64 * (j))
#define XB_TOP      3328
#define XB_TOPGEN   3392
#define XCD_BAR_WORDS 3456
#define XB_SPIN_CAP (1u << 20)
__device__ __forceinline__ unsigned xb_ld(unsigned* p)              { return __hip_atomic_load(p, __ATOMIC_RELAXED, __HIP_MEMORY_SCOPE_AGENT); }
__device__ __forceinline__ unsigned xb_add(unsigned* p, unsigned v) { return __hip_atomic_fetch_add(p, v, __ATOMIC_RELAXED, __HIP_MEMORY_SCOPE_AGENT); }
__device__ __forceinline__ unsigned xb_xcc_id() { return (unsigned)__builtin_amdgcn_s_getreg((3 << 11) | 20) & 0xFu; }
#define XB_SPIN(cond, bar) do { unsigned _sp = 0; while (cond) { __builtin_amdgcn_s_sleep(1); \
    if ((++_sp & 255u) == 0u) { if (xb_ld(&(bar)[XB_TMO])) break; if (_sp > XB_SPIN_CAP) { atomicAdd(&(bar)[XB_TMO], 1u); break; } } } } while (0)
struct XcdBarrier { unsigned* bar; unsigned x; volatile LAS unsigned* st; };
__device__ __forceinline__ XcdBarrier xcd_barrier_post(unsigned* bar, volatile LAS unsigned* st) {
    XcdBarrier b; b.bar = bar; b.x = xb_xcc_id(); b.st = st;
    if (threadIdx.x == 0) (void)xb_add(&bar[XB_XCNT(b.x)], 1u);
    return b;
}
__device__ __forceinline__ void xcd_barrier_complete(unsigned* bar, unsigned x, unsigned& nloc, unsigned& nx) {
    const unsigned G = gridDim.x;
    unsigned sum, cnt, mine, sp = 0u;
    for (;;) {
        sum = 0u; cnt = 0u; mine = 0u;
#pragma unroll
        for (unsigned j = 0; j < 16; ++j) { const unsigned c = xb_ld(&bar[XB_XCNT(j)]); sum += c; cnt += (c > 0u) ? 1u : 0u; mine = (j == x) ? c : mine; }
        if (sum == G) break;
        __builtin_amdgcn_s_sleep(1);
        if ((++sp & 255u) == 0u) { if (xb_ld(&bar[XB_TMO])) break; if (sp > XB_SPIN_CAP) { atomicAdd(&bar[XB_TMO], 1u); break; } }
    }
    nloc = mine > 0u ? mine : 1u; nx = cnt > 0u ? cnt : 1u;
}
__device__ __forceinline__ void xcd_barrier(const XcdBarrier& b) {
    asm volatile("s_waitcnt vmcnt(0)" ::: "memory");
    __syncthreads();
    if (threadIdx.x == 0) {
        unsigned* bar = b.bar;
        __builtin_amdgcn_s_waitcnt(0);
        unsigned nloc = b.st[0], nx = b.st[1];
        if (nloc == 0u) { xcd_barrier_complete(bar, b.x, nloc, nx); b.st[0] = nloc; b.st[1] = nx; }
        const unsigned old = xb_add(&bar[XB_XSUB(b.x)], 1u);
        const unsigned gen = old / nloc;
        if (old + 1u == (gen + 1u) * nloc) {
            __builtin_amdgcn_fence(__ATOMIC_RELEASE, "agent");
            asm volatile("s_waitcnt vmcnt(0)" ::: "memory");
            const unsigned og = xb_add(&bar[XB_TOP], 1u);
            if (og + 1u != (gen + 1u) * nx) XB_SPIN(xb_ld(&bar[XB_TOP]) < (gen + 1u) * nx, bar);
        } else {
            XB_SPIN(xb_ld(&bar[XB_TOP]) < (gen + 1u) * nx, bar);
        }
        __builtin_amdgcn_fence(__ATOMIC_ACQUIRE, "agent");
        asm volatile("s_waitcnt vmcnt(0)" ::: "memory");
    }
    __syncthreads();
}

struct Args { const void* in[23]; float* out; unsigned char* ws; int ph_lo, ph_hi; };
enum { IN_X = 0, IN_P, IN_POS, IN_MIXN, IN_AWIN, IN_AVG, IN_AWS, IN_ABS, IN_AWOUT, IN_BWIN, IN_BWOUT, IN_FFNN, IN_WG, IN_BG, IN_WE, IN_BE,
       IN_W1, IN_W3, IN_W2, IN_PLEN, IN_PLEG, IN_PLEP, IN_FINN };

struct Ctx {
    LAS unsigned char* lds;
    int tid, lane, wave, vb, nb, half;
    LAS unsigned char* ldsp;
    const __attribute__((address_space(4))) Args* a;
    unsigned char* ws;
};

template <int BK> struct TileK { static constexpr int NP = (BK == 64) ? 4 : 2; static constexpr int TB = 128 * BK * 2; };

template <int BK>
__device__ __forceinline__ void stage_tile(LAS unsigned char* tile, const bf16_t* const (&rp)[TileK<BK>::NP], int k0, int tid) {
    const int lc = (BK == 64) ? ((tid & 7) ^ ((tid >> 3) & 7)) : ((tid & 3) ^ ((tid >> 3) & 3));
#pragma unroll
    for (int p = 0; p < TileK<BK>::NP; ++p)
        __builtin_amdgcn_global_load_lds((const unsigned*)(rp[p] + k0 + lc * 8), (LAS unsigned*)(tile + p * 4096 + tid * 16), 16, 0, 0);
}
template <int BK>
__device__ __forceinline__ void rows_regular(const bf16_t* (&rp)[TileK<BK>::NP], const bf16_t* base, size_t ld, int tid) {
#pragma unroll
    for (int p = 0; p < TileK<BK>::NP; ++p) { const int r = (BK == 64) ? (p * 32 + (tid >> 3)) : (p * 64 + (tid >> 2)); rp[p] = base + (size_t)r * ld; }
}
template <int BK>
__device__ __forceinline__ int frag_off(int row, int ks, int fq) {
    return (BK == 64) ? (row * 128 + (((ks * 4 + fq) ^ (row & 7)) << 4)) : (row * 64 + ((fq ^ ((row >> 1) & 3)) << 4));
}

template <int BK, int NBOP, bool SWAP, bool FP8 = false>
__device__ __forceinline__ void gemm_loop(const Ctx& c, const bf16_t* const (&ap)[TileK<BK>::NP], const bf16_t* const (&b0p)[TileK<BK>::NP], const bf16_t* const (&b1p)[TileK<BK>::NP],
                                          int K, f32x4 (&acc0)[4][4], f32x4 (&acc1)[4][4]) {
    constexpr int TB = TileK<BK>::TB, SB = (1 + NBOP) * TB;
    static_assert(2 * SB <= LDS_MAIN, "lds");
    const int nk = K / BK, tid = c.tid;
    const int fr = c.lane & 15, fq = c.lane >> 4, wr = c.wave >> 1, wc = c.wave & 1;
    LAS unsigned char* lds = c.lds;
    stage_tile<BK>(lds, ap, 0, tid); stage_tile<BK>(lds + TB, b0p, 0, tid);
    if (NBOP == 2) stage_tile<BK>(lds + 2 * TB, b1p, 0, tid);
    for (int kt = 0; kt < nk; ++kt) {
        VM_WAIT();
        __syncthreads();
        LAS unsigned char* cur = lds + (kt & 1) * SB;
        if (kt + 1 < nk) {
            LAS unsigned char* nxt = lds + ((kt + 1) & 1) * SB;
            stage_tile<BK>(nxt, ap, (kt + 1) * BK, tid); stage_tile<BK>(nxt + TB, b0p, (kt + 1) * BK, tid);
            if (NBOP == 2) stage_tile<BK>(nxt + 2 * TB, b1p, (kt + 1) * BK, tid);
        }
#pragma unroll
        for (int ks = 0; ks < BK / 32; ++ks) {
            bf16x8 af[4], bf0[4], bf1[4];
#pragma unroll
            for (int m = 0; m < 4; ++m) af[m] = *(const LAS bf16x8*)(cur + frag_off<BK>(wr * 64 + m * 16 + fr, ks, fq));
#pragma unroll
            for (int n = 0; n < 4; ++n) bf0[n] = *(const LAS bf16x8*)(cur + TB + frag_off<BK>(wc * 64 + n * 16 + fr, ks, fq));
            if (NBOP == 2) {
#pragma unroll
                for (int n = 0; n < 4; ++n) bf1[n] = *(const LAS bf16x8*)(cur + 2 * TB + frag_off<BK>(wc * 64 + n * 16 + fr, ks, fq));
            }
#pragma unroll
            for (int m = 0; m < 4; ++m)
#pragma unroll
                for (int n = 0; n < 4; ++n) {
                    if (FP8) {
                        const i64x2 a2 = __builtin_bit_cast(i64x2, af[m]), b2 = __builtin_bit_cast(i64x2, bf0[n]);
                        if (SWAP) { acc0[m][n] = __builtin_amdgcn_mfma_f32_16x16x32_fp8_fp8(b2.x, a2.x, acc0[m][n], 0, 0, 0); acc0[m][n] = __builtin_amdgcn_mfma_f32_16x16x32_fp8_fp8(b2.y, a2.y, acc0[m][n], 0, 0, 0); }
                        else      { acc0[m][n] = __builtin_amdgcn_mfma_f32_16x16x32_fp8_fp8(a2.x, b2.x, acc0[m][n], 0, 0, 0); acc0[m][n] = __builtin_amdgcn_mfma_f32_16x16x32_fp8_fp8(a2.y, b2.y, acc0[m][n], 0, 0, 0); }
                        continue;
                    }
                    if (SWAP) acc0[m][n] = __builtin_amdgcn_mfma_f32_16x16x32_bf16(bf0[n], af[m], acc0[m][n], 0, 0, 0);
                    else      acc0[m][n] = __builtin_amdgcn_mfma_f32_16x16x32_bf16(af[m], bf0[n], acc0[m][n], 0, 0, 0);
                    if (NBOP == 2) {
                        if (SWAP) acc1[m][n] = __builtin_amdgcn_mfma_f32_16x16x32_bf16(bf1[n], af[m], acc1[m][n], 0, 0, 0);
                        else      acc1[m][n] = __builtin_amdgcn_mfma_f32_16x16x32_bf16(af[m], bf1[n], acc1[m][n], 0, 0, 0);
                    }
                }
        }
    }
    __syncthreads();
}
__device__ __forceinline__ void zero_acc(f32x4 (&acc)[4][4]) {
#pragma unroll
    for (int m = 0; m < 4; ++m)
#pragma unroll
        for (int n = 0; n < 4; ++n) acc[m][n] = (f32x4){0.f, 0.f, 0.f, 0.f};
}
__device__ __forceinline__ void map_unit(int u, int nnt, int& mt, int& nt) { const int per = 8 * nnt, band = u / per, r = u - band * per; nt = r >> 3; mt = band * 8 + (r & 7); }


__device__ __forceinline__ float gelu_tanh(float x) {
    const float y2 = 1.5957691216057308f * (x + 0.044715f * x * x * x);
    return x * __builtin_amdgcn_rcpf(1.f + __expf(-y2));
}
__device__ __forceinline__ float sigmoidf_(float x) { return __builtin_amdgcn_rcpf(1.f + __expf(-x)); }
__device__ __forceinline__ f32x4 sigmoid4(f32x4 x) {
    const f32x4 t = x * (-1.4426950408889634f);
    f32x4 e; e.x = __builtin_amdgcn_exp2f(t.x); e.y = __builtin_amdgcn_exp2f(t.y); e.z = __builtin_amdgcn_exp2f(t.z); e.w = __builtin_amdgcn_exp2f(t.w);
    const f32x4 d = e + 1.f;
    f32x4 r; r.x = __builtin_amdgcn_rcpf(d.x); r.y = __builtin_amdgcn_rcpf(d.y); r.z = __builtin_amdgcn_rcpf(d.z); r.w = __builtin_amdgcn_rcpf(d.w);
    return r;
}
__device__ __forceinline__ f32x4 gelu_tanh4(f32x4 x) {
    const f32x4 t = ((x * x) * (-1.5957691216057308f * 0.044715f * 1.4426950408889634f) + (-1.5957691216057308f * 1.4426950408889634f)) * x;
    f32x4 e; e.x = __builtin_amdgcn_exp2f(t.x); e.y = __builtin_amdgcn_exp2f(t.y); e.z = __builtin_amdgcn_exp2f(t.z); e.w = __builtin_amdgcn_exp2f(t.w);
    const f32x4 d = e + 1.f;
    f32x4 r; r.x = __builtin_amdgcn_rcpf(d.x); r.y = __builtin_amdgcn_rcpf(d.y); r.z = __builtin_amdgcn_rcpf(d.z); r.w = __builtin_amdgcn_rcpf(d.w);
    return x * r;
}

__device__ __forceinline__ void row_load(const float* row, int lane, f32x4 (&v)[4]) {
#pragma unroll
    for (int j = 0; j < 4; ++j) v[j] = ((const f32x4*)row)[lane + 64 * j];
}
__device__ __forceinline__ void row_load_h(const bf16_t* row, int lane, f32x4 (&v)[4]) {
#pragma unroll
    for (int j = 0; j < 4; ++j) { const u32x2 w = ((const u32x2*)row)[lane + 64 * j]; v[j] = (f32x4){bf_lo(w.x), bf_hi(w.x), bf_lo(w.y), bf_hi(w.y)}; }
}
__device__ __forceinline__ float row_sumsq(const f32x4 (&v)[4]) {
    float s = 0.f;
#pragma unroll
    for (int j = 0; j < 4; ++j) s += (v[j].x * v[j].x + v[j].y * v[j].y) + (v[j].z * v[j].z + v[j].w * v[j].w);
    return wave_sum(s);
}
__device__ __forceinline__ void gain_load(const float* gain, int lane, f32x4 (&g)[4]) {
#pragma unroll
    for (int j = 0; j < 4; ++j) g[j] = ((const f32x4*)gain)[lane + 64 * j];
}
__device__ __forceinline__ void row_store_norm_bf16(bf16_t* orow, int lane, const f32x4 (&v)[4], float r, const f32x4 (&gv)[4]) {
#pragma unroll
    for (int j = 0; j < 4; ++j) {
        const f32x4 g = gv[j];
        u32x2 o; o.x = pk_bf16(v[j].x * r * g.x, v[j].y * r * g.y); o.y = pk_bf16(v[j].z * r * g.z, v[j].w * r * g.w);
        ((u32x2*)orow)[lane + 64 * j] = o;
    }
}

__device__ __forceinline__ void row_store_h(bf16_t* orow, int lane, const f32x4 (&v)[4]) {
#pragma unroll
    for (int j = 0; j < 4; ++j) { u32x2 o; o.x = pk_bf16(v[j].x, v[j].y); o.y = pk_bf16(v[j].z, v[j].w); ((u32x2*)orow)[lane + 64 * j] = o; }
}
__device__ __forceinline__ unsigned pk_fp8x4(float a, float b, float c_, float d);
__device__ __forceinline__ void row_store_norm_fp8(unsigned char* orow, int lane, const f32x4 (&v)[4], float r, const f32x4 (&gv)[4]) {
#pragma unroll
    for (int j = 0; j < 4; ++j) ((unsigned*)orow)[lane + 64 * j] = pk_fp8x4(v[j].x * r * gv[j].x, v[j].y * r * gv[j].y, v[j].z * r * gv[j].z, v[j].w * r * gv[j].w);
}
constexpr int TR_SCR = 64 * 136;
__device__ __forceinline__ void transpose_item(const float* W, int K, int N, int nvalid, int ldw, bf16_t* WT, LAS unsigned char* scr, int item, int lane, const float* kg = nullptr) {
    const int nblk = N / 64, kb = item / nblk, nb = item - kb * nblk, k0 = 64 * kb, n0 = 64 * nb;
    const int n = n0 + 4 * (lane & 15);
    const int nc_ = (n < nvalid) ? n : 0; const float keep = (n < nvalid) ? 1.f : 0.f;
    f32x4 v[16];
#pragma unroll
    for (int i = 0; i < 16; ++i) v[i] = *(const f32x4*)(W + (size_t)(k0 + 4 * i + (lane >> 4)) * ldw + nc_);
#pragma unroll
    for (int i = 0; i < 16; ++i) {
        const int kk = 4 * i + (lane >> 4); const float kp = kg ? keep * kg[k0 + kk] : keep;
        u32x2 o; o.x = pk_bf16(v[i].x * kp, v[i].y * kp); o.y = pk_bf16(v[i].z * kp, v[i].w * kp);
        *(LAS u32x2*)(scr + kk * 136 + (lane & 15) * 8) = o;
    }
    LDS_WAIT();
    const int cc = lane & 7;
#pragma unroll
    for (int j = 0; j < 8; ++j) {
        const int nn = (lane >> 3) + 8 * j; const LAS unsigned short* sp = (const LAS unsigned short*)(scr + (8 * cc) * 136 + nn * 2);
        u32x4 o;
        o.x = (unsigned)sp[0 * 68] | ((unsigned)sp[1 * 68] << 16); o.y = (unsigned)sp[2 * 68] | ((unsigned)sp[3 * 68] << 16);
        o.z = (unsigned)sp[4 * 68] | ((unsigned)sp[5 * 68] << 16); o.w = (unsigned)sp[6 * 68] | ((unsigned)sp[7 * 68] << 16);
        *(u32x4*)(WT + (size_t)(n0 + nn) * K + k0 + 8 * cc) = o;
    }
    LDS_WAIT();
}

__device__ __forceinline__ unsigned pk_fp8x4(float a, float b, float c_, float d) {
    a = fminf(fmaxf(a, -448.f), 448.f); b = fminf(fmaxf(b, -448.f), 448.f); c_ = fminf(fmaxf(c_, -448.f), 448.f); d = fminf(fmaxf(d, -448.f), 448.f);
    int p = __builtin_amdgcn_cvt_pk_fp8_f32(a, b, 0, false);
    p = __builtin_amdgcn_cvt_pk_fp8_f32(c_, d, p, true);
    return (unsigned)p;
}
__device__ __forceinline__ unsigned pk_fp8x4_nc(float a, float b, float c_, float d) {
    int p = __builtin_amdgcn_cvt_pk_fp8_f32(a, b, 0, false);
    p = __builtin_amdgcn_cvt_pk_fp8_f32(c_, d, p, true);
    return (unsigned)p;
}
constexpr float W8_SCALE = 64.f, H8_SCALE = 4.f, O8_SCALE = 8.f, Y8_SCALE = 16.f;
__device__ __forceinline__ void transpose_item8(const float* W, int K, int N, unsigned char* WT, LAS unsigned char* scr, int item, int lane, int nvalid = 1 << 30, int ldw = 0, const float* kg = nullptr) {
    const int nblk = N / 64, kb = item / nblk, nb = item - kb * nblk, k0 = 128 * kb, n0 = 64 * nb;
    const int n = n0 + 4 * (lane & 15), ld = ldw ? ldw : N, nc_ = (n < nvalid) ? n : 0; const float keep = (n < nvalid) ? W8_SCALE : 0.f;
#pragma unroll 2
    for (int h = 0; h < 2; ++h) {
        f32x4 v[16];
#pragma unroll
        for (int i = 0; i < 16; ++i) v[i] = *(const f32x4*)(W + (size_t)(k0 + 64 * h + 4 * i + (lane >> 4)) * ld + nc_);
#pragma unroll
        for (int i = 0; i < 16; ++i) { const int kk = 64 * h + 4 * i + (lane >> 4); const float kp = kg ? keep * kg[k0 + kk] : keep;
            *(LAS unsigned*)(scr + kk * 68 + (lane & 15) * 4) = (kg ? pk_fp8x4(v[i].x * kp, v[i].y * kp, v[i].z * kp, v[i].w * kp) : pk_fp8x4_nc(v[i].x * kp, v[i].y * kp, v[i].z * kp, v[i].w * kp)); }
    }
    LDS_WAIT();
    const int cc = lane & 7;
#pragma unroll
    for (int j = 0; j < 8; ++j) {
        const int nn = (lane >> 3) + 8 * j; const LAS unsigned char* sp = scr + (16 * cc) * 68 + nn;
        unsigned w[4];
#pragma unroll
        for (int q = 0; q < 4; ++q) w[q] = (unsigned)sp[(4 * q + 0) * 68] | ((unsigned)sp[(4 * q + 1) * 68] << 8) | ((unsigned)sp[(4 * q + 2) * 68] << 16) | ((unsigned)sp[(4 * q + 3) * 68] << 24);
        u32x4 o = {w[0], w[1], w[2], w[3]};
        *(u32x4*)(WT + (size_t)(n0 + nn) * K + k0 + 16 * cc) = o;
    }
    LDS_WAIT();
}
__device__ __forceinline__ void convert_moe_item(const Ctx& c, int l, int it, LAS unsigned char* scr) {
    const float* w1 = (const float*)c.a->in[IN_W1] + (size_t)l * NE * D * DE;
    const float* w3 = (const float*)c.a->in[IN_W3] + (size_t)l * NE * D * DE;
    const float* w2 = (const float*)c.a->in[IN_W2] + (size_t)l * NE * DE * D;
    unsigned char* W3 = c.ws + WS_W3; unsigned char* W2 = c.ws + WS_W2;
    const int e = it / 192, r = it - e * 192;
    if (r < 64)       transpose_item8(w1 + (size_t)e * D * DE, D, DE, W3 + ((size_t)e * 1024 + ((r & 7) >> 1) * 128) * D, scr, r, c.lane);
    else if (r < 128) transpose_item8(w3 + (size_t)e * D * DE, D, DE, W3 + ((size_t)e * 1024 + ((r & 7) >> 1) * 128 + 128) * D, scr, r - 64, c.lane);
    else              transpose_item8(w2 + (size_t)e * DE * D, DE, D, W2 + (size_t)e * D * DE, scr, r - 128, c.lane);
}
__device__ __forceinline__ void convert_moe_layer(const Ctx& c, int l) {
    LAS unsigned char* scr = c.lds + c.wave * TR_SCR;
    const int gw = c.vb * 4 + c.wave, ngw = c.nb * 4;
    for (int it = gw; it < NE * 192; it += ngw) convert_moe_item(c, l, it, scr);
}

__device__ __forceinline__ void phase_prep(const Ctx& c) {
    const __attribute__((address_space(4))) Args& a = *c.a;
    LAS unsigned char* scr = c.lds + c.wave * TR_SCR;
    const int gw = c.vb * 4 + c.wave, ngw = c.nb * 4;
    constexpr int I_AIN = 16 * 64, I_AOUT = 32 * 16, I_PP = 4 * 16, I_BIN8 = 8 * 34, I_BOUT8 = 8 * 16, I_PG8 = 8 * 16, I_BINI = 16 * 10;
    constexpr int NIT = I_AIN + I_AOUT + 2 * I_PP + I_BIN8 + I_BOUT8 + 2 * I_PG8 + I_BINI;
    for (int it = gw; it < NIT; it += ngw) {
        int r = it;
        if (r < I_AIN) { transpose_item((const float*)a.in[IN_AWIN], D, 4096, 4096, 4096, (bf16_t*)(c.ws + WS_WAIN), scr, r, c.lane); continue; } r -= I_AIN;
        if (r < I_AOUT) { transpose_item((const float*)a.in[IN_AWOUT], GW, D, D, D, (bf16_t*)(c.ws + WS_WAOUT), scr, r, c.lane); continue; } r -= I_AOUT;
        if (r < 2 * I_PP) { const int l = r / I_PP; transpose_item((const float*)a.in[IN_PLEP] + (size_t)l * PLE * D, PLE, D, D, D, (bf16_t*)(c.ws + WS_WPROJ) + (size_t)l * D * PLE, scr, r - l * I_PP, c.lane); continue; } r -= 2 * I_PP;
        if (r < I_BIN8) { transpose_item8((const float*)a.in[IN_BWIN], D, BINP, c.ws + WS_WBIN, scr, r, c.lane, BIN, BIN, (const float*)a.in[IN_MIXN] + D); continue; } r -= I_BIN8;
        if (r < I_BOUT8) { transpose_item8((const float*)a.in[IN_BWOUT], D, D, c.ws + WS_WBOUT, scr, r, c.lane); continue; } r -= I_BOUT8;
        if (r < 2 * I_PG8) { const int l = r / I_PG8; transpose_item8((const float*)a.in[IN_PLEG] + (size_t)l * D * D, D, D, c.ws + WS_WGATE + (size_t)l * D * D, scr, r - l * I_PG8, c.lane); continue; } r -= 2 * I_PG8;
        transpose_item((const float*)a.in[IN_BWIN] + 1536, D, 640, BIN - 1536, BIN, (bf16_t*)(c.ws + WS_WBIN + 3 * MB), scr, r, c.lane, (const float*)a.in[IN_MIXN] + D);
    }
    const int gt = c.vb * NTH + c.tid, ngt = c.nb * NTH;
    { const float* p = (const float*)a.in[IN_P]; bf16_t* pb = (bf16_t*)(c.ws + WS_PBF);
      for (int i = gt; i < 2 * T * PLE / 8; i += ngt) {
          const f32x4 v0 = ((const f32x4*)p)[2 * i], v1 = ((const f32x4*)p)[2 * i + 1];
          u32x4 o; o.x = pk_bf16(v0.x, v0.y); o.y = pk_bf16(v0.z, v0.w); o.z = pk_bf16(v1.x, v1.y); o.w = pk_bf16(v1.z, v1.w);
          ((u32x4*)pb)[i] = o; } }
    { float* wr = (float*)(c.ws + WS_WR);
      for (int i = gt; i < 2 * D * 48; i += ngt) {
          const int l = i / (D * 48), r = i - l * D * 48, k = r / 48, o = r - k * 48;
          float w = 0.f;
          if (o < 4) w = ((const float*)a.in[IN_WG])[(size_t)l * D * 4 + k * 4 + o];
          else if (o < 36) w = ((const float*)a.in[IN_WE])[(size_t)l * D * 32 + k * 32 + (o - 4)];
          const int kh = k >> 9, ii = (k >> 5) & 15, q = (k >> 3) & 3, e = k & 7, nt = o >> 4, m = o & 15;
          wr[(size_t)l * D * 48 + ((((kh * 16 + ii) * 3 + nt) * 64 + q * 16 + m) << 3) + e] = w * ((const float*)a.in[IN_FFNN])[l * D + k]; } }
    if (c.vb == 0) for (int i = c.tid; i < 4 * NSUB * 32; i += 256) ((int*)(c.ws + WS_CNT))[i * CNT_STRIDE] = 0;
    { const int* pos = (const int*)a.in[IN_POS]; float* cst = (float*)(c.ws + WS_CST);
      for (int i = gt; i < T * 24; i += ngt) {
          const int t = i / 24, f = i - t * 24;
          const double ex = (f < 16) ? (double)f * (1.0 / 16.0) : (double)(f - 16) * (1.0 / 8.0);
          const float invf = (float)exp2(-ex * 18.931568569324174);
          const float ang = (float)pos[t] * invf;
          const double ad = (double)ang; const double n = rint(ad * 0.15915494309189535); const float red = (float)(ad - n * 6.283185307179586);
          cst[(size_t)t * 64 + f] = __cosf(red); cst[(size_t)t * 64 + 32 + f] = __sinf(red); } }
    f32x4 gv[4]; gain_load((const float*)a.in[IN_MIXN], c.lane, gv);
    const int nheavy = (NIT > ngw && NIT - ngw < ngw / 2) ? NIT - ngw : 0;
    if (gw >= nheavy) for (int t = gw - nheavy; t < T; t += ngw - nheavy) {
        f32x4 v[4]; row_load((const float*)a.in[IN_X] + (size_t)t * D, c.lane, v);
        const float r = rsqrtf(row_sumsq(v) * (1.f / D) + EPS);
        row_store_norm_bf16((bf16_t*)(c.ws + WS_XN) + (size_t)t * D, c.lane, v, r, gv);
    }
}

namespace pg8 {
#define PG8_LAS __attribute__((address_space(3)))
typedef unsigned short bf16_t;
typedef short bf16x8 __attribute__((ext_vector_type(8)));
typedef float f32x4 __attribute__((ext_vector_type(4)));
typedef unsigned u32x4 __attribute__((ext_vector_type(4)));
constexpr int BM = 256, BK = 64, HALF = 128, HTB = HALF * BK * 2  , STAGE_BYTES = 8 * HTB, NXCD = 8, WGM = 8;

__host__ __device__ __forceinline__ int lds_byte(int r, int c) { const int st = (r >> 4) * 2 + (c >> 5), rr = r & 15, cc = c & 31, ob = rr * 64 + cc * 2; return st * 1024 + (ob ^ (((ob >> 9) & 1) << 5)); }
__host__ __device__ __forceinline__ void stage_rc(int b, int& R, int& C) { const int st = b / 1024, sb = b % 1024, swz = sb ^ (((sb >> 9) & 1) << 5); R = (st >> 1) * 16 + swz / 64; C = (st & 1) * 32 + (swz % 64) / 2; }
__host__ __device__ __forceinline__ int perm32(int rho) { const int n = rho >> 4, i = rho & 15; return 8 * (i >> 2) + 4 * n + (i & 3); }

struct Unit { int pm, pn, aux; };
struct Gemm { const bf16_t* A; const bf16_t* Bt; int M, N, K; };

struct StaticOrder {
    int nM, nN, nwg, G, c;
    __host__ __device__ void init(int M, int N, int G_, int c_) { nM = M / BM; nN = N / BM; nwg = nM * nN; G = G_; c = c_; }
    __host__ __device__ bool next(int i, Unit& u) const {
        const long L = (long)i * G + c; if (L >= nwg) return false;
        int wgid = (int)L; { const int q = nwg / NXCD, r = nwg % NXCD, xcd = wgid % NXCD, off = wgid / NXCD; wgid = (xcd < r ? xcd * (q + 1) : r * (q + 1) + (xcd - r) * q) + off; }
        const int nig = WGM * nN, gid = wgid / nig, fm = gid * WGM, gsz = (nM - fm) < WGM ? (nM - fm) : WGM;
        u.pm = fm + ((wgid % nig) % gsz); u.pn = (wgid % nig) / gsz; return true;
    }
    __device__ __forceinline__ void a_ready(const Unit&) const {}
    __device__ __forceinline__ void done(const Unit&) const {}
};


template <class Epi, class Sched, bool ALIGN_EPI = false, bool SP2 = false, bool FP8 = false, bool GATHER = false>
__device__ __forceinline__ void gemm_phase(PG8_LAS unsigned char* lds, const Gemm g, const Sched& S, const Epi& E, const PG8_LAS unsigned* gtab = nullptr) {
    int tido_ = threadIdx.x; asm volatile("" : "+v"(tido_));
    const int tid = tido_, wid = __builtin_amdgcn_readfirstlane(tid >> 6), lane = tid & 63, wr = wid >> 2, wc = wid & 3, fr = lane & 15, fq = lane >> 4;
    int Kop_ = g.K; asm volatile("" : "+s"(Kop_));
    const int K = Kop_, nt = K / BK;
    unsigned voffA[2], voffB[2];
#pragma unroll
    for (int i = 0; i < 2; ++i) { int R, C; stage_rc(tid * 16 + i * 8192, R, C);
        const int Rb = Epi::W16 ? (64 * (R >> 5) + 16 * ((R & 15) >> 2) + 4 * ((R >> 4) & 1) + (R & 3)) : (Epi::PERM ? ((R & ~31) + perm32(R & 31)) : R);
        voffA[i] = GATHER ? (unsigned)(R * 4 + C * 2 * 65536) : (unsigned)(R * K + C) * 2u; voffB[i] = (unsigned)(Rb * K + C) * 2u; }
    unsigned gA[2][2] = {{0u, 0u}, {0u, 0u}};
#define PG8_GLOAD(slot) do { _Pragma("unroll") for (int h_ = 0; h_ < 2; ++h_) _Pragma("unroll") for (int i_ = 0; i_ < 2; ++i_) \
        gA[h_][i_] = *(const PG8_LAS unsigned*)((const PG8_LAS unsigned char*)gtab + (slot) * 1024 + h_ * 512 + (voffA[i_] & 0xffffu)) + (voffA[i_] >> 16); } while (0)
#define PG8_STA(bufoff, base, h) do { if constexpr (GATHER) PG8_STAGE(bufoff, base, gA[h]); else PG8_STAGE(bufoff, (base) + (h) * hstep, voffA); } while (0)
    const size_t kstep = (size_t)(BK * 2);
    const size_t hstep = (size_t)HALF * K * 2;
    const size_t hstepB = Epi::W16 ? (size_t)8 * K * 2 : hstep;
    const size_t tstep = 2 * hstep;
    const unsigned ldsw = (unsigned)wid * 1024u;
    const int aoff = lds_byte(wr * 64 + fr, fq * 8), boff = lds_byte(wc * 32 + fr, fq * 8);
#define PG8_SA(b, h) (((b) * 2 + (h)) * HTB)
#define PG8_SB(b, h) ((4 + (b) * 2 + (h)) * HTB)
#define PG8_STAGE(bufoff, gbase, voff) do { _Pragma("unroll") for (int _i = 0; _i < 2; ++_i) \
        __builtin_amdgcn_global_load_lds((const unsigned*)((const char*)(gbase) + (voff)[_i]), (PG8_LAS unsigned*)(lds + (bufoff) + ldsw + _i * 8192), 16, 0, 0); } while (0)
#define PG8_LDA(dst, b, h) do { _Pragma("unroll") for (int m = 0; m < 4; ++m) dst[m] = __builtin_shufflevector(*(const PG8_LAS i32x4*)(lds + PG8_SA(b, h) + aoff + m * 2048), *(const PG8_LAS i32x4*)(lds + PG8_SA(b, h) + aoff + m * 2048 + 1024), 0, 1, 2, 3, 4, 5, 6, 7); } while (0)
#define PG8_LDB(dst, b, h) do { _Pragma("unroll") for (int n = 0; n < 2; ++n) dst[n] = __builtin_shufflevector(*(const PG8_LAS i32x4*)(lds + PG8_SB(b, h) + boff + n * 2048), *(const PG8_LAS i32x4*)(lds + PG8_SB(b, h) + boff + n * 2048 + 1024), 0, 1, 2, 3, 4, 5, 6, 7); } while (0)
#define PG8_MMA(ai, bj, At, Bt) do { __builtin_amdgcn_s_setprio(1); _Pragma("unroll") for (int m = 0; m < 4; ++m) _Pragma("unroll") for (int n = 0; n < 2; ++n) { \
        if constexpr (FP8)      \
            asm volatile("v_mfma_scale_f32_16x16x128_f8f6f4 %0, %1, %2, %0, %3, %3 op_sel_hi:[0,0,0]" : "+v"(acc[ai][bj][m][n]) : "v"(Bt[n]), "v"(At[m]), "v"(one8_)); \
        else { acc[ai][bj][m][n] = __builtin_amdgcn_mfma_f32_16x16x32_bf16(__builtin_bit_cast(bf16x8, __builtin_shufflevector(Bt[n], Bt[n], 0, 1, 2, 3)), __builtin_bit_cast(bf16x8, __builtin_shufflevector(At[m], At[m], 0, 1, 2, 3)), acc[ai][bj][m][n], 0, 0, 0); \
               acc[ai][bj][m][n] = __builtin_amdgcn_mfma_f32_16x16x32_bf16(__builtin_bit_cast(bf16x8, __builtin_shufflevector(Bt[n], Bt[n], 4, 5, 6, 7)), __builtin_bit_cast(bf16x8, __builtin_shufflevector(At[m], At[m], 4, 5, 6, 7)), acc[ai][bj][m][n], 0, 0, 0); } } __builtin_amdgcn_s_setprio(0); } while (0)
#define PG8_WAIT_V(n) asm volatile("s_waitcnt vmcnt(" #n ")" ::: "memory")
#define PG8_WAIT_L(n) asm volatile("s_waitcnt lgkmcnt(" #n ")" ::: "memory")
#define PG8_BAR __builtin_amdgcn_s_barrier()
#define PG8_SCHED __builtin_amdgcn_sched_barrier(0)
    Unit cur, nxt; int ui = 0;
    if (!S.next(0, cur)) return;
    int one8_ = 0x7f7f7f7f; asm volatile("" : "+v"(one8_));
    f32x4 acc[2][2][4][2];
    float zf_ = 0.f; asm volatile("" : "+v"(zf_));
#pragma unroll
    for (int a = 0; a < 2; ++a)
#pragma unroll
        for (int b = 0; b < 2; ++b)
#pragma unroll
            for (int m = 0; m < 4; ++m)
#pragma unroll
                for (int n = 0; n < 2; ++n) acc[a][b][m][n] = (f32x4){zf_, zf_, zf_, zf_};
    i32x8 At[4], B0[2], B1[2];
    const char* cA = (const char*)g.A + (GATHER ? (size_t)0 : (size_t)cur.pm * tstep); const char* cB = (const char*)g.Bt + (size_t)cur.pn * tstep;
    S.a_ready(cur);
    if constexpr (GATHER) PG8_GLOAD(cur.pm);
    if constexpr (SP2) {
        PG8_STAGE(PG8_SB(0, 0), cB, voffB); PG8_STAGE(PG8_SB(0, 1), cB + hstepB, voffB); PG8_STA(PG8_SA(0, 0), cA, 0); PG8_STA(PG8_SA(0, 1), cA, 1);
        if (wr == 1) PG8_BAR;
        PG8_WAIT_V(2); PG8_BAR;
        PG8_STAGE(PG8_SB(1, 0), cB + kstep, voffB); PG8_STA(PG8_SA(1, 0), cA + kstep, 0); PG8_STAGE(PG8_SB(1, 1), cB + hstepB + kstep, voffB);
        PG8_WAIT_V(6); PG8_BAR;
    } else {
        PG8_STAGE(PG8_SB(0, 0), cB, voffB); PG8_STA(PG8_SA(0, 0), cA, 0); PG8_STAGE(PG8_SB(0, 1), cB + hstepB, voffB); PG8_STA(PG8_SA(0, 1), cA, 1);
        if (wr == 1) PG8_BAR;
        PG8_WAIT_V(4); PG8_BAR;
        PG8_STAGE(PG8_SB(1, 0), cB + kstep, voffB); PG8_STA(PG8_SA(1, 0), cA + kstep, 0); PG8_STAGE(PG8_SB(1, 1), cB + hstepB + kstep, voffB);
        PG8_WAIT_V(6); PG8_BAR;
    }
    for (;;) {
        const bool has_next = S.next(ui + 1, nxt);
        const char* nA = (has_next && !GATHER) ? (const char*)g.A + (size_t)nxt.pm * tstep : cA; const char* nB = has_next ? (const char*)g.Bt + (size_t)nxt.pn * tstep : cB;
        for (int t = 0; t < nt; t += 2) {
            const bool last = (t == nt - 2);
            const char* a1 = cA + (size_t)(t + 1) * kstep;
            const char* a2 = last ? nA : cA + (size_t)(t + 2) * kstep; const char* b2 = last ? nB : cB + (size_t)(t + 2) * kstep;
            const char* a3 = a2 + kstep; const char* b3 = b2 + kstep;
            if (last && has_next) S.a_ready(nxt);
            if constexpr (SP2) {
            PG8_LDB(B0, 0, 0); PG8_LDB(B1, 0, 1); PG8_SCHED; PG8_LDA(At, 0, 0); PG8_STA(PG8_SA(1, 1), a1, 1);
            if constexpr (GATHER) { if (last && has_next) PG8_GLOAD(nxt.pm); }
            PG8_WAIT_V(8); PG8_WAIT_L(0); PG8_BAR; PG8_MMA(0, 0, At, B0); PG8_MMA(0, 1, At, B1); PG8_BAR; PG8_SCHED;
            PG8_LDA(At, 0, 1); PG8_STAGE(PG8_SB(0, 0), b2, voffB); PG8_STAGE(PG8_SB(0, 1), b2 + hstepB, voffB); PG8_STA(PG8_SA(0, 0), a2, 0);
            PG8_WAIT_V(8); PG8_WAIT_L(0); PG8_BAR; PG8_MMA(1, 0, At, B0); PG8_MMA(1, 1, At, B1); PG8_BAR; PG8_SCHED;
            PG8_LDB(B0, 1, 0); PG8_LDB(B1, 1, 1); PG8_SCHED; PG8_LDA(At, 1, 0); PG8_STA(PG8_SA(0, 1), a2, 1);
            PG8_WAIT_V(8); PG8_WAIT_L(0); PG8_BAR; PG8_MMA(0, 0, At, B0); PG8_MMA(0, 1, At, B1); PG8_BAR; PG8_SCHED;
            PG8_LDA(At, 1, 1); PG8_STAGE(PG8_SB(1, 0), b3, voffB); PG8_STAGE(PG8_SB(1, 1), b3 + hstepB, voffB); PG8_STA(PG8_SA(1, 0), a3, 0);
            PG8_WAIT_V(8); PG8_WAIT_L(0); PG8_BAR; PG8_MMA(1, 0, At, B0); PG8_MMA(1, 1, At, B1); PG8_BAR; PG8_SCHED;
            } else {
            static_assert(SP2 || !GATHER, "GATHER is wired into the SP2 loop only");
            PG8_LDB(B0, 0, 0); PG8_SCHED; PG8_LDA(At, 0, 0); PG8_STAGE(PG8_SA(1, 1), a1 + hstep, voffA);
            PG8_WAIT_L(8); PG8_BAR; PG8_WAIT_L(0); PG8_MMA(0, 0, At, B0); PG8_BAR; PG8_SCHED;
            PG8_LDB(B1, 0, 1); PG8_STAGE(PG8_SB(0, 0), b2, voffB);
            PG8_BAR; PG8_WAIT_L(0); PG8_MMA(0, 1, At, B1); PG8_BAR;
            PG8_LDA(At, 0, 1); PG8_STAGE(PG8_SA(0, 0), a2, voffA);
            PG8_BAR; PG8_WAIT_L(0); PG8_MMA(1, 0, At, B0); PG8_BAR; PG8_SCHED;
            PG8_STAGE(PG8_SB(0, 1), b2 + hstepB, voffB);
            PG8_WAIT_V(6); PG8_BAR; PG8_MMA(1, 1, At, B1); PG8_BAR;
            PG8_LDB(B0, 1, 0); PG8_SCHED; PG8_LDA(At, 1, 0); PG8_STAGE(PG8_SA(0, 1), a2 + hstep, voffA);
            PG8_WAIT_L(8); PG8_BAR; PG8_WAIT_L(0); PG8_MMA(0, 0, At, B0); PG8_BAR; PG8_SCHED;
            PG8_LDB(B1, 1, 1); PG8_STAGE(PG8_SB(1, 0), b3, voffB);
            PG8_BAR; PG8_WAIT_L(0); PG8_MMA(0, 1, At, B1); PG8_BAR;
            PG8_LDA(At, 1, 1); PG8_STAGE(PG8_SA(1, 0), a3, voffA);
            PG8_BAR; PG8_WAIT_L(0); PG8_MMA(1, 0, At, B0); PG8_BAR; PG8_SCHED;
            PG8_STAGE(PG8_SB(1, 1), b3 + hstepB, voffB);
            PG8_WAIT_V(6); PG8_BAR; PG8_MMA(1, 1, At, B1); PG8_BAR;
            }
        }
        if constexpr (ALIGN_EPI) { if (wr == 0) PG8_BAR; }
        if constexpr (FP8) asm volatile("s_nop 15\n\ts_nop 15" ::: "memory");
        if constexpr (!Epi::AFTER_DRAIN) { int le_ = lane; asm volatile("" : "+v"(le_));
            E(acc, cur, wr, wc, le_ & 15, le_ >> 4); S.done(cur); }
        if (!has_next) break;
        asm volatile("v_mov_b32 %0, 0" : "=v"(zf_));
#pragma unroll
        for (int a = 0; a < 2; ++a)
#pragma unroll
            for (int b = 0; b < 2; ++b)
#pragma unroll
                for (int m = 0; m < 4; ++m)
#pragma unroll
                    for (int n = 0; n < 2; ++n) acc[a][b][m][n] = (f32x4){zf_, zf_, zf_, zf_};
        cur = nxt; cA = nA; cB = nB; ++ui;
        if constexpr (ALIGN_EPI) { if (wr == 1) PG8_BAR; }
    }
    PG8_WAIT_V(0);
    if constexpr (!ALIGN_EPI) { if (wr == 0) PG8_BAR; }
    PG8_BAR;
    if constexpr (Epi::AFTER_DRAIN) { E.fused(acc, cur, wr, wc, fr, fq, lds, wid, lane); S.done(cur); }
#undef PG8_SA
#undef PG8_STA
#undef PG8_GLOAD
#undef PG8_SB
#undef PG8_STAGE
#undef PG8_LDA
#undef PG8_LDB
#undef PG8_MMA
#undef PG8_WAIT_V
#undef PG8_WAIT_L
#undef PG8_BAR
#undef PG8_SCHED
}

}

struct EpiA1U {
    static constexpr bool PERM = true, AFTER_DRAIN = false, W16 = false;
    bf16_t* U;
    __device__ __forceinline__ void operator()(const pg8::f32x4 (&acc)[2][2][4][2], const pg8::Unit& u, int wr, int wc, int fr, int fq) const {
        bf16_t* up = U + (size_t)(u.pm * 256 + wr * 64 + fr) * GW + u.pn * 256 + wc * 32 + 8 * fq;
#pragma unroll
        for (int ai = 0; ai < 2; ++ai)
#pragma unroll
            for (int m = 0; m < 4; ++m)
#pragma unroll
                for (int bj = 0; bj < 2; ++bj) {
                    const f32x4 v0 = gelu_tanh4(acc[ai][bj][m][0]), v1 = gelu_tanh4(acc[ai][bj][m][1]);
                    u32x4 w; w.x = pk_bf16(v0.x, v0.y); w.y = pk_bf16(v0.z, v0.w); w.z = pk_bf16(v1.x, v1.y); w.w = pk_bf16(v1.z, v1.w);
                    *(u32x4*)(up + (size_t)(ai * 128 + m * 16) * GW + bj * 128) = w;
                }
    }
};
struct EpiA1V {
    static constexpr bool PERM = true, AFTER_DRAIN = false, W16 = false;
    bf16_t* VT; float* VSS;
    __device__ __forceinline__ void operator()(const pg8::f32x4 (&acc)[2][2][4][2], const pg8::Unit& u, int wr, int wc, int fr, int fq) const {
        const int tok0 = u.pn * 256 + wc * 32 + 8 * fq;
        bf16_t* vp = VT + (size_t)(u.pm * 256 + wr * 64 + fr) * T + tok0;
        f32x4 ss[2][2];
#pragma unroll
        for (int bj = 0; bj < 2; ++bj) { ss[bj][0] = (f32x4){0.f, 0.f, 0.f, 0.f}; ss[bj][1] = (f32x4){0.f, 0.f, 0.f, 0.f}; }
#pragma unroll
        for (int ai = 0; ai < 2; ++ai)
#pragma unroll
            for (int m = 0; m < 4; ++m)
#pragma unroll
                for (int bj = 0; bj < 2; ++bj) {
                    f32x4 v0 = acc[ai][bj][m][0], v1 = acc[ai][bj][m][1];
                    v0 = gelu_tanh4(v0); v1 = gelu_tanh4(v1);
                    ss[bj][0] += v0 * v0; ss[bj][1] += v1 * v1;
                    u32x4 w; w.x = pk_bf16(v0.x, v0.y); w.y = pk_bf16(v0.z, v0.w); w.z = pk_bf16(v1.x, v1.y); w.w = pk_bf16(v1.z, v1.w);
                    *(u32x4*)(vp + (size_t)(ai * 128 + m * 16) * T + bj * 128) = w;
                }
#pragma unroll
        for (int bj = 0; bj < 2; ++bj)
#pragma unroll
            for (int n = 0; n < 2; ++n) {
                f32x4 q = ss[bj][n];
#pragma unroll
                for (int o = 1; o < 16; o <<= 1) { q.x += __shfl_xor(q.x, o); q.y += __shfl_xor(q.y, o); q.z += __shfl_xor(q.z, o); q.w += __shfl_xor(q.w, o); }
                if (fr == 0) *(f32x4*)(VSS + (size_t)(u.pm * 2 + wr) * T + tok0 + bj * 128 + 4 * n) = q;
            }
    }
};
__device__ __forceinline__ void phase_a1(const Ctx& c) {
    const pg8::bf16_t* XN = (const pg8::bf16_t*)(c.ws + WS_XN); const pg8::bf16_t* W = (const pg8::bf16_t*)(c.ws + WS_WAIN);
    {
        pg8::Gemm g{XN, W, T, GW, D}; pg8::StaticOrder S; S.init(T, GW, (int)gridDim.x, (int)blockIdx.x);
        EpiA1U E{(bf16_t*)(c.ws + WS_U)};
        pg8::gemm_phase<EpiA1U, pg8::StaticOrder, true, true, false>(c.ldsp, g, S, E);
    }
    __syncthreads();
    {
        pg8::Gemm g{W + (size_t)GW * D, XN, GW, T, D}; pg8::StaticOrder S; S.init(GW, T, (int)gridDim.x, (int)blockIdx.x);
        EpiA1V E{(bf16_t*)(c.ws + WS_VT), (float*)(c.ws + WS_VSS)};
        pg8::gemm_phase<EpiA1V, pg8::StaticOrder, true, true, false>(c.ldsp, g, S, E);
    }
}

__device__ __forceinline__ void phase_a2(const Ctx& c, bool dry = false) {
    const __attribute__((address_space(4))) Args& a = *c.a;
    bf16_t* U = (bf16_t*)(c.ws + WS_U); const bf16_t* VT = (const bf16_t*)(c.ws + WS_VT); const float* VSS = (const float*)(c.ws + WS_VSS);
    const float* ws_ = (const float*)a.in[IN_AWS]; const float* bs_ = (const float*)a.in[IN_ABS]; const float* vg = (const float*)a.in[IN_AVG];
    const int fr = c.lane & 15, fq = c.lane >> 4, wr = c.wave >> 1, wc = c.wave & 1, tid = c.tid;
    LAS unsigned char* lds = c.lds;
    LAS float* rl = (LAS float*)(lds + LDS_MAIN);
    for (int u = c.vb; u < 128 * 8; u += c.nb) {
        const int ci = u >> 3, g = u & 7, tokbase = ci * 128;
        __syncthreads();
        if (tid < 128) {
            const float* p = VSS + tokbase + tid; float s = 0.f;
#pragma unroll
            for (int i = 0; i < 16; ++i) s += p[(size_t)i * T];
            rl[tid] = rsqrtf(s * (1.f / GW) + EPS);
        }
        __syncthreads();
        {
            const int t = tid >> 1, half = tid & 1;
            const float* wrow = ws_ + ((size_t)g * 128 + t) * 128 + half * 64;
#pragma unroll
            for (int cc = 0; cc < 8; ++cc) {
                const int s0 = half * 64 + cc * 8;
                u32x4 o;
                {
                    const f32x4 w0 = ((const f32x4*)wrow)[2 * cc], w1 = ((const f32x4*)wrow)[2 * cc + 1];
                    float e[8] = {w0.x, w0.y, w0.z, w0.w, w1.x, w1.y, w1.z, w1.w};
                    const f32x4 r0_ = *(const LAS f32x4*)(rl + s0), r1_ = *(const LAS f32x4*)(rl + s0 + 4);
                    const float rr[8] = {r0_.x, r0_.y, r0_.z, r0_.w, r1_.x, r1_.y, r1_.z, r1_.w};
#pragma unroll
                    for (int i = 0; i < 8; ++i) e[i] = (s0 + i <= t) ? e[i] * rr[i] : 0.f;
                    o.x = pk_bf16(e[0], e[1]); o.y = pk_bf16(e[2], e[3]); o.z = pk_bf16(e[4], e[5]); o.w = pk_bf16(e[6], e[7]);
                }
                *(LAS u32x4*)(lds + half * 16384 + t * 128 + ((cc ^ (t & 7)) << 4)) = o;
            }
        }
        for (int hn = 0; hn < 2; ++hn) {
            const int c0 = g * 256 + hn * 128;
            const bf16_t* bp[4]; rows_regular<64>(bp, VT + (size_t)c0 * T + tokbase, T, tid);
            stage_tile<64>(lds + 32768, bp, 0, tid); stage_tile<64>(lds + 32768 + 16384, bp, 64, tid);
            VM_WAIT();
            __syncthreads();
            f32x4 acc[4][4]; zero_acc(acc);
#pragma unroll 1
            for (int kh = 0; kh < 2; ++kh)
#pragma unroll 1
                for (int ks = 0; ks < 2; ++ks) {
                    bf16x8 af[4], bf[4];
#pragma unroll
                    for (int m = 0; m < 4; ++m) af[m] = *(const LAS bf16x8*)(lds + kh * 16384 + frag_off<64>(wr * 64 + m * 16 + fr, ks, fq));
#pragma unroll
                    for (int n = 0; n < 4; ++n) bf[n] = *(const LAS bf16x8*)(lds + 32768 + kh * 16384 + frag_off<64>(wc * 64 + 16 * (fr >> 2) + 4 * n + (fr & 3), ks, fq));
#pragma unroll
                    for (int m = 0; m < 4; ++m)
#pragma unroll
                        for (int n = 0; n < 4; ++n) acc[m][n] = __builtin_amdgcn_mfma_f32_16x16x32_bf16(bf[n], af[m], acc[m][n], 0, 0, 0);
                }
            u32x4 uvv[4][2]; float bsvv[4];
            const int chb = c0 + wc * 64 + 16 * fq;
#pragma unroll
            for (int m = 0; m < 4; ++m) { const int tl = wr * 64 + m * 16 + fr; bsvv[m] = bs_[g * 128 + tl];
                const u32x4* up = (const u32x4*)(U + (size_t)(tokbase + tl) * GW + chb); uvv[m][0] = up[0]; uvv[m][1] = up[1]; }
            f32x4 gn[4];
#pragma unroll
            for (int n = 0; n < 4; ++n) gn[n] = *(const f32x4*)(vg + chb + 4 * n);
#pragma unroll
            for (int m = 0; m < 4; ++m) {
                const int tl = wr * 64 + m * 16 + fr; const float bsv = bsvv[m];
                u32x4 o[2];
#pragma unroll
                for (int h2 = 0; h2 < 2; ++h2) {
                    const u32x4 uv = uvv[m][h2]; const f32x4 v0 = acc[m][2 * h2], v1 = acc[m][2 * h2 + 1], g0 = gn[2 * h2], g1 = gn[2 * h2 + 1];
                    o[h2].x = pk_bf16(bf_lo(uv.x) * (g0.x * v0.x + bsv), bf_hi(uv.x) * (g0.y * v0.y + bsv));
                    o[h2].y = pk_bf16(bf_lo(uv.y) * (g0.z * v0.z + bsv), bf_hi(uv.y) * (g0.w * v0.w + bsv));
                    o[h2].z = pk_bf16(bf_lo(uv.z) * (g1.x * v1.x + bsv), bf_hi(uv.z) * (g1.y * v1.y + bsv));
                    o[h2].w = pk_bf16(bf_lo(uv.w) * (g1.z * v1.z + bsv), bf_hi(uv.w) * (g1.w * v1.w + bsv));
                }
                u32x4* op = (u32x4*)(dry ? (bf16_t*)(c.ws + 440 * MB) + ((size_t)(tokbase + tl) * GW + chb) : U + (size_t)(tokbase + tl) * GW + chb);
                op[0] = o[0]; op[1] = o[1];
            }
            __syncthreads();
        }
    }
}

template <bool BASE_F32> struct EpiResH {
    static constexpr bool PERM = true, AFTER_DRAIN = false, W16 = false;
    const void* base; bf16_t* out; float ascale;
    __device__ __forceinline__ void operator()(const pg8::f32x4 (&acc)[2][2][4][2], const pg8::Unit& u, int wr, int wc, int fr, int fq) const {
        const size_t o0 = (size_t)(u.pm * 256 + wr * 64 + fr) * D + u.pn * 256 + wc * 32 + 8 * fq;
#pragma unroll
        for (int ai = 0; ai < 2; ++ai) {
            f32x4 b0[4][2], b1[4][2];
#pragma unroll
            for (int m = 0; m < 4; ++m)
#pragma unroll
                for (int bj = 0; bj < 2; ++bj) { const size_t o = o0 + (size_t)(ai * 128 + m * 16) * D + bj * 128;
                    if (BASE_F32) { b0[m][bj] = *(const f32x4*)((const float*)base + o); b1[m][bj] = *(const f32x4*)((const float*)base + o + 4); }
                    else { const u32x4 w = *(const u32x4*)((const bf16_t*)base + o); b0[m][bj] = (f32x4){bf_lo(w.x), bf_hi(w.x), bf_lo(w.y), bf_hi(w.y)}; b1[m][bj] = (f32x4){bf_lo(w.z), bf_hi(w.z), bf_lo(w.w), bf_hi(w.w)}; } }
#pragma unroll
            for (int m = 0; m < 4; ++m)
#pragma unroll
                for (int bj = 0; bj < 2; ++bj) { const size_t o = o0 + (size_t)(ai * 128 + m * 16) * D + bj * 128;
                    const f32x4 v0 = b0[m][bj] + acc[ai][bj][m][0] * ascale, v1 = b1[m][bj] + acc[ai][bj][m][1] * ascale;
                    u32x4 w; w.x = pk_bf16(v0.x, v0.y); w.y = pk_bf16(v0.z, v0.w); w.z = pk_bf16(v1.x, v1.y); w.w = pk_bf16(v1.z, v1.w);
                    *(u32x4*)(out + o) = w; }
        }
    }
};
__device__ __forceinline__ void phase_a3(const Ctx& c) {
    pg8::Gemm g{(const pg8::bf16_t*)(c.ws + WS_U), (const pg8::bf16_t*)(c.ws + WS_WAOUT), T, D, GW};
    pg8::StaticOrder S; S.init(T, D, (int)gridDim.x, (int)blockIdx.x);
    EpiResH<true> E{c.a->in[IN_X], (bf16_t*)(c.ws + WS_H), 1.f};
    pg8::gemm_phase<EpiResH<true>, pg8::StaticOrder, true, true, false>(c.ldsp, g, S, E);
}

__device__ __forceinline__ void phase_route(const Ctx& c, int l, bool dry = false) {
    const __attribute__((address_space(4))) Args& a = *c.a;
    const bf16_t* H = (const bf16_t*)(c.ws + WS_H);
    const float* wr_ = (const float*)(c.ws + WS_WR) + (size_t)l * D * 48;
    const float* gain = (const float*)a.in[IN_FFNN] + l * D;
    int* cnt = (int*)(c.ws + WS_CNT) + (size_t)(l + (dry ? 2 : 0)) * NSUB * 32 * CNT_STRIDE; int* list = (int*)(c.ws + (dry ? 480 * MB : WS_LIST)); float* gatel = (float*)(c.ws + (dry ? 484 * MB : WS_GATE)); int* tokslot = (int*)(c.ws + (dry ? 488 * MB : WS_TOKSLOT));
    LAS float* rl = (LAS float*)(c.lds);
    LAS float* lgl = (LAS float*)(c.lds + 256);
    const int lane = c.lane, w = c.wave;
    f32x4 gv[4]; gain_load(gain, lane, gv);
    LAS unsigned char* cscr = c.lds + 16384 + c.wave * TR_SCR; static_assert(16384 + 4 * TR_SCR <= LDS_MAIN, "route lds");
    const bool conv = (l == 0) && !dry;
    if (conv && c.half == 1) for (int it = c.vb * 4 + c.wave; it < NE * 192; it += c.nb * 4) convert_moe_item(c, 0, it, cscr);
    for (int unit = c.vb; unit < T / 32; unit += c.nb) {
        const int tok0 = unit * 32;
        __syncthreads();
#pragma unroll 1
        for (int i0 = 0; i0 < 8; i0 += 4) {
            f32x4 v[4][4];
#pragma unroll
            for (int i = 0; i < 4; ++i) row_load_h(H + (size_t)(tok0 + w * 8 + i0 + i) * D, lane, v[i]);
#pragma unroll
            for (int i = 0; i < 4; ++i) {
                const int t = tok0 + w * 8 + i0 + i;
                const float r = rsqrtf(row_sumsq(v[i]) * (1.f / D) + EPS);
                if (lane == 0) rl[w * 8 + i0 + i] = r;
                row_store_norm_fp8(c.ws + (dry ? 440 * MB : WS_XN8) + (size_t)t * D, lane, v[i], r, gv);
            }
        }
#ifndef MK_DRYPART
#define MK_DRYPART 3
#endif
        if (!(dry && MK_DRYPART < 2))
        {
            const int th = w & 1, kh = w >> 1, m = lane & 15, q = lane >> 4;
            const u32x4* ap = (const u32x4*)(H + (size_t)(tok0 + 16 * th + m) * D + 512 * kh + 8 * q);
            const f32x4* bp = (const f32x4*)wr_ + ((size_t)kh * 16 * 3 * 64 + lane) * 2;
            f32x4 acc[3]; acc[0] = acc[1] = acc[2] = (f32x4){0.f, 0.f, 0.f, 0.f};
#pragma unroll 1
            for (int i0 = 0; i0 < 16; i0 += 2) {
                u32x4 aw[2]; f32x4 bv[2][3][2];
#pragma unroll
                for (int i = 0; i < 2; ++i) { aw[i] = ap[(i0 + i) * 4];
#pragma unroll
                    for (int nt = 0; nt < 3; ++nt) { const f32x4* b2 = bp + (size_t)((i0 + i) * 3 + nt) * 128; bv[i][nt][0] = b2[0]; bv[i][nt][1] = b2[1]; } }
#pragma unroll
                for (int i = 0; i < 2; ++i) {
                    const float av[8] = {bf_lo(aw[i].x), bf_hi(aw[i].x), bf_lo(aw[i].y), bf_hi(aw[i].y), bf_lo(aw[i].z), bf_hi(aw[i].z), bf_lo(aw[i].w), bf_hi(aw[i].w)};
#pragma unroll
                    for (int e = 0; e < 8; ++e)
#pragma unroll
                        for (int nt = 0; nt < 3; ++nt) acc[nt] = __builtin_amdgcn_mfma_f32_16x16x4f32(av[e], bv[i][nt][e >> 2][e & 3], acc[nt], 0, 0, 0);
                }
            }
#pragma unroll
            for (int nt = 0; nt < 3; ++nt)
#pragma unroll
                for (int j = 0; j < 4; ++j) lgl[(kh * 32 + th * 16 + 4 * q + j) * 48 + nt * 16 + m] = acc[nt][j];
        }
        __syncthreads();
        if (c.tid < 32 && !(dry && MK_DRYPART < 3)) {
            const int tt = c.tid, t = tok0 + tt; const float r = rl[tt];
            const float* bg = (const float*)a.in[IN_BG] + l * 4; const float* be = (const float*)a.in[IN_BE] + l * 32;
            float gl[4];
#pragma unroll
            for (int o = 0; o < 4; ++o) gl[o] = (lgl[tt * 48 + o] + lgl[(32 + tt) * 48 + o]) * r + bg[o];
            int gs = 0; float gm = gl[0];
#pragma unroll
            for (int o = 1; o < 4; ++o) if (gl[o] > gm) { gm = gl[o]; gs = o; }
            float gden = 0.f;
#pragma unroll
            for (int o = 0; o < 4; ++o) gden += __expf(gl[o] - gm);
            const float pg = 1.f / gden;
            float l1 = -INFINITY, l2 = -INFINITY; int i1 = 0, i2 = 0;
            for (int i = 0; i < 8; ++i) {
                const int o = 4 + gs * 8 + i;
                const float v = (lgl[tt * 48 + o] + lgl[(32 + tt) * 48 + o]) * r + be[gs * 8 + i];
                if (v > l1) { l2 = l1; i2 = i1; l1 = v; i1 = i; } else if (v > l2) { l2 = v; i2 = i; }
            }
            const float e2 = __expf(l2 - l1), inv = 1.f / (1.f + e2);
            const float g1 = pg * inv, g2 = pg * e2 * inv;
            const int ea = gs * 8 + i1, eb = gs * 8 + i2;
            const int sub = unit & (NSUB - 1);
            const int sa = sub * SUBCAP + atomicAdd(&cnt[(sub * 32 + ea) * CNT_STRIDE], 1), sb = sub * SUBCAP + atomicAdd(&cnt[(sub * 32 + eb) * CNT_STRIDE], 1);
            list[ea * T + sa] = t; gatel[ea * T + sa] = g1; tokslot[2 * t] = (ea << 16) | sa;
            list[eb * T + sb] = t; gatel[eb * T + sb] = g2; tokslot[2 * t + 1] = (eb << 16) | sb;
        }
    }
    if (conv && c.half == 0) for (int it = c.vb * 4 + c.wave; it < NE * 192; it += c.nb * 4) convert_moe_item(c, 0, it, cscr);
}

__device__ __forceinline__ void moe_table_build(const unsigned char* ws, int l, int tl, LAS int* pst, LAS int* cn, LAS int* sub) {
    if (tl < 32) {
        const int* cnt = (const int*)(ws + WS_CNT) + (size_t)l * NSUB * 32 * CNT_STRIDE + tl * CNT_STRIDE;
        int v[NSUB];
#pragma unroll
        for (int s2 = 0; s2 < NSUB; ++s2) v[s2] = cnt[(size_t)s2 * 32 * CNT_STRIDE];
        int acc = 0;
#pragma unroll
        for (int s2 = 0; s2 < NSUB; ++s2) { sub[tl * 33 + s2] = acc; acc += v[s2]; }
        sub[tl * 33 + NSUB] = acc; cn[tl] = acc;
        const int nb = (acc + 255) >> 8; int inc = nb;
#pragma unroll
        for (int o = 1; o < 32; o <<= 1) { const int t2 = __shfl_up(inc, o); if (tl >= o) inc += t2; }
        pst[tl] = inc - nb; if (tl == 31) pst[32] = inc;
    }
}
__device__ __forceinline__ void moe_table(const Ctx& c, int l, LAS int* pst, LAS int* cn, LAS int* sub) {
    __syncthreads();
    moe_table_build(c.ws, l, c.tid, pst, cn, sub);
    __syncthreads();
}
__device__ __forceinline__ void moe_table_wg(const Ctx& c, int l, LAS int* pst, LAS int* cn, LAS int* sub) {
    __syncthreads();
    moe_table_build(c.ws, l, (int)threadIdx.x, pst, cn, sub);
    __syncthreads();
}
__device__ __forceinline__ void moe_table_copy(const unsigned char* ws, int l, int tl, int nth, LAS int* pst, LAS int* sub) {
    const int* tab = (const int*)(ws + WS_TAB) + l * 1152;
    for (int i = tl; i < 1152; i += nth) { const int v = tab[i]; if (i < 96) pst[i] = v; else sub[i - 96] = v; }
}
__device__ __forceinline__ int moe_row_idx(LAS const int* sub, int e, int r) {
    int s2 = 0;
    for (int i = 1; i < NSUB; ++i) s2 = (sub[e * 33 + i] <= r) ? i : s2;
    return s2 * SUBCAP + (r - sub[e * 33 + s2]);
}
__device__ __forceinline__ int moe_find(LAS const int* pst, int mb) { int e = 0; for (int i = 1; i < 32; ++i) e = (pst[i] <= mb) ? i : e; return e; }

constexpr int MOE_LDS = 131072;
constexpr int CAPU = 16;
constexpr int MOE_SUB = MOE_LDS + 1024 + CAPU * 1024;
static_assert(MOE_SUB + 32 * 33 * 4 <= LDS_BYTES - 16, "moe lds");
__device__ __forceinline__ void moe_table_wg(const Ctx& c, int l, LAS int* pst, LAS int* cn) {
    __syncthreads();
    if (threadIdx.x == 0) {
        const int* cnt = (const int*)(c.ws + WS_CNT) + l * 32 * CNT_STRIDE; int acc = 0;
        for (int e = 0; e < 32; ++e) { const int n = cnt[e * CNT_STRIDE]; cn[e] = n; pst[e] = acc; acc += (n + 255) >> 8; }
        pst[32] = acc;
    }
    __syncthreads();
}
struct MoeOrder {
    LAS const int* pst; int nunits, G, c, i0; bool gather;
    __device__ __forceinline__ bool next(int i, pg8::Unit& u) const {
        if (i >= CAPU) return false;
        const long L = (long)(i0 + i) * G + c; if (L >= nunits) return false;
        int wgid = (int)L; { const int q = nunits / 8, r = nunits % 8, xcd = wgid % 8, off = wgid / 8; wgid = (xcd < r ? xcd * (q + 1) : r * (q + 1) + (xcd - r) * q) + off; }
        const int mb = wgid >> 2, e = __builtin_amdgcn_readfirstlane(moe_find(pst, mb));
        u.pm = gather ? i : mb; u.pn = e * 4 + (wgid & 3); u.aux = mb; return true;
    }
    __device__ __forceinline__ void a_ready(const pg8::Unit&) const {}
    __device__ __forceinline__ void done(const pg8::Unit&) const {}
};
struct EpiE1 {
    static constexpr bool PERM = true, AFTER_DRAIN = false, W16 = false;
    unsigned char* HM;
    __device__ __forceinline__ void operator()(const pg8::f32x4 (&acc)[2][2][4][2], const pg8::Unit& u, int wr, int wc, int fr, int fq) const {
        const float ws_ = 1.f / W8_SCALE;
        unsigned char* hp = HM + ((size_t)u.aux * 256 + wr * 64 + fr) * DE + (u.pn & 3) * 128 + wc * 32 + 8 * fq;
#pragma unroll
        for (int ai = 0; ai < 2; ++ai)
#pragma unroll
            for (int m = 0; m < 4; ++m) {
                u32x2 o;
#pragma unroll
                for (int n = 0; n < 2; ++n) {
                    const f32x4 x = acc[ai][0][m][n] * ws_, y = acc[ai][1][m][n] * (ws_ * H8_SCALE);
                    const f32x4 hv = (x * sigmoid4(x)) * y;
                    const unsigned w = pk_fp8x4(hv.x, hv.y, hv.z, hv.w);
                    if (n == 0) o.x = w; else o.y = w;
                }
                *(u32x2*)(hp + (size_t)(ai * 128 + m * 16) * DE) = o;
            }
    }
};
__device__ __forceinline__ void phase_e1(const Ctx& c, int l) {
    LAS int* pst = (LAS int*)(c.ldsp + MOE_LDS); LAS int* cn = pst + 40; LAS unsigned* gtab = (LAS unsigned*)(c.ldsp + MOE_LDS + 1024); LAS int* sub = (LAS int*)(c.ldsp + MOE_SUB);
    moe_table_wg(c, l, pst, cn, sub);
    if (blockIdx.x == 0) { int* tab = (int*)(c.ws + WS_TAB) + l * 1152;
        for (int i = threadIdx.x; i < 1152; i += NTHP) tab[i] = (i < 96) ? ((i < 33 || (i >= 40 && i < 72)) ? pst[i] : 0) : sub[i - 96]; }
    const float* gatel = (const float*)(c.ws + WS_GATE); float* grow = (float*)(c.ws + WS_GROW);
    const int* list = (const int*)(c.ws + WS_LIST);
    pg8::Gemm g{(const pg8::bf16_t*)(c.ws + WS_XN8), (const pg8::bf16_t*)(c.ws + WS_W3), RPAD, 1024, D / 2};
    MoeOrder S{pst, __builtin_amdgcn_readfirstlane(pst[32]) * 4, (int)gridDim.x, (int)blockIdx.x, 0, true};
    EpiE1 E{c.ws + WS_HMID};
    for (;; S.i0 += CAPU) {
        pg8::Unit u; if (!S.next(0, u)) break;
        for (int i = 0; i < CAPU; ++i) {
            if (!S.next(i, u)) break;
            const int e = u.pn >> 2, row0 = (u.aux - __builtin_amdgcn_readfirstlane(pst[e])) * 256, count = __builtin_amdgcn_readfirstlane(cn[e]);
            if (threadIdx.x < 256) {
                const int r = row0 + (int)threadIdx.x, idx = moe_row_idx(sub, e, r < count ? r : row0);
                gtab[i * 256 + threadIdx.x] = (unsigned)list[e * T + idx] * (unsigned)D;
                if ((u.pn & 3) == 0) grow[(size_t)u.aux * 256 + threadIdx.x] = (r < count) ? gatel[e * T + idx] : 0.f;
            }
        }
        __syncthreads();
        pg8::gemm_phase<EpiE1, MoeOrder, true, true, true, true>(c.ldsp, g, S, E, gtab);
        __syncthreads();
    }
}
struct EpiE2 {
    static constexpr bool PERM = true, AFTER_DRAIN = false, W16 = true;
    unsigned char* Y; const float* grow;
    __device__ __forceinline__ void operator()(const pg8::f32x4 (&acc)[2][2][4][2], const pg8::Unit& u, int wr, int wc, int fr, int fq) const {
        const int mb = u.aux;
        unsigned char* yp = Y + ((size_t)mb * 256 + wr * 64 + fr) * D + (u.pn & 3) * 256 + wc * 64 + 16 * fq;
        const float* gp = grow + (size_t)mb * 256 + wr * 64 + fr;
#pragma unroll
        for (int ai = 0; ai < 2; ++ai) {
            float gt[4];
#pragma unroll
            for (int m = 0; m < 4; ++m) gt[m] = gp[ai * 128 + m * 16] * (Y8_SCALE / (W8_SCALE * H8_SCALE));
#pragma unroll
            for (int m = 0; m < 4; ++m) {
                const f32x4 v00 = acc[ai][0][m][0] * gt[m], v01 = acc[ai][0][m][1] * gt[m], v10 = acc[ai][1][m][0] * gt[m], v11 = acc[ai][1][m][1] * gt[m];
                u32x4 w; w.x = pk_fp8x4(v00.x, v00.y, v00.z, v00.w); w.y = pk_fp8x4(v01.x, v01.y, v01.z, v01.w); w.z = pk_fp8x4(v10.x, v10.y, v10.z, v10.w); w.w = pk_fp8x4(v11.x, v11.y, v11.z, v11.w);
                *(u32x4*)(yp + (size_t)(ai * 128 + m * 16) * D) = w;
            }
        }
    }
};
__device__ __forceinline__ void phase_e2(const Ctx& c, int l) {
    LAS int* pst = (LAS int*)(c.ldsp + MOE_LDS); LAS int* cn = pst + 40; LAS int* sub = (LAS int*)(c.ldsp + MOE_SUB);
    __syncthreads(); moe_table_copy(c.ws, l, (int)threadIdx.x, NTHP, pst, sub); __syncthreads();
    int kq = DE / 2; asm volatile("" : "+s"(kq));
    pg8::Gemm g{(const pg8::bf16_t*)(c.ws + WS_HMID), (const pg8::bf16_t*)(c.ws + WS_W2), RPAD, 1024, kq};
    MoeOrder S{pst, __builtin_amdgcn_readfirstlane(pst[32]) * 4, (int)gridDim.x, (int)blockIdx.x, 0, false};
    EpiE2 E{c.ws + WS_Y, (const float*)(c.ws + WS_GROW)};
    for (;; S.i0 += CAPU) {
        pg8::Unit u; if (!S.next(0, u)) break;
        pg8::gemm_phase<EpiE2, MoeOrder, true, true, true, false>(c.ldsp, g, S, E);
        __syncthreads();
    }
}
__device__ __forceinline__ void phase_p1(const Ctx& c, int l, bool dry = false) {
    const bf16_t* H = (const bf16_t*)(c.ws + WS_H); bf16_t* HO = (bf16_t*)(c.ws + (dry ? 440 * MB : WS_H)); const unsigned char* Y = c.ws + WS_Y;
    const int* tokslot = (const int*)(c.ws + WS_TOKSLOT); const float* gain = (const float*)c.a->in[IN_PLEN] + l * D;
    LAS int* pst = (LAS int*)(c.lds + LDS_MAIN); LAS int* cn = pst + 40; LAS int* sub = (LAS int*)c.lds;
    __syncthreads(); moe_table_copy(c.ws, l, c.tid, 256, pst, sub); __syncthreads();
    const int gw = c.vb * 4 + c.wave, ngw = c.nb * 4, lane = c.lane;
    f32x4 gv[4]; gain_load(gain, lane, gv);
    int s0n = 0, s1n = 0;
    if (gw < T) { s0n = tokslot[2 * gw]; s1n = tokslot[2 * gw + 1]; }
    for (int t = gw; t < T; t += ngw) {
        const int s0 = s0n, s1 = s1n;
        { const int tn = (t + ngw < T) ? t + ngw : t; s0n = tokslot[2 * tn]; s1n = tokslot[2 * tn + 1]; }
        const int e0 = s0 >> 16, i0 = s0 & 0xffff, e1 = s1 >> 16, i1 = s1 & 0xffff;
        const unsigned char* y0 = Y + ((size_t)pst[e0] * 256 + sub[e0 * 33 + i0 / SUBCAP] + (i0 % SUBCAP)) * D; const unsigned char* y1 = Y + ((size_t)pst[e1] * 256 + sub[e1 * 33 + i1 / SUBCAP] + (i1 % SUBCAP)) * D;
        f32x4 v[4]; unsigned a0[4], a1[4];
        row_load_h(H + (size_t)t * D, lane, v);
#pragma unroll
        for (int j = 0; j < 4; ++j) { a0[j] = ((const unsigned*)y0)[lane + 64 * j]; a1[j] = ((const unsigned*)y1)[lane + 64 * j]; }
#pragma unroll
        for (int j = 0; j < 4; ++j) {
            const f32x4 ya = {__builtin_amdgcn_cvt_f32_fp8((int)a0[j], 0), __builtin_amdgcn_cvt_f32_fp8((int)a0[j], 1), __builtin_amdgcn_cvt_f32_fp8((int)a0[j], 2), __builtin_amdgcn_cvt_f32_fp8((int)a0[j], 3)};
            const f32x4 yb = {__builtin_amdgcn_cvt_f32_fp8((int)a1[j], 0), __builtin_amdgcn_cvt_f32_fp8((int)a1[j], 1), __builtin_amdgcn_cvt_f32_fp8((int)a1[j], 2), __builtin_amdgcn_cvt_f32_fp8((int)a1[j], 3)};
            v[j] += (ya + yb) * (1.f / Y8_SCALE);
        }
        row_store_h(HO + (size_t)t * D, lane, v);
        const float r = rsqrtf(row_sumsq(v) * (1.f / D) + EPS);
        row_store_norm_fp8(c.ws + (dry ? 440 * MB : WS_XN8) + (size_t)t * D, lane, v, r, gv);
    }
}
struct EpiPJ {
    static constexpr bool PERM = true, AFTER_DRAIN = false, W16 = false;
    bf16_t* PJ;
    __device__ __forceinline__ void operator()(const pg8::f32x4 (&acc)[2][2][4][2], const pg8::Unit& u, int wr, int wc, int fr, int fq) const {
        bf16_t* pp = PJ + (size_t)(u.pm * 256 + wr * 64 + fr) * D + u.pn * 256 + wc * 32 + 8 * fq;
#pragma unroll
        for (int ai = 0; ai < 2; ++ai)
#pragma unroll
            for (int m = 0; m < 4; ++m)
#pragma unroll
                for (int bj = 0; bj < 2; ++bj) {
                    const f32x4 v0 = acc[ai][bj][m][0], v1 = acc[ai][bj][m][1];
                    u32x4 w; w.x = pk_bf16(v0.x, v0.y); w.y = pk_bf16(v0.z, v0.w); w.z = pk_bf16(v1.x, v1.y); w.w = pk_bf16(v1.z, v1.w);
                    *(u32x4*)(pp + (size_t)(ai * 128 + m * 16) * D + bj * 128) = w;
                }
    }
};
template <bool EMIT> struct EpiP2 {
    static constexpr bool PERM = true, AFTER_DRAIN = false, W16 = false;
    const bf16_t* PJ; const bf16_t* H; bf16_t* HO; unsigned char* H8; float* RSS;
    __device__ __forceinline__ void operator()(const pg8::f32x4 (&acc)[2][2][4][2], const pg8::Unit& u, int wr, int wc, int fr, int fq) const {
        const size_t o0 = (size_t)(u.pm * 256 + wr * 64 + fr) * D + u.pn * 256 + wc * 32 + 8 * fq;
        u32x4 pj[3][2], hw[3][2];
#define P2_LOAD(it_, b_) do { _Pragma("unroll") for (int bj = 0; bj < 2; ++bj) { const size_t o = o0 + (size_t)(((it_) >> 2) * 128 + ((it_) & 3) * 16) * D + bj * 128; \
            pj[b_][bj] = *(const u32x4*)(PJ + o); hw[b_][bj] = *(const u32x4*)(H + o); } } while (0)
        P2_LOAD(0, 0); P2_LOAD(1, 1);
#pragma unroll
        for (int it = 0; it < 8; ++it) {
            const int ai = it >> 2, m = it & 3, cb = it % 3;
            if (it + 2 < 8) P2_LOAD(it + 2, (it + 2) % 3);
            float ssq = 0.f;
#pragma unroll
            for (int bj = 0; bj < 2; ++bj) { const size_t o = o0 + (size_t)(ai * 128 + m * 16) * D + bj * 128;
                const f32x4 g0 = acc[ai][bj][m][0] * (1.f / W8_SCALE), g1 = acc[ai][bj][m][1] * (1.f / W8_SCALE);
                const u32x4 hq = hw[cb][bj], pq = pj[cb][bj];
                f32x4 a0 = {bf_lo(hq.x), bf_hi(hq.x), bf_lo(hq.y), bf_hi(hq.y)}, a1 = {bf_lo(hq.z), bf_hi(hq.z), bf_lo(hq.w), bf_hi(hq.w)};
                a0 += sigmoid4(g0) * (f32x4){bf_lo(pq.x), bf_hi(pq.x), bf_lo(pq.y), bf_hi(pq.y)};
                a1 += sigmoid4(g1) * (f32x4){bf_lo(pq.z), bf_hi(pq.z), bf_lo(pq.w), bf_hi(pq.w)};
                u32x4 ow; ow.x = pk_bf16(a0.x, a0.y); ow.y = pk_bf16(a0.z, a0.w); ow.z = pk_bf16(a1.x, a1.y); ow.w = pk_bf16(a1.z, a1.w);
                *(u32x4*)(HO + o) = ow;
                if (EMIT) { u32x2 o8; o8.x = pk_fp8x4(a0.x, a0.y, a0.z, a0.w); o8.y = pk_fp8x4(a1.x, a1.y, a1.z, a1.w); *(u32x2*)(H8 + o) = o8;
                    ssq += (a0.x * a0.x + a0.y * a0.y) + (a0.z * a0.z + a0.w * a0.w) + (a1.x * a1.x + a1.y * a1.y) + (a1.z * a1.z + a1.w * a1.w); } }
            if (EMIT) { ssq += __shfl_xor(ssq, 16); ssq += __shfl_xor(ssq, 32);
                if (fq == 0) RSS[(size_t)(u.pm * 256 + ai * 128 + wr * 64 + m * 16 + fr) * 16 + u.pn * 4 + wc] = ssq; }
        }
#undef P2_LOAD
    }
};
__device__ __forceinline__ void phase_p2(const Ctx& c, int l, bool dry = false) {
    bf16_t* PJ = (bf16_t*)(c.ws + WS_Y);
    pg8::StaticOrder S; S.init(T, D, (int)gridDim.x, (int)blockIdx.x);
    {
        pg8::Gemm g{(const pg8::bf16_t*)(c.ws + WS_PBF) + (size_t)l * T * PLE, (const pg8::bf16_t*)(c.ws + WS_WPROJ) + (size_t)l * D * PLE, T, D, PLE};
        EpiPJ E{PJ};
        pg8::gemm_phase<EpiPJ, pg8::StaticOrder, true, true, false>(c.ldsp, g, S, E);
    }
    __syncthreads();
    {
        pg8::Gemm g{(const pg8::bf16_t*)(c.ws + WS_XN8), (const pg8::bf16_t*)(c.ws + WS_WGATE + (size_t)l * D * D), T, D, D / 2};
        if (l == 0) { EpiP2<true> E{PJ, (const bf16_t*)(c.ws + WS_H), (bf16_t*)(c.ws + (dry ? 440 * MB : WS_H)), c.ws + (dry ? 440 * MB + 64 * MB : WS_H8), (float*)(c.ws + (dry ? 440 * MB + 80 * MB : WS_RSS))};
            pg8::gemm_phase<EpiP2<true>, pg8::StaticOrder, true, true, true>(c.ldsp, g, S, E); }
        else { EpiP2<false> E{PJ, (const bf16_t*)(c.ws + WS_H), (bf16_t*)(c.ws + (dry ? 440 * MB : WS_H)), nullptr, nullptr};
            pg8::gemm_phase<EpiP2<false>, pg8::StaticOrder, true, true, true>(c.ldsp, g, S, E); }
    }
}
__device__ __forceinline__ void phase_norm_bf16(const Ctx& c, const float* gain) {
    const bf16_t* H = (const bf16_t*)(c.ws + WS_H);
    const int gw = c.vb * 4 + c.wave, ngw = c.nb * 4;
    f32x4 gv[4]; gain_load(gain, c.lane, gv);
    for (int t = gw; t < T; t += ngw) {
        f32x4 v[4]; row_load_h(H + (size_t)t * D, c.lane, v);
        const float r = rsqrtf(row_sumsq(v) * (1.f / D) + EPS);
        row_store_norm_fp8(c.ws + WS_XN8 + (size_t)t * D, c.lane, v, r, gv);
        row_store_norm_bf16((bf16_t*)(c.ws + WS_XN) + (size_t)t * D, c.lane, v, r, gv);
    }
}
__device__ __forceinline__ void phase_final(const Ctx& c) {
    const bf16_t* H = (const bf16_t*)(c.ws + WS_H); float* O = c.a->out; const float* gain = (const float*)c.a->in[IN_FINN];
    const int gw = c.vb * 4 + c.wave, ngw = c.nb * 4;
    f32x4 gv[4]; gain_load(gain, c.lane, gv);
    for (int t = gw; t < T; t += ngw) {
        f32x4 v[4]; row_load_h(H + (size_t)t * D, c.lane, v);
        const float r = rsqrtf(row_sumsq(v) * (1.f / D) + EPS);
#pragma unroll
        for (int j = 0; j < 4; ++j) ((f32x4*)(O + (size_t)t * D))[c.lane + 64 * j] = v[j] * r * gv[j];
    }
}

struct B1Order {
    int G, c, nN, mode;
    __device__ __forceinline__ bool next(int i, pg8::Unit& u) const {
        int L;
        if (G == 256) {
            if (mode == 0) { if (c < 64) { if (i >= 3) return false; L = c * 3 + i; } else { if (i >= 1) return false; L = 192 + (c - 64); } }
            else { if (c < 64 || i >= 1) return false; L = c - 64; }
        } else { L = i * G + c; if (L >= 64 * nN) return false; }
        u.pm = L / nN; u.pn = L - u.pm * nN; u.aux = 0; return true;
    }
    __device__ __forceinline__ void a_ready(const pg8::Unit&) const {}
    __device__ __forceinline__ void done(const pg8::Unit&) const {}
};
__device__ __forceinline__ float row_rn(const float* RSS, int row) {
    const f32x4* pp = (const f32x4*)(RSS + (size_t)row * 16); const f32x4 qs = (pp[0] + pp[1]) + (pp[2] + pp[3]);
    return rsqrtf(((qs.x + qs.y) + (qs.z + qs.w)) * (1.f / D) + EPS);
}
__device__ __forceinline__ f32x4 shfl_xor4(f32x4 v, int m) { f32x4 r; r.x = __shfl_xor(v.x, m); r.y = __shfl_xor(v.y, m); r.z = __shfl_xor(v.z, m); r.w = __shfl_xor(v.w, m); return r; }
struct EpiQKV {
    static constexpr bool PERM = true, AFTER_DRAIN = false, W16 = false;
    unsigned char* Q8; unsigned char* K8; unsigned char* V8; const float* RSS; const float* CST;
    __device__ __forceinline__ void operator()(const pg8::f32x4 (&acc)[2][2][4][2], const pg8::Unit& u, int wr, int wc, int fr, int fq) const {
        const int pn = u.pn;
        unsigned char* base = (pn < 4) ? Q8 + pn * 256 : (pn == 4 ? K8 : V8); const int stride = (pn < 4) ? D : 256;
        const bool rope = (pn < 5) && (wc == 0);
        const float sgn = (fq < 2) ? -1.f : 1.f;
#pragma unroll
        for (int ai = 0; ai < 2; ++ai)
#pragma unroll
            for (int m = 0; m < 4; ++m) {
                const int row = u.pm * 256 + ai * 128 + wr * 64 + m * 16 + fr;
                const float rn = row_rn(RSS, row) * (1.f / W8_SCALE);
                f32x4 co[2], si[2];
                if (rope) {
#pragma unroll
                    for (int n = 0; n < 2; ++n) { const float* cp = CST + (size_t)row * 64 + 8 * (fq & 1) + 4 * n; co[n] = *(const f32x4*)cp; si[n] = *(const f32x4*)(cp + 32) * sgn; }
                }
#pragma unroll
                for (int bj = 0; bj < 2; ++bj) {
                    f32x4 v0 = acc[ai][bj][m][0] * rn, v1 = acc[ai][bj][m][1] * rn;
                    if (rope) { const f32x4 p0 = shfl_xor4(v0, 32), p1 = shfl_xor4(v1, 32); v0 = v0 * co[0] + p0 * si[0]; v1 = v1 * co[1] + p1 * si[1]; }
                    u32x2 o8; o8.x = pk_fp8x4(v0.x, v0.y, v0.z, v0.w); o8.y = pk_fp8x4(v1.x, v1.y, v1.z, v1.w);
                    *(u32x2*)(base + (size_t)row * stride + bj * 128 + wc * 32 + 8 * fq) = o8;
                }
            }
    }
};
struct EpiIDX {
    static constexpr bool PERM = true, AFTER_DRAIN = false, W16 = false;
    bf16_t* QI; bf16_t* KI; float* WI; const float* RSS; const float* CST;
    __device__ __forceinline__ void operator()(const pg8::f32x4 (&acc)[2][2][4][2], const pg8::Unit& u, int wr, int wc, int fr, int fq) const {
        const int pn = u.pn;
        const bool rope = ((wc & 1) == 0) && (pn < 2 || wc == 0);
        const float sgn = (fq == 0) ? -1.f : 1.f;
#pragma unroll
        for (int ai = 0; ai < 2; ++ai)
#pragma unroll
            for (int m = 0; m < 4; ++m) {
                const int row = u.pm * 256 + ai * 128 + wr * 64 + m * 16 + fr;
                const float rn = row_rn(RSS, row);
                f32x4 co[2], si[2];
                if (rope) {
#pragma unroll
                    for (int n = 0; n < 2; ++n) { const float* cp = CST + (size_t)row * 64 + 16 + 4 * n; co[n] = *(const f32x4*)cp; si[n] = *(const f32x4*)(cp + 32) * sgn; }
                }
#pragma unroll
                for (int bj = 0; bj < 2; ++bj) {
                    if (pn == 2 && bj == 1) continue;
                    f32x4 v0 = acc[ai][bj][m][0] * rn, v1 = acc[ai][bj][m][1] * rn;
                    if (rope) { const f32x4 p0 = shfl_xor4(v0, 16), p1 = shfl_xor4(v1, 16);
                        if (fq < 2) { v0 = v0 * co[0] + p0 * si[0]; v1 = v1 * co[1] + p1 * si[1]; } }
                    if (pn < 2) { u32x4 w; w.x = pk_bf16(v0.x, v0.y); w.y = pk_bf16(v0.z, v0.w); w.z = pk_bf16(v1.x, v1.y); w.w = pk_bf16(v1.z, v1.w);
                        *(u32x4*)(QI + (size_t)row * 512 + pn * 256 + bj * 128 + wc * 32 + 8 * fq) = w; }
                    else if (wc < 2) { u32x4 w; w.x = pk_bf16(v0.x, v0.y); w.y = pk_bf16(v0.z, v0.w); w.z = pk_bf16(v1.x, v1.y); w.w = pk_bf16(v1.z, v1.w);
                        *(u32x4*)(KI + (size_t)row * 64 + wc * 32 + 8 * fq) = w; }
                    else if (wc == 2 && fq == 0) { const float sc = 0.044194173824159216f;
                        ((f32x4*)(WI + (size_t)row * 8))[0] = v0 * sc; ((f32x4*)(WI + (size_t)row * 8))[1] = v1 * sc; }
                }
            }
    }
};
__device__ __forceinline__ void phase_b1(const Ctx& c) {
    const float* RSS = (const float*)(c.ws + WS_RSS); const float* CST = (const float*)(c.ws + WS_CST);
    {
        pg8::Gemm g{(const pg8::bf16_t*)(c.ws + WS_H8), (const pg8::bf16_t*)(c.ws + WS_WBIN), T, 1536, D / 2};
        B1Order S{(int)gridDim.x, (int)blockIdx.x, 6, 0}; EpiQKV E{c.ws + WS_Q, c.ws + WS_K, c.ws + WS_V, RSS, CST};
        pg8::gemm_phase<EpiQKV, B1Order, true, true, true>(c.ldsp, g, S, E);
    }
    __syncthreads();
    {
        pg8::Gemm g{(const pg8::bf16_t*)(c.ws + WS_H), (const pg8::bf16_t*)(c.ws + WS_WBIN + 3 * MB), T, 768, D};
        B1Order S{(int)gridDim.x, (int)blockIdx.x, 3, 1}; EpiIDX E{(bf16_t*)(c.ws + WS_QI), (bf16_t*)(c.ws + WS_KI), (float*)(c.ws + WS_WI), RSS, CST};
        pg8::gemm_phase<EpiIDX, B1Order, true, true, false>(c.ldsp, g, S, E);
    }
}
__device__ __forceinline__ void unpack8(const u32x4 r, float (&e)[8]) { e[0] = bf_lo(r.x); e[1] = bf_hi(r.x); e[2] = bf_lo(r.y); e[3] = bf_hi(r.y); e[4] = bf_lo(r.z); e[5] = bf_hi(r.z); e[6] = bf_lo(r.w); e[7] = bf_hi(r.w); }
__device__ __forceinline__ u32x4 pack8(const float (&e)[8]) { u32x4 o; o.x = pk_bf16(e[0], e[1]); o.y = pk_bf16(e[2], e[3]); o.z = pk_bf16(e[4], e[5]); o.w = pk_bf16(e[6], e[7]); return o; }
__device__ __forceinline__ void phase_rope(const Ctx& c) {
    const bf16_t* RAW = (const bf16_t*)(c.ws + WS_RAW);
    bf16_t* Q = (bf16_t*)(c.ws + WS_Q); bf16_t* K = (bf16_t*)(c.ws + WS_K); bf16_t* V = (bf16_t*)(c.ws + WS_V);
    bf16_t* QI = (bf16_t*)(c.ws + WS_QI); bf16_t* KI = (bf16_t*)(c.ws + WS_KI); float* WI = (float*)(c.ws + WS_WI);
    const int* pos = (const int*)c.a->in[IN_POS];
    LAS float* cs = (LAS float*)(c.lds + c.wave * 256);
    const int gw = c.vb * 4 + c.wave, ngw = c.nb * 4, lane = c.lane;
    const double ex = (lane < 16) ? (double)lane * (1.0 / 16.0) : (double)((lane - 16) & 7) * (1.0 / 8.0);
    const float invf = (float)exp2(-ex * 18.931568569324174);
    for (int t = gw; t < T; t += ngw) {
        if (lane < 24) {
            const float ang = (float)pos[t] * invf;
            const double ad = (double)ang; const double n = rint(ad * 0.15915494309189535); const float red = (float)(ad - n * 6.283185307179586);
            cs[lane] = __cosf(red); cs[32 + lane] = __sinf(red);
        }
        LDS_WAIT();
        const bf16_t* row = RAW + (size_t)t * BINP;
        float rn;
        { const f32x4* pp = (const f32x4*)((const float*)(c.ws + WS_RSS) + (size_t)t * 16); const f32x4 q0 = pp[0], q1 = pp[1], q2 = pp[2], q3 = pp[3];
          const f32x4 qs = (q0 + q1) + (q2 + q3); rn = rsqrtf(((qs.x + qs.y) + (qs.z + qs.w)) * (1.f / D) + EPS); }
        for (int ch = lane; ch < BINP / 8; ch += 64) {
            const u32x4 own = ((const u32x4*)row)[ch];
            float e[8]; unpack8(own, e);
#pragma unroll
            for (int i = 0; i < 8; ++i) e[i] *= rn;
            if (ch < 160) {
                const int cc = ch & 15;
                if (cc < 4) {
                    const u32x4 oth = ((const u32x4*)row)[ch ^ 2]; float p[8]; unpack8(oth, p);
#pragma unroll
                    for (int i = 0; i < 8; ++i) p[i] *= rn;
                    const int f0 = (cc & 1) * 8;
#pragma unroll
                    for (int i = 0; i < 8; ++i) { const float co = cs[f0 + i], si = cs[32 + f0 + i]; e[i] = (cc < 2) ? (e[i] * co - p[i] * si) : (e[i] * co + p[i] * si); }
                }
                u32x2 o8; o8.x = pk_fp8x4(e[0], e[1], e[2], e[3]); o8.y = pk_fp8x4(e[4], e[5], e[6], e[7]);
                if (ch < 128) ((u32x2*)((unsigned char*)Q + (size_t)t * D))[ch] = o8;
                else ((u32x2*)((unsigned char*)K + (size_t)t * 256))[ch - 128] = o8;
            } else if (ch < 192) {
                u32x2 o8; o8.x = pk_fp8x4(e[0], e[1], e[2], e[3]); o8.y = pk_fp8x4(e[4], e[5], e[6], e[7]);
                ((u32x2*)((unsigned char*)V + (size_t)t * 256))[ch - 160] = o8;
            } else if (ch < 264) {
                const int cc = ch & 7;
                if (cc < 2) {
                    const u32x4 oth = ((const u32x4*)row)[ch ^ 1]; float p[8]; unpack8(oth, p);
#pragma unroll
                    for (int i = 0; i < 8; ++i) p[i] *= rn;
#pragma unroll
                    for (int i = 0; i < 8; ++i) { const float co = cs[16 + i], si = cs[32 + 16 + i]; e[i] = (cc == 0) ? (e[i] * co - p[i] * si) : (e[i] * co + p[i] * si); }
                }
                if (ch < 256) ((u32x4*)(QI + (size_t)t * 512))[ch - 192] = pack8(e);
                else ((u32x4*)(KI + (size_t)t * 64))[ch - 256] = pack8(e);
            } else if (ch == 264) {
                f32x4 w0 = {e[0], e[1], e[2], e[3]}, w1 = {e[4], e[5], e[6], e[7]};
                const float sc = 0.044194173824159216f;
                ((f32x4*)(WI + (size_t)t * 8))[0] = w0 * sc; ((f32x4*)(WI + (size_t)t * 8))[1] = w1 * sc;
            }
        }
        LDS_WAIT();
    }
}

__device__ __forceinline__ size_t srow_off(int t) { const int m = t >> 6, r = t & 63; return (size_t)64 * (m + 1) * (32 * m + r); }
constexpr size_t S_BATCH = (size_t)64 * 65 * 2048;
constexpr int SCORE_UNITS = 4 * 312;
__device__ __forceinline__ void phase_score(const Ctx& c) {
    const bf16_t* QI = (const bf16_t*)(c.ws + WS_QI); const bf16_t* KI = (const bf16_t*)(c.ws + WS_KI); const float* WI = (const float*)(c.ws + WS_WI);
    float* S = (float*)(c.ws + WS_S);
    const int lane = c.lane, hf = lane >> 5, col = lane & 31, w = c.wave;
    unsigned* qctr = (unsigned*)(c.ws + WS_CTL + 15360);
    LAS int* qslot = (LAS int*)(c.ldsp + LDS_BYTES - 64);
    for (;;) {
        __syncthreads();
        if (threadIdx.x == 0) *qslot = (int)atomicAdd(qctr, 1u);
        __syncthreads();
        const int pq = *qslot;
        if (pq >= 2 * 312) break;
        const int idx = pq >> 1, b = 2 * (pq & 1) + c.half;
        int kc, qb;
        if (idx < 97) { kc = 0; qb = 31 + idx; } else if (idx < 162) { kc = 1; qb = 63 + (idx - 97); } else if (idx < 195) { kc = 2; qb = 95 + (idx - 162); } else if (idx < 196) { kc = 3; qb = 127; }
        else { const int j = idx - 196; int n; if (j < 92) { n = 31 - (j >> 2); kc = j & 3; } else { const int j2 = j - 92; n = 8 - j2 / 3; kc = 1 + j2 % 3; } qb = 32 * kc + n - 1; }
        const int tb = b * SEQ, t0 = 32 * qb + 8 * w;
        bf16x8 af[2][4]; f32x4 wv[2][4];
        { const int rho = lane & 31, ql = 2 * ((rho >> 2) & 1) + (rho >> 4), hd = 4 * ((rho >> 3) & 1) + (rho & 3);
#pragma unroll
          for (int a = 0; a < 2; ++a) {
              const bf16_t* qp = QI + (size_t)(tb + t0 + 4 * a + ql) * 512 + hd * 64 + 8 * hf;
#pragma unroll
              for (int ks = 0; ks < 4; ++ks) af[a][ks] = *(const bf16x8*)(qp + 16 * ks);
              const float* wp = WI + (size_t)(tb + t0 + 4 * a + 2 * hf) * 8;
#pragma unroll
              for (int i = 0; i < 4; ++i) wv[a][i] = ((const f32x4*)wp)[i];
          } }
        const int ntile = min(32, qb + 1 - 32 * kc), key0 = 1024 * kc;
        float* Sb = S + (size_t)b * S_BATCH;
        size_t ro[2][2];
#pragma unroll
        for (int a = 0; a < 2; ++a) { ro[a][0] = srow_off(t0 + 4 * a + 2 * hf); ro[a][1] = srow_off(t0 + 4 * a + 2 * hf + 1); }
        const int nsub = (ntile + 3) >> 2;
        const bf16_t* krp[4];
        rows_regular<64>(krp, KI + (size_t)(tb + key0) * 64, 64, c.tid);
        __syncthreads();
        stage_tile<64>(c.lds, krp, 0, c.tid);
        for (int sc = 0; sc < 8; ++sc) {
            VM_WAIT();
            __syncthreads();
            const LAS unsigned char* cur = c.lds + (sc & 1) * 16384;
            if (sc + 1 < nsub) stage_tile<64>(c.lds + ((sc + 1) & 1) * 16384, krp, (sc + 1) * 128 * 64, c.tid);
#pragma unroll
            for (int j = 0; j < 4; ++j) {
                const int kt = 4 * sc + j;
                if (sc < nsub && kt < ntile) {
                    const int key = key0 + 32 * kt + col, row = 32 * j + col;
                    bf16x8 cb[4];
#pragma unroll
                    for (int ks = 0; ks < 4; ++ks) cb[ks] = *(const LAS bf16x8*)(cur + row * 128 + (((2 * ks + hf) ^ (row & 7)) << 4));
#pragma unroll
                    for (int a = 0; a < 2; ++a) {
                        f32x16 acc = {};
#pragma unroll
                        for (int ks = 0; ks < 4; ++ks) acc = __builtin_amdgcn_mfma_f32_32x32x16_bf16(af[a][ks], cb[ks], acc, 0, 0, 0);
                        float s0 = fmaxf(acc[0], 0.f) * wv[a][0].x; s0 += fmaxf(acc[1], 0.f) * wv[a][0].y; s0 += fmaxf(acc[2], 0.f) * wv[a][0].z; s0 += fmaxf(acc[3], 0.f) * wv[a][0].w;
                        s0 += fmaxf(acc[4], 0.f) * wv[a][1].x; s0 += fmaxf(acc[5], 0.f) * wv[a][1].y; s0 += fmaxf(acc[6], 0.f) * wv[a][1].z; s0 += fmaxf(acc[7], 0.f) * wv[a][1].w;
                        float s1 = fmaxf(acc[8], 0.f) * wv[a][2].x; s1 += fmaxf(acc[9], 0.f) * wv[a][2].y; s1 += fmaxf(acc[10], 0.f) * wv[a][2].z; s1 += fmaxf(acc[11], 0.f) * wv[a][2].w;
                        s1 += fmaxf(acc[12], 0.f) * wv[a][3].x; s1 += fmaxf(acc[13], 0.f) * wv[a][3].y; s1 += fmaxf(acc[14], 0.f) * wv[a][3].z; s1 += fmaxf(acc[15], 0.f) * wv[a][3].w;
                        const int tA = t0 + 4 * a + 2 * hf;
                        Sb[ro[a][0] + key] = (key <= tA) ? s0 : -INFINITY;
                        Sb[ro[a][1] + key] = (key <= tA + 1) ? s1 : -INFINITY;
                    }
                }
            }
        }
    }
}

constexpr int NBINS = 2048, CAND_CAP = 256, SEL_WAVE_LDS = 8192 + 2048 + 64;
__device__ __forceinline__ int clamp_bin(int x) { return min(max(x, 0), NBINS - 1); }
__device__ __forceinline__ void phase_select(const Ctx& c) {
    const float* S = (const float*)(c.ws + WS_S); int* SEL = (int*)(c.ws + WS_SEL);
    LAS int* hist = (LAS int*)(c.lds + c.wave * SEL_WAVE_LDS);
    LAS float* candv = (LAS float*)(hist + NBINS);
    LAS int* candi = (LAS int*)(candv + CAND_CAP);
    LAS int* thr = candi + CAND_CAP;
    const int gw = c.vb * 4 + c.wave, ngw = c.nb * 4;
    LAS unsigned char* cscr = c.lds + 4 * SEL_WAVE_LDS + c.wave * TR_SCR; static_assert(4 * SEL_WAVE_LDS + 4 * TR_SCR <= LDS_MAIN, "select lds");
    int cit = gw, rcount = 0;
    for (int j = gw; j < 4 * 3840; j += ngw) {
        int lane = c.lane;
        asm volatile("" : "+v"(lane));
        const int b = j & 3, t = 4095 - (j >> 2), ni = (t + 64) >> 6;
        const float* row = S + (size_t)b * S_BATCH + srow_off(t);
        float s[64];
#pragma unroll
        for (int g4 = 0; g4 < 4; ++g4) {
            if (16 * g4 < ni) {
#pragma unroll
                for (int i = 16 * g4; i < 16 * g4 + 16; ++i) { const int k = 64 * i + lane; const float v = row[min(k, t)]; s[i] = (k <= t) ? v : -INFINITY; }
            } else {
#pragma unroll
                for (int i = 16 * g4; i < 16 * g4 + 16; ++i) s[i] = -INFINITY;
            }
        }
        float mn = INFINITY, mx = -INFINITY;
#pragma unroll
        for (int g8 = 0; g8 < 8; ++g8) if (8 * g8 < ni) {
#pragma unroll
            for (int i = 8 * g8; i < 8 * g8 + 8; ++i) { mx = fmaxf(mx, s[i]); mn = fminf(mn, (s[i] == -INFINITY) ? INFINITY : s[i]); }
        }
#pragma unroll
        for (int o = 1; o < 64; o <<= 1) { mx = fmaxf(mx, __shfl_xor(mx, o)); mn = fminf(mn, __shfl_xor(mn, o)); }
        const float sc = (mx > mn) ? (float)NBINS / (mx - mn) : 0.f, a0 = -mn * sc;
#pragma unroll
        for (int i = 0; i < 8; ++i) ((LAS u32x4*)hist)[lane * 8 + i] = (u32x4){0u, 0u, 0u, 0u};
        LDS_WAIT();
#define BINOF(v) clamp_bin((int)__builtin_fmaf((v), sc, a0))
#pragma unroll
        for (int g8 = 0; g8 < 8; ++g8) if (8 * g8 < ni) {
#pragma unroll
            for (int i = 8 * g8; i < 8 * g8 + 8; ++i) lds_inc(&hist[BINOF(s[i])]);
        }
        LDS_WAIT();
        int bs, need;
        {
            const LAS int* hq = hist + lane * 32;
            u32x4 hr[8];
            int loc = 0;
#pragma unroll
            for (int i = 0; i < 8; ++i) { hr[i] = ((const LAS u32x4*)hq)[i]; loc += (int)(hr[i].x + hr[i].y + hr[i].z + hr[i].w); }
            int suf = loc;
#pragma unroll
            for (int o = 1; o < 64; o <<= 1) { const int v = __shfl_down(suf, o); if (lane + o < 64) suf += v; }
            const int above = suf - loc;
            const bool cross = (above < 256 && suf >= 256);
            int bsl = 0, abl = 0;
            { int run = above;
#pragma unroll
              for (int i = 31; i >= 0; --i) { const int h = (int)hr[i >> 2][i & 3]; const bool hit = (run < 256 && run + h >= 256); bsl = hit ? lane * 32 + i : bsl; abl = hit ? run : abl; run += h; } }
            const unsigned long long cm = __ballot(cross);
            const int src = cm ? (int)__builtin_ctzll(cm) : 0;
            bs = __shfl(bsl, src); need = 256 - __shfl(abl, src);
        }
        int bs2 = -1;
#define SUBOF(v) clamp_bin((int)((__builtin_fmaf((v), sc, a0) - (float)bs) * (float)NBINS))
        if (__shfl(hist[bs], 0) > 48) {
#pragma unroll
            for (int i = 0; i < 8; ++i) ((LAS u32x4*)hist)[lane * 8 + i] = (u32x4){0u, 0u, 0u, 0u};
            LDS_WAIT();
#pragma unroll
            for (int i = 0; i < 64; ++i) if (s[i] != -INFINITY && BINOF(s[i]) == bs) lds_inc(&hist[SUBOF(s[i])]);
            LDS_WAIT();
            const LAS int* hq = hist + lane * 32;
            int loc = 0;
#pragma unroll
            for (int i = 0; i < 8; ++i) { const u32x4 h4 = ((const LAS u32x4*)hq)[i]; loc += (int)(h4.x + h4.y + h4.z + h4.w); }
            int suf = loc;
#pragma unroll
            for (int o = 1; o < 64; o <<= 1) { const int v = __shfl_down(suf, o); if (lane + o < 64) suf += v; }
            const int above = suf - loc;
            const bool cross = (above < need && suf >= need);
            int bsl = 0, abl = 0;
            if (cross) { int run = above; for (int i = 31; i >= 0; --i) { const int h = hq[i]; if (run < need && run + h >= need) { bsl = lane * 32 + i; abl = run; } run += h; } }
            const unsigned long long cm = __ballot(cross);
            const int src = cm ? (int)__builtin_ctzll(cm) : 0;
            bs2 = __shfl(bsl, src); need = need - __shfl(abl, src);
        }
        asm volatile("" : "+v"(lane));
        float sc2 = sc, a02 = a0;
        asm volatile("" : "+v"(sc2), "+v"(a02));
#undef BINOF
#define BINOF(v) clamp_bin((int)__builtin_fmaf((v), sc2, a02))
        int* selr = SEL + ((size_t)b * SEQ + t) * 256;
        int nc = 0, base = 0;
        LAS int* stage = hist;
#define SEL_SWEEP(HAS2, Z0) do { _Pragma("unroll") for (int g4 = 0; g4 < 4; ++g4) if (16 * g4 < ni) { _Pragma("unroll") for (int i = 16 * g4; i < 16 * g4 + 16; ++i) { \
                const int bn = BINOF(s[i]); \
                bool pd = (bn > bs), pc = (bn == bs); \
                if (Z0) pc = pc && (s[i] != -INFINITY); \
                if ((HAS2) && bs2 >= 0) { const int sb = SUBOF(s[i]); pd = pd || (pc && sb > bs2); pc = pc && (sb == bs2); } \
                const unsigned long long md = __ballot(pd), mc = __ballot(pc); \
                const int posd = base + (int)__builtin_amdgcn_mbcnt_hi((unsigned)(md >> 32), __builtin_amdgcn_mbcnt_lo((unsigned)md, 0u)); \
                const int posc = nc + (int)__builtin_amdgcn_mbcnt_hi((unsigned)(mc >> 32), __builtin_amdgcn_mbcnt_lo((unsigned)mc, 0u)); \
                if (pd) stage[posd] = 64 * i + lane; \
                if (pc && (!(HAS2) || posc < CAND_CAP)) { candv[posc] = s[i]; candi[posc] = 64 * i + lane; } \
                base += (int)__popcll(md); nc += (int)__popcll(mc); } } } while (0)
        if (bs2 < 0 && bs > 0) SEL_SWEEP(false, false); else SEL_SWEEP(true, true);
#undef SEL_SWEEP
        nc = min(nc, CAND_CAP);
        LDS_WAIT();
        for (int i = lane; i < nc; i += 64) {
            const float v = candv[i]; const int id = candi[i];
            int rank = 0;
            for (int k = 0; k < nc; ++k) { const float vk = candv[k]; const int ik = candi[k]; rank += (vk > v || (vk == v && ik < id)) ? 1 : 0; }
            if (rank < need && base + rank < 256) stage[base + rank] = id;
        }
        LDS_WAIT();
        ((u32x4*)selr)[lane] = ((const LAS u32x4*)stage)[lane];
        LDS_WAIT();
#undef BINOF
#undef SUBOF
        if ((rcount & 1) && cit < NE * 192) { convert_moe_item(c, 1, cit, cscr); cit += ngw; }
        ++rcount;
    }
    for (; cit < NE * 192; cit += ngw) convert_moe_item(c, 1, cit, cscr);
}

typedef short s16x4 __attribute__((ext_vector_type(4)));
__device__ __forceinline__ unsigned vimg_f(unsigned r) { return ((r & 3u) << 2) | ((r >> 2) & 3u); }
__device__ __forceinline__ void tr_read8(const unsigned (&ad)[8], s16x4 (&r)[8]) {
    asm volatile("ds_read_b64_tr_b16 %0, %8\n\tds_read_b64_tr_b16 %1, %9\n\tds_read_b64_tr_b16 %2, %10\n\tds_read_b64_tr_b16 %3, %11\n\t"
                 "ds_read_b64_tr_b16 %4, %12\n\tds_read_b64_tr_b16 %5, %13\n\tds_read_b64_tr_b16 %6, %14\n\tds_read_b64_tr_b16 %7, %15\n\ts_waitcnt lgkmcnt(0)"
                 : "=&v"(r[0]), "=&v"(r[1]), "=&v"(r[2]), "=&v"(r[3]), "=&v"(r[4]), "=&v"(r[5]), "=&v"(r[6]), "=&v"(r[7])
                 : "v"(ad[0]), "v"(ad[1]), "v"(ad[2]), "v"(ad[3]), "v"(ad[4]), "v"(ad[5]), "v"(ad[6]), "v"(ad[7]) : "memory");
}
__device__ __forceinline__ void tr_read8_b8(const unsigned (&ad)[8], s16x4 (&r)[8]) {
    asm volatile("ds_read_b64_tr_b8 %0, %8\n\tds_read_b64_tr_b8 %1, %9\n\tds_read_b64_tr_b8 %2, %10\n\tds_read_b64_tr_b8 %3, %11\n\t"
                 "ds_read_b64_tr_b8 %4, %12\n\tds_read_b64_tr_b8 %5, %13\n\tds_read_b64_tr_b8 %6, %14\n\tds_read_b64_tr_b8 %7, %15\n\ts_waitcnt lgkmcnt(0)"
                 : "=&v"(r[0]), "=&v"(r[1]), "=&v"(r[2]), "=&v"(r[3]), "=&v"(r[4]), "=&v"(r[5]), "=&v"(r[6]), "=&v"(r[7])
                 : "v"(ad[0]), "v"(ad[1]), "v"(ad[2]), "v"(ad[3]), "v"(ad[4]), "v"(ad[5]), "v"(ad[6]), "v"(ad[7]) : "memory");
}
constexpr int ATT_WAVE_LDS = 19456;
__device__ __forceinline__ void phase_attn(const Ctx& c) {
    const bf16_t* Q = (const bf16_t*)(c.ws + WS_Q); const bf16_t* K = (const bf16_t*)(c.ws + WS_K); const bf16_t* V = (const bf16_t*)(c.ws + WS_V);
    const int* SEL = (const int*)(c.ws + WS_SEL); bf16_t* O = (bf16_t*)(c.ws + WS_O);
    LAS unsigned char* wl = c.lds + c.wave * ATT_WAVE_LDS;
    LAS int* sl = (LAS int*)wl;
    LAS unsigned short* pT = (LAS unsigned short*)(wl + 1024);
    LAS unsigned char* vb = wl + 3072;
    const int lane = c.lane, fr = lane & 15, fq = lane >> 4;
    const int gw = c.vb * 4 + c.wave, ngw = c.nb * 4;
    unsigned tro[8];
    { const unsigned row = 8u * fq + ((unsigned)fr >> 1);
#pragma unroll
      for (int c2 = 0; c2 < 8; ++c2) tro[c2] = 128u * row + 16u * ((unsigned)c2 ^ (row & 7u)) + 8u * ((unsigned)fr & 1u); }
    const unsigned vb_addr = (unsigned)(size_t)vb;
    int tcount = 0, cit = gw;
    const bool xsplit = (c.nb % 128) == 0;
    const int xg = (c.vb >> 6) & 1, wi0 = xsplit ? (((c.vb >> 7) * 64 + (c.vb & 63)) * 4 + c.wave) : gw, wstride = xsplit ? ngw / 2 : ngw;
    const unsigned chunkoff = (((unsigned)lane & 7u) ^ (((unsigned)lane >> 3) & 7u)) << 4;
    unsigned trh[8];
    { const unsigned row = 8u * (fq & 1) + ((unsigned)fr >> 1);
#pragma unroll
      for (int c2 = 0; c2 < 8; ++c2) trh[c2] = 128u * row + 16u * ((unsigned)c2 ^ (row & 7u)) + 8u * ((unsigned)fr & 1u); }
#define SEL_PREFETCH(tg_) __builtin_amdgcn_global_load_lds((const unsigned*)(SEL + (size_t)(tg_) * 256 + lane * 4), (LAS unsigned*)((LAS unsigned char*)sl + lane * 16), 16, 0, 0)
    const int task_end = xsplit ? T : T * 2;
    if (wi0 < task_end) { SEL_PREFETCH(xsplit ? wi0 : (wi0 >> 1)); }
    for (int task = wi0; task < task_end; task += wstride) {
        const int tg = xsplit ? task : (task >> 1), g = xsplit ? xg : (task & 1), b = tg >> 12, t = tg & 4095, tb = b * SEQ;
        const int nsel = min(256, t + 1), nch = (nsel + 31) >> 5;
        asm volatile("s_waitcnt vmcnt(0)" ::: "memory");
        unsigned koff[32];
#pragma unroll
        for (int q = 0; q < 32; ++q) { const int s_ = 8 * q + (lane >> 3); int idx = sl[s_]; idx = (t < 256) ? s_ : idx; idx = (s_ < nsel && (unsigned)idx <= (unsigned)t) ? idx : 0; koff[q] = (unsigned)idx * 256u + chunkoff; }
        i64x2 qf[2];
        { const unsigned char* qp = (const unsigned char*)Q + (size_t)tg * D + (4 * g + (fr >> 2)) * 128 + 16 * fq;
#pragma unroll
          for (int i = 0; i < 2; ++i) qf[i] = *(const i64x2*)(qp + 64 * i); }
        asm volatile("s_waitcnt vmcnt(0) lgkmcnt(0)" ::: "memory");
        asm volatile("" : "+v"(qf[0]), "+v"(qf[1]));
        { const int tn = task + wstride; if (tn < task_end) SEL_PREFETCH(xsplit ? tn : (tn >> 1)); }
        const unsigned char* kbase = (const unsigned char*)K + (size_t)tb * 256 + g * 128;
        const unsigned char* vbase = (const unsigned char*)V + (size_t)tb * 256 + g * 128;
#define CH_GATHER(cidx) do { const unsigned char* bp_ = ((cidx) < 16) ? kbase : vbase; _Pragma("unroll") for (int i_ = 0; i_ < 2; ++i_) { \
            unsigned o_ = koff[2 * ((cidx) & 15) + i_]; asm volatile("" : "+v"(o_));     \
            __builtin_amdgcn_global_load_lds((const unsigned*)(bp_ + o_), (LAS unsigned*)(vb + ((cidx) & 7) * 2048 + i_ * 1024 + lane * 16), 16, 0, 0); } } while (0)
        float lg[16];
#pragma unroll
        for (int c0 = 0; c0 < 6; ++c0) CH_GATHER(c0);
#pragma unroll
        for (int ch = 0; ch < 16; ++ch) {
            asm volatile("s_waitcnt lgkmcnt(0)" ::: "memory");
            CH_GATHER(ch + 6);
            asm volatile("s_waitcnt vmcnt(12)" ::: "memory");
            const LAS unsigned char* kb = vb + (ch & 7) * 2048;
            f32x4 acc = {0.f, 0.f, 0.f, 0.f};
#pragma unroll
            for (int i = 0; i < 2; ++i) { const i64x2 kf = *(const LAS i64x2*)(kb + 128u * fr + 16u * ((4u * i + fq) ^ ((unsigned)fr & 7u)));
                acc = __builtin_amdgcn_mfma_f32_16x16x32_fp8_fp8(qf[i].x, kf.x, acc, 0, 0, 0); acc = __builtin_amdgcn_mfma_f32_16x16x32_fp8_fp8(qf[i].y, kf.y, acc, 0, 0, 0); }
            lg[ch] = (ch * 16 + fr < nsel) ? acc.x * 0.08838834764831845f : -INFINITY;
        }
        float mx = lg[0];
#pragma unroll
        for (int kt = 1; kt < 16; ++kt) mx = fmaxf(mx, lg[kt]);
#pragma unroll
        for (int o = 1; o < 16; o <<= 1) mx = fmaxf(mx, __shfl_xor(mx, o));
        float sm = 0.f;
#pragma unroll
        for (int kt = 0; kt < 16; ++kt) { lg[kt] = __expf(lg[kt] - mx); sm += lg[kt]; }
#pragma unroll
        for (int o = 1; o < 16; o <<= 1) sm += __shfl_xor(sm, o);
        { const float inv = 256.f / sm;
#pragma unroll
          for (int kt = 0; kt < 16; ++kt) { const float pv = lg[kt] * inv; ((LAS unsigned char*)pT)[fq * 256 + kt * 16 + fr] = (unsigned char)(pk_fp8x4_nc(pv, pv, pv, pv) & 0xffu); } }
        f32x4 oacc[8];
#pragma unroll
        for (int c2 = 0; c2 < 8; ++c2) oacc[c2] = (f32x4){0.f, 0.f, 0.f, 0.f};
#pragma unroll
        for (int p = 0; p < 8; ++p) {
            asm volatile("s_waitcnt lgkmcnt(0)" ::: "memory");
            if (16 + 2 * p + 6 < 32) { CH_GATHER(16 + 2 * p + 6); CH_GATHER(16 + 2 * p + 7); }
            if (p < 5) asm volatile("s_waitcnt vmcnt(12)" ::: "memory"); else if (p == 5) asm volatile("s_waitcnt vmcnt(8)" ::: "memory");
            else if (p == 6) asm volatile("s_waitcnt vmcnt(4)" ::: "memory"); else asm volatile("s_waitcnt vmcnt(0)" ::: "memory");
            if (p < nch) {
                const long pa = *(const LAS long*)((const LAS unsigned char*)pT + (fr >> 2) * 256 + 32 * p + 8 * fq);
                const unsigned cb = vb_addr + (unsigned)(((16 + 2 * p) & 7) + (fq >> 1)) * 2048u;
                unsigned ad[8]; s16x4 r0[8];
#pragma unroll
                for (int i = 0; i < 8; ++i) ad[i] = cb + trh[i];
                tr_read8_b8(ad, r0);
#pragma unroll
                for (int c2 = 0; c2 < 8; ++c2) oacc[c2] = __builtin_amdgcn_mfma_f32_16x16x32_fp8_fp8(pa, __builtin_bit_cast(long, r0[c2]), oacc[c2], 0, 0, 0);
            }
        }
        { unsigned char* op = (unsigned char*)O + (size_t)tg * D + (4 * g + fq) * 128 + fr;
#pragma unroll
          for (int c2 = 0; c2 < 8; ++c2) { const float ov = oacc[c2].x * (O8_SCALE / 256.f); op[16 * c2] = (unsigned char)(pk_fp8x4(ov, ov, ov, ov) & 0xffu); } }
        LDS_WAIT();
#undef CH_GATHER
        ++tcount;
    }
}

__device__ __forceinline__ void phase_b4(const Ctx& c, bool dry = false) {
    bf16_t* H = (bf16_t*)(c.ws + WS_H);
    pg8::Gemm g{(const pg8::bf16_t*)(c.ws + WS_O), (const pg8::bf16_t*)(c.ws + WS_WBOUT), T, D, D / 2};
    pg8::StaticOrder S; S.init(T, D, (int)gridDim.x, (int)blockIdx.x);
    EpiResH<false> E{H, dry ? (bf16_t*)(c.ws + 440 * MB) : H, 1.f / (W8_SCALE * O8_SCALE)};
    pg8::gemm_phase<EpiResH<false>, pg8::StaticOrder, true, true, true>(c.ldsp, g, S, E);
}

constexpr int NPHASE = 22;
__global__ void __launch_bounds__(NTHP, 2) mk_fwd(Args args) {
    extern __shared__ __attribute__((aligned(16))) unsigned char lds_raw[];
    Ctx c;
    { const int pt = threadIdx.x; c.half = __builtin_amdgcn_readfirstlane(pt >> 8); c.tid = pt & 255; c.lane = pt & 63; c.wave = __builtin_amdgcn_readfirstlane(pt >> 6) & 3; }
    c.ldsp = (LAS unsigned char*)lds_raw; c.lds = c.ldsp + c.half * LDS_HALF;
    c.nb = 2 * gridDim.x; { const int bx = blockIdx.x, G = gridDim.x; c.vb = 2 * ((G % 8 == 0) ? (bx % 8) * (G / 8) + bx / 8 : bx) + c.half; }
    c.a = (const __attribute__((address_space(4))) Args*)__builtin_amdgcn_kernarg_segment_ptr(); c.ws = args.ws;
    volatile LAS unsigned* st = (volatile LAS unsigned*)((LAS unsigned char*)lds_raw + LDS_BYTES - 16);
    const bool multi = (args.ph_hi - args.ph_lo) > 1;
    XcdBarrier bar; bar.bar = (unsigned*)(c.ws + WS_CTL); bar.x = 0; bar.st = st;
    if (multi) {
        if (threadIdx.x == 0) { st[0] = 0u; st[1] = 0u; }
        __syncthreads();
        bar = xcd_barrier_post((unsigned*)(c.ws + WS_CTL), st);
    }
    const int ph_lo = args.ph_lo, ph_hi = args.ph_hi;
#ifndef PH_MASK
#define PH_MASK 0x3fffff
#endif
#define PHON(k) ((PH_MASK >> (k)) & 1)
#define PHASE(k, body) do { if (PHON(k) && ph_lo <= (k) && (k) < ph_hi) { \
        { int t_ = threadIdx.x, vb_ = __builtin_amdgcn_readfirstlane(c.vb); \
          const __attribute__((address_space(4))) Args* ka = (const __attribute__((address_space(4))) Args*)__builtin_amdgcn_kernarg_segment_ptr(); \
          asm volatile("" : "+v"(t_), "+s"(vb_), "+s"(ka)); \
          c.tid = t_ & 255; c.lane = t_ & 63; c.wave = __builtin_amdgcn_readfirstlane(t_ >> 6) & 3; c.vb = vb_; c.a = ka; c.ws = ka->ws; } \
        body; \
        if (MK_REP == (k)) { __syncthreads(); body; } \
        if ((k) + 1 < ph_hi) xcd_barrier(bar); \
        if ((k) == 3) { for (int xb_ = 0; xb_ < MK_XBAR; ++xb_) xcd_barrier(bar); } } } while (0)
    PHASE(0, phase_prep(c));
    PHASE(1, phase_a1(c));
    PHASE(2, { if (MK_DRY == 2) { phase_a2(c, true); __syncthreads(); } phase_a2(c); });
    PHASE(3, phase_a3(c));
    PHASE(4, { if (MK_DRY == 4) { phase_route(c, 0, true); __syncthreads(); } phase_route(c, 0); });
    PHASE(5, phase_e1(c, 0));
    PHASE(6, phase_e2(c, 0));
    PHASE(7, { if (MK_DRY == 7) { phase_p1(c, 0, true); __syncthreads(); } phase_p1(c, 0); });
    PHASE(8, { if (MK_DRY == 8) { phase_p2(c, 0, true); __syncthreads(); } phase_p2(c, 0); });
    PHASE(10, phase_b1(c));
    PHASE(12, phase_score(c));
    PHASE(13, phase_select(c));
    PHASE(14, phase_attn(c));
    PHASE(15, { if (MK_DRY == 15) { phase_b4(c, true); __syncthreads(); } phase_b4(c); });
    PHASE(16, phase_route(c, 1));
    PHASE(17, phase_e1(c, 1));
    PHASE(18, phase_e2(c, 1));
    PHASE(19, phase_p1(c, 1));
    PHASE(20, phase_p2(c, 1));
    PHASE(21, phase_final(c));
}

#ifdef MK_DUMP
__global__ void dump_k(const unsigned char* ws, float* out) {
    const size_t i = (size_t)blockIdx.x * 256 + threadIdx.x;
#if MK_DUMP == 1
    ((f32x4*)out)[i] = ((const f32x4*)(ws + WS_H))[i];
#elif MK_DUMP == 2
    { const u32x2 v = ((const u32x2*)(ws + WS_O))[i]; f32x4 o = {bf_lo(v.x), bf_hi(v.x), bf_lo(v.y), bf_hi(v.y)}; ((f32x4*)out)[i] = o; }
#elif MK_DUMP == 3
    { const int* sp = (const int*)(ws + WS_SEL); f32x4 o = {0.f,0.f,0.f,0.f}; if (i < (size_t)T * 64) { o.x = (float)sp[4*i]; o.y = (float)sp[4*i+1]; o.z = (float)sp[4*i+2]; o.w = (float)sp[4*i+3]; } ((f32x4*)out)[i] = o; }
#elif MK_DUMP == 5
    { const u32x2 v = ((const u32x2*)(ws + WS_XN))[i]; f32x4 o = {bf_lo(v.x), bf_hi(v.x), bf_lo(v.y), bf_hi(v.y)}; ((f32x4*)out)[i] = o; }
#elif MK_DUMP == 6
    { const u32x2 v = ((const u32x2*)(ws + WS_RAW))[i]; f32x4 o = {bf_lo(v.x), bf_hi(v.x), bf_lo(v.y), bf_hi(v.y)}; ((f32x4*)out)[i] = o; }
#elif MK_DUMP == 7
    { f32x4 o = {0.f,0.f,0.f,0.f}; if (i < (size_t)BINP * D / 4) { const u32x2 v = ((const u32x2*)(ws + WS_WBIN))[i]; o = (f32x4){bf_lo(v.x), bf_hi(v.x), bf_lo(v.y), bf_hi(v.y)}; } ((f32x4*)out)[i] = o; }
#elif MK_DUMP == 8
    { const u32x2 v = ((const u32x2*)(ws + WS_RAW))[i], w = ((const u32x2*)(ws + 458 * MB))[i]; f32x4 o = {bf_lo(v.x) - bf_lo(w.x), bf_hi(v.x) - bf_hi(w.x), bf_lo(v.y) - bf_lo(w.y), bf_hi(v.y) - bf_hi(w.y)}; ((f32x4*)out)[i] = o; }
#elif MK_DUMP == 9
    { const u32x2 v = ((const u32x2*)(ws + WS_RAW))[i], w = ((const u32x2*)(ws + 458 * MB))[i]; f32x4 o = {(v.x & 0xffffu) != (w.x & 0xffffu) ? 1.f : 0.f, (v.x >> 16) != (w.x >> 16) ? 1.f : 0.f, (v.y & 0xffffu) != (w.y & 0xffffu) ? 1.f : 0.f, (v.y >> 16) != (w.y >> 16) ? 1.f : 0.f}; ((f32x4*)out)[i] = o; }
#elif MK_DUMP == 4
    { const u32x2 v = ((const u32x2*)(ws + WS_Q))[i]; f32x4 o = {bf_lo(v.x), bf_hi(v.x), bf_lo(v.y), bf_hi(v.y)}; ((f32x4*)out)[i] = o; }
#endif
}
#endif
extern "C" void kernel_launch(void* const* d_in, const int* in_sizes, int n_in, void* d_out, int out_size, void* d_ws, size_t ws_size, hipStream_t stream) {
    static int grid = 0;
    if (grid == 0) {
        if (n_in != 23 || out_size != T * D || ws_size < WS_TOTAL) { fprintf(stderr, "kernel_launch: unexpected sizes n_in %d out %d ws %zu (need %zu)\n", n_in, out_size, ws_size, (size_t)WS_TOTAL); grid = -1; return; }
        int dev = 0, cus = 0, per_cu = 0;
        hipGetDevice(&dev); hipDeviceGetAttribute(&cus, hipDeviceAttributeMultiprocessorCount, dev);
        hipFuncSetAttribute((const void*)mk_fwd, hipFuncAttributeMaxDynamicSharedMemorySize, LDS_BYTES);
        hipOccupancyMaxActiveBlocksPerMultiprocessor(&per_cu, (const void*)mk_fwd, NTHP, LDS_BYTES);
        (void)hipGetLastError();
        if (per_cu < 1) per_cu = 1;
        if (per_cu > 1) per_cu = 1;
        grid = cus * per_cu;
    }
    if (grid < 0) return;
    hipMemsetAsync((char*)d_ws + WS_CTL, 0, 16384, stream);
    Args a{};
    for (int i = 0; i < 23; ++i) a.in[i] = d_in[i];
    a.out = (float*)d_out; a.ws = (unsigned char*)d_ws;
#if MK_ONE_LAUNCH
    a.ph_lo = 0; a.ph_hi = NPHASE;
    hipLaunchKernelGGL(mk_fwd, dim3(grid), dim3(NTHP), LDS_BYTES, stream, a);
#else
    for (int ph = 0; ph <= MK_LAST_PHASE; ++ph) { a.ph_lo = ph; a.ph_hi = ph + 1; hipLaunchKernelGGL(mk_fwd, dim3(grid), dim3(NTHP), LDS_BYTES, stream, a); }
#ifdef MK_DUMP
    hipLaunchKernelGGL(dump_k, dim3(T * D / 4 / 256), dim3(256), 0, stream, (const unsigned char*)d_ws, (float*)d_out);
#endif
#endif
}
```
